# Optimizing an MI355X kernel written in HIP

```python
import jax
import jax.numpy as jnp
from jax import lax
import numpy as np

D_MODEL = 1024
BATCH = 16
SEQ = 2048
DEPTH = 1

N_META = 16
CHUNK = 64
N_PAD = CHUNK - N_META
EPS = 1e-6

HG_HEADS = 4
HG_EXPAND = 128
HG_VDIM = 128
HG_FDIM = HG_HEADS * HG_EXPAND
HG_WIDTH = HG_HEADS * HG_VDIM

ML_HEADS = 4
ML_QKDIM = 64
ML_VDIM = 128
ML_WIDTH = ML_HEADS * ML_VDIM
ML_CONV = 4

N_BRANCH = 2
IN_SPLITS = (
    HG_FDIM,
    2 * HG_FDIM,
    2 * HG_FDIM + HG_WIDTH,
    2 * HG_FDIM + 2 * HG_WIDTH,
    2 * HG_FDIM + 2 * HG_WIDTH + ML_WIDTH,
    2 * HG_FDIM + 2 * HG_WIDTH + 2 * ML_WIDTH,
    2 * HG_FDIM + 2 * HG_WIDTH + 2 * ML_WIDTH + 2 * ML_HEADS,
)
IN_TOTAL = IN_SPLITS[-1] + N_BRANCH * D_MODEL

N_EXPERTS = 32
TOP_K = 4
D_FF = 1024
SWIGLU_LIMIT = 7.0
SWIGLU_ALPHA = 1.702
MOE_BLOCK = 128

kernel_name = 'hybrid_hgrn2_mlstm_moe'


def _rms(x):
    xf = x.astype(jnp.float32)
    y = xf * lax.rsqrt(jnp.mean(xf * xf, axis=-1, keepdims=True) + EPS)
    return y.astype(x.dtype)


def rmsnorm(x, w):
    return _rms(x) * w


def head_rmsnorm(o, w):
    b, t, h, d = o.shape
    return _rms(o).reshape(b, t, h * d) * w


def to_chunks(a):
    b, t = a.shape[:2]
    a = a.reshape((b, t // CHUNK, CHUNK) + a.shape[2:])
    perm = (1, 0, 3, 2) + tuple(range(4, a.ndim))
    return a.transpose(perm)


def from_chunks(o):
    nc, b, h, l, d = o.shape
    return o.transpose(1, 0, 3, 2, 4).reshape(b, nc * l, h, d)


def causal_depthwise_conv(u, w, bias):
    c = u.shape[-1]
    y = lax.conv_general_dilated(
        u, w[:, None, :].astype(u.dtype), window_strides=(1,),
        padding=[(ML_CONV - 1, 0)], dimension_numbers=('NWC', 'WIO', 'NWC'),
        feature_group_count=c)
    return y + bias


def hgrn2_chunkwise(q, k, v, log_f):
    f32 = jnp.float32
    qc, kc, vc, gc = (to_chunks(a.astype(f32)) for a in (q, k, v, log_f))
    cum = jnp.cumsum(gc, axis=-2)
    causal = jnp.tril(jnp.ones((CHUNK, CHUNK), bool))[:, :, None]

    def step(state, inp):
        q_, k_, v_, b_ = inp
        diff = b_[..., :, None, :] - b_[..., None, :, :]
        decay = jnp.exp(jnp.where(causal, diff, -jnp.inf))
        scores = jnp.einsum('bhtd,bhsd,bhtsd->bhts', q_, k_, decay)
        o = (jnp.einsum('bhts,bhsv->bhtv', scores, v_)
             + jnp.einsum('bhtd,bhdv->bhtv', q_ * jnp.exp(b_), state))
        b_last = b_[..., -1:, :]
        new_state = (jnp.exp(b_last[..., 0, :])[..., None] * state
                     + jnp.einsum('bhsd,bhsv->bhdv', k_ * jnp.exp(b_last - b_), v_))
        return new_state, o

    bsz, _, heads, dk = q.shape
    state0 = jnp.zeros((bsz, heads, dk, v.shape[-1]), f32)
    _, o = lax.scan(step, state0, (qc, kc, vc, cum))
    return from_chunks(o)


def mlstm_chunkwise(q, k, v, log_i, log_f):
    f32 = jnp.float32
    dk = q.shape[-1]
    qc, kc, vc = (to_chunks(a.astype(f32)) for a in (q * (dk ** -0.5), k, v))
    ic, fc = (to_chunks(a.astype(f32)) for a in (log_i, log_f))
    cum = jnp.cumsum(fc, axis=-1)
    causal = jnp.tril(jnp.ones((CHUNK, CHUNK), bool))

    def step(carry, inp):
        s, n, m = carry
        q_, k_, v_, li, b_ = inp
        d = jnp.where(causal, b_[..., :, None] - b_[..., None, :] + li[..., None, :], -jnp.inf)
        a = b_ + m[..., None]
        m_t = jnp.maximum(a, jnp.max(d, axis=-1))
        w_intra = jnp.exp(d - m_t[..., None])
        w_inter = jnp.exp(a - m_t)
        qk = jnp.einsum('bhtd,bhsd->bhts', q_, k_) * w_intra
        num = (jnp.einsum('bhts,bhsv->bhtv', qk, v_)
               + w_inter[..., None] * jnp.einsum('bhtd,bhdv->bhtv', q_, s))
        den = jnp.sum(qk, axis=-1) + w_inter * jnp.einsum('bhtd,bhd->bht', q_, n)
        h = num / jnp.maximum(jnp.abs(den), jnp.exp(-m_t))[..., None]
        g_last = b_[..., -1]
        e = g_last[..., None] - b_ + li
        m_new = jnp.maximum(g_last + m, jnp.max(e, axis=-1))
        w_s = jnp.exp(e - m_new[..., None])
        w_p = jnp.exp(g_last + m - m_new)
        s_new = w_p[..., None, None] * s + jnp.einsum('bhs,bhsd,bhsv->bhdv', w_s, k_, v_)
        n_new = w_p[..., None] * n + jnp.einsum('bhs,bhsd->bhd', w_s, k_)
        return (s_new, n_new, m_new), h

    bsz, _, heads, _ = q.shape
    carry0 = (jnp.zeros((bsz, heads, dk, v.shape[-1]), f32),
              jnp.zeros((bsz, heads, dk), f32),
              jnp.zeros((bsz, heads), f32))
    _, h = lax.scan(step, carry0, (qc, kc, vc, ic, cum))
    return from_chunks(h)


def moe_ffn(xn, router_w, router_b, w_gu, b_gu, w_dn, b_dn):
    bsz, t, d = xn.shape
    n_tok = bsz * t
    xt = xn.reshape(n_tok, d)
    logits = (xt @ router_w + router_b).astype(jnp.float32)
    top_v, top_e = lax.top_k(logits, TOP_K)
    gate_w = jax.nn.softmax(top_v, axis=-1)
    n_assign = n_tok * TOP_K
    e_flat = top_e.reshape(n_assign).astype(jnp.int32)
    tok_flat = jnp.arange(n_assign, dtype=jnp.int32) // TOP_K
    w_flat = gate_w.reshape(n_assign)
    order = jnp.argsort(e_flat)
    e_sorted = e_flat[order]
    tok_sorted = tok_flat[order]
    w_sorted = w_flat[order]
    counts = jnp.bincount(e_flat, length=N_EXPERTS).astype(jnp.int32)
    starts = jnp.cumsum(counts) - counts
    padded = ((counts + MOE_BLOCK - 1) // MOE_BLOCK) * MOE_BLOCK
    pend = jnp.cumsum(padded)
    pstart = pend - padded
    dest = pstart[e_sorted] + (jnp.arange(n_assign, dtype=jnp.int32) - starts[e_sorted])
    n_blocks = -(-n_assign // MOE_BLOCK) + N_EXPERTS
    n_rows = n_blocks * MOE_BLOCK
    row_tok = jnp.full((n_rows,), n_tok, jnp.int32).at[dest].set(tok_sorted)
    row_w = jnp.zeros((n_rows,), jnp.float32).at[dest].set(w_sorted)
    block_e = jnp.minimum(
        jnp.searchsorted(pend, jnp.arange(n_blocks, dtype=jnp.int32) * MOE_BLOCK, side='right'),
        N_EXPERTS - 1)
    x_pad = jnp.concatenate([xt, jnp.zeros((1, d), xt.dtype)], axis=0)
    xb = x_pad[row_tok].reshape(n_blocks, MOE_BLOCK, d)

    def expert_block(args):
        xblk, e = args
        gu = xblk @ w_gu[e] + b_gu[e]
        gate = jnp.minimum(gu[:, 0::2], SWIGLU_LIMIT)
        up = jnp.clip(gu[:, 1::2], -SWIGLU_LIMIT, SWIGLU_LIMIT)
        act = (up + 1.0) * gate * jax.nn.sigmoid(SWIGLU_ALPHA * gate)
        return act @ w_dn[e] + b_dn[e]

    yb = lax.map(expert_block, (xb, block_e)).reshape(n_rows, d)
    y = jnp.zeros((n_tok + 1, d), jnp.float32).at[row_tok].add(
        yb.astype(jnp.float32) * row_w[:, None])
    return y[:n_tok].reshape(bsz, t, d).astype(xn.dtype)


def setup_inputs(seed: int = 0) -> dict:
    key = jax.random.key(seed)
    ks = jax.random.split(key, 32)
    f32 = jnp.float32

    def nrm(k, shape, scale):
        return jax.random.normal(k, shape, f32) * scale

    def gain(k, shape):
        return 1.0 + 0.02 * jax.random.normal(k, shape, f32)

    ml_gate_b = jnp.concatenate([
        nrm(ks[10], (DEPTH, ML_HEADS), 0.1),
        jnp.linspace(3.0, 6.0, ML_HEADS, dtype=f32)[None, :] + nrm(ks[11], (DEPTH, ML_HEADS), 0.1),
    ], axis=-1)
    return {
        'x': nrm(ks[0], (BATCH, SEQ, D_MODEL), 1.0),
        'meta_tokens': nrm(ks[1], (N_META, D_MODEL), 1.0),
        'hg_lb_logits': nrm(ks[2], (DEPTH + 1, HG_FDIM), 0.5),
        'norm_mix': gain(ks[3], (DEPTH, D_MODEL)),
        'w_in': nrm(ks[4], (DEPTH, D_MODEL, IN_TOTAL), D_MODEL ** -0.5),
        'hg_norm': gain(ks[5], (DEPTH, HG_WIDTH)),
        'ml_conv_w': nrm(ks[6], (DEPTH, ML_CONV, ML_WIDTH), ML_CONV ** -0.5),
        'ml_conv_b': nrm(ks[7], (DEPTH, ML_WIDTH), 0.01),
        'ml_wq': nrm(ks[8], (DEPTH, ML_HEADS, ML_VDIM, ML_QKDIM), ML_VDIM ** -0.5),
        'ml_wk': nrm(ks[9], (DEPTH, ML_HEADS, ML_VDIM, ML_QKDIM), ML_VDIM ** -0.5),
        'ml_wv': nrm(ks[12], (DEPTH, ML_HEADS, ML_VDIM, ML_VDIM), ML_VDIM ** -0.5),
        'ml_gate_b': ml_gate_b,
        'ml_norm': gain(ks[13], (DEPTH, ML_WIDTH)),
        'ml_skip': gain(ks[14], (DEPTH, ML_WIDTH)),
        'w_branch_hg': nrm(ks[15], (DEPTH, HG_WIDTH, D_MODEL), HG_WIDTH ** -0.5),
        'w_branch_ml': nrm(ks[16], (DEPTH, ML_WIDTH, D_MODEL), ML_WIDTH ** -0.5),
        'w_out': nrm(ks[17], (DEPTH, D_MODEL, D_MODEL), D_MODEL ** -0.5),
        'norm_ffn': gain(ks[18], (DEPTH, D_MODEL)),
        'router_w': nrm(ks[19], (DEPTH, D_MODEL, N_EXPERTS), D_MODEL ** -0.5),
        'router_b': nrm(ks[20], (DEPTH, N_EXPERTS), 0.01),
        'exp_w_gu': nrm(ks[21], (DEPTH, N_EXPERTS, D_MODEL, 2 * D_FF), D_MODEL ** -0.5),
        'exp_b_gu': nrm(ks[22], (DEPTH, N_EXPERTS, 2 * D_FF), 0.01),
        'exp_w_down': nrm(ks[23], (DEPTH, N_EXPERTS, D_FF, D_MODEL), D_FF ** -0.5),
        'exp_b_down': nrm(ks[24], (DEPTH, N_EXPERTS, D_MODEL), 0.01),
        'norm_final': gain(ks[25], (D_MODEL,)),
    }


def reference(x, meta_tokens, hg_lb_logits, norm_mix, w_in, hg_norm, ml_conv_w, ml_conv_b,
              ml_wq, ml_wk, ml_wv, ml_gate_b, ml_norm, ml_skip, w_branch_hg, w_branch_ml,
              w_out, norm_ffn, router_w, router_b, exp_w_gu, exp_b_gu, exp_w_down,
              exp_b_down, norm_final):
    f32 = jnp.float32
    bsz = x.shape[0]
    dt = x.dtype
    h = jnp.concatenate([
        jnp.zeros((bsz, N_PAD, D_MODEL), dt),
        jnp.broadcast_to(meta_tokens.astype(dt)[None], (bsz, N_META, D_MODEL)),
        x,
    ], axis=1)
    t = h.shape[1]
    valid = (jnp.arange(t) >= N_PAD)[None, :, None]
    lower_bounds = jnp.cumsum(jax.nn.softmax(hg_lb_logits.astype(f32), axis=0), axis=0)

    for l in range(DEPTH):
        xn = rmsnorm(h, norm_mix[l])
        proj = xn @ w_in[l]
        hq, hf, hi, hg, mm, mo, mif, gates = jnp.split(proj, IN_SPLITS, axis=-1)

        lb = lower_bounds[l]
        f = lb + (1.0 - lb) * jax.nn.sigmoid(hf.astype(f32))
        f = jnp.where(valid, f, 1.0)
        q_h = jax.nn.silu(hq).reshape(bsz, t, HG_HEADS, HG_EXPAND)
        k_h = (1.0 - f).reshape(bsz, t, HG_HEADS, HG_EXPAND)
        logf_h = jnp.log(f).reshape(bsz, t, HG_HEADS, HG_EXPAND)
        v_h = hi.reshape(bsz, t, HG_HEADS, HG_VDIM)
        o_h = hgrn2_chunkwise(q_h, k_h, v_h, logf_h).astype(dt)
        y_hg = head_rmsnorm(o_h, hg_norm[l]) * jax.nn.silu(hg)

        mm = jnp.where(valid, mm, 0.0)
        c = jax.nn.silu(causal_depthwise_conv(mm, ml_conv_w[l], ml_conv_b[l]))
        ch = c.reshape(bsz, t, ML_HEADS, ML_VDIM)
        mh = mm.reshape(bsz, t, ML_HEADS, ML_VDIM)
        q_m = jnp.einsum('bthc,hcd->bthd', ch, ml_wq[l])
        k_m = jnp.einsum('bthc,hcd->bthd', ch, ml_wk[l])
        v_m = jnp.einsum('bthc,hcd->bthd', mh, ml_wv[l])
        gi, gf = jnp.split(mif.astype(f32) + ml_gate_b[l].astype(f32), 2, axis=-1)
        log_i = jnp.where(valid, gi, -jnp.inf)
        log_fm = jnp.where(valid, jax.nn.log_sigmoid(gf), 0.0)
        o_m = mlstm_chunkwise(q_m, k_m, v_m, log_i, log_fm).astype(dt)
        y_ml = (head_rmsnorm(o_m, ml_norm[l]) + ml_skip[l] * c) * jax.nn.sigmoid(mo)

        g = jax.nn.sigmoid(gates).reshape(bsz, t, N_BRANCH, D_MODEL)
        merged = g[:, :, 0] * (y_hg @ w_branch_hg[l]) + g[:, :, 1] * (y_ml @ w_branch_ml[l])
        h = h + merged @ w_out[l]

        ffn_out = moe_ffn(rmsnorm(h[:, N_PAD:], norm_ffn[l]), router_w[l], router_b[l],
                          exp_w_gu[l], exp_b_gu[l], exp_w_down[l], exp_b_down[l])
        h = h.at[:, N_PAD:].add(ffn_out)

    return rmsnorm(h[:, N_PAD + N_META:], norm_final)
```

```cpp
#include <hip/hip_runtime.h>
#include <cstdio>
#include <cstdint>
namespace pg8 {
#define PG8_LAS __attribute__((address_space(3)))
typedef unsigned short bf16_t;
typedef short bf16x8 __attribute__((ext_vector_type(8)));
typedef float f32x4 __attribute__((ext_vector_type(4)));
typedef unsigned u32x4 __attribute__((ext_vector_type(4)));
constexpr int BM = 256, BK = 64, HALF = 128, HTB = HALF * BK * 2  , STAGE_BYTES = 8 * HTB, NXCD = 8, WGM = 8;

__host__ __device__ __forceinline__ int lds_byte(int r, int c) { const int st = (r >> 4) * 2 + (c >> 5), rr = r & 15, cc = c & 31, ob = rr * 64 + cc * 2; return st * 1024 + (ob ^ (((ob >> 9) & 1) << 5)); }
__host__ __device__ __forceinline__ void stage_rc(int b, int& R, int& C) { const int st = b / 1024, sb = b % 1024, swz = sb ^ (((sb >> 9) & 1) << 5); R = (st >> 1) * 16 + swz / 64; C = (st & 1) * 32 + (swz % 64) / 2; }
__host__ __device__ __forceinline__ int perm32(int rho) { const int n = rho >> 4, i = rho & 15; return 8 * (i >> 2) + 4 * n + (i & 3); }

struct Unit { int pm, pn; };
struct Gemm { const bf16_t* A; const bf16_t* Bt; int M, N, K; };

struct StaticOrder {
    int nM, nN, nwg, G, c;
    __host__ __device__ void init(int M, int N, int G_, int c_) { nM = M / BM; nN = N / BM; nwg = nM * nN; G = G_; c = c_; }
    __host__ __device__ __forceinline__ bool next(int i, Unit& u) const {
        const long L = (long)i * G + c; if (L >= nwg) return false;
        int wgid = (int)L; { const int q = nwg / NXCD, r = nwg % NXCD, xcd = wgid % NXCD, off = wgid / NXCD; wgid = (xcd < r ? xcd * (q + 1) : r * (q + 1) + (xcd - r) * q) + off; }
        const int nig = WGM * nN, gid = wgid / nig, fm = gid * WGM, gsz = (nM - fm) < WGM ? (nM - fm) : WGM;
        u.pm = fm + ((wgid % nig) % gsz); u.pn = (wgid % nig) / gsz; return true;
    }
    __device__ __forceinline__ void a_ready(const Unit&) const {}
    __device__ __forceinline__ void done(const Unit&) const {}
};

typedef __bf16 bf16v2 __attribute__((ext_vector_type(2)));
typedef float f32v2 __attribute__((ext_vector_type(2)));
__device__ __forceinline__ unsigned cvt_pk_bf16(float lo, float hi) { const f32v2 v = {lo, hi}; return __builtin_bit_cast(unsigned, __builtin_convertvector(v, bf16v2)); }
typedef float f32x2 __attribute__((ext_vector_type(2)));
typedef int i32x4 __attribute__((ext_vector_type(4)));
typedef int i32x8 __attribute__((ext_vector_type(8)));
__device__ __forceinline__ i32x8 cat8(const bf16x8 a, const bf16x8 b) { const i32x4 x = __builtin_bit_cast(i32x4, a), y = __builtin_bit_cast(i32x4, b); return __builtin_shufflevector(x, y, 0, 1, 2, 3, 4, 5, 6, 7); }
template <class Epi, class Sched, bool ALIGN_EPI = false, bool SP2 = false, bool FP8 = false>
__device__ __forceinline__ void gemm_phase(PG8_LAS unsigned char* lds, const Gemm g, const Sched& S, const Epi& E) {
    const int tid = threadIdx.x, wid = __builtin_amdgcn_readfirstlane(tid >> 6), lane = tid & 63, wr = wid >> 2, wc = wid & 3, fr = lane & 15, fq = lane >> 4;
    const int K = g.K, nt = K / BK;
    unsigned voffA[2], voffB[2];
#pragma unroll
    for (int i = 0; i < 2; ++i) { int R, C; stage_rc(tid * 16 + i * 8192, R, C); const int Rb = Epi::PERM ? ((R & ~31) + perm32(R & 31)) : R;
        voffA[i] = (unsigned)(R * K + C) * 2u; voffB[i] = (unsigned)(Rb * K + C) * 2u; }
    const size_t kstep = (size_t)(BK * 2);
    const size_t hstep = (size_t)HALF * K * 2;
    const size_t tstep = 2 * hstep;
    const unsigned ldsw = (unsigned)wid * 1024u;
    const int aoff = lds_byte(wr * 64 + fr, fq * 8), boff = lds_byte(wc * 32 + fr, fq * 8);
#define PG8_SA(b, h) (((b) * 2 + (h)) * HTB)
#define PG8_SB(b, h) ((4 + (b) * 2 + (h)) * HTB)
#define PG8_STAGE(bufoff, gbase, voff) do { _Pragma("unroll") for (int _i = 0; _i < 2; ++_i) \
        __builtin_amdgcn_global_load_lds((const unsigned*)((const char*)(gbase) + (voff)[_i]), (PG8_LAS unsigned*)(lds + (bufoff) + ldsw + _i * 8192), 16, 0, 0); } while (0)
#define PG8_LDA(dst, b, h) do { _Pragma("unroll") for (int m = 0; m < 4; ++m) { if constexpr (FP8) dst##8[m] = cat8(*(const PG8_LAS bf16x8*)(lds + PG8_SA(b, h) + aoff + m * 2048), *(const PG8_LAS bf16x8*)(lds + PG8_SA(b, h) + aoff + m * 2048 + 1024)); \
        else { _Pragma("unroll") for (int k = 0; k < 2; ++k) dst[m][k] = *(const PG8_LAS bf16x8*)(lds + PG8_SA(b, h) + aoff + m * 2048 + k * 1024); } } } while (0)
#define PG8_LDB(dst, b, h) do { _Pragma("unroll") for (int n = 0; n < 2; ++n) { if constexpr (FP8) dst##8[n] = cat8(*(const PG8_LAS bf16x8*)(lds + PG8_SB(b, h) + boff + n * 2048), *(const PG8_LAS bf16x8*)(lds + PG8_SB(b, h) + boff + n * 2048 + 1024)); \
        else { _Pragma("unroll") for (int k = 0; k < 2; ++k) dst[n][k] = *(const PG8_LAS bf16x8*)(lds + PG8_SB(b, h) + boff + n * 2048 + k * 1024); } } } while (0)
#define PG8_MMA(ai, bj, At, Bt) do { __builtin_amdgcn_s_setprio(1); _Pragma("unroll") for (int m = 0; m < 4; ++m) _Pragma("unroll") for (int n = 0; n < 2; ++n) { \
        if constexpr (FP8) acc[ai][bj][m][n] = __builtin_amdgcn_mfma_scale_f32_16x16x128_f8f6f4(Bt##8[n], At##8[m], acc[ai][bj][m][n], 0, 0, 0, 0x7f7f7f7f, 0, 0x7f7f7f7f); \
        else { _Pragma("unroll") for (int k = 0; k < 2; ++k) acc[ai][bj][m][n] = __builtin_amdgcn_mfma_f32_16x16x32_bf16(Bt[n][k], At[m][k], acc[ai][bj][m][n], 0, 0, 0); } } \
        if constexpr (FP8) { _Pragma("unroll") for (int m = 0; m < 4; ++m) _Pragma("unroll") for (int n = 0; n < 2; ++n) asm volatile("" : "+v"(acc[ai][bj][m][n])); }     \
        __builtin_amdgcn_s_setprio(0); } while (0)
#define PG8_WAIT_V(n) asm volatile("s_waitcnt vmcnt(" #n ")" ::: "memory")
#define PG8_WAIT_V8_UNLESS(flag) asm volatile("s_cmp_lg_u32 %0, 0\n\ts_cbranch_scc1 .Lskw%=\n\ts_waitcnt vmcnt(8)\n.Lskw%=:" :: "s"(__builtin_amdgcn_readfirstlane(flag)) : "memory", "scc")
#define PG8_WAIT_L(n) asm volatile("s_waitcnt lgkmcnt(" #n ")" ::: "memory")
#define PG8_BAR __builtin_amdgcn_s_barrier()
#define PG8_SCHED __builtin_amdgcn_sched_barrier(0)
    Unit cur, nxt; int ui = 0;
    if (!S.next(0, cur)) return;
    f32x4 acc[2][2][4][2];
#pragma unroll
    for (int a = 0; a < 2; ++a)
#pragma unroll
        for (int b = 0; b < 2; ++b)
#pragma unroll
            for (int m = 0; m < 4; ++m)
#pragma unroll
                for (int n = 0; n < 2; ++n) acc[a][b][m][n] = (f32x4){0.f, 0.f, 0.f, 0.f};
    bf16x8 At[4][2], B0[2][2], B1[2][2]; i32x8 At8[4], B08[2], B18[2];
    const char* cA = (const char*)g.A + (size_t)cur.pm * tstep; const char* cB = (const char*)g.Bt + (size_t)cur.pn * tstep;
    S.a_ready(cur);
    if constexpr (SP2) {
        PG8_STAGE(PG8_SB(0, 0), cB, voffB); PG8_STAGE(PG8_SB(0, 1), cB + hstep, voffB); PG8_STAGE(PG8_SA(0, 0), cA, voffA); PG8_STAGE(PG8_SA(0, 1), cA + hstep, voffA);
        if (wr == 1) PG8_BAR;
        PG8_WAIT_V(2); PG8_BAR;
        PG8_STAGE(PG8_SB(1, 0), cB + kstep, voffB); PG8_STAGE(PG8_SA(1, 0), cA + kstep, voffA); PG8_STAGE(PG8_SB(1, 1), cB + hstep + kstep, voffB);
        PG8_WAIT_V(6); PG8_BAR;
    } else {
        PG8_STAGE(PG8_SB(0, 0), cB, voffB); PG8_STAGE(PG8_SA(0, 0), cA, voffA); PG8_STAGE(PG8_SB(0, 1), cB + hstep, voffB); PG8_STAGE(PG8_SA(0, 1), cA + hstep, voffA);
        if (wr == 1) PG8_BAR;
        PG8_WAIT_V(4); PG8_BAR;
        PG8_STAGE(PG8_SB(1, 0), cB + kstep, voffB); PG8_STAGE(PG8_SA(1, 0), cA + kstep, voffA); PG8_STAGE(PG8_SB(1, 1), cB + hstep + kstep, voffB);
        PG8_WAIT_V(6); PG8_BAR;
    }
    for (;;) {
        const bool has_next = S.next(ui + 1, nxt);
        const char* nA = has_next ? (const char*)g.A + (size_t)nxt.pm * tstep : cA; const char* nB = has_next ? (const char*)g.Bt + (size_t)nxt.pn * tstep : cB;
        for (int t = 0; t < nt; t += 2) {
            const bool last = (t == nt - 2);
            const int skipw = (SP2 && ui > 0 && t == 0) ? 1 : 0;
            const char* a1 = cA + (size_t)(t + 1) * kstep;
            const char* a2 = last ? nA : cA + (size_t)(t + 2) * kstep; const char* b2 = last ? nB : cB + (size_t)(t + 2) * kstep;
            const char* a3 = a2 + kstep; const char* b3 = b2 + kstep;
            if (last && has_next) S.a_ready(nxt);
            if constexpr (SP2) {
            PG8_LDB(B0, 0, 0); PG8_LDB(B1, 0, 1); PG8_SCHED; PG8_LDA(At, 0, 0); PG8_STAGE(PG8_SA(1, 1), a1 + hstep, voffA);
            PG8_WAIT_V8_UNLESS(skipw); PG8_WAIT_L(0); PG8_BAR; PG8_MMA(0, 0, At, B0); PG8_MMA(0, 1, At, B1); PG8_BAR; PG8_SCHED;
            PG8_LDA(At, 0, 1); PG8_STAGE(PG8_SB(0, 0), b2, voffB); PG8_STAGE(PG8_SB(0, 1), b2 + hstep, voffB); PG8_STAGE(PG8_SA(0, 0), a2, voffA);
            PG8_WAIT_V8_UNLESS(skipw); PG8_WAIT_L(0); PG8_BAR; PG8_MMA(1, 0, At, B0); PG8_MMA(1, 1, At, B1); PG8_BAR; PG8_SCHED;
            PG8_LDB(B0, 1, 0); PG8_LDB(B1, 1, 1); PG8_SCHED; PG8_LDA(At, 1, 0); PG8_STAGE(PG8_SA(0, 1), a2 + hstep, voffA);
            PG8_WAIT_V(8); PG8_WAIT_L(0); PG8_BAR; PG8_MMA(0, 0, At, B0); PG8_MMA(0, 1, At, B1); PG8_BAR; PG8_SCHED;
            PG8_LDA(At, 1, 1); PG8_STAGE(PG8_SB(1, 0), b3, voffB); PG8_STAGE(PG8_SB(1, 1), b3 + hstep, voffB); PG8_STAGE(PG8_SA(1, 0), a3, voffA);
            PG8_WAIT_V(8); PG8_WAIT_L(0); PG8_BAR; PG8_MMA(1, 0, At, B0); PG8_MMA(1, 1, At, B1); PG8_BAR; PG8_SCHED;
            } else {
            PG8_LDB(B0, 0, 0); PG8_SCHED; PG8_LDA(At, 0, 0); PG8_STAGE(PG8_SA(1, 1), a1 + hstep, voffA);
            PG8_WAIT_L(8); PG8_BAR; PG8_WAIT_L(0); PG8_MMA(0, 0, At, B0); PG8_BAR; PG8_SCHED;
            PG8_LDB(B1, 0, 1); PG8_STAGE(PG8_SB(0, 0), b2, voffB);
            PG8_BAR; PG8_WAIT_L(0); PG8_MMA(0, 1, At, B1); PG8_BAR;
            PG8_LDA(At, 0, 1); PG8_STAGE(PG8_SA(0, 0), a2, voffA);
            PG8_BAR; PG8_WAIT_L(0); PG8_MMA(1, 0, At, B0); PG8_BAR; PG8_SCHED;
            PG8_STAGE(PG8_SB(0, 1), b2 + hstep, voffB);
            PG8_WAIT_V(6); PG8_BAR; PG8_MMA(1, 1, At, B1); PG8_BAR;
            PG8_LDB(B0, 1, 0); PG8_SCHED; PG8_LDA(At, 1, 0); PG8_STAGE(PG8_SA(0, 1), a2 + hstep, voffA);
            PG8_WAIT_L(8); PG8_BAR; PG8_WAIT_L(0); PG8_MMA(0, 0, At, B0); PG8_BAR; PG8_SCHED;
            PG8_LDB(B1, 1, 1); PG8_STAGE(PG8_SB(1, 0), b3, voffB);
            PG8_BAR; PG8_WAIT_L(0); PG8_MMA(0, 1, At, B1); PG8_BAR;
            PG8_LDA(At, 1, 1); PG8_STAGE(PG8_SA(1, 0), a3, voffA);
            PG8_BAR; PG8_WAIT_L(0); PG8_MMA(1, 0, At, B0); PG8_BAR; PG8_SCHED;
            PG8_STAGE(PG8_SB(1, 1), b3 + hstep, voffB);
            PG8_WAIT_V(6); PG8_BAR; PG8_MMA(1, 1, At, B1); PG8_BAR;
            }
        }
        if constexpr (SP2) PG8_WAIT_V(0);
        if constexpr (ALIGN_EPI) { if (wr == 0) PG8_BAR; }
        if constexpr (!Epi::AFTER_DRAIN) { E(acc, cur, wr, wc, fr, fq); S.done(cur); }
        if (!has_next) break;
#pragma unroll
        for (int a = 0; a < 2; ++a)
#pragma unroll
            for (int b = 0; b < 2; ++b)
#pragma unroll
                for (int m = 0; m < 4; ++m)
#pragma unroll
                    for (int n = 0; n < 2; ++n) acc[a][b][m][n] = (f32x4){0.f, 0.f, 0.f, 0.f};
        cur = nxt; cA = nA; cB = nB; ++ui;
        if constexpr (ALIGN_EPI) { if (wr == 1) PG8_BAR; }
    }
    PG8_WAIT_V(0);
    if constexpr (!ALIGN_EPI) { if (wr == 0) PG8_BAR; }
    PG8_BAR;
    if constexpr (Epi::AFTER_DRAIN) { E.fused(acc, cur, wr, wc, fr, fq, lds, wid, lane); S.done(cur); }
#undef PG8_SA
#undef PG8_SB
#undef PG8_STAGE
#undef PG8_LDA
#undef PG8_LDB
#undef PG8_MMA
#undef PG8_WAIT_V
#undef PG8_WAIT_L
#undef PG8_BAR
#undef PG8_SCHED
}
template <class Epi, class Sched, bool FP8 = false>
__device__ __forceinline__ void gemm_phase_g(PG8_LAS unsigned char* lds, const Gemm g, const Sched& S, const Epi& E, const PG8_LAS unsigned short* tok16) {
    constexpr bool ALIGN_EPI = true, SP2 = true;
    const int tid = threadIdx.x, wid = __builtin_amdgcn_readfirstlane(tid >> 6), lane = tid & 63, wr = wid >> 2, wc = wid & 3, fr = lane & 15, fq = lane >> 4;
    const int K = g.K, nt = K / BK;
    unsigned voffB[2]; int RA[2]; unsigned CA[2];
#pragma unroll
    for (int i = 0; i < 2; ++i) { int R, C; stage_rc(tid * 16 + i * 8192, R, C); const int Rb = Epi::PERM ? ((R & ~31) + perm32(R & 31)) : R;
        RA[i] = R; CA[i] = (unsigned)C * 2u; voffB[i] = (unsigned)(Rb * K + C) * 2u; }
    unsigned oc[2][2];
#define PG8_TOKS(dst, ui_) do { _Pragma("unroll") for (int _h = 0; _h < 2; ++_h) _Pragma("unroll") for (int _i = 0; _i < 2; ++_i) \
        dst[_h][_i] = (unsigned)tok16[(ui_) * 256 + _h * HALF + RA[_i]] * (unsigned)(K * 2) + CA[_i]; } while (0)
    const size_t kstep = (size_t)(BK * 2);
    const size_t hstep = (size_t)HALF * K * 2;
    const size_t tstep = 2 * hstep;
    const unsigned ldsw = (unsigned)wid * 1024u;
    const int aoff = lds_byte(wr * 64 + fr, fq * 8), boff = lds_byte(wc * 32 + fr, fq * 8);
#define PG8_SA(b, h) (((b) * 2 + (h)) * HTB)
#define PG8_SB(b, h) ((4 + (b) * 2 + (h)) * HTB)
#define PG8_STAGE(bufoff, gbase, voff) do { _Pragma("unroll") for (int _i = 0; _i < 2; ++_i) \
        __builtin_amdgcn_global_load_lds((const unsigned*)((const char*)(gbase) + (voff)[_i]), (PG8_LAS unsigned*)(lds + (bufoff) + ldsw + _i * 8192), 16, 0, 0); } while (0)
#define PG8_LDA(dst, b, h) do { _Pragma("unroll") for (int m = 0; m < 4; ++m) { if constexpr (FP8) dst##8[m] = cat8(*(const PG8_LAS bf16x8*)(lds + PG8_SA(b, h) + aoff + m * 2048), *(const PG8_LAS bf16x8*)(lds + PG8_SA(b, h) + aoff + m * 2048 + 1024)); \
        else { _Pragma("unroll") for (int k = 0; k < 2; ++k) dst[m][k] = *(const PG8_LAS bf16x8*)(lds + PG8_SA(b, h) + aoff + m * 2048 + k * 1024); } } } while (0)
#define PG8_LDB(dst, b, h) do { _Pragma("unroll") for (int n = 0; n < 2; ++n) { if constexpr (FP8) dst##8[n] = cat8(*(const PG8_LAS bf16x8*)(lds + PG8_SB(b, h) + boff + n * 2048), *(const PG8_LAS bf16x8*)(lds + PG8_SB(b, h) + boff + n * 2048 + 1024)); \
        else { _Pragma("unroll") for (int k = 0; k < 2; ++k) dst[n][k] = *(const PG8_LAS bf16x8*)(lds + PG8_SB(b, h) + boff + n * 2048 + k * 1024); } } } while (0)
#define PG8_MMA(ai, bj, At, Bt) do { __builtin_amdgcn_s_setprio(1); _Pragma("unroll") for (int m = 0; m < 4; ++m) _Pragma("unroll") for (int n = 0; n < 2; ++n) { \
        if constexpr (FP8) acc[ai][bj][m][n] = __builtin_amdgcn_mfma_scale_f32_16x16x128_f8f6f4(Bt##8[n], At##8[m], acc[ai][bj][m][n], 0, 0, 0, 0x7f7f7f7f, 0, 0x7f7f7f7f); \
        else { _Pragma("unroll") for (int k = 0; k < 2; ++k) acc[ai][bj][m][n] = __builtin_amdgcn_mfma_f32_16x16x32_bf16(Bt[n][k], At[m][k], acc[ai][bj][m][n], 0, 0, 0); } } \
        if constexpr (FP8) { _Pragma("unroll") for (int m = 0; m < 4; ++m) _Pragma("unroll") for (int n = 0; n < 2; ++n) asm volatile("" : "+v"(acc[ai][bj][m][n])); }     \
        __builtin_amdgcn_s_setprio(0); } while (0)
#define PG8_WAIT_V(n) asm volatile("s_waitcnt vmcnt(" #n ")" ::: "memory")
#define PG8_WAIT_L(n) asm volatile("s_waitcnt lgkmcnt(" #n ")" ::: "memory")
#define PG8_BAR __builtin_amdgcn_s_barrier()
#define PG8_SCHED __builtin_amdgcn_sched_barrier(0)
    Unit cur, nxt; int ui = 0;
    if (!S.next(0, cur)) return;
    f32x4 acc[2][2][4][2];
#pragma unroll
    for (int a = 0; a < 2; ++a)
#pragma unroll
        for (int b = 0; b < 2; ++b)
#pragma unroll
            for (int m = 0; m < 4; ++m)
#pragma unroll
                for (int n = 0; n < 2; ++n) acc[a][b][m][n] = (f32x4){0.f, 0.f, 0.f, 0.f};
    bf16x8 At[4][2], B0[2][2], B1[2][2]; i32x8 At8[4], B08[2], B18[2];
    const char* cA = (const char*)g.A; const char* cB = (const char*)g.Bt + (size_t)cur.pn * tstep; PG8_TOKS(oc, 0);
    S.a_ready(cur);
    if constexpr (SP2) {
        PG8_STAGE(PG8_SB(0, 0), cB, voffB); PG8_STAGE(PG8_SB(0, 1), cB + hstep, voffB); PG8_STAGE(PG8_SA(0, 0), cA, oc[0]); PG8_STAGE(PG8_SA(0, 1), cA, oc[1]);
        if (wr == 1) PG8_BAR;
        PG8_WAIT_V(2); PG8_BAR;
        PG8_STAGE(PG8_SB(1, 0), cB + kstep, voffB); PG8_STAGE(PG8_SA(1, 0), cA + kstep, oc[0]); PG8_STAGE(PG8_SB(1, 1), cB + hstep + kstep, voffB);
        PG8_WAIT_V(6); PG8_BAR;
    } else {
        PG8_STAGE(PG8_SB(0, 0), cB, voffB); PG8_STAGE(PG8_SA(0, 0), cA, oc[0]); PG8_STAGE(PG8_SB(0, 1), cB + hstep, voffB); PG8_STAGE(PG8_SA(0, 1), cA + hstep, oc[0]);
        if (wr == 1) PG8_BAR;
        PG8_WAIT_V(4); PG8_BAR;
        PG8_STAGE(PG8_SB(1, 0), cB + kstep, voffB); PG8_STAGE(PG8_SA(1, 0), cA + kstep, oc[0]); PG8_STAGE(PG8_SB(1, 1), cB + hstep + kstep, voffB);
        PG8_WAIT_V(6); PG8_BAR;
    }
    for (;;) {
        const bool has_next = S.next(ui + 1, nxt);
        const char* nB = has_next ? (const char*)g.Bt + (size_t)nxt.pn * tstep : cB;
        for (int t = 0; t < nt; t += 2) {
            const bool last = (t == nt - 2);
            const int skipw = (SP2 && ui > 0 && t == 0) ? 1 : 0;
            const char* a1 = cA + (size_t)(t + 1) * kstep;
            const char* a2 = last ? cA : cA + (size_t)(t + 2) * kstep; const char* b2 = last ? nB : cB + (size_t)(t + 2) * kstep;
            unsigned o2[2][2]; if (last && has_next) PG8_TOKS(o2, ui + 1); else { _Pragma("unroll") for (int _h = 0; _h < 2; ++_h) _Pragma("unroll") for (int _i = 0; _i < 2; ++_i) o2[_h][_i] = oc[_h][_i]; }
            const char* a3 = a2 + kstep; const char* b3 = b2 + kstep;
            if (last && has_next) S.a_ready(nxt);
            if constexpr (SP2) {
            PG8_LDB(B0, 0, 0); PG8_LDB(B1, 0, 1); PG8_SCHED; PG8_LDA(At, 0, 0); PG8_STAGE(PG8_SA(1, 1), a1, oc[1]);
            PG8_WAIT_V8_UNLESS(skipw); PG8_WAIT_L(0); PG8_BAR; PG8_MMA(0, 0, At, B0); PG8_MMA(0, 1, At, B1); PG8_BAR; PG8_SCHED;
            PG8_LDA(At, 0, 1); PG8_STAGE(PG8_SB(0, 0), b2, voffB); PG8_STAGE(PG8_SB(0, 1), b2 + hstep, voffB); PG8_STAGE(PG8_SA(0, 0), a2, o2[0]);
            PG8_WAIT_V8_UNLESS(skipw); PG8_WAIT_L(0); PG8_BAR; PG8_MMA(1, 0, At, B0); PG8_MMA(1, 1, At, B1); PG8_BAR; PG8_SCHED;
            PG8_LDB(B0, 1, 0); PG8_LDB(B1, 1, 1); PG8_SCHED; PG8_LDA(At, 1, 0); PG8_STAGE(PG8_SA(0, 1), a2, o2[1]);
            PG8_WAIT_V(8); PG8_WAIT_L(0); PG8_BAR; PG8_MMA(0, 0, At, B0); PG8_MMA(0, 1, At, B1); PG8_BAR; PG8_SCHED;
            PG8_LDA(At, 1, 1); PG8_STAGE(PG8_SB(1, 0), b3, voffB); PG8_STAGE(PG8_SB(1, 1), b3 + hstep, voffB); PG8_STAGE(PG8_SA(1, 0), a3, o2[0]);
            PG8_WAIT_V(8); PG8_WAIT_L(0); PG8_BAR; PG8_MMA(1, 0, At, B0); PG8_MMA(1, 1, At, B1); PG8_BAR; PG8_SCHED;
            } else {
            PG8_LDB(B0, 0, 0); PG8_SCHED; PG8_LDA(At, 0, 0); PG8_STAGE(PG8_SA(1, 1), a1 + hstep, oc[0]);
            PG8_WAIT_L(8); PG8_BAR; PG8_WAIT_L(0); PG8_MMA(0, 0, At, B0); PG8_BAR; PG8_SCHED;
            PG8_LDB(B1, 0, 1); PG8_STAGE(PG8_SB(0, 0), b2, voffB);
            PG8_BAR; PG8_WAIT_L(0); PG8_MMA(0, 1, At, B1); PG8_BAR;
            PG8_LDA(At, 0, 1); PG8_STAGE(PG8_SA(0, 0), a2, oc[0]);
            PG8_BAR; PG8_WAIT_L(0); PG8_MMA(1, 0, At, B0); PG8_BAR; PG8_SCHED;
            PG8_STAGE(PG8_SB(0, 1), b2 + hstep, voffB);
            PG8_WAIT_V(6); PG8_BAR; PG8_MMA(1, 1, At, B1); PG8_BAR;
            PG8_LDB(B0, 1, 0); PG8_SCHED; PG8_LDA(At, 1, 0); PG8_STAGE(PG8_SA(0, 1), a2 + hstep, oc[0]);
            PG8_WAIT_L(8); PG8_BAR; PG8_WAIT_L(0); PG8_MMA(0, 0, At, B0); PG8_BAR; PG8_SCHED;
            PG8_LDB(B1, 1, 1); PG8_STAGE(PG8_SB(1, 0), b3, voffB);
            PG8_BAR; PG8_WAIT_L(0); PG8_MMA(0, 1, At, B1); PG8_BAR;
            PG8_LDA(At, 1, 1); PG8_STAGE(PG8_SA(1, 0), a3, oc[0]);
            PG8_BAR; PG8_WAIT_L(0); PG8_MMA(1, 0, At, B0); PG8_BAR; PG8_SCHED;
            PG8_STAGE(PG8_SB(1, 1), b3 + hstep, voffB);
            PG8_WAIT_V(6); PG8_BAR; PG8_MMA(1, 1, At, B1); PG8_BAR;
            }
        }
        if constexpr (SP2) PG8_WAIT_V(0);
        if constexpr (ALIGN_EPI) { if (wr == 0) PG8_BAR; }
        if constexpr (!Epi::AFTER_DRAIN) { E(acc, cur, wr, wc, fr, fq); S.done(cur); }
        if (!has_next) break;
#pragma unroll
        for (int a = 0; a < 2; ++a)
#pragma unroll
            for (int b = 0; b < 2; ++b)
#pragma unroll
                for (int m = 0; m < 4; ++m)
#pragma unroll
                    for (int n = 0; n < 2; ++n) acc[a][b][m][n] = (f32x4){0.f, 0.f, 0.f, 0.f};
        cur = nxt; cB = nB; ++ui; PG8_TOKS(oc, ui);
        if constexpr (ALIGN_EPI) { if (wr == 1) PG8_BAR; }
    }
    PG8_WAIT_V(0);
    if constexpr (!ALIGN_EPI) { if (wr == 0) PG8_BAR; }
    PG8_BAR;
    if constexpr (Epi::AFTER_DRAIN) { E.fused(acc, cur, wr, wc, fr, fq, lds, wid, lane); S.done(cur); }
#undef PG8_TOKS
#undef PG8_SA
#undef PG8_SB
#undef PG8_STAGE
#undef PG8_LDA
#undef PG8_LDB
#undef PG8_MMA
#undef PG8_WAIT_V
#undef PG8_WAIT_L
#undef PG8_BAR
#undef PG8_SCHED
}
}

constexpr int BATCH = 16, SEQ = 2048, D = 1024, NMETA = 16;
constexpr int TV = SEQ + NMETA;
constexpr int NV = BATCH * TV;
constexpr int NTOK = BATCH * SEQ;
constexpr int NR = NTOK + NMETA;
constexpr int NIN = 5128, NPROJ = 5120;
constexpr int HW = 512;
constexpr int NE = 32, TOPK = 4, DFF = 1024;
constexpr int MAXTILES = 548;
constexpr float EPS = 1e-6f;
constexpr int NWAVES = 8, NTHREADS = 512;

constexpr size_t MiB = 1u << 20, KiB = 1u << 10;
constexpr size_t WS_CTL = 0, CTL_ZERO_BYTES = 1 * MiB;
constexpr size_t WS_WIN = 2 * MiB;
constexpr size_t WS_WBH = 12 * MiB, WS_WBM = 13 * MiB, WS_WOUT = 14 * MiB;
constexpr size_t WS_WGU = 16 * MiB;
constexpr size_t WS_WDN = 144 * MiB;
constexpr size_t WS_BGUP = 208 * MiB;
constexpr size_t WS_RWT = WS_BGUP + 256 * KiB;
constexpr size_t WS_TOPE = WS_RWT + 128 * KiB;
constexpr size_t WS_TOPP = WS_TOPE + 520 * KiB;
constexpr size_t WS_TOPW = WS_TOPP + 520 * KiB;
constexpr size_t WS_RS = WS_TOPW + 520 * KiB;
constexpr size_t WS_LI = WS_RS + 136 * KiB;
constexpr size_t WS_LF = WS_LI + 520 * KiB;
constexpr size_t WS_SLOTRS = WS_LF + 520 * KiB;
constexpr size_t WS_SLOTW = WS_SLOTRS + 552 * KiB;
constexpr size_t WS_SMALL_END = WS_SLOTW + 552 * KiB;
constexpr size_t WS_RA = 214 * MiB;
constexpr size_t WS_HQ = WS_RA, WS_HG = WS_RA + 33 * MiB, WS_HV = WS_RA + 99 * MiB, WS_HGATE = WS_RA + 132 * MiB, WS_MM = WS_RA + 165 * MiB, WS_MO = WS_RA + 198 * MiB, WS_GATES = WS_RA + 231 * MiB;
constexpr size_t WS_MERGED = WS_RA, WS_TMP = WS_RA + 66 * MiB, WS_H1B = WS_RA + 364 * MiB, WS_ACT = WS_RA;
constexpr size_t WS_RB = WS_RA + 364 * MiB;
constexpr size_t WS_XN0 = WS_RB, WS_QKVM = WS_RB, WS_CM = WS_RB + 130 * MiB, WS_YHG = WS_RB + 196 * MiB, WS_YML = WS_RB + 229 * MiB, WS_XS = WS_RB, WS_YB = WS_RB;
constexpr size_t WS_RC = WS_RB + 274 * MiB;
constexpr size_t WS_H1 = WS_RC, WS_ETOK = WS_RC + 130 * MiB, WS_ERS = WS_ETOK + 5 * MiB, WS_EW = WS_ERS + 5 * MiB, WS_END = WS_EW + 5 * MiB;
static_assert(WS_SMALL_END <= WS_RA && WS_END <= 1024 * MiB, "d_ws map");
static_assert((size_t)NV * HW * 2 <= 33 * MiB && (size_t)NV * HW * 4 <= 66 * MiB && (size_t)NV * 2048 * 2 <= 132 * MiB + MiB && (size_t)NV * D * 4 <= 130 * MiB && (size_t)MAXTILES * 256 * D * 2 <= 274 * MiB, "d_ws sizes");
static_assert((size_t)NE * NV * 4 <= 5 * MiB, "per-expert lists");
constexpr int CW_TMO = 0, CW_CNT = 64  , CW_BAR = 4096;

constexpr int RING_OFF = 0, RING_BYTES = 131072;
constexpr int MISC_OFF = RING_BYTES;
constexpr int TEXP_OFF = MISC_OFF + 256;
constexpr int PST_OFF = TEXP_OFF + 640;
constexpr int TOK_OFF = PST_OFF + 384;
constexpr int LDS_BYTES = 147456;
static_assert(TOK_OFF + 18 * 512 <= LDS_BYTES, "LDS map");

#define GAS __attribute__((address_space(1)))
#define LAS __attribute__((address_space(3)))
typedef unsigned short bf16;
typedef unsigned v4u __attribute__((ext_vector_type(4)));
typedef unsigned v2u __attribute__((ext_vector_type(2)));
typedef float f32x4 __attribute__((ext_vector_type(4)));
typedef GAS unsigned gu32;
#define RLX_AGENT __ATOMIC_RELAXED, __HIP_MEMORY_SCOPE_AGENT
#define LDS_WAIT() asm volatile("s_waitcnt lgkmcnt(0)" ::: "memory")
#define VM_WAIT() asm volatile("s_waitcnt vmcnt(0)" ::: "memory")
__device__ __forceinline__ unsigned pk2(float lo, float hi) { return pg8::cvt_pk_bf16(lo, hi); }
__device__ __forceinline__ unsigned f2bf(float f) { return pg8::cvt_pk_bf16(f, 0.f) & 0xffffu; }
__device__ __forceinline__ float bflo(unsigned w) { return __builtin_bit_cast(float, w << 16); }
__device__ __forceinline__ float bfhi(unsigned w) { return __builtin_bit_cast(float, w & 0xffff0000u); }
__device__ __forceinline__ float bf1(bf16 h) { return __builtin_bit_cast(float, (unsigned)h << 16); }
__device__ __forceinline__ float fsigmoid(float x) { return __builtin_amdgcn_rcpf(1.0f + __expf(-x)); }
__device__ __forceinline__ float fsilu(float x) { return x * fsigmoid(x); }
__device__ __forceinline__ size_t rowof(int b, int tt) { return tt < NMETA ? (size_t)(NTOK + tt) : (size_t)b * SEQ + (tt - NMETA); }
__host__ __device__ __forceinline__ int gu_slot(int j) { const int g = (j >> 3) & 3, p = ((g & 1) << 1) | (g >> 1); return (j & ~31) + 8 * p + (j & 7); }
__device__ __forceinline__ float wave_sum(float v) {
#pragma unroll
    for (int o = 1; o < 64; o <<= 1) v += __shfl_xor(v, o);
    return v;
}
__device__ __forceinline__ float wave_max(float v) {
#pragma unroll
    for (int o = 1; o < 64; o <<= 1) v = fmaxf(v, __shfl_xor(v, o));
    return v;
}
#define XB_TMO      128
#define XB_XCNT(j)  (256  + 64 * (j))
#define XB_XSUB(j)  (1280 + 64 * (j))
#define XB_XGEN(j)  (2304 + 64 * (j))
#define XB_TOP      3328
#define XB_TOPGEN   3392
#define XCD_BAR_WORDS 3456
#define XB_SPIN_CAP (1u << 18)

__device__ __forceinline__ unsigned xb_ld(unsigned* p)              { return __hip_atomic_load(p, __ATOMIC_RELAXED, __HIP_MEMORY_SCOPE_AGENT); }
__device__ __forceinline__ unsigned xb_add(unsigned* p, unsigned v) { return __hip_atomic_fetch_add(p, v, __ATOMIC_RELAXED, __HIP_MEMORY_SCOPE_AGENT); }
__device__ __forceinline__ unsigned xb_xcc_id() { return (unsigned)__builtin_amdgcn_s_getreg((3 << 11) | 20) & 0xFu; }
#define XB_SPIN(cond, bar) do { unsigned _sp = 0; while (cond) { __builtin_amdgcn_s_sleep(1); \
    if ((++_sp & 255u) == 0u) { if (xb_ld(&(bar)[XB_TMO])) break; if (_sp > XB_SPIN_CAP) { atomicAdd(&(bar)[XB_TMO], 1u); break; } } } } while (0)

struct XcdBarrier {
    unsigned* bar; unsigned x;
    volatile LAS unsigned* st;
};

__device__ __forceinline__ XcdBarrier xcd_barrier_post(unsigned* bar, volatile LAS unsigned* st) {
    XcdBarrier b; b.bar = bar; b.x = xb_xcc_id(); b.st = st;
    if (threadIdx.x == 0) (void)xb_add(&bar[XB_XCNT(b.x)], 1u);
    return b;
}
__device__ __forceinline__ void xcd_barrier_complete(unsigned* bar, unsigned x, unsigned& nloc, unsigned& nx) {
    const unsigned G = gridDim.x * gridDim.y * gridDim.z;
    unsigned sum, cnt, mine, sp = 0u;
    for (;;) {
        sum = 0u; cnt = 0u; mine = 0u;
#pragma unroll
        for (unsigned j = 0; j < 16; ++j) { const unsigned c = xb_ld(&bar[XB_XCNT(j)]); sum += c; cnt += (c > 0u) ? 1u : 0u; mine = (j == x) ? c : mine; }
        if (sum == G) break;
        __builtin_amdgcn_s_sleep(1);
        if ((++sp & 255u) == 0u) { if (xb_ld(&bar[XB_TMO])) break; if (sp > XB_SPIN_CAP) { atomicAdd(&bar[XB_TMO], 1u); break; } }
    }
    nloc = mine > 0u ? mine : 1u; nx = cnt > 0u ? cnt : 1u;
}

__device__ __forceinline__ void xcd_barrier(const XcdBarrier& b) {
    asm volatile("s_waitcnt vmcnt(0)" ::: "memory");
    __syncthreads();
    if (threadIdx.x == 0) {
        unsigned* bar = b.bar;
        __builtin_amdgcn_s_waitcnt(0);
        unsigned nloc = b.st[0], nx = b.st[1];
        if (nloc == 0u) { xcd_barrier_complete(bar, b.x, nloc, nx); b.st[0] = nloc; b.st[1] = nx; }
        const unsigned old = xb_add(&bar[XB_XSUB(b.x)], 1u);
        const unsigned gen = old / nloc;
        if (old + 1u == (gen + 1u) * nloc) {
            __builtin_amdgcn_fence(__ATOMIC_RELEASE, "agent");
            asm volatile("s_waitcnt vmcnt(0)" ::: "memory");
            const unsigned og = xb_add(&bar[XB_TOP], 1u);
            const unsigned tg = og / nx;
            if (og + 1u == (tg + 1u) * nx) xb_add(&bar[XB_TOPGEN], 1u);
            else XB_SPIN(xb_ld(&bar[XB_TOPGEN]) == tg, bar);
            __builtin_amdgcn_fence(__ATOMIC_ACQUIRE, "agent");
            xb_add(&bar[XB_XGEN(b.x)], 1u);
            asm volatile("s_waitcnt vmcnt(0)" ::: "memory");
        } else {
            XB_SPIN(xb_ld(&bar[XB_XGEN(b.x)]) == gen, bar);
            __builtin_amdgcn_fence(__ATOMIC_ACQUIRE, "agent");
            asm volatile("s_waitcnt vmcnt(0)" ::: "memory");
        }
    }
    __syncthreads();
}

struct Frame {
    LAS unsigned char* lds;
    volatile LAS unsigned* MISC;
    gu32* ctl;
    int tid, lane, wave, vcu, G;
    const float* in[25];
    float* out;
    unsigned char* ws;
};
#define IN_X 0
#define IN_META 1
#define IN_LBL 2
#define IN_NMIX 3
#define IN_WIN 4
#define IN_HGNORM 5
#define IN_CONVW 6
#define IN_CONVB 7
#define IN_WQ 8
#define IN_WK 9
#define IN_WV 10
#define IN_GATEB 11
#define IN_MLNORM 12
#define IN_MLSKIP 13
#define IN_WBH 14
#define IN_WBM 15
#define IN_WOUT 16
#define IN_NFFN 17
#define IN_RW 18
#define IN_RB 19
#define IN_WGU 20
#define IN_BGU 21
#define IN_WDN 22
#define IN_BDN 23
#define IN_NFIN 24

__device__ __forceinline__ void p0_item(const float* W, int ldw, int col0, int cstride, const float* kscale, bf16* WT, int K, int dstrow0, int k0, LAS float* scr, int lane) {
    (void)cstride;
    const int r = lane >> 3, c4 = (lane & 7) * 4;
    f32x4 v[8];
#pragma unroll
    for (int i = 0; i < 8; ++i) v[i] = *(const GAS f32x4*)(W + (size_t)(k0 + 8 * i + r) * ldw + col0 + c4);
#pragma unroll
    for (int i = 0; i < 8; ++i) { const float sc = kscale ? kscale[k0 + 8 * i + r] : 1.f; LAS float* s = scr + (8 * i + r) * 33 + c4; s[0] = v[i].x * sc; s[1] = v[i].y * sc; s[2] = v[i].z * sc; s[3] = v[i].w * sc; }
    LDS_WAIT(); asm volatile("" ::: "memory");
    const int c = lane & 7;
#pragma unroll
    for (int j = 0; j < 4; ++j) { const int n = (lane >> 3) + 8 * j; const LAS float* s = scr + (8 * c) * 33 + n;
        v4u o; o.x = pk2(s[0 * 33], s[1 * 33]); o.y = pk2(s[2 * 33], s[3 * 33]); o.z = pk2(s[4 * 33], s[5 * 33]); o.w = pk2(s[6 * 33], s[7 * 33]);
        *(GAS v4u*)(WT + (size_t)(dstrow0 + n) * K + k0 + 8 * c) = o; }
    LDS_WAIT(); asm volatile("" ::: "memory");
}
__device__ __forceinline__ void p0_prologue(Frame& F) {
    unsigned char* ws = F.ws;
    const int gw = F.vcu * NWAVES + F.wave, NGW = F.G * NWAVES, gt = F.vcu * NTHREADS + F.tid, NGT = F.G * NTHREADS;
    {
        LAS float* wm = (LAS float*)(F.lds + RING_OFF + 65536);
        { float wa[16], wb[16];
#pragma unroll
          for (int q = 0; q < 16; ++q) { const int u = F.tid + q * NTHREADS, j = u & 7, l = (u >> 3) & 63, i = u >> 9, k = 4 * l + 256 * (i >> 2) + (i & 3); wa[q] = F.in[IN_NMIX][k]; wb[q] = F.in[IN_WIN][(size_t)k * NIN + 3072 + j]; }
#pragma unroll
          for (int q = 0; q < 16; ++q) wm[F.tid + q * NTHREADS] = wa[q] * wb[q]; }
        __syncthreads();
        bf16* XN0 = (bf16*)(ws + WS_XN0); float* LI = (float*)(ws + WS_LI); float* LF = (float*)(ws + WS_LF);
        f32x4 vn[4];
#define P0_LOADROW(dst, V_) do { const int Vc_ = (V_) < NR ? (V_) : NR - 1; const float* src_ = (Vc_ >= NTOK) ? F.in[IN_META] + (size_t)(Vc_ - NTOK) * D : F.in[IN_X] + (size_t)Vc_ * D; \
        const GAS f32x4* xr_ = (const GAS f32x4*)src_ + F.lane; _Pragma("unroll") for (int j = 0; j < 4; ++j) dst[j] = xr_[64 * j]; } while (0)
        P0_LOADROW(vn, gw);
        for (int V = gw; V < NR; V += NGW) {
            f32x4 v[4]; float s = 0.f;
#pragma unroll
            for (int j = 0; j < 4; ++j) { v[j] = vn[j]; s += (v[j].x * v[j].x + v[j].y * v[j].y) + (v[j].z * v[j].z + v[j].w * v[j].w); }
            P0_LOADROW(vn, V + NGW);
            asm volatile("" ::: "memory");
            const float rs = 1.0f / sqrtf(wave_sum(s) * (1.f / D) + EPS);
            float g[8];
#pragma unroll
            for (int j = 0; j < 8; ++j) g[j] = 0.f;
            GAS unsigned long long* o8 = (GAS unsigned long long*)(XN0 + (size_t)V * D) + F.lane;
#pragma unroll
            for (int j = 0; j < 4; ++j) {
                v[j] = v[j] * rs;
                o8[64 * j] = (unsigned long long)pk2(v[j].x, v[j].y) | ((unsigned long long)pk2(v[j].z, v[j].w) << 32);
#pragma unroll
                for (int q = 0; q < 4; ++q) { const LAS f32x4* wp = (const LAS f32x4*)(wm + (((4 * j + q) * 64 + F.lane) * 8)); const f32x4 w0 = wp[0], w1 = wp[1]; const float xv = v[j][q];
                    g[0] += xv * w0.x; g[1] += xv * w0.y; g[2] += xv * w0.z; g[3] += xv * w0.w; g[4] += xv * w1.x; g[5] += xv * w1.y; g[6] += xv * w1.z; g[7] += xv * w1.w; }
            }
#pragma unroll
            for (int j = 0; j < 8; ++j) g[j] = wave_sum(g[j]);
            if (F.lane < 4) {
                const float gi = (F.lane == 0 ? g[0] : F.lane == 1 ? g[1] : F.lane == 2 ? g[2] : g[3]) + F.in[IN_GATEB][F.lane];
                const float gf = (F.lane == 0 ? g[4] : F.lane == 1 ? g[5] : F.lane == 2 ? g[6] : g[7]) + F.in[IN_GATEB][4 + F.lane];
                LI[(size_t)V * 4 + F.lane] = gi;
                LF[(size_t)V * 4 + F.lane] = fminf(gf, 0.f) - log1pf(__expf(-fabsf(gf)));
            }
        }
        __syncthreads();
    }
    {
        LAS float* scr = (LAS float*)(F.lds + RING_OFF + F.wave * 16384);
        constexpr int I_IN1 = 16 * 96, I_IN2 = 16 * 64, I_BH = 8 * 32, I_OUT = 16 * 32;
        constexpr int NITEMS = I_IN1 + I_IN2 + 2 * I_BH + I_OUT;
        for (int it = gw; it < NITEMS; it += NGW) {
            int r = it;
            if (r < I_IN1) { const int kb = r / 96, nb = r % 96; p0_item(F.in[IN_WIN], NIN, 32 * nb, 1, F.in[IN_NMIX], (bf16*)(ws + WS_WIN), D, 32 * nb, 64 * kb, scr, F.lane); continue; } r -= I_IN1;
            if (r < I_IN2) { const int kb = r / 64, nb = r % 64; p0_item(F.in[IN_WIN], NIN, 3080 + 32 * nb, 1, F.in[IN_NMIX], (bf16*)(ws + WS_WIN), D, 3072 + 32 * nb, 64 * kb, scr, F.lane); continue; } r -= I_IN2;
            if (r < I_BH) { const int kb = r / 32, nb = r % 32; p0_item(F.in[IN_WBH], D, 32 * nb, 1, nullptr, (bf16*)(ws + WS_WBH), HW, 32 * nb, 64 * kb, scr, F.lane); continue; } r -= I_BH;
            if (r < I_BH) { const int kb = r / 32, nb = r % 32; p0_item(F.in[IN_WBM], D, 32 * nb, 1, nullptr, (bf16*)(ws + WS_WBM), HW, 32 * nb, 64 * kb, scr, F.lane); continue; } r -= I_BH;
            { const int kb = r / 32, nb = r % 32; p0_item(F.in[IN_WOUT], D, 32 * nb, 1, nullptr, (bf16*)(ws + WS_WOUT), D, 32 * nb, 64 * kb, scr, F.lane); }
        }
    }
    { float* BGUP = (float*)(ws + WS_BGUP); float* RWT = (float*)(ws + WS_RWT);
      for (int u = gt; u < NE * 2 * DFF; u += NGT) { const int e = u >> 11, n = u & 2047, pn = n >> 8, bj = (n >> 7) & 1, j = gu_slot(n & 127); BGUP[u] = F.in[IN_BGU][(size_t)e * 2 * DFF + 2 * (128 * pn + j) + bj]; }
      for (int u = gt; u < NE * D; u += NGT) { const int e = u >> 10, k = u & 1023; RWT[u] = F.in[IN_NFFN][k] * F.in[IN_RW][(size_t)k * NE + e]; } }
}

__device__ __forceinline__ unsigned pk4_fp8(float a, float b, float c, float d) { unsigned w = 0;
    a = __builtin_amdgcn_fmed3f(a, -448.f, 448.f); b = __builtin_amdgcn_fmed3f(b, -448.f, 448.f); c = __builtin_amdgcn_fmed3f(c, -448.f, 448.f); d = __builtin_amdgcn_fmed3f(d, -448.f, 448.f);
    w = __builtin_amdgcn_cvt_pk_fp8_f32(a, b, w, false); w = __builtin_amdgcn_cvt_pk_fp8_f32(c, d, w, true); return w; }
__device__ __forceinline__ void cvdn_load(const float* Wdn, int it, f32x4 (&v)[8], int lane) {
    const int e = it >> 9, kb = (it >> 5) & 15, nb = it & 31, r = lane >> 3, c4 = (lane & 7) * 4; const float* W = Wdn + (size_t)e * DFF * D;
#pragma unroll
    for (int i = 0; i < 8; ++i) v[i] = *(const GAS f32x4*)(W + (size_t)(64 * kb + 8 * i + r) * D + 32 * nb + c4);
}
__device__ __forceinline__ void cvdn_proc(unsigned char* WTdn, int it, const f32x4 (&v)[8], LAS float* scr, int lane) {
    const int e = it >> 9, kb = (it >> 5) & 15, nb = it & 31, r = lane >> 3, c4 = (lane & 7) * 4; unsigned char* WT = WTdn + (size_t)e * D * DFF;
#pragma unroll
    for (int i = 0; i < 8; ++i) { LAS float* s = scr + (8 * i + r) * 33 + c4; s[0] = v[i].x * 32.f; s[1] = v[i].y * 32.f; s[2] = v[i].z * 32.f; s[3] = v[i].w * 32.f; }
    LDS_WAIT(); asm volatile("" ::: "memory");
    const int c = lane & 7;
#pragma unroll
    for (int j = 0; j < 4; ++j) { const int n = (lane >> 3) + 8 * j; const LAS float* s = scr + (8 * c) * 33 + n;
        v2u o; o.x = pk4_fp8(s[0 * 33], s[1 * 33], s[2 * 33], s[3 * 33]); o.y = pk4_fp8(s[4 * 33], s[5 * 33], s[6 * 33], s[7 * 33]);
        const int cn = 32 * nb + n, rowp = (cn & ~255) + 128 * ((cn >> 3) & 1) + 32 * ((cn >> 6) & 3) + 8 * ((cn >> 4) & 3) + (cn & 7);
        *(GAS v2u*)(WT + (size_t)rowp * DFF + 64 * kb + 8 * c) = o; }
    LDS_WAIT(); asm volatile("" ::: "memory");
}
__device__ __forceinline__ void cvgu_load(const float* Wgu, const float* nffn, int it, f32x4 (&v)[8], float (&sc)[8], int lane) {
    const int e = it >> 10, kb = (it >> 5) & 31, nb = it & 31, r = lane >> 4, c4 = (lane & 15) * 4; const float* W = Wgu + (size_t)e * D * 2 * DFF;
#pragma unroll
    for (int i = 0; i < 8; ++i) { v[i] = *(const GAS f32x4*)(W + (size_t)(32 * kb + 4 * i + r) * (2 * DFF) + 64 * nb + c4); sc[i] = nffn[32 * kb + 4 * i + r] * 32.f; }
}
__device__ __forceinline__ void cvgu_proc(unsigned char* WTgu, int it, const f32x4 (&v)[8], const float (&sc)[8], LAS float* scr, int lane) {
    const int e = it >> 10, kb = (it >> 5) & 31, nb = it & 31, r = lane >> 4, c4 = (lane & 15) * 4, A0 = 32 * nb, k0 = 32 * kb; unsigned char* WT = WTgu + (size_t)e * 2 * DFF * D;
    LAS float* sg = scr; LAS float* su = scr + 32 * 33;
#pragma unroll
    for (int i = 0; i < 8; ++i) { const int o = (4 * i + r) * 33 + (c4 >> 1); sg[o] = v[i].x * sc[i]; su[o] = v[i].y * sc[i]; sg[o + 1] = v[i].z * sc[i]; su[o + 1] = v[i].w * sc[i]; }
    LDS_WAIT(); asm volatile("" ::: "memory");
    const int c = lane & 3;
#pragma unroll
    for (int j = 0; j < 4; ++j) { const int q = (lane >> 2) + 16 * j, isup = q >> 5, jj = q & 31, A = A0 + jj; const LAS float* s = scr + isup * 32 * 33 + (8 * c) * 33 + jj;
        v2u o; o.x = pk4_fp8(s[0 * 33], s[1 * 33], s[2 * 33], s[3 * 33]); o.y = pk4_fp8(s[4 * 33], s[5 * 33], s[6 * 33], s[7 * 33]);
        *(GAS v2u*)(WT + (size_t)(256 * (A >> 7) + 128 * isup + gu_slot(A & 127)) * D + k0 + 8 * c) = o; }
    LDS_WAIT(); asm volatile("" ::: "memory");
}
__device__ __forceinline__ void px_experts(Frame& F, int rank, int nwg) {
    unsigned char* ws = F.ws;
    LAS float* scr = (LAS float*)(F.lds + RING_OFF + F.wave * 16384);
    const int gw = rank * NWAVES + F.wave, NGW = nwg * NWAVES;
    { constexpr int NIT = NE * 1024; f32x4 v[8], vn[8]; float sc[8], sn[8]; int it = gw;
      if (it < NIT) cvgu_load(F.in[IN_WGU], F.in[IN_NFFN], it, v, sc, F.lane);
      while (it < NIT) { const int nx = it + NGW; if (nx < NIT) cvgu_load(F.in[IN_WGU], F.in[IN_NFFN], nx, vn, sn, F.lane);
          asm volatile("" ::: "memory");
          cvgu_proc((unsigned char*)(ws + WS_WGU), it, v, sc, scr, F.lane); asm volatile("" ::: "memory");
#pragma unroll
          for (int i = 0; i < 8; ++i) { v[i] = vn[i]; sc[i] = sn[i]; }
          it = nx; } }
    { constexpr int NIT = NE * 512; f32x4 v[8], vn[8]; int it = gw;
      if (it < NIT) cvdn_load(F.in[IN_WDN], it, v, F.lane);
      while (it < NIT) { const int nx = it + NGW; if (nx < NIT) cvdn_load(F.in[IN_WDN], nx, vn, F.lane);
          asm volatile("" ::: "memory");
          cvdn_proc((unsigned char*)(ws + WS_WDN), it, v, scr, F.lane); asm volatile("" ::: "memory");
#pragma unroll
          for (int i = 0; i < 8; ++i) v[i] = vn[i];
          it = nx; } }
}

namespace pg8 {
typedef unsigned v2u_t __attribute__((ext_vector_type(2)));
__device__ __forceinline__ u32x4 pack8(const f32x4& a, const f32x4& b) { u32x4 w; w.x = cvt_pk_bf16(a[0], a[1]); w.y = cvt_pk_bf16(a[2], a[3]); w.z = cvt_pk_bf16(b[0], b[1]); w.w = cvt_pk_bf16(b[2], b[3]); return w; }
__device__ __forceinline__ v2u_t pack8_fp8(const f32x4& a, const f32x4& b) { unsigned lo = 0, hi = 0;
    lo = __builtin_amdgcn_cvt_pk_fp8_f32(a[0], a[1], lo, false); lo = __builtin_amdgcn_cvt_pk_fp8_f32(a[2], a[3], lo, true);
    hi = __builtin_amdgcn_cvt_pk_fp8_f32(b[0], b[1], hi, false); hi = __builtin_amdgcn_cvt_pk_fp8_f32(b[2], b[3], hi, true); return (v2u_t){lo, hi}; }
__device__ __forceinline__ v2u_t pack8_fp8_sat(const f32x4& a, const f32x4& b) { f32x4 x, y;
#pragma unroll
    for (int i = 0; i < 4; ++i) { x[i] = __builtin_amdgcn_fmed3f(a[i], -448.f, 448.f); y[i] = __builtin_amdgcn_fmed3f(b[i], -448.f, 448.f); }
    return pack8_fp8(x, y); }
__device__ __forceinline__ void unpack8(const u32x4& w, f32x4& a, f32x4& b) { a = (f32x4){bflo(w.x), bfhi(w.x), bflo(w.y), bfhi(w.y)}; b = (f32x4){bflo(w.z), bfhi(w.z), bflo(w.w), bfhi(w.w)}; }
struct EpiProj {
    static constexpr bool PERM = true, AFTER_DRAIN = false;
    unsigned char* ws; const float* lbl;
    __device__ __forceinline__ void operator()(const f32x4 (&acc)[2][2][4][2], const Unit& u, int wr, int wc, int fr, int fq) const {
        const int row0 = u.pm * BM + wr * 64 + fr, kind = u.pn < 12 ? (u.pn >> 1) : 6;
        const int colt = (u.pn < 12 ? (u.pn & 1) : (u.pn - 12)) * BM + wc * 32 + 8 * fq;
        if (kind == 1) {
            float* HG = (float*)(ws + WS_HG);
#pragma unroll
            for (int bj = 0; bj < 2; ++bj) { const int c = colt + bj * HALF; float lb[8];
#pragma unroll
                for (int i = 0; i < 8; ++i) lb[i] = fsigmoid(lbl[c + i] - lbl[HW + c + i]);
#pragma unroll
                for (int ai = 0; ai < 2; ++ai)
#pragma unroll
                    for (int m = 0; m < 4; ++m) { float* rowp = HG + (size_t)(row0 + ai * HALF + m * 16) * HW + c; f32x4 o0, o1;
#pragma unroll
                        for (int i = 0; i < 4; ++i) { o0[i] = __logf(lb[i] + (1.f - lb[i]) * fsigmoid(acc[ai][bj][m][0][i])); o1[i] = __logf(lb[4 + i] + (1.f - lb[4 + i]) * fsigmoid(acc[ai][bj][m][1][i])); }
                        *(f32x4*)rowp = o0; *(f32x4*)(rowp + 4) = o1; } }
            return;
        }
        bf16_t* O; int ldc = HW; int act = 0;
        if (kind == 0) { O = (bf16_t*)(ws + WS_HQ); act = 1; } else if (kind == 2) { O = (bf16_t*)(ws + WS_HV); } else if (kind == 3) { O = (bf16_t*)(ws + WS_HGATE); act = 1; }
        else if (kind == 4) { O = (bf16_t*)(ws + WS_MM); } else if (kind == 5) { O = (bf16_t*)(ws + WS_MO); act = 2; } else { O = (bf16_t*)(ws + WS_GATES); ldc = 2048; act = 2; }
#pragma unroll
        for (int ai = 0; ai < 2; ++ai)
#pragma unroll
            for (int m = 0; m < 4; ++m) { bf16_t* rowp = O + (size_t)(row0 + ai * HALF + m * 16) * ldc + colt;
#pragma unroll
                for (int bj = 0; bj < 2; ++bj) { f32x4 v0 = acc[ai][bj][m][0], v1 = acc[ai][bj][m][1];
                    if (act) {
#pragma unroll
                        for (int i = 0; i < 4; ++i) { const float s0 = fsigmoid(v0[i]), s1 = fsigmoid(v1[i]); v0[i] = act == 1 ? v0[i] * s0 : s0; v1[i] = act == 1 ? v1[i] * s1 : s1; } }
                    *(u32x4*)(rowp + bj * HALF) = pack8(v0, v1); } }
    }
};
constexpr int PAIR_DA = 132, PAIR_DB = 4;
struct PairOrder { StaticOrder S;
    __device__ __forceinline__ bool next(int i, Unit& u) const { Unit t; if (!S.next(i >> 1, t)) return false; const int s = i & 1; u.pm = t.pm + PAIR_DA * s; u.pn = t.pn + PAIR_DB * s; return true; }
    __device__ __forceinline__ void a_ready(const Unit&) const {}
    __device__ __forceinline__ void done(const Unit&) const {}
};
struct EpiGate2 {
    static constexpr bool PERM = true, AFTER_DRAIN = false;
    const bf16_t* __restrict__ gates; bf16_t* __restrict__ tmp; bf16_t* __restrict__ merged;
    __device__ __forceinline__ void operator()(const f32x4 (&acc)[2][2][4][2], const Unit& u, int wr, int wc, int fr, int fq) const {
        const int step = u.pm >= PAIR_DA ? 1 : 0, pm = u.pm - PAIR_DA * step, pn = u.pn - PAIR_DB * step;
        const int row0 = pm * BM + wr * 64 + fr, col0 = pn * BM + wc * 32 + 8 * fq;
        constexpr int NB = 2, NBAT = 8 / NB;
        bf16_t* obuf = tmp + (ptrdiff_t)(merged - tmp) * step;
        u32x4 gc[NB][2], tc[NB][2], gn[NB][2], tn[NB][2];
#define EG_LOAD(G, T, b_) do { _Pragma("unroll") for (int s_ = 0; s_ < NB; ++s_) { const int it_ = (b_) * NB + s_; const size_t row_ = (size_t)(row0 + (it_ >> 2) * HALF + (it_ & 3) * 16); _Pragma("unroll") for (int bj = 0; bj < 2; ++bj) { \
        G[s_][bj] = *(const u32x4*)(gates + row_ * 2048 + step * D + col0 + bj * HALF); if (step) T[s_][bj] = *(const u32x4*)(tmp + row_ * D + col0 + bj * HALF); else T[s_][bj] = (u32x4){0u, 0u, 0u, 0u}; } } } while (0)
        EG_LOAD(gc, tc, 0);
#pragma unroll
        for (int b = 0; b < NBAT; ++b) {
            if (b + 1 < NBAT) EG_LOAD(gn, tn, b + 1);
#pragma unroll
            for (int s = 0; s < NB; ++s) { const int it = b * NB + s, ai = it >> 2, m = it & 3; const size_t row = (size_t)(row0 + ai * HALF + m * 16);
#pragma unroll
                for (int bj = 0; bj < 2; ++bj) { const int c = col0 + bj * HALF; f32x4 g0, g1, t0, t1; unpack8(gc[s][bj], g0, g1); unpack8(tc[s][bj], t0, t1);
                    const u32x4 o = pack8(acc[ai][bj][m][0] * g0 + t0, acc[ai][bj][m][1] * g1 + t1);
                    *(u32x4*)(obuf + row * D + c) = o; } }
#pragma unroll
            for (int s = 0; s < NB; ++s)
#pragma unroll
                for (int bj = 0; bj < 2; ++bj) { gc[s][bj] = gn[s][bj]; tc[s][bj] = tn[s][bj]; } }
#undef EG_LOAD
    }
};
struct EpiH1 {
    static constexpr bool PERM = true, AFTER_DRAIN = false;
    const float* __restrict__ x; const float* __restrict__ meta; float* __restrict__ H1; unsigned char* __restrict__ H1B8;
    __device__ __forceinline__ void operator()(const f32x4 (&acc)[2][2][4][2], const Unit& u, int wr, int wc, int fr, int fq) const {
        const int row0 = u.pm * BM + wr * 64 + fr, col0 = u.pn * BM + wc * 32 + 8 * fq;
        f32x4 xc[2][2], xn[2][2];
#define EH_LOAD(X, it_) do { const float* src_ = x + (size_t)(row0 + ((it_) >> 2) * HALF + ((it_) & 3) * 16) * D + col0; _Pragma("unroll") for (int bj = 0; bj < 2; ++bj) { X[bj][0] = *(const f32x4*)(src_ + bj * HALF); X[bj][1] = *(const f32x4*)(src_ + bj * HALF + 4); } } while (0)
        EH_LOAD(xc, 0);
#pragma unroll
        for (int it = 0; it < 8; ++it) { const int ai = it >> 2, m = it & 3; const size_t V = (size_t)(row0 + ai * HALF + m * 16);
            if (it + 1 < 8) EH_LOAD(xn, it + 1);
#pragma unroll
            for (int bj = 0; bj < 2; ++bj) { const int c = col0 + bj * HALF;
                const f32x4 v0 = acc[ai][bj][m][0] + xc[bj][0], v1 = acc[ai][bj][m][1] + xc[bj][1];
                *(f32x4*)(H1 + V * D + c) = v0; *(f32x4*)(H1 + V * D + c + 4) = v1; *(v2u_t*)(H1B8 + V * D + c) = pack8_fp8_sat(v0, v1); }
#pragma unroll
            for (int bj = 0; bj < 2; ++bj) { xc[bj][0] = xn[bj][0]; xc[bj][1] = xn[bj][1]; } }
#undef EH_LOAD
    }
};
struct EpiGU {
    static constexpr bool PERM = true, AFTER_DRAIN = false;
    const float* __restrict__ bgup; const float* __restrict__ ers; unsigned char* __restrict__ act; const PG8_LAS int* pst;
    __device__ __forceinline__ void operator()(const f32x4 (&acc)[2][2][4][2], const Unit& u, int wr, int wc, int fr, int fq) const {
        const int e = u.pn >> 3, pn = u.pn & 7, row0 = u.pm * BM + wr * 64 + fr, cc = wc * 32 + 8 * fq;
        const float* rsp = ers + (size_t)e * NV + (row0 - pst[e]);
        const float* bp = bgup + (size_t)e * 2 * DFF + pn * BM + cc;
        const f32x4 bg0 = *(const f32x4*)bp, bg1 = *(const f32x4*)(bp + 4), bu0 = *(const f32x4*)(bp + HALF), bu1 = *(const f32x4*)(bp + HALF + 4);
        float rsv[8];
#pragma unroll
        for (int it = 0; it < 8; ++it) rsv[it] = rsp[(it >> 2) * HALF + (it & 3) * 16];
        const int hi = fq >> 1;
        unsigned char* obase = act + (size_t)(row0 + 16 * hi) * DFF + pn * HALF + wc * 32 + 16 * (fq & 1);
#pragma unroll
        for (int ai = 0; ai < 2; ++ai)
#pragma unroll
            for (int mp = 0; mp < 2; ++mp) { v2u_t pk[2];
#pragma unroll
                for (int q = 0; q < 2; ++q) { const int m = 2 * mp + q; const float rs = rsv[ai * 4 + m] * 0.03125f;
                    f32x4 o0, o1;
#pragma unroll
                    for (int i = 0; i < 4; ++i) {
                        float g0 = fminf(acc[ai][0][m][0][i] * rs + bg0[i], 7.f), u0 = fminf(fmaxf(acc[ai][1][m][0][i] * rs + bu0[i], -7.f), 7.f);
                        float g1 = fminf(acc[ai][0][m][1][i] * rs + bg1[i], 7.f), u1 = fminf(fmaxf(acc[ai][1][m][1][i] * rs + bu1[i], -7.f), 7.f);
                        o0[i] = (u0 + 1.f) * g0 * fsigmoid(1.702f * g0); o1[i] = (u1 + 1.f) * g1 * fsigmoid(1.702f * g1); }
                    pk[q] = pack8_fp8(o0, o1); }
                const auto r0 = __builtin_amdgcn_permlane32_swap(pk[0][0], pk[1][0], false, false), r1 = __builtin_amdgcn_permlane32_swap(pk[0][1], pk[1][1], false, false);
                *(u32x4*)(obase + (size_t)(ai * HALF + mp * 32) * DFF) = (u32x4){r0[0], r1[0], r0[1], r1[1]}; }
    }
};
struct EpiDown {
    static constexpr bool PERM = true, AFTER_DRAIN = false;
    const float* __restrict__ bdn; const float* __restrict__ ew; unsigned char* __restrict__ yb; const PG8_LAS int* pst;
    __device__ __forceinline__ void operator()(const f32x4 (&acc)[2][2][4][2], const Unit& u, int wr, int wc, int fr, int fq) const {
        const int e = u.pn >> 2, pn = u.pn & 3, row0 = u.pm * BM + wr * 64 + fr, col0 = pn * BM + wc * 64 + 16 * fq;
        const float* wp = ew + (size_t)e * NV + (row0 - pst[e]);
        f32x4 bv[2][2];
#pragma unroll
        for (int bj = 0; bj < 2; ++bj) { bv[bj][0] = *(const f32x4*)(bdn + (size_t)e * D + col0 + 8 * bj); bv[bj][1] = *(const f32x4*)(bdn + (size_t)e * D + col0 + 8 * bj + 4); }
        float wv[8];
#pragma unroll
        for (int it = 0; it < 8; ++it) wv[it] = wp[(it >> 2) * HALF + (it & 3) * 16];
#pragma unroll
        for (int ai = 0; ai < 2; ++ai)
#pragma unroll
            for (int m = 0; m < 4; ++m) { const size_t row = (size_t)(row0 + ai * HALF + m * 16); const float w = wv[ai * 4 + m] * 16.f;
                const v2u_t lo = pack8_fp8_sat((acc[ai][0][m][0] * 0.03125f + bv[0][0]) * w, (acc[ai][0][m][1] * 0.03125f + bv[0][1]) * w), hi = pack8_fp8_sat((acc[ai][1][m][0] * 0.03125f + bv[1][0]) * w, (acc[ai][1][m][1] * 0.03125f + bv[1][1]) * w);
                *(u32x4*)(yb + row * D + col0) = (u32x4){lo[0], lo[1], hi[0], hi[1]}; }
    }
};
struct GroupOrder {
    int ntiles, ncol, G, c; const PG8_LAS unsigned char* texp;
    __device__ __forceinline__ bool next(int i, Unit& u) const { const int x = c & 7, w = c >> 3, uu = i * (G >> 3) + w, lj = uu / ncol, pn = uu - lj * ncol, j = lj * 8 + x; if (j >= ntiles) return false; u.pm = j; u.pn = (int)texp[j] * ncol + pn; return true; }
    __device__ __forceinline__ void a_ready(const Unit&) const {}
    __device__ __forceinline__ void done(const Unit&) const {}
};
}

typedef short bf16x8 __attribute__((ext_vector_type(8)));
typedef float f32x16 __attribute__((ext_vector_type(16)));
#define MFMA32(a, b, c) __builtin_amdgcn_mfma_f32_32x32x16_bf16(a, b, c, 0, 0, 0)
__device__ __forceinline__ bf16x8 ldfrag(const LAS unsigned char* base, int st, int row0, int k0, int lane) { return *(const LAS bf16x8*)(base + (row0 + (lane & 31)) * st + (k0 + 8 * (lane >> 5)) * 2); }
__device__ __forceinline__ bf16x8 ldf(const LAS unsigned char* lanebase, int off) { return *(const LAS bf16x8*)(lanebase + off); }
__device__ __forceinline__ float fexp(float x) { return __builtin_amdgcn_exp2f(x * 1.4426950408889634f); }

__device__ __forceinline__ void p3_hgrn2_mfma(Frame& F, int bh) {
    unsigned char* ws = F.ws; const int b = bh >> 2, h = bh & 3, tid = F.tid, lane = F.lane, wave = F.wave, hh = lane >> 5, l31 = lane & 31;
    const bf16* HQ = (const bf16*)(ws + WS_HQ) + h * 128; const float* HG = (const float*)(ws + WS_HG) + h * 128; const bf16* HV = (const bf16*)(ws + WS_HV) + h * 128;
    const bf16* HGATE = (const bf16*)(ws + WS_HGATE) + h * 128; bf16* YHG = (bf16*)(ws + WS_YHG) + h * 128;
    LAS unsigned char* L = F.lds + RING_OFF;
    LAS unsigned char* QT = L; LAS unsigned char* KT = L + 17408; LAS unsigned char* KTT = L + 34816; LAS unsigned char* VT = L + 53248; LAS unsigned char* ST = L + 71680; LAS unsigned char* PP = L + 106496;
    LAS float* SEG = (LAS float*)(L + 115712); LAS float* ER = (LAS float*)(L + 117760); LAS float* EL = (LAS float*)(L + 118272); LAS float* OST = (LAS float*)(L + 17408);
    const int d = tid & 127, pq = tid >> 7;
    const int et = tid >> 3, evq = tid & 7;
    const int f144 = l31 * 144 + hh * 16, f272 = l31 * 272 + hh * 16;
    const int sst = wave == 2 ? 1 : 0, stt = wave == 0 ? 0 : 1, dt = wave & 3, vt0 = 2 * (wave >> 2), btt = wave & 1, bvt = wave >> 1;
    const LAS unsigned char* aK = KT + 32 * sst * 272 + f272; const LAS unsigned char* bQ = QT + 32 * stt * 272 + f272;
    LAS unsigned char* pst = PP + (32 * stt + l31) * 144 + (32 * sst + 4 * hh) * 2;
    const LAS unsigned char* aKTT = KTT + 32 * dt * 144 + f144; const LAS unsigned char* bV0 = VT + 32 * vt0 * 144 + f144;
    LAS unsigned char* sst_ = ST + (32 * vt0 + l31) * 272 + (32 * dt + 4 * hh) * 2;
    const LAS float* erp = ER + 32 * dt + 4 * hh; const LAS float* elp = EL + 32 * dt + 4 * hh;
    const LAS unsigned char* aP = PP + 32 * btt * 144 + f144; const LAS unsigned char* bVB = VT + 32 * bvt * 144 + f144;
    const LAS unsigned char* aQ = QT + 32 * btt * 272 + f272; const LAS unsigned char* bS = ST + 32 * bvt * 272 + f272;
    LAS float* ost = OST + (32 * btt + 4 * hh) * 132 + 32 * bvt + l31; const LAS float* oep = OST + et * 132 + 16 * evq;
    LAS unsigned char* tq = QT + 16 * pq * 272 + d * 2; LAS unsigned char* tk = KT + 16 * pq * 272 + d * 2; LAS unsigned char* tkt = KTT + d * 144 + pq * 32; LAS unsigned char* tv = VT + d * 144 + pq * 32;
    f32x16 S0, S1;
#pragma unroll
    for (int i = 0; i < 16; ++i) { S0[i] = 0.f; S1[i] = 0.f; }
    float gq[16]; unsigned qr[16], vr[16]; v4u gt0, gt1;
    float gn[16];
#pragma unroll
    for (int i = 0; i < 16; ++i) gn[i] = F.in[IN_HGNORM][h * 128 + 16 * evq + i];
#define HG_LOAD(c) do { const int ttb = 64 * (c) - 48 + 16 * pq; \
        _Pragma("unroll") for (int i = 0; i < 16; ++i) { const int tt = ttb + i; if (tt >= 0) { const size_t gi = rowof(b, tt) * HW + d; gq[i] = HG[gi]; qr[i] = (unsigned)HQ[gi]; vr[i] = (unsigned)HV[gi]; } else { gq[i] = 0.f; qr[i] = 0u; vr[i] = 0u; } } \
        { const int tt = 64 * (c) - 48 + et; if (tt >= 0) { const GAS v4u* gp = (const GAS v4u*)(HGATE + rowof(b, tt) * HW + 16 * evq); gt0 = gp[0]; gt1 = gp[1]; } else { gt0 = (v4u){0u, 0u, 0u, 0u}; gt1 = gt0; } } } while (0)
    HG_LOAD(0);
    for (int c = 0; c < 33; ++c) {
        float bl[16];
        { float a = 0.f;
#pragma unroll
          for (int i = 0; i < 16; ++i) { a += gq[i]; bl[i] = a; } }
        SEG[pq * 128 + d] = bl[15];
        __syncthreads();
        { const float s0 = SEG[d], s1 = SEG[128 + d], s2 = SEG[256 + d], s3 = SEG[384 + d];
          const float off = pq == 0 ? 0.f : pq == 1 ? s0 : pq == 2 ? s0 + s1 : (s0 + s1) + s2, r = s0 + s1, blast = (s0 + s1) + (s2 + s3);
          unsigned kp[8], vp[8];
#pragma unroll
          for (int i = 0; i < 16; i += 2) {
              const float b0 = off + bl[i], b1 = off + bl[i + 1];
              const float q0 = __builtin_bit_cast(float, qr[i] << 16) * fexp(b0 - r), q1 = __builtin_bit_cast(float, qr[i + 1] << 16) * fexp(b1 - r);
              const float k0 = (1.f - fexp(gq[i])) * fexp(r - b0), k1 = (1.f - fexp(gq[i + 1])) * fexp(r - b1);
              const unsigned kk = pg8::cvt_pk_bf16(k0, k1), qq = pg8::cvt_pk_bf16(q0, q1);
              *(LAS unsigned short*)(tq + i * 272) = (unsigned short)qq; *(LAS unsigned short*)(tq + (i + 1) * 272) = (unsigned short)(qq >> 16);
              *(LAS unsigned short*)(tk + i * 272) = (unsigned short)kk; *(LAS unsigned short*)(tk + (i + 1) * 272) = (unsigned short)(kk >> 16);
              kp[i >> 1] = kk; vp[i >> 1] = vr[i] | (vr[i + 1] << 16); }
          *(LAS v4u*)(tkt) = (v4u){kp[0], kp[1], kp[2], kp[3]}; *(LAS v4u*)(tkt + 16) = (v4u){kp[4], kp[5], kp[6], kp[7]};
          *(LAS v4u*)(tv) = (v4u){vp[0], vp[1], vp[2], vp[3]}; *(LAS v4u*)(tv + 16) = (v4u){vp[4], vp[5], vp[6], vp[7]};
          if (pq == 0) { ER[d] = fexp(r); EL[d] = fexp(blast - r); } }
        const v4u g0 = gt0, g1 = gt1;
        __syncthreads();
        if (c + 1 < 33) HG_LOAD(c + 1);
        asm volatile("" ::: "memory");
        if (wave < 3) {
            f32x16 acc;
#pragma unroll
            for (int i = 0; i < 16; ++i) acc[i] = 0.f;
#pragma unroll
            for (int ks = 0; ks < 8; ++ks) acc = MFMA32(ldf(aK, 32 * ks), ldf(bQ, 32 * ks), acc);
            const int t = 32 * stt + l31;
#pragma unroll
            for (int g4 = 0; g4 < 4; ++g4) { const int s0 = 32 * sst + 8 * g4 + 4 * hh;
                const float x0 = (s0 + 0 <= t) ? acc[4 * g4 + 0] : 0.f, x1 = (s0 + 1 <= t) ? acc[4 * g4 + 1] : 0.f, x2 = (s0 + 2 <= t) ? acc[4 * g4 + 2] : 0.f, x3 = (s0 + 3 <= t) ? acc[4 * g4 + 3] : 0.f;
                *(LAS v2u*)(pst + 16 * g4) = (v2u){pg8::cvt_pk_bf16(x0, x1), pg8::cvt_pk_bf16(x2, x3)}; }
        }
        {
#pragma unroll
          for (int g4 = 0; g4 < 4; ++g4) { const f32x4 er = *(const LAS f32x4*)(erp + 8 * g4);
#pragma unroll
              for (int i = 0; i < 4; ++i) { S0[4 * g4 + i] *= er[i]; S1[4 * g4 + i] *= er[i]; }
              *(LAS v2u*)(sst_ + 16 * g4) = (v2u){pg8::cvt_pk_bf16(S0[4 * g4], S0[4 * g4 + 1]), pg8::cvt_pk_bf16(S0[4 * g4 + 2], S0[4 * g4 + 3])};
              *(LAS v2u*)(sst_ + 32 * 272 + 16 * g4) = (v2u){pg8::cvt_pk_bf16(S1[4 * g4], S1[4 * g4 + 1]), pg8::cvt_pk_bf16(S1[4 * g4 + 2], S1[4 * g4 + 3])}; }
#pragma unroll
          for (int ks = 0; ks < 4; ++ks) { const bf16x8 a = ldf(aKTT, 32 * ks); S0 = MFMA32(a, ldf(bV0, 32 * ks), S0); S1 = MFMA32(a, ldf(bV0, 32 * 144 + 32 * ks), S1); }
#pragma unroll
          for (int g4 = 0; g4 < 4; ++g4) { const f32x4 el = *(const LAS f32x4*)(elp + 8 * g4);
#pragma unroll
              for (int i = 0; i < 4; ++i) { S0[4 * g4 + i] *= el[i]; S1[4 * g4 + i] *= el[i]; } } }
        __syncthreads();
        { f32x16 acc;
#pragma unroll
          for (int i = 0; i < 16; ++i) acc[i] = 0.f;
#pragma unroll
          for (int ks = 0; ks < 4; ++ks) if (ks < 2 || btt == 1) acc = MFMA32(ldf(aP, 32 * ks), ldf(bVB, 32 * ks), acc);
#pragma unroll
          for (int ks = 0; ks < 8; ++ks) acc = MFMA32(ldf(aQ, 32 * ks), ldf(bS, 32 * ks), acc);
#pragma unroll
          for (int i = 0; i < 16; ++i) ost[((i & 3) + 8 * (i >> 2)) * 132] = acc[i]; }
        __syncthreads();
        { const int tt = 64 * c - 48 + et;
          f32x4 o[4]; float ss = 0.f;
#pragma unroll
          for (int j = 0; j < 4; ++j) { o[j] = *(const LAS f32x4*)(oep + 4 * j); ss += (o[j].x * o[j].x + o[j].y * o[j].y) + (o[j].z * o[j].z + o[j].w * o[j].w); }
          ss += __shfl_xor(ss, 1); ss += __shfl_xor(ss, 2); ss += __shfl_xor(ss, 4);
          const float rs = 1.0f / sqrtf(ss * (1.f / 128.f) + EPS);
          if (tt >= NMETA || (tt >= 0 && b == 0)) { const unsigned gw[8] = {g0.x, g0.y, g0.z, g0.w, g1.x, g1.y, g1.z, g1.w}; unsigned w[8];
#pragma unroll
              for (int j = 0; j < 4; ++j) { w[2 * j] = pk2(o[j].x * rs * gn[4 * j] * bflo(gw[2 * j]), o[j].y * rs * gn[4 * j + 1] * bfhi(gw[2 * j])); w[2 * j + 1] = pk2(o[j].z * rs * gn[4 * j + 2] * bflo(gw[2 * j + 1]), o[j].w * rs * gn[4 * j + 3] * bfhi(gw[2 * j + 1])); }
              GAS v4u* yp = (GAS v4u*)(YHG + rowof(b, tt) * HW + 16 * evq); yp[0] = (v4u){w[0], w[1], w[2], w[3]}; yp[1] = (v4u){w[4], w[5], w[6], w[7]}; } }
        __syncthreads();
    }
#undef HG_LOAD
}


#define DPP_F(old, v, ctrl, rmask) __builtin_bit_cast(float, __builtin_amdgcn_update_dpp(__builtin_bit_cast(int, (float)(old)), __builtin_bit_cast(int, (float)(v)), (ctrl), (rmask), 0xf, false))
__device__ __forceinline__ float wave_scan_add(float v) {
    v += DPP_F(0.f, v, 0x111, 0xf); v += DPP_F(0.f, v, 0x112, 0xf); v += DPP_F(0.f, v, 0x114, 0xf); v += DPP_F(0.f, v, 0x118, 0xf);
    v += DPP_F(0.f, v, 0x142, 0xa); v += DPP_F(0.f, v, 0x143, 0xc); return v;
}
__device__ __forceinline__ float wave_scan_max(float v) {
    const float ni = -INFINITY;
    v = fmaxf(v, DPP_F(ni, v, 0x111, 0xf)); v = fmaxf(v, DPP_F(ni, v, 0x112, 0xf)); v = fmaxf(v, DPP_F(ni, v, 0x114, 0xf)); v = fmaxf(v, DPP_F(ni, v, 0x118, 0xf));
    v = fmaxf(v, DPP_F(ni, v, 0x142, 0xa)); v = fmaxf(v, DPP_F(ni, v, 0x143, 0xc)); return v;
}
__device__ __forceinline__ void p3_mlstm_mfma(Frame& F, int bh) {
    unsigned char* ws = F.ws; const int b = bh >> 2, h = bh & 3, tid = F.tid, lane = F.lane, wave = F.wave, hh = lane >> 5, l31 = lane & 31;
    const bf16* MMg = (const bf16*)(ws + WS_MM) + h * 128; const bf16* MOg = (const bf16*)(ws + WS_MO) + h * 128; const float* LI = (const float*)(ws + WS_LI) + h; const float* LF = (const float*)(ws + WS_LF) + h;
    bf16* YML = (bf16*)(ws + WS_YML) + h * 128;
    LAS unsigned char* L = F.lds + RING_OFF;
    LAS unsigned char* CT = L; LAS unsigned char* MT = L + 17408; LAS unsigned char* KM = L + 34816; LAS unsigned char* KW = L + 44032; LAS unsigned char* QM = L + 53248; LAS unsigned char* QW = L + 62464;
    LAS unsigned char* VT = L + 71680; LAS unsigned char* SV = L + 90112; LAS unsigned char* PP = L + 108544; LAS float* OST = (LAS float*)(L + 17408);
    LAS float* SM = (LAS float*)(L + 117760);
    LAS float* U = SM; LAS float* MX = SM + 64; LAS float* BB = SM + 128; LAS float* WSs = SM + 192; LAS float* WI = SM + 256; LAS float* DENP = SM + 320  ; LAS float* NN = SM + 416; LAS float* DENI = SM + 480; LAS float* SC = SM + 544  ; LAS float* GNS = SM + 560  ;
    const int ch = tid & 127, pq = tid >> 7, et = tid >> 3, evq = tid & 7;
    const int f144 = l31 * 144 + hh * 16, f272 = l31 * 272 + hh * 16;
    const int sst = wave == 2 ? 1 : 0, stt = wave == 0 ? 0 : 1, dkt = wave & 1, svt = wave >> 1;
    const LAS unsigned char* cfp = (wave < 4 ? CT : MT) + f272;
    LAS unsigned char* qst = QM + l31 * 144 + (32 * (wave & 1) + 4 * hh) * 2; LAS unsigned char* qwst = QW + l31 * 144 + (32 * (wave & 1) + 4 * hh) * 2;
    const int kdk = 32 * (wave & 1) + l31;
    LAS unsigned char* kmst = KM + 4 * hh * 144 + kdk * 2; LAS unsigned char* kwst = KW + kdk * 144 + 4 * hh * 2; const LAS float* wsp = WSs + 4 * hh;
    LAS unsigned char* vst = VT + (32 * (wave & 3) + l31) * 144 + 4 * hh * 2;
    const LAS unsigned char* aKM = KM + 32 * sst * 144 + f144; const LAS unsigned char* bQM = QM + 32 * stt * 144 + f144;
    LAS unsigned char* pst = PP + (32 * stt + l31) * 144 + (32 * sst + 4 * hh) * 2; const LAS float* up = U + 32 * sst + 4 * hh;
    LAS unsigned char* svst = SV + (32 * svt + l31) * 144 + (32 * dkt + 4 * hh) * 2;
    const LAS unsigned char* aKW = KW + 32 * dkt * 144 + f144; const LAS unsigned char* bVT = VT + 32 * svt * 144 + f144;
    const LAS unsigned char* aP = PP + 32 * dkt * 144 + f144; const LAS unsigned char* aQW = QW + 32 * dkt * 144 + f144; const LAS unsigned char* bSV = SV + 32 * svt * 144 + f144;
    LAS float* ost = OST + (32 * dkt + 4 * hh) * 132 + 32 * svt + l31; const LAS float* oep = OST + et * 132 + 16 * evq;
    LAS unsigned char* tc = CT + 16 * pq * 272 + ch * 2; LAS unsigned char* tm = MT + 16 * pq * 272 + ch * 2;
    bf16x8 wf[8];
    { const float* W = wave < 2 ? F.in[IN_WQ] + (size_t)h * 128 * 64 + 32 * wave + l31 : wave < 4 ? F.in[IN_WK] + (size_t)h * 128 * 64 + 32 * (wave - 2) + l31 : F.in[IN_WV] + (size_t)h * 128 * 128 + 32 * (wave - 4) + l31;
      const int ld = wave < 4 ? 64 : 128; const float sc = wave < 2 ? 0.125f : 1.f;
#pragma unroll
      for (int ks = 0; ks < 8; ++ks) { unsigned p[4];
#pragma unroll
          for (int j = 0; j < 4; ++j) p[j] = pk2(W[(size_t)(16 * ks + 8 * hh + 2 * j) * ld] * sc, W[(size_t)(16 * ks + 8 * hh + 2 * j + 1) * ld] * sc);
          wf[ks] = __builtin_bit_cast(bf16x8, (v4u){p[0], p[1], p[2], p[3]}); } }
    float cw[4]; const float cb = F.in[IN_CONVB][h * 128 + ch];
#pragma unroll
    for (int j = 0; j < 4; ++j) cw[j] = F.in[IN_CONVW][j * HW + h * 128 + ch];
    if (tid < 128) GNS[tid] = F.in[IN_MLNORM][h * 128 + tid]; else if (tid < 256) GNS[tid] = F.in[IN_MLSKIP][h * 128 + tid - 128];
    f32x16 S;
#pragma unroll
    for (int i = 0; i < 16; ++i) S[i] = 0.f;
    float mcar = 0.f, nreg = 0.f;
    unsigned mr[19]; v4u gt0, gt1; float pli = 0.f, plf = 0.f;
#define ML_LOAD(c) do { const int ttb = 64 * (c) - 48 + 16 * pq - 3; \
        _Pragma("unroll") for (int i = 0; i < 19; ++i) { const int tt = ttb + i; mr[i] = tt >= 0 ? (unsigned)MMg[rowof(b, tt) * HW + ch] : 0u; } \
        { const int tt = 64 * (c) - 48 + et; if (tt >= 0) { const GAS v4u* gp = (const GAS v4u*)(MOg + rowof(b, tt) * HW + 16 * evq); gt0 = gp[0]; gt1 = gp[1]; } else { gt0 = (v4u){0u, 0u, 0u, 0u}; gt1 = gt0; } } \
        if (wave == 0) { const int tt = 64 * (c) - 48 + lane; if (tt >= 0) { pli = LI[rowof(b, tt) * 4]; plf = LF[rowof(b, tt) * 4]; } else { pli = -1e30f; plf = 0.f; } } } while (0)
    ML_LOAD(0);
    for (int c = 0; c < 33; ++c) {
#pragma unroll
        for (int i = 0; i < 16; ++i) { const float a = cb + (cw[0] * __builtin_bit_cast(float, mr[i] << 16) + cw[1] * __builtin_bit_cast(float, mr[i + 1] << 16)) + (cw[2] * __builtin_bit_cast(float, mr[i + 2] << 16) + cw[3] * __builtin_bit_cast(float, mr[i + 3] << 16));
            *(LAS unsigned short*)(tc + i * 272) = (unsigned short)f2bf(fsilu(a)); *(LAS unsigned short*)(tm + i * 272) = (unsigned short)mr[i + 3]; }
        if (wave == 0) {
            const float bs = wave_scan_add(plf);
            const float u = pli - bs; const float pm = wave_scan_max(u);
            const float M = fmaxf(mcar, pm), M63 = __shfl(M, 63), b63 = __shfl(bs, 63);
            U[lane] = u; MX[lane] = M; BB[lane] = bs; WSs[lane] = fexp(u - M63); WI[lane] = fexp(mcar - M);
            if (lane == 0) { SC[0] = b63; SC[1] = M63; }
        }
        __syncthreads();
        { f32x16 a0, a1;
#pragma unroll
          for (int i = 0; i < 16; ++i) { a0[i] = 0.f; a1[i] = 0.f; }
          if (wave < 2) {
#pragma unroll
              for (int ks = 0; ks < 8; ++ks) { a0 = MFMA32(wf[ks], ldf(cfp, 32 * ks), a0); a1 = MFMA32(wf[ks], ldf(cfp, 32 * 272 + 32 * ks), a1); }
              const float wi0 = WI[l31], wi1 = WI[32 + l31];
#pragma unroll
              for (int g4 = 0; g4 < 4; ++g4) {
                  *(LAS v2u*)(qst + 16 * g4) = (v2u){pg8::cvt_pk_bf16(a0[4 * g4], a0[4 * g4 + 1]), pg8::cvt_pk_bf16(a0[4 * g4 + 2], a0[4 * g4 + 3])};
                  *(LAS v2u*)(qst + 32 * 144 + 16 * g4) = (v2u){pg8::cvt_pk_bf16(a1[4 * g4], a1[4 * g4 + 1]), pg8::cvt_pk_bf16(a1[4 * g4 + 2], a1[4 * g4 + 3])};
                  *(LAS v2u*)(qwst + 16 * g4) = (v2u){pg8::cvt_pk_bf16(a0[4 * g4] * wi0, a0[4 * g4 + 1] * wi0), pg8::cvt_pk_bf16(a0[4 * g4 + 2] * wi0, a0[4 * g4 + 3] * wi0)};
                  *(LAS v2u*)(qwst + 32 * 144 + 16 * g4) = (v2u){pg8::cvt_pk_bf16(a1[4 * g4] * wi1, a1[4 * g4 + 1] * wi1), pg8::cvt_pk_bf16(a1[4 * g4 + 2] * wi1, a1[4 * g4 + 3] * wi1)}; }
          } else {
#pragma unroll
              for (int ks = 0; ks < 8; ++ks) { a0 = MFMA32(ldf(cfp, 32 * ks), wf[ks], a0); a1 = MFMA32(ldf(cfp, 32 * 272 + 32 * ks), wf[ks], a1); }
              if (wave < 4) {
                  float nsum = 0.f;
#pragma unroll
                  for (int g4 = 0; g4 < 4; ++g4) { const f32x4 w0 = *(const LAS f32x4*)(wsp + 8 * g4), w1 = *(const LAS f32x4*)(wsp + 32 + 8 * g4);
#pragma unroll
                      for (int i = 0; i < 4; ++i) { *(LAS unsigned short*)(kmst + (8 * g4 + i) * 144) = (unsigned short)f2bf(a0[4 * g4 + i]); *(LAS unsigned short*)(kmst + (32 + 8 * g4 + i) * 144) = (unsigned short)f2bf(a1[4 * g4 + i]); }
                      const float x0 = a0[4 * g4] * w0[0], x1 = a0[4 * g4 + 1] * w0[1], x2 = a0[4 * g4 + 2] * w0[2], x3 = a0[4 * g4 + 3] * w0[3];
                      const float y0 = a1[4 * g4] * w1[0], y1 = a1[4 * g4 + 1] * w1[1], y2 = a1[4 * g4 + 2] * w1[2], y3 = a1[4 * g4 + 3] * w1[3];
                      nsum += ((x0 + x1) + (x2 + x3)) + ((y0 + y1) + (y2 + y3));
                      *(LAS v2u*)(kwst + 16 * g4) = (v2u){pg8::cvt_pk_bf16(x0, x1), pg8::cvt_pk_bf16(x2, x3)};
                      *(LAS v2u*)(kwst + 64 + 16 * g4) = (v2u){pg8::cvt_pk_bf16(y0, y1), pg8::cvt_pk_bf16(y2, y3)}; }
                  nsum += __shfl_xor(nsum, 32);
                  if (hh == 0) NN[kdk] = nreg;
                  nreg = fexp(mcar - SC[1]) * nreg + nsum;
              } else {
#pragma unroll
                  for (int g4 = 0; g4 < 4; ++g4) {
                      *(LAS v2u*)(vst + 16 * g4) = (v2u){pg8::cvt_pk_bf16(a0[4 * g4], a0[4 * g4 + 1]), pg8::cvt_pk_bf16(a0[4 * g4 + 2], a0[4 * g4 + 3])};
                      *(LAS v2u*)(vst + 64 + 16 * g4) = (v2u){pg8::cvt_pk_bf16(a1[4 * g4], a1[4 * g4 + 1]), pg8::cvt_pk_bf16(a1[4 * g4 + 2], a1[4 * g4 + 3])}; }
              }
          } }
        __syncthreads();
        const v4u g0 = gt0, g1 = gt1;
        if (c + 1 < 33) ML_LOAD(c + 1);
        asm volatile("" ::: "memory");
        if (wave < 3) {
            f32x16 acc;
#pragma unroll
            for (int i = 0; i < 16; ++i) acc[i] = 0.f;
#pragma unroll
            for (int ks = 0; ks < 4; ++ks) acc = MFMA32(ldf(aKM, 32 * ks), ldf(bQM, 32 * ks), acc);
            const int t = 32 * stt + l31; const float mt = MX[t]; float dsum = 0.f;
#pragma unroll
            for (int g4 = 0; g4 < 4; ++g4) { const int s0 = 32 * sst + 8 * g4 + 4 * hh; const f32x4 us = *(const LAS f32x4*)(up + 8 * g4);
                const float x0 = (s0 + 0 <= t) ? acc[4 * g4 + 0] * fexp(us[0] - mt) : 0.f, x1 = (s0 + 1 <= t) ? acc[4 * g4 + 1] * fexp(us[1] - mt) : 0.f;
                const float x2 = (s0 + 2 <= t) ? acc[4 * g4 + 2] * fexp(us[2] - mt) : 0.f, x3 = (s0 + 3 <= t) ? acc[4 * g4 + 3] * fexp(us[3] - mt) : 0.f;
                dsum += (x0 + x1) + (x2 + x3);
                *(LAS v2u*)(pst + 16 * g4) = (v2u){pg8::cvt_pk_bf16(x0, x1), pg8::cvt_pk_bf16(x2, x3)}; }
            dsum += __shfl_xor(dsum, 32);
            if (hh == 0) DENP[wave * 32 + l31] = dsum;
        } else if (wave == 3) {
            float a = 0.f;
#pragma unroll 2
            for (int j = 0; j < 8; ++j) { const v4u q = *(const LAS v4u*)(QW + lane * 144 + 16 * j); const f32x4 n0 = *(const LAS f32x4*)(NN + 8 * j), n1 = *(const LAS f32x4*)(NN + 8 * j + 4);
                a += (bflo(q.x) * n0[0] + bfhi(q.x) * n0[1]) + (bflo(q.y) * n0[2] + bfhi(q.y) * n0[3]) + (bflo(q.z) * n1[0] + bfhi(q.z) * n1[1]) + (bflo(q.w) * n1[2] + bfhi(q.w) * n1[3]); }
            DENI[lane] = a;
        }
        { const float wp = fexp(mcar - SC[1]);
#pragma unroll
          for (int g4 = 0; g4 < 4; ++g4) {
              *(LAS v2u*)(svst + 16 * g4) = (v2u){pg8::cvt_pk_bf16(S[4 * g4], S[4 * g4 + 1]), pg8::cvt_pk_bf16(S[4 * g4 + 2], S[4 * g4 + 3])};
#pragma unroll
              for (int i = 0; i < 4; ++i) S[4 * g4 + i] *= wp; }
#pragma unroll
          for (int ks = 0; ks < 4; ++ks) S = MFMA32(ldf(aKW, 32 * ks), ldf(bVT, 32 * ks), S); }
        __syncthreads();
        { f32x16 acc;
#pragma unroll
          for (int i = 0; i < 16; ++i) acc[i] = 0.f;
#pragma unroll
          for (int ks = 0; ks < 4; ++ks) if (ks < 2 || dkt == 1) acc = MFMA32(ldf(aP, 32 * ks), ldf(bVT, 32 * ks), acc);
#pragma unroll
          for (int ks = 0; ks < 4; ++ks) acc = MFMA32(ldf(aQW, 32 * ks), ldf(bSV, 32 * ks), acc);
#pragma unroll
          for (int i = 0; i < 16; ++i) ost[((i & 3) + 8 * (i >> 2)) * 132] = acc[i]; }
        __syncthreads();
        { const int tt = 64 * c - 48 + et;
          const float den = (et < 32 ? DENP[et] : DENP[et] + DENP[32 + et]) + DENI[et];
          const float inv = 1.0f / fmaxf(fabsf(den), fexp(-(BB[et] + MX[et])));
          f32x4 o[4]; float ss = 0.f;
#pragma unroll
          for (int j = 0; j < 4; ++j) { o[j] = *(const LAS f32x4*)(oep + 4 * j) * inv; ss += (o[j].x * o[j].x + o[j].y * o[j].y) + (o[j].z * o[j].z + o[j].w * o[j].w); }
          ss += __shfl_xor(ss, 1); ss += __shfl_xor(ss, 2); ss += __shfl_xor(ss, 4);
          const float rs = 1.0f / sqrtf(ss * (1.f / 128.f) + EPS);
          if (tt >= NMETA || (tt >= 0 && b == 0)) { const unsigned gw[8] = {g0.x, g0.y, g0.z, g0.w, g1.x, g1.y, g1.z, g1.w}; unsigned w[8];
              const v4u c0 = *(const LAS v4u*)(CT + et * 272 + 32 * evq), c1 = *(const LAS v4u*)(CT + et * 272 + 32 * evq + 16); const unsigned cwd[8] = {c0.x, c0.y, c0.z, c0.w, c1.x, c1.y, c1.z, c1.w};
#pragma unroll
              for (int j = 0; j < 4; ++j) { const f32x4 gn = *(const LAS f32x4*)(GNS + 16 * evq + 4 * j), sk = *(const LAS f32x4*)(GNS + 128 + 16 * evq + 4 * j);
                  w[2 * j] = pk2((o[j].x * rs * gn[0] + sk[0] * bflo(cwd[2 * j])) * bflo(gw[2 * j]), (o[j].y * rs * gn[1] + sk[1] * bfhi(cwd[2 * j])) * bfhi(gw[2 * j]));
                  w[2 * j + 1] = pk2((o[j].z * rs * gn[2] + sk[2] * bflo(cwd[2 * j + 1])) * bflo(gw[2 * j + 1]), (o[j].w * rs * gn[3] + sk[3] * bfhi(cwd[2 * j + 1])) * bfhi(gw[2 * j + 1])); }
              GAS v4u* yp = (GAS v4u*)(YML + rowof(b, tt) * HW + 16 * evq); yp[0] = (v4u){w[0], w[1], w[2], w[3]}; yp[1] = (v4u){w[4], w[5], w[6], w[7]}; }
          mcar = SC[0] + SC[1]; }
        __syncthreads();
    }
#undef ML_LOAD
}

typedef float f32x4v __attribute__((ext_vector_type(4)));
#define MFMA16F(a, b, c) __builtin_amdgcn_mfma_f32_16x16x4f32(a, b, c, 0, 0, 0)
constexpr int RW_LD = 516;
__device__ __forceinline__ void router_topk16(LAS float* LGw, int V, float rsv, int resrow, int lane, LAS int* hist, LAS int* res, int* TOPE, float* TOPW, float* RS) {
    if (lane < 16) {
        int se[4]; float sv[4];
#pragma unroll
        for (int k = 0; k < 4; ++k) { float best = -INFINITY; int bi = 0;
            for (int e = 0; e < 32; ++e) { const float v = LGw[lane * 33 + e]; if (v > best) { best = v; bi = e; } }
            se[k] = bi; sv[k] = best; LGw[lane * 33 + bi] = -INFINITY; }
        const float e1 = __expf(sv[1] - sv[0]), e2 = __expf(sv[2] - sv[0]), e3 = __expf(sv[3] - sv[0]), inv = 1.0f / (1.f + e1 + e2 + e3);
        const float w4[4] = {inv, e1 * inv, e2 * inv, e3 * inv};
#pragma unroll
        for (int k = 0; k < 4; ++k) { const int lp = __hip_atomic_fetch_add(hist + se[k], 1, __ATOMIC_RELAXED, __HIP_MEMORY_SCOPE_WORKGROUP);
            TOPE[(size_t)V * 4 + k] = se[k]; TOPW[(size_t)V * 4 + k] = w4[k]; res[(resrow + lane) * 4 + k] = lp; }
        RS[V] = rsv;
    }
}
__device__ __forceinline__ void p6_router(Frame& F) {
    unsigned char* ws = F.ws;
    const float* H1 = (const float*)(ws + WS_H1); const float* RWT = (const float*)(ws + WS_RWT);
    int* TOPE = (int*)(ws + WS_TOPE); int* TOPP = (int*)(ws + WS_TOPP); float* TOPW = (float*)(ws + WS_TOPW); float* RS = (float*)(ws + WS_RS);
    int* ETOK = (int*)(ws + WS_ETOK); float* ERS = (float*)(ws + WS_ERS); float* EW = (float*)(ws + WS_EW);
    LAS float* rw = (LAS float*)(F.lds + RING_OFF);
    LAS float* LG = (LAS float*)(F.lds + RING_OFF + 66048) + F.wave * 528;
    LAS int* hist = (LAS int*)(F.lds + RING_OFF + 66048 + 8 * 2112);
    LAS int* res = hist + 64;
    LAS float* XP = (LAS float*)(res + 144 * 4);
    LAS float* XQ = XP + 8 * 528;
    const int lane = F.lane, wave = F.wave, i16 = lane & 15, kk = lane >> 4;
    constexpr int RPW = NTOK / 256;
    const bool has_meta = (F.vcu == 0);
    const int Vbase = F.vcu * RPW, Vt = Vbase + 16 * wave;
    if (F.tid < 64) hist[F.tid] = 0;
    f32x4v acc0 = {0.f, 0.f, 0.f, 0.f}, acc1 = {0.f, 0.f, 0.f, 0.f}, acx0 = {0.f, 0.f, 0.f, 0.f}, acx1 = {0.f, 0.f, 0.f, 0.f}; float ssq = 0.f, xss = 0.f;
    const float* arow = H1 + (size_t)(Vt + i16) * D + 4 * kk;
    const float* xrow = H1 + (size_t)(NTOK + i16) * D + 4 * kk;
    f32x4 a0[8], a1[8];
#define RT_MMA(A, SB, C0, C1, SS) do { const LAS float* b0p = rw + i16 * RW_LD + 4 * kk + 128 * (SB); const LAS float* b1p = rw + (16 + i16) * RW_LD + 4 * kk + 128 * (SB); \
        _Pragma("unroll") for (int s = 0; s < 8; ++s) { const f32x4 a = A[s]; const f32x4 b0 = *(const LAS f32x4*)(b0p + 16 * s), b1 = *(const LAS f32x4*)(b1p + 16 * s); \
            SS += (a.x * a.x + a.y * a.y) + (a.z * a.z + a.w * a.w); \
            C0 = MFMA16F(a.x, b0.x, C0); C1 = MFMA16F(a.x, b1.x, C1); C0 = MFMA16F(a.y, b0.y, C0); C1 = MFMA16F(a.y, b1.y, C1); \
            C0 = MFMA16F(a.z, b0.z, C0); C1 = MFMA16F(a.z, b1.z, C1); C0 = MFMA16F(a.w, b0.w, C0); C1 = MFMA16F(a.w, b1.w, C1); } } while (0)
#pragma unroll
    for (int s = 0; s < 8; ++s) a0[s] = *(const GAS f32x4*)(arow + 16 * s);
#pragma unroll 1
    for (int it = 0; it < 4; ++it) {
        const int half = it >> 1, sb0 = (2 * it) & 3;
        if ((it & 1) == 0) {
            __syncthreads();
            { f32x4 stg[8];
#pragma unroll
              for (int q = 0; q < 8; ++q) { const int u = F.tid + q * NTHREADS, e = u >> 7, c = u & 127; stg[q] = *(const GAS f32x4*)(RWT + (size_t)e * D + 512 * half + 4 * c); }
#pragma unroll
              for (int q = 0; q < 8; ++q) { const int u = F.tid + q * NTHREADS, e = u >> 7, c = u & 127; *(LAS f32x4*)(rw + e * RW_LD + 4 * c) = stg[q]; } }
            __syncthreads();
        }
#pragma unroll
        for (int s = 0; s < 8; ++s) a1[s] = *(const GAS f32x4*)(arow + 128 * (2 * it + 1) + 16 * s);
        RT_MMA(a0, sb0, acc0, acc1, ssq);
        if (it < 3) {
#pragma unroll
            for (int s = 0; s < 8; ++s) a0[s] = *(const GAS f32x4*)(arow + 128 * (2 * it + 2) + 16 * s);
        }
        RT_MMA(a1, sb0 + 1, acc0, acc1, ssq);
        if (has_meta && (wave >> 1) == it) {
            f32x4 ax[8];
#pragma unroll
            for (int s = 0; s < 8; ++s) ax[s] = *(const GAS f32x4*)(xrow + 128 * wave + 16 * s);
            RT_MMA(ax, wave & 3, acx0, acx1, xss);
        }
    }
#undef RT_MMA
    if (has_meta) {
        xss += __shfl_xor(xss, 16); xss += __shfl_xor(xss, 32);
#pragma unroll
        for (int r = 0; r < 4; ++r) { XP[wave * 528 + (4 * kk + r) * 33 + i16] = acx0[r]; XP[wave * 528 + (4 * kk + r) * 33 + 16 + i16] = acx1[r]; }
        if (kk == 0) XQ[wave * 16 + i16] = xss;
    }
    ssq += __shfl_xor(ssq, 16); ssq += __shfl_xor(ssq, 32);
    const float rsrow = 1.0f / sqrtf(ssq * (1.f / D) + EPS);
    const float rb0 = F.in[IN_RB][i16], rb1 = F.in[IN_RB][16 + i16];
#pragma unroll
    for (int r = 0; r < 4; ++r) { const float rsr = __shfl(rsrow, 4 * kk + r); LG[(4 * kk + r) * 33 + i16] = acc0[r] * rsr + rb0; LG[(4 * kk + r) * 33 + 16 + i16] = acc1[r] * rsr + rb1; }
    LDS_WAIT(); asm volatile("" ::: "memory");
    router_topk16(LG, Vt + lane, rsrow, 16 * wave, lane, hist, res, TOPE, TOPW, RS);
    __syncthreads();
    if (has_meta && wave == 7) {
        float q = 0.f;
#pragma unroll
        for (int w = 0; w < 8; ++w) q += XQ[w * 16 + i16];
        const float rsm = 1.0f / sqrtf(q * (1.f / D) + EPS);
#pragma unroll
        for (int r = 0; r < 4; ++r) { float v0 = 0.f, v1 = 0.f;
#pragma unroll
            for (int w = 0; w < 8; ++w) { v0 += XP[w * 528 + (4 * kk + r) * 33 + i16]; v1 += XP[w * 528 + (4 * kk + r) * 33 + 16 + i16]; }
            const float rsr = __shfl(rsm, 4 * kk + r); LG[(4 * kk + r) * 33 + i16] = v0 * rsr + rb0; LG[(4 * kk + r) * 33 + 16 + i16] = v1 * rsr + rb1; }
        LDS_WAIT(); asm volatile("" ::: "memory");
        router_topk16(LG, NTOK + lane, rsm, 128, lane, hist, res, TOPE, TOPW, RS);
    }
    __syncthreads();
    if (F.tid < NE) hist[32 + F.tid] = (int)__hip_atomic_fetch_add(F.ctl + CW_CNT + 64 * F.tid, (unsigned)hist[F.tid], RLX_AGENT);
    __syncthreads();
    const int nrows = has_meta ? RPW + 16 : RPW;
    for (int u = F.tid; u < nrows * 4; u += NTHREADS) { const int rr = u >> 2, V = rr < RPW ? Vbase + rr : NTOK + (rr - RPW); const size_t gi = (size_t)V * 4 + (u & 3); const int e = TOPE[gi], pos = hist[32 + e] + res[u];
        TOPP[gi] = pos; ETOK[(size_t)e * NV + pos] = V; ERS[(size_t)e * NV + pos] = RS[V]; EW[(size_t)e * NV + pos] = TOPW[gi]; }
}

__device__ __forceinline__ void build_tables(Frame& F) {
    LAS int* pst = (LAS int*)(F.lds + PST_OFF); LAS unsigned char* texp = (LAS unsigned char*)(F.lds + TEXP_OFF);
    __syncthreads();
    if (F.tid < 64) {
        const int e = F.lane & 31; const int c = (int)__hip_atomic_load(F.ctl + CW_CNT + 64 * e, RLX_AGENT); const int nt = (c + 255) >> 8;
        int incl = nt;
#pragma unroll
        for (int o = 1; o < 32; o <<= 1) { const int t = __shfl_up(incl, o); if ((F.lane & 31) >= o) incl += t; }
        const int start = incl - nt;
        if (F.lane < 32) { pst[e] = start * 256; pst[33 + e] = c; for (int j = 0; j < nt && start + j < MAXTILES; ++j) texp[start + j] = (unsigned char)e; if (e == 31) pst[32] = incl < MAXTILES ? incl : MAXTILES; }
    }
    __syncthreads();
}
typedef float f32v2_t __attribute__((ext_vector_type(2)));
__device__ __forceinline__ void p10_combine(Frame& F) {
    unsigned char* ws = F.ws; build_tables(F);
    const LAS int* pst = (const LAS int*)(F.lds + PST_OFF);
    const float* H1 = (const float*)(ws + WS_H1); const unsigned char* YB = (const unsigned char*)(ws + WS_YB);
    const int* TOPE = (const int*)(ws + WS_TOPE); const int* TOPP = (const int*)(ws + WS_TOPP);
    const int gw = F.vcu * NWAVES + F.wave, NGW = F.G * NWAVES;
    const GAS f32x4* nf = (const GAS f32x4*)F.in[IN_NFIN] + F.lane; f32x4 nfv[4];
#pragma unroll
    for (int j = 0; j < 4; ++j) nfv[j] = nf[64 * j];
    int sl[2][4];
#define CMB_SLOTS(Rbase) do { _Pragma("unroll") for (int q = 0; q < 2; ++q) { const int R = (Rbase) + q * NGW; if (R < BATCH * SEQ) { const size_t V = (size_t)R; \
        _Pragma("unroll") for (int k = 0; k < 4; ++k) sl[q][k] = pst[TOPE[V * 4 + k]] + TOPP[V * 4 + k]; } else { _Pragma("unroll") for (int k = 0; k < 4; ++k) sl[q][k] = 0; } } } while (0)
    CMB_SLOTS(gw);
    for (int R0 = gw; R0 < BATCH * SEQ; R0 += 2 * NGW) {
        f32x4 v[2][4]; unsigned y[2][4][4];
#pragma unroll
        for (int q = 0; q < 2; ++q) { const int R = (R0 + q * NGW < BATCH * SEQ) ? R0 + q * NGW : R0; const size_t V = (size_t)R;
            const GAS f32x4* hr = (const GAS f32x4*)(H1 + V * D) + F.lane;
#pragma unroll
            for (int j = 0; j < 4; ++j) v[q][j] = hr[64 * j];
#pragma unroll
            for (int k = 0; k < 4; ++k) { const GAS unsigned* yr = (const GAS unsigned*)(YB + (size_t)sl[q][k] * D) + F.lane;
#pragma unroll
                for (int j = 0; j < 4; ++j) y[q][k][j] = yr[64 * j]; } }
        CMB_SLOTS(R0 + 2 * NGW);
#pragma unroll
        for (int q = 0; q < 2; ++q) { const int R = R0 + q * NGW; if (R >= BATCH * SEQ) continue;
#pragma unroll
            for (int k = 0; k < 4; ++k)
#pragma unroll
                for (int j = 0; j < 4; ++j) { const unsigned w = y[q][k][j]; const f32v2_t lo = __builtin_amdgcn_cvt_pk_f32_fp8(w, false), hi = __builtin_amdgcn_cvt_pk_f32_fp8(w, true);
                    v[q][j].x += lo[0] * 0.0625f; v[q][j].y += lo[1] * 0.0625f; v[q][j].z += hi[0] * 0.0625f; v[q][j].w += hi[1] * 0.0625f; }
            float s = 0.f;
#pragma unroll
            for (int j = 0; j < 4; ++j) s += (v[q][j].x * v[q][j].x + v[q][j].y * v[q][j].y) + (v[q][j].z * v[q][j].z + v[q][j].w * v[q][j].w);
            const float rs = 1.0f / sqrtf(wave_sum(s) * (1.f / D) + EPS);
            GAS f32x4* orow = (GAS f32x4*)(F.out + (size_t)R * D) + F.lane;
#pragma unroll
            for (int j = 0; j < 4; ++j) orow[64 * j] = v[q][j] * rs * nfv[j]; }
    }
#undef CMB_SLOTS
}

__device__ __forceinline__ int meta_row(int lane) { return ((lane >> 5) & 1) * 8 + ((lane >> 4) & 1) * 4 + ((lane >> 3) & 1) * 2 + ((lane >> 2) & 1); }
template <int KPL> __device__ __forceinline__ float meta_col(const LAS unsigned char* A, const bf16* wrow, int lane) {
    constexpr int K = 64 * KPL; float w[KPL];
#pragma unroll
    for (int j = 0; j < KPL / 8; ++j) { const v4u x = *(const GAS v4u*)(wrow + lane * KPL + 8 * j);
        w[8 * j] = bflo(x.x); w[8 * j + 1] = bfhi(x.x); w[8 * j + 2] = bflo(x.y); w[8 * j + 3] = bfhi(x.y); w[8 * j + 4] = bflo(x.z); w[8 * j + 5] = bfhi(x.z); w[8 * j + 6] = bflo(x.w); w[8 * j + 7] = bfhi(x.w); }
    float p[16];
#pragma unroll
    for (int r = 0; r < 16; ++r) { float s = 0.f;
#pragma unroll
        for (int j = 0; j < KPL / 8; ++j) { const v4u a = *(const LAS v4u*)(A + (r * K + lane * KPL + 8 * j) * 2);
            s += (bflo(a.x) * w[8 * j] + bfhi(a.x) * w[8 * j + 1]) + (bflo(a.y) * w[8 * j + 2] + bfhi(a.y) * w[8 * j + 3]) + (bflo(a.z) * w[8 * j + 4] + bfhi(a.z) * w[8 * j + 5]) + (bflo(a.w) * w[8 * j + 6] + bfhi(a.w) * w[8 * j + 7]); }
        p[r] = s; if ((r & 3) == 3) asm volatile("" ::: "memory"); }
    const bool b32 = lane & 32, b16 = lane & 16, b8 = lane & 8, b4 = lane & 4;
    float q8[8], q4[4], q2[2];
#pragma unroll
    for (int i = 0; i < 8; ++i) { const float keep = b32 ? p[i + 8] : p[i], send = b32 ? p[i] : p[i + 8]; q8[i] = keep + __shfl_xor(send, 32); }
#pragma unroll
    for (int i = 0; i < 4; ++i) { const float keep = b16 ? q8[i + 4] : q8[i], send = b16 ? q8[i] : q8[i + 4]; q4[i] = keep + __shfl_xor(send, 16); }
#pragma unroll
    for (int i = 0; i < 2; ++i) { const float keep = b8 ? q4[i + 2] : q4[i], send = b8 ? q4[i] : q4[i + 2]; q2[i] = keep + __shfl_xor(send, 8); }
    float v = (b4 ? q2[1] : q2[0]) + __shfl_xor(b4 ? q2[0] : q2[1], 4);
    v += __shfl_xor(v, 2); v += __shfl_xor(v, 1);
    return v;
}
__device__ __forceinline__ void meta_stage(Frame& F, LAS unsigned char* dst, const bf16* src, int K) {
    v4u t[4]; const int n = 16 * K / 8;
#pragma unroll
    for (int q = 0; q < 4; ++q) { const int u = F.tid + q * NTHREADS; if (u < n) t[q] = *(const GAS v4u*)(src + (size_t)u * 8); }
#pragma unroll
    for (int q = 0; q < 4; ++q) { const int u = F.tid + q * NTHREADS; if (u < n) *(LAS v4u*)(dst + u * 16) = t[q]; }
}
__device__ __forceinline__ void meta_proj(Frame& F) {
    unsigned char* ws = F.ws; const bf16* WIN = (const bf16*)(ws + WS_WIN); const float* lbl = F.in[IN_LBL];
    LAS unsigned char* A = F.lds + RING_OFF;
    __syncthreads(); meta_stage(F, A, (const bf16*)(ws + WS_XN0) + (size_t)NTOK * D, D); __syncthreads();
    for (int c = F.vcu * NWAVES + F.wave; c < NPROJ; c += F.G * NWAVES) {
        const float v = meta_col<16>(A, WIN + (size_t)c * D, F.lane);
        if ((F.lane & 3) == 0) { const size_t row = NTOK + meta_row(F.lane); const int kind = c < 3072 ? (c >> 9) : 6, cc = c & 511;
            if (kind == 0) ((bf16*)(ws + WS_HQ))[row * HW + cc] = (bf16)f2bf(fsilu(v));
            else if (kind == 1) { const float lb = fsigmoid(lbl[cc] - lbl[HW + cc]); ((float*)(ws + WS_HG))[row * HW + cc] = __logf(lb + (1.f - lb) * fsigmoid(v)); }
            else if (kind == 2) ((bf16*)(ws + WS_HV))[row * HW + cc] = (bf16)f2bf(v);
            else if (kind == 3) ((bf16*)(ws + WS_HGATE))[row * HW + cc] = (bf16)f2bf(fsilu(v));
            else if (kind == 4) ((bf16*)(ws + WS_MM))[row * HW + cc] = (bf16)f2bf(v);
            else if (kind == 5) ((bf16*)(ws + WS_MO))[row * HW + cc] = (bf16)f2bf(fsigmoid(v));
            else ((bf16*)(ws + WS_GATES))[row * 2048 + (c - 3072)] = (bf16)f2bf(fsigmoid(v)); } }
}
__device__ __forceinline__ void meta_merged(Frame& F) {
    unsigned char* ws = F.ws; const bf16* GATES = (const bf16*)(ws + WS_GATES);
    LAS unsigned char* A0 = F.lds + RING_OFF; LAS unsigned char* A1 = A0 + 16 * HW * 2;
    __syncthreads(); meta_stage(F, A0, (const bf16*)(ws + WS_YHG) + (size_t)NTOK * HW, HW); meta_stage(F, A1, (const bf16*)(ws + WS_YML) + (size_t)NTOK * HW, HW); __syncthreads();
    for (int c = F.vcu * NWAVES + F.wave; c < D; c += F.G * NWAVES) {
        const float vh = meta_col<8>(A0, (const bf16*)(ws + WS_WBH) + (size_t)c * HW, F.lane), vm = meta_col<8>(A1, (const bf16*)(ws + WS_WBM) + (size_t)c * HW, F.lane);
        if ((F.lane & 3) == 0) { const size_t row = NTOK + meta_row(F.lane); ((bf16*)(ws + WS_MERGED))[row * D + c] = (bf16)f2bf(bf1(GATES[row * 2048 + c]) * vh + bf1(GATES[row * 2048 + D + c]) * vm); } }
}
__device__ __forceinline__ void meta_wout(Frame& F) {
    unsigned char* ws = F.ws; LAS unsigned char* A = F.lds + RING_OFF;
    __syncthreads(); meta_stage(F, A, (const bf16*)(ws + WS_MERGED) + (size_t)NTOK * D, D); __syncthreads();
    for (int c = F.vcu * NWAVES + F.wave; c < D; c += F.G * NWAVES) {
        const float d = meta_col<16>(A, (const bf16*)(ws + WS_WOUT) + (size_t)c * D, F.lane);
        if ((F.lane & 3) == 0) { const int mr_ = meta_row(F.lane); const size_t row = NTOK + mr_; const float v = F.in[IN_META][(size_t)mr_ * D + c] + d;
            ((float*)(ws + WS_H1))[row * D + c] = v; ((unsigned char*)(ws + WS_H1B))[row * D + c] = (unsigned char)(__builtin_amdgcn_cvt_pk_fp8_f32(__builtin_amdgcn_fmed3f(v, -448.f, 448.f), 0.f, 0u, false) & 0xffu); } }
}

__device__ __forceinline__ void ph_proj(Frame& F) {
    unsigned char* ws = F.ws;
    pg8::Gemm g{(const pg8::bf16_t*)(ws + WS_XN0), (const pg8::bf16_t*)(ws + WS_WIN), NTOK, NPROJ, D}; pg8::StaticOrder S; S.init(NTOK, NPROJ, F.G, (int)blockIdx.x);
    pg8::EpiProj E{ws, F.in[IN_LBL]};
    pg8::gemm_phase<pg8::EpiProj, pg8::StaticOrder, true, true>(F.lds + RING_OFF, g, S, E);
    meta_proj(F);
}
__device__ __forceinline__ void ph_scan(Frame& F) {
    const int sb = (int)blockIdx.x;
    if (sb < 64) p3_hgrn2_mfma(F, sb); else if (sb < 128) p3_mlstm_mfma(F, sb - 64);
#if !CONV_IN_P0
    else px_experts(F, sb - 128, F.G - 128);
#endif
}
__device__ __forceinline__ void ph_merged(Frame& F) {
    unsigned char* ws = F.ws;
    static_assert(WS_YML - WS_YHG == (size_t)pg8::PAIR_DA * 256 * HW * 2 && WS_WBM - WS_WBH == (size_t)pg8::PAIR_DB * 256 * HW * 2, "the second branch's operands sit a whole number of tiles behind the first's");
    pg8::PairOrder S; S.S.init(NTOK, D, F.G, (int)blockIdx.x);
    pg8::Gemm g{(const pg8::bf16_t*)(ws + WS_YHG), (const pg8::bf16_t*)(ws + WS_WBH), NTOK, D, HW};
    pg8::EpiGate2 E{(const pg8::bf16_t*)(ws + WS_GATES), (pg8::bf16_t*)(ws + WS_TMP), (pg8::bf16_t*)(ws + WS_MERGED)};
    pg8::gemm_phase<pg8::EpiGate2, pg8::PairOrder, true, true>(F.lds + RING_OFF, g, S, E);
    meta_merged(F);
}
__device__ __forceinline__ void ph_wout(Frame& F) {
    unsigned char* ws = F.ws;
    pg8::Gemm g{(const pg8::bf16_t*)(ws + WS_MERGED), (const pg8::bf16_t*)(ws + WS_WOUT), NTOK, D, D}; pg8::StaticOrder S; S.init(NTOK, D, F.G, (int)blockIdx.x);
    pg8::EpiH1 E{F.in[IN_X], F.in[IN_META], (float*)(ws + WS_H1), (unsigned char*)(ws + WS_H1B)};
    pg8::gemm_phase<pg8::EpiH1, pg8::StaticOrder, true, true>(F.lds + RING_OFF, g, S, E);
    meta_wout(F);
}
__device__ __forceinline__ void ph_gu(Frame& F) {
    unsigned char* ws = F.ws; build_tables(F);
    const LAS int* pst = (const LAS int*)(F.lds + PST_OFF); LAS unsigned short* tok16 = (LAS unsigned short*)(F.lds + TOK_OFF);
    pg8::Gemm g{(const pg8::bf16_t*)(ws + WS_H1B), (const pg8::bf16_t*)(ws + WS_WGU), NV, NE * 2 * DFF, D / 2};
    pg8::GroupOrder S{pst[32], 8, F.G, (int)blockIdx.x, (const LAS unsigned char*)(F.lds + TEXP_OFF)};
    { const int* ETOK = (const int*)(ws + WS_ETOK);
      int tokv[18];
#pragma unroll
      for (int i = 0; i < 18; ++i) { pg8::Unit u; int t = 0; if (S.next(i, u) && F.tid < 256) { const int e = u.pn >> 3, pos = u.pm * 256 - pst[e] + F.tid; if (pos < pst[33 + e]) t = ETOK[(size_t)e * NV + pos]; } tokv[i] = t; }
      if (F.tid < 256) {
#pragma unroll
          for (int i = 0; i < 18; ++i) tok16[i * 256 + F.tid] = (unsigned short)tokv[i]; }
      __syncthreads(); }
    pg8::EpiGU E{(const float*)(ws + WS_BGUP), (const float*)(ws + WS_ERS), (unsigned char*)(ws + WS_ACT), pst};
    pg8::gemm_phase_g<pg8::EpiGU, pg8::GroupOrder, true>(F.lds + RING_OFF, g, S, E, tok16);
}
__device__ __forceinline__ void ph_down(Frame& F) {
    unsigned char* ws = F.ws; build_tables(F);
    pg8::Gemm g{(const pg8::bf16_t*)(ws + WS_ACT), (const pg8::bf16_t*)(ws + WS_WDN), MAXTILES * 256, NE * D, DFF / 2};
    pg8::GroupOrder S{((const LAS int*)(F.lds + PST_OFF))[32], 4, F.G, (int)blockIdx.x, (const LAS unsigned char*)(F.lds + TEXP_OFF)};
    pg8::EpiDown E{F.in[IN_BDN], (const float*)(ws + WS_EW), (unsigned char*)(ws + WS_YB), (const LAS int*)(F.lds + PST_OFF)};
    pg8::gemm_phase<pg8::EpiDown, pg8::GroupOrder, true, true, true>(F.lds + RING_OFF, g, S, E);
}

#ifndef CONV_IN_P0
#define CONV_IN_P0 0
#endif
#ifndef PROBE_DOUBLE
#define PROBE_DOUBLE 0
#endif
#define DBL(k) ((PROBE_DOUBLE >> (k)) & 1)
#ifndef MK_N_LAUNCHES
#define MK_N_LAUNCHES 1
#endif
constexpr int NPHASE = 9;
struct Args { const float* in[25]; float* out; unsigned char* ws; int ph_lo, ph_hi, li, pad; };
__global__ void __launch_bounds__(NTHREADS, 2) fwd_kernel(Args args) {
    extern __shared__ __attribute__((aligned(16))) unsigned char lds[];
    Frame F;
    F.lds = (LAS unsigned char*)lds; F.MISC = (volatile LAS unsigned*)(F.lds + MISC_OFF);
    F.tid = threadIdx.x; F.lane = F.tid & 63; F.wave = __builtin_amdgcn_readfirstlane(F.tid >> 6);
    F.G = gridDim.x; { const int bx = blockIdx.x; F.vcu = (F.G % 8 == 0) ? (bx % 8) * (F.G / 8) + bx / 8 : bx; }
    F.ws = args.ws; F.ctl = (gu32*)(args.ws + WS_CTL); F.out = args.out;
#pragma unroll
    for (int i = 0; i < 25; ++i) F.in[i] = args.in[i];
    { int t0 = F.tid; asm volatile("" : "+v"(t0)); if (t0 < 64) F.MISC[t0] = 0u; }
    __syncthreads();
    const int lo = args.ph_lo, hi = args.ph_hi;
    XcdBarrier bar; bar.bar = (unsigned*)(F.ctl + CW_BAR) + args.li * XCD_BAR_WORDS; bar.x = 0; bar.st = nullptr;
    if (hi - lo > 1) bar = xcd_barrier_post((unsigned*)(F.ctl + CW_BAR) + args.li * XCD_BAR_WORDS, F.MISC + 8);
#define IN(k) (lo <= (k) && (k) < hi)
#define SEAM(k) do { if (IN(k) && IN((k) + 1)) xcd_barrier(bar); } while (0)

    if (IN(0)) { p0_prologue(F);
#if CONV_IN_P0
        __syncthreads(); px_experts(F, F.vcu, F.G);
#endif
    } SEAM(0);
    if (IN(1)) { ph_proj(F); } SEAM(1);
    if (IN(2)) { ph_scan(F); } SEAM(2);
    if (IN(3)) { ph_merged(F); } SEAM(3);
    if (IN(4)) { ph_wout(F); } SEAM(4);
    if (IN(5)) { p6_router(F); } SEAM(5);
    if (IN(6)) { ph_gu(F); } SEAM(6);
    if (IN(7)) { ph_down(F); } SEAM(7);
    if (IN(8)) { p10_combine(F); }
#undef IN
#undef SEAM
}

extern "C" void kernel_launch(void* const* d_in, const int* in_sizes, int n_in, void* d_out, int out_size, void* d_ws, size_t ws_size, hipStream_t stream) {
    static int grid = 0;
    if (grid == 0) {
        if (n_in != 25 || in_sizes[0] != BATCH * SEQ * D || out_size != BATCH * SEQ * D || ws_size < WS_END) { fprintf(stderr, "kernel_launch: unexpected shapes (n_in %d, in0 %d, out %d, ws %zu); nothing launched\n", n_in, n_in > 0 ? in_sizes[0] : -1, out_size, ws_size); grid = -1; return; }
        int dev = 0, cus = 0, per_cu = 0;
        if (hipGetDevice(&dev) != hipSuccess || hipDeviceGetAttribute(&cus, hipDeviceAttributeMultiprocessorCount, dev) != hipSuccess) { grid = -1; return; }
        if (hipFuncSetAttribute((const void*)fwd_kernel, hipFuncAttributeMaxDynamicSharedMemorySize, LDS_BYTES) != hipSuccess) { fprintf(stderr, "kernel_launch: hipFuncSetAttribute failed\n"); grid = -1; return; }
        if (hipOccupancyMaxActiveBlocksPerMultiprocessor(&per_cu, (const void*)fwd_kernel, NTHREADS, LDS_BYTES) != hipSuccess || per_cu < 1) { fprintf(stderr, "kernel_launch: occupancy query reports %d blocks per CU\n", per_cu); }
        (void)hipGetLastError();
        grid = 256;
        if (cus < 256) { fprintf(stderr, "kernel_launch: %d CUs < 256: the grid would not be resident; nothing launched\n", cus); grid = -1; return; }
    }
    if (grid < 0) return;
    if (hipMemsetAsync((char*)d_ws + WS_CTL, 0, CTL_ZERO_BYTES, stream) != hipSuccess) return;
    Args a{};
    for (int i = 0; i < 25; ++i) a.in[i] = (const float*)d_in[i];
    a.out = (float*)d_out; a.ws = (unsigned char*)d_ws; a.pad = 0;
#if MK_N_LAUNCHES == 1
    a.ph_lo = 0; a.ph_hi = NPHASE; a.li = 0;
    hipLaunchKernelGGL(fwd_kernel, dim3(grid), dim3(NTHREADS), LDS_BYTES, stream, a);
#else
    for (int p = 0; p < NPHASE; ++p) for (int rep = 0; rep <= DBL(p); ++rep) { a.ph_lo = p; a.ph_hi = p + 1; a.li = 0; hipLaunchKernelGGL(fwd_kernel, dim3(grid), dim3(NTHREADS), LDS_BYTES, stream, a); }
#endif
}
```

```cpp
#include <hip/hip_runtime.h>
#include <cstdio>
#include <cstdint>
namespace pg8 {
#define PG8_LAS __attribute__((address_space(3)))
typedef unsigned short bf16_t;
typedef short bf16x8 __attribute__((ext_vector_type(8)));
typedef float f32x4 __attribute__((ext_vector_type(4)));
typedef unsigned u32x4 __attribute__((ext_vector_type(4)));
constexpr int BM = 256, BK = 64, HALF = 128, HTB = HALF * BK * 2  , STAGE_BYTES = 8 * HTB, NXCD = 8, WGM = 8;

__host__ __device__ __forceinline__ int lds_byte(int r, int c) { const int st = (r >> 4) * 2 + (c >> 5), rr = r & 15, cc = c & 31, ob = rr * 64 + cc * 2; return st * 1024 + (ob ^ (((ob >> 9) & 1) << 5)); }
__host__ __device__ __forceinline__ void stage_rc(int b, int& R, int& C) { const int st = b / 1024, sb = b % 1024, swz = sb ^ (((sb >> 9) & 1) << 5); R = (st >> 1) * 16 + swz / 64; C = (st & 1) * 32 + (swz % 64) / 2; }
__host__ __device__ __forceinline__ int perm32(int rho) { const int n = rho >> 4, i = rho & 15; return 8 * (i >> 2) + 4 * n + (i & 3); }

struct Unit { int pm, pn; };
struct Gemm { const bf16_t* A; const bf16_t* Bt; int M, N, K; };

struct StaticOrder {
    int nM, nN, nwg, G, c;
    __host__ __device__ void init(int M, int N, int G_, int c_) { nM = M / BM; nN = N / BM; nwg = nM * nN; G = G_; c = c_; }
    __host__ __device__ __forceinline__ bool next(int i, Unit& u) const {
        const long L = (long)i * G + c; if (L >= nwg) return false;
        int wgid = (int)L; { const int q = nwg / NXCD, r = nwg % NXCD, xcd = wgid % NXCD, off = wgid / NXCD; wgid = (xcd < r ? xcd * (q + 1) : r * (q + 1) + (xcd - r) * q) + off; }
        const int nig = WGM * nN, gid = wgid / nig, fm = gid * WGM, gsz = (nM - fm) < WGM ? (nM - fm) : WGM;
        u.pm = fm + ((wgid % nig) % gsz); u.pn = (wgid % nig) / gsz; return true;
    }
    __device__ __forceinline__ void a_ready(const Unit&) const {}
    __device__ __forceinline__ void done(const Unit&) const {}
};

typedef __bf16 bf16v2 __attribute__((ext_vector_type(2)));
typedef float f32v2 __attribute__((ext_vector_type(2)));
__device__ __forceinline__ unsigned cvt_pk_bf16(float lo, float hi) { const f32v2 v = {lo, hi}; return __builtin_bit_cast(unsigned, __builtin_convertvector(v, bf16v2)); }
typedef float f32x2 __attribute__((ext_vector_type(2)));
typedef int i32x4 __attribute__((ext_vector_type(4)));
typedef int i32x8 __attribute__((ext_vector_type(8)));
__device__ __forceinline__ i32x8 cat8(const bf16x8 a, const bf16x8 b) { const i32x4 x = __builtin_bit_cast(i32x4, a), y = __builtin_bit_cast(i32x4, b); return __builtin_shufflevector(x, y, 0, 1, 2, 3, 4, 5, 6, 7); }
template <class Epi, class Sched, bool ALIGN_EPI = false, bool SP2 = false, bool FP8 = false>
__device__ __forceinline__ void gemm_phase(PG8_LAS unsigned char* lds, const Gemm g, const Sched& S, const Epi& E) {
    const int tid = threadIdx.x, wid = __builtin_amdgcn_readfirstlane(tid >> 6), lane = tid & 63, wr = wid >> 2, wc = wid & 3, fr = lane & 15, fq = lane >> 4;
    const int K = g.K, nt = K / BK;
    unsigned voffA[2], voffB[2];
#pragma unroll
    for (int i = 0; i < 2; ++i) { int R, C; stage_rc(tid * 16 + i * 8192, R, C); const int Rb = Epi::PERM ? ((R & ~31) + perm32(R & 31)) : R;
        voffA[i] = (unsigned)(R * K + C) * 2u; voffB[i] = (unsigned)(Rb * K + C) * 2u; }
    const size_t kstep = (size_t)(BK * 2);
    const size_t hstep = (size_t)HALF * K * 2;
    const size_t tstep = 2 * hstep;
    const unsigned ldsw = (unsigned)wid * 1024u;
    const int aoff = lds_byte(wr * 64 + fr, fq * 8), boff = lds_byte(wc * 32 + fr, fq * 8);
#define PG8_SA(b, h) (((b) * 2 + (h)) * HTB)
#define PG8_SB(b, h) ((4 + (b) * 2 + (h)) * HTB)
#define PG8_STAGE(bufoff, gbase, voff) do { _Pragma("unroll") for (int _i = 0; _i < 2; ++_i) \
        __builtin_amdgcn_global_load_lds((const unsigned*)((const char*)(gbase) + (voff)[_i]), (PG8_LAS unsigned*)(lds + (bufoff) + ldsw + _i * 8192), 16, 0, 0); } while (0)
#define PG8_LDA(dst, b, h) do { _Pragma("unroll") for (int m = 0; m < 4; ++m) { if constexpr (FP8) dst##8[m] = cat8(*(const PG8_LAS bf16x8*)(lds + PG8_SA(b, h) + aoff + m * 2048), *(const PG8_LAS bf16x8*)(lds + PG8_SA(b, h) + aoff + m * 2048 + 1024)); \
        else { _Pragma("unroll") for (int k = 0; k < 2; ++k) dst[m][k] = *(const PG8_LAS bf16x8*)(lds + PG8_SA(b, h) + aoff + m * 2048 + k * 1024); } } } while (0)
#define PG8_LDB(dst, b, h) do { _Pragma("unroll") for (int n = 0; n < 2; ++n) { if constexpr (FP8) dst##8[n] = cat8(*(const PG8_LAS bf16x8*)(lds + PG8_SB(b, h) + boff + n * 2048), *(const PG8_LAS bf16x8*)(lds + PG8_SB(b, h) + boff + n * 2048 + 1024)); \
        else { _Pragma("unroll") for (int k = 0; k < 2; ++k) dst[n][k] = *(const PG8_LAS bf16x8*)(lds + PG8_SB(b, h) + boff + n * 2048 + k * 1024); } } } while (0)
#define PG8_MMA(ai, bj, At, Bt) do { __builtin_amdgcn_s_setprio(1); _Pragma("unroll") for (int m = 0; m < 4; ++m) _Pragma("unroll") for (int n = 0; n < 2; ++n) { \
        if constexpr (FP8) acc[ai][bj][m][n] = __builtin_amdgcn_mfma_scale_f32_16x16x128_f8f6f4(Bt##8[n], At##8[m], acc[ai][bj][m][n], 0, 0, 0, 0x7f7f7f7f, 0, 0x7f7f7f7f); \
        else { _Pragma("unroll") for (int k = 0; k < 2; ++k) acc[ai][bj][m][n] = __builtin_amdgcn_mfma_f32_16x16x32_bf16(Bt[n][k], At[m][k], acc[ai][bj][m][n], 0, 0, 0); } } \
        if constexpr (FP8) { _Pragma("unroll") for (int m = 0; m < 4; ++m) _Pragma("unroll") for (int n = 0; n < 2; ++n) asm volatile("" : "+v"(acc[ai][bj][m][n])); }     \
        __builtin_amdgcn_s_setprio(0); } while (0)
#define PG8_WAIT_V(n) asm volatile("s_waitcnt vmcnt(" #n ")" ::: "memory")
#define PG8_WAIT_L(n) asm volatile("s_waitcnt lgkmcnt(" #n ")" ::: "memory")
#define PG8_BAR __builtin_amdgcn_s_barrier()
#define PG8_SCHED __builtin_amdgcn_sched_barrier(0)
    Unit cur, nxt; int ui = 0;
    if (!S.next(0, cur)) return;
    f32x4 acc[2][2][4][2];
#pragma unroll
    for (int a = 0; a < 2; ++a)
#pragma unroll
        for (int b = 0; b < 2; ++b)
#pragma unroll
            for (int m = 0; m < 4; ++m)
#pragma unroll
                for (int n = 0; n < 2; ++n) acc[a][b][m][n] = (f32x4){0.f, 0.f, 0.f, 0.f};
    bf16x8 At[4][2], B0[2][2], B1[2][2]; i32x8 At8[4], B08[2], B18[2];
    const char* cA = (const char*)g.A + (size_t)cur.pm * tstep; const char* cB = (const char*)g.Bt + (size_t)cur.pn * tstep;
    S.a_ready(cur);
    if constexpr (SP2) {
        PG8_STAGE(PG8_SB(0, 0), cB, voffB); PG8_STAGE(PG8_SB(0, 1), cB + hstep, voffB); PG8_STAGE(PG8_SA(0, 0), cA, voffA); PG8_STAGE(PG8_SA(0, 1), cA + hstep, voffA);
        if (wr == 1) PG8_BAR;
        PG8_WAIT_V(2); PG8_BAR;
        PG8_STAGE(PG8_SB(1, 0), cB + kstep, voffB); PG8_STAGE(PG8_SA(1, 0), cA + kstep, voffA); PG8_STAGE(PG8_SB(1, 1), cB + hstep + kstep, voffB);
        PG8_WAIT_V(6); PG8_BAR;
    } else {
        PG8_STAGE(PG8_SB(0, 0), cB, voffB); PG8_STAGE(PG8_SA(0, 0), cA, voffA); PG8_STAGE(PG8_SB(0, 1), cB + hstep, voffB); PG8_STAGE(PG8_SA(0, 1), cA + hstep, voffA);
        if (wr == 1) PG8_BAR;
        PG8_WAIT_V(4); PG8_BAR;
        PG8_STAGE(PG8_SB(1, 0), cB + kstep, voffB); PG8_STAGE(PG8_SA(1, 0), cA + kstep, voffA); PG8_STAGE(PG8_SB(1, 1), cB + hstep + kstep, voffB);
        PG8_WAIT_V(6); PG8_BAR;
    }
    for (;;) {
        const bool has_next = S.next(ui + 1, nxt);
        const char* nA = has_next ? (const char*)g.A + (size_t)nxt.pm * tstep : cA; const char* nB = has_next ? (const char*)g.Bt + (size_t)nxt.pn * tstep : cB;
        for (int t = 0; t < nt; t += 2) {
            const bool last = (t == nt - 2);
            const char* a1 = cA + (size_t)(t + 1) * kstep;
            const char* a2 = last ? nA : cA + (size_t)(t + 2) * kstep; const char* b2 = last ? nB : cB + (size_t)(t + 2) * kstep;
            const char* a3 = a2 + kstep; const char* b3 = b2 + kstep;
            if (last && has_next) S.a_ready(nxt);
            if constexpr (SP2) {
            PG8_LDB(B0, 0, 0); PG8_LDB(B1, 0, 1); PG8_SCHED; PG8_LDA(At, 0, 0); PG8_STAGE(PG8_SA(1, 1), a1 + hstep, voffA);
            PG8_WAIT_V(8); PG8_WAIT_L(0); PG8_BAR; PG8_MMA(0, 0, At, B0); PG8_MMA(0, 1, At, B1); PG8_BAR; PG8_SCHED;
            PG8_LDA(At, 0, 1); PG8_STAGE(PG8_SB(0, 0), b2, voffB); PG8_STAGE(PG8_SB(0, 1), b2 + hstep, voffB); PG8_STAGE(PG8_SA(0, 0), a2, voffA);
            PG8_WAIT_V(8); PG8_WAIT_L(0); PG8_BAR; PG8_MMA(1, 0, At, B0); PG8_MMA(1, 1, At, B1); PG8_BAR; PG8_SCHED;
            PG8_LDB(B0, 1, 0); PG8_LDB(B1, 1, 1); PG8_SCHED; PG8_LDA(At, 1, 0); PG8_STAGE(PG8_SA(0, 1), a2 + hstep, voffA);
            PG8_WAIT_V(8); PG8_WAIT_L(0); PG8_BAR; PG8_MMA(0, 0, At, B0); PG8_MMA(0, 1, At, B1); PG8_BAR; PG8_SCHED;
            PG8_LDA(At, 1, 1); PG8_STAGE(PG8_SB(1, 0), b3, voffB); PG8_STAGE(PG8_SB(1, 1), b3 + hstep, voffB); PG8_STAGE(PG8_SA(1, 0), a3, voffA);
            PG8_WAIT_V(8); PG8_WAIT_L(0); PG8_BAR; PG8_MMA(1, 0, At, B0); PG8_MMA(1, 1, At, B1); PG8_BAR; PG8_SCHED;
            } else {
            PG8_LDB(B0, 0, 0); PG8_SCHED; PG8_LDA(At, 0, 0); PG8_STAGE(PG8_SA(1, 1), a1 + hstep, voffA);
            PG8_WAIT_L(8); PG8_BAR; PG8_WAIT_L(0); PG8_MMA(0, 0, At, B0); PG8_BAR; PG8_SCHED;
            PG8_LDB(B1, 0, 1); PG8_STAGE(PG8_SB(0, 0), b2, voffB);
            PG8_BAR; PG8_WAIT_L(0); PG8_MMA(0, 1, At, B1); PG8_BAR;
            PG8_LDA(At, 0, 1); PG8_STAGE(PG8_SA(0, 0), a2, voffA);
            PG8_BAR; PG8_WAIT_L(0); PG8_MMA(1, 0, At, B0); PG8_BAR; PG8_SCHED;
            PG8_STAGE(PG8_SB(0, 1), b2 + hstep, voffB);
            PG8_WAIT_V(6); PG8_BAR; PG8_MMA(1, 1, At, B1); PG8_BAR;
            PG8_LDB(B0, 1, 0); PG8_SCHED; PG8_LDA(At, 1, 0); PG8_STAGE(PG8_SA(0, 1), a2 + hstep, voffA);
            PG8_WAIT_L(8); PG8_BAR; PG8_WAIT_L(0); PG8_MMA(0, 0, At, B0); PG8_BAR; PG8_SCHED;
            PG8_LDB(B1, 1, 1); PG8_STAGE(PG8_SB(1, 0), b3, voffB);
            PG8_BAR; PG8_WAIT_L(0); PG8_MMA(0, 1, At, B1); PG8_BAR;
            PG8_LDA(At, 1, 1); PG8_STAGE(PG8_SA(1, 0), a3, voffA);
            PG8_BAR; PG8_WAIT_L(0); PG8_MMA(1, 0, At, B0); PG8_BAR; PG8_SCHED;
            PG8_STAGE(PG8_SB(1, 1), b3 + hstep, voffB);
            PG8_WAIT_V(6); PG8_BAR; PG8_MMA(1, 1, At, B1); PG8_BAR;
            }
        }
        if constexpr (ALIGN_EPI) { if (wr == 0) PG8_BAR; }
        if constexpr (!Epi::AFTER_DRAIN) { E(acc, cur, wr, wc, fr, fq); S.done(cur); }
        if (!has_next) break;
#pragma unroll
        for (int a = 0; a < 2; ++a)
#pragma unroll
            for (int b = 0; b < 2; ++b)
#pragma unroll
                for (int m = 0; m < 4; ++m)
#pragma unroll
                    for (int n = 0; n < 2; ++n) acc[a][b][m][n] = (f32x4){0.f, 0.f, 0.f, 0.f};
        cur = nxt; cA = nA; cB = nB; ++ui;
        if constexpr (ALIGN_EPI) { if (wr == 1) PG8_BAR; }
    }
    PG8_WAIT_V(0);
    if constexpr (!ALIGN_EPI) { if (wr == 0) PG8_BAR; }
    PG8_BAR;
    if constexpr (Epi::AFTER_DRAIN) { E.fused(acc, cur, wr, wc, fr, fq, lds, wid, lane); S.done(cur); }
#undef PG8_SA
#undef PG8_SB
#undef PG8_STAGE
#undef PG8_LDA
#undef PG8_LDB
#undef PG8_MMA
#undef PG8_WAIT_V
#undef PG8_WAIT_L
#undef PG8_BAR
#undef PG8_SCHED
}
template <class Epi, class Sched, bool FP8 = false>
__device__ __forceinline__ void gemm_phase_g(PG8_LAS unsigned char* lds, const Gemm g, const Sched& S, const Epi& E, const PG8_LAS unsigned short* tok16) {
    constexpr bool ALIGN_EPI = true, SP2 = true;
    const int tid = threadIdx.x, wid = __builtin_amdgcn_readfirstlane(tid >> 6), lane = tid & 63, wr = wid >> 2, wc = wid & 3, fr = lane & 15, fq = lane >> 4;
    const int K = g.K, nt = K / BK;
    unsigned voffB[2]; int RA[2]; unsigned CA[2];
#pragma unroll
    for (int i = 0; i < 2; ++i) { int R, C; stage_rc(tid * 16 + i * 8192, R, C); const int Rb = Epi::PERM ? ((R & ~31) + perm32(R & 31)) : R;
        RA[i] = R; CA[i] = (unsigned)C * 2u; voffB[i] = (unsigned)(Rb * K + C) * 2u; }
    unsigned oc[2][2];
#define PG8_TOKS(dst, ui_) do { _Pragma("unroll") for (int _h = 0; _h < 2; ++_h) _Pragma("unroll") for (int _i = 0; _i < 2; ++_i) \
        dst[_h][_i] = (unsigned)tok16[(ui_) * 256 + _h * HALF + RA[_i]] * (unsigned)(K * 2) + CA[_i]; } while (0)
    const size_t kstep = (size_t)(BK * 2);
    const size_t hstep = (size_t)HALF * K * 2;
    const size_t tstep = 2 * hstep;
    const unsigned ldsw = (unsigned)wid * 1024u;
    const int aoff = lds_byte(wr * 64 + fr, fq * 8), boff = lds_byte(wc * 32 + fr, fq * 8);
#define PG8_SA(b, h) (((b) * 2 + (h)) * HTB)
#define PG8_SB(b, h) ((4 + (b) * 2 + (h)) * HTB)
#define PG8_STAGE(bufoff, gbase, voff) do { _Pragma("unroll") for (int _i = 0; _i < 2; ++_i) \
        __builtin_amdgcn_global_load_lds((const unsigned*)((const char*)(gbase) + (voff)[_i]), (PG8_LAS unsigned*)(lds + (bufoff) + ldsw + _i * 8192), 16, 0, 0); } while (0)
#define PG8_LDA(dst, b, h) do { _Pragma("unroll") for (int m = 0; m < 4; ++m) { if constexpr (FP8) dst##8[m] = cat8(*(const PG8_LAS bf16x8*)(lds + PG8_SA(b, h) + aoff + m * 2048), *(const PG8_LAS bf16x8*)(lds + PG8_SA(b, h) + aoff + m * 2048 + 1024)); \
        else { _Pragma("unroll") for (int k = 0; k < 2; ++k) dst[m][k] = *(const PG8_LAS bf16x8*)(lds + PG8_SA(b, h) + aoff + m * 2048 + k * 1024); } } } while (0)
#define PG8_LDB(dst, b, h) do { _Pragma("unroll") for (int n = 0; n < 2; ++n) { if constexpr (FP8) dst##8[n] = cat8(*(const PG8_LAS bf16x8*)(lds + PG8_SB(b, h) + boff + n * 2048), *(const PG8_LAS bf16x8*)(lds + PG8_SB(b, h) + boff + n * 2048 + 1024)); \
        else { _Pragma("unroll") for (int k = 0; k < 2; ++k) dst[n][k] = *(const PG8_LAS bf16x8*)(lds + PG8_SB(b, h) + boff + n * 2048 + k * 1024); } } } while (0)
#define PG8_MMA(ai, bj, At, Bt) do { __builtin_amdgcn_s_setprio(1); _Pragma("unroll") for (int m = 0; m < 4; ++m) _Pragma("unroll") for (int n = 0; n < 2; ++n) { \
        if constexpr (FP8) acc[ai][bj][m][n] = __builtin_amdgcn_mfma_scale_f32_16x16x128_f8f6f4(Bt##8[n], At##8[m], acc[ai][bj][m][n], 0, 0, 0, 0x7f7f7f7f, 0, 0x7f7f7f7f); \
        else { _Pragma("unroll") for (int k = 0; k < 2; ++k) acc[ai][bj][m][n] = __builtin_amdgcn_mfma_f32_16x16x32_bf16(Bt[n][k], At[m][k], acc[ai][bj][m][n], 0, 0, 0); } } \
        if constexpr (FP8) { _Pragma("unroll") for (int m = 0; m < 4; ++m) _Pragma("unroll") for (int n = 0; n < 2; ++n) asm volatile("" : "+v"(acc[ai][bj][m][n])); }     \
        __builtin_amdgcn_s_setprio(0); } while (0)
#define PG8_WAIT_V(n) asm volatile("s_waitcnt vmcnt(" #n ")" ::: "memory")
#define PG8_WAIT_L(n) asm volatile("s_waitcnt lgkmcnt(" #n ")" ::: "memory")
#define PG8_BAR __builtin_amdgcn_s_barrier()
#define PG8_SCHED __builtin_amdgcn_sched_barrier(0)
    Unit cur, nxt; int ui = 0;
    if (!S.next(0, cur)) return;
    f32x4 acc[2][2][4][2];
#pragma unroll
    for (int a = 0; a < 2; ++a)
#pragma unroll
        for (int b = 0; b < 2; ++b)
#pragma unroll
            for (int m = 0; m < 4; ++m)
#pragma unroll
                for (int n = 0; n < 2; ++n) acc[a][b][m][n] = (f32x4){0.f, 0.f, 0.f, 0.f};
    bf16x8 At[4][2], B0[2][2], B1[2][2]; i32x8 At8[4], B08[2], B18[2];
    const char* cA = (const char*)g.A; const char* cB = (const char*)g.Bt + (size_t)cur.pn * tstep; PG8_TOKS(oc, 0);
    S.a_ready(cur);
    if constexpr (SP2) {
        PG8_STAGE(PG8_SB(0, 0), cB, voffB); PG8_STAGE(PG8_SB(0, 1), cB + hstep, voffB); PG8_STAGE(PG8_SA(0, 0), cA, oc[0]); PG8_STAGE(PG8_SA(0, 1), cA, oc[1]);
        if (wr == 1) PG8_BAR;
        PG8_WAIT_V(2); PG8_BAR;
        PG8_STAGE(PG8_SB(1, 0), cB + kstep, voffB); PG8_STAGE(PG8_SA(1, 0), cA + kstep, oc[0]); PG8_STAGE(PG8_SB(1, 1), cB + hstep + kstep, voffB);
        PG8_WAIT_V(6); PG8_BAR;
    } else {
        PG8_STAGE(PG8_SB(0, 0), cB, voffB); PG8_STAGE(PG8_SA(0, 0), cA, oc[0]); PG8_STAGE(PG8_SB(0, 1), cB + hstep, voffB); PG8_STAGE(PG8_SA(0, 1), cA + hstep, oc[0]);
        if (wr == 1) PG8_BAR;
        PG8_WAIT_V(4); PG8_BAR;
        PG8_STAGE(PG8_SB(1, 0), cB + kstep, voffB); PG8_STAGE(PG8_SA(1, 0), cA + kstep, oc[0]); PG8_STAGE(PG8_SB(1, 1), cB + hstep + kstep, voffB);
        PG8_WAIT_V(6); PG8_BAR;
    }
    for (;;) {
        const bool has_next = S.next(ui + 1, nxt);
        const char* nB = has_next ? (const char*)g.Bt + (size_t)nxt.pn * tstep : cB;
        for (int t = 0; t < nt; t += 2) {
            const bool last = (t == nt - 2);
            const char* a1 = cA + (size_t)(t + 1) * kstep;
            const char* a2 = last ? cA : cA + (size_t)(t + 2) * kstep; const char* b2 = last ? nB : cB + (size_t)(t + 2) * kstep;
            unsigned o2[2][2]; if (last && has_next) PG8_TOKS(o2, ui + 1); else { _Pragma("unroll") for (int _h = 0; _h < 2; ++_h) _Pragma("unroll") for (int _i = 0; _i < 2; ++_i) o2[_h][_i] = oc[_h][_i]; }
            const char* a3 = a2 + kstep; const char* b3 = b2 + kstep;
            if (last && has_next) S.a_ready(nxt);
            if constexpr (SP2) {
            PG8_LDB(B0, 0, 0); PG8_LDB(B1, 0, 1); PG8_SCHED; PG8_LDA(At, 0, 0); PG8_STAGE(PG8_SA(1, 1), a1, oc[1]);
            PG8_WAIT_V(8); PG8_WAIT_L(0); PG8_BAR; PG8_MMA(0, 0, At, B0); PG8_MMA(0, 1, At, B1); PG8_BAR; PG8_SCHED;
            PG8_LDA(At, 0, 1); PG8_STAGE(PG8_SB(0, 0), b2, voffB); PG8_STAGE(PG8_SB(0, 1), b2 + hstep, voffB); PG8_STAGE(PG8_SA(0, 0), a2, o2[0]);
            PG8_WAIT_V(8); PG8_WAIT_L(0); PG8_BAR; PG8_MMA(1, 0, At, B0); PG8_MMA(1, 1, At, B1); PG8_BAR; PG8_SCHED;
            PG8_LDB(B0, 1, 0); PG8_LDB(B1, 1, 1); PG8_SCHED; PG8_LDA(At, 1, 0); PG8_STAGE(PG8_SA(0, 1), a2, o2[1]);
            PG8_WAIT_V(8); PG8_WAIT_L(0); PG8_BAR; PG8_MMA(0, 0, At, B0); PG8_MMA(0, 1, At, B1); PG8_BAR; PG8_SCHED;
            PG8_LDA(At, 1, 1); PG8_STAGE(PG8_SB(1, 0), b3, voffB); PG8_STAGE(PG8_SB(1, 1), b3 + hstep, voffB); PG8_STAGE(PG8_SA(1, 0), a3, o2[0]);
            PG8_WAIT_V(8); PG8_WAIT_L(0); PG8_BAR; PG8_MMA(1, 0, At, B0); PG8_MMA(1, 1, At, B1); PG8_BAR; PG8_SCHED;
            } else {
            PG8_LDB(B0, 0, 0); PG8_SCHED; PG8_LDA(At, 0, 0); PG8_STAGE(PG8_SA(1, 1), a1 + hstep, oc[0]);
            PG8_WAIT_L(8); PG8_BAR; PG8_WAIT_L(0); PG8_MMA(0, 0, At, B0); PG8_BAR; PG8_SCHED;
            PG8_LDB(B1, 0, 1); PG8_STAGE(PG8_SB(0, 0), b2, voffB);
            PG8_BAR; PG8_WAIT_L(0); PG8_MMA(0, 1, At, B1); PG8_BAR;
            PG8_LDA(At, 0, 1); PG8_STAGE(PG8_SA(0, 0), a2, oc[0]);
            PG8_BAR; PG8_WAIT_L(0); PG8_MMA(1, 0, At, B0); PG8_BAR; PG8_SCHED;
            PG8_STAGE(PG8_SB(0, 1), b2 + hstep, voffB);
            PG8_WAIT_V(6); PG8_BAR; PG8_MMA(1, 1, At, B1); PG8_BAR;
            PG8_LDB(B0, 1, 0); PG8_SCHED; PG8_LDA(At, 1, 0); PG8_STAGE(PG8_SA(0, 1), a2 + hstep, oc[0]);
            PG8_WAIT_L(8); PG8_BAR; PG8_WAIT_L(0); PG8_MMA(0, 0, At, B0); PG8_BAR; PG8_SCHED;
            PG8_LDB(B1, 1, 1); PG8_STAGE(PG8_SB(1, 0), b3, voffB);
            PG8_BAR; PG8_WAIT_L(0); PG8_MMA(0, 1, At, B1); PG8_BAR;
            PG8_LDA(At, 1, 1); PG8_STAGE(PG8_SA(1, 0), a3, oc[0]);
            PG8_BAR; PG8_WAIT_L(0); PG8_MMA(1, 0, At, B0); PG8_BAR; PG8_SCHED;
            PG8_STAGE(PG8_SB(1, 1), b3 + hstep, voffB);
            PG8_WAIT_V(6); PG8_BAR; PG8_MMA(1, 1, At, B1); PG8_BAR;
            }
        }
        if constexpr (ALIGN_EPI) { if (wr == 0) PG8_BAR; }
        if constexpr (!Epi::AFTER_DRAIN) { E(acc, cur, wr, wc, fr, fq); S.done(cur); }
        if (!has_next) break;
#pragma unroll
        for (int a = 0; a < 2; ++a)
#pragma unroll
            for (int b = 0; b < 2; ++b)
#pragma unroll
                for (int m = 0; m < 4; ++m)
#pragma unroll
                    for (int n = 0; n < 2; ++n) acc[a][b][m][n] = (f32x4){0.f, 0.f, 0.f, 0.f};
        cur = nxt; cB = nB; ++ui; PG8_TOKS(oc, ui);
        if constexpr (ALIGN_EPI) { if (wr == 1) PG8_BAR; }
    }
    PG8_WAIT_V(0);
    if constexpr (!ALIGN_EPI) { if (wr == 0) PG8_BAR; }
    PG8_BAR;
    if constexpr (Epi::AFTER_DRAIN) { E.fused(acc, cur, wr, wc, fr, fq, lds, wid, lane); S.done(cur); }
#undef PG8_TOKS
#undef PG8_SA
#undef PG8_SB
#undef PG8_STAGE
#undef PG8_LDA
#undef PG8_LDB
#undef PG8_MMA
#undef PG8_WAIT_V
#undef PG8_WAIT_L
#undef PG8_BAR
#undef PG8_SCHED
}
}

constexpr int BATCH = 16, SEQ = 2048, D = 1024, NMETA = 16;
constexpr int TV = SEQ + NMETA;
constexpr int NV = BATCH * TV;
constexpr int NTOK = BATCH * SEQ;
constexpr int NR = NTOK + NMETA;
constexpr int NIN = 5128, NPROJ = 5120;
constexpr int HW = 512;
constexpr int NE = 32, TOPK = 4, DFF = 1024;
constexpr int MAXTILES = 548;
constexpr float EPS = 1e-6f;
constexpr int NWAVES = 8, NTHREADS = 512;

constexpr size_t MiB = 1u << 20, KiB = 1u << 10;
constexpr size_t WS_CTL = 0, CTL_ZERO_BYTES = 1 * MiB;
constexpr size_t WS_WIN = 2 * MiB;
constexpr size_t WS_WBH = 12 * MiB, WS_WBM = 13 * MiB, WS_WOUT = 14 * MiB;
constexpr size_t WS_WGU = 16 * MiB;
constexpr size_t WS_WDN = 144 * MiB;
constexpr size_t WS_BGUP = 208 * MiB;
constexpr size_t WS_RWT = WS_BGUP + 256 * KiB;
constexpr size_t WS_TOPE = WS_RWT + 128 * KiB;
constexpr size_t WS_TOPP = WS_TOPE + 520 * KiB;
constexpr size_t WS_TOPW = WS_TOPP + 520 * KiB;
constexpr size_t WS_RS = WS_TOPW + 520 * KiB;
constexpr size_t WS_LI = WS_RS + 136 * KiB;
constexpr size_t WS_LF = WS_LI + 520 * KiB;
constexpr size_t WS_SLOTRS = WS_LF + 520 * KiB;
constexpr size_t WS_SLOTW = WS_SLOTRS + 552 * KiB;
constexpr size_t WS_XSQ = WS_SLOTW + 552 * KiB;
constexpr size_t WS_SMALL_END = WS_XSQ + 136 * KiB;
constexpr size_t WS_RA = 214 * MiB;
constexpr size_t WS_HQ = WS_RA, WS_HG = WS_RA + 33 * MiB, WS_HV = WS_RA + 99 * MiB, WS_HGATE = WS_RA + 132 * MiB, WS_MM = WS_RA + 165 * MiB, WS_MO = WS_RA + 198 * MiB, WS_GATES = WS_RA + 231 * MiB;
constexpr size_t WS_MERGED = WS_RA, WS_TMP = WS_RA + 66 * MiB, WS_H1B = WS_RA + 364 * MiB, WS_ACT = WS_RA;
constexpr size_t WS_RB = WS_RA + 364 * MiB;
constexpr size_t WS_QKVM = WS_RB, WS_CM = WS_RB + 130 * MiB, WS_YHG = WS_RB + 196 * MiB, WS_YML = WS_RB + 229 * MiB, WS_XS = WS_RB, WS_YB = WS_RB;
constexpr size_t WS_RC = WS_RB + 274 * MiB;
constexpr size_t WS_XN0 = WS_RC + 65 * MiB;
constexpr size_t WS_H1 = WS_RC, WS_ETOK = WS_RC + 130 * MiB, WS_ERS = WS_ETOK + 5 * MiB, WS_EW = WS_ERS + 5 * MiB, WS_END = WS_EW + 5 * MiB;
static_assert(WS_SMALL_END <= WS_RA && WS_END <= 1024 * MiB, "d_ws map");
static_assert((size_t)NV * HW * 2 <= 33 * MiB && (size_t)NV * HW * 4 <= 66 * MiB && (size_t)NV * 2048 * 2 <= 132 * MiB + MiB && (size_t)NV * D * 4 <= 130 * MiB && (size_t)MAXTILES * 256 * D * 2 <= 274 * MiB, "d_ws sizes");
static_assert((size_t)NE * NV * 4 <= 5 * MiB, "per-expert lists");
static_assert((size_t)NR * D * 2 <= 65 * MiB && (size_t)NR * 4 <= 136 * KiB, "H1 / XN0 / XSQ");
constexpr int CW_TMO = 0, CW_CNT = 64  , CW_BAR = 4096;

constexpr int RING_OFF = 0, RING_BYTES = 131072;
constexpr int MISC_OFF = RING_BYTES;
constexpr int TEXP_OFF = MISC_OFF + 256;
constexpr int PST_OFF = TEXP_OFF + 640;
constexpr int TOK_OFF = PST_OFF + 384;
constexpr int LDS_BYTES = 147456;
static_assert(TOK_OFF + 18 * 512 <= LDS_BYTES, "LDS map");

#define GAS __attribute__((address_space(1)))
#define LAS __attribute__((address_space(3)))
typedef unsigned short bf16;
typedef unsigned v4u __attribute__((ext_vector_type(4)));
typedef unsigned v2u __attribute__((ext_vector_type(2)));
typedef float f32x4 __attribute__((ext_vector_type(4)));
typedef GAS unsigned gu32;
#define RLX_AGENT __ATOMIC_RELAXED, __HIP_MEMORY_SCOPE_AGENT
#define LDS_WAIT() asm volatile("s_waitcnt lgkmcnt(0)" ::: "memory")
#define VM_WAIT() asm volatile("s_waitcnt vmcnt(0)" ::: "memory")
__device__ __forceinline__ unsigned pk2(float lo, float hi) { return pg8::cvt_pk_bf16(lo, hi); }
__device__ __forceinline__ unsigned f2bf(float f) { return pg8::cvt_pk_bf16(f, 0.f) & 0xffffu; }
__device__ __forceinline__ float bflo(unsigned w) { return __builtin_bit_cast(float, w << 16); }
__device__ __forceinline__ float bfhi(unsigned w) { return __builtin_bit_cast(float, w & 0xffff0000u); }
__device__ __forceinline__ float bf1(bf16 h) { return __builtin_bit_cast(float, (unsigned)h << 16); }
__device__ __forceinline__ float fsigmoid(float x) { return __builtin_amdgcn_rcpf(1.0f + __expf(-x)); }
__device__ __forceinline__ float fsilu(float x) { return x * fsigmoid(x); }
__device__ __forceinline__ size_t rowof(int b, int tt) { return tt < NMETA ? (size_t)(NTOK + tt) : (size_t)b * SEQ + (tt - NMETA); }
__host__ __device__ __forceinline__ int gu_slot(int j) { const int g = (j >> 3) & 3, p = ((g & 1) << 1) | (g >> 1); return (j & ~31) + 8 * p + (j & 7); }
__device__ __forceinline__ float wave_sum(float v) {
#pragma unroll
    for (int o = 1; o < 64; o <<= 1) v += __shfl_xor(v, o);
    return v;
}
__device__ __forceinline__ float wave_max(float v) {
#pragma unroll
    for (int o = 1; o < 64; o <<= 1) v = fmaxf(v, __shfl_xor(v, o));
    return v;
}
#define XB_TMO      128
#define XB_XCNT(j)  (256  + 64 * (j))
#define XB_XSUB(j)  (1280 + 64 * (j))
#define XB_XGEN(j)  (2304 + 64 * (j))
#define XB_TOP      3328
#define XB_TOPGEN   3392
#define XCD_BAR_WORDS 3456
#define XB_SPIN_CAP (1u << 18)

__device__ __forceinline__ unsigned xb_ld(unsigned* p)              { return __hip_atomic_load(p, __ATOMIC_RELAXED, __HIP_MEMORY_SCOPE_AGENT); }
__device__ __forceinline__ unsigned xb_add(unsigned* p, unsigned v) { return __hip_atomic_fetch_add(p, v, __ATOMIC_RELAXED, __HIP_MEMORY_SCOPE_AGENT); }
__device__ __forceinline__ unsigned xb_xcc_id() { return (unsigned)__builtin_amdgcn_s_getreg((3 << 11) | 20) & 0xFu; }
#define XB_SPIN(cond, bar) do { unsigned _sp = 0; while (cond) { __builtin_amdgcn_s_sleep(1); \
    if ((++_sp & 255u) == 0u) { if (xb_ld(&(bar)[XB_TMO])) break; if (_sp > XB_SPIN_CAP) { atomicAdd(&(bar)[XB_TMO], 1u); break; } } } } while (0)

struct XcdBarrier {
    unsigned* bar; unsigned x;
    volatile LAS unsigned* st;
};

__device__ __forceinline__ XcdBarrier xcd_barrier_post(unsigned* bar, volatile LAS unsigned* st) {
    XcdBarrier b; b.bar = bar; b.x = xb_xcc_id(); b.st = st;
    if (threadIdx.x == 0) (void)xb_add(&bar[XB_XCNT(b.x)], 1u);
    return b;
}
__device__ __forceinline__ void xcd_barrier_complete(unsigned* bar, unsigned x, unsigned& nloc, unsigned& nx) {
    const unsigned G = gridDim.x * gridDim.y * gridDim.z;
    unsigned sum, cnt, mine, sp = 0u;
    for (;;) {
        sum = 0u; cnt = 0u; mine = 0u;
#pragma unroll
        for (unsigned j = 0; j < 16; ++j) { const unsigned c = xb_ld(&bar[XB_XCNT(j)]); sum += c; cnt += (c > 0u) ? 1u : 0u; mine = (j == x) ? c : mine; }
        if (sum == G) break;
        __builtin_amdgcn_s_sleep(1);
        if ((++sp & 255u) == 0u) { if (xb_ld(&bar[XB_TMO])) break; if (sp > XB_SPIN_CAP) { atomicAdd(&bar[XB_TMO], 1u); break; } }
    }
    nloc = mine > 0u ? mine : 1u; nx = cnt > 0u ? cnt : 1u;
}

__device__ __forceinline__ void xcd_barrier(const XcdBarrier& b) {
    asm volatile("s_waitcnt vmcnt(0)" ::: "memory");
    __syncthreads();
    if (threadIdx.x == 0) {
        unsigned* bar = b.bar;
        __builtin_amdgcn_s_waitcnt(0);
        unsigned nloc = b.st[0], nx = b.st[1];
        if (nloc == 0u) { xcd_barrier_complete(bar, b.x, nloc, nx); b.st[0] = nloc; b.st[1] = nx; }
        const unsigned old = xb_add(&bar[XB_XSUB(b.x)], 1u);
        const unsigned gen = old / nloc;
        if (old + 1u == (gen + 1u) * nloc) {
            __builtin_amdgcn_fence(__ATOMIC_RELEASE, "agent");
            asm volatile("s_waitcnt vmcnt(0)" ::: "memory");
            const unsigned og = xb_add(&bar[XB_TOP], 1u);
            const unsigned tg = og / nx;
            if (og + 1u == (tg + 1u) * nx) xb_add(&bar[XB_TOPGEN], 1u);
            else XB_SPIN(xb_ld(&bar[XB_TOPGEN]) == tg, bar);
            __builtin_amdgcn_fence(__ATOMIC_ACQUIRE, "agent");
            xb_add(&bar[XB_XGEN(b.x)], 1u);
            asm volatile("s_waitcnt vmcnt(0)" ::: "memory");
        } else {
            XB_SPIN(xb_ld(&bar[XB_XGEN(b.x)]) == gen, bar);
            __builtin_amdgcn_fence(__ATOMIC_ACQUIRE, "agent");
            asm volatile("s_waitcnt vmcnt(0)" ::: "memory");
        }
    }
    __syncthreads();
}

struct Frame {
    LAS unsigned char* lds;
    volatile LAS unsigned* MISC;
    gu32* ctl;
    int tid, lane, wave, vcu, G;
    const float* in[25];
    float* out;
    unsigned char* ws;
};
#define IN_X 0
#define IN_META 1
#define IN_LBL 2
#define IN_NMIX 3
#define IN_WIN 4
#define IN_HGNORM 5
#define IN_CONVW 6
#define IN_CONVB 7
#define IN_WQ 8
#define IN_WK 9
#define IN_WV 10
#define IN_GATEB 11
#define IN_MLNORM 12
#define IN_MLSKIP 13
#define IN_WBH 14
#define IN_WBM 15
#define IN_WOUT 16
#define IN_NFFN 17
#define IN_RW 18
#define IN_RB 19
#define IN_WGU 20
#define IN_BGU 21
#define IN_WDN 22
#define IN_BDN 23
#define IN_NFIN 24

__device__ __forceinline__ void p0_item(const float* W, int ldw, int col0, int cstride, const float* kscale, bf16* WT, int K, int dstrow0, int k0, LAS float* scr, int lane) {
    (void)cstride;
    const int r = lane >> 3, c4 = (lane & 7) * 4;
    f32x4 v[8];
#pragma unroll
    for (int i = 0; i < 8; ++i) v[i] = *(const GAS f32x4*)(W + (size_t)(k0 + 8 * i + r) * ldw + col0 + c4);
#pragma unroll
    for (int i = 0; i < 8; ++i) { const float sc = kscale ? kscale[k0 + 8 * i + r] : 1.f; LAS float* s = scr + (8 * i + r) * 33 + c4; s[0] = v[i].x * sc; s[1] = v[i].y * sc; s[2] = v[i].z * sc; s[3] = v[i].w * sc; }
    LDS_WAIT(); asm volatile("" ::: "memory");
    const int c = lane & 7;
#pragma unroll
    for (int j = 0; j < 4; ++j) { const int n = (lane >> 3) + 8 * j; const LAS float* s = scr + (8 * c) * 33 + n;
        v4u o; o.x = pk2(s[0 * 33], s[1 * 33]); o.y = pk2(s[2 * 33], s[3 * 33]); o.z = pk2(s[4 * 33], s[5 * 33]); o.w = pk2(s[6 * 33], s[7 * 33]);
        *(GAS v4u*)(WT + (size_t)(dstrow0 + n) * K + k0 + 8 * c) = o; }
    LDS_WAIT(); asm volatile("" ::: "memory");
}
__device__ __forceinline__ void p0_prologue(Frame& F) {
    unsigned char* ws = F.ws;
    const int gw = F.vcu * NWAVES + F.wave, NGW = F.G * NWAVES, gt = F.vcu * NTHREADS + F.tid, NGT = F.G * NTHREADS;
    {
        LAS float* wm = (LAS float*)(F.lds + RING_OFF + 65536);
        { float wa[16], wb[16];
#pragma unroll
          for (int q = 0; q < 16; ++q) { const int u = F.tid + q * NTHREADS, j = u & 7, l = (u >> 3) & 63, i = u >> 9, k = 4 * l + 256 * (i >> 2) + (i & 3); wa[q] = F.in[IN_NMIX][k]; wb[q] = F.in[IN_WIN][(size_t)k * NIN + 3072 + j]; }
#pragma unroll
          for (int q = 0; q < 16; ++q) wm[F.tid + q * NTHREADS] = wa[q] * wb[q]; }
        __syncthreads();
        bf16* XN0 = (bf16*)(ws + WS_XN0); float* XSQ = (float*)(ws + WS_XSQ); float* LI = (float*)(ws + WS_LI); float* LF = (float*)(ws + WS_LF);
        f32x4 vn[4];
#define P0_LOADROW(dst, V_) do { const int Vc_ = (V_) < NR ? (V_) : NR - 1; const float* src_ = (Vc_ >= NTOK) ? F.in[IN_META] + (size_t)(Vc_ - NTOK) * D : F.in[IN_X] + (size_t)Vc_ * D; \
        const GAS f32x4* xr_ = (const GAS f32x4*)src_ + F.lane; _Pragma("unroll") for (int j = 0; j < 4; ++j) dst[j] = xr_[64 * j]; } while (0)
        P0_LOADROW(vn, gw);
        for (int V = gw; V < NR; V += NGW) {
            f32x4 v[4]; float s = 0.f;
#pragma unroll
            for (int j = 0; j < 4; ++j) { v[j] = vn[j]; s += (v[j].x * v[j].x + v[j].y * v[j].y) + (v[j].z * v[j].z + v[j].w * v[j].w); }
            P0_LOADROW(vn, V + NGW);
            asm volatile("" ::: "memory");
            const float sq = sqrtf(wave_sum(s) * (1.f / D) + EPS), rs = 1.0f / sq;
            if (F.lane == 0) XSQ[V] = sq;
            float g[8];
#pragma unroll
            for (int j = 0; j < 8; ++j) g[j] = 0.f;
            GAS unsigned long long* o8 = (GAS unsigned long long*)(XN0 + (size_t)V * D) + F.lane;
#pragma unroll
            for (int j = 0; j < 4; ++j) {
                v[j] = v[j] * rs;
                o8[64 * j] = (unsigned long long)pk2(v[j].x, v[j].y) | ((unsigned long long)pk2(v[j].z, v[j].w) << 32);
#pragma unroll
                for (int q = 0; q < 4; ++q) { const LAS f32x4* wp = (const LAS f32x4*)(wm + (((4 * j + q) * 64 + F.lane) * 8)); const f32x4 w0 = wp[0], w1 = wp[1]; const float xv = v[j][q];
                    g[0] += xv * w0.x; g[1] += xv * w0.y; g[2] += xv * w0.z; g[3] += xv * w0.w; g[4] += xv * w1.x; g[5] += xv * w1.y; g[6] += xv * w1.z; g[7] += xv * w1.w; }
            }
#pragma unroll
            for (int j = 0; j < 8; ++j) g[j] = wave_sum(g[j]);
            if (F.lane < 4) {
                const float gi = (F.lane == 0 ? g[0] : F.lane == 1 ? g[1] : F.lane == 2 ? g[2] : g[3]) + F.in[IN_GATEB][F.lane];
                const float gf = (F.lane == 0 ? g[4] : F.lane == 1 ? g[5] : F.lane == 2 ? g[6] : g[7]) + F.in[IN_GATEB][4 + F.lane];
                LI[(size_t)V * 4 + F.lane] = gi;
                LF[(size_t)V * 4 + F.lane] = fminf(gf, 0.f) - log1pf(__expf(-fabsf(gf)));
            }
        }
        __syncthreads();
    }
    {
        LAS float* scr = (LAS float*)(F.lds + RING_OFF + F.wave * 16384);
        constexpr int I_IN1 = 16 * 96, I_IN2 = 16 * 64, I_BH = 8 * 32, I_OUT = 16 * 32;
        constexpr int NITEMS = I_IN1 + I_IN2 + 2 * I_BH + I_OUT;
        for (int it = gw; it < NITEMS; it += NGW) {
            int r = it;
            if (r < I_IN1) { const int kb = r / 96, nb = r % 96; p0_item(F.in[IN_WIN], NIN, 32 * nb, 1, F.in[IN_NMIX], (bf16*)(ws + WS_WIN), D, 32 * nb, 64 * kb, scr, F.lane); continue; } r -= I_IN1;
            if (r < I_IN2) { const int kb = r / 64, nb = r % 64; p0_item(F.in[IN_WIN], NIN, 3080 + 32 * nb, 1, F.in[IN_NMIX], (bf16*)(ws + WS_WIN), D, 3072 + 32 * nb, 64 * kb, scr, F.lane); continue; } r -= I_IN2;
            if (r < I_BH) { const int kb = r / 32, nb = r % 32; p0_item(F.in[IN_WBH], D, 32 * nb, 1, nullptr, (bf16*)(ws + WS_WBH), HW, 32 * nb, 64 * kb, scr, F.lane); continue; } r -= I_BH;
            if (r < I_BH) { const int kb = r / 32, nb = r % 32; p0_item(F.in[IN_WBM], D, 32 * nb, 1, nullptr, (bf16*)(ws + WS_WBM), HW, 32 * nb, 64 * kb, scr, F.lane); continue; } r -= I_BH;
            { const int kb = r / 32, nb = r % 32; p0_item(F.in[IN_WOUT], D, 32 * nb, 1, nullptr, (bf16*)(ws + WS_WOUT), D, 32 * nb, 64 * kb, scr, F.lane); }
        }
    }
    { float* BGUP = (float*)(ws + WS_BGUP); float* RWT = (float*)(ws + WS_RWT);
      for (int u = gt; u < NE * 2 * DFF; u += NGT) { const int e = u >> 11, n = u & 2047, pn = n >> 8, bj = (n >> 7) & 1, j = gu_slot(n & 127); BGUP[u] = F.in[IN_BGU][(size_t)e * 2 * DFF + 2 * (128 * pn + j) + bj]; }
      for (int u = gt; u < NE * D; u += NGT) { const int e = u >> 10, k = u & 1023; RWT[u] = F.in[IN_NFFN][k] * F.in[IN_RW][(size_t)k * NE + e]; } }
}

__device__ __forceinline__ unsigned pk4_fp8(float a, float b, float c, float d) { unsigned w = 0;
    a = __builtin_amdgcn_fmed3f(a, -448.f, 448.f); b = __builtin_amdgcn_fmed3f(b, -448.f, 448.f); c = __builtin_amdgcn_fmed3f(c, -448.f, 448.f); d = __builtin_amdgcn_fmed3f(d, -448.f, 448.f);
    w = __builtin_amdgcn_cvt_pk_fp8_f32(a, b, w, false); w = __builtin_amdgcn_cvt_pk_fp8_f32(c, d, w, true); return w; }
__device__ __forceinline__ void cvdn_load(const float* Wdn, int it, f32x4 (&v)[8], int lane) {
    const int e = it >> 9, kb = (it >> 5) & 15, nb = it & 31, r = lane >> 3, c4 = (lane & 7) * 4; const float* W = Wdn + (size_t)e * DFF * D;
#pragma unroll
    for (int i = 0; i < 8; ++i) v[i] = *(const GAS f32x4*)(W + (size_t)(64 * kb + 8 * i + r) * D + 32 * nb + c4);
}
__device__ __forceinline__ void cvdn_proc(unsigned char* WTdn, int it, const f32x4 (&v)[8], LAS float* scr, int lane) {
    const int e = it >> 9, kb = (it >> 5) & 15, nb = it & 31, r = lane >> 3, c4 = (lane & 7) * 4; unsigned char* WT = WTdn + (size_t)e * D * DFF;
#pragma unroll
    for (int i = 0; i < 8; ++i) { LAS float* s = scr + (8 * i + r) * 33 + c4; s[0] = v[i].x * 32.f; s[1] = v[i].y * 32.f; s[2] = v[i].z * 32.f; s[3] = v[i].w * 32.f; }
    LDS_WAIT(); asm volatile("" ::: "memory");
    const int c = lane & 7;
#pragma unroll
    for (int j = 0; j < 4; ++j) { const int n = (lane >> 3) + 8 * j; const LAS float* s = scr + (8 * c) * 33 + n;
        v2u o; o.x = pk4_fp8(s[0 * 33], s[1 * 33], s[2 * 33], s[3 * 33]); o.y = pk4_fp8(s[4 * 33], s[5 * 33], s[6 * 33], s[7 * 33]);
        const int cn = 32 * nb + n, rowp = (cn & ~255) + 128 * ((cn >> 3) & 1) + 32 * ((cn >> 6) & 3) + 8 * ((cn >> 4) & 3) + (cn & 7);
        *(GAS v2u*)(WT + (size_t)rowp * DFF + 64 * kb + 8 * c) = o; }
    LDS_WAIT(); asm volatile("" ::: "memory");
}
__device__ __forceinline__ void cvgu_load(const float* Wgu, const float* nffn, int it, f32x4 (&v)[8], float (&sc)[8], int lane) {
    const int e = it >> 10, kb = (it >> 5) & 31, nb = it & 31, r = lane >> 4, c4 = (lane & 15) * 4; const float* W = Wgu + (size_t)e * D * 2 * DFF;
#pragma unroll
    for (int i = 0; i < 8; ++i) { v[i] = *(const GAS f32x4*)(W + (size_t)(32 * kb + 4 * i + r) * (2 * DFF) + 64 * nb + c4); sc[i] = nffn[32 * kb + 4 * i + r] * 32.f; }
}
__device__ __forceinline__ void cvgu_proc(unsigned char* WTgu, int it, const f32x4 (&v)[8], const float (&sc)[8], LAS float* scr, int lane) {
    const int e = it >> 10, kb = (it >> 5) & 31, nb = it & 31, r = lane >> 4, c4 = (lane & 15) * 4, A0 = 32 * nb, k0 = 32 * kb; unsigned char* WT = WTgu + (size_t)e * 2 * DFF * D;
    LAS float* sg = scr; LAS float* su = scr + 32 * 33;
#pragma unroll
    for (int i = 0; i < 8; ++i) { const int o = (4 * i + r) * 33 + (c4 >> 1); sg[o] = v[i].x * sc[i]; su[o] = v[i].y * sc[i]; sg[o + 1] = v[i].z * sc[i]; su[o + 1] = v[i].w * sc[i]; }
    LDS_WAIT(); asm volatile("" ::: "memory");
    const int c = lane & 3;
#pragma unroll
    for (int j = 0; j < 4; ++j) { const int q = (lane >> 2) + 16 * j, isup = q >> 5, jj = q & 31, A = A0 + jj; const LAS float* s = scr + isup * 32 * 33 + (8 * c) * 33 + jj;
        v2u o; o.x = pk4_fp8(s[0 * 33], s[1 * 33], s[2 * 33], s[3 * 33]); o.y = pk4_fp8(s[4 * 33], s[5 * 33], s[6 * 33], s[7 * 33]);
        *(GAS v2u*)(WT + (size_t)(256 * (A >> 7) + 128 * isup + gu_slot(A & 127)) * D + k0 + 8 * c) = o; }
    LDS_WAIT(); asm volatile("" ::: "memory");
}
__device__ __forceinline__ void px_experts(Frame& F, int rank, int nwg) {
    unsigned char* ws = F.ws;
    LAS float* scr = (LAS float*)(F.lds + RING_OFF + F.wave * 16384);
    const int gw = rank * NWAVES + F.wave, NGW = nwg * NWAVES;
    { constexpr int NIT = NE * 1024; f32x4 v[8], vn[8]; float sc[8], sn[8]; int it = gw;
      if (it < NIT) cvgu_load(F.in[IN_WGU], F.in[IN_NFFN], it, v, sc, F.lane);
      while (it < NIT) { const int nx = it + NGW; if (nx < NIT) cvgu_load(F.in[IN_WGU], F.in[IN_NFFN], nx, vn, sn, F.lane);
          asm volatile("" ::: "memory");
          cvgu_proc((unsigned char*)(ws + WS_WGU), it, v, sc, scr, F.lane); asm volatile("" ::: "memory");
#pragma unroll
          for (int i = 0; i < 8; ++i) { v[i] = vn[i]; sc[i] = sn[i]; }
          it = nx; } }
    { constexpr int NIT = NE * 512; f32x4 v[8], vn[8]; int it = gw;
      if (it < NIT) cvdn_load(F.in[IN_WDN], it, v, F.lane);
      while (it < NIT) { const int nx = it + NGW; if (nx < NIT) cvdn_load(F.in[IN_WDN], nx, vn, F.lane);
          asm volatile("" ::: "memory");
          cvdn_proc((unsigned char*)(ws + WS_WDN), it, v, scr, F.lane); asm volatile("" ::: "memory");
#pragma unroll
          for (int i = 0; i < 8; ++i) v[i] = vn[i];
          it = nx; } }
}

namespace pg8 {
typedef unsigned v2u_t __attribute__((ext_vector_type(2)));
__device__ __forceinline__ u32x4 pack8(const f32x4& a, const f32x4& b) { u32x4 w; w.x = cvt_pk_bf16(a[0], a[1]); w.y = cvt_pk_bf16(a[2], a[3]); w.z = cvt_pk_bf16(b[0], b[1]); w.w = cvt_pk_bf16(b[2], b[3]); return w; }
__device__ __forceinline__ v2u_t pack8_fp8(const f32x4& a, const f32x4& b) { unsigned lo = 0, hi = 0;
    lo = __builtin_amdgcn_cvt_pk_fp8_f32(a[0], a[1], lo, false); lo = __builtin_amdgcn_cvt_pk_fp8_f32(a[2], a[3], lo, true);
    hi = __builtin_amdgcn_cvt_pk_fp8_f32(b[0], b[1], hi, false); hi = __builtin_amdgcn_cvt_pk_fp8_f32(b[2], b[3], hi, true); return (v2u_t){lo, hi}; }
__device__ __forceinline__ v2u_t pack8_fp8_sat(const f32x4& a, const f32x4& b) { f32x4 x, y;
#pragma unroll
    for (int i = 0; i < 4; ++i) { x[i] = __builtin_amdgcn_fmed3f(a[i], -448.f, 448.f); y[i] = __builtin_amdgcn_fmed3f(b[i], -448.f, 448.f); }
    return pack8_fp8(x, y); }
__device__ __forceinline__ void unpack8(const u32x4& w, f32x4& a, f32x4& b) { a = (f32x4){bflo(w.x), bfhi(w.x), bflo(w.y), bfhi(w.y)}; b = (f32x4){bflo(w.z), bfhi(w.z), bflo(w.w), bfhi(w.w)}; }
struct EpiProj {
    static constexpr bool PERM = true, AFTER_DRAIN = false;
    unsigned char* ws; const float* lbl;
    __device__ __forceinline__ void operator()(const f32x4 (&acc)[2][2][4][2], const Unit& u, int wr, int wc, int fr, int fq) const {
        const int row0 = u.pm * BM + wr * 64 + fr, kind = u.pn < 12 ? (u.pn >> 1) : 6;
        const int colt = (u.pn < 12 ? (u.pn & 1) : (u.pn - 12)) * BM + wc * 32 + 8 * fq;
        if (kind == 1) {
            float* HG = (float*)(ws + WS_HG);
#pragma unroll
            for (int bj = 0; bj < 2; ++bj) { const int c = colt + bj * HALF; float lb[8];
#pragma unroll
                for (int i = 0; i < 8; ++i) lb[i] = fsigmoid(lbl[c + i] - lbl[HW + c + i]);
#pragma unroll
                for (int ai = 0; ai < 2; ++ai)
#pragma unroll
                    for (int m = 0; m < 4; ++m) { float* rowp = HG + (size_t)(row0 + ai * HALF + m * 16) * HW + c; f32x4 o0, o1;
#pragma unroll
                        for (int i = 0; i < 4; ++i) { o0[i] = __logf(lb[i] + (1.f - lb[i]) * fsigmoid(acc[ai][bj][m][0][i])); o1[i] = __logf(lb[4 + i] + (1.f - lb[4 + i]) * fsigmoid(acc[ai][bj][m][1][i])); }
                        *(f32x4*)rowp = o0; *(f32x4*)(rowp + 4) = o1; } }
            return;
        }
        bf16_t* O; int ldc = HW; int act = 0;
        if (kind == 0) { O = (bf16_t*)(ws + WS_HQ); act = 1; } else if (kind == 2) { O = (bf16_t*)(ws + WS_HV); } else if (kind == 3) { O = (bf16_t*)(ws + WS_HGATE); act = 1; }
        else if (kind == 4) { O = (bf16_t*)(ws + WS_MM); } else if (kind == 5) { O = (bf16_t*)(ws + WS_MO); act = 2; } else { O = (bf16_t*)(ws + WS_GATES); ldc = 2048; act = 2; }
#pragma unroll
        for (int ai = 0; ai < 2; ++ai)
#pragma unroll
            for (int m = 0; m < 4; ++m) { bf16_t* rowp = O + (size_t)(row0 + ai * HALF + m * 16) * ldc + colt;
#pragma unroll
                for (int bj = 0; bj < 2; ++bj) { f32x4 v0 = acc[ai][bj][m][0], v1 = acc[ai][bj][m][1];
                    if (act) {
#pragma unroll
                        for (int i = 0; i < 4; ++i) { const float s0 = fsigmoid(v0[i]), s1 = fsigmoid(v1[i]); v0[i] = act == 1 ? v0[i] * s0 : s0; v1[i] = act == 1 ? v1[i] * s1 : s1; } }
                    *(u32x4*)(rowp + bj * HALF) = pack8(v0, v1); } }
    }
};
constexpr int PAIR_DA = 132, PAIR_DB = 4;
struct PairOrder { StaticOrder S;
    __device__ __forceinline__ bool next(int i, Unit& u) const { Unit t; if (!S.next(i >> 1, t)) return false; const int s = i & 1; u.pm = t.pm + PAIR_DA * s; u.pn = t.pn + PAIR_DB * s; return true; }
    __device__ __forceinline__ void a_ready(const Unit&) const {}
    __device__ __forceinline__ void done(const Unit&) const {}
};
struct EpiGate2 {
    static constexpr bool PERM = true, AFTER_DRAIN = false;
    const bf16_t* __restrict__ gates; bf16_t* __restrict__ tmp; bf16_t* __restrict__ merged;
    __device__ __forceinline__ void operator()(const f32x4 (&acc)[2][2][4][2], const Unit& u, int wr, int wc, int fr, int fq) const {
        const int step = u.pm >= PAIR_DA ? 1 : 0, pm = u.pm - PAIR_DA * step, pn = u.pn - PAIR_DB * step;
        const int row0 = pm * BM + wr * 64 + fr, col0 = pn * BM + wc * 32 + 8 * fq;
        constexpr int NB = 2, NBAT = 8 / NB;
        bf16_t* obuf = tmp + (ptrdiff_t)(merged - tmp) * step;
        u32x4 gc[NB][2], tc[NB][2], gn[NB][2], tn[NB][2];
#define EG_LOAD(G, T, b_) do { _Pragma("unroll") for (int s_ = 0; s_ < NB; ++s_) { const int it_ = (b_) * NB + s_; const size_t row_ = (size_t)(row0 + (it_ >> 2) * HALF + (it_ & 3) * 16); _Pragma("unroll") for (int bj = 0; bj < 2; ++bj) { \
        G[s_][bj] = *(const u32x4*)(gates + row_ * 2048 + step * D + col0 + bj * HALF); if (step) T[s_][bj] = *(const u32x4*)(tmp + row_ * D + col0 + bj * HALF); else T[s_][bj] = (u32x4){0u, 0u, 0u, 0u}; } } } while (0)
        EG_LOAD(gc, tc, 0);
#pragma unroll
        for (int b = 0; b < NBAT; ++b) {
            if (b + 1 < NBAT) EG_LOAD(gn, tn, b + 1);
#pragma unroll
            for (int s = 0; s < NB; ++s) { const int it = b * NB + s, ai = it >> 2, m = it & 3; const size_t row = (size_t)(row0 + ai * HALF + m * 16);
#pragma unroll
                for (int bj = 0; bj < 2; ++bj) { const int c = col0 + bj * HALF; f32x4 g0, g1, t0, t1; unpack8(gc[s][bj], g0, g1); unpack8(tc[s][bj], t0, t1);
                    const u32x4 o = pack8(acc[ai][bj][m][0] * g0 + t0, acc[ai][bj][m][1] * g1 + t1);
                    *(u32x4*)(obuf + row * D + c) = o; } }
#pragma unroll
            for (int s = 0; s < NB; ++s)
#pragma unroll
                for (int bj = 0; bj < 2; ++bj) { gc[s][bj] = gn[s][bj]; tc[s][bj] = tn[s][bj]; } }
#undef EG_LOAD
    }
};
struct EpiH1 {
    static constexpr bool PERM = true, AFTER_DRAIN = false;
    const bf16_t* __restrict__ xn0; const float* __restrict__ xsq; bf16_t* __restrict__ H1; unsigned char* __restrict__ H1B8;
    __device__ __forceinline__ void operator()(const f32x4 (&acc)[2][2][4][2], const Unit& u, int wr, int wc, int fr, int fq) const {
        const int row0 = u.pm * BM + wr * 64 + fr, col0 = u.pn * BM + wc * 32 + 8 * fq;
        u32x4 xc[2], xn[2]; float sc, sn;
#define EH_LOAD(X, S_, it_) do { const size_t r_ = (size_t)(row0 + ((it_) >> 2) * HALF + ((it_) & 3) * 16); const bf16_t* src_ = xn0 + r_ * D + col0; S_ = xsq[r_]; _Pragma("unroll") for (int bj = 0; bj < 2; ++bj) X[bj] = *(const u32x4*)(src_ + bj * HALF); } while (0)
        EH_LOAD(xc, sc, 0);
#pragma unroll
        for (int it = 0; it < 8; ++it) { const int ai = it >> 2, m = it & 3; const size_t V = (size_t)(row0 + ai * HALF + m * 16);
            if (it + 1 < 8) EH_LOAD(xn, sn, it + 1);
#pragma unroll
            for (int bj = 0; bj < 2; ++bj) { const int c = col0 + bj * HALF; f32x4 x0, x1; unpack8(xc[bj], x0, x1);
                const f32x4 v0 = acc[ai][bj][m][0] + x0 * sc, v1 = acc[ai][bj][m][1] + x1 * sc;
                *(u32x4*)(H1 + V * D + c) = pack8(v0, v1); *(v2u_t*)(H1B8 + V * D + c) = pack8_fp8_sat(v0, v1); }
#pragma unroll
            for (int bj = 0; bj < 2; ++bj) xc[bj] = xn[bj];
            sc = sn; }
#undef EH_LOAD
    }
};
struct EpiGU {
    static constexpr bool PERM = true, AFTER_DRAIN = false;
    const float* __restrict__ bgup; const float* __restrict__ ers; unsigned char* __restrict__ act; const PG8_LAS int* pst;
    __device__ __forceinline__ void operator()(const f32x4 (&acc)[2][2][4][2], const Unit& u, int wr, int wc, int fr, int fq) const {
        const int e = u.pn >> 3, pn = u.pn & 7, row0 = u.pm * BM + wr * 64 + fr, cc = wc * 32 + 8 * fq;
        const float* rsp = ers + (size_t)e * NV + (row0 - pst[e]);
        const float* bp = bgup + (size_t)e * 2 * DFF + pn * BM + cc;
        const f32x4 bg0 = *(const f32x4*)bp, bg1 = *(const f32x4*)(bp + 4), bu0 = *(const f32x4*)(bp + HALF), bu1 = *(const f32x4*)(bp + HALF + 4);
        float rsv[8];
#pragma unroll
        for (int it = 0; it < 8; ++it) rsv[it] = rsp[(it >> 2) * HALF + (it & 3) * 16];
        const int hi = fq >> 1;
        unsigned char* obase = act + (size_t)(row0 + 16 * hi) * DFF + pn * HALF + wc * 32 + 16 * (fq & 1);
#pragma unroll
        for (int ai = 0; ai < 2; ++ai)
#pragma unroll
            for (int mp = 0; mp < 2; ++mp) { v2u_t pk[2];
#pragma unroll
                for (int q = 0; q < 2; ++q) { const int m = 2 * mp + q; const float rs = rsv[ai * 4 + m] * 0.03125f;
                    f32x4 o0, o1;
#pragma unroll
                    for (int i = 0; i < 4; ++i) {
                        float g0 = fminf(acc[ai][0][m][0][i] * rs + bg0[i], 7.f), u0 = fminf(fmaxf(acc[ai][1][m][0][i] * rs + bu0[i], -7.f), 7.f);
                        float g1 = fminf(acc[ai][0][m][1][i] * rs + bg1[i], 7.f), u1 = fminf(fmaxf(acc[ai][1][m][1][i] * rs + bu1[i], -7.f), 7.f);
                        o0[i] = (u0 + 1.f) * g0 * fsigmoid(1.702f * g0); o1[i] = (u1 + 1.f) * g1 * fsigmoid(1.702f * g1); }
                    pk[q] = pack8_fp8(o0, o1); }
                const auto r0 = __builtin_amdgcn_permlane32_swap(pk[0][0], pk[1][0], false, false), r1 = __builtin_amdgcn_permlane32_swap(pk[0][1], pk[1][1], false, false);
                *(u32x4*)(obase + (size_t)(ai * HALF + mp * 32) * DFF) = (u32x4){r0[0], r1[0], r0[1], r1[1]}; }
    }
};
struct EpiDown {
    static constexpr bool PERM = true, AFTER_DRAIN = false;
    const float* __restrict__ bdn; const float* __restrict__ ew; unsigned char* __restrict__ yb; const PG8_LAS int* pst;
    __device__ __forceinline__ void operator()(const f32x4 (&acc)[2][2][4][2], const Unit& u, int wr, int wc, int fr, int fq) const {
        const int e = u.pn >> 2, pn = u.pn & 3, row0 = u.pm * BM + wr * 64 + fr, col0 = pn * BM + wc * 64 + 16 * fq;
        const float* wp = ew + (size_t)e * NV + (row0 - pst[e]);
        f32x4 bv[2][2];
#pragma unroll
        for (int bj = 0; bj < 2; ++bj) { bv[bj][0] = *(const f32x4*)(bdn + (size_t)e * D + col0 + 8 * bj); bv[bj][1] = *(const f32x4*)(bdn + (size_t)e * D + col0 + 8 * bj + 4); }
        float wv[8];
#pragma unroll
        for (int it = 0; it < 8; ++it) wv[it] = wp[(it >> 2) * HALF + (it & 3) * 16];
#pragma unroll
        for (int ai = 0; ai < 2; ++ai)
#pragma unroll
            for (int m = 0; m < 4; ++m) { const size_t row = (size_t)(row0 + ai * HALF + m * 16); const float w = wv[ai * 4 + m] * 16.f;
                const v2u_t lo = pack8_fp8_sat((acc[ai][0][m][0] * 0.03125f + bv[0][0]) * w, (acc[ai][0][m][1] * 0.03125f + bv[0][1]) * w), hi = pack8_fp8_sat((acc[ai][1][m][0] * 0.03125f + bv[1][0]) * w, (acc[ai][1][m][1] * 0.03125f + bv[1][1]) * w);
                *(u32x4*)(yb + row * D + col0) = (u32x4){lo[0], lo[1], hi[0], hi[1]}; }
    }
};
struct GroupOrder {
    int ntiles, ncol, G, c; const PG8_LAS unsigned char* texp;
    __device__ __forceinline__ bool next(int i, Unit& u) const { const int x = c & 7, w = c >> 3, uu = i * (G >> 3) + w, lj = uu / ncol, pn = uu - lj * ncol, j = lj * 8 + x; if (j >= ntiles) return false; u.pm = j; u.pn = (int)texp[j] * ncol + pn; return true; }
    __device__ __forceinline__ void a_ready(const Unit&) const {}
    __device__ __forceinline__ void done(const Unit&) const {}
};
}

typedef short bf16x8 __attribute__((ext_vector_type(8)));
typedef float f32x16 __attribute__((ext_vector_type(16)));
#define MFMA32(a, b, c) __builtin_amdgcn_mfma_f32_32x32x16_bf16(a, b, c, 0, 0, 0)
__device__ __forceinline__ bf16x8 ldfrag(const LAS unsigned char* base, int st, int row0, int k0, int lane) { return *(const LAS bf16x8*)(base + (row0 + (lane & 31)) * st + (k0 + 8 * (lane >> 5)) * 2); }
__device__ __forceinline__ bf16x8 ldf(const LAS unsigned char* lanebase, int off) { return *(const LAS bf16x8*)(lanebase + off); }
__device__ __forceinline__ float fexp(float x) { return __builtin_amdgcn_exp2f(x * 1.4426950408889634f); }

__device__ __forceinline__ void p3_hgrn2_mfma(Frame& F, int bh) {
    unsigned char* ws = F.ws; const int b = bh >> 2, h = bh & 3, tid = F.tid, lane = F.lane, wave = F.wave, hh = lane >> 5, l31 = lane & 31;
    const bf16* HQ = (const bf16*)(ws + WS_HQ) + h * 128; const float* HG = (const float*)(ws + WS_HG) + h * 128; const bf16* HV = (const bf16*)(ws + WS_HV) + h * 128;
    const bf16* HGATE = (const bf16*)(ws + WS_HGATE) + h * 128; bf16* YHG = (bf16*)(ws + WS_YHG) + h * 128;
    LAS unsigned char* L = F.lds + RING_OFF;
    LAS unsigned char* QT = L; LAS unsigned char* KT = L + 17408; LAS unsigned char* KTT = L + 34816; LAS unsigned char* VT = L + 53248; LAS unsigned char* ST = L + 71680; LAS unsigned char* PP = L + 106496;
    LAS float* SEG = (LAS float*)(L + 115712); LAS float* ER = (LAS float*)(L + 117760); LAS float* EL = (LAS float*)(L + 118272); LAS float* OST = (LAS float*)(L + 17408);
    const int d = tid & 127, pq = tid >> 7;
    const int et = tid >> 3, evq = tid & 7;
    const int f144 = l31 * 144 + hh * 16, f272 = l31 * 272 + hh * 16;
    const int sst = wave == 2 ? 1 : 0, stt = wave == 0 ? 0 : 1, dt = wave & 3, vt0 = 2 * (wave >> 2), btt = wave & 1, bvt = wave >> 1;
    const LAS unsigned char* aK = KT + 32 * sst * 272 + f272; const LAS unsigned char* bQ = QT + 32 * stt * 272 + f272;
    LAS unsigned char* pst = PP + (32 * stt + l31) * 144 + (32 * sst + 4 * hh) * 2;
    const LAS unsigned char* aKTT = KTT + 32 * dt * 144 + f144; const LAS unsigned char* bV0 = VT + 32 * vt0 * 144 + f144;
    LAS unsigned char* sst_ = ST + (32 * vt0 + l31) * 272 + (32 * dt + 4 * hh) * 2;
    const LAS float* erp = ER + 32 * dt + 4 * hh; const LAS float* elp = EL + 32 * dt + 4 * hh;
    const LAS unsigned char* aP = PP + 32 * btt * 144 + f144; const LAS unsigned char* bVB = VT + 32 * bvt * 144 + f144;
    const LAS unsigned char* aQ = QT + 32 * btt * 272 + f272; const LAS unsigned char* bS = ST + 32 * bvt * 272 + f272;
    LAS float* ost = OST + (32 * btt + 4 * hh) * 132 + 32 * bvt + l31; const LAS float* oep = OST + et * 132 + 16 * evq;
    LAS unsigned char* tq = QT + 16 * pq * 272 + d * 2; LAS unsigned char* tk = KT + 16 * pq * 272 + d * 2; LAS unsigned char* tkt = KTT + d * 144 + pq * 32; LAS unsigned char* tv = VT + d * 144 + pq * 32;
    f32x16 S0, S1;
#pragma unroll
    for (int i = 0; i < 16; ++i) { S0[i] = 0.f; S1[i] = 0.f; }
    float gq[16]; unsigned qr[16], vr[16]; v4u gt0, gt1;
    float gn[16];
#pragma unroll
    for (int i = 0; i < 16; ++i) gn[i] = F.in[IN_HGNORM][h * 128 + 16 * evq + i];
#define HG_LOAD(c) do { const int ttb = 64 * (c) - 48 + 16 * pq; \
        _Pragma("unroll") for (int i = 0; i < 16; ++i) { const int tt = ttb + i; if (tt >= 0) { const size_t gi = rowof(b, tt) * HW + d; gq[i] = HG[gi]; qr[i] = (unsigned)HQ[gi]; vr[i] = (unsigned)HV[gi]; } else { gq[i] = 0.f; qr[i] = 0u; vr[i] = 0u; } } \
        { const int tt = 64 * (c) - 48 + et; if (tt >= 0) { const GAS v4u* gp = (const GAS v4u*)(HGATE + rowof(b, tt) * HW + 16 * evq); gt0 = gp[0]; gt1 = gp[1]; } else { gt0 = (v4u){0u, 0u, 0u, 0u}; gt1 = gt0; } } } while (0)
    HG_LOAD(0);
    for (int c = 0; c < 33; ++c) {
        float bl[16];
        { float a = 0.f;
#pragma unroll
          for (int i = 0; i < 16; ++i) { a += gq[i]; bl[i] = a; } }
        SEG[pq * 128 + d] = bl[15];
        __syncthreads();
        { const float s0 = SEG[d], s1 = SEG[128 + d], s2 = SEG[256 + d], s3 = SEG[384 + d];
          const float off = pq == 0 ? 0.f : pq == 1 ? s0 : pq == 2 ? s0 + s1 : (s0 + s1) + s2, r = s0 + s1, blast = (s0 + s1) + (s2 + s3);
          unsigned kp[8], vp[8];
#pragma unroll
          for (int i = 0; i < 16; i += 2) {
              const float b0 = off + bl[i], b1 = off + bl[i + 1];
              const float q0 = __builtin_bit_cast(float, qr[i] << 16) * fexp(b0 - r), q1 = __builtin_bit_cast(float, qr[i + 1] << 16) * fexp(b1 - r);
              const float k0 = (1.f - fexp(gq[i])) * fexp(r - b0), k1 = (1.f - fexp(gq[i + 1])) * fexp(r - b1);
              const unsigned kk = pg8::cvt_pk_bf16(k0, k1), qq = pg8::cvt_pk_bf16(q0, q1);
              *(LAS unsigned short*)(tq + i * 272) = (unsigned short)qq; *(LAS unsigned short*)(tq + (i + 1) * 272) = (unsigned short)(qq >> 16);
              *(LAS unsigned short*)(tk + i * 272) = (unsigned short)kk; *(LAS unsigned short*)(tk + (i + 1) * 272) = (unsigned short)(kk >> 16);
              kp[i >> 1] = kk; vp[i >> 1] = vr[i] | (vr[i + 1] << 16); }
          *(LAS v4u*)(tkt) = (v4u){kp[0], kp[1], kp[2], kp[3]}; *(LAS v4u*)(tkt + 16) = (v4u){kp[4], kp[5], kp[6], kp[7]};
          *(LAS v4u*)(tv) = (v4u){vp[0], vp[1], vp[2], vp[3]}; *(LAS v4u*)(tv + 16) = (v4u){vp[4], vp[5], vp[6], vp[7]};
          if (pq == 0) { ER[d] = fexp(r); EL[d] = fexp(blast - r); } }
        const v4u g0 = gt0, g1 = gt1;
        __syncthreads();
        if (c + 1 < 33) HG_LOAD(c + 1);
        asm volatile("" ::: "memory");
        if (wave < 3) {
            f32x16 acc;
#pragma unroll
            for (int i = 0; i < 16; ++i) acc[i] = 0.f;
#pragma unroll
            for (int ks = 0; ks < 8; ++ks) acc = MFMA32(ldf(aK, 32 * ks), ldf(bQ, 32 * ks), acc);
            const int t = 32 * stt + l31;
#pragma unroll
            for (int g4 = 0; g4 < 4; ++g4) { const int s0 = 32 * sst + 8 * g4 + 4 * hh;
                const float x0 = (s0 + 0 <= t) ? acc[4 * g4 + 0] : 0.f, x1 = (s0 + 1 <= t) ? acc[4 * g4 + 1] : 0.f, x2 = (s0 + 2 <= t) ? acc[4 * g4 + 2] : 0.f, x3 = (s0 + 3 <= t) ? acc[4 * g4 + 3] : 0.f;
                *(LAS v2u*)(pst + 16 * g4) = (v2u){pg8::cvt_pk_bf16(x0, x1), pg8::cvt_pk_bf16(x2, x3)}; }
        }
        {
#pragma unroll
          for (int g4 = 0; g4 < 4; ++g4) { const f32x4 er = *(const LAS f32x4*)(erp + 8 * g4);
#pragma unroll
              for (int i = 0; i < 4; ++i) { S0[4 * g4 + i] *= er[i]; S1[4 * g4 + i] *= er[i]; }
              *(LAS v2u*)(sst_ + 16 * g4) = (v2u){pg8::cvt_pk_bf16(S0[4 * g4], S0[4 * g4 + 1]), pg8::cvt_pk_bf16(S0[4 * g4 + 2], S0[4 * g4 + 3])};
              *(LAS v2u*)(sst_ + 32 * 272 + 16 * g4) = (v2u){pg8::cvt_pk_bf16(S1[4 * g4], S1[4 * g4 + 1]), pg8::cvt_pk_bf16(S1[4 * g4 + 2], S1[4 * g4 + 3])}; }
#pragma unroll
          for (int ks = 0; ks < 4; ++ks) { const bf16x8 a = ldf(aKTT, 32 * ks); S0 = MFMA32(a, ldf(bV0, 32 * ks), S0); S1 = MFMA32(a, ldf(bV0, 32 * 144 + 32 * ks), S1); }
#pragma unroll
          for (int g4 = 0; g4 < 4; ++g4) { const f32x4 el = *(const LAS f32x4*)(elp + 8 * g4);
#pragma unroll
              for (int i = 0; i < 4; ++i) { S0[4 * g4 + i] *= el[i]; S1[4 * g4 + i] *= el[i]; } } }
        __syncthreads();
        { f32x16 acc;
#pragma unroll
          for (int i = 0; i < 16; ++i) acc[i] = 0.f;
#pragma unroll
          for (int ks = 0; ks < 4; ++ks) if (ks < 2 || btt == 1) acc = MFMA32(ldf(aP, 32 * ks), ldf(bVB, 32 * ks), acc);
#pragma unroll
          for (int ks = 0; ks < 8; ++ks) acc = MFMA32(ldf(aQ, 32 * ks), ldf(bS, 32 * ks), acc);
#pragma unroll
          for (int i = 0; i < 16; ++i) ost[((i & 3) + 8 * (i >> 2)) * 132] = acc[i]; }
        __syncthreads();
        { const int tt = 64 * c - 48 + et;
          f32x4 o[4]; float ss = 0.f;
#pragma unroll
          for (int j = 0; j < 4; ++j) { o[j] = *(const LAS f32x4*)(oep + 4 * j); ss += (o[j].x * o[j].x + o[j].y * o[j].y) + (o[j].z * o[j].z + o[j].w * o[j].w); }
          ss += __shfl_xor(ss, 1); ss += __shfl_xor(ss, 2); ss += __shfl_xor(ss, 4);
          const float rs = 1.0f / sqrtf(ss * (1.f / 128.f) + EPS);
          if (tt >= NMETA || (tt >= 0 && b == 0)) { const unsigned gw[8] = {g0.x, g0.y, g0.z, g0.w, g1.x, g1.y, g1.z, g1.w}; unsigned w[8];
#pragma unroll
              for (int j = 0; j < 4; ++j) { w[2 * j] = pk2(o[j].x * rs * gn[4 * j] * bflo(gw[2 * j]), o[j].y * rs * gn[4 * j + 1] * bfhi(gw[2 * j])); w[2 * j + 1] = pk2(o[j].z * rs * gn[4 * j + 2] * bflo(gw[2 * j + 1]), o[j].w * rs * gn[4 * j + 3] * bfhi(gw[2 * j + 1])); }
              GAS v4u* yp = (GAS v4u*)(YHG + rowof(b, tt) * HW + 16 * evq); yp[0] = (v4u){w[0], w[1], w[2], w[3]}; yp[1] = (v4u){w[4], w[5], w[6], w[7]}; } }
        __syncthreads();
    }
#undef HG_LOAD
}


#define DPP_F(old, v, ctrl, rmask) __builtin_bit_cast(float, __builtin_amdgcn_update_dpp(__builtin_bit_cast(int, (float)(old)), __builtin_bit_cast(int, (float)(v)), (ctrl), (rmask), 0xf, false))
__device__ __forceinline__ float wave_scan_add(float v) {
    v += DPP_F(0.f, v, 0x111, 0xf); v += DPP_F(0.f, v, 0x112, 0xf); v += DPP_F(0.f, v, 0x114, 0xf); v += DPP_F(0.f, v, 0x118, 0xf);
    v += DPP_F(0.f, v, 0x142, 0xa); v += DPP_F(0.f, v, 0x143, 0xc); return v;
}
__device__ __forceinline__ float wave_scan_max(float v) {
    const float ni = -INFINITY;
    v = fmaxf(v, DPP_F(ni, v, 0x111, 0xf)); v = fmaxf(v, DPP_F(ni, v, 0x112, 0xf)); v = fmaxf(v, DPP_F(ni, v, 0x114, 0xf)); v = fmaxf(v, DPP_F(ni, v, 0x118, 0xf));
    v = fmaxf(v, DPP_F(ni, v, 0x142, 0xa)); v = fmaxf(v, DPP_F(ni, v, 0x143, 0xc)); return v;
}
__device__ __forceinline__ void p3_mlstm_mfma(Frame& F, int bh) {
    unsigned char* ws = F.ws; const int b = bh >> 2, h = bh & 3, tid = F.tid, lane = F.lane, wave = F.wave, hh = lane >> 5, l31 = lane & 31;
    const bf16* MMg = (const bf16*)(ws + WS_MM) + h * 128; const bf16* MOg = (const bf16*)(ws + WS_MO) + h * 128; const float* LI = (const float*)(ws + WS_LI) + h; const float* LF = (const float*)(ws + WS_LF) + h;
    bf16* YML = (bf16*)(ws + WS_YML) + h * 128;
    LAS unsigned char* L = F.lds + RING_OFF;
    LAS unsigned char* CT = L; LAS unsigned char* MT = L + 17408; LAS unsigned char* KM = L + 34816; LAS unsigned char* KW = L + 44032; LAS unsigned char* QM = L + 53248; LAS unsigned char* QW = L + 62464;
    LAS unsigned char* VT = L + 71680; LAS unsigned char* SV = L + 90112; LAS unsigned char* PP = L + 108544; LAS float* OST = (LAS float*)(L + 17408);
    LAS float* SM = (LAS float*)(L + 117760);
    LAS float* U = SM; LAS float* MX = SM + 64; LAS float* BB = SM + 128; LAS float* WSs = SM + 192; LAS float* WI = SM + 256; LAS float* DENP = SM + 320  ; LAS float* NN = SM + 416; LAS float* DENI = SM + 480; LAS float* SC = SM + 544  ; LAS float* GNS = SM + 560  ;
    const int ch = tid & 127, pq = tid >> 7, et = tid >> 3, evq = tid & 7;
    const int f144 = l31 * 144 + hh * 16, f272 = l31 * 272 + hh * 16;
    const int sst = wave == 2 ? 1 : 0, stt = wave == 0 ? 0 : 1, dkt = wave & 1, svt = wave >> 1;
    const LAS unsigned char* cfp = (wave < 4 ? CT : MT) + f272;
    LAS unsigned char* qst = QM + l31 * 144 + (32 * (wave & 1) + 4 * hh) * 2; LAS unsigned char* qwst = QW + l31 * 144 + (32 * (wave & 1) + 4 * hh) * 2;
    const int kdk = 32 * (wave & 1) + l31;
    LAS unsigned char* kmst = KM + 4 * hh * 144 + kdk * 2; LAS unsigned char* kwst = KW + kdk * 144 + 4 * hh * 2; const LAS float* wsp = WSs + 4 * hh;
    LAS unsigned char* vst = VT + (32 * (wave & 3) + l31) * 144 + 4 * hh * 2;
    const LAS unsigned char* aKM = KM + 32 * sst * 144 + f144; const LAS unsigned char* bQM = QM + 32 * stt * 144 + f144;
    LAS unsigned char* pst = PP + (32 * stt + l31) * 144 + (32 * sst + 4 * hh) * 2; const LAS float* up = U + 32 * sst + 4 * hh;
    LAS unsigned char* svst = SV + (32 * svt + l31) * 144 + (32 * dkt + 4 * hh) * 2;
    const LAS unsigned char* aKW = KW + 32 * dkt * 144 + f144; const LAS unsigned char* bVT = VT + 32 * svt * 144 + f144;
    const LAS unsigned char* aP = PP + 32 * dkt * 144 + f144; const LAS unsigned char* aQW = QW + 32 * dkt * 144 + f144; const LAS unsigned char* bSV = SV + 32 * svt * 144 + f144;
    LAS float* ost = OST + (32 * dkt + 4 * hh) * 132 + 32 * svt + l31; const LAS float* oep = OST + et * 132 + 16 * evq;
    LAS unsigned char* tc = CT + 16 * pq * 272 + ch * 2; LAS unsigned char* tm = MT + 16 * pq * 272 + ch * 2;
    bf16x8 wf[8];
    { const float* W = wave < 2 ? F.in[IN_WQ] + (size_t)h * 128 * 64 + 32 * wave + l31 : wave < 4 ? F.in[IN_WK] + (size_t)h * 128 * 64 + 32 * (wave - 2) + l31 : F.in[IN_WV] + (size_t)h * 128 * 128 + 32 * (wave - 4) + l31;
      const int ld = wave < 4 ? 64 : 128; const float sc = wave < 2 ? 0.125f : 1.f;
#pragma unroll
      for (int ks = 0; ks < 8; ++ks) { unsigned p[4];
#pragma unroll
          for (int j = 0; j < 4; ++j) p[j] = pk2(W[(size_t)(16 * ks + 8 * hh + 2 * j) * ld] * sc, W[(size_t)(16 * ks + 8 * hh + 2 * j + 1) * ld] * sc);
          wf[ks] = __builtin_bit_cast(bf16x8, (v4u){p[0], p[1], p[2], p[3]}); } }
    float cw[4]; const float cb = F.in[IN_CONVB][h * 128 + ch];
#pragma unroll
    for (int j = 0; j < 4; ++j) cw[j] = F.in[IN_CONVW][j * HW + h * 128 + ch];
    if (tid < 128) GNS[tid] = F.in[IN_MLNORM][h * 128 + tid]; else if (tid < 256) GNS[tid] = F.in[IN_MLSKIP][h * 128 + tid - 128];
    f32x16 S;
#pragma unroll
    for (int i = 0; i < 16; ++i) S[i] = 0.f;
    float mcar = 0.f, nreg = 0.f;
    unsigned mr[19]; v4u gt0, gt1; float pli = 0.f, plf = 0.f;
#define ML_LOAD(c) do { const int ttb = 64 * (c) - 48 + 16 * pq - 3; \
        _Pragma("unroll") for (int i = 0; i < 19; ++i) { const int tt = ttb + i; mr[i] = tt >= 0 ? (unsigned)MMg[rowof(b, tt) * HW + ch] : 0u; } \
        { const int tt = 64 * (c) - 48 + et; if (tt >= 0) { const GAS v4u* gp = (const GAS v4u*)(MOg + rowof(b, tt) * HW + 16 * evq); gt0 = gp[0]; gt1 = gp[1]; } else { gt0 = (v4u){0u, 0u, 0u, 0u}; gt1 = gt0; } } \
        if (wave == 0) { const int tt = 64 * (c) - 48 + lane; if (tt >= 0) { pli = LI[rowof(b, tt) * 4]; plf = LF[rowof(b, tt) * 4]; } else { pli = -1e30f; plf = 0.f; } } } while (0)
    ML_LOAD(0);
    for (int c = 0; c < 33; ++c) {
#pragma unroll
        for (int i = 0; i < 16; ++i) { const float a = cb + (cw[0] * __builtin_bit_cast(float, mr[i] << 16) + cw[1] * __builtin_bit_cast(float, mr[i + 1] << 16)) + (cw[2] * __builtin_bit_cast(float, mr[i + 2] << 16) + cw[3] * __builtin_bit_cast(float, mr[i + 3] << 16));
            *(LAS unsigned short*)(tc + i * 272) = (unsigned short)f2bf(fsilu(a)); *(LAS unsigned short*)(tm + i * 272) = (unsigned short)mr[i + 3]; }
        if (wave == 0) {
            const float bs = wave_scan_add(plf);
            const float u = pli - bs; const float pm = wave_scan_max(u);
            const float M = fmaxf(mcar, pm), M63 = __shfl(M, 63), b63 = __shfl(bs, 63);
            U[lane] = u; MX[lane] = M; BB[lane] = bs; WSs[lane] = fexp(u - M63); WI[lane] = fexp(mcar - M);
            if (lane == 0) { SC[0] = b63; SC[1] = M63; }
        }
        __syncthreads();
        { f32x16 a0, a1;
#pragma unroll
          for (int i = 0; i < 16; ++i) { a0[i] = 0.f; a1[i] = 0.f; }
          if (wave < 2) {
#pragma unroll
              for (int ks = 0; ks < 8; ++ks) { a0 = MFMA32(wf[ks], ldf(cfp, 32 * ks), a0); a1 = MFMA32(wf[ks], ldf(cfp, 32 * 272 + 32 * ks), a1); }
              const float wi0 = WI[l31], wi1 = WI[32 + l31];
#pragma unroll
              for (int g4 = 0; g4 < 4; ++g4) {
                  *(LAS v2u*)(qst + 16 * g4) = (v2u){pg8::cvt_pk_bf16(a0[4 * g4], a0[4 * g4 + 1]), pg8::cvt_pk_bf16(a0[4 * g4 + 2], a0[4 * g4 + 3])};
                  *(LAS v2u*)(qst + 32 * 144 + 16 * g4) = (v2u){pg8::cvt_pk_bf16(a1[4 * g4], a1[4 * g4 + 1]), pg8::cvt_pk_bf16(a1[4 * g4 + 2], a1[4 * g4 + 3])};
                  *(LAS v2u*)(qwst + 16 * g4) = (v2u){pg8::cvt_pk_bf16(a0[4 * g4] * wi0, a0[4 * g4 + 1] * wi0), pg8::cvt_pk_bf16(a0[4 * g4 + 2] * wi0, a0[4 * g4 + 3] * wi0)};
                  *(LAS v2u*)(qwst + 32 * 144 + 16 * g4) = (v2u){pg8::cvt_pk_bf16(a1[4 * g4] * wi1, a1[4 * g4 + 1] * wi1), pg8::cvt_pk_bf16(a1[4 * g4 + 2] * wi1, a1[4 * g4 + 3] * wi1)}; }
          } else {
#pragma unroll
              for (int ks = 0; ks < 8; ++ks) { a0 = MFMA32(ldf(cfp, 32 * ks), wf[ks], a0); a1 = MFMA32(ldf(cfp, 32 * 272 + 32 * ks), wf[ks], a1); }
              if (wave < 4) {
                  float nsum = 0.f;
#pragma unroll
                  for (int g4 = 0; g4 < 4; ++g4) { const f32x4 w0 = *(const LAS f32x4*)(wsp + 8 * g4), w1 = *(const LAS f32x4*)(wsp + 32 + 8 * g4);
#pragma unroll
                      for (int i = 0; i < 4; ++i) { *(LAS unsigned short*)(kmst + (8 * g4 + i) * 144) = (unsigned short)f2bf(a0[4 * g4 + i]); *(LAS unsigned short*)(kmst + (32 + 8 * g4 + i) * 144) = (unsigned short)f2bf(a1[4 * g4 + i]); }
                      const float x0 = a0[4 * g4] * w0[0], x1 = a0[4 * g4 + 1] * w0[1], x2 = a0[4 * g4 + 2] * w0[2], x3 = a0[4 * g4 + 3] * w0[3];
                      const float y0 = a1[4 * g4] * w1[0], y1 = a1[4 * g4 + 1] * w1[1], y2 = a1[4 * g4 + 2] * w1[2], y3 = a1[4 * g4 + 3] * w1[3];
                      nsum += ((x0 + x1) + (x2 + x3)) + ((y0 + y1) + (y2 + y3));
                      *(LAS v2u*)(kwst + 16 * g4) = (v2u){pg8::cvt_pk_bf16(x0, x1), pg8::cvt_pk_bf16(x2, x3)};
                      *(LAS v2u*)(kwst + 64 + 16 * g4) = (v2u){pg8::cvt_pk_bf16(y0, y1), pg8::cvt_pk_bf16(y2, y3)}; }
                  nsum += __shfl_xor(nsum, 32);
                  if (hh == 0) NN[kdk] = nreg;
                  nreg = fexp(mcar - SC[1]) * nreg + nsum;
              } else {
#pragma unroll
                  for (int g4 = 0; g4 < 4; ++g4) {
                      *(LAS v2u*)(vst + 16 * g4) = (v2u){pg8::cvt_pk_bf16(a0[4 * g4], a0[4 * g4 + 1]), pg8::cvt_pk_bf16(a0[4 * g4 + 2], a0[4 * g4 + 3])};
                      *(LAS v2u*)(vst + 64 + 16 * g4) = (v2u){pg8::cvt_pk_bf16(a1[4 * g4], a1[4 * g4 + 1]), pg8::cvt_pk_bf16(a1[4 * g4 + 2], a1[4 * g4 + 3])}; }
              }
          } }
        __syncthreads();
        const v4u g0 = gt0, g1 = gt1;
        if (c + 1 < 33) ML_LOAD(c + 1);
        asm volatile("" ::: "memory");
        if (wave < 3) {
            f32x16 acc;
#pragma unroll
            for (int i = 0; i < 16; ++i) acc[i] = 0.f;
#pragma unroll
            for (int ks = 0; ks < 4; ++ks) acc = MFMA32(ldf(aKM, 32 * ks), ldf(bQM, 32 * ks), acc);
            const int t = 32 * stt + l31; const float mt = MX[t]; float dsum = 0.f;
#pragma unroll
            for (int g4 = 0; g4 < 4; ++g4) { const int s0 = 32 * sst + 8 * g4 + 4 * hh; const f32x4 us = *(const LAS f32x4*)(up + 8 * g4);
                const float x0 = (s0 + 0 <= t) ? acc[4 * g4 + 0] * fexp(us[0] - mt) : 0.f, x1 = (s0 + 1 <= t) ? acc[4 * g4 + 1] * fexp(us[1] - mt) : 0.f;
                const float x2 = (s0 + 2 <= t) ? acc[4 * g4 + 2] * fexp(us[2] - mt) : 0.f, x3 = (s0 + 3 <= t) ? acc[4 * g4 + 3] * fexp(us[3] - mt) : 0.f;
                dsum += (x0 + x1) + (x2 + x3);
                *(LAS v2u*)(pst + 16 * g4) = (v2u){pg8::cvt_pk_bf16(x0, x1), pg8::cvt_pk_bf16(x2, x3)}; }
            dsum += __shfl_xor(dsum, 32);
            if (hh == 0) DENP[wave * 32 + l31] = dsum;
        } else if (wave == 3) {
            float a = 0.f;
#pragma unroll 2
            for (int j = 0; j < 8; ++j) { const v4u q = *(const LAS v4u*)(QW + lane * 144 + 16 * j); const f32x4 n0 = *(const LAS f32x4*)(NN + 8 * j), n1 = *(const LAS f32x4*)(NN + 8 * j + 4);
                a += (bflo(q.x) * n0[0] + bfhi(q.x) * n0[1]) + (bflo(q.y) * n0[2] + bfhi(q.y) * n0[3]) + (bflo(q.z) * n1[0] + bfhi(q.z) * n1[1]) + (bflo(q.w) * n1[2] + bfhi(q.w) * n1[3]); }
            DENI[lane] = a;
        }
        { const float wp = fexp(mcar - SC[1]);
#pragma unroll
          for (int g4 = 0; g4 < 4; ++g4) {
              *(LAS v2u*)(svst + 16 * g4) = (v2u){pg8::cvt_pk_bf16(S[4 * g4], S[4 * g4 + 1]), pg8::cvt_pk_bf16(S[4 * g4 + 2], S[4 * g4 + 3])};
#pragma unroll
              for (int i = 0; i < 4; ++i) S[4 * g4 + i] *= wp; }
#pragma unroll
          for (int ks = 0; ks < 4; ++ks) S = MFMA32(ldf(aKW, 32 * ks), ldf(bVT, 32 * ks), S); }
        __syncthreads();
        { f32x16 acc;
#pragma unroll
          for (int i = 0; i < 16; ++i) acc[i] = 0.f;
#pragma unroll
          for (int ks = 0; ks < 4; ++ks) if (ks < 2 || dkt == 1) acc = MFMA32(ldf(aP, 32 * ks), ldf(bVT, 32 * ks), acc);
#pragma unroll
          for (int ks = 0; ks < 4; ++ks) acc = MFMA32(ldf(aQW, 32 * ks), ldf(bSV, 32 * ks), acc);
#pragma unroll
          for (int i = 0; i < 16; ++i) ost[((i & 3) + 8 * (i >> 2)) * 132] = acc[i]; }
        __syncthreads();
        { const int tt = 64 * c - 48 + et;
          const float den = (et < 32 ? DENP[et] : DENP[et] + DENP[32 + et]) + DENI[et];
          const float inv = 1.0f / fmaxf(fabsf(den), fexp(-(BB[et] + MX[et])));
          f32x4 o[4]; float ss = 0.f;
#pragma unroll
          for (int j = 0; j < 4; ++j) { o[j] = *(const LAS f32x4*)(oep + 4 * j) * inv; ss += (o[j].x * o[j].x + o[j].y * o[j].y) + (o[j].z * o[j].z + o[j].w * o[j].w); }
          ss += __shfl_xor(ss, 1); ss += __shfl_xor(ss, 2); ss += __shfl_xor(ss, 4);
          const float rs = 1.0f / sqrtf(ss * (1.f / 128.f) + EPS);
          if (tt >= NMETA || (tt >= 0 && b == 0)) { const unsigned gw[8] = {g0.x, g0.y, g0.z, g0.w, g1.x, g1.y, g1.z, g1.w}; unsigned w[8];
              const v4u c0 = *(const LAS v4u*)(CT + et * 272 + 32 * evq), c1 = *(const LAS v4u*)(CT + et * 272 + 32 * evq + 16); const unsigned cwd[8] = {c0.x, c0.y, c0.z, c0.w, c1.x, c1.y, c1.z, c1.w};
#pragma unroll
              for (int j = 0; j < 4; ++j) { const f32x4 gn = *(const LAS f32x4*)(GNS + 16 * evq + 4 * j), sk = *(const LAS f32x4*)(GNS + 128 + 16 * evq + 4 * j);
                  w[2 * j] = pk2((o[j].x * rs * gn[0] + sk[0] * bflo(cwd[2 * j])) * bflo(gw[2 * j]), (o[j].y * rs * gn[1] + sk[1] * bfhi(cwd[2 * j])) * bfhi(gw[2 * j]));
                  w[2 * j + 1] = pk2((o[j].z * rs * gn[2] + sk[2] * bflo(cwd[2 * j + 1])) * bflo(gw[2 * j + 1]), (o[j].w * rs * gn[3] + sk[3] * bfhi(cwd[2 * j + 1])) * bfhi(gw[2 * j + 1])); }
              GAS v4u* yp = (GAS v4u*)(YML + rowof(b, tt) * HW + 16 * evq); yp[0] = (v4u){w[0], w[1], w[2], w[3]}; yp[1] = (v4u){w[4], w[5], w[6], w[7]}; }
          mcar = SC[0] + SC[1]; }
        __syncthreads();
    }
#undef ML_LOAD
}

typedef float f32x4v __attribute__((ext_vector_type(4)));
#define MFMA16F(a, b, c) __builtin_amdgcn_mfma_f32_16x16x4f32(a, b, c, 0, 0, 0)
constexpr int RW_LD = 516;
__device__ __forceinline__ void router_topk16(LAS float* LGw, int V, float rsv, int resrow, int lane, LAS int* hist, LAS int* res, int* TOPE, float* TOPW, float* RS) {
    if (lane < 16) {
        int se[4]; float sv[4];
#pragma unroll
        for (int k = 0; k < 4; ++k) { float best = -INFINITY; int bi = 0;
            for (int e = 0; e < 32; ++e) { const float v = LGw[lane * 33 + e]; if (v > best) { best = v; bi = e; } }
            se[k] = bi; sv[k] = best; LGw[lane * 33 + bi] = -INFINITY; }
        const float e1 = __expf(sv[1] - sv[0]), e2 = __expf(sv[2] - sv[0]), e3 = __expf(sv[3] - sv[0]), inv = 1.0f / (1.f + e1 + e2 + e3);
        const float w4[4] = {inv, e1 * inv, e2 * inv, e3 * inv};
#pragma unroll
        for (int k = 0; k < 4; ++k) { const int lp = __hip_atomic_fetch_add(hist + se[k], 1, __ATOMIC_RELAXED, __HIP_MEMORY_SCOPE_WORKGROUP);
            TOPE[(size_t)V * 4 + k] = se[k]; TOPW[(size_t)V * 4 + k] = w4[k]; res[(resrow + lane) * 4 + k] = lp; }
        RS[V] = rsv;
    }
}
__device__ __forceinline__ void p6_router(Frame& F) {
    unsigned char* ws = F.ws;
    const bf16* H1 = (const bf16*)(ws + WS_H1); const float* RWT = (const float*)(ws + WS_RWT);
    int* TOPE = (int*)(ws + WS_TOPE); int* TOPP = (int*)(ws + WS_TOPP); float* TOPW = (float*)(ws + WS_TOPW); float* RS = (float*)(ws + WS_RS);
    int* ETOK = (int*)(ws + WS_ETOK); float* ERS = (float*)(ws + WS_ERS); float* EW = (float*)(ws + WS_EW);
    LAS float* rw = (LAS float*)(F.lds + RING_OFF);
    LAS float* LG = (LAS float*)(F.lds + RING_OFF + 66048) + F.wave * 528;
    LAS int* hist = (LAS int*)(F.lds + RING_OFF + 66048 + 8 * 2112);
    LAS int* res = hist + 64;
    LAS float* XP = (LAS float*)(res + 144 * 4);
    LAS float* XQ = XP + 8 * 528;
    const int lane = F.lane, wave = F.wave, i16 = lane & 15, kk = lane >> 4;
    constexpr int RPW = NTOK / 256;
    const bool has_meta = (F.vcu == 0);
    const int Vbase = F.vcu * RPW, Vt = Vbase + 16 * wave;
    if (F.tid < 64) hist[F.tid] = 0;
    f32x4v acc0 = {0.f, 0.f, 0.f, 0.f}, acc1 = {0.f, 0.f, 0.f, 0.f}, acx0 = {0.f, 0.f, 0.f, 0.f}, acx1 = {0.f, 0.f, 0.f, 0.f}; float ssq = 0.f, xss = 0.f;
    const bf16* arow = H1 + (size_t)(Vt + i16) * D + 8 * kk;
    const bf16* xrow = H1 + (size_t)(NTOK + i16) * D + 8 * kk;
    v4u a0[4], a1[4];
#define RT_MMA(A, SB, C0, C1, SS) do { const LAS float* b0p = rw + i16 * RW_LD + 8 * kk + 128 * (SB); const LAS float* b1p = rw + (16 + i16) * RW_LD + 8 * kk + 128 * (SB); \
        _Pragma("unroll") for (int s = 0; s < 4; ++s) { const v4u aw = A[s]; \
            _Pragma("unroll") for (int h = 0; h < 2; ++h) { const unsigned w0 = h ? aw.z : aw.x, w1 = h ? aw.w : aw.y; const f32x4 a = {bflo(w0), bfhi(w0), bflo(w1), bfhi(w1)}; \
            const f32x4 b0 = *(const LAS f32x4*)(b0p + 32 * s + 4 * h), b1 = *(const LAS f32x4*)(b1p + 32 * s + 4 * h); \
            SS += (a.x * a.x + a.y * a.y) + (a.z * a.z + a.w * a.w); \
            C0 = MFMA16F(a.x, b0.x, C0); C1 = MFMA16F(a.x, b1.x, C1); C0 = MFMA16F(a.y, b0.y, C0); C1 = MFMA16F(a.y, b1.y, C1); \
            C0 = MFMA16F(a.z, b0.z, C0); C1 = MFMA16F(a.z, b1.z, C1); C0 = MFMA16F(a.w, b0.w, C0); C1 = MFMA16F(a.w, b1.w, C1); } } } while (0)
#pragma unroll
    for (int s = 0; s < 4; ++s) a0[s] = *(const GAS v4u*)(arow + 32 * s);
#pragma unroll 1
    for (int it = 0; it < 4; ++it) {
        const int half = it >> 1, sb0 = (2 * it) & 3;
        if ((it & 1) == 0) {
            __syncthreads();
            { f32x4 stg[8];
#pragma unroll
              for (int q = 0; q < 8; ++q) { const int u = F.tid + q * NTHREADS, e = u >> 7, c = u & 127; stg[q] = *(const GAS f32x4*)(RWT + (size_t)e * D + 512 * half + 4 * c); }
#pragma unroll
              for (int q = 0; q < 8; ++q) { const int u = F.tid + q * NTHREADS, e = u >> 7, c = u & 127; *(LAS f32x4*)(rw + e * RW_LD + 4 * c) = stg[q]; } }
            __syncthreads();
        }
#pragma unroll
        for (int s = 0; s < 4; ++s) a1[s] = *(const GAS v4u*)(arow + 128 * (2 * it + 1) + 32 * s);
        RT_MMA(a0, sb0, acc0, acc1, ssq);
        if (it < 3) {
#pragma unroll
            for (int s = 0; s < 4; ++s) a0[s] = *(const GAS v4u*)(arow + 128 * (2 * it + 2) + 32 * s);
        }
        RT_MMA(a1, sb0 + 1, acc0, acc1, ssq);
        if (has_meta && (wave >> 1) == it) {
            v4u ax[4];
#pragma unroll
            for (int s = 0; s < 4; ++s) ax[s] = *(const GAS v4u*)(xrow + 128 * wave + 32 * s);
            RT_MMA(ax, wave & 3, acx0, acx1, xss);
        }
    }
#undef RT_MMA
    if (has_meta) {
        xss += __shfl_xor(xss, 16); xss += __shfl_xor(xss, 32);
#pragma unroll
        for (int r = 0; r < 4; ++r) { XP[wave * 528 + (4 * kk + r) * 33 + i16] = acx0[r]; XP[wave * 528 + (4 * kk + r) * 33 + 16 + i16] = acx1[r]; }
        if (kk == 0) XQ[wave * 16 + i16] = xss;
    }
    ssq += __shfl_xor(ssq, 16); ssq += __shfl_xor(ssq, 32);
    const float rsrow = 1.0f / sqrtf(ssq * (1.f / D) + EPS);
    const float rb0 = F.in[IN_RB][i16], rb1 = F.in[IN_RB][16 + i16];
#pragma unroll
    for (int r = 0; r < 4; ++r) { const float rsr = __shfl(rsrow, 4 * kk + r); LG[(4 * kk + r) * 33 + i16] = acc0[r] * rsr + rb0; LG[(4 * kk + r) * 33 + 16 + i16] = acc1[r] * rsr + rb1; }
    LDS_WAIT(); asm volatile("" ::: "memory");
    router_topk16(LG, Vt + lane, rsrow, 16 * wave, lane, hist, res, TOPE, TOPW, RS);
    __syncthreads();
    if (has_meta && wave == 7) {
        float q = 0.f;
#pragma unroll
        for (int w = 0; w < 8; ++w) q += XQ[w * 16 + i16];
        const float rsm = 1.0f / sqrtf(q * (1.f / D) + EPS);
#pragma unroll
        for (int r = 0; r < 4; ++r) { float v0 = 0.f, v1 = 0.f;
#pragma unroll
            for (int w = 0; w < 8; ++w) { v0 += XP[w * 528 + (4 * kk + r) * 33 + i16]; v1 += XP[w * 528 + (4 * kk + r) * 33 + 16 + i16]; }
            const float rsr = __shfl(rsm, 4 * kk + r); LG[(4 * kk + r) * 33 + i16] = v0 * rsr + rb0; LG[(4 * kk + r) * 33 + 16 + i16] = v1 * rsr + rb1; }
        LDS_WAIT(); asm volatile("" ::: "memory");
        router_topk16(LG, NTOK + lane, rsm, 128, lane, hist, res, TOPE, TOPW, RS);
    }
    __syncthreads();
    if (F.tid < NE) hist[32 + F.tid] = (int)__hip_atomic_fetch_add(F.ctl + CW_CNT + 64 * F.tid, (unsigned)hist[F.tid], RLX_AGENT);
    __syncthreads();
    const int nrows = has_meta ? RPW + 16 : RPW;
    for (int u = F.tid; u < nrows * 4; u += NTHREADS) { const int rr = u >> 2, V = rr < RPW ? Vbase + rr : NTOK + (rr - RPW); const size_t gi = (size_t)V * 4 + (u & 3); const int e = TOPE[gi], pos = hist[32 + e] + res[u];
        TOPP[gi] = pos; ETOK[(size_t)e * NV + pos] = V; ERS[(size_t)e * NV + pos] = RS[V]; EW[(size_t)e * NV + pos] = TOPW[gi]; }
}

__device__ __forceinline__ void build_tables(Frame& F) {
    LAS int* pst = (LAS int*)(F.lds + PST_OFF); LAS unsigned char* texp = (LAS unsigned char*)(F.lds + TEXP_OFF);
    __syncthreads();
    if (F.tid < 64) {
        const int e = F.lane & 31; const int c = (int)__hip_atomic_load(F.ctl + CW_CNT + 64 * e, RLX_AGENT); const int nt = (c + 255) >> 8;
        int incl = nt;
#pragma unroll
        for (int o = 1; o < 32; o <<= 1) { const int t = __shfl_up(incl, o); if ((F.lane & 31) >= o) incl += t; }
        const int start = incl - nt;
        if (F.lane < 32) { pst[e] = start * 256; pst[33 + e] = c; for (int j = 0; j < nt && start + j < MAXTILES; ++j) texp[start + j] = (unsigned char)e; if (e == 31) pst[32] = incl < MAXTILES ? incl : MAXTILES; }
    }
    __syncthreads();
}
typedef float f32v2_t __attribute__((ext_vector_type(2)));
__device__ __forceinline__ void p10_combine(Frame& F) {
    unsigned char* ws = F.ws; build_tables(F);
    const LAS int* pst = (const LAS int*)(F.lds + PST_OFF);
    const bf16* H1 = (const bf16*)(ws + WS_H1); const unsigned char* YB = (const unsigned char*)(ws + WS_YB);
    const int* TOPE = (const int*)(ws + WS_TOPE); const int* TOPP = (const int*)(ws + WS_TOPP);
    const int gw = F.vcu * NWAVES + F.wave, NGW = F.G * NWAVES;
    const GAS f32x4* nf = (const GAS f32x4*)F.in[IN_NFIN] + F.lane; f32x4 nfv[4];
#pragma unroll
    for (int j = 0; j < 4; ++j) nfv[j] = nf[64 * j];
    int sl[2][4];
#define CMB_SLOTS(Rbase) do { _Pragma("unroll") for (int q = 0; q < 2; ++q) { const int R = (Rbase) + q * NGW; if (R < BATCH * SEQ) { const size_t V = (size_t)R; \
        _Pragma("unroll") for (int k = 0; k < 4; ++k) sl[q][k] = pst[TOPE[V * 4 + k]] + TOPP[V * 4 + k]; } else { _Pragma("unroll") for (int k = 0; k < 4; ++k) sl[q][k] = 0; } } } while (0)
    CMB_SLOTS(gw);
    for (int R0 = gw; R0 < BATCH * SEQ; R0 += 2 * NGW) {
        f32x4 v[2][4]; unsigned y[2][4][4];
#pragma unroll
        for (int q = 0; q < 2; ++q) { const int R = (R0 + q * NGW < BATCH * SEQ) ? R0 + q * NGW : R0; const size_t V = (size_t)R;
            const GAS v2u* hr = (const GAS v2u*)(H1 + V * D) + F.lane;
#pragma unroll
            for (int j = 0; j < 4; ++j) { const v2u hw = hr[64 * j]; v[q][j] = (f32x4){bflo(hw.x), bfhi(hw.x), bflo(hw.y), bfhi(hw.y)}; }
#pragma unroll
            for (int k = 0; k < 4; ++k) { const GAS unsigned* yr = (const GAS unsigned*)(YB + (size_t)sl[q][k] * D) + F.lane;
#pragma unroll
                for (int j = 0; j < 4; ++j) y[q][k][j] = yr[64 * j]; } }
        CMB_SLOTS(R0 + 2 * NGW);
#pragma unroll
        for (int q = 0; q < 2; ++q) { const int R = R0 + q * NGW; if (R >= BATCH * SEQ) continue;
#pragma unroll
            for (int k = 0; k < 4; ++k)
#pragma unroll
                for (int j = 0; j < 4; ++j) { const unsigned w = y[q][k][j]; const f32v2_t lo = __builtin_amdgcn_cvt_pk_f32_fp8(w, false), hi = __builtin_amdgcn_cvt_pk_f32_fp8(w, true);
                    v[q][j].x += lo[0] * 0.0625f; v[q][j].y += lo[1] * 0.0625f; v[q][j].z += hi[0] * 0.0625f; v[q][j].w += hi[1] * 0.0625f; }
            float s = 0.f;
#pragma unroll
            for (int j = 0; j < 4; ++j) s += (v[q][j].x * v[q][j].x + v[q][j].y * v[q][j].y) + (v[q][j].z * v[q][j].z + v[q][j].w * v[q][j].w);
            const float rs = 1.0f / sqrtf(wave_sum(s) * (1.f / D) + EPS);
            GAS f32x4* orow = (GAS f32x4*)(F.out + (size_t)R * D) + F.lane;
#pragma unroll
            for (int j = 0; j < 4; ++j) orow[64 * j] = v[q][j] * rs * nfv[j]; }
    }
#undef CMB_SLOTS
}

__device__ __forceinline__ int meta_row(int lane) { return ((lane >> 5) & 1) * 8 + ((lane >> 4) & 1) * 4 + ((lane >> 3) & 1) * 2 + ((lane >> 2) & 1); }
template <int KPL> __device__ __forceinline__ float meta_col(const LAS unsigned char* A, const bf16* wrow, int lane) {
    constexpr int K = 64 * KPL; float w[KPL];
#pragma unroll
    for (int j = 0; j < KPL / 8; ++j) { const v4u x = *(const GAS v4u*)(wrow + lane * KPL + 8 * j);
        w[8 * j] = bflo(x.x); w[8 * j + 1] = bfhi(x.x); w[8 * j + 2] = bflo(x.y); w[8 * j + 3] = bfhi(x.y); w[8 * j + 4] = bflo(x.z); w[8 * j + 5] = bfhi(x.z); w[8 * j + 6] = bflo(x.w); w[8 * j + 7] = bfhi(x.w); }
    float p[16];
#pragma unroll
    for (int r = 0; r < 16; ++r) { float s = 0.f;
#pragma unroll
        for (int j = 0; j < KPL / 8; ++j) { const v4u a = *(const LAS v4u*)(A + (r * K + lane * KPL + 8 * j) * 2);
            s += (bflo(a.x) * w[8 * j] + bfhi(a.x) * w[8 * j + 1]) + (bflo(a.y) * w[8 * j + 2] + bfhi(a.y) * w[8 * j + 3]) + (bflo(a.z) * w[8 * j + 4] + bfhi(a.z) * w[8 * j + 5]) + (bflo(a.w) * w[8 * j + 6] + bfhi(a.w) * w[8 * j + 7]); }
        p[r] = s; if ((r & 3) == 3) asm volatile("" ::: "memory"); }
    const bool b32 = lane & 32, b16 = lane & 16, b8 = lane & 8, b4 = lane & 4;
    float q8[8], q4[4], q2[2];
#pragma unroll
    for (int i = 0; i < 8; ++i) { const float keep = b32 ? p[i + 8] : p[i], send = b32 ? p[i] : p[i + 8]; q8[i] = keep + __shfl_xor(send, 32); }
#pragma unroll
    for (int i = 0; i < 4; ++i) { const float keep = b16 ? q8[i + 4] : q8[i], send = b16 ? q8[i] : q8[i + 4]; q4[i] = keep + __shfl_xor(send, 16); }
#pragma unroll
    for (int i = 0; i < 2; ++i) { const float keep = b8 ? q4[i + 2] : q4[i], send = b8 ? q4[i] : q4[i + 2]; q2[i] = keep + __shfl_xor(send, 8); }
    float v = (b4 ? q2[1] : q2[0]) + __shfl_xor(b4 ? q2[0] : q2[1], 4);
    v += __shfl_xor(v, 2); v += __shfl_xor(v, 1);
    return v;
}
__device__ __forceinline__ void meta_stage(Frame& F, LAS unsigned char* dst, const bf16* src, int K) {
    v4u t[4]; const int n = 16 * K / 8;
#pragma unroll
    for (int q = 0; q < 4; ++q) { const int u = F.tid + q * NTHREADS; if (u < n) t[q] = *(const GAS v4u*)(src + (size_t)u * 8); }
#pragma unroll
    for (int q = 0; q < 4; ++q) { const int u = F.tid + q * NTHREADS; if (u < n) *(LAS v4u*)(dst + u * 16) = t[q]; }
}
__device__ __forceinline__ void meta_proj(Frame& F) {
    unsigned char* ws = F.ws; const bf16* WIN = (const bf16*)(ws + WS_WIN); const float* lbl = F.in[IN_LBL];
    LAS unsigned char* A = F.lds + RING_OFF;
    __syncthreads(); meta_stage(F, A, (const bf16*)(ws + WS_XN0) + (size_t)NTOK * D, D); __syncthreads();
    for (int c = F.vcu * NWAVES + F.wave; c < NPROJ; c += F.G * NWAVES) {
        const float v = meta_col<16>(A, WIN + (size_t)c * D, F.lane);
        if ((F.lane & 3) == 0) { const size_t row = NTOK + meta_row(F.lane); const int kind = c < 3072 ? (c >> 9) : 6, cc = c & 511;
            if (kind == 0) ((bf16*)(ws + WS_HQ))[row * HW + cc] = (bf16)f2bf(fsilu(v));
            else if (kind == 1) { const float lb = fsigmoid(lbl[cc] - lbl[HW + cc]); ((float*)(ws + WS_HG))[row * HW + cc] = __logf(lb + (1.f - lb) * fsigmoid(v)); }
            else if (kind == 2) ((bf16*)(ws + WS_HV))[row * HW + cc] = (bf16)f2bf(v);
            else if (kind == 3) ((bf16*)(ws + WS_HGATE))[row * HW + cc] = (bf16)f2bf(fsilu(v));
            else if (kind == 4) ((bf16*)(ws + WS_MM))[row * HW + cc] = (bf16)f2bf(v);
            else if (kind == 5) ((bf16*)(ws + WS_MO))[row * HW + cc] = (bf16)f2bf(fsigmoid(v));
            else ((bf16*)(ws + WS_GATES))[row * 2048 + (c - 3072)] = (bf16)f2bf(fsigmoid(v)); } }
}
__device__ __forceinline__ void meta_merged(Frame& F) {
    unsigned char* ws = F.ws; const bf16* GATES = (const bf16*)(ws + WS_GATES);
    LAS unsigned char* A0 = F.lds + RING_OFF; LAS unsigned char* A1 = A0 + 16 * HW * 2;
    __syncthreads(); meta_stage(F, A0, (const bf16*)(ws + WS_YHG) + (size_t)NTOK * HW, HW); meta_stage(F, A1, (const bf16*)(ws + WS_YML) + (size_t)NTOK * HW, HW); __syncthreads();
    for (int c = F.vcu * NWAVES + F.wave; c < D; c += F.G * NWAVES) {
        const float vh = meta_col<8>(A0, (const bf16*)(ws + WS_WBH) + (size_t)c * HW, F.lane), vm = meta_col<8>(A1, (const bf16*)(ws + WS_WBM) + (size_t)c * HW, F.lane);
        if ((F.lane & 3) == 0) { const size_t row = NTOK + meta_row(F.lane); ((bf16*)(ws + WS_MERGED))[row * D + c] = (bf16)f2bf(bf1(GATES[row * 2048 + c]) * vh + bf1(GATES[row * 2048 + D + c]) * vm); } }
}
__device__ __forceinline__ void meta_wout(Frame& F) {
    unsigned char* ws = F.ws; LAS unsigned char* A = F.lds + RING_OFF;
    __syncthreads(); meta_stage(F, A, (const bf16*)(ws + WS_MERGED) + (size_t)NTOK * D, D); __syncthreads();
    for (int c = F.vcu * NWAVES + F.wave; c < D; c += F.G * NWAVES) {
        const float d = meta_col<16>(A, (const bf16*)(ws + WS_WOUT) + (size_t)c * D, F.lane);
        if ((F.lane & 3) == 0) { const int mr_ = meta_row(F.lane); const size_t row = NTOK + mr_; const float v = F.in[IN_META][(size_t)mr_ * D + c] + d;
            ((bf16*)(ws + WS_H1))[row * D + c] = (bf16)f2bf(v); ((unsigned char*)(ws + WS_H1B))[row * D + c] = (unsigned char)(__builtin_amdgcn_cvt_pk_fp8_f32(__builtin_amdgcn_fmed3f(v, -448.f, 448.f), 0.f, 0u, false) & 0xffu); } }
}

__device__ __forceinline__ void ph_proj(Frame& F) {
    unsigned char* ws = F.ws;
    pg8::Gemm g{(const pg8::bf16_t*)(ws + WS_XN0), (const pg8::bf16_t*)(ws + WS_WIN), NTOK, NPROJ, D}; pg8::StaticOrder S; S.init(NTOK, NPROJ, F.G, (int)blockIdx.x);
    pg8::EpiProj E{ws, F.in[IN_LBL]};
    pg8::gemm_phase<pg8::EpiProj, pg8::StaticOrder, true, true>(F.lds + RING_OFF, g, S, E);
    meta_proj(F);
}
__device__ __forceinline__ void ph_scan(Frame& F) {
    const int sb = (int)blockIdx.x;
    if (sb < 64) p3_hgrn2_mfma(F, sb); else if (sb < 128) p3_mlstm_mfma(F, sb - 64);
#if !CONV_IN_P0
    else px_experts(F, sb - 128, F.G - 128);
#endif
}
__device__ __forceinline__ void ph_merged(Frame& F) {
    unsigned char* ws = F.ws;
    static_assert(WS_YML - WS_YHG == (size_t)pg8::PAIR_DA * 256 * HW * 2 && WS_WBM - WS_WBH == (size_t)pg8::PAIR_DB * 256 * HW * 2, "the second branch's operands sit a whole number of tiles behind the first's");
    pg8::PairOrder S; S.S.init(NTOK, D, F.G, (int)blockIdx.x);
    pg8::Gemm g{(const pg8::bf16_t*)(ws + WS_YHG), (const pg8::bf16_t*)(ws + WS_WBH), NTOK, D, HW};
    pg8::EpiGate2 E{(const pg8::bf16_t*)(ws + WS_GATES), (pg8::bf16_t*)(ws + WS_TMP), (pg8::bf16_t*)(ws + WS_MERGED)};
    pg8::gemm_phase<pg8::EpiGate2, pg8::PairOrder, true, true>(F.lds + RING_OFF, g, S, E);
    meta_merged(F);
}
__device__ __forceinline__ void ph_wout(Frame& F) {
    unsigned char* ws = F.ws;
    pg8::Gemm g{(const pg8::bf16_t*)(ws + WS_MERGED), (const pg8::bf16_t*)(ws + WS_WOUT), NTOK, D, D}; pg8::StaticOrder S; S.init(NTOK, D, F.G, (int)blockIdx.x);
    pg8::EpiH1 E{(const pg8::bf16_t*)(ws + WS_XN0), (const float*)(ws + WS_XSQ), (pg8::bf16_t*)(ws + WS_H1), (unsigned char*)(ws + WS_H1B)};
    pg8::gemm_phase<pg8::EpiH1, pg8::StaticOrder, true, true>(F.lds + RING_OFF, g, S, E);
    meta_wout(F);
}
__device__ __forceinline__ void ph_gu(Frame& F) {
    unsigned char* ws = F.ws; build_tables(F);
    const LAS int* pst = (const LAS int*)(F.lds + PST_OFF); LAS unsigned short* tok16 = (LAS unsigned short*)(F.lds + TOK_OFF);
    pg8::Gemm g{(const pg8::bf16_t*)(ws + WS_H1B), (const pg8::bf16_t*)(ws + WS_WGU), NV, NE * 2 * DFF, D / 2};
    pg8::GroupOrder S{pst[32], 8, F.G, (int)blockIdx.x, (const LAS unsigned char*)(F.lds + TEXP_OFF)};
    { const int* ETOK = (const int*)(ws + WS_ETOK);
      int tokv[18];
#pragma unroll
      for (int i = 0; i < 18; ++i) { pg8::Unit u; int t = 0; if (S.next(i, u) && F.tid < 256) { const int e = u.pn >> 3, pos = u.pm * 256 - pst[e] + F.tid; if (pos < pst[33 + e]) t = ETOK[(size_t)e * NV + pos]; } tokv[i] = t; }
      if (F.tid < 256) {
#pragma unroll
          for (int i = 0; i < 18; ++i) tok16[i * 256 + F.tid] = (unsigned short)tokv[i]; }
      __syncthreads(); }
    pg8::EpiGU E{(const float*)(ws + WS_BGUP), (const float*)(ws + WS_ERS), (unsigned char*)(ws + WS_ACT), pst};
    pg8::gemm_phase_g<pg8::EpiGU, pg8::GroupOrder, true>(F.lds + RING_OFF, g, S, E, tok16);
}
__device__ __forceinline__ void ph_down(Frame& F) {
    unsigned char* ws = F.ws; build_tables(F);
    pg8::Gemm g{(const pg8::bf16_t*)(ws + WS_ACT), (const pg8::bf16_t*)(ws + WS_WDN), MAXTILES * 256, NE * D, DFF / 2};
    pg8::GroupOrder S{((const LAS int*)(F.lds + PST_OFF))[32], 4, F.G, (int)blockIdx.x, (const LAS unsigned char*)(F.lds + TEXP_OFF)};
    pg8::EpiDown E{F.in[IN_BDN], (const float*)(ws + WS_EW), (unsigned char*)(ws + WS_YB), (const LAS int*)(F.lds + PST_OFF)};
    pg8::gemm_phase<pg8::EpiDown, pg8::GroupOrder, true, true, true>(F.lds + RING_OFF, g, S, E);
}

#ifndef CONV_IN_P0
#define CONV_IN_P0 0
#endif
#ifndef PROBE_DOUBLE
#define PROBE_DOUBLE 0
#endif
#define DBL(k) ((PROBE_DOUBLE >> (k)) & 1)
#ifndef MK_N_LAUNCHES
#define MK_N_LAUNCHES 1
#endif
constexpr int NPHASE = 9;
struct Args { const float* in[25]; float* out; unsigned char* ws; int ph_lo, ph_hi, li, pad; };
__global__ void __launch_bounds__(NTHREADS, 2) fwd_kernel(Args args) {
    extern __shared__ __attribute__((aligned(16))) unsigned char lds[];
    Frame F;
    F.lds = (LAS unsigned char*)lds; F.MISC = (volatile LAS unsigned*)(F.lds + MISC_OFF);
    F.tid = threadIdx.x; F.lane = F.tid & 63; F.wave = __builtin_amdgcn_readfirstlane(F.tid >> 6);
    F.G = gridDim.x; { const int bx = blockIdx.x; F.vcu = (F.G % 8 == 0) ? (bx % 8) * (F.G / 8) + bx / 8 : bx; }
    F.ws = args.ws; F.ctl = (gu32*)(args.ws + WS_CTL); F.out = args.out;
#pragma unroll
    for (int i = 0; i < 25; ++i) F.in[i] = args.in[i];
    { int t0 = F.tid; asm volatile("" : "+v"(t0)); if (t0 < 64) F.MISC[t0] = 0u; }
    __syncthreads();
    const int lo = args.ph_lo, hi = args.ph_hi;
    XcdBarrier bar; bar.bar = (unsigned*)(F.ctl + CW_BAR) + args.li * XCD_BAR_WORDS; bar.x = 0; bar.st = nullptr;
    if (hi - lo > 1) bar = xcd_barrier_post((unsigned*)(F.ctl + CW_BAR) + args.li * XCD_BAR_WORDS, F.MISC + 8);
#define IN(k) (lo <= (k) && (k) < hi)
#define SEAM(k) do { if (IN(k) && IN((k) + 1)) xcd_barrier(bar); } while (0)

    if (IN(0)) { p0_prologue(F);
#if CONV_IN_P0
        __syncthreads(); px_experts(F, F.vcu, F.G);
#endif
    } SEAM(0);
    if (IN(1)) { ph_proj(F); } SEAM(1);
    if (IN(2)) { ph_scan(F); } SEAM(2);
    if (IN(3)) { ph_merged(F); } SEAM(3);
    if (IN(4)) { ph_wout(F); } SEAM(4);
    if (IN(5)) { p6_router(F); } SEAM(5);
    if (IN(6)) { ph_gu(F); } SEAM(6);
    if (IN(7)) { ph_down(F); } SEAM(7);
    if (IN(8)) { p10_combine(F); }
#undef IN
#undef SEAM
}

extern "C" void kernel_launch(void* const* d_in, const int* in_sizes, int n_in, void* d_out, int out_size, void* d_ws, size_t ws_size, hipStream_t stream) {
    static int grid = 0;
    if (grid == 0) {
        if (n_in != 25 || in_sizes[0] != BATCH * SEQ * D || out_size != BATCH * SEQ * D || ws_size < WS_END) { fprintf(stderr, "kernel_launch: unexpected shapes (n_in %d, in0 %d, out %d, ws %zu); nothing launched\n", n_in, n_in > 0 ? in_sizes[0] : -1, out_size, ws_size); grid = -1; return; }
        int dev = 0, cus = 0, per_cu = 0;
        if (hipGetDevice(&dev) != hipSuccess || hipDeviceGetAttribute(&cus, hipDeviceAttributeMultiprocessorCount, dev) != hipSuccess) { grid = -1; return; }
        if (hipFuncSetAttribute((const void*)fwd_kernel, hipFuncAttributeMaxDynamicSharedMemorySize, LDS_BYTES) != hipSuccess) { fprintf(stderr, "kernel_launch: hipFuncSetAttribute failed\n"); grid = -1; return; }
        if (hipOccupancyMaxActiveBlocksPerMultiprocessor(&per_cu, (const void*)fwd_kernel, NTHREADS, LDS_BYTES) != hipSuccess || per_cu < 1) { fprintf(stderr, "kernel_launch: occupancy query reports %d blocks per CU\n", per_cu); }
        (void)hipGetLastError();
        grid = 256;
        if (cus < 256) { fprintf(stderr, "kernel_launch: %d CUs < 256: the grid would not be resident; nothing launched\n", cus); grid = -1; return; }
    }
    if (grid < 0) return;
    if (hipMemsetAsync((char*)d_ws + WS_CTL, 0, CTL_ZERO_BYTES, stream) != hipSuccess) return;
    Args a{};
    for (int i = 0; i < 25; ++i) a.in[i] = (const float*)d_in[i];
    a.out = (float*)d_out; a.ws = (unsigned char*)d_ws; a.pad = 0;
#if MK_N_LAUNCHES == 1
    a.ph_lo = 0; a.ph_hi = NPHASE; a.li = 0;
    hipLaunchKernelGGL(fwd_kernel, dim3(grid), dim3(NTHREADS), LDS_BYTES, stream, a);
#else
    for (int p = 0; p < NPHASE; ++p) for (int rep = 0; rep <= DBL(p); ++rep) { a.ph_lo = p; a.ph_hi = p + 1; a.li = 0; hipLaunchKernelGGL(fwd_kernel, dim3(grid), dim3(NTHREADS), LDS_BYTES, stream, a); }
#endif
}
```

```cpp
#include <hip/hip_runtime.h>
#include <cstdio>
#include <cstdint>
namespace pg8 {
#define PG8_LAS __attribute__((address_space(3)))
typedef unsigned short bf16_t;
typedef short bf16x8 __attribute__((ext_vector_type(8)));
typedef float f32x4 __attribute__((ext_vector_type(4)));
typedef unsigned u32x4 __attribute__((ext_vector_type(4)));
constexpr int BM = 256, BK = 64, HALF = 128, HTB = HALF * BK * 2  , STAGE_BYTES = 8 * HTB, NXCD = 8, WGM = 8;

__host__ __device__ __forceinline__ int lds_byte(int r, int c) { const int st = (r >> 4) * 2 + (c >> 5), rr = r & 15, cc = c & 31, ob = rr * 64 + cc * 2; return st * 1024 + (ob ^ (((ob >> 9) & 1) << 5)); }
__host__ __device__ __forceinline__ void stage_rc(int b, int& R, int& C) { const int st = b / 1024, sb = b % 1024, swz = sb ^ (((sb >> 9) & 1) << 5); R = (st >> 1) * 16 + swz / 64; C = (st & 1) * 32 + (swz % 64) / 2; }
__host__ __device__ __forceinline__ int perm32(int rho) { const int n = rho >> 4, i = rho & 15; return 8 * (i >> 2) + 4 * n + (i & 3); }

struct Unit { int pm, pn; };
struct Gemm { const bf16_t* A; const bf16_t* Bt; int M, N, K; };

struct StaticOrder {
    int nM, nN, nwg, G, c;
    __host__ __device__ void init(int M, int N, int G_, int c_) { nM = M / BM; nN = N / BM; nwg = nM * nN; G = G_; c = c_; }
    __host__ __device__ __forceinline__ bool next(int i, Unit& u) const {
        const long L = (long)i * G + c; if (L >= nwg) return false;
        int wgid = (int)L; { const int q = nwg / NXCD, r = nwg % NXCD, xcd = wgid % NXCD, off = wgid / NXCD; wgid = (xcd < r ? xcd * (q + 1) : r * (q + 1) + (xcd - r) * q) + off; }
        const int nig = WGM * nN, gid = wgid / nig, fm = gid * WGM, gsz = (nM - fm) < WGM ? (nM - fm) : WGM;
        u.pm = fm + ((wgid % nig) % gsz); u.pn = (wgid % nig) / gsz; return true;
    }
    __device__ __forceinline__ void a_ready(const Unit&) const {}
    __device__ __forceinline__ void done(const Unit&) const {}
};

typedef __bf16 bf16v2 __attribute__((ext_vector_type(2)));
typedef float f32v2 __attribute__((ext_vector_type(2)));
__device__ __forceinline__ unsigned cvt_pk_bf16(float lo, float hi) { const f32v2 v = {lo, hi}; return __builtin_bit_cast(unsigned, __builtin_convertvector(v, bf16v2)); }
typedef float f32x2 __attribute__((ext_vector_type(2)));
typedef int i32x4 __attribute__((ext_vector_type(4)));
typedef int i32x8 __attribute__((ext_vector_type(8)));
__device__ __forceinline__ i32x8 cat8(const bf16x8 a, const bf16x8 b) { const i32x4 x = __builtin_bit_cast(i32x4, a), y = __builtin_bit_cast(i32x4, b); return __builtin_shufflevector(x, y, 0, 1, 2, 3, 4, 5, 6, 7); }
template <class Epi, class Sched, bool ALIGN_EPI = false, bool SP2 = false, bool FP8 = false>
__device__ __forceinline__ void gemm_phase(PG8_LAS unsigned char* lds, const Gemm g, const Sched& S, const Epi& E) {
    const int tid = threadIdx.x, wid = __builtin_amdgcn_readfirstlane(tid >> 6), lane = tid & 63, wr = wid >> 2, wc = wid & 3, fr = lane & 15, fq = lane >> 4;
    const int K = g.K, nt = K / BK;
    unsigned voffA[2], voffB[2];
#pragma unroll
    for (int i = 0; i < 2; ++i) { int R, C; stage_rc(tid * 16 + i * 8192, R, C); const int Rb = Epi::PERM ? ((R & ~31) + perm32(R & 31)) : R;
        voffA[i] = (unsigned)(R * K + C) * 2u; voffB[i] = (unsigned)(Rb * K + C) * 2u; }
    const size_t kstep = (size_t)(BK * 2);
    const size_t hstep = (size_t)HALF * K * 2;
    const size_t tstep = 2 * hstep;
    const unsigned ldsw = (unsigned)wid * 1024u;
    const int aoff = lds_byte(wr * 64 + fr, fq * 8), boff = lds_byte(wc * 32 + fr, fq * 8);
#define PG8_SA(b, h) (((b) * 2 + (h)) * HTB)
#define PG8_SB(b, h) ((4 + (b) * 2 + (h)) * HTB)
#define PG8_STAGE(bufoff, gbase, voff) do { _Pragma("unroll") for (int _i = 0; _i < 2; ++_i) \
        __builtin_amdgcn_global_load_lds((const unsigned*)((const char*)(gbase) + (voff)[_i]), (PG8_LAS unsigned*)(lds + (bufoff) + ldsw + _i * 8192), 16, 0, 0); } while (0)
#define PG8_LDA(dst, b, h) do { _Pragma("unroll") for (int m = 0; m < 4; ++m) { if constexpr (FP8) dst##8[m] = cat8(*(const PG8_LAS bf16x8*)(lds + PG8_SA(b, h) + aoff + m * 2048), *(const PG8_LAS bf16x8*)(lds + PG8_SA(b, h) + aoff + m * 2048 + 1024)); \
        else { _Pragma("unroll") for (int k = 0; k < 2; ++k) dst[m][k] = *(const PG8_LAS bf16x8*)(lds + PG8_SA(b, h) + aoff + m * 2048 + k * 1024); } } } while (0)
#define PG8_LDB(dst, b, h) do { _Pragma("unroll") for (int n = 0; n < 2; ++n) { if constexpr (FP8) dst##8[n] = cat8(*(const PG8_LAS bf16x8*)(lds + PG8_SB(b, h) + boff + n * 2048), *(const PG8_LAS bf16x8*)(lds + PG8_SB(b, h) + boff + n * 2048 + 1024)); \
        else { _Pragma("unroll") for (int k = 0; k < 2; ++k) dst[n][k] = *(const PG8_LAS bf16x8*)(lds + PG8_SB(b, h) + boff + n * 2048 + k * 1024); } } } while (0)
#define PG8_MMA(ai, bj, At, Bt) do { __builtin_amdgcn_s_setprio(1); _Pragma("unroll") for (int m = 0; m < 4; ++m) _Pragma("unroll") for (int n = 0; n < 2; ++n) { \
        if constexpr (FP8) acc[ai][bj][m][n] = __builtin_amdgcn_mfma_scale_f32_16x16x128_f8f6f4(Bt##8[n], At##8[m], acc[ai][bj][m][n], 0, 0, 0, 0x7f7f7f7f, 0, 0x7f7f7f7f); \
        else { _Pragma("unroll") for (int k = 0; k < 2; ++k) acc[ai][bj][m][n] = __builtin_amdgcn_mfma_f32_16x16x32_bf16(Bt[n][k], At[m][k], acc[ai][bj][m][n], 0, 0, 0); } } \
        if constexpr (FP8) { _Pragma("unroll") for (int m = 0; m < 4; ++m) _Pragma("unroll") for (int n = 0; n < 2; ++n) asm volatile("" : "+v"(acc[ai][bj][m][n])); }     \
        __builtin_amdgcn_s_setprio(0); } while (0)
#define PG8_WAIT_V(n) asm volatile("s_waitcnt vmcnt(" #n ")" ::: "memory")
#define PG8_WAIT_L(n) asm volatile("s_waitcnt lgkmcnt(" #n ")" ::: "memory")
#define PG8_BAR __builtin_amdgcn_s_barrier()
#define PG8_SCHED __builtin_amdgcn_sched_barrier(0)
    Unit cur, nxt; int ui = 0;
    if (!S.next(0, cur)) return;
    f32x4 acc[2][2][4][2];
#pragma unroll
    for (int a = 0; a < 2; ++a)
#pragma unroll
        for (int b = 0; b < 2; ++b)
#pragma unroll
            for (int m = 0; m < 4; ++m)
#pragma unroll
                for (int n = 0; n < 2; ++n) acc[a][b][m][n] = (f32x4){0.f, 0.f, 0.f, 0.f};
    bf16x8 At[4][2], B0[2][2], B1[2][2]; i32x8 At8[4], B08[2], B18[2];
    const char* cA = (const char*)g.A + (size_t)cur.pm * tstep; const char* cB = (const char*)g.Bt + (size_t)cur.pn * tstep;
    S.a_ready(cur);
    if constexpr (SP2) {
        PG8_STAGE(PG8_SB(0, 0), cB, voffB); PG8_STAGE(PG8_SB(0, 1), cB + hstep, voffB); PG8_STAGE(PG8_SA(0, 0), cA, voffA); PG8_STAGE(PG8_SA(0, 1), cA + hstep, voffA);
        if (wr == 1) PG8_BAR;
        PG8_WAIT_V(2); PG8_BAR;
        PG8_STAGE(PG8_SB(1, 0), cB + kstep, voffB); PG8_STAGE(PG8_SA(1, 0), cA + kstep, voffA); PG8_STAGE(PG8_SB(1, 1), cB + hstep + kstep, voffB);
        PG8_WAIT_V(6); PG8_BAR;
    } else {
        PG8_STAGE(PG8_SB(0, 0), cB, voffB); PG8_STAGE(PG8_SA(0, 0), cA, voffA); PG8_STAGE(PG8_SB(0, 1), cB + hstep, voffB); PG8_STAGE(PG8_SA(0, 1), cA + hstep, voffA);
        if (wr == 1) PG8_BAR;
        PG8_WAIT_V(4); PG8_BAR;
        PG8_STAGE(PG8_SB(1, 0), cB + kstep, voffB); PG8_STAGE(PG8_SA(1, 0), cA + kstep, voffA); PG8_STAGE(PG8_SB(1, 1), cB + hstep + kstep, voffB);
        PG8_WAIT_V(6); PG8_BAR;
    }
    for (;;) {
        const bool has_next = S.next(ui + 1, nxt);
        const char* nA = has_next ? (const char*)g.A + (size_t)nxt.pm * tstep : cA; const char* nB = has_next ? (const char*)g.Bt + (size_t)nxt.pn * tstep : cB;
        for (int t = 0; t < nt; t += 2) {
            const bool last = (t == nt - 2);
            const char* a1 = cA + (size_t)(t + 1) * kstep;
            const char* a2 = last ? nA : cA + (size_t)(t + 2) * kstep; const char* b2 = last ? nB : cB + (size_t)(t + 2) * kstep;
            const char* a3 = a2 + kstep; const char* b3 = b2 + kstep;
            if (last && has_next) S.a_ready(nxt);
            if constexpr (SP2) {
            PG8_LDB(B0, 0, 0); PG8_LDB(B1, 0, 1); PG8_SCHED; PG8_LDA(At, 0, 0); PG8_STAGE(PG8_SA(1, 1), a1 + hstep, voffA);
            PG8_WAIT_V(8); PG8_WAIT_L(0); PG8_BAR; PG8_MMA(0, 0, At, B0); PG8_MMA(0, 1, At, B1); PG8_BAR; PG8_SCHED;
            PG8_LDA(At, 0, 1); PG8_STAGE(PG8_SB(0, 0), b2, voffB); PG8_STAGE(PG8_SB(0, 1), b2 + hstep, voffB); PG8_STAGE(PG8_SA(0, 0), a2, voffA);
            PG8_WAIT_V(8); PG8_WAIT_L(0); PG8_BAR; PG8_MMA(1, 0, At, B0); PG8_MMA(1, 1, At, B1); PG8_BAR; PG8_SCHED;
            PG8_LDB(B0, 1, 0); PG8_LDB(B1, 1, 1); PG8_SCHED; PG8_LDA(At, 1, 0); PG8_STAGE(PG8_SA(0, 1), a2 + hstep, voffA);
            PG8_WAIT_V(8); PG8_WAIT_L(0); PG8_BAR; PG8_MMA(0, 0, At, B0); PG8_MMA(0, 1, At, B1); PG8_BAR; PG8_SCHED;
            PG8_LDA(At, 1, 1); PG8_STAGE(PG8_SB(1, 0), b3, voffB); PG8_STAGE(PG8_SB(1, 1), b3 + hstep, voffB); PG8_STAGE(PG8_SA(1, 0), a3, voffA);
            PG8_WAIT_V(8); PG8_WAIT_L(0); PG8_BAR; PG8_MMA(1, 0, At, B0); PG8_MMA(1, 1, At, B1); PG8_BAR; PG8_SCHED;
            } else {
            PG8_LDB(B0, 0, 0); PG8_SCHED; PG8_LDA(At, 0, 0); PG8_STAGE(PG8_SA(1, 1), a1 + hstep, voffA);
            PG8_WAIT_L(8); PG8_BAR; PG8_WAIT_L(0); PG8_MMA(0, 0, At, B0); PG8_BAR; PG8_SCHED;
            PG8_LDB(B1, 0, 1); PG8_STAGE(PG8_SB(0, 0), b2, voffB);
            PG8_BAR; PG8_WAIT_L(0); PG8_MMA(0, 1, At, B1); PG8_BAR;
            PG8_LDA(At, 0, 1); PG8_STAGE(PG8_SA(0, 0), a2, voffA);
            PG8_BAR; PG8_WAIT_L(0); PG8_MMA(1, 0, At, B0); PG8_BAR; PG8_SCHED;
            PG8_STAGE(PG8_SB(0, 1), b2 + hstep, voffB);
            PG8_WAIT_V(6); PG8_BAR; PG8_MMA(1, 1, At, B1); PG8_BAR;
            PG8_LDB(B0, 1, 0); PG8_SCHED; PG8_LDA(At, 1, 0); PG8_STAGE(PG8_SA(0, 1), a2 + hstep, voffA);
            PG8_WAIT_L(8); PG8_BAR; PG8_WAIT_L(0); PG8_MMA(0, 0, At, B0); PG8_BAR; PG8_SCHED;
            PG8_LDB(B1, 1, 1); PG8_STAGE(PG8_SB(1, 0), b3, voffB);
            PG8_BAR; PG8_WAIT_L(0); PG8_MMA(0, 1, At, B1); PG8_BAR;
            PG8_LDA(At, 1, 1); PG8_STAGE(PG8_SA(1, 0), a3, voffA);
            PG8_BAR; PG8_WAIT_L(0); PG8_MMA(1, 0, At, B0); PG8_BAR; PG8_SCHED;
            PG8_STAGE(PG8_SB(1, 1), b3 + hstep, voffB);
            PG8_WAIT_V(6); PG8_BAR; PG8_MMA(1, 1, At, B1); PG8_BAR;
            }
        }
        if constexpr (ALIGN_EPI) { if (wr == 0) PG8_BAR; }
        if constexpr (!Epi::AFTER_DRAIN) { E(acc, cur, wr, wc, fr, fq); S.done(cur); }
        if (!has_next) break;
#pragma unroll
        for (int a = 0; a < 2; ++a)
#pragma unroll
            for (int b = 0; b < 2; ++b)
#pragma unroll
                for (int m = 0; m < 4; ++m)
#pragma unroll
                    for (int n = 0; n < 2; ++n) acc[a][b][m][n] = (f32x4){0.f, 0.f, 0.f, 0.f};
        cur = nxt; cA = nA; cB = nB; ++ui;
        if constexpr (ALIGN_EPI) { if (wr == 1) PG8_BAR; }
    }
    PG8_WAIT_V(0);
    if constexpr (!ALIGN_EPI) { if (wr == 0) PG8_BAR; }
    PG8_BAR;
    if constexpr (Epi::AFTER_DRAIN) { E.fused(acc, cur, wr, wc, fr, fq, lds, wid, lane); S.done(cur); }
#undef PG8_SA
#undef PG8_SB
#undef PG8_STAGE
#undef PG8_LDA
#undef PG8_LDB
#undef PG8_MMA
#undef PG8_WAIT_V
#undef PG8_WAIT_L
#undef PG8_BAR
#undef PG8_SCHED
}
template <class Epi, class Sched, bool FP8 = false>
__device__ __forceinline__ void gemm_phase_g(PG8_LAS unsigned char* lds, const Gemm g, const Sched& S, const Epi& E, const PG8_LAS unsigned short* tok16) {
    constexpr bool ALIGN_EPI = true, SP2 = true;
    const int tid = threadIdx.x, wid = __builtin_amdgcn_readfirstlane(tid >> 6), lane = tid & 63, wr = wid >> 2, wc = wid & 3, fr = lane & 15, fq = lane >> 4;
    const int K = g.K, nt = K / BK;
    unsigned voffB[2]; int RA[2]; unsigned CA[2];
#pragma unroll
    for (int i = 0; i < 2; ++i) { int R, C; stage_rc(tid * 16 + i * 8192, R, C); const int Rb = Epi::PERM ? ((R & ~31) + perm32(R & 31)) : R;
        RA[i] = R; CA[i] = (unsigned)C * 2u; voffB[i] = (unsigned)(Rb * K + C) * 2u; }
    unsigned oc[2][2];
#define PG8_TOKS(dst, ui_) do { _Pragma("unroll") for (int _h = 0; _h < 2; ++_h) _Pragma("unroll") for (int _i = 0; _i < 2; ++_i) \
        dst[_h][_i] = (unsigned)tok16[(ui_) * 256 + _h * HALF + RA[_i]] * (unsigned)(K * 2) + CA[_i]; } while (0)
    const size_t kstep = (size_t)(BK * 2);
    const size_t hstep = (size_t)HALF * K * 2;
    const size_t tstep = 2 * hstep;
    const unsigned ldsw = (unsigned)wid * 1024u;
    const int aoff = lds_byte(wr * 64 + fr, fq * 8), boff = lds_byte(wc * 32 + fr, fq * 8);
#define PG8_SA(b, h) (((b) * 2 + (h)) * HTB)
#define PG8_SB(b, h) ((4 + (b) * 2 + (h)) * HTB)
#define PG8_STAGE(bufoff, gbase, voff) do { _Pragma("unroll") for (int _i = 0; _i < 2; ++_i) \
        __builtin_amdgcn_global_load_lds((const unsigned*)((const char*)(gbase) + (voff)[_i]), (PG8_LAS unsigned*)(lds + (bufoff) + ldsw + _i * 8192), 16, 0, 0); } while (0)
#define PG8_LDA(dst, b, h) do { _Pragma("unroll") for (int m = 0; m < 4; ++m) { if constexpr (FP8) dst##8[m] = cat8(*(const PG8_LAS bf16x8*)(lds + PG8_SA(b, h) + aoff + m * 2048), *(const PG8_LAS bf16x8*)(lds + PG8_SA(b, h) + aoff + m * 2048 + 1024)); \
        else { _Pragma("unroll") for (int k = 0; k < 2; ++k) dst[m][k] = *(const PG8_LAS bf16x8*)(lds + PG8_SA(b, h) + aoff + m * 2048 + k * 1024); } } } while (0)
#define PG8_LDB(dst, b, h) do { _Pragma("unroll") for (int n = 0; n < 2; ++n) { if constexpr (FP8) dst##8[n] = cat8(*(const PG8_LAS bf16x8*)(lds + PG8_SB(b, h) + boff + n * 2048), *(const PG8_LAS bf16x8*)(lds + PG8_SB(b, h) + boff + n * 2048 + 1024)); \
        else { _Pragma("unroll") for (int k = 0; k < 2; ++k) dst[n][k] = *(const PG8_LAS bf16x8*)(lds + PG8_SB(b, h) + boff + n * 2048 + k * 1024); } } } while (0)
#define PG8_MMA(ai, bj, At, Bt) do { __builtin_amdgcn_s_setprio(1); _Pragma("unroll") for (int m = 0; m < 4; ++m) _Pragma("unroll") for (int n = 0; n < 2; ++n) { \
        if constexpr (FP8) acc[ai][bj][m][n] = __builtin_amdgcn_mfma_scale_f32_16x16x128_f8f6f4(Bt##8[n], At##8[m], acc[ai][bj][m][n], 0, 0, 0, 0x7f7f7f7f, 0, 0x7f7f7f7f); \
        else { _Pragma("unroll") for (int k = 0; k < 2; ++k) acc[ai][bj][m][n] = __builtin_amdgcn_mfma_f32_16x16x32_bf16(Bt[n][k], At[m][k], acc[ai][bj][m][n], 0, 0, 0); } } \
        if constexpr (FP8) { _Pragma("unroll") for (int m = 0; m < 4; ++m) _Pragma("unroll") for (int n = 0; n < 2; ++n) asm volatile("" : "+v"(acc[ai][bj][m][n])); }     \
        __builtin_amdgcn_s_setprio(0); } while (0)
#define PG8_WAIT_V(n) asm volatile("s_waitcnt vmcnt(" #n ")" ::: "memory")
#define PG8_WAIT_L(n) asm volatile("s_waitcnt lgkmcnt(" #n ")" ::: "memory")
#define PG8_BAR __builtin_amdgcn_s_barrier()
#define PG8_SCHED __builtin_amdgcn_sched_barrier(0)
    Unit cur, nxt; int ui = 0;
    if (!S.next(0, cur)) return;
    f32x4 acc[2][2][4][2];
#pragma unroll
    for (int a = 0; a < 2; ++a)
#pragma unroll
        for (int b = 0; b < 2; ++b)
#pragma unroll
            for (int m = 0; m < 4; ++m)
#pragma unroll
                for (int n = 0; n < 2; ++n) acc[a][b][m][n] = (f32x4){0.f, 0.f, 0.f, 0.f};
    bf16x8 At[4][2], B0[2][2], B1[2][2]; i32x8 At8[4], B08[2], B18[2];
    const char* cA = (const char*)g.A; const char* cB = (const char*)g.Bt + (size_t)cur.pn * tstep; PG8_TOKS(oc, 0);
    S.a_ready(cur);
    if constexpr (SP2) {
        PG8_STAGE(PG8_SB(0, 0), cB, voffB); PG8_STAGE(PG8_SB(0, 1), cB + hstep, voffB); PG8_STAGE(PG8_SA(0, 0), cA, oc[0]); PG8_STAGE(PG8_SA(0, 1), cA, oc[1]);
        if (wr == 1) PG8_BAR;
        PG8_WAIT_V(2); PG8_BAR;
        PG8_STAGE(PG8_SB(1, 0), cB + kstep, voffB); PG8_STAGE(PG8_SA(1, 0), cA + kstep, oc[0]); PG8_STAGE(PG8_SB(1, 1), cB + hstep + kstep, voffB);
        PG8_WAIT_V(6); PG8_BAR;
    } else {
        PG8_STAGE(PG8_SB(0, 0), cB, voffB); PG8_STAGE(PG8_SA(0, 0), cA, oc[0]); PG8_STAGE(PG8_SB(0, 1), cB + hstep, voffB); PG8_STAGE(PG8_SA(0, 1), cA + hstep, oc[0]);
        if (wr == 1) PG8_BAR;
        PG8_WAIT_V(4); PG8_BAR;
        PG8_STAGE(PG8_SB(1, 0), cB + kstep, voffB); PG8_STAGE(PG8_SA(1, 0), cA + kstep, oc[0]); PG8_STAGE(PG8_SB(1, 1), cB + hstep + kstep, voffB);
        PG8_WAIT_V(6); PG8_BAR;
    }
    for (;;) {
        const bool has_next = S.next(ui + 1, nxt);
        const char* nB = has_next ? (const char*)g.Bt + (size_t)nxt.pn * tstep : cB;
        for (int t = 0; t < nt; t += 2) {
            const bool last = (t == nt - 2);
            const char* a1 = cA + (size_t)(t + 1) * kstep;
            const char* a2 = last ? cA : cA + (size_t)(t + 2) * kstep; const char* b2 = last ? nB : cB + (size_t)(t + 2) * kstep;
            unsigned o2[2][2]; if (last && has_next) PG8_TOKS(o2, ui + 1); else { _Pragma("unroll") for (int _h = 0; _h < 2; ++_h) _Pragma("unroll") for (int _i = 0; _i < 2; ++_i) o2[_h][_i] = oc[_h][_i]; }
            const char* a3 = a2 + kstep; const char* b3 = b2 + kstep;
            if (last && has_next) S.a_ready(nxt);
            if constexpr (SP2) {
            PG8_LDB(B0, 0, 0); PG8_LDB(B1, 0, 1); PG8_SCHED; PG8_LDA(At, 0, 0); PG8_STAGE(PG8_SA(1, 1), a1, oc[1]);
            PG8_WAIT_V(8); PG8_WAIT_L(0); PG8_BAR; PG8_MMA(0, 0, At, B0); PG8_MMA(0, 1, At, B1); PG8_BAR; PG8_SCHED;
            PG8_LDA(At, 0, 1); PG8_STAGE(PG8_SB(0, 0), b2, voffB); PG8_STAGE(PG8_SB(0, 1), b2 + hstep, voffB); PG8_STAGE(PG8_SA(0, 0), a2, o2[0]);
            PG8_WAIT_V(8); PG8_WAIT_L(0); PG8_BAR; PG8_MMA(1, 0, At, B0); PG8_MMA(1, 1, At, B1); PG8_BAR; PG8_SCHED;
            PG8_LDB(B0, 1, 0); PG8_LDB(B1, 1, 1); PG8_SCHED; PG8_LDA(At, 1, 0); PG8_STAGE(PG8_SA(0, 1), a2, o2[1]);
            PG8_WAIT_V(8); PG8_WAIT_L(0); PG8_BAR; PG8_MMA(0, 0, At, B0); PG8_MMA(0, 1, At, B1); PG8_BAR; PG8_SCHED;
            PG8_LDA(At, 1, 1); PG8_STAGE(PG8_SB(1, 0), b3, voffB); PG8_STAGE(PG8_SB(1, 1), b3 + hstep, voffB); PG8_STAGE(PG8_SA(1, 0), a3, o2[0]);
            PG8_WAIT_V(8); PG8_WAIT_L(0); PG8_BAR; PG8_MMA(1, 0, At, B0); PG8_MMA(1, 1, At, B1); PG8_BAR; PG8_SCHED;
            } else {
            PG8_LDB(B0, 0, 0); PG8_SCHED; PG8_LDA(At, 0, 0); PG8_STAGE(PG8_SA(1, 1), a1 + hstep, oc[0]);
            PG8_WAIT_L(8); PG8_BAR; PG8_WAIT_L(0); PG8_MMA(0, 0, At, B0); PG8_BAR; PG8_SCHED;
            PG8_LDB(B1, 0, 1); PG8_STAGE(PG8_SB(0, 0), b2, voffB);
            PG8_BAR; PG8_WAIT_L(0); PG8_MMA(0, 1, At, B1); PG8_BAR;
            PG8_LDA(At, 0, 1); PG8_STAGE(PG8_SA(0, 0), a2, oc[0]);
            PG8_BAR; PG8_WAIT_L(0); PG8_MMA(1, 0, At, B0); PG8_BAR; PG8_SCHED;
            PG8_STAGE(PG8_SB(0, 1), b2 + hstep, voffB);
            PG8_WAIT_V(6); PG8_BAR; PG8_MMA(1, 1, At, B1); PG8_BAR;
            PG8_LDB(B0, 1, 0); PG8_SCHED; PG8_LDA(At, 1, 0); PG8_STAGE(PG8_SA(0, 1), a2 + hstep, oc[0]);
            PG8_WAIT_L(8); PG8_BAR; PG8_WAIT_L(0); PG8_MMA(0, 0, At, B0); PG8_BAR; PG8_SCHED;
            PG8_LDB(B1, 1, 1); PG8_STAGE(PG8_SB(1, 0), b3, voffB);
            PG8_BAR; PG8_WAIT_L(0); PG8_MMA(0, 1, At, B1); PG8_BAR;
            PG8_LDA(At, 1, 1); PG8_STAGE(PG8_SA(1, 0), a3, oc[0]);
            PG8_BAR; PG8_WAIT_L(0); PG8_MMA(1, 0, At, B0); PG8_BAR; PG8_SCHED;
            PG8_STAGE(PG8_SB(1, 1), b3 + hstep, voffB);
            PG8_WAIT_V(6); PG8_BAR; PG8_MMA(1, 1, At, B1); PG8_BAR;
            }
        }
        if constexpr (ALIGN_EPI) { if (wr == 0) PG8_BAR; }
        if constexpr (!Epi::AFTER_DRAIN) { E(acc, cur, wr, wc, fr, fq); S.done(cur); }
        if (!has_next) break;
#pragma unroll
        for (int a = 0; a < 2; ++a)
#pragma unroll
            for (int b = 0; b < 2; ++b)
#pragma unroll
                for (int m = 0; m < 4; ++m)
#pragma unroll
                    for (int n = 0; n < 2; ++n) acc[a][b][m][n] = (f32x4){0.f, 0.f, 0.f, 0.f};
        cur = nxt; cB = nB; ++ui; PG8_TOKS(oc, ui);
        if constexpr (ALIGN_EPI) { if (wr == 1) PG8_BAR; }
    }
    PG8_WAIT_V(0);
    if constexpr (!ALIGN_EPI) { if (wr == 0) PG8_BAR; }
    PG8_BAR;
    if constexpr (Epi::AFTER_DRAIN) { E.fused(acc, cur, wr, wc, fr, fq, lds, wid, lane); S.done(cur); }
#undef PG8_TOKS
#undef PG8_SA
#undef PG8_SB
#undef PG8_STAGE
#undef PG8_LDA
#undef PG8_LDB
#undef PG8_MMA
#undef PG8_WAIT_V
#undef PG8_WAIT_L
#undef PG8_BAR
#undef PG8_SCHED
}
}

constexpr int BATCH = 16, SEQ = 2048, D = 1024, NMETA = 16;
constexpr int TV = SEQ + NMETA;
constexpr int NV = BATCH * TV;
constexpr int NTOK = BATCH * SEQ;
constexpr int NR = NTOK + NMETA;
constexpr int NIN = 5128, NPROJ = 5120;
constexpr int HW = 512;
constexpr int NE = 32, TOPK = 4, DFF = 1024;
constexpr int MAXTILES = 548;
constexpr float EPS = 1e-6f;
constexpr int NWAVES = 8, NTHREADS = 512;

constexpr size_t MiB = 1u << 20, KiB = 1u << 10;
constexpr size_t WS_CTL = 0, CTL_ZERO_BYTES = 1 * MiB;
constexpr size_t WS_WIN = 2 * MiB;
constexpr size_t WS_WBH = 12 * MiB, WS_WBM = 13 * MiB, WS_WOUT = 14 * MiB;
constexpr size_t WS_WGU = 16 * MiB;
constexpr size_t WS_WDN = 144 * MiB;
constexpr size_t WS_BGUP = 208 * MiB;
constexpr size_t WS_RWT = WS_BGUP + 256 * KiB;
constexpr size_t WS_TOPE = WS_RWT + 128 * KiB;
constexpr size_t WS_TOPP = WS_TOPE + 520 * KiB;
constexpr size_t WS_TOPW = WS_TOPP + 520 * KiB;
constexpr size_t WS_RS = WS_TOPW + 520 * KiB;
constexpr size_t WS_LI = WS_RS + 136 * KiB;
constexpr size_t WS_LF = WS_LI + 520 * KiB;
constexpr size_t WS_SLOTRS = WS_LF + 520 * KiB;
constexpr size_t WS_SLOTW = WS_SLOTRS + 552 * KiB;
constexpr size_t WS_XSQ = WS_SLOTW + 552 * KiB;
constexpr size_t WS_SMALL_END = WS_XSQ + 136 * KiB;
constexpr size_t WS_RA = 214 * MiB;
constexpr size_t WS_HQ = WS_RA, WS_HG = WS_RA + 33 * MiB, WS_HV = WS_RA + 99 * MiB, WS_HGATE = WS_RA + 132 * MiB, WS_MM = WS_RA + 165 * MiB, WS_MO = WS_RA + 198 * MiB, WS_GATES = WS_RA + 231 * MiB;
constexpr size_t WS_MERGED = WS_RA, WS_TMP = WS_RA + 66 * MiB, WS_H1B = WS_RA + 364 * MiB, WS_ACT = WS_RA;
constexpr size_t WS_RB = WS_RA + 364 * MiB;
constexpr size_t WS_QKVM = WS_RB, WS_CM = WS_RB + 130 * MiB, WS_YHG = WS_RB + 196 * MiB, WS_YML = WS_RB + 229 * MiB, WS_XS = WS_RB, WS_YB = WS_RB;
constexpr size_t WS_RC = WS_RB + 274 * MiB;
constexpr size_t WS_XN0 = WS_RC + 65 * MiB;
constexpr size_t WS_H1 = WS_RC, WS_ETOK = WS_RC + 130 * MiB, WS_ERS = WS_ETOK + 5 * MiB, WS_EW = WS_ERS + 5 * MiB, WS_END = WS_EW + 5 * MiB;
static_assert(WS_SMALL_END <= WS_RA && WS_END <= 1024 * MiB, "d_ws map");
static_assert((size_t)NV * HW * 2 <= 33 * MiB && (size_t)NV * HW * 4 <= 66 * MiB && (size_t)NV * 2048 * 2 <= 132 * MiB + MiB && (size_t)NV * D * 4 <= 130 * MiB && (size_t)MAXTILES * 256 * D * 2 <= 274 * MiB, "d_ws sizes");
static_assert((size_t)NE * NV * 4 <= 5 * MiB, "per-expert lists");
static_assert((size_t)NR * D * 2 <= 65 * MiB && (size_t)NR * 4 <= 136 * KiB, "H1 / XN0 / XSQ");
constexpr int CW_TMO = 0, CW_CNT = 64  , CW_BAR = 4096;

constexpr int RING_OFF = 0, RING_BYTES = 131072;
constexpr int MISC_OFF = RING_BYTES;
constexpr int TEXP_OFF = MISC_OFF + 256;
constexpr int PST_OFF = TEXP_OFF + 640;
constexpr int TOK_OFF = PST_OFF + 384;
constexpr int LDS_BYTES = 147456;
static_assert(TOK_OFF + 18 * 512 <= LDS_BYTES, "LDS map");

#define GAS __attribute__((address_space(1)))
#define LAS __attribute__((address_space(3)))
typedef unsigned short bf16;
typedef unsigned v4u __attribute__((ext_vector_type(4)));
typedef unsigned v2u __attribute__((ext_vector_type(2)));
typedef float f32x4 __attribute__((ext_vector_type(4)));
typedef GAS unsigned gu32;
#define RLX_AGENT __ATOMIC_RELAXED, __HIP_MEMORY_SCOPE_AGENT
#define LDS_WAIT() asm volatile("s_waitcnt lgkmcnt(0)" ::: "memory")
#define VM_WAIT() asm volatile("s_waitcnt vmcnt(0)" ::: "memory")
__device__ __forceinline__ unsigned pk2(float lo, float hi) { return pg8::cvt_pk_bf16(lo, hi); }
__device__ __forceinline__ unsigned f2bf(float f) { return pg8::cvt_pk_bf16(f, 0.f) & 0xffffu; }
__device__ __forceinline__ float bflo(unsigned w) { return __builtin_bit_cast(float, w << 16); }
__device__ __forceinline__ float bfhi(unsigned w) { return __builtin_bit_cast(float, w & 0xffff0000u); }
__device__ __forceinline__ float bf1(bf16 h) { return __builtin_bit_cast(float, (unsigned)h << 16); }
__device__ __forceinline__ float fsigmoid(float x) { return __builtin_amdgcn_rcpf(1.0f + __expf(-x)); }
__device__ __forceinline__ float fsilu(float x) { return x * fsigmoid(x); }
__device__ __forceinline__ size_t rowof(int b, int tt) { return tt < NMETA ? (size_t)(NTOK + tt) : (size_t)b * SEQ + (tt - NMETA); }
__host__ __device__ __forceinline__ int gu_slot(int j) { const int g = (j >> 3) & 3, p = ((g & 1) << 1) | (g >> 1); return (j & ~31) + 8 * p + (j & 7); }
__device__ __forceinline__ float wave_sum(float v) {
#pragma unroll
    for (int o = 1; o < 64; o <<= 1) v += __shfl_xor(v, o);
    return v;
}
__device__ __forceinline__ float wave_max(float v) {
#pragma unroll
    for (int o = 1; o < 64; o <<= 1) v = fmaxf(v, __shfl_xor(v, o));
    return v;
}
#define XB_TMO      128
#define XB_XCNT(j)  (256  + 64 * (j))
#define XB_XSUB(j)  (1280 + 64 * (j))
#define XB_XGEN(j)  (2304 + 64 * (j))
#define XB_TOP      3328
#define XB_TOPGEN   3392
#define XCD_BAR_WORDS 3456
#define XB_SPIN_CAP (1u << 18)

__device__ __forceinline__ unsigned xb_ld(unsigned* p)              { return __hip_atomic_load(p, __ATOMIC_RELAXED, __HIP_MEMORY_SCOPE_AGENT); }
__device__ __forceinline__ unsigned xb_add(unsigned* p, unsigned v) { return __hip_atomic_fetch_add(p, v, __ATOMIC_RELAXED, __HIP_MEMORY_SCOPE_AGENT); }
__device__ __forceinline__ unsigned xb_xcc_id() { return (unsigned)__builtin_amdgcn_s_getreg((3 << 11) | 20) & 0xFu; }
#define XB_SPIN(cond, bar) do { unsigned _sp = 0; while (cond) { __builtin_amdgcn_s_sleep(1); \
    if ((++_sp & 255u) == 0u) { if (xb_ld(&(bar)[XB_TMO])) break; if (_sp > XB_SPIN_CAP) { atomicAdd(&(bar)[XB_TMO], 1u); break; } } } } while (0)

struct XcdBarrier {
    unsigned* bar; unsigned x;
    volatile LAS unsigned* st;
};

__device__ __forceinline__ XcdBarrier xcd_barrier_post(unsigned* bar, volatile LAS unsigned* st) {
    XcdBarrier b; b.bar = bar; b.x = xb_xcc_id(); b.st = st;
    if (threadIdx.x == 0) (void)xb_add(&bar[XB_XCNT(b.x)], 1u);
    return b;
}
__device__ __forceinline__ void xcd_barrier_complete(unsigned* bar, unsigned x, unsigned& nloc, unsigned& nx) {
    const unsigned G = gridDim.x * gridDim.y * gridDim.z;
    unsigned sum, cnt, mine, sp = 0u;
    for (;;) {
        sum = 0u; cnt = 0u; mine = 0u;
#pragma unroll
        for (unsigned j = 0; j < 16; ++j) { const unsigned c = xb_ld(&bar[XB_XCNT(j)]); sum += c; cnt += (c > 0u) ? 1u : 0u; mine = (j == x) ? c : mine; }
        if (sum == G) break;
        __builtin_amdgcn_s_sleep(1);
        if ((++sp & 255u) == 0u) { if (xb_ld(&bar[XB_TMO])) break; if (sp > XB_SPIN_CAP) { atomicAdd(&bar[XB_TMO], 1u); break; } }
    }
    nloc = mine > 0u ? mine : 1u; nx = cnt > 0u ? cnt : 1u;
}

__device__ __forceinline__ void xcd_barrier(const XcdBarrier& b) {
    asm volatile("s_waitcnt vmcnt(0)" ::: "memory");
    __syncthreads();
    if (threadIdx.x == 0) {
        unsigned* bar = b.bar;
        __builtin_amdgcn_s_waitcnt(0);
        unsigned nloc = b.st[0], nx = b.st[1];
        if (nloc == 0u) { xcd_barrier_complete(bar, b.x, nloc, nx); b.st[0] = nloc; b.st[1] = nx; }
        const unsigned old = xb_add(&bar[XB_XSUB(b.x)], 1u);
        const unsigned gen = old / nloc;
        if (old + 1u == (gen + 1u) * nloc) {
            __builtin_amdgcn_fence(__ATOMIC_RELEASE, "agent");
            asm volatile("s_waitcnt vmcnt(0)" ::: "memory");
            const unsigned og = xb_add(&bar[XB_TOP], 1u);
            const unsigned tg = og / nx;
            if (og + 1u == (tg + 1u) * nx) xb_add(&bar[XB_TOPGEN], 1u);
            else XB_SPIN(xb_ld(&bar[XB_TOPGEN]) == tg, bar);
            __builtin_amdgcn_fence(__ATOMIC_ACQUIRE, "agent");
            xb_add(&bar[XB_XGEN(b.x)], 1u);
            asm volatile("s_waitcnt vmcnt(0)" ::: "memory");
        } else {
            XB_SPIN(xb_ld(&bar[XB_XGEN(b.x)]) == gen, bar);
            __builtin_amdgcn_fence(__ATOMIC_ACQUIRE, "agent");
            asm volatile("s_waitcnt vmcnt(0)" ::: "memory");
        }
    }
    __syncthreads();
}

struct Frame {
    LAS unsigned char* lds;
    volatile LAS unsigned* MISC;
    gu32* ctl;
    int tid, lane, wave, vcu, G;
    const float* in[25];
    float* out;
    unsigned char* ws;
};
#define IN_X 0
#define IN_META 1
#define IN_LBL 2
#define IN_NMIX 3
#define IN_WIN 4
#define IN_HGNORM 5
#define IN_CONVW 6
#define IN_CONVB 7
#define IN_WQ 8
#define IN_WK 9
#define IN_WV 10
#define IN_GATEB 11
#define IN_MLNORM 12
#define IN_MLSKIP 13
#define IN_WBH 14
#define IN_WBM 15
#define IN_WOUT 16
#define IN_NFFN 17
#define IN_RW 18
#define IN_RB 19
#define IN_WGU 20
#define IN_BGU 21
#define IN_WDN 22
#define IN_BDN 23
#define IN_NFIN 24

__device__ __forceinline__ void p0_item(const float* W, int ldw, int col0, int cstride, const float* kscale, bf16* WT, int K, int dstrow0, int k0, LAS float* scr, int lane) {
    (void)cstride;
    const int r = lane >> 3, c4 = (lane & 7) * 4;
    f32x4 v[8];
#pragma unroll
    for (int i = 0; i < 8; ++i) v[i] = *(const GAS f32x4*)(W + (size_t)(k0 + 8 * i + r) * ldw + col0 + c4);
#pragma unroll
    for (int i = 0; i < 8; ++i) { const float sc = kscale ? kscale[k0 + 8 * i + r] : 1.f; LAS float* s = scr + (8 * i + r) * 33 + c4; s[0] = v[i].x * sc; s[1] = v[i].y * sc; s[2] = v[i].z * sc; s[3] = v[i].w * sc; }
    LDS_WAIT(); asm volatile("" ::: "memory");
    const int c = lane & 7;
#pragma unroll
    for (int j = 0; j < 4; ++j) { const int n = (lane >> 3) + 8 * j; const LAS float* s = scr + (8 * c) * 33 + n;
        v4u o; o.x = pk2(s[0 * 33], s[1 * 33]); o.y = pk2(s[2 * 33], s[3 * 33]); o.z = pk2(s[4 * 33], s[5 * 33]); o.w = pk2(s[6 * 33], s[7 * 33]);
        *(GAS v4u*)(WT + (size_t)(dstrow0 + n) * K + k0 + 8 * c) = o; }
    LDS_WAIT(); asm volatile("" ::: "memory");
}
__device__ __forceinline__ void p0_prologue(Frame& F) {
    unsigned char* ws = F.ws;
    const int gw = F.vcu * NWAVES + F.wave, NGW = F.G * NWAVES, gt = F.vcu * NTHREADS + F.tid, NGT = F.G * NTHREADS;
    {
        LAS float* wm = (LAS float*)(F.lds + RING_OFF + 65536);
        { float wa[16], wb[16];
#pragma unroll
          for (int q = 0; q < 16; ++q) { const int u = F.tid + q * NTHREADS, j = u & 7, l = (u >> 3) & 63, i = u >> 9, k = 4 * l + 256 * (i >> 2) + (i & 3); wa[q] = F.in[IN_NMIX][k]; wb[q] = F.in[IN_WIN][(size_t)k * NIN + 3072 + j]; }
#pragma unroll
          for (int q = 0; q < 16; ++q) wm[F.tid + q * NTHREADS] = wa[q] * wb[q]; }
        __syncthreads();
        bf16* XN0 = (bf16*)(ws + WS_XN0); float* XSQ = (float*)(ws + WS_XSQ); float* LI = (float*)(ws + WS_LI); float* LF = (float*)(ws + WS_LF);
        f32x4 vn[4];
#define P0_LOADROW(dst, V_) do { const int Vc_ = (V_) < NR ? (V_) : NR - 1; const float* src_ = (Vc_ >= NTOK) ? F.in[IN_META] + (size_t)(Vc_ - NTOK) * D : F.in[IN_X] + (size_t)Vc_ * D; \
        const GAS f32x4* xr_ = (const GAS f32x4*)src_ + F.lane; _Pragma("unroll") for (int j = 0; j < 4; ++j) dst[j] = xr_[64 * j]; } while (0)
        P0_LOADROW(vn, gw);
        for (int V = gw; V < NR; V += NGW) {
            f32x4 v[4]; float s = 0.f;
#pragma unroll
            for (int j = 0; j < 4; ++j) { v[j] = vn[j]; s += (v[j].x * v[j].x + v[j].y * v[j].y) + (v[j].z * v[j].z + v[j].w * v[j].w); }
            P0_LOADROW(vn, V + NGW);
            asm volatile("" ::: "memory");
            const float sq = sqrtf(wave_sum(s) * (1.f / D) + EPS), rs = 1.0f / sq;
            if (F.lane == 0) XSQ[V] = sq;
            float g[8];
#pragma unroll
            for (int j = 0; j < 8; ++j) g[j] = 0.f;
            GAS unsigned long long* o8 = (GAS unsigned long long*)(XN0 + (size_t)V * D) + F.lane;
#pragma unroll
            for (int j = 0; j < 4; ++j) {
                v[j] = v[j] * rs;
                o8[64 * j] = (unsigned long long)pk2(v[j].x, v[j].y) | ((unsigned long long)pk2(v[j].z, v[j].w) << 32);
#pragma unroll
                for (int q = 0; q < 4; ++q) { const LAS f32x4* wp = (const LAS f32x4*)(wm + (((4 * j + q) * 64 + F.lane) * 8)); const f32x4 w0 = wp[0], w1 = wp[1]; const float xv = v[j][q];
                    g[0] += xv * w0.x; g[1] += xv * w0.y; g[2] += xv * w0.z; g[3] += xv * w0.w; g[4] += xv * w1.x; g[5] += xv * w1.y; g[6] += xv * w1.z; g[7] += xv * w1.w; }
            }
#pragma unroll
            for (int j = 0; j < 8; ++j) g[j] = wave_sum(g[j]);
            if (F.lane < 4) {
                const float gi = (F.lane == 0 ? g[0] : F.lane == 1 ? g[1] : F.lane == 2 ? g[2] : g[3]) + F.in[IN_GATEB][F.lane];
                const float gf = (F.lane == 0 ? g[4] : F.lane == 1 ? g[5] : F.lane == 2 ? g[6] : g[7]) + F.in[IN_GATEB][4 + F.lane];
                LI[(size_t)V * 4 + F.lane] = gi;
                LF[(size_t)V * 4 + F.lane] = fminf(gf, 0.f) - log1pf(__expf(-fabsf(gf)));
            }
        }
        __syncthreads();
    }
    {
        LAS float* scr = (LAS float*)(F.lds + RING_OFF + F.wave * 16384);
        constexpr int I_IN1 = 16 * 96, I_IN2 = 16 * 64, I_BH = 8 * 32, I_OUT = 16 * 32;
        constexpr int NITEMS = I_IN1 + I_IN2 + 2 * I_BH + I_OUT;
        for (int it = gw; it < NITEMS; it += NGW) {
            int r = it;
            if (r < I_IN1) { const int kb = r / 96, nb = r % 96; p0_item(F.in[IN_WIN], NIN, 32 * nb, 1, F.in[IN_NMIX], (bf16*)(ws + WS_WIN), D, 32 * nb, 64 * kb, scr, F.lane); continue; } r -= I_IN1;
            if (r < I_IN2) { const int kb = r / 64, nb = r % 64; p0_item(F.in[IN_WIN], NIN, 3080 + 32 * nb, 1, F.in[IN_NMIX], (bf16*)(ws + WS_WIN), D, 3072 + 32 * nb, 64 * kb, scr, F.lane); continue; } r -= I_IN2;
            if (r < I_BH) { const int kb = r / 32, nb = r % 32; p0_item(F.in[IN_WBH], D, 32 * nb, 1, nullptr, (bf16*)(ws + WS_WBH), HW, 32 * nb, 64 * kb, scr, F.lane); continue; } r -= I_BH;
            if (r < I_BH) { const int kb = r / 32, nb = r % 32; p0_item(F.in[IN_WBM], D, 32 * nb, 1, nullptr, (bf16*)(ws + WS_WBM), HW, 32 * nb, 64 * kb, scr, F.lane); continue; } r -= I_BH;
            { const int kb = r / 32, nb = r % 32; p0_item(F.in[IN_WOUT], D, 32 * nb, 1, nullptr, (bf16*)(ws + WS_WOUT), D, 32 * nb, 64 * kb, scr, F.lane); }
        }
    }
    { float* BGUP = (float*)(ws + WS_BGUP); float* RWT = (float*)(ws + WS_RWT);
      for (int u = gt; u < NE * 2 * DFF; u += NGT) { const int e = u >> 11, n = u & 2047, pn = n >> 8, bj = (n >> 7) & 1, j = gu_slot(n & 127); BGUP[u] = F.in[IN_BGU][(size_t)e * 2 * DFF + 2 * (128 * pn + j) + bj]; }
      for (int u = gt; u < NE * D; u += NGT) { const int e = u >> 10, k = u & 1023; RWT[u] = F.in[IN_NFFN][k] * F.in[IN_RW][(size_t)k * NE + e]; } }
}

__device__ __forceinline__ unsigned pk4_fp8(float a, float b, float c, float d) { unsigned w = 0;
    a = __builtin_amdgcn_fmed3f(a, -448.f, 448.f); b = __builtin_amdgcn_fmed3f(b, -448.f, 448.f); c = __builtin_amdgcn_fmed3f(c, -448.f, 448.f); d = __builtin_amdgcn_fmed3f(d, -448.f, 448.f);
    w = __builtin_amdgcn_cvt_pk_fp8_f32(a, b, w, false); w = __builtin_amdgcn_cvt_pk_fp8_f32(c, d, w, true); return w; }
__device__ __forceinline__ void cvdn_load(const float* Wdn, int it, f32x4 (&v)[8], int lane) {
    const int e = it >> 9, kb = (it >> 5) & 15, nb = it & 31, r = lane >> 3, c4 = (lane & 7) * 4; const float* W = Wdn + (size_t)e * DFF * D;
#pragma unroll
    for (int i = 0; i < 8; ++i) v[i] = *(const GAS f32x4*)(W + (size_t)(64 * kb + 8 * i + r) * D + 32 * nb + c4);
}
__device__ __forceinline__ void cvdn_proc(unsigned char* WTdn, int it, const f32x4 (&v)[8], LAS float* scr, int lane) {
    const int e = it >> 9, kb = (it >> 5) & 15, nb = it & 31, r = lane >> 3, c4 = (lane & 7) * 4; unsigned char* WT = WTdn + (size_t)e * D * DFF;
#pragma unroll
    for (int i = 0; i < 8; ++i) { LAS float* s = scr + (8 * i + r) * 33 + c4; s[0] = v[i].x * 32.f; s[1] = v[i].y * 32.f; s[2] = v[i].z * 32.f; s[3] = v[i].w * 32.f; }
    LDS_WAIT(); asm volatile("" ::: "memory");
    const int c = lane & 7;
#pragma unroll
    for (int j = 0; j < 4; ++j) { const int n = (lane >> 3) + 8 * j; const LAS float* s = scr + (8 * c) * 33 + n;
        v2u o; o.x = pk4_fp8(s[0 * 33], s[1 * 33], s[2 * 33], s[3 * 33]); o.y = pk4_fp8(s[4 * 33], s[5 * 33], s[6 * 33], s[7 * 33]);
        const int cn = 32 * nb + n, rowp = (cn & ~255) + 128 * ((cn >> 3) & 1) + 32 * ((cn >> 6) & 3) + 8 * ((cn >> 4) & 3) + (cn & 7);
        *(GAS v2u*)(WT + (size_t)rowp * DFF + 64 * kb + 8 * c) = o; }
    LDS_WAIT(); asm volatile("" ::: "memory");
}
__device__ __forceinline__ void cvgu_load(const float* Wgu, const float* nffn, int it, f32x4 (&v)[8], float (&sc)[8], int lane) {
    const int e = it >> 10, kb = (it >> 5) & 31, nb = it & 31, r = lane >> 4, c4 = (lane & 15) * 4; const float* W = Wgu + (size_t)e * D * 2 * DFF;
#pragma unroll
    for (int i = 0; i < 8; ++i) { v[i] = *(const GAS f32x4*)(W + (size_t)(32 * kb + 4 * i + r) * (2 * DFF) + 64 * nb + c4); sc[i] = nffn[32 * kb + 4 * i + r] * 32.f; }
}
__device__ __forceinline__ void cvgu_proc(unsigned char* WTgu, int it, const f32x4 (&v)[8], const float (&sc)[8], LAS float* scr, int lane) {
    const int e = it >> 10, kb = (it >> 5) & 31, nb = it & 31, r = lane >> 4, c4 = (lane & 15) * 4, A0 = 32 * nb, k0 = 32 * kb; unsigned char* WT = WTgu + (size_t)e * 2 * DFF * D;
    LAS float* sg = scr; LAS float* su = scr + 32 * 33;
#pragma unroll
    for (int i = 0; i < 8; ++i) { const int o = (4 * i + r) * 33 + (c4 >> 1); sg[o] = v[i].x * sc[i]; su[o] = v[i].y * sc[i]; sg[o + 1] = v[i].z * sc[i]; su[o + 1] = v[i].w * sc[i]; }
    LDS_WAIT(); asm volatile("" ::: "memory");
    const int c = lane & 3;
#pragma unroll
    for (int j = 0; j < 4; ++j) { const int q = (lane >> 2) + 16 * j, isup = q >> 5, jj = q & 31, A = A0 + jj; const LAS float* s = scr + isup * 32 * 33 + (8 * c) * 33 + jj;
        v2u o; o.x = pk4_fp8(s[0 * 33], s[1 * 33], s[2 * 33], s[3 * 33]); o.y = pk4_fp8(s[4 * 33], s[5 * 33], s[6 * 33], s[7 * 33]);
        *(GAS v2u*)(WT + (size_t)(256 * (A >> 7) + 128 * isup + gu_slot(A & 127)) * D + k0 + 8 * c) = o; }
    LDS_WAIT(); asm volatile("" ::: "memory");
}
__device__ __forceinline__ void px_experts(Frame& F, int rank, int nwg) {
    unsigned char* ws = F.ws;
    LAS float* scr = (LAS float*)(F.lds + RING_OFF + F.wave * 16384);
    const int gw = rank * NWAVES + F.wave, NGW = nwg * NWAVES;
    { constexpr int NIT = NE * 1024; f32x4 v[8], vn[8]; float sc[8], sn[8]; int it = gw;
      if (it < NIT) cvgu_load(F.in[IN_WGU], F.in[IN_NFFN], it, v, sc, F.lane);
      while (it < NIT) { const int nx = it + NGW; if (nx < NIT) cvgu_load(F.in[IN_WGU], F.in[IN_NFFN], nx, vn, sn, F.lane);
          asm volatile("" ::: "memory");
          cvgu_proc((unsigned char*)(ws + WS_WGU), it, v, sc, scr, F.lane); asm volatile("" ::: "memory");
#pragma unroll
          for (int i = 0; i < 8; ++i) { v[i] = vn[i]; sc[i] = sn[i]; }
          it = nx; } }
    { constexpr int NIT = NE * 512; f32x4 v[8], vn[8]; int it = gw;
      if (it < NIT) cvdn_load(F.in[IN_WDN], it, v, F.lane);
      while (it < NIT) { const int nx = it + NGW; if (nx < NIT) cvdn_load(F.in[IN_WDN], nx, vn, F.lane);
          asm volatile("" ::: "memory");
          cvdn_proc((unsigned char*)(ws + WS_WDN), it, v, scr, F.lane); asm volatile("" ::: "memory");
#pragma unroll
          for (int i = 0; i < 8; ++i) v[i] = vn[i];
          it = nx; } }
}

namespace pg8 {
typedef unsigned v2u_t __attribute__((ext_vector_type(2)));
__device__ __forceinline__ u32x4 pack8(const f32x4& a, const f32x4& b) { u32x4 w; w.x = cvt_pk_bf16(a[0], a[1]); w.y = cvt_pk_bf16(a[2], a[3]); w.z = cvt_pk_bf16(b[0], b[1]); w.w = cvt_pk_bf16(b[2], b[3]); return w; }
__device__ __forceinline__ v2u_t pack8_fp8(const f32x4& a, const f32x4& b) { unsigned lo = 0, hi = 0;
    lo = __builtin_amdgcn_cvt_pk_fp8_f32(a[0], a[1], lo, false); lo = __builtin_amdgcn_cvt_pk_fp8_f32(a[2], a[3], lo, true);
    hi = __builtin_amdgcn_cvt_pk_fp8_f32(b[0], b[1], hi, false); hi = __builtin_amdgcn_cvt_pk_fp8_f32(b[2], b[3], hi, true); return (v2u_t){lo, hi}; }
__device__ __forceinline__ v2u_t pack8_fp8_sat(const f32x4& a, const f32x4& b) { f32x4 x, y;
#pragma unroll
    for (int i = 0; i < 4; ++i) { x[i] = __builtin_amdgcn_fmed3f(a[i], -448.f, 448.f); y[i] = __builtin_amdgcn_fmed3f(b[i], -448.f, 448.f); }
    return pack8_fp8(x, y); }
__device__ __forceinline__ void unpack8(const u32x4& w, f32x4& a, f32x4& b) { a = (f32x4){bflo(w.x), bfhi(w.x), bflo(w.y), bfhi(w.y)}; b = (f32x4){bflo(w.z), bfhi(w.z), bflo(w.w), bfhi(w.w)}; }
__host__ __device__ __forceinline__ int gate_pos(int c) { return (c & ~255) + ((((c >> 5) & 3) * 4 + ((c >> 3) & 3)) * 16) + (((c >> 7) & 1) * 8) + (c & 7); }
__device__ __forceinline__ unsigned q8x4(float a, float b, float c, float d) {
    const unsigned t0 = __builtin_bit_cast(unsigned, __builtin_fmaf(a, 255.f, 8388608.f)), t1 = __builtin_bit_cast(unsigned, __builtin_fmaf(b, 255.f, 8388608.f));
    const unsigned t2 = __builtin_bit_cast(unsigned, __builtin_fmaf(c, 255.f, 8388608.f)), t3 = __builtin_bit_cast(unsigned, __builtin_fmaf(d, 255.f, 8388608.f));
    return __builtin_amdgcn_perm(t1, t0, 0x0c0c0400u) | __builtin_amdgcn_perm(t3, t2, 0x04000c0cu); }
__device__ __forceinline__ f32x4 dq8x4(unsigned w) { return (f32x4){(float)(w & 0xffu), (float)((w >> 8) & 0xffu), (float)((w >> 16) & 0xffu), (float)(w >> 24)}; }
struct EpiProj {
    static constexpr bool PERM = true, AFTER_DRAIN = false;
    unsigned char* ws; const float* lbl;
    __device__ __forceinline__ void operator()(const f32x4 (&acc)[2][2][4][2], const Unit& u, int wr, int wc, int fr, int fq) const {
        const int row0 = u.pm * BM + wr * 64 + fr, kind = u.pn < 12 ? (u.pn >> 1) : 6;
        const int colt = (u.pn < 12 ? (u.pn & 1) : (u.pn - 12)) * BM + wc * 32 + 8 * fq;
        if (kind == 1) {
            float* HG = (float*)(ws + WS_HG);
#pragma unroll
            for (int bj = 0; bj < 2; ++bj) { const int c = colt + bj * HALF; float lb[8];
#pragma unroll
                for (int i = 0; i < 8; ++i) lb[i] = fsigmoid(lbl[c + i] - lbl[HW + c + i]);
#pragma unroll
                for (int ai = 0; ai < 2; ++ai)
#pragma unroll
                    for (int m = 0; m < 4; ++m) { float* rowp = HG + (size_t)(row0 + ai * HALF + m * 16) * HW + c; f32x4 o0, o1;
#pragma unroll
                        for (int i = 0; i < 4; ++i) { o0[i] = __logf(lb[i] + (1.f - lb[i]) * fsigmoid(acc[ai][bj][m][0][i])); o1[i] = __logf(lb[4 + i] + (1.f - lb[4 + i]) * fsigmoid(acc[ai][bj][m][1][i])); }
                        *(f32x4*)rowp = o0; *(f32x4*)(rowp + 4) = o1; } }
            return;
        }
        if (kind == 6) {
            unsigned char* G8 = ws + WS_GATES; const int gofs = (u.pn - 12) * BM + (wc * 4 + fq) * 16;
#pragma unroll
            for (int ai = 0; ai < 2; ++ai)
#pragma unroll
                for (int m = 0; m < 4; ++m) { u32x4 o;
#pragma unroll
                    for (int bj = 0; bj < 2; ++bj) { const f32x4 v0 = acc[ai][bj][m][0], v1 = acc[ai][bj][m][1];
                        o[2 * bj] = q8x4(fsigmoid(v0[0]), fsigmoid(v0[1]), fsigmoid(v0[2]), fsigmoid(v0[3])); o[2 * bj + 1] = q8x4(fsigmoid(v1[0]), fsigmoid(v1[1]), fsigmoid(v1[2]), fsigmoid(v1[3])); }
                    *(u32x4*)(G8 + (size_t)(row0 + ai * HALF + m * 16) * 2048 + gofs) = o; }
            return;
        }
        bf16_t* O; constexpr int ldc = HW; int act = 0;
        if (kind == 0) { O = (bf16_t*)(ws + WS_HQ); act = 1; } else if (kind == 2) { O = (bf16_t*)(ws + WS_HV); } else if (kind == 3) { O = (bf16_t*)(ws + WS_HGATE); act = 1; }
        else if (kind == 4) { O = (bf16_t*)(ws + WS_MM); } else { O = (bf16_t*)(ws + WS_MO); act = 2; }
#pragma unroll
        for (int ai = 0; ai < 2; ++ai)
#pragma unroll
            for (int m = 0; m < 4; ++m) { bf16_t* rowp = O + (size_t)(row0 + ai * HALF + m * 16) * ldc + colt;
#pragma unroll
                for (int bj = 0; bj < 2; ++bj) { f32x4 v0 = acc[ai][bj][m][0], v1 = acc[ai][bj][m][1];
                    if (act) {
#pragma unroll
                        for (int i = 0; i < 4; ++i) { const float s0 = fsigmoid(v0[i]), s1 = fsigmoid(v1[i]); v0[i] = act == 1 ? v0[i] * s0 : s0; v1[i] = act == 1 ? v1[i] * s1 : s1; } }
                    *(u32x4*)(rowp + bj * HALF) = pack8(v0, v1); } }
    }
};
constexpr int PAIR_DA = 132, PAIR_DB = 4;
struct PairOrder { StaticOrder S;
    __device__ __forceinline__ bool next(int i, Unit& u) const { Unit t; if (!S.next(i >> 1, t)) return false; const int s = i & 1; u.pm = t.pm + PAIR_DA * s; u.pn = t.pn + PAIR_DB * s; return true; }
    __device__ __forceinline__ void a_ready(const Unit&) const {}
    __device__ __forceinline__ void done(const Unit&) const {}
};
struct EpiGate2 {
    static constexpr bool PERM = true, AFTER_DRAIN = false;
    const unsigned char* __restrict__ gates; bf16_t* __restrict__ tmp; bf16_t* __restrict__ merged;
    __device__ __forceinline__ void operator()(const f32x4 (&acc)[2][2][4][2], const Unit& u, int wr, int wc, int fr, int fq) const {
        const int step = u.pm >= PAIR_DA ? 1 : 0, pm = u.pm - PAIR_DA * step, pn = u.pn - PAIR_DB * step;
        const int row0 = pm * BM + wr * 64 + fr, col0 = pn * BM + wc * 32 + 8 * fq, gofs = step * D + pn * BM + (wc * 4 + fq) * 16;
        constexpr int NB = 2, NBAT = 8 / NB;
        bf16_t* obuf = tmp + (ptrdiff_t)(merged - tmp) * step;
        u32x4 gc[NB], tc[NB][2], gn[NB], tn[NB][2];
#define EG_LOAD(G, T, b_) do { _Pragma("unroll") for (int s_ = 0; s_ < NB; ++s_) { const int it_ = (b_) * NB + s_; const size_t row_ = (size_t)(row0 + (it_ >> 2) * HALF + (it_ & 3) * 16); G[s_] = *(const u32x4*)(gates + row_ * 2048 + gofs); _Pragma("unroll") for (int bj = 0; bj < 2; ++bj) { \
        if (step) T[s_][bj] = *(const u32x4*)(tmp + row_ * D + col0 + bj * HALF); else T[s_][bj] = (u32x4){0u, 0u, 0u, 0u}; } } } while (0)
        EG_LOAD(gc, tc, 0);
#pragma unroll
        for (int b = 0; b < NBAT; ++b) {
            if (b + 1 < NBAT) EG_LOAD(gn, tn, b + 1);
#pragma unroll
            for (int s = 0; s < NB; ++s) { const int it = b * NB + s, ai = it >> 2, m = it & 3; const size_t row = (size_t)(row0 + ai * HALF + m * 16);
#pragma unroll
                for (int bj = 0; bj < 2; ++bj) { const int c = col0 + bj * HALF; f32x4 t0, t1; unpack8(tc[s][bj], t0, t1); const f32x4 g0 = dq8x4(gc[s][2 * bj]), g1 = dq8x4(gc[s][2 * bj + 1]);
                    const u32x4 o = pack8((acc[ai][bj][m][0] * g0) * (1.f / 255.f) + t0, (acc[ai][bj][m][1] * g1) * (1.f / 255.f) + t1);
                    *(u32x4*)(obuf + row * D + c) = o; } }
#pragma unroll
            for (int s = 0; s < NB; ++s)
#pragma unroll
                for (int bj = 0; bj < 2; ++bj) tc[s][bj] = tn[s][bj];
#pragma unroll
            for (int s = 0; s < NB; ++s) gc[s] = gn[s]; }
#undef EG_LOAD
    }
};
struct EpiH1 {
    static constexpr bool PERM = true, AFTER_DRAIN = false;
    const bf16_t* __restrict__ xn0; const float* __restrict__ xsq; bf16_t* __restrict__ H1; unsigned char* __restrict__ H1B8;
    __device__ __forceinline__ void operator()(const f32x4 (&acc)[2][2][4][2], const Unit& u, int wr, int wc, int fr, int fq) const {
        const int row0 = u.pm * BM + wr * 64 + fr, col0 = u.pn * BM + wc * 32 + 8 * fq;
        u32x4 xc[2], xn[2]; float sc, sn;
#define EH_LOAD(X, S_, it_) do { const size_t r_ = (size_t)(row0 + ((it_) >> 2) * HALF + ((it_) & 3) * 16); const bf16_t* src_ = xn0 + r_ * D + col0; S_ = xsq[r_]; _Pragma("unroll") for (int bj = 0; bj < 2; ++bj) X[bj] = *(const u32x4*)(src_ + bj * HALF); } while (0)
        EH_LOAD(xc, sc, 0);
#pragma unroll
        for (int it = 0; it < 8; ++it) { const int ai = it >> 2, m = it & 3; const size_t V = (size_t)(row0 + ai * HALF + m * 16);
            if (it + 1 < 8) EH_LOAD(xn, sn, it + 1);
#pragma unroll
            for (int bj = 0; bj < 2; ++bj) { const int c = col0 + bj * HALF; f32x4 x0, x1; unpack8(xc[bj], x0, x1);
                const f32x4 v0 = acc[ai][bj][m][0] + x0 * sc, v1 = acc[ai][bj][m][1] + x1 * sc;
                *(u32x4*)(H1 + V * D + c) = pack8(v0, v1); *(v2u_t*)(H1B8 + V * D + c) = pack8_fp8_sat(v0, v1); }
#pragma unroll
            for (int bj = 0; bj < 2; ++bj) xc[bj] = xn[bj];
            sc = sn; }
#undef EH_LOAD
    }
};
struct EpiGU {
    static constexpr bool PERM = true, AFTER_DRAIN = false;
    const float* __restrict__ bgup; const float* __restrict__ ers; unsigned char* __restrict__ act; const PG8_LAS int* pst;
    __device__ __forceinline__ void operator()(const f32x4 (&acc)[2][2][4][2], const Unit& u, int wr, int wc, int fr, int fq) const {
        const int e = u.pn >> 3, pn = u.pn & 7, row0 = u.pm * BM + wr * 64 + fr, cc = wc * 32 + 8 * fq;
        const float* rsp = ers + (size_t)e * NV + (row0 - pst[e]);
        const float* bp = bgup + (size_t)e * 2 * DFF + pn * BM + cc;
        const f32x4 bg0 = *(const f32x4*)bp, bg1 = *(const f32x4*)(bp + 4), bu0 = *(const f32x4*)(bp + HALF), bu1 = *(const f32x4*)(bp + HALF + 4);
        float rsv[8];
#pragma unroll
        for (int it = 0; it < 8; ++it) rsv[it] = rsp[(it >> 2) * HALF + (it & 3) * 16];
        const int hi = fq >> 1;
        unsigned char* obase = act + (size_t)(row0 + 16 * hi) * DFF + pn * HALF + wc * 32 + 16 * (fq & 1);
#pragma unroll
        for (int ai = 0; ai < 2; ++ai)
#pragma unroll
            for (int mp = 0; mp < 2; ++mp) { v2u_t pk[2];
#pragma unroll
                for (int q = 0; q < 2; ++q) { const int m = 2 * mp + q; const float rs = rsv[ai * 4 + m] * 0.03125f;
                    f32x4 o0, o1;
#pragma unroll
                    for (int i = 0; i < 4; ++i) {
                        float g0 = fminf(acc[ai][0][m][0][i] * rs + bg0[i], 7.f), u0 = fminf(fmaxf(acc[ai][1][m][0][i] * rs + bu0[i], -7.f), 7.f);
                        float g1 = fminf(acc[ai][0][m][1][i] * rs + bg1[i], 7.f), u1 = fminf(fmaxf(acc[ai][1][m][1][i] * rs + bu1[i], -7.f), 7.f);
                        o0[i] = (u0 + 1.f) * g0 * fsigmoid(1.702f * g0); o1[i] = (u1 + 1.f) * g1 * fsigmoid(1.702f * g1); }
                    pk[q] = pack8_fp8(o0, o1); }
                const auto r0 = __builtin_amdgcn_permlane32_swap(pk[0][0], pk[1][0], false, false), r1 = __builtin_amdgcn_permlane32_swap(pk[0][1], pk[1][1], false, false);
                *(u32x4*)(obase + (size_t)(ai * HALF + mp * 32) * DFF) = (u32x4){r0[0], r1[0], r0[1], r1[1]}; }
    }
};
struct EpiDown {
    static constexpr bool PERM = true, AFTER_DRAIN = false;
    const float* __restrict__ bdn; const float* __restrict__ ew; unsigned char* __restrict__ yb; const PG8_LAS int* pst;
    __device__ __forceinline__ void operator()(const f32x4 (&acc)[2][2][4][2], const Unit& u, int wr, int wc, int fr, int fq) const {
        const int e = u.pn >> 2, pn = u.pn & 3, row0 = u.pm * BM + wr * 64 + fr, col0 = pn * BM + wc * 64 + 16 * fq;
        const float* wp = ew + (size_t)e * NV + (row0 - pst[e]);
        f32x4 bv[2][2];
#pragma unroll
        for (int bj = 0; bj < 2; ++bj) { bv[bj][0] = *(const f32x4*)(bdn + (size_t)e * D + col0 + 8 * bj); bv[bj][1] = *(const f32x4*)(bdn + (size_t)e * D + col0 + 8 * bj + 4); }
        float wv[8];
#pragma unroll
        for (int it = 0; it < 8; ++it) wv[it] = wp[(it >> 2) * HALF + (it & 3) * 16];
#pragma unroll
        for (int ai = 0; ai < 2; ++ai)
#pragma unroll
            for (int m = 0; m < 4; ++m) { const size_t row = (size_t)(row0 + ai * HALF + m * 16); const float w = wv[ai * 4 + m] * 16.f;
                const v2u_t lo = pack8_fp8_sat((acc[ai][0][m][0] * 0.03125f + bv[0][0]) * w, (acc[ai][0][m][1] * 0.03125f + bv[0][1]) * w), hi = pack8_fp8_sat((acc[ai][1][m][0] * 0.03125f + bv[1][0]) * w, (acc[ai][1][m][1] * 0.03125f + bv[1][1]) * w);
                *(u32x4*)(yb + row * D + col0) = (u32x4){lo[0], lo[1], hi[0], hi[1]}; }
    }
};
struct GroupOrder {
    int ntiles, ncol, G, c; const PG8_LAS unsigned char* texp;
    __device__ __forceinline__ bool next(int i, Unit& u) const { const int x = c & 7, w = c >> 3, uu = i * (G >> 3) + w, lj = uu / ncol, pn = uu - lj * ncol, j = lj * 8 + x; if (j >= ntiles) return false; u.pm = j; u.pn = (int)texp[j] * ncol + pn; return true; }
    __device__ __forceinline__ void a_ready(const Unit&) const {}
    __device__ __forceinline__ void done(const Unit&) const {}
};
}

typedef short bf16x8 __attribute__((ext_vector_type(8)));
typedef float f32x16 __attribute__((ext_vector_type(16)));
#define MFMA32(a, b, c) __builtin_amdgcn_mfma_f32_32x32x16_bf16(a, b, c, 0, 0, 0)
__device__ __forceinline__ bf16x8 ldfrag(const LAS unsigned char* base, int st, int row0, int k0, int lane) { return *(const LAS bf16x8*)(base + (row0 + (lane & 31)) * st + (k0 + 8 * (lane >> 5)) * 2); }
__device__ __forceinline__ bf16x8 ldf(const LAS unsigned char* lanebase, int off) { return *(const LAS bf16x8*)(lanebase + off); }
__device__ __forceinline__ float fexp(float x) { return __builtin_amdgcn_exp2f(x * 1.4426950408889634f); }

__device__ __forceinline__ void p3_hgrn2_mfma(Frame& F, int bh) {
    unsigned char* ws = F.ws; const int b = bh >> 2, h = bh & 3, tid = F.tid, lane = F.lane, wave = F.wave, hh = lane >> 5, l31 = lane & 31;
    const bf16* HQ = (const bf16*)(ws + WS_HQ) + h * 128; const float* HG = (const float*)(ws + WS_HG) + h * 128; const bf16* HV = (const bf16*)(ws + WS_HV) + h * 128;
    const bf16* HGATE = (const bf16*)(ws + WS_HGATE) + h * 128; bf16* YHG = (bf16*)(ws + WS_YHG) + h * 128;
    LAS unsigned char* L = F.lds + RING_OFF;
    LAS unsigned char* QT = L; LAS unsigned char* KT = L + 17408; LAS unsigned char* KTT = L + 34816; LAS unsigned char* VT = L + 53248; LAS unsigned char* ST = L + 71680; LAS unsigned char* PP = L + 106496;
    LAS float* SEG = (LAS float*)(L + 115712); LAS float* ER = (LAS float*)(L + 117760); LAS float* EL = (LAS float*)(L + 118272); LAS float* OST = (LAS float*)(L + 17408);
    const int d = tid & 127, pq = tid >> 7;
    const int et = tid >> 3, evq = tid & 7;
    const int f144 = l31 * 144 + hh * 16, f272 = l31 * 272 + hh * 16;
    const int sst = wave == 2 ? 1 : 0, stt = wave == 0 ? 0 : 1, dt = wave & 3, vt0 = 2 * (wave >> 2), btt = wave & 1, bvt = wave >> 1;
    const LAS unsigned char* aK = KT + 32 * sst * 272 + f272; const LAS unsigned char* bQ = QT + 32 * stt * 272 + f272;
    LAS unsigned char* pst = PP + (32 * stt + l31) * 144 + (32 * sst + 4 * hh) * 2;
    const LAS unsigned char* aKTT = KTT + 32 * dt * 144 + f144; const LAS unsigned char* bV0 = VT + 32 * vt0 * 144 + f144;
    LAS unsigned char* sst_ = ST + (32 * vt0 + l31) * 272 + (32 * dt + 4 * hh) * 2;
    const LAS float* erp = ER + 32 * dt + 4 * hh; const LAS float* elp = EL + 32 * dt + 4 * hh;
    const LAS unsigned char* aP = PP + 32 * btt * 144 + f144; const LAS unsigned char* bVB = VT + 32 * bvt * 144 + f144;
    const LAS unsigned char* aQ = QT + 32 * btt * 272 + f272; const LAS unsigned char* bS = ST + 32 * bvt * 272 + f272;
    LAS float* ost = OST + (32 * btt + 4 * hh) * 132 + 32 * bvt + l31; const LAS float* oep = OST + et * 132 + 16 * evq;
    LAS unsigned char* tq = QT + 16 * pq * 272 + d * 2; LAS unsigned char* tk = KT + 16 * pq * 272 + d * 2; LAS unsigned char* tkt = KTT + d * 144 + pq * 32; LAS unsigned char* tv = VT + d * 144 + pq * 32;
    f32x16 S0, S1;
#pragma unroll
    for (int i = 0; i < 16; ++i) { S0[i] = 0.f; S1[i] = 0.f; }
    float gq[16]; unsigned qr[16], vr[16]; v4u gt0, gt1;
    float gn[16];
#pragma unroll
    for (int i = 0; i < 16; ++i) gn[i] = F.in[IN_HGNORM][h * 128 + 16 * evq + i];
#define HG_LOAD(c) do { const int ttb = 64 * (c) - 48 + 16 * pq; \
        _Pragma("unroll") for (int i = 0; i < 16; ++i) { const int tt = ttb + i; if (tt >= 0) { const size_t gi = rowof(b, tt) * HW + d; gq[i] = HG[gi]; qr[i] = (unsigned)HQ[gi]; vr[i] = (unsigned)HV[gi]; } else { gq[i] = 0.f; qr[i] = 0u; vr[i] = 0u; } } \
        { const int tt = 64 * (c) - 48 + et; if (tt >= 0) { const GAS v4u* gp = (const GAS v4u*)(HGATE + rowof(b, tt) * HW + 16 * evq); gt0 = gp[0]; gt1 = gp[1]; } else { gt0 = (v4u){0u, 0u, 0u, 0u}; gt1 = gt0; } } } while (0)
    HG_LOAD(0);
    for (int c = 0; c < 33; ++c) {
        float bl[16];
        { float a = 0.f;
#pragma unroll
          for (int i = 0; i < 16; ++i) { a += gq[i]; bl[i] = a; } }
        SEG[pq * 128 + d] = bl[15];
        __syncthreads();
        { const float s0 = SEG[d], s1 = SEG[128 + d], s2 = SEG[256 + d], s3 = SEG[384 + d];
          const float off = pq == 0 ? 0.f : pq == 1 ? s0 : pq == 2 ? s0 + s1 : (s0 + s1) + s2, r = s0 + s1, blast = (s0 + s1) + (s2 + s3);
          unsigned kp[8], vp[8];
#pragma unroll
          for (int i = 0; i < 16; i += 2) {
              const float b0 = off + bl[i], b1 = off + bl[i + 1];
              const float q0 = __builtin_bit_cast(float, qr[i] << 16) * fexp(b0 - r), q1 = __builtin_bit_cast(float, qr[i + 1] << 16) * fexp(b1 - r);
              const float k0 = (1.f - fexp(gq[i])) * fexp(r - b0), k1 = (1.f - fexp(gq[i + 1])) * fexp(r - b1);
              const unsigned kk = pg8::cvt_pk_bf16(k0, k1), qq = pg8::cvt_pk_bf16(q0, q1);
              *(LAS unsigned short*)(tq + i * 272) = (unsigned short)qq; *(LAS unsigned short*)(tq + (i + 1) * 272) = (unsigned short)(qq >> 16);
              *(LAS unsigned short*)(tk + i * 272) = (unsigned short)kk; *(LAS unsigned short*)(tk + (i + 1) * 272) = (unsigned short)(kk >> 16);
              kp[i >> 1] = kk; vp[i >> 1] = vr[i] | (vr[i + 1] << 16); }
          *(LAS v4u*)(tkt) = (v4u){kp[0], kp[1], kp[2], kp[3]}; *(LAS v4u*)(tkt + 16) = (v4u){kp[4], kp[5], kp[6], kp[7]};
          *(LAS v4u*)(tv) = (v4u){vp[0], vp[1], vp[2], vp[3]}; *(LAS v4u*)(tv + 16) = (v4u){vp[4], vp[5], vp[6], vp[7]};
          if (pq == 0) { ER[d] = fexp(r); EL[d] = fexp(blast - r); } }
        const v4u g0 = gt0, g1 = gt1;
        __syncthreads();
        if (c + 1 < 33) HG_LOAD(c + 1);
        asm volatile("" ::: "memory");
        if (wave < 3) {
            f32x16 acc;
#pragma unroll
            for (int i = 0; i < 16; ++i) acc[i] = 0.f;
#pragma unroll
            for (int ks = 0; ks < 8; ++ks) acc = MFMA32(ldf(aK, 32 * ks), ldf(bQ, 32 * ks), acc);
            const int t = 32 * stt + l31;
#pragma unroll
            for (int g4 = 0; g4 < 4; ++g4) { const int s0 = 32 * sst + 8 * g4 + 4 * hh;
                const float x0 = (s0 + 0 <= t) ? acc[4 * g4 + 0] : 0.f, x1 = (s0 + 1 <= t) ? acc[4 * g4 + 1] : 0.f, x2 = (s0 + 2 <= t) ? acc[4 * g4 + 2] : 0.f, x3 = (s0 + 3 <= t) ? acc[4 * g4 + 3] : 0.f;
                *(LAS v2u*)(pst + 16 * g4) = (v2u){pg8::cvt_pk_bf16(x0, x1), pg8::cvt_pk_bf16(x2, x3)}; }
        }
        {
#pragma unroll
          for (int g4 = 0; g4 < 4; ++g4) { const f32x4 er = *(const LAS f32x4*)(erp + 8 * g4);
#pragma unroll
              for (int i = 0; i < 4; ++i) { S0[4 * g4 + i] *= er[i]; S1[4 * g4 + i] *= er[i]; }
              *(LAS v2u*)(sst_ + 16 * g4) = (v2u){pg8::cvt_pk_bf16(S0[4 * g4], S0[4 * g4 + 1]), pg8::cvt_pk_bf16(S0[4 * g4 + 2], S0[4 * g4 + 3])};
              *(LAS v2u*)(sst_ + 32 * 272 + 16 * g4) = (v2u){pg8::cvt_pk_bf16(S1[4 * g4], S1[4 * g4 + 1]), pg8::cvt_pk_bf16(S1[4 * g4 + 2], S1[4 * g4 + 3])}; }
#pragma unroll
          for (int ks = 0; ks < 4; ++ks) { const bf16x8 a = ldf(aKTT, 32 * ks); S0 = MFMA32(a, ldf(bV0, 32 * ks), S0); S1 = MFMA32(a, ldf(bV0, 32 * 144 + 32 * ks), S1); }
#pragma unroll
          for (int g4 = 0; g4 < 4; ++g4) { const f32x4 el = *(const LAS f32x4*)(elp + 8 * g4);
#pragma unroll
              for (int i = 0; i < 4; ++i) { S0[4 * g4 + i] *= el[i]; S1[4 * g4 + i] *= el[i]; } } }
        __syncthreads();
        { f32x16 acc;
#pragma unroll
          for (int i = 0; i < 16; ++i) acc[i] = 0.f;
#pragma unroll
          for (int ks = 0; ks < 4; ++ks) if (ks < 2 || btt == 1) acc = MFMA32(ldf(aP, 32 * ks), ldf(bVB, 32 * ks), acc);
#pragma unroll
          for (int ks = 0; ks < 8; ++ks) acc = MFMA32(ldf(aQ, 32 * ks), ldf(bS, 32 * ks), acc);
#pragma unroll
          for (int i = 0; i < 16; ++i) ost[((i & 3) + 8 * (i >> 2)) * 132] = acc[i]; }
        __syncthreads();
        { const int tt = 64 * c - 48 + et;
          f32x4 o[4]; float ss = 0.f;
#pragma unroll
          for (int j = 0; j < 4; ++j) { o[j] = *(const LAS f32x4*)(oep + 4 * j); ss += (o[j].x * o[j].x + o[j].y * o[j].y) + (o[j].z * o[j].z + o[j].w * o[j].w); }
          ss += __shfl_xor(ss, 1); ss += __shfl_xor(ss, 2); ss += __shfl_xor(ss, 4);
          const float rs = 1.0f / sqrtf(ss * (1.f / 128.f) + EPS);
          if (tt >= NMETA || (tt >= 0 && b == 0)) { const unsigned gw[8] = {g0.x, g0.y, g0.z, g0.w, g1.x, g1.y, g1.z, g1.w}; unsigned w[8];
#pragma unroll
              for (int j = 0; j < 4; ++j) { w[2 * j] = pk2(o[j].x * rs * gn[4 * j] * bflo(gw[2 * j]), o[j].y * rs * gn[4 * j + 1] * bfhi(gw[2 * j])); w[2 * j + 1] = pk2(o[j].z * rs * gn[4 * j + 2] * bflo(gw[2 * j + 1]), o[j].w * rs * gn[4 * j + 3] * bfhi(gw[2 * j + 1])); }
              GAS v4u* yp = (GAS v4u*)(YHG + rowof(b, tt) * HW + 16 * evq); yp[0] = (v4u){w[0], w[1], w[2], w[3]}; yp[1] = (v4u){w[4], w[5], w[6], w[7]}; } }
        __syncthreads();
    }
#undef HG_LOAD
}


#define DPP_F(old, v, ctrl, rmask) __builtin_bit_cast(float, __builtin_amdgcn_update_dpp(__builtin_bit_cast(int, (float)(old)), __builtin_bit_cast(int, (float)(v)), (ctrl), (rmask), 0xf, false))
__device__ __forceinline__ float wave_scan_add(float v) {
    v += DPP_F(0.f, v, 0x111, 0xf); v += DPP_F(0.f, v, 0x112, 0xf); v += DPP_F(0.f, v, 0x114, 0xf); v += DPP_F(0.f, v, 0x118, 0xf);
    v += DPP_F(0.f, v, 0x142, 0xa); v += DPP_F(0.f, v, 0x143, 0xc); return v;
}
__device__ __forceinline__ float wave_scan_max(float v) {
    const float ni = -INFINITY;
    v = fmaxf(v, DPP_F(ni, v, 0x111, 0xf)); v = fmaxf(v, DPP_F(ni, v, 0x112, 0xf)); v = fmaxf(v, DPP_F(ni, v, 0x114, 0xf)); v = fmaxf(v, DPP_F(ni, v, 0x118, 0xf));
    v = fmaxf(v, DPP_F(ni, v, 0x142, 0xa)); v = fmaxf(v, DPP_F(ni, v, 0x143, 0xc)); return v;
}
__device__ __forceinline__ void p3_mlstm_mfma(Frame& F, int bh) {
    unsigned char* ws = F.ws; const int b = bh >> 2, h = bh & 3, tid = F.tid, lane = F.lane, wave = F.wave, hh = lane >> 5, l31 = lane & 31;
    const bf16* MMg = (const bf16*)(ws + WS_MM) + h * 128; const bf16* MOg = (const bf16*)(ws + WS_MO) + h * 128; const float* LI = (const float*)(ws + WS_LI) + h; const float* LF = (const float*)(ws + WS_LF) + h;
    bf16* YML = (bf16*)(ws + WS_YML) + h * 128;
    LAS unsigned char* L = F.lds + RING_OFF;
    LAS unsigned char* CT = L; LAS unsigned char* MT = L + 17408; LAS unsigned char* KM = L + 34816; LAS unsigned char* KW = L + 44032; LAS unsigned char* QM = L + 53248; LAS unsigned char* QW = L + 62464;
    LAS unsigned char* VT = L + 71680; LAS unsigned char* SV = L + 90112; LAS unsigned char* PP = L + 108544; LAS float* OST = (LAS float*)(L + 17408);
    LAS float* SM = (LAS float*)(L + 117760);
    LAS float* U = SM; LAS float* MX = SM + 64; LAS float* BB = SM + 128; LAS float* WSs = SM + 192; LAS float* WI = SM + 256; LAS float* DENP = SM + 320  ; LAS float* NN = SM + 416; LAS float* DENI = SM + 480; LAS float* SC = SM + 544  ; LAS float* GNS = SM + 560  ;
    const int ch = tid & 127, pq = tid >> 7, et = tid >> 3, evq = tid & 7;
    const int f144 = l31 * 144 + hh * 16, f272 = l31 * 272 + hh * 16;
    const int sst = wave == 2 ? 1 : 0, stt = wave == 0 ? 0 : 1, dkt = wave & 1, svt = wave >> 1;
    const LAS unsigned char* cfp = (wave < 4 ? CT : MT) + f272;
    LAS unsigned char* qst = QM + l31 * 144 + (32 * (wave & 1) + 4 * hh) * 2; LAS unsigned char* qwst = QW + l31 * 144 + (32 * (wave & 1) + 4 * hh) * 2;
    const int kdk = 32 * (wave & 1) + l31;
    LAS unsigned char* kmst = KM + 4 * hh * 144 + kdk * 2; LAS unsigned char* kwst = KW + kdk * 144 + 4 * hh * 2; const LAS float* wsp = WSs + 4 * hh;
    LAS unsigned char* vst = VT + (32 * (wave & 3) + l31) * 144 + 4 * hh * 2;
    const LAS unsigned char* aKM = KM + 32 * sst * 144 + f144; const LAS unsigned char* bQM = QM + 32 * stt * 144 + f144;
    LAS unsigned char* pst = PP + (32 * stt + l31) * 144 + (32 * sst + 4 * hh) * 2; const LAS float* up = U + 32 * sst + 4 * hh;
    LAS unsigned char* svst = SV + (32 * svt + l31) * 144 + (32 * dkt + 4 * hh) * 2;
    const LAS unsigned char* aKW = KW + 32 * dkt * 144 + f144; const LAS unsigned char* bVT = VT + 32 * svt * 144 + f144;
    const LAS unsigned char* aP = PP + 32 * dkt * 144 + f144; const LAS unsigned char* aQW = QW + 32 * dkt * 144 + f144; const LAS unsigned char* bSV = SV + 32 * svt * 144 + f144;
    LAS float* ost = OST + (32 * dkt + 4 * hh) * 132 + 32 * svt + l31; const LAS float* oep = OST + et * 132 + 16 * evq;
    LAS unsigned char* tc = CT + 16 * pq * 272 + ch * 2; LAS unsigned char* tm = MT + 16 * pq * 272 + ch * 2;
    bf16x8 wf[8];
    { const float* W = wave < 2 ? F.in[IN_WQ] + (size_t)h * 128 * 64 + 32 * wave + l31 : wave < 4 ? F.in[IN_WK] + (size_t)h * 128 * 64 + 32 * (wave - 2) + l31 : F.in[IN_WV] + (size_t)h * 128 * 128 + 32 * (wave - 4) + l31;
      const int ld = wave < 4 ? 64 : 128; const float sc = wave < 2 ? 0.125f : 1.f;
#pragma unroll
      for (int ks = 0; ks < 8; ++ks) { unsigned p[4];
#pragma unroll
          for (int j = 0; j < 4; ++j) p[j] = pk2(W[(size_t)(16 * ks + 8 * hh + 2 * j) * ld] * sc, W[(size_t)(16 * ks + 8 * hh + 2 * j + 1) * ld] * sc);
          wf[ks] = __builtin_bit_cast(bf16x8, (v4u){p[0], p[1], p[2], p[3]}); } }
    float cw[4]; const float cb = F.in[IN_CONVB][h * 128 + ch];
#pragma unroll
    for (int j = 0; j < 4; ++j) cw[j] = F.in[IN_CONVW][j * HW + h * 128 + ch];
    if (tid < 128) GNS[tid] = F.in[IN_MLNORM][h * 128 + tid]; else if (tid < 256) GNS[tid] = F.in[IN_MLSKIP][h * 128 + tid - 128];
    f32x16 S;
#pragma unroll
    for (int i = 0; i < 16; ++i) S[i] = 0.f;
    float mcar = 0.f, nreg = 0.f;
    unsigned mr[19]; v4u gt0, gt1; float pli = 0.f, plf = 0.f;
#define ML_LOAD(c) do { const int ttb = 64 * (c) - 48 + 16 * pq - 3; \
        _Pragma("unroll") for (int i = 0; i < 19; ++i) { const int tt = ttb + i; mr[i] = tt >= 0 ? (unsigned)MMg[rowof(b, tt) * HW + ch] : 0u; } \
        { const int tt = 64 * (c) - 48 + et; if (tt >= 0) { const GAS v4u* gp = (const GAS v4u*)(MOg + rowof(b, tt) * HW + 16 * evq); gt0 = gp[0]; gt1 = gp[1]; } else { gt0 = (v4u){0u, 0u, 0u, 0u}; gt1 = gt0; } } \
        if (wave == 0) { const int tt = 64 * (c) - 48 + lane; if (tt >= 0) { pli = LI[rowof(b, tt) * 4]; plf = LF[rowof(b, tt) * 4]; } else { pli = -1e30f; plf = 0.f; } } } while (0)
    ML_LOAD(0);
    for (int c = 0; c < 33; ++c) {
#pragma unroll
        for (int i = 0; i < 16; ++i) { const float a = cb + (cw[0] * __builtin_bit_cast(float, mr[i] << 16) + cw[1] * __builtin_bit_cast(float, mr[i + 1] << 16)) + (cw[2] * __builtin_bit_cast(float, mr[i + 2] << 16) + cw[3] * __builtin_bit_cast(float, mr[i + 3] << 16));
            *(LAS unsigned short*)(tc + i * 272) = (unsigned short)f2bf(fsilu(a)); *(LAS unsigned short*)(tm + i * 272) = (unsigned short)mr[i + 3]; }
        if (wave == 0) {
            const float bs = wave_scan_add(plf);
            const float u = pli - bs; const float pm = wave_scan_max(u);
            const float M = fmaxf(mcar, pm), M63 = __shfl(M, 63), b63 = __shfl(bs, 63);
            U[lane] = u; MX[lane] = M; BB[lane] = bs; WSs[lane] = fexp(u - M63); WI[lane] = fexp(mcar - M);
            if (lane == 0) { SC[0] = b63; SC[1] = M63; }
        }
        __syncthreads();
        { f32x16 a0, a1;
#pragma unroll
          for (int i = 0; i < 16; ++i) { a0[i] = 0.f; a1[i] = 0.f; }
          if (wave < 2) {
#pragma unroll
              for (int ks = 0; ks < 8; ++ks) { a0 = MFMA32(wf[ks], ldf(cfp, 32 * ks), a0); a1 = MFMA32(wf[ks], ldf(cfp, 32 * 272 + 32 * ks), a1); }
              const float wi0 = WI[l31], wi1 = WI[32 + l31];
#pragma unroll
              for (int g4 = 0; g4 < 4; ++g4) {
                  *(LAS v2u*)(qst + 16 * g4) = (v2u){pg8::cvt_pk_bf16(a0[4 * g4], a0[4 * g4 + 1]), pg8::cvt_pk_bf16(a0[4 * g4 + 2], a0[4 * g4 + 3])};
                  *(LAS v2u*)(qst + 32 * 144 + 16 * g4) = (v2u){pg8::cvt_pk_bf16(a1[4 * g4], a1[4 * g4 + 1]), pg8::cvt_pk_bf16(a1[4 * g4 + 2], a1[4 * g4 + 3])};
                  *(LAS v2u*)(qwst + 16 * g4) = (v2u){pg8::cvt_pk_bf16(a0[4 * g4] * wi0, a0[4 * g4 + 1] * wi0), pg8::cvt_pk_bf16(a0[4 * g4 + 2] * wi0, a0[4 * g4 + 3] * wi0)};
                  *(LAS v2u*)(qwst + 32 * 144 + 16 * g4) = (v2u){pg8::cvt_pk_bf16(a1[4 * g4] * wi1, a1[4 * g4 + 1] * wi1), pg8::cvt_pk_bf16(a1[4 * g4 + 2] * wi1, a1[4 * g4 + 3] * wi1)}; }
          } else {
#pragma unroll
              for (int ks = 0; ks < 8; ++ks) { a0 = MFMA32(ldf(cfp, 32 * ks), wf[ks], a0); a1 = MFMA32(ldf(cfp, 32 * 272 + 32 * ks), wf[ks], a1); }
              if (wave < 4) {
                  float nsum = 0.f;
#pragma unroll
                  for (int g4 = 0; g4 < 4; ++g4) { const f32x4 w0 = *(const LAS f32x4*)(wsp + 8 * g4), w1 = *(const LAS f32x4*)(wsp + 32 + 8 * g4);
#pragma unroll
                      for (int i = 0; i < 4; ++i) { *(LAS unsigned short*)(kmst + (8 * g4 + i) * 144) = (unsigned short)f2bf(a0[4 * g4 + i]); *(LAS unsigned short*)(kmst + (32 + 8 * g4 + i) * 144) = (unsigned short)f2bf(a1[4 * g4 + i]); }
                      const float x0 = a0[4 * g4] * w0[0], x1 = a0[4 * g4 + 1] * w0[1], x2 = a0[4 * g4 + 2] * w0[2], x3 = a0[4 * g4 + 3] * w0[3];
                      const float y0 = a1[4 * g4] * w1[0], y1 = a1[4 * g4 + 1] * w1[1], y2 = a1[4 * g4 + 2] * w1[2], y3 = a1[4 * g4 + 3] * w1[3];
                      nsum += ((x0 + x1) + (x2 + x3)) + ((y0 + y1) + (y2 + y3));
                      *(LAS v2u*)(kwst + 16 * g4) = (v2u){pg8::cvt_pk_bf16(x0, x1), pg8::cvt_pk_bf16(x2, x3)};
                      *(LAS v2u*)(kwst + 64 + 16 * g4) = (v2u){pg8::cvt_pk_bf16(y0, y1), pg8::cvt_pk_bf16(y2, y3)}; }
                  nsum += __shfl_xor(nsum, 32);
                  if (hh == 0) NN[kdk] = nreg;
                  nreg = fexp(mcar - SC[1]) * nreg + nsum;
              } else {
#pragma unroll
                  for (int g4 = 0; g4 < 4; ++g4) {
                      *(LAS v2u*)(vst + 16 * g4) = (v2u){pg8::cvt_pk_bf16(a0[4 * g4], a0[4 * g4 + 1]), pg8::cvt_pk_bf16(a0[4 * g4 + 2], a0[4 * g4 + 3])};
                      *(LAS v2u*)(vst + 64 + 16 * g4) = (v2u){pg8::cvt_pk_bf16(a1[4 * g4], a1[4 * g4 + 1]), pg8::cvt_pk_bf16(a1[4 * g4 + 2], a1[4 * g4 + 3])}; }
              }
          } }
        __syncthreads();
        const v4u g0 = gt0, g1 = gt1;
        if (c + 1 < 33) ML_LOAD(c + 1);
        asm volatile("" ::: "memory");
        if (wave < 3) {
            f32x16 acc;
#pragma unroll
            for (int i = 0; i < 16; ++i) acc[i] = 0.f;
#pragma unroll
            for (int ks = 0; ks < 4; ++ks) acc = MFMA32(ldf(aKM, 32 * ks), ldf(bQM, 32 * ks), acc);
            const int t = 32 * stt + l31; const float mt = MX[t]; float dsum = 0.f;
#pragma unroll
            for (int g4 = 0; g4 < 4; ++g4) { const int s0 = 32 * sst + 8 * g4 + 4 * hh; const f32x4 us = *(const LAS f32x4*)(up + 8 * g4);
                const float x0 = (s0 + 0 <= t) ? acc[4 * g4 + 0] * fexp(us[0] - mt) : 0.f, x1 = (s0 + 1 <= t) ? acc[4 * g4 + 1] * fexp(us[1] - mt) : 0.f;
                const float x2 = (s0 + 2 <= t) ? acc[4 * g4 + 2] * fexp(us[2] - mt) : 0.f, x3 = (s0 + 3 <= t) ? acc[4 * g4 + 3] * fexp(us[3] - mt) : 0.f;
                dsum += (x0 + x1) + (x2 + x3);
                *(LAS v2u*)(pst + 16 * g4) = (v2u){pg8::cvt_pk_bf16(x0, x1), pg8::cvt_pk_bf16(x2, x3)}; }
            dsum += __shfl_xor(dsum, 32);
            if (hh == 0) DENP[wave * 32 + l31] = dsum;
        } else if (wave == 3) {
            float a = 0.f;
#pragma unroll 2
            for (int j = 0; j < 8; ++j) { const v4u q = *(const LAS v4u*)(QW + lane * 144 + 16 * j); const f32x4 n0 = *(const LAS f32x4*)(NN + 8 * j), n1 = *(const LAS f32x4*)(NN + 8 * j + 4);
                a += (bflo(q.x) * n0[0] + bfhi(q.x) * n0[1]) + (bflo(q.y) * n0[2] + bfhi(q.y) * n0[3]) + (bflo(q.z) * n1[0] + bfhi(q.z) * n1[1]) + (bflo(q.w) * n1[2] + bfhi(q.w) * n1[3]); }
            DENI[lane] = a;
        }
        { const float wp = fexp(mcar - SC[1]);
#pragma unroll
          for (int g4 = 0; g4 < 4; ++g4) {
              *(LAS v2u*)(svst + 16 * g4) = (v2u){pg8::cvt_pk_bf16(S[4 * g4], S[4 * g4 + 1]), pg8::cvt_pk_bf16(S[4 * g4 + 2], S[4 * g4 + 3])};
#pragma unroll
              for (int i = 0; i < 4; ++i) S[4 * g4 + i] *= wp; }
#pragma unroll
          for (int ks = 0; ks < 4; ++ks) S = MFMA32(ldf(aKW, 32 * ks), ldf(bVT, 32 * ks), S); }
        __syncthreads();
        { f32x16 acc;
#pragma unroll
          for (int i = 0; i < 16; ++i) acc[i] = 0.f;
#pragma unroll
          for (int ks = 0; ks < 4; ++ks) if (ks < 2 || dkt == 1) acc = MFMA32(ldf(aP, 32 * ks), ldf(bVT, 32 * ks), acc);
#pragma unroll
          for (int ks = 0; ks < 4; ++ks) acc = MFMA32(ldf(aQW, 32 * ks), ldf(bSV, 32 * ks), acc);
#pragma unroll
          for (int i = 0; i < 16; ++i) ost[((i & 3) + 8 * (i >> 2)) * 132] = acc[i]; }
        __syncthreads();
        { const int tt = 64 * c - 48 + et;
          const float den = (et < 32 ? DENP[et] : DENP[et] + DENP[32 + et]) + DENI[et];
          const float inv = 1.0f / fmaxf(fabsf(den), fexp(-(BB[et] + MX[et])));
          f32x4 o[4]; float ss = 0.f;
#pragma unroll
          for (int j = 0; j < 4; ++j) { o[j] = *(const LAS f32x4*)(oep + 4 * j) * inv; ss += (o[j].x * o[j].x + o[j].y * o[j].y) + (o[j].z * o[j].z + o[j].w * o[j].w); }
          ss += __shfl_xor(ss, 1); ss += __shfl_xor(ss, 2); ss += __shfl_xor(ss, 4);
          const float rs = 1.0f / sqrtf(ss * (1.f / 128.f) + EPS);
          if (tt >= NMETA || (tt >= 0 && b == 0)) { const unsigned gw[8] = {g0.x, g0.y, g0.z, g0.w, g1.x, g1.y, g1.z, g1.w}; unsigned w[8];
              const v4u c0 = *(const LAS v4u*)(CT + et * 272 + 32 * evq), c1 = *(const LAS v4u*)(CT + et * 272 + 32 * evq + 16); const unsigned cwd[8] = {c0.x, c0.y, c0.z, c0.w, c1.x, c1.y, c1.z, c1.w};
#pragma unroll
              for (int j = 0; j < 4; ++j) { const f32x4 gn = *(const LAS f32x4*)(GNS + 16 * evq + 4 * j), sk = *(const LAS f32x4*)(GNS + 128 + 16 * evq + 4 * j);
                  w[2 * j] = pk2((o[j].x * rs * gn[0] + sk[0] * bflo(cwd[2 * j])) * bflo(gw[2 * j]), (o[j].y * rs * gn[1] + sk[1] * bfhi(cwd[2 * j])) * bfhi(gw[2 * j]));
                  w[2 * j + 1] = pk2((o[j].z * rs * gn[2] + sk[2] * bflo(cwd[2 * j + 1])) * bflo(gw[2 * j + 1]), (o[j].w * rs * gn[3] + sk[3] * bfhi(cwd[2 * j + 1])) * bfhi(gw[2 * j + 1])); }
              GAS v4u* yp = (GAS v4u*)(YML + rowof(b, tt) * HW + 16 * evq); yp[0] = (v4u){w[0], w[1], w[2], w[3]}; yp[1] = (v4u){w[4], w[5], w[6], w[7]}; }
          mcar = SC[0] + SC[1]; }
        __syncthreads();
    }
#undef ML_LOAD
}

typedef float f32x4v __attribute__((ext_vector_type(4)));
#define MFMA16F(a, b, c) __builtin_amdgcn_mfma_f32_16x16x4f32(a, b, c, 0, 0, 0)
constexpr int RW_LD = 516;
__device__ __forceinline__ void router_topk16(LAS float* LGw, int V, float rsv, int resrow, int lane, LAS int* hist, LAS int* res, int* TOPE, float* TOPW, float* RS) {
    if (lane < 16) {
        int se[4]; float sv[4];
#pragma unroll
        for (int k = 0; k < 4; ++k) { float best = -INFINITY; int bi = 0;
            for (int e = 0; e < 32; ++e) { const float v = LGw[lane * 33 + e]; if (v > best) { best = v; bi = e; } }
            se[k] = bi; sv[k] = best; LGw[lane * 33 + bi] = -INFINITY; }
        const float e1 = __expf(sv[1] - sv[0]), e2 = __expf(sv[2] - sv[0]), e3 = __expf(sv[3] - sv[0]), inv = 1.0f / (1.f + e1 + e2 + e3);
        const float w4[4] = {inv, e1 * inv, e2 * inv, e3 * inv};
#pragma unroll
        for (int k = 0; k < 4; ++k) { const int lp = __hip_atomic_fetch_add(hist + se[k], 1, __ATOMIC_RELAXED, __HIP_MEMORY_SCOPE_WORKGROUP);
            TOPE[(size_t)V * 4 + k] = se[k]; TOPW[(size_t)V * 4 + k] = w4[k]; res[(resrow + lane) * 4 + k] = lp; }
        RS[V] = rsv;
    }
}
__device__ __forceinline__ void p6_router(Frame& F) {
    unsigned char* ws = F.ws;
    const bf16* H1 = (const bf16*)(ws + WS_H1); const float* RWT = (const float*)(ws + WS_RWT);
    int* TOPE = (int*)(ws + WS_TOPE); int* TOPP = (int*)(ws + WS_TOPP); float* TOPW = (float*)(ws + WS_TOPW); float* RS = (float*)(ws + WS_RS);
    int* ETOK = (int*)(ws + WS_ETOK); float* ERS = (float*)(ws + WS_ERS); float* EW = (float*)(ws + WS_EW);
    LAS float* rw = (LAS float*)(F.lds + RING_OFF);
    LAS float* LG = (LAS float*)(F.lds + RING_OFF + 66048) + F.wave * 528;
    LAS int* hist = (LAS int*)(F.lds + RING_OFF + 66048 + 8 * 2112);
    LAS int* res = hist + 64;
    LAS float* XP = (LAS float*)(res + 144 * 4);
    LAS float* XQ = XP + 8 * 528;
    const int lane = F.lane, wave = F.wave, i16 = lane & 15, kk = lane >> 4;
    constexpr int RPW = NTOK / 256;
    const bool has_meta = (F.vcu == 0);
    const int Vbase = F.vcu * RPW, Vt = Vbase + 16 * wave;
    if (F.tid < 64) hist[F.tid] = 0;
    f32x4v acc0 = {0.f, 0.f, 0.f, 0.f}, acc1 = {0.f, 0.f, 0.f, 0.f}, acx0 = {0.f, 0.f, 0.f, 0.f}, acx1 = {0.f, 0.f, 0.f, 0.f}; float ssq = 0.f, xss = 0.f;
    const bf16* arow = H1 + (size_t)(Vt + i16) * D + 8 * kk;
    const bf16* xrow = H1 + (size_t)(NTOK + i16) * D + 8 * kk;
    v4u a0[4], a1[4];
#define RT_MMA(A, SB, C0, C1, SS) do { const LAS float* b0p = rw + i16 * RW_LD + 8 * kk + 128 * (SB); const LAS float* b1p = rw + (16 + i16) * RW_LD + 8 * kk + 128 * (SB); \
        _Pragma("unroll") for (int s = 0; s < 4; ++s) { const v4u aw = A[s]; \
            _Pragma("unroll") for (int h = 0; h < 2; ++h) { const unsigned w0 = h ? aw.z : aw.x, w1 = h ? aw.w : aw.y; const f32x4 a = {bflo(w0), bfhi(w0), bflo(w1), bfhi(w1)}; \
            const f32x4 b0 = *(const LAS f32x4*)(b0p + 32 * s + 4 * h), b1 = *(const LAS f32x4*)(b1p + 32 * s + 4 * h); \
            SS += (a.x * a.x + a.y * a.y) + (a.z * a.z + a.w * a.w); \
            C0 = MFMA16F(a.x, b0.x, C0); C1 = MFMA16F(a.x, b1.x, C1); C0 = MFMA16F(a.y, b0.y, C0); C1 = MFMA16F(a.y, b1.y, C1); \
            C0 = MFMA16F(a.z, b0.z, C0); C1 = MFMA16F(a.z, b1.z, C1); C0 = MFMA16F(a.w, b0.w, C0); C1 = MFMA16F(a.w, b1.w, C1); } } } while (0)
#pragma unroll
    for (int s = 0; s < 4; ++s) a0[s] = *(const GAS v4u*)(arow + 32 * s);
#pragma unroll 1
    for (int it = 0; it < 4; ++it) {
        const int half = it >> 1, sb0 = (2 * it) & 3;
        if ((it & 1) == 0) {
            __syncthreads();
            { f32x4 stg[8];
#pragma unroll
              for (int q = 0; q < 8; ++q) { const int u = F.tid + q * NTHREADS, e = u >> 7, c = u & 127; stg[q] = *(const GAS f32x4*)(RWT + (size_t)e * D + 512 * half + 4 * c); }
#pragma unroll
              for (int q = 0; q < 8; ++q) { const int u = F.tid + q * NTHREADS, e = u >> 7, c = u & 127; *(LAS f32x4*)(rw + e * RW_LD + 4 * c) = stg[q]; } }
            __syncthreads();
        }
#pragma unroll
        for (int s = 0; s < 4; ++s) a1[s] = *(const GAS v4u*)(arow + 128 * (2 * it + 1) + 32 * s);
        RT_MMA(a0, sb0, acc0, acc1, ssq);
        if (it < 3) {
#pragma unroll
            for (int s = 0; s < 4; ++s) a0[s] = *(const GAS v4u*)(arow + 128 * (2 * it + 2) + 32 * s);
        }
        RT_MMA(a1, sb0 + 1, acc0, acc1, ssq);
        if (has_meta && (wave >> 1) == it) {
            v4u ax[4];
#pragma unroll
            for (int s = 0; s < 4; ++s) ax[s] = *(const GAS v4u*)(xrow + 128 * wave + 32 * s);
            RT_MMA(ax, wave & 3, acx0, acx1, xss);
        }
    }
#undef RT_MMA
    if (has_meta) {
        xss += __shfl_xor(xss, 16); xss += __shfl_xor(xss, 32);
#pragma unroll
        for (int r = 0; r < 4; ++r) { XP[wave * 528 + (4 * kk + r) * 33 + i16] = acx0[r]; XP[wave * 528 + (4 * kk + r) * 33 + 16 + i16] = acx1[r]; }
        if (kk == 0) XQ[wave * 16 + i16] = xss;
    }
    ssq += __shfl_xor(ssq, 16); ssq += __shfl_xor(ssq, 32);
    const float rsrow = 1.0f / sqrtf(ssq * (1.f / D) + EPS);
    const float rb0 = F.in[IN_RB][i16], rb1 = F.in[IN_RB][16 + i16];
#pragma unroll
    for (int r = 0; r < 4; ++r) { const float rsr = __shfl(rsrow, 4 * kk + r); LG[(4 * kk + r) * 33 + i16] = acc0[r] * rsr + rb0; LG[(4 * kk + r) * 33 + 16 + i16] = acc1[r] * rsr + rb1; }
    LDS_WAIT(); asm volatile("" ::: "memory");
    router_topk16(LG, Vt + lane, rsrow, 16 * wave, lane, hist, res, TOPE, TOPW, RS);
    __syncthreads();
    if (has_meta && wave == 7) {
        float q = 0.f;
#pragma unroll
        for (int w = 0; w < 8; ++w) q += XQ[w * 16 + i16];
        const float rsm = 1.0f / sqrtf(q * (1.f / D) + EPS);
#pragma unroll
        for (int r = 0; r < 4; ++r) { float v0 = 0.f, v1 = 0.f;
#pragma unroll
            for (int w = 0; w < 8; ++w) { v0 += XP[w * 528 + (4 * kk + r) * 33 + i16]; v1 += XP[w * 528 + (4 * kk + r) * 33 + 16 + i16]; }
            const float rsr = __shfl(rsm, 4 * kk + r); LG[(4 * kk + r) * 33 + i16] = v0 * rsr + rb0; LG[(4 * kk + r) * 33 + 16 + i16] = v1 * rsr + rb1; }
        LDS_WAIT(); asm volatile("" ::: "memory");
        router_topk16(LG, NTOK + lane, rsm, 128, lane, hist, res, TOPE, TOPW, RS);
    }
    __syncthreads();
    if (F.tid < NE) hist[32 + F.tid] = (int)__hip_atomic_fetch_add(F.ctl + CW_CNT + 64 * F.tid, (unsigned)hist[F.tid], RLX_AGENT);
    __syncthreads();
    const int nrows = has_meta ? RPW + 16 : RPW;
    for (int u = F.tid; u < nrows * 4; u += NTHREADS) { const int rr = u >> 2, V = rr < RPW ? Vbase + rr : NTOK + (rr - RPW); const size_t gi = (size_t)V * 4 + (u & 3); const int e = TOPE[gi], pos = hist[32 + e] + res[u];
        TOPP[gi] = pos; ETOK[(size_t)e * NV + pos] = V; ERS[(size_t)e * NV + pos] = RS[V]; EW[(size_t)e * NV + pos] = TOPW[gi]; }
}

__device__ __forceinline__ void build_tables(Frame& F) {
    LAS int* pst = (LAS int*)(F.lds + PST_OFF); LAS unsigned char* texp = (LAS unsigned char*)(F.lds + TEXP_OFF);
    __syncthreads();
    if (F.tid < 64) {
        const int e = F.lane & 31; const int c = (int)__hip_atomic_load(F.ctl + CW_CNT + 64 * e, RLX_AGENT); const int nt = (c + 255) >> 8;
        int incl = nt;
#pragma unroll
        for (int o = 1; o < 32; o <<= 1) { const int t = __shfl_up(incl, o); if ((F.lane & 31) >= o) incl += t; }
        const int start = incl - nt;
        if (F.lane < 32) { pst[e] = start * 256; pst[33 + e] = c; for (int j = 0; j < nt && start + j < MAXTILES; ++j) texp[start + j] = (unsigned char)e; if (e == 31) pst[32] = incl < MAXTILES ? incl : MAXTILES; }
    }
    __syncthreads();
}
typedef float f32v2_t __attribute__((ext_vector_type(2)));
__device__ __forceinline__ void p10_combine(Frame& F) {
    unsigned char* ws = F.ws; build_tables(F);
    const LAS int* pst = (const LAS int*)(F.lds + PST_OFF);
    const bf16* H1 = (const bf16*)(ws + WS_H1); const unsigned char* YB = (const unsigned char*)(ws + WS_YB);
    const int* TOPE = (const int*)(ws + WS_TOPE); const int* TOPP = (const int*)(ws + WS_TOPP);
    const int gw = F.vcu * NWAVES + F.wave, NGW = F.G * NWAVES;
    const GAS f32x4* nf = (const GAS f32x4*)F.in[IN_NFIN] + F.lane; f32x4 nfv[4];
#pragma unroll
    for (int j = 0; j < 4; ++j) nfv[j] = nf[64 * j];
    int sl[2][4];
#define CMB_SLOTS(Rbase) do { _Pragma("unroll") for (int q = 0; q < 2; ++q) { const int R = (Rbase) + q * NGW; if (R < BATCH * SEQ) { const size_t V = (size_t)R; \
        _Pragma("unroll") for (int k = 0; k < 4; ++k) sl[q][k] = pst[TOPE[V * 4 + k]] + TOPP[V * 4 + k]; } else { _Pragma("unroll") for (int k = 0; k < 4; ++k) sl[q][k] = 0; } } } while (0)
    CMB_SLOTS(gw);
    for (int R0 = gw; R0 < BATCH * SEQ; R0 += 2 * NGW) {
        f32x4 v[2][4]; unsigned y[2][4][4];
#pragma unroll
        for (int q = 0; q < 2; ++q) { const int R = (R0 + q * NGW < BATCH * SEQ) ? R0 + q * NGW : R0; const size_t V = (size_t)R;
            const GAS v2u* hr = (const GAS v2u*)(H1 + V * D) + F.lane;
#pragma unroll
            for (int j = 0; j < 4; ++j) { const v2u hw = hr[64 * j]; v[q][j] = (f32x4){bflo(hw.x), bfhi(hw.x), bflo(hw.y), bfhi(hw.y)}; }
#pragma unroll
            for (int k = 0; k < 4; ++k) { const GAS unsigned* yr = (const GAS unsigned*)(YB + (size_t)sl[q][k] * D) + F.lane;
#pragma unroll
                for (int j = 0; j < 4; ++j) y[q][k][j] = yr[64 * j]; } }
        CMB_SLOTS(R0 + 2 * NGW);
#pragma unroll
        for (int q = 0; q < 2; ++q) { const int R = R0 + q * NGW; if (R >= BATCH * SEQ) continue;
#pragma unroll
            for (int k = 0; k < 4; ++k)
#pragma unroll
                for (int j = 0; j < 4; ++j) { const unsigned w = y[q][k][j]; const f32v2_t lo = __builtin_amdgcn_cvt_pk_f32_fp8(w, false), hi = __builtin_amdgcn_cvt_pk_f32_fp8(w, true);
                    v[q][j].x += lo[0] * 0.0625f; v[q][j].y += lo[1] * 0.0625f; v[q][j].z += hi[0] * 0.0625f; v[q][j].w += hi[1] * 0.0625f; }
            float s = 0.f;
#pragma unroll
            for (int j = 0; j < 4; ++j) s += (v[q][j].x * v[q][j].x + v[q][j].y * v[q][j].y) + (v[q][j].z * v[q][j].z + v[q][j].w * v[q][j].w);
            const float rs = 1.0f / sqrtf(wave_sum(s) * (1.f / D) + EPS);
            GAS f32x4* orow = (GAS f32x4*)(F.out + (size_t)R * D) + F.lane;
#pragma unroll
            for (int j = 0; j < 4; ++j) orow[64 * j] = v[q][j] * rs * nfv[j]; }
    }
#undef CMB_SLOTS
}

__device__ __forceinline__ int meta_row(int lane) { return ((lane >> 5) & 1) * 8 + ((lane >> 4) & 1) * 4 + ((lane >> 3) & 1) * 2 + ((lane >> 2) & 1); }
template <int KPL> __device__ __forceinline__ float meta_col(const LAS unsigned char* A, const bf16* wrow, int lane) {
    constexpr int K = 64 * KPL; float w[KPL];
#pragma unroll
    for (int j = 0; j < KPL / 8; ++j) { const v4u x = *(const GAS v4u*)(wrow + lane * KPL + 8 * j);
        w[8 * j] = bflo(x.x); w[8 * j + 1] = bfhi(x.x); w[8 * j + 2] = bflo(x.y); w[8 * j + 3] = bfhi(x.y); w[8 * j + 4] = bflo(x.z); w[8 * j + 5] = bfhi(x.z); w[8 * j + 6] = bflo(x.w); w[8 * j + 7] = bfhi(x.w); }
    float p[16];
#pragma unroll
    for (int r = 0; r < 16; ++r) { float s = 0.f;
#pragma unroll
        for (int j = 0; j < KPL / 8; ++j) { const v4u a = *(const LAS v4u*)(A + (r * K + lane * KPL + 8 * j) * 2);
            s += (bflo(a.x) * w[8 * j] + bfhi(a.x) * w[8 * j + 1]) + (bflo(a.y) * w[8 * j + 2] + bfhi(a.y) * w[8 * j + 3]) + (bflo(a.z) * w[8 * j + 4] + bfhi(a.z) * w[8 * j + 5]) + (bflo(a.w) * w[8 * j + 6] + bfhi(a.w) * w[8 * j + 7]); }
        p[r] = s; if ((r & 3) == 3) asm volatile("" ::: "memory"); }
    const bool b32 = lane & 32, b16 = lane & 16, b8 = lane & 8, b4 = lane & 4;
    float q8[8], q4[4], q2[2];
#pragma unroll
    for (int i = 0; i < 8; ++i) { const float keep = b32 ? p[i + 8] : p[i], send = b32 ? p[i] : p[i + 8]; q8[i] = keep + __shfl_xor(send, 32); }
#pragma unroll
    for (int i = 0; i < 4; ++i) { const float keep = b16 ? q8[i + 4] : q8[i], send = b16 ? q8[i] : q8[i + 4]; q4[i] = keep + __shfl_xor(send, 16); }
#pragma unroll
    for (int i = 0; i < 2; ++i) { const float keep = b8 ? q4[i + 2] : q4[i], send = b8 ? q4[i] : q4[i + 2]; q2[i] = keep + __shfl_xor(send, 8); }
    float v = (b4 ? q2[1] : q2[0]) + __shfl_xor(b4 ? q2[0] : q2[1], 4);
    v += __shfl_xor(v, 2); v += __shfl_xor(v, 1);
    return v;
}
__device__ __forceinline__ void meta_stage(Frame& F, LAS unsigned char* dst, const bf16* src, int K) {
    v4u t[4]; const int n = 16 * K / 8;
#pragma unroll
    for (int q = 0; q < 4; ++q) { const int u = F.tid + q * NTHREADS; if (u < n) t[q] = *(const GAS v4u*)(src + (size_t)u * 8); }
#pragma unroll
    for (int q = 0; q < 4; ++q) { const int u = F.tid + q * NTHREADS; if (u < n) *(LAS v4u*)(dst + u * 16) = t[q]; }
}
__device__ __forceinline__ void meta_proj(Frame& F) {
    unsigned char* ws = F.ws; const bf16* WIN = (const bf16*)(ws + WS_WIN); const float* lbl = F.in[IN_LBL];
    LAS unsigned char* A = F.lds + RING_OFF;
    __syncthreads(); meta_stage(F, A, (const bf16*)(ws + WS_XN0) + (size_t)NTOK * D, D); __syncthreads();
    for (int c = F.vcu * NWAVES + F.wave; c < NPROJ; c += F.G * NWAVES) {
        const float v = meta_col<16>(A, WIN + (size_t)c * D, F.lane);
        if ((F.lane & 3) == 0) { const size_t row = NTOK + meta_row(F.lane); const int kind = c < 3072 ? (c >> 9) : 6, cc = c & 511;
            if (kind == 0) ((bf16*)(ws + WS_HQ))[row * HW + cc] = (bf16)f2bf(fsilu(v));
            else if (kind == 1) { const float lb = fsigmoid(lbl[cc] - lbl[HW + cc]); ((float*)(ws + WS_HG))[row * HW + cc] = __logf(lb + (1.f - lb) * fsigmoid(v)); }
            else if (kind == 2) ((bf16*)(ws + WS_HV))[row * HW + cc] = (bf16)f2bf(v);
            else if (kind == 3) ((bf16*)(ws + WS_HGATE))[row * HW + cc] = (bf16)f2bf(fsilu(v));
            else if (kind == 4) ((bf16*)(ws + WS_MM))[row * HW + cc] = (bf16)f2bf(v);
            else if (kind == 5) ((bf16*)(ws + WS_MO))[row * HW + cc] = (bf16)f2bf(fsigmoid(v));
            else (ws + WS_GATES)[row * 2048 + pg8::gate_pos(c - 3072)] = (unsigned char)(__builtin_bit_cast(unsigned, __builtin_fmaf(fsigmoid(v), 255.f, 8388608.f)) & 0xffu); } }
}
__device__ __forceinline__ void meta_merged(Frame& F) {
    unsigned char* ws = F.ws; const unsigned char* GATES = ws + WS_GATES;
    LAS unsigned char* A0 = F.lds + RING_OFF; LAS unsigned char* A1 = A0 + 16 * HW * 2;
    __syncthreads(); meta_stage(F, A0, (const bf16*)(ws + WS_YHG) + (size_t)NTOK * HW, HW); meta_stage(F, A1, (const bf16*)(ws + WS_YML) + (size_t)NTOK * HW, HW); __syncthreads();
    for (int c = F.vcu * NWAVES + F.wave; c < D; c += F.G * NWAVES) {
        const float vh = meta_col<8>(A0, (const bf16*)(ws + WS_WBH) + (size_t)c * HW, F.lane), vm = meta_col<8>(A1, (const bf16*)(ws + WS_WBM) + (size_t)c * HW, F.lane);
        if ((F.lane & 3) == 0) { const size_t row = NTOK + meta_row(F.lane); ((bf16*)(ws + WS_MERGED))[row * D + c] = (bf16)f2bf(((float)GATES[row * 2048 + pg8::gate_pos(c)] * vh) * (1.f / 255.f) + ((float)GATES[row * 2048 + pg8::gate_pos(D + c)] * vm) * (1.f / 255.f)); } }
}
__device__ __forceinline__ void meta_wout(Frame& F) {
    unsigned char* ws = F.ws; LAS unsigned char* A = F.lds + RING_OFF;
    __syncthreads(); meta_stage(F, A, (const bf16*)(ws + WS_MERGED) + (size_t)NTOK * D, D); __syncthreads();
    for (int c = F.vcu * NWAVES + F.wave; c < D; c += F.G * NWAVES) {
        const float d = meta_col<16>(A, (const bf16*)(ws + WS_WOUT) + (size_t)c * D, F.lane);
        if ((F.lane & 3) == 0) { const int mr_ = meta_row(F.lane); const size_t row = NTOK + mr_; const float v = F.in[IN_META][(size_t)mr_ * D + c] + d;
            ((bf16*)(ws + WS_H1))[row * D + c] = (bf16)f2bf(v); ((unsigned char*)(ws + WS_H1B))[row * D + c] = (unsigned char)(__builtin_amdgcn_cvt_pk_fp8_f32(__builtin_amdgcn_fmed3f(v, -448.f, 448.f), 0.f, 0u, false) & 0xffu); } }
}

__device__ __forceinline__ void ph_proj(Frame& F) {
    unsigned char* ws = F.ws;
    pg8::Gemm g{(const pg8::bf16_t*)(ws + WS_XN0), (const pg8::bf16_t*)(ws + WS_WIN), NTOK, NPROJ, D}; pg8::StaticOrder S; S.init(NTOK, NPROJ, F.G, (int)blockIdx.x);
    pg8::EpiProj E{ws, F.in[IN_LBL]};
    pg8::gemm_phase<pg8::EpiProj, pg8::StaticOrder, true, true>(F.lds + RING_OFF, g, S, E);
    meta_proj(F);
}
__device__ __forceinline__ void ph_scan(Frame& F) {
    const int sb = (int)blockIdx.x;
    if (sb < 64) p3_hgrn2_mfma(F, sb); else if (sb < 128) p3_mlstm_mfma(F, sb - 64);
#if !CONV_IN_P0
    else px_experts(F, sb - 128, F.G - 128);
#endif
}
__device__ __forceinline__ void ph_merged(Frame& F) {
    unsigned char* ws = F.ws;
    static_assert(WS_YML - WS_YHG == (size_t)pg8::PAIR_DA * 256 * HW * 2 && WS_WBM - WS_WBH == (size_t)pg8::PAIR_DB * 256 * HW * 2, "the second branch's operands sit a whole number of tiles behind the first's");
    pg8::PairOrder S; S.S.init(NTOK, D, F.G, (int)blockIdx.x);
    pg8::Gemm g{(const pg8::bf16_t*)(ws + WS_YHG), (const pg8::bf16_t*)(ws + WS_WBH), NTOK, D, HW};
    pg8::EpiGate2 E{(const unsigned char*)(ws + WS_GATES), (pg8::bf16_t*)(ws + WS_TMP), (pg8::bf16_t*)(ws + WS_MERGED)};
    pg8::gemm_phase<pg8::EpiGate2, pg8::PairOrder, true, true>(F.lds + RING_OFF, g, S, E);
    meta_merged(F);
}
__device__ __forceinline__ void ph_wout(Frame& F) {
    unsigned char* ws = F.ws;
    pg8::Gemm g{(const pg8::bf16_t*)(ws + WS_MERGED), (const pg8::bf16_t*)(ws + WS_WOUT), NTOK, D, D}; pg8::StaticOrder S; S.init(NTOK, D, F.G, (int)blockIdx.x);
    pg8::EpiH1 E{(const pg8::bf16_t*)(ws + WS_XN0), (const float*)(ws + WS_XSQ), (pg8::bf16_t*)(ws + WS_H1), (unsigned char*)(ws + WS_H1B)};
    pg8::gemm_phase<pg8::EpiH1, pg8::StaticOrder, true, true>(F.lds + RING_OFF, g, S, E);
    meta_wout(F);
}
__device__ __forceinline__ void ph_gu(Frame& F) {
    unsigned char* ws = F.ws; build_tables(F);
    const LAS int* pst = (const LAS int*)(F.lds + PST_OFF); LAS unsigned short* tok16 = (LAS unsigned short*)(F.lds + TOK_OFF);
    pg8::Gemm g{(const pg8::bf16_t*)(ws + WS_H1B), (const pg8::bf16_t*)(ws + WS_WGU), NV, NE * 2 * DFF, D / 2};
    pg8::GroupOrder S{pst[32], 8, F.G, (int)blockIdx.x, (const LAS unsigned char*)(F.lds + TEXP_OFF)};
    { const int* ETOK = (const int*)(ws + WS_ETOK);
      int tokv[18];
#pragma unroll
      for (int i = 0; i < 18; ++i) { pg8::Unit u; int t = 0; if (S.next(i, u) && F.tid < 256) { const int e = u.pn >> 3, pos = u.pm * 256 - pst[e] + F.tid; if (pos < pst[33 + e]) t = ETOK[(size_t)e * NV + pos]; } tokv[i] = t; }
      if (F.tid < 256) {
#pragma unroll
          for (int i = 0; i < 18; ++i) tok16[i * 256 + F.tid] = (unsigned short)tokv[i]; }
      __syncthreads(); }
    pg8::EpiGU E{(const float*)(ws + WS_BGUP), (const float*)(ws + WS_ERS), (unsigned char*)(ws + WS_ACT), pst};
    pg8::gemm_phase_g<pg8::EpiGU, pg8::GroupOrder, true>(F.lds + RING_OFF, g, S, E, tok16);
}
__device__ __forceinline__ void ph_down(Frame& F) {
    unsigned char* ws = F.ws; build_tables(F);
    pg8::Gemm g{(const pg8::bf16_t*)(ws + WS_ACT), (const pg8::bf16_t*)(ws + WS_WDN), MAXTILES * 256, NE * D, DFF / 2};
    pg8::GroupOrder S{((const LAS int*)(F.lds + PST_OFF))[32], 4, F.G, (int)blockIdx.x, (const LAS unsigned char*)(F.lds + TEXP_OFF)};
    pg8::EpiDown E{F.in[IN_BDN], (const float*)(ws + WS_EW), (unsigned char*)(ws + WS_YB), (const LAS int*)(F.lds + PST_OFF)};
    pg8::gemm_phase<pg8::EpiDown, pg8::GroupOrder, true, true, true>(F.lds + RING_OFF, g, S, E);
}

#ifndef CONV_IN_P0
#define CONV_IN_P0 0
#endif
#ifndef PROBE_DOUBLE
#define PROBE_DOUBLE 0
#endif
#define DBL(k) ((PROBE_DOUBLE >> (k)) & 1)
#ifndef MK_N_LAUNCHES
#define MK_N_LAUNCHES 1
#endif
constexpr int NPHASE = 9;
struct Args { const float* in[25]; float* out; unsigned char* ws; int ph_lo, ph_hi, li, pad; };
__global__ void __launch_bounds__(NTHREADS, 2) fwd_kernel(Args args) {
    extern __shared__ __attribute__((aligned(16))) unsigned char lds[];
    Frame F;
    F.lds = (LAS unsigned char*)lds; F.MISC = (volatile LAS unsigned*)(F.lds + MISC_OFF);
    F.tid = threadIdx.x; F.lane = F.tid & 63; F.wave = __builtin_amdgcn_readfirstlane(F.tid >> 6);
    F.G = gridDim.x; { const int bx = blockIdx.x; F.vcu = (F.G % 8 == 0) ? (bx % 8) * (F.G / 8) + bx / 8 : bx; }
    F.ws = args.ws; F.ctl = (gu32*)(args.ws + WS_CTL); F.out = args.out;
#pragma unroll
    for (int i = 0; i < 25; ++i) F.in[i] = args.in[i];
    { int t0 = F.tid; asm volatile("" : "+v"(t0)); if (t0 < 64) F.MISC[t0] = 0u; }
    __syncthreads();
    const int lo = args.ph_lo, hi = args.ph_hi;
    XcdBarrier bar; bar.bar = (unsigned*)(F.ctl + CW_BAR) + args.li * XCD_BAR_WORDS; bar.x = 0; bar.st = nullptr;
    if (hi - lo > 1) bar = xcd_barrier_post((unsigned*)(F.ctl + CW_BAR) + args.li * XCD_BAR_WORDS, F.MISC + 8);
#define IN(k) (lo <= (k) && (k) < hi)
#define SEAM(k) do { if (IN(k) && IN((k) + 1)) xcd_barrier(bar); } while (0)

    if (IN(0)) { p0_prologue(F);
#if CONV_IN_P0
        __syncthreads(); px_experts(F, F.vcu, F.G);
#endif
    } SEAM(0);
    if (IN(1)) { ph_proj(F); } SEAM(1);
    if (IN(2)) { ph_scan(F); } SEAM(2);
    if (IN(3)) { ph_merged(F); } SEAM(3);
    if (IN(4)) { ph_wout(F); } SEAM(4);
    if (IN(5)) { p6_router(F); } SEAM(5);
    if (IN(6)) { ph_gu(F); } SEAM(6);
    if (IN(7)) { ph_down(F); } SEAM(7);
    if (IN(8)) { p10_combine(F); }
#undef IN
#undef SEAM
}

extern "C" void kernel_launch(void* const* d_in, const int* in_sizes, int n_in, void* d_out, int out_size, void* d_ws, size_t ws_size, hipStream_t stream) {
    static int grid = 0;
    if (grid == 0) {
        if (n_in != 25 || in_sizes[0] != BATCH * SEQ * D || out_size != BATCH * SEQ * D || ws_size < WS_END) { fprintf(stderr, "kernel_launch: unexpected shapes (n_in %d, in0 %d, out %d, ws %zu); nothing launched\n", n_in, n_in > 0 ? in_sizes[0] : -1, out_size, ws_size); grid = -1; return; }
        int dev = 0, cus = 0, per_cu = 0;
        if (hipGetDevice(&dev) != hipSuccess || hipDeviceGetAttribute(&cus, hipDeviceAttributeMultiprocessorCount, dev) != hipSuccess) { grid = -1; return; }
        if (hipFuncSetAttribute((const void*)fwd_kernel, hipFuncAttributeMaxDynamicSharedMemorySize, LDS_BYTES) != hipSuccess) { fprintf(stderr, "kernel_launch: hipFuncSetAttribute failed\n"); grid = -1; return; }
        if (hipOccupancyMaxActiveBlocksPerMultiprocessor(&per_cu, (const void*)fwd_kernel, NTHREADS, LDS_BYTES) != hipSuccess || per_cu < 1) { fprintf(stderr, "kernel_launch: occupancy query reports %d blocks per CU\n", per_cu); }
        (void)hipGetLastError();
        grid = 256;
        if (cus < 256) { fprintf(stderr, "kernel_launch: %d CUs < 256: the grid would not be resident; nothing launched\n", cus); grid = -1; return; }
    }
    if (grid < 0) return;
    if (hipMemsetAsync((char*)d_ws + WS_CTL, 0, CTL_ZERO_BYTES, stream) != hipSuccess) return;
    Args a{};
    for (int i = 0; i < 25; ++i) a.in[i] = (const float*)d_in[i];
    a.out = (float*)d_out; a.ws = (unsigned char*)d_ws; a.pad = 0;
#if MK_N_LAUNCHES == 1
    a.ph_lo = 0; a.ph_hi = NPHASE; a.li = 0;
    hipLaunchKernelGGL(fwd_kernel, dim3(grid), dim3(NTHREADS), LDS_BYTES, stream, a);
#else
    for (int p = 0; p < NPHASE; ++p) for (int rep = 0; rep <= DBL(p); ++rep) { a.ph_lo = p; a.ph_hi = p + 1; a.li = 0; hipLaunchKernelGGL(fwd_kernel, dim3(grid), dim3(NTHREADS), LDS_BYTES, stream, a); }
#endif
}
```

```cpp
#include <hip/hip_runtime.h>
#include <cstdio>
#include <cstdint>
namespace pg8 {
#define PG8_LAS __attribute__((address_space(3)))
typedef unsigned short bf16_t;
typedef short bf16x8 __attribute__((ext_vector_type(8)));
typedef float f32x4 __attribute__((ext_vector_type(4)));
typedef unsigned u32x4 __attribute__((ext_vector_type(4)));
constexpr int BM = 256, BK = 64, HALF = 128, HTB = HALF * BK * 2  , STAGE_BYTES = 8 * HTB, NXCD = 8, WGM = 8;

__host__ __device__ __forceinline__ int lds_byte(int r, int c) { const int st = (r >> 4) * 2 + (c >> 5), rr = r & 15, cc = c & 31, ob = rr * 64 + cc * 2; return st * 1024 + (ob ^ (((ob >> 9) & 1) << 5)); }
__host__ __device__ __forceinline__ void stage_rc(int b, int& R, int& C) { const int st = b / 1024, sb = b % 1024, swz = sb ^ (((sb >> 9) & 1) << 5); R = (st >> 1) * 16 + swz / 64; C = (st & 1) * 32 + (swz % 64) / 2; }
__host__ __device__ __forceinline__ int perm32(int rho) { const int n = rho >> 4, i = rho & 15; return 8 * (i >> 2) + 4 * n + (i & 3); }

struct Unit { int pm, pn; };
struct Gemm { const bf16_t* A; const bf16_t* Bt; int M, N, K; };

struct StaticOrder {
    int nM, nN, nwg, G, c;
    __host__ __device__ void init(int M, int N, int G_, int c_) { nM = M / BM; nN = N / BM; nwg = nM * nN; G = G_; c = c_; }
    __host__ __device__ __forceinline__ bool next(int i, Unit& u) const {
        const long L = (long)i * G + c; if (L >= nwg) return false;
        int wgid = (int)L; { const int q = nwg / NXCD, r = nwg % NXCD, xcd = wgid % NXCD, off = wgid / NXCD; wgid = (xcd < r ? xcd * (q + 1) : r * (q + 1) + (xcd - r) * q) + off; }
        const int nig = WGM * nN, gid = wgid / nig, fm = gid * WGM, gsz = (nM - fm) < WGM ? (nM - fm) : WGM;
        u.pm = fm + ((wgid % nig) % gsz); u.pn = (wgid % nig) / gsz; return true;
    }
    __device__ __forceinline__ void a_ready(const Unit&) const {}
    __device__ __forceinline__ void done(const Unit&) const {}
};

typedef __bf16 bf16v2 __attribute__((ext_vector_type(2)));
typedef float f32v2 __attribute__((ext_vector_type(2)));
__device__ __forceinline__ unsigned cvt_pk_bf16(float lo, float hi) { const f32v2 v = {lo, hi}; return __builtin_bit_cast(unsigned, __builtin_convertvector(v, bf16v2)); }
typedef float f32x2 __attribute__((ext_vector_type(2)));
typedef int i32x4 __attribute__((ext_vector_type(4)));
typedef int i32x8 __attribute__((ext_vector_type(8)));
__device__ __forceinline__ i32x8 cat8(const bf16x8 a, const bf16x8 b) { const i32x4 x = __builtin_bit_cast(i32x4, a), y = __builtin_bit_cast(i32x4, b); return __builtin_shufflevector(x, y, 0, 1, 2, 3, 4, 5, 6, 7); }
template <class Epi, class Sched, bool ALIGN_EPI = false, bool SP2 = false, bool FP8 = false>
__device__ __forceinline__ void gemm_phase(PG8_LAS unsigned char* lds, const Gemm g, const Sched& S, const Epi& E) {
    const int tid = threadIdx.x, wid = __builtin_amdgcn_readfirstlane(tid >> 6), lane = tid & 63, wr = wid >> 2, wc = wid & 3, fr = lane & 15, fq = lane >> 4;
    const int K = g.K, nt = K / BK;
    unsigned voffA[2], voffB[2];
#pragma unroll
    for (int i = 0; i < 2; ++i) { int R, C; stage_rc(tid * 16 + i * 8192, R, C); const int Rb = Epi::PERM ? ((R & ~31) + perm32(R & 31)) : R;
        voffA[i] = (unsigned)(R * K + C) * 2u; voffB[i] = (unsigned)(Rb * K + C) * 2u; }
    const size_t kstep = (size_t)(BK * 2);
    const size_t hstep = (size_t)HALF * K * 2;
    const size_t tstep = 2 * hstep;
    const unsigned ldsw = (unsigned)wid * 1024u;
    const int aoff = lds_byte(wr * 64 + fr, fq * 8), boff = lds_byte(wc * 32 + fr, fq * 8);
#define PG8_SA(b, h) (((b) * 2 + (h)) * HTB)
#define PG8_SB(b, h) ((4 + (b) * 2 + (h)) * HTB)
#define PG8_STAGE(bufoff, gbase, voff) do { _Pragma("unroll") for (int _i = 0; _i < 2; ++_i) \
        __builtin_amdgcn_global_load_lds((const unsigned*)((const char*)(gbase) + (voff)[_i]), (PG8_LAS unsigned*)(lds + (bufoff) + ldsw + _i * 8192), 16, 0, 0); } while (0)
#define PG8_LDA(dst, b, h) do { _Pragma("unroll") for (int m = 0; m < 4; ++m) { if constexpr (FP8) dst##8[m] = cat8(*(const PG8_LAS bf16x8*)(lds + PG8_SA(b, h) + aoff + m * 2048), *(const PG8_LAS bf16x8*)(lds + PG8_SA(b, h) + aoff + m * 2048 + 1024)); \
        else { _Pragma("unroll") for (int k = 0; k < 2; ++k) dst[m][k] = *(const PG8_LAS bf16x8*)(lds + PG8_SA(b, h) + aoff + m * 2048 + k * 1024); } } } while (0)
#define PG8_LDB(dst, b, h) do { _Pragma("unroll") for (int n = 0; n < 2; ++n) { if constexpr (FP8) dst##8[n] = cat8(*(const PG8_LAS bf16x8*)(lds + PG8_SB(b, h) + boff + n * 2048), *(const PG8_LAS bf16x8*)(lds + PG8_SB(b, h) + boff + n * 2048 + 1024)); \
        else { _Pragma("unroll") for (int k = 0; k < 2; ++k) dst[n][k] = *(const PG8_LAS bf16x8*)(lds + PG8_SB(b, h) + boff + n * 2048 + k * 1024); } } } while (0)
#define PG8_MMA(ai, bj, At, Bt) do { __builtin_amdgcn_s_setprio(1); _Pragma("unroll") for (int m = 0; m < 4; ++m) _Pragma("unroll") for (int n = 0; n < 2; ++n) { \
        if constexpr (FP8) acc[ai][bj][m][n] = __builtin_amdgcn_mfma_scale_f32_16x16x128_f8f6f4(Bt##8[n], At##8[m], acc[ai][bj][m][n], 0, 0, 0, 0x7f7f7f7f, 0, 0x7f7f7f7f); \
        else { _Pragma("unroll") for (int k = 0; k < 2; ++k) acc[ai][bj][m][n] = __builtin_amdgcn_mfma_f32_16x16x32_bf16(Bt[n][k], At[m][k], acc[ai][bj][m][n], 0, 0, 0); } } \
        if constexpr (FP8) { _Pragma("unroll") for (int m = 0; m < 4; ++m) _Pragma("unroll") for (int n = 0; n < 2; ++n) asm volatile("" : "+v"(acc[ai][bj][m][n])); }     \
        __builtin_amdgcn_s_setprio(0); } while (0)
#define PG8_WAIT_V(n) asm volatile("s_waitcnt vmcnt(" #n ")" ::: "memory")
#define PG8_WAIT_L(n) asm volatile("s_waitcnt lgkmcnt(" #n ")" ::: "memory")
#define PG8_BAR __builtin_amdgcn_s_barrier()
#define PG8_SCHED __builtin_amdgcn_sched_barrier(0)
    Unit cur, nxt; int ui = 0;
    if (!S.next(0, cur)) return;
    f32x4 acc[2][2][4][2];
#pragma unroll
    for (int a = 0; a < 2; ++a)
#pragma unroll
        for (int b = 0; b < 2; ++b)
#pragma unroll
            for (int m = 0; m < 4; ++m)
#pragma unroll
                for (int n = 0; n < 2; ++n) acc[a][b][m][n] = (f32x4){0.f, 0.f, 0.f, 0.f};
    bf16x8 At[4][2], B0[2][2], B1[2][2]; i32x8 At8[4], B08[2], B18[2];
    const char* cA = (const char*)g.A + (size_t)cur.pm * tstep; const char* cB = (const char*)g.Bt + (size_t)cur.pn * tstep;
    S.a_ready(cur);
    if constexpr (SP2) {
        PG8_STAGE(PG8_SB(0, 0), cB, voffB); PG8_STAGE(PG8_SB(0, 1), cB + hstep, voffB); PG8_STAGE(PG8_SA(0, 0), cA, voffA); PG8_STAGE(PG8_SA(0, 1), cA + hstep, voffA);
        if (wr == 1) PG8_BAR;
        PG8_WAIT_V(2); PG8_BAR;
        PG8_STAGE(PG8_SB(1, 0), cB + kstep, voffB); PG8_STAGE(PG8_SA(1, 0), cA + kstep, voffA); PG8_STAGE(PG8_SB(1, 1), cB + hstep + kstep, voffB);
        PG8_WAIT_V(6); PG8_BAR;
    } else {
        PG8_STAGE(PG8_SB(0, 0), cB, voffB); PG8_STAGE(PG8_SA(0, 0), cA, voffA); PG8_STAGE(PG8_SB(0, 1), cB + hstep, voffB); PG8_STAGE(PG8_SA(0, 1), cA + hstep, voffA);
        if (wr == 1) PG8_BAR;
        PG8_WAIT_V(4); PG8_BAR;
        PG8_STAGE(PG8_SB(1, 0), cB + kstep, voffB); PG8_STAGE(PG8_SA(1, 0), cA + kstep, voffA); PG8_STAGE(PG8_SB(1, 1), cB + hstep + kstep, voffB);
        PG8_WAIT_V(6); PG8_BAR;
    }
    for (;;) {
        const bool has_next = S.next(ui + 1, nxt);
        const char* nA = has_next ? (const char*)g.A + (size_t)nxt.pm * tstep : cA; const char* nB = has_next ? (const char*)g.Bt + (size_t)nxt.pn * tstep : cB;
        for (int t = 0; t < nt; t += 2) {
            const bool last = (t == nt - 2);
            const char* a1 = cA + (size_t)(t + 1) * kstep;
            const char* a2 = last ? nA : cA + (size_t)(t + 2) * kstep; const char* b2 = last ? nB : cB + (size_t)(t + 2) * kstep;
            const char* a3 = a2 + kstep; const char* b3 = b2 + kstep;
            if (last && has_next) S.a_ready(nxt);
            if constexpr (SP2) {
            PG8_LDB(B0, 0, 0); PG8_LDB(B1, 0, 1); PG8_SCHED; PG8_LDA(At, 0, 0); PG8_STAGE(PG8_SA(1, 1), a1 + hstep, voffA);
            PG8_WAIT_V(8); PG8_WAIT_L(0); PG8_BAR; PG8_MMA(0, 0, At, B0); PG8_MMA(0, 1, At, B1); PG8_BAR; PG8_SCHED;
            PG8_LDA(At, 0, 1); PG8_STAGE(PG8_SB(0, 0), b2, voffB); PG8_STAGE(PG8_SB(0, 1), b2 + hstep, voffB); PG8_STAGE(PG8_SA(0, 0), a2, voffA);
            PG8_WAIT_V(8); PG8_WAIT_L(0); PG8_BAR; PG8_MMA(1, 0, At, B0); PG8_MMA(1, 1, At, B1); PG8_BAR; PG8_SCHED;
            PG8_LDB(B0, 1, 0); PG8_LDB(B1, 1, 1); PG8_SCHED; PG8_LDA(At, 1, 0); PG8_STAGE(PG8_SA(0, 1), a2 + hstep, voffA);
            PG8_WAIT_V(8); PG8_WAIT_L(0); PG8_BAR; PG8_MMA(0, 0, At, B0); PG8_MMA(0, 1, At, B1); PG8_BAR; PG8_SCHED;
            PG8_LDA(At, 1, 1); PG8_STAGE(PG8_SB(1, 0), b3, voffB); PG8_STAGE(PG8_SB(1, 1), b3 + hstep, voffB); PG8_STAGE(PG8_SA(1, 0), a3, voffA);
            PG8_WAIT_V(8); PG8_WAIT_L(0); PG8_BAR; PG8_MMA(1, 0, At, B0); PG8_MMA(1, 1, At, B1); PG8_BAR; PG8_SCHED;
            } else {
            PG8_LDB(B0, 0, 0); PG8_SCHED; PG8_LDA(At, 0, 0); PG8_STAGE(PG8_SA(1, 1), a1 + hstep, voffA);
            PG8_WAIT_L(8); PG8_BAR; PG8_WAIT_L(0); PG8_MMA(0, 0, At, B0); PG8_BAR; PG8_SCHED;
            PG8_LDB(B1, 0, 1); PG8_STAGE(PG8_SB(0, 0), b2, voffB);
            PG8_BAR; PG8_WAIT_L(0); PG8_MMA(0, 1, At, B1); PG8_BAR;
            PG8_LDA(At, 0, 1); PG8_STAGE(PG8_SA(0, 0), a2, voffA);
            PG8_BAR; PG8_WAIT_L(0); PG8_MMA(1, 0, At, B0); PG8_BAR; PG8_SCHED;
            PG8_STAGE(PG8_SB(0, 1), b2 + hstep, voffB);
            PG8_WAIT_V(6); PG8_BAR; PG8_MMA(1, 1, At, B1); PG8_BAR;
            PG8_LDB(B0, 1, 0); PG8_SCHED; PG8_LDA(At, 1, 0); PG8_STAGE(PG8_SA(0, 1), a2 + hstep, voffA);
            PG8_WAIT_L(8); PG8_BAR; PG8_WAIT_L(0); PG8_MMA(0, 0, At, B0); PG8_BAR; PG8_SCHED;
            PG8_LDB(B1, 1, 1); PG8_STAGE(PG8_SB(1, 0), b3, voffB);
            PG8_BAR; PG8_WAIT_L(0); PG8_MMA(0, 1, At, B1); PG8_BAR;
            PG8_LDA(At, 1, 1); PG8_STAGE(PG8_SA(1, 0), a3, voffA);
            PG8_BAR; PG8_WAIT_L(0); PG8_MMA(1, 0, At, B0); PG8_BAR; PG8_SCHED;
            PG8_STAGE(PG8_SB(1, 1), b3 + hstep, voffB);
            PG8_WAIT_V(6); PG8_BAR; PG8_MMA(1, 1, At, B1); PG8_BAR;
            }
        }
        if constexpr (ALIGN_EPI) { if (wr == 0) PG8_BAR; }
        if constexpr (!Epi::AFTER_DRAIN) { E(acc, cur, wr, wc, fr, fq); S.done(cur); }
        if (!has_next) break;
#pragma unroll
        for (int a = 0; a < 2; ++a)
#pragma unroll
            for (int b = 0; b < 2; ++b)
#pragma unroll
                for (int m = 0; m < 4; ++m)
#pragma unroll
                    for (int n = 0; n < 2; ++n) acc[a][b][m][n] = (f32x4){0.f, 0.f, 0.f, 0.f};
        cur = nxt; cA = nA; cB = nB; ++ui;
        if constexpr (ALIGN_EPI) { if (wr == 1) PG8_BAR; }
    }
    PG8_WAIT_V(0);
    if constexpr (!ALIGN_EPI) { if (wr == 0) PG8_BAR; }
    PG8_BAR;
    if constexpr (Epi::AFTER_DRAIN) { E.fused(acc, cur, wr, wc, fr, fq, lds, wid, lane); S.done(cur); }
#undef PG8_SA
#undef PG8_SB
#undef PG8_STAGE
#undef PG8_LDA
#undef PG8_LDB
#undef PG8_MMA
#undef PG8_WAIT_V
#undef PG8_WAIT_L
#undef PG8_BAR
#undef PG8_SCHED
}
template <class Epi, class Sched, bool FP8 = false>
__device__ __forceinline__ void gemm_phase_g(PG8_LAS unsigned char* lds, const Gemm g, const Sched& S, const Epi& E, const PG8_LAS unsigned short* tok16) {
    constexpr bool ALIGN_EPI = true, SP2 = true;
    const int tid = threadIdx.x, wid = __builtin_amdgcn_readfirstlane(tid >> 6), lane = tid & 63, wr = wid >> 2, wc = wid & 3, fr = lane & 15, fq = lane >> 4;
    const int K = g.K, nt = K / BK;
    unsigned voffB[2]; int RA[2]; unsigned CA[2];
#pragma unroll
    for (int i = 0; i < 2; ++i) { int R, C; stage_rc(tid * 16 + i * 8192, R, C); const int Rb = Epi::PERM ? ((R & ~31) + perm32(R & 31)) : R;
        RA[i] = R; CA[i] = (unsigned)C * 2u; voffB[i] = (unsigned)(Rb * K + C) * 2u; }
    unsigned oc[2][2];
#define PG8_TOKS(dst, ui_) do { _Pragma("unroll") for (int _h = 0; _h < 2; ++_h) _Pragma("unroll") for (int _i = 0; _i < 2; ++_i) \
        dst[_h][_i] = (unsigned)tok16[(ui_) * 256 + _h * HALF + RA[_i]] * (unsigned)(K * 2) + CA[_i]; } while (0)
    const size_t kstep = (size_t)(BK * 2);
    const size_t hstep = (size_t)HALF * K * 2;
    const size_t tstep = 2 * hstep;
    const unsigned ldsw = (unsigned)wid * 1024u;
    const int aoff = lds_byte(wr * 64 + fr, fq * 8), boff = lds_byte(wc * 32 + fr, fq * 8);
#define PG8_SA(b, h) (((b) * 2 + (h)) * HTB)
#define PG8_SB(b, h) ((4 + (b) * 2 + (h)) * HTB)
#define PG8_STAGE(bufoff, gbase, voff) do { _Pragma("unroll") for (int _i = 0; _i < 2; ++_i) \
        __builtin_amdgcn_global_load_lds((const unsigned*)((const char*)(gbase) + (voff)[_i]), (PG8_LAS unsigned*)(lds + (bufoff) + ldsw + _i * 8192), 16, 0, 0); } while (0)
#define PG8_LDA(dst, b, h) do { _Pragma("unroll") for (int m = 0; m < 4; ++m) { if constexpr (FP8) dst##8[m] = cat8(*(const PG8_LAS bf16x8*)(lds + PG8_SA(b, h) + aoff + m * 2048), *(const PG8_LAS bf16x8*)(lds + PG8_SA(b, h) + aoff + m * 2048 + 1024)); \
        else { _Pragma("unroll") for (int k = 0; k < 2; ++k) dst[m][k] = *(const PG8_LAS bf16x8*)(lds + PG8_SA(b, h) + aoff + m * 2048 + k * 1024); } } } while (0)
#define PG8_LDB(dst, b, h) do { _Pragma("unroll") for (int n = 0; n < 2; ++n) { if constexpr (FP8) dst##8[n] = cat8(*(const PG8_LAS bf16x8*)(lds + PG8_SB(b, h) + boff + n * 2048), *(const PG8_LAS bf16x8*)(lds + PG8_SB(b, h) + boff + n * 2048 + 1024)); \
        else { _Pragma("unroll") for (int k = 0; k < 2; ++k) dst[n][k] = *(const PG8_LAS bf16x8*)(lds + PG8_SB(b, h) + boff + n * 2048 + k * 1024); } } } while (0)
#define PG8_MMA(ai, bj, At, Bt) do { __builtin_amdgcn_s_setprio(1); _Pragma("unroll") for (int m = 0; m < 4; ++m) _Pragma("unroll") for (int n = 0; n < 2; ++n) { \
        if constexpr (FP8) acc[ai][bj][m][n] = __builtin_amdgcn_mfma_scale_f32_16x16x128_f8f6f4(Bt##8[n], At##8[m], acc[ai][bj][m][n], 0, 0, 0, 0x7f7f7f7f, 0, 0x7f7f7f7f); \
        else { _Pragma("unroll") for (int k = 0; k < 2; ++k) acc[ai][bj][m][n] = __builtin_amdgcn_mfma_f32_16x16x32_bf16(Bt[n][k], At[m][k], acc[ai][bj][m][n], 0, 0, 0); } } \
        if constexpr (FP8) { _Pragma("unroll") for (int m = 0; m < 4; ++m) _Pragma("unroll") for (int n = 0; n < 2; ++n) asm volatile("" : "+v"(acc[ai][bj][m][n])); }     \
        __builtin_amdgcn_s_setprio(0); } while (0)
#define PG8_WAIT_V(n) asm volatile("s_waitcnt vmcnt(" #n ")" ::: "memory")
#define PG8_WAIT_L(n) asm volatile("s_waitcnt lgkmcnt(" #n ")" ::: "memory")
#define PG8_BAR __builtin_amdgcn_s_barrier()
#define PG8_SCHED __builtin_amdgcn_sched_barrier(0)
    Unit cur, nxt; int ui = 0;
    if (!S.next(0, cur)) return;
    f32x4 acc[2][2][4][2];
#pragma unroll
    for (int a = 0; a < 2; ++a)
#pragma unroll
        for (int b = 0; b < 2; ++b)
#pragma unroll
            for (int m = 0; m < 4; ++m)
#pragma unroll
                for (int n = 0; n < 2; ++n) acc[a][b][m][n] = (f32x4){0.f, 0.f, 0.f, 0.f};
    bf16x8 At[4][2], B0[2][2], B1[2][2]; i32x8 At8[4], B08[2], B18[2];
    const char* cA = (const char*)g.A; const char* cB = (const char*)g.Bt + (size_t)cur.pn * tstep; PG8_TOKS(oc, 0);
    S.a_ready(cur);
    if constexpr (SP2) {
        PG8_STAGE(PG8_SB(0, 0), cB, voffB); PG8_STAGE(PG8_SB(0, 1), cB + hstep, voffB); PG8_STAGE(PG8_SA(0, 0), cA, oc[0]); PG8_STAGE(PG8_SA(0, 1), cA, oc[1]);
        if (wr == 1) PG8_BAR;
        PG8_WAIT_V(2); PG8_BAR;
        PG8_STAGE(PG8_SB(1, 0), cB + kstep, voffB); PG8_STAGE(PG8_SA(1, 0), cA + kstep, oc[0]); PG8_STAGE(PG8_SB(1, 1), cB + hstep + kstep, voffB);
        PG8_WAIT_V(6); PG8_BAR;
    } else {
        PG8_STAGE(PG8_SB(0, 0), cB, voffB); PG8_STAGE(PG8_SA(0, 0), cA, oc[0]); PG8_STAGE(PG8_SB(0, 1), cB + hstep, voffB); PG8_STAGE(PG8_SA(0, 1), cA + hstep, oc[0]);
        if (wr == 1) PG8_BAR;
        PG8_WAIT_V(4); PG8_BAR;
        PG8_STAGE(PG8_SB(1, 0), cB + kstep, voffB); PG8_STAGE(PG8_SA(1, 0), cA + kstep, oc[0]); PG8_STAGE(PG8_SB(1, 1), cB + hstep + kstep, voffB);
        PG8_WAIT_V(6); PG8_BAR;
    }
    for (;;) {
        const bool has_next = S.next(ui + 1, nxt);
        const char* nB = has_next ? (const char*)g.Bt + (size_t)nxt.pn * tstep : cB;
        for (int t = 0; t < nt; t += 2) {
            const bool last = (t == nt - 2);
            const char* a1 = cA + (size_t)(t + 1) * kstep;
            const char* a2 = last ? cA : cA + (size_t)(t + 2) * kstep; const char* b2 = last ? nB : cB + (size_t)(t + 2) * kstep;
            unsigned o2[2][2]; if (last && has_next) PG8_TOKS(o2, ui + 1); else { _Pragma("unroll") for (int _h = 0; _h < 2; ++_h) _Pragma("unroll") for (int _i = 0; _i < 2; ++_i) o2[_h][_i] = oc[_h][_i]; }
            const char* a3 = a2 + kstep; const char* b3 = b2 + kstep;
            if (last && has_next) S.a_ready(nxt);
            if constexpr (SP2) {
            PG8_LDB(B0, 0, 0); PG8_LDB(B1, 0, 1); PG8_SCHED; PG8_LDA(At, 0, 0); PG8_STAGE(PG8_SA(1, 1), a1, oc[1]);
            PG8_WAIT_V(8); PG8_WAIT_L(0); PG8_BAR; PG8_MMA(0, 0, At, B0); PG8_MMA(0, 1, At, B1); PG8_BAR; PG8_SCHED;
            PG8_LDA(At, 0, 1); PG8_STAGE(PG8_SB(0, 0), b2, voffB); PG8_STAGE(PG8_SB(0, 1), b2 + hstep, voffB); PG8_STAGE(PG8_SA(0, 0), a2, o2[0]);
            PG8_WAIT_V(8); PG8_WAIT_L(0); PG8_BAR; PG8_MMA(1, 0, At, B0); PG8_MMA(1, 1, At, B1); PG8_BAR; PG8_SCHED;
            PG8_LDB(B0, 1, 0); PG8_LDB(B1, 1, 1); PG8_SCHED; PG8_LDA(At, 1, 0); PG8_STAGE(PG8_SA(0, 1), a2, o2[1]);
            PG8_WAIT_V(8); PG8_WAIT_L(0); PG8_BAR; PG8_MMA(0, 0, At, B0); PG8_MMA(0, 1, At, B1); PG8_BAR; PG8_SCHED;
            PG8_LDA(At, 1, 1); PG8_STAGE(PG8_SB(1, 0), b3, voffB); PG8_STAGE(PG8_SB(1, 1), b3 + hstep, voffB); PG8_STAGE(PG8_SA(1, 0), a3, o2[0]);
            PG8_WAIT_V(8); PG8_WAIT_L(0); PG8_BAR; PG8_MMA(1, 0, At, B0); PG8_MMA(1, 1, At, B1); PG8_BAR; PG8_SCHED;
            } else {
            PG8_LDB(B0, 0, 0); PG8_SCHED; PG8_LDA(At, 0, 0); PG8_STAGE(PG8_SA(1, 1), a1 + hstep, oc[0]);
            PG8_WAIT_L(8); PG8_BAR; PG8_WAIT_L(0); PG8_MMA(0, 0, At, B0); PG8_BAR; PG8_SCHED;
            PG8_LDB(B1, 0, 1); PG8_STAGE(PG8_SB(0, 0), b2, voffB);
            PG8_BAR; PG8_WAIT_L(0); PG8_MMA(0, 1, At, B1); PG8_BAR;
            PG8_LDA(At, 0, 1); PG8_STAGE(PG8_SA(0, 0), a2, oc[0]);
            PG8_BAR; PG8_WAIT_L(0); PG8_MMA(1, 0, At, B0); PG8_BAR; PG8_SCHED;
            PG8_STAGE(PG8_SB(0, 1), b2 + hstep, voffB);
            PG8_WAIT_V(6); PG8_BAR; PG8_MMA(1, 1, At, B1); PG8_BAR;
            PG8_LDB(B0, 1, 0); PG8_SCHED; PG8_LDA(At, 1, 0); PG8_STAGE(PG8_SA(0, 1), a2 + hstep, oc[0]);
            PG8_WAIT_L(8); PG8_BAR; PG8_WAIT_L(0); PG8_MMA(0, 0, At, B0); PG8_BAR; PG8_SCHED;
            PG8_LDB(B1, 1, 1); PG8_STAGE(PG8_SB(1, 0), b3, voffB);
            PG8_BAR; PG8_WAIT_L(0); PG8_MMA(0, 1, At, B1); PG8_BAR;
            PG8_LDA(At, 1, 1); PG8_STAGE(PG8_SA(1, 0), a3, oc[0]);
            PG8_BAR; PG8_WAIT_L(0); PG8_MMA(1, 0, At, B0); PG8_BAR; PG8_SCHED;
            PG8_STAGE(PG8_SB(1, 1), b3 + hstep, voffB);
            PG8_WAIT_V(6); PG8_BAR; PG8_MMA(1, 1, At, B1); PG8_BAR;
            }
        }
        if constexpr (ALIGN_EPI) { if (wr == 0) PG8_BAR; }
        if constexpr (!Epi::AFTER_DRAIN) { E(acc, cur, wr, wc, fr, fq); S.done(cur); }
        if (!has_next) break;
#pragma unroll
        for (int a = 0; a < 2; ++a)
#pragma unroll
            for (int b = 0; b < 2; ++b)
#pragma unroll
                for (int m = 0; m < 4; ++m)
#pragma unroll
                    for (int n = 0; n < 2; ++n) acc[a][b][m][n] = (f32x4){0.f, 0.f, 0.f, 0.f};
        cur = nxt; cB = nB; ++ui; PG8_TOKS(oc, ui);
        if constexpr (ALIGN_EPI) { if (wr == 1) PG8_BAR; }
    }
    PG8_WAIT_V(0);
    if constexpr (!ALIGN_EPI) { if (wr == 0) PG8_BAR; }
    PG8_BAR;
    if constexpr (Epi::AFTER_DRAIN) { E.fused(acc, cur, wr, wc, fr, fq, lds, wid, lane); S.done(cur); }
#undef PG8_TOKS
#undef PG8_SA
#undef PG8_SB
#undef PG8_STAGE
#undef PG8_LDA
#undef PG8_LDB
#undef PG8_MMA
#undef PG8_WAIT_V
#undef PG8_WAIT_L
#undef PG8_BAR
#undef PG8_SCHED
}
}

constexpr int BATCH = 16, SEQ = 2048, D = 1024, NMETA = 16;
constexpr int TV = SEQ + NMETA;
constexpr int NV = BATCH * TV;
constexpr int NTOK = BATCH * SEQ;
constexpr int NR = NTOK + NMETA;
constexpr int NIN = 5128, NPROJ = 5120;
constexpr int HW = 512;
constexpr int NE = 32, TOPK = 4, DFF = 1024;
constexpr int MAXTILES = 548;
constexpr float EPS = 1e-6f;
constexpr int NWAVES = 8, NTHREADS = 512;

constexpr size_t MiB = 1u << 20, KiB = 1u << 10;
constexpr size_t WS_CTL = 0, CTL_ZERO_BYTES = 1 * MiB;
constexpr size_t WS_WIN = 2 * MiB;
constexpr size_t WS_WBH = 12 * MiB, WS_WBM = 13 * MiB, WS_WOUT = 14 * MiB;
constexpr size_t WS_WGU = 16 * MiB;
constexpr size_t WS_WDN = 144 * MiB;
constexpr size_t WS_BGUP = 208 * MiB;
constexpr size_t WS_RWT = WS_BGUP + 256 * KiB;
constexpr size_t WS_TOPE = WS_RWT + 128 * KiB;
constexpr size_t WS_TOPP = WS_TOPE + 520 * KiB;
constexpr size_t WS_TOPW = WS_TOPP + 520 * KiB;
constexpr size_t WS_RS = WS_TOPW + 520 * KiB;
constexpr size_t WS_LI = WS_RS + 136 * KiB;
constexpr size_t WS_LF = WS_LI + 520 * KiB;
constexpr size_t WS_SLOTRS = WS_LF + 520 * KiB;
constexpr size_t WS_SLOTW = WS_SLOTRS + 552 * KiB;
constexpr size_t WS_XSQ = WS_SLOTW + 552 * KiB;
constexpr size_t WS_SMALL_END = WS_XSQ + 136 * KiB;
constexpr size_t WS_RA = 214 * MiB;
constexpr size_t WS_HQ = WS_RA, WS_HG = WS_RA + 33 * MiB, WS_HV = WS_RA + 99 * MiB, WS_HGATE = WS_RA + 132 * MiB, WS_MM = WS_RA + 165 * MiB, WS_MO = WS_RA + 198 * MiB, WS_GATES = WS_RA + 231 * MiB;
constexpr size_t WS_MERGED = WS_RA, WS_TMP = WS_RA + 66 * MiB, WS_H1B = WS_RA + 364 * MiB, WS_ACT = WS_RA;
constexpr size_t WS_RB = WS_RA + 364 * MiB;
constexpr size_t WS_QKVM = WS_RB, WS_CM = WS_RB + 130 * MiB, WS_YHG = WS_RB + 196 * MiB, WS_YML = WS_RB + 229 * MiB, WS_XS = WS_RB, WS_YB = WS_RB;
constexpr size_t WS_RC = WS_RB + 274 * MiB;
constexpr size_t WS_XN0 = WS_RC + 65 * MiB;
constexpr size_t WS_H1 = WS_RC, WS_ETOK = WS_RC + 130 * MiB, WS_ERS = WS_ETOK + 5 * MiB, WS_EW = WS_ERS + 5 * MiB, WS_END = WS_EW + 5 * MiB;
static_assert(WS_SMALL_END <= WS_RA && WS_END <= 1024 * MiB, "d_ws map");
static_assert((size_t)NV * HW * 2 <= 33 * MiB && (size_t)NV * HW * 4 <= 66 * MiB && (size_t)NV * 2048 * 2 <= 132 * MiB + MiB && (size_t)NV * D * 4 <= 130 * MiB && (size_t)MAXTILES * 256 * D * 2 <= 274 * MiB, "d_ws sizes");
static_assert((size_t)NE * NV * 4 <= 5 * MiB, "per-expert lists");
static_assert((size_t)NR * D * 2 <= 65 * MiB && (size_t)NR * 4 <= 136 * KiB, "H1 / XN0 / XSQ");
constexpr int CW_TMO = 0, CW_CNT = 64  , CW_BAR = 4096;

constexpr int RING_OFF = 0, RING_BYTES = 131072;
constexpr int MISC_OFF = RING_BYTES;
constexpr int TEXP_OFF = MISC_OFF + 256;
constexpr int PST_OFF = TEXP_OFF + 640;
constexpr int TOK_OFF = PST_OFF + 384;
constexpr int LDS_BYTES = 147456;
static_assert(TOK_OFF + 18 * 512 <= LDS_BYTES, "LDS map");

#define GAS __attribute__((address_space(1)))
#define LAS __attribute__((address_space(3)))
typedef unsigned short bf16;
typedef unsigned v4u __attribute__((ext_vector_type(4)));
typedef unsigned v2u __attribute__((ext_vector_type(2)));
typedef float f32x4 __attribute__((ext_vector_type(4)));
typedef GAS unsigned gu32;
#define RLX_AGENT __ATOMIC_RELAXED, __HIP_MEMORY_SCOPE_AGENT
#define LDS_WAIT() asm volatile("s_waitcnt lgkmcnt(0)" ::: "memory")
#define VM_WAIT() asm volatile("s_waitcnt vmcnt(0)" ::: "memory")
__device__ __forceinline__ unsigned pk2(float lo, float hi) { return pg8::cvt_pk_bf16(lo, hi); }
__device__ __forceinline__ unsigned f2bf(float f) { return pg8::cvt_pk_bf16(f, 0.f) & 0xffffu; }
__device__ __forceinline__ float bflo(unsigned w) { return __builtin_bit_cast(float, w << 16); }
__device__ __forceinline__ float bfhi(unsigned w) { return __builtin_bit_cast(float, w & 0xffff0000u); }
__device__ __forceinline__ float bf1(bf16 h) { return __builtin_bit_cast(float, (unsigned)h << 16); }
__device__ __forceinline__ float fsigmoid(float x) { return __builtin_amdgcn_rcpf(1.0f + __expf(-x)); }
__device__ __forceinline__ float fsilu(float x) { return x * fsigmoid(x); }
__device__ __forceinline__ size_t rowof(int b, int tt) { return tt < NMETA ? (size_t)(NTOK + tt) : (size_t)b * SEQ + (tt - NMETA); }
__host__ __device__ __forceinline__ int gu_slot(int j) { const int g = (j >> 3) & 3, p = ((g & 1) << 1) | (g >> 1); return (j & ~31) + 8 * p + (j & 7); }
__device__ __forceinline__ float wave_sum(float v) {
#pragma unroll
    for (int o = 1; o < 64; o <<= 1) v += __shfl_xor(v, o);
    return v;
}
__device__ __forceinline__ float wave_max(float v) {
#pragma unroll
    for (int o = 1; o < 64; o <<= 1) v = fmaxf(v, __shfl_xor(v, o));
    return v;
}
#define XB_TMO      128
#define XB_XCNT(j)  (256  + 64 * (j))
#define XB_XSUB(j)  (1280 + 64 * (j))
#define XB_XGEN(j)  (2304 + 64 * (j))
#define XB_TOP      3328
#define XB_TOPGEN   3392
#define XCD_BAR_WORDS 3456
#define XB_SPIN_CAP (1u << 18)

__device__ __forceinline__ unsigned xb_ld(unsigned* p)              { return __hip_atomic_load(p, __ATOMIC_RELAXED, __HIP_MEMORY_SCOPE_AGENT); }
__device__ __forceinline__ unsigned xb_add(unsigned* p, unsigned v) { return __hip_atomic_fetch_add(p, v, __ATOMIC_RELAXED, __HIP_MEMORY_SCOPE_AGENT); }
__device__ __forceinline__ unsigned xb_xcc_id() { return (unsigned)__builtin_amdgcn_s_getreg((3 << 11) | 20) & 0xFu; }
#define XB_SPIN(cond, bar) do { unsigned _sp = 0; while (cond) { __builtin_amdgcn_s_sleep(1); \
    if ((++_sp & 255u) == 0u) { if (xb_ld(&(bar)[XB_TMO])) break; if (_sp > XB_SPIN_CAP) { atomicAdd(&(bar)[XB_TMO], 1u); break; } } } } while (0)

struct XcdBarrier {
    unsigned* bar; unsigned x;
    volatile LAS unsigned* st;
};

__device__ __forceinline__ XcdBarrier xcd_barrier_post(unsigned* bar, volatile LAS unsigned* st) {
    XcdBarrier b; b.bar = bar; b.x = xb_xcc_id(); b.st = st;
    if (threadIdx.x == 0) (void)xb_add(&bar[XB_XCNT(b.x)], 1u);
    return b;
}
__device__ __forceinline__ void xcd_barrier_complete(unsigned* bar, unsigned x, unsigned& nloc, unsigned& nx) {
    const unsigned G = gridDim.x * gridDim.y * gridDim.z;
    unsigned sum, cnt, mine, sp = 0u;
    for (;;) {
        sum = 0u; cnt = 0u; mine = 0u;
#pragma unroll
        for (unsigned j = 0; j < 16; ++j) { const unsigned c = xb_ld(&bar[XB_XCNT(j)]); sum += c; cnt += (c > 0u) ? 1u : 0u; mine = (j == x) ? c : mine; }
        if (sum == G) break;
        __builtin_amdgcn_s_sleep(1);
        if ((++sp & 255u) == 0u) { if (xb_ld(&bar[XB_TMO])) break; if (sp > XB_SPIN_CAP) { atomicAdd(&bar[XB_TMO], 1u); break; } }
    }
    nloc = mine > 0u ? mine : 1u; nx = cnt > 0u ? cnt : 1u;
}

__device__ __forceinline__ void xcd_barrier(const XcdBarrier& b) {
    asm volatile("s_waitcnt vmcnt(0)" ::: "memory");
    __syncthreads();
    if (threadIdx.x == 0) {
        unsigned* bar = b.bar;
        __builtin_amdgcn_s_waitcnt(0);
        unsigned nloc = b.st[0], nx = b.st[1];
        if (nloc == 0u) { xcd_barrier_complete(bar, b.x, nloc, nx); b.st[0] = nloc; b.st[1] = nx; }
        const unsigned old = xb_add(&bar[XB_XSUB(b.x)], 1u);
        const unsigned gen = old / nloc;
        if (old + 1u == (gen + 1u) * nloc) {
            __builtin_amdgcn_fence(__ATOMIC_RELEASE, "agent");
            asm volatile("s_waitcnt vmcnt(0)" ::: "memory");
            const unsigned og = xb_add(&bar[XB_TOP], 1u);
            const unsigned tg = og / nx;
            if (og + 1u == (tg + 1u) * nx) xb_add(&bar[XB_TOPGEN], 1u);
            else XB_SPIN(xb_ld(&bar[XB_TOPGEN]) == tg, bar);
            __builtin_amdgcn_fence(__ATOMIC_ACQUIRE, "agent");
            xb_add(&bar[XB_XGEN(b.x)], 1u);
            asm volatile("s_waitcnt vmcnt(0)" ::: "memory");
        } else {
            XB_SPIN(xb_ld(&bar[XB_XGEN(b.x)]) == gen, bar);
            __builtin_amdgcn_fence(__ATOMIC_ACQUIRE, "agent");
            asm volatile("s_waitcnt vmcnt(0)" ::: "memory");
        }
    }
    __syncthreads();
}

struct Frame {
    LAS unsigned char* lds;
    volatile LAS unsigned* MISC;
    gu32* ctl;
    int tid, lane, wave, vcu, G;
    const float* in[25];
    float* out;
    unsigned char* ws;
};
#define IN_X 0
#define IN_META 1
#define IN_LBL 2
#define IN_NMIX 3
#define IN_WIN 4
#define IN_HGNORM 5
#define IN_CONVW 6
#define IN_CONVB 7
#define IN_WQ 8
#define IN_WK 9
#define IN_WV 10
#define IN_GATEB 11
#define IN_MLNORM 12
#define IN_MLSKIP 13
#define IN_WBH 14
#define IN_WBM 15
#define IN_WOUT 16
#define IN_NFFN 17
#define IN_RW 18
#define IN_RB 19
#define IN_WGU 20
#define IN_BGU 21
#define IN_WDN 22
#define IN_BDN 23
#define IN_NFIN 24

__device__ __forceinline__ void p0_item(const float* W, int ldw, int col0, int cstride, const float* kscale, bf16* WT, int K, int dstrow0, int k0, LAS float* scr, int lane) {
    (void)cstride;
    const int r = lane >> 3, c4 = (lane & 7) * 4;
    f32x4 v[8];
#pragma unroll
    for (int i = 0; i < 8; ++i) v[i] = *(const GAS f32x4*)(W + (size_t)(k0 + 8 * i + r) * ldw + col0 + c4);
#pragma unroll
    for (int i = 0; i < 8; ++i) { const float sc = kscale ? kscale[k0 + 8 * i + r] : 1.f; LAS float* s = scr + (8 * i + r) * 33 + c4; s[0] = v[i].x * sc; s[1] = v[i].y * sc; s[2] = v[i].z * sc; s[3] = v[i].w * sc; }
    LDS_WAIT(); asm volatile("" ::: "memory");
    const int c = lane & 7;
#pragma unroll
    for (int j = 0; j < 4; ++j) { const int n = (lane >> 3) + 8 * j; const LAS float* s = scr + (8 * c) * 33 + n;
        v4u o; o.x = pk2(s[0 * 33], s[1 * 33]); o.y = pk2(s[2 * 33], s[3 * 33]); o.z = pk2(s[4 * 33], s[5 * 33]); o.w = pk2(s[6 * 33], s[7 * 33]);
        *(GAS v4u*)(WT + (size_t)(dstrow0 + n) * K + k0 + 8 * c) = o; }
    LDS_WAIT(); asm volatile("" ::: "memory");
}
__device__ __forceinline__ void p0_prologue(Frame& F) {
    unsigned char* ws = F.ws;
    const int gw = F.vcu * NWAVES + F.wave, NGW = F.G * NWAVES, gt = F.vcu * NTHREADS + F.tid, NGT = F.G * NTHREADS;
    {
        LAS float* wm = (LAS float*)(F.lds + RING_OFF + 65536);
        { float wa[16], wb[16];
#pragma unroll
          for (int q = 0; q < 16; ++q) { const int u = F.tid + q * NTHREADS, j = u & 7, l = (u >> 3) & 63, i = u >> 9, k = 4 * l + 256 * (i >> 2) + (i & 3); wa[q] = F.in[IN_NMIX][k]; wb[q] = F.in[IN_WIN][(size_t)k * NIN + 3072 + j]; }
#pragma unroll
          for (int q = 0; q < 16; ++q) wm[F.tid + q * NTHREADS] = wa[q] * wb[q]; }
        __syncthreads();
        bf16* XN0 = (bf16*)(ws + WS_XN0); float* XSQ = (float*)(ws + WS_XSQ); float* LI = (float*)(ws + WS_LI); float* LF = (float*)(ws + WS_LF);
        f32x4 vn[4];
#define P0_LOADROW(dst, V_) do { const int Vc_ = (V_) < NR ? (V_) : NR - 1; const float* src_ = (Vc_ >= NTOK) ? F.in[IN_META] + (size_t)(Vc_ - NTOK) * D : F.in[IN_X] + (size_t)Vc_ * D; \
        const GAS f32x4* xr_ = (const GAS f32x4*)src_ + F.lane; _Pragma("unroll") for (int j = 0; j < 4; ++j) dst[j] = xr_[64 * j]; } while (0)
        P0_LOADROW(vn, gw);
        for (int V = gw; V < NR; V += NGW) {
            f32x4 v[4]; float s = 0.f;
#pragma unroll
            for (int j = 0; j < 4; ++j) { v[j] = vn[j]; s += (v[j].x * v[j].x + v[j].y * v[j].y) + (v[j].z * v[j].z + v[j].w * v[j].w); }
            P0_LOADROW(vn, V + NGW);
            asm volatile("" ::: "memory");
            const float sq = sqrtf(wave_sum(s) * (1.f / D) + EPS), rs = 1.0f / sq;
            if (F.lane == 0) XSQ[V] = sq;
            float g[8];
#pragma unroll
            for (int j = 0; j < 8; ++j) g[j] = 0.f;
            GAS unsigned long long* o8 = (GAS unsigned long long*)(XN0 + (size_t)V * D) + F.lane;
#pragma unroll
            for (int j = 0; j < 4; ++j) {
                v[j] = v[j] * rs;
                o8[64 * j] = (unsigned long long)pk2(v[j].x, v[j].y) | ((unsigned long long)pk2(v[j].z, v[j].w) << 32);
#pragma unroll
                for (int q = 0; q < 4; ++q) { const LAS f32x4* wp = (const LAS f32x4*)(wm + (((4 * j + q) * 64 + F.lane) * 8)); const f32x4 w0 = wp[0], w1 = wp[1]; const float xv = v[j][q];
                    g[0] += xv * w0.x; g[1] += xv * w0.y; g[2] += xv * w0.z; g[3] += xv * w0.w; g[4] += xv * w1.x; g[5] += xv * w1.y; g[6] += xv * w1.z; g[7] += xv * w1.w; }
            }
#pragma unroll
            for (int j = 0; j < 8; ++j) g[j] = wave_sum(g[j]);
            if (F.lane < 4) {
                const float gi = (F.lane == 0 ? g[0] : F.lane == 1 ? g[1] : F.lane == 2 ? g[2] : g[3]) + F.in[IN_GATEB][F.lane];
                const float gf = (F.lane == 0 ? g[4] : F.lane == 1 ? g[5] : F.lane == 2 ? g[6] : g[7]) + F.in[IN_GATEB][4 + F.lane];
                LI[(size_t)V * 4 + F.lane] = gi;
                LF[(size_t)V * 4 + F.lane] = fminf(gf, 0.f) - log1pf(__expf(-fabsf(gf)));
            }
        }
        __syncthreads();
    }
    {
        LAS float* scr = (LAS float*)(F.lds + RING_OFF + F.wave * 16384);
        constexpr int I_IN1 = 16 * 96, I_IN2 = 16 * 64, I_BH = 8 * 32, I_OUT = 16 * 32;
        constexpr int NITEMS = I_IN1 + I_IN2 + 2 * I_BH + I_OUT;
        for (int it = gw; it < NITEMS; it += NGW) {
            int r = it;
            if (r < I_IN1) { const int kb = r / 96, nb = r % 96; p0_item(F.in[IN_WIN], NIN, 32 * nb, 1, F.in[IN_NMIX], (bf16*)(ws + WS_WIN), D, 32 * nb, 64 * kb, scr, F.lane); continue; } r -= I_IN1;
            if (r < I_IN2) { const int kb = r / 64, nb = r % 64; p0_item(F.in[IN_WIN], NIN, 3080 + 32 * nb, 1, F.in[IN_NMIX], (bf16*)(ws + WS_WIN), D, 3072 + 32 * nb, 64 * kb, scr, F.lane); continue; } r -= I_IN2;
            if (r < I_BH) { const int kb = r / 32, nb = r % 32; p0_item(F.in[IN_WBH], D, 32 * nb, 1, nullptr, (bf16*)(ws + WS_WBH), HW, 32 * nb, 64 * kb, scr, F.lane); continue; } r -= I_BH;
            if (r < I_BH) { const int kb = r / 32, nb = r % 32; p0_item(F.in[IN_WBM], D, 32 * nb, 1, nullptr, (bf16*)(ws + WS_WBM), HW, 32 * nb, 64 * kb, scr, F.lane); continue; } r -= I_BH;
            { const int kb = r / 32, nb = r % 32; p0_item(F.in[IN_WOUT], D, 32 * nb, 1, nullptr, (bf16*)(ws + WS_WOUT), D, 32 * nb, 64 * kb, scr, F.lane); }
        }
    }
    { float* BGUP = (float*)(ws + WS_BGUP); float* RWT = (float*)(ws + WS_RWT);
      for (int u = gt; u < NE * 2 * DFF; u += NGT) { const int e = u >> 11, n = u & 2047, pn = n >> 8, bj = (n >> 7) & 1, j = gu_slot(n & 127); BGUP[u] = F.in[IN_BGU][(size_t)e * 2 * DFF + 2 * (128 * pn + j) + bj]; }
      for (int u = gt; u < NE * D; u += NGT) { const int e = u >> 10, k = u & 1023; RWT[u] = F.in[IN_NFFN][k] * F.in[IN_RW][(size_t)k * NE + e]; } }
}

__device__ __forceinline__ unsigned pk4_fp8(float a, float b, float c, float d) { unsigned w = 0;
    a = __builtin_amdgcn_fmed3f(a, -448.f, 448.f); b = __builtin_amdgcn_fmed3f(b, -448.f, 448.f); c = __builtin_amdgcn_fmed3f(c, -448.f, 448.f); d = __builtin_amdgcn_fmed3f(d, -448.f, 448.f);
    w = __builtin_amdgcn_cvt_pk_fp8_f32(a, b, w, false); w = __builtin_amdgcn_cvt_pk_fp8_f32(c, d, w, true); return w; }
__device__ __forceinline__ void cvdn_load(const float* Wdn, int it, f32x4 (&v)[8], int lane) {
    const int e = it >> 9, kb = (it >> 5) & 15, nb = it & 31, r = lane >> 3, c4 = (lane & 7) * 4; const float* W = Wdn + (size_t)e * DFF * D;
#pragma unroll
    for (int i = 0; i < 8; ++i) v[i] = *(const GAS f32x4*)(W + (size_t)(64 * kb + 8 * i + r) * D + 32 * nb + c4);
}
__device__ __forceinline__ void cvdn_proc(unsigned char* WTdn, int it, const f32x4 (&v)[8], LAS float* scr, int lane) {
    const int e = it >> 9, kb = (it >> 5) & 15, nb = it & 31, r = lane >> 3, c4 = (lane & 7) * 4; unsigned char* WT = WTdn + (size_t)e * D * DFF;
#pragma unroll
    for (int i = 0; i < 8; ++i) { LAS float* s = scr + (8 * i + r) * 33 + c4; s[0] = v[i].x * 32.f; s[1] = v[i].y * 32.f; s[2] = v[i].z * 32.f; s[3] = v[i].w * 32.f; }
    LDS_WAIT(); asm volatile("" ::: "memory");
    const int c = lane & 7;
#pragma unroll
    for (int j = 0; j < 4; ++j) { const int n = (lane >> 3) + 8 * j; const LAS float* s = scr + (8 * c) * 33 + n;
        v2u o; o.x = pk4_fp8(s[0 * 33], s[1 * 33], s[2 * 33], s[3 * 33]); o.y = pk4_fp8(s[4 * 33], s[5 * 33], s[6 * 33], s[7 * 33]);
        const int cn = 32 * nb + n, rowp = (cn & ~255) + 128 * ((cn >> 3) & 1) + 32 * ((cn >> 6) & 3) + 8 * ((cn >> 4) & 3) + (cn & 7);
        *(GAS v2u*)(WT + (size_t)rowp * DFF + 64 * kb + 8 * c) = o; }
    LDS_WAIT(); asm volatile("" ::: "memory");
}
__device__ __forceinline__ void cvgu_load(const float* Wgu, const float* nffn, int it, f32x4 (&v)[8], float (&sc)[8], int lane) {
    const int e = it >> 10, kb = (it >> 5) & 31, nb = it & 31, r = lane >> 4, c4 = (lane & 15) * 4; const float* W = Wgu + (size_t)e * D * 2 * DFF;
#pragma unroll
    for (int i = 0; i < 8; ++i) { v[i] = *(const GAS f32x4*)(W + (size_t)(32 * kb + 4 * i + r) * (2 * DFF) + 64 * nb + c4); sc[i] = nffn[32 * kb + 4 * i + r] * 32.f; }
}
__device__ __forceinline__ void cvgu_proc(unsigned char* WTgu, int it, const f32x4 (&v)[8], const float (&sc)[8], LAS float* scr, int lane) {
    const int e = it >> 10, kb = (it >> 5) & 31, nb = it & 31, r = lane >> 4, c4 = (lane & 15) * 4, A0 = 32 * nb, k0 = 32 * kb; unsigned char* WT = WTgu + (size_t)e * 2 * DFF * D;
    LAS float* sg = scr; LAS float* su = scr + 32 * 33;
#pragma unroll
    for (int i = 0; i < 8; ++i) { const int o = (4 * i + r) * 33 + (c4 >> 1); sg[o] = v[i].x * sc[i]; su[o] = v[i].y * sc[i]; sg[o + 1] = v[i].z * sc[i]; su[o + 1] = v[i].w * sc[i]; }
    LDS_WAIT(); asm volatile("" ::: "memory");
    const int c = lane & 3;
#pragma unroll
    for (int j = 0; j < 4; ++j) { const int q = (lane >> 2) + 16 * j, isup = q >> 5, jj = q & 31, A = A0 + jj; const LAS float* s = scr + isup * 32 * 33 + (8 * c) * 33 + jj;
        v2u o; o.x = pk4_fp8(s[0 * 33], s[1 * 33], s[2 * 33], s[3 * 33]); o.y = pk4_fp8(s[4 * 33], s[5 * 33], s[6 * 33], s[7 * 33]);
        *(GAS v2u*)(WT + (size_t)(256 * (A >> 7) + 128 * isup + gu_slot(A & 127)) * D + k0 + 8 * c) = o; }
    LDS_WAIT(); asm volatile("" ::: "memory");
}
__device__ __forceinline__ void px_experts(Frame& F, int rank, int nwg) {
    unsigned char* ws = F.ws;
    LAS float* scr = (LAS float*)(F.lds + RING_OFF + F.wave * 16384);
    const int gw = rank * NWAVES + F.wave, NGW = nwg * NWAVES;
    { constexpr int NIT = NE * 1024; f32x4 v[8], vn[8]; float sc[8], sn[8]; int it = gw;
      if (it < NIT) cvgu_load(F.in[IN_WGU], F.in[IN_NFFN], it, v, sc, F.lane);
      while (it < NIT) { const int nx = it + NGW; if (nx < NIT) cvgu_load(F.in[IN_WGU], F.in[IN_NFFN], nx, vn, sn, F.lane);
          asm volatile("" ::: "memory");
          cvgu_proc((unsigned char*)(ws + WS_WGU), it, v, sc, scr, F.lane); asm volatile("" ::: "memory");
#pragma unroll
          for (int i = 0; i < 8; ++i) { v[i] = vn[i]; sc[i] = sn[i]; }
          it = nx; } }
    { constexpr int NIT = NE * 512; f32x4 v[8], vn[8]; int it = gw;
      if (it < NIT) cvdn_load(F.in[IN_WDN], it, v, F.lane);
      while (it < NIT) { const int nx = it + NGW; if (nx < NIT) cvdn_load(F.in[IN_WDN], nx, vn, F.lane);
          asm volatile("" ::: "memory");
          cvdn_proc((unsigned char*)(ws + WS_WDN), it, v, scr, F.lane); asm volatile("" ::: "memory");
#pragma unroll
          for (int i = 0; i < 8; ++i) v[i] = vn[i];
          it = nx; } }
}

namespace pg8 {
typedef unsigned v2u_t __attribute__((ext_vector_type(2)));
__device__ __forceinline__ u32x4 pack8(const f32x4& a, const f32x4& b) { u32x4 w; w.x = cvt_pk_bf16(a[0], a[1]); w.y = cvt_pk_bf16(a[2], a[3]); w.z = cvt_pk_bf16(b[0], b[1]); w.w = cvt_pk_bf16(b[2], b[3]); return w; }
__device__ __forceinline__ v2u_t pack8_fp8(const f32x4& a, const f32x4& b) { unsigned lo = 0, hi = 0;
    lo = __builtin_amdgcn_cvt_pk_fp8_f32(a[0], a[1], lo, false); lo = __builtin_amdgcn_cvt_pk_fp8_f32(a[2], a[3], lo, true);
    hi = __builtin_amdgcn_cvt_pk_fp8_f32(b[0], b[1], hi, false); hi = __builtin_amdgcn_cvt_pk_fp8_f32(b[2], b[3], hi, true); return (v2u_t){lo, hi}; }
__device__ __forceinline__ v2u_t pack8_fp8_sat(const f32x4& a, const f32x4& b) { f32x4 x, y;
#pragma unroll
    for (int i = 0; i < 4; ++i) { x[i] = __builtin_amdgcn_fmed3f(a[i], -448.f, 448.f); y[i] = __builtin_amdgcn_fmed3f(b[i], -448.f, 448.f); }
    return pack8_fp8(x, y); }
__device__ __forceinline__ void unpack8(const u32x4& w, f32x4& a, f32x4& b) { a = (f32x4){bflo(w.x), bfhi(w.x), bflo(w.y), bfhi(w.y)}; b = (f32x4){bflo(w.z), bfhi(w.z), bflo(w.w), bfhi(w.w)}; }
__host__ __device__ __forceinline__ int gate_pos(int c) { return (c & ~255) + ((((c >> 5) & 3) * 4 + ((c >> 3) & 3)) * 16) + (((c >> 7) & 1) * 8) + (c & 7); }
__device__ __forceinline__ unsigned q8x4(float a, float b, float c, float d) {
    const unsigned t0 = __builtin_bit_cast(unsigned, __builtin_fmaf(a, 255.f, 8388608.f)), t1 = __builtin_bit_cast(unsigned, __builtin_fmaf(b, 255.f, 8388608.f));
    const unsigned t2 = __builtin_bit_cast(unsigned, __builtin_fmaf(c, 255.f, 8388608.f)), t3 = __builtin_bit_cast(unsigned, __builtin_fmaf(d, 255.f, 8388608.f));
    return __builtin_amdgcn_perm(t1, t0, 0x0c0c0400u) | __builtin_amdgcn_perm(t3, t2, 0x04000c0cu); }
__device__ __forceinline__ f32x4 dq8x4(unsigned w) { return (f32x4){(float)(w & 0xffu), (float)((w >> 8) & 0xffu), (float)((w >> 16) & 0xffu), (float)(w >> 24)}; }
struct EpiProj {
    static constexpr bool PERM = true, AFTER_DRAIN = false;
    unsigned char* ws; const float* lbl;
    __device__ __forceinline__ void operator()(const f32x4 (&acc)[2][2][4][2], const Unit& u, int wr, int wc, int fr, int fq) const {
        const int row0 = u.pm * BM + wr * 64 + fr, kind = u.pn < 12 ? (u.pn >> 1) : 6;
        const int colt = (u.pn < 12 ? (u.pn & 1) : (u.pn - 12)) * BM + wc * 32 + 8 * fq;
        if (kind == 1) {
            float* HG = (float*)(ws + WS_HG);
#pragma unroll
            for (int bj = 0; bj < 2; ++bj) { const int c = colt + bj * HALF; float lb[8];
#pragma unroll
                for (int i = 0; i < 8; ++i) lb[i] = fsigmoid(lbl[c + i] - lbl[HW + c + i]);
#pragma unroll
                for (int ai = 0; ai < 2; ++ai)
#pragma unroll
                    for (int m = 0; m < 4; ++m) { float* rowp = HG + (size_t)(row0 + ai * HALF + m * 16) * HW + c; f32x4 o0, o1;
#pragma unroll
                        for (int i = 0; i < 4; ++i) { o0[i] = __logf(lb[i] + (1.f - lb[i]) * fsigmoid(acc[ai][bj][m][0][i])); o1[i] = __logf(lb[4 + i] + (1.f - lb[4 + i]) * fsigmoid(acc[ai][bj][m][1][i])); }
                        *(f32x4*)rowp = o0; *(f32x4*)(rowp + 4) = o1; } }
            return;
        }
        if (kind == 6) {
            unsigned char* G8 = ws + WS_GATES; const int gofs = (u.pn - 12) * BM + (wc * 4 + fq) * 16;
#pragma unroll
            for (int ai = 0; ai < 2; ++ai)
#pragma unroll
                for (int m = 0; m < 4; ++m) { u32x4 o;
#pragma unroll
                    for (int bj = 0; bj < 2; ++bj) { const f32x4 v0 = acc[ai][bj][m][0], v1 = acc[ai][bj][m][1];
                        o[2 * bj] = q8x4(fsigmoid(v0[0]), fsigmoid(v0[1]), fsigmoid(v0[2]), fsigmoid(v0[3])); o[2 * bj + 1] = q8x4(fsigmoid(v1[0]), fsigmoid(v1[1]), fsigmoid(v1[2]), fsigmoid(v1[3])); }
                    *(u32x4*)(G8 + (size_t)(row0 + ai * HALF + m * 16) * 2048 + gofs) = o; }
            return;
        }
        bf16_t* O; constexpr int ldc = HW; int act = 0;
        if (kind == 0) { O = (bf16_t*)(ws + WS_HQ); act = 1; } else if (kind == 2) { O = (bf16_t*)(ws + WS_HV); } else if (kind == 3) { O = (bf16_t*)(ws + WS_HGATE); act = 1; }
        else if (kind == 4) { O = (bf16_t*)(ws + WS_MM); } else { O = (bf16_t*)(ws + WS_MO); act = 2; }
#pragma unroll
        for (int ai = 0; ai < 2; ++ai)
#pragma unroll
            for (int m = 0; m < 4; ++m) { bf16_t* rowp = O + (size_t)(row0 + ai * HALF + m * 16) * ldc + colt;
#pragma unroll
                for (int bj = 0; bj < 2; ++bj) { f32x4 v0 = acc[ai][bj][m][0], v1 = acc[ai][bj][m][1];
                    if (act) {
#pragma unroll
                        for (int i = 0; i < 4; ++i) { const float s0 = fsigmoid(v0[i]), s1 = fsigmoid(v1[i]); v0[i] = act == 1 ? v0[i] * s0 : s0; v1[i] = act == 1 ? v1[i] * s1 : s1; } }
                    *(u32x4*)(rowp + bj * HALF) = pack8(v0, v1); } }
    }
};
constexpr int PAIR_DA = 132, PAIR_DB = 4;
struct PairOrder { StaticOrder S;
    __device__ __forceinline__ bool next(int i, Unit& u) const { Unit t; if (!S.next(i >> 1, t)) return false; const int s = i & 1; u.pm = t.pm + PAIR_DA * s; u.pn = t.pn + PAIR_DB * s; return true; }
    __device__ __forceinline__ void a_ready(const Unit&) const {}
    __device__ __forceinline__ void done(const Unit&) const {}
};
struct EpiGate2 {
    static constexpr bool PERM = true, AFTER_DRAIN = false;
    const unsigned char* __restrict__ gates; bf16_t* __restrict__ tmp; bf16_t* __restrict__ merged;
    __device__ __forceinline__ void operator()(const f32x4 (&acc)[2][2][4][2], const Unit& u, int wr, int wc, int fr, int fq) const {
        const int step = u.pm >= PAIR_DA ? 1 : 0, pm = u.pm - PAIR_DA * step, pn = u.pn - PAIR_DB * step;
        const int row0 = pm * BM + wr * 64 + fr, col0 = pn * BM + wc * 32 + 8 * fq, gofs = step * D + pn * BM + (wc * 4 + fq) * 16;
        constexpr int NB = 2, NBAT = 8 / NB;
        bf16_t* obuf = tmp + (ptrdiff_t)(merged - tmp) * step;
        u32x4 gc[NB], tc[NB][2], gn[NB], tn[NB][2];
#define EG_LOAD(G, T, b_) do { _Pragma("unroll") for (int s_ = 0; s_ < NB; ++s_) { const int it_ = (b_) * NB + s_; const size_t row_ = (size_t)(row0 + (it_ >> 2) * HALF + (it_ & 3) * 16); G[s_] = *(const u32x4*)(gates + row_ * 2048 + gofs); _Pragma("unroll") for (int bj = 0; bj < 2; ++bj) { \
        if (step) T[s_][bj] = *(const u32x4*)(tmp + row_ * D + col0 + bj * HALF); else T[s_][bj] = (u32x4){0u, 0u, 0u, 0u}; } } } while (0)
        EG_LOAD(gc, tc, 0);
#pragma unroll
        for (int b = 0; b < NBAT; ++b) {
            if (b + 1 < NBAT) EG_LOAD(gn, tn, b + 1);
#pragma unroll
            for (int s = 0; s < NB; ++s) { const int it = b * NB + s, ai = it >> 2, m = it & 3; const size_t row = (size_t)(row0 + ai * HALF + m * 16);
#pragma unroll
                for (int bj = 0; bj < 2; ++bj) { const int c = col0 + bj * HALF; f32x4 t0, t1; unpack8(tc[s][bj], t0, t1); const f32x4 g0 = dq8x4(gc[s][2 * bj]), g1 = dq8x4(gc[s][2 * bj + 1]);
                    const u32x4 o = pack8((acc[ai][bj][m][0] * g0) * (1.f / 255.f) + t0, (acc[ai][bj][m][1] * g1) * (1.f / 255.f) + t1);
                    *(u32x4*)(obuf + row * D + c) = o; } }
#pragma unroll
            for (int s = 0; s < NB; ++s)
#pragma unroll
                for (int bj = 0; bj < 2; ++bj) tc[s][bj] = tn[s][bj];
#pragma unroll
            for (int s = 0; s < NB; ++s) gc[s] = gn[s]; }
#undef EG_LOAD
    }
};
struct EpiH1 {
    static constexpr bool PERM = true, AFTER_DRAIN = false;
    const bf16_t* __restrict__ xn0; const float* __restrict__ xsq; bf16_t* __restrict__ H1; unsigned char* __restrict__ H1B8;
    __device__ __forceinline__ void operator()(const f32x4 (&acc)[2][2][4][2], const Unit& u, int wr, int wc, int fr, int fq) const {
        const int row0 = u.pm * BM + wr * 64 + fr, col0 = u.pn * BM + wc * 32 + 8 * fq;
        u32x4 xc[2], xn[2]; float sc, sn;
#define EH_LOAD(X, S_, it_) do { const size_t r_ = (size_t)(row0 + ((it_) >> 2) * HALF + ((it_) & 3) * 16); const bf16_t* src_ = xn0 + r_ * D + col0; S_ = xsq[r_]; _Pragma("unroll") for (int bj = 0; bj < 2; ++bj) X[bj] = *(const u32x4*)(src_ + bj * HALF); } while (0)
        EH_LOAD(xc, sc, 0);
#pragma unroll
        for (int it = 0; it < 8; ++it) { const int ai = it >> 2, m = it & 3; const size_t V = (size_t)(row0 + ai * HALF + m * 16);
            if (it + 1 < 8) EH_LOAD(xn, sn, it + 1);
#pragma unroll
            for (int bj = 0; bj < 2; ++bj) { const int c = col0 + bj * HALF; f32x4 x0, x1; unpack8(xc[bj], x0, x1);
                const f32x4 v0 = acc[ai][bj][m][0] + x0 * sc, v1 = acc[ai][bj][m][1] + x1 * sc;
                *(u32x4*)(H1 + V * D + c) = pack8(v0, v1); *(v2u_t*)(H1B8 + V * D + c) = pack8_fp8_sat(v0, v1); }
#pragma unroll
            for (int bj = 0; bj < 2; ++bj) xc[bj] = xn[bj];
            sc = sn; }
#undef EH_LOAD
    }
};
typedef float f32x2 __attribute__((ext_vector_type(2)));
struct EpiGU {
    static constexpr bool PERM = true, AFTER_DRAIN = false;
    const float* __restrict__ bgup; const float* __restrict__ ers; unsigned char* __restrict__ act; const PG8_LAS int* pst;
    __device__ __forceinline__ void operator()(const f32x4 (&acc)[2][2][4][2], const Unit& u, int wr, int wc, int fr, int fq) const {
        const int e = u.pn >> 3, pn = u.pn & 7, row0 = u.pm * BM + wr * 64 + fr, cc = wc * 32 + 8 * fq;
        const float* rsp = ers + (size_t)e * NV + (row0 - pst[e]);
        const float* bp = bgup + (size_t)e * 2 * DFF + pn * BM + cc;
        f32x2 bg[2][2], bu[2][2];
#pragma unroll
        for (int h = 0; h < 2; ++h) { const f32x4 g4 = *(const f32x4*)(bp + 4 * h), u4 = *(const f32x4*)(bp + HALF + 4 * h);
            bg[h][0] = (f32x2){g4[0], g4[1]}; bg[h][1] = (f32x2){g4[2], g4[3]}; bu[h][0] = (f32x2){u4[0] + 1.f, u4[1] + 1.f}; bu[h][1] = (f32x2){u4[2] + 1.f, u4[3] + 1.f}; }
        float rsv[8];
#pragma unroll
        for (int it = 0; it < 8; ++it) rsv[it] = rsp[(it >> 2) * HALF + (it & 3) * 16];
        const int hi = fq >> 1;
        unsigned char* obase = act + (size_t)(row0 + 16 * hi) * DFF + pn * HALF + wc * 32 + 16 * (fq & 1);
        constexpr float KS = -1.702f * 1.4426950408889634f;
#pragma unroll
        for (int ai = 0; ai < 2; ++ai)
#pragma unroll
            for (int mp = 0; mp < 2; ++mp) { v2u_t pk[2];
#pragma unroll
                for (int q = 0; q < 2; ++q) { const int m = 2 * mp + q; const float rs = rsv[ai * 4 + m] * 0.03125f;
                    const f32x2 rs2 = {rs, rs}; unsigned w[2];
#pragma unroll
                    for (int h = 0; h < 2; ++h) { f32x2 o[2];
#pragma unroll
                        for (int p = 0; p < 2; ++p) {
                            f32x2 g = (f32x2){acc[ai][0][m][h][2 * p], acc[ai][0][m][h][2 * p + 1]} * rs2 + bg[h][p];
                            f32x2 u1 = (f32x2){acc[ai][1][m][h][2 * p], acc[ai][1][m][h][2 * p + 1]} * rs2 + bu[h][p];
                            g.x = fminf(g.x, 7.f); g.y = fminf(g.y, 7.f); u1.x = __builtin_amdgcn_fmed3f(u1.x, -6.f, 8.f); u1.y = __builtin_amdgcn_fmed3f(u1.y, -6.f, 8.f);
                            const f32x2 t = g * (f32x2){KS, KS};
                            const f32x2 d = (f32x2){__builtin_amdgcn_exp2f(t.x), __builtin_amdgcn_exp2f(t.y)} + (f32x2){1.f, 1.f};
                            const f32x2 r = {__builtin_amdgcn_rcpf(d.x), __builtin_amdgcn_rcpf(d.y)};
                            o[p] = (g * r) * u1; }
                        w[h] = __builtin_amdgcn_cvt_pk_fp8_f32(o[0].x, o[0].y, 0u, false); w[h] = __builtin_amdgcn_cvt_pk_fp8_f32(o[1].x, o[1].y, w[h], true); }
                    pk[q] = (v2u_t){w[0], w[1]}; }
                const auto r0 = __builtin_amdgcn_permlane32_swap(pk[0][0], pk[1][0], false, false), r1 = __builtin_amdgcn_permlane32_swap(pk[0][1], pk[1][1], false, false);
                *(u32x4*)(obase + (size_t)(ai * HALF + mp * 32) * DFF) = (u32x4){r0[0], r1[0], r0[1], r1[1]}; }
    }
};
struct EpiDown {
    static constexpr bool PERM = true, AFTER_DRAIN = false;
    const float* __restrict__ bdn; const float* __restrict__ ew; unsigned char* __restrict__ yb; const PG8_LAS int* pst;
    __device__ __forceinline__ void operator()(const f32x4 (&acc)[2][2][4][2], const Unit& u, int wr, int wc, int fr, int fq) const {
        const int e = u.pn >> 2, pn = u.pn & 3, row0 = u.pm * BM + wr * 64 + fr, col0 = pn * BM + wc * 64 + 16 * fq;
        const float* wp = ew + (size_t)e * NV + (row0 - pst[e]);
        f32x4 bv[2][2];
#pragma unroll
        for (int bj = 0; bj < 2; ++bj) { bv[bj][0] = *(const f32x4*)(bdn + (size_t)e * D + col0 + 8 * bj); bv[bj][1] = *(const f32x4*)(bdn + (size_t)e * D + col0 + 8 * bj + 4); }
        float wv[8];
#pragma unroll
        for (int it = 0; it < 8; ++it) wv[it] = wp[(it >> 2) * HALF + (it & 3) * 16];
#pragma unroll
        for (int ai = 0; ai < 2; ++ai)
#pragma unroll
            for (int m = 0; m < 4; ++m) { const size_t row = (size_t)(row0 + ai * HALF + m * 16); const float w = wv[ai * 4 + m] * 16.f;
                const v2u_t lo = pack8_fp8_sat((acc[ai][0][m][0] * 0.03125f + bv[0][0]) * w, (acc[ai][0][m][1] * 0.03125f + bv[0][1]) * w), hi = pack8_fp8_sat((acc[ai][1][m][0] * 0.03125f + bv[1][0]) * w, (acc[ai][1][m][1] * 0.03125f + bv[1][1]) * w);
                *(u32x4*)(yb + row * D + col0) = (u32x4){lo[0], lo[1], hi[0], hi[1]}; }
    }
};
struct GroupOrder {
    int ntiles, ncol, G, c; const PG8_LAS unsigned char* texp;
    __device__ __forceinline__ bool next(int i, Unit& u) const { const int x = c & 7, w = c >> 3, uu = i * (G >> 3) + w, lj = uu / ncol, pn = uu - lj * ncol, j = lj * 8 + x; if (j >= ntiles) return false; u.pm = j; u.pn = (int)texp[j] * ncol + pn; return true; }
    __device__ __forceinline__ void a_ready(const Unit&) const {}
    __device__ __forceinline__ void done(const Unit&) const {}
};
}

typedef short bf16x8 __attribute__((ext_vector_type(8)));
typedef float f32x16 __attribute__((ext_vector_type(16)));
#define MFMA32(a, b, c) __builtin_amdgcn_mfma_f32_32x32x16_bf16(a, b, c, 0, 0, 0)
__device__ __forceinline__ bf16x8 ldfrag(const LAS unsigned char* base, int st, int row0, int k0, int lane) { return *(const LAS bf16x8*)(base + (row0 + (lane & 31)) * st + (k0 + 8 * (lane >> 5)) * 2); }
__device__ __forceinline__ bf16x8 ldf(const LAS unsigned char* lanebase, int off) { return *(const LAS bf16x8*)(lanebase + off); }
__device__ __forceinline__ float fexp(float x) { return __builtin_amdgcn_exp2f(x * 1.4426950408889634f); }

__device__ __forceinline__ void p3_hgrn2_mfma(Frame& F, int bh) {
    unsigned char* ws = F.ws; const int b = bh >> 2, h = bh & 3, tid = F.tid, lane = F.lane, wave = F.wave, hh = lane >> 5, l31 = lane & 31;
    const bf16* HQ = (const bf16*)(ws + WS_HQ) + h * 128; const float* HG = (const float*)(ws + WS_HG) + h * 128; const bf16* HV = (const bf16*)(ws + WS_HV) + h * 128;
    const bf16* HGATE = (const bf16*)(ws + WS_HGATE) + h * 128; bf16* YHG = (bf16*)(ws + WS_YHG) + h * 128;
    LAS unsigned char* L = F.lds + RING_OFF;
    LAS unsigned char* QT = L; LAS unsigned char* KT = L + 17408; LAS unsigned char* KTT = L + 34816; LAS unsigned char* VT = L + 53248; LAS unsigned char* ST = L + 71680; LAS unsigned char* PP = L + 106496;
    LAS float* SEG = (LAS float*)(L + 115712); LAS float* ER = (LAS float*)(L + 117760); LAS float* EL = (LAS float*)(L + 118272); LAS float* OST = (LAS float*)(L + 17408);
    const int d = tid & 127, pq = tid >> 7;
    const int et = tid >> 3, evq = tid & 7;
    const int f144 = l31 * 144 + hh * 16, f272 = l31 * 272 + hh * 16;
    const int sst = wave == 2 ? 1 : 0, stt = wave == 0 ? 0 : 1, dt = wave & 3, vt0 = 2 * (wave >> 2), btt = wave & 1, bvt = wave >> 1;
    const LAS unsigned char* aK = KT + 32 * sst * 272 + f272; const LAS unsigned char* bQ = QT + 32 * stt * 272 + f272;
    LAS unsigned char* pst = PP + (32 * stt + l31) * 144 + (32 * sst + 4 * hh) * 2;
    const LAS unsigned char* aKTT = KTT + 32 * dt * 144 + f144; const LAS unsigned char* bV0 = VT + 32 * vt0 * 144 + f144;
    LAS unsigned char* sst_ = ST + (32 * vt0 + l31) * 272 + (32 * dt + 4 * hh) * 2;
    const LAS float* erp = ER + 32 * dt + 4 * hh; const LAS float* elp = EL + 32 * dt + 4 * hh;
    const LAS unsigned char* aP = PP + 32 * btt * 144 + f144; const LAS unsigned char* bVB = VT + 32 * bvt * 144 + f144;
    const LAS unsigned char* aQ = QT + 32 * btt * 272 + f272; const LAS unsigned char* bS = ST + 32 * bvt * 272 + f272;
    LAS float* ost = OST + (32 * btt + 4 * hh) * 132 + 32 * bvt + l31; const LAS float* oep = OST + et * 132 + 16 * evq;
    LAS unsigned char* tq = QT + 16 * pq * 272 + d * 2; LAS unsigned char* tk = KT + 16 * pq * 272 + d * 2; LAS unsigned char* tkt = KTT + d * 144 + pq * 32; LAS unsigned char* tv = VT + d * 144 + pq * 32;
    f32x16 S0, S1;
#pragma unroll
    for (int i = 0; i < 16; ++i) { S0[i] = 0.f; S1[i] = 0.f; }
    float gq[16]; unsigned qr[16], vr[16]; v4u gt0, gt1;
    float gn[16];
#pragma unroll
    for (int i = 0; i < 16; ++i) gn[i] = F.in[IN_HGNORM][h * 128 + 16 * evq + i];
#define HG_LOAD(c) do { const int ttb = 64 * (c) - 48 + 16 * pq; \
        _Pragma("unroll") for (int i = 0; i < 16; ++i) { const int tt = ttb + i; if (tt >= 0) { const size_t gi = rowof(b, tt) * HW + d; gq[i] = HG[gi]; qr[i] = (unsigned)HQ[gi]; vr[i] = (unsigned)HV[gi]; } else { gq[i] = 0.f; qr[i] = 0u; vr[i] = 0u; } } \
        { const int tt = 64 * (c) - 48 + et; if (tt >= 0) { const GAS v4u* gp = (const GAS v4u*)(HGATE + rowof(b, tt) * HW + 16 * evq); gt0 = gp[0]; gt1 = gp[1]; } else { gt0 = (v4u){0u, 0u, 0u, 0u}; gt1 = gt0; } } } while (0)
    HG_LOAD(0);
    for (int c = 0; c < 33; ++c) {
        float bl[16];
        { float a = 0.f;
#pragma unroll
          for (int i = 0; i < 16; ++i) { a += gq[i]; bl[i] = a; } }
        SEG[pq * 128 + d] = bl[15];
        __syncthreads();
        { const float s0 = SEG[d], s1 = SEG[128 + d], s2 = SEG[256 + d], s3 = SEG[384 + d];
          const float off = pq == 0 ? 0.f : pq == 1 ? s0 : pq == 2 ? s0 + s1 : (s0 + s1) + s2, r = s0 + s1, blast = (s0 + s1) + (s2 + s3);
          unsigned kp[8], vp[8];
#pragma unroll
          for (int i = 0; i < 16; i += 2) {
              const float b0 = off + bl[i], b1 = off + bl[i + 1];
              const float q0 = __builtin_bit_cast(float, qr[i] << 16) * fexp(b0 - r), q1 = __builtin_bit_cast(float, qr[i + 1] << 16) * fexp(b1 - r);
              const float k0 = (1.f - fexp(gq[i])) * fexp(r - b0), k1 = (1.f - fexp(gq[i + 1])) * fexp(r - b1);
              const unsigned kk = pg8::cvt_pk_bf16(k0, k1), qq = pg8::cvt_pk_bf16(q0, q1);
              *(LAS unsigned short*)(tq + i * 272) = (unsigned short)qq; *(LAS unsigned short*)(tq + (i + 1) * 272) = (unsigned short)(qq >> 16);
              *(LAS unsigned short*)(tk + i * 272) = (unsigned short)kk; *(LAS unsigned short*)(tk + (i + 1) * 272) = (unsigned short)(kk >> 16);
              kp[i >> 1] = kk; vp[i >> 1] = vr[i] | (vr[i + 1] << 16); }
          *(LAS v4u*)(tkt) = (v4u){kp[0], kp[1], kp[2], kp[3]}; *(LAS v4u*)(tkt + 16) = (v4u){kp[4], kp[5], kp[6], kp[7]};
          *(LAS v4u*)(tv) = (v4u){vp[0], vp[1], vp[2], vp[3]}; *(LAS v4u*)(tv + 16) = (v4u){vp[4], vp[5], vp[6], vp[7]};
          if (pq == 0) { ER[d] = fexp(r); EL[d] = fexp(blast - r); } }
        const v4u g0 = gt0, g1 = gt1;
        __syncthreads();
        if (c + 1 < 33) HG_LOAD(c + 1);
        asm volatile("" ::: "memory");
        if (wave < 3) {
            f32x16 acc;
#pragma unroll
            for (int i = 0; i < 16; ++i) acc[i] = 0.f;
#pragma unroll
            for (int ks = 0; ks < 8; ++ks) acc = MFMA32(ldf(aK, 32 * ks), ldf(bQ, 32 * ks), acc);
            const int t = 32 * stt + l31;
#pragma unroll
            for (int g4 = 0; g4 < 4; ++g4) { const int s0 = 32 * sst + 8 * g4 + 4 * hh;
                const float x0 = (s0 + 0 <= t) ? acc[4 * g4 + 0] : 0.f, x1 = (s0 + 1 <= t) ? acc[4 * g4 + 1] : 0.f, x2 = (s0 + 2 <= t) ? acc[4 * g4 + 2] : 0.f, x3 = (s0 + 3 <= t) ? acc[4 * g4 + 3] : 0.f;
                *(LAS v2u*)(pst + 16 * g4) = (v2u){pg8::cvt_pk_bf16(x0, x1), pg8::cvt_pk_bf16(x2, x3)}; }
        }
        {
#pragma unroll
          for (int g4 = 0; g4 < 4; ++g4) { const f32x4 er = *(const LAS f32x4*)(erp + 8 * g4);
#pragma unroll
              for (int i = 0; i < 4; ++i) { S0[4 * g4 + i] *= er[i]; S1[4 * g4 + i] *= er[i]; }
              *(LAS v2u*)(sst_ + 16 * g4) = (v2u){pg8::cvt_pk_bf16(S0[4 * g4], S0[4 * g4 + 1]), pg8::cvt_pk_bf16(S0[4 * g4 + 2], S0[4 * g4 + 3])};
              *(LAS v2u*)(sst_ + 32 * 272 + 16 * g4) = (v2u){pg8::cvt_pk_bf16(S1[4 * g4], S1[4 * g4 + 1]), pg8::cvt_pk_bf16(S1[4 * g4 + 2], S1[4 * g4 + 3])}; }
#pragma unroll
          for (int ks = 0; ks < 4; ++ks) { const bf16x8 a = ldf(aKTT, 32 * ks); S0 = MFMA32(a, ldf(bV0, 32 * ks), S0); S1 = MFMA32(a, ldf(bV0, 32 * 144 + 32 * ks), S1); }
#pragma unroll
          for (int g4 = 0; g4 < 4; ++g4) { const f32x4 el = *(const LAS f32x4*)(elp + 8 * g4);
#pragma unroll
              for (int i = 0; i < 4; ++i) { S0[4 * g4 + i] *= el[i]; S1[4 * g4 + i] *= el[i]; } } }
        __syncthreads();
        { f32x16 acc;
#pragma unroll
          for (int i = 0; i < 16; ++i) acc[i] = 0.f;
#pragma unroll
          for (int ks = 0; ks < 4; ++ks) if (ks < 2 || btt == 1) acc = MFMA32(ldf(aP, 32 * ks), ldf(bVB, 32 * ks), acc);
#pragma unroll
          for (int ks = 0; ks < 8; ++ks) acc = MFMA32(ldf(aQ, 32 * ks), ldf(bS, 32 * ks), acc);
#pragma unroll
          for (int i = 0; i < 16; ++i) ost[((i & 3) + 8 * (i >> 2)) * 132] = acc[i]; }
        __syncthreads();
        { const int tt = 64 * c - 48 + et;
          f32x4 o[4]; float ss = 0.f;
#pragma unroll
          for (int j = 0; j < 4; ++j) { o[j] = *(const LAS f32x4*)(oep + 4 * j); ss += (o[j].x * o[j].x + o[j].y * o[j].y) + (o[j].z * o[j].z + o[j].w * o[j].w); }
          ss += __shfl_xor(ss, 1); ss += __shfl_xor(ss, 2); ss += __shfl_xor(ss, 4);
          const float rs = 1.0f / sqrtf(ss * (1.f / 128.f) + EPS);
          if (tt >= NMETA || (tt >= 0 && b == 0)) { const unsigned gw[8] = {g0.x, g0.y, g0.z, g0.w, g1.x, g1.y, g1.z, g1.w}; unsigned w[8];
#pragma unroll
              for (int j = 0; j < 4; ++j) { w[2 * j] = pk2(o[j].x * rs * gn[4 * j] * bflo(gw[2 * j]), o[j].y * rs * gn[4 * j + 1] * bfhi(gw[2 * j])); w[2 * j + 1] = pk2(o[j].z * rs * gn[4 * j + 2] * bflo(gw[2 * j + 1]), o[j].w * rs * gn[4 * j + 3] * bfhi(gw[2 * j + 1])); }
              GAS v4u* yp = (GAS v4u*)(YHG + rowof(b, tt) * HW + 16 * evq); yp[0] = (v4u){w[0], w[1], w[2], w[3]}; yp[1] = (v4u){w[4], w[5], w[6], w[7]}; } }
        __syncthreads();
    }
#undef HG_LOAD
}


#define DPP_F(old, v, ctrl, rmask) __builtin_bit_cast(float, __builtin_amdgcn_update_dpp(__builtin_bit_cast(int, (float)(old)), __builtin_bit_cast(int, (float)(v)), (ctrl), (rmask), 0xf, false))
__device__ __forceinline__ float wave_scan_add(float v) {
    v += DPP_F(0.f, v, 0x111, 0xf); v += DPP_F(0.f, v, 0x112, 0xf); v += DPP_F(0.f, v, 0x114, 0xf); v += DPP_F(0.f, v, 0x118, 0xf);
    v += DPP_F(0.f, v, 0x142, 0xa); v += DPP_F(0.f, v, 0x143, 0xc); return v;
}
__device__ __forceinline__ float wave_scan_max(float v) {
    const float ni = -INFINITY;
    v = fmaxf(v, DPP_F(ni, v, 0x111, 0xf)); v = fmaxf(v, DPP_F(ni, v, 0x112, 0xf)); v = fmaxf(v, DPP_F(ni, v, 0x114, 0xf)); v = fmaxf(v, DPP_F(ni, v, 0x118, 0xf));
    v = fmaxf(v, DPP_F(ni, v, 0x142, 0xa)); v = fmaxf(v, DPP_F(ni, v, 0x143, 0xc)); return v;
}
__device__ __forceinline__ void p3_mlstm_mfma(Frame& F, int bh) {
    unsigned char* ws = F.ws; const int b = bh >> 2, h = bh & 3, tid = F.tid, lane = F.lane, wave = F.wave, hh = lane >> 5, l31 = lane & 31;
    const bf16* MMg = (const bf16*)(ws + WS_MM) + h * 128; const bf16* MOg = (const bf16*)(ws + WS_MO) + h * 128; const float* LI = (const float*)(ws + WS_LI) + h; const float* LF = (const float*)(ws + WS_LF) + h;
    bf16* YML = (bf16*)(ws + WS_YML) + h * 128;
    LAS unsigned char* L = F.lds + RING_OFF;
    LAS unsigned char* CT = L; LAS unsigned char* MT = L + 17408; LAS unsigned char* KM = L + 34816; LAS unsigned char* KW = L + 44032; LAS unsigned char* QM = L + 53248; LAS unsigned char* QW = L + 62464;
    LAS unsigned char* VT = L + 71680; LAS unsigned char* SV = L + 90112; LAS unsigned char* PP = L + 108544; LAS float* OST = (LAS float*)(L + 17408);
    LAS float* SM = (LAS float*)(L + 117760);
    LAS float* U = SM; LAS float* MX = SM + 64; LAS float* BB = SM + 128; LAS float* WSs = SM + 192; LAS float* WI = SM + 256; LAS float* DENP = SM + 320  ; LAS float* NN = SM + 416; LAS float* DENI = SM + 480; LAS float* SC = SM + 544  ; LAS float* GNS = SM + 560  ;
    const int ch = tid & 127, pq = tid >> 7, et = tid >> 3, evq = tid & 7;
    const int f144 = l31 * 144 + hh * 16, f272 = l31 * 272 + hh * 16;
    const int sst = wave == 2 ? 1 : 0, stt = wave == 0 ? 0 : 1, dkt = wave & 1, svt = wave >> 1;
    const LAS unsigned char* cfp = (wave < 4 ? CT : MT) + f272;
    LAS unsigned char* qst = QM + l31 * 144 + (32 * (wave & 1) + 4 * hh) * 2; LAS unsigned char* qwst = QW + l31 * 144 + (32 * (wave & 1) + 4 * hh) * 2;
    const int kdk = 32 * (wave & 1) + l31;
    LAS unsigned char* kmst = KM + 4 * hh * 144 + kdk * 2; LAS unsigned char* kwst = KW + kdk * 144 + 4 * hh * 2; const LAS float* wsp = WSs + 4 * hh;
    LAS unsigned char* vst = VT + (32 * (wave & 3) + l31) * 144 + 4 * hh * 2;
    const LAS unsigned char* aKM = KM + 32 * sst * 144 + f144; const LAS unsigned char* bQM = QM + 32 * stt * 144 + f144;
    LAS unsigned char* pst = PP + (32 * stt + l31) * 144 + (32 * sst + 4 * hh) * 2; const LAS float* up = U + 32 * sst + 4 * hh;
    LAS unsigned char* svst = SV + (32 * svt + l31) * 144 + (32 * dkt + 4 * hh) * 2;
    const LAS unsigned char* aKW = KW + 32 * dkt * 144 + f144; const LAS unsigned char* bVT = VT + 32 * svt * 144 + f144;
    const LAS unsigned char* aP = PP + 32 * dkt * 144 + f144; const LAS unsigned char* aQW = QW + 32 * dkt * 144 + f144; const LAS unsigned char* bSV = SV + 32 * svt * 144 + f144;
    LAS float* ost = OST + (32 * dkt + 4 * hh) * 132 + 32 * svt + l31; const LAS float* oep = OST + et * 132 + 16 * evq;
    LAS unsigned char* tc = CT + 16 * pq * 272 + ch * 2; LAS unsigned char* tm = MT + 16 * pq * 272 + ch * 2;
    bf16x8 wf[8];
    { const float* W = wave < 2 ? F.in[IN_WQ] + (size_t)h * 128 * 64 + 32 * wave + l31 : wave < 4 ? F.in[IN_WK] + (size_t)h * 128 * 64 + 32 * (wave - 2) + l31 : F.in[IN_WV] + (size_t)h * 128 * 128 + 32 * (wave - 4) + l31;
      const int ld = wave < 4 ? 64 : 128; const float sc = wave < 2 ? 0.125f : 1.f;
#pragma unroll
      for (int ks = 0; ks < 8; ++ks) { unsigned p[4];
#pragma unroll
          for (int j = 0; j < 4; ++j) p[j] = pk2(W[(size_t)(16 * ks + 8 * hh + 2 * j) * ld] * sc, W[(size_t)(16 * ks + 8 * hh + 2 * j + 1) * ld] * sc);
          wf[ks] = __builtin_bit_cast(bf16x8, (v4u){p[0], p[1], p[2], p[3]}); } }
    float cw[4]; const float cb = F.in[IN_CONVB][h * 128 + ch];
#pragma unroll
    for (int j = 0; j < 4; ++j) cw[j] = F.in[IN_CONVW][j * HW + h * 128 + ch];
    if (tid < 128) GNS[tid] = F.in[IN_MLNORM][h * 128 + tid]; else if (tid < 256) GNS[tid] = F.in[IN_MLSKIP][h * 128 + tid - 128];
    f32x16 S;
#pragma unroll
    for (int i = 0; i < 16; ++i) S[i] = 0.f;
    float mcar = 0.f, nreg = 0.f;
    unsigned mr[19]; v4u gt0, gt1; float pli = 0.f, plf = 0.f;
#define ML_LOAD(c) do { const int ttb = 64 * (c) - 48 + 16 * pq - 3; \
        _Pragma("unroll") for (int i = 0; i < 19; ++i) { const int tt = ttb + i; mr[i] = tt >= 0 ? (unsigned)MMg[rowof(b, tt) * HW + ch] : 0u; } \
        { const int tt = 64 * (c) - 48 + et; if (tt >= 0) { const GAS v4u* gp = (const GAS v4u*)(MOg + rowof(b, tt) * HW + 16 * evq); gt0 = gp[0]; gt1 = gp[1]; } else { gt0 = (v4u){0u, 0u, 0u, 0u}; gt1 = gt0; } } \
        if (wave == 0) { const int tt = 64 * (c) - 48 + lane; if (tt >= 0) { pli = LI[rowof(b, tt) * 4]; plf = LF[rowof(b, tt) * 4]; } else { pli = -1e30f; plf = 0.f; } } } while (0)
    ML_LOAD(0);
    for (int c = 0; c < 33; ++c) {
#pragma unroll
        for (int i = 0; i < 16; ++i) { const float a = cb + (cw[0] * __builtin_bit_cast(float, mr[i] << 16) + cw[1] * __builtin_bit_cast(float, mr[i + 1] << 16)) + (cw[2] * __builtin_bit_cast(float, mr[i + 2] << 16) + cw[3] * __builtin_bit_cast(float, mr[i + 3] << 16));
            *(LAS unsigned short*)(tc + i * 272) = (unsigned short)f2bf(fsilu(a)); *(LAS unsigned short*)(tm + i * 272) = (unsigned short)mr[i + 3]; }
        if (wave == 0) {
            const float bs = wave_scan_add(plf);
            const float u = pli - bs; const float pm = wave_scan_max(u);
            const float M = fmaxf(mcar, pm), M63 = __shfl(M, 63), b63 = __shfl(bs, 63);
            U[lane] = u; MX[lane] = M; BB[lane] = bs; WSs[lane] = fexp(u - M63); WI[lane] = fexp(mcar - M);
            if (lane == 0) { SC[0] = b63; SC[1] = M63; }
        }
        __syncthreads();
        { f32x16 a0, a1;
#pragma unroll
          for (int i = 0; i < 16; ++i) { a0[i] = 0.f; a1[i] = 0.f; }
          if (wave < 2) {
#pragma unroll
              for (int ks = 0; ks < 8; ++ks) { a0 = MFMA32(wf[ks], ldf(cfp, 32 * ks), a0); a1 = MFMA32(wf[ks], ldf(cfp, 32 * 272 + 32 * ks), a1); }
              const float wi0 = WI[l31], wi1 = WI[32 + l31];
#pragma unroll
              for (int g4 = 0; g4 < 4; ++g4) {
                  *(LAS v2u*)(qst + 16 * g4) = (v2u){pg8::cvt_pk_bf16(a0[4 * g4], a0[4 * g4 + 1]), pg8::cvt_pk_bf16(a0[4 * g4 + 2], a0[4 * g4 + 3])};
                  *(LAS v2u*)(qst + 32 * 144 + 16 * g4) = (v2u){pg8::cvt_pk_bf16(a1[4 * g4], a1[4 * g4 + 1]), pg8::cvt_pk_bf16(a1[4 * g4 + 2], a1[4 * g4 + 3])};
                  *(LAS v2u*)(qwst + 16 * g4) = (v2u){pg8::cvt_pk_bf16(a0[4 * g4] * wi0, a0[4 * g4 + 1] * wi0), pg8::cvt_pk_bf16(a0[4 * g4 + 2] * wi0, a0[4 * g4 + 3] * wi0)};
                  *(LAS v2u*)(qwst + 32 * 144 + 16 * g4) = (v2u){pg8::cvt_pk_bf16(a1[4 * g4] * wi1, a1[4 * g4 + 1] * wi1), pg8::cvt_pk_bf16(a1[4 * g4 + 2] * wi1, a1[4 * g4 + 3] * wi1)}; }
          } else {
#pragma unroll
              for (int ks = 0; ks < 8; ++ks) { a0 = MFMA32(ldf(cfp, 32 * ks), wf[ks], a0); a1 = MFMA32(ldf(cfp, 32 * 272 + 32 * ks), wf[ks], a1); }
              if (wave < 4) {
                  float nsum = 0.f;
#pragma unroll
                  for (int g4 = 0; g4 < 4; ++g4) { const f32x4 w0 = *(const LAS f32x4*)(wsp + 8 * g4), w1 = *(const LAS f32x4*)(wsp + 32 + 8 * g4);
#pragma unroll
                      for (int i = 0; i < 4; ++i) { *(LAS unsigned short*)(kmst + (8 * g4 + i) * 144) = (unsigned short)f2bf(a0[4 * g4 + i]); *(LAS unsigned short*)(kmst + (32 + 8 * g4 + i) * 144) = (unsigned short)f2bf(a1[4 * g4 + i]); }
                      const float x0 = a0[4 * g4] * w0[0], x1 = a0[4 * g4 + 1] * w0[1], x2 = a0[4 * g4 + 2] * w0[2], x3 = a0[4 * g4 + 3] * w0[3];
                      const float y0 = a1[4 * g4] * w1[0], y1 = a1[4 * g4 + 1] * w1[1], y2 = a1[4 * g4 + 2] * w1[2], y3 = a1[4 * g4 + 3] * w1[3];
                      nsum += ((x0 + x1) + (x2 + x3)) + ((y0 + y1) + (y2 + y3));
                      *(LAS v2u*)(kwst + 16 * g4) = (v2u){pg8::cvt_pk_bf16(x0, x1), pg8::cvt_pk_bf16(x2, x3)};
                      *(LAS v2u*)(kwst + 64 + 16 * g4) = (v2u){pg8::cvt_pk_bf16(y0, y1), pg8::cvt_pk_bf16(y2, y3)}; }
                  nsum += __shfl_xor(nsum, 32);
                  if (hh == 0) NN[kdk] = nreg;
                  nreg = fexp(mcar - SC[1]) * nreg + nsum;
              } else {
#pragma unroll
                  for (int g4 = 0; g4 < 4; ++g4) {
                      *(LAS v2u*)(vst + 16 * g4) = (v2u){pg8::cvt_pk_bf16(a0[4 * g4], a0[4 * g4 + 1]), pg8::cvt_pk_bf16(a0[4 * g4 + 2], a0[4 * g4 + 3])};
                      *(LAS v2u*)(vst + 64 + 16 * g4) = (v2u){pg8::cvt_pk_bf16(a1[4 * g4], a1[4 * g4 + 1]), pg8::cvt_pk_bf16(a1[4 * g4 + 2], a1[4 * g4 + 3])}; }
              }
          } }
        __syncthreads();
        const v4u g0 = gt0, g1 = gt1;
        if (c + 1 < 33) ML_LOAD(c + 1);
        asm volatile("" ::: "memory");
        if (wave < 3) {
            f32x16 acc;
#pragma unroll
            for (int i = 0; i < 16; ++i) acc[i] = 0.f;
#pragma unroll
            for (int ks = 0; ks < 4; ++ks) acc = MFMA32(ldf(aKM, 32 * ks), ldf(bQM, 32 * ks), acc);
            const int t = 32 * stt + l31; const float mt = MX[t]; float dsum = 0.f;
#pragma unroll
            for (int g4 = 0; g4 < 4; ++g4) { const int s0 = 32 * sst + 8 * g4 + 4 * hh; const f32x4 us = *(const LAS f32x4*)(up + 8 * g4);
                const float x0 = (s0 + 0 <= t) ? acc[4 * g4 + 0] * fexp(us[0] - mt) : 0.f, x1 = (s0 + 1 <= t) ? acc[4 * g4 + 1] * fexp(us[1] - mt) : 0.f;
                const float x2 = (s0 + 2 <= t) ? acc[4 * g4 + 2] * fexp(us[2] - mt) : 0.f, x3 = (s0 + 3 <= t) ? acc[4 * g4 + 3] * fexp(us[3] - mt) : 0.f;
                dsum += (x0 + x1) + (x2 + x3);
                *(LAS v2u*)(pst + 16 * g4) = (v2u){pg8::cvt_pk_bf16(x0, x1), pg8::cvt_pk_bf16(x2, x3)}; }
            dsum += __shfl_xor(dsum, 32);
            if (hh == 0) DENP[wave * 32 + l31] = dsum;
        } else if (wave == 3) {
            float a = 0.f;
#pragma unroll 2
            for (int j = 0; j < 8; ++j) { const v4u q = *(const LAS v4u*)(QW + lane * 144 + 16 * j); const f32x4 n0 = *(const LAS f32x4*)(NN + 8 * j), n1 = *(const LAS f32x4*)(NN + 8 * j + 4);
                a += (bflo(q.x) * n0[0] + bfhi(q.x) * n0[1]) + (bflo(q.y) * n0[2] + bfhi(q.y) * n0[3]) + (bflo(q.z) * n1[0] + bfhi(q.z) * n1[1]) + (bflo(q.w) * n1[2] + bfhi(q.w) * n1[3]); }
            DENI[lane] = a;
        }
        { const float wp = fexp(mcar - SC[1]);
#pragma unroll
          for (int g4 = 0; g4 < 4; ++g4) {
              *(LAS v2u*)(svst + 16 * g4) = (v2u){pg8::cvt_pk_bf16(S[4 * g4], S[4 * g4 + 1]), pg8::cvt_pk_bf16(S[4 * g4 + 2], S[4 * g4 + 3])};
#pragma unroll
              for (int i = 0; i < 4; ++i) S[4 * g4 + i] *= wp; }
#pragma unroll
          for (int ks = 0; ks < 4; ++ks) S = MFMA32(ldf(aKW, 32 * ks), ldf(bVT, 32 * ks), S); }
        __syncthreads();
        { f32x16 acc;
#pragma unroll
          for (int i = 0; i < 16; ++i) acc[i] = 0.f;
#pragma unroll
          for (int ks = 0; ks < 4; ++ks) if (ks < 2 || dkt == 1) acc = MFMA32(ldf(aP, 32 * ks), ldf(bVT, 32 * ks), acc);
#pragma unroll
          for (int ks = 0; ks < 4; ++ks) acc = MFMA32(ldf(aQW, 32 * ks), ldf(bSV, 32 * ks), acc);
#pragma unroll
          for (int i = 0; i < 16; ++i) ost[((i & 3) + 8 * (i >> 2)) * 132] = acc[i]; }
        __syncthreads();
        { const int tt = 64 * c - 48 + et;
          const float den = (et < 32 ? DENP[et] : DENP[et] + DENP[32 + et]) + DENI[et];
          const float inv = 1.0f / fmaxf(fabsf(den), fexp(-(BB[et] + MX[et])));
          f32x4 o[4]; float ss = 0.f;
#pragma unroll
          for (int j = 0; j < 4; ++j) { o[j] = *(const LAS f32x4*)(oep + 4 * j) * inv; ss += (o[j].x * o[j].x + o[j].y * o[j].y) + (o[j].z * o[j].z + o[j].w * o[j].w); }
          ss += __shfl_xor(ss, 1); ss += __shfl_xor(ss, 2); ss += __shfl_xor(ss, 4);
          const float rs = 1.0f / sqrtf(ss * (1.f / 128.f) + EPS);
          if (tt >= NMETA || (tt >= 0 && b == 0)) { const unsigned gw[8] = {g0.x, g0.y, g0.z, g0.w, g1.x, g1.y, g1.z, g1.w}; unsigned w[8];
              const v4u c0 = *(const LAS v4u*)(CT + et * 272 + 32 * evq), c1 = *(const LAS v4u*)(CT + et * 272 + 32 * evq + 16); const unsigned cwd[8] = {c0.x, c0.y, c0.z, c0.w, c1.x, c1.y, c1.z, c1.w};
#pragma unroll
              for (int j = 0; j < 4; ++j) { const f32x4 gn = *(const LAS f32x4*)(GNS + 16 * evq + 4 * j), sk = *(const LAS f32x4*)(GNS + 128 + 16 * evq + 4 * j);
                  w[2 * j] = pk2((o[j].x * rs * gn[0] + sk[0] * bflo(cwd[2 * j])) * bflo(gw[2 * j]), (o[j].y * rs * gn[1] + sk[1] * bfhi(cwd[2 * j])) * bfhi(gw[2 * j]));
                  w[2 * j + 1] = pk2((o[j].z * rs * gn[2] + sk[2] * bflo(cwd[2 * j + 1])) * bflo(gw[2 * j + 1]), (o[j].w * rs * gn[3] + sk[3] * bfhi(cwd[2 * j + 1])) * bfhi(gw[2 * j + 1])); }
              GAS v4u* yp = (GAS v4u*)(YML + rowof(b, tt) * HW + 16 * evq); yp[0] = (v4u){w[0], w[1], w[2], w[3]}; yp[1] = (v4u){w[4], w[5], w[6], w[7]}; }
          mcar = SC[0] + SC[1]; }
        __syncthreads();
    }
#undef ML_LOAD
}

typedef float f32x4v __attribute__((ext_vector_type(4)));
#define MFMA16F(a, b, c) __builtin_amdgcn_mfma_f32_16x16x4f32(a, b, c, 0, 0, 0)
constexpr int RW_LD = 516;
__device__ __forceinline__ void router_topk16(LAS float* LGw, int V, float rsv, int resrow, int lane, LAS int* hist, LAS int* res, int* TOPE, float* TOPW, float* RS) {
    if (lane < 16) {
        int se[4]; float sv[4];
#pragma unroll
        for (int k = 0; k < 4; ++k) { float best = -INFINITY; int bi = 0;
            for (int e = 0; e < 32; ++e) { const float v = LGw[lane * 33 + e]; if (v > best) { best = v; bi = e; } }
            se[k] = bi; sv[k] = best; LGw[lane * 33 + bi] = -INFINITY; }
        const float e1 = __expf(sv[1] - sv[0]), e2 = __expf(sv[2] - sv[0]), e3 = __expf(sv[3] - sv[0]), inv = 1.0f / (1.f + e1 + e2 + e3);
        const float w4[4] = {inv, e1 * inv, e2 * inv, e3 * inv};
#pragma unroll
        for (int k = 0; k < 4; ++k) { const int lp = __hip_atomic_fetch_add(hist + se[k], 1, __ATOMIC_RELAXED, __HIP_MEMORY_SCOPE_WORKGROUP);
            TOPE[(size_t)V * 4 + k] = se[k]; TOPW[(size_t)V * 4 + k] = w4[k]; res[(resrow + lane) * 4 + k] = lp; }
        RS[V] = rsv;
    }
}
__device__ __forceinline__ void p6_router(Frame& F) {
    unsigned char* ws = F.ws;
    const bf16* H1 = (const bf16*)(ws + WS_H1); const float* RWT = (const float*)(ws + WS_RWT);
    int* TOPE = (int*)(ws + WS_TOPE); int* TOPP = (int*)(ws + WS_TOPP); float* TOPW = (float*)(ws + WS_TOPW); float* RS = (float*)(ws + WS_RS);
    int* ETOK = (int*)(ws + WS_ETOK); float* ERS = (float*)(ws + WS_ERS); float* EW = (float*)(ws + WS_EW);
    LAS float* rw = (LAS float*)(F.lds + RING_OFF);
    LAS float* LG = (LAS float*)(F.lds + RING_OFF + 66048) + F.wave * 528;
    LAS int* hist = (LAS int*)(F.lds + RING_OFF + 66048 + 8 * 2112);
    LAS int* res = hist + 64;
    LAS float* XP = (LAS float*)(res + 144 * 4);
    LAS float* XQ = XP + 8 * 528;
    const int lane = F.lane, wave = F.wave, i16 = lane & 15, kk = lane >> 4;
    constexpr int RPW = NTOK / 256;
    const bool has_meta = (F.vcu == 0);
    const int Vbase = F.vcu * RPW, Vt = Vbase + 16 * wave;
    if (F.tid < 64) hist[F.tid] = 0;
    f32x4v acc0 = {0.f, 0.f, 0.f, 0.f}, acc1 = {0.f, 0.f, 0.f, 0.f}, acx0 = {0.f, 0.f, 0.f, 0.f}, acx1 = {0.f, 0.f, 0.f, 0.f}; float ssq = 0.f, xss = 0.f;
    const bf16* arow = H1 + (size_t)(Vt + i16) * D + 8 * kk;
    const bf16* xrow = H1 + (size_t)(NTOK + i16) * D + 8 * kk;
    v4u a0[4], a1[4];
#define RT_MMA(A, SB, C0, C1, SS) do { const LAS float* b0p = rw + i16 * RW_LD + 8 * kk + 128 * (SB); const LAS float* b1p = rw + (16 + i16) * RW_LD + 8 * kk + 128 * (SB); \
        _Pragma("unroll") for (int s = 0; s < 4; ++s) { const v4u aw = A[s]; \
            _Pragma("unroll") for (int h = 0; h < 2; ++h) { const unsigned w0 = h ? aw.z : aw.x, w1 = h ? aw.w : aw.y; const f32x4 a = {bflo(w0), bfhi(w0), bflo(w1), bfhi(w1)}; \
            const f32x4 b0 = *(const LAS f32x4*)(b0p + 32 * s + 4 * h), b1 = *(const LAS f32x4*)(b1p + 32 * s + 4 * h); \
            SS += (a.x * a.x + a.y * a.y) + (a.z * a.z + a.w * a.w); \
            C0 = MFMA16F(a.x, b0.x, C0); C1 = MFMA16F(a.x, b1.x, C1); C0 = MFMA16F(a.y, b0.y, C0); C1 = MFMA16F(a.y, b1.y, C1); \
            C0 = MFMA16F(a.z, b0.z, C0); C1 = MFMA16F(a.z, b1.z, C1); C0 = MFMA16F(a.w, b0.w, C0); C1 = MFMA16F(a.w, b1.w, C1); } } } while (0)
#pragma unroll
    for (int s = 0; s < 4; ++s) a0[s] = *(const GAS v4u*)(arow + 32 * s);
#pragma unroll 1
    for (int it = 0; it < 4; ++it) {
        const int half = it >> 1, sb0 = (2 * it) & 3;
        if ((it & 1) == 0) {
            __syncthreads();
            { f32x4 stg[8];
#pragma unroll
              for (int q = 0; q < 8; ++q) { const int u = F.tid + q * NTHREADS, e = u >> 7, c = u & 127; stg[q] = *(const GAS f32x4*)(RWT + (size_t)e * D + 512 * half + 4 * c); }
#pragma unroll
              for (int q = 0; q < 8; ++q) { const int u = F.tid + q * NTHREADS, e = u >> 7, c = u & 127; *(LAS f32x4*)(rw + e * RW_LD + 4 * c) = stg[q]; } }
            __syncthreads();
        }
#pragma unroll
        for (int s = 0; s < 4; ++s) a1[s] = *(const GAS v4u*)(arow + 128 * (2 * it + 1) + 32 * s);
        RT_MMA(a0, sb0, acc0, acc1, ssq);
        if (it < 3) {
#pragma unroll
            for (int s = 0; s < 4; ++s) a0[s] = *(const GAS v4u*)(arow + 128 * (2 * it + 2) + 32 * s);
        }
        RT_MMA(a1, sb0 + 1, acc0, acc1, ssq);
        if (has_meta && (wave >> 1) == it) {
            v4u ax[4];
#pragma unroll
            for (int s = 0; s < 4; ++s) ax[s] = *(const GAS v4u*)(xrow + 128 * wave + 32 * s);
            RT_MMA(ax, wave & 3, acx0, acx1, xss);
        }
    }
#undef RT_MMA
    if (has_meta) {
        xss += __shfl_xor(xss, 16); xss += __shfl_xor(xss, 32);
#pragma unroll
        for (int r = 0; r < 4; ++r) { XP[wave * 528 + (4 * kk + r) * 33 + i16] = acx0[r]; XP[wave * 528 + (4 * kk + r) * 33 + 16 + i16] = acx1[r]; }
        if (kk == 0) XQ[wave * 16 + i16] = xss;
    }
    ssq += __shfl_xor(ssq, 16); ssq += __shfl_xor(ssq, 32);
    const float rsrow = 1.0f / sqrtf(ssq * (1.f / D) + EPS);
    const float rb0 = F.in[IN_RB][i16], rb1 = F.in[IN_RB][16 + i16];
#pragma unroll
    for (int r = 0; r < 4; ++r) { const float rsr = __shfl(rsrow, 4 * kk + r); LG[(4 * kk + r) * 33 + i16] = acc0[r] * rsr + rb0; LG[(4 * kk + r) * 33 + 16 + i16] = acc1[r] * rsr + rb1; }
    LDS_WAIT(); asm volatile("" ::: "memory");
    router_topk16(LG, Vt + lane, rsrow, 16 * wave, lane, hist, res, TOPE, TOPW, RS);
    __syncthreads();
    if (has_meta && wave == 7) {
        float q = 0.f;
#pragma unroll
        for (int w = 0; w < 8; ++w) q += XQ[w * 16 + i16];
        const float rsm = 1.0f / sqrtf(q * (1.f / D) + EPS);
#pragma unroll
        for (int r = 0; r < 4; ++r) { float v0 = 0.f, v1 = 0.f;
#pragma unroll
            for (int w = 0; w < 8; ++w) { v0 += XP[w * 528 + (4 * kk + r) * 33 + i16]; v1 += XP[w * 528 + (4 * kk + r) * 33 + 16 + i16]; }
            const float rsr = __shfl(rsm, 4 * kk + r); LG[(4 * kk + r) * 33 + i16] = v0 * rsr + rb0; LG[(4 * kk + r) * 33 + 16 + i16] = v1 * rsr + rb1; }
        LDS_WAIT(); asm volatile("" ::: "memory");
        router_topk16(LG, NTOK + lane, rsm, 128, lane, hist, res, TOPE, TOPW, RS);
    }
    __syncthreads();
    if (F.tid < NE) hist[32 + F.tid] = (int)__hip_atomic_fetch_add(F.ctl + CW_CNT + 64 * F.tid, (unsigned)hist[F.tid], RLX_AGENT);
    __syncthreads();
    const int nrows = has_meta ? RPW + 16 : RPW;
    for (int u = F.tid; u < nrows * 4; u += NTHREADS) { const int rr = u >> 2, V = rr < RPW ? Vbase + rr : NTOK + (rr - RPW); const size_t gi = (size_t)V * 4 + (u & 3); const int e = TOPE[gi], pos = hist[32 + e] + res[u];
        TOPP[gi] = pos; ETOK[(size_t)e * NV + pos] = V; ERS[(size_t)e * NV + pos] = RS[V]; EW[(size_t)e * NV + pos] = TOPW[gi]; }
}

__device__ __forceinline__ void build_tables(Frame& F) {
    LAS int* pst = (LAS int*)(F.lds + PST_OFF); LAS unsigned char* texp = (LAS unsigned char*)(F.lds + TEXP_OFF);
    __syncthreads();
    if (F.tid < 64) {
        const int e = F.lane & 31; const int c = (int)__hip_atomic_load(F.ctl + CW_CNT + 64 * e, RLX_AGENT); const int nt = (c + 255) >> 8;
        int incl = nt;
#pragma unroll
        for (int o = 1; o < 32; o <<= 1) { const int t = __shfl_up(incl, o); if ((F.lane & 31) >= o) incl += t; }
        const int start = incl - nt;
        if (F.lane < 32) { pst[e] = start * 256; pst[33 + e] = c; for (int j = 0; j < nt && start + j < MAXTILES; ++j) texp[start + j] = (unsigned char)e; if (e == 31) pst[32] = incl < MAXTILES ? incl : MAXTILES; }
    }
    __syncthreads();
}
typedef float f32v2_t __attribute__((ext_vector_type(2)));
__device__ __forceinline__ void p10_combine(Frame& F) {
    unsigned char* ws = F.ws; build_tables(F);
    const LAS int* pst = (const LAS int*)(F.lds + PST_OFF);
    const bf16* H1 = (const bf16*)(ws + WS_H1); const unsigned char* YB = (const unsigned char*)(ws + WS_YB);
    const int* TOPE = (const int*)(ws + WS_TOPE); const int* TOPP = (const int*)(ws + WS_TOPP);
    const int gw = F.vcu * NWAVES + F.wave, NGW = F.G * NWAVES;
    const GAS f32x4* nf = (const GAS f32x4*)F.in[IN_NFIN] + F.lane; f32x4 nfv[4];
#pragma unroll
    for (int j = 0; j < 4; ++j) nfv[j] = nf[64 * j];
    int sl[2][4];
#define CMB_SLOTS(Rbase) do { _Pragma("unroll") for (int q = 0; q < 2; ++q) { const int R = (Rbase) + q * NGW; if (R < BATCH * SEQ) { const size_t V = (size_t)R; \
        _Pragma("unroll") for (int k = 0; k < 4; ++k) sl[q][k] = pst[TOPE[V * 4 + k]] + TOPP[V * 4 + k]; } else { _Pragma("unroll") for (int k = 0; k < 4; ++k) sl[q][k] = 0; } } } while (0)
    CMB_SLOTS(gw);
    for (int R0 = gw; R0 < BATCH * SEQ; R0 += 2 * NGW) {
        f32x4 v[2][4]; unsigned y[2][4][4];
#pragma unroll
        for (int q = 0; q < 2; ++q) { const int R = (R0 + q * NGW < BATCH * SEQ) ? R0 + q * NGW : R0; const size_t V = (size_t)R;
            const GAS v2u* hr = (const GAS v2u*)(H1 + V * D) + F.lane;
#pragma unroll
            for (int j = 0; j < 4; ++j) { const v2u hw = hr[64 * j]; v[q][j] = (f32x4){bflo(hw.x), bfhi(hw.x), bflo(hw.y), bfhi(hw.y)}; }
#pragma unroll
            for (int k = 0; k < 4; ++k) { const GAS unsigned* yr = (const GAS unsigned*)(YB + (size_t)sl[q][k] * D) + F.lane;
#pragma unroll
                for (int j = 0; j < 4; ++j) y[q][k][j] = yr[64 * j]; } }
        CMB_SLOTS(R0 + 2 * NGW);
#pragma unroll
        for (int q = 0; q < 2; ++q) { const int R = R0 + q * NGW; if (R >= BATCH * SEQ) continue;
#pragma unroll
            for (int k = 0; k < 4; ++k)
#pragma unroll
                for (int j = 0; j < 4; ++j) { const unsigned w = y[q][k][j]; const f32v2_t lo = __builtin_amdgcn_cvt_pk_f32_fp8(w, false), hi = __builtin_amdgcn_cvt_pk_f32_fp8(w, true);
                    v[q][j].x += lo[0] * 0.0625f; v[q][j].y += lo[1] * 0.0625f; v[q][j].z += hi[0] * 0.0625f; v[q][j].w += hi[1] * 0.0625f; }
            float s = 0.f;
#pragma unroll
            for (int j = 0; j < 4; ++j) s += (v[q][j].x * v[q][j].x + v[q][j].y * v[q][j].y) + (v[q][j].z * v[q][j].z + v[q][j].w * v[q][j].w);
            const float rs = 1.0f / sqrtf(wave_sum(s) * (1.f / D) + EPS);
            GAS f32x4* orow = (GAS f32x4*)(F.out + (size_t)R * D) + F.lane;
#pragma unroll
            for (int j = 0; j < 4; ++j) orow[64 * j] = v[q][j] * rs * nfv[j]; }
    }
#undef CMB_SLOTS
}

__device__ __forceinline__ int meta_row(int lane) { return ((lane >> 5) & 1) * 8 + ((lane >> 4) & 1) * 4 + ((lane >> 3) & 1) * 2 + ((lane >> 2) & 1); }
template <int KPL> __device__ __forceinline__ float meta_col(const LAS unsigned char* A, const bf16* wrow, int lane) {
    constexpr int K = 64 * KPL; float w[KPL];
#pragma unroll
    for (int j = 0; j < KPL / 8; ++j) { const v4u x = *(const GAS v4u*)(wrow + lane * KPL + 8 * j);
        w[8 * j] = bflo(x.x); w[8 * j + 1] = bfhi(x.x); w[8 * j + 2] = bflo(x.y); w[8 * j + 3] = bfhi(x.y); w[8 * j + 4] = bflo(x.z); w[8 * j + 5] = bfhi(x.z); w[8 * j + 6] = bflo(x.w); w[8 * j + 7] = bfhi(x.w); }
    float p[16];
#pragma unroll
    for (int r = 0; r < 16; ++r) { float s = 0.f;
#pragma unroll
        for (int j = 0; j < KPL / 8; ++j) { const v4u a = *(const LAS v4u*)(A + (r * K + lane * KPL + 8 * j) * 2);
            s += (bflo(a.x) * w[8 * j] + bfhi(a.x) * w[8 * j + 1]) + (bflo(a.y) * w[8 * j + 2] + bfhi(a.y) * w[8 * j + 3]) + (bflo(a.z) * w[8 * j + 4] + bfhi(a.z) * w[8 * j + 5]) + (bflo(a.w) * w[8 * j + 6] + bfhi(a.w) * w[8 * j + 7]); }
        p[r] = s; if ((r & 3) == 3) asm volatile("" ::: "memory"); }
    const bool b32 = lane & 32, b16 = lane & 16, b8 = lane & 8, b4 = lane & 4;
    float q8[8], q4[4], q2[2];
#pragma unroll
    for (int i = 0; i < 8; ++i) { const float keep = b32 ? p[i + 8] : p[i], send = b32 ? p[i] : p[i + 8]; q8[i] = keep + __shfl_xor(send, 32); }
#pragma unroll
    for (int i = 0; i < 4; ++i) { const float keep = b16 ? q8[i + 4] : q8[i], send = b16 ? q8[i] : q8[i + 4]; q4[i] = keep + __shfl_xor(send, 16); }
#pragma unroll
    for (int i = 0; i < 2; ++i) { const float keep = b8 ? q4[i + 2] : q4[i], send = b8 ? q4[i] : q4[i + 2]; q2[i] = keep + __shfl_xor(send, 8); }
    float v = (b4 ? q2[1] : q2[0]) + __shfl_xor(b4 ? q2[0] : q2[1], 4);
    v += __shfl_xor(v, 2); v += __shfl_xor(v, 1);
    return v;
}
__device__ __forceinline__ void meta_stage(Frame& F, LAS unsigned char* dst, const bf16* src, int K) {
    v4u t[4]; const int n = 16 * K / 8;
#pragma unroll
    for (int q = 0; q < 4; ++q) { const int u = F.tid + q * NTHREADS; if (u < n) t[q] = *(const GAS v4u*)(src + (size_t)u * 8); }
#pragma unroll
    for (int q = 0; q < 4; ++q) { const int u = F.tid + q * NTHREADS; if (u < n) *(LAS v4u*)(dst + u * 16) = t[q]; }
}
__device__ __forceinline__ void meta_proj(Frame& F) {
    unsigned char* ws = F.ws; const bf16* WIN = (const bf16*)(ws + WS_WIN); const float* lbl = F.in[IN_LBL];
    LAS unsigned char* A = F.lds + RING_OFF;
    __syncthreads(); meta_stage(F, A, (const bf16*)(ws + WS_XN0) + (size_t)NTOK * D, D); __syncthreads();
    for (int c = F.vcu * NWAVES + F.wave; c < NPROJ; c += F.G * NWAVES) {
        const float v = meta_col<16>(A, WIN + (size_t)c * D, F.lane);
        if ((F.lane & 3) == 0) { const size_t row = NTOK + meta_row(F.lane); const int kind = c < 3072 ? (c >> 9) : 6, cc = c & 511;
            if (kind == 0) ((bf16*)(ws + WS_HQ))[row * HW + cc] = (bf16)f2bf(fsilu(v));
            else if (kind == 1) { const float lb = fsigmoid(lbl[cc] - lbl[HW + cc]); ((float*)(ws + WS_HG))[row * HW + cc] = __logf(lb + (1.f - lb) * fsigmoid(v)); }
            else if (kind == 2) ((bf16*)(ws + WS_HV))[row * HW + cc] = (bf16)f2bf(v);
            else if (kind == 3) ((bf16*)(ws + WS_HGATE))[row * HW + cc] = (bf16)f2bf(fsilu(v));
            else if (kind == 4) ((bf16*)(ws + WS_MM))[row * HW + cc] = (bf16)f2bf(v);
            else if (kind == 5) ((bf16*)(ws + WS_MO))[row * HW + cc] = (bf16)f2bf(fsigmoid(v));
            else (ws + WS_GATES)[row * 2048 + pg8::gate_pos(c - 3072)] = (unsigned char)(__builtin_bit_cast(unsigned, __builtin_fmaf(fsigmoid(v), 255.f, 8388608.f)) & 0xffu); } }
}
__device__ __forceinline__ void meta_merged(Frame& F) {
    unsigned char* ws = F.ws; const unsigned char* GATES = ws + WS_GATES;
    LAS unsigned char* A0 = F.lds + RING_OFF; LAS unsigned char* A1 = A0 + 16 * HW * 2;
    __syncthreads(); meta_stage(F, A0, (const bf16*)(ws + WS_YHG) + (size_t)NTOK * HW, HW); meta_stage(F, A1, (const bf16*)(ws + WS_YML) + (size_t)NTOK * HW, HW); __syncthreads();
    for (int c = F.vcu * NWAVES + F.wave; c < D; c += F.G * NWAVES) {
        const float vh = meta_col<8>(A0, (const bf16*)(ws + WS_WBH) + (size_t)c * HW, F.lane), vm = meta_col<8>(A1, (const bf16*)(ws + WS_WBM) + (size_t)c * HW, F.lane);
        if ((F.lane & 3) == 0) { const size_t row = NTOK + meta_row(F.lane); ((bf16*)(ws + WS_MERGED))[row * D + c] = (bf16)f2bf(((float)GATES[row * 2048 + pg8::gate_pos(c)] * vh) * (1.f / 255.f) + ((float)GATES[row * 2048 + pg8::gate_pos(D + c)] * vm) * (1.f / 255.f)); } }
}
__device__ __forceinline__ void meta_wout(Frame& F) {
    unsigned char* ws = F.ws; LAS unsigned char* A = F.lds + RING_OFF;
    __syncthreads(); meta_stage(F, A, (const bf16*)(ws + WS_MERGED) + (size_t)NTOK * D, D); __syncthreads();
    for (int c = F.vcu * NWAVES + F.wave; c < D; c += F.G * NWAVES) {
        const float d = meta_col<16>(A, (const bf16*)(ws + WS_WOUT) + (size_t)c * D, F.lane);
        if ((F.lane & 3) == 0) { const int mr_ = meta_row(F.lane); const size_t row = NTOK + mr_; const float v = F.in[IN_META][(size_t)mr_ * D + c] + d;
            ((bf16*)(ws + WS_H1))[row * D + c] = (bf16)f2bf(v); ((unsigned char*)(ws + WS_H1B))[row * D + c] = (unsigned char)(__builtin_amdgcn_cvt_pk_fp8_f32(__builtin_amdgcn_fmed3f(v, -448.f, 448.f), 0.f, 0u, false) & 0xffu); } }
}

__device__ __forceinline__ void ph_proj(Frame& F) {
    unsigned char* ws = F.ws;
    pg8::Gemm g{(const pg8::bf16_t*)(ws + WS_XN0), (const pg8::bf16_t*)(ws + WS_WIN), NTOK, NPROJ, D}; pg8::StaticOrder S; S.init(NTOK, NPROJ, F.G, (int)blockIdx.x);
    pg8::EpiProj E{ws, F.in[IN_LBL]};
    pg8::gemm_phase<pg8::EpiProj, pg8::StaticOrder, true, true>(F.lds + RING_OFF, g, S, E);
    meta_proj(F);
}
__device__ __forceinline__ void ph_scan(Frame& F) {
    const int sb = (int)blockIdx.x;
    if (sb < 64) p3_hgrn2_mfma(F, sb); else if (sb < 128) p3_mlstm_mfma(F, sb - 64);
#if !CONV_IN_P0
    else px_experts(F, sb - 128, F.G - 128);
#endif
}
__device__ __forceinline__ void ph_merged(Frame& F) {
    unsigned char* ws = F.ws;
    static_assert(WS_YML - WS_YHG == (size_t)pg8::PAIR_DA * 256 * HW * 2 && WS_WBM - WS_WBH == (size_t)pg8::PAIR_DB * 256 * HW * 2, "the second branch's operands sit a whole number of tiles behind the first's");
    pg8::PairOrder S; S.S.init(NTOK, D, F.G, (int)blockIdx.x);
    pg8::Gemm g{(const pg8::bf16_t*)(ws + WS_YHG), (const pg8::bf16_t*)(ws + WS_WBH), NTOK, D, HW};
    pg8::EpiGate2 E{(const unsigned char*)(ws + WS_GATES), (pg8::bf16_t*)(ws + WS_TMP), (pg8::bf16_t*)(ws + WS_MERGED)};
    pg8::gemm_phase<pg8::EpiGate2, pg8::PairOrder, true, true>(F.lds + RING_OFF, g, S, E);
    meta_merged(F);
}
__device__ __forceinline__ void ph_wout(Frame& F) {
    unsigned char* ws = F.ws;
    pg8::Gemm g{(const pg8::bf16_t*)(ws + WS_MERGED), (const pg8::bf16_t*)(ws + WS_WOUT), NTOK, D, D}; pg8::StaticOrder S; S.init(NTOK, D, F.G, (int)blockIdx.x);
    pg8::EpiH1 E{(const pg8::bf16_t*)(ws + WS_XN0), (const float*)(ws + WS_XSQ), (pg8::bf16_t*)(ws + WS_H1), (unsigned char*)(ws + WS_H1B)};
    pg8::gemm_phase<pg8::EpiH1, pg8::StaticOrder, true, true>(F.lds + RING_OFF, g, S, E);
    meta_wout(F);
}
__device__ __forceinline__ void ph_gu(Frame& F) {
    unsigned char* ws = F.ws; build_tables(F);
    const LAS int* pst = (const LAS int*)(F.lds + PST_OFF); LAS unsigned short* tok16 = (LAS unsigned short*)(F.lds + TOK_OFF);
    pg8::Gemm g{(const pg8::bf16_t*)(ws + WS_H1B), (const pg8::bf16_t*)(ws + WS_WGU), NV, NE * 2 * DFF, D / 2};
    pg8::GroupOrder S{pst[32], 8, F.G, (int)blockIdx.x, (const LAS unsigned char*)(F.lds + TEXP_OFF)};
    { const int* ETOK = (const int*)(ws + WS_ETOK);
      int tokv[18];
#pragma unroll
      for (int i = 0; i < 18; ++i) { pg8::Unit u; int t = 0; if (S.next(i, u) && F.tid < 256) { const int e = u.pn >> 3, pos = u.pm * 256 - pst[e] + F.tid; if (pos < pst[33 + e]) t = ETOK[(size_t)e * NV + pos]; } tokv[i] = t; }
      if (F.tid < 256) {
#pragma unroll
          for (int i = 0; i < 18; ++i) tok16[i * 256 + F.tid] = (unsigned short)tokv[i]; }
      __syncthreads(); }
    pg8::EpiGU E{(const float*)(ws + WS_BGUP), (const float*)(ws + WS_ERS), (unsigned char*)(ws + WS_ACT), pst};
    pg8::gemm_phase_g<pg8::EpiGU, pg8::GroupOrder, true>(F.lds + RING_OFF, g, S, E, tok16);
}
__device__ __forceinline__ void ph_down(Frame& F) {
    unsigned char* ws = F.ws; build_tables(F);
    pg8::Gemm g{(const pg8::bf16_t*)(ws + WS_ACT), (const pg8::bf16_t*)(ws + WS_WDN), MAXTILES * 256, NE * D, DFF / 2};
    pg8::GroupOrder S{((const LAS int*)(F.lds + PST_OFF))[32], 4, F.G, (int)blockIdx.x, (const LAS unsigned char*)(F.lds + TEXP_OFF)};
    pg8::EpiDown E{F.in[IN_BDN], (const float*)(ws + WS_EW), (unsigned char*)(ws + WS_YB), (const LAS int*)(F.lds + PST_OFF)};
    pg8::gemm_phase<pg8::EpiDown, pg8::GroupOrder, true, true, true>(F.lds + RING_OFF, g, S, E);
}

#ifndef CONV_IN_P0
#define CONV_IN_P0 0
#endif
#ifndef PROBE_DOUBLE
#define PROBE_DOUBLE 0
#endif
#define DBL(k) ((PROBE_DOUBLE >> (k)) & 1)
#ifndef MK_N_LAUNCHES
#define MK_N_LAUNCHES 1
#endif
constexpr int NPHASE = 9;
struct Args { const float* in[25]; float* out; unsigned char* ws; int ph_lo, ph_hi, li, pad; };
__global__ void __launch_bounds__(NTHREADS, 2) fwd_kernel(Args args) {
    extern __shared__ __attribute__((aligned(16))) unsigned char lds[];
    Frame F;
    F.lds = (LAS unsigned char*)lds; F.MISC = (volatile LAS unsigned*)(F.lds + MISC_OFF);
    F.tid = threadIdx.x; F.lane = F.tid & 63; F.wave = __builtin_amdgcn_readfirstlane(F.tid >> 6);
    F.G = gridDim.x; { const int bx = blockIdx.x; F.vcu = (F.G % 8 == 0) ? (bx % 8) * (F.G / 8) + bx / 8 : bx; }
    F.ws = args.ws; F.ctl = (gu32*)(args.ws + WS_CTL); F.out = args.out;
#pragma unroll
    for (int i = 0; i < 25; ++i) F.in[i] = args.in[i];
    { int t0 = F.tid; asm volatile("" : "+v"(t0)); if (t0 < 64) F.MISC[t0] = 0u; }
    __syncthreads();
    const int lo = args.ph_lo, hi = args.ph_hi;
    XcdBarrier bar; bar.bar = (unsigned*)(F.ctl + CW_BAR) + args.li * XCD_BAR_WORDS; bar.x = 0; bar.st = nullptr;
    if (hi - lo > 1) bar = xcd_barrier_post((unsigned*)(F.ctl + CW_BAR) + args.li * XCD_BAR_WORDS, F.MISC + 8);
#define IN(k) (lo <= (k) && (k) < hi)
#define SEAM(k) do { if (IN(k) && IN((k) + 1)) xcd_barrier(bar); } while (0)

    if (IN(0)) { p0_prologue(F);
#if CONV_IN_P0
        __syncthreads(); px_experts(F, F.vcu, F.G);
#endif
    } SEAM(0);
    if (IN(1)) { ph_proj(F); } SEAM(1);
    if (IN(2)) { ph_scan(F); } SEAM(2);
    if (IN(3)) { ph_merged(F); } SEAM(3);
    if (IN(4)) { ph_wout(F); } SEAM(4);
    if (IN(5)) { p6_router(F); } SEAM(5);
    if (IN(6)) { ph_gu(F); } SEAM(6);
    if (IN(7)) { ph_down(F); } SEAM(7);
    if (IN(8)) { p10_combine(F); }
#undef IN
#undef SEAM
}

extern "C" void kernel_launch(void* const* d_in, const int* in_sizes, int n_in, void* d_out, int out_size, void* d_ws, size_t ws_size, hipStream_t stream) {
    static int grid = 0;
    if (grid == 0) {
        if (n_in != 25 || in_sizes[0] != BATCH * SEQ * D || out_size != BATCH * SEQ * D || ws_size < WS_END) { fprintf(stderr, "kernel_launch: unexpected shapes (n_in %d, in0 %d, out %d, ws %zu); nothing launched\n", n_in, n_in > 0 ? in_sizes[0] : -1, out_size, ws_size); grid = -1; return; }
        int dev = 0, cus = 0, per_cu = 0;
        if (hipGetDevice(&dev) != hipSuccess || hipDeviceGetAttribute(&cus, hipDeviceAttributeMultiprocessorCount, dev) != hipSuccess) { grid = -1; return; }
        if (hipFuncSetAttribute((const void*)fwd_kernel, hipFuncAttributeMaxDynamicSharedMemorySize, LDS_BYTES) != hipSuccess) { fprintf(stderr, "kernel_launch: hipFuncSetAttribute failed\n"); grid = -1; return; }
        if (hipOccupancyMaxActiveBlocksPerMultiprocessor(&per_cu, (const void*)fwd_kernel, NTHREADS, LDS_BYTES) != hipSuccess || per_cu < 1) { fprintf(stderr, "kernel_launch: occupancy query reports %d blocks per CU\n", per_cu); }
        (void)hipGetLastError();
        grid = 256;
        if (cus < 256) { fprintf(stderr, "kernel_launch: %d CUs < 256: the grid would not be resident; nothing launched\n", cus); grid = -1; return; }
    }
    if (grid < 0) return;
    if (hipMemsetAsync((char*)d_ws + WS_CTL, 0, CTL_ZERO_BYTES, stream) != hipSuccess) return;
    Args a{};
    for (int i = 0; i < 25; ++i) a.in[i] = (const float*)d_in[i];
    a.out = (float*)d_out; a.ws = (unsigned char*)d_ws; a.pad = 0;
#if MK_N_LAUNCHES == 1
    a.ph_lo = 0; a.ph_hi = NPHASE; a.li = 0;
    hipLaunchKernelGGL(fwd_kernel, dim3(grid), dim3(NTHREADS), LDS_BYTES, stream, a);
#else
    for (int p = 0; p < NPHASE; ++p) for (int rep = 0; rep <= DBL(p); ++rep) { a.ph_lo = p; a.ph_hi = p + 1; a.li = 0; hipLaunchKernelGGL(fwd_kernel, dim3(grid), dim3(NTHREADS), LDS_BYTES, stream, a); }
#endif
}
```

```cpp
#include <hip/hip_runtime.h>
#include <cstdio>
#include <cstdint>
namespace pg8 {
#define PG8_LAS __attribute__((address_space(3)))
typedef unsigned short bf16_t;
typedef short bf16x8 __attribute__((ext_vector_type(8)));
typedef float f32x4 __attribute__((ext_vector_type(4)));
typedef unsigned u32x4 __attribute__((ext_vector_type(4)));
constexpr int BM = 256, BK = 64, HALF = 128, HTB = HALF * BK * 2  , STAGE_BYTES = 8 * HTB, NXCD = 8, WGM = 8;

__host__ __device__ __forceinline__ int lds_byte(int r, int c) { const int st = (r >> 4) * 2 + (c >> 5), rr = r & 15, cc = c & 31, ob = rr * 64 + cc * 2; return st * 1024 + (ob ^ (((ob >> 9) & 1) << 5)); }
__host__ __device__ __forceinline__ void stage_rc(int b, int& R, int& C) { const int st = b / 1024, sb = b % 1024, swz = sb ^ (((sb >> 9) & 1) << 5); R = (st >> 1) * 16 + swz / 64; C = (st & 1) * 32 + (swz % 64) / 2; }
__host__ __device__ __forceinline__ int perm32(int rho) { const int n = rho >> 4, i = rho & 15; return 8 * (i >> 2) + 4 * n + (i & 3); }

struct Unit { int pm, pn; };
struct Gemm { const bf16_t* A; const bf16_t* Bt; int M, N, K; };

struct StaticOrder {
    int nM, nN, nwg, G, c;
    __host__ __device__ void init(int M, int N, int G_, int c_) { nM = M / BM; nN = N / BM; nwg = nM * nN; G = G_; c = c_; }
    __host__ __device__ __forceinline__ bool next(int i, Unit& u) const {
        const long L = (long)i * G + c; if (L >= nwg) return false;
        int wgid = (int)L; { const int q = nwg / NXCD, r = nwg % NXCD, xcd = wgid % NXCD, off = wgid / NXCD; wgid = (xcd < r ? xcd * (q + 1) : r * (q + 1) + (xcd - r) * q) + off; }
        const int nig = WGM * nN, gid = wgid / nig, fm = gid * WGM, gsz = (nM - fm) < WGM ? (nM - fm) : WGM;
        u.pm = fm + ((wgid % nig) % gsz); u.pn = (wgid % nig) / gsz; return true;
    }
    __device__ __forceinline__ void a_ready(const Unit&) const {}
    __device__ __forceinline__ void done(const Unit&) const {}
};

typedef __bf16 bf16v2 __attribute__((ext_vector_type(2)));
typedef float f32v2 __attribute__((ext_vector_type(2)));
__device__ __forceinline__ unsigned cvt_pk_bf16(float lo, float hi) { const f32v2 v = {lo, hi}; return __builtin_bit_cast(unsigned, __builtin_convertvector(v, bf16v2)); }
typedef float f32x2 __attribute__((ext_vector_type(2)));
typedef int i32x4 __attribute__((ext_vector_type(4)));
typedef int i32x8 __attribute__((ext_vector_type(8)));
__device__ __forceinline__ i32x8 cat8(const bf16x8 a, const bf16x8 b) { const i32x4 x = __builtin_bit_cast(i32x4, a), y = __builtin_bit_cast(i32x4, b); return __builtin_shufflevector(x, y, 0, 1, 2, 3, 4, 5, 6, 7); }
template <class Epi, class Sched, bool ALIGN_EPI = false, bool SP2 = false, bool FP8 = false>
__device__ __forceinline__ void gemm_phase(PG8_LAS unsigned char* lds, const Gemm g, const Sched& S, const Epi& E) {
    const int tid = threadIdx.x, wid = __builtin_amdgcn_readfirstlane(tid >> 6), lane = tid & 63, wr = wid >> 2, wc = wid & 3, fr = lane & 15, fq = lane >> 4;
    const int K = g.K, nt = K / BK;
    unsigned voffA[2], voffB[2];
#pragma unroll
    for (int i = 0; i < 2; ++i) { int R, C; stage_rc(tid * 16 + i * 8192, R, C); const int Rb = Epi::PERM ? ((R & ~31) + perm32(R & 31)) : R;
        voffA[i] = (unsigned)(R * K + C) * 2u; voffB[i] = (unsigned)(Rb * K + C) * 2u; }
    const size_t kstep = (size_t)(BK * 2);
    const size_t hstep = (size_t)HALF * K * 2;
    const size_t tstep = 2 * hstep;
    const unsigned ldsw = (unsigned)wid * 1024u;
    const int aoff = lds_byte(wr * 64 + fr, fq * 8), boff = lds_byte(wc * 32 + fr, fq * 8);
#define PG8_SA(b, h) (((b) * 2 + (h)) * HTB)
#define PG8_SB(b, h) ((4 + (b) * 2 + (h)) * HTB)
#define PG8_STAGE(bufoff, gbase, voff) do { _Pragma("unroll") for (int _i = 0; _i < 2; ++_i) \
        __builtin_amdgcn_global_load_lds((const unsigned*)((const char*)(gbase) + (voff)[_i]), (PG8_LAS unsigned*)(lds + (bufoff) + ldsw + _i * 8192), 16, 0, 0); } while (0)
#define PG8_LDA(dst, b, h) do { _Pragma("unroll") for (int m = 0; m < 4; ++m) { if constexpr (FP8) dst##8[m] = cat8(*(const PG8_LAS bf16x8*)(lds + PG8_SA(b, h) + aoff + m * 2048), *(const PG8_LAS bf16x8*)(lds + PG8_SA(b, h) + aoff + m * 2048 + 1024)); \
        else { _Pragma("unroll") for (int k = 0; k < 2; ++k) dst[m][k] = *(const PG8_LAS bf16x8*)(lds + PG8_SA(b, h) + aoff + m * 2048 + k * 1024); } } } while (0)
#define PG8_LDB(dst, b, h) do { _Pragma("unroll") for (int n = 0; n < 2; ++n) { if constexpr (FP8) dst##8[n] = cat8(*(const PG8_LAS bf16x8*)(lds + PG8_SB(b, h) + boff + n * 2048), *(const PG8_LAS bf16x8*)(lds + PG8_SB(b, h) + boff + n * 2048 + 1024)); \
        else { _Pragma("unroll") for (int k = 0; k < 2; ++k) dst[n][k] = *(const PG8_LAS bf16x8*)(lds + PG8_SB(b, h) + boff + n * 2048 + k * 1024); } } } while (0)
#define PG8_MMA(ai, bj, At, Bt) do { __builtin_amdgcn_s_setprio(1); _Pragma("unroll") for (int m = 0; m < 4; ++m) _Pragma("unroll") for (int n = 0; n < 2; ++n) { \
        if constexpr (FP8) acc[ai][bj][m][n] = __builtin_amdgcn_mfma_scale_f32_16x16x128_f8f6f4(Bt##8[n], At##8[m], acc[ai][bj][m][n], 0, 0, 0, 0x7f7f7f7f, 0, 0x7f7f7f7f); \
        else { _Pragma("unroll") for (int k = 0; k < 2; ++k) acc[ai][bj][m][n] = __builtin_amdgcn_mfma_f32_16x16x32_bf16(Bt[n][k], At[m][k], acc[ai][bj][m][n], 0, 0, 0); } } \
        if constexpr (FP8) { _Pragma("unroll") for (int m = 0; m < 4; ++m) _Pragma("unroll") for (int n = 0; n < 2; ++n) asm volatile("" : "+v"(acc[ai][bj][m][n])); }     \
        __builtin_amdgcn_s_setprio(0); } while (0)
#define PG8_WAIT_V(n) asm volatile("s_waitcnt vmcnt(" #n ")" ::: "memory")
#define PG8_WAIT_L(n) asm volatile("s_waitcnt lgkmcnt(" #n ")" ::: "memory")
#define PG8_BAR __builtin_amdgcn_s_barrier()
#define PG8_SCHED __builtin_amdgcn_sched_barrier(0)
    Unit cur, nxt; int ui = 0;
    if (!S.next(0, cur)) return;
    f32x4 acc[2][2][4][2];
#pragma unroll
    for (int a = 0; a < 2; ++a)
#pragma unroll
        for (int b = 0; b < 2; ++b)
#pragma unroll
            for (int m = 0; m < 4; ++m)
#pragma unroll
                for (int n = 0; n < 2; ++n) acc[a][b][m][n] = (f32x4){0.f, 0.f, 0.f, 0.f};
    bf16x8 At[4][2], B0[2][2], B1[2][2]; i32x8 At8[4], B08[2], B18[2];
    const char* cA = (const char*)g.A + (size_t)cur.pm * tstep; const char* cB = (const char*)g.Bt + (size_t)cur.pn * tstep;
    S.a_ready(cur);
    if constexpr (SP2) {
        PG8_STAGE(PG8_SB(0, 0), cB, voffB); PG8_STAGE(PG8_SB(0, 1), cB + hstep, voffB); PG8_STAGE(PG8_SA(0, 0), cA, voffA); PG8_STAGE(PG8_SA(0, 1), cA + hstep, voffA);
        if (wr == 1) PG8_BAR;
        PG8_WAIT_V(2); PG8_BAR;
        PG8_STAGE(PG8_SB(1, 0), cB + kstep, voffB); PG8_STAGE(PG8_SA(1, 0), cA + kstep, voffA); PG8_STAGE(PG8_SB(1, 1), cB + hstep + kstep, voffB);
        PG8_WAIT_V(6); PG8_BAR;
    } else {
        PG8_STAGE(PG8_SB(0, 0), cB, voffB); PG8_STAGE(PG8_SA(0, 0), cA, voffA); PG8_STAGE(PG8_SB(0, 1), cB + hstep, voffB); PG8_STAGE(PG8_SA(0, 1), cA + hstep, voffA);
        if (wr == 1) PG8_BAR;
        PG8_WAIT_V(4); PG8_BAR;
        PG8_STAGE(PG8_SB(1, 0), cB + kstep, voffB); PG8_STAGE(PG8_SA(1, 0), cA + kstep, voffA); PG8_STAGE(PG8_SB(1, 1), cB + hstep + kstep, voffB);
        PG8_WAIT_V(6); PG8_BAR;
    }
    for (;;) {
        const bool has_next = S.next(ui + 1, nxt);
        const char* nA = has_next ? (const char*)g.A + (size_t)nxt.pm * tstep : cA; const char* nB = has_next ? (const char*)g.Bt + (size_t)nxt.pn * tstep : cB;
        for (int t = 0; t < nt; t += 2) {
            const bool last = (t == nt - 2);
            const char* a1 = cA + (size_t)(t + 1) * kstep;
            const char* a2 = last ? nA : cA + (size_t)(t + 2) * kstep; const char* b2 = last ? nB : cB + (size_t)(t + 2) * kstep;
            const char* a3 = a2 + kstep; const char* b3 = b2 + kstep;
            if (last && has_next) S.a_ready(nxt);
            if constexpr (SP2) {
            PG8_LDB(B0, 0, 0); PG8_LDB(B1, 0, 1); PG8_SCHED; PG8_LDA(At, 0, 0); PG8_STAGE(PG8_SA(1, 1), a1 + hstep, voffA);
            PG8_WAIT_V(8); PG8_WAIT_L(0); PG8_BAR; PG8_MMA(0, 0, At, B0); PG8_MMA(0, 1, At, B1); PG8_BAR; PG8_SCHED;
            PG8_LDA(At, 0, 1); PG8_STAGE(PG8_SB(0, 0), b2, voffB); PG8_STAGE(PG8_SB(0, 1), b2 + hstep, voffB); PG8_STAGE(PG8_SA(0, 0), a2, voffA);
            PG8_WAIT_V(8); PG8_WAIT_L(0); PG8_BAR; PG8_MMA(1, 0, At, B0); PG8_MMA(1, 1, At, B1); PG8_BAR; PG8_SCHED;
            PG8_LDB(B0, 1, 0); PG8_LDB(B1, 1, 1); PG8_SCHED; PG8_LDA(At, 1, 0); PG8_STAGE(PG8_SA(0, 1), a2 + hstep, voffA);
            PG8_WAIT_V(8); PG8_WAIT_L(0); PG8_BAR; PG8_MMA(0, 0, At, B0); PG8_MMA(0, 1, At, B1); PG8_BAR; PG8_SCHED;
            PG8_LDA(At, 1, 1); PG8_STAGE(PG8_SB(1, 0), b3, voffB); PG8_STAGE(PG8_SB(1, 1), b3 + hstep, voffB); PG8_STAGE(PG8_SA(1, 0), a3, voffA);
            PG8_WAIT_V(8); PG8_WAIT_L(0); PG8_BAR; PG8_MMA(1, 0, At, B0); PG8_MMA(1, 1, At, B1); PG8_BAR; PG8_SCHED;
            } else {
            PG8_LDB(B0, 0, 0); PG8_SCHED; PG8_LDA(At, 0, 0); PG8_STAGE(PG8_SA(1, 1), a1 + hstep, voffA);
            PG8_WAIT_L(8); PG8_BAR; PG8_WAIT_L(0); PG8_MMA(0, 0, At, B0); PG8_BAR; PG8_SCHED;
            PG8_LDB(B1, 0, 1); PG8_STAGE(PG8_SB(0, 0), b2, voffB);
            PG8_BAR; PG8_WAIT_L(0); PG8_MMA(0, 1, At, B1); PG8_BAR;
            PG8_LDA(At, 0, 1); PG8_STAGE(PG8_SA(0, 0), a2, voffA);
            PG8_BAR; PG8_WAIT_L(0); PG8_MMA(1, 0, At, B0); PG8_BAR; PG8_SCHED;
            PG8_STAGE(PG8_SB(0, 1), b2 + hstep, voffB);
            PG8_WAIT_V(6); PG8_BAR; PG8_MMA(1, 1, At, B1); PG8_BAR;
            PG8_LDB(B0, 1, 0); PG8_SCHED; PG8_LDA(At, 1, 0); PG8_STAGE(PG8_SA(0, 1), a2 + hstep, voffA);
            PG8_WAIT_L(8); PG8_BAR; PG8_WAIT_L(0); PG8_MMA(0, 0, At, B0); PG8_BAR; PG8_SCHED;
            PG8_LDB(B1, 1, 1); PG8_STAGE(PG8_SB(1, 0), b3, voffB);
            PG8_BAR; PG8_WAIT_L(0); PG8_MMA(0, 1, At, B1); PG8_BAR;
            PG8_LDA(At, 1, 1); PG8_STAGE(PG8_SA(1, 0), a3, voffA);
            PG8_BAR; PG8_WAIT_L(0); PG8_MMA(1, 0, At, B0); PG8_BAR; PG8_SCHED;
            PG8_STAGE(PG8_SB(1, 1), b3 + hstep, voffB);
            PG8_WAIT_V(6); PG8_BAR; PG8_MMA(1, 1, At, B1); PG8_BAR;
            }
        }
        if constexpr (ALIGN_EPI) { if (wr == 0) PG8_BAR; }
        if constexpr (!Epi::AFTER_DRAIN) { E(acc, cur, wr, wc, fr, fq); S.done(cur); }
        if (!has_next) break;
#pragma unroll
        for (int a = 0; a < 2; ++a)
#pragma unroll
            for (int b = 0; b < 2; ++b)
#pragma unroll
                for (int m = 0; m < 4; ++m)
#pragma unroll
                    for (int n = 0; n < 2; ++n) acc[a][b][m][n] = (f32x4){0.f, 0.f, 0.f, 0.f};
        cur = nxt; cA = nA; cB = nB; ++ui;
        if constexpr (ALIGN_EPI) { if (wr == 1) PG8_BAR; }
    }
    PG8_WAIT_V(0);
    if constexpr (!ALIGN_EPI) { if (wr == 0) PG8_BAR; }
    PG8_BAR;
    if constexpr (Epi::AFTER_DRAIN) { E.fused(acc, cur, wr, wc, fr, fq, lds, wid, lane); S.done(cur); }
#undef PG8_SA
#undef PG8_SB
#undef PG8_STAGE
#undef PG8_LDA
#undef PG8_LDB
#undef PG8_MMA
#undef PG8_WAIT_V
#undef PG8_WAIT_L
#undef PG8_BAR
#undef PG8_SCHED
}
template <class Epi, class Sched, bool FP8 = false>
__device__ __forceinline__ void gemm_phase_g(PG8_LAS unsigned char* lds, const Gemm g, const Sched& S, const Epi& E, const PG8_LAS unsigned short* tok16) {
    constexpr bool ALIGN_EPI = true, SP2 = true;
    const int tid = threadIdx.x, wid = __builtin_amdgcn_readfirstlane(tid >> 6), lane = tid & 63, wr = wid >> 2, wc = wid & 3, fr = lane & 15, fq = lane >> 4;
    const int K = g.K, nt = K / BK;
    unsigned voffB[2]; int RA[2]; unsigned CA[2];
#pragma unroll
    for (int i = 0; i < 2; ++i) { int R, C; stage_rc(tid * 16 + i * 8192, R, C); const int Rb = Epi::PERM ? ((R & ~31) + perm32(R & 31)) : R;
        RA[i] = R; CA[i] = (unsigned)C * 2u; voffB[i] = (unsigned)(Rb * K + C) * 2u; }
    unsigned oc[2][2];
#define PG8_TOKS(dst, ui_) do { _Pragma("unroll") for (int _h = 0; _h < 2; ++_h) _Pragma("unroll") for (int _i = 0; _i < 2; ++_i) \
        dst[_h][_i] = (unsigned)tok16[(ui_) * 256 + _h * HALF + RA[_i]] * (unsigned)(K * 2) + CA[_i]; } while (0)
    const size_t kstep = (size_t)(BK * 2);
    const size_t hstep = (size_t)HALF * K * 2;
    const size_t tstep = 2 * hstep;
    const unsigned ldsw = (unsigned)wid * 1024u;
    const int aoff = lds_byte(wr * 64 + fr, fq * 8), boff = lds_byte(wc * 32 + fr, fq * 8);
#define PG8_SA(b, h) (((b) * 2 + (h)) * HTB)
#define PG8_SB(b, h) ((4 + (b) * 2 + (h)) * HTB)
#define PG8_STAGE(bufoff, gbase, voff) do { _Pragma("unroll") for (int _i = 0; _i < 2; ++_i) \
        __builtin_amdgcn_global_load_lds((const unsigned*)((const char*)(gbase) + (voff)[_i]), (PG8_LAS unsigned*)(lds + (bufoff) + ldsw + _i * 8192), 16, 0, 0); } while (0)
#define PG8_LDA(dst, b, h) do { _Pragma("unroll") for (int m = 0; m < 4; ++m) { if constexpr (FP8) dst##8[m] = cat8(*(const PG8_LAS bf16x8*)(lds + PG8_SA(b, h) + aoff + m * 2048), *(const PG8_LAS bf16x8*)(lds + PG8_SA(b, h) + aoff + m * 2048 + 1024)); \
        else { _Pragma("unroll") for (int k = 0; k < 2; ++k) dst[m][k] = *(const PG8_LAS bf16x8*)(lds + PG8_SA(b, h) + aoff + m * 2048 + k * 1024); } } } while (0)
#define PG8_LDB(dst, b, h) do { _Pragma("unroll") for (int n = 0; n < 2; ++n) { if constexpr (FP8) dst##8[n] = cat8(*(const PG8_LAS bf16x8*)(lds + PG8_SB(b, h) + boff + n * 2048), *(const PG8_LAS bf16x8*)(lds + PG8_SB(b, h) + boff + n * 2048 + 1024)); \
        else { _Pragma("unroll") for (int k = 0; k < 2; ++k) dst[n][k] = *(const PG8_LAS bf16x8*)(lds + PG8_SB(b, h) + boff + n * 2048 + k * 1024); } } } while (0)
#define PG8_MMA(ai, bj, At, Bt) do { __builtin_amdgcn_s_setprio(1); _Pragma("unroll") for (int m = 0; m < 4; ++m) _Pragma("unroll") for (int n = 0; n < 2; ++n) { \
        if constexpr (FP8) acc[ai][bj][m][n] = __builtin_amdgcn_mfma_scale_f32_16x16x128_f8f6f4(Bt##8[n], At##8[m], acc[ai][bj][m][n], 0, 0, 0, 0x7f7f7f7f, 0, 0x7f7f7f7f); \
        else { _Pragma("unroll") for (int k = 0; k < 2; ++k) acc[ai][bj][m][n] = __builtin_amdgcn_mfma_f32_16x16x32_bf16(Bt[n][k], At[m][k], acc[ai][bj][m][n], 0, 0, 0); } } \
        if constexpr (FP8) { _Pragma("unroll") for (int m = 0; m < 4; ++m) _Pragma("unroll") for (int n = 0; n < 2; ++n) asm volatile("" : "+v"(acc[ai][bj][m][n])); }     \
        __builtin_amdgcn_s_setprio(0); } while (0)
#define PG8_WAIT_V(n) asm volatile("s_waitcnt vmcnt(" #n ")" ::: "memory")
#define PG8_WAIT_L(n) asm volatile("s_waitcnt lgkmcnt(" #n ")" ::: "memory")
#define PG8_BAR __builtin_amdgcn_s_barrier()
#define PG8_SCHED __builtin_amdgcn_sched_barrier(0)
    Unit cur, nxt; int ui = 0;
    if (!S.next(0, cur)) return;
    f32x4 acc[2][2][4][2];
#pragma unroll
    for (int a = 0; a < 2; ++a)
#pragma unroll
        for (int b = 0; b < 2; ++b)
#pragma unroll
            for (int m = 0; m < 4; ++m)
#pragma unroll
                for (int n = 0; n < 2; ++n) acc[a][b][m][n] = (f32x4){0.f, 0.f, 0.f, 0.f};
    bf16x8 At[4][2], B0[2][2], B1[2][2]; i32x8 At8[4], B08[2], B18[2];
    const char* cA = (const char*)g.A; const char* cB = (const char*)g.Bt + (size_t)cur.pn * tstep; PG8_TOKS(oc, 0);
    S.a_ready(cur);
    if constexpr (SP2) {
        PG8_STAGE(PG8_SB(0, 0), cB, voffB); PG8_STAGE(PG8_SB(0, 1), cB + hstep, voffB); PG8_STAGE(PG8_SA(0, 0), cA, oc[0]); PG8_STAGE(PG8_SA(0, 1), cA, oc[1]);
        if (wr == 1) PG8_BAR;
        PG8_WAIT_V(2); PG8_BAR;
        PG8_STAGE(PG8_SB(1, 0), cB + kstep, voffB); PG8_STAGE(PG8_SA(1, 0), cA + kstep, oc[0]); PG8_STAGE(PG8_SB(1, 1), cB + hstep + kstep, voffB);
        PG8_WAIT_V(6); PG8_BAR;
    } else {
        PG8_STAGE(PG8_SB(0, 0), cB, voffB); PG8_STAGE(PG8_SA(0, 0), cA, oc[0]); PG8_STAGE(PG8_SB(0, 1), cB + hstep, voffB); PG8_STAGE(PG8_SA(0, 1), cA + hstep, oc[0]);
        if (wr == 1) PG8_BAR;
        PG8_WAIT_V(4); PG8_BAR;
        PG8_STAGE(PG8_SB(1, 0), cB + kstep, voffB); PG8_STAGE(PG8_SA(1, 0), cA + kstep, oc[0]); PG8_STAGE(PG8_SB(1, 1), cB + hstep + kstep, voffB);
        PG8_WAIT_V(6); PG8_BAR;
    }
    for (;;) {
        const bool has_next = S.next(ui + 1, nxt);
        const char* nB = has_next ? (const char*)g.Bt + (size_t)nxt.pn * tstep : cB;
        for (int t = 0; t < nt; t += 2) {
            const bool last = (t == nt - 2);
            const char* a1 = cA + (size_t)(t + 1) * kstep;
            const char* a2 = last ? cA : cA + (size_t)(t + 2) * kstep; const char* b2 = last ? nB : cB + (size_t)(t + 2) * kstep;
            unsigned o2[2][2]; if (last && has_next) PG8_TOKS(o2, ui + 1); else { _Pragma("unroll") for (int _h = 0; _h < 2; ++_h) _Pragma("unroll") for (int _i = 0; _i < 2; ++_i) o2[_h][_i] = oc[_h][_i]; }
            const char* a3 = a2 + kstep; const char* b3 = b2 + kstep;
            if (last && has_next) S.a_ready(nxt);
            if constexpr (SP2) {
            PG8_LDB(B0, 0, 0); PG8_LDB(B1, 0, 1); PG8_SCHED; PG8_LDA(At, 0, 0); PG8_STAGE(PG8_SA(1, 1), a1, oc[1]);
            PG8_WAIT_V(8); PG8_WAIT_L(0); PG8_BAR; PG8_MMA(0, 0, At, B0); PG8_MMA(0, 1, At, B1); PG8_BAR; PG8_SCHED;
            PG8_LDA(At, 0, 1); PG8_STAGE(PG8_SB(0, 0), b2, voffB); PG8_STAGE(PG8_SB(0, 1), b2 + hstep, voffB); PG8_STAGE(PG8_SA(0, 0), a2, o2[0]);
            PG8_WAIT_V(8); PG8_WAIT_L(0); PG8_BAR; PG8_MMA(1, 0, At, B0); PG8_MMA(1, 1, At, B1); PG8_BAR; PG8_SCHED;
            PG8_LDB(B0, 1, 0); PG8_LDB(B1, 1, 1); PG8_SCHED; PG8_LDA(At, 1, 0); PG8_STAGE(PG8_SA(0, 1), a2, o2[1]);
            PG8_WAIT_V(8); PG8_WAIT_L(0); PG8_BAR; PG8_MMA(0, 0, At, B0); PG8_MMA(0, 1, At, B1); PG8_BAR; PG8_SCHED;
            PG8_LDA(At, 1, 1); PG8_STAGE(PG8_SB(1, 0), b3, voffB); PG8_STAGE(PG8_SB(1, 1), b3 + hstep, voffB); PG8_STAGE(PG8_SA(1, 0), a3, o2[0]);
            PG8_WAIT_V(8); PG8_WAIT_L(0); PG8_BAR; PG8_MMA(1, 0, At, B0); PG8_MMA(1, 1, At, B1); PG8_BAR; PG8_SCHED;
            } else {
            PG8_LDB(B0, 0, 0); PG8_SCHED; PG8_LDA(At, 0, 0); PG8_STAGE(PG8_SA(1, 1), a1 + hstep, oc[0]);
            PG8_WAIT_L(8); PG8_BAR; PG8_WAIT_L(0); PG8_MMA(0, 0, At, B0); PG8_BAR; PG8_SCHED;
            PG8_LDB(B1, 0, 1); PG8_STAGE(PG8_SB(0, 0), b2, voffB);
            PG8_BAR; PG8_WAIT_L(0); PG8_MMA(0, 1, At, B1); PG8_BAR;
            PG8_LDA(At, 0, 1); PG8_STAGE(PG8_SA(0, 0), a2, oc[0]);
            PG8_BAR; PG8_WAIT_L(0); PG8_MMA(1, 0, At, B0); PG8_BAR; PG8_SCHED;
            PG8_STAGE(PG8_SB(0, 1), b2 + hstep, voffB);
            PG8_WAIT_V(6); PG8_BAR; PG8_MMA(1, 1, At, B1); PG8_BAR;
            PG8_LDB(B0, 1, 0); PG8_SCHED; PG8_LDA(At, 1, 0); PG8_STAGE(PG8_SA(0, 1), a2 + hstep, oc[0]);
            PG8_WAIT_L(8); PG8_BAR; PG8_WAIT_L(0); PG8_MMA(0, 0, At, B0); PG8_BAR; PG8_SCHED;
            PG8_LDB(B1, 1, 1); PG8_STAGE(PG8_SB(1, 0), b3, voffB);
            PG8_BAR; PG8_WAIT_L(0); PG8_MMA(0, 1, At, B1); PG8_BAR;
            PG8_LDA(At, 1, 1); PG8_STAGE(PG8_SA(1, 0), a3, oc[0]);
            PG8_BAR; PG8_WAIT_L(0); PG8_MMA(1, 0, At, B0); PG8_BAR; PG8_SCHED;
            PG8_STAGE(PG8_SB(1, 1), b3 + hstep, voffB);
            PG8_WAIT_V(6); PG8_BAR; PG8_MMA(1, 1, At, B1); PG8_BAR;
            }
        }
        if constexpr (ALIGN_EPI) { if (wr == 0) PG8_BAR; }
        if constexpr (!Epi::AFTER_DRAIN) { E(acc, cur, wr, wc, fr, fq); S.done(cur); }
        if (!has_next) break;
#pragma unroll
        for (int a = 0; a < 2; ++a)
#pragma unroll
            for (int b = 0; b < 2; ++b)
#pragma unroll
                for (int m = 0; m < 4; ++m)
#pragma unroll
                    for (int n = 0; n < 2; ++n) acc[a][b][m][n] = (f32x4){0.f, 0.f, 0.f, 0.f};
        cur = nxt; cB = nB; ++ui; PG8_TOKS(oc, ui);
        if constexpr (ALIGN_EPI) { if (wr == 1) PG8_BAR; }
    }
    PG8_WAIT_V(0);
    if constexpr (!ALIGN_EPI) { if (wr == 0) PG8_BAR; }
    PG8_BAR;
    if constexpr (Epi::AFTER_DRAIN) { E.fused(acc, cur, wr, wc, fr, fq, lds, wid, lane); S.done(cur); }
#undef PG8_TOKS
#undef PG8_SA
#undef PG8_SB
#undef PG8_STAGE
#undef PG8_LDA
#undef PG8_LDB
#undef PG8_MMA
#undef PG8_WAIT_V
#undef PG8_WAIT_L
#undef PG8_BAR
#undef PG8_SCHED
}
}

constexpr int BATCH = 16, SEQ = 2048, D = 1024, NMETA = 16;
constexpr int TV = SEQ + NMETA;
constexpr int NV = BATCH * TV;
constexpr int NTOK = BATCH * SEQ;
constexpr int NR = NTOK + NMETA;
constexpr int NIN = 5128, NPROJ = 5120;
constexpr int HW = 512;
constexpr int NE = 32, TOPK = 4, DFF = 1024;
constexpr int MAXTILES = 548;
constexpr float EPS = 1e-6f;
constexpr int NWAVES = 8, NTHREADS = 512;

constexpr size_t MiB = 1u << 20, KiB = 1u << 10;
constexpr size_t WS_CTL = 0, CTL_ZERO_BYTES = 1 * MiB;
constexpr size_t WS_WIN = 2 * MiB;
constexpr size_t WS_WBH = 12 * MiB, WS_WBM = 13 * MiB, WS_WOUT = 14 * MiB;
constexpr size_t WS_WGU = 16 * MiB;
constexpr size_t WS_WDN = 144 * MiB;
constexpr size_t WS_BGUP = 208 * MiB;
constexpr size_t WS_RWT = WS_BGUP + 256 * KiB;
constexpr size_t WS_TOPE = WS_RWT + 128 * KiB;
constexpr size_t WS_TOPP = WS_TOPE + 520 * KiB;
constexpr size_t WS_TOPW = WS_TOPP + 520 * KiB;
constexpr size_t WS_RS = WS_TOPW + 520 * KiB;
constexpr size_t WS_LI = WS_RS + 136 * KiB;
constexpr size_t WS_LF = WS_LI + 520 * KiB;
constexpr size_t WS_SLOTRS = WS_LF + 520 * KiB;
constexpr size_t WS_SLOTW = WS_SLOTRS + 552 * KiB;
constexpr size_t WS_XSQ = WS_SLOTW + 552 * KiB;
constexpr size_t WS_SMALL_END = WS_XSQ + 136 * KiB;
constexpr size_t WS_RA = 214 * MiB;
constexpr size_t WS_HQ = WS_RA, WS_HG = WS_RA + 33 * MiB, WS_HV = WS_RA + 99 * MiB, WS_HGATE = WS_RA + 132 * MiB, WS_MM = WS_RA + 165 * MiB, WS_MO = WS_RA + 198 * MiB, WS_GATES = WS_RA + 231 * MiB;
constexpr size_t WS_MERGED = WS_RA, WS_TMP = WS_RA + 66 * MiB, WS_H1B = WS_RA + 364 * MiB, WS_ACT = WS_RA;
constexpr size_t WS_RB = WS_RA + 364 * MiB;
constexpr size_t WS_QKVM = WS_RB, WS_CM = WS_RB + 130 * MiB, WS_YHG = WS_RB + 196 * MiB, WS_YML = WS_RB + 229 * MiB, WS_XS = WS_RB, WS_YB = WS_RB;
constexpr size_t WS_RC = WS_RB + 274 * MiB;
constexpr size_t WS_XN0 = WS_RC + 65 * MiB;
constexpr size_t WS_H1 = WS_RC, WS_ETOK = WS_RC + 130 * MiB, WS_ERS = WS_ETOK + 5 * MiB, WS_EW = WS_ERS + 5 * MiB, WS_END = WS_EW + 5 * MiB;
static_assert(WS_SMALL_END <= WS_RA && WS_END <= 1024 * MiB, "d_ws map");
static_assert((size_t)NV * HW * 2 <= 33 * MiB && (size_t)NV * HW * 4 <= 66 * MiB && (size_t)NV * 2048 * 2 <= 132 * MiB + MiB && (size_t)NV * D * 4 <= 130 * MiB && (size_t)MAXTILES * 256 * D * 2 <= 274 * MiB, "d_ws sizes");
static_assert((size_t)NE * NV * 4 <= 5 * MiB, "per-expert lists");
static_assert((size_t)NR * D * 2 <= 65 * MiB && (size_t)NR * 4 <= 136 * KiB, "H1 / XN0 / XSQ");
constexpr int CW_TMO = 0, CW_CNT = 64  , CW_BAR = 4096;

constexpr int RING_OFF = 0, RING_BYTES = 131072;
constexpr int MISC_OFF = RING_BYTES;
constexpr int TEXP_OFF = MISC_OFF + 256;
constexpr int PST_OFF = TEXP_OFF + 640;
constexpr int TOK_OFF = PST_OFF + 384;
constexpr int LDS_BYTES = 147456;
static_assert(TOK_OFF + 18 * 512 <= LDS_BYTES, "LDS map");

#define GAS __attribute__((address_space(1)))
#define LAS __attribute__((address_space(3)))
typedef unsigned short bf16;
typedef unsigned v4u __attribute__((ext_vector_type(4)));
typedef unsigned v2u __attribute__((ext_vector_type(2)));
typedef float f32x4 __attribute__((ext_vector_type(4)));
typedef GAS unsigned gu32;
#define RLX_AGENT __ATOMIC_RELAXED, __HIP_MEMORY_SCOPE_AGENT
#define LDS_WAIT() asm volatile("s_waitcnt lgkmcnt(0)" ::: "memory")
#define VM_WAIT() asm volatile("s_waitcnt vmcnt(0)" ::: "memory")
__device__ __forceinline__ unsigned pk2(float lo, float hi) { return pg8::cvt_pk_bf16(lo, hi); }
__device__ __forceinline__ unsigned f2bf(float f) { return pg8::cvt_pk_bf16(f, 0.f) & 0xffffu; }
__device__ __forceinline__ float bflo(unsigned w) { return __builtin_bit_cast(float, w << 16); }
__device__ __forceinline__ float bfhi(unsigned w) { return __builtin_bit_cast(float, w & 0xffff0000u); }
__device__ __forceinline__ float bf1(bf16 h) { return __builtin_bit_cast(float, (unsigned)h << 16); }
__device__ __forceinline__ float fsigmoid(float x) { return __builtin_amdgcn_rcpf(1.0f + __expf(-x)); }
__device__ __forceinline__ float fsilu(float x) { return x * fsigmoid(x); }
__device__ __forceinline__ size_t rowof(int b, int tt) { return tt < NMETA ? (size_t)(NTOK + tt) : (size_t)b * SEQ + (tt - NMETA); }
__host__ __device__ __forceinline__ int gu_slot(int j) { const int g = (j >> 3) & 3, p = ((g & 1) << 1) | (g >> 1); return (j & ~31) + 8 * p + (j & 7); }
__device__ __forceinline__ float wave_sum(float v) {
#pragma unroll
    for (int o = 1; o < 64; o <<= 1) v += __shfl_xor(v, o);
    return v;
}
__device__ __forceinline__ float wave_max(float v) {
#pragma unroll
    for (int o = 1; o < 64; o <<= 1) v = fmaxf(v, __shfl_xor(v, o));
    return v;
}
#define XB_TMO      128
#define XB_XCNT(j)  (256  + 64 * (j))
#define XB_XSUB(j)  (1280 + 64 * (j))
#define XB_XGEN(j)  (2304 + 64 * (j))
#define XB_TOP      3328
#define XB_TOPGEN   3392
#define XCD_BAR_WORDS 3456
#define XB_SPIN_CAP (1u << 18)

__device__ __forceinline__ unsigned xb_ld(unsigned* p)              { return __hip_atomic_load(p, __ATOMIC_RELAXED, __HIP_MEMORY_SCOPE_AGENT); }
__device__ __forceinline__ unsigned xb_add(unsigned* p, unsigned v) { return __hip_atomic_fetch_add(p, v, __ATOMIC_RELAXED, __HIP_MEMORY_SCOPE_AGENT); }
__device__ __forceinline__ unsigned xb_xcc_id() { return (unsigned)__builtin_amdgcn_s_getreg((3 << 11) | 20) & 0xFu; }
#define XB_SPIN(cond, bar) do { unsigned _sp = 0; while (cond) { __builtin_amdgcn_s_sleep(1); \
    if ((++_sp & 255u) == 0u) { if (xb_ld(&(bar)[XB_TMO])) break; if (_sp > XB_SPIN_CAP) { atomicAdd(&(bar)[XB_TMO], 1u); break; } } } } while (0)

struct XcdBarrier {
    unsigned* bar; unsigned x;
    volatile LAS unsigned* st;
};

__device__ __forceinline__ XcdBarrier xcd_barrier_post(unsigned* bar, volatile LAS unsigned* st) {
    XcdBarrier b; b.bar = bar; b.x = xb_xcc_id(); b.st = st;
    if (threadIdx.x == 0) (void)xb_add(&bar[XB_XCNT(b.x)], 1u);
    return b;
}
__device__ __forceinline__ void xcd_barrier_complete(unsigned* bar, unsigned x, unsigned& nloc, unsigned& nx) {
    const unsigned G = gridDim.x * gridDim.y * gridDim.z;
    unsigned sum, cnt, mine, sp = 0u;
    for (;;) {
        sum = 0u; cnt = 0u; mine = 0u;
#pragma unroll
        for (unsigned j = 0; j < 16; ++j) { const unsigned c = xb_ld(&bar[XB_XCNT(j)]); sum += c; cnt += (c > 0u) ? 1u : 0u; mine = (j == x) ? c : mine; }
        if (sum == G) break;
        __builtin_amdgcn_s_sleep(1);
        if ((++sp & 255u) == 0u) { if (xb_ld(&bar[XB_TMO])) break; if (sp > XB_SPIN_CAP) { atomicAdd(&bar[XB_TMO], 1u); break; } }
    }
    nloc = mine > 0u ? mine : 1u; nx = cnt > 0u ? cnt : 1u;
}

__device__ __forceinline__ void xcd_barrier(const XcdBarrier& b) {
    asm volatile("s_waitcnt vmcnt(0)" ::: "memory");
    __syncthreads();
    if (threadIdx.x == 0) {
        unsigned* bar = b.bar;
        __builtin_amdgcn_s_waitcnt(0);
        unsigned nloc = b.st[0], nx = b.st[1];
        if (nloc == 0u) { xcd_barrier_complete(bar, b.x, nloc, nx); b.st[0] = nloc; b.st[1] = nx; }
        const unsigned old = xb_add(&bar[XB_XSUB(b.x)], 1u);
        const unsigned gen = old / nloc;
        if (old + 1u == (gen + 1u) * nloc) {
            __builtin_amdgcn_fence(__ATOMIC_RELEASE, "agent");
            asm volatile("s_waitcnt vmcnt(0)" ::: "memory");
            const unsigned og = xb_add(&bar[XB_TOP], 1u);
            const unsigned tg = og / nx;
            if (og + 1u == (tg + 1u) * nx) xb_add(&bar[XB_TOPGEN], 1u);
            else XB_SPIN(xb_ld(&bar[XB_TOPGEN]) == tg, bar);
            __builtin_amdgcn_fence(__ATOMIC_ACQUIRE, "agent");
            xb_add(&bar[XB_XGEN(b.x)], 1u);
            asm volatile("s_waitcnt vmcnt(0)" ::: "memory");
        } else {
            XB_SPIN(xb_ld(&bar[XB_XGEN(b.x)]) == gen, bar);
            __builtin_amdgcn_fence(__ATOMIC_ACQUIRE, "agent");
            asm volatile("s_waitcnt vmcnt(0)" ::: "memory");
        }
    }
    __syncthreads();
}

struct Frame {
    LAS unsigned char* lds;
    volatile LAS unsigned* MISC;
    gu32* ctl;
    int tid, lane, wave, vcu, G;
    const float* in[25];
    float* out;
    unsigned char* ws;
};
#define IN_X 0
#define IN_META 1
#define IN_LBL 2
#define IN_NMIX 3
#define IN_WIN 4
#define IN_HGNORM 5
#define IN_CONVW 6
#define IN_CONVB 7
#define IN_WQ 8
#define IN_WK 9
#define IN_WV 10
#define IN_GATEB 11
#define IN_MLNORM 12
#define IN_MLSKIP 13
#define IN_WBH 14
#define IN_WBM 15
#define IN_WOUT 16
#define IN_NFFN 17
#define IN_RW 18
#define IN_RB 19
#define IN_WGU 20
#define IN_BGU 21
#define IN_WDN 22
#define IN_BDN 23
#define IN_NFIN 24

__device__ __forceinline__ void p0_item(const float* W, int ldw, int col0, int cstride, const float* kscale, bf16* WT, int K, int dstrow0, int k0, LAS float* scr, int lane, float gsc = 1.f) {
    (void)cstride;
    const int r = lane >> 3, c4 = (lane & 7) * 4;
    f32x4 v[8];
#pragma unroll
    for (int i = 0; i < 8; ++i) v[i] = *(const GAS f32x4*)(W + (size_t)(k0 + 8 * i + r) * ldw + col0 + c4);
#pragma unroll
    for (int i = 0; i < 8; ++i) { const float sc = kscale ? kscale[k0 + 8 * i + r] : gsc; LAS float* s = scr + (8 * i + r) * 33 + c4; s[0] = v[i].x * sc; s[1] = v[i].y * sc; s[2] = v[i].z * sc; s[3] = v[i].w * sc; }
    LDS_WAIT(); asm volatile("" ::: "memory");
    const int c = lane & 7;
#pragma unroll
    for (int j = 0; j < 4; ++j) { const int n = (lane >> 3) + 8 * j; const LAS float* s = scr + (8 * c) * 33 + n;
        v4u o; o.x = pk2(s[0 * 33], s[1 * 33]); o.y = pk2(s[2 * 33], s[3 * 33]); o.z = pk2(s[4 * 33], s[5 * 33]); o.w = pk2(s[6 * 33], s[7 * 33]);
        *(GAS v4u*)(WT + (size_t)(dstrow0 + n) * K + k0 + 8 * c) = o; }
    LDS_WAIT(); asm volatile("" ::: "memory");
}
__device__ __forceinline__ void p0_prologue(Frame& F) {
    unsigned char* ws = F.ws;
    const int gw = F.vcu * NWAVES + F.wave, NGW = F.G * NWAVES, gt = F.vcu * NTHREADS + F.tid, NGT = F.G * NTHREADS;
    {
        LAS float* wm = (LAS float*)(F.lds + RING_OFF + 65536);
        { float wa[16], wb[16];
#pragma unroll
          for (int q = 0; q < 16; ++q) { const int u = F.tid + q * NTHREADS, j = u & 7, l = (u >> 3) & 63, i = u >> 9, k = 4 * l + 256 * (i >> 2) + (i & 3); wa[q] = F.in[IN_NMIX][k]; wb[q] = F.in[IN_WIN][(size_t)k * NIN + 3072 + j]; }
#pragma unroll
          for (int q = 0; q < 16; ++q) wm[F.tid + q * NTHREADS] = wa[q] * wb[q]; }
        __syncthreads();
        bf16* XN0 = (bf16*)(ws + WS_XN0); float* XSQ = (float*)(ws + WS_XSQ); float* LI = (float*)(ws + WS_LI); float* LF = (float*)(ws + WS_LF);
        f32x4 vn[4];
#define P0_LOADROW(dst, V_) do { const int Vc_ = (V_) < NR ? (V_) : NR - 1; const float* src_ = (Vc_ >= NTOK) ? F.in[IN_META] + (size_t)(Vc_ - NTOK) * D : F.in[IN_X] + (size_t)Vc_ * D; \
        const GAS f32x4* xr_ = (const GAS f32x4*)src_ + F.lane; _Pragma("unroll") for (int j = 0; j < 4; ++j) dst[j] = xr_[64 * j]; } while (0)
        P0_LOADROW(vn, gw);
        for (int V = gw; V < NR; V += NGW) {
            f32x4 v[4]; float s = 0.f;
#pragma unroll
            for (int j = 0; j < 4; ++j) { v[j] = vn[j]; s += (v[j].x * v[j].x + v[j].y * v[j].y) + (v[j].z * v[j].z + v[j].w * v[j].w); }
            P0_LOADROW(vn, V + NGW);
            asm volatile("" ::: "memory");
            const float sq = sqrtf(wave_sum(s) * (1.f / D) + EPS), rs = 1.0f / sq;
            if (F.lane == 0) XSQ[V] = sq;
            float g[8];
#pragma unroll
            for (int j = 0; j < 8; ++j) g[j] = 0.f;
            GAS unsigned long long* o8 = (GAS unsigned long long*)(XN0 + (size_t)V * D) + F.lane;
#pragma unroll
            for (int j = 0; j < 4; ++j) {
                v[j] = v[j] * rs;
                o8[64 * j] = (unsigned long long)pk2(v[j].x, v[j].y) | ((unsigned long long)pk2(v[j].z, v[j].w) << 32);
#pragma unroll
                for (int q = 0; q < 4; ++q) { const LAS f32x4* wp = (const LAS f32x4*)(wm + (((4 * j + q) * 64 + F.lane) * 8)); const f32x4 w0 = wp[0], w1 = wp[1]; const float xv = v[j][q];
                    g[0] += xv * w0.x; g[1] += xv * w0.y; g[2] += xv * w0.z; g[3] += xv * w0.w; g[4] += xv * w1.x; g[5] += xv * w1.y; g[6] += xv * w1.z; g[7] += xv * w1.w; }
            }
#pragma unroll
            for (int j = 0; j < 8; ++j) g[j] = wave_sum(g[j]);
            if (F.lane < 4) {
                const float gi = (F.lane == 0 ? g[0] : F.lane == 1 ? g[1] : F.lane == 2 ? g[2] : g[3]) + F.in[IN_GATEB][F.lane];
                const float gf = (F.lane == 0 ? g[4] : F.lane == 1 ? g[5] : F.lane == 2 ? g[6] : g[7]) + F.in[IN_GATEB][4 + F.lane];
                LI[(size_t)V * 4 + F.lane] = gi;
                LF[(size_t)V * 4 + F.lane] = fminf(gf, 0.f) - log1pf(__expf(-fabsf(gf)));
            }
        }
        __syncthreads();
    }
    {
        LAS float* scr = (LAS float*)(F.lds + RING_OFF + F.wave * 16384);
        constexpr int I_IN1 = 16 * 96, I_IN2 = 16 * 64, I_BH = 8 * 32, I_OUT = 16 * 32;
        constexpr int NITEMS = I_IN1 + I_IN2 + 2 * I_BH + I_OUT;
        for (int it = gw; it < NITEMS; it += NGW) {
            int r = it;
            if (r < I_IN1) { const int kb = r / 96, nb = r % 96; p0_item(F.in[IN_WIN], NIN, 32 * nb, 1, F.in[IN_NMIX], (bf16*)(ws + WS_WIN), D, 32 * nb, 64 * kb, scr, F.lane); continue; } r -= I_IN1;
            if (r < I_IN2) { const int kb = r / 64, nb = r % 64; p0_item(F.in[IN_WIN], NIN, 3080 + 32 * nb, 1, F.in[IN_NMIX], (bf16*)(ws + WS_WIN), D, 3072 + 32 * nb, 64 * kb, scr, F.lane); continue; } r -= I_IN2;
            if (r < I_BH) { const int kb = r / 32, nb = r % 32; p0_item(F.in[IN_WBH], D, 32 * nb, 1, nullptr, (bf16*)(ws + WS_WBH), HW, 32 * nb, 64 * kb, scr, F.lane, 1.f / 255.f); continue; } r -= I_BH;
            if (r < I_BH) { const int kb = r / 32, nb = r % 32; p0_item(F.in[IN_WBM], D, 32 * nb, 1, nullptr, (bf16*)(ws + WS_WBM), HW, 32 * nb, 64 * kb, scr, F.lane, 1.f / 255.f); continue; } r -= I_BH;
            { const int kb = r / 32, nb = r % 32; p0_item(F.in[IN_WOUT], D, 32 * nb, 1, nullptr, (bf16*)(ws + WS_WOUT), D, 32 * nb, 64 * kb, scr, F.lane); }
        }
    }
    { float* BGUP = (float*)(ws + WS_BGUP); float* RWT = (float*)(ws + WS_RWT);
      for (int u = gt; u < NE * 2 * DFF; u += NGT) { const int e = u >> 11, n = u & 2047, pn = n >> 8, bj = (n >> 7) & 1, j = gu_slot(n & 127); BGUP[u] = F.in[IN_BGU][(size_t)e * 2 * DFF + 2 * (128 * pn + j) + bj]; }
      for (int u = gt; u < NE * D; u += NGT) { const int e = u >> 10, k = u & 1023; RWT[u] = F.in[IN_NFFN][k] * F.in[IN_RW][(size_t)k * NE + e]; } }
}

__device__ __forceinline__ unsigned pk4_fp8(float a, float b, float c, float d) { unsigned w = 0;
    a = __builtin_amdgcn_fmed3f(a, -448.f, 448.f); b = __builtin_amdgcn_fmed3f(b, -448.f, 448.f); c = __builtin_amdgcn_fmed3f(c, -448.f, 448.f); d = __builtin_amdgcn_fmed3f(d, -448.f, 448.f);
    w = __builtin_amdgcn_cvt_pk_fp8_f32(a, b, w, false); w = __builtin_amdgcn_cvt_pk_fp8_f32(c, d, w, true); return w; }
__device__ __forceinline__ void cvdn_load(const float* Wdn, int it, f32x4 (&v)[8], int lane) {
    const int e = it >> 9, kb = (it >> 5) & 15, nb = it & 31, r = lane >> 3, c4 = (lane & 7) * 4; const float* W = Wdn + (size_t)e * DFF * D;
#pragma unroll
    for (int i = 0; i < 8; ++i) v[i] = *(const GAS f32x4*)(W + (size_t)(64 * kb + 8 * i + r) * D + 32 * nb + c4);
}
__device__ __forceinline__ void cvdn_proc(unsigned char* WTdn, int it, const f32x4 (&v)[8], LAS float* scr, int lane) {
    const int e = it >> 9, kb = (it >> 5) & 15, nb = it & 31, r = lane >> 3, c4 = (lane & 7) * 4; unsigned char* WT = WTdn + (size_t)e * D * DFF;
#pragma unroll
    for (int i = 0; i < 8; ++i) { LAS float* s = scr + (8 * i + r) * 33 + c4; s[0] = v[i].x * 32.f; s[1] = v[i].y * 32.f; s[2] = v[i].z * 32.f; s[3] = v[i].w * 32.f; }
    LDS_WAIT(); asm volatile("" ::: "memory");
    const int c = lane & 7;
#pragma unroll
    for (int j = 0; j < 4; ++j) { const int n = (lane >> 3) + 8 * j; const LAS float* s = scr + (8 * c) * 33 + n;
        v2u o; o.x = pk4_fp8(s[0 * 33], s[1 * 33], s[2 * 33], s[3 * 33]); o.y = pk4_fp8(s[4 * 33], s[5 * 33], s[6 * 33], s[7 * 33]);
        const int cn = 32 * nb + n, rowp = (cn & ~255) + 128 * ((cn >> 3) & 1) + 32 * ((cn >> 6) & 3) + 8 * ((cn >> 4) & 3) + (cn & 7);
        *(GAS v2u*)(WT + (size_t)rowp * DFF + 64 * kb + 8 * c) = o; }
    LDS_WAIT(); asm volatile("" ::: "memory");
}
__device__ __forceinline__ void cvgu_load(const float* Wgu, const float* nffn, int it, f32x4 (&v)[8], float (&sc)[8], int lane) {
    const int e = it >> 10, kb = (it >> 5) & 31, nb = it & 31, r = lane >> 4, c4 = (lane & 15) * 4; const float* W = Wgu + (size_t)e * D * 2 * DFF;
#pragma unroll
    for (int i = 0; i < 8; ++i) { v[i] = *(const GAS f32x4*)(W + (size_t)(32 * kb + 4 * i + r) * (2 * DFF) + 64 * nb + c4); sc[i] = nffn[32 * kb + 4 * i + r] * 32.f; }
}
__device__ __forceinline__ void cvgu_proc(unsigned char* WTgu, int it, const f32x4 (&v)[8], const float (&sc)[8], LAS float* scr, int lane) {
    const int e = it >> 10, kb = (it >> 5) & 31, nb = it & 31, r = lane >> 4, c4 = (lane & 15) * 4, A0 = 32 * nb, k0 = 32 * kb; unsigned char* WT = WTgu + (size_t)e * 2 * DFF * D;
    LAS float* sg = scr; LAS float* su = scr + 32 * 33;
#pragma unroll
    for (int i = 0; i < 8; ++i) { const int o = (4 * i + r) * 33 + (c4 >> 1); sg[o] = v[i].x * sc[i]; su[o] = v[i].y * sc[i]; sg[o + 1] = v[i].z * sc[i]; su[o + 1] = v[i].w * sc[i]; }
    LDS_WAIT(); asm volatile("" ::: "memory");
    const int c = lane & 3;
#pragma unroll
    for (int j = 0; j < 4; ++j) { const int q = (lane >> 2) + 16 * j, isup = q >> 5, jj = q & 31, A = A0 + jj; const LAS float* s = scr + isup * 32 * 33 + (8 * c) * 33 + jj;
        v2u o; o.x = pk4_fp8(s[0 * 33], s[1 * 33], s[2 * 33], s[3 * 33]); o.y = pk4_fp8(s[4 * 33], s[5 * 33], s[6 * 33], s[7 * 33]);
        *(GAS v2u*)(WT + (size_t)(256 * (A >> 7) + 128 * isup + gu_slot(A & 127)) * D + k0 + 8 * c) = o; }
    LDS_WAIT(); asm volatile("" ::: "memory");
}
__device__ __forceinline__ void px_experts(Frame& F, int rank, int nwg) {
    unsigned char* ws = F.ws;
    LAS float* scr = (LAS float*)(F.lds + RING_OFF + F.wave * 16384);
    const int gw = rank * NWAVES + F.wave, NGW = nwg * NWAVES;
    { constexpr int NIT = NE * 1024; f32x4 v[8], vn[8]; float sc[8], sn[8]; int it = gw;
      if (it < NIT) cvgu_load(F.in[IN_WGU], F.in[IN_NFFN], it, v, sc, F.lane);
      while (it < NIT) { const int nx = it + NGW; if (nx < NIT) cvgu_load(F.in[IN_WGU], F.in[IN_NFFN], nx, vn, sn, F.lane);
          asm volatile("" ::: "memory");
          cvgu_proc((unsigned char*)(ws + WS_WGU), it, v, sc, scr, F.lane); asm volatile("" ::: "memory");
#pragma unroll
          for (int i = 0; i < 8; ++i) { v[i] = vn[i]; sc[i] = sn[i]; }
          it = nx; } }
    { constexpr int NIT = NE * 512; f32x4 v[8], vn[8]; int it = gw;
      if (it < NIT) cvdn_load(F.in[IN_WDN], it, v, F.lane);
      while (it < NIT) { const int nx = it + NGW; if (nx < NIT) cvdn_load(F.in[IN_WDN], nx, vn, F.lane);
          asm volatile("" ::: "memory");
          cvdn_proc((unsigned char*)(ws + WS_WDN), it, v, scr, F.lane); asm volatile("" ::: "memory");
#pragma unroll
          for (int i = 0; i < 8; ++i) v[i] = vn[i];
          it = nx; } }
}

namespace pg8 {
typedef unsigned v2u_t __attribute__((ext_vector_type(2)));
typedef float f32x2 __attribute__((ext_vector_type(2)));
__device__ __forceinline__ f32x2 sig2(f32x2 x) { const f32x2 t = x * (f32x2){-1.4426950408889634f, -1.4426950408889634f};
    const f32x2 d = (f32x2){__builtin_amdgcn_exp2f(t.x), __builtin_amdgcn_exp2f(t.y)} + (f32x2){1.f, 1.f}; return (f32x2){__builtin_amdgcn_rcpf(d.x), __builtin_amdgcn_rcpf(d.y)}; }
__device__ __forceinline__ u32x4 pack8(const f32x4& a, const f32x4& b) { u32x4 w; w.x = cvt_pk_bf16(a[0], a[1]); w.y = cvt_pk_bf16(a[2], a[3]); w.z = cvt_pk_bf16(b[0], b[1]); w.w = cvt_pk_bf16(b[2], b[3]); return w; }
__device__ __forceinline__ v2u_t pack8_fp8(const f32x4& a, const f32x4& b) { unsigned lo = 0, hi = 0;
    lo = __builtin_amdgcn_cvt_pk_fp8_f32(a[0], a[1], lo, false); lo = __builtin_amdgcn_cvt_pk_fp8_f32(a[2], a[3], lo, true);
    hi = __builtin_amdgcn_cvt_pk_fp8_f32(b[0], b[1], hi, false); hi = __builtin_amdgcn_cvt_pk_fp8_f32(b[2], b[3], hi, true); return (v2u_t){lo, hi}; }
__device__ __forceinline__ v2u_t pack8_fp8_sat(const f32x4& a, const f32x4& b) { f32x4 x, y;
#pragma unroll
    for (int i = 0; i < 4; ++i) { x[i] = __builtin_amdgcn_fmed3f(a[i], -448.f, 448.f); y[i] = __builtin_amdgcn_fmed3f(b[i], -448.f, 448.f); }
    return pack8_fp8(x, y); }
__device__ __forceinline__ void unpack8(const u32x4& w, f32x4& a, f32x4& b) { a = (f32x4){bflo(w.x), bfhi(w.x), bflo(w.y), bfhi(w.y)}; b = (f32x4){bflo(w.z), bfhi(w.z), bflo(w.w), bfhi(w.w)}; }
__host__ __device__ __forceinline__ int gate_pos(int c) { return (c & ~255) + ((((c >> 5) & 3) * 4 + ((c >> 3) & 3)) * 16) + (((c >> 7) & 1) * 8) + (c & 7); }
__device__ __forceinline__ unsigned q8x4(float a, float b, float c, float d) {
    const unsigned t0 = __builtin_bit_cast(unsigned, __builtin_fmaf(a, 255.f, 8388608.f)), t1 = __builtin_bit_cast(unsigned, __builtin_fmaf(b, 255.f, 8388608.f));
    const unsigned t2 = __builtin_bit_cast(unsigned, __builtin_fmaf(c, 255.f, 8388608.f)), t3 = __builtin_bit_cast(unsigned, __builtin_fmaf(d, 255.f, 8388608.f));
    return (t0 & 0xffu) | (t1 << 8) | (t2 << 16) | (t3 << 24); }
__device__ __forceinline__ f32x4 dq8x4(unsigned w) { return (f32x4){(float)(w & 0xffu), (float)((w >> 8) & 0xffu), (float)((w >> 16) & 0xffu), (float)(w >> 24)}; }
struct EpiProj {
    static constexpr bool PERM = true, AFTER_DRAIN = false;
    unsigned char* ws; const float* lbl;
    template <int ACT>
    __device__ __forceinline__ void emit(const f32x4 (&acc)[2][2][4][2], bf16_t* O, int row0, int colt) const {
#pragma unroll
        for (int ai = 0; ai < 2; ++ai)
#pragma unroll
            for (int m = 0; m < 4; ++m) { bf16_t* rowp = O + (size_t)(row0 + ai * HALF + m * 16) * HW + colt;
#pragma unroll
                for (int bj = 0; bj < 2; ++bj) { u32x4 o;
#pragma unroll
                    for (int k = 0; k < 4; ++k) { f32x2 p = {acc[ai][bj][m][k >> 1][2 * (k & 1)], acc[ai][bj][m][k >> 1][2 * (k & 1) + 1]};
                        if constexpr (ACT == 1) p = p * sig2(p); else if constexpr (ACT == 2) p = sig2(p);
                        o[k] = cvt_pk_bf16(p.x, p.y); }
                    *(u32x4*)(rowp + bj * HALF) = o; } }
    }
    __device__ __forceinline__ void operator()(const f32x4 (&acc)[2][2][4][2], const Unit& u, int wr, int wc, int fr, int fq) const {
        const int row0 = u.pm * BM + wr * 64 + fr, kind = u.pn < 12 ? (u.pn >> 1) : 6;
        const int colt = (u.pn < 12 ? (u.pn & 1) : (u.pn - 12)) * BM + wc * 32 + 8 * fq;
        if (kind == 1) {
            float* HG = (float*)(ws + WS_HG);
#pragma unroll
            for (int bj = 0; bj < 2; ++bj) { const int c = colt + bj * HALF; f32x2 lb[4], ol[4];
#pragma unroll
                for (int k = 0; k < 4; ++k) { lb[k] = sig2((f32x2){lbl[c + 2 * k] - lbl[HW + c + 2 * k], lbl[c + 2 * k + 1] - lbl[HW + c + 2 * k + 1]}); ol[k] = (f32x2){1.f, 1.f} - lb[k]; }
#pragma unroll
                for (int ai = 0; ai < 2; ++ai)
#pragma unroll
                    for (int m = 0; m < 4; ++m) { float* rowp = HG + (size_t)(row0 + ai * HALF + m * 16) * HW + c; f32x2 o[4];
#pragma unroll
                        for (int k = 0; k < 4; ++k) { const f32x2 f = ol[k] * sig2((f32x2){acc[ai][bj][m][k >> 1][2 * (k & 1)], acc[ai][bj][m][k >> 1][2 * (k & 1) + 1]}) + lb[k];
                            o[k] = (f32x2){__builtin_amdgcn_logf(f.x), __builtin_amdgcn_logf(f.y)} * (f32x2){0.6931471805599453f, 0.6931471805599453f}; }
                        *(f32x4*)rowp = (f32x4){o[0].x, o[0].y, o[1].x, o[1].y}; *(f32x4*)(rowp + 4) = (f32x4){o[2].x, o[2].y, o[3].x, o[3].y}; } }
            return;
        }
        if (kind == 6) {
            unsigned char* G8 = ws + WS_GATES; const int gofs = (u.pn - 12) * BM + (wc * 4 + fq) * 16;
#pragma unroll
            for (int ai = 0; ai < 2; ++ai)
#pragma unroll
                for (int m = 0; m < 4; ++m) { u32x4 o;
#pragma unroll
                    for (int bj = 0; bj < 2; ++bj)
#pragma unroll
                        for (int h = 0; h < 2; ++h) { const f32x4 v = acc[ai][bj][m][h];
                            const f32x2 sa = sig2((f32x2){v[0], v[1]}), sb = sig2((f32x2){v[2], v[3]});
                            o[2 * bj + h] = q8x4(sa.x, sa.y, sb.x, sb.y); }
                    *(u32x4*)(G8 + (size_t)(row0 + ai * HALF + m * 16) * 2048 + gofs) = o; }
            return;
        }
        if (kind == 0) emit<1>(acc, (bf16_t*)(ws + WS_HQ), row0, colt); else if (kind == 2) emit<0>(acc, (bf16_t*)(ws + WS_HV), row0, colt); else if (kind == 3) emit<1>(acc, (bf16_t*)(ws + WS_HGATE), row0, colt);
        else if (kind == 4) emit<0>(acc, (bf16_t*)(ws + WS_MM), row0, colt); else emit<2>(acc, (bf16_t*)(ws + WS_MO), row0, colt);
    }
};
constexpr int PAIR_DA = 132, PAIR_DB = 4;
struct PairOrder { StaticOrder S;
    __device__ __forceinline__ bool next(int i, Unit& u) const { Unit t; if (!S.next(i >> 1, t)) return false; const int s = i & 1; u.pm = t.pm + PAIR_DA * s; u.pn = t.pn + PAIR_DB * s; return true; }
    __device__ __forceinline__ void a_ready(const Unit&) const {}
    __device__ __forceinline__ void done(const Unit&) const {}
};
struct EpiGate2 {
    static constexpr bool PERM = true, AFTER_DRAIN = false;
    const unsigned char* __restrict__ gates; bf16_t* __restrict__ tmp; bf16_t* __restrict__ merged;
    __device__ __forceinline__ void operator()(const f32x4 (&acc)[2][2][4][2], const Unit& u, int wr, int wc, int fr, int fq) const {
        const int step = u.pm >= PAIR_DA ? 1 : 0, pm = u.pm - PAIR_DA * step, pn = u.pn - PAIR_DB * step;
        const int row0 = pm * BM + wr * 64 + fr, col0 = pn * BM + wc * 32 + 8 * fq, gofs = step * D + pn * BM + (wc * 4 + fq) * 16;
        constexpr int NB = 2, NBAT = 8 / NB;
        bf16_t* obuf = tmp + (ptrdiff_t)(merged - tmp) * step;
        u32x4 gc[NB], tc[NB][2], gn[NB], tn[NB][2];
#define EG_LOAD(G, T, b_) do { _Pragma("unroll") for (int s_ = 0; s_ < NB; ++s_) { const int it_ = (b_) * NB + s_; const size_t row_ = (size_t)(row0 + (it_ >> 2) * HALF + (it_ & 3) * 16); G[s_] = *(const u32x4*)(gates + row_ * 2048 + gofs); _Pragma("unroll") for (int bj = 0; bj < 2; ++bj) { \
        if (step) T[s_][bj] = *(const u32x4*)(tmp + row_ * D + col0 + bj * HALF); else T[s_][bj] = (u32x4){0u, 0u, 0u, 0u}; } } } while (0)
        EG_LOAD(gc, tc, 0);
#pragma unroll
        for (int b = 0; b < NBAT; ++b) {
            if (b + 1 < NBAT) EG_LOAD(gn, tn, b + 1);
#pragma unroll
            for (int s = 0; s < NB; ++s) { const int it = b * NB + s, ai = it >> 2, m = it & 3; const size_t row = (size_t)(row0 + ai * HALF + m * 16);
#pragma unroll
                for (int bj = 0; bj < 2; ++bj) { const int c = col0 + bj * HALF; f32x4 t0, t1; unpack8(tc[s][bj], t0, t1); const f32x4 g0 = dq8x4(gc[s][2 * bj]), g1 = dq8x4(gc[s][2 * bj + 1]);
                    const u32x4 o = pack8(acc[ai][bj][m][0] * g0 + t0, acc[ai][bj][m][1] * g1 + t1);
                    *(u32x4*)(obuf + row * D + c) = o; } }
#pragma unroll
            for (int s = 0; s < NB; ++s)
#pragma unroll
                for (int bj = 0; bj < 2; ++bj) tc[s][bj] = tn[s][bj];
#pragma unroll
            for (int s = 0; s < NB; ++s) gc[s] = gn[s]; }
#undef EG_LOAD
    }
};
struct EpiH1 {
    static constexpr bool PERM = true, AFTER_DRAIN = false;
    const bf16_t* __restrict__ xn0; const float* __restrict__ xsq; bf16_t* __restrict__ H1; unsigned char* __restrict__ H1B8;
    __device__ __forceinline__ void operator()(const f32x4 (&acc)[2][2][4][2], const Unit& u, int wr, int wc, int fr, int fq) const {
        const int row0 = u.pm * BM + wr * 64 + fr, col0 = u.pn * BM + wc * 32 + 8 * fq;
        u32x4 xc[2], xn[2]; float sc, sn;
#define EH_LOAD(X, S_, it_) do { const size_t r_ = (size_t)(row0 + ((it_) >> 2) * HALF + ((it_) & 3) * 16); const bf16_t* src_ = xn0 + r_ * D + col0; S_ = xsq[r_]; _Pragma("unroll") for (int bj = 0; bj < 2; ++bj) X[bj] = *(const u32x4*)(src_ + bj * HALF); } while (0)
        EH_LOAD(xc, sc, 0);
#pragma unroll
        for (int it = 0; it < 8; ++it) { const int ai = it >> 2, m = it & 3; const size_t V = (size_t)(row0 + ai * HALF + m * 16);
            if (it + 1 < 8) EH_LOAD(xn, sn, it + 1);
#pragma unroll
            for (int bj = 0; bj < 2; ++bj) { const int c = col0 + bj * HALF; f32x4 x0, x1; unpack8(xc[bj], x0, x1);
                const f32x4 v0 = x0 * sc + acc[ai][bj][m][0], v1 = x1 * sc + acc[ai][bj][m][1];
                *(u32x4*)(H1 + V * D + c) = pack8(v0, v1); *(v2u_t*)(H1B8 + V * D + c) = pack8_fp8_sat(v0, v1); }
#pragma unroll
            for (int bj = 0; bj < 2; ++bj) xc[bj] = xn[bj];
            sc = sn; }
#undef EH_LOAD
    }
};
struct EpiGU {
    static constexpr bool PERM = true, AFTER_DRAIN = false;
    const float* __restrict__ bgup; const float* __restrict__ ers; unsigned char* __restrict__ act; const PG8_LAS int* pst;
    __device__ __forceinline__ void operator()(const f32x4 (&acc)[2][2][4][2], const Unit& u, int wr, int wc, int fr, int fq) const {
        const int e = u.pn >> 3, pn = u.pn & 7, row0 = u.pm * BM + wr * 64 + fr, cc = wc * 32 + 8 * fq;
        const float* rsp = ers + (size_t)e * NV + (row0 - pst[e]);
        const float* bp = bgup + (size_t)e * 2 * DFF + pn * BM + cc;
        f32x2 bg[2][2], bu[2][2];
#pragma unroll
        for (int h = 0; h < 2; ++h) { const f32x4 g4 = *(const f32x4*)(bp + 4 * h), u4 = *(const f32x4*)(bp + HALF + 4 * h);
            bg[h][0] = (f32x2){g4[0], g4[1]}; bg[h][1] = (f32x2){g4[2], g4[3]}; bu[h][0] = (f32x2){u4[0] + 1.f, u4[1] + 1.f}; bu[h][1] = (f32x2){u4[2] + 1.f, u4[3] + 1.f}; }
        float rsv[8];
#pragma unroll
        for (int it = 0; it < 8; ++it) rsv[it] = rsp[(it >> 2) * HALF + (it & 3) * 16];
        const int hi = fq >> 1;
        unsigned char* obase = act + (size_t)(row0 + 16 * hi) * DFF + pn * HALF + wc * 32 + 16 * (fq & 1);
        constexpr float KS = -1.702f * 1.4426950408889634f;
#pragma unroll
        for (int ai = 0; ai < 2; ++ai)
#pragma unroll
            for (int mp = 0; mp < 2; ++mp) { v2u_t pk[2];
#pragma unroll
                for (int q = 0; q < 2; ++q) { const int m = 2 * mp + q; const float rs = rsv[ai * 4 + m] * 0.03125f;
                    const f32x2 rs2 = {rs, rs}; unsigned w[2];
#pragma unroll
                    for (int h = 0; h < 2; ++h) { f32x2 o[2];
#pragma unroll
                        for (int p = 0; p < 2; ++p) {
                            f32x2 g = (f32x2){acc[ai][0][m][h][2 * p], acc[ai][0][m][h][2 * p + 1]} * rs2 + bg[h][p];
                            f32x2 u1 = (f32x2){acc[ai][1][m][h][2 * p], acc[ai][1][m][h][2 * p + 1]} * rs2 + bu[h][p];
                            g.x = fminf(g.x, 7.f); g.y = fminf(g.y, 7.f); u1.x = __builtin_amdgcn_fmed3f(u1.x, -6.f, 8.f); u1.y = __builtin_amdgcn_fmed3f(u1.y, -6.f, 8.f);
                            const f32x2 t = g * (f32x2){KS, KS};
                            const f32x2 d = (f32x2){__builtin_amdgcn_exp2f(t.x), __builtin_amdgcn_exp2f(t.y)} + (f32x2){1.f, 1.f};
                            const f32x2 r = {__builtin_amdgcn_rcpf(d.x), __builtin_amdgcn_rcpf(d.y)};
                            o[p] = (g * r) * u1; }
                        w[h] = __builtin_amdgcn_cvt_pk_fp8_f32(o[0].x, o[0].y, 0u, false); w[h] = __builtin_amdgcn_cvt_pk_fp8_f32(o[1].x, o[1].y, w[h], true); }
                    pk[q] = (v2u_t){w[0], w[1]}; }
                const auto r0 = __builtin_amdgcn_permlane32_swap(pk[0][0], pk[1][0], false, false), r1 = __builtin_amdgcn_permlane32_swap(pk[0][1], pk[1][1], false, false);
                *(u32x4*)(obase + (size_t)(ai * HALF + mp * 32) * DFF) = (u32x4){r0[0], r1[0], r0[1], r1[1]}; }
    }
};
struct EpiDown {
    static constexpr bool PERM = true, AFTER_DRAIN = false;
    const float* __restrict__ bdn; const float* __restrict__ ew; unsigned char* __restrict__ yb; const PG8_LAS int* pst;
    __device__ __forceinline__ void operator()(const f32x4 (&acc)[2][2][4][2], const Unit& u, int wr, int wc, int fr, int fq) const {
        const int e = u.pn >> 2, pn = u.pn & 3, row0 = u.pm * BM + wr * 64 + fr, col0 = pn * BM + wc * 64 + 16 * fq;
        const float* wp = ew + (size_t)e * NV + (row0 - pst[e]);
        f32x4 bv[2][2];
#pragma unroll
        for (int bj = 0; bj < 2; ++bj) { bv[bj][0] = *(const f32x4*)(bdn + (size_t)e * D + col0 + 8 * bj); bv[bj][1] = *(const f32x4*)(bdn + (size_t)e * D + col0 + 8 * bj + 4); }
        float wv[8];
#pragma unroll
        for (int it = 0; it < 8; ++it) wv[it] = wp[(it >> 2) * HALF + (it & 3) * 16];
#pragma unroll
        for (int ai = 0; ai < 2; ++ai)
#pragma unroll
            for (int m = 0; m < 4; ++m) { const size_t row = (size_t)(row0 + ai * HALF + m * 16); const float w = wv[ai * 4 + m] * 16.f;
                const v2u_t lo = pack8_fp8_sat((acc[ai][0][m][0] * 0.03125f + bv[0][0]) * w, (acc[ai][0][m][1] * 0.03125f + bv[0][1]) * w), hi = pack8_fp8_sat((acc[ai][1][m][0] * 0.03125f + bv[1][0]) * w, (acc[ai][1][m][1] * 0.03125f + bv[1][1]) * w);
                *(u32x4*)(yb + row * D + col0) = (u32x4){lo[0], lo[1], hi[0], hi[1]}; }
    }
};
struct GroupOrder {
    int ntiles, ncol, G, c; const PG8_LAS unsigned char* texp;
    __device__ __forceinline__ bool next(int i, Unit& u) const { const int x = c & 7, w = c >> 3, uu = i * (G >> 3) + w, lj = uu / ncol, pn = uu - lj * ncol, j = lj * 8 + x; if (j >= ntiles) return false; u.pm = j; u.pn = (int)texp[j] * ncol + pn; return true; }
    __device__ __forceinline__ void a_ready(const Unit&) const {}
    __device__ __forceinline__ void done(const Unit&) const {}
};
}

typedef short bf16x8 __attribute__((ext_vector_type(8)));
typedef float f32x16 __attribute__((ext_vector_type(16)));
#define MFMA32(a, b, c) __builtin_amdgcn_mfma_f32_32x32x16_bf16(a, b, c, 0, 0, 0)
__device__ __forceinline__ bf16x8 ldfrag(const LAS unsigned char* base, int st, int row0, int k0, int lane) { return *(const LAS bf16x8*)(base + (row0 + (lane & 31)) * st + (k0 + 8 * (lane >> 5)) * 2); }
__device__ __forceinline__ bf16x8 ldf(const LAS unsigned char* lanebase, int off) { return *(const LAS bf16x8*)(lanebase + off); }
__device__ __forceinline__ float fexp(float x) { return __builtin_amdgcn_exp2f(x * 1.4426950408889634f); }

__device__ __forceinline__ void p3_hgrn2_mfma(Frame& F, int bh) {
    unsigned char* ws = F.ws; const int b = bh >> 2, h = bh & 3, tid = F.tid, lane = F.lane, wave = F.wave, hh = lane >> 5, l31 = lane & 31;
    const bf16* HQ = (const bf16*)(ws + WS_HQ) + h * 128; const float* HG = (const float*)(ws + WS_HG) + h * 128; const bf16* HV = (const bf16*)(ws + WS_HV) + h * 128;
    const bf16* HGATE = (const bf16*)(ws + WS_HGATE) + h * 128; bf16* YHG = (bf16*)(ws + WS_YHG) + h * 128;
    LAS unsigned char* L = F.lds + RING_OFF;
    LAS unsigned char* QT = L; LAS unsigned char* KT = L + 17408; LAS unsigned char* KTT = L + 34816; LAS unsigned char* VT = L + 53248; LAS unsigned char* ST = L + 71680; LAS unsigned char* PP = L + 106496;
    LAS float* SEG = (LAS float*)(L + 115712); LAS float* ER = (LAS float*)(L + 117760); LAS float* EL = (LAS float*)(L + 118272); LAS float* OST = (LAS float*)(L + 17408);
    const int d = tid & 127, pq = tid >> 7;
    const int et = tid >> 3, evq = tid & 7;
    const int f144 = l31 * 144 + hh * 16, f272 = l31 * 272 + hh * 16;
    const int sst = wave == 2 ? 1 : 0, stt = wave == 0 ? 0 : 1, dt = wave & 3, vt0 = 2 * (wave >> 2), btt = wave & 1, bvt = wave >> 1;
    const LAS unsigned char* aK = KT + 32 * sst * 272 + f272; const LAS unsigned char* bQ = QT + 32 * stt * 272 + f272;
    LAS unsigned char* pst = PP + (32 * stt + l31) * 144 + (32 * sst + 4 * hh) * 2;
    const LAS unsigned char* aKTT = KTT + 32 * dt * 144 + f144; const LAS unsigned char* bV0 = VT + 32 * vt0 * 144 + f144;
    LAS unsigned char* sst_ = ST + (32 * vt0 + l31) * 272 + (32 * dt + 4 * hh) * 2;
    const LAS float* erp = ER + 32 * dt + 4 * hh; const LAS float* elp = EL + 32 * dt + 4 * hh;
    const LAS unsigned char* aP = PP + 32 * btt * 144 + f144; const LAS unsigned char* bVB = VT + 32 * bvt * 144 + f144;
    const LAS unsigned char* aQ = QT + 32 * btt * 272 + f272; const LAS unsigned char* bS = ST + 32 * bvt * 272 + f272;
    LAS float* ost = OST + (32 * btt + 4 * hh) * 132 + 32 * bvt + l31; const LAS float* oep = OST + et * 132 + 16 * evq;
    LAS unsigned char* tq = QT + 16 * pq * 272 + d * 2; LAS unsigned char* tk = KT + 16 * pq * 272 + d * 2; LAS unsigned char* tkt = KTT + d * 144 + pq * 32; LAS unsigned char* tv = VT + d * 144 + pq * 32;
    f32x16 S0, S1;
#pragma unroll
    for (int i = 0; i < 16; ++i) { S0[i] = 0.f; S1[i] = 0.f; }
    float gq[16]; unsigned qr[16], vr[16]; v4u gt0, gt1;
    float gn[16];
#pragma unroll
    for (int i = 0; i < 16; ++i) gn[i] = F.in[IN_HGNORM][h * 128 + 16 * evq + i];
#define HG_LOAD(c) do { const int ttb = 64 * (c) - 48 + 16 * pq; \
        _Pragma("unroll") for (int i = 0; i < 16; ++i) { const int tt = ttb + i; if (tt >= 0) { const size_t gi = rowof(b, tt) * HW + d; gq[i] = HG[gi]; qr[i] = (unsigned)HQ[gi]; vr[i] = (unsigned)HV[gi]; } else { gq[i] = 0.f; qr[i] = 0u; vr[i] = 0u; } } \
        { const int tt = 64 * (c) - 48 + et; if (tt >= 0) { const GAS v4u* gp = (const GAS v4u*)(HGATE + rowof(b, tt) * HW + 16 * evq); gt0 = gp[0]; gt1 = gp[1]; } else { gt0 = (v4u){0u, 0u, 0u, 0u}; gt1 = gt0; } } } while (0)
    HG_LOAD(0);
    for (int c = 0; c < 33; ++c) {
        float bl[16];
        { float a = 0.f;
#pragma unroll
          for (int i = 0; i < 16; ++i) { a += gq[i]; bl[i] = a; } }
        SEG[pq * 128 + d] = bl[15];
        __syncthreads();
        { const float s0 = SEG[d], s1 = SEG[128 + d], s2 = SEG[256 + d], s3 = SEG[384 + d];
          const float off = pq == 0 ? 0.f : pq == 1 ? s0 : pq == 2 ? s0 + s1 : (s0 + s1) + s2, r = s0 + s1, blast = (s0 + s1) + (s2 + s3);
          unsigned kp[8], vp[8];
#pragma unroll
          for (int i = 0; i < 16; i += 2) {
              const float b0 = off + bl[i], b1 = off + bl[i + 1];
              const float q0 = __builtin_bit_cast(float, qr[i] << 16) * fexp(b0 - r), q1 = __builtin_bit_cast(float, qr[i + 1] << 16) * fexp(b1 - r);
              const float k0 = (1.f - fexp(gq[i])) * fexp(r - b0), k1 = (1.f - fexp(gq[i + 1])) * fexp(r - b1);
              const unsigned kk = pg8::cvt_pk_bf16(k0, k1), qq = pg8::cvt_pk_bf16(q0, q1);
              *(LAS unsigned short*)(tq + i * 272) = (unsigned short)qq; *(LAS unsigned short*)(tq + (i + 1) * 272) = (unsigned short)(qq >> 16);
              *(LAS unsigned short*)(tk + i * 272) = (unsigned short)kk; *(LAS unsigned short*)(tk + (i + 1) * 272) = (unsigned short)(kk >> 16);
              kp[i >> 1] = kk; vp[i >> 1] = vr[i] | (vr[i + 1] << 16); }
          *(LAS v4u*)(tkt) = (v4u){kp[0], kp[1], kp[2], kp[3]}; *(LAS v4u*)(tkt + 16) = (v4u){kp[4], kp[5], kp[6], kp[7]};
          *(LAS v4u*)(tv) = (v4u){vp[0], vp[1], vp[2], vp[3]}; *(LAS v4u*)(tv + 16) = (v4u){vp[4], vp[5], vp[6], vp[7]};
          if (pq == 0) { ER[d] = fexp(r); EL[d] = fexp(blast - r); } }
        const v4u g0 = gt0, g1 = gt1;
        __syncthreads();
        if (c + 1 < 33) HG_LOAD(c + 1);
        asm volatile("" ::: "memory");
        if (wave < 3) {
            f32x16 acc;
#pragma unroll
            for (int i = 0; i < 16; ++i) acc[i] = 0.f;
#pragma unroll
            for (int ks = 0; ks < 8; ++ks) acc = MFMA32(ldf(aK, 32 * ks), ldf(bQ, 32 * ks), acc);
            const int t = 32 * stt + l31;
#pragma unroll
            for (int g4 = 0; g4 < 4; ++g4) { const int s0 = 32 * sst + 8 * g4 + 4 * hh;
                const float x0 = (s0 + 0 <= t) ? acc[4 * g4 + 0] : 0.f, x1 = (s0 + 1 <= t) ? acc[4 * g4 + 1] : 0.f, x2 = (s0 + 2 <= t) ? acc[4 * g4 + 2] : 0.f, x3 = (s0 + 3 <= t) ? acc[4 * g4 + 3] : 0.f;
                *(LAS v2u*)(pst + 16 * g4) = (v2u){pg8::cvt_pk_bf16(x0, x1), pg8::cvt_pk_bf16(x2, x3)}; }
        }
        {
#pragma unroll
          for (int g4 = 0; g4 < 4; ++g4) { const f32x4 er = *(const LAS f32x4*)(erp + 8 * g4);
#pragma unroll
              for (int i = 0; i < 4; ++i) { S0[4 * g4 + i] *= er[i]; S1[4 * g4 + i] *= er[i]; }
              *(LAS v2u*)(sst_ + 16 * g4) = (v2u){pg8::cvt_pk_bf16(S0[4 * g4], S0[4 * g4 + 1]), pg8::cvt_pk_bf16(S0[4 * g4 + 2], S0[4 * g4 + 3])};
              *(LAS v2u*)(sst_ + 32 * 272 + 16 * g4) = (v2u){pg8::cvt_pk_bf16(S1[4 * g4], S1[4 * g4 + 1]), pg8::cvt_pk_bf16(S1[4 * g4 + 2], S1[4 * g4 + 3])}; }
#pragma unroll
          for (int ks = 0; ks < 4; ++ks) { const bf16x8 a = ldf(aKTT, 32 * ks); S0 = MFMA32(a, ldf(bV0, 32 * ks), S0); S1 = MFMA32(a, ldf(bV0, 32 * 144 + 32 * ks), S1); }
#pragma unroll
          for (int g4 = 0; g4 < 4; ++g4) { const f32x4 el = *(const LAS f32x4*)(elp + 8 * g4);
#pragma unroll
              for (int i = 0; i < 4; ++i) { S0[4 * g4 + i] *= el[i]; S1[4 * g4 + i] *= el[i]; } } }
        __syncthreads();
        { f32x16 acc;
#pragma unroll
          for (int i = 0; i < 16; ++i) acc[i] = 0.f;
#pragma unroll
          for (int ks = 0; ks < 4; ++ks) if (ks < 2 || btt == 1) acc = MFMA32(ldf(aP, 32 * ks), ldf(bVB, 32 * ks), acc);
#pragma unroll
          for (int ks = 0; ks < 8; ++ks) acc = MFMA32(ldf(aQ, 32 * ks), ldf(bS, 32 * ks), acc);
#pragma unroll
          for (int i = 0; i < 16; ++i) ost[((i & 3) + 8 * (i >> 2)) * 132] = acc[i]; }
        __syncthreads();
        { const int tt = 64 * c - 48 + et;
          f32x4 o[4]; float ss = 0.f;
#pragma unroll
          for (int j = 0; j < 4; ++j) { o[j] = *(const LAS f32x4*)(oep + 4 * j); ss += (o[j].x * o[j].x + o[j].y * o[j].y) + (o[j].z * o[j].z + o[j].w * o[j].w); }
          ss += __shfl_xor(ss, 1); ss += __shfl_xor(ss, 2); ss += __shfl_xor(ss, 4);
          const float rs = 1.0f / sqrtf(ss * (1.f / 128.f) + EPS);
          if (tt >= NMETA || (tt >= 0 && b == 0)) { const unsigned gw[8] = {g0.x, g0.y, g0.z, g0.w, g1.x, g1.y, g1.z, g1.w}; unsigned w[8];
#pragma unroll
              for (int j = 0; j < 4; ++j) { w[2 * j] = pk2(o[j].x * rs * gn[4 * j] * bflo(gw[2 * j]), o[j].y * rs * gn[4 * j + 1] * bfhi(gw[2 * j])); w[2 * j + 1] = pk2(o[j].z * rs * gn[4 * j + 2] * bflo(gw[2 * j + 1]), o[j].w * rs * gn[4 * j + 3] * bfhi(gw[2 * j + 1])); }
              GAS v4u* yp = (GAS v4u*)(YHG + rowof(b, tt) * HW + 16 * evq); yp[0] = (v4u){w[0], w[1], w[2], w[3]}; yp[1] = (v4u){w[4], w[5], w[6], w[7]}; } }
        __syncthreads();
    }
#undef HG_LOAD
}


#define DPP_F(old, v, ctrl, rmask) __builtin_bit_cast(float, __builtin_amdgcn_update_dpp(__builtin_bit_cast(int, (float)(old)), __builtin_bit_cast(int, (float)(v)), (ctrl), (rmask), 0xf, false))
__device__ __forceinline__ float wave_scan_add(float v) {
    v += DPP_F(0.f, v, 0x111, 0xf); v += DPP_F(0.f, v, 0x112, 0xf); v += DPP_F(0.f, v, 0x114, 0xf); v += DPP_F(0.f, v, 0x118, 0xf);
    v += DPP_F(0.f, v, 0x142, 0xa); v += DPP_F(0.f, v, 0x143, 0xc); return v;
}
__device__ __forceinline__ float wave_scan_max(float v) {
    const float ni = -INFINITY;
    v = fmaxf(v, DPP_F(ni, v, 0x111, 0xf)); v = fmaxf(v, DPP_F(ni, v, 0x112, 0xf)); v = fmaxf(v, DPP_F(ni, v, 0x114, 0xf)); v = fmaxf(v, DPP_F(ni, v, 0x118, 0xf));
    v = fmaxf(v, DPP_F(ni, v, 0x142, 0xa)); v = fmaxf(v, DPP_F(ni, v, 0x143, 0xc)); return v;
}
__device__ __forceinline__ void p3_mlstm_mfma(Frame& F, int bh) {
    unsigned char* ws = F.ws; const int b = bh >> 2, h = bh & 3, tid = F.tid, lane = F.lane, wave = F.wave, hh = lane >> 5, l31 = lane & 31;
    const bf16* MMg = (const bf16*)(ws + WS_MM) + h * 128; const bf16* MOg = (const bf16*)(ws + WS_MO) + h * 128; const float* LI = (const float*)(ws + WS_LI) + h; const float* LF = (const float*)(ws + WS_LF) + h;
    bf16* YML = (bf16*)(ws + WS_YML) + h * 128;
    LAS unsigned char* L = F.lds + RING_OFF;
    LAS unsigned char* CT = L; LAS unsigned char* MT = L + 17408; LAS unsigned char* KM = L + 34816; LAS unsigned char* KW = L + 44032; LAS unsigned char* QM = L + 53248; LAS unsigned char* QW = L + 62464;
    LAS unsigned char* VT = L + 71680; LAS unsigned char* SV = L + 90112; LAS unsigned char* PP = L + 108544; LAS float* OST = (LAS float*)(L + 17408);
    LAS float* SM = (LAS float*)(L + 117760);
    LAS float* U = SM; LAS float* MX = SM + 64; LAS float* BB = SM + 128; LAS float* WSs = SM + 192; LAS float* WI = SM + 256; LAS float* DENP = SM + 320  ; LAS float* NN = SM + 416; LAS float* DENI = SM + 480; LAS float* SC = SM + 544  ; LAS float* GNS = SM + 560  ;
    const int ch = tid & 127, pq = tid >> 7, et = tid >> 3, evq = tid & 7;
    const int f144 = l31 * 144 + hh * 16, f272 = l31 * 272 + hh * 16;
    const int sst = wave == 2 ? 1 : 0, stt = wave == 0 ? 0 : 1, dkt = wave & 1, svt = wave >> 1;
    const LAS unsigned char* cfp = (wave < 4 ? CT : MT) + f272;
    LAS unsigned char* qst = QM + l31 * 144 + (32 * (wave & 1) + 4 * hh) * 2; LAS unsigned char* qwst = QW + l31 * 144 + (32 * (wave & 1) + 4 * hh) * 2;
    const int kdk = 32 * (wave & 1) + l31;
    LAS unsigned char* kmst = KM + 4 * hh * 144 + kdk * 2; LAS unsigned char* kwst = KW + kdk * 144 + 4 * hh * 2; const LAS float* wsp = WSs + 4 * hh;
    LAS unsigned char* vst = VT + (32 * (wave & 3) + l31) * 144 + 4 * hh * 2;
    const LAS unsigned char* aKM = KM + 32 * sst * 144 + f144; const LAS unsigned char* bQM = QM + 32 * stt * 144 + f144;
    LAS unsigned char* pst = PP + (32 * stt + l31) * 144 + (32 * sst + 4 * hh) * 2; const LAS float* up = U + 32 * sst + 4 * hh;
    LAS unsigned char* svst = SV + (32 * svt + l31) * 144 + (32 * dkt + 4 * hh) * 2;
    const LAS unsigned char* aKW = KW + 32 * dkt * 144 + f144; const LAS unsigned char* bVT = VT + 32 * svt * 144 + f144;
    const LAS unsigned char* aP = PP + 32 * dkt * 144 + f144; const LAS unsigned char* aQW = QW + 32 * dkt * 144 + f144; const LAS unsigned char* bSV = SV + 32 * svt * 144 + f144;
    LAS float* ost = OST + (32 * dkt + 4 * hh) * 132 + 32 * svt + l31; const LAS float* oep = OST + et * 132 + 16 * evq;
    LAS unsigned char* tc = CT + 16 * pq * 272 + ch * 2; LAS unsigned char* tm = MT + 16 * pq * 272 + ch * 2;
    bf16x8 wf[8];
    { const float* W = wave < 2 ? F.in[IN_WQ] + (size_t)h * 128 * 64 + 32 * wave + l31 : wave < 4 ? F.in[IN_WK] + (size_t)h * 128 * 64 + 32 * (wave - 2) + l31 : F.in[IN_WV] + (size_t)h * 128 * 128 + 32 * (wave - 4) + l31;
      const int ld = wave < 4 ? 64 : 128; const float sc = wave < 2 ? 0.125f : 1.f;
#pragma unroll
      for (int ks = 0; ks < 8; ++ks) { unsigned p[4];
#pragma unroll
          for (int j = 0; j < 4; ++j) p[j] = pk2(W[(size_t)(16 * ks + 8 * hh + 2 * j) * ld] * sc, W[(size_t)(16 * ks + 8 * hh + 2 * j + 1) * ld] * sc);
          wf[ks] = __builtin_bit_cast(bf16x8, (v4u){p[0], p[1], p[2], p[3]}); } }
    float cw[4]; const float cb = F.in[IN_CONVB][h * 128 + ch];
#pragma unroll
    for (int j = 0; j < 4; ++j) cw[j] = F.in[IN_CONVW][j * HW + h * 128 + ch];
    if (tid < 128) GNS[tid] = F.in[IN_MLNORM][h * 128 + tid]; else if (tid < 256) GNS[tid] = F.in[IN_MLSKIP][h * 128 + tid - 128];
    f32x16 S;
#pragma unroll
    for (int i = 0; i < 16; ++i) S[i] = 0.f;
    float mcar = 0.f, nreg = 0.f;
    unsigned mr[19]; v4u gt0, gt1; float pli = 0.f, plf = 0.f;
#define ML_LOAD(c) do { const int ttb = 64 * (c) - 48 + 16 * pq - 3; \
        _Pragma("unroll") for (int i = 0; i < 19; ++i) { const int tt = ttb + i; mr[i] = tt >= 0 ? (unsigned)MMg[rowof(b, tt) * HW + ch] : 0u; } \
        { const int tt = 64 * (c) - 48 + et; if (tt >= 0) { const GAS v4u* gp = (const GAS v4u*)(MOg + rowof(b, tt) * HW + 16 * evq); gt0 = gp[0]; gt1 = gp[1]; } else { gt0 = (v4u){0u, 0u, 0u, 0u}; gt1 = gt0; } } \
        if (wave == 0) { const int tt = 64 * (c) - 48 + lane; if (tt >= 0) { pli = LI[rowof(b, tt) * 4]; plf = LF[rowof(b, tt) * 4]; } else { pli = -1e30f; plf = 0.f; } } } while (0)
    ML_LOAD(0);
    for (int c = 0; c < 33; ++c) {
#pragma unroll
        for (int i = 0; i < 16; ++i) { const float a = cb + (cw[0] * __builtin_bit_cast(float, mr[i] << 16) + cw[1] * __builtin_bit_cast(float, mr[i + 1] << 16)) + (cw[2] * __builtin_bit_cast(float, mr[i + 2] << 16) + cw[3] * __builtin_bit_cast(float, mr[i + 3] << 16));
            *(LAS unsigned short*)(tc + i * 272) = (unsigned short)f2bf(fsilu(a)); *(LAS unsigned short*)(tm + i * 272) = (unsigned short)mr[i + 3]; }
        if (wave == 0) {
            const float bs = wave_scan_add(plf);
            const float u = pli - bs; const float pm = wave_scan_max(u);
            const float M = fmaxf(mcar, pm), M63 = __shfl(M, 63), b63 = __shfl(bs, 63);
            U[lane] = u; MX[lane] = M; BB[lane] = bs; WSs[lane] = fexp(u - M63); WI[lane] = fexp(mcar - M);
            if (lane == 0) { SC[0] = b63; SC[1] = M63; }
        }
        __syncthreads();
        { f32x16 a0, a1;
#pragma unroll
          for (int i = 0; i < 16; ++i) { a0[i] = 0.f; a1[i] = 0.f; }
          if (wave < 2) {
#pragma unroll
              for (int ks = 0; ks < 8; ++ks) { a0 = MFMA32(wf[ks], ldf(cfp, 32 * ks), a0); a1 = MFMA32(wf[ks], ldf(cfp, 32 * 272 + 32 * ks), a1); }
              const float wi0 = WI[l31], wi1 = WI[32 + l31];
#pragma unroll
              for (int g4 = 0; g4 < 4; ++g4) {
                  *(LAS v2u*)(qst + 16 * g4) = (v2u){pg8::cvt_pk_bf16(a0[4 * g4], a0[4 * g4 + 1]), pg8::cvt_pk_bf16(a0[4 * g4 + 2], a0[4 * g4 + 3])};
                  *(LAS v2u*)(qst + 32 * 144 + 16 * g4) = (v2u){pg8::cvt_pk_bf16(a1[4 * g4], a1[4 * g4 + 1]), pg8::cvt_pk_bf16(a1[4 * g4 + 2], a1[4 * g4 + 3])};
                  *(LAS v2u*)(qwst + 16 * g4) = (v2u){pg8::cvt_pk_bf16(a0[4 * g4] * wi0, a0[4 * g4 + 1] * wi0), pg8::cvt_pk_bf16(a0[4 * g4 + 2] * wi0, a0[4 * g4 + 3] * wi0)};
                  *(LAS v2u*)(qwst + 32 * 144 + 16 * g4) = (v2u){pg8::cvt_pk_bf16(a1[4 * g4] * wi1, a1[4 * g4 + 1] * wi1), pg8::cvt_pk_bf16(a1[4 * g4 + 2] * wi1, a1[4 * g4 + 3] * wi1)}; }
          } else {
#pragma unroll
              for (int ks = 0; ks < 8; ++ks) { a0 = MFMA32(ldf(cfp, 32 * ks), wf[ks], a0); a1 = MFMA32(ldf(cfp, 32 * 272 + 32 * ks), wf[ks], a1); }
              if (wave < 4) {
                  float nsum = 0.f;
#pragma unroll
                  for (int g4 = 0; g4 < 4; ++g4) { const f32x4 w0 = *(const LAS f32x4*)(wsp + 8 * g4), w1 = *(const LAS f32x4*)(wsp + 32 + 8 * g4);
#pragma unroll
                      for (int i = 0; i < 4; ++i) { *(LAS unsigned short*)(kmst + (8 * g4 + i) * 144) = (unsigned short)f2bf(a0[4 * g4 + i]); *(LAS unsigned short*)(kmst + (32 + 8 * g4 + i) * 144) = (unsigned short)f2bf(a1[4 * g4 + i]); }
                      const float x0 = a0[4 * g4] * w0[0], x1 = a0[4 * g4 + 1] * w0[1], x2 = a0[4 * g4 + 2] * w0[2], x3 = a0[4 * g4 + 3] * w0[3];
                      const float y0 = a1[4 * g4] * w1[0], y1 = a1[4 * g4 + 1] * w1[1], y2 = a1[4 * g4 + 2] * w1[2], y3 = a1[4 * g4 + 3] * w1[3];
                      nsum += ((x0 + x1) + (x2 + x3)) + ((y0 + y1) + (y2 + y3));
                      *(LAS v2u*)(kwst + 16 * g4) = (v2u){pg8::cvt_pk_bf16(x0, x1), pg8::cvt_pk_bf16(x2, x3)};
                      *(LAS v2u*)(kwst + 64 + 16 * g4) = (v2u){pg8::cvt_pk_bf16(y0, y1), pg8::cvt_pk_bf16(y2, y3)}; }
                  nsum += __shfl_xor(nsum, 32);
                  if (hh == 0) NN[kdk] = nreg;
                  nreg = fexp(mcar - SC[1]) * nreg + nsum;
              } else {
#pragma unroll
                  for (int g4 = 0; g4 < 4; ++g4) {
                      *(LAS v2u*)(vst + 16 * g4) = (v2u){pg8::cvt_pk_bf16(a0[4 * g4], a0[4 * g4 + 1]), pg8::cvt_pk_bf16(a0[4 * g4 + 2], a0[4 * g4 + 3])};
                      *(LAS v2u*)(vst + 64 + 16 * g4) = (v2u){pg8::cvt_pk_bf16(a1[4 * g4], a1[4 * g4 + 1]), pg8::cvt_pk_bf16(a1[4 * g4 + 2], a1[4 * g4 + 3])}; }
              }
          } }
        __syncthreads();
        const v4u g0 = gt0, g1 = gt1;
        if (c + 1 < 33) ML_LOAD(c + 1);
        asm volatile("" ::: "memory");
        if (wave < 3) {
            f32x16 acc;
#pragma unroll
            for (int i = 0; i < 16; ++i) acc[i] = 0.f;
#pragma unroll
            for (int ks = 0; ks < 4; ++ks) acc = MFMA32(ldf(aKM, 32 * ks), ldf(bQM, 32 * ks), acc);
            const int t = 32 * stt + l31; const float mt = MX[t]; float dsum = 0.f;
#pragma unroll
            for (int g4 = 0; g4 < 4; ++g4) { const int s0 = 32 * sst + 8 * g4 + 4 * hh; const f32x4 us = *(const LAS f32x4*)(up + 8 * g4);
                const float x0 = (s0 + 0 <= t) ? acc[4 * g4 + 0] * fexp(us[0] - mt) : 0.f, x1 = (s0 + 1 <= t) ? acc[4 * g4 + 1] * fexp(us[1] - mt) : 0.f;
                const float x2 = (s0 + 2 <= t) ? acc[4 * g4 + 2] * fexp(us[2] - mt) : 0.f, x3 = (s0 + 3 <= t) ? acc[4 * g4 + 3] * fexp(us[3] - mt) : 0.f;
                dsum += (x0 + x1) + (x2 + x3);
                *(LAS v2u*)(pst + 16 * g4) = (v2u){pg8::cvt_pk_bf16(x0, x1), pg8::cvt_pk_bf16(x2, x3)}; }
            dsum += __shfl_xor(dsum, 32);
            if (hh == 0) DENP[wave * 32 + l31] = dsum;
        } else if (wave == 3) {
            float a = 0.f;
#pragma unroll 2
            for (int j = 0; j < 8; ++j) { const v4u q = *(const LAS v4u*)(QW + lane * 144 + 16 * j); const f32x4 n0 = *(const LAS f32x4*)(NN + 8 * j), n1 = *(const LAS f32x4*)(NN + 8 * j + 4);
                a += (bflo(q.x) * n0[0] + bfhi(q.x) * n0[1]) + (bflo(q.y) * n0[2] + bfhi(q.y) * n0[3]) + (bflo(q.z) * n1[0] + bfhi(q.z) * n1[1]) + (bflo(q.w) * n1[2] + bfhi(q.w) * n1[3]); }
            DENI[lane] = a;
        }
        { const float wp = fexp(mcar - SC[1]);
#pragma unroll
          for (int g4 = 0; g4 < 4; ++g4) {
              *(LAS v2u*)(svst + 16 * g4) = (v2u){pg8::cvt_pk_bf16(S[4 * g4], S[4 * g4 + 1]), pg8::cvt_pk_bf16(S[4 * g4 + 2], S[4 * g4 + 3])};
#pragma unroll
              for (int i = 0; i < 4; ++i) S[4 * g4 + i] *= wp; }
#pragma unroll
          for (int ks = 0; ks < 4; ++ks) S = MFMA32(ldf(aKW, 32 * ks), ldf(bVT, 32 * ks), S); }
        __syncthreads();
        { f32x16 acc;
#pragma unroll
          for (int i = 0; i < 16; ++i) acc[i] = 0.f;
#pragma unroll
          for (int ks = 0; ks < 4; ++ks) if (ks < 2 || dkt == 1) acc = MFMA32(ldf(aP, 32 * ks), ldf(bVT, 32 * ks), acc);
#pragma unroll
          for (int ks = 0; ks < 4; ++ks) acc = MFMA32(ldf(aQW, 32 * ks), ldf(bSV, 32 * ks), acc);
#pragma unroll
          for (int i = 0; i < 16; ++i) ost[((i & 3) + 8 * (i >> 2)) * 132] = acc[i]; }
        __syncthreads();
        { const int tt = 64 * c - 48 + et;
          const float den = (et < 32 ? DENP[et] : DENP[et] + DENP[32 + et]) + DENI[et];
          const float inv = 1.0f / fmaxf(fabsf(den), fexp(-(BB[et] + MX[et])));
          f32x4 o[4]; float ss = 0.f;
#pragma unroll
          for (int j = 0; j < 4; ++j) { o[j] = *(const LAS f32x4*)(oep + 4 * j) * inv; ss += (o[j].x * o[j].x + o[j].y * o[j].y) + (o[j].z * o[j].z + o[j].w * o[j].w); }
          ss += __shfl_xor(ss, 1); ss += __shfl_xor(ss, 2); ss += __shfl_xor(ss, 4);
          const float rs = 1.0f / sqrtf(ss * (1.f / 128.f) + EPS);
          if (tt >= NMETA || (tt >= 0 && b == 0)) { const unsigned gw[8] = {g0.x, g0.y, g0.z, g0.w, g1.x, g1.y, g1.z, g1.w}; unsigned w[8];
              const v4u c0 = *(const LAS v4u*)(CT + et * 272 + 32 * evq), c1 = *(const LAS v4u*)(CT + et * 272 + 32 * evq + 16); const unsigned cwd[8] = {c0.x, c0.y, c0.z, c0.w, c1.x, c1.y, c1.z, c1.w};
#pragma unroll
              for (int j = 0; j < 4; ++j) { const f32x4 gn = *(const LAS f32x4*)(GNS + 16 * evq + 4 * j), sk = *(const LAS f32x4*)(GNS + 128 + 16 * evq + 4 * j);
                  w[2 * j] = pk2((o[j].x * rs * gn[0] + sk[0] * bflo(cwd[2 * j])) * bflo(gw[2 * j]), (o[j].y * rs * gn[1] + sk[1] * bfhi(cwd[2 * j])) * bfhi(gw[2 * j]));
                  w[2 * j + 1] = pk2((o[j].z * rs * gn[2] + sk[2] * bflo(cwd[2 * j + 1])) * bflo(gw[2 * j + 1]), (o[j].w * rs * gn[3] + sk[3] * bfhi(cwd[2 * j + 1])) * bfhi(gw[2 * j + 1])); }
              GAS v4u* yp = (GAS v4u*)(YML + rowof(b, tt) * HW + 16 * evq); yp[0] = (v4u){w[0], w[1], w[2], w[3]}; yp[1] = (v4u){w[4], w[5], w[6], w[7]}; }
          mcar = SC[0] + SC[1]; }
        __syncthreads();
    }
#undef ML_LOAD
}

typedef float f32x4v __attribute__((ext_vector_type(4)));
#define MFMA16F(a, b, c) __builtin_amdgcn_mfma_f32_16x16x4f32(a, b, c, 0, 0, 0)
constexpr int RW_LD = 516;
__device__ __forceinline__ void router_topk16(LAS float* LGw, int V, float rsv, int resrow, int lane, LAS int* hist, LAS int* res, int* TOPE, float* TOPW, float* RS) {
    if (lane < 16) {
        int se[4]; float sv[4];
#pragma unroll
        for (int k = 0; k < 4; ++k) { float best = -INFINITY; int bi = 0;
            for (int e = 0; e < 32; ++e) { const float v = LGw[lane * 33 + e]; if (v > best) { best = v; bi = e; } }
            se[k] = bi; sv[k] = best; LGw[lane * 33 + bi] = -INFINITY; }
        const float e1 = __expf(sv[1] - sv[0]), e2 = __expf(sv[2] - sv[0]), e3 = __expf(sv[3] - sv[0]), inv = 1.0f / (1.f + e1 + e2 + e3);
        const float w4[4] = {inv, e1 * inv, e2 * inv, e3 * inv};
#pragma unroll
        for (int k = 0; k < 4; ++k) { const int lp = __hip_atomic_fetch_add(hist + se[k], 1, __ATOMIC_RELAXED, __HIP_MEMORY_SCOPE_WORKGROUP);
            TOPE[(size_t)V * 4 + k] = se[k]; TOPW[(size_t)V * 4 + k] = w4[k]; res[(resrow + lane) * 4 + k] = lp; }
        RS[V] = rsv;
    }
}
__device__ __forceinline__ void p6_router(Frame& F) {
    unsigned char* ws = F.ws;
    const bf16* H1 = (const bf16*)(ws + WS_H1); const float* RWT = (const float*)(ws + WS_RWT);
    int* TOPE = (int*)(ws + WS_TOPE); int* TOPP = (int*)(ws + WS_TOPP); float* TOPW = (float*)(ws + WS_TOPW); float* RS = (float*)(ws + WS_RS);
    int* ETOK = (int*)(ws + WS_ETOK); float* ERS = (float*)(ws + WS_ERS); float* EW = (float*)(ws + WS_EW);
    LAS float* rw = (LAS float*)(F.lds + RING_OFF);
    LAS float* LG = (LAS float*)(F.lds + RING_OFF + 66048) + F.wave * 528;
    LAS int* hist = (LAS int*)(F.lds + RING_OFF + 66048 + 8 * 2112);
    LAS int* res = hist + 64;
    LAS float* XP = (LAS float*)(res + 144 * 4);
    LAS float* XQ = XP + 8 * 528;
    const int lane = F.lane, wave = F.wave, i16 = lane & 15, kk = lane >> 4;
    constexpr int RPW = NTOK / 256;
    const bool has_meta = (F.vcu == 0);
    const int Vbase = F.vcu * RPW, Vt = Vbase + 16 * wave;
    if (F.tid < 64) hist[F.tid] = 0;
    f32x4v acc0 = {0.f, 0.f, 0.f, 0.f}, acc1 = {0.f, 0.f, 0.f, 0.f}, acx0 = {0.f, 0.f, 0.f, 0.f}, acx1 = {0.f, 0.f, 0.f, 0.f}; float ssq = 0.f, xss = 0.f;
    const bf16* arow = H1 + (size_t)(Vt + i16) * D + 8 * kk;
    const bf16* xrow = H1 + (size_t)(NTOK + i16) * D + 8 * kk;
    v4u a0[4], a1[4];
#define RT_MMA(A, SB, C0, C1, SS) do { const LAS float* b0p = rw + i16 * RW_LD + 8 * kk + 128 * (SB); const LAS float* b1p = rw + (16 + i16) * RW_LD + 8 * kk + 128 * (SB); \
        _Pragma("unroll") for (int s = 0; s < 4; ++s) { const v4u aw = A[s]; \
            _Pragma("unroll") for (int h = 0; h < 2; ++h) { const unsigned w0 = h ? aw.z : aw.x, w1 = h ? aw.w : aw.y; const f32x4 a = {bflo(w0), bfhi(w0), bflo(w1), bfhi(w1)}; \
            const f32x4 b0 = *(const LAS f32x4*)(b0p + 32 * s + 4 * h), b1 = *(const LAS f32x4*)(b1p + 32 * s + 4 * h); \
            SS += (a.x * a.x + a.y * a.y) + (a.z * a.z + a.w * a.w); \
            C0 = MFMA16F(a.x, b0.x, C0); C1 = MFMA16F(a.x, b1.x, C1); C0 = MFMA16F(a.y, b0.y, C0); C1 = MFMA16F(a.y, b1.y, C1); \
            C0 = MFMA16F(a.z, b0.z, C0); C1 = MFMA16F(a.z, b1.z, C1); C0 = MFMA16F(a.w, b0.w, C0); C1 = MFMA16F(a.w, b1.w, C1); } } } while (0)
#pragma unroll
    for (int s = 0; s < 4; ++s) a0[s] = *(const GAS v4u*)(arow + 32 * s);
#pragma unroll 1
    for (int it = 0; it < 4; ++it) {
        const int half = it >> 1, sb0 = (2 * it) & 3;
        if ((it & 1) == 0) {
            __syncthreads();
            { f32x4 stg[8];
#pragma unroll
              for (int q = 0; q < 8; ++q) { const int u = F.tid + q * NTHREADS, e = u >> 7, c = u & 127; stg[q] = *(const GAS f32x4*)(RWT + (size_t)e * D + 512 * half + 4 * c); }
#pragma unroll
              for (int q = 0; q < 8; ++q) { const int u = F.tid + q * NTHREADS, e = u >> 7, c = u & 127; *(LAS f32x4*)(rw + e * RW_LD + 4 * c) = stg[q]; } }
            __syncthreads();
        }
#pragma unroll
        for (int s = 0; s < 4; ++s) a1[s] = *(const GAS v4u*)(arow + 128 * (2 * it + 1) + 32 * s);
        RT_MMA(a0, sb0, acc0, acc1, ssq);
        if (it < 3) {
#pragma unroll
            for (int s = 0; s < 4; ++s) a0[s] = *(const GAS v4u*)(arow + 128 * (2 * it + 2) + 32 * s);
        }
        RT_MMA(a1, sb0 + 1, acc0, acc1, ssq);
        if (has_meta && (wave >> 1) == it) {
            v4u ax[4];
#pragma unroll
            for (int s = 0; s < 4; ++s) ax[s] = *(const GAS v4u*)(xrow + 128 * wave + 32 * s);
            RT_MMA(ax, wave & 3, acx0, acx1, xss);
        }
    }
#undef RT_MMA
    if (has_meta) {
        xss += __shfl_xor(xss, 16); xss += __shfl_xor(xss, 32);
#pragma unroll
        for (int r = 0; r < 4; ++r) { XP[wave * 528 + (4 * kk + r) * 33 + i16] = acx0[r]; XP[wave * 528 + (4 * kk + r) * 33 + 16 + i16] = acx1[r]; }
        if (kk == 0) XQ[wave * 16 + i16] = xss;
    }
    ssq += __shfl_xor(ssq, 16); ssq += __shfl_xor(ssq, 32);
    const float rsrow = 1.0f / sqrtf(ssq * (1.f / D) + EPS);
    const float rb0 = F.in[IN_RB][i16], rb1 = F.in[IN_RB][16 + i16];
#pragma unroll
    for (int r = 0; r < 4; ++r) { const float rsr = __shfl(rsrow, 4 * kk + r); LG[(4 * kk + r) * 33 + i16] = acc0[r] * rsr + rb0; LG[(4 * kk + r) * 33 + 16 + i16] = acc1[r] * rsr + rb1; }
    LDS_WAIT(); asm volatile("" ::: "memory");
    router_topk16(LG, Vt + lane, rsrow, 16 * wave, lane, hist, res, TOPE, TOPW, RS);
    __syncthreads();
    if (has_meta && wave == 7) {
        float q = 0.f;
#pragma unroll
        for (int w = 0; w < 8; ++w) q += XQ[w * 16 + i16];
        const float rsm = 1.0f / sqrtf(q * (1.f / D) + EPS);
#pragma unroll
        for (int r = 0; r < 4; ++r) { float v0 = 0.f, v1 = 0.f;
#pragma unroll
            for (int w = 0; w < 8; ++w) { v0 += XP[w * 528 + (4 * kk + r) * 33 + i16]; v1 += XP[w * 528 + (4 * kk + r) * 33 + 16 + i16]; }
            const float rsr = __shfl(rsm, 4 * kk + r); LG[(4 * kk + r) * 33 + i16] = v0 * rsr + rb0; LG[(4 * kk + r) * 33 + 16 + i16] = v1 * rsr + rb1; }
        LDS_WAIT(); asm volatile("" ::: "memory");
        router_topk16(LG, NTOK + lane, rsm, 128, lane, hist, res, TOPE, TOPW, RS);
    }
    __syncthreads();
    if (F.tid < NE) hist[32 + F.tid] = (int)__hip_atomic_fetch_add(F.ctl + CW_CNT + 64 * F.tid, (unsigned)hist[F.tid], RLX_AGENT);
    __syncthreads();
    const int nrows = has_meta ? RPW + 16 : RPW;
    for (int u = F.tid; u < nrows * 4; u += NTHREADS) { const int rr = u >> 2, V = rr < RPW ? Vbase + rr : NTOK + (rr - RPW); const size_t gi = (size_t)V * 4 + (u & 3); const int e = TOPE[gi], pos = hist[32 + e] + res[u];
        TOPP[gi] = pos; ETOK[(size_t)e * NV + pos] = V; ERS[(size_t)e * NV + pos] = RS[V]; EW[(size_t)e * NV + pos] = TOPW[gi]; }
}

__device__ __forceinline__ void build_tables(Frame& F) {
    LAS int* pst = (LAS int*)(F.lds + PST_OFF); LAS unsigned char* texp = (LAS unsigned char*)(F.lds + TEXP_OFF);
    __syncthreads();
    if (F.tid < 64) {
        const int e = F.lane & 31; const int c = (int)__hip_atomic_load(F.ctl + CW_CNT + 64 * e, RLX_AGENT); const int nt = (c + 255) >> 8;
        int incl = nt;
#pragma unroll
        for (int o = 1; o < 32; o <<= 1) { const int t = __shfl_up(incl, o); if ((F.lane & 31) >= o) incl += t; }
        const int start = incl - nt;
        if (F.lane < 32) { pst[e] = start * 256; pst[33 + e] = c; for (int j = 0; j < nt && start + j < MAXTILES; ++j) texp[start + j] = (unsigned char)e; if (e == 31) pst[32] = incl < MAXTILES ? incl : MAXTILES; }
    }
    __syncthreads();
}
typedef float f32v2_t __attribute__((ext_vector_type(2)));
__device__ __forceinline__ void p10_combine(Frame& F) {
    unsigned char* ws = F.ws; build_tables(F);
    const LAS int* pst = (const LAS int*)(F.lds + PST_OFF);
    const bf16* H1 = (const bf16*)(ws + WS_H1); const unsigned char* YB = (const unsigned char*)(ws + WS_YB);
    const int* TOPE = (const int*)(ws + WS_TOPE); const int* TOPP = (const int*)(ws + WS_TOPP);
    const int gw = F.vcu * NWAVES + F.wave, NGW = F.G * NWAVES;
    const GAS f32x4* nf = (const GAS f32x4*)F.in[IN_NFIN] + F.lane; f32x4 nfv[4];
#pragma unroll
    for (int j = 0; j < 4; ++j) nfv[j] = nf[64 * j];
    int sl[2][4];
#define CMB_SLOTS(Rbase) do { _Pragma("unroll") for (int q = 0; q < 2; ++q) { const int R = (Rbase) + q * NGW; if (R < BATCH * SEQ) { const size_t V = (size_t)R; \
        _Pragma("unroll") for (int k = 0; k < 4; ++k) sl[q][k] = pst[TOPE[V * 4 + k]] + TOPP[V * 4 + k]; } else { _Pragma("unroll") for (int k = 0; k < 4; ++k) sl[q][k] = 0; } } } while (0)
    CMB_SLOTS(gw);
    for (int R0 = gw; R0 < BATCH * SEQ; R0 += 2 * NGW) {
        f32x4 v[2][4]; unsigned y[2][4][4];
#pragma unroll
        for (int q = 0; q < 2; ++q) { const int R = (R0 + q * NGW < BATCH * SEQ) ? R0 + q * NGW : R0; const size_t V = (size_t)R;
            const GAS v2u* hr = (const GAS v2u*)(H1 + V * D) + F.lane;
#pragma unroll
            for (int j = 0; j < 4; ++j) { const v2u hw = hr[64 * j]; v[q][j] = (f32x4){bflo(hw.x), bfhi(hw.x), bflo(hw.y), bfhi(hw.y)}; }
#pragma unroll
            for (int k = 0; k < 4; ++k) { const GAS unsigned* yr = (const GAS unsigned*)(YB + (size_t)sl[q][k] * D) + F.lane;
#pragma unroll
                for (int j = 0; j < 4; ++j) y[q][k][j] = yr[64 * j]; } }
        CMB_SLOTS(R0 + 2 * NGW);
#pragma unroll
        for (int q = 0; q < 2; ++q) { const int R = R0 + q * NGW; if (R >= BATCH * SEQ) continue;
#pragma unroll
            for (int k = 0; k < 4; ++k)
#pragma unroll
                for (int j = 0; j < 4; ++j) { const unsigned w = y[q][k][j]; const f32v2_t lo = __builtin_amdgcn_cvt_pk_f32_fp8(w, false), hi = __builtin_amdgcn_cvt_pk_f32_fp8(w, true);
                    v[q][j].x += lo[0] * 0.0625f; v[q][j].y += lo[1] * 0.0625f; v[q][j].z += hi[0] * 0.0625f; v[q][j].w += hi[1] * 0.0625f; }
            float s = 0.f;
#pragma unroll
            for (int j = 0; j < 4; ++j) s += (v[q][j].x * v[q][j].x + v[q][j].y * v[q][j].y) + (v[q][j].z * v[q][j].z + v[q][j].w * v[q][j].w);
            const float rs = 1.0f / sqrtf(wave_sum(s) * (1.f / D) + EPS);
            GAS f32x4* orow = (GAS f32x4*)(F.out + (size_t)R * D) + F.lane;
#pragma unroll
            for (int j = 0; j < 4; ++j) orow[64 * j] = v[q][j] * rs * nfv[j]; }
    }
#undef CMB_SLOTS
}

__device__ __forceinline__ int meta_row(int lane) { return ((lane >> 5) & 1) * 8 + ((lane >> 4) & 1) * 4 + ((lane >> 3) & 1) * 2 + ((lane >> 2) & 1); }
template <int KPL> __device__ __forceinline__ float meta_col(const LAS unsigned char* A, const bf16* wrow, int lane) {
    constexpr int K = 64 * KPL; float w[KPL];
#pragma unroll
    for (int j = 0; j < KPL / 8; ++j) { const v4u x = *(const GAS v4u*)(wrow + lane * KPL + 8 * j);
        w[8 * j] = bflo(x.x); w[8 * j + 1] = bfhi(x.x); w[8 * j + 2] = bflo(x.y); w[8 * j + 3] = bfhi(x.y); w[8 * j + 4] = bflo(x.z); w[8 * j + 5] = bfhi(x.z); w[8 * j + 6] = bflo(x.w); w[8 * j + 7] = bfhi(x.w); }
    float p[16];
#pragma unroll
    for (int r = 0; r < 16; ++r) { float s = 0.f;
#pragma unroll
        for (int j = 0; j < KPL / 8; ++j) { const v4u a = *(const LAS v4u*)(A + (r * K + lane * KPL + 8 * j) * 2);
            s += (bflo(a.x) * w[8 * j] + bfhi(a.x) * w[8 * j + 1]) + (bflo(a.y) * w[8 * j + 2] + bfhi(a.y) * w[8 * j + 3]) + (bflo(a.z) * w[8 * j + 4] + bfhi(a.z) * w[8 * j + 5]) + (bflo(a.w) * w[8 * j + 6] + bfhi(a.w) * w[8 * j + 7]); }
        p[r] = s; if ((r & 3) == 3) asm volatile("" ::: "memory"); }
    const bool b32 = lane & 32, b16 = lane & 16, b8 = lane & 8, b4 = lane & 4;
    float q8[8], q4[4], q2[2];
#pragma unroll
    for (int i = 0; i < 8; ++i) { const float keep = b32 ? p[i + 8] : p[i], send = b32 ? p[i] : p[i + 8]; q8[i] = keep + __shfl_xor(send, 32); }
#pragma unroll
    for (int i = 0; i < 4; ++i) { const float keep = b16 ? q8[i + 4] : q8[i], send = b16 ? q8[i] : q8[i + 4]; q4[i] = keep + __shfl_xor(send, 16); }
#pragma unroll
    for (int i = 0; i < 2; ++i) { const float keep = b8 ? q4[i + 2] : q4[i], send = b8 ? q4[i] : q4[i + 2]; q2[i] = keep + __shfl_xor(send, 8); }
    float v = (b4 ? q2[1] : q2[0]) + __shfl_xor(b4 ? q2[0] : q2[1], 4);
    v += __shfl_xor(v, 2); v += __shfl_xor(v, 1);
    return v;
}
__device__ __forceinline__ void meta_stage(Frame& F, LAS unsigned char* dst, const bf16* src, int K) {
    v4u t[4]; const int n = 16 * K / 8;
#pragma unroll
    for (int q = 0; q < 4; ++q) { const int u = F.tid + q * NTHREADS; if (u < n) t[q] = *(const GAS v4u*)(src + (size_t)u * 8); }
#pragma unroll
    for (int q = 0; q < 4; ++q) { const int u = F.tid + q * NTHREADS; if (u < n) *(LAS v4u*)(dst + u * 16) = t[q]; }
}
__device__ __forceinline__ void meta_proj(Frame& F) {
    unsigned char* ws = F.ws; const bf16* WIN = (const bf16*)(ws + WS_WIN); const float* lbl = F.in[IN_LBL];
    LAS unsigned char* A = F.lds + RING_OFF;
    __syncthreads(); meta_stage(F, A, (const bf16*)(ws + WS_XN0) + (size_t)NTOK * D, D); __syncthreads();
    for (int c = F.vcu * NWAVES + F.wave; c < NPROJ; c += F.G * NWAVES) {
        const float v = meta_col<16>(A, WIN + (size_t)c * D, F.lane);
        if ((F.lane & 3) == 0) { const size_t row = NTOK + meta_row(F.lane); const int kind = c < 3072 ? (c >> 9) : 6, cc = c & 511;
            if (kind == 0) ((bf16*)(ws + WS_HQ))[row * HW + cc] = (bf16)f2bf(fsilu(v));
            else if (kind == 1) { const float lb = fsigmoid(lbl[cc] - lbl[HW + cc]); ((float*)(ws + WS_HG))[row * HW + cc] = __logf(lb + (1.f - lb) * fsigmoid(v)); }
            else if (kind == 2) ((bf16*)(ws + WS_HV))[row * HW + cc] = (bf16)f2bf(v);
            else if (kind == 3) ((bf16*)(ws + WS_HGATE))[row * HW + cc] = (bf16)f2bf(fsilu(v));
            else if (kind == 4) ((bf16*)(ws + WS_MM))[row * HW + cc] = (bf16)f2bf(v);
            else if (kind == 5) ((bf16*)(ws + WS_MO))[row * HW + cc] = (bf16)f2bf(fsigmoid(v));
            else (ws + WS_GATES)[row * 2048 + pg8::gate_pos(c - 3072)] = (unsigned char)(__builtin_bit_cast(unsigned, __builtin_fmaf(fsigmoid(v), 255.f, 8388608.f)) & 0xffu); } }
}
__device__ __forceinline__ void meta_merged(Frame& F) {
    unsigned char* ws = F.ws; const unsigned char* GATES = ws + WS_GATES;
    LAS unsigned char* A0 = F.lds + RING_OFF; LAS unsigned char* A1 = A0 + 16 * HW * 2;
    __syncthreads(); meta_stage(F, A0, (const bf16*)(ws + WS_YHG) + (size_t)NTOK * HW, HW); meta_stage(F, A1, (const bf16*)(ws + WS_YML) + (size_t)NTOK * HW, HW); __syncthreads();
    for (int c = F.vcu * NWAVES + F.wave; c < D; c += F.G * NWAVES) {
        const float vh = meta_col<8>(A0, (const bf16*)(ws + WS_WBH) + (size_t)c * HW, F.lane), vm = meta_col<8>(A1, (const bf16*)(ws + WS_WBM) + (size_t)c * HW, F.lane);
        if ((F.lane & 3) == 0) { const size_t row = NTOK + meta_row(F.lane); ((bf16*)(ws + WS_MERGED))[row * D + c] = (bf16)f2bf((float)GATES[row * 2048 + pg8::gate_pos(c)] * vh + (float)GATES[row * 2048 + pg8::gate_pos(D + c)] * vm); } }
}
__device__ __forceinline__ void meta_wout(Frame& F) {
    unsigned char* ws = F.ws; LAS unsigned char* A = F.lds + RING_OFF;
    __syncthreads(); meta_stage(F, A, (const bf16*)(ws + WS_MERGED) + (size_t)NTOK * D, D); __syncthreads();
    for (int c = F.vcu * NWAVES + F.wave; c < D; c += F.G * NWAVES) {
        const float d = meta_col<16>(A, (const bf16*)(ws + WS_WOUT) + (size_t)c * D, F.lane);
        if ((F.lane & 3) == 0) { const int mr_ = meta_row(F.lane); const size_t row = NTOK + mr_; const float v = F.in[IN_META][(size_t)mr_ * D + c] + d;
            ((bf16*)(ws + WS_H1))[row * D + c] = (bf16)f2bf(v); ((unsigned char*)(ws + WS_H1B))[row * D + c] = (unsigned char)(__builtin_amdgcn_cvt_pk_fp8_f32(__builtin_amdgcn_fmed3f(v, -448.f, 448.f), 0.f, 0u, false) & 0xffu); } }
}

__device__ __forceinline__ void ph_proj(Frame& F) {
    unsigned char* ws = F.ws;
    pg8::Gemm g{(const pg8::bf16_t*)(ws + WS_XN0), (const pg8::bf16_t*)(ws + WS_WIN), NTOK, NPROJ, D}; pg8::StaticOrder S; S.init(NTOK, NPROJ, F.G, (int)blockIdx.x);
    pg8::EpiProj E{ws, F.in[IN_LBL]};
    pg8::gemm_phase<pg8::EpiProj, pg8::StaticOrder, true, true>(F.lds + RING_OFF, g, S, E);
    meta_proj(F);
}
__device__ __forceinline__ void ph_scan(Frame& F) {
    const int sb = (int)blockIdx.x;
    if (sb < 64) p3_hgrn2_mfma(F, sb); else if (sb < 128) p3_mlstm_mfma(F, sb - 64);
#if !CONV_IN_P0
    else px_experts(F, sb - 128, F.G - 128);
#endif
}
__device__ __forceinline__ void ph_merged(Frame& F) {
    unsigned char* ws = F.ws;
    static_assert(WS_YML - WS_YHG == (size_t)pg8::PAIR_DA * 256 * HW * 2 && WS_WBM - WS_WBH == (size_t)pg8::PAIR_DB * 256 * HW * 2, "the second branch's operands sit a whole number of tiles behind the first's");
    pg8::PairOrder S; S.S.init(NTOK, D, F.G, (int)blockIdx.x);
    pg8::Gemm g{(const pg8::bf16_t*)(ws + WS_YHG), (const pg8::bf16_t*)(ws + WS_WBH), NTOK, D, HW};
    pg8::EpiGate2 E{(const unsigned char*)(ws + WS_GATES), (pg8::bf16_t*)(ws + WS_TMP), (pg8::bf16_t*)(ws + WS_MERGED)};
    pg8::gemm_phase<pg8::EpiGate2, pg8::PairOrder, true, true>(F.lds + RING_OFF, g, S, E);
    meta_merged(F);
}
__device__ __forceinline__ void ph_wout(Frame& F) {
    unsigned char* ws = F.ws;
    pg8::Gemm g{(const pg8::bf16_t*)(ws + WS_MERGED), (const pg8::bf16_t*)(ws + WS_WOUT), NTOK, D, D}; pg8::StaticOrder S; S.init(NTOK, D, F.G, (int)blockIdx.x);
    pg8::EpiH1 E{(const pg8::bf16_t*)(ws + WS_XN0), (const float*)(ws + WS_XSQ), (pg8::bf16_t*)(ws + WS_H1), (unsigned char*)(ws + WS_H1B)};
    pg8::gemm_phase<pg8::EpiH1, pg8::StaticOrder, true, true>(F.lds + RING_OFF, g, S, E);
    meta_wout(F);
}
__device__ __forceinline__ void ph_gu(Frame& F) {
    unsigned char* ws = F.ws; build_tables(F);
    const LAS int* pst = (const LAS int*)(F.lds + PST_OFF); LAS unsigned short* tok16 = (LAS unsigned short*)(F.lds + TOK_OFF);
    pg8::Gemm g{(const pg8::bf16_t*)(ws + WS_H1B), (const pg8::bf16_t*)(ws + WS_WGU), NV, NE * 2 * DFF, D / 2};
    pg8::GroupOrder S{pst[32], 8, F.G, (int)blockIdx.x, (const LAS unsigned char*)(F.lds + TEXP_OFF)};
    { const int* ETOK = (const int*)(ws + WS_ETOK);
      int tokv[18];
#pragma unroll
      for (int i = 0; i < 18; ++i) { pg8::Unit u; int t = 0; if (S.next(i, u) && F.tid < 256) { const int e = u.pn >> 3, pos = u.pm * 256 - pst[e] + F.tid; if (pos < pst[33 + e]) t = ETOK[(size_t)e * NV + pos]; } tokv[i] = t; }
      if (F.tid < 256) {
#pragma unroll
          for (int i = 0; i < 18; ++i) tok16[i * 256 + F.tid] = (unsigned short)tokv[i]; }
      __syncthreads(); }
    pg8::EpiGU E{(const float*)(ws + WS_BGUP), (const float*)(ws + WS_ERS), (unsigned char*)(ws + WS_ACT), pst};
    pg8::gemm_phase_g<pg8::EpiGU, pg8::GroupOrder, true>(F.lds + RING_OFF, g, S, E, tok16);
}
__device__ __forceinline__ void ph_down(Frame& F) {
    unsigned char* ws = F.ws; build_tables(F);
    pg8::Gemm g{(const pg8::bf16_t*)(ws + WS_ACT), (const pg8::bf16_t*)(ws + WS_WDN), MAXTILES * 256, NE * D, DFF / 2};
    pg8::GroupOrder S{((const LAS int*)(F.lds + PST_OFF))[32], 4, F.G, (int)blockIdx.x, (const LAS unsigned char*)(F.lds + TEXP_OFF)};
    pg8::EpiDown E{F.in[IN_BDN], (const float*)(ws + WS_EW), (unsigned char*)(ws + WS_YB), (const LAS int*)(F.lds + PST_OFF)};
    pg8::gemm_phase<pg8::EpiDown, pg8::GroupOrder, true, true, true>(F.lds + RING_OFF, g, S, E);
}

#ifndef CONV_IN_P0
#define CONV_IN_P0 0
#endif
#ifndef PROBE_DOUBLE
#define PROBE_DOUBLE 0
#endif
#define DBL(k) ((PROBE_DOUBLE >> (k)) & 1)
#ifndef MK_N_LAUNCHES
#define MK_N_LAUNCHES 1
#endif
constexpr int NPHASE = 9;
struct Args { const float* in[25]; float* out; unsigned char* ws; int ph_lo, ph_hi, li, pad; };
__global__ void __launch_bounds__(NTHREADS, 2) fwd_kernel(Args args) {
    extern __shared__ __attribute__((aligned(16))) unsigned char lds[];
    Frame F;
    F.lds = (LAS unsigned char*)lds; F.MISC = (volatile LAS unsigned*)(F.lds + MISC_OFF);
    F.tid = threadIdx.x; F.lane = F.tid & 63; F.wave = __builtin_amdgcn_readfirstlane(F.tid >> 6);
    F.G = gridDim.x; { const int bx = blockIdx.x; F.vcu = (F.G % 8 == 0) ? (bx % 8) * (F.G / 8) + bx / 8 : bx; }
    F.ws = args.ws; F.ctl = (gu32*)(args.ws + WS_CTL); F.out = args.out;
#pragma unroll
    for (int i = 0; i < 25; ++i) F.in[i] = args.in[i];
    { int t0 = F.tid; asm volatile("" : "+v"(t0)); if (t0 < 64) F.MISC[t0] = 0u; }
    __syncthreads();
    const int lo = args.ph_lo, hi = args.ph_hi;
    XcdBarrier bar; bar.bar = (unsigned*)(F.ctl + CW_BAR) + args.li * XCD_BAR_WORDS; bar.x = 0; bar.st = nullptr;
    if (hi - lo > 1) bar = xcd_barrier_post((unsigned*)(F.ctl + CW_BAR) + args.li * XCD_BAR_WORDS, F.MISC + 8);
#define IN(k) (lo <= (k) && (k) < hi)
#define SEAM(k) do { if (IN(k) && IN((k) + 1)) xcd_barrier(bar); } while (0)

    if (IN(0)) { p0_prologue(F);
#if CONV_IN_P0
        __syncthreads(); px_experts(F, F.vcu, F.G);
#endif
    } SEAM(0);
    if (IN(1)) { ph_proj(F); } SEAM(1);
    if (IN(2)) { ph_scan(F); } SEAM(2);
    if (IN(3)) { ph_merged(F); } SEAM(3);
    if (IN(4)) { ph_wout(F); } SEAM(4);
    if (IN(5)) { p6_router(F); } SEAM(5);
    if (IN(6)) { ph_gu(F); } SEAM(6);
    if (IN(7)) { ph_down(F); } SEAM(7);
    if (IN(8)) { p10_combine(F); }
#undef IN
#undef SEAM
}

extern "C" void kernel_launch(void* const* d_in, const int* in_sizes, int n_in, void* d_out, int out_size, void* d_ws, size_t ws_size, hipStream_t stream) {
    static int grid = 0;
    if (grid == 0) {
        if (n_in != 25 || in_sizes[0] != BATCH * SEQ * D || out_size != BATCH * SEQ * D || ws_size < WS_END) { fprintf(stderr, "kernel_launch: unexpected shapes (n_in %d, in0 %d, out %d, ws %zu); nothing launched\n", n_in, n_in > 0 ? in_sizes[0] : -1, out_size, ws_size); grid = -1; return; }
        int dev = 0, cus = 0, per_cu = 0;
        if (hipGetDevice(&dev) != hipSuccess || hipDeviceGetAttribute(&cus, hipDeviceAttributeMultiprocessorCount, dev) != hipSuccess) { grid = -1; return; }
        if (hipFuncSetAttribute((const void*)fwd_kernel, hipFuncAttributeMaxDynamicSharedMemorySize, LDS_BYTES) != hipSuccess) { fprintf(stderr, "kernel_launch: hipFuncSetAttribute failed\n"); grid = -1; return; }
        if (hipOccupancyMaxActiveBlocksPerMultiprocessor(&per_cu, (const void*)fwd_kernel, NTHREADS, LDS_BYTES) != hipSuccess || per_cu < 1) { fprintf(stderr, "kernel_launch: occupancy query reports %d blocks per CU\n", per_cu); }
        (void)hipGetLastError();
        grid = 256;
        if (cus < 256) { fprintf(stderr, "kernel_launch: %d CUs < 256: the grid would not be resident; nothing launched\n", cus); grid = -1; return; }
    }
    if (grid < 0) return;
    if (hipMemsetAsync((char*)d_ws + WS_CTL, 0, CTL_ZERO_BYTES, stream) != hipSuccess) return;
    Args a{};
    for (int i = 0; i < 25; ++i) a.in[i] = (const float*)d_in[i];
    a.out = (float*)d_out; a.ws = (unsigned char*)d_ws; a.pad = 0;
#if MK_N_LAUNCHES == 1
    a.ph_lo = 0; a.ph_hi = NPHASE; a.li = 0;
    hipLaunchKernelGGL(fwd_kernel, dim3(grid), dim3(NTHREADS), LDS_BYTES, stream, a);
#else
    for (int p = 0; p < NPHASE; ++p) for (int rep = 0; rep <= DBL(p); ++rep) { a.ph_lo = p; a.ph_hi = p + 1; a.li = 0; hipLaunchKernelGGL(fwd_kernel, dim3(grid), dim3(NTHREADS), LDS_BYTES, stream, a); }
#endif
}
```

```cpp
#include <hip/hip_runtime.h>
#include <cstdio>
#include <cstdint>
namespace pg8 {
#define PG8_LAS __attribute__((address_space(3)))
typedef unsigned short bf16_t;
typedef short bf16x8 __attribute__((ext_vector_type(8)));
typedef float f32x4 __attribute__((ext_vector_type(4)));
typedef unsigned u32x4 __attribute__((ext_vector_type(4)));
constexpr int BM = 256, BK = 64, HALF = 128, HTB = HALF * BK * 2  , STAGE_BYTES = 8 * HTB, NXCD = 8, WGM = 8;

__host__ __device__ __forceinline__ int lds_byte(int r, int c) { const int st = (r >> 4) * 2 + (c >> 5), rr = r & 15, cc = c & 31, ob = rr * 64 + cc * 2; return st * 1024 + (ob ^ (((ob >> 9) & 1) << 5)); }
__host__ __device__ __forceinline__ void stage_rc(int b, int& R, int& C) { const int st = b / 1024, sb = b % 1024, swz = sb ^ (((sb >> 9) & 1) << 5); R = (st >> 1) * 16 + swz / 64; C = (st & 1) * 32 + (swz % 64) / 2; }
__host__ __device__ __forceinline__ int perm32(int rho) { const int n = rho >> 4, i = rho & 15; return 8 * (i >> 2) + 4 * n + (i & 3); }

struct Unit { int pm, pn; };
struct Gemm { const bf16_t* A; const bf16_t* Bt; int M, N, K; };

struct StaticOrder {
    int nM, nN, nwg, G, c;
    __host__ __device__ void init(int M, int N, int G_, int c_) { nM = M / BM; nN = N / BM; nwg = nM * nN; G = G_; c = c_; }
    __host__ __device__ __forceinline__ bool next(int i, Unit& u) const {
        const long L = (long)i * G + c; if (L >= nwg) return false;
        int wgid = (int)L; { const int q = nwg / NXCD, r = nwg % NXCD, xcd = wgid % NXCD, off = wgid / NXCD; wgid = (xcd < r ? xcd * (q + 1) : r * (q + 1) + (xcd - r) * q) + off; }
        const int nig = WGM * nN, gid = wgid / nig, fm = gid * WGM, gsz = (nM - fm) < WGM ? (nM - fm) : WGM;
        u.pm = fm + ((wgid % nig) % gsz); u.pn = (wgid % nig) / gsz; return true;
    }
    __device__ __forceinline__ void a_ready(const Unit&) const {}
    __device__ __forceinline__ void done(const Unit&) const {}
};

typedef __bf16 bf16v2 __attribute__((ext_vector_type(2)));
typedef float f32v2 __attribute__((ext_vector_type(2)));
__device__ __forceinline__ unsigned cvt_pk_bf16(float lo, float hi) { const f32v2 v = {lo, hi}; return __builtin_bit_cast(unsigned, __builtin_convertvector(v, bf16v2)); }
typedef float f32x2 __attribute__((ext_vector_type(2)));
typedef int i32x4 __attribute__((ext_vector_type(4)));
typedef int i32x8 __attribute__((ext_vector_type(8)));
__device__ __forceinline__ i32x8 cat8(const bf16x8 a, const bf16x8 b) { const i32x4 x = __builtin_bit_cast(i32x4, a), y = __builtin_bit_cast(i32x4, b); return __builtin_shufflevector(x, y, 0, 1, 2, 3, 4, 5, 6, 7); }
template <class Epi, class Sched, bool ALIGN_EPI = false, bool SP2 = false, bool FP8 = false>
__device__ __forceinline__ void gemm_phase(PG8_LAS unsigned char* lds, const Gemm g, const Sched& S, const Epi& E) {
    const int tid = threadIdx.x, wid = __builtin_amdgcn_readfirstlane(tid >> 6), lane = tid & 63, wr = wid >> 2, wc = wid & 3, fr = lane & 15, fq = lane >> 4;
    const int K = g.K, nt = K / BK;
    unsigned voffA[2], voffB[2];
#pragma unroll
    for (int i = 0; i < 2; ++i) { int R, C; stage_rc(tid * 16 + i * 8192, R, C); const int Rb = Epi::PERM ? ((R & ~31) + perm32(R & 31)) : R;
        voffA[i] = (unsigned)(R * K + C) * 2u; voffB[i] = (unsigned)(Rb * K + C) * 2u; }
    const size_t kstep = (size_t)(BK * 2);
    const size_t hstep = (size_t)HALF * K * 2;
    const size_t tstep = 2 * hstep;
    const unsigned ldsw = (unsigned)wid * 1024u;
    const int aoff = lds_byte(wr * 64 + fr, fq * 8), boff = lds_byte(wc * 32 + fr, fq * 8);
#define PG8_SA(b, h) (((b) * 2 + (h)) * HTB)
#define PG8_SB(b, h) ((4 + (b) * 2 + (h)) * HTB)
#define PG8_STAGE(bufoff, gbase, voff) do { _Pragma("unroll") for (int _i = 0; _i < 2; ++_i) \
        __builtin_amdgcn_global_load_lds((const unsigned*)((const char*)(gbase) + (voff)[_i]), (PG8_LAS unsigned*)(lds + (bufoff) + ldsw + _i * 8192), 16, 0, 0); } while (0)
#define PG8_LDA(dst, b, h) do { _Pragma("unroll") for (int m = 0; m < 4; ++m) { if constexpr (FP8) dst##8[m] = cat8(*(const PG8_LAS bf16x8*)(lds + PG8_SA(b, h) + aoff + m * 2048), *(const PG8_LAS bf16x8*)(lds + PG8_SA(b, h) + aoff + m * 2048 + 1024)); \
        else { _Pragma("unroll") for (int k = 0; k < 2; ++k) dst[m][k] = *(const PG8_LAS bf16x8*)(lds + PG8_SA(b, h) + aoff + m * 2048 + k * 1024); } } } while (0)
#define PG8_LDB(dst, b, h) do { _Pragma("unroll") for (int n = 0; n < 2; ++n) { if constexpr (FP8) dst##8[n] = cat8(*(const PG8_LAS bf16x8*)(lds + PG8_SB(b, h) + boff + n * 2048), *(const PG8_LAS bf16x8*)(lds + PG8_SB(b, h) + boff + n * 2048 + 1024)); \
        else { _Pragma("unroll") for (int k = 0; k < 2; ++k) dst[n][k] = *(const PG8_LAS bf16x8*)(lds + PG8_SB(b, h) + boff + n * 2048 + k * 1024); } } } while (0)
#define PG8_MMA(ai, bj, At, Bt) do { __builtin_amdgcn_s_setprio(1); _Pragma("unroll") for (int m = 0; m < 4; ++m) _Pragma("unroll") for (int n = 0; n < 2; ++n) { \
        if constexpr (FP8) acc[ai][bj][m][n] = __builtin_amdgcn_mfma_scale_f32_16x16x128_f8f6f4(Bt##8[n], At##8[m], acc[ai][bj][m][n], 0, 0, 0, 0x7f7f7f7f, 0, 0x7f7f7f7f); \
        else { _Pragma("unroll") for (int k = 0; k < 2; ++k) acc[ai][bj][m][n] = __builtin_amdgcn_mfma_f32_16x16x32_bf16(Bt[n][k], At[m][k], acc[ai][bj][m][n], 0, 0, 0); } } \
        if constexpr (FP8) { _Pragma("unroll") for (int m = 0; m < 4; ++m) _Pragma("unroll") for (int n = 0; n < 2; ++n) asm volatile("" : "+v"(acc[ai][bj][m][n])); }     \
        __builtin_amdgcn_s_setprio(0); } while (0)
#define PG8_WAIT_V(n) asm volatile("s_waitcnt vmcnt(" #n ")" ::: "memory")
#define PG8_WAIT_L(n) asm volatile("s_waitcnt lgkmcnt(" #n ")" ::: "memory")
#define PG8_BAR __builtin_amdgcn_s_barrier()
#define PG8_SCHED __builtin_amdgcn_sched_barrier(0)
    Unit cur, nxt; int ui = 0;
    if (!S.next(0, cur)) return;
    f32x4 acc[2][2][4][2];
#pragma unroll
    for (int a = 0; a < 2; ++a)
#pragma unroll
        for (int b = 0; b < 2; ++b)
#pragma unroll
            for (int m = 0; m < 4; ++m)
#pragma unroll
                for (int n = 0; n < 2; ++n) acc[a][b][m][n] = (f32x4){0.f, 0.f, 0.f, 0.f};
    bf16x8 At[4][2], B0[2][2], B1[2][2]; i32x8 At8[4], B08[2], B18[2];
    const char* cA = (const char*)g.A + (size_t)cur.pm * tstep; const char* cB = (const char*)g.Bt + (size_t)cur.pn * tstep;
    S.a_ready(cur);
    if constexpr (SP2) {
        PG8_STAGE(PG8_SB(0, 0), cB, voffB); PG8_STAGE(PG8_SB(0, 1), cB + hstep, voffB); PG8_STAGE(PG8_SA(0, 0), cA, voffA); PG8_STAGE(PG8_SA(0, 1), cA + hstep, voffA);
        if (wr == 1) PG8_BAR;
        PG8_WAIT_V(2); PG8_BAR;
        PG8_STAGE(PG8_SB(1, 0), cB + kstep, voffB); PG8_STAGE(PG8_SA(1, 0), cA + kstep, voffA); PG8_STAGE(PG8_SB(1, 1), cB + hstep + kstep, voffB);
        PG8_WAIT_V(6); PG8_BAR;
    } else {
        PG8_STAGE(PG8_SB(0, 0), cB, voffB); PG8_STAGE(PG8_SA(0, 0), cA, voffA); PG8_STAGE(PG8_SB(0, 1), cB + hstep, voffB); PG8_STAGE(PG8_SA(0, 1), cA + hstep, voffA);
        if (wr == 1) PG8_BAR;
        PG8_WAIT_V(4); PG8_BAR;
        PG8_STAGE(PG8_SB(1, 0), cB + kstep, voffB); PG8_STAGE(PG8_SA(1, 0), cA + kstep, voffA); PG8_STAGE(PG8_SB(1, 1), cB + hstep + kstep, voffB);
        PG8_WAIT_V(6); PG8_BAR;
    }
    for (;;) {
        const bool has_next = S.next(ui + 1, nxt);
        const char* nA = has_next ? (const char*)g.A + (size_t)nxt.pm * tstep : cA; const char* nB = has_next ? (const char*)g.Bt + (size_t)nxt.pn * tstep : cB;
        for (int t = 0; t < nt; t += 2) {
            const bool last = (t == nt - 2);
            const char* a1 = cA + (size_t)(t + 1) * kstep;
            const char* a2 = last ? nA : cA + (size_t)(t + 2) * kstep; const char* b2 = last ? nB : cB + (size_t)(t + 2) * kstep;
            const char* a3 = a2 + kstep; const char* b3 = b2 + kstep;
            if (last && has_next) S.a_ready(nxt);
            if constexpr (SP2) {
            PG8_LDB(B0, 0, 0); PG8_LDB(B1, 0, 1); PG8_SCHED; PG8_LDA(At, 0, 0); PG8_STAGE(PG8_SA(1, 1), a1 + hstep, voffA);
            PG8_WAIT_V(8); PG8_WAIT_L(0); PG8_BAR; PG8_MMA(0, 0, At, B0); PG8_MMA(0, 1, At, B1); PG8_BAR; PG8_SCHED;
            PG8_LDA(At, 0, 1); PG8_STAGE(PG8_SB(0, 0), b2, voffB); PG8_STAGE(PG8_SB(0, 1), b2 + hstep, voffB); PG8_STAGE(PG8_SA(0, 0), a2, voffA);
            PG8_WAIT_V(8); PG8_WAIT_L(0); PG8_BAR; PG8_MMA(1, 0, At, B0); PG8_MMA(1, 1, At, B1); PG8_BAR; PG8_SCHED;
            PG8_LDB(B0, 1, 0); PG8_LDB(B1, 1, 1); PG8_SCHED; PG8_LDA(At, 1, 0); PG8_STAGE(PG8_SA(0, 1), a2 + hstep, voffA);
            PG8_WAIT_V(8); PG8_WAIT_L(0); PG8_BAR; PG8_MMA(0, 0, At, B0); PG8_MMA(0, 1, At, B1); PG8_BAR; PG8_SCHED;
            PG8_LDA(At, 1, 1); PG8_STAGE(PG8_SB(1, 0), b3, voffB); PG8_STAGE(PG8_SB(1, 1), b3 + hstep, voffB); PG8_STAGE(PG8_SA(1, 0), a3, voffA);
            PG8_WAIT_V(8); PG8_WAIT_L(0); PG8_BAR; PG8_MMA(1, 0, At, B0); PG8_MMA(1, 1, At, B1); PG8_BAR; PG8_SCHED;
            } else {
            PG8_LDB(B0, 0, 0); PG8_SCHED; PG8_LDA(At, 0, 0); PG8_STAGE(PG8_SA(1, 1), a1 + hstep, voffA);
            PG8_WAIT_L(8); PG8_BAR; PG8_WAIT_L(0); PG8_MMA(0, 0, At, B0); PG8_BAR; PG8_SCHED;
            PG8_LDB(B1, 0, 1); PG8_STAGE(PG8_SB(0, 0), b2, voffB);
            PG8_BAR; PG8_WAIT_L(0); PG8_MMA(0, 1, At, B1); PG8_BAR;
            PG8_LDA(At, 0, 1); PG8_STAGE(PG8_SA(0, 0), a2, voffA);
            PG8_BAR; PG8_WAIT_L(0); PG8_MMA(1, 0, At, B0); PG8_BAR; PG8_SCHED;
            PG8_STAGE(PG8_SB(0, 1), b2 + hstep, voffB);
            PG8_WAIT_V(6); PG8_BAR; PG8_MMA(1, 1, At, B1); PG8_BAR;
            PG8_LDB(B0, 1, 0); PG8_SCHED; PG8_LDA(At, 1, 0); PG8_STAGE(PG8_SA(0, 1), a2 + hstep, voffA);
            PG8_WAIT_L(8); PG8_BAR; PG8_WAIT_L(0); PG8_MMA(0, 0, At, B0); PG8_BAR; PG8_SCHED;
            PG8_LDB(B1, 1, 1); PG8_STAGE(PG8_SB(1, 0), b3, voffB);
            PG8_BAR; PG8_WAIT_L(0); PG8_MMA(0, 1, At, B1); PG8_BAR;
            PG8_LDA(At, 1, 1); PG8_STAGE(PG8_SA(1, 0), a3, voffA);
            PG8_BAR; PG8_WAIT_L(0); PG8_MMA(1, 0, At, B0); PG8_BAR; PG8_SCHED;
            PG8_STAGE(PG8_SB(1, 1), b3 + hstep, voffB);
            PG8_WAIT_V(6); PG8_BAR; PG8_MMA(1, 1, At, B1); PG8_BAR;
            }
        }
        if constexpr (ALIGN_EPI) { if (wr == 0) PG8_BAR; }
        if constexpr (!Epi::AFTER_DRAIN) { E(acc, cur, wr, wc, fr, fq); S.done(cur); }
        if (!has_next) break;
#pragma unroll
        for (int a = 0; a < 2; ++a)
#pragma unroll
            for (int b = 0; b < 2; ++b)
#pragma unroll
                for (int m = 0; m < 4; ++m)
#pragma unroll
                    for (int n = 0; n < 2; ++n) acc[a][b][m][n] = (f32x4){0.f, 0.f, 0.f, 0.f};
        cur = nxt; cA = nA; cB = nB; ++ui;
        if constexpr (ALIGN_EPI) { if (wr == 1) PG8_BAR; }
    }
    PG8_WAIT_V(0);
    if constexpr (!ALIGN_EPI) { if (wr == 0) PG8_BAR; }
    PG8_BAR;
    if constexpr (Epi::AFTER_DRAIN) { E.fused(acc, cur, wr, wc, fr, fq, lds, wid, lane); S.done(cur); }
#undef PG8_SA
#undef PG8_SB
#undef PG8_STAGE
#undef PG8_LDA
#undef PG8_LDB
#undef PG8_MMA
#undef PG8_WAIT_V
#undef PG8_WAIT_L
#undef PG8_BAR
#undef PG8_SCHED
}
template <class Epi, class Sched, bool FP8 = false>
__device__ __forceinline__ void gemm_phase_g(PG8_LAS unsigned char* lds, const Gemm g, const Sched& S, const Epi& E, const PG8_LAS unsigned short* tok16) {
    constexpr bool ALIGN_EPI = true, SP2 = true;
    const int tid = threadIdx.x, wid = __builtin_amdgcn_readfirstlane(tid >> 6), lane = tid & 63, wr = wid >> 2, wc = wid & 3, fr = lane & 15, fq = lane >> 4;
    const int K = g.K, nt = K / BK;
    unsigned voffB[2]; int RA[2]; unsigned CA[2];
#pragma unroll
    for (int i = 0; i < 2; ++i) { int R, C; stage_rc(tid * 16 + i * 8192, R, C); const int Rb = Epi::PERM ? ((R & ~31) + perm32(R & 31)) : R;
        RA[i] = R; CA[i] = (unsigned)C * 2u; voffB[i] = (unsigned)(Rb * K + C) * 2u; }
    unsigned oc[2][2];
#define PG8_TOKS(dst, ui_) do { _Pragma("unroll") for (int _h = 0; _h < 2; ++_h) _Pragma("unroll") for (int _i = 0; _i < 2; ++_i) \
        dst[_h][_i] = (unsigned)tok16[(ui_) * 256 + _h * HALF + RA[_i]] * (unsigned)(K * 2) + CA[_i]; } while (0)
    const size_t kstep = (size_t)(BK * 2);
    const size_t hstep = (size_t)HALF * K * 2;
    const size_t tstep = 2 * hstep;
    const unsigned ldsw = (unsigned)wid * 1024u;
    const int aoff = lds_byte(wr * 64 + fr, fq * 8), boff = lds_byte(wc * 32 + fr, fq * 8);
#define PG8_SA(b, h) (((b) * 2 + (h)) * HTB)
#define PG8_SB(b, h) ((4 + (b) * 2 + (h)) * HTB)
#define PG8_STAGE(bufoff, gbase, voff) do { _Pragma("unroll") for (int _i = 0; _i < 2; ++_i) \
        __builtin_amdgcn_global_load_lds((const unsigned*)((const char*)(gbase) + (voff)[_i]), (PG8_LAS unsigned*)(lds + (bufoff) + ldsw + _i * 8192), 16, 0, 0); } while (0)
#define PG8_LDA(dst, b, h) do { _Pragma("unroll") for (int m = 0; m < 4; ++m) { if constexpr (FP8) dst##8[m] = cat8(*(const PG8_LAS bf16x8*)(lds + PG8_SA(b, h) + aoff + m * 2048), *(const PG8_LAS bf16x8*)(lds + PG8_SA(b, h) + aoff + m * 2048 + 1024)); \
        else { _Pragma("unroll") for (int k = 0; k < 2; ++k) dst[m][k] = *(const PG8_LAS bf16x8*)(lds + PG8_SA(b, h) + aoff + m * 2048 + k * 1024); } } } while (0)
#define PG8_LDB(dst, b, h) do { _Pragma("unroll") for (int n = 0; n < 2; ++n) { if constexpr (FP8) dst##8[n] = cat8(*(const PG8_LAS bf16x8*)(lds + PG8_SB(b, h) + boff + n * 2048), *(const PG8_LAS bf16x8*)(lds + PG8_SB(b, h) + boff + n * 2048 + 1024)); \
        else { _Pragma("unroll") for (int k = 0; k < 2; ++k) dst[n][k] = *(const PG8_LAS bf16x8*)(lds + PG8_SB(b, h) + boff + n * 2048 + k * 1024); } } } while (0)
#define PG8_MMA(ai, bj, At, Bt) do { __builtin_amdgcn_s_setprio(1); _Pragma("unroll") for (int m = 0; m < 4; ++m) _Pragma("unroll") for (int n = 0; n < 2; ++n) { \
        if constexpr (FP8) acc[ai][bj][m][n] = __builtin_amdgcn_mfma_scale_f32_16x16x128_f8f6f4(Bt##8[n], At##8[m], acc[ai][bj][m][n], 0, 0, 0, 0x7f7f7f7f, 0, 0x7f7f7f7f); \
        else { _Pragma("unroll") for (int k = 0; k < 2; ++k) acc[ai][bj][m][n] = __builtin_amdgcn_mfma_f32_16x16x32_bf16(Bt[n][k], At[m][k], acc[ai][bj][m][n], 0, 0, 0); } } \
        if constexpr (FP8) { _Pragma("unroll") for (int m = 0; m < 4; ++m) _Pragma("unroll") for (int n = 0; n < 2; ++n) asm volatile("" : "+v"(acc[ai][bj][m][n])); }     \
        __builtin_amdgcn_s_setprio(0); } while (0)
#define PG8_WAIT_V(n) asm volatile("s_waitcnt vmcnt(" #n ")" ::: "memory")
#define PG8_WAIT_L(n) asm volatile("s_waitcnt lgkmcnt(" #n ")" ::: "memory")
#define PG8_BAR __builtin_amdgcn_s_barrier()
#define PG8_SCHED __builtin_amdgcn_sched_barrier(0)
    Unit cur, nxt; int ui = 0;
    if (!S.next(0, cur)) return;
    f32x4 acc[2][2][4][2];
#pragma unroll
    for (int a = 0; a < 2; ++a)
#pragma unroll
        for (int b = 0; b < 2; ++b)
#pragma unroll
            for (int m = 0; m < 4; ++m)
#pragma unroll
                for (int n = 0; n < 2; ++n) acc[a][b][m][n] = (f32x4){0.f, 0.f, 0.f, 0.f};
    bf16x8 At[4][2], B0[2][2], B1[2][2]; i32x8 At8[4], B08[2], B18[2];
    const char* cA = (const char*)g.A; const char* cB = (const char*)g.Bt + (size_t)cur.pn * tstep; PG8_TOKS(oc, 0);
    S.a_ready(cur);
    if constexpr (SP2) {
        PG8_STAGE(PG8_SB(0, 0), cB, voffB); PG8_STAGE(PG8_SB(0, 1), cB + hstep, voffB); PG8_STAGE(PG8_SA(0, 0), cA, oc[0]); PG8_STAGE(PG8_SA(0, 1), cA, oc[1]);
        if (wr == 1) PG8_BAR;
        PG8_WAIT_V(2); PG8_BAR;
        PG8_STAGE(PG8_SB(1, 0), cB + kstep, voffB); PG8_STAGE(PG8_SA(1, 0), cA + kstep, oc[0]); PG8_STAGE(PG8_SB(1, 1), cB + hstep + kstep, voffB);
        PG8_WAIT_V(6); PG8_BAR;
    } else {
        PG8_STAGE(PG8_SB(0, 0), cB, voffB); PG8_STAGE(PG8_SA(0, 0), cA, oc[0]); PG8_STAGE(PG8_SB(0, 1), cB + hstep, voffB); PG8_STAGE(PG8_SA(0, 1), cA + hstep, oc[0]);
        if (wr == 1) PG8_BAR;
        PG8_WAIT_V(4); PG8_BAR;
        PG8_STAGE(PG8_SB(1, 0), cB + kstep, voffB); PG8_STAGE(PG8_SA(1, 0), cA + kstep, oc[0]); PG8_STAGE(PG8_SB(1, 1), cB + hstep + kstep, voffB);
        PG8_WAIT_V(6); PG8_BAR;
    }
    for (;;) {
        const bool has_next = S.next(ui + 1, nxt);
        const char* nB = has_next ? (const char*)g.Bt + (size_t)nxt.pn * tstep : cB;
        for (int t = 0; t < nt; t += 2) {
            const bool last = (t == nt - 2);
            const char* a1 = cA + (size_t)(t + 1) * kstep;
            const char* a2 = last ? cA : cA + (size_t)(t + 2) * kstep; const char* b2 = last ? nB : cB + (size_t)(t + 2) * kstep;
            unsigned o2[2][2]; if (last && has_next) PG8_TOKS(o2, ui + 1); else { _Pragma("unroll") for (int _h = 0; _h < 2; ++_h) _Pragma("unroll") for (int _i = 0; _i < 2; ++_i) o2[_h][_i] = oc[_h][_i]; }
            const char* a3 = a2 + kstep; const char* b3 = b2 + kstep;
            if (last && has_next) S.a_ready(nxt);
            if constexpr (SP2) {
            PG8_LDB(B0, 0, 0); PG8_LDB(B1, 0, 1); PG8_SCHED; PG8_LDA(At, 0, 0); PG8_STAGE(PG8_SA(1, 1), a1, oc[1]);
            PG8_WAIT_V(8); PG8_WAIT_L(0); PG8_BAR; PG8_MMA(0, 0, At, B0); PG8_MMA(0, 1, At, B1); PG8_BAR; PG8_SCHED;
            PG8_LDA(At, 0, 1); PG8_STAGE(PG8_SB(0, 0), b2, voffB); PG8_STAGE(PG8_SB(0, 1), b2 + hstep, voffB); PG8_STAGE(PG8_SA(0, 0), a2, o2[0]);
            PG8_WAIT_V(8); PG8_WAIT_L(0); PG8_BAR; PG8_MMA(1, 0, At, B0); PG8_MMA(1, 1, At, B1); PG8_BAR; PG8_SCHED;
            PG8_LDB(B0, 1, 0); PG8_LDB(B1, 1, 1); PG8_SCHED; PG8_LDA(At, 1, 0); PG8_STAGE(PG8_SA(0, 1), a2, o2[1]);
            PG8_WAIT_V(8); PG8_WAIT_L(0); PG8_BAR; PG8_MMA(0, 0, At, B0); PG8_MMA(0, 1, At, B1); PG8_BAR; PG8_SCHED;
            PG8_LDA(At, 1, 1); PG8_STAGE(PG8_SB(1, 0), b3, voffB); PG8_STAGE(PG8_SB(1, 1), b3 + hstep, voffB); PG8_STAGE(PG8_SA(1, 0), a3, o2[0]);
            PG8_WAIT_V(8); PG8_WAIT_L(0); PG8_BAR; PG8_MMA(1, 0, At, B0); PG8_MMA(1, 1, At, B1); PG8_BAR; PG8_SCHED;
            } else {
            PG8_LDB(B0, 0, 0); PG8_SCHED; PG8_LDA(At, 0, 0); PG8_STAGE(PG8_SA(1, 1), a1 + hstep, oc[0]);
            PG8_WAIT_L(8); PG8_BAR; PG8_WAIT_L(0); PG8_MMA(0, 0, At, B0); PG8_BAR; PG8_SCHED;
            PG8_LDB(B1, 0, 1); PG8_STAGE(PG8_SB(0, 0), b2, voffB);
            PG8_BAR; PG8_WAIT_L(0); PG8_MMA(0, 1, At, B1); PG8_BAR;
            PG8_LDA(At, 0, 1); PG8_STAGE(PG8_SA(0, 0), a2, oc[0]);
            PG8_BAR; PG8_WAIT_L(0); PG8_MMA(1, 0, At, B0); PG8_BAR; PG8_SCHED;
            PG8_STAGE(PG8_SB(0, 1), b2 + hstep, voffB);
            PG8_WAIT_V(6); PG8_BAR; PG8_MMA(1, 1, At, B1); PG8_BAR;
            PG8_LDB(B0, 1, 0); PG8_SCHED; PG8_LDA(At, 1, 0); PG8_STAGE(PG8_SA(0, 1), a2 + hstep, oc[0]);
            PG8_WAIT_L(8); PG8_BAR; PG8_WAIT_L(0); PG8_MMA(0, 0, At, B0); PG8_BAR; PG8_SCHED;
            PG8_LDB(B1, 1, 1); PG8_STAGE(PG8_SB(1, 0), b3, voffB);
            PG8_BAR; PG8_WAIT_L(0); PG8_MMA(0, 1, At, B1); PG8_BAR;
            PG8_LDA(At, 1, 1); PG8_STAGE(PG8_SA(1, 0), a3, oc[0]);
            PG8_BAR; PG8_WAIT_L(0); PG8_MMA(1, 0, At, B0); PG8_BAR; PG8_SCHED;
            PG8_STAGE(PG8_SB(1, 1), b3 + hstep, voffB);
            PG8_WAIT_V(6); PG8_BAR; PG8_MMA(1, 1, At, B1); PG8_BAR;
            }
        }
        if constexpr (ALIGN_EPI) { if (wr == 0) PG8_BAR; }
        if constexpr (!Epi::AFTER_DRAIN) { E(acc, cur, wr, wc, fr, fq); S.done(cur); }
        if (!has_next) break;
#pragma unroll
        for (int a = 0; a < 2; ++a)
#pragma unroll
            for (int b = 0; b < 2; ++b)
#pragma unroll
                for (int m = 0; m < 4; ++m)
#pragma unroll
                    for (int n = 0; n < 2; ++n) acc[a][b][m][n] = (f32x4){0.f, 0.f, 0.f, 0.f};
        cur = nxt; cB = nB; ++ui; PG8_TOKS(oc, ui);
        if constexpr (ALIGN_EPI) { if (wr == 1) PG8_BAR; }
    }
    PG8_WAIT_V(0);
    if constexpr (!ALIGN_EPI) { if (wr == 0) PG8_BAR; }
    PG8_BAR;
    if constexpr (Epi::AFTER_DRAIN) { E.fused(acc, cur, wr, wc, fr, fq, lds, wid, lane); S.done(cur); }
#undef PG8_TOKS
#undef PG8_SA
#undef PG8_SB
#undef PG8_STAGE
#undef PG8_LDA
#undef PG8_LDB
#undef PG8_MMA
#undef PG8_WAIT_V
#undef PG8_WAIT_L
#undef PG8_BAR
#undef PG8_SCHED
}
}

constexpr int BATCH = 16, SEQ = 2048, D = 1024, NMETA = 16;
constexpr int TV = SEQ + NMETA;
constexpr int NV = BATCH * TV;
constexpr int NTOK = BATCH * SEQ;
constexpr int NR = NTOK + NMETA;
constexpr int NIN = 5128, NPROJ = 5120;
constexpr int HW = 512;
constexpr int NE = 32, TOPK = 4, DFF = 1024;
constexpr int MAXTILES = 548;
constexpr float EPS = 1e-6f;
constexpr int NWAVES = 8, NTHREADS = 512;

constexpr size_t MiB = 1u << 20, KiB = 1u << 10;
constexpr size_t WS_CTL = 0, CTL_ZERO_BYTES = 1 * MiB;
constexpr size_t WS_WIN = 2 * MiB;
constexpr size_t WS_WBH = 12 * MiB, WS_WBM = 13 * MiB, WS_WOUT = 14 * MiB;
constexpr size_t WS_WGU = 16 * MiB;
constexpr size_t WS_WDN = 144 * MiB;
constexpr size_t WS_BGUP = 208 * MiB;
constexpr size_t WS_RWT = WS_BGUP + 256 * KiB;
constexpr size_t WS_TOPE = WS_RWT + 128 * KiB;
constexpr size_t WS_TOPP = WS_TOPE + 520 * KiB;
constexpr size_t WS_TOPW = WS_TOPP + 520 * KiB;
constexpr size_t WS_RS = WS_TOPW + 520 * KiB;
constexpr size_t WS_LI = WS_RS + 136 * KiB;
constexpr size_t WS_LF = WS_LI + 520 * KiB;
constexpr size_t WS_SLOTRS = WS_LF + 520 * KiB;
constexpr size_t WS_SLOTW = WS_SLOTRS + 552 * KiB;
constexpr size_t WS_XSQ = WS_SLOTW + 552 * KiB;
constexpr size_t WS_SMALL_END = WS_XSQ + 136 * KiB;
constexpr size_t WS_RA = 214 * MiB;
constexpr size_t WS_HQ = WS_RA, WS_HG = WS_RA + 33 * MiB, WS_HV = WS_RA + 99 * MiB, WS_HGATE = WS_RA + 132 * MiB, WS_MM = WS_RA + 165 * MiB, WS_MO = WS_RA + 198 * MiB, WS_GATES = WS_RA + 231 * MiB;
constexpr size_t WS_MERGED = WS_RA, WS_TMP = WS_RA + 66 * MiB, WS_H1B = WS_RA + 364 * MiB, WS_ACT = WS_RA;
constexpr size_t WS_RB = WS_RA + 364 * MiB;
constexpr size_t WS_QKVM = WS_RB, WS_CM = WS_RB + 130 * MiB, WS_YHG = WS_RB + 196 * MiB, WS_YML = WS_RB + 229 * MiB, WS_XS = WS_RB, WS_YB = WS_RB;
constexpr size_t WS_RC = WS_RB + 274 * MiB;
constexpr size_t WS_XN0 = WS_RC + 65 * MiB;
constexpr size_t WS_H1 = WS_RC, WS_ETOK = WS_RC + 130 * MiB, WS_ERS = WS_ETOK + 5 * MiB, WS_EW = WS_ERS + 5 * MiB, WS_END = WS_EW + 5 * MiB;
static_assert(WS_SMALL_END <= WS_RA && WS_END <= 1024 * MiB, "d_ws map");
static_assert((size_t)NV * HW * 2 <= 33 * MiB && (size_t)NV * HW * 4 <= 66 * MiB && (size_t)NV * 2048 * 2 <= 132 * MiB + MiB && (size_t)NV * D * 4 <= 130 * MiB && (size_t)MAXTILES * 256 * D * 2 <= 274 * MiB, "d_ws sizes");
static_assert((size_t)NE * NV * 4 <= 5 * MiB, "per-expert lists");
static_assert((size_t)NR * D * 2 <= 65 * MiB && (size_t)NR * 4 <= 136 * KiB, "H1 / XN0 / XSQ");
constexpr int CW_TMO = 0, CW_CNT = 64  , CW_BAR = 4096;

constexpr int RING_OFF = 0, RING_BYTES = 131072;
constexpr int MISC_OFF = RING_BYTES;
constexpr int TEXP_OFF = MISC_OFF + 256;
constexpr int PST_OFF = TEXP_OFF + 640;
constexpr int TOK_OFF = PST_OFF + 384;
constexpr int LDS_BYTES = 147456;
static_assert(TOK_OFF + 18 * 512 <= LDS_BYTES, "LDS map");

#define GAS __attribute__((address_space(1)))
#define LAS __attribute__((address_space(3)))
typedef unsigned short bf16;
typedef unsigned v4u __attribute__((ext_vector_type(4)));
typedef unsigned v2u __attribute__((ext_vector_type(2)));
typedef float f32x4 __attribute__((ext_vector_type(4)));
typedef GAS unsigned gu32;
#define RLX_AGENT __ATOMIC_RELAXED, __HIP_MEMORY_SCOPE_AGENT
#define LDS_WAIT() asm volatile("s_waitcnt lgkmcnt(0)" ::: "memory")
#define VM_WAIT() asm volatile("s_waitcnt vmcnt(0)" ::: "memory")
__device__ __forceinline__ unsigned pk2(float lo, float hi) { return pg8::cvt_pk_bf16(lo, hi); }
__device__ __forceinline__ unsigned f2bf(float f) { return pg8::cvt_pk_bf16(f, 0.f) & 0xffffu; }
__device__ __forceinline__ float bflo(unsigned w) { return __builtin_bit_cast(float, w << 16); }
__device__ __forceinline__ float bfhi(unsigned w) { return __builtin_bit_cast(float, w & 0xffff0000u); }
__device__ __forceinline__ float bf1(bf16 h) { return __builtin_bit_cast(float, (unsigned)h << 16); }
__device__ __forceinline__ float fsigmoid(float x) { return __builtin_amdgcn_rcpf(1.0f + __expf(-x)); }
__device__ __forceinline__ float fsilu(float x) { return x * fsigmoid(x); }
__device__ __forceinline__ size_t rowof(int b, int tt) { return tt < NMETA ? (size_t)(NTOK + tt) : (size_t)b * SEQ + (tt - NMETA); }
__host__ __device__ __forceinline__ int gu_slot(int j) { const int g = (j >> 3) & 3, p = ((g & 1) << 1) | (g >> 1); return (j & ~31) + 8 * p + (j & 7); }
__device__ __forceinline__ float wave_sum(float v) {
#pragma unroll
    for (int o = 1; o < 64; o <<= 1) v += __shfl_xor(v, o);
    return v;
}
__device__ __forceinline__ float wave_max(float v) {
#pragma unroll
    for (int o = 1; o < 64; o <<= 1) v = fmaxf(v, __shfl_xor(v, o));
    return v;
}
#define XB_TMO      128
#define XB_XCNT(j)  (256  + 64 * (j))
#define XB_XSUB(j)  (1280 + 64 * (j))
#define XB_XGEN(j)  (2304 + 64 * (j))
#define XB_TOP      3328
#define XB_TOPGEN   3392
#define XCD_BAR_WORDS 3456
#define XB_SPIN_CAP (1u << 18)

__device__ __forceinline__ unsigned xb_ld(unsigned* p)              { return __hip_atomic_load(p, __ATOMIC_RELAXED, __HIP_MEMORY_SCOPE_AGENT); }
__device__ __forceinline__ unsigned xb_add(unsigned* p, unsigned v) { return __hip_atomic_fetch_add(p, v, __ATOMIC_RELAXED, __HIP_MEMORY_SCOPE_AGENT); }
__device__ __forceinline__ unsigned xb_xcc_id() { return (unsigned)__builtin_amdgcn_s_getreg((3 << 11) | 20) & 0xFu; }
#define XB_SPIN(cond, bar) do { unsigned _sp = 0; while (cond) { __builtin_amdgcn_s_sleep(1); \
    if ((++_sp & 255u) == 0u) { if (xb_ld(&(bar)[XB_TMO])) break; if (_sp > XB_SPIN_CAP) { atomicAdd(&(bar)[XB_TMO], 1u); break; } } } } while (0)

struct XcdBarrier {
    unsigned* bar; unsigned x;
    volatile LAS unsigned* st;
};

__device__ __forceinline__ XcdBarrier xcd_barrier_post(unsigned* bar, volatile LAS unsigned* st) {
    XcdBarrier b; b.bar = bar; b.x = xb_xcc_id(); b.st = st;
    if (threadIdx.x == 0) (void)xb_add(&bar[XB_XCNT(b.x)], 1u);
    return b;
}
__device__ __forceinline__ void xcd_barrier_complete(unsigned* bar, unsigned x, unsigned& nloc, unsigned& nx) {
    const unsigned G = gridDim.x * gridDim.y * gridDim.z;
    unsigned sum, cnt, mine, sp = 0u;
    for (;;) {
        sum = 0u; cnt = 0u; mine = 0u;
#pragma unroll
        for (unsigned j = 0; j < 16; ++j) { const unsigned c = xb_ld(&bar[XB_XCNT(j)]); sum += c; cnt += (c > 0u) ? 1u : 0u; mine = (j == x) ? c : mine; }
        if (sum == G) break;
        __builtin_amdgcn_s_sleep(1);
        if ((++sp & 255u) == 0u) { if (xb_ld(&bar[XB_TMO])) break; if (sp > XB_SPIN_CAP) { atomicAdd(&bar[XB_TMO], 1u); break; } }
    }
    nloc = mine > 0u ? mine : 1u; nx = cnt > 0u ? cnt : 1u;
}

__device__ __forceinline__ void xcd_barrier(const XcdBarrier& b) {
    asm volatile("s_waitcnt vmcnt(0)" ::: "memory");
    __syncthreads();
    if (threadIdx.x == 0) {
        unsigned* bar = b.bar;
        __builtin_amdgcn_s_waitcnt(0);
        unsigned nloc = b.st[0], nx = b.st[1];
        if (nloc == 0u) { xcd_barrier_complete(bar, b.x, nloc, nx); b.st[0] = nloc; b.st[1] = nx; }
        const unsigned old = xb_add(&bar[XB_XSUB(b.x)], 1u);
        const unsigned gen = old / nloc;
        if (old + 1u == (gen + 1u) * nloc) {
            __builtin_amdgcn_fence(__ATOMIC_RELEASE, "agent");
            asm volatile("s_waitcnt vmcnt(0)" ::: "memory");
            const unsigned og = xb_add(&bar[XB_TOP], 1u);
            const unsigned tg = og / nx;
            if (og + 1u == (tg + 1u) * nx) xb_add(&bar[XB_TOPGEN], 1u);
            else XB_SPIN(xb_ld(&bar[XB_TOPGEN]) == tg, bar);
            __builtin_amdgcn_fence(__ATOMIC_ACQUIRE, "agent");
            xb_add(&bar[XB_XGEN(b.x)], 1u);
            asm volatile("s_waitcnt vmcnt(0)" ::: "memory");
        } else {
            XB_SPIN(xb_ld(&bar[XB_XGEN(b.x)]) == gen, bar);
            __builtin_amdgcn_fence(__ATOMIC_ACQUIRE, "agent");
            asm volatile("s_waitcnt vmcnt(0)" ::: "memory");
        }
    }
    __syncthreads();
}

struct Frame {
    LAS unsigned char* lds;
    volatile LAS unsigned* MISC;
    gu32* ctl;
    int tid, lane, wave, vcu, G;
    const float* in[25];
    float* out;
    unsigned char* ws;
};
#define IN_X 0
#define IN_META 1
#define IN_LBL 2
#define IN_NMIX 3
#define IN_WIN 4
#define IN_HGNORM 5
#define IN_CONVW 6
#define IN_CONVB 7
#define IN_WQ 8
#define IN_WK 9
#define IN_WV 10
#define IN_GATEB 11
#define IN_MLNORM 12
#define IN_MLSKIP 13
#define IN_WBH 14
#define IN_WBM 15
#define IN_WOUT 16
#define IN_NFFN 17
#define IN_RW 18
#define IN_RB 19
#define IN_WGU 20
#define IN_BGU 21
#define IN_WDN 22
#define IN_BDN 23
#define IN_NFIN 24

__device__ __forceinline__ void p0_item(const float* W, int ldw, int col0, int cstride, const float* kscale, bf16* WT, int K, int dstrow0, int k0, LAS float* scr, int lane, float gsc = 1.f) {
    (void)cstride;
    const int r = lane >> 3, c4 = (lane & 7) * 4;
    f32x4 v[8];
#pragma unroll
    for (int i = 0; i < 8; ++i) v[i] = *(const GAS f32x4*)(W + (size_t)(k0 + 8 * i + r) * ldw + col0 + c4);
#pragma unroll
    for (int i = 0; i < 8; ++i) { const float sc = kscale ? kscale[k0 + 8 * i + r] : gsc; LAS float* s = scr + (8 * i + r) * 33 + c4; s[0] = v[i].x * sc; s[1] = v[i].y * sc; s[2] = v[i].z * sc; s[3] = v[i].w * sc; }
    LDS_WAIT(); asm volatile("" ::: "memory");
    const int c = lane & 7;
#pragma unroll
    for (int j = 0; j < 4; ++j) { const int n = (lane >> 3) + 8 * j; const LAS float* s = scr + (8 * c) * 33 + n;
        v4u o; o.x = pk2(s[0 * 33], s[1 * 33]); o.y = pk2(s[2 * 33], s[3 * 33]); o.z = pk2(s[4 * 33], s[5 * 33]); o.w = pk2(s[6 * 33], s[7 * 33]);
        *(GAS v4u*)(WT + (size_t)(dstrow0 + n) * K + k0 + 8 * c) = o; }
    LDS_WAIT(); asm volatile("" ::: "memory");
}
__device__ __forceinline__ void p0_prologue(Frame& F) {
    unsigned char* ws = F.ws;
    const int gw = F.vcu * NWAVES + F.wave, NGW = F.G * NWAVES, gt = F.vcu * NTHREADS + F.tid, NGT = F.G * NTHREADS;
    {
        LAS float* wm = (LAS float*)(F.lds + RING_OFF + 65536);
        { float wa[16], wb[16];
#pragma unroll
          for (int q = 0; q < 16; ++q) { const int u = F.tid + q * NTHREADS, j = u & 7, l = (u >> 3) & 63, i = u >> 9, k = 4 * l + 256 * (i >> 2) + (i & 3); wa[q] = F.in[IN_NMIX][k]; wb[q] = F.in[IN_WIN][(size_t)k * NIN + 3072 + j]; }
#pragma unroll
          for (int q = 0; q < 16; ++q) wm[F.tid + q * NTHREADS] = wa[q] * wb[q]; }
        __syncthreads();
        bf16* XN0 = (bf16*)(ws + WS_XN0); float* XSQ = (float*)(ws + WS_XSQ); float* LI = (float*)(ws + WS_LI); float* LF = (float*)(ws + WS_LF);
        f32x4 vn[4];
#define P0_LOADROW(dst, V_) do { const int Vc_ = (V_) < NR ? (V_) : NR - 1; const float* src_ = (Vc_ >= NTOK) ? F.in[IN_META] + (size_t)(Vc_ - NTOK) * D : F.in[IN_X] + (size_t)Vc_ * D; \
        const GAS f32x4* xr_ = (const GAS f32x4*)src_ + F.lane; _Pragma("unroll") for (int j = 0; j < 4; ++j) dst[j] = xr_[64 * j]; } while (0)
        P0_LOADROW(vn, gw);
        for (int V = gw; V < NR; V += NGW) {
            f32x4 v[4]; float s = 0.f;
#pragma unroll
            for (int j = 0; j < 4; ++j) { v[j] = vn[j]; s += (v[j].x * v[j].x + v[j].y * v[j].y) + (v[j].z * v[j].z + v[j].w * v[j].w); }
            P0_LOADROW(vn, V + NGW);
            asm volatile("" ::: "memory");
            const float sq = sqrtf(wave_sum(s) * (1.f / D) + EPS), rs = 1.0f / sq;
            if (F.lane == 0) XSQ[V] = sq;
            float g[8];
#pragma unroll
            for (int j = 0; j < 8; ++j) g[j] = 0.f;
            GAS unsigned long long* o8 = (GAS unsigned long long*)(XN0 + (size_t)V * D) + F.lane;
#pragma unroll
            for (int j = 0; j < 4; ++j) {
                v[j] = v[j] * rs;
                o8[64 * j] = (unsigned long long)pk2(v[j].x, v[j].y) | ((unsigned long long)pk2(v[j].z, v[j].w) << 32);
#pragma unroll
                for (int q = 0; q < 4; ++q) { const LAS f32x4* wp = (const LAS f32x4*)(wm + (((4 * j + q) * 64 + F.lane) * 8)); const f32x4 w0 = wp[0], w1 = wp[1]; const float xv = v[j][q];
                    g[0] += xv * w0.x; g[1] += xv * w0.y; g[2] += xv * w0.z; g[3] += xv * w0.w; g[4] += xv * w1.x; g[5] += xv * w1.y; g[6] += xv * w1.z; g[7] += xv * w1.w; }
            }
#pragma unroll
            for (int j = 0; j < 8; ++j) g[j] = wave_sum(g[j]);
            if (F.lane < 4) {
                const float gi = (F.lane == 0 ? g[0] : F.lane == 1 ? g[1] : F.lane == 2 ? g[2] : g[3]) + F.in[IN_GATEB][F.lane];
                const float gf = (F.lane == 0 ? g[4] : F.lane == 1 ? g[5] : F.lane == 2 ? g[6] : g[7]) + F.in[IN_GATEB][4 + F.lane];
                LI[(size_t)V * 4 + F.lane] = gi;
                LF[(size_t)V * 4 + F.lane] = fminf(gf, 0.f) - log1pf(__expf(-fabsf(gf)));
            }
        }
        __syncthreads();
    }
    {
        LAS float* scr = (LAS float*)(F.lds + RING_OFF + F.wave * 16384);
        constexpr int I_IN1 = 16 * 96, I_IN2 = 16 * 64, I_BH = 8 * 32, I_OUT = 16 * 32;
        constexpr int NITEMS = I_IN1 + I_IN2 + 2 * I_BH + I_OUT;
        for (int it = gw; it < NITEMS; it += NGW) {
            int r = it;
            if (r < I_IN1) { const int kb = r / 96, nb = r % 96; p0_item(F.in[IN_WIN], NIN, 32 * nb, 1, F.in[IN_NMIX], (bf16*)(ws + WS_WIN), D, 32 * nb, 64 * kb, scr, F.lane); continue; } r -= I_IN1;
            if (r < I_IN2) { const int kb = r / 64, nb = r % 64; p0_item(F.in[IN_WIN], NIN, 3080 + 32 * nb, 1, F.in[IN_NMIX], (bf16*)(ws + WS_WIN), D, 3072 + 32 * nb, 64 * kb, scr, F.lane); continue; } r -= I_IN2;
            if (r < I_BH) { const int kb = r / 32, nb = r % 32; p0_item(F.in[IN_WBH], D, 32 * nb, 1, nullptr, (bf16*)(ws + WS_WBH), HW, 32 * nb, 64 * kb, scr, F.lane, 1.f / 255.f); continue; } r -= I_BH;
            if (r < I_BH) { const int kb = r / 32, nb = r % 32; p0_item(F.in[IN_WBM], D, 32 * nb, 1, nullptr, (bf16*)(ws + WS_WBM), HW, 32 * nb, 64 * kb, scr, F.lane, 1.f / 255.f); continue; } r -= I_BH;
            { const int kb = r / 32, nb = r % 32; p0_item(F.in[IN_WOUT], D, 32 * nb, 1, nullptr, (bf16*)(ws + WS_WOUT), D, 32 * nb, 64 * kb, scr, F.lane); }
        }
    }
    { float* BGUP = (float*)(ws + WS_BGUP); float* RWT = (float*)(ws + WS_RWT);
      for (int u = gt; u < NE * 2 * DFF; u += NGT) { const int e = u >> 11, n = u & 2047, pn = n >> 8, bj = (n >> 7) & 1, j = gu_slot(n & 127); BGUP[u] = F.in[IN_BGU][(size_t)e * 2 * DFF + 2 * (128 * pn + j) + bj]; }
      for (int u = gt; u < NE * D; u += NGT) { const int e = u >> 10, k = u & 1023; RWT[u] = F.in[IN_NFFN][k] * F.in[IN_RW][(size_t)k * NE + e]; } }
}

__device__ __forceinline__ unsigned pk4_fp8(float a, float b, float c, float d) { unsigned w = 0;
    a = __builtin_amdgcn_fmed3f(a, -448.f, 448.f); b = __builtin_amdgcn_fmed3f(b, -448.f, 448.f); c = __builtin_amdgcn_fmed3f(c, -448.f, 448.f); d = __builtin_amdgcn_fmed3f(d, -448.f, 448.f);
    w = __builtin_amdgcn_cvt_pk_fp8_f32(a, b, w, false); w = __builtin_amdgcn_cvt_pk_fp8_f32(c, d, w, true); return w; }
__device__ __forceinline__ void cvdn_load(const float* Wdn, int it, f32x4 (&v)[8], int lane) {
    const int e = it >> 9, kb = (it >> 5) & 15, nb = it & 31, r = lane >> 3, c4 = (lane & 7) * 4; const float* W = Wdn + (size_t)e * DFF * D;
#pragma unroll
    for (int i = 0; i < 8; ++i) v[i] = *(const GAS f32x4*)(W + (size_t)(64 * kb + 8 * i + r) * D + 32 * nb + c4);
}
__device__ __forceinline__ void cvdn_proc(unsigned char* WTdn, int it, const f32x4 (&v)[8], LAS float* scr, int lane) {
    const int e = it >> 9, kb = (it >> 5) & 15, nb = it & 31, r = lane >> 3, c4 = (lane & 7) * 4; unsigned char* WT = WTdn + (size_t)e * D * DFF;
#pragma unroll
    for (int i = 0; i < 8; ++i) { LAS float* s = scr + (8 * i + r) * 33 + c4; s[0] = v[i].x * 32.f; s[1] = v[i].y * 32.f; s[2] = v[i].z * 32.f; s[3] = v[i].w * 32.f; }
    LDS_WAIT(); asm volatile("" ::: "memory");
    const int c = lane & 7;
#pragma unroll
    for (int j = 0; j < 4; ++j) { const int n = (lane >> 3) + 8 * j; const LAS float* s = scr + (8 * c) * 33 + n;
        v2u o; o.x = pk4_fp8(s[0 * 33], s[1 * 33], s[2 * 33], s[3 * 33]); o.y = pk4_fp8(s[4 * 33], s[5 * 33], s[6 * 33], s[7 * 33]);
        const int cn = 32 * nb + n, rowp = (cn & ~255) + 128 * ((cn >> 3) & 1) + 32 * ((cn >> 6) & 3) + 8 * ((cn >> 4) & 3) + (cn & 7);
        *(GAS v2u*)(WT + (size_t)rowp * DFF + 64 * kb + 8 * c) = o; }
    LDS_WAIT(); asm volatile("" ::: "memory");
}
__device__ __forceinline__ void cvgu_load(const float* Wgu, const float* nffn, int it, f32x4 (&v)[8], float (&sc)[8], int lane) {
    const int e = it >> 10, kb = (it >> 5) & 31, nb = it & 31, r = lane >> 4, c4 = (lane & 15) * 4; const float* W = Wgu + (size_t)e * D * 2 * DFF;
#pragma unroll
    for (int i = 0; i < 8; ++i) { v[i] = *(const GAS f32x4*)(W + (size_t)(32 * kb + 4 * i + r) * (2 * DFF) + 64 * nb + c4); sc[i] = nffn[32 * kb + 4 * i + r] * 32.f; }
}
__device__ __forceinline__ void cvgu_proc(unsigned char* WTgu, int it, const f32x4 (&v)[8], const float (&sc)[8], LAS float* scr, int lane) {
    const int e = it >> 10, kb = (it >> 5) & 31, nb = it & 31, r = lane >> 4, c4 = (lane & 15) * 4, A0 = 32 * nb, k0 = 32 * kb; unsigned char* WT = WTgu + (size_t)e * 2 * DFF * D;
    LAS float* sg = scr; LAS float* su = scr + 32 * 33;
#pragma unroll
    for (int i = 0; i < 8; ++i) { const int o = (4 * i + r) * 33 + (c4 >> 1); sg[o] = v[i].x * sc[i]; su[o] = v[i].y * sc[i]; sg[o + 1] = v[i].z * sc[i]; su[o + 1] = v[i].w * sc[i]; }
    LDS_WAIT(); asm volatile("" ::: "memory");
    const int c = lane & 3;
#pragma unroll
    for (int j = 0; j < 4; ++j) { const int q = (lane >> 2) + 16 * j, isup = q >> 5, jj = q & 31, A = A0 + jj; const LAS float* s = scr + isup * 32 * 33 + (8 * c) * 33 + jj;
        v2u o; o.x = pk4_fp8(s[0 * 33], s[1 * 33], s[2 * 33], s[3 * 33]); o.y = pk4_fp8(s[4 * 33], s[5 * 33], s[6 * 33], s[7 * 33]);
        *(GAS v2u*)(WT + (size_t)(256 * (A >> 7) + 128 * isup + gu_slot(A & 127)) * D + k0 + 8 * c) = o; }
    LDS_WAIT(); asm volatile("" ::: "memory");
}
__device__ __forceinline__ void px_experts(Frame& F, int rank, int nwg) {
    unsigned char* ws = F.ws;
    LAS float* scr = (LAS float*)(F.lds + RING_OFF + F.wave * 16384);
    const int gw = rank * NWAVES + F.wave, NGW = nwg * NWAVES;
    { constexpr int NIT = NE * 1024; f32x4 v[8], vn[8]; float sc[8], sn[8]; int it = gw;
      if (it < NIT) cvgu_load(F.in[IN_WGU], F.in[IN_NFFN], it, v, sc, F.lane);
      while (it < NIT) { const int nx = it + NGW; if (nx < NIT) cvgu_load(F.in[IN_WGU], F.in[IN_NFFN], nx, vn, sn, F.lane);
          asm volatile("" ::: "memory");
          cvgu_proc((unsigned char*)(ws + WS_WGU), it, v, sc, scr, F.lane); asm volatile("" ::: "memory");
#pragma unroll
          for (int i = 0; i < 8; ++i) { v[i] = vn[i]; sc[i] = sn[i]; }
          it = nx; } }
    { constexpr int NIT = NE * 512; f32x4 v[8], vn[8]; int it = gw;
      if (it < NIT) cvdn_load(F.in[IN_WDN], it, v, F.lane);
      while (it < NIT) { const int nx = it + NGW; if (nx < NIT) cvdn_load(F.in[IN_WDN], nx, vn, F.lane);
          asm volatile("" ::: "memory");
          cvdn_proc((unsigned char*)(ws + WS_WDN), it, v, scr, F.lane); asm volatile("" ::: "memory");
#pragma unroll
          for (int i = 0; i < 8; ++i) v[i] = vn[i];
          it = nx; } }
}

namespace pg8 {
typedef unsigned v2u_t __attribute__((ext_vector_type(2)));
typedef float f32x2 __attribute__((ext_vector_type(2)));
__device__ __forceinline__ f32x2 sig2(f32x2 x) { const f32x2 t = x * (f32x2){-1.4426950408889634f, -1.4426950408889634f};
    const f32x2 d = (f32x2){__builtin_amdgcn_exp2f(t.x), __builtin_amdgcn_exp2f(t.y)} + (f32x2){1.f, 1.f}; return (f32x2){__builtin_amdgcn_rcpf(d.x), __builtin_amdgcn_rcpf(d.y)}; }
__device__ __forceinline__ u32x4 pack8(const f32x4& a, const f32x4& b) { u32x4 w; w.x = cvt_pk_bf16(a[0], a[1]); w.y = cvt_pk_bf16(a[2], a[3]); w.z = cvt_pk_bf16(b[0], b[1]); w.w = cvt_pk_bf16(b[2], b[3]); return w; }
__device__ __forceinline__ v2u_t pack8_fp8(const f32x4& a, const f32x4& b) { unsigned lo = 0, hi = 0;
    lo = __builtin_amdgcn_cvt_pk_fp8_f32(a[0], a[1], lo, false); lo = __builtin_amdgcn_cvt_pk_fp8_f32(a[2], a[3], lo, true);
    hi = __builtin_amdgcn_cvt_pk_fp8_f32(b[0], b[1], hi, false); hi = __builtin_amdgcn_cvt_pk_fp8_f32(b[2], b[3], hi, true); return (v2u_t){lo, hi}; }
__device__ __forceinline__ v2u_t pack8_fp8_sat(const f32x4& a, const f32x4& b) { f32x4 x, y;
#pragma unroll
    for (int i = 0; i < 4; ++i) { x[i] = __builtin_amdgcn_fmed3f(a[i], -448.f, 448.f); y[i] = __builtin_amdgcn_fmed3f(b[i], -448.f, 448.f); }
    return pack8_fp8(x, y); }
__device__ __forceinline__ void unpack8(const u32x4& w, f32x4& a, f32x4& b) { a = (f32x4){bflo(w.x), bfhi(w.x), bflo(w.y), bfhi(w.y)}; b = (f32x4){bflo(w.z), bfhi(w.z), bflo(w.w), bfhi(w.w)}; }
__host__ __device__ __forceinline__ int gate_pos(int c) { return (c & ~255) + ((((c >> 5) & 3) * 4 + ((c >> 3) & 3)) * 16) + (((c >> 7) & 1) * 8) + (c & 7); }
__device__ __forceinline__ unsigned q8x4(float a, float b, float c, float d) {
    const unsigned t0 = __builtin_bit_cast(unsigned, __builtin_fmaf(a, 255.f, 8388608.f)), t1 = __builtin_bit_cast(unsigned, __builtin_fmaf(b, 255.f, 8388608.f));
    const unsigned t2 = __builtin_bit_cast(unsigned, __builtin_fmaf(c, 255.f, 8388608.f)), t3 = __builtin_bit_cast(unsigned, __builtin_fmaf(d, 255.f, 8388608.f));
    return (t0 & 0xffu) | (t1 << 8) | (t2 << 16) | (t3 << 24); }
__device__ __forceinline__ f32x4 dq8x4(unsigned w) { return (f32x4){(float)(w & 0xffu), (float)((w >> 8) & 0xffu), (float)((w >> 16) & 0xffu), (float)(w >> 24)}; }
struct EpiProj {
    static constexpr bool PERM = true, AFTER_DRAIN = false;
    unsigned char* ws; const float* lbl;
    template <int ACT>
    __device__ __forceinline__ void emit(const f32x4 (&acc)[2][2][4][2], bf16_t* O, int row0, int colt) const {
#pragma unroll
        for (int ai = 0; ai < 2; ++ai)
#pragma unroll
            for (int m = 0; m < 4; ++m) { bf16_t* rowp = O + (size_t)(row0 + ai * HALF + m * 16) * HW + colt;
#pragma unroll
                for (int bj = 0; bj < 2; ++bj) { u32x4 o;
#pragma unroll
                    for (int k = 0; k < 4; ++k) { f32x2 p = {acc[ai][bj][m][k >> 1][2 * (k & 1)], acc[ai][bj][m][k >> 1][2 * (k & 1) + 1]};
                        if constexpr (ACT == 1) p = p * sig2(p); else if constexpr (ACT == 2) p = sig2(p);
                        o[k] = cvt_pk_bf16(p.x, p.y); }
                    *(u32x4*)(rowp + bj * HALF) = o; } }
    }
    __device__ __forceinline__ void operator()(const f32x4 (&acc)[2][2][4][2], const Unit& u, int wr, int wc, int fr, int fq) const {
        const int row0 = u.pm * BM + wr * 64 + fr, kind = u.pn < 12 ? (u.pn >> 1) : 6;
        const int colt = (u.pn < 12 ? (u.pn & 1) : (u.pn - 12)) * BM + wc * 32 + 8 * fq;
        if (kind == 1) {
            bf16_t* HG = (bf16_t*)(ws + WS_HG);
#pragma unroll
            for (int bj = 0; bj < 2; ++bj) { const int c = colt + bj * HALF; f32x2 lb[4], ol[4];
#pragma unroll
                for (int k = 0; k < 4; ++k) { lb[k] = sig2((f32x2){lbl[c + 2 * k] - lbl[HW + c + 2 * k], lbl[c + 2 * k + 1] - lbl[HW + c + 2 * k + 1]}); ol[k] = (f32x2){1.f, 1.f} - lb[k]; }
#pragma unroll
                for (int ai = 0; ai < 2; ++ai)
#pragma unroll
                    for (int m = 0; m < 4; ++m) { u32x4 o;
#pragma unroll
                        for (int k = 0; k < 4; ++k) { const f32x2 f = ol[k] * sig2((f32x2){acc[ai][bj][m][k >> 1][2 * (k & 1)], acc[ai][bj][m][k >> 1][2 * (k & 1) + 1]}) + lb[k];
                            const f32x2 lg = (f32x2){__builtin_amdgcn_logf(f.x), __builtin_amdgcn_logf(f.y)} * (f32x2){0.6931471805599453f, 0.6931471805599453f}; o[k] = cvt_pk_bf16(lg.x, lg.y); }
                        *(u32x4*)(HG + (size_t)(row0 + ai * HALF + m * 16) * HW + c) = o; } }
            return;
        }
        if (kind == 6) {
            unsigned char* G8 = ws + WS_GATES; const int gofs = (u.pn - 12) * BM + (wc * 4 + fq) * 16;
#pragma unroll
            for (int ai = 0; ai < 2; ++ai)
#pragma unroll
                for (int m = 0; m < 4; ++m) { u32x4 o;
#pragma unroll
                    for (int bj = 0; bj < 2; ++bj)
#pragma unroll
                        for (int h = 0; h < 2; ++h) { const f32x4 v = acc[ai][bj][m][h];
                            const f32x2 sa = sig2((f32x2){v[0], v[1]}), sb = sig2((f32x2){v[2], v[3]});
                            o[2 * bj + h] = q8x4(sa.x, sa.y, sb.x, sb.y); }
                    *(u32x4*)(G8 + (size_t)(row0 + ai * HALF + m * 16) * 2048 + gofs) = o; }
            return;
        }
        if (kind == 0) emit<1>(acc, (bf16_t*)(ws + WS_HQ), row0, colt); else if (kind == 2) emit<0>(acc, (bf16_t*)(ws + WS_HV), row0, colt); else if (kind == 3) emit<1>(acc, (bf16_t*)(ws + WS_HGATE), row0, colt);
        else if (kind == 4) emit<0>(acc, (bf16_t*)(ws + WS_MM), row0, colt); else emit<2>(acc, (bf16_t*)(ws + WS_MO), row0, colt);
    }
};
constexpr int PAIR_DA = 132, PAIR_DB = 4;
struct PairOrder { StaticOrder S;
    __device__ __forceinline__ bool next(int i, Unit& u) const { Unit t; if (!S.next(i >> 1, t)) return false; const int s = i & 1; u.pm = t.pm + PAIR_DA * s; u.pn = t.pn + PAIR_DB * s; return true; }
    __device__ __forceinline__ void a_ready(const Unit&) const {}
    __device__ __forceinline__ void done(const Unit&) const {}
};
struct EpiGate2 {
    static constexpr bool PERM = true, AFTER_DRAIN = false;
    const unsigned char* __restrict__ gates; bf16_t* __restrict__ tmp; bf16_t* __restrict__ merged;
    __device__ __forceinline__ void operator()(const f32x4 (&acc)[2][2][4][2], const Unit& u, int wr, int wc, int fr, int fq) const {
        const int step = u.pm >= PAIR_DA ? 1 : 0, pm = u.pm - PAIR_DA * step, pn = u.pn - PAIR_DB * step;
        const int row0 = pm * BM + wr * 64 + fr, col0 = pn * BM + wc * 32 + 8 * fq, gofs = step * D + pn * BM + (wc * 4 + fq) * 16;
        constexpr int NB = 2, NBAT = 8 / NB;
        bf16_t* obuf = tmp + (ptrdiff_t)(merged - tmp) * step;
        u32x4 gc[NB], tc[NB][2], gn[NB], tn[NB][2];
#define EG_LOAD(G, T, b_) do { _Pragma("unroll") for (int s_ = 0; s_ < NB; ++s_) { const int it_ = (b_) * NB + s_; const size_t row_ = (size_t)(row0 + (it_ >> 2) * HALF + (it_ & 3) * 16); G[s_] = *(const u32x4*)(gates + row_ * 2048 + gofs); _Pragma("unroll") for (int bj = 0; bj < 2; ++bj) { \
        if (step) T[s_][bj] = *(const u32x4*)(tmp + row_ * D + col0 + bj * HALF); else T[s_][bj] = (u32x4){0u, 0u, 0u, 0u}; } } } while (0)
        EG_LOAD(gc, tc, 0);
#pragma unroll
        for (int b = 0; b < NBAT; ++b) {
            if (b + 1 < NBAT) EG_LOAD(gn, tn, b + 1);
#pragma unroll
            for (int s = 0; s < NB; ++s) { const int it = b * NB + s, ai = it >> 2, m = it & 3; const size_t row = (size_t)(row0 + ai * HALF + m * 16);
#pragma unroll
                for (int bj = 0; bj < 2; ++bj) { const int c = col0 + bj * HALF; f32x4 t0, t1; unpack8(tc[s][bj], t0, t1); const f32x4 g0 = dq8x4(gc[s][2 * bj]), g1 = dq8x4(gc[s][2 * bj + 1]);
                    const u32x4 o = pack8(acc[ai][bj][m][0] * g0 + t0, acc[ai][bj][m][1] * g1 + t1);
                    *(u32x4*)(obuf + row * D + c) = o; } }
#pragma unroll
            for (int s = 0; s < NB; ++s)
#pragma unroll
                for (int bj = 0; bj < 2; ++bj) tc[s][bj] = tn[s][bj];
#pragma unroll
            for (int s = 0; s < NB; ++s) gc[s] = gn[s]; }
#undef EG_LOAD
    }
};
struct EpiH1 {
    static constexpr bool PERM = true, AFTER_DRAIN = false;
    const bf16_t* __restrict__ xn0; const float* __restrict__ xsq; bf16_t* __restrict__ H1; unsigned char* __restrict__ H1B8;
    __device__ __forceinline__ void operator()(const f32x4 (&acc)[2][2][4][2], const Unit& u, int wr, int wc, int fr, int fq) const {
        const int row0 = u.pm * BM + wr * 64 + fr, col0 = u.pn * BM + wc * 32 + 8 * fq;
        u32x4 xc[2], xn[2]; float sc, sn;
#define EH_LOAD(X, S_, it_) do { const size_t r_ = (size_t)(row0 + ((it_) >> 2) * HALF + ((it_) & 3) * 16); const bf16_t* src_ = xn0 + r_ * D + col0; S_ = xsq[r_]; _Pragma("unroll") for (int bj = 0; bj < 2; ++bj) X[bj] = *(const u32x4*)(src_ + bj * HALF); } while (0)
        EH_LOAD(xc, sc, 0);
#pragma unroll
        for (int it = 0; it < 8; ++it) { const int ai = it >> 2, m = it & 3; const size_t V = (size_t)(row0 + ai * HALF + m * 16);
            if (it + 1 < 8) EH_LOAD(xn, sn, it + 1);
#pragma unroll
            for (int bj = 0; bj < 2; ++bj) { const int c = col0 + bj * HALF; f32x4 x0, x1; unpack8(xc[bj], x0, x1);
                const f32x4 v0 = x0 * sc + acc[ai][bj][m][0], v1 = x1 * sc + acc[ai][bj][m][1];
                *(u32x4*)(H1 + V * D + c) = pack8(v0, v1); *(v2u_t*)(H1B8 + V * D + c) = pack8_fp8_sat(v0, v1); }
#pragma unroll
            for (int bj = 0; bj < 2; ++bj) xc[bj] = xn[bj];
            sc = sn; }
#undef EH_LOAD
    }
};
struct EpiGU {
    static constexpr bool PERM = true, AFTER_DRAIN = false;
    const float* __restrict__ bgup; const float* __restrict__ ers; unsigned char* __restrict__ act; const PG8_LAS int* pst;
    __device__ __forceinline__ void operator()(const f32x4 (&acc)[2][2][4][2], const Unit& u, int wr, int wc, int fr, int fq) const {
        const int e = u.pn >> 3, pn = u.pn & 7, row0 = u.pm * BM + wr * 64 + fr, cc = wc * 32 + 8 * fq;
        const float* rsp = ers + (size_t)e * NV + (row0 - pst[e]);
        const float* bp = bgup + (size_t)e * 2 * DFF + pn * BM + cc;
        f32x2 bg[2][2], bu[2][2];
#pragma unroll
        for (int h = 0; h < 2; ++h) { const f32x4 g4 = *(const f32x4*)(bp + 4 * h), u4 = *(const f32x4*)(bp + HALF + 4 * h);
            bg[h][0] = (f32x2){g4[0], g4[1]}; bg[h][1] = (f32x2){g4[2], g4[3]}; bu[h][0] = (f32x2){u4[0] + 1.f, u4[1] + 1.f}; bu[h][1] = (f32x2){u4[2] + 1.f, u4[3] + 1.f}; }
        float rsv[8];
#pragma unroll
        for (int it = 0; it < 8; ++it) rsv[it] = rsp[(it >> 2) * HALF + (it & 3) * 16];
        const int hi = fq >> 1;
        unsigned char* obase = act + (size_t)(row0 + 16 * hi) * DFF + pn * HALF + wc * 32 + 16 * (fq & 1);
        constexpr float KS = -1.702f * 1.4426950408889634f;
#pragma unroll
        for (int ai = 0; ai < 2; ++ai)
#pragma unroll
            for (int mp = 0; mp < 2; ++mp) { v2u_t pk[2];
#pragma unroll
                for (int q = 0; q < 2; ++q) { const int m = 2 * mp + q; const float rs = rsv[ai * 4 + m] * 0.03125f;
                    const f32x2 rs2 = {rs, rs}; unsigned w[2];
#pragma unroll
                    for (int h = 0; h < 2; ++h) { f32x2 o[2];
#pragma unroll
                        for (int p = 0; p < 2; ++p) {
                            f32x2 g = (f32x2){acc[ai][0][m][h][2 * p], acc[ai][0][m][h][2 * p + 1]} * rs2 + bg[h][p];
                            f32x2 u1 = (f32x2){acc[ai][1][m][h][2 * p], acc[ai][1][m][h][2 * p + 1]} * rs2 + bu[h][p];
                            g.x = fminf(g.x, 7.f); g.y = fminf(g.y, 7.f); u1.x = __builtin_amdgcn_fmed3f(u1.x, -6.f, 8.f); u1.y = __builtin_amdgcn_fmed3f(u1.y, -6.f, 8.f);
                            const f32x2 t = g * (f32x2){KS, KS};
                            const f32x2 d = (f32x2){__builtin_amdgcn_exp2f(t.x), __builtin_amdgcn_exp2f(t.y)} + (f32x2){1.f, 1.f};
                            const f32x2 r = {__builtin_amdgcn_rcpf(d.x), __builtin_amdgcn_rcpf(d.y)};
                            o[p] = (g * r) * u1; }
                        w[h] = __builtin_amdgcn_cvt_pk_fp8_f32(o[0].x, o[0].y, 0u, false); w[h] = __builtin_amdgcn_cvt_pk_fp8_f32(o[1].x, o[1].y, w[h], true); }
                    pk[q] = (v2u_t){w[0], w[1]}; }
                const auto r0 = __builtin_amdgcn_permlane32_swap(pk[0][0], pk[1][0], false, false), r1 = __builtin_amdgcn_permlane32_swap(pk[0][1], pk[1][1], false, false);
                *(u32x4*)(obase + (size_t)(ai * HALF + mp * 32) * DFF) = (u32x4){r0[0], r1[0], r0[1], r1[1]}; }
    }
};
struct EpiDown {
    static constexpr bool PERM = true, AFTER_DRAIN = false;
    const float* __restrict__ bdn; const float* __restrict__ ew; unsigned char* __restrict__ yb; const PG8_LAS int* pst;
    __device__ __forceinline__ void operator()(const f32x4 (&acc)[2][2][4][2], const Unit& u, int wr, int wc, int fr, int fq) const {
        const int e = u.pn >> 2, pn = u.pn & 3, row0 = u.pm * BM + wr * 64 + fr, col0 = pn * BM + wc * 64 + 16 * fq;
        const float* wp = ew + (size_t)e * NV + (row0 - pst[e]);
        f32x4 bv[2][2];
#pragma unroll
        for (int bj = 0; bj < 2; ++bj) { bv[bj][0] = *(const f32x4*)(bdn + (size_t)e * D + col0 + 8 * bj); bv[bj][1] = *(const f32x4*)(bdn + (size_t)e * D + col0 + 8 * bj + 4); }
        float wv[8];
#pragma unroll
        for (int it = 0; it < 8; ++it) wv[it] = wp[(it >> 2) * HALF + (it & 3) * 16];
#pragma unroll
        for (int ai = 0; ai < 2; ++ai)
#pragma unroll
            for (int m = 0; m < 4; ++m) { const size_t row = (size_t)(row0 + ai * HALF + m * 16); const float w = wv[ai * 4 + m] * 16.f;
                const v2u_t lo = pack8_fp8_sat((acc[ai][0][m][0] * 0.03125f + bv[0][0]) * w, (acc[ai][0][m][1] * 0.03125f + bv[0][1]) * w), hi = pack8_fp8_sat((acc[ai][1][m][0] * 0.03125f + bv[1][0]) * w, (acc[ai][1][m][1] * 0.03125f + bv[1][1]) * w);
                *(u32x4*)(yb + row * D + col0) = (u32x4){lo[0], lo[1], hi[0], hi[1]}; }
    }
};
struct GroupOrder {
    int ntiles, ncol, G, c; const PG8_LAS unsigned char* texp;
    __device__ __forceinline__ bool next(int i, Unit& u) const { const int x = c & 7, w = c >> 3, uu = i * (G >> 3) + w, lj = uu / ncol, pn = uu - lj * ncol, j = lj * 8 + x; if (j >= ntiles) return false; u.pm = j; u.pn = (int)texp[j] * ncol + pn; return true; }
    __device__ __forceinline__ void a_ready(const Unit&) const {}
    __device__ __forceinline__ void done(const Unit&) const {}
};
}

typedef short bf16x8 __attribute__((ext_vector_type(8)));
typedef float f32x16 __attribute__((ext_vector_type(16)));
#define MFMA32(a, b, c) __builtin_amdgcn_mfma_f32_32x32x16_bf16(a, b, c, 0, 0, 0)
__device__ __forceinline__ bf16x8 ldfrag(const LAS unsigned char* base, int st, int row0, int k0, int lane) { return *(const LAS bf16x8*)(base + (row0 + (lane & 31)) * st + (k0 + 8 * (lane >> 5)) * 2); }
__device__ __forceinline__ bf16x8 ldf(const LAS unsigned char* lanebase, int off) { return *(const LAS bf16x8*)(lanebase + off); }
__device__ __forceinline__ float fexp(float x) { return __builtin_amdgcn_exp2f(x * 1.4426950408889634f); }

__device__ __forceinline__ void p3_hgrn2_mfma(Frame& F, int bh) {
    unsigned char* ws = F.ws; const int b = bh >> 2, h = bh & 3, tid = F.tid, lane = F.lane, wave = F.wave, hh = lane >> 5, l31 = lane & 31;
    const bf16* HQ = (const bf16*)(ws + WS_HQ) + h * 128; const bf16* HG = (const bf16*)(ws + WS_HG) + h * 128; const bf16* HV = (const bf16*)(ws + WS_HV) + h * 128;
    const bf16* HGATE = (const bf16*)(ws + WS_HGATE) + h * 128; bf16* YHG = (bf16*)(ws + WS_YHG) + h * 128;
    LAS unsigned char* L = F.lds + RING_OFF;
    LAS unsigned char* QT = L; LAS unsigned char* KT = L + 17408; LAS unsigned char* KTT = L + 34816; LAS unsigned char* VT = L + 53248; LAS unsigned char* ST = L + 71680; LAS unsigned char* PP = L + 106496;
    LAS float* SEG = (LAS float*)(L + 115712); LAS float* ER = (LAS float*)(L + 117760); LAS float* EL = (LAS float*)(L + 118272); LAS float* OST = (LAS float*)(L + 17408);
    const int d = tid & 127, pq = tid >> 7;
    const int et = tid >> 3, evq = tid & 7;
    const int f144 = l31 * 144 + hh * 16, f272 = l31 * 272 + hh * 16;
    const int sst = wave == 2 ? 1 : 0, stt = wave == 0 ? 0 : 1, dt = wave & 3, vt0 = 2 * (wave >> 2), btt = wave & 1, bvt = wave >> 1;
    const LAS unsigned char* aK = KT + 32 * sst * 272 + f272; const LAS unsigned char* bQ = QT + 32 * stt * 272 + f272;
    LAS unsigned char* pst = PP + (32 * stt + l31) * 144 + (32 * sst + 4 * hh) * 2;
    const LAS unsigned char* aKTT = KTT + 32 * dt * 144 + f144; const LAS unsigned char* bV0 = VT + 32 * vt0 * 144 + f144;
    LAS unsigned char* sst_ = ST + (32 * vt0 + l31) * 272 + (32 * dt + 4 * hh) * 2;
    const LAS float* erp = ER + 32 * dt + 4 * hh; const LAS float* elp = EL + 32 * dt + 4 * hh;
    const LAS unsigned char* aP = PP + 32 * btt * 144 + f144; const LAS unsigned char* bVB = VT + 32 * bvt * 144 + f144;
    const LAS unsigned char* aQ = QT + 32 * btt * 272 + f272; const LAS unsigned char* bS = ST + 32 * bvt * 272 + f272;
    LAS float* ost = OST + (32 * btt + 4 * hh) * 132 + 32 * bvt + l31; const LAS float* oep = OST + et * 132 + 16 * evq;
    LAS unsigned char* tq = QT + 16 * pq * 272 + d * 2; LAS unsigned char* tk = KT + 16 * pq * 272 + d * 2; LAS unsigned char* tkt = KTT + d * 144 + pq * 32; LAS unsigned char* tv = VT + d * 144 + pq * 32;
    f32x16 S0, S1;
#pragma unroll
    for (int i = 0; i < 16; ++i) { S0[i] = 0.f; S1[i] = 0.f; }
    unsigned gr[16], qr[16], vr[16]; v4u gt0, gt1;
    float gn[16];
#pragma unroll
    for (int i = 0; i < 16; ++i) gn[i] = F.in[IN_HGNORM][h * 128 + 16 * evq + i];
#define HG_LOAD(c) do { const int ttb = 64 * (c) - 48 + 16 * pq; \
        _Pragma("unroll") for (int i = 0; i < 16; ++i) { const int tt = ttb + i; if (tt >= 0) { const size_t gi = rowof(b, tt) * HW + d; gr[i] = (unsigned)HG[gi]; qr[i] = (unsigned)HQ[gi]; vr[i] = (unsigned)HV[gi]; } else { gr[i] = 0u; qr[i] = 0u; vr[i] = 0u; } } \
        { const int tt = 64 * (c) - 48 + et; if (tt >= 0) { const GAS v4u* gp = (const GAS v4u*)(HGATE + rowof(b, tt) * HW + 16 * evq); gt0 = gp[0]; gt1 = gp[1]; } else { gt0 = (v4u){0u, 0u, 0u, 0u}; gt1 = gt0; } } } while (0)
    HG_LOAD(0);
    for (int c = 0; c < 33; ++c) {
        float bl[16], gq[16];
#pragma unroll
        for (int i = 0; i < 16; ++i) gq[i] = __builtin_bit_cast(float, gr[i] << 16);
        { float a = 0.f;
#pragma unroll
          for (int i = 0; i < 16; ++i) { a += gq[i]; bl[i] = a; } }
        SEG[pq * 128 + d] = bl[15];
        __syncthreads();
        { const float s0 = SEG[d], s1 = SEG[128 + d], s2 = SEG[256 + d], s3 = SEG[384 + d];
          const float off = pq == 0 ? 0.f : pq == 1 ? s0 : pq == 2 ? s0 + s1 : (s0 + s1) + s2, r = s0 + s1, blast = (s0 + s1) + (s2 + s3);
          unsigned kp[8], vp[8];
#pragma unroll
          for (int i = 0; i < 16; i += 2) {
              const float b0 = off + bl[i], b1 = off + bl[i + 1];
              const float q0 = __builtin_bit_cast(float, qr[i] << 16) * fexp(b0 - r), q1 = __builtin_bit_cast(float, qr[i + 1] << 16) * fexp(b1 - r);
              const float k0 = (1.f - fexp(gq[i])) * fexp(r - b0), k1 = (1.f - fexp(gq[i + 1])) * fexp(r - b1);
              const unsigned kk = pg8::cvt_pk_bf16(k0, k1), qq = pg8::cvt_pk_bf16(q0, q1);
              *(LAS unsigned short*)(tq + i * 272) = (unsigned short)qq; *(LAS unsigned short*)(tq + (i + 1) * 272) = (unsigned short)(qq >> 16);
              *(LAS unsigned short*)(tk + i * 272) = (unsigned short)kk; *(LAS unsigned short*)(tk + (i + 1) * 272) = (unsigned short)(kk >> 16);
              kp[i >> 1] = kk; vp[i >> 1] = vr[i] | (vr[i + 1] << 16); }
          *(LAS v4u*)(tkt) = (v4u){kp[0], kp[1], kp[2], kp[3]}; *(LAS v4u*)(tkt + 16) = (v4u){kp[4], kp[5], kp[6], kp[7]};
          *(LAS v4u*)(tv) = (v4u){vp[0], vp[1], vp[2], vp[3]}; *(LAS v4u*)(tv + 16) = (v4u){vp[4], vp[5], vp[6], vp[7]};
          if (pq == 0) { ER[d] = fexp(r); EL[d] = fexp(blast - r); } }
        const v4u g0 = gt0, g1 = gt1;
        __syncthreads();
        if (c + 1 < 33) HG_LOAD(c + 1);
        asm volatile("" ::: "memory");
        if (wave < 3) {
            f32x16 acc;
#pragma unroll
            for (int i = 0; i < 16; ++i) acc[i] = 0.f;
#pragma unroll
            for (int ks = 0; ks < 8; ++ks) acc = MFMA32(ldf(aK, 32 * ks), ldf(bQ, 32 * ks), acc);
            const int t = 32 * stt + l31;
#pragma unroll
            for (int g4 = 0; g4 < 4; ++g4) { const int s0 = 32 * sst + 8 * g4 + 4 * hh;
                const float x0 = (s0 + 0 <= t) ? acc[4 * g4 + 0] : 0.f, x1 = (s0 + 1 <= t) ? acc[4 * g4 + 1] : 0.f, x2 = (s0 + 2 <= t) ? acc[4 * g4 + 2] : 0.f, x3 = (s0 + 3 <= t) ? acc[4 * g4 + 3] : 0.f;
                *(LAS v2u*)(pst + 16 * g4) = (v2u){pg8::cvt_pk_bf16(x0, x1), pg8::cvt_pk_bf16(x2, x3)}; }
        }
        {
#pragma unroll
          for (int g4 = 0; g4 < 4; ++g4) { const f32x4 er = *(const LAS f32x4*)(erp + 8 * g4);
#pragma unroll
              for (int i = 0; i < 4; ++i) { S0[4 * g4 + i] *= er[i]; S1[4 * g4 + i] *= er[i]; }
              *(LAS v2u*)(sst_ + 16 * g4) = (v2u){pg8::cvt_pk_bf16(S0[4 * g4], S0[4 * g4 + 1]), pg8::cvt_pk_bf16(S0[4 * g4 + 2], S0[4 * g4 + 3])};
              *(LAS v2u*)(sst_ + 32 * 272 + 16 * g4) = (v2u){pg8::cvt_pk_bf16(S1[4 * g4], S1[4 * g4 + 1]), pg8::cvt_pk_bf16(S1[4 * g4 + 2], S1[4 * g4 + 3])}; }
#pragma unroll
          for (int ks = 0; ks < 4; ++ks) { const bf16x8 a = ldf(aKTT, 32 * ks); S0 = MFMA32(a, ldf(bV0, 32 * ks), S0); S1 = MFMA32(a, ldf(bV0, 32 * 144 + 32 * ks), S1); }
#pragma unroll
          for (int g4 = 0; g4 < 4; ++g4) { const f32x4 el = *(const LAS f32x4*)(elp + 8 * g4);
#pragma unroll
              for (int i = 0; i < 4; ++i) { S0[4 * g4 + i] *= el[i]; S1[4 * g4 + i] *= el[i]; } } }
        __syncthreads();
        { f32x16 acc;
#pragma unroll
          for (int i = 0; i < 16; ++i) acc[i] = 0.f;
#pragma unroll
          for (int ks = 0; ks < 4; ++ks) if (ks < 2 || btt == 1) acc = MFMA32(ldf(aP, 32 * ks), ldf(bVB, 32 * ks), acc);
#pragma unroll
          for (int ks = 0; ks < 8; ++ks) acc = MFMA32(ldf(aQ, 32 * ks), ldf(bS, 32 * ks), acc);
#pragma unroll
          for (int i = 0; i < 16; ++i) ost[((i & 3) + 8 * (i >> 2)) * 132] = acc[i]; }
        __syncthreads();
        { const int tt = 64 * c - 48 + et;
          f32x4 o[4]; float ss = 0.f;
#pragma unroll
          for (int j = 0; j < 4; ++j) { o[j] = *(const LAS f32x4*)(oep + 4 * j); ss += (o[j].x * o[j].x + o[j].y * o[j].y) + (o[j].z * o[j].z + o[j].w * o[j].w); }
          ss += __shfl_xor(ss, 1); ss += __shfl_xor(ss, 2); ss += __shfl_xor(ss, 4);
          const float rs = 1.0f / sqrtf(ss * (1.f / 128.f) + EPS);
          if (tt >= NMETA || (tt >= 0 && b == 0)) { const unsigned gw[8] = {g0.x, g0.y, g0.z, g0.w, g1.x, g1.y, g1.z, g1.w}; unsigned w[8];
#pragma unroll
              for (int j = 0; j < 4; ++j) { w[2 * j] = pk2(o[j].x * rs * gn[4 * j] * bflo(gw[2 * j]), o[j].y * rs * gn[4 * j + 1] * bfhi(gw[2 * j])); w[2 * j + 1] = pk2(o[j].z * rs * gn[4 * j + 2] * bflo(gw[2 * j + 1]), o[j].w * rs * gn[4 * j + 3] * bfhi(gw[2 * j + 1])); }
              GAS v4u* yp = (GAS v4u*)(YHG + rowof(b, tt) * HW + 16 * evq); yp[0] = (v4u){w[0], w[1], w[2], w[3]}; yp[1] = (v4u){w[4], w[5], w[6], w[7]}; } }
        __syncthreads();
    }
#undef HG_LOAD
}


#define DPP_F(old, v, ctrl, rmask) __builtin_bit_cast(float, __builtin_amdgcn_update_dpp(__builtin_bit_cast(int, (float)(old)), __builtin_bit_cast(int, (float)(v)), (ctrl), (rmask), 0xf, false))
__device__ __forceinline__ float wave_scan_add(float v) {
    v += DPP_F(0.f, v, 0x111, 0xf); v += DPP_F(0.f, v, 0x112, 0xf); v += DPP_F(0.f, v, 0x114, 0xf); v += DPP_F(0.f, v, 0x118, 0xf);
    v += DPP_F(0.f, v, 0x142, 0xa); v += DPP_F(0.f, v, 0x143, 0xc); return v;
}
__device__ __forceinline__ float wave_scan_max(float v) {
    const float ni = -INFINITY;
    v = fmaxf(v, DPP_F(ni, v, 0x111, 0xf)); v = fmaxf(v, DPP_F(ni, v, 0x112, 0xf)); v = fmaxf(v, DPP_F(ni, v, 0x114, 0xf)); v = fmaxf(v, DPP_F(ni, v, 0x118, 0xf));
    v = fmaxf(v, DPP_F(ni, v, 0x142, 0xa)); v = fmaxf(v, DPP_F(ni, v, 0x143, 0xc)); return v;
}
__device__ __forceinline__ void p3_mlstm_mfma(Frame& F, int bh) {
    unsigned char* ws = F.ws; const int b = bh >> 2, h = bh & 3, tid = F.tid, lane = F.lane, wave = F.wave, hh = lane >> 5, l31 = lane & 31;
    const bf16* MMg = (const bf16*)(ws + WS_MM) + h * 128; const bf16* MOg = (const bf16*)(ws + WS_MO) + h * 128; const float* LI = (const float*)(ws + WS_LI) + h; const float* LF = (const float*)(ws + WS_LF) + h;
    bf16* YML = (bf16*)(ws + WS_YML) + h * 128;
    LAS unsigned char* L = F.lds + RING_OFF;
    LAS unsigned char* CT = L; LAS unsigned char* MT = L + 17408; LAS unsigned char* KM = L + 34816; LAS unsigned char* KW = L + 44032; LAS unsigned char* QM = L + 53248; LAS unsigned char* QW = L + 62464;
    LAS unsigned char* VT = L + 71680; LAS unsigned char* SV = L + 90112; LAS unsigned char* PP = L + 108544; LAS float* OST = (LAS float*)(L + 17408);
    LAS float* SM = (LAS float*)(L + 117760);
    LAS float* U = SM; LAS float* MX = SM + 64; LAS float* BB = SM + 128; LAS float* WSs = SM + 192; LAS float* WI = SM + 256; LAS float* DENP = SM + 320  ; LAS float* NN = SM + 416; LAS float* DENI = SM + 480; LAS float* SC = SM + 544  ; LAS float* GNS = SM + 560  ;
    const int ch = tid & 127, pq = tid >> 7, et = tid >> 3, evq = tid & 7;
    const int f144 = l31 * 144 + hh * 16, f272 = l31 * 272 + hh * 16;
    const int sst = wave == 2 ? 1 : 0, stt = wave == 0 ? 0 : 1, dkt = wave & 1, svt = wave >> 1;
    const LAS unsigned char* cfp = (wave < 4 ? CT : MT) + f272;
    LAS unsigned char* qst = QM + l31 * 144 + (32 * (wave & 1) + 4 * hh) * 2; LAS unsigned char* qwst = QW + l31 * 144 + (32 * (wave & 1) + 4 * hh) * 2;
    const int kdk = 32 * (wave & 1) + l31;
    LAS unsigned char* kmst = KM + 4 * hh * 144 + kdk * 2; LAS unsigned char* kwst = KW + kdk * 144 + 4 * hh * 2; const LAS float* wsp = WSs + 4 * hh;
    LAS unsigned char* vst = VT + (32 * (wave & 3) + l31) * 144 + 4 * hh * 2;
    const LAS unsigned char* aKM = KM + 32 * sst * 144 + f144; const LAS unsigned char* bQM = QM + 32 * stt * 144 + f144;
    LAS unsigned char* pst = PP + (32 * stt + l31) * 144 + (32 * sst + 4 * hh) * 2; const LAS float* up = U + 32 * sst + 4 * hh;
    LAS unsigned char* svst = SV + (32 * svt + l31) * 144 + (32 * dkt + 4 * hh) * 2;
    const LAS unsigned char* aKW = KW + 32 * dkt * 144 + f144; const LAS unsigned char* bVT = VT + 32 * svt * 144 + f144;
    const LAS unsigned char* aP = PP + 32 * dkt * 144 + f144; const LAS unsigned char* aQW = QW + 32 * dkt * 144 + f144; const LAS unsigned char* bSV = SV + 32 * svt * 144 + f144;
    LAS float* ost = OST + (32 * dkt + 4 * hh) * 132 + 32 * svt + l31; const LAS float* oep = OST + et * 132 + 16 * evq;
    LAS unsigned char* tc = CT + 16 * pq * 272 + ch * 2; LAS unsigned char* tm = MT + 16 * pq * 272 + ch * 2;
    bf16x8 wf[8];
    { const float* W = wave < 2 ? F.in[IN_WQ] + (size_t)h * 128 * 64 + 32 * wave + l31 : wave < 4 ? F.in[IN_WK] + (size_t)h * 128 * 64 + 32 * (wave - 2) + l31 : F.in[IN_WV] + (size_t)h * 128 * 128 + 32 * (wave - 4) + l31;
      const int ld = wave < 4 ? 64 : 128; const float sc = wave < 2 ? 0.125f : 1.f;
#pragma unroll
      for (int ks = 0; ks < 8; ++ks) { unsigned p[4];
#pragma unroll
          for (int j = 0; j < 4; ++j) p[j] = pk2(W[(size_t)(16 * ks + 8 * hh + 2 * j) * ld] * sc, W[(size_t)(16 * ks + 8 * hh + 2 * j + 1) * ld] * sc);
          wf[ks] = __builtin_bit_cast(bf16x8, (v4u){p[0], p[1], p[2], p[3]}); } }
    float cw[4]; const float cb = F.in[IN_CONVB][h * 128 + ch];
#pragma unroll
    for (int j = 0; j < 4; ++j) cw[j] = F.in[IN_CONVW][j * HW + h * 128 + ch];
    if (tid < 128) GNS[tid] = F.in[IN_MLNORM][h * 128 + tid]; else if (tid < 256) GNS[tid] = F.in[IN_MLSKIP][h * 128 + tid - 128];
    f32x16 S;
#pragma unroll
    for (int i = 0; i < 16; ++i) S[i] = 0.f;
    float mcar = 0.f, nreg = 0.f;
    unsigned mr[19]; v4u gt0, gt1; float pli = 0.f, plf = 0.f;
#define ML_LOAD(c) do { const int ttb = 64 * (c) - 48 + 16 * pq - 3; \
        _Pragma("unroll") for (int i = 0; i < 19; ++i) { const int tt = ttb + i; mr[i] = tt >= 0 ? (unsigned)MMg[rowof(b, tt) * HW + ch] : 0u; } \
        { const int tt = 64 * (c) - 48 + et; if (tt >= 0) { const GAS v4u* gp = (const GAS v4u*)(MOg + rowof(b, tt) * HW + 16 * evq); gt0 = gp[0]; gt1 = gp[1]; } else { gt0 = (v4u){0u, 0u, 0u, 0u}; gt1 = gt0; } } \
        if (wave == 0) { const int tt = 64 * (c) - 48 + lane; if (tt >= 0) { pli = LI[rowof(b, tt) * 4]; plf = LF[rowof(b, tt) * 4]; } else { pli = -1e30f; plf = 0.f; } } } while (0)
    ML_LOAD(0);
    for (int c = 0; c < 33; ++c) {
#pragma unroll
        for (int i = 0; i < 16; ++i) { const float a = cb + (cw[0] * __builtin_bit_cast(float, mr[i] << 16) + cw[1] * __builtin_bit_cast(float, mr[i + 1] << 16)) + (cw[2] * __builtin_bit_cast(float, mr[i + 2] << 16) + cw[3] * __builtin_bit_cast(float, mr[i + 3] << 16));
            *(LAS unsigned short*)(tc + i * 272) = (unsigned short)f2bf(fsilu(a)); *(LAS unsigned short*)(tm + i * 272) = (unsigned short)mr[i + 3]; }
        if (wave == 0) {
            const float bs = wave_scan_add(plf);
            const float u = pli - bs; const float pm = wave_scan_max(u);
            const float M = fmaxf(mcar, pm), M63 = __shfl(M, 63), b63 = __shfl(bs, 63);
            U[lane] = u; MX[lane] = M; BB[lane] = bs; WSs[lane] = fexp(u - M63); WI[lane] = fexp(mcar - M);
            if (lane == 0) { SC[0] = b63; SC[1] = M63; }
        }
        __syncthreads();
        { f32x16 a0, a1;
#pragma unroll
          for (int i = 0; i < 16; ++i) { a0[i] = 0.f; a1[i] = 0.f; }
          if (wave < 2) {
#pragma unroll
              for (int ks = 0; ks < 8; ++ks) { a0 = MFMA32(wf[ks], ldf(cfp, 32 * ks), a0); a1 = MFMA32(wf[ks], ldf(cfp, 32 * 272 + 32 * ks), a1); }
              const float wi0 = WI[l31], wi1 = WI[32 + l31];
#pragma unroll
              for (int g4 = 0; g4 < 4; ++g4) {
                  *(LAS v2u*)(qst + 16 * g4) = (v2u){pg8::cvt_pk_bf16(a0[4 * g4], a0[4 * g4 + 1]), pg8::cvt_pk_bf16(a0[4 * g4 + 2], a0[4 * g4 + 3])};
                  *(LAS v2u*)(qst + 32 * 144 + 16 * g4) = (v2u){pg8::cvt_pk_bf16(a1[4 * g4], a1[4 * g4 + 1]), pg8::cvt_pk_bf16(a1[4 * g4 + 2], a1[4 * g4 + 3])};
                  *(LAS v2u*)(qwst + 16 * g4) = (v2u){pg8::cvt_pk_bf16(a0[4 * g4] * wi0, a0[4 * g4 + 1] * wi0), pg8::cvt_pk_bf16(a0[4 * g4 + 2] * wi0, a0[4 * g4 + 3] * wi0)};
                  *(LAS v2u*)(qwst + 32 * 144 + 16 * g4) = (v2u){pg8::cvt_pk_bf16(a1[4 * g4] * wi1, a1[4 * g4 + 1] * wi1), pg8::cvt_pk_bf16(a1[4 * g4 + 2] * wi1, a1[4 * g4 + 3] * wi1)}; }
          } else {
#pragma unroll
              for (int ks = 0; ks < 8; ++ks) { a0 = MFMA32(ldf(cfp, 32 * ks), wf[ks], a0); a1 = MFMA32(ldf(cfp, 32 * 272 + 32 * ks), wf[ks], a1); }
              if (wave < 4) {
                  float nsum = 0.f;
#pragma unroll
                  for (int g4 = 0; g4 < 4; ++g4) { const f32x4 w0 = *(const LAS f32x4*)(wsp + 8 * g4), w1 = *(const LAS f32x4*)(wsp + 32 + 8 * g4);
#pragma unroll
                      for (int i = 0; i < 4; ++i) { *(LAS unsigned short*)(kmst + (8 * g4 + i) * 144) = (unsigned short)f2bf(a0[4 * g4 + i]); *(LAS unsigned short*)(kmst + (32 + 8 * g4 + i) * 144) = (unsigned short)f2bf(a1[4 * g4 + i]); }
                      const float x0 = a0[4 * g4] * w0[0], x1 = a0[4 * g4 + 1] * w0[1], x2 = a0[4 * g4 + 2] * w0[2], x3 = a0[4 * g4 + 3] * w0[3];
                      const float y0 = a1[4 * g4] * w1[0], y1 = a1[4 * g4 + 1] * w1[1], y2 = a1[4 * g4 + 2] * w1[2], y3 = a1[4 * g4 + 3] * w1[3];
                      nsum += ((x0 + x1) + (x2 + x3)) + ((y0 + y1) + (y2 + y3));
                      *(LAS v2u*)(kwst + 16 * g4) = (v2u){pg8::cvt_pk_bf16(x0, x1), pg8::cvt_pk_bf16(x2, x3)};
                      *(LAS v2u*)(kwst + 64 + 16 * g4) = (v2u){pg8::cvt_pk_bf16(y0, y1), pg8::cvt_pk_bf16(y2, y3)}; }
                  nsum += __shfl_xor(nsum, 32);
                  if (hh == 0) NN[kdk] = nreg;
                  nreg = fexp(mcar - SC[1]) * nreg + nsum;
              } else {
#pragma unroll
                  for (int g4 = 0; g4 < 4; ++g4) {
                      *(LAS v2u*)(vst + 16 * g4) = (v2u){pg8::cvt_pk_bf16(a0[4 * g4], a0[4 * g4 + 1]), pg8::cvt_pk_bf16(a0[4 * g4 + 2], a0[4 * g4 + 3])};
                      *(LAS v2u*)(vst + 64 + 16 * g4) = (v2u){pg8::cvt_pk_bf16(a1[4 * g4], a1[4 * g4 + 1]), pg8::cvt_pk_bf16(a1[4 * g4 + 2], a1[4 * g4 + 3])}; }
              }
          } }
        __syncthreads();
        const v4u g0 = gt0, g1 = gt1;
        if (c + 1 < 33) ML_LOAD(c + 1);
        asm volatile("" ::: "memory");
        if (wave < 3) {
            f32x16 acc;
#pragma unroll
            for (int i = 0; i < 16; ++i) acc[i] = 0.f;
#pragma unroll
            for (int ks = 0; ks < 4; ++ks) acc = MFMA32(ldf(aKM, 32 * ks), ldf(bQM, 32 * ks), acc);
            const int t = 32 * stt + l31; const float mt = MX[t]; float dsum = 0.f;
#pragma unroll
            for (int g4 = 0; g4 < 4; ++g4) { const int s0 = 32 * sst + 8 * g4 + 4 * hh; const f32x4 us = *(const LAS f32x4*)(up + 8 * g4);
                const float x0 = (s0 + 0 <= t) ? acc[4 * g4 + 0] * fexp(us[0] - mt) : 0.f, x1 = (s0 + 1 <= t) ? acc[4 * g4 + 1] * fexp(us[1] - mt) : 0.f;
                const float x2 = (s0 + 2 <= t) ? acc[4 * g4 + 2] * fexp(us[2] - mt) : 0.f, x3 = (s0 + 3 <= t) ? acc[4 * g4 + 3] * fexp(us[3] - mt) : 0.f;
                dsum += (x0 + x1) + (x2 + x3);
                *(LAS v2u*)(pst + 16 * g4) = (v2u){pg8::cvt_pk_bf16(x0, x1), pg8::cvt_pk_bf16(x2, x3)}; }
            dsum += __shfl_xor(dsum, 32);
            if (hh == 0) DENP[wave * 32 + l31] = dsum;
        } else if (wave == 3) {
            float a = 0.f;
#pragma unroll 2
            for (int j = 0; j < 8; ++j) { const v4u q = *(const LAS v4u*)(QW + lane * 144 + 16 * j); const f32x4 n0 = *(const LAS f32x4*)(NN + 8 * j), n1 = *(const LAS f32x4*)(NN + 8 * j + 4);
                a += (bflo(q.x) * n0[0] + bfhi(q.x) * n0[1]) + (bflo(q.y) * n0[2] + bfhi(q.y) * n0[3]) + (bflo(q.z) * n1[0] + bfhi(q.z) * n1[1]) + (bflo(q.w) * n1[2] + bfhi(q.w) * n1[3]); }
            DENI[lane] = a;
        }
        { const float wp = fexp(mcar - SC[1]);
#pragma unroll
          for (int g4 = 0; g4 < 4; ++g4) {
              *(LAS v2u*)(svst + 16 * g4) = (v2u){pg8::cvt_pk_bf16(S[4 * g4], S[4 * g4 + 1]), pg8::cvt_pk_bf16(S[4 * g4 + 2], S[4 * g4 + 3])};
#pragma unroll
              for (int i = 0; i < 4; ++i) S[4 * g4 + i] *= wp; }
#pragma unroll
          for (int ks = 0; ks < 4; ++ks) S = MFMA32(ldf(aKW, 32 * ks), ldf(bVT, 32 * ks), S); }
        __syncthreads();
        { f32x16 acc;
#pragma unroll
          for (int i = 0; i < 16; ++i) acc[i] = 0.f;
#pragma unroll
          for (int ks = 0; ks < 4; ++ks) if (ks < 2 || dkt == 1) acc = MFMA32(ldf(aP, 32 * ks), ldf(bVT, 32 * ks), acc);
#pragma unroll
          for (int ks = 0; ks < 4; ++ks) acc = MFMA32(ldf(aQW, 32 * ks), ldf(bSV, 32 * ks), acc);
#pragma unroll
          for (int i = 0; i < 16; ++i) ost[((i & 3) + 8 * (i >> 2)) * 132] = acc[i]; }
        __syncthreads();
        { const int tt = 64 * c - 48 + et;
          const float den = (et < 32 ? DENP[et] : DENP[et] + DENP[32 + et]) + DENI[et];
          const float inv = 1.0f / fmaxf(fabsf(den), fexp(-(BB[et] + MX[et])));
          f32x4 o[4]; float ss = 0.f;
#pragma unroll
          for (int j = 0; j < 4; ++j) { o[j] = *(const LAS f32x4*)(oep + 4 * j) * inv; ss += (o[j].x * o[j].x + o[j].y * o[j].y) + (o[j].z * o[j].z + o[j].w * o[j].w); }
          ss += __shfl_xor(ss, 1); ss += __shfl_xor(ss, 2); ss += __shfl_xor(ss, 4);
          const float rs = 1.0f / sqrtf(ss * (1.f / 128.f) + EPS);
          if (tt >= NMETA || (tt >= 0 && b == 0)) { const unsigned gw[8] = {g0.x, g0.y, g0.z, g0.w, g1.x, g1.y, g1.z, g1.w}; unsigned w[8];
              const v4u c0 = *(const LAS v4u*)(CT + et * 272 + 32 * evq), c1 = *(const LAS v4u*)(CT + et * 272 + 32 * evq + 16); const unsigned cwd[8] = {c0.x, c0.y, c0.z, c0.w, c1.x, c1.y, c1.z, c1.w};
#pragma unroll
              for (int j = 0; j < 4; ++j) { const f32x4 gn = *(const LAS f32x4*)(GNS + 16 * evq + 4 * j), sk = *(const LAS f32x4*)(GNS + 128 + 16 * evq + 4 * j);
                  w[2 * j] = pk2((o[j].x * rs * gn[0] + sk[0] * bflo(cwd[2 * j])) * bflo(gw[2 * j]), (o[j].y * rs * gn[1] + sk[1] * bfhi(cwd[2 * j])) * bfhi(gw[2 * j]));
                  w[2 * j + 1] = pk2((o[j].z * rs * gn[2] + sk[2] * bflo(cwd[2 * j + 1])) * bflo(gw[2 * j + 1]), (o[j].w * rs * gn[3] + sk[3] * bfhi(cwd[2 * j + 1])) * bfhi(gw[2 * j + 1])); }
              GAS v4u* yp = (GAS v4u*)(YML + rowof(b, tt) * HW + 16 * evq); yp[0] = (v4u){w[0], w[1], w[2], w[3]}; yp[1] = (v4u){w[4], w[5], w[6], w[7]}; }
          mcar = SC[0] + SC[1]; }
        __syncthreads();
    }
#undef ML_LOAD
}

typedef float f32x4v __attribute__((ext_vector_type(4)));
#define MFMA16F(a, b, c) __builtin_amdgcn_mfma_f32_16x16x4f32(a, b, c, 0, 0, 0)
constexpr int RW_LD = 516;
__device__ __forceinline__ void router_topk16(LAS float* LGw, int V, float rsv, int resrow, int lane, LAS int* hist, LAS int* res, int* TOPE, float* TOPW, float* RS) {
    if (lane < 16) {
        int se[4]; float sv[4];
#pragma unroll
        for (int k = 0; k < 4; ++k) { float best = -INFINITY; int bi = 0;
            for (int e = 0; e < 32; ++e) { const float v = LGw[lane * 33 + e]; if (v > best) { best = v; bi = e; } }
            se[k] = bi; sv[k] = best; LGw[lane * 33 + bi] = -INFINITY; }
        const float e1 = __expf(sv[1] - sv[0]), e2 = __expf(sv[2] - sv[0]), e3 = __expf(sv[3] - sv[0]), inv = 1.0f / (1.f + e1 + e2 + e3);
        const float w4[4] = {inv, e1 * inv, e2 * inv, e3 * inv};
#pragma unroll
        for (int k = 0; k < 4; ++k) { const int lp = __hip_atomic_fetch_add(hist + se[k], 1, __ATOMIC_RELAXED, __HIP_MEMORY_SCOPE_WORKGROUP);
            TOPE[(size_t)V * 4 + k] = se[k]; TOPW[(size_t)V * 4 + k] = w4[k]; res[(resrow + lane) * 4 + k] = lp; }
        RS[V] = rsv;
    }
}
__device__ __forceinline__ void p6_router(Frame& F) {
    unsigned char* ws = F.ws;
    const bf16* H1 = (const bf16*)(ws + WS_H1); const float* RWT = (const float*)(ws + WS_RWT);
    int* TOPE = (int*)(ws + WS_TOPE); int* TOPP = (int*)(ws + WS_TOPP); float* TOPW = (float*)(ws + WS_TOPW); float* RS = (float*)(ws + WS_RS);
    int* ETOK = (int*)(ws + WS_ETOK); float* ERS = (float*)(ws + WS_ERS); float* EW = (float*)(ws + WS_EW);
    LAS float* rw = (LAS float*)(F.lds + RING_OFF);
    LAS float* LG = (LAS float*)(F.lds + RING_OFF + 66048) + F.wave * 528;
    LAS int* hist = (LAS int*)(F.lds + RING_OFF + 66048 + 8 * 2112);
    LAS int* res = hist + 64;
    LAS float* XP = (LAS float*)(res + 144 * 4);
    LAS float* XQ = XP + 8 * 528;
    const int lane = F.lane, wave = F.wave, i16 = lane & 15, kk = lane >> 4;
    constexpr int RPW = NTOK / 256;
    const bool has_meta = (F.vcu == 0);
    const int Vbase = F.vcu * RPW, Vt = Vbase + 16 * wave;
    if (F.tid < 64) hist[F.tid] = 0;
    f32x4v acc0 = {0.f, 0.f, 0.f, 0.f}, acc1 = {0.f, 0.f, 0.f, 0.f}, acx0 = {0.f, 0.f, 0.f, 0.f}, acx1 = {0.f, 0.f, 0.f, 0.f}; float ssq = 0.f, xss = 0.f;
    const bf16* arow = H1 + (size_t)(Vt + i16) * D + 8 * kk;
    const bf16* xrow = H1 + (size_t)(NTOK + i16) * D + 8 * kk;
    v4u a0[4], a1[4];
#define RT_MMA(A, SB, C0, C1, SS) do { const LAS float* b0p = rw + i16 * RW_LD + 8 * kk + 128 * (SB); const LAS float* b1p = rw + (16 + i16) * RW_LD + 8 * kk + 128 * (SB); \
        _Pragma("unroll") for (int s = 0; s < 4; ++s) { const v4u aw = A[s]; \
            _Pragma("unroll") for (int h = 0; h < 2; ++h) { const unsigned w0 = h ? aw.z : aw.x, w1 = h ? aw.w : aw.y; const f32x4 a = {bflo(w0), bfhi(w0), bflo(w1), bfhi(w1)}; \
            const f32x4 b0 = *(const LAS f32x4*)(b0p + 32 * s + 4 * h), b1 = *(const LAS f32x4*)(b1p + 32 * s + 4 * h); \
            SS += (a.x * a.x + a.y * a.y) + (a.z * a.z + a.w * a.w); \
            C0 = MFMA16F(a.x, b0.x, C0); C1 = MFMA16F(a.x, b1.x, C1); C0 = MFMA16F(a.y, b0.y, C0); C1 = MFMA16F(a.y, b1.y, C1); \
            C0 = MFMA16F(a.z, b0.z, C0); C1 = MFMA16F(a.z, b1.z, C1); C0 = MFMA16F(a.w, b0.w, C0); C1 = MFMA16F(a.w, b1.w, C1); } } } while (0)
#pragma unroll
    for (int s = 0; s < 4; ++s) a0[s] = *(const GAS v4u*)(arow + 32 * s);
#pragma unroll 1
    for (int it = 0; it < 4; ++it) {
        const int half = it >> 1, sb0 = (2 * it) & 3;
        if ((it & 1) == 0) {
            __syncthreads();
            { f32x4 stg[8];
#pragma unroll
              for (int q = 0; q < 8; ++q) { const int u = F.tid + q * NTHREADS, e = u >> 7, c = u & 127; stg[q] = *(const GAS f32x4*)(RWT + (size_t)e * D + 512 * half + 4 * c); }
#pragma unroll
              for (int q = 0; q < 8; ++q) { const int u = F.tid + q * NTHREADS, e = u >> 7, c = u & 127; *(LAS f32x4*)(rw + e * RW_LD + 4 * c) = stg[q]; } }
            __syncthreads();
        }
#pragma unroll
        for (int s = 0; s < 4; ++s) a1[s] = *(const GAS v4u*)(arow + 128 * (2 * it + 1) + 32 * s);
        RT_MMA(a0, sb0, acc0, acc1, ssq);
        if (it < 3) {
#pragma unroll
            for (int s = 0; s < 4; ++s) a0[s] = *(const GAS v4u*)(arow + 128 * (2 * it + 2) + 32 * s);
        }
        RT_MMA(a1, sb0 + 1, acc0, acc1, ssq);
        if (has_meta && (wave >> 1) == it) {
            v4u ax[4];
#pragma unroll
            for (int s = 0; s < 4; ++s) ax[s] = *(const GAS v4u*)(xrow + 128 * wave + 32 * s);
            RT_MMA(ax, wave & 3, acx0, acx1, xss);
        }
    }
#undef RT_MMA
    if (has_meta) {
        xss += __shfl_xor(xss, 16); xss += __shfl_xor(xss, 32);
#pragma unroll
        for (int r = 0; r < 4; ++r) { XP[wave * 528 + (4 * kk + r) * 33 + i16] = acx0[r]; XP[wave * 528 + (4 * kk + r) * 33 + 16 + i16] = acx1[r]; }
        if (kk == 0) XQ[wave * 16 + i16] = xss;
    }
    ssq += __shfl_xor(ssq, 16); ssq += __shfl_xor(ssq, 32);
    const float rsrow = 1.0f / sqrtf(ssq * (1.f / D) + EPS);
    const float rb0 = F.in[IN_RB][i16], rb1 = F.in[IN_RB][16 + i16];
#pragma unroll
    for (int r = 0; r < 4; ++r) { const float rsr = __shfl(rsrow, 4 * kk + r); LG[(4 * kk + r) * 33 + i16] = acc0[r] * rsr + rb0; LG[(4 * kk + r) * 33 + 16 + i16] = acc1[r] * rsr + rb1; }
    LDS_WAIT(); asm volatile("" ::: "memory");
    router_topk16(LG, Vt + lane, rsrow, 16 * wave, lane, hist, res, TOPE, TOPW, RS);
    __syncthreads();
    if (has_meta && wave == 7) {
        float q = 0.f;
#pragma unroll
        for (int w = 0; w < 8; ++w) q += XQ[w * 16 + i16];
        const float rsm = 1.0f / sqrtf(q * (1.f / D) + EPS);
#pragma unroll
        for (int r = 0; r < 4; ++r) { float v0 = 0.f, v1 = 0.f;
#pragma unroll
            for (int w = 0; w < 8; ++w) { v0 += XP[w * 528 + (4 * kk + r) * 33 + i16]; v1 += XP[w * 528 + (4 * kk + r) * 33 + 16 + i16]; }
            const float rsr = __shfl(rsm, 4 * kk + r); LG[(4 * kk + r) * 33 + i16] = v0 * rsr + rb0; LG[(4 * kk + r) * 33 + 16 + i16] = v1 * rsr + rb1; }
        LDS_WAIT(); asm volatile("" ::: "memory");
        router_topk16(LG, NTOK + lane, rsm, 128, lane, hist, res, TOPE, TOPW, RS);
    }
    __syncthreads();
    if (F.tid < NE) hist[32 + F.tid] = (int)__hip_atomic_fetch_add(F.ctl + CW_CNT + 64 * F.tid, (unsigned)hist[F.tid], RLX_AGENT);
    __syncthreads();
    const int nrows = has_meta ? RPW + 16 : RPW;
    for (int u = F.tid; u < nrows * 4; u += NTHREADS) { const int rr = u >> 2, V = rr < RPW ? Vbase + rr : NTOK + (rr - RPW); const size_t gi = (size_t)V * 4 + (u & 3); const int e = TOPE[gi], pos = hist[32 + e] + res[u];
        TOPP[gi] = pos; ETOK[(size_t)e * NV + pos] = V; ERS[(size_t)e * NV + pos] = RS[V]; EW[(size_t)e * NV + pos] = TOPW[gi]; }
}

__device__ __forceinline__ void build_tables(Frame& F) {
    LAS int* pst = (LAS int*)(F.lds + PST_OFF); LAS unsigned char* texp = (LAS unsigned char*)(F.lds + TEXP_OFF);
    __syncthreads();
    if (F.tid < 64) {
        const int e = F.lane & 31; const int c = (int)__hip_atomic_load(F.ctl + CW_CNT + 64 * e, RLX_AGENT); const int nt = (c + 255) >> 8;
        int incl = nt;
#pragma unroll
        for (int o = 1; o < 32; o <<= 1) { const int t = __shfl_up(incl, o); if ((F.lane & 31) >= o) incl += t; }
        const int start = incl - nt;
        if (F.lane < 32) { pst[e] = start * 256; pst[33 + e] = c; for (int j = 0; j < nt && start + j < MAXTILES; ++j) texp[start + j] = (unsigned char)e; if (e == 31) pst[32] = incl < MAXTILES ? incl : MAXTILES; }
    }
    __syncthreads();
}
typedef float f32v2_t __attribute__((ext_vector_type(2)));
__device__ __forceinline__ void p10_combine(Frame& F) {
    unsigned char* ws = F.ws; build_tables(F);
    const LAS int* pst = (const LAS int*)(F.lds + PST_OFF);
    const bf16* H1 = (const bf16*)(ws + WS_H1); const unsigned char* YB = (const unsigned char*)(ws + WS_YB);
    const int* TOPE = (const int*)(ws + WS_TOPE); const int* TOPP = (const int*)(ws + WS_TOPP);
    const int gw = F.vcu * NWAVES + F.wave, NGW = F.G * NWAVES;
    const GAS f32x4* nf = (const GAS f32x4*)F.in[IN_NFIN] + F.lane; f32x4 nfv[4];
#pragma unroll
    for (int j = 0; j < 4; ++j) nfv[j] = nf[64 * j];
    int sl[2][4];
#define CMB_SLOTS(Rbase) do { _Pragma("unroll") for (int q = 0; q < 2; ++q) { const int R = (Rbase) + q * NGW; if (R < BATCH * SEQ) { const size_t V = (size_t)R; \
        _Pragma("unroll") for (int k = 0; k < 4; ++k) sl[q][k] = pst[TOPE[V * 4 + k]] + TOPP[V * 4 + k]; } else { _Pragma("unroll") for (int k = 0; k < 4; ++k) sl[q][k] = 0; } } } while (0)
    CMB_SLOTS(gw);
    for (int R0 = gw; R0 < BATCH * SEQ; R0 += 2 * NGW) {
        f32x4 v[2][4]; unsigned y[2][4][4];
#pragma unroll
        for (int q = 0; q < 2; ++q) { const int R = (R0 + q * NGW < BATCH * SEQ) ? R0 + q * NGW : R0; const size_t V = (size_t)R;
            const GAS v2u* hr = (const GAS v2u*)(H1 + V * D) + F.lane;
#pragma unroll
            for (int j = 0; j < 4; ++j) { const v2u hw = hr[64 * j]; v[q][j] = (f32x4){bflo(hw.x), bfhi(hw.x), bflo(hw.y), bfhi(hw.y)}; }
#pragma unroll
            for (int k = 0; k < 4; ++k) { const GAS unsigned* yr = (const GAS unsigned*)(YB + (size_t)sl[q][k] * D) + F.lane;
#pragma unroll
                for (int j = 0; j < 4; ++j) y[q][k][j] = yr[64 * j]; } }
        CMB_SLOTS(R0 + 2 * NGW);
#pragma unroll
        for (int q = 0; q < 2; ++q) { const int R = R0 + q * NGW; if (R >= BATCH * SEQ) continue;
#pragma unroll
            for (int k = 0; k < 4; ++k)
#pragma unroll
                for (int j = 0; j < 4; ++j) { const unsigned w = y[q][k][j]; const f32v2_t lo = __builtin_amdgcn_cvt_pk_f32_fp8(w, false), hi = __builtin_amdgcn_cvt_pk_f32_fp8(w, true);
                    v[q][j].x += lo[0] * 0.0625f; v[q][j].y += lo[1] * 0.0625f; v[q][j].z += hi[0] * 0.0625f; v[q][j].w += hi[1] * 0.0625f; }
            float s = 0.f;
#pragma unroll
            for (int j = 0; j < 4; ++j) s += (v[q][j].x * v[q][j].x + v[q][j].y * v[q][j].y) + (v[q][j].z * v[q][j].z + v[q][j].w * v[q][j].w);
            const float rs = 1.0f / sqrtf(wave_sum(s) * (1.f / D) + EPS);
            GAS f32x4* orow = (GAS f32x4*)(F.out + (size_t)R * D) + F.lane;
#pragma unroll
            for (int j = 0; j < 4; ++j) orow[64 * j] = v[q][j] * rs * nfv[j]; }
    }
#undef CMB_SLOTS
}

__device__ __forceinline__ int meta_row(int lane) { return ((lane >> 5) & 1) * 8 + ((lane >> 4) & 1) * 4 + ((lane >> 3) & 1) * 2 + ((lane >> 2) & 1); }
template <int KPL> __device__ __forceinline__ float meta_col(const LAS unsigned char* A, const bf16* wrow, int lane) {
    constexpr int K = 64 * KPL; float w[KPL];
#pragma unroll
    for (int j = 0; j < KPL / 8; ++j) { const v4u x = *(const GAS v4u*)(wrow + lane * KPL + 8 * j);
        w[8 * j] = bflo(x.x); w[8 * j + 1] = bfhi(x.x); w[8 * j + 2] = bflo(x.y); w[8 * j + 3] = bfhi(x.y); w[8 * j + 4] = bflo(x.z); w[8 * j + 5] = bfhi(x.z); w[8 * j + 6] = bflo(x.w); w[8 * j + 7] = bfhi(x.w); }
    float p[16];
#pragma unroll
    for (int r = 0; r < 16; ++r) { float s = 0.f;
#pragma unroll
        for (int j = 0; j < KPL / 8; ++j) { const v4u a = *(const LAS v4u*)(A + (r * K + lane * KPL + 8 * j) * 2);
            s += (bflo(a.x) * w[8 * j] + bfhi(a.x) * w[8 * j + 1]) + (bflo(a.y) * w[8 * j + 2] + bfhi(a.y) * w[8 * j + 3]) + (bflo(a.z) * w[8 * j + 4] + bfhi(a.z) * w[8 * j + 5]) + (bflo(a.w) * w[8 * j + 6] + bfhi(a.w) * w[8 * j + 7]); }
        p[r] = s; if ((r & 3) == 3) asm volatile("" ::: "memory"); }
    const bool b32 = lane & 32, b16 = lane & 16, b8 = lane & 8, b4 = lane & 4;
    float q8[8], q4[4], q2[2];
#pragma unroll
    for (int i = 0; i < 8; ++i) { const float keep = b32 ? p[i + 8] : p[i], send = b32 ? p[i] : p[i + 8]; q8[i] = keep + __shfl_xor(send, 32); }
#pragma unroll
    for (int i = 0; i < 4; ++i) { const float keep = b16 ? q8[i + 4] : q8[i], send = b16 ? q8[i] : q8[i + 4]; q4[i] = keep + __shfl_xor(send, 16); }
#pragma unroll
    for (int i = 0; i < 2; ++i) { const float keep = b8 ? q4[i + 2] : q4[i], send = b8 ? q4[i] : q4[i + 2]; q2[i] = keep + __shfl_xor(send, 8); }
    float v = (b4 ? q2[1] : q2[0]) + __shfl_xor(b4 ? q2[0] : q2[1], 4);
    v += __shfl_xor(v, 2); v += __shfl_xor(v, 1);
    return v;
}
__device__ __forceinline__ void meta_stage(Frame& F, LAS unsigned char* dst, const bf16* src, int K) {
    v4u t[4]; const int n = 16 * K / 8;
#pragma unroll
    for (int q = 0; q < 4; ++q) { const int u = F.tid + q * NTHREADS; if (u < n) t[q] = *(const GAS v4u*)(src + (size_t)u * 8); }
#pragma unroll
    for (int q = 0; q < 4; ++q) { const int u = F.tid + q * NTHREADS; if (u < n) *(LAS v4u*)(dst + u * 16) = t[q]; }
}
__device__ __forceinline__ void meta_proj(Frame& F) {
    unsigned char* ws = F.ws; const bf16* WIN = (const bf16*)(ws + WS_WIN); const float* lbl = F.in[IN_LBL];
    LAS unsigned char* A = F.lds + RING_OFF;
    __syncthreads(); meta_stage(F, A, (const bf16*)(ws + WS_XN0) + (size_t)NTOK * D, D); __syncthreads();
    for (int c = F.vcu * NWAVES + F.wave; c < NPROJ; c += F.G * NWAVES) {
        const float v = meta_col<16>(A, WIN + (size_t)c * D, F.lane);
        if ((F.lane & 3) == 0) { const size_t row = NTOK + meta_row(F.lane); const int kind = c < 3072 ? (c >> 9) : 6, cc = c & 511;
            if (kind == 0) ((bf16*)(ws + WS_HQ))[row * HW + cc] = (bf16)f2bf(fsilu(v));
            else if (kind == 1) { const float lb = fsigmoid(lbl[cc] - lbl[HW + cc]); ((bf16*)(ws + WS_HG))[row * HW + cc] = (bf16)f2bf(__logf(lb + (1.f - lb) * fsigmoid(v))); }
            else if (kind == 2) ((bf16*)(ws + WS_HV))[row * HW + cc] = (bf16)f2bf(v);
            else if (kind == 3) ((bf16*)(ws + WS_HGATE))[row * HW + cc] = (bf16)f2bf(fsilu(v));
            else if (kind == 4) ((bf16*)(ws + WS_MM))[row * HW + cc] = (bf16)f2bf(v);
            else if (kind == 5) ((bf16*)(ws + WS_MO))[row * HW + cc] = (bf16)f2bf(fsigmoid(v));
            else (ws + WS_GATES)[row * 2048 + pg8::gate_pos(c - 3072)] = (unsigned char)(__builtin_bit_cast(unsigned, __builtin_fmaf(fsigmoid(v), 255.f, 8388608.f)) & 0xffu); } }
}
__device__ __forceinline__ void meta_merged(Frame& F) {
    unsigned char* ws = F.ws; const unsigned char* GATES = ws + WS_GATES;
    LAS unsigned char* A0 = F.lds + RING_OFF; LAS unsigned char* A1 = A0 + 16 * HW * 2;
    __syncthreads(); meta_stage(F, A0, (const bf16*)(ws + WS_YHG) + (size_t)NTOK * HW, HW); meta_stage(F, A1, (const bf16*)(ws + WS_YML) + (size_t)NTOK * HW, HW); __syncthreads();
    for (int c = F.vcu * NWAVES + F.wave; c < D; c += F.G * NWAVES) {
        const float vh = meta_col<8>(A0, (const bf16*)(ws + WS_WBH) + (size_t)c * HW, F.lane), vm = meta_col<8>(A1, (const bf16*)(ws + WS_WBM) + (size_t)c * HW, F.lane);
        if ((F.lane & 3) == 0) { const size_t row = NTOK + meta_row(F.lane); ((bf16*)(ws + WS_MERGED))[row * D + c] = (bf16)f2bf((float)GATES[row * 2048 + pg8::gate_pos(c)] * vh + (float)GATES[row * 2048 + pg8::gate_pos(D + c)] * vm); } }
}
__device__ __forceinline__ void meta_wout(Frame& F) {
    unsigned char* ws = F.ws; LAS unsigned char* A = F.lds + RING_OFF;
    __syncthreads(); meta_stage(F, A, (const bf16*)(ws + WS_MERGED) + (size_t)NTOK * D, D); __syncthreads();
    for (int c = F.vcu * NWAVES + F.wave; c < D; c += F.G * NWAVES) {
        const float d = meta_col<16>(A, (const bf16*)(ws + WS_WOUT) + (size_t)c * D, F.lane);
        if ((F.lane & 3) == 0) { const int mr_ = meta_row(F.lane); const size_t row = NTOK + mr_; const float v = F.in[IN_META][(size_t)mr_ * D + c] + d;
            ((bf16*)(ws + WS_H1))[row * D + c] = (bf16)f2bf(v); ((unsigned char*)(ws + WS_H1B))[row * D + c] = (unsigned char)(__builtin_amdgcn_cvt_pk_fp8_f32(__builtin_amdgcn_fmed3f(v, -448.f, 448.f), 0.f, 0u, false) & 0xffu); } }
}

__device__ __forceinline__ void ph_proj(Frame& F) {
    unsigned char* ws = F.ws;
    pg8::Gemm g{(const pg8::bf16_t*)(ws + WS_XN0), (const pg8::bf16_t*)(ws + WS_WIN), NTOK, NPROJ, D}; pg8::StaticOrder S; S.init(NTOK, NPROJ, F.G, (int)blockIdx.x);
    pg8::EpiProj E{ws, F.in[IN_LBL]};
    pg8::gemm_phase<pg8::EpiProj, pg8::StaticOrder, true, true>(F.lds + RING_OFF, g, S, E);
    meta_proj(F);
}
__device__ __forceinline__ void ph_scan(Frame& F) {
    const int sb = (int)blockIdx.x;
    if (sb < 64) p3_hgrn2_mfma(F, sb); else if (sb < 128) p3_mlstm_mfma(F, sb - 64);
#if !CONV_IN_P0
    else px_experts(F, sb - 128, F.G - 128);
#endif
}
__device__ __forceinline__ void ph_merged(Frame& F) {
    unsigned char* ws = F.ws;
    static_assert(WS_YML - WS_YHG == (size_t)pg8::PAIR_DA * 256 * HW * 2 && WS_WBM - WS_WBH == (size_t)pg8::PAIR_DB * 256 * HW * 2, "the second branch's operands sit a whole number of tiles behind the first's");
    pg8::PairOrder S; S.S.init(NTOK, D, F.G, (int)blockIdx.x);
    pg8::Gemm g{(const pg8::bf16_t*)(ws + WS_YHG), (const pg8::bf16_t*)(ws + WS_WBH), NTOK, D, HW};
    pg8::EpiGate2 E{(const unsigned char*)(ws + WS_GATES), (pg8::bf16_t*)(ws + WS_TMP), (pg8::bf16_t*)(ws + WS_MERGED)};
    pg8::gemm_phase<pg8::EpiGate2, pg8::PairOrder, true, true>(F.lds + RING_OFF, g, S, E);
    meta_merged(F);
}
__device__ __forceinline__ void ph_wout(Frame& F) {
    unsigned char* ws = F.ws;
    pg8::Gemm g{(const pg8::bf16_t*)(ws + WS_MERGED), (const pg8::bf16_t*)(ws + WS_WOUT), NTOK, D, D}; pg8::StaticOrder S; S.init(NTOK, D, F.G, (int)blockIdx.x);
    pg8::EpiH1 E{(const pg8::bf16_t*)(ws + WS_XN0), (const float*)(ws + WS_XSQ), (pg8::bf16_t*)(ws + WS_H1), (unsigned char*)(ws + WS_H1B)};
    pg8::gemm_phase<pg8::EpiH1, pg8::StaticOrder, true, true>(F.lds + RING_OFF, g, S, E);
    meta_wout(F);
}
__device__ __forceinline__ void ph_gu(Frame& F) {
    unsigned char* ws = F.ws; build_tables(F);
    const LAS int* pst = (const LAS int*)(F.lds + PST_OFF); LAS unsigned short* tok16 = (LAS unsigned short*)(F.lds + TOK_OFF);
    pg8::Gemm g{(const pg8::bf16_t*)(ws + WS_H1B), (const pg8::bf16_t*)(ws + WS_WGU), NV, NE * 2 * DFF, D / 2};
    pg8::GroupOrder S{pst[32], 8, F.G, (int)blockIdx.x, (const LAS unsigned char*)(F.lds + TEXP_OFF)};
    { const int* ETOK = (const int*)(ws + WS_ETOK);
      int tokv[18];
#pragma unroll
      for (int i = 0; i < 18; ++i) { pg8::Unit u; int t = 0; if (S.next(i, u) && F.tid < 256) { const int e = u.pn >> 3, pos = u.pm * 256 - pst[e] + F.tid; if (pos < pst[33 + e]) t = ETOK[(size_t)e * NV + pos]; } tokv[i] = t; }
      if (F.tid < 256) {
#pragma unroll
          for (int i = 0; i < 18; ++i) tok16[i * 256 + F.tid] = (unsigned short)tokv[i]; }
      __syncthreads(); }
    pg8::EpiGU E{(const float*)(ws + WS_BGUP), (const float*)(ws + WS_ERS), (unsigned char*)(ws + WS_ACT), pst};
    pg8::gemm_phase_g<pg8::EpiGU, pg8::GroupOrder, true>(F.lds + RING_OFF, g, S, E, tok16);
}
__device__ __forceinline__ void ph_down(Frame& F) {
    unsigned char* ws = F.ws; build_tables(F);
    pg8::Gemm g{(const pg8::bf16_t*)(ws + WS_ACT), (const pg8::bf16_t*)(ws + WS_WDN), MAXTILES * 256, NE * D, DFF / 2};
    pg8::GroupOrder S{((const LAS int*)(F.lds + PST_OFF))[32], 4, F.G, (int)blockIdx.x, (const LAS unsigned char*)(F.lds + TEXP_OFF)};
    pg8::EpiDown E{F.in[IN_BDN], (const float*)(ws + WS_EW), (unsigned char*)(ws + WS_YB), (const LAS int*)(F.lds + PST_OFF)};
    pg8::gemm_phase<pg8::EpiDown, pg8::GroupOrder, true, true, true>(F.lds + RING_OFF, g, S, E);
}

#ifndef CONV_IN_P0
#define CONV_IN_P0 0
#endif
#ifndef PROBE_DOUBLE
#define PROBE_DOUBLE 0
#endif
#define DBL(k) ((PROBE_DOUBLE >> (k)) & 1)
#ifndef MK_N_LAUNCHES
#define MK_N_LAUNCHES 1
#endif
constexpr int NPHASE = 9;
struct Args { const float* in[25]; float* out; unsigned char* ws; int ph_lo, ph_hi, li, pad; };
__global__ void __launch_bounds__(NTHREADS, 2) fwd_kernel(Args args) {
    extern __shared__ __attribute__((aligned(16))) unsigned char lds[];
    Frame F;
    F.lds = (LAS unsigned char*)lds; F.MISC = (volatile LAS unsigned*)(F.lds + MISC_OFF);
    F.tid = threadIdx.x; F.lane = F.tid & 63; F.wave = __builtin_amdgcn_readfirstlane(F.tid >> 6);
    F.G = gridDim.x; { const int bx = blockIdx.x; F.vcu = (F.G % 8 == 0) ? (bx % 8) * (F.G / 8) + bx / 8 : bx; }
    F.ws = args.ws; F.ctl = (gu32*)(args.ws + WS_CTL); F.out = args.out;
#pragma unroll
    for (int i = 0; i < 25; ++i) F.in[i] = args.in[i];
    { int t0 = F.tid; asm volatile("" : "+v"(t0)); if (t0 < 64) F.MISC[t0] = 0u; }
    __syncthreads();
    const int lo = args.ph_lo, hi = args.ph_hi;
    XcdBarrier bar; bar.bar = (unsigned*)(F.ctl + CW_BAR) + args.li * XCD_BAR_WORDS; bar.x = 0; bar.st = nullptr;
    if (hi - lo > 1) bar = xcd_barrier_post((unsigned*)(F.ctl + CW_BAR) + args.li * XCD_BAR_WORDS, F.MISC + 8);
#define IN(k) (lo <= (k) && (k) < hi)
#define SEAM(k) do { if (IN(k) && IN((k) + 1)) xcd_barrier(bar); } while (0)

    if (IN(0)) { p0_prologue(F);
#if CONV_IN_P0
        __syncthreads(); px_experts(F, F.vcu, F.G);
#endif
    } SEAM(0);
    if (IN(1)) { ph_proj(F); } SEAM(1);
    if (IN(2)) { ph_scan(F); } SEAM(2);
    if (IN(3)) { ph_merged(F); } SEAM(3);
    if (IN(4)) { ph_wout(F); } SEAM(4);
    if (IN(5)) { p6_router(F); } SEAM(5);
    if (IN(6)) { ph_gu(F); } SEAM(6);
    if (IN(7)) { ph_down(F); } SEAM(7);
    if (IN(8)) { p10_combine(F); }
#undef IN
#undef SEAM
}

extern "C" void kernel_launch(void* const* d_in, const int* in_sizes, int n_in, void* d_out, int out_size, void* d_ws, size_t ws_size, hipStream_t stream) {
    static int grid = 0;
    if (grid == 0) {
        if (n_in != 25 || in_sizes[0] != BATCH * SEQ * D || out_size != BATCH * SEQ * D || ws_size < WS_END) { fprintf(stderr, "kernel_launch: unexpected shapes (n_in %d, in0 %d, out %d, ws %zu); nothing launched\n", n_in, n_in > 0 ? in_sizes[0] : -1, out_size, ws_size); grid = -1; return; }
        int dev = 0, cus = 0, per_cu = 0;
        if (hipGetDevice(&dev) != hipSuccess || hipDeviceGetAttribute(&cus, hipDeviceAttributeMultiprocessorCount, dev) != hipSuccess) { grid = -1; return; }
        if (hipFuncSetAttribute((const void*)fwd_kernel, hipFuncAttributeMaxDynamicSharedMemorySize, LDS_BYTES) != hipSuccess) { fprintf(stderr, "kernel_launch: hipFuncSetAttribute failed\n"); grid = -1; return; }
        if (hipOccupancyMaxActiveBlocksPerMultiprocessor(&per_cu, (const void*)fwd_kernel, NTHREADS, LDS_BYTES) != hipSuccess || per_cu < 1) { fprintf(stderr, "kernel_launch: occupancy query reports %d blocks per CU\n", per_cu); }
        (void)hipGetLastError();
        grid = 256;
        if (cus < 256) { fprintf(stderr, "kernel_launch: %d CUs < 256: the grid would not be resident; nothing launched\n", cus); grid = -1; return; }
    }
    if (grid < 0) return;
    if (hipMemsetAsync((char*)d_ws + WS_CTL, 0, CTL_ZERO_BYTES, stream) != hipSuccess) return;
    Args a{};
    for (int i = 0; i < 25; ++i) a.in[i] = (const float*)d_in[i];
    a.out = (float*)d_out; a.ws = (unsigned char*)d_ws; a.pad = 0;
#if MK_N_LAUNCHES == 1
    a.ph_lo = 0; a.ph_hi = NPHASE; a.li = 0;
    hipLaunchKernelGGL(fwd_kernel, dim3(grid), dim3(NTHREADS), LDS_BYTES, stream, a);
#else
    for (int p = 0; p < NPHASE; ++p) for (int rep = 0; rep <= DBL(p); ++rep) { a.ph_lo = p; a.ph_hi = p + 1; a.li = 0; hipLaunchKernelGGL(fwd_kernel, dim3(grid), dim3(NTHREADS), LDS_BYTES, stream, a); }
#endif
}
```

```cpp
#include <hip/hip_runtime.h>
#include <cstdio>
#include <cstdint>
namespace pg8 {
#define PG8_LAS __attribute__((address_space(3)))
typedef unsigned short bf16_t;
typedef short bf16x8 __attribute__((ext_vector_type(8)));
typedef float f32x4 __attribute__((ext_vector_type(4)));
typedef unsigned u32x4 __attribute__((ext_vector_type(4)));
constexpr int BM = 256, BK = 64, HALF = 128, HTB = HALF * BK * 2  , STAGE_BYTES = 8 * HTB, NXCD = 8, WGM = 8;

__host__ __device__ __forceinline__ int lds_byte(int r, int c) { const int st = (r >> 4) * 2 + (c >> 5), rr = r & 15, cc = c & 31, ob = rr * 64 + cc * 2; return st * 1024 + (ob ^ (((ob >> 9) & 1) << 5)); }
__host__ __device__ __forceinline__ void stage_rc(int b, int& R, int& C) { const int st = b / 1024, sb = b % 1024, swz = sb ^ (((sb >> 9) & 1) << 5); R = (st >> 1) * 16 + swz / 64; C = (st & 1) * 32 + (swz % 64) / 2; }
__host__ __device__ __forceinline__ int perm32(int rho) { const int n = rho >> 4, i = rho & 15; return 8 * (i >> 2) + 4 * n + (i & 3); }

struct Unit { int pm, pn; };
struct Gemm { const bf16_t* A; const bf16_t* Bt; int M, N, K; };

struct StaticOrder {
    int nM, nN, nwg, G, c;
    __host__ __device__ void init(int M, int N, int G_, int c_) { nM = M / BM; nN = N / BM; nwg = nM * nN; G = G_; c = c_; }
    __host__ __device__ __forceinline__ bool next(int i, Unit& u) const {
        const long L = (long)i * G + c; if (L >= nwg) return false;
        int wgid = (int)L; { const int q = nwg / NXCD, r = nwg % NXCD, xcd = wgid % NXCD, off = wgid / NXCD; wgid = (xcd < r ? xcd * (q + 1) : r * (q + 1) + (xcd - r) * q) + off; }
        const int nig = WGM * nN, gid = wgid / nig, fm = gid * WGM, gsz = (nM - fm) < WGM ? (nM - fm) : WGM;
        u.pm = fm + ((wgid % nig) % gsz); u.pn = (wgid % nig) / gsz; return true;
    }
    __device__ __forceinline__ void a_ready(const Unit&) const {}
    __device__ __forceinline__ void done(const Unit&) const {}
};

typedef __bf16 bf16v2 __attribute__((ext_vector_type(2)));
typedef float f32v2 __attribute__((ext_vector_type(2)));
__device__ __forceinline__ unsigned cvt_pk_bf16(float lo, float hi) { const f32v2 v = {lo, hi}; return __builtin_bit_cast(unsigned, __builtin_convertvector(v, bf16v2)); }
typedef float f32x2 __attribute__((ext_vector_type(2)));
typedef int i32x4 __attribute__((ext_vector_type(4)));
typedef int i32x8 __attribute__((ext_vector_type(8)));
__device__ __forceinline__ i32x8 cat8(const bf16x8 a, const bf16x8 b) { const i32x4 x = __builtin_bit_cast(i32x4, a), y = __builtin_bit_cast(i32x4, b); return __builtin_shufflevector(x, y, 0, 1, 2, 3, 4, 5, 6, 7); }
template <class Epi, class Sched, bool ALIGN_EPI = false, bool SP2 = false, bool FP8 = false, bool I8 = false>
__device__ __forceinline__ void gemm_phase(PG8_LAS unsigned char* lds, const Gemm g, const Sched& S, const Epi& E) {
    const int tid = threadIdx.x, wid = __builtin_amdgcn_readfirstlane(tid >> 6), lane = tid & 63, wr = wid >> 2, wc = wid & 3, fr = lane & 15, fq = lane >> 4;
    const int K = g.K, nt = K / BK;
    unsigned voffA[2], voffB[2];
#pragma unroll
    for (int i = 0; i < 2; ++i) { int R, C; stage_rc(tid * 16 + i * 8192, R, C); const int Rb = Epi::PERM ? ((R & ~31) + perm32(R & 31)) : R;
        voffA[i] = (unsigned)(R * K + C) * 2u; voffB[i] = (unsigned)(Rb * K + C) * 2u; }
    const size_t kstep = (size_t)(BK * 2);
    const size_t hstep = (size_t)HALF * K * 2;
    const size_t tstep = 2 * hstep;
    const unsigned ldsw = (unsigned)wid * 1024u;
    const int aoff = lds_byte(wr * 64 + fr, fq * 8), boff = lds_byte(wc * 32 + fr, fq * 8);
#define PG8_SA(b, h) (((b) * 2 + (h)) * HTB)
#define PG8_SB(b, h) ((4 + (b) * 2 + (h)) * HTB)
#define PG8_STAGE(bufoff, gbase, voff) do { _Pragma("unroll") for (int _i = 0; _i < 2; ++_i) \
        __builtin_amdgcn_global_load_lds((const unsigned*)((const char*)(gbase) + (voff)[_i]), (PG8_LAS unsigned*)(lds + (bufoff) + ldsw + _i * 8192), 16, 0, 0); } while (0)
#define PG8_LDA(dst, b, h) do { _Pragma("unroll") for (int m = 0; m < 4; ++m) { if constexpr (FP8) dst##8[m] = cat8(*(const PG8_LAS bf16x8*)(lds + PG8_SA(b, h) + aoff + m * 2048), *(const PG8_LAS bf16x8*)(lds + PG8_SA(b, h) + aoff + m * 2048 + 1024)); \
        else { _Pragma("unroll") for (int k = 0; k < 2; ++k) dst[m][k] = *(const PG8_LAS bf16x8*)(lds + PG8_SA(b, h) + aoff + m * 2048 + k * 1024); } } } while (0)
#define PG8_LDB(dst, b, h) do { _Pragma("unroll") for (int n = 0; n < 2; ++n) { if constexpr (FP8) dst##8[n] = cat8(*(const PG8_LAS bf16x8*)(lds + PG8_SB(b, h) + boff + n * 2048), *(const PG8_LAS bf16x8*)(lds + PG8_SB(b, h) + boff + n * 2048 + 1024)); \
        else { _Pragma("unroll") for (int k = 0; k < 2; ++k) dst[n][k] = *(const PG8_LAS bf16x8*)(lds + PG8_SB(b, h) + boff + n * 2048 + k * 1024); } } } while (0)
#define PG8_MMA(ai, bj, At, Bt) do { __builtin_amdgcn_s_setprio(1); _Pragma("unroll") for (int m = 0; m < 4; ++m) _Pragma("unroll") for (int n = 0; n < 2; ++n) { \
        if constexpr (FP8) acc[ai][bj][m][n] = __builtin_amdgcn_mfma_scale_f32_16x16x128_f8f6f4(Bt##8[n], At##8[m], acc[ai][bj][m][n], 0, 0, 0, 0x7f7f7f7f, 0, 0x7f7f7f7f); \
        else if constexpr (I8) { _Pragma("unroll") for (int k = 0; k < 2; ++k) acc[ai][bj][m][n] = __builtin_bit_cast(f32x4, __builtin_amdgcn_mfma_i32_16x16x64_i8(__builtin_bit_cast(i32x4, Bt[n][k]), __builtin_bit_cast(i32x4, At[m][k]), __builtin_bit_cast(i32x4, acc[ai][bj][m][n]), 0, 0, 0)); } \
        else { _Pragma("unroll") for (int k = 0; k < 2; ++k) acc[ai][bj][m][n] = __builtin_amdgcn_mfma_f32_16x16x32_bf16(Bt[n][k], At[m][k], acc[ai][bj][m][n], 0, 0, 0); } } \
        if constexpr (FP8) { _Pragma("unroll") for (int m = 0; m < 4; ++m) _Pragma("unroll") for (int n = 0; n < 2; ++n) asm volatile("" : "+v"(acc[ai][bj][m][n])); }     \
        __builtin_amdgcn_s_setprio(0); } while (0)
#define PG8_WAIT_V(n) asm volatile("s_waitcnt vmcnt(" #n ")" ::: "memory")
#define PG8_WAIT_L(n) asm volatile("s_waitcnt lgkmcnt(" #n ")" ::: "memory")
#define PG8_BAR __builtin_amdgcn_s_barrier()
#define PG8_SCHED __builtin_amdgcn_sched_barrier(0)
    Unit cur, nxt; int ui = 0;
    if (!S.next(0, cur)) return;
    f32x4 acc[2][2][4][2];
#pragma unroll
    for (int a = 0; a < 2; ++a)
#pragma unroll
        for (int b = 0; b < 2; ++b)
#pragma unroll
            for (int m = 0; m < 4; ++m)
#pragma unroll
                for (int n = 0; n < 2; ++n) acc[a][b][m][n] = (f32x4){0.f, 0.f, 0.f, 0.f};
    bf16x8 At[4][2], B0[2][2], B1[2][2]; i32x8 At8[4], B08[2], B18[2];
    const char* cA = (const char*)g.A + (size_t)cur.pm * tstep; const char* cB = (const char*)g.Bt + (size_t)cur.pn * tstep;
    S.a_ready(cur);
    if constexpr (SP2) {
        PG8_STAGE(PG8_SB(0, 0), cB, voffB); PG8_STAGE(PG8_SB(0, 1), cB + hstep, voffB); PG8_STAGE(PG8_SA(0, 0), cA, voffA); PG8_STAGE(PG8_SA(0, 1), cA + hstep, voffA);
        if (wr == 1) PG8_BAR;
        PG8_WAIT_V(2); PG8_BAR;
        PG8_STAGE(PG8_SB(1, 0), cB + kstep, voffB); PG8_STAGE(PG8_SA(1, 0), cA + kstep, voffA); PG8_STAGE(PG8_SB(1, 1), cB + hstep + kstep, voffB);
        PG8_WAIT_V(6); PG8_BAR;
    } else {
        PG8_STAGE(PG8_SB(0, 0), cB, voffB); PG8_STAGE(PG8_SA(0, 0), cA, voffA); PG8_STAGE(PG8_SB(0, 1), cB + hstep, voffB); PG8_STAGE(PG8_SA(0, 1), cA + hstep, voffA);
        if (wr == 1) PG8_BAR;
        PG8_WAIT_V(4); PG8_BAR;
        PG8_STAGE(PG8_SB(1, 0), cB + kstep, voffB); PG8_STAGE(PG8_SA(1, 0), cA + kstep, voffA); PG8_STAGE(PG8_SB(1, 1), cB + hstep + kstep, voffB);
        PG8_WAIT_V(6); PG8_BAR;
    }
    for (;;) {
        const bool has_next = S.next(ui + 1, nxt);
        const char* nA = has_next ? (const char*)g.A + (size_t)nxt.pm * tstep : cA; const char* nB = has_next ? (const char*)g.Bt + (size_t)nxt.pn * tstep : cB;
        for (int t = 0; t < nt; t += 2) {
            const bool last = (t == nt - 2);
            const char* a1 = cA + (size_t)(t + 1) * kstep;
            const char* a2 = last ? nA : cA + (size_t)(t + 2) * kstep; const char* b2 = last ? nB : cB + (size_t)(t + 2) * kstep;
            const char* a3 = a2 + kstep; const char* b3 = b2 + kstep;
            if (last && has_next) S.a_ready(nxt);
            if constexpr (SP2) {
            PG8_LDB(B0, 0, 0); PG8_LDB(B1, 0, 1); PG8_SCHED; PG8_LDA(At, 0, 0); PG8_STAGE(PG8_SA(1, 1), a1 + hstep, voffA);
            PG8_WAIT_V(8); PG8_WAIT_L(0); PG8_BAR; PG8_MMA(0, 0, At, B0); PG8_MMA(0, 1, At, B1); PG8_BAR; PG8_SCHED;
            PG8_LDA(At, 0, 1); PG8_STAGE(PG8_SB(0, 0), b2, voffB); PG8_STAGE(PG8_SB(0, 1), b2 + hstep, voffB); PG8_STAGE(PG8_SA(0, 0), a2, voffA);
            PG8_WAIT_V(8); PG8_WAIT_L(0); PG8_BAR; PG8_MMA(1, 0, At, B0); PG8_MMA(1, 1, At, B1); PG8_BAR; PG8_SCHED;
            PG8_LDB(B0, 1, 0); PG8_LDB(B1, 1, 1); PG8_SCHED; PG8_LDA(At, 1, 0); PG8_STAGE(PG8_SA(0, 1), a2 + hstep, voffA);
            PG8_WAIT_V(8); PG8_WAIT_L(0); PG8_BAR; PG8_MMA(0, 0, At, B0); PG8_MMA(0, 1, At, B1); PG8_BAR; PG8_SCHED;
            PG8_LDA(At, 1, 1); PG8_STAGE(PG8_SB(1, 0), b3, voffB); PG8_STAGE(PG8_SB(1, 1), b3 + hstep, voffB); PG8_STAGE(PG8_SA(1, 0), a3, voffA);
            PG8_WAIT_V(8); PG8_WAIT_L(0); PG8_BAR; PG8_MMA(1, 0, At, B0); PG8_MMA(1, 1, At, B1); PG8_BAR; PG8_SCHED;
            } else {
            PG8_LDB(B0, 0, 0); PG8_SCHED; PG8_LDA(At, 0, 0); PG8_STAGE(PG8_SA(1, 1), a1 + hstep, voffA);
            PG8_WAIT_L(8); PG8_BAR; PG8_WAIT_L(0); PG8_MMA(0, 0, At, B0); PG8_BAR; PG8_SCHED;
            PG8_LDB(B1, 0, 1); PG8_STAGE(PG8_SB(0, 0), b2, voffB);
            PG8_BAR; PG8_WAIT_L(0); PG8_MMA(0, 1, At, B1); PG8_BAR;
            PG8_LDA(At, 0, 1); PG8_STAGE(PG8_SA(0, 0), a2, voffA);
            PG8_BAR; PG8_WAIT_L(0); PG8_MMA(1, 0, At, B0); PG8_BAR; PG8_SCHED;
            PG8_STAGE(PG8_SB(0, 1), b2 + hstep, voffB);
            PG8_WAIT_V(6); PG8_BAR; PG8_MMA(1, 1, At, B1); PG8_BAR;
            PG8_LDB(B0, 1, 0); PG8_SCHED; PG8_LDA(At, 1, 0); PG8_STAGE(PG8_SA(0, 1), a2 + hstep, voffA);
            PG8_WAIT_L(8); PG8_BAR; PG8_WAIT_L(0); PG8_MMA(0, 0, At, B0); PG8_BAR; PG8_SCHED;
            PG8_LDB(B1, 1, 1); PG8_STAGE(PG8_SB(1, 0), b3, voffB);
            PG8_BAR; PG8_WAIT_L(0); PG8_MMA(0, 1, At, B1); PG8_BAR;
            PG8_LDA(At, 1, 1); PG8_STAGE(PG8_SA(1, 0), a3, voffA);
            PG8_BAR; PG8_WAIT_L(0); PG8_MMA(1, 0, At, B0); PG8_BAR; PG8_SCHED;
            PG8_STAGE(PG8_SB(1, 1), b3 + hstep, voffB);
            PG8_WAIT_V(6); PG8_BAR; PG8_MMA(1, 1, At, B1); PG8_BAR;
            }
        }
        if constexpr (ALIGN_EPI) { if (wr == 0) PG8_BAR; }
        if constexpr (!Epi::AFTER_DRAIN) { E(acc, cur, wr, wc, fr, fq); S.done(cur); }
        if (!has_next) break;
#pragma unroll
        for (int a = 0; a < 2; ++a)
#pragma unroll
            for (int b = 0; b < 2; ++b)
#pragma unroll
                for (int m = 0; m < 4; ++m)
#pragma unroll
                    for (int n = 0; n < 2; ++n) acc[a][b][m][n] = (f32x4){0.f, 0.f, 0.f, 0.f};
        cur = nxt; cA = nA; cB = nB; ++ui;
        if constexpr (ALIGN_EPI) { if (wr == 1) PG8_BAR; }
    }
    PG8_WAIT_V(0);
    if constexpr (!ALIGN_EPI) { if (wr == 0) PG8_BAR; }
    PG8_BAR;
    if constexpr (Epi::AFTER_DRAIN) { E.fused(acc, cur, wr, wc, fr, fq, lds, wid, lane); S.done(cur); }
#undef PG8_SA
#undef PG8_SB
#undef PG8_STAGE
#undef PG8_LDA
#undef PG8_LDB
#undef PG8_MMA
#undef PG8_WAIT_V
#undef PG8_WAIT_L
#undef PG8_BAR
#undef PG8_SCHED
}
template <class Epi, class Sched, bool FP8 = false>
__device__ __forceinline__ void gemm_phase_g(PG8_LAS unsigned char* lds, const Gemm g, const Sched& S, const Epi& E, const PG8_LAS unsigned short* tok16) {
    constexpr bool ALIGN_EPI = true, SP2 = true;
    const int tid = threadIdx.x, wid = __builtin_amdgcn_readfirstlane(tid >> 6), lane = tid & 63, wr = wid >> 2, wc = wid & 3, fr = lane & 15, fq = lane >> 4;
    const int K = g.K, nt = K / BK;
    unsigned voffB[2]; int RA[2]; unsigned CA[2];
#pragma unroll
    for (int i = 0; i < 2; ++i) { int R, C; stage_rc(tid * 16 + i * 8192, R, C); const int Rb = Epi::PERM ? ((R & ~31) + perm32(R & 31)) : R;
        RA[i] = R; CA[i] = (unsigned)C * 2u; voffB[i] = (unsigned)(Rb * K + C) * 2u; }
    unsigned oc[2][2];
#define PG8_TOKS(dst, ui_) do { _Pragma("unroll") for (int _h = 0; _h < 2; ++_h) _Pragma("unroll") for (int _i = 0; _i < 2; ++_i) \
        dst[_h][_i] = (unsigned)tok16[(ui_) * 256 + _h * HALF + RA[_i]] * (unsigned)(K * 2) + CA[_i]; } while (0)
    const size_t kstep = (size_t)(BK * 2);
    const size_t hstep = (size_t)HALF * K * 2;
    const size_t tstep = 2 * hstep;
    const unsigned ldsw = (unsigned)wid * 1024u;
    const int aoff = lds_byte(wr * 64 + fr, fq * 8), boff = lds_byte(wc * 32 + fr, fq * 8);
#define PG8_SA(b, h) (((b) * 2 + (h)) * HTB)
#define PG8_SB(b, h) ((4 + (b) * 2 + (h)) * HTB)
#define PG8_STAGE(bufoff, gbase, voff) do { _Pragma("unroll") for (int _i = 0; _i < 2; ++_i) \
        __builtin_amdgcn_global_load_lds((const unsigned*)((const char*)(gbase) + (voff)[_i]), (PG8_LAS unsigned*)(lds + (bufoff) + ldsw + _i * 8192), 16, 0, 0); } while (0)
#define PG8_LDA(dst, b, h) do { _Pragma("unroll") for (int m = 0; m < 4; ++m) { if constexpr (FP8) dst##8[m] = cat8(*(const PG8_LAS bf16x8*)(lds + PG8_SA(b, h) + aoff + m * 2048), *(const PG8_LAS bf16x8*)(lds + PG8_SA(b, h) + aoff + m * 2048 + 1024)); \
        else { _Pragma("unroll") for (int k = 0; k < 2; ++k) dst[m][k] = *(const PG8_LAS bf16x8*)(lds + PG8_SA(b, h) + aoff + m * 2048 + k * 1024); } } } while (0)
#define PG8_LDB(dst, b, h) do { _Pragma("unroll") for (int n = 0; n < 2; ++n) { if constexpr (FP8) dst##8[n] = cat8(*(const PG8_LAS bf16x8*)(lds + PG8_SB(b, h) + boff + n * 2048), *(const PG8_LAS bf16x8*)(lds + PG8_SB(b, h) + boff + n * 2048 + 1024)); \
        else { _Pragma("unroll") for (int k = 0; k < 2; ++k) dst[n][k] = *(const PG8_LAS bf16x8*)(lds + PG8_SB(b, h) + boff + n * 2048 + k * 1024); } } } while (0)
#define PG8_MMA(ai, bj, At, Bt) do { __builtin_amdgcn_s_setprio(1); _Pragma("unroll") for (int m = 0; m < 4; ++m) _Pragma("unroll") for (int n = 0; n < 2; ++n) { \
        if constexpr (FP8) acc[ai][bj][m][n] = __builtin_amdgcn_mfma_scale_f32_16x16x128_f8f6f4(Bt##8[n], At##8[m], acc[ai][bj][m][n], 0, 0, 0, 0x7f7f7f7f, 0, 0x7f7f7f7f); \
        else { _Pragma("unroll") for (int k = 0; k < 2; ++k) acc[ai][bj][m][n] = __builtin_amdgcn_mfma_f32_16x16x32_bf16(Bt[n][k], At[m][k], acc[ai][bj][m][n], 0, 0, 0); } } \
        if constexpr (FP8) { _Pragma("unroll") for (int m = 0; m < 4; ++m) _Pragma("unroll") for (int n = 0; n < 2; ++n) asm volatile("" : "+v"(acc[ai][bj][m][n])); }     \
        __builtin_amdgcn_s_setprio(0); } while (0)
#define PG8_WAIT_V(n) asm volatile("s_waitcnt vmcnt(" #n ")" ::: "memory")
#define PG8_WAIT_L(n) asm volatile("s_waitcnt lgkmcnt(" #n ")" ::: "memory")
#define PG8_BAR __builtin_amdgcn_s_barrier()
#define PG8_SCHED __builtin_amdgcn_sched_barrier(0)
    Unit cur, nxt; int ui = 0;
    if (!S.next(0, cur)) return;
    f32x4 acc[2][2][4][2];
#pragma unroll
    for (int a = 0; a < 2; ++a)
#pragma unroll
        for (int b = 0; b < 2; ++b)
#pragma unroll
            for (int m = 0; m < 4; ++m)
#pragma unroll
                for (int n = 0; n < 2; ++n) acc[a][b][m][n] = (f32x4){0.f, 0.f, 0.f, 0.f};
    bf16x8 At[4][2], B0[2][2], B1[2][2]; i32x8 At8[4], B08[2], B18[2];
    const char* cA = (const char*)g.A; const char* cB = (const char*)g.Bt + (size_t)cur.pn * tstep; PG8_TOKS(oc, 0);
    S.a_ready(cur);
    if constexpr (SP2) {
        PG8_STAGE(PG8_SB(0, 0), cB, voffB); PG8_STAGE(PG8_SB(0, 1), cB + hstep, voffB); PG8_STAGE(PG8_SA(0, 0), cA, oc[0]); PG8_STAGE(PG8_SA(0, 1), cA, oc[1]);
        if (wr == 1) PG8_BAR;
        PG8_WAIT_V(2); PG8_BAR;
        PG8_STAGE(PG8_SB(1, 0), cB + kstep, voffB); PG8_STAGE(PG8_SA(1, 0), cA + kstep, oc[0]); PG8_STAGE(PG8_SB(1, 1), cB + hstep + kstep, voffB);
        PG8_WAIT_V(6); PG8_BAR;
    } else {
        PG8_STAGE(PG8_SB(0, 0), cB, voffB); PG8_STAGE(PG8_SA(0, 0), cA, oc[0]); PG8_STAGE(PG8_SB(0, 1), cB + hstep, voffB); PG8_STAGE(PG8_SA(0, 1), cA + hstep, oc[0]);
        if (wr == 1) PG8_BAR;
        PG8_WAIT_V(4); PG8_BAR;
        PG8_STAGE(PG8_SB(1, 0), cB + kstep, voffB); PG8_STAGE(PG8_SA(1, 0), cA + kstep, oc[0]); PG8_STAGE(PG8_SB(1, 1), cB + hstep + kstep, voffB);
        PG8_WAIT_V(6); PG8_BAR;
    }
    for (;;) {
        const bool has_next = S.next(ui + 1, nxt);
        const char* nB = has_next ? (const char*)g.Bt + (size_t)nxt.pn * tstep : cB;
        for (int t = 0; t < nt; t += 2) {
            const bool last = (t == nt - 2);
            const char* a1 = cA + (size_t)(t + 1) * kstep;
            const char* a2 = last ? cA : cA + (size_t)(t + 2) * kstep; const char* b2 = last ? nB : cB + (size_t)(t + 2) * kstep;
            unsigned o2[2][2]; if (last && has_next) PG8_TOKS(o2, ui + 1); else { _Pragma("unroll") for (int _h = 0; _h < 2; ++_h) _Pragma("unroll") for (int _i = 0; _i < 2; ++_i) o2[_h][_i] = oc[_h][_i]; }
            const char* a3 = a2 + kstep; const char* b3 = b2 + kstep;
            if (last && has_next) S.a_ready(nxt);
            if constexpr (SP2) {
            PG8_LDB(B0, 0, 0); PG8_LDB(B1, 0, 1); PG8_SCHED; PG8_LDA(At, 0, 0); PG8_STAGE(PG8_SA(1, 1), a1, oc[1]);
            PG8_WAIT_V(8); PG8_WAIT_L(0); PG8_BAR; PG8_MMA(0, 0, At, B0); PG8_MMA(0, 1, At, B1); PG8_BAR; PG8_SCHED;
            PG8_LDA(At, 0, 1); PG8_STAGE(PG8_SB(0, 0), b2, voffB); PG8_STAGE(PG8_SB(0, 1), b2 + hstep, voffB); PG8_STAGE(PG8_SA(0, 0), a2, o2[0]);
            PG8_WAIT_V(8); PG8_WAIT_L(0); PG8_BAR; PG8_MMA(1, 0, At, B0); PG8_MMA(1, 1, At, B1); PG8_BAR; PG8_SCHED;
            PG8_LDB(B0, 1, 0); PG8_LDB(B1, 1, 1); PG8_SCHED; PG8_LDA(At, 1, 0); PG8_STAGE(PG8_SA(0, 1), a2, o2[1]);
            PG8_WAIT_V(8); PG8_WAIT_L(0); PG8_BAR; PG8_MMA(0, 0, At, B0); PG8_MMA(0, 1, At, B1); PG8_BAR; PG8_SCHED;
            PG8_LDA(At, 1, 1); PG8_STAGE(PG8_SB(1, 0), b3, voffB); PG8_STAGE(PG8_SB(1, 1), b3 + hstep, voffB); PG8_STAGE(PG8_SA(1, 0), a3, o2[0]);
            PG8_WAIT_V(8); PG8_WAIT_L(0); PG8_BAR; PG8_MMA(1, 0, At, B0); PG8_MMA(1, 1, At, B1); PG8_BAR; PG8_SCHED;
            } else {
            PG8_LDB(B0, 0, 0); PG8_SCHED; PG8_LDA(At, 0, 0); PG8_STAGE(PG8_SA(1, 1), a1 + hstep, oc[0]);
            PG8_WAIT_L(8); PG8_BAR; PG8_WAIT_L(0); PG8_MMA(0, 0, At, B0); PG8_BAR; PG8_SCHED;
            PG8_LDB(B1, 0, 1); PG8_STAGE(PG8_SB(0, 0), b2, voffB);
            PG8_BAR; PG8_WAIT_L(0); PG8_MMA(0, 1, At, B1); PG8_BAR;
            PG8_LDA(At, 0, 1); PG8_STAGE(PG8_SA(0, 0), a2, oc[0]);
            PG8_BAR; PG8_WAIT_L(0); PG8_MMA(1, 0, At, B0); PG8_BAR; PG8_SCHED;
            PG8_STAGE(PG8_SB(0, 1), b2 + hstep, voffB);
            PG8_WAIT_V(6); PG8_BAR; PG8_MMA(1, 1, At, B1); PG8_BAR;
            PG8_LDB(B0, 1, 0); PG8_SCHED; PG8_LDA(At, 1, 0); PG8_STAGE(PG8_SA(0, 1), a2 + hstep, oc[0]);
            PG8_WAIT_L(8); PG8_BAR; PG8_WAIT_L(0); PG8_MMA(0, 0, At, B0); PG8_BAR; PG8_SCHED;
            PG8_LDB(B1, 1, 1); PG8_STAGE(PG8_SB(1, 0), b3, voffB);
            PG8_BAR; PG8_WAIT_L(0); PG8_MMA(0, 1, At, B1); PG8_BAR;
            PG8_LDA(At, 1, 1); PG8_STAGE(PG8_SA(1, 0), a3, oc[0]);
            PG8_BAR; PG8_WAIT_L(0); PG8_MMA(1, 0, At, B0); PG8_BAR; PG8_SCHED;
            PG8_STAGE(PG8_SB(1, 1), b3 + hstep, voffB);
            PG8_WAIT_V(6); PG8_BAR; PG8_MMA(1, 1, At, B1); PG8_BAR;
            }
        }
        if constexpr (ALIGN_EPI) { if (wr == 0) PG8_BAR; }
        if constexpr (!Epi::AFTER_DRAIN) { E(acc, cur, wr, wc, fr, fq); S.done(cur); }
        if (!has_next) break;
#pragma unroll
        for (int a = 0; a < 2; ++a)
#pragma unroll
            for (int b = 0; b < 2; ++b)
#pragma unroll
                for (int m = 0; m < 4; ++m)
#pragma unroll
                    for (int n = 0; n < 2; ++n) acc[a][b][m][n] = (f32x4){0.f, 0.f, 0.f, 0.f};
        cur = nxt; cB = nB; ++ui; PG8_TOKS(oc, ui);
        if constexpr (ALIGN_EPI) { if (wr == 1) PG8_BAR; }
    }
    PG8_WAIT_V(0);
    if constexpr (!ALIGN_EPI) { if (wr == 0) PG8_BAR; }
    PG8_BAR;
    if constexpr (Epi::AFTER_DRAIN) { E.fused(acc, cur, wr, wc, fr, fq, lds, wid, lane); S.done(cur); }
#undef PG8_TOKS
#undef PG8_SA
#undef PG8_SB
#undef PG8_STAGE
#undef PG8_LDA
#undef PG8_LDB
#undef PG8_MMA
#undef PG8_WAIT_V
#undef PG8_WAIT_L
#undef PG8_BAR
#undef PG8_SCHED
}
}

constexpr int BATCH = 16, SEQ = 2048, D = 1024, NMETA = 16;
constexpr int TV = SEQ + NMETA;
constexpr int NV = BATCH * TV;
constexpr int NTOK = BATCH * SEQ;
constexpr int NR = NTOK + NMETA;
constexpr int NIN = 5128, NPROJ = 5120;
constexpr int HW = 512;
constexpr int NE = 32, TOPK = 4, DFF = 1024;
constexpr int MAXTILES = 548;
constexpr float EPS = 1e-6f;
constexpr int NWAVES = 8, NTHREADS = 512;

constexpr size_t MiB = 1u << 20, KiB = 1u << 10;
constexpr size_t WS_CTL = 0, CTL_ZERO_BYTES = 1 * MiB;
constexpr size_t WS_WIN = 2 * MiB;
constexpr size_t WS_WBH = 12 * MiB, WS_WBM = 13 * MiB, WS_WOUT = 14 * MiB;
constexpr size_t WS_WGU = 16 * MiB;
constexpr size_t WS_WDN = 144 * MiB;
constexpr size_t WS_BGUP = 208 * MiB;
constexpr size_t WS_RWT = WS_BGUP + 256 * KiB;
constexpr size_t WS_TOPE = WS_RWT + 128 * KiB;
constexpr size_t WS_TOPP = WS_TOPE + 520 * KiB;
constexpr size_t WS_TOPW = WS_TOPP + 520 * KiB;
constexpr size_t WS_RS = WS_TOPW + 520 * KiB;
constexpr size_t WS_LI = WS_RS + 136 * KiB;
constexpr size_t WS_LF = WS_LI + 520 * KiB;
constexpr size_t WS_SLOTRS = WS_LF + 520 * KiB;
constexpr size_t WS_SLOTW = WS_SLOTRS + 552 * KiB;
constexpr size_t WS_XSQ = WS_SLOTW + 552 * KiB;
constexpr size_t WS_SROW = WS_XSQ + 136 * KiB;
constexpr size_t WS_SCOL = WS_SROW + 136 * KiB;
constexpr size_t WS_SMALL_END = WS_SCOL + 32 * KiB;
constexpr size_t WS_RA = 214 * MiB;
constexpr size_t WS_HQ = WS_RA, WS_HG = WS_RA + 33 * MiB, WS_HV = WS_RA + 99 * MiB, WS_HGATE = WS_RA + 132 * MiB, WS_MM = WS_RA + 165 * MiB, WS_MO = WS_RA + 198 * MiB, WS_GATES = WS_RA + 231 * MiB;
constexpr size_t WS_MERGED = WS_RA, WS_TMP = WS_RA + 66 * MiB, WS_H1B = WS_RA + 364 * MiB, WS_ACT = WS_RA;
constexpr size_t WS_RB = WS_RA + 364 * MiB;
constexpr size_t WS_XQ = WS_RB;
constexpr size_t WS_QKVM = WS_RB, WS_CM = WS_RB + 130 * MiB, WS_YHG = WS_RB + 196 * MiB, WS_YML = WS_RB + 229 * MiB, WS_XS = WS_RB, WS_YB = WS_RB;
constexpr size_t WS_RC = WS_RB + 274 * MiB;
constexpr size_t WS_XN0 = WS_RC + 65 * MiB;
constexpr size_t WS_H1 = WS_RC, WS_ETOK = WS_RC + 130 * MiB, WS_ERS = WS_ETOK + 5 * MiB, WS_EW = WS_ERS + 5 * MiB, WS_WIN8 = WS_EW + 5 * MiB, WS_END = WS_WIN8 + 5 * MiB;
static_assert(WS_SMALL_END <= WS_RA && WS_END <= 1024 * MiB, "d_ws map");
static_assert((size_t)NV * HW * 2 <= 33 * MiB && (size_t)NV * HW * 4 <= 66 * MiB && (size_t)NV * 2048 * 2 <= 132 * MiB + MiB && (size_t)NV * D * 4 <= 130 * MiB && (size_t)MAXTILES * 256 * D * 2 <= 274 * MiB, "d_ws sizes");
static_assert((size_t)NE * NV * 4 <= 5 * MiB, "per-expert lists");
static_assert((size_t)NR * D * 2 <= 65 * MiB && (size_t)NR * 4 <= 136 * KiB, "H1 / XN0 / XSQ");
constexpr int CW_TMO = 0, CW_CNT = 64  , CW_BAR = 4096, CW_CMAX = 65536  ;

constexpr int RING_OFF = 0, RING_BYTES = 131072;
constexpr int MISC_OFF = RING_BYTES;
constexpr int TEXP_OFF = MISC_OFF + 256;
constexpr int PST_OFF = TEXP_OFF + 640;
constexpr int TOK_OFF = PST_OFF + 384;
constexpr int LDS_BYTES = 147456;
static_assert(TOK_OFF + 18 * 512 <= LDS_BYTES, "LDS map");

#define GAS __attribute__((address_space(1)))
#define LAS __attribute__((address_space(3)))
typedef unsigned short bf16;
typedef unsigned v4u __attribute__((ext_vector_type(4)));
typedef unsigned v2u __attribute__((ext_vector_type(2)));
typedef float f32x4 __attribute__((ext_vector_type(4)));
typedef GAS unsigned gu32;
#define RLX_AGENT __ATOMIC_RELAXED, __HIP_MEMORY_SCOPE_AGENT
#define LDS_WAIT() asm volatile("s_waitcnt lgkmcnt(0)" ::: "memory")
#define VM_WAIT() asm volatile("s_waitcnt vmcnt(0)" ::: "memory")
__device__ __forceinline__ unsigned pk2(float lo, float hi) { return pg8::cvt_pk_bf16(lo, hi); }
__device__ __forceinline__ unsigned f2bf(float f) { return pg8::cvt_pk_bf16(f, 0.f) & 0xffffu; }
__device__ __forceinline__ float bflo(unsigned w) { return __builtin_bit_cast(float, w << 16); }
__device__ __forceinline__ float bfhi(unsigned w) { return __builtin_bit_cast(float, w & 0xffff0000u); }
__device__ __forceinline__ float bf1(bf16 h) { return __builtin_bit_cast(float, (unsigned)h << 16); }
__device__ __forceinline__ float fsigmoid(float x) { return __builtin_amdgcn_rcpf(1.0f + __expf(-x)); }
__device__ __forceinline__ float fsilu(float x) { return x * fsigmoid(x); }
__device__ __forceinline__ size_t rowof(int b, int tt) { return tt < NMETA ? (size_t)(NTOK + tt) : (size_t)b * SEQ + (tt - NMETA); }
__host__ __device__ __forceinline__ int gu_slot(int j) { const int g = (j >> 3) & 3, p = ((g & 1) << 1) | (g >> 1); return (j & ~31) + 8 * p + (j & 7); }
__device__ __forceinline__ float wave_sum(float v) {
#pragma unroll
    for (int o = 1; o < 64; o <<= 1) v += __shfl_xor(v, o);
    return v;
}
__device__ __forceinline__ float wave_max(float v) {
#pragma unroll
    for (int o = 1; o < 64; o <<= 1) v = fmaxf(v, __shfl_xor(v, o));
    return v;
}
#define XB_TMO      128
#define XB_XCNT(j)  (256  + 64 * (j))
#define XB_XSUB(j)  (1280 + 64 * (j))
#define XB_XGEN(j)  (2304 + 64 * (j))
#define XB_TOP      3328
#define XB_TOPGEN   3392
#define XCD_BAR_WORDS 3456
#define XB_SPIN_CAP (1u << 18)

__device__ __forceinline__ unsigned xb_ld(unsigned* p)              { return __hip_atomic_load(p, __ATOMIC_RELAXED, __HIP_MEMORY_SCOPE_AGENT); }
__device__ __forceinline__ unsigned xb_add(unsigned* p, unsigned v) { return __hip_atomic_fetch_add(p, v, __ATOMIC_RELAXED, __HIP_MEMORY_SCOPE_AGENT); }
__device__ __forceinline__ unsigned xb_xcc_id() { return (unsigned)__builtin_amdgcn_s_getreg((3 << 11) | 20) & 0xFu; }
#define XB_SPIN(cond, bar) do { unsigned _sp = 0; while (cond) { __builtin_amdgcn_s_sleep(1); \
    if ((++_sp & 255u) == 0u) { if (xb_ld(&(bar)[XB_TMO])) break; if (_sp > XB_SPIN_CAP) { atomicAdd(&(bar)[XB_TMO], 1u); break; } } } } while (0)

struct XcdBarrier {
    unsigned* bar; unsigned x;
    volatile LAS unsigned* st;
};

__device__ __forceinline__ XcdBarrier xcd_barrier_post(unsigned* bar, volatile LAS unsigned* st) {
    XcdBarrier b; b.bar = bar; b.x = xb_xcc_id(); b.st = st;
    if (threadIdx.x == 0) (void)xb_add(&bar[XB_XCNT(b.x)], 1u);
    return b;
}
__device__ __forceinline__ void xcd_barrier_complete(unsigned* bar, unsigned x, unsigned& nloc, unsigned& nx) {
    const unsigned G = gridDim.x * gridDim.y * gridDim.z;
    unsigned sum, cnt, mine, sp = 0u;
    for (;;) {
        sum = 0u; cnt = 0u; mine = 0u;
#pragma unroll
        for (unsigned j = 0; j < 16; ++j) { const unsigned c = xb_ld(&bar[XB_XCNT(j)]); sum += c; cnt += (c > 0u) ? 1u : 0u; mine = (j == x) ? c : mine; }
        if (sum == G) break;
        __builtin_amdgcn_s_sleep(1);
        if ((++sp & 255u) == 0u) { if (xb_ld(&bar[XB_TMO])) break; if (sp > XB_SPIN_CAP) { atomicAdd(&bar[XB_TMO], 1u); break; } }
    }
    nloc = mine > 0u ? mine : 1u; nx = cnt > 0u ? cnt : 1u;
}

__device__ __forceinline__ void xcd_barrier(const XcdBarrier& b) {
    asm volatile("s_waitcnt vmcnt(0)" ::: "memory");
    __syncthreads();
    if (threadIdx.x == 0) {
        unsigned* bar = b.bar;
        __builtin_amdgcn_s_waitcnt(0);
        unsigned nloc = b.st[0], nx = b.st[1];
        if (nloc == 0u) { xcd_barrier_complete(bar, b.x, nloc, nx); b.st[0] = nloc; b.st[1] = nx; }
        const unsigned old = xb_add(&bar[XB_XSUB(b.x)], 1u);
        const unsigned gen = old / nloc;
        if (old + 1u == (gen + 1u) * nloc) {
            __builtin_amdgcn_fence(__ATOMIC_RELEASE, "agent");
            asm volatile("s_waitcnt vmcnt(0)" ::: "memory");
            const unsigned og = xb_add(&bar[XB_TOP], 1u);
            const unsigned tg = og / nx;
            if (og + 1u == (tg + 1u) * nx) xb_add(&bar[XB_TOPGEN], 1u);
            else XB_SPIN(xb_ld(&bar[XB_TOPGEN]) == tg, bar);
            __builtin_amdgcn_fence(__ATOMIC_ACQUIRE, "agent");
            xb_add(&bar[XB_XGEN(b.x)], 1u);
            asm volatile("s_waitcnt vmcnt(0)" ::: "memory");
        } else {
            XB_SPIN(xb_ld(&bar[XB_XGEN(b.x)]) == gen, bar);
            __builtin_amdgcn_fence(__ATOMIC_ACQUIRE, "agent");
            asm volatile("s_waitcnt vmcnt(0)" ::: "memory");
        }
    }
    __syncthreads();
}

struct Frame {
    LAS unsigned char* lds;
    volatile LAS unsigned* MISC;
    gu32* ctl;
    int tid, lane, wave, vcu, G;
    const float* in[25];
    float* out;
    unsigned char* ws;
};
#define IN_X 0
#define IN_META 1
#define IN_LBL 2
#define IN_NMIX 3
#define IN_WIN 4
#define IN_HGNORM 5
#define IN_CONVW 6
#define IN_CONVB 7
#define IN_WQ 8
#define IN_WK 9
#define IN_WV 10
#define IN_GATEB 11
#define IN_MLNORM 12
#define IN_MLSKIP 13
#define IN_WBH 14
#define IN_WBM 15
#define IN_WOUT 16
#define IN_NFFN 17
#define IN_RW 18
#define IN_RB 19
#define IN_WGU 20
#define IN_BGU 21
#define IN_WDN 22
#define IN_BDN 23
#define IN_NFIN 24

__device__ __forceinline__ void p0_item(const float* W, int ldw, int col0, int cstride, const float* kscale, bf16* WT, int K, int dstrow0, int k0, LAS float* scr, int lane, float gsc = 1.f, gu32* cmax = nullptr) {
    (void)cstride;
    const int r = lane >> 3, c4 = (lane & 7) * 4;
    f32x4 v[8];
#pragma unroll
    for (int i = 0; i < 8; ++i) v[i] = *(const GAS f32x4*)(W + (size_t)(k0 + 8 * i + r) * ldw + col0 + c4);
#pragma unroll
    for (int i = 0; i < 8; ++i) { const float sc = kscale ? kscale[k0 + 8 * i + r] : gsc; LAS float* s = scr + (8 * i + r) * 33 + c4; s[0] = v[i].x * sc; s[1] = v[i].y * sc; s[2] = v[i].z * sc; s[3] = v[i].w * sc; }
    LDS_WAIT(); asm volatile("" ::: "memory");
    const int c = lane & 7;
#pragma unroll
    for (int j = 0; j < 4; ++j) { const int n = (lane >> 3) + 8 * j; const LAS float* s = scr + (8 * c) * 33 + n;
        v4u o; o.x = pk2(s[0 * 33], s[1 * 33]); o.y = pk2(s[2 * 33], s[3 * 33]); o.z = pk2(s[4 * 33], s[5 * 33]); o.w = pk2(s[6 * 33], s[7 * 33]);
        if (cmax) { float m = fmaxf(fmaxf(fmaxf(fabsf(s[0 * 33]), fabsf(s[1 * 33])), fmaxf(fabsf(s[2 * 33]), fabsf(s[3 * 33]))), fmaxf(fmaxf(fabsf(s[4 * 33]), fabsf(s[5 * 33])), fmaxf(fabsf(s[6 * 33]), fabsf(s[7 * 33]))));
            m = fmaxf(m, __shfl_xor(m, 1)); m = fmaxf(m, __shfl_xor(m, 2)); m = fmaxf(m, __shfl_xor(m, 4));
            if (c == 0) (void)__hip_atomic_fetch_max(cmax + dstrow0 + n, __builtin_bit_cast(unsigned, m), RLX_AGENT); }
        *(GAS v4u*)(WT + (size_t)(dstrow0 + n) * K + k0 + 8 * c) = o; }
    LDS_WAIT(); asm volatile("" ::: "memory");
}
__device__ __forceinline__ void p0_prologue(Frame& F) {
    unsigned char* ws = F.ws;
    const int gw = F.vcu * NWAVES + F.wave, NGW = F.G * NWAVES, gt = F.vcu * NTHREADS + F.tid, NGT = F.G * NTHREADS;
    {
        LAS float* wm = (LAS float*)(F.lds + RING_OFF + 65536);
        { float wa[16], wb[16];
#pragma unroll
          for (int q = 0; q < 16; ++q) { const int u = F.tid + q * NTHREADS, j = u & 7, l = (u >> 3) & 63, i = u >> 9, k = 4 * l + 256 * (i >> 2) + (i & 3); wa[q] = F.in[IN_NMIX][k]; wb[q] = F.in[IN_WIN][(size_t)k * NIN + 3072 + j]; }
#pragma unroll
          for (int q = 0; q < 16; ++q) wm[F.tid + q * NTHREADS] = wa[q] * wb[q]; }
        __syncthreads();
        bf16* XN0 = (bf16*)(ws + WS_XN0); float* XSQ = (float*)(ws + WS_XSQ); unsigned char* XQ = ws + WS_XQ; float* SROW = (float*)(ws + WS_SROW); float* LI = (float*)(ws + WS_LI); float* LF = (float*)(ws + WS_LF);
        f32x4 vn[4];
#define P0_LOADROW(dst, V_) do { const int Vc_ = (V_) < NR ? (V_) : NR - 1; const float* src_ = (Vc_ >= NTOK) ? F.in[IN_META] + (size_t)(Vc_ - NTOK) * D : F.in[IN_X] + (size_t)Vc_ * D; \
        const GAS f32x4* xr_ = (const GAS f32x4*)src_ + F.lane; _Pragma("unroll") for (int j = 0; j < 4; ++j) dst[j] = xr_[64 * j]; } while (0)
        P0_LOADROW(vn, gw);
        for (int V = gw; V < NR; V += NGW) {
            f32x4 v[4]; float s = 0.f, am = 0.f;
#pragma unroll
            for (int j = 0; j < 4; ++j) { v[j] = vn[j]; s += (v[j].x * v[j].x + v[j].y * v[j].y) + (v[j].z * v[j].z + v[j].w * v[j].w); am = fmaxf(am, fmaxf(fmaxf(fabsf(v[j].x), fabsf(v[j].y)), fmaxf(fabsf(v[j].z), fabsf(v[j].w)))); }
            P0_LOADROW(vn, V + NGW);
            asm volatile("" ::: "memory");
            const float sq = sqrtf(wave_sum(s) * (1.f / D) + EPS), rs = 1.0f / sq;
            am = wave_max(am) * rs; const float srow = am > 0.f ? am * (1.f / 127.f) : 1.f, qi = 1.f / srow;
            if (F.lane == 0) { XSQ[V] = sq; SROW[V] = srow; }
            GAS unsigned* q4 = (GAS unsigned*)(XQ + (size_t)V * D) + F.lane;
            float g[8];
#pragma unroll
            for (int j = 0; j < 8; ++j) g[j] = 0.f;
            GAS unsigned long long* o8 = (GAS unsigned long long*)(XN0 + (size_t)V * D) + F.lane;
#pragma unroll
            for (int j = 0; j < 4; ++j) {
                v[j] = v[j] * rs;
                o8[64 * j] = (unsigned long long)pk2(v[j].x, v[j].y) | ((unsigned long long)pk2(v[j].z, v[j].w) << 32);
                q4[64 * j] = ((unsigned)(int)rintf(v[j].x * qi) & 0xffu) | (((unsigned)(int)rintf(v[j].y * qi) & 0xffu) << 8) | (((unsigned)(int)rintf(v[j].z * qi) & 0xffu) << 16) | ((unsigned)(int)rintf(v[j].w * qi) << 24);
#pragma unroll
                for (int q = 0; q < 4; ++q) { const LAS f32x4* wp = (const LAS f32x4*)(wm + (((4 * j + q) * 64 + F.lane) * 8)); const f32x4 w0 = wp[0], w1 = wp[1]; const float xv = v[j][q];
                    g[0] += xv * w0.x; g[1] += xv * w0.y; g[2] += xv * w0.z; g[3] += xv * w0.w; g[4] += xv * w1.x; g[5] += xv * w1.y; g[6] += xv * w1.z; g[7] += xv * w1.w; }
            }
#pragma unroll
            for (int j = 0; j < 8; ++j) g[j] = wave_sum(g[j]);
            if (F.lane < 4) {
                const float gi = (F.lane == 0 ? g[0] : F.lane == 1 ? g[1] : F.lane == 2 ? g[2] : g[3]) + F.in[IN_GATEB][F.lane];
                const float gf = (F.lane == 0 ? g[4] : F.lane == 1 ? g[5] : F.lane == 2 ? g[6] : g[7]) + F.in[IN_GATEB][4 + F.lane];
                LI[(size_t)V * 4 + F.lane] = gi;
                LF[(size_t)V * 4 + F.lane] = fminf(gf, 0.f) - log1pf(__expf(-fabsf(gf)));
            }
        }
        __syncthreads();
    }
    {
        LAS float* scr = (LAS float*)(F.lds + RING_OFF + F.wave * 16384);
        constexpr int I_IN1 = 16 * 96, I_IN2 = 16 * 64, I_BH = 8 * 32, I_OUT = 16 * 32;
        constexpr int NITEMS = I_IN1 + I_IN2 + 2 * I_BH + I_OUT;
        for (int it = gw; it < NITEMS; it += NGW) {
            int r = it;
            if (r < I_IN1) { const int kb = r / 96, nb = r % 96; p0_item(F.in[IN_WIN], NIN, 32 * nb, 1, F.in[IN_NMIX], (bf16*)(ws + WS_WIN), D, 32 * nb, 64 * kb, scr, F.lane, 1.f, F.ctl + CW_CMAX); continue; } r -= I_IN1;
            if (r < I_IN2) { const int kb = r / 64, nb = r % 64; p0_item(F.in[IN_WIN], NIN, 3080 + 32 * nb, 1, F.in[IN_NMIX], (bf16*)(ws + WS_WIN), D, 3072 + 32 * nb, 64 * kb, scr, F.lane, 1.f, F.ctl + CW_CMAX); continue; } r -= I_IN2;
            if (r < I_BH) { const int kb = r / 32, nb = r % 32; p0_item(F.in[IN_WBH], D, 32 * nb, 1, nullptr, (bf16*)(ws + WS_WBH), HW, 32 * nb, 64 * kb, scr, F.lane, 1.f / 255.f); continue; } r -= I_BH;
            if (r < I_BH) { const int kb = r / 32, nb = r % 32; p0_item(F.in[IN_WBM], D, 32 * nb, 1, nullptr, (bf16*)(ws + WS_WBM), HW, 32 * nb, 64 * kb, scr, F.lane, 1.f / 255.f); continue; } r -= I_BH;
            { const int kb = r / 32, nb = r % 32; p0_item(F.in[IN_WOUT], D, 32 * nb, 1, nullptr, (bf16*)(ws + WS_WOUT), D, 32 * nb, 64 * kb, scr, F.lane); }
        }
    }
    { float* BGUP = (float*)(ws + WS_BGUP); float* RWT = (float*)(ws + WS_RWT);
      for (int u = gt; u < NE * 2 * DFF; u += NGT) { const int e = u >> 11, n = u & 2047, pn = n >> 8, bj = (n >> 7) & 1, j = gu_slot(n & 127); BGUP[u] = F.in[IN_BGU][(size_t)e * 2 * DFF + 2 * (128 * pn + j) + bj]; }
      for (int u = gt; u < NE * D; u += NGT) { const int e = u >> 10, k = u & 1023; RWT[u] = F.in[IN_NFFN][k] * F.in[IN_RW][(size_t)k * NE + e]; } }
}

__device__ __forceinline__ void p0b_quant(Frame& F) {
    unsigned char* ws = F.ws; const int gw = F.vcu * NWAVES + F.wave, NGW = F.G * NWAVES, lane = F.lane;
    LAS float* scr = (LAS float*)(F.lds + RING_OFF + F.wave * 16384);
    unsigned char* W8 = ws + WS_WIN8; float* SCOL = (float*)(ws + WS_SCOL); const float* W = F.in[IN_WIN]; const float* kscale = F.in[IN_NMIX];
    constexpr int I_IN1 = 16 * 96, I_IN2 = 16 * 64;
    const int r = lane >> 3, c4 = (lane & 7) * 4;
    for (int it = gw; it < I_IN1 + I_IN2; it += NGW) {
        int kb, nb, col0, dstrow0;
        if (it < I_IN1) { kb = it / 96; nb = it % 96; col0 = 32 * nb; dstrow0 = 32 * nb; } else { const int q = it - I_IN1; kb = q / 64; nb = q % 64; col0 = 3080 + 32 * nb; dstrow0 = 3072 + 32 * nb; }
        const int k0 = 64 * kb;
        f32x4 v[8];
#pragma unroll
        for (int i = 0; i < 8; ++i) v[i] = *(const GAS f32x4*)(W + (size_t)(k0 + 8 * i + r) * NIN + col0 + c4);
        float qs[4];
#pragma unroll
        for (int e = 0; e < 4; ++e) { const float m = __builtin_bit_cast(float, __hip_atomic_load(F.ctl + CW_CMAX + dstrow0 + c4 + e, RLX_AGENT)); qs[e] = 127.f / fmaxf(m, 1e-30f); }
        if (kb == 0 && lane < 8) {
#pragma unroll
            for (int e = 0; e < 4; ++e) SCOL[dstrow0 + c4 + e] = 1.f / qs[e]; }
#pragma unroll
        for (int i = 0; i < 8; ++i) { const float sc = kscale[k0 + 8 * i + r]; LAS float* s = scr + (8 * i + r) * 33 + c4; s[0] = rintf(v[i].x * sc * qs[0]); s[1] = rintf(v[i].y * sc * qs[1]); s[2] = rintf(v[i].z * sc * qs[2]); s[3] = rintf(v[i].w * sc * qs[3]); }
        LDS_WAIT(); asm volatile("" ::: "memory");
        const int c = lane & 7;
#pragma unroll
        for (int j = 0; j < 4; ++j) { const int n = (lane >> 3) + 8 * j; const LAS float* s = scr + (8 * c) * 33 + n;
            v2u o;
            o.x = ((unsigned)(int)s[0 * 33] & 0xffu) | (((unsigned)(int)s[1 * 33] & 0xffu) << 8) | (((unsigned)(int)s[2 * 33] & 0xffu) << 16) | ((unsigned)(int)s[3 * 33] << 24);
            o.y = ((unsigned)(int)s[4 * 33] & 0xffu) | (((unsigned)(int)s[5 * 33] & 0xffu) << 8) | (((unsigned)(int)s[6 * 33] & 0xffu) << 16) | ((unsigned)(int)s[7 * 33] << 24);
            *(GAS v2u*)(W8 + (size_t)(dstrow0 + n) * D + k0 + 8 * c) = o; }
        LDS_WAIT(); asm volatile("" ::: "memory");
    }
}

__device__ __forceinline__ unsigned pk4_fp8(float a, float b, float c, float d) { unsigned w = 0;
    a = __builtin_amdgcn_fmed3f(a, -448.f, 448.f); b = __builtin_amdgcn_fmed3f(b, -448.f, 448.f); c = __builtin_amdgcn_fmed3f(c, -448.f, 448.f); d = __builtin_amdgcn_fmed3f(d, -448.f, 448.f);
    w = __builtin_amdgcn_cvt_pk_fp8_f32(a, b, w, false); w = __builtin_amdgcn_cvt_pk_fp8_f32(c, d, w, true); return w; }
__device__ __forceinline__ void cvdn_load(const float* Wdn, int it, f32x4 (&v)[8], int lane) {
    const int e = it >> 9, kb = (it >> 5) & 15, nb = it & 31, r = lane >> 3, c4 = (lane & 7) * 4; const float* W = Wdn + (size_t)e * DFF * D;
#pragma unroll
    for (int i = 0; i < 8; ++i) v[i] = *(const GAS f32x4*)(W + (size_t)(64 * kb + 8 * i + r) * D + 32 * nb + c4);
}
__device__ __forceinline__ void cvdn_proc(unsigned char* WTdn, int it, const f32x4 (&v)[8], LAS float* scr, int lane) {
    const int e = it >> 9, kb = (it >> 5) & 15, nb = it & 31, r = lane >> 3, c4 = (lane & 7) * 4; unsigned char* WT = WTdn + (size_t)e * D * DFF;
#pragma unroll
    for (int i = 0; i < 8; ++i) { LAS float* s = scr + (8 * i + r) * 33 + c4; s[0] = v[i].x * 32.f; s[1] = v[i].y * 32.f; s[2] = v[i].z * 32.f; s[3] = v[i].w * 32.f; }
    LDS_WAIT(); asm volatile("" ::: "memory");
    const int c = lane & 7;
#pragma unroll
    for (int j = 0; j < 4; ++j) { const int n = (lane >> 3) + 8 * j; const LAS float* s = scr + (8 * c) * 33 + n;
        v2u o; o.x = pk4_fp8(s[0 * 33], s[1 * 33], s[2 * 33], s[3 * 33]); o.y = pk4_fp8(s[4 * 33], s[5 * 33], s[6 * 33], s[7 * 33]);
        const int cn = 32 * nb + n, rowp = (cn & ~255) + 128 * ((cn >> 3) & 1) + 32 * ((cn >> 6) & 3) + 8 * ((cn >> 4) & 3) + (cn & 7);
        *(GAS v2u*)(WT + (size_t)rowp * DFF + 64 * kb + 8 * c) = o; }
    LDS_WAIT(); asm volatile("" ::: "memory");
}
__device__ __forceinline__ void cvgu_load(const float* Wgu, const float* nffn, int it, f32x4 (&v)[8], float (&sc)[8], int lane) {
    const int e = it >> 10, kb = (it >> 5) & 31, nb = it & 31, r = lane >> 4, c4 = (lane & 15) * 4; const float* W = Wgu + (size_t)e * D * 2 * DFF;
#pragma unroll
    for (int i = 0; i < 8; ++i) { v[i] = *(const GAS f32x4*)(W + (size_t)(32 * kb + 4 * i + r) * (2 * DFF) + 64 * nb + c4); sc[i] = nffn[32 * kb + 4 * i + r] * 32.f; }
}
__device__ __forceinline__ void cvgu_proc(unsigned char* WTgu, int it, const f32x4 (&v)[8], const float (&sc)[8], LAS float* scr, int lane) {
    const int e = it >> 10, kb = (it >> 5) & 31, nb = it & 31, r = lane >> 4, c4 = (lane & 15) * 4, A0 = 32 * nb, k0 = 32 * kb; unsigned char* WT = WTgu + (size_t)e * 2 * DFF * D;
    LAS float* sg = scr; LAS float* su = scr + 32 * 33;
#pragma unroll
    for (int i = 0; i < 8; ++i) { const int o = (4 * i + r) * 33 + (c4 >> 1); sg[o] = v[i].x * sc[i]; su[o] = v[i].y * sc[i]; sg[o + 1] = v[i].z * sc[i]; su[o + 1] = v[i].w * sc[i]; }
    LDS_WAIT(); asm volatile("" ::: "memory");
    const int c = lane & 3;
#pragma unroll
    for (int j = 0; j < 4; ++j) { const int q = (lane >> 2) + 16 * j, isup = q >> 5, jj = q & 31, A = A0 + jj; const LAS float* s = scr + isup * 32 * 33 + (8 * c) * 33 + jj;
        v2u o; o.x = pk4_fp8(s[0 * 33], s[1 * 33], s[2 * 33], s[3 * 33]); o.y = pk4_fp8(s[4 * 33], s[5 * 33], s[6 * 33], s[7 * 33]);
        *(GAS v2u*)(WT + (size_t)(256 * (A >> 7) + 128 * isup + gu_slot(A & 127)) * D + k0 + 8 * c) = o; }
    LDS_WAIT(); asm volatile("" ::: "memory");
}
__device__ __forceinline__ void px_experts(Frame& F, int rank, int nwg) {
    unsigned char* ws = F.ws;
    LAS float* scr = (LAS float*)(F.lds + RING_OFF + F.wave * 16384);
    const int gw = rank * NWAVES + F.wave, NGW = nwg * NWAVES;
    { constexpr int NIT = NE * 1024; f32x4 v[8], vn[8]; float sc[8], sn[8]; int it = gw;
      if (it < NIT) cvgu_load(F.in[IN_WGU], F.in[IN_NFFN], it, v, sc, F.lane);
      while (it < NIT) { const int nx = it + NGW; if (nx < NIT) cvgu_load(F.in[IN_WGU], F.in[IN_NFFN], nx, vn, sn, F.lane);
          asm volatile("" ::: "memory");
          cvgu_proc((unsigned char*)(ws + WS_WGU), it, v, sc, scr, F.lane); asm volatile("" ::: "memory");
#pragma unroll
          for (int i = 0; i < 8; ++i) { v[i] = vn[i]; sc[i] = sn[i]; }
          it = nx; } }
    { constexpr int NIT = NE * 512; f32x4 v[8], vn[8]; int it = gw;
      if (it < NIT) cvdn_load(F.in[IN_WDN], it, v, F.lane);
      while (it < NIT) { const int nx = it + NGW; if (nx < NIT) cvdn_load(F.in[IN_WDN], nx, vn, F.lane);
          asm volatile("" ::: "memory");
          cvdn_proc((unsigned char*)(ws + WS_WDN), it, v, scr, F.lane); asm volatile("" ::: "memory");
#pragma unroll
          for (int i = 0; i < 8; ++i) v[i] = vn[i];
          it = nx; } }
}

namespace pg8 {
typedef unsigned v2u_t __attribute__((ext_vector_type(2)));
typedef float f32x2 __attribute__((ext_vector_type(2)));
__device__ __forceinline__ f32x2 sig2(f32x2 x) { const f32x2 t = x * (f32x2){-1.4426950408889634f, -1.4426950408889634f};
    const f32x2 d = (f32x2){__builtin_amdgcn_exp2f(t.x), __builtin_amdgcn_exp2f(t.y)} + (f32x2){1.f, 1.f}; return (f32x2){__builtin_amdgcn_rcpf(d.x), __builtin_amdgcn_rcpf(d.y)}; }
__device__ __forceinline__ u32x4 pack8(const f32x4& a, const f32x4& b) { u32x4 w; w.x = cvt_pk_bf16(a[0], a[1]); w.y = cvt_pk_bf16(a[2], a[3]); w.z = cvt_pk_bf16(b[0], b[1]); w.w = cvt_pk_bf16(b[2], b[3]); return w; }
__device__ __forceinline__ v2u_t pack8_fp8(const f32x4& a, const f32x4& b) { unsigned lo = 0, hi = 0;
    lo = __builtin_amdgcn_cvt_pk_fp8_f32(a[0], a[1], lo, false); lo = __builtin_amdgcn_cvt_pk_fp8_f32(a[2], a[3], lo, true);
    hi = __builtin_amdgcn_cvt_pk_fp8_f32(b[0], b[1], hi, false); hi = __builtin_amdgcn_cvt_pk_fp8_f32(b[2], b[3], hi, true); return (v2u_t){lo, hi}; }
__device__ __forceinline__ v2u_t pack8_fp8_sat(const f32x4& a, const f32x4& b) { f32x4 x, y;
#pragma unroll
    for (int i = 0; i < 4; ++i) { x[i] = __builtin_amdgcn_fmed3f(a[i], -448.f, 448.f); y[i] = __builtin_amdgcn_fmed3f(b[i], -448.f, 448.f); }
    return pack8_fp8(x, y); }
__device__ __forceinline__ void unpack8(const u32x4& w, f32x4& a, f32x4& b) { a = (f32x4){bflo(w.x), bfhi(w.x), bflo(w.y), bfhi(w.y)}; b = (f32x4){bflo(w.z), bfhi(w.z), bflo(w.w), bfhi(w.w)}; }
__host__ __device__ __forceinline__ int gate_pos(int c) { return (c & ~255) + ((((c >> 5) & 3) * 4 + ((c >> 3) & 3)) * 16) + (((c >> 7) & 1) * 8) + (c & 7); }
__device__ __forceinline__ unsigned q8x4(float a, float b, float c, float d) {
    const unsigned t0 = __builtin_bit_cast(unsigned, __builtin_fmaf(a, 255.f, 8388608.f)), t1 = __builtin_bit_cast(unsigned, __builtin_fmaf(b, 255.f, 8388608.f));
    const unsigned t2 = __builtin_bit_cast(unsigned, __builtin_fmaf(c, 255.f, 8388608.f)), t3 = __builtin_bit_cast(unsigned, __builtin_fmaf(d, 255.f, 8388608.f));
    return (t0 & 0xffu) | (t1 << 8) | (t2 << 16) | (t3 << 24); }
__device__ __forceinline__ f32x4 dq8x4(unsigned w) { return (f32x4){(float)(w & 0xffu), (float)((w >> 8) & 0xffu), (float)((w >> 16) & 0xffu), (float)(w >> 24)}; }
template <bool Q>
struct EpiProjT {
    static constexpr bool PERM = true, AFTER_DRAIN = false;
    unsigned char* ws; const float* lbl; const float* srow; const float* scol;
    struct Sc { float rs[8]; f32x2 cs[2][4]; };
    __device__ __forceinline__ f32x2 val(const f32x4 (&acc)[2][2][4][2], const Sc& sc, int ai, int bj, int m, int k) const {
        const f32x4 a = acc[ai][bj][m][k >> 1];
        if constexpr (Q) { const i32x4 q = __builtin_bit_cast(i32x4, a); const float r = sc.rs[ai * 4 + m]; return ((f32x2){(float)q[2 * (k & 1)], (float)q[2 * (k & 1) + 1]} * sc.cs[bj][k]) * (f32x2){r, r}; }
        else return (f32x2){a[2 * (k & 1)], a[2 * (k & 1) + 1]};
    }
    template <int ACT>
    __device__ __forceinline__ void emit(const f32x4 (&acc)[2][2][4][2], const Sc& sc, bf16_t* O, int row0, int colt) const {
#pragma unroll
        for (int ai = 0; ai < 2; ++ai)
#pragma unroll
            for (int m = 0; m < 4; ++m) { bf16_t* rowp = O + (size_t)(row0 + ai * HALF + m * 16) * HW + colt;
#pragma unroll
                for (int bj = 0; bj < 2; ++bj) { u32x4 o;
#pragma unroll
                    for (int k = 0; k < 4; ++k) { f32x2 p = val(acc, sc, ai, bj, m, k);
                        if constexpr (ACT == 1) p = p * sig2(p); else if constexpr (ACT == 2) p = sig2(p);
                        o[k] = cvt_pk_bf16(p.x, p.y); }
                    *(u32x4*)(rowp + bj * HALF) = o; } }
    }
    __device__ __forceinline__ void operator()(const f32x4 (&acc)[2][2][4][2], const Unit& u, int wr, int wc, int fr, int fq) const {
        const int row0 = u.pm * BM + wr * 64 + fr, kind = u.pn < 12 ? (u.pn >> 1) : 6;
        const int colt = (u.pn < 12 ? (u.pn & 1) : (u.pn - 12)) * BM + wc * 32 + 8 * fq;
        Sc sc;
        if constexpr (Q) {
#pragma unroll
            for (int it = 0; it < 8; ++it) sc.rs[it] = srow[row0 + (it >> 2) * HALF + (it & 3) * 16];
#pragma unroll
            for (int bj = 0; bj < 2; ++bj) { const float* cp = scol + u.pn * BM + wc * 32 + 8 * fq + bj * HALF; const f32x4 c0 = *(const f32x4*)cp, c1 = *(const f32x4*)(cp + 4);
                sc.cs[bj][0] = (f32x2){c0[0], c0[1]}; sc.cs[bj][1] = (f32x2){c0[2], c0[3]}; sc.cs[bj][2] = (f32x2){c1[0], c1[1]}; sc.cs[bj][3] = (f32x2){c1[2], c1[3]}; }
        }
        if (kind == 1) {
            bf16_t* HG = (bf16_t*)(ws + WS_HG);
#pragma unroll
            for (int bj = 0; bj < 2; ++bj) { const int c = colt + bj * HALF; f32x2 lb[4], ol[4];
#pragma unroll
                for (int k = 0; k < 4; ++k) { lb[k] = sig2((f32x2){lbl[c + 2 * k] - lbl[HW + c + 2 * k], lbl[c + 2 * k + 1] - lbl[HW + c + 2 * k + 1]}); ol[k] = (f32x2){1.f, 1.f} - lb[k]; }
#pragma unroll
                for (int ai = 0; ai < 2; ++ai)
#pragma unroll
                    for (int m = 0; m < 4; ++m) { u32x4 o;
#pragma unroll
                        for (int k = 0; k < 4; ++k) { const f32x2 f = ol[k] * sig2(val(acc, sc, ai, bj, m, k)) + lb[k];
                            const f32x2 lg = (f32x2){__builtin_amdgcn_logf(f.x), __builtin_amdgcn_logf(f.y)} * (f32x2){0.6931471805599453f, 0.6931471805599453f}; o[k] = cvt_pk_bf16(lg.x, lg.y); }
                        *(u32x4*)(HG + (size_t)(row0 + ai * HALF + m * 16) * HW + c) = o; } }
            return;
        }
        if (kind == 6) {
            unsigned char* G8 = ws + WS_GATES; const int gofs = (u.pn - 12) * BM + (wc * 4 + fq) * 16;
#pragma unroll
            for (int ai = 0; ai < 2; ++ai)
#pragma unroll
                for (int m = 0; m < 4; ++m) { u32x4 o;
#pragma unroll
                    for (int bj = 0; bj < 2; ++bj)
#pragma unroll
                        for (int h = 0; h < 2; ++h) {
                            const f32x2 sa = sig2(val(acc, sc, ai, bj, m, 2 * h)), sb = sig2(val(acc, sc, ai, bj, m, 2 * h + 1));
                            o[2 * bj + h] = q8x4(sa.x, sa.y, sb.x, sb.y); }
                    *(u32x4*)(G8 + (size_t)(row0 + ai * HALF + m * 16) * 2048 + gofs) = o; }
            return;
        }
        if (kind == 0) emit<1>(acc, sc, (bf16_t*)(ws + WS_HQ), row0, colt); else if (kind == 2) emit<0>(acc, sc, (bf16_t*)(ws + WS_HV), row0, colt); else if (kind == 3) emit<1>(acc, sc, (bf16_t*)(ws + WS_HGATE), row0, colt);
        else if (kind == 4) emit<0>(acc, sc, (bf16_t*)(ws + WS_MM), row0, colt); else emit<2>(acc, sc, (bf16_t*)(ws + WS_MO), row0, colt);
    }
};
constexpr int PAIR_DA = 132, PAIR_DB = 4;
struct PairOrder { StaticOrder S;
    __device__ __forceinline__ bool next(int i, Unit& u) const { Unit t; if (!S.next(i >> 1, t)) return false; const int s = i & 1; u.pm = t.pm + PAIR_DA * s; u.pn = t.pn + PAIR_DB * s; return true; }
    __device__ __forceinline__ void a_ready(const Unit&) const {}
    __device__ __forceinline__ void done(const Unit&) const {}
};
struct EpiGate2 {
    static constexpr bool PERM = true, AFTER_DRAIN = false;
    const unsigned char* __restrict__ gates; bf16_t* __restrict__ tmp; bf16_t* __restrict__ merged;
    __device__ __forceinline__ void operator()(const f32x4 (&acc)[2][2][4][2], const Unit& u, int wr, int wc, int fr, int fq) const {
        const int step = u.pm >= PAIR_DA ? 1 : 0, pm = u.pm - PAIR_DA * step, pn = u.pn - PAIR_DB * step;
        const int row0 = pm * BM + wr * 64 + fr, col0 = pn * BM + wc * 32 + 8 * fq, gofs = step * D + pn * BM + (wc * 4 + fq) * 16;
        constexpr int NB = 2, NBAT = 8 / NB;
        bf16_t* obuf = tmp + (ptrdiff_t)(merged - tmp) * step;
        u32x4 gc[NB], tc[NB][2], gn[NB], tn[NB][2];
#define EG_LOAD(G, T, b_) do { _Pragma("unroll") for (int s_ = 0; s_ < NB; ++s_) { const int it_ = (b_) * NB + s_; const size_t row_ = (size_t)(row0 + (it_ >> 2) * HALF + (it_ & 3) * 16); G[s_] = *(const u32x4*)(gates + row_ * 2048 + gofs); _Pragma("unroll") for (int bj = 0; bj < 2; ++bj) { \
        if (step) T[s_][bj] = *(const u32x4*)(tmp + row_ * D + col0 + bj * HALF); else T[s_][bj] = (u32x4){0u, 0u, 0u, 0u}; } } } while (0)
        EG_LOAD(gc, tc, 0);
#pragma unroll
        for (int b = 0; b < NBAT; ++b) {
            if (b + 1 < NBAT) EG_LOAD(gn, tn, b + 1);
#pragma unroll
            for (int s = 0; s < NB; ++s) { const int it = b * NB + s, ai = it >> 2, m = it & 3; const size_t row = (size_t)(row0 + ai * HALF + m * 16);
#pragma unroll
                for (int bj = 0; bj < 2; ++bj) { const int c = col0 + bj * HALF; f32x4 t0, t1; unpack8(tc[s][bj], t0, t1); const f32x4 g0 = dq8x4(gc[s][2 * bj]), g1 = dq8x4(gc[s][2 * bj + 1]);
                    const u32x4 o = pack8(acc[ai][bj][m][0] * g0 + t0, acc[ai][bj][m][1] * g1 + t1);
                    *(u32x4*)(obuf + row * D + c) = o; } }
#pragma unroll
            for (int s = 0; s < NB; ++s)
#pragma unroll
                for (int bj = 0; bj < 2; ++bj) tc[s][bj] = tn[s][bj];
#pragma unroll
            for (int s = 0; s < NB; ++s) gc[s] = gn[s]; }
#undef EG_LOAD
    }
};
struct EpiH1 {
    static constexpr bool PERM = true, AFTER_DRAIN = false;
    const bf16_t* __restrict__ xn0; const float* __restrict__ xsq; bf16_t* __restrict__ H1; unsigned char* __restrict__ H1B8;
    __device__ __forceinline__ void operator()(const f32x4 (&acc)[2][2][4][2], const Unit& u, int wr, int wc, int fr, int fq) const {
        const int row0 = u.pm * BM + wr * 64 + fr, col0 = u.pn * BM + wc * 32 + 8 * fq;
        u32x4 xc[2], xn[2]; float sc, sn;
#define EH_LOAD(X, S_, it_) do { const size_t r_ = (size_t)(row0 + ((it_) >> 2) * HALF + ((it_) & 3) * 16); const bf16_t* src_ = xn0 + r_ * D + col0; S_ = xsq[r_]; _Pragma("unroll") for (int bj = 0; bj < 2; ++bj) X[bj] = *(const u32x4*)(src_ + bj * HALF); } while (0)
        EH_LOAD(xc, sc, 0);
#pragma unroll
        for (int it = 0; it < 8; ++it) { const int ai = it >> 2, m = it & 3; const size_t V = (size_t)(row0 + ai * HALF + m * 16);
            if (it + 1 < 8) EH_LOAD(xn, sn, it + 1);
#pragma unroll
            for (int bj = 0; bj < 2; ++bj) { const int c = col0 + bj * HALF; f32x4 x0, x1; unpack8(xc[bj], x0, x1);
                const f32x4 v0 = x0 * sc + acc[ai][bj][m][0], v1 = x1 * sc + acc[ai][bj][m][1];
                *(u32x4*)(H1 + V * D + c) = pack8(v0, v1); *(v2u_t*)(H1B8 + V * D + c) = pack8_fp8_sat(v0, v1); }
#pragma unroll
            for (int bj = 0; bj < 2; ++bj) xc[bj] = xn[bj];
            sc = sn; }
#undef EH_LOAD
    }
};
struct EpiGU {
    static constexpr bool PERM = true, AFTER_DRAIN = false;
    const float* __restrict__ bgup; const float* __restrict__ ers; unsigned char* __restrict__ act; const PG8_LAS int* pst;
    __device__ __forceinline__ void operator()(const f32x4 (&acc)[2][2][4][2], const Unit& u, int wr, int wc, int fr, int fq) const {
        const int e = u.pn >> 3, pn = u.pn & 7, row0 = u.pm * BM + wr * 64 + fr, cc = wc * 32 + 8 * fq;
        const float* rsp = ers + (size_t)e * NV + (row0 - pst[e]);
        const float* bp = bgup + (size_t)e * 2 * DFF + pn * BM + cc;
        f32x2 bg[2][2], bu[2][2];
#pragma unroll
        for (int h = 0; h < 2; ++h) { const f32x4 g4 = *(const f32x4*)(bp + 4 * h), u4 = *(const f32x4*)(bp + HALF + 4 * h);
            bg[h][0] = (f32x2){g4[0], g4[1]}; bg[h][1] = (f32x2){g4[2], g4[3]}; bu[h][0] = (f32x2){u4[0] + 1.f, u4[1] + 1.f}; bu[h][1] = (f32x2){u4[2] + 1.f, u4[3] + 1.f}; }
        float rsv[8];
#pragma unroll
        for (int it = 0; it < 8; ++it) rsv[it] = rsp[(it >> 2) * HALF + (it & 3) * 16];
        const int hi = fq >> 1;
        unsigned char* obase = act + (size_t)(row0 + 16 * hi) * DFF + pn * HALF + wc * 32 + 16 * (fq & 1);
        constexpr float KS = -1.702f * 1.4426950408889634f;
#pragma unroll
        for (int ai = 0; ai < 2; ++ai)
#pragma unroll
            for (int mp = 0; mp < 2; ++mp) { v2u_t pk[2];
#pragma unroll
                for (int q = 0; q < 2; ++q) { const int m = 2 * mp + q; const float rs = rsv[ai * 4 + m] * 0.03125f;
                    const f32x2 rs2 = {rs, rs}; unsigned w[2];
#pragma unroll
                    for (int h = 0; h < 2; ++h) { f32x2 o[2];
#pragma unroll
                        for (int p = 0; p < 2; ++p) {
                            f32x2 g = (f32x2){acc[ai][0][m][h][2 * p], acc[ai][0][m][h][2 * p + 1]} * rs2 + bg[h][p];
                            f32x2 u1 = (f32x2){acc[ai][1][m][h][2 * p], acc[ai][1][m][h][2 * p + 1]} * rs2 + bu[h][p];
                            g.x = fminf(g.x, 7.f); g.y = fminf(g.y, 7.f); u1.x = __builtin_amdgcn_fmed3f(u1.x, -6.f, 8.f); u1.y = __builtin_amdgcn_fmed3f(u1.y, -6.f, 8.f);
                            const f32x2 t = g * (f32x2){KS, KS};
                            const f32x2 d = (f32x2){__builtin_amdgcn_exp2f(t.x), __builtin_amdgcn_exp2f(t.y)} + (f32x2){1.f, 1.f};
                            const f32x2 r = {__builtin_amdgcn_rcpf(d.x), __builtin_amdgcn_rcpf(d.y)};
                            o[p] = (g * r) * u1; }
                        w[h] = __builtin_amdgcn_cvt_pk_fp8_f32(o[0].x, o[0].y, 0u, false); w[h] = __builtin_amdgcn_cvt_pk_fp8_f32(o[1].x, o[1].y, w[h], true); }
                    pk[q] = (v2u_t){w[0], w[1]}; }
                const auto r0 = __builtin_amdgcn_permlane32_swap(pk[0][0], pk[1][0], false, false), r1 = __builtin_amdgcn_permlane32_swap(pk[0][1], pk[1][1], false, false);
                *(u32x4*)(obase + (size_t)(ai * HALF + mp * 32) * DFF) = (u32x4){r0[0], r1[0], r0[1], r1[1]}; }
    }
};
struct EpiDown {
    static constexpr bool PERM = true, AFTER_DRAIN = false;
    const float* __restrict__ bdn; const float* __restrict__ ew; unsigned char* __restrict__ yb; const PG8_LAS int* pst;
    __device__ __forceinline__ void operator()(const f32x4 (&acc)[2][2][4][2], const Unit& u, int wr, int wc, int fr, int fq) const {
        const int e = u.pn >> 2, pn = u.pn & 3, row0 = u.pm * BM + wr * 64 + fr, col0 = pn * BM + wc * 64 + 16 * fq;
        const float* wp = ew + (size_t)e * NV + (row0 - pst[e]);
        f32x4 bv[2][2];
#pragma unroll
        for (int bj = 0; bj < 2; ++bj) { bv[bj][0] = *(const f32x4*)(bdn + (size_t)e * D + col0 + 8 * bj); bv[bj][1] = *(const f32x4*)(bdn + (size_t)e * D + col0 + 8 * bj + 4); }
        float wv[8];
#pragma unroll
        for (int it = 0; it < 8; ++it) wv[it] = wp[(it >> 2) * HALF + (it & 3) * 16];
#pragma unroll
        for (int ai = 0; ai < 2; ++ai)
#pragma unroll
            for (int m = 0; m < 4; ++m) { const size_t row = (size_t)(row0 + ai * HALF + m * 16); const float w = wv[ai * 4 + m] * 16.f;
                const v2u_t lo = pack8_fp8_sat((acc[ai][0][m][0] * 0.03125f + bv[0][0]) * w, (acc[ai][0][m][1] * 0.03125f + bv[0][1]) * w), hi = pack8_fp8_sat((acc[ai][1][m][0] * 0.03125f + bv[1][0]) * w, (acc[ai][1][m][1] * 0.03125f + bv[1][1]) * w);
                *(u32x4*)(yb + row * D + col0) = (u32x4){lo[0], lo[1], hi[0], hi[1]}; }
    }
};
struct GroupOrder {
    int ntiles, ncol, G, c; const PG8_LAS unsigned char* texp;
    __device__ __forceinline__ bool next(int i, Unit& u) const { const int x = c & 7, w = c >> 3, uu = i * (G >> 3) + w, lj = uu / ncol, pn = uu - lj * ncol, j = lj * 8 + x; if (j >= ntiles) return false; u.pm = j; u.pn = (int)texp[j] * ncol + pn; return true; }
    __device__ __forceinline__ void a_ready(const Unit&) const {}
    __device__ __forceinline__ void done(const Unit&) const {}
};
}

typedef short bf16x8 __attribute__((ext_vector_type(8)));
typedef float f32x16 __attribute__((ext_vector_type(16)));
#define MFMA32(a, b, c) __builtin_amdgcn_mfma_f32_32x32x16_bf16(a, b, c, 0, 0, 0)
__device__ __forceinline__ bf16x8 ldfrag(const LAS unsigned char* base, int st, int row0, int k0, int lane) { return *(const LAS bf16x8*)(base + (row0 + (lane & 31)) * st + (k0 + 8 * (lane >> 5)) * 2); }
__device__ __forceinline__ bf16x8 ldf(const LAS unsigned char* lanebase, int off) { return *(const LAS bf16x8*)(lanebase + off); }
__device__ __forceinline__ float fexp(float x) { return __builtin_amdgcn_exp2f(x * 1.4426950408889634f); }

__device__ __forceinline__ void p3_hgrn2_mfma(Frame& F, int bh) {
    unsigned char* ws = F.ws; const int b = bh >> 2, h = bh & 3, tid = F.tid, lane = F.lane, wave = F.wave, hh = lane >> 5, l31 = lane & 31;
    const bf16* HQ = (const bf16*)(ws + WS_HQ) + h * 128; const bf16* HG = (const bf16*)(ws + WS_HG) + h * 128; const bf16* HV = (const bf16*)(ws + WS_HV) + h * 128;
    const bf16* HGATE = (const bf16*)(ws + WS_HGATE) + h * 128; bf16* YHG = (bf16*)(ws + WS_YHG) + h * 128;
    LAS unsigned char* L = F.lds + RING_OFF;
    LAS unsigned char* QT = L; LAS unsigned char* KT = L + 17408; LAS unsigned char* KTT = L + 34816; LAS unsigned char* VT = L + 53248; LAS unsigned char* ST = L + 71680; LAS unsigned char* PP = L + 106496;
    LAS float* SEG = (LAS float*)(L + 115712); LAS float* ER = (LAS float*)(L + 117760); LAS float* EL = (LAS float*)(L + 118272); LAS float* OST = (LAS float*)(L + 17408);
    const int d = tid & 127, pq = tid >> 7;
    const int et = tid >> 3, evq = tid & 7;
    const int f144 = l31 * 144 + hh * 16, f272 = l31 * 272 + hh * 16;
    const int sst = wave == 2 ? 1 : 0, stt = wave == 0 ? 0 : 1, dt = wave & 3, vt0 = 2 * (wave >> 2), btt = wave & 1, bvt = wave >> 1;
    const LAS unsigned char* aK = KT + 32 * sst * 272 + f272; const LAS unsigned char* bQ = QT + 32 * stt * 272 + f272;
    LAS unsigned char* pst = PP + (32 * stt + l31) * 144 + (32 * sst + 4 * hh) * 2;
    const LAS unsigned char* aKTT = KTT + 32 * dt * 144 + f144; const LAS unsigned char* bV0 = VT + 32 * vt0 * 144 + f144;
    LAS unsigned char* sst_ = ST + (32 * vt0 + l31) * 272 + (32 * dt + 4 * hh) * 2;
    const LAS float* erp = ER + 32 * dt + 4 * hh; const LAS float* elp = EL + 32 * dt + 4 * hh;
    const LAS unsigned char* aP = PP + 32 * btt * 144 + f144; const LAS unsigned char* bVB = VT + 32 * bvt * 144 + f144;
    const LAS unsigned char* aQ = QT + 32 * btt * 272 + f272; const LAS unsigned char* bS = ST + 32 * bvt * 272 + f272;
    LAS float* ost = OST + (32 * btt + 4 * hh) * 132 + 32 * bvt + l31; const LAS float* oep = OST + et * 132 + 16 * evq;
    LAS unsigned char* tq = QT + 16 * pq * 272 + d * 2; LAS unsigned char* tk = KT + 16 * pq * 272 + d * 2; LAS unsigned char* tkt = KTT + d * 144 + pq * 32; LAS unsigned char* tv = VT + d * 144 + pq * 32;
    f32x16 S0, S1;
#pragma unroll
    for (int i = 0; i < 16; ++i) { S0[i] = 0.f; S1[i] = 0.f; }
    unsigned gr[16], qr[16], vr[16]; v4u gt0, gt1;
    float gn[16];
#pragma unroll
    for (int i = 0; i < 16; ++i) gn[i] = F.in[IN_HGNORM][h * 128 + 16 * evq + i];
#define HG_LOAD(c) do { const int ttb = 64 * (c) - 48 + 16 * pq; \
        _Pragma("unroll") for (int i = 0; i < 16; ++i) { const int tt = ttb + i; if (tt >= 0) { const size_t gi = rowof(b, tt) * HW + d; gr[i] = (unsigned)HG[gi]; qr[i] = (unsigned)HQ[gi]; vr[i] = (unsigned)HV[gi]; } else { gr[i] = 0u; qr[i] = 0u; vr[i] = 0u; } } \
        { const int tt = 64 * (c) - 48 + et; if (tt >= 0) { const GAS v4u* gp = (const GAS v4u*)(HGATE + rowof(b, tt) * HW + 16 * evq); gt0 = gp[0]; gt1 = gp[1]; } else { gt0 = (v4u){0u, 0u, 0u, 0u}; gt1 = gt0; } } } while (0)
    HG_LOAD(0);
    for (int c = 0; c < 33; ++c) {
        float bl[16], gq[16];
#pragma unroll
        for (int i = 0; i < 16; ++i) gq[i] = __builtin_bit_cast(float, gr[i] << 16);
        { float a = 0.f;
#pragma unroll
          for (int i = 0; i < 16; ++i) { a += gq[i]; bl[i] = a; } }
        SEG[pq * 128 + d] = bl[15];
        __syncthreads();
        { const float s0 = SEG[d], s1 = SEG[128 + d], s2 = SEG[256 + d], s3 = SEG[384 + d];
          const float off = pq == 0 ? 0.f : pq == 1 ? s0 : pq == 2 ? s0 + s1 : (s0 + s1) + s2, r = s0 + s1, blast = (s0 + s1) + (s2 + s3);
          unsigned kp[8], vp[8];
#pragma unroll
          for (int i = 0; i < 16; i += 2) {
              const float b0 = off + bl[i], b1 = off + bl[i + 1];
              const float q0 = __builtin_bit_cast(float, qr[i] << 16) * fexp(b0 - r), q1 = __builtin_bit_cast(float, qr[i + 1] << 16) * fexp(b1 - r);
              const float k0 = (1.f - fexp(gq[i])) * fexp(r - b0), k1 = (1.f - fexp(gq[i + 1])) * fexp(r - b1);
              const unsigned kk = pg8::cvt_pk_bf16(k0, k1), qq = pg8::cvt_pk_bf16(q0, q1);
              *(LAS unsigned short*)(tq + i * 272) = (unsigned short)qq; *(LAS unsigned short*)(tq + (i + 1) * 272) = (unsigned short)(qq >> 16);
              *(LAS unsigned short*)(tk + i * 272) = (unsigned short)kk; *(LAS unsigned short*)(tk + (i + 1) * 272) = (unsigned short)(kk >> 16);
              kp[i >> 1] = kk; vp[i >> 1] = vr[i] | (vr[i + 1] << 16); }
          *(LAS v4u*)(tkt) = (v4u){kp[0], kp[1], kp[2], kp[3]}; *(LAS v4u*)(tkt + 16) = (v4u){kp[4], kp[5], kp[6], kp[7]};
          *(LAS v4u*)(tv) = (v4u){vp[0], vp[1], vp[2], vp[3]}; *(LAS v4u*)(tv + 16) = (v4u){vp[4], vp[5], vp[6], vp[7]};
          if (pq == 0) { ER[d] = fexp(r); EL[d] = fexp(blast - r); } }
        const v4u g0 = gt0, g1 = gt1;
        __syncthreads();
        if (c + 1 < 33) HG_LOAD(c + 1);
        asm volatile("" ::: "memory");
        if (wave < 3) {
            f32x16 acc;
#pragma unroll
            for (int i = 0; i < 16; ++i) acc[i] = 0.f;
#pragma unroll
            for (int ks = 0; ks < 8; ++ks) acc = MFMA32(ldf(aK, 32 * ks), ldf(bQ, 32 * ks), acc);
            const int t = 32 * stt + l31;
#pragma unroll
            for (int g4 = 0; g4 < 4; ++g4) { const int s0 = 32 * sst + 8 * g4 + 4 * hh;
                const float x0 = (s0 + 0 <= t) ? acc[4 * g4 + 0] : 0.f, x1 = (s0 + 1 <= t) ? acc[4 * g4 + 1] : 0.f, x2 = (s0 + 2 <= t) ? acc[4 * g4 + 2] : 0.f, x3 = (s0 + 3 <= t) ? acc[4 * g4 + 3] : 0.f;
                *(LAS v2u*)(pst + 16 * g4) = (v2u){pg8::cvt_pk_bf16(x0, x1), pg8::cvt_pk_bf16(x2, x3)}; }
        }
        {
#pragma unroll
          for (int g4 = 0; g4 < 4; ++g4) { const f32x4 er = *(const LAS f32x4*)(erp + 8 * g4);
#pragma unroll
              for (int i = 0; i < 4; ++i) { S0[4 * g4 + i] *= er[i]; S1[4 * g4 + i] *= er[i]; }
              *(LAS v2u*)(sst_ + 16 * g4) = (v2u){pg8::cvt_pk_bf16(S0[4 * g4], S0[4 * g4 + 1]), pg8::cvt_pk_bf16(S0[4 * g4 + 2], S0[4 * g4 + 3])};
              *(LAS v2u*)(sst_ + 32 * 272 + 16 * g4) = (v2u){pg8::cvt_pk_bf16(S1[4 * g4], S1[4 * g4 + 1]), pg8::cvt_pk_bf16(S1[4 * g4 + 2], S1[4 * g4 + 3])}; }
#pragma unroll
          for (int ks = 0; ks < 4; ++ks) { const bf16x8 a = ldf(aKTT, 32 * ks); S0 = MFMA32(a, ldf(bV0, 32 * ks), S0); S1 = MFMA32(a, ldf(bV0, 32 * 144 + 32 * ks), S1); }
#pragma unroll
          for (int g4 = 0; g4 < 4; ++g4) { const f32x4 el = *(const LAS f32x4*)(elp + 8 * g4);
#pragma unroll
              for (int i = 0; i < 4; ++i) { S0[4 * g4 + i] *= el[i]; S1[4 * g4 + i] *= el[i]; } } }
        __syncthreads();
        { f32x16 acc;
#pragma unroll
          for (int i = 0; i < 16; ++i) acc[i] = 0.f;
#pragma unroll
          for (int ks = 0; ks < 4; ++ks) if (ks < 2 || btt == 1) acc = MFMA32(ldf(aP, 32 * ks), ldf(bVB, 32 * ks), acc);
#pragma unroll
          for (int ks = 0; ks < 8; ++ks) acc = MFMA32(ldf(aQ, 32 * ks), ldf(bS, 32 * ks), acc);
#pragma unroll
          for (int i = 0; i < 16; ++i) ost[((i & 3) + 8 * (i >> 2)) * 132] = acc[i]; }
        __syncthreads();
        { const int tt = 64 * c - 48 + et;
          f32x4 o[4]; float ss = 0.f;
#pragma unroll
          for (int j = 0; j < 4; ++j) { o[j] = *(const LAS f32x4*)(oep + 4 * j); ss += (o[j].x * o[j].x + o[j].y * o[j].y) + (o[j].z * o[j].z + o[j].w * o[j].w); }
          ss += __shfl_xor(ss, 1); ss += __shfl_xor(ss, 2); ss += __shfl_xor(ss, 4);
          const float rs = 1.0f / sqrtf(ss * (1.f / 128.f) + EPS);
          if (tt >= NMETA || (tt >= 0 && b == 0)) { const unsigned gw[8] = {g0.x, g0.y, g0.z, g0.w, g1.x, g1.y, g1.z, g1.w}; unsigned w[8];
#pragma unroll
              for (int j = 0; j < 4; ++j) { w[2 * j] = pk2(o[j].x * rs * gn[4 * j] * bflo(gw[2 * j]), o[j].y * rs * gn[4 * j + 1] * bfhi(gw[2 * j])); w[2 * j + 1] = pk2(o[j].z * rs * gn[4 * j + 2] * bflo(gw[2 * j + 1]), o[j].w * rs * gn[4 * j + 3] * bfhi(gw[2 * j + 1])); }
              GAS v4u* yp = (GAS v4u*)(YHG + rowof(b, tt) * HW + 16 * evq); yp[0] = (v4u){w[0], w[1], w[2], w[3]}; yp[1] = (v4u){w[4], w[5], w[6], w[7]}; } }
        __syncthreads();
    }
#undef HG_LOAD
}


#define DPP_F(old, v, ctrl, rmask) __builtin_bit_cast(float, __builtin_amdgcn_update_dpp(__builtin_bit_cast(int, (float)(old)), __builtin_bit_cast(int, (float)(v)), (ctrl), (rmask), 0xf, false))
__device__ __forceinline__ float wave_scan_add(float v) {
    v += DPP_F(0.f, v, 0x111, 0xf); v += DPP_F(0.f, v, 0x112, 0xf); v += DPP_F(0.f, v, 0x114, 0xf); v += DPP_F(0.f, v, 0x118, 0xf);
    v += DPP_F(0.f, v, 0x142, 0xa); v += DPP_F(0.f, v, 0x143, 0xc); return v;
}
__device__ __forceinline__ float wave_scan_max(float v) {
    const float ni = -INFINITY;
    v = fmaxf(v, DPP_F(ni, v, 0x111, 0xf)); v = fmaxf(v, DPP_F(ni, v, 0x112, 0xf)); v = fmaxf(v, DPP_F(ni, v, 0x114, 0xf)); v = fmaxf(v, DPP_F(ni, v, 0x118, 0xf));
    v = fmaxf(v, DPP_F(ni, v, 0x142, 0xa)); v = fmaxf(v, DPP_F(ni, v, 0x143, 0xc)); return v;
}
__device__ __forceinline__ void p3_mlstm_mfma(Frame& F, int bh) {
    unsigned char* ws = F.ws; const int b = bh >> 2, h = bh & 3, tid = F.tid, lane = F.lane, wave = F.wave, hh = lane >> 5, l31 = lane & 31;
    const bf16* MMg = (const bf16*)(ws + WS_MM) + h * 128; const bf16* MOg = (const bf16*)(ws + WS_MO) + h * 128; const float* LI = (const float*)(ws + WS_LI) + h; const float* LF = (const float*)(ws + WS_LF) + h;
    bf16* YML = (bf16*)(ws + WS_YML) + h * 128;
    LAS unsigned char* L = F.lds + RING_OFF;
    LAS unsigned char* CT = L; LAS unsigned char* MT = L + 17408; LAS unsigned char* KM = L + 34816; LAS unsigned char* KW = L + 44032; LAS unsigned char* QM = L + 53248; LAS unsigned char* QW = L + 62464;
    LAS unsigned char* VT = L + 71680; LAS unsigned char* SV = L + 90112; LAS unsigned char* PP = L + 108544; LAS float* OST = (LAS float*)(L + 17408);
    LAS float* SM = (LAS float*)(L + 117760);
    LAS float* U = SM; LAS float* MX = SM + 64; LAS float* BB = SM + 128; LAS float* WSs = SM + 192; LAS float* WI = SM + 256; LAS float* DENP = SM + 320  ; LAS float* NN = SM + 416; LAS float* DENI = SM + 480; LAS float* SC = SM + 544  ; LAS float* GNS = SM + 560  ;
    const int ch = tid & 127, pq = tid >> 7, et = tid >> 3, evq = tid & 7;
    const int f144 = l31 * 144 + hh * 16, f272 = l31 * 272 + hh * 16;
    const int sst = wave == 2 ? 1 : 0, stt = wave == 0 ? 0 : 1, dkt = wave & 1, svt = wave >> 1;
    const LAS unsigned char* cfp = (wave < 4 ? CT : MT) + f272;
    LAS unsigned char* qst = QM + l31 * 144 + (32 * (wave & 1) + 4 * hh) * 2; LAS unsigned char* qwst = QW + l31 * 144 + (32 * (wave & 1) + 4 * hh) * 2;
    const int kdk = 32 * (wave & 1) + l31;
    LAS unsigned char* kmst = KM + 4 * hh * 144 + kdk * 2; LAS unsigned char* kwst = KW + kdk * 144 + 4 * hh * 2; const LAS float* wsp = WSs + 4 * hh;
    LAS unsigned char* vst = VT + (32 * (wave & 3) + l31) * 144 + 4 * hh * 2;
    const LAS unsigned char* aKM = KM + 32 * sst * 144 + f144; const LAS unsigned char* bQM = QM + 32 * stt * 144 + f144;
    LAS unsigned char* pst = PP + (32 * stt + l31) * 144 + (32 * sst + 4 * hh) * 2; const LAS float* up = U + 32 * sst + 4 * hh;
    LAS unsigned char* svst = SV + (32 * svt + l31) * 144 + (32 * dkt + 4 * hh) * 2;
    const LAS unsigned char* aKW = KW + 32 * dkt * 144 + f144; const LAS unsigned char* bVT = VT + 32 * svt * 144 + f144;
    const LAS unsigned char* aP = PP + 32 * dkt * 144 + f144; const LAS unsigned char* aQW = QW + 32 * dkt * 144 + f144; const LAS unsigned char* bSV = SV + 32 * svt * 144 + f144;
    LAS float* ost = OST + (32 * dkt + 4 * hh) * 132 + 32 * svt + l31; const LAS float* oep = OST + et * 132 + 16 * evq;
    LAS unsigned char* tc = CT + 16 * pq * 272 + ch * 2; LAS unsigned char* tm = MT + 16 * pq * 272 + ch * 2;
    bf16x8 wf[8];
    { const float* W = wave < 2 ? F.in[IN_WQ] + (size_t)h * 128 * 64 + 32 * wave + l31 : wave < 4 ? F.in[IN_WK] + (size_t)h * 128 * 64 + 32 * (wave - 2) + l31 : F.in[IN_WV] + (size_t)h * 128 * 128 + 32 * (wave - 4) + l31;
      const int ld = wave < 4 ? 64 : 128; const float sc = wave < 2 ? 0.125f : 1.f;
#pragma unroll
      for (int ks = 0; ks < 8; ++ks) { unsigned p[4];
#pragma unroll
          for (int j = 0; j < 4; ++j) p[j] = pk2(W[(size_t)(16 * ks + 8 * hh + 2 * j) * ld] * sc, W[(size_t)(16 * ks + 8 * hh + 2 * j + 1) * ld] * sc);
          wf[ks] = __builtin_bit_cast(bf16x8, (v4u){p[0], p[1], p[2], p[3]}); } }
    float cw[4]; const float cb = F.in[IN_CONVB][h * 128 + ch];
#pragma unroll
    for (int j = 0; j < 4; ++j) cw[j] = F.in[IN_CONVW][j * HW + h * 128 + ch];
    if (tid < 128) GNS[tid] = F.in[IN_MLNORM][h * 128 + tid]; else if (tid < 256) GNS[tid] = F.in[IN_MLSKIP][h * 128 + tid - 128];
    f32x16 S;
#pragma unroll
    for (int i = 0; i < 16; ++i) S[i] = 0.f;
    float mcar = 0.f, nreg = 0.f;
    unsigned mr[19]; v4u gt0, gt1; float pli = 0.f, plf = 0.f;
#define ML_LOAD(c) do { const int ttb = 64 * (c) - 48 + 16 * pq - 3; \
        _Pragma("unroll") for (int i = 0; i < 19; ++i) { const int tt = ttb + i; mr[i] = tt >= 0 ? (unsigned)MMg[rowof(b, tt) * HW + ch] : 0u; } \
        { const int tt = 64 * (c) - 48 + et; if (tt >= 0) { const GAS v4u* gp = (const GAS v4u*)(MOg + rowof(b, tt) * HW + 16 * evq); gt0 = gp[0]; gt1 = gp[1]; } else { gt0 = (v4u){0u, 0u, 0u, 0u}; gt1 = gt0; } } \
        if (wave == 0) { const int tt = 64 * (c) - 48 + lane; if (tt >= 0) { pli = LI[rowof(b, tt) * 4]; plf = LF[rowof(b, tt) * 4]; } else { pli = -1e30f; plf = 0.f; } } } while (0)
    ML_LOAD(0);
    for (int c = 0; c < 33; ++c) {
#pragma unroll
        for (int i = 0; i < 16; ++i) { const float a = cb + (cw[0] * __builtin_bit_cast(float, mr[i] << 16) + cw[1] * __builtin_bit_cast(float, mr[i + 1] << 16)) + (cw[2] * __builtin_bit_cast(float, mr[i + 2] << 16) + cw[3] * __builtin_bit_cast(float, mr[i + 3] << 16));
            *(LAS unsigned short*)(tc + i * 272) = (unsigned short)f2bf(fsilu(a)); *(LAS unsigned short*)(tm + i * 272) = (unsigned short)mr[i + 3]; }
        if (wave == 0) {
            const float bs = wave_scan_add(plf);
            const float u = pli - bs; const float pm = wave_scan_max(u);
            const float M = fmaxf(mcar, pm), M63 = __shfl(M, 63), b63 = __shfl(bs, 63);
            U[lane] = u; MX[lane] = M; BB[lane] = bs; WSs[lane] = fexp(u - M63); WI[lane] = fexp(mcar - M);
            if (lane == 0) { SC[0] = b63; SC[1] = M63; }
        }
        __syncthreads();
        { f32x16 a0, a1;
#pragma unroll
          for (int i = 0; i < 16; ++i) { a0[i] = 0.f; a1[i] = 0.f; }
          if (wave < 2) {
#pragma unroll
              for (int ks = 0; ks < 8; ++ks) { a0 = MFMA32(wf[ks], ldf(cfp, 32 * ks), a0); a1 = MFMA32(wf[ks], ldf(cfp, 32 * 272 + 32 * ks), a1); }
              const float wi0 = WI[l31], wi1 = WI[32 + l31];
#pragma unroll
              for (int g4 = 0; g4 < 4; ++g4) {
                  *(LAS v2u*)(qst + 16 * g4) = (v2u){pg8::cvt_pk_bf16(a0[4 * g4], a0[4 * g4 + 1]), pg8::cvt_pk_bf16(a0[4 * g4 + 2], a0[4 * g4 + 3])};
                  *(LAS v2u*)(qst + 32 * 144 + 16 * g4) = (v2u){pg8::cvt_pk_bf16(a1[4 * g4], a1[4 * g4 + 1]), pg8::cvt_pk_bf16(a1[4 * g4 + 2], a1[4 * g4 + 3])};
                  *(LAS v2u*)(qwst + 16 * g4) = (v2u){pg8::cvt_pk_bf16(a0[4 * g4] * wi0, a0[4 * g4 + 1] * wi0), pg8::cvt_pk_bf16(a0[4 * g4 + 2] * wi0, a0[4 * g4 + 3] * wi0)};
                  *(LAS v2u*)(qwst + 32 * 144 + 16 * g4) = (v2u){pg8::cvt_pk_bf16(a1[4 * g4] * wi1, a1[4 * g4 + 1] * wi1), pg8::cvt_pk_bf16(a1[4 * g4 + 2] * wi1, a1[4 * g4 + 3] * wi1)}; }
          } else {
#pragma unroll
              for (int ks = 0; ks < 8; ++ks) { a0 = MFMA32(ldf(cfp, 32 * ks), wf[ks], a0); a1 = MFMA32(ldf(cfp, 32 * 272 + 32 * ks), wf[ks], a1); }
              if (wave < 4) {
                  float nsum = 0.f;
#pragma unroll
                  for (int g4 = 0; g4 < 4; ++g4) { const f32x4 w0 = *(const LAS f32x4*)(wsp + 8 * g4), w1 = *(const LAS f32x4*)(wsp + 32 + 8 * g4);
#pragma unroll
                      for (int i = 0; i < 4; ++i) { *(LAS unsigned short*)(kmst + (8 * g4 + i) * 144) = (unsigned short)f2bf(a0[4 * g4 + i]); *(LAS unsigned short*)(kmst + (32 + 8 * g4 + i) * 144) = (unsigned short)f2bf(a1[4 * g4 + i]); }
                      const float x0 = a0[4 * g4] * w0[0], x1 = a0[4 * g4 + 1] * w0[1], x2 = a0[4 * g4 + 2] * w0[2], x3 = a0[4 * g4 + 3] * w0[3];
                      const float y0 = a1[4 * g4] * w1[0], y1 = a1[4 * g4 + 1] * w1[1], y2 = a1[4 * g4 + 2] * w1[2], y3 = a1[4 * g4 + 3] * w1[3];
                      nsum += ((x0 + x1) + (x2 + x3)) + ((y0 + y1) + (y2 + y3));
                      *(LAS v2u*)(kwst + 16 * g4) = (v2u){pg8::cvt_pk_bf16(x0, x1), pg8::cvt_pk_bf16(x2, x3)};
                      *(LAS v2u*)(kwst + 64 + 16 * g4) = (v2u){pg8::cvt_pk_bf16(y0, y1), pg8::cvt_pk_bf16(y2, y3)}; }
                  nsum += __shfl_xor(nsum, 32);
                  if (hh == 0) NN[kdk] = nreg;
                  nreg = fexp(mcar - SC[1]) * nreg + nsum;
              } else {
#pragma unroll
                  for (int g4 = 0; g4 < 4; ++g4) {
                      *(LAS v2u*)(vst + 16 * g4) = (v2u){pg8::cvt_pk_bf16(a0[4 * g4], a0[4 * g4 + 1]), pg8::cvt_pk_bf16(a0[4 * g4 + 2], a0[4 * g4 + 3])};
                      *(LAS v2u*)(vst + 64 + 16 * g4) = (v2u){pg8::cvt_pk_bf16(a1[4 * g4], a1[4 * g4 + 1]), pg8::cvt_pk_bf16(a1[4 * g4 + 2], a1[4 * g4 + 3])}; }
              }
          } }
        __syncthreads();
        const v4u g0 = gt0, g1 = gt1;
        if (c + 1 < 33) ML_LOAD(c + 1);
        asm volatile("" ::: "memory");
        if (wave < 3) {
            f32x16 acc;
#pragma unroll
            for (int i = 0; i < 16; ++i) acc[i] = 0.f;
#pragma unroll
            for (int ks = 0; ks < 4; ++ks) acc = MFMA32(ldf(aKM, 32 * ks), ldf(bQM, 32 * ks), acc);
            const int t = 32 * stt + l31; const float mt = MX[t]; float dsum = 0.f;
#pragma unroll
            for (int g4 = 0; g4 < 4; ++g4) { const int s0 = 32 * sst + 8 * g4 + 4 * hh; const f32x4 us = *(const LAS f32x4*)(up + 8 * g4);
                const float x0 = (s0 + 0 <= t) ? acc[4 * g4 + 0] * fexp(us[0] - mt) : 0.f, x1 = (s0 + 1 <= t) ? acc[4 * g4 + 1] * fexp(us[1] - mt) : 0.f;
                const float x2 = (s0 + 2 <= t) ? acc[4 * g4 + 2] * fexp(us[2] - mt) : 0.f, x3 = (s0 + 3 <= t) ? acc[4 * g4 + 3] * fexp(us[3] - mt) : 0.f;
                dsum += (x0 + x1) + (x2 + x3);
                *(LAS v2u*)(pst + 16 * g4) = (v2u){pg8::cvt_pk_bf16(x0, x1), pg8::cvt_pk_bf16(x2, x3)}; }
            dsum += __shfl_xor(dsum, 32);
            if (hh == 0) DENP[wave * 32 + l31] = dsum;
        } else if (wave == 3) {
            float a = 0.f;
#pragma unroll 2
            for (int j = 0; j < 8; ++j) { const v4u q = *(const LAS v4u*)(QW + lane * 144 + 16 * j); const f32x4 n0 = *(const LAS f32x4*)(NN + 8 * j), n1 = *(const LAS f32x4*)(NN + 8 * j + 4);
                a += (bflo(q.x) * n0[0] + bfhi(q.x) * n0[1]) + (bflo(q.y) * n0[2] + bfhi(q.y) * n0[3]) + (bflo(q.z) * n1[0] + bfhi(q.z) * n1[1]) + (bflo(q.w) * n1[2] + bfhi(q.w) * n1[3]); }
            DENI[lane] = a;
        }
        { const float wp = fexp(mcar - SC[1]);
#pragma unroll
          for (int g4 = 0; g4 < 4; ++g4) {
              *(LAS v2u*)(svst + 16 * g4) = (v2u){pg8::cvt_pk_bf16(S[4 * g4], S[4 * g4 + 1]), pg8::cvt_pk_bf16(S[4 * g4 + 2], S[4 * g4 + 3])};
#pragma unroll
              for (int i = 0; i < 4; ++i) S[4 * g4 + i] *= wp; }
#pragma unroll
          for (int ks = 0; ks < 4; ++ks) S = MFMA32(ldf(aKW, 32 * ks), ldf(bVT, 32 * ks), S); }
        __syncthreads();
        { f32x16 acc;
#pragma unroll
          for (int i = 0; i < 16; ++i) acc[i] = 0.f;
#pragma unroll
          for (int ks = 0; ks < 4; ++ks) if (ks < 2 || dkt == 1) acc = MFMA32(ldf(aP, 32 * ks), ldf(bVT, 32 * ks), acc);
#pragma unroll
          for (int ks = 0; ks < 4; ++ks) acc = MFMA32(ldf(aQW, 32 * ks), ldf(bSV, 32 * ks), acc);
#pragma unroll
          for (int i = 0; i < 16; ++i) ost[((i & 3) + 8 * (i >> 2)) * 132] = acc[i]; }
        __syncthreads();
        { const int tt = 64 * c - 48 + et;
          const float den = (et < 32 ? DENP[et] : DENP[et] + DENP[32 + et]) + DENI[et];
          const float inv = 1.0f / fmaxf(fabsf(den), fexp(-(BB[et] + MX[et])));
          f32x4 o[4]; float ss = 0.f;
#pragma unroll
          for (int j = 0; j < 4; ++j) { o[j] = *(const LAS f32x4*)(oep + 4 * j) * inv; ss += (o[j].x * o[j].x + o[j].y * o[j].y) + (o[j].z * o[j].z + o[j].w * o[j].w); }
          ss += __shfl_xor(ss, 1); ss += __shfl_xor(ss, 2); ss += __shfl_xor(ss, 4);
          const float rs = 1.0f / sqrtf(ss * (1.f / 128.f) + EPS);
          if (tt >= NMETA || (tt >= 0 && b == 0)) { const unsigned gw[8] = {g0.x, g0.y, g0.z, g0.w, g1.x, g1.y, g1.z, g1.w}; unsigned w[8];
              const v4u c0 = *(const LAS v4u*)(CT + et * 272 + 32 * evq), c1 = *(const LAS v4u*)(CT + et * 272 + 32 * evq + 16); const unsigned cwd[8] = {c0.x, c0.y, c0.z, c0.w, c1.x, c1.y, c1.z, c1.w};
#pragma unroll
              for (int j = 0; j < 4; ++j) { const f32x4 gn = *(const LAS f32x4*)(GNS + 16 * evq + 4 * j), sk = *(const LAS f32x4*)(GNS + 128 + 16 * evq + 4 * j);
                  w[2 * j] = pk2((o[j].x * rs * gn[0] + sk[0] * bflo(cwd[2 * j])) * bflo(gw[2 * j]), (o[j].y * rs * gn[1] + sk[1] * bfhi(cwd[2 * j])) * bfhi(gw[2 * j]));
                  w[2 * j + 1] = pk2((o[j].z * rs * gn[2] + sk[2] * bflo(cwd[2 * j + 1])) * bflo(gw[2 * j + 1]), (o[j].w * rs * gn[3] + sk[3] * bfhi(cwd[2 * j + 1])) * bfhi(gw[2 * j + 1])); }
              GAS v4u* yp = (GAS v4u*)(YML + rowof(b, tt) * HW + 16 * evq); yp[0] = (v4u){w[0], w[1], w[2], w[3]}; yp[1] = (v4u){w[4], w[5], w[6], w[7]}; }
          mcar = SC[0] + SC[1]; }
        __syncthreads();
    }
#undef ML_LOAD
}

typedef float f32x4v __attribute__((ext_vector_type(4)));
#define MFMA16F(a, b, c) __builtin_amdgcn_mfma_f32_16x16x4f32(a, b, c, 0, 0, 0)
constexpr int RW_LD = 516;
__device__ __forceinline__ void router_topk16(LAS float* LGw, int V, float rsv, int resrow, int lane, LAS int* hist, LAS int* res, int* TOPE, float* TOPW, float* RS) {
    if (lane < 16) {
        int se[4]; float sv[4];
#pragma unroll
        for (int k = 0; k < 4; ++k) { float best = -INFINITY; int bi = 0;
            for (int e = 0; e < 32; ++e) { const float v = LGw[lane * 33 + e]; if (v > best) { best = v; bi = e; } }
            se[k] = bi; sv[k] = best; LGw[lane * 33 + bi] = -INFINITY; }
        const float e1 = __expf(sv[1] - sv[0]), e2 = __expf(sv[2] - sv[0]), e3 = __expf(sv[3] - sv[0]), inv = 1.0f / (1.f + e1 + e2 + e3);
        const float w4[4] = {inv, e1 * inv, e2 * inv, e3 * inv};
#pragma unroll
        for (int k = 0; k < 4; ++k) { const int lp = __hip_atomic_fetch_add(hist + se[k], 1, __ATOMIC_RELAXED, __HIP_MEMORY_SCOPE_WORKGROUP);
            TOPE[(size_t)V * 4 + k] = se[k]; TOPW[(size_t)V * 4 + k] = w4[k]; res[(resrow + lane) * 4 + k] = lp; }
        RS[V] = rsv;
    }
}
__device__ __forceinline__ void p6_router(Frame& F) {
    unsigned char* ws = F.ws;
    const bf16* H1 = (const bf16*)(ws + WS_H1); const float* RWT = (const float*)(ws + WS_RWT);
    int* TOPE = (int*)(ws + WS_TOPE); int* TOPP = (int*)(ws + WS_TOPP); float* TOPW = (float*)(ws + WS_TOPW); float* RS = (float*)(ws + WS_RS);
    int* ETOK = (int*)(ws + WS_ETOK); float* ERS = (float*)(ws + WS_ERS); float* EW = (float*)(ws + WS_EW);
    LAS float* rw = (LAS float*)(F.lds + RING_OFF);
    LAS float* LG = (LAS float*)(F.lds + RING_OFF + 66048) + F.wave * 528;
    LAS int* hist = (LAS int*)(F.lds + RING_OFF + 66048 + 8 * 2112);
    LAS int* res = hist + 64;
    LAS float* XP = (LAS float*)(res + 144 * 4);
    LAS float* XQ = XP + 8 * 528;
    const int lane = F.lane, wave = F.wave, i16 = lane & 15, kk = lane >> 4;
    constexpr int RPW = NTOK / 256;
    const bool has_meta = (F.vcu == 0);
    const int Vbase = F.vcu * RPW, Vt = Vbase + 16 * wave;
    if (F.tid < 64) hist[F.tid] = 0;
    f32x4v acc0 = {0.f, 0.f, 0.f, 0.f}, acc1 = {0.f, 0.f, 0.f, 0.f}, acx0 = {0.f, 0.f, 0.f, 0.f}, acx1 = {0.f, 0.f, 0.f, 0.f}; float ssq = 0.f, xss = 0.f;
    const bf16* arow = H1 + (size_t)(Vt + i16) * D + 8 * kk;
    const bf16* xrow = H1 + (size_t)(NTOK + i16) * D + 8 * kk;
    v4u a0[4], a1[4];
#define RT_MMA(A, SB, C0, C1, SS) do { const LAS float* b0p = rw + i16 * RW_LD + 8 * kk + 128 * (SB); const LAS float* b1p = rw + (16 + i16) * RW_LD + 8 * kk + 128 * (SB); \
        _Pragma("unroll") for (int s = 0; s < 4; ++s) { const v4u aw = A[s]; \
            _Pragma("unroll") for (int h = 0; h < 2; ++h) { const unsigned w0 = h ? aw.z : aw.x, w1 = h ? aw.w : aw.y; const f32x4 a = {bflo(w0), bfhi(w0), bflo(w1), bfhi(w1)}; \
            const f32x4 b0 = *(const LAS f32x4*)(b0p + 32 * s + 4 * h), b1 = *(const LAS f32x4*)(b1p + 32 * s + 4 * h); \
            SS += (a.x * a.x + a.y * a.y) + (a.z * a.z + a.w * a.w); \
            C0 = MFMA16F(a.x, b0.x, C0); C1 = MFMA16F(a.x, b1.x, C1); C0 = MFMA16F(a.y, b0.y, C0); C1 = MFMA16F(a.y, b1.y, C1); \
            C0 = MFMA16F(a.z, b0.z, C0); C1 = MFMA16F(a.z, b1.z, C1); C0 = MFMA16F(a.w, b0.w, C0); C1 = MFMA16F(a.w, b1.w, C1); } } } while (0)
#pragma unroll
    for (int s = 0; s < 4; ++s) a0[s] = *(const GAS v4u*)(arow + 32 * s);
#pragma unroll 1
    for (int it = 0; it < 4; ++it) {
        const int half = it >> 1, sb0 = (2 * it) & 3;
        if ((it & 1) == 0) {
            __syncthreads();
            { f32x4 stg[8];
#pragma unroll
              for (int q = 0; q < 8; ++q) { const int u = F.tid + q * NTHREADS, e = u >> 7, c = u & 127; stg[q] = *(const GAS f32x4*)(RWT + (size_t)e * D + 512 * half + 4 * c); }
#pragma unroll
              for (int q = 0; q < 8; ++q) { const int u = F.tid + q * NTHREADS, e = u >> 7, c = u & 127; *(LAS f32x4*)(rw + e * RW_LD + 4 * c) = stg[q]; } }
            __syncthreads();
        }
#pragma unroll
        for (int s = 0; s < 4; ++s) a1[s] = *(const GAS v4u*)(arow + 128 * (2 * it + 1) + 32 * s);
        RT_MMA(a0, sb0, acc0, acc1, ssq);
        if (it < 3) {
#pragma unroll
            for (int s = 0; s < 4; ++s) a0[s] = *(const GAS v4u*)(arow + 128 * (2 * it + 2) + 32 * s);
        }
        RT_MMA(a1, sb0 + 1, acc0, acc1, ssq);
        if (has_meta && (wave >> 1) == it) {
            v4u ax[4];
#pragma unroll
            for (int s = 0; s < 4; ++s) ax[s] = *(const GAS v4u*)(xrow + 128 * wave + 32 * s);
            RT_MMA(ax, wave & 3, acx0, acx1, xss);
        }
    }
#undef RT_MMA
    if (has_meta) {
        xss += __shfl_xor(xss, 16); xss += __shfl_xor(xss, 32);
#pragma unroll
        for (int r = 0; r < 4; ++r) { XP[wave * 528 + (4 * kk + r) * 33 + i16] = acx0[r]; XP[wave * 528 + (4 * kk + r) * 33 + 16 + i16] = acx1[r]; }
        if (kk == 0) XQ[wave * 16 + i16] = xss;
    }
    ssq += __shfl_xor(ssq, 16); ssq += __shfl_xor(ssq, 32);
    const float rsrow = 1.0f / sqrtf(ssq * (1.f / D) + EPS);
    const float rb0 = F.in[IN_RB][i16], rb1 = F.in[IN_RB][16 + i16];
#pragma unroll
    for (int r = 0; r < 4; ++r) { const float rsr = __shfl(rsrow, 4 * kk + r); LG[(4 * kk + r) * 33 + i16] = acc0[r] * rsr + rb0; LG[(4 * kk + r) * 33 + 16 + i16] = acc1[r] * rsr + rb1; }
    LDS_WAIT(); asm volatile("" ::: "memory");
    router_topk16(LG, Vt + lane, rsrow, 16 * wave, lane, hist, res, TOPE, TOPW, RS);
    __syncthreads();
    if (has_meta && wave == 7) {
        float q = 0.f;
#pragma unroll
        for (int w = 0; w < 8; ++w) q += XQ[w * 16 + i16];
        const float rsm = 1.0f / sqrtf(q * (1.f / D) + EPS);
#pragma unroll
        for (int r = 0; r < 4; ++r) { float v0 = 0.f, v1 = 0.f;
#pragma unroll
            for (int w = 0; w < 8; ++w) { v0 += XP[w * 528 + (4 * kk + r) * 33 + i16]; v1 += XP[w * 528 + (4 * kk + r) * 33 + 16 + i16]; }
            const float rsr = __shfl(rsm, 4 * kk + r); LG[(4 * kk + r) * 33 + i16] = v0 * rsr + rb0; LG[(4 * kk + r) * 33 + 16 + i16] = v1 * rsr + rb1; }
        LDS_WAIT(); asm volatile("" ::: "memory");
        router_topk16(LG, NTOK + lane, rsm, 128, lane, hist, res, TOPE, TOPW, RS);
    }
    __syncthreads();
    if (F.tid < NE) hist[32 + F.tid] = (int)__hip_atomic_fetch_add(F.ctl + CW_CNT + 64 * F.tid, (unsigned)hist[F.tid], RLX_AGENT);
    __syncthreads();
    const int nrows = has_meta ? RPW + 16 : RPW;
    for (int u = F.tid; u < nrows * 4; u += NTHREADS) { const int rr = u >> 2, V = rr < RPW ? Vbase + rr : NTOK + (rr - RPW); const size_t gi = (size_t)V * 4 + (u & 3); const int e = TOPE[gi], pos = hist[32 + e] + res[u];
        TOPP[gi] = pos; ETOK[(size_t)e * NV + pos] = V; ERS[(size_t)e * NV + pos] = RS[V]; EW[(size_t)e * NV + pos] = TOPW[gi]; }
}

__device__ __forceinline__ void build_tables(Frame& F) {
    LAS int* pst = (LAS int*)(F.lds + PST_OFF); LAS unsigned char* texp = (LAS unsigned char*)(F.lds + TEXP_OFF);
    __syncthreads();
    if (F.tid < 64) {
        const int e = F.lane & 31; const int c = (int)__hip_atomic_load(F.ctl + CW_CNT + 64 * e, RLX_AGENT); const int nt = (c + 255) >> 8;
        int incl = nt;
#pragma unroll
        for (int o = 1; o < 32; o <<= 1) { const int t = __shfl_up(incl, o); if ((F.lane & 31) >= o) incl += t; }
        const int start = incl - nt;
        if (F.lane < 32) { pst[e] = start * 256; pst[33 + e] = c; for (int j = 0; j < nt && start + j < MAXTILES; ++j) texp[start + j] = (unsigned char)e; if (e == 31) pst[32] = incl < MAXTILES ? incl : MAXTILES; }
    }
    __syncthreads();
}
typedef float f32v2_t __attribute__((ext_vector_type(2)));
__device__ __forceinline__ void p10_combine(Frame& F) {
    unsigned char* ws = F.ws; build_tables(F);
    const LAS int* pst = (const LAS int*)(F.lds + PST_OFF);
    const bf16* H1 = (const bf16*)(ws + WS_H1); const unsigned char* YB = (const unsigned char*)(ws + WS_YB);
    const int* TOPE = (const int*)(ws + WS_TOPE); const int* TOPP = (const int*)(ws + WS_TOPP);
    const int gw = F.vcu * NWAVES + F.wave, NGW = F.G * NWAVES;
    const GAS f32x4* nf = (const GAS f32x4*)F.in[IN_NFIN] + F.lane; f32x4 nfv[4];
#pragma unroll
    for (int j = 0; j < 4; ++j) nfv[j] = nf[64 * j];
    int sl[2][4];
#define CMB_SLOTS(Rbase) do { _Pragma("unroll") for (int q = 0; q < 2; ++q) { const int R = (Rbase) + q * NGW; if (R < BATCH * SEQ) { const size_t V = (size_t)R; \
        _Pragma("unroll") for (int k = 0; k < 4; ++k) sl[q][k] = pst[TOPE[V * 4 + k]] + TOPP[V * 4 + k]; } else { _Pragma("unroll") for (int k = 0; k < 4; ++k) sl[q][k] = 0; } } } while (0)
    CMB_SLOTS(gw);
    for (int R0 = gw; R0 < BATCH * SEQ; R0 += 2 * NGW) {
        f32x4 v[2][4]; unsigned y[2][4][4];
#pragma unroll
        for (int q = 0; q < 2; ++q) { const int R = (R0 + q * NGW < BATCH * SEQ) ? R0 + q * NGW : R0; const size_t V = (size_t)R;
            const GAS v2u* hr = (const GAS v2u*)(H1 + V * D) + F.lane;
#pragma unroll
            for (int j = 0; j < 4; ++j) { const v2u hw = hr[64 * j]; v[q][j] = (f32x4){bflo(hw.x), bfhi(hw.x), bflo(hw.y), bfhi(hw.y)}; }
#pragma unroll
            for (int k = 0; k < 4; ++k) { const GAS unsigned* yr = (const GAS unsigned*)(YB + (size_t)sl[q][k] * D) + F.lane;
#pragma unroll
                for (int j = 0; j < 4; ++j) y[q][k][j] = yr[64 * j]; } }
        CMB_SLOTS(R0 + 2 * NGW);
#pragma unroll
        for (int q = 0; q < 2; ++q) { const int R = R0 + q * NGW; if (R >= BATCH * SEQ) continue;
#pragma unroll
            for (int k = 0; k < 4; ++k)
#pragma unroll
                for (int j = 0; j < 4; ++j) { const unsigned w = y[q][k][j]; const f32v2_t lo = __builtin_amdgcn_cvt_pk_f32_fp8(w, false), hi = __builtin_amdgcn_cvt_pk_f32_fp8(w, true);
                    v[q][j].x += lo[0] * 0.0625f; v[q][j].y += lo[1] * 0.0625f; v[q][j].z += hi[0] * 0.0625f; v[q][j].w += hi[1] * 0.0625f; }
            float s = 0.f;
#pragma unroll
            for (int j = 0; j < 4; ++j) s += (v[q][j].x * v[q][j].x + v[q][j].y * v[q][j].y) + (v[q][j].z * v[q][j].z + v[q][j].w * v[q][j].w);
            const float rs = 1.0f / sqrtf(wave_sum(s) * (1.f / D) + EPS);
            GAS f32x4* orow = (GAS f32x4*)(F.out + (size_t)R * D) + F.lane;
#pragma unroll
            for (int j = 0; j < 4; ++j) orow[64 * j] = v[q][j] * rs * nfv[j]; }
    }
#undef CMB_SLOTS
}

__device__ __forceinline__ int meta_row(int lane) { return ((lane >> 5) & 1) * 8 + ((lane >> 4) & 1) * 4 + ((lane >> 3) & 1) * 2 + ((lane >> 2) & 1); }
template <int KPL> __device__ __forceinline__ float meta_col(const LAS unsigned char* A, const bf16* wrow, int lane) {
    constexpr int K = 64 * KPL; float w[KPL];
#pragma unroll
    for (int j = 0; j < KPL / 8; ++j) { const v4u x = *(const GAS v4u*)(wrow + lane * KPL + 8 * j);
        w[8 * j] = bflo(x.x); w[8 * j + 1] = bfhi(x.x); w[8 * j + 2] = bflo(x.y); w[8 * j + 3] = bfhi(x.y); w[8 * j + 4] = bflo(x.z); w[8 * j + 5] = bfhi(x.z); w[8 * j + 6] = bflo(x.w); w[8 * j + 7] = bfhi(x.w); }
    float p[16];
#pragma unroll
    for (int r = 0; r < 16; ++r) { float s = 0.f;
#pragma unroll
        for (int j = 0; j < KPL / 8; ++j) { const v4u a = *(const LAS v4u*)(A + (r * K + lane * KPL + 8 * j) * 2);
            s += (bflo(a.x) * w[8 * j] + bfhi(a.x) * w[8 * j + 1]) + (bflo(a.y) * w[8 * j + 2] + bfhi(a.y) * w[8 * j + 3]) + (bflo(a.z) * w[8 * j + 4] + bfhi(a.z) * w[8 * j + 5]) + (bflo(a.w) * w[8 * j + 6] + bfhi(a.w) * w[8 * j + 7]); }
        p[r] = s; if ((r & 3) == 3) asm volatile("" ::: "memory"); }
    const bool b32 = lane & 32, b16 = lane & 16, b8 = lane & 8, b4 = lane & 4;
    float q8[8], q4[4], q2[2];
#pragma unroll
    for (int i = 0; i < 8; ++i) { const float keep = b32 ? p[i + 8] : p[i], send = b32 ? p[i] : p[i + 8]; q8[i] = keep + __shfl_xor(send, 32); }
#pragma unroll
    for (int i = 0; i < 4; ++i) { const float keep = b16 ? q8[i + 4] : q8[i], send = b16 ? q8[i] : q8[i + 4]; q4[i] = keep + __shfl_xor(send, 16); }
#pragma unroll
    for (int i = 0; i < 2; ++i) { const float keep = b8 ? q4[i + 2] : q4[i], send = b8 ? q4[i] : q4[i + 2]; q2[i] = keep + __shfl_xor(send, 8); }
    float v = (b4 ? q2[1] : q2[0]) + __shfl_xor(b4 ? q2[0] : q2[1], 4);
    v += __shfl_xor(v, 2); v += __shfl_xor(v, 1);
    return v;
}
__device__ __forceinline__ void meta_stage(Frame& F, LAS unsigned char* dst, const bf16* src, int K) {
    v4u t[4]; const int n = 16 * K / 8;
#pragma unroll
    for (int q = 0; q < 4; ++q) { const int u = F.tid + q * NTHREADS; if (u < n) t[q] = *(const GAS v4u*)(src + (size_t)u * 8); }
#pragma unroll
    for (int q = 0; q < 4; ++q) { const int u = F.tid + q * NTHREADS; if (u < n) *(LAS v4u*)(dst + u * 16) = t[q]; }
}
__device__ __forceinline__ void meta_proj(Frame& F) {
    unsigned char* ws = F.ws; const bf16* WIN = (const bf16*)(ws + WS_WIN); const float* lbl = F.in[IN_LBL];
    LAS unsigned char* A = F.lds + RING_OFF;
    __syncthreads(); meta_stage(F, A, (const bf16*)(ws + WS_XN0) + (size_t)NTOK * D, D); __syncthreads();
    for (int c = F.vcu * NWAVES + F.wave; c < NPROJ; c += F.G * NWAVES) {
        const float v = meta_col<16>(A, WIN + (size_t)c * D, F.lane);
        if ((F.lane & 3) == 0) { const size_t row = NTOK + meta_row(F.lane); const int kind = c < 3072 ? (c >> 9) : 6, cc = c & 511;
            if (kind == 0) ((bf16*)(ws + WS_HQ))[row * HW + cc] = (bf16)f2bf(fsilu(v));
            else if (kind == 1) { const float lb = fsigmoid(lbl[cc] - lbl[HW + cc]); ((bf16*)(ws + WS_HG))[row * HW + cc] = (bf16)f2bf(__logf(lb + (1.f - lb) * fsigmoid(v))); }
            else if (kind == 2) ((bf16*)(ws + WS_HV))[row * HW + cc] = (bf16)f2bf(v);
            else if (kind == 3) ((bf16*)(ws + WS_HGATE))[row * HW + cc] = (bf16)f2bf(fsilu(v));
            else if (kind == 4) ((bf16*)(ws + WS_MM))[row * HW + cc] = (bf16)f2bf(v);
            else if (kind == 5) ((bf16*)(ws + WS_MO))[row * HW + cc] = (bf16)f2bf(fsigmoid(v));
            else (ws + WS_GATES)[row * 2048 + pg8::gate_pos(c - 3072)] = (unsigned char)(__builtin_bit_cast(unsigned, __builtin_fmaf(fsigmoid(v), 255.f, 8388608.f)) & 0xffu); } }
}
__device__ __forceinline__ void meta_merged(Frame& F) {
    unsigned char* ws = F.ws; const unsigned char* GATES = ws + WS_GATES;
    LAS unsigned char* A0 = F.lds + RING_OFF; LAS unsigned char* A1 = A0 + 16 * HW * 2;
    __syncthreads(); meta_stage(F, A0, (const bf16*)(ws + WS_YHG) + (size_t)NTOK * HW, HW); meta_stage(F, A1, (const bf16*)(ws + WS_YML) + (size_t)NTOK * HW, HW); __syncthreads();
    for (int c = F.vcu * NWAVES + F.wave; c < D; c += F.G * NWAVES) {
        const float vh = meta_col<8>(A0, (const bf16*)(ws + WS_WBH) + (size_t)c * HW, F.lane), vm = meta_col<8>(A1, (const bf16*)(ws + WS_WBM) + (size_t)c * HW, F.lane);
        if ((F.lane & 3) == 0) { const size_t row = NTOK + meta_row(F.lane); ((bf16*)(ws + WS_MERGED))[row * D + c] = (bf16)f2bf((float)GATES[row * 2048 + pg8::gate_pos(c)] * vh + (float)GATES[row * 2048 + pg8::gate_pos(D + c)] * vm); } }
}
__device__ __forceinline__ void meta_wout(Frame& F) {
    unsigned char* ws = F.ws; LAS unsigned char* A = F.lds + RING_OFF;
    __syncthreads(); meta_stage(F, A, (const bf16*)(ws + WS_MERGED) + (size_t)NTOK * D, D); __syncthreads();
    for (int c = F.vcu * NWAVES + F.wave; c < D; c += F.G * NWAVES) {
        const float d = meta_col<16>(A, (const bf16*)(ws + WS_WOUT) + (size_t)c * D, F.lane);
        if ((F.lane & 3) == 0) { const int mr_ = meta_row(F.lane); const size_t row = NTOK + mr_; const float v = F.in[IN_META][(size_t)mr_ * D + c] + d;
            ((bf16*)(ws + WS_H1))[row * D + c] = (bf16)f2bf(v); ((unsigned char*)(ws + WS_H1B))[row * D + c] = (unsigned char)(__builtin_amdgcn_cvt_pk_fp8_f32(__builtin_amdgcn_fmed3f(v, -448.f, 448.f), 0.f, 0u, false) & 0xffu); } }
}

__device__ __forceinline__ void ph_proj(Frame& F) {
    unsigned char* ws = F.ws;
    pg8::Gemm g{(const pg8::bf16_t*)(ws + WS_XQ), (const pg8::bf16_t*)(ws + WS_WIN8), NTOK, NPROJ, D / 2}; pg8::StaticOrder S; S.init(NTOK, NPROJ, F.G, (int)blockIdx.x);
    pg8::EpiProjT<true> E{ws, F.in[IN_LBL], (const float*)(ws + WS_SROW), (const float*)(ws + WS_SCOL)};
    pg8::gemm_phase<pg8::EpiProjT<true>, pg8::StaticOrder, true, true, false, true>(F.lds + RING_OFF, g, S, E);
    meta_proj(F);
}
__device__ __forceinline__ void ph_scan(Frame& F) {
    const int sb = (int)blockIdx.x;
    if (sb < 64) p3_hgrn2_mfma(F, sb); else if (sb < 128) p3_mlstm_mfma(F, sb - 64);
#if !CONV_IN_P0
    else px_experts(F, sb - 128, F.G - 128);
#endif
}
__device__ __forceinline__ void ph_merged(Frame& F) {
    unsigned char* ws = F.ws;
    static_assert(WS_YML - WS_YHG == (size_t)pg8::PAIR_DA * 256 * HW * 2 && WS_WBM - WS_WBH == (size_t)pg8::PAIR_DB * 256 * HW * 2, "the second branch's operands sit a whole number of tiles behind the first's");
    pg8::PairOrder S; S.S.init(NTOK, D, F.G, (int)blockIdx.x);
    pg8::Gemm g{(const pg8::bf16_t*)(ws + WS_YHG), (const pg8::bf16_t*)(ws + WS_WBH), NTOK, D, HW};
    pg8::EpiGate2 E{(const unsigned char*)(ws + WS_GATES), (pg8::bf16_t*)(ws + WS_TMP), (pg8::bf16_t*)(ws + WS_MERGED)};
    pg8::gemm_phase<pg8::EpiGate2, pg8::PairOrder, true, true>(F.lds + RING_OFF, g, S, E);
    meta_merged(F);
}
__device__ __forceinline__ void ph_wout(Frame& F) {
    unsigned char* ws = F.ws;
    pg8::Gemm g{(const pg8::bf16_t*)(ws + WS_MERGED), (const pg8::bf16_t*)(ws + WS_WOUT), NTOK, D, D}; pg8::StaticOrder S; S.init(NTOK, D, F.G, (int)blockIdx.x);
    pg8::EpiH1 E{(const pg8::bf16_t*)(ws + WS_XN0), (const float*)(ws + WS_XSQ), (pg8::bf16_t*)(ws + WS_H1), (unsigned char*)(ws + WS_H1B)};
    pg8::gemm_phase<pg8::EpiH1, pg8::StaticOrder, true, true>(F.lds + RING_OFF, g, S, E);
    meta_wout(F);
}
__device__ __forceinline__ void ph_gu(Frame& F) {
    unsigned char* ws = F.ws; build_tables(F);
    const LAS int* pst = (const LAS int*)(F.lds + PST_OFF); LAS unsigned short* tok16 = (LAS unsigned short*)(F.lds + TOK_OFF);
    pg8::Gemm g{(const pg8::bf16_t*)(ws + WS_H1B), (const pg8::bf16_t*)(ws + WS_WGU), NV, NE * 2 * DFF, D / 2};
    pg8::GroupOrder S{pst[32], 8, F.G, (int)blockIdx.x, (const LAS unsigned char*)(F.lds + TEXP_OFF)};
    { const int* ETOK = (const int*)(ws + WS_ETOK);
      int tokv[18];
#pragma unroll
      for (int i = 0; i < 18; ++i) { pg8::Unit u; int t = 0; if (S.next(i, u) && F.tid < 256) { const int e = u.pn >> 3, pos = u.pm * 256 - pst[e] + F.tid; if (pos < pst[33 + e]) t = ETOK[(size_t)e * NV + pos]; } tokv[i] = t; }
      if (F.tid < 256) {
#pragma unroll
          for (int i = 0; i < 18; ++i) tok16[i * 256 + F.tid] = (unsigned short)tokv[i]; }
      __syncthreads(); }
    pg8::EpiGU E{(const float*)(ws + WS_BGUP), (const float*)(ws + WS_ERS), (unsigned char*)(ws + WS_ACT), pst};
    pg8::gemm_phase_g<pg8::EpiGU, pg8::GroupOrder, true>(F.lds + RING_OFF, g, S, E, tok16);
}
__device__ __forceinline__ void ph_down(Frame& F) {
    unsigned char* ws = F.ws; build_tables(F);
    pg8::Gemm g{(const pg8::bf16_t*)(ws + WS_ACT), (const pg8::bf16_t*)(ws + WS_WDN), MAXTILES * 256, NE * D, DFF / 2};
    pg8::GroupOrder S{((const LAS int*)(F.lds + PST_OFF))[32], 4, F.G, (int)blockIdx.x, (const LAS unsigned char*)(F.lds + TEXP_OFF)};
    pg8::EpiDown E{F.in[IN_BDN], (const float*)(ws + WS_EW), (unsigned char*)(ws + WS_YB), (const LAS int*)(F.lds + PST_OFF)};
    pg8::gemm_phase<pg8::EpiDown, pg8::GroupOrder, true, true, true>(F.lds + RING_OFF, g, S, E);
}

#ifndef CONV_IN_P0
#define CONV_IN_P0 0
#endif
#ifndef PROBE_DOUBLE
#define PROBE_DOUBLE 0
#endif
#define DBL(k) ((PROBE_DOUBLE >> (k)) & 1)
#ifndef MK_N_LAUNCHES
#define MK_N_LAUNCHES 1
#endif
constexpr int NPHASE = 9;
struct Args { const float* in[25]; float* out; unsigned char* ws; int ph_lo, ph_hi, li, pad; };
__global__ void __launch_bounds__(NTHREADS, 2) fwd_kernel(Args args) {
    extern __shared__ __attribute__((aligned(16))) unsigned char lds[];
    Frame F;
    F.lds = (LAS unsigned char*)lds; F.MISC = (volatile LAS unsigned*)(F.lds + MISC_OFF);
    F.tid = threadIdx.x; F.lane = F.tid & 63; F.wave = __builtin_amdgcn_readfirstlane(F.tid >> 6);
    F.G = gridDim.x; { const int bx = blockIdx.x; F.vcu = (F.G % 8 == 0) ? (bx % 8) * (F.G / 8) + bx / 8 : bx; }
    F.ws = args.ws; F.ctl = (gu32*)(args.ws + WS_CTL); F.out = args.out;
#pragma unroll
    for (int i = 0; i < 25; ++i) F.in[i] = args.in[i];
    { int t0 = F.tid; asm volatile("" : "+v"(t0)); if (t0 < 64) F.MISC[t0] = 0u; }
    __syncthreads();
    const int lo = args.ph_lo, hi = args.ph_hi;
    XcdBarrier bar; bar.bar = (unsigned*)(F.ctl + CW_BAR) + args.li * XCD_BAR_WORDS; bar.x = 0; bar.st = nullptr;
    if (hi - lo > 1) bar = xcd_barrier_post((unsigned*)(F.ctl + CW_BAR) + args.li * XCD_BAR_WORDS, F.MISC + 8);
#define IN(k) (lo <= (k) && (k) < hi)
#define SEAM(k) do { if (IN(k) && IN((k) + 1)) xcd_barrier(bar); } while (0)

    if (IN(0)) { p0_prologue(F);
        if (hi - lo > 1) { xcd_barrier(bar); p0b_quant(F); }
#if CONV_IN_P0
        __syncthreads(); px_experts(F, F.vcu, F.G);
#endif
    } SEAM(0);
    if (IN(1)) { ph_proj(F); } SEAM(1);
    if (IN(2)) { ph_scan(F); } SEAM(2);
    if (IN(3)) { ph_merged(F); } SEAM(3);
    if (IN(4)) { ph_wout(F); } SEAM(4);
    if (IN(5)) { p6_router(F); } SEAM(5);
    if (IN(6)) { ph_gu(F); } SEAM(6);
    if (IN(7)) { ph_down(F); } SEAM(7);
    if (IN(8)) { p10_combine(F); }
#undef IN
#undef SEAM
}

extern "C" void kernel_launch(void* const* d_in, const int* in_sizes, int n_in, void* d_out, int out_size, void* d_ws, size_t ws_size, hipStream_t stream) {
    static int grid = 0;
    if (grid == 0) {
        if (n_in != 25 || in_sizes[0] != BATCH * SEQ * D || out_size != BATCH * SEQ * D || ws_size < WS_END) { fprintf(stderr, "kernel_launch: unexpected shapes (n_in %d, in0 %d, out %d, ws %zu); nothing launched\n", n_in, n_in > 0 ? in_sizes[0] : -1, out_size, ws_size); grid = -1; return; }
        int dev = 0, cus = 0, per_cu = 0;
        if (hipGetDevice(&dev) != hipSuccess || hipDeviceGetAttribute(&cus, hipDeviceAttributeMultiprocessorCount, dev) != hipSuccess) { grid = -1; return; }
        if (hipFuncSetAttribute((const void*)fwd_kernel, hipFuncAttributeMaxDynamicSharedMemorySize, LDS_BYTES) != hipSuccess) { fprintf(stderr, "kernel_launch: hipFuncSetAttribute failed\n"); grid = -1; return; }
        if (hipOccupancyMaxActiveBlocksPerMultiprocessor(&per_cu, (const void*)fwd_kernel, NTHREADS, LDS_BYTES) != hipSuccess || per_cu < 1) { fprintf(stderr, "kernel_launch: occupancy query reports %d blocks per CU\n", per_cu); }
        (void)hipGetLastError();
        grid = 256;
        if (cus < 256) { fprintf(stderr, "kernel_launch: %d CUs < 256: the grid would not be resident; nothing launched\n", cus); grid = -1; return; }
    }
    if (grid < 0) return;
    if (hipMemsetAsync((char*)d_ws + WS_CTL, 0, CTL_ZERO_BYTES, stream) != hipSuccess) return;
    Args a{};
    for (int i = 0; i < 25; ++i) a.in[i] = (const float*)d_in[i];
    a.out = (float*)d_out; a.ws = (unsigned char*)d_ws; a.pad = 0;
#if MK_N_LAUNCHES == 1
    a.ph_lo = 0; a.ph_hi = NPHASE; a.li = 0;
    hipLaunchKernelGGL(fwd_kernel, dim3(grid), dim3(NTHREADS), LDS_BYTES, stream, a);
#else
    for (int p = 0; p < NPHASE; ++p) for (int rep = 0; rep <= DBL(p); ++rep) { a.ph_lo = p; a.ph_hi = p + 1; a.li = 0; hipLaunchKernelGGL(fwd_kernel, dim3(grid), dim3(NTHREADS), LDS_BYTES, stream, a); }
#endif
}
```

```cpp
#include <hip/hip_runtime.h>
#include <cstdio>
#include <cstdint>
namespace pg8 {
#define PG8_LAS __attribute__((address_space(3)))
typedef unsigned short bf16_t;
typedef short bf16x8 __attribute__((ext_vector_type(8)));
typedef float f32x4 __attribute__((ext_vector_type(4)));
typedef unsigned u32x4 __attribute__((ext_vector_type(4)));
constexpr int BM = 256, BK = 64, HALF = 128, HTB = HALF * BK * 2  , STAGE_BYTES = 8 * HTB, NXCD = 8, WGM = 8;

__host__ __device__ __forceinline__ int lds_byte(int r, int c) { const int st = (r >> 4) * 2 + (c >> 5), rr = r & 15, cc = c & 31, ob = rr * 64 + cc * 2; return st * 1024 + (ob ^ (((ob >> 9) & 1) << 5)); }
__host__ __device__ __forceinline__ void stage_rc(int b, int& R, int& C) { const int st = b / 1024, sb = b % 1024, swz = sb ^ (((sb >> 9) & 1) << 5); R = (st >> 1) * 16 + swz / 64; C = (st & 1) * 32 + (swz % 64) / 2; }
__host__ __device__ __forceinline__ int perm32(int rho) { const int n = rho >> 4, i = rho & 15; return 8 * (i >> 2) + 4 * n + (i & 3); }

struct Unit { int pm, pn; };
struct Gemm { const bf16_t* A; const bf16_t* Bt; int M, N, K; };

struct StaticOrder {
    int nM, nN, nwg, G, c;
    __host__ __device__ void init(int M, int N, int G_, int c_) { nM = M / BM; nN = N / BM; nwg = nM * nN; G = G_; c = c_; }
    __host__ __device__ __forceinline__ bool next(int i, Unit& u) const {
        const long L = (long)i * G + c; if (L >= nwg) return false;
        int wgid = (int)L; { const int q = nwg / NXCD, r = nwg % NXCD, xcd = wgid % NXCD, off = wgid / NXCD; wgid = (xcd < r ? xcd * (q + 1) : r * (q + 1) + (xcd - r) * q) + off; }
        const int nig = WGM * nN, gid = wgid / nig, fm = gid * WGM, gsz = (nM - fm) < WGM ? (nM - fm) : WGM;
        u.pm = fm + ((wgid % nig) % gsz); u.pn = (wgid % nig) / gsz; return true;
    }
    __device__ __forceinline__ void a_ready(const Unit&) const {}
    __device__ __forceinline__ void done(const Unit&) const {}
};

typedef __bf16 bf16v2 __attribute__((ext_vector_type(2)));
typedef float f32v2 __attribute__((ext_vector_type(2)));
__device__ __forceinline__ unsigned cvt_pk_bf16(float lo, float hi) { const f32v2 v = {lo, hi}; return __builtin_bit_cast(unsigned, __builtin_convertvector(v, bf16v2)); }
typedef float f32x2 __attribute__((ext_vector_type(2)));
typedef int i32x4 __attribute__((ext_vector_type(4)));
typedef int i32x8 __attribute__((ext_vector_type(8)));
__device__ __forceinline__ i32x8 cat8(const bf16x8 a, const bf16x8 b) { const i32x4 x = __builtin_bit_cast(i32x4, a), y = __builtin_bit_cast(i32x4, b); return __builtin_shufflevector(x, y, 0, 1, 2, 3, 4, 5, 6, 7); }
template <class Epi, class Sched, bool ALIGN_EPI = false, bool SP2 = false, bool FP8 = false, bool I8 = false>
__device__ __forceinline__ void gemm_phase(PG8_LAS unsigned char* lds, const Gemm g, const Sched& S, const Epi& E) {
    const int tid = threadIdx.x, wid = __builtin_amdgcn_readfirstlane(tid >> 6), lane = tid & 63, wr = wid >> 2, wc = wid & 3, fr = lane & 15, fq = lane >> 4;
    const int K = g.K, nt = K / BK;
    unsigned voffA[2], voffB[2];
#pragma unroll
    for (int i = 0; i < 2; ++i) { int R, C; stage_rc(tid * 16 + i * 8192, R, C); const int Rb = Epi::PERM ? ((R & ~31) + perm32(R & 31)) : R;
        voffA[i] = (unsigned)(R * K + C) * 2u; voffB[i] = (unsigned)(Rb * K + C) * 2u; }
    const size_t kstep = (size_t)(BK * 2);
    const size_t hstep = (size_t)HALF * K * 2;
    const size_t tstep = 2 * hstep;
    const unsigned ldsw = (unsigned)wid * 1024u;
    const int aoff = lds_byte(wr * 64 + fr, fq * 8), boff = lds_byte(wc * 32 + fr, fq * 8);
#define PG8_SA(b, h) (((b) * 2 + (h)) * HTB)
#define PG8_SB(b, h) ((4 + (b) * 2 + (h)) * HTB)
#define PG8_STAGE(bufoff, gbase, voff) do { _Pragma("unroll") for (int _i = 0; _i < 2; ++_i) \
        __builtin_amdgcn_global_load_lds((const unsigned*)((const char*)(gbase) + (voff)[_i]), (PG8_LAS unsigned*)(lds + (bufoff) + ldsw + _i * 8192), 16, 0, 0); } while (0)
#define PG8_LDA(dst, b, h) do { _Pragma("unroll") for (int m = 0; m < 4; ++m) { if constexpr (FP8) dst##8[m] = cat8(*(const PG8_LAS bf16x8*)(lds + PG8_SA(b, h) + aoff + m * 2048), *(const PG8_LAS bf16x8*)(lds + PG8_SA(b, h) + aoff + m * 2048 + 1024)); \
        else { _Pragma("unroll") for (int k = 0; k < 2; ++k) dst[m][k] = *(const PG8_LAS bf16x8*)(lds + PG8_SA(b, h) + aoff + m * 2048 + k * 1024); } } } while (0)
#define PG8_LDB(dst, b, h) do { _Pragma("unroll") for (int n = 0; n < 2; ++n) { if constexpr (FP8) dst##8[n] = cat8(*(const PG8_LAS bf16x8*)(lds + PG8_SB(b, h) + boff + n * 2048), *(const PG8_LAS bf16x8*)(lds + PG8_SB(b, h) + boff + n * 2048 + 1024)); \
        else { _Pragma("unroll") for (int k = 0; k < 2; ++k) dst[n][k] = *(const PG8_LAS bf16x8*)(lds + PG8_SB(b, h) + boff + n * 2048 + k * 1024); } } } while (0)
#define PG8_MMA(ai, bj, At, Bt) do { __builtin_amdgcn_s_setprio(1); _Pragma("unroll") for (int m = 0; m < 4; ++m) _Pragma("unroll") for (int n = 0; n < 2; ++n) { \
        if constexpr (FP8) acc[ai][bj][m][n] = __builtin_amdgcn_mfma_scale_f32_16x16x128_f8f6f4(Bt##8[n], At##8[m], acc[ai][bj][m][n], 0, 0, 0, 0x7f7f7f7f, 0, 0x7f7f7f7f); \
        else if constexpr (I8) { _Pragma("unroll") for (int k = 0; k < 2; ++k) acc[ai][bj][m][n] = __builtin_bit_cast(f32x4, __builtin_amdgcn_mfma_i32_16x16x64_i8(__builtin_bit_cast(i32x4, Bt[n][k]), __builtin_bit_cast(i32x4, At[m][k]), __builtin_bit_cast(i32x4, acc[ai][bj][m][n]), 0, 0, 0)); } \
        else { _Pragma("unroll") for (int k = 0; k < 2; ++k) acc[ai][bj][m][n] = __builtin_amdgcn_mfma_f32_16x16x32_bf16(Bt[n][k], At[m][k], acc[ai][bj][m][n], 0, 0, 0); } } \
        if constexpr (FP8) { _Pragma("unroll") for (int m = 0; m < 4; ++m) _Pragma("unroll") for (int n = 0; n < 2; ++n) asm volatile("" : "+v"(acc[ai][bj][m][n])); }     \
        __builtin_amdgcn_s_setprio(0); } while (0)
#define PG8_WAIT_V(n) asm volatile("s_waitcnt vmcnt(" #n ")" ::: "memory")
#define PG8_WAIT_L(n) asm volatile("s_waitcnt lgkmcnt(" #n ")" ::: "memory")
#define PG8_BAR __builtin_amdgcn_s_barrier()
#define PG8_SCHED __builtin_amdgcn_sched_barrier(0)
    Unit cur, nxt; int ui = 0;
    if (!S.next(0, cur)) return;
    f32x4 acc[2][2][4][2];
#pragma unroll
    for (int a = 0; a < 2; ++a)
#pragma unroll
        for (int b = 0; b < 2; ++b)
#pragma unroll
            for (int m = 0; m < 4; ++m)
#pragma unroll
                for (int n = 0; n < 2; ++n) acc[a][b][m][n] = (f32x4){0.f, 0.f, 0.f, 0.f};
    bf16x8 At[4][2], B0[2][2], B1[2][2]; i32x8 At8[4], B08[2], B18[2];
    const char* cA = (const char*)g.A + (size_t)cur.pm * tstep; const char* cB = (const char*)g.Bt + (size_t)cur.pn * tstep;
    S.a_ready(cur);
    if constexpr (SP2) {
        PG8_STAGE(PG8_SB(0, 0), cB, voffB); PG8_STAGE(PG8_SB(0, 1), cB + hstep, voffB); PG8_STAGE(PG8_SA(0, 0), cA, voffA); PG8_STAGE(PG8_SA(0, 1), cA + hstep, voffA);
        if (wr == 1) PG8_BAR;
        PG8_WAIT_V(2); PG8_BAR;
        PG8_STAGE(PG8_SB(1, 0), cB + kstep, voffB); PG8_STAGE(PG8_SA(1, 0), cA + kstep, voffA); PG8_STAGE(PG8_SB(1, 1), cB + hstep + kstep, voffB);
        PG8_WAIT_V(6); PG8_BAR;
    } else {
        PG8_STAGE(PG8_SB(0, 0), cB, voffB); PG8_STAGE(PG8_SA(0, 0), cA, voffA); PG8_STAGE(PG8_SB(0, 1), cB + hstep, voffB); PG8_STAGE(PG8_SA(0, 1), cA + hstep, voffA);
        if (wr == 1) PG8_BAR;
        PG8_WAIT_V(4); PG8_BAR;
        PG8_STAGE(PG8_SB(1, 0), cB + kstep, voffB); PG8_STAGE(PG8_SA(1, 0), cA + kstep, voffA); PG8_STAGE(PG8_SB(1, 1), cB + hstep + kstep, voffB);
        PG8_WAIT_V(6); PG8_BAR;
    }
    for (;;) {
        const bool has_next = S.next(ui + 1, nxt);
        const char* nA = has_next ? (const char*)g.A + (size_t)nxt.pm * tstep : cA; const char* nB = has_next ? (const char*)g.Bt + (size_t)nxt.pn * tstep : cB;
        for (int t = 0; t < nt; t += 2) {
            const bool last = (t == nt - 2);
            const char* a1 = cA + (size_t)(t + 1) * kstep;
            const char* a2 = last ? nA : cA + (size_t)(t + 2) * kstep; const char* b2 = last ? nB : cB + (size_t)(t + 2) * kstep;
            const char* a3 = a2 + kstep; const char* b3 = b2 + kstep;
            if (last && has_next) S.a_ready(nxt);
            if constexpr (SP2) {
            PG8_LDB(B0, 0, 0); PG8_LDB(B1, 0, 1); PG8_SCHED; PG8_LDA(At, 0, 0); PG8_STAGE(PG8_SA(1, 1), a1 + hstep, voffA);
            PG8_WAIT_V(8); PG8_WAIT_L(0); PG8_BAR; PG8_MMA(0, 0, At, B0); PG8_MMA(0, 1, At, B1); PG8_BAR; PG8_SCHED;
            PG8_LDA(At, 0, 1); PG8_STAGE(PG8_SB(0, 0), b2, voffB); PG8_STAGE(PG8_SB(0, 1), b2 + hstep, voffB); PG8_STAGE(PG8_SA(0, 0), a2, voffA);
            PG8_WAIT_V(8); PG8_WAIT_L(0); PG8_BAR; PG8_MMA(1, 0, At, B0); PG8_MMA(1, 1, At, B1); PG8_BAR; PG8_SCHED;
            PG8_LDB(B0, 1, 0); PG8_LDB(B1, 1, 1); PG8_SCHED; PG8_LDA(At, 1, 0); PG8_STAGE(PG8_SA(0, 1), a2 + hstep, voffA);
            PG8_WAIT_V(8); PG8_WAIT_L(0); PG8_BAR; PG8_MMA(0, 0, At, B0); PG8_MMA(0, 1, At, B1); PG8_BAR; PG8_SCHED;
            PG8_LDA(At, 1, 1); PG8_STAGE(PG8_SB(1, 0), b3, voffB); PG8_STAGE(PG8_SB(1, 1), b3 + hstep, voffB); PG8_STAGE(PG8_SA(1, 0), a3, voffA);
            PG8_WAIT_V(8); PG8_WAIT_L(0); PG8_BAR; PG8_MMA(1, 0, At, B0); PG8_MMA(1, 1, At, B1); PG8_BAR; PG8_SCHED;
            } else {
            PG8_LDB(B0, 0, 0); PG8_SCHED; PG8_LDA(At, 0, 0); PG8_STAGE(PG8_SA(1, 1), a1 + hstep, voffA);
            PG8_WAIT_L(8); PG8_BAR; PG8_WAIT_L(0); PG8_MMA(0, 0, At, B0); PG8_BAR; PG8_SCHED;
            PG8_LDB(B1, 0, 1); PG8_STAGE(PG8_SB(0, 0), b2, voffB);
            PG8_BAR; PG8_WAIT_L(0); PG8_MMA(0, 1, At, B1); PG8_BAR;
            PG8_LDA(At, 0, 1); PG8_STAGE(PG8_SA(0, 0), a2, voffA);
            PG8_BAR; PG8_WAIT_L(0); PG8_MMA(1, 0, At, B0); PG8_BAR; PG8_SCHED;
            PG8_STAGE(PG8_SB(0, 1), b2 + hstep, voffB);
            PG8_WAIT_V(6); PG8_BAR; PG8_MMA(1, 1, At, B1); PG8_BAR;
            PG8_LDB(B0, 1, 0); PG8_SCHED; PG8_LDA(At, 1, 0); PG8_STAGE(PG8_SA(0, 1), a2 + hstep, voffA);
            PG8_WAIT_L(8); PG8_BAR; PG8_WAIT_L(0); PG8_MMA(0, 0, At, B0); PG8_BAR; PG8_SCHED;
            PG8_LDB(B1, 1, 1); PG8_STAGE(PG8_SB(1, 0), b3, voffB);
            PG8_BAR; PG8_WAIT_L(0); PG8_MMA(0, 1, At, B1); PG8_BAR;
            PG8_LDA(At, 1, 1); PG8_STAGE(PG8_SA(1, 0), a3, voffA);
            PG8_BAR; PG8_WAIT_L(0); PG8_MMA(1, 0, At, B0); PG8_BAR; PG8_SCHED;
            PG8_STAGE(PG8_SB(1, 1), b3 + hstep, voffB);
            PG8_WAIT_V(6); PG8_BAR; PG8_MMA(1, 1, At, B1); PG8_BAR;
            }
        }
        if constexpr (ALIGN_EPI) { if (wr == 0) PG8_BAR; }
        if constexpr (!Epi::AFTER_DRAIN) { E(acc, cur, wr, wc, fr, fq); S.done(cur); }
        if (!has_next) break;
#pragma unroll
        for (int a = 0; a < 2; ++a)
#pragma unroll
            for (int b = 0; b < 2; ++b)
#pragma unroll
                for (int m = 0; m < 4; ++m)
#pragma unroll
                    for (int n = 0; n < 2; ++n) acc[a][b][m][n] = (f32x4){0.f, 0.f, 0.f, 0.f};
        cur = nxt; cA = nA; cB = nB; ++ui;
        if constexpr (ALIGN_EPI) { if (wr == 1) PG8_BAR; }
    }
    PG8_WAIT_V(0);
    if constexpr (!ALIGN_EPI) { if (wr == 0) PG8_BAR; }
    PG8_BAR;
    if constexpr (Epi::AFTER_DRAIN) { E.fused(acc, cur, wr, wc, fr, fq, lds, wid, lane); S.done(cur); }
#undef PG8_SA
#undef PG8_SB
#undef PG8_STAGE
#undef PG8_LDA
#undef PG8_LDB
#undef PG8_MMA
#undef PG8_WAIT_V
#undef PG8_WAIT_L
#undef PG8_BAR
#undef PG8_SCHED
}
template <class Epi, class Sched, bool FP8 = false>
__device__ __forceinline__ void gemm_phase_g(PG8_LAS unsigned char* lds, const Gemm g, const Sched& S, const Epi& E, const PG8_LAS unsigned short* tok16) {
    constexpr bool ALIGN_EPI = true, SP2 = true;
    const int tid = threadIdx.x, wid = __builtin_amdgcn_readfirstlane(tid >> 6), lane = tid & 63, wr = wid >> 2, wc = wid & 3, fr = lane & 15, fq = lane >> 4;
    const int K = g.K, nt = K / BK;
    unsigned voffB[2]; int RA[2]; unsigned CA[2];
#pragma unroll
    for (int i = 0; i < 2; ++i) { int R, C; stage_rc(tid * 16 + i * 8192, R, C); const int Rb = Epi::PERM ? ((R & ~31) + perm32(R & 31)) : R;
        RA[i] = R; CA[i] = (unsigned)C * 2u; voffB[i] = (unsigned)(Rb * K + C) * 2u; }
    unsigned oc[2][2];
#define PG8_TOKS(dst, ui_) do { _Pragma("unroll") for (int _h = 0; _h < 2; ++_h) _Pragma("unroll") for (int _i = 0; _i < 2; ++_i) \
        dst[_h][_i] = (unsigned)tok16[(ui_) * 256 + _h * HALF + RA[_i]] * (unsigned)(K * 2) + CA[_i]; } while (0)
    const size_t kstep = (size_t)(BK * 2);
    const size_t hstep = (size_t)HALF * K * 2;
    const size_t tstep = 2 * hstep;
    const unsigned ldsw = (unsigned)wid * 1024u;
    const int aoff = lds_byte(wr * 64 + fr, fq * 8), boff = lds_byte(wc * 32 + fr, fq * 8);
#define PG8_SA(b, h) (((b) * 2 + (h)) * HTB)
#define PG8_SB(b, h) ((4 + (b) * 2 + (h)) * HTB)
#define PG8_STAGE(bufoff, gbase, voff) do { _Pragma("unroll") for (int _i = 0; _i < 2; ++_i) \
        __builtin_amdgcn_global_load_lds((const unsigned*)((const char*)(gbase) + (voff)[_i]), (PG8_LAS unsigned*)(lds + (bufoff) + ldsw + _i * 8192), 16, 0, 0); } while (0)
#define PG8_LDA(dst, b, h) do { _Pragma("unroll") for (int m = 0; m < 4; ++m) { if constexpr (FP8) dst##8[m] = cat8(*(const PG8_LAS bf16x8*)(lds + PG8_SA(b, h) + aoff + m * 2048), *(const PG8_LAS bf16x8*)(lds + PG8_SA(b, h) + aoff + m * 2048 + 1024)); \
        else { _Pragma("unroll") for (int k = 0; k < 2; ++k) dst[m][k] = *(const PG8_LAS bf16x8*)(lds + PG8_SA(b, h) + aoff + m * 2048 + k * 1024); } } } while (0)
#define PG8_LDB(dst, b, h) do { _Pragma("unroll") for (int n = 0; n < 2; ++n) { if constexpr (FP8) dst##8[n] = cat8(*(const PG8_LAS bf16x8*)(lds + PG8_SB(b, h) + boff + n * 2048), *(const PG8_LAS bf16x8*)(lds + PG8_SB(b, h) + boff + n * 2048 + 1024)); \
        else { _Pragma("unroll") for (int k = 0; k < 2; ++k) dst[n][k] = *(const PG8_LAS bf16x8*)(lds + PG8_SB(b, h) + boff + n * 2048 + k * 1024); } } } while (0)
#define PG8_MMA(ai, bj, At, Bt) do { __builtin_amdgcn_s_setprio(1); _Pragma("unroll") for (int m = 0; m < 4; ++m) _Pragma("unroll") for (int n = 0; n < 2; ++n) { \
        if constexpr (FP8) acc[ai][bj][m][n] = __builtin_amdgcn_mfma_scale_f32_16x16x128_f8f6f4(Bt##8[n], At##8[m], acc[ai][bj][m][n], 0, 0, 0, 0x7f7f7f7f, 0, 0x7f7f7f7f); \
        else { _Pragma("unroll") for (int k = 0; k < 2; ++k) acc[ai][bj][m][n] = __builtin_amdgcn_mfma_f32_16x16x32_bf16(Bt[n][k], At[m][k], acc[ai][bj][m][n], 0, 0, 0); } } \
        if constexpr (FP8) { _Pragma("unroll") for (int m = 0; m < 4; ++m) _Pragma("unroll") for (int n = 0; n < 2; ++n) asm volatile("" : "+v"(acc[ai][bj][m][n])); }     \
        __builtin_amdgcn_s_setprio(0); } while (0)
#define PG8_WAIT_V(n) asm volatile("s_waitcnt vmcnt(" #n ")" ::: "memory")
#define PG8_WAIT_L(n) asm volatile("s_waitcnt lgkmcnt(" #n ")" ::: "memory")
#define PG8_BAR __builtin_amdgcn_s_barrier()
#define PG8_SCHED __builtin_amdgcn_sched_barrier(0)
    Unit cur, nxt; int ui = 0;
    if (!S.next(0, cur)) return;
    f32x4 acc[2][2][4][2];
#pragma unroll
    for (int a = 0; a < 2; ++a)
#pragma unroll
        for (int b = 0; b < 2; ++b)
#pragma unroll
            for (int m = 0; m < 4; ++m)
#pragma unroll
                for (int n = 0; n < 2; ++n) acc[a][b][m][n] = (f32x4){0.f, 0.f, 0.f, 0.f};
    bf16x8 At[4][2], B0[2][2], B1[2][2]; i32x8 At8[4], B08[2], B18[2];
    const char* cA = (const char*)g.A; const char* cB = (const char*)g.Bt + (size_t)cur.pn * tstep; PG8_TOKS(oc, 0);
    S.a_ready(cur);
    if constexpr (SP2) {
        PG8_STAGE(PG8_SB(0, 0), cB, voffB); PG8_STAGE(PG8_SB(0, 1), cB + hstep, voffB); PG8_STAGE(PG8_SA(0, 0), cA, oc[0]); PG8_STAGE(PG8_SA(0, 1), cA, oc[1]);
        if (wr == 1) PG8_BAR;
        PG8_WAIT_V(2); PG8_BAR;
        PG8_STAGE(PG8_SB(1, 0), cB + kstep, voffB); PG8_STAGE(PG8_SA(1, 0), cA + kstep, oc[0]); PG8_STAGE(PG8_SB(1, 1), cB + hstep + kstep, voffB);
        PG8_WAIT_V(6); PG8_BAR;
    } else {
        PG8_STAGE(PG8_SB(0, 0), cB, voffB); PG8_STAGE(PG8_SA(0, 0), cA, oc[0]); PG8_STAGE(PG8_SB(0, 1), cB + hstep, voffB); PG8_STAGE(PG8_SA(0, 1), cA + hstep, oc[0]);
        if (wr == 1) PG8_BAR;
        PG8_WAIT_V(4); PG8_BAR;
        PG8_STAGE(PG8_SB(1, 0), cB + kstep, voffB); PG8_STAGE(PG8_SA(1, 0), cA + kstep, oc[0]); PG8_STAGE(PG8_SB(1, 1), cB + hstep + kstep, voffB);
        PG8_WAIT_V(6); PG8_BAR;
    }
    for (;;) {
        const bool has_next = S.next(ui + 1, nxt);
        const char* nB = has_next ? (const char*)g.Bt + (size_t)nxt.pn * tstep : cB;
        for (int t = 0; t < nt; t += 2) {
            const bool last = (t == nt - 2);
            const char* a1 = cA + (size_t)(t + 1) * kstep;
            const char* a2 = last ? cA : cA + (size_t)(t + 2) * kstep; const char* b2 = last ? nB : cB + (size_t)(t + 2) * kstep;
            unsigned o2[2][2]; if (last && has_next) PG8_TOKS(o2, ui + 1); else { _Pragma("unroll") for (int _h = 0; _h < 2; ++_h) _Pragma("unroll") for (int _i = 0; _i < 2; ++_i) o2[_h][_i] = oc[_h][_i]; }
            const char* a3 = a2 + kstep; const char* b3 = b2 + kstep;
            if (last && has_next) S.a_ready(nxt);
            if constexpr (SP2) {
            PG8_LDB(B0, 0, 0); PG8_LDB(B1, 0, 1); PG8_SCHED; PG8_LDA(At, 0, 0); PG8_STAGE(PG8_SA(1, 1), a1, oc[1]);
            PG8_WAIT_V(8); PG8_WAIT_L(0); PG8_BAR; PG8_MMA(0, 0, At, B0); PG8_MMA(0, 1, At, B1); PG8_BAR; PG8_SCHED;
            PG8_LDA(At, 0, 1); PG8_STAGE(PG8_SB(0, 0), b2, voffB); PG8_STAGE(PG8_SB(0, 1), b2 + hstep, voffB); PG8_STAGE(PG8_SA(0, 0), a2, o2[0]);
            PG8_WAIT_V(8); PG8_WAIT_L(0); PG8_BAR; PG8_MMA(1, 0, At, B0); PG8_MMA(1, 1, At, B1); PG8_BAR; PG8_SCHED;
            PG8_LDB(B0, 1, 0); PG8_LDB(B1, 1, 1); PG8_SCHED; PG8_LDA(At, 1, 0); PG8_STAGE(PG8_SA(0, 1), a2, o2[1]);
            PG8_WAIT_V(8); PG8_WAIT_L(0); PG8_BAR; PG8_MMA(0, 0, At, B0); PG8_MMA(0, 1, At, B1); PG8_BAR; PG8_SCHED;
            PG8_LDA(At, 1, 1); PG8_STAGE(PG8_SB(1, 0), b3, voffB); PG8_STAGE(PG8_SB(1, 1), b3 + hstep, voffB); PG8_STAGE(PG8_SA(1, 0), a3, o2[0]);
            PG8_WAIT_V(8); PG8_WAIT_L(0); PG8_BAR; PG8_MMA(1, 0, At, B0); PG8_MMA(1, 1, At, B1); PG8_BAR; PG8_SCHED;
            } else {
            PG8_LDB(B0, 0, 0); PG8_SCHED; PG8_LDA(At, 0, 0); PG8_STAGE(PG8_SA(1, 1), a1 + hstep, oc[0]);
            PG8_WAIT_L(8); PG8_BAR; PG8_WAIT_L(0); PG8_MMA(0, 0, At, B0); PG8_BAR; PG8_SCHED;
            PG8_LDB(B1, 0, 1); PG8_STAGE(PG8_SB(0, 0), b2, voffB);
            PG8_BAR; PG8_WAIT_L(0); PG8_MMA(0, 1, At, B1); PG8_BAR;
            PG8_LDA(At, 0, 1); PG8_STAGE(PG8_SA(0, 0), a2, oc[0]);
            PG8_BAR; PG8_WAIT_L(0); PG8_MMA(1, 0, At, B0); PG8_BAR; PG8_SCHED;
            PG8_STAGE(PG8_SB(0, 1), b2 + hstep, voffB);
            PG8_WAIT_V(6); PG8_BAR; PG8_MMA(1, 1, At, B1); PG8_BAR;
            PG8_LDB(B0, 1, 0); PG8_SCHED; PG8_LDA(At, 1, 0); PG8_STAGE(PG8_SA(0, 1), a2 + hstep, oc[0]);
            PG8_WAIT_L(8); PG8_BAR; PG8_WAIT_L(0); PG8_MMA(0, 0, At, B0); PG8_BAR; PG8_SCHED;
            PG8_LDB(B1, 1, 1); PG8_STAGE(PG8_SB(1, 0), b3, voffB);
            PG8_BAR; PG8_WAIT_L(0); PG8_MMA(0, 1, At, B1); PG8_BAR;
            PG8_LDA(At, 1, 1); PG8_STAGE(PG8_SA(1, 0), a3, oc[0]);
            PG8_BAR; PG8_WAIT_L(0); PG8_MMA(1, 0, At, B0); PG8_BAR; PG8_SCHED;
            PG8_STAGE(PG8_SB(1, 1), b3 + hstep, voffB);
            PG8_WAIT_V(6); PG8_BAR; PG8_MMA(1, 1, At, B1); PG8_BAR;
            }
        }
        if constexpr (ALIGN_EPI) { if (wr == 0) PG8_BAR; }
        if constexpr (!Epi::AFTER_DRAIN) { E(acc, cur, wr, wc, fr, fq); S.done(cur); }
        if (!has_next) break;
#pragma unroll
        for (int a = 0; a < 2; ++a)
#pragma unroll
            for (int b = 0; b < 2; ++b)
#pragma unroll
                for (int m = 0; m < 4; ++m)
#pragma unroll
                    for (int n = 0; n < 2; ++n) acc[a][b][m][n] = (f32x4){0.f, 0.f, 0.f, 0.f};
        cur = nxt; cB = nB; ++ui; PG8_TOKS(oc, ui);
        if constexpr (ALIGN_EPI) { if (wr == 1) PG8_BAR; }
    }
    PG8_WAIT_V(0);
    if constexpr (!ALIGN_EPI) { if (wr == 0) PG8_BAR; }
    PG8_BAR;
    if constexpr (Epi::AFTER_DRAIN) { E.fused(acc, cur, wr, wc, fr, fq, lds, wid, lane); S.done(cur); }
#undef PG8_TOKS
#undef PG8_SA
#undef PG8_SB
#undef PG8_STAGE
#undef PG8_LDA
#undef PG8_LDB
#undef PG8_MMA
#undef PG8_WAIT_V
#undef PG8_WAIT_L
#undef PG8_BAR
#undef PG8_SCHED
}
}

constexpr int BATCH = 16, SEQ = 2048, D = 1024, NMETA = 16;
constexpr int TV = SEQ + NMETA;
constexpr int NV = BATCH * TV;
constexpr int NTOK = BATCH * SEQ;
constexpr int NR = NTOK + NMETA;
constexpr int NIN = 5128, NPROJ = 5120;
constexpr int HW = 512;
constexpr int NE = 32, TOPK = 4, DFF = 1024;
constexpr int MAXTILES = 548;
constexpr float EPS = 1e-6f;
constexpr int NWAVES = 8, NTHREADS = 512;

constexpr size_t MiB = 1u << 20, KiB = 1u << 10;
constexpr size_t WS_CTL = 0, CTL_ZERO_BYTES = 1 * MiB;
constexpr size_t WS_WIN = 2 * MiB;
constexpr size_t WS_WBH = 12 * MiB, WS_WBM = 13 * MiB, WS_WOUT = 14 * MiB;
constexpr size_t WS_WGU = 16 * MiB;
constexpr size_t WS_WDN = 144 * MiB;
constexpr size_t WS_BGUP = 208 * MiB;
constexpr size_t WS_RWT = WS_BGUP + 256 * KiB;
constexpr size_t WS_TOPE = WS_RWT + 128 * KiB;
constexpr size_t WS_TOPP = WS_TOPE + 520 * KiB;
constexpr size_t WS_TOPW = WS_TOPP + 520 * KiB;
constexpr size_t WS_RS = WS_TOPW + 520 * KiB;
constexpr size_t WS_LI = WS_RS + 136 * KiB;
constexpr size_t WS_LF = WS_LI + 520 * KiB;
constexpr size_t WS_SLOTRS = WS_LF + 520 * KiB;
constexpr size_t WS_SLOTW = WS_SLOTRS + 552 * KiB;
constexpr size_t WS_XSQ = WS_SLOTW + 552 * KiB;
constexpr size_t WS_SROW = WS_XSQ + 136 * KiB;
constexpr size_t WS_SCOL = WS_SROW + 136 * KiB;
constexpr size_t WS_SMALL_END = WS_SCOL + 32 * KiB;
constexpr size_t WS_RA = 214 * MiB;
constexpr size_t WS_HQ = WS_RA, WS_HG = WS_RA + 33 * MiB, WS_HV = WS_RA + 99 * MiB, WS_HGATE = WS_RA + 132 * MiB, WS_MM = WS_RA + 165 * MiB, WS_MO = WS_RA + 198 * MiB, WS_GATES = WS_RA + 231 * MiB;
constexpr size_t WS_MERGED = WS_RA, WS_TMP = WS_RA + 66 * MiB, WS_H1B = WS_RA + 364 * MiB, WS_ACT = WS_RA;
constexpr size_t WS_RB = WS_RA + 364 * MiB;
constexpr size_t WS_XQ = WS_RB;
constexpr size_t WS_QKVM = WS_RB, WS_CM = WS_RB + 130 * MiB, WS_YHG = WS_RB + 196 * MiB, WS_YML = WS_RB + 229 * MiB, WS_XS = WS_RB, WS_YB = WS_RB;
constexpr size_t WS_RC = WS_RB + 274 * MiB;
constexpr size_t WS_XN0 = WS_RC + 65 * MiB;
constexpr size_t WS_H1 = WS_RC, WS_ETOK = WS_RC + 130 * MiB, WS_ERS = WS_ETOK + 5 * MiB, WS_EW = WS_ERS + 5 * MiB, WS_WIN8 = WS_EW + 5 * MiB, WS_END = WS_WIN8 + 5 * MiB;
static_assert(WS_SMALL_END <= WS_RA && WS_END <= 1024 * MiB, "d_ws map");
static_assert((size_t)NV * HW * 2 <= 33 * MiB && (size_t)NV * HW * 4 <= 66 * MiB && (size_t)NV * 2048 * 2 <= 132 * MiB + MiB && (size_t)NV * D * 4 <= 130 * MiB && (size_t)MAXTILES * 256 * D * 2 <= 274 * MiB, "d_ws sizes");
static_assert((size_t)NE * NV * 4 <= 5 * MiB, "per-expert lists");
static_assert((size_t)NR * D * 2 <= 65 * MiB && (size_t)NR * 4 <= 136 * KiB, "H1 / XN0 / XSQ");
constexpr int CW_TMO = 0, CW_CNT = 64  , CW_BAR = 4096, CW_CMAX = 65536  ;

constexpr int RING_OFF = 0, RING_BYTES = 131072;
constexpr int MISC_OFF = RING_BYTES;
constexpr int TEXP_OFF = MISC_OFF + 256;
constexpr int PST_OFF = TEXP_OFF + 640;
constexpr int TOK_OFF = PST_OFF + 384;
constexpr int LDS_BYTES = 147456;
static_assert(TOK_OFF + 18 * 512 <= LDS_BYTES, "LDS map");

#define GAS __attribute__((address_space(1)))
#define LAS __attribute__((address_space(3)))
typedef unsigned short bf16;
typedef unsigned v4u __attribute__((ext_vector_type(4)));
typedef unsigned v2u __attribute__((ext_vector_type(2)));
typedef float f32x4 __attribute__((ext_vector_type(4)));
typedef GAS unsigned gu32;
#define RLX_AGENT __ATOMIC_RELAXED, __HIP_MEMORY_SCOPE_AGENT
#define LDS_WAIT() asm volatile("s_waitcnt lgkmcnt(0)" ::: "memory")
#define VM_WAIT() asm volatile("s_waitcnt vmcnt(0)" ::: "memory")
__device__ __forceinline__ unsigned pk2(float lo, float hi) { return pg8::cvt_pk_bf16(lo, hi); }
__device__ __forceinline__ unsigned f2bf(float f) { return pg8::cvt_pk_bf16(f, 0.f) & 0xffffu; }
__device__ __forceinline__ float bflo(unsigned w) { return __builtin_bit_cast(float, w << 16); }
__device__ __forceinline__ float bfhi(unsigned w) { return __builtin_bit_cast(float, w & 0xffff0000u); }
__device__ __forceinline__ float bf1(bf16 h) { return __builtin_bit_cast(float, (unsigned)h << 16); }
__device__ __forceinline__ float fsigmoid(float x) { return __builtin_amdgcn_rcpf(1.0f + __expf(-x)); }
__device__ __forceinline__ float fsilu(float x) { return x * fsigmoid(x); }
__device__ __forceinline__ size_t rowof(int b, int tt) { return tt < NMETA ? (size_t)(NTOK + tt) : (size_t)b * SEQ + (tt - NMETA); }
__host__ __device__ __forceinline__ int gu_slot(int j) { const int g = (j >> 3) & 3, p = ((g & 1) << 1) | (g >> 1); return (j & ~31) + 8 * p + (j & 7); }
__device__ __forceinline__ float wave_sum(float v) {
#pragma unroll
    for (int o = 1; o < 64; o <<= 1) v += __shfl_xor(v, o);
    return v;
}
__device__ __forceinline__ float wave_max(float v) {
#pragma unroll
    for (int o = 1; o < 64; o <<= 1) v = fmaxf(v, __shfl_xor(v, o));
    return v;
}
#define XB_TMO      128
#define XB_XCNT(j)  (256  + 64 * (j))
#define XB_XSUB(j)  (1280 + 64 * (j))
#define XB_XGEN(j)  (2304 + 64 * (j))
#define XB_TOP      3328
#define XB_TOPGEN   3392
#define XCD_BAR_WORDS 3456
#define XB_SPIN_CAP (1u << 18)

__device__ __forceinline__ unsigned xb_ld(unsigned* p)              { return __hip_atomic_load(p, __ATOMIC_RELAXED, __HIP_MEMORY_SCOPE_AGENT); }
__device__ __forceinline__ unsigned xb_add(unsigned* p, unsigned v) { return __hip_atomic_fetch_add(p, v, __ATOMIC_RELAXED, __HIP_MEMORY_SCOPE_AGENT); }
__device__ __forceinline__ unsigned xb_xcc_id() { return (unsigned)__builtin_amdgcn_s_getreg((3 << 11) | 20) & 0xFu; }
#define XB_SPIN(cond, bar) do { unsigned _sp = 0; while (cond) { __builtin_amdgcn_s_sleep(1); \
    if ((++_sp & 255u) == 0u) { if (xb_ld(&(bar)[XB_TMO])) break; if (_sp > XB_SPIN_CAP) { atomicAdd(&(bar)[XB_TMO], 1u); break; } } } } while (0)

struct XcdBarrier {
    unsigned* bar; unsigned x;
    volatile LAS unsigned* st;
};

__device__ __forceinline__ XcdBarrier xcd_barrier_post(unsigned* bar, volatile LAS unsigned* st) {
    XcdBarrier b; b.bar = bar; b.x = xb_xcc_id(); b.st = st;
    if (threadIdx.x == 0) (void)xb_add(&bar[XB_XCNT(b.x)], 1u);
    return b;
}
__device__ __forceinline__ void xcd_barrier_complete(unsigned* bar, unsigned x, unsigned& nloc, unsigned& nx) {
    const unsigned G = gridDim.x * gridDim.y * gridDim.z;
    unsigned sum, cnt, mine, sp = 0u;
    for (;;) {
        sum = 0u; cnt = 0u; mine = 0u;
#pragma unroll
        for (unsigned j = 0; j < 16; ++j) { const unsigned c = xb_ld(&bar[XB_XCNT(j)]); sum += c; cnt += (c > 0u) ? 1u : 0u; mine = (j == x) ? c : mine; }
        if (sum == G) break;
        __builtin_amdgcn_s_sleep(1);
        if ((++sp & 255u) == 0u) { if (xb_ld(&bar[XB_TMO])) break; if (sp > XB_SPIN_CAP) { atomicAdd(&bar[XB_TMO], 1u); break; } }
    }
    nloc = mine > 0u ? mine : 1u; nx = cnt > 0u ? cnt : 1u;
}

__device__ __forceinline__ void xcd_barrier(const XcdBarrier& b) {
    asm volatile("s_waitcnt vmcnt(0)" ::: "memory");
    __syncthreads();
    if (threadIdx.x == 0) {
        unsigned* bar = b.bar;
        __builtin_amdgcn_s_waitcnt(0);
        unsigned nloc = b.st[0], nx = b.st[1];
        if (nloc == 0u) { xcd_barrier_complete(bar, b.x, nloc, nx); b.st[0] = nloc; b.st[1] = nx; }
        const unsigned old = xb_add(&bar[XB_XSUB(b.x)], 1u);
        const unsigned gen = old / nloc;
        if (old + 1u == (gen + 1u) * nloc) {
            __builtin_amdgcn_fence(__ATOMIC_RELEASE, "agent");
            asm volatile("s_waitcnt vmcnt(0)" ::: "memory");
            const unsigned og = xb_add(&bar[XB_TOP], 1u);
            const unsigned tg = og / nx;
            if (og + 1u == (tg + 1u) * nx) xb_add(&bar[XB_TOPGEN], 1u);
            else XB_SPIN(xb_ld(&bar[XB_TOPGEN]) == tg, bar);
            __builtin_amdgcn_fence(__ATOMIC_ACQUIRE, "agent");
            xb_add(&bar[XB_XGEN(b.x)], 1u);
            asm volatile("s_waitcnt vmcnt(0)" ::: "memory");
        } else {
            XB_SPIN(xb_ld(&bar[XB_XGEN(b.x)]) == gen, bar);
            __builtin_amdgcn_fence(__ATOMIC_ACQUIRE, "agent");
            asm volatile("s_waitcnt vmcnt(0)" ::: "memory");
        }
    }
    __syncthreads();
}

struct Frame {
    LAS unsigned char* lds;
    volatile LAS unsigned* MISC;
    gu32* ctl;
    int tid, lane, wave, vcu, G;
    const float* in[25];
    float* out;
    unsigned char* ws;
};
#define IN_X 0
#define IN_META 1
#define IN_LBL 2
#define IN_NMIX 3
#define IN_WIN 4
#define IN_HGNORM 5
#define IN_CONVW 6
#define IN_CONVB 7
#define IN_WQ 8
#define IN_WK 9
#define IN_WV 10
#define IN_GATEB 11
#define IN_MLNORM 12
#define IN_MLSKIP 13
#define IN_WBH 14
#define IN_WBM 15
#define IN_WOUT 16
#define IN_NFFN 17
#define IN_RW 18
#define IN_RB 19
#define IN_WGU 20
#define IN_BGU 21
#define IN_WDN 22
#define IN_BDN 23
#define IN_NFIN 24

__device__ __forceinline__ void p0_item(const float* W, int ldw, int col0, int cstride, const float* kscale, bf16* WT, int K, int dstrow0, int k0, LAS float* scr, int lane, float gsc = 1.f, gu32* cmax = nullptr) {
    (void)cstride;
    const int r = lane >> 3, c4 = (lane & 7) * 4;
    f32x4 v[8];
#pragma unroll
    for (int i = 0; i < 8; ++i) v[i] = *(const GAS f32x4*)(W + (size_t)(k0 + 8 * i + r) * ldw + col0 + c4);
#pragma unroll
    for (int i = 0; i < 8; ++i) { const float sc = kscale ? kscale[k0 + 8 * i + r] : gsc; LAS float* s = scr + (8 * i + r) * 33 + c4; s[0] = v[i].x * sc; s[1] = v[i].y * sc; s[2] = v[i].z * sc; s[3] = v[i].w * sc; }
    LDS_WAIT(); asm volatile("" ::: "memory");
    const int c = lane & 7;
#pragma unroll
    for (int j = 0; j < 4; ++j) { const int n = (lane >> 3) + 8 * j; const LAS float* s = scr + (8 * c) * 33 + n;
        v4u o; o.x = pk2(s[0 * 33], s[1 * 33]); o.y = pk2(s[2 * 33], s[3 * 33]); o.z = pk2(s[4 * 33], s[5 * 33]); o.w = pk2(s[6 * 33], s[7 * 33]);
        if (cmax) { float m = fmaxf(fmaxf(fmaxf(fabsf(s[0 * 33]), fabsf(s[1 * 33])), fmaxf(fabsf(s[2 * 33]), fabsf(s[3 * 33]))), fmaxf(fmaxf(fabsf(s[4 * 33]), fabsf(s[5 * 33])), fmaxf(fabsf(s[6 * 33]), fabsf(s[7 * 33]))));
            m = fmaxf(m, __shfl_xor(m, 1)); m = fmaxf(m, __shfl_xor(m, 2)); m = fmaxf(m, __shfl_xor(m, 4));
            if (c == 0) (void)__hip_atomic_fetch_max(cmax + dstrow0 + n, __builtin_bit_cast(unsigned, m), RLX_AGENT); }
        *(GAS v4u*)(WT + (size_t)(dstrow0 + n) * K + k0 + 8 * c) = o; }
    LDS_WAIT(); asm volatile("" ::: "memory");
}
__device__ __forceinline__ void p0_prologue(Frame& F) {
    unsigned char* ws = F.ws;
    const int gw = F.vcu * NWAVES + F.wave, NGW = F.G * NWAVES, gt = F.vcu * NTHREADS + F.tid, NGT = F.G * NTHREADS;
    {
        LAS float* wm = (LAS float*)(F.lds + RING_OFF + 65536);
        { float wa[16], wb[16];
#pragma unroll
          for (int q = 0; q < 16; ++q) { const int u = F.tid + q * NTHREADS, j = u & 7, l = (u >> 3) & 63, i = u >> 9, k = 4 * l + 256 * (i >> 2) + (i & 3); wa[q] = F.in[IN_NMIX][k]; wb[q] = F.in[IN_WIN][(size_t)k * NIN + 3072 + j]; }
#pragma unroll
          for (int q = 0; q < 16; ++q) wm[F.tid + q * NTHREADS] = wa[q] * wb[q]; }
        __syncthreads();
        bf16* XN0 = (bf16*)(ws + WS_XN0); float* XSQ = (float*)(ws + WS_XSQ); unsigned char* XQ = ws + WS_XQ; float* SROW = (float*)(ws + WS_SROW); float* LI = (float*)(ws + WS_LI); float* LF = (float*)(ws + WS_LF);
        f32x4 vn[4];
#define P0_LOADROW(dst, V_) do { const int Vc_ = (V_) < NR ? (V_) : NR - 1; const float* src_ = (Vc_ >= NTOK) ? F.in[IN_META] + (size_t)(Vc_ - NTOK) * D : F.in[IN_X] + (size_t)Vc_ * D; \
        const GAS f32x4* xr_ = (const GAS f32x4*)src_ + F.lane; _Pragma("unroll") for (int j = 0; j < 4; ++j) dst[j] = xr_[64 * j]; } while (0)
        P0_LOADROW(vn, gw);
        for (int V = gw; V < NR; V += NGW) {
            f32x4 v[4]; float s = 0.f, am = 0.f;
#pragma unroll
            for (int j = 0; j < 4; ++j) { v[j] = vn[j]; s += (v[j].x * v[j].x + v[j].y * v[j].y) + (v[j].z * v[j].z + v[j].w * v[j].w); am = fmaxf(am, fmaxf(fmaxf(fabsf(v[j].x), fabsf(v[j].y)), fmaxf(fabsf(v[j].z), fabsf(v[j].w)))); }
            P0_LOADROW(vn, V + NGW);
            asm volatile("" ::: "memory");
            const float sq = sqrtf(wave_sum(s) * (1.f / D) + EPS), rs = 1.0f / sq;
            am = wave_max(am) * rs; const float srow = am > 0.f ? am * (1.f / 127.f) : 1.f, qi = 1.f / srow;
            if (F.lane == 0) { XSQ[V] = sq; SROW[V] = srow; }
            GAS unsigned* q4 = (GAS unsigned*)(XQ + (size_t)V * D) + F.lane;
            float g[8];
#pragma unroll
            for (int j = 0; j < 8; ++j) g[j] = 0.f;
            GAS unsigned long long* o8 = (GAS unsigned long long*)(XN0 + (size_t)V * D) + F.lane;
#pragma unroll
            for (int j = 0; j < 4; ++j) {
                v[j] = v[j] * rs;
                o8[64 * j] = (unsigned long long)pk2(v[j].x, v[j].y) | ((unsigned long long)pk2(v[j].z, v[j].w) << 32);
                q4[64 * j] = ((unsigned)(int)rintf(v[j].x * qi) & 0xffu) | (((unsigned)(int)rintf(v[j].y * qi) & 0xffu) << 8) | (((unsigned)(int)rintf(v[j].z * qi) & 0xffu) << 16) | ((unsigned)(int)rintf(v[j].w * qi) << 24);
#pragma unroll
                for (int q = 0; q < 4; ++q) { const LAS f32x4* wp = (const LAS f32x4*)(wm + (((4 * j + q) * 64 + F.lane) * 8)); const f32x4 w0 = wp[0], w1 = wp[1]; const float xv = v[j][q];
                    g[0] += xv * w0.x; g[1] += xv * w0.y; g[2] += xv * w0.z; g[3] += xv * w0.w; g[4] += xv * w1.x; g[5] += xv * w1.y; g[6] += xv * w1.z; g[7] += xv * w1.w; }
            }
#pragma unroll
            for (int j = 0; j < 8; ++j) g[j] = wave_sum(g[j]);
            if (F.lane < 4) {
                const float gi = (F.lane == 0 ? g[0] : F.lane == 1 ? g[1] : F.lane == 2 ? g[2] : g[3]) + F.in[IN_GATEB][F.lane];
                const float gf = (F.lane == 0 ? g[4] : F.lane == 1 ? g[5] : F.lane == 2 ? g[6] : g[7]) + F.in[IN_GATEB][4 + F.lane];
                LI[(size_t)V * 4 + F.lane] = gi;
                LF[(size_t)V * 4 + F.lane] = fminf(gf, 0.f) - log1pf(__expf(-fabsf(gf)));
            }
        }
        __syncthreads();
    }
    {
        LAS float* scr = (LAS float*)(F.lds + RING_OFF + F.wave * 16384);
        constexpr int I_IN1 = 16 * 96, I_IN2 = 16 * 64, I_BH = 8 * 32, I_OUT = 16 * 32;
        constexpr int NITEMS = I_IN1 + I_IN2 + 2 * I_BH + I_OUT;
        for (int it = gw; it < NITEMS; it += NGW) {
            int r = it;
            if (r < I_IN1) { const int kb = r / 96, nb = r % 96; p0_item(F.in[IN_WIN], NIN, 32 * nb, 1, F.in[IN_NMIX], (bf16*)(ws + WS_WIN), D, 32 * nb, 64 * kb, scr, F.lane, 1.f, F.ctl + CW_CMAX); continue; } r -= I_IN1;
            if (r < I_IN2) { const int kb = r / 64, nb = r % 64; p0_item(F.in[IN_WIN], NIN, 3080 + 32 * nb, 1, F.in[IN_NMIX], (bf16*)(ws + WS_WIN), D, 3072 + 32 * nb, 64 * kb, scr, F.lane, 1.f, F.ctl + CW_CMAX); continue; } r -= I_IN2;
            if (r < I_BH) { const int kb = r / 32, nb = r % 32; p0_item(F.in[IN_WBH], D, 32 * nb, 1, nullptr, (bf16*)(ws + WS_WBH), HW, 32 * nb, 64 * kb, scr, F.lane, 1.f / 255.f); continue; } r -= I_BH;
            if (r < I_BH) { const int kb = r / 32, nb = r % 32; p0_item(F.in[IN_WBM], D, 32 * nb, 1, nullptr, (bf16*)(ws + WS_WBM), HW, 32 * nb, 64 * kb, scr, F.lane, 1.f / 255.f); continue; } r -= I_BH;
            { const int kb = r / 32, nb = r % 32; p0_item(F.in[IN_WOUT], D, 32 * nb, 1, nullptr, (bf16*)(ws + WS_WOUT), D, 32 * nb, 64 * kb, scr, F.lane); }
        }
    }
    { float* BGUP = (float*)(ws + WS_BGUP); float* RWT = (float*)(ws + WS_RWT);
      for (int u = gt; u < NE * 2 * DFF; u += NGT) { const int e = u >> 11, n = u & 2047, pn = n >> 8, bj = (n >> 7) & 1, j = gu_slot(n & 127); BGUP[u] = F.in[IN_BGU][(size_t)e * 2 * DFF + 2 * (128 * pn + j) + bj]; }
      for (int u = gt; u < NE * D; u += NGT) { const int e = u >> 10, k = u & 1023; RWT[u] = F.in[IN_NFFN][k] * F.in[IN_RW][(size_t)k * NE + e]; } }
}

__device__ __forceinline__ void p0b_quant(Frame& F) {
    unsigned char* ws = F.ws; const int gw = F.vcu * NWAVES + F.wave, NGW = F.G * NWAVES, lane = F.lane;
    LAS float* scr = (LAS float*)(F.lds + RING_OFF + F.wave * 16384);
    unsigned char* W8 = ws + WS_WIN8; float* SCOL = (float*)(ws + WS_SCOL); const float* W = F.in[IN_WIN]; const float* kscale = F.in[IN_NMIX];
    constexpr int I_IN1 = 16 * 96, I_IN2 = 16 * 64;
    const int r = lane >> 3, c4 = (lane & 7) * 4;
    for (int it = gw; it < I_IN1 + I_IN2; it += NGW) {
        int kb, nb, col0, dstrow0;
        if (it < I_IN1) { kb = it / 96; nb = it % 96; col0 = 32 * nb; dstrow0 = 32 * nb; } else { const int q = it - I_IN1; kb = q / 64; nb = q % 64; col0 = 3080 + 32 * nb; dstrow0 = 3072 + 32 * nb; }
        const int k0 = 64 * kb;
        f32x4 v[8];
#pragma unroll
        for (int i = 0; i < 8; ++i) v[i] = *(const GAS f32x4*)(W + (size_t)(k0 + 8 * i + r) * NIN + col0 + c4);
        float qs[4];
#pragma unroll
        for (int e = 0; e < 4; ++e) { const float m = __builtin_bit_cast(float, __hip_atomic_load(F.ctl + CW_CMAX + dstrow0 + c4 + e, RLX_AGENT)); qs[e] = 127.f / fmaxf(m, 1e-30f); }
        if (kb == 0 && lane < 8) {
#pragma unroll
            for (int e = 0; e < 4; ++e) SCOL[dstrow0 + c4 + e] = 1.f / qs[e]; }
#pragma unroll
        for (int i = 0; i < 8; ++i) { const float sc = kscale[k0 + 8 * i + r]; LAS float* s = scr + (8 * i + r) * 33 + c4; s[0] = rintf(v[i].x * sc * qs[0]); s[1] = rintf(v[i].y * sc * qs[1]); s[2] = rintf(v[i].z * sc * qs[2]); s[3] = rintf(v[i].w * sc * qs[3]); }
        LDS_WAIT(); asm volatile("" ::: "memory");
        const int c = lane & 7;
#pragma unroll
        for (int j = 0; j < 4; ++j) { const int n = (lane >> 3) + 8 * j; const LAS float* s = scr + (8 * c) * 33 + n;
            v2u o;
            o.x = ((unsigned)(int)s[0 * 33] & 0xffu) | (((unsigned)(int)s[1 * 33] & 0xffu) << 8) | (((unsigned)(int)s[2 * 33] & 0xffu) << 16) | ((unsigned)(int)s[3 * 33] << 24);
            o.y = ((unsigned)(int)s[4 * 33] & 0xffu) | (((unsigned)(int)s[5 * 33] & 0xffu) << 8) | (((unsigned)(int)s[6 * 33] & 0xffu) << 16) | ((unsigned)(int)s[7 * 33] << 24);
            *(GAS v2u*)(W8 + (size_t)(dstrow0 + n) * D + k0 + 8 * c) = o; }
        LDS_WAIT(); asm volatile("" ::: "memory");
    }
}

__device__ __forceinline__ unsigned pk4_fp8(float a, float b, float c, float d) { unsigned w = 0;
    a = __builtin_amdgcn_fmed3f(a, -448.f, 448.f); b = __builtin_amdgcn_fmed3f(b, -448.f, 448.f); c = __builtin_amdgcn_fmed3f(c, -448.f, 448.f); d = __builtin_amdgcn_fmed3f(d, -448.f, 448.f);
    w = __builtin_amdgcn_cvt_pk_fp8_f32(a, b, w, false); w = __builtin_amdgcn_cvt_pk_fp8_f32(c, d, w, true); return w; }
__device__ __forceinline__ void cvdn_load(const float* Wdn, int it, f32x4 (&v)[8], int lane) {
    const int e = it >> 9, kb = (it >> 5) & 15, nb = it & 31, r = lane >> 3, c4 = (lane & 7) * 4; const float* W = Wdn + (size_t)e * DFF * D;
#pragma unroll
    for (int i = 0; i < 8; ++i) v[i] = *(const GAS f32x4*)(W + (size_t)(64 * kb + 8 * i + r) * D + 32 * nb + c4);
}
__device__ __forceinline__ void cvdn_proc(unsigned char* WTdn, int it, const f32x4 (&v)[8], LAS float* scr, int lane) {
    const int e = it >> 9, kb = (it >> 5) & 15, nb = it & 31, r = lane >> 3, c4 = (lane & 7) * 4; unsigned char* WT = WTdn + (size_t)e * D * DFF;
#pragma unroll
    for (int i = 0; i < 8; ++i) { LAS float* s = scr + (8 * i + r) * 33 + c4; s[0] = v[i].x * 32.f; s[1] = v[i].y * 32.f; s[2] = v[i].z * 32.f; s[3] = v[i].w * 32.f; }
    LDS_WAIT(); asm volatile("" ::: "memory");
    const int c = lane & 7;
#pragma unroll
    for (int j = 0; j < 4; ++j) { const int n = (lane >> 3) + 8 * j; const LAS float* s = scr + (8 * c) * 33 + n;
        v2u o; o.x = pk4_fp8(s[0 * 33], s[1 * 33], s[2 * 33], s[3 * 33]); o.y = pk4_fp8(s[4 * 33], s[5 * 33], s[6 * 33], s[7 * 33]);
        const int cn = 32 * nb + n, rowp = (cn & ~255) + 128 * ((cn >> 3) & 1) + 32 * ((cn >> 6) & 3) + 8 * ((cn >> 4) & 3) + (cn & 7);
        *(GAS v2u*)(WT + (size_t)rowp * DFF + 64 * kb + 8 * c) = o; }
    LDS_WAIT(); asm volatile("" ::: "memory");
}
__device__ __forceinline__ void cvgu_load(const float* Wgu, const float* nffn, int it, f32x4 (&v)[8], float (&sc)[8], int lane) {
    const int e = it >> 10, kb = (it >> 5) & 31, nb = it & 31, r = lane >> 4, c4 = (lane & 15) * 4; const float* W = Wgu + (size_t)e * D * 2 * DFF;
#pragma unroll
    for (int i = 0; i < 8; ++i) { v[i] = *(const GAS f32x4*)(W + (size_t)(32 * kb + 4 * i + r) * (2 * DFF) + 64 * nb + c4); sc[i] = nffn[32 * kb + 4 * i + r] * 32.f; }
}
__device__ __forceinline__ void cvgu_proc(unsigned char* WTgu, int it, const f32x4 (&v)[8], const float (&sc)[8], LAS float* scr, int lane) {
    const int e = it >> 10, kb = (it >> 5) & 31, nb = it & 31, r = lane >> 4, c4 = (lane & 15) * 4, A0 = 32 * nb, k0 = 32 * kb; unsigned char* WT = WTgu + (size_t)e * 2 * DFF * D;
    LAS float* sg = scr; LAS float* su = scr + 32 * 33;
#pragma unroll
    for (int i = 0; i < 8; ++i) { const int o = (4 * i + r) * 33 + (c4 >> 1); sg[o] = v[i].x * sc[i]; su[o] = v[i].y * sc[i]; sg[o + 1] = v[i].z * sc[i]; su[o + 1] = v[i].w * sc[i]; }
    LDS_WAIT(); asm volatile("" ::: "memory");
    const int c = lane & 3;
#pragma unroll
    for (int j = 0; j < 4; ++j) { const int q = (lane >> 2) + 16 * j, isup = q >> 5, jj = q & 31, A = A0 + jj; const LAS float* s = scr + isup * 32 * 33 + (8 * c) * 33 + jj;
        v2u o; o.x = pk4_fp8(s[0 * 33], s[1 * 33], s[2 * 33], s[3 * 33]); o.y = pk4_fp8(s[4 * 33], s[5 * 33], s[6 * 33], s[7 * 33]);
        *(GAS v2u*)(WT + (size_t)(256 * (A >> 7) + 128 * isup + gu_slot(A & 127)) * D + k0 + 8 * c) = o; }
    LDS_WAIT(); asm volatile("" ::: "memory");
}
__device__ __forceinline__ void px_experts(Frame& F, int rank, int nwg) {
    unsigned char* ws = F.ws;
    LAS float* scr = (LAS float*)(F.lds + RING_OFF + F.wave * 16384);
    const int gw = rank * NWAVES + F.wave, NGW = nwg * NWAVES;
    { constexpr int NIT = NE * 1024; f32x4 v[8], vn[8]; float sc[8], sn[8]; int it = gw;
      if (it < NIT) cvgu_load(F.in[IN_WGU], F.in[IN_NFFN], it, v, sc, F.lane);
      while (it < NIT) { const int nx = it + NGW; if (nx < NIT) cvgu_load(F.in[IN_WGU], F.in[IN_NFFN], nx, vn, sn, F.lane);
          asm volatile("" ::: "memory");
          cvgu_proc((unsigned char*)(ws + WS_WGU), it, v, sc, scr, F.lane); asm volatile("" ::: "memory");
#pragma unroll
          for (int i = 0; i < 8; ++i) { v[i] = vn[i]; sc[i] = sn[i]; }
          it = nx; } }
    { constexpr int NIT = NE * 512; f32x4 v[8], vn[8]; int it = gw;
      if (it < NIT) cvdn_load(F.in[IN_WDN], it, v, F.lane);
      while (it < NIT) { const int nx = it + NGW; if (nx < NIT) cvdn_load(F.in[IN_WDN], nx, vn, F.lane);
          asm volatile("" ::: "memory");
          cvdn_proc((unsigned char*)(ws + WS_WDN), it, v, scr, F.lane); asm volatile("" ::: "memory");
#pragma unroll
          for (int i = 0; i < 8; ++i) v[i] = vn[i];
          it = nx; } }
}

namespace pg8 {
typedef unsigned v2u_t __attribute__((ext_vector_type(2)));
typedef float f32x2 __attribute__((ext_vector_type(2)));
__device__ __forceinline__ f32x2 sig2(f32x2 x) { const f32x2 t = x * (f32x2){-1.4426950408889634f, -1.4426950408889634f};
    const f32x2 d = (f32x2){__builtin_amdgcn_exp2f(t.x), __builtin_amdgcn_exp2f(t.y)} + (f32x2){1.f, 1.f}; return (f32x2){__builtin_amdgcn_rcpf(d.x), __builtin_amdgcn_rcpf(d.y)}; }
__device__ __forceinline__ u32x4 pack8(const f32x4& a, const f32x4& b) { u32x4 w; w.x = cvt_pk_bf16(a[0], a[1]); w.y = cvt_pk_bf16(a[2], a[3]); w.z = cvt_pk_bf16(b[0], b[1]); w.w = cvt_pk_bf16(b[2], b[3]); return w; }
__device__ __forceinline__ v2u_t pack8_fp8(const f32x4& a, const f32x4& b) { unsigned lo = 0, hi = 0;
    lo = __builtin_amdgcn_cvt_pk_fp8_f32(a[0], a[1], lo, false); lo = __builtin_amdgcn_cvt_pk_fp8_f32(a[2], a[3], lo, true);
    hi = __builtin_amdgcn_cvt_pk_fp8_f32(b[0], b[1], hi, false); hi = __builtin_amdgcn_cvt_pk_fp8_f32(b[2], b[3], hi, true); return (v2u_t){lo, hi}; }
__device__ __forceinline__ v2u_t pack8_fp8_sat(const f32x4& a, const f32x4& b) { f32x4 x, y;
#pragma unroll
    for (int i = 0; i < 4; ++i) { x[i] = __builtin_amdgcn_fmed3f(a[i], -448.f, 448.f); y[i] = __builtin_amdgcn_fmed3f(b[i], -448.f, 448.f); }
    return pack8_fp8(x, y); }
__device__ __forceinline__ void unpack8(const u32x4& w, f32x4& a, f32x4& b) { a = (f32x4){bflo(w.x), bfhi(w.x), bflo(w.y), bfhi(w.y)}; b = (f32x4){bflo(w.z), bfhi(w.z), bflo(w.w), bfhi(w.w)}; }
__host__ __device__ __forceinline__ int gate_pos(int c) { return (c & ~255) + ((((c >> 5) & 3) * 4 + ((c >> 3) & 3)) * 16) + (((c >> 7) & 1) * 8) + (c & 7); }
__device__ __forceinline__ unsigned q8x4(float a, float b, float c, float d) {
    const unsigned t0 = __builtin_bit_cast(unsigned, __builtin_fmaf(a, 255.f, 8388608.f)), t1 = __builtin_bit_cast(unsigned, __builtin_fmaf(b, 255.f, 8388608.f));
    const unsigned t2 = __builtin_bit_cast(unsigned, __builtin_fmaf(c, 255.f, 8388608.f)), t3 = __builtin_bit_cast(unsigned, __builtin_fmaf(d, 255.f, 8388608.f));
    return (t0 & 0xffu) | (t1 << 8) | (t2 << 16) | (t3 << 24); }
__device__ __forceinline__ f32x4 dq8x4(unsigned w) { return (f32x4){(float)(w & 0xffu), (float)((w >> 8) & 0xffu), (float)((w >> 16) & 0xffu), (float)(w >> 24)}; }
struct EpiNull { static constexpr bool PERM = true, AFTER_DRAIN = false; int* sink;
    __device__ __forceinline__ void operator()(const f32x4 (&acc)[2][2][4][2], const Unit& u, int wr, int wc, int fr, int fq) const { int s = 0;
#pragma unroll
        for (int a = 0; a < 2; ++a)
#pragma unroll
            for (int b = 0; b < 2; ++b)
#pragma unroll
                for (int m = 0; m < 4; ++m)
#pragma unroll
                    for (int n = 0; n < 2; ++n) { const i32x4 q = __builtin_bit_cast(i32x4, acc[a][b][m][n]); s += (q[0] ^ q[1]) + (q[2] ^ q[3]); }
        if (s == 0x7fffff01 + u.pm) sink[0] = s; } };
template <bool Q, bool NS = false>
struct EpiProjT {
    static constexpr bool PERM = true, AFTER_DRAIN = false;
    unsigned char* ws; const float* lbl; const float* srow; const float* scol;
    struct Sc { float rs[8]; f32x2 cs[2][4]; };
    __device__ __forceinline__ f32x2 val(const f32x4 (&acc)[2][2][4][2], const Sc& sc, int ai, int bj, int m, int k) const {
        const f32x4 a = acc[ai][bj][m][k >> 1];
        if constexpr (Q) { const i32x4 q = __builtin_bit_cast(i32x4, a); const float r = sc.rs[ai * 4 + m]; return ((f32x2){(float)q[2 * (k & 1)], (float)q[2 * (k & 1) + 1]} * sc.cs[bj][k]) * (f32x2){r, r}; }
        else return (f32x2){a[2 * (k & 1)], a[2 * (k & 1) + 1]};
    }
    template <int ACT>
    __device__ __forceinline__ void emit(const f32x4 (&acc)[2][2][4][2], const Sc& sc, bf16_t* O, int row0, int colt) const {
#pragma unroll
        for (int ai = 0; ai < 2; ++ai)
#pragma unroll
            for (int m = 0; m < 4; ++m) { bf16_t* rowp = O + (size_t)(row0 + ai * HALF + m * 16) * HW + colt;
#pragma unroll
                for (int bj = 0; bj < 2; ++bj) { u32x4 o;
#pragma unroll
                    for (int k = 0; k < 4; ++k) { f32x2 p = val(acc, sc, ai, bj, m, k);
                        if constexpr (ACT == 1) p = p * sig2(p); else if constexpr (ACT == 2) p = sig2(p);
                        o[k] = cvt_pk_bf16(p.x, p.y); }
                    if constexpr (NS) asm volatile("" :: "v"(o.x), "v"(o.y), "v"(o.z), "v"(o.w)); else *(u32x4*)(rowp + bj * HALF) = o; } }
    }
    __device__ __forceinline__ void operator()(const f32x4 (&acc)[2][2][4][2], const Unit& u, int wr, int wc, int fr, int fq) const {
        const int row0 = u.pm * BM + wr * 64 + fr, kind = u.pn < 12 ? (u.pn >> 1) : 6;
        const int colt = (u.pn < 12 ? (u.pn & 1) : (u.pn - 12)) * BM + wc * 32 + 8 * fq;
        Sc sc;
        if constexpr (Q) {
#pragma unroll
            for (int it = 0; it < 8; ++it) sc.rs[it] = srow[row0 + (it >> 2) * HALF + (it & 3) * 16];
#pragma unroll
            for (int bj = 0; bj < 2; ++bj) { const float* cp = scol + u.pn * BM + wc * 32 + 8 * fq + bj * HALF; const f32x4 c0 = *(const f32x4*)cp, c1 = *(const f32x4*)(cp + 4);
                sc.cs[bj][0] = (f32x2){c0[0], c0[1]}; sc.cs[bj][1] = (f32x2){c0[2], c0[3]}; sc.cs[bj][2] = (f32x2){c1[0], c1[1]}; sc.cs[bj][3] = (f32x2){c1[2], c1[3]}; }
        }
        if (kind == 1) {
            bf16_t* HG = (bf16_t*)(ws + WS_HG);
#pragma unroll
            for (int bj = 0; bj < 2; ++bj) { const int c = colt + bj * HALF; f32x2 lb[4], ol[4];
#pragma unroll
                for (int k = 0; k < 4; ++k) { lb[k] = sig2((f32x2){lbl[c + 2 * k] - lbl[HW + c + 2 * k], lbl[c + 2 * k + 1] - lbl[HW + c + 2 * k + 1]}); ol[k] = (f32x2){1.f, 1.f} - lb[k]; }
#pragma unroll
                for (int ai = 0; ai < 2; ++ai)
#pragma unroll
                    for (int m = 0; m < 4; ++m) { u32x4 o;
#pragma unroll
                        for (int k = 0; k < 4; ++k) { const f32x2 f = ol[k] * sig2(val(acc, sc, ai, bj, m, k)) + lb[k];
                            const f32x2 lg = (f32x2){__builtin_amdgcn_logf(f.x), __builtin_amdgcn_logf(f.y)} * (f32x2){0.6931471805599453f, 0.6931471805599453f}; o[k] = cvt_pk_bf16(lg.x, lg.y); }
                        if constexpr (NS) asm volatile("" :: "v"(o.x), "v"(o.y), "v"(o.z), "v"(o.w)); else *(u32x4*)(HG + (size_t)(row0 + ai * HALF + m * 16) * HW + c) = o; } }
            return;
        }
        if (kind == 6) {
            unsigned char* G8 = ws + WS_GATES; const int gofs = (u.pn - 12) * BM + (wc * 4 + fq) * 16;
#pragma unroll
            for (int ai = 0; ai < 2; ++ai)
#pragma unroll
                for (int m = 0; m < 4; ++m) { u32x4 o;
#pragma unroll
                    for (int bj = 0; bj < 2; ++bj)
#pragma unroll
                        for (int h = 0; h < 2; ++h) {
                            const f32x2 sa = sig2(val(acc, sc, ai, bj, m, 2 * h)), sb = sig2(val(acc, sc, ai, bj, m, 2 * h + 1));
                            o[2 * bj + h] = q8x4(sa.x, sa.y, sb.x, sb.y); }
                    if constexpr (NS) asm volatile("" :: "v"(o.x), "v"(o.y), "v"(o.z), "v"(o.w)); else *(u32x4*)(G8 + (size_t)(row0 + ai * HALF + m * 16) * 2048 + gofs) = o; }
            return;
        }
        if (kind == 0) emit<1>(acc, sc, (bf16_t*)(ws + WS_HQ), row0, colt); else if (kind == 2) emit<0>(acc, sc, (bf16_t*)(ws + WS_HV), row0, colt); else if (kind == 3) emit<1>(acc, sc, (bf16_t*)(ws + WS_HGATE), row0, colt);
        else if (kind == 4) emit<0>(acc, sc, (bf16_t*)(ws + WS_MM), row0, colt); else emit<2>(acc, sc, (bf16_t*)(ws + WS_MO), row0, colt);
    }
};
constexpr int PAIR_DA = 132, PAIR_DB = 4;
struct PairOrder { StaticOrder S;
    __device__ __forceinline__ bool next(int i, Unit& u) const { Unit t; if (!S.next(i >> 1, t)) return false; const int s = i & 1; u.pm = t.pm + PAIR_DA * s; u.pn = t.pn + PAIR_DB * s; return true; }
    __device__ __forceinline__ void a_ready(const Unit&) const {}
    __device__ __forceinline__ void done(const Unit&) const {}
};
struct EpiGate2 {
    static constexpr bool PERM = true, AFTER_DRAIN = false;
    const unsigned char* __restrict__ gates; bf16_t* __restrict__ tmp; bf16_t* __restrict__ merged;
    __device__ __forceinline__ void operator()(const f32x4 (&acc)[2][2][4][2], const Unit& u, int wr, int wc, int fr, int fq) const {
        const int step = u.pm >= PAIR_DA ? 1 : 0, pm = u.pm - PAIR_DA * step, pn = u.pn - PAIR_DB * step;
        const int row0 = pm * BM + wr * 64 + fr, col0 = pn * BM + wc * 32 + 8 * fq, gofs = step * D + pn * BM + (wc * 4 + fq) * 16;
        constexpr int NB = 2, NBAT = 8 / NB;
        bf16_t* obuf = tmp + (ptrdiff_t)(merged - tmp) * step;
        u32x4 gc[NB], tc[NB][2], gn[NB], tn[NB][2];
#define EG_LOAD(G, T, b_) do { _Pragma("unroll") for (int s_ = 0; s_ < NB; ++s_) { const int it_ = (b_) * NB + s_; const size_t row_ = (size_t)(row0 + (it_ >> 2) * HALF + (it_ & 3) * 16); G[s_] = *(const u32x4*)(gates + row_ * 2048 + gofs); _Pragma("unroll") for (int bj = 0; bj < 2; ++bj) { \
        if (step) T[s_][bj] = *(const u32x4*)(tmp + row_ * D + col0 + bj * HALF); else T[s_][bj] = (u32x4){0u, 0u, 0u, 0u}; } } } while (0)
        EG_LOAD(gc, tc, 0);
#pragma unroll
        for (int b = 0; b < NBAT; ++b) {
            if (b + 1 < NBAT) EG_LOAD(gn, tn, b + 1);
#pragma unroll
            for (int s = 0; s < NB; ++s) { const int it = b * NB + s, ai = it >> 2, m = it & 3; const size_t row = (size_t)(row0 + ai * HALF + m * 16);
#pragma unroll
                for (int bj = 0; bj < 2; ++bj) { const int c = col0 + bj * HALF; f32x4 t0, t1; unpack8(tc[s][bj], t0, t1); const f32x4 g0 = dq8x4(gc[s][2 * bj]), g1 = dq8x4(gc[s][2 * bj + 1]);
                    const u32x4 o = pack8(acc[ai][bj][m][0] * g0 + t0, acc[ai][bj][m][1] * g1 + t1);
                    *(u32x4*)(obuf + row * D + c) = o; } }
#pragma unroll
            for (int s = 0; s < NB; ++s)
#pragma unroll
                for (int bj = 0; bj < 2; ++bj) tc[s][bj] = tn[s][bj];
#pragma unroll
            for (int s = 0; s < NB; ++s) gc[s] = gn[s]; }
#undef EG_LOAD
    }
};
struct EpiH1 {
    static constexpr bool PERM = true, AFTER_DRAIN = false;
    const bf16_t* __restrict__ xn0; const float* __restrict__ xsq; bf16_t* __restrict__ H1; unsigned char* __restrict__ H1B8;
    __device__ __forceinline__ void operator()(const f32x4 (&acc)[2][2][4][2], const Unit& u, int wr, int wc, int fr, int fq) const {
        const int row0 = u.pm * BM + wr * 64 + fr, col0 = u.pn * BM + wc * 32 + 8 * fq;
        u32x4 xc[2], xn[2]; float sc, sn;
#define EH_LOAD(X, S_, it_) do { const size_t r_ = (size_t)(row0 + ((it_) >> 2) * HALF + ((it_) & 3) * 16); const bf16_t* src_ = xn0 + r_ * D + col0; S_ = xsq[r_]; _Pragma("unroll") for (int bj = 0; bj < 2; ++bj) X[bj] = *(const u32x4*)(src_ + bj * HALF); } while (0)
        EH_LOAD(xc, sc, 0);
#pragma unroll
        for (int it = 0; it < 8; ++it) { const int ai = it >> 2, m = it & 3; const size_t V = (size_t)(row0 + ai * HALF + m * 16);
            if (it + 1 < 8) EH_LOAD(xn, sn, it + 1);
#pragma unroll
            for (int bj = 0; bj < 2; ++bj) { const int c = col0 + bj * HALF; f32x4 x0, x1; unpack8(xc[bj], x0, x1);
                const f32x4 v0 = x0 * sc + acc[ai][bj][m][0], v1 = x1 * sc + acc[ai][bj][m][1];
                *(u32x4*)(H1 + V * D + c) = pack8(v0, v1); *(v2u_t*)(H1B8 + V * D + c) = pack8_fp8_sat(v0, v1); }
#pragma unroll
            for (int bj = 0; bj < 2; ++bj) xc[bj] = xn[bj];
            sc = sn; }
#undef EH_LOAD
    }
};
template <bool NS = false>
struct EpiGUT {
    static constexpr bool PERM = true, AFTER_DRAIN = false;
    const float* __restrict__ bgup; const float* __restrict__ ers; unsigned char* __restrict__ act; const PG8_LAS int* pst;
    __device__ __forceinline__ void operator()(const f32x4 (&acc)[2][2][4][2], const Unit& u, int wr, int wc, int fr, int fq) const {
        const int e = u.pn >> 3, pn = u.pn & 7, row0 = u.pm * BM + wr * 64 + fr, cc = wc * 32 + 8 * fq;
        const float* rsp = ers + (size_t)e * NV + (row0 - pst[e]);
        const float* bp = bgup + (size_t)e * 2 * DFF + pn * BM + cc;
        f32x2 bg[2][2], bu[2][2];
#pragma unroll
        for (int h = 0; h < 2; ++h) { const f32x4 g4 = *(const f32x4*)(bp + 4 * h), u4 = *(const f32x4*)(bp + HALF + 4 * h);
            bg[h][0] = (f32x2){g4[0], g4[1]}; bg[h][1] = (f32x2){g4[2], g4[3]}; bu[h][0] = (f32x2){u4[0] + 1.f, u4[1] + 1.f}; bu[h][1] = (f32x2){u4[2] + 1.f, u4[3] + 1.f}; }
        float rsv[8];
#pragma unroll
        for (int it = 0; it < 8; ++it) rsv[it] = rsp[(it >> 2) * HALF + (it & 3) * 16];
        const int hi = fq >> 1;
        unsigned char* obase = act + (size_t)(row0 + 16 * hi) * DFF + pn * HALF + wc * 32 + 16 * (fq & 1);
        constexpr float KS = -1.702f * 1.4426950408889634f;
#pragma unroll
        for (int ai = 0; ai < 2; ++ai)
#pragma unroll
            for (int mp = 0; mp < 2; ++mp) { v2u_t pk[2];
#pragma unroll
                for (int q = 0; q < 2; ++q) { const int m = 2 * mp + q; const float rs = rsv[ai * 4 + m] * 0.03125f;
                    const f32x2 rs2 = {rs, rs}; unsigned w[2];
#pragma unroll
                    for (int h = 0; h < 2; ++h) { f32x2 o[2];
#pragma unroll
                        for (int p = 0; p < 2; ++p) {
                            f32x2 g = (f32x2){acc[ai][0][m][h][2 * p], acc[ai][0][m][h][2 * p + 1]} * rs2 + bg[h][p];
                            f32x2 u1 = (f32x2){acc[ai][1][m][h][2 * p], acc[ai][1][m][h][2 * p + 1]} * rs2 + bu[h][p];
                            g.x = fminf(g.x, 7.f); g.y = fminf(g.y, 7.f); u1.x = __builtin_amdgcn_fmed3f(u1.x, -6.f, 8.f); u1.y = __builtin_amdgcn_fmed3f(u1.y, -6.f, 8.f);
                            const f32x2 t = g * (f32x2){KS, KS};
                            const f32x2 d = (f32x2){__builtin_amdgcn_exp2f(t.x), __builtin_amdgcn_exp2f(t.y)} + (f32x2){1.f, 1.f};
                            const f32x2 r = {__builtin_amdgcn_rcpf(d.x), __builtin_amdgcn_rcpf(d.y)};
                            o[p] = (g * r) * u1; }
                        w[h] = __builtin_amdgcn_cvt_pk_fp8_f32(o[0].x, o[0].y, 0u, false); w[h] = __builtin_amdgcn_cvt_pk_fp8_f32(o[1].x, o[1].y, w[h], true); }
                    pk[q] = (v2u_t){w[0], w[1]}; }
                const auto r0 = __builtin_amdgcn_permlane32_swap(pk[0][0], pk[1][0], false, false), r1 = __builtin_amdgcn_permlane32_swap(pk[0][1], pk[1][1], false, false);
                if constexpr (NS) asm volatile("" :: "v"(r0[0]), "v"(r1[0]), "v"(r0[1]), "v"(r1[1])); else *(u32x4*)(obase + (size_t)(ai * HALF + mp * 32) * DFF) = (u32x4){r0[0], r1[0], r0[1], r1[1]}; }
    }
};
template <bool NS = false>
struct EpiDownT {
    static constexpr bool PERM = true, AFTER_DRAIN = false;
    const float* __restrict__ bdn; const float* __restrict__ ew; unsigned char* __restrict__ yb; const PG8_LAS int* pst;
    __device__ __forceinline__ void operator()(const f32x4 (&acc)[2][2][4][2], const Unit& u, int wr, int wc, int fr, int fq) const {
        const int e = u.pn >> 2, pn = u.pn & 3, row0 = u.pm * BM + wr * 64 + fr, col0 = pn * BM + wc * 64 + 16 * fq;
        const float* wp = ew + (size_t)e * NV + (row0 - pst[e]);
        f32x4 bv[2][2];
#pragma unroll
        for (int bj = 0; bj < 2; ++bj) { bv[bj][0] = *(const f32x4*)(bdn + (size_t)e * D + col0 + 8 * bj); bv[bj][1] = *(const f32x4*)(bdn + (size_t)e * D + col0 + 8 * bj + 4); }
        float wv[8];
#pragma unroll
        for (int it = 0; it < 8; ++it) wv[it] = wp[(it >> 2) * HALF + (it & 3) * 16];
#pragma unroll
        for (int ai = 0; ai < 2; ++ai)
#pragma unroll
            for (int m = 0; m < 4; ++m) { const size_t row = (size_t)(row0 + ai * HALF + m * 16); const float w = wv[ai * 4 + m] * 16.f;
                const v2u_t lo = pack8_fp8_sat((acc[ai][0][m][0] * 0.03125f + bv[0][0]) * w, (acc[ai][0][m][1] * 0.03125f + bv[0][1]) * w), hi = pack8_fp8_sat((acc[ai][1][m][0] * 0.03125f + bv[1][0]) * w, (acc[ai][1][m][1] * 0.03125f + bv[1][1]) * w);
                if constexpr (NS) asm volatile("" :: "v"(lo[0]), "v"(lo[1]), "v"(hi[0]), "v"(hi[1])); else __builtin_nontemporal_store((u32x4){lo[0], lo[1], hi[0], hi[1]}, (u32x4*)(yb + row * D + col0)); }
    }
};
struct GroupOrder {
    int ntiles, ncol, G, c; const PG8_LAS unsigned char* texp;
    __device__ __forceinline__ bool next(int i, Unit& u) const { const int x = c & 7, w = c >> 3, uu = i * (G >> 3) + w, lj = uu / ncol, pn = uu - lj * ncol, j = lj * 8 + x; if (j >= ntiles) return false; u.pm = j; u.pn = (int)texp[j] * ncol + pn; return true; }
    __device__ __forceinline__ void a_ready(const Unit&) const {}
    __device__ __forceinline__ void done(const Unit&) const {}
};
typedef EpiDownT<false> EpiDown; typedef EpiGUT<false> EpiGU;
}

typedef short bf16x8 __attribute__((ext_vector_type(8)));
typedef float f32x16 __attribute__((ext_vector_type(16)));
#define MFMA32(a, b, c) __builtin_amdgcn_mfma_f32_32x32x16_bf16(a, b, c, 0, 0, 0)
__device__ __forceinline__ bf16x8 ldfrag(const LAS unsigned char* base, int st, int row0, int k0, int lane) { return *(const LAS bf16x8*)(base + (row0 + (lane & 31)) * st + (k0 + 8 * (lane >> 5)) * 2); }
__device__ __forceinline__ bf16x8 ldf(const LAS unsigned char* lanebase, int off) { return *(const LAS bf16x8*)(lanebase + off); }
__device__ __forceinline__ float fexp(float x) { return __builtin_amdgcn_exp2f(x * 1.4426950408889634f); }

__device__ __forceinline__ void p3_hgrn2_mfma(Frame& F, int bh) {
    unsigned char* ws = F.ws; const int b = bh >> 2, h = bh & 3, tid = F.tid, lane = F.lane, wave = F.wave, hh = lane >> 5, l31 = lane & 31;
    const bf16* HQ = (const bf16*)(ws + WS_HQ) + h * 128; const bf16* HG = (const bf16*)(ws + WS_HG) + h * 128; const bf16* HV = (const bf16*)(ws + WS_HV) + h * 128;
    const bf16* HGATE = (const bf16*)(ws + WS_HGATE) + h * 128; bf16* YHG = (bf16*)(ws + WS_YHG) + h * 128;
    LAS unsigned char* L = F.lds + RING_OFF;
    LAS unsigned char* QT = L; LAS unsigned char* KT = L + 17408; LAS unsigned char* KTT = L + 34816; LAS unsigned char* VT = L + 53248; LAS unsigned char* ST = L + 71680; LAS unsigned char* PP = L + 106496;
    LAS float* SEG = (LAS float*)(L + 115712); LAS float* ER = (LAS float*)(L + 117760); LAS float* EL = (LAS float*)(L + 118272); LAS float* OST = (LAS float*)(L + 17408);
    const int d = tid & 127, pq = tid >> 7;
    const int et = tid >> 3, evq = tid & 7;
    const int f144 = l31 * 144 + hh * 16, f272 = l31 * 272 + hh * 16;
    const int sst = wave == 2 ? 1 : 0, stt = wave == 0 ? 0 : 1, dt = wave & 3, vt0 = 2 * (wave >> 2), btt = wave & 1, bvt = wave >> 1;
    const LAS unsigned char* aK = KT + 32 * sst * 272 + f272; const LAS unsigned char* bQ = QT + 32 * stt * 272 + f272;
    LAS unsigned char* pst = PP + (32 * stt + l31) * 144 + (32 * sst + 4 * hh) * 2;
    const LAS unsigned char* aKTT = KTT + 32 * dt * 144 + f144; const LAS unsigned char* bV0 = VT + 32 * vt0 * 144 + f144;
    LAS unsigned char* sst_ = ST + (32 * vt0 + l31) * 272 + (32 * dt + 4 * hh) * 2;
    const LAS float* erp = ER + 32 * dt + 4 * hh; const LAS float* elp = EL + 32 * dt + 4 * hh;
    const LAS unsigned char* aP = PP + 32 * btt * 144 + f144; const LAS unsigned char* bVB = VT + 32 * bvt * 144 + f144;
    const LAS unsigned char* aQ = QT + 32 * btt * 272 + f272; const LAS unsigned char* bS = ST + 32 * bvt * 272 + f272;
    LAS float* ost = OST + (32 * btt + 4 * hh) * 132 + 32 * bvt + l31; const LAS float* oep = OST + et * 132 + 16 * evq;
    LAS unsigned char* tq = QT + 16 * pq * 272 + d * 2; LAS unsigned char* tk = KT + 16 * pq * 272 + d * 2; LAS unsigned char* tkt = KTT + d * 144 + pq * 32; LAS unsigned char* tv = VT + d * 144 + pq * 32;
    f32x16 S0, S1;
#pragma unroll
    for (int i = 0; i < 16; ++i) { S0[i] = 0.f; S1[i] = 0.f; }
    unsigned gr[16], qr[16], vr[16]; v4u gt0, gt1;
    float gn[16];
#pragma unroll
    for (int i = 0; i < 16; ++i) gn[i] = F.in[IN_HGNORM][h * 128 + 16 * evq + i];
#define HG_LOAD(c) do { const int ttb = 64 * (c) - 48 + 16 * pq; \
        _Pragma("unroll") for (int i = 0; i < 16; ++i) { const int tt = ttb + i; if (tt >= 0) { const size_t gi = rowof(b, tt) * HW + d; gr[i] = (unsigned)HG[gi]; qr[i] = (unsigned)HQ[gi]; vr[i] = (unsigned)HV[gi]; } else { gr[i] = 0u; qr[i] = 0u; vr[i] = 0u; } } \
        { const int tt = 64 * (c) - 48 + et; if (tt >= 0) { const GAS v4u* gp = (const GAS v4u*)(HGATE + rowof(b, tt) * HW + 16 * evq); gt0 = gp[0]; gt1 = gp[1]; } else { gt0 = (v4u){0u, 0u, 0u, 0u}; gt1 = gt0; } } } while (0)
    HG_LOAD(0);
    for (int c = 0; c < 33; ++c) {
        float bl[16], gq[16];
#pragma unroll
        for (int i = 0; i < 16; ++i) gq[i] = __builtin_bit_cast(float, gr[i] << 16);
        { float a = 0.f;
#pragma unroll
          for (int i = 0; i < 16; ++i) { a += gq[i]; bl[i] = a; } }
        SEG[pq * 128 + d] = bl[15];
        __syncthreads();
        { const float s0 = SEG[d], s1 = SEG[128 + d], s2 = SEG[256 + d], s3 = SEG[384 + d];
          const float off = pq == 0 ? 0.f : pq == 1 ? s0 : pq == 2 ? s0 + s1 : (s0 + s1) + s2, r = s0 + s1, blast = (s0 + s1) + (s2 + s3);
          unsigned kp[8], vp[8];
#pragma unroll
          for (int i = 0; i < 16; i += 2) {
              const float b0 = off + bl[i], b1 = off + bl[i + 1];
              const float q0 = __builtin_bit_cast(float, qr[i] << 16) * fexp(b0 - r), q1 = __builtin_bit_cast(float, qr[i + 1] << 16) * fexp(b1 - r);
              const float k0 = (1.f - fexp(gq[i])) * fexp(r - b0), k1 = (1.f - fexp(gq[i + 1])) * fexp(r - b1);
              const unsigned kk = pg8::cvt_pk_bf16(k0, k1), qq = pg8::cvt_pk_bf16(q0, q1);
              *(LAS unsigned short*)(tq + i * 272) = (unsigned short)qq; *(LAS unsigned short*)(tq + (i + 1) * 272) = (unsigned short)(qq >> 16);
              *(LAS unsigned short*)(tk + i * 272) = (unsigned short)kk; *(LAS unsigned short*)(tk + (i + 1) * 272) = (unsigned short)(kk >> 16);
              kp[i >> 1] = kk; vp[i >> 1] = vr[i] | (vr[i + 1] << 16); }
          *(LAS v4u*)(tkt) = (v4u){kp[0], kp[1], kp[2], kp[3]}; *(LAS v4u*)(tkt + 16) = (v4u){kp[4], kp[5], kp[6], kp[7]};
          *(LAS v4u*)(tv) = (v4u){vp[0], vp[1], vp[2], vp[3]}; *(LAS v4u*)(tv + 16) = (v4u){vp[4], vp[5], vp[6], vp[7]};
          if (pq == 0) { ER[d] = fexp(r); EL[d] = fexp(blast - r); } }
        const v4u g0 = gt0, g1 = gt1;
        __syncthreads();
        if (c + 1 < 33) HG_LOAD(c + 1);
        asm volatile("" ::: "memory");
        if (wave < 3) {
            f32x16 acc;
#pragma unroll
            for (int i = 0; i < 16; ++i) acc[i] = 0.f;
#pragma unroll
            for (int ks = 0; ks < 8; ++ks) acc = MFMA32(ldf(aK, 32 * ks), ldf(bQ, 32 * ks), acc);
            const int t = 32 * stt + l31;
#pragma unroll
            for (int g4 = 0; g4 < 4; ++g4) { const int s0 = 32 * sst + 8 * g4 + 4 * hh;
                const float x0 = (s0 + 0 <= t) ? acc[4 * g4 + 0] : 0.f, x1 = (s0 + 1 <= t) ? acc[4 * g4 + 1] : 0.f, x2 = (s0 + 2 <= t) ? acc[4 * g4 + 2] : 0.f, x3 = (s0 + 3 <= t) ? acc[4 * g4 + 3] : 0.f;
                *(LAS v2u*)(pst + 16 * g4) = (v2u){pg8::cvt_pk_bf16(x0, x1), pg8::cvt_pk_bf16(x2, x3)}; }
        }
        {
#pragma unroll
          for (int g4 = 0; g4 < 4; ++g4) { const f32x4 er = *(const LAS f32x4*)(erp + 8 * g4);
#pragma unroll
              for (int i = 0; i < 4; ++i) { S0[4 * g4 + i] *= er[i]; S1[4 * g4 + i] *= er[i]; }
              *(LAS v2u*)(sst_ + 16 * g4) = (v2u){pg8::cvt_pk_bf16(S0[4 * g4], S0[4 * g4 + 1]), pg8::cvt_pk_bf16(S0[4 * g4 + 2], S0[4 * g4 + 3])};
              *(LAS v2u*)(sst_ + 32 * 272 + 16 * g4) = (v2u){pg8::cvt_pk_bf16(S1[4 * g4], S1[4 * g4 + 1]), pg8::cvt_pk_bf16(S1[4 * g4 + 2], S1[4 * g4 + 3])}; }
#pragma unroll
          for (int ks = 0; ks < 4; ++ks) { const bf16x8 a = ldf(aKTT, 32 * ks); S0 = MFMA32(a, ldf(bV0, 32 * ks), S0); S1 = MFMA32(a, ldf(bV0, 32 * 144 + 32 * ks), S1); }
#pragma unroll
          for (int g4 = 0; g4 < 4; ++g4) { const f32x4 el = *(const LAS f32x4*)(elp + 8 * g4);
#pragma unroll
              for (int i = 0; i < 4; ++i) { S0[4 * g4 + i] *= el[i]; S1[4 * g4 + i] *= el[i]; } } }
        __syncthreads();
        { f32x16 acc;
#pragma unroll
          for (int i = 0; i < 16; ++i) acc[i] = 0.f;
#pragma unroll
          for (int ks = 0; ks < 4; ++ks) if (ks < 2 || btt == 1) acc = MFMA32(ldf(aP, 32 * ks), ldf(bVB, 32 * ks), acc);
#pragma unroll
          for (int ks = 0; ks < 8; ++ks) acc = MFMA32(ldf(aQ, 32 * ks), ldf(bS, 32 * ks), acc);
#pragma unroll
          for (int i = 0; i < 16; ++i) ost[((i & 3) + 8 * (i >> 2)) * 132] = acc[i]; }
        __syncthreads();
        { const int tt = 64 * c - 48 + et;
          f32x4 o[4]; float ss = 0.f;
#pragma unroll
          for (int j = 0; j < 4; ++j) { o[j] = *(const LAS f32x4*)(oep + 4 * j); ss += (o[j].x * o[j].x + o[j].y * o[j].y) + (o[j].z * o[j].z + o[j].w * o[j].w); }
          ss += __shfl_xor(ss, 1); ss += __shfl_xor(ss, 2); ss += __shfl_xor(ss, 4);
          const float rs = 1.0f / sqrtf(ss * (1.f / 128.f) + EPS);
          if (tt >= NMETA || (tt >= 0 && b == 0)) { const unsigned gw[8] = {g0.x, g0.y, g0.z, g0.w, g1.x, g1.y, g1.z, g1.w}; unsigned w[8];
#pragma unroll
              for (int j = 0; j < 4; ++j) { w[2 * j] = pk2(o[j].x * rs * gn[4 * j] * bflo(gw[2 * j]), o[j].y * rs * gn[4 * j + 1] * bfhi(gw[2 * j])); w[2 * j + 1] = pk2(o[j].z * rs * gn[4 * j + 2] * bflo(gw[2 * j + 1]), o[j].w * rs * gn[4 * j + 3] * bfhi(gw[2 * j + 1])); }
              GAS v4u* yp = (GAS v4u*)(YHG + rowof(b, tt) * HW + 16 * evq); yp[0] = (v4u){w[0], w[1], w[2], w[3]}; yp[1] = (v4u){w[4], w[5], w[6], w[7]}; } }
        __syncthreads();
    }
#undef HG_LOAD
}


#define DPP_F(old, v, ctrl, rmask) __builtin_bit_cast(float, __builtin_amdgcn_update_dpp(__builtin_bit_cast(int, (float)(old)), __builtin_bit_cast(int, (float)(v)), (ctrl), (rmask), 0xf, false))
__device__ __forceinline__ float wave_scan_add(float v) {
    v += DPP_F(0.f, v, 0x111, 0xf); v += DPP_F(0.f, v, 0x112, 0xf); v += DPP_F(0.f, v, 0x114, 0xf); v += DPP_F(0.f, v, 0x118, 0xf);
    v += DPP_F(0.f, v, 0x142, 0xa); v += DPP_F(0.f, v, 0x143, 0xc); return v;
}
__device__ __forceinline__ float wave_scan_max(float v) {
    const float ni = -INFINITY;
    v = fmaxf(v, DPP_F(ni, v, 0x111, 0xf)); v = fmaxf(v, DPP_F(ni, v, 0x112, 0xf)); v = fmaxf(v, DPP_F(ni, v, 0x114, 0xf)); v = fmaxf(v, DPP_F(ni, v, 0x118, 0xf));
    v = fmaxf(v, DPP_F(ni, v, 0x142, 0xa)); v = fmaxf(v, DPP_F(ni, v, 0x143, 0xc)); return v;
}
__device__ __forceinline__ void p3_mlstm_mfma(Frame& F, int bh) {
    unsigned char* ws = F.ws; const int b = bh >> 2, h = bh & 3, tid = F.tid, lane = F.lane, wave = F.wave, hh = lane >> 5, l31 = lane & 31;
    const bf16* MMg = (const bf16*)(ws + WS_MM) + h * 128; const bf16* MOg = (const bf16*)(ws + WS_MO) + h * 128; const float* LI = (const float*)(ws + WS_LI) + h; const float* LF = (const float*)(ws + WS_LF) + h;
    bf16* YML = (bf16*)(ws + WS_YML) + h * 128;
    LAS unsigned char* L = F.lds + RING_OFF;
    LAS unsigned char* CT = L; LAS unsigned char* MT = L + 17408; LAS unsigned char* KM = L + 34816; LAS unsigned char* KW = L + 44032; LAS unsigned char* QM = L + 53248; LAS unsigned char* QW = L + 62464;
    LAS unsigned char* VT = L + 71680; LAS unsigned char* SV = L + 90112; LAS unsigned char* PP = L + 108544; LAS float* OST = (LAS float*)(L + 17408);
    LAS float* SM = (LAS float*)(L + 117760);
    LAS float* U = SM; LAS float* MX = SM + 64; LAS float* BB = SM + 128; LAS float* WSs = SM + 192; LAS float* WI = SM + 256; LAS float* DENP = SM + 320  ; LAS float* NN = SM + 416; LAS float* DENI = SM + 480; LAS float* SC = SM + 544  ; LAS float* GNS = SM + 560  ;
    const int ch = tid & 127, pq = tid >> 7, et = tid >> 3, evq = tid & 7;
    const int f144 = l31 * 144 + hh * 16, f272 = l31 * 272 + hh * 16;
    const int sst = wave == 2 ? 1 : 0, stt = wave == 0 ? 0 : 1, dkt = wave & 1, svt = wave >> 1;
    const LAS unsigned char* cfp = (wave < 4 ? CT : MT) + f272;
    LAS unsigned char* qst = QM + l31 * 144 + (32 * (wave & 1) + 4 * hh) * 2; LAS unsigned char* qwst = QW + l31 * 144 + (32 * (wave & 1) + 4 * hh) * 2;
    const int kdk = 32 * (wave & 1) + l31;
    LAS unsigned char* kmst = KM + 4 * hh * 144 + kdk * 2; LAS unsigned char* kwst = KW + kdk * 144 + 4 * hh * 2; const LAS float* wsp = WSs + 4 * hh;
    LAS unsigned char* vst = VT + (32 * (wave & 3) + l31) * 144 + 4 * hh * 2;
    const LAS unsigned char* aKM = KM + 32 * sst * 144 + f144; const LAS unsigned char* bQM = QM + 32 * stt * 144 + f144;
    LAS unsigned char* pst = PP + (32 * stt + l31) * 144 + (32 * sst + 4 * hh) * 2; const LAS float* up = U + 32 * sst + 4 * hh;
    LAS unsigned char* svst = SV + (32 * svt + l31) * 144 + (32 * dkt + 4 * hh) * 2;
    const LAS unsigned char* aKW = KW + 32 * dkt * 144 + f144; const LAS unsigned char* bVT = VT + 32 * svt * 144 + f144;
    const LAS unsigned char* aP = PP + 32 * dkt * 144 + f144; const LAS unsigned char* aQW = QW + 32 * dkt * 144 + f144; const LAS unsigned char* bSV = SV + 32 * svt * 144 + f144;
    LAS float* ost = OST + (32 * dkt + 4 * hh) * 132 + 32 * svt + l31; const LAS float* oep = OST + et * 132 + 16 * evq;
    LAS unsigned char* tc = CT + 16 * pq * 272 + ch * 2; LAS unsigned char* tm = MT + 16 * pq * 272 + ch * 2;
    bf16x8 wf[8];
    { const float* W = wave < 2 ? F.in[IN_WQ] + (size_t)h * 128 * 64 + 32 * wave + l31 : wave < 4 ? F.in[IN_WK] + (size_t)h * 128 * 64 + 32 * (wave - 2) + l31 : F.in[IN_WV] + (size_t)h * 128 * 128 + 32 * (wave - 4) + l31;
      const int ld = wave < 4 ? 64 : 128; const float sc = wave < 2 ? 0.125f : 1.f;
#pragma unroll
      for (int ks = 0; ks < 8; ++ks) { unsigned p[4];
#pragma unroll
          for (int j = 0; j < 4; ++j) p[j] = pk2(W[(size_t)(16 * ks + 8 * hh + 2 * j) * ld] * sc, W[(size_t)(16 * ks + 8 * hh + 2 * j + 1) * ld] * sc);
          wf[ks] = __builtin_bit_cast(bf16x8, (v4u){p[0], p[1], p[2], p[3]}); } }
    float cw[4]; const float cb = F.in[IN_CONVB][h * 128 + ch];
#pragma unroll
    for (int j = 0; j < 4; ++j) cw[j] = F.in[IN_CONVW][j * HW + h * 128 + ch];
    if (tid < 128) GNS[tid] = F.in[IN_MLNORM][h * 128 + tid]; else if (tid < 256) GNS[tid] = F.in[IN_MLSKIP][h * 128 + tid - 128];
    f32x16 S;
#pragma unroll
    for (int i = 0; i < 16; ++i) S[i] = 0.f;
    float mcar = 0.f, nreg = 0.f;
    unsigned mr[19]; v4u gt0, gt1; float pli = 0.f, plf = 0.f;
#define ML_LOAD(c) do { const int ttb = 64 * (c) - 48 + 16 * pq - 3; \
        _Pragma("unroll") for (int i = 0; i < 19; ++i) { const int tt = ttb + i; mr[i] = tt >= 0 ? (unsigned)MMg[rowof(b, tt) * HW + ch] : 0u; } \
        { const int tt = 64 * (c) - 48 + et; if (tt >= 0) { const GAS v4u* gp = (const GAS v4u*)(MOg + rowof(b, tt) * HW + 16 * evq); gt0 = gp[0]; gt1 = gp[1]; } else { gt0 = (v4u){0u, 0u, 0u, 0u}; gt1 = gt0; } } \
        if (wave == 0) { const int tt = 64 * (c) - 48 + lane; if (tt >= 0) { pli = LI[rowof(b, tt) * 4]; plf = LF[rowof(b, tt) * 4]; } else { pli = -1e30f; plf = 0.f; } } } while (0)
    ML_LOAD(0);
    for (int c = 0; c < 33; ++c) {
#pragma unroll
        for (int i = 0; i < 16; ++i) { const float a = cb + (cw[0] * __builtin_bit_cast(float, mr[i] << 16) + cw[1] * __builtin_bit_cast(float, mr[i + 1] << 16)) + (cw[2] * __builtin_bit_cast(float, mr[i + 2] << 16) + cw[3] * __builtin_bit_cast(float, mr[i + 3] << 16));
            *(LAS unsigned short*)(tc + i * 272) = (unsigned short)f2bf(fsilu(a)); *(LAS unsigned short*)(tm + i * 272) = (unsigned short)mr[i + 3]; }
        if (wave == 0) {
            const float bs = wave_scan_add(plf);
            const float u = pli - bs; const float pm = wave_scan_max(u);
            const float M = fmaxf(mcar, pm), M63 = __shfl(M, 63), b63 = __shfl(bs, 63);
            U[lane] = u; MX[lane] = M; BB[lane] = bs; WSs[lane] = fexp(u - M63); WI[lane] = fexp(mcar - M);
            if (lane == 0) { SC[0] = b63; SC[1] = M63; }
        }
        __syncthreads();
        { f32x16 a0, a1;
#pragma unroll
          for (int i = 0; i < 16; ++i) { a0[i] = 0.f; a1[i] = 0.f; }
          if (wave < 2) {
#pragma unroll
              for (int ks = 0; ks < 8; ++ks) { a0 = MFMA32(wf[ks], ldf(cfp, 32 * ks), a0); a1 = MFMA32(wf[ks], ldf(cfp, 32 * 272 + 32 * ks), a1); }
              const float wi0 = WI[l31], wi1 = WI[32 + l31];
#pragma unroll
              for (int g4 = 0; g4 < 4; ++g4) {
                  *(LAS v2u*)(qst + 16 * g4) = (v2u){pg8::cvt_pk_bf16(a0[4 * g4], a0[4 * g4 + 1]), pg8::cvt_pk_bf16(a0[4 * g4 + 2], a0[4 * g4 + 3])};
                  *(LAS v2u*)(qst + 32 * 144 + 16 * g4) = (v2u){pg8::cvt_pk_bf16(a1[4 * g4], a1[4 * g4 + 1]), pg8::cvt_pk_bf16(a1[4 * g4 + 2], a1[4 * g4 + 3])};
                  *(LAS v2u*)(qwst + 16 * g4) = (v2u){pg8::cvt_pk_bf16(a0[4 * g4] * wi0, a0[4 * g4 + 1] * wi0), pg8::cvt_pk_bf16(a0[4 * g4 + 2] * wi0, a0[4 * g4 + 3] * wi0)};
                  *(LAS v2u*)(qwst + 32 * 144 + 16 * g4) = (v2u){pg8::cvt_pk_bf16(a1[4 * g4] * wi1, a1[4 * g4 + 1] * wi1), pg8::cvt_pk_bf16(a1[4 * g4 + 2] * wi1, a1[4 * g4 + 3] * wi1)}; }
          } else {
#pragma unroll
              for (int ks = 0; ks < 8; ++ks) { a0 = MFMA32(ldf(cfp, 32 * ks), wf[ks], a0); a1 = MFMA32(ldf(cfp, 32 * 272 + 32 * ks), wf[ks], a1); }
              if (wave < 4) {
                  float nsum = 0.f;
#pragma unroll
                  for (int g4 = 0; g4 < 4; ++g4) { const f32x4 w0 = *(const LAS f32x4*)(wsp + 8 * g4), w1 = *(const LAS f32x4*)(wsp + 32 + 8 * g4);
#pragma unroll
                      for (int i = 0; i < 4; ++i) { *(LAS unsigned short*)(kmst + (8 * g4 + i) * 144) = (unsigned short)f2bf(a0[4 * g4 + i]); *(LAS unsigned short*)(kmst + (32 + 8 * g4 + i) * 144) = (unsigned short)f2bf(a1[4 * g4 + i]); }
                      const float x0 = a0[4 * g4] * w0[0], x1 = a0[4 * g4 + 1] * w0[1], x2 = a0[4 * g4 + 2] * w0[2], x3 = a0[4 * g4 + 3] * w0[3];
                      const float y0 = a1[4 * g4] * w1[0], y1 = a1[4 * g4 + 1] * w1[1], y2 = a1[4 * g4 + 2] * w1[2], y3 = a1[4 * g4 + 3] * w1[3];
                      nsum += ((x0 + x1) + (x2 + x3)) + ((y0 + y1) + (y2 + y3));
                      *(LAS v2u*)(kwst + 16 * g4) = (v2u){pg8::cvt_pk_bf16(x0, x1), pg8::cvt_pk_bf16(x2, x3)};
                      *(LAS v2u*)(kwst + 64 + 16 * g4) = (v2u){pg8::cvt_pk_bf16(y0, y1), pg8::cvt_pk_bf16(y2, y3)}; }
                  nsum += __shfl_xor(nsum, 32);
                  if (hh == 0) NN[kdk] = nreg;
                  nreg = fexp(mcar - SC[1]) * nreg + nsum;
              } else {
#pragma unroll
                  for (int g4 = 0; g4 < 4; ++g4) {
                      *(LAS v2u*)(vst + 16 * g4) = (v2u){pg8::cvt_pk_bf16(a0[4 * g4], a0[4 * g4 + 1]), pg8::cvt_pk_bf16(a0[4 * g4 + 2], a0[4 * g4 + 3])};
                      *(LAS v2u*)(vst + 64 + 16 * g4) = (v2u){pg8::cvt_pk_bf16(a1[4 * g4], a1[4 * g4 + 1]), pg8::cvt_pk_bf16(a1[4 * g4 + 2], a1[4 * g4 + 3])}; }
              }
          } }
        __syncthreads();
        const v4u g0 = gt0, g1 = gt1;
        if (c + 1 < 33) ML_LOAD(c + 1);
        asm volatile("" ::: "memory");
        if (wave < 3) {
            f32x16 acc;
#pragma unroll
            for (int i = 0; i < 16; ++i) acc[i] = 0.f;
#pragma unroll
            for (int ks = 0; ks < 4; ++ks) acc = MFMA32(ldf(aKM, 32 * ks), ldf(bQM, 32 * ks), acc);
            const int t = 32 * stt + l31; const float mt = MX[t]; float dsum = 0.f;
#pragma unroll
            for (int g4 = 0; g4 < 4; ++g4) { const int s0 = 32 * sst + 8 * g4 + 4 * hh; const f32x4 us = *(const LAS f32x4*)(up + 8 * g4);
                const float x0 = (s0 + 0 <= t) ? acc[4 * g4 + 0] * fexp(us[0] - mt) : 0.f, x1 = (s0 + 1 <= t) ? acc[4 * g4 + 1] * fexp(us[1] - mt) : 0.f;
                const float x2 = (s0 + 2 <= t) ? acc[4 * g4 + 2] * fexp(us[2] - mt) : 0.f, x3 = (s0 + 3 <= t) ? acc[4 * g4 + 3] * fexp(us[3] - mt) : 0.f;
                dsum += (x0 + x1) + (x2 + x3);
                *(LAS v2u*)(pst + 16 * g4) = (v2u){pg8::cvt_pk_bf16(x0, x1), pg8::cvt_pk_bf16(x2, x3)}; }
            dsum += __shfl_xor(dsum, 32);
            if (hh == 0) DENP[wave * 32 + l31] = dsum;
        } else if (wave == 3) {
            float a = 0.f;
#pragma unroll 2
            for (int j = 0; j < 8; ++j) { const v4u q = *(const LAS v4u*)(QW + lane * 144 + 16 * j); const f32x4 n0 = *(const LAS f32x4*)(NN + 8 * j), n1 = *(const LAS f32x4*)(NN + 8 * j + 4);
                a += (bflo(q.x) * n0[0] + bfhi(q.x) * n0[1]) + (bflo(q.y) * n0[2] + bfhi(q.y) * n0[3]) + (bflo(q.z) * n1[0] + bfhi(q.z) * n1[1]) + (bflo(q.w) * n1[2] + bfhi(q.w) * n1[3]); }
            DENI[lane] = a;
        }
        { const float wp = fexp(mcar - SC[1]);
#pragma unroll
          for (int g4 = 0; g4 < 4; ++g4) {
              *(LAS v2u*)(svst + 16 * g4) = (v2u){pg8::cvt_pk_bf16(S[4 * g4], S[4 * g4 + 1]), pg8::cvt_pk_bf16(S[4 * g4 + 2], S[4 * g4 + 3])};
#pragma unroll
              for (int i = 0; i < 4; ++i) S[4 * g4 + i] *= wp; }
#pragma unroll
          for (int ks = 0; ks < 4; ++ks) S = MFMA32(ldf(aKW, 32 * ks), ldf(bVT, 32 * ks), S); }
        __syncthreads();
        { f32x16 acc;
#pragma unroll
          for (int i = 0; i < 16; ++i) acc[i] = 0.f;
#pragma unroll
          for (int ks = 0; ks < 4; ++ks) if (ks < 2 || dkt == 1) acc = MFMA32(ldf(aP, 32 * ks), ldf(bVT, 32 * ks), acc);
#pragma unroll
          for (int ks = 0; ks < 4; ++ks) acc = MFMA32(ldf(aQW, 32 * ks), ldf(bSV, 32 * ks), acc);
#pragma unroll
          for (int i = 0; i < 16; ++i) ost[((i & 3) + 8 * (i >> 2)) * 132] = acc[i]; }
        __syncthreads();
        { const int tt = 64 * c - 48 + et;
          const float den = (et < 32 ? DENP[et] : DENP[et] + DENP[32 + et]) + DENI[et];
          const float inv = 1.0f / fmaxf(fabsf(den), fexp(-(BB[et] + MX[et])));
          f32x4 o[4]; float ss = 0.f;
#pragma unroll
          for (int j = 0; j < 4; ++j) { o[j] = *(const LAS f32x4*)(oep + 4 * j) * inv; ss += (o[j].x * o[j].x + o[j].y * o[j].y) + (o[j].z * o[j].z + o[j].w * o[j].w); }
          ss += __shfl_xor(ss, 1); ss += __shfl_xor(ss, 2); ss += __shfl_xor(ss, 4);
          const float rs = 1.0f / sqrtf(ss * (1.f / 128.f) + EPS);
          if (tt >= NMETA || (tt >= 0 && b == 0)) { const unsigned gw[8] = {g0.x, g0.y, g0.z, g0.w, g1.x, g1.y, g1.z, g1.w}; unsigned w[8];
              const v4u c0 = *(const LAS v4u*)(CT + et * 272 + 32 * evq), c1 = *(const LAS v4u*)(CT + et * 272 + 32 * evq + 16); const unsigned cwd[8] = {c0.x, c0.y, c0.z, c0.w, c1.x, c1.y, c1.z, c1.w};
#pragma unroll
              for (int j = 0; j < 4; ++j) { const f32x4 gn = *(const LAS f32x4*)(GNS + 16 * evq + 4 * j), sk = *(const LAS f32x4*)(GNS + 128 + 16 * evq + 4 * j);
                  w[2 * j] = pk2((o[j].x * rs * gn[0] + sk[0] * bflo(cwd[2 * j])) * bflo(gw[2 * j]), (o[j].y * rs * gn[1] + sk[1] * bfhi(cwd[2 * j])) * bfhi(gw[2 * j]));
                  w[2 * j + 1] = pk2((o[j].z * rs * gn[2] + sk[2] * bflo(cwd[2 * j + 1])) * bflo(gw[2 * j + 1]), (o[j].w * rs * gn[3] + sk[3] * bfhi(cwd[2 * j + 1])) * bfhi(gw[2 * j + 1])); }
              GAS v4u* yp = (GAS v4u*)(YML + rowof(b, tt) * HW + 16 * evq); yp[0] = (v4u){w[0], w[1], w[2], w[3]}; yp[1] = (v4u){w[4], w[5], w[6], w[7]}; }
          mcar = SC[0] + SC[1]; }
        __syncthreads();
    }
#undef ML_LOAD
}

typedef float f32x4v __attribute__((ext_vector_type(4)));
#define MFMA16F(a, b, c) __builtin_amdgcn_mfma_f32_16x16x4f32(a, b, c, 0, 0, 0)
constexpr int RW_LD = 516;
__device__ __forceinline__ void router_topk16(LAS float* LGw, int V, float rsv, int resrow, int lane, LAS int* hist, LAS int* res, int* TOPE, float* TOPW, float* RS) {
    if (lane < 16) {
        int se[4]; float sv[4];
#pragma unroll
        for (int k = 0; k < 4; ++k) { float best = -INFINITY; int bi = 0;
            for (int e = 0; e < 32; ++e) { const float v = LGw[lane * 33 + e]; if (v > best) { best = v; bi = e; } }
            se[k] = bi; sv[k] = best; LGw[lane * 33 + bi] = -INFINITY; }
        const float e1 = __expf(sv[1] - sv[0]), e2 = __expf(sv[2] - sv[0]), e3 = __expf(sv[3] - sv[0]), inv = 1.0f / (1.f + e1 + e2 + e3);
        const float w4[4] = {inv, e1 * inv, e2 * inv, e3 * inv};
#pragma unroll
        for (int k = 0; k < 4; ++k) { const int lp = __hip_atomic_fetch_add(hist + se[k], 1, __ATOMIC_RELAXED, __HIP_MEMORY_SCOPE_WORKGROUP);
            TOPE[(size_t)V * 4 + k] = se[k]; TOPW[(size_t)V * 4 + k] = w4[k]; res[(resrow + lane) * 4 + k] = lp; }
        RS[V] = rsv;
    }
}
__device__ __forceinline__ void p6_router(Frame& F) {
    unsigned char* ws = F.ws;
    const bf16* H1 = (const bf16*)(ws + WS_H1); const float* RWT = (const float*)(ws + WS_RWT);
    int* TOPE = (int*)(ws + WS_TOPE); int* TOPP = (int*)(ws + WS_TOPP); float* TOPW = (float*)(ws + WS_TOPW); float* RS = (float*)(ws + WS_RS);
    int* ETOK = (int*)(ws + WS_ETOK); float* ERS = (float*)(ws + WS_ERS); float* EW = (float*)(ws + WS_EW);
    LAS float* rw = (LAS float*)(F.lds + RING_OFF);
    LAS float* LG = (LAS float*)(F.lds + RING_OFF + 66048) + F.wave * 528;
    LAS int* hist = (LAS int*)(F.lds + RING_OFF + 66048 + 8 * 2112);
    LAS int* res = hist + 64;
    LAS float* XP = (LAS float*)(res + 144 * 4);
    LAS float* XQ = XP + 8 * 528;
    const int lane = F.lane, wave = F.wave, i16 = lane & 15, kk = lane >> 4;
    constexpr int RPW = NTOK / 256;
    const bool has_meta = (F.vcu == 0);
    const int Vbase = F.vcu * RPW, Vt = Vbase + 16 * wave;
    if (F.tid < 64) hist[F.tid] = 0;
    f32x4v acc0 = {0.f, 0.f, 0.f, 0.f}, acc1 = {0.f, 0.f, 0.f, 0.f}, acx0 = {0.f, 0.f, 0.f, 0.f}, acx1 = {0.f, 0.f, 0.f, 0.f}; float ssq = 0.f, xss = 0.f;
    const bf16* arow = H1 + (size_t)(Vt + i16) * D + 8 * kk;
    const bf16* xrow = H1 + (size_t)(NTOK + i16) * D + 8 * kk;
    v4u a0[4], a1[4];
#define RT_MMA(A, SB, C0, C1, SS) do { const LAS float* b0p = rw + i16 * RW_LD + 8 * kk + 128 * (SB); const LAS float* b1p = rw + (16 + i16) * RW_LD + 8 * kk + 128 * (SB); \
        _Pragma("unroll") for (int s = 0; s < 4; ++s) { const v4u aw = A[s]; \
            _Pragma("unroll") for (int h = 0; h < 2; ++h) { const unsigned w0 = h ? aw.z : aw.x, w1 = h ? aw.w : aw.y; const f32x4 a = {bflo(w0), bfhi(w0), bflo(w1), bfhi(w1)}; \
            const f32x4 b0 = *(const LAS f32x4*)(b0p + 32 * s + 4 * h), b1 = *(const LAS f32x4*)(b1p + 32 * s + 4 * h); \
            SS += (a.x * a.x + a.y * a.y) + (a.z * a.z + a.w * a.w); \
            C0 = MFMA16F(a.x, b0.x, C0); C1 = MFMA16F(a.x, b1.x, C1); C0 = MFMA16F(a.y, b0.y, C0); C1 = MFMA16F(a.y, b1.y, C1); \
            C0 = MFMA16F(a.z, b0.z, C0); C1 = MFMA16F(a.z, b1.z, C1); C0 = MFMA16F(a.w, b0.w, C0); C1 = MFMA16F(a.w, b1.w, C1); } } } while (0)
#pragma unroll
    for (int s = 0; s < 4; ++s) a0[s] = *(const GAS v4u*)(arow + 32 * s);
#pragma unroll 1
    for (int it = 0; it < 4; ++it) {
        const int half = it >> 1, sb0 = (2 * it) & 3;
        if ((it & 1) == 0) {
            __syncthreads();
            { f32x4 stg[8];
#pragma unroll
              for (int q = 0; q < 8; ++q) { const int u = F.tid + q * NTHREADS, e = u >> 7, c = u & 127; stg[q] = *(const GAS f32x4*)(RWT + (size_t)e * D + 512 * half + 4 * c); }
#pragma unroll
              for (int q = 0; q < 8; ++q) { const int u = F.tid + q * NTHREADS, e = u >> 7, c = u & 127; *(LAS f32x4*)(rw + e * RW_LD + 4 * c) = stg[q]; } }
            __syncthreads();
        }
#pragma unroll
        for (int s = 0; s < 4; ++s) a1[s] = *(const GAS v4u*)(arow + 128 * (2 * it + 1) + 32 * s);
        RT_MMA(a0, sb0, acc0, acc1, ssq);
        if (it < 3) {
#pragma unroll
            for (int s = 0; s < 4; ++s) a0[s] = *(const GAS v4u*)(arow + 128 * (2 * it + 2) + 32 * s);
        }
        RT_MMA(a1, sb0 + 1, acc0, acc1, ssq);
        if (has_meta && (wave >> 1) == it) {
            v4u ax[4];
#pragma unroll
            for (int s = 0; s < 4; ++s) ax[s] = *(const GAS v4u*)(xrow + 128 * wave + 32 * s);
            RT_MMA(ax, wave & 3, acx0, acx1, xss);
        }
    }
#undef RT_MMA
    if (has_meta) {
        xss += __shfl_xor(xss, 16); xss += __shfl_xor(xss, 32);
#pragma unroll
        for (int r = 0; r < 4; ++r) { XP[wave * 528 + (4 * kk + r) * 33 + i16] = acx0[r]; XP[wave * 528 + (4 * kk + r) * 33 + 16 + i16] = acx1[r]; }
        if (kk == 0) XQ[wave * 16 + i16] = xss;
    }
    ssq += __shfl_xor(ssq, 16); ssq += __shfl_xor(ssq, 32);
    const float rsrow = 1.0f / sqrtf(ssq * (1.f / D) + EPS);
    const float rb0 = F.in[IN_RB][i16], rb1 = F.in[IN_RB][16 + i16];
#pragma unroll
    for (int r = 0; r < 4; ++r) { const float rsr = __shfl(rsrow, 4 * kk + r); LG[(4 * kk + r) * 33 + i16] = acc0[r] * rsr + rb0; LG[(4 * kk + r) * 33 + 16 + i16] = acc1[r] * rsr + rb1; }
    LDS_WAIT(); asm volatile("" ::: "memory");
    router_topk16(LG, Vt + lane, rsrow, 16 * wave, lane, hist, res, TOPE, TOPW, RS);
    __syncthreads();
    if (has_meta && wave == 7) {
        float q = 0.f;
#pragma unroll
        for (int w = 0; w < 8; ++w) q += XQ[w * 16 + i16];
        const float rsm = 1.0f / sqrtf(q * (1.f / D) + EPS);
#pragma unroll
        for (int r = 0; r < 4; ++r) { float v0 = 0.f, v1 = 0.f;
#pragma unroll
            for (int w = 0; w < 8; ++w) { v0 += XP[w * 528 + (4 * kk + r) * 33 + i16]; v1 += XP[w * 528 + (4 * kk + r) * 33 + 16 + i16]; }
            const float rsr = __shfl(rsm, 4 * kk + r); LG[(4 * kk + r) * 33 + i16] = v0 * rsr + rb0; LG[(4 * kk + r) * 33 + 16 + i16] = v1 * rsr + rb1; }
        LDS_WAIT(); asm volatile("" ::: "memory");
        router_topk16(LG, NTOK + lane, rsm, 128, lane, hist, res, TOPE, TOPW, RS);
    }
    __syncthreads();
    if (F.tid < NE) hist[32 + F.tid] = (int)__hip_atomic_fetch_add(F.ctl + CW_CNT + 64 * F.tid, (unsigned)hist[F.tid], RLX_AGENT);
    __syncthreads();
    const int nrows = has_meta ? RPW + 16 : RPW;
    for (int u = F.tid; u < nrows * 4; u += NTHREADS) { const int rr = u >> 2, V = rr < RPW ? Vbase + rr : NTOK + (rr - RPW); const size_t gi = (size_t)V * 4 + (u & 3); const int e = TOPE[gi], pos = hist[32 + e] + res[u];
        TOPP[gi] = pos; ETOK[(size_t)e * NV + pos] = V; ERS[(size_t)e * NV + pos] = RS[V]; EW[(size_t)e * NV + pos] = TOPW[gi]; }
}

__device__ __forceinline__ void build_tables(Frame& F) {
    LAS int* pst = (LAS int*)(F.lds + PST_OFF); LAS unsigned char* texp = (LAS unsigned char*)(F.lds + TEXP_OFF);
    __syncthreads();
    if (F.tid < 64) {
        const int e = F.lane & 31; const int c = (int)__hip_atomic_load(F.ctl + CW_CNT + 64 * e, RLX_AGENT); const int nt = (c + 255) >> 8;
        int incl = nt;
#pragma unroll
        for (int o = 1; o < 32; o <<= 1) { const int t = __shfl_up(incl, o); if ((F.lane & 31) >= o) incl += t; }
        const int start = incl - nt;
        if (F.lane < 32) { pst[e] = start * 256; pst[33 + e] = c; for (int j = 0; j < nt && start + j < MAXTILES; ++j) texp[start + j] = (unsigned char)e; if (e == 31) pst[32] = incl < MAXTILES ? incl : MAXTILES; }
    }
    __syncthreads();
}
typedef float f32v2_t __attribute__((ext_vector_type(2)));
__device__ __forceinline__ void p10_combine(Frame& F) {
    unsigned char* ws = F.ws; build_tables(F);
    const LAS int* pst = (const LAS int*)(F.lds + PST_OFF);
    const bf16* H1 = (const bf16*)(ws + WS_H1); const unsigned char* YB = (const unsigned char*)(ws + WS_YB);
    const int* TOPE = (const int*)(ws + WS_TOPE); const int* TOPP = (const int*)(ws + WS_TOPP);
    const int gw = F.vcu * NWAVES + F.wave, NGW = F.G * NWAVES;
    const GAS f32x4* nf = (const GAS f32x4*)F.in[IN_NFIN] + F.lane; f32x4 nfv[4];
#pragma unroll
    for (int j = 0; j < 4; ++j) nfv[j] = nf[64 * j];
    int sl[2][4];
#define CMB_SLOTS(Rbase) do { _Pragma("unroll") for (int q = 0; q < 2; ++q) { const int R = (Rbase) + q * NGW; if (R < BATCH * SEQ) { const size_t V = (size_t)R; \
        _Pragma("unroll") for (int k = 0; k < 4; ++k) sl[q][k] = pst[TOPE[V * 4 + k]] + TOPP[V * 4 + k]; } else { _Pragma("unroll") for (int k = 0; k < 4; ++k) sl[q][k] = 0; } } } while (0)
    CMB_SLOTS(gw);
    for (int R0 = gw; R0 < BATCH * SEQ; R0 += 2 * NGW) {
        f32x4 v[2][4]; unsigned y[2][4][4];
#pragma unroll
        for (int q = 0; q < 2; ++q) { const int R = (R0 + q * NGW < BATCH * SEQ) ? R0 + q * NGW : R0; const size_t V = (size_t)R;
            const GAS v2u* hr = (const GAS v2u*)(H1 + V * D) + F.lane;
#pragma unroll
            for (int j = 0; j < 4; ++j) { const v2u hw = hr[64 * j]; v[q][j] = (f32x4){bflo(hw.x), bfhi(hw.x), bflo(hw.y), bfhi(hw.y)}; }
#pragma unroll
            for (int k = 0; k < 4; ++k) { const GAS unsigned* yr = (const GAS unsigned*)(YB + (size_t)sl[q][k] * D) + F.lane;
#pragma unroll
                for (int j = 0; j < 4; ++j) y[q][k][j] = yr[64 * j]; } }
        CMB_SLOTS(R0 + 2 * NGW);
#pragma unroll
        for (int q = 0; q < 2; ++q) { const int R = R0 + q * NGW; if (R >= BATCH * SEQ) continue;
#pragma unroll
            for (int k = 0; k < 4; ++k)
#pragma unroll
                for (int j = 0; j < 4; ++j) { const unsigned w = y[q][k][j]; const f32v2_t lo = __builtin_amdgcn_cvt_pk_f32_fp8(w, false), hi = __builtin_amdgcn_cvt_pk_f32_fp8(w, true);
                    v[q][j].x += lo[0] * 0.0625f; v[q][j].y += lo[1] * 0.0625f; v[q][j].z += hi[0] * 0.0625f; v[q][j].w += hi[1] * 0.0625f; }
            float s = 0.f;
#pragma unroll
            for (int j = 0; j < 4; ++j) s += (v[q][j].x * v[q][j].x + v[q][j].y * v[q][j].y) + (v[q][j].z * v[q][j].z + v[q][j].w * v[q][j].w);
            const float rs = 1.0f / sqrtf(wave_sum(s) * (1.f / D) + EPS);
            GAS f32x4* orow = (GAS f32x4*)(F.out + (size_t)R * D) + F.lane;
#pragma unroll
            for (int j = 0; j < 4; ++j) orow[64 * j] = v[q][j] * rs * nfv[j]; }
    }
#undef CMB_SLOTS
}

__device__ __forceinline__ int meta_row(int lane) { return ((lane >> 5) & 1) * 8 + ((lane >> 4) & 1) * 4 + ((lane >> 3) & 1) * 2 + ((lane >> 2) & 1); }
template <int KPL> __device__ __forceinline__ float meta_col(const LAS unsigned char* A, const bf16* wrow, int lane) {
    constexpr int K = 64 * KPL; float w[KPL];
#pragma unroll
    for (int j = 0; j < KPL / 8; ++j) { const v4u x = *(const GAS v4u*)(wrow + lane * KPL + 8 * j);
        w[8 * j] = bflo(x.x); w[8 * j + 1] = bfhi(x.x); w[8 * j + 2] = bflo(x.y); w[8 * j + 3] = bfhi(x.y); w[8 * j + 4] = bflo(x.z); w[8 * j + 5] = bfhi(x.z); w[8 * j + 6] = bflo(x.w); w[8 * j + 7] = bfhi(x.w); }
    float p[16];
#pragma unroll
    for (int r = 0; r < 16; ++r) { float s = 0.f;
#pragma unroll
        for (int j = 0; j < KPL / 8; ++j) { const v4u a = *(const LAS v4u*)(A + (r * K + lane * KPL + 8 * j) * 2);
            s += (bflo(a.x) * w[8 * j] + bfhi(a.x) * w[8 * j + 1]) + (bflo(a.y) * w[8 * j + 2] + bfhi(a.y) * w[8 * j + 3]) + (bflo(a.z) * w[8 * j + 4] + bfhi(a.z) * w[8 * j + 5]) + (bflo(a.w) * w[8 * j + 6] + bfhi(a.w) * w[8 * j + 7]); }
        p[r] = s; if ((r & 3) == 3) asm volatile("" ::: "memory"); }
    const bool b32 = lane & 32, b16 = lane & 16, b8 = lane & 8, b4 = lane & 4;
    float q8[8], q4[4], q2[2];
#pragma unroll
    for (int i = 0; i < 8; ++i) { const float keep = b32 ? p[i + 8] : p[i], send = b32 ? p[i] : p[i + 8]; q8[i] = keep + __shfl_xor(send, 32); }
#pragma unroll
    for (int i = 0; i < 4; ++i) { const float keep = b16 ? q8[i + 4] : q8[i], send = b16 ? q8[i] : q8[i + 4]; q4[i] = keep + __shfl_xor(send, 16); }
#pragma unroll
    for (int i = 0; i < 2; ++i) { const float keep = b8 ? q4[i + 2] : q4[i], send = b8 ? q4[i] : q4[i + 2]; q2[i] = keep + __shfl_xor(send, 8); }
    float v = (b4 ? q2[1] : q2[0]) + __shfl_xor(b4 ? q2[0] : q2[1], 4);
    v += __shfl_xor(v, 2); v += __shfl_xor(v, 1);
    return v;
}
__device__ __forceinline__ void meta_stage(Frame& F, LAS unsigned char* dst, const bf16* src, int K) {
    v4u t[4]; const int n = 16 * K / 8;
#pragma unroll
    for (int q = 0; q < 4; ++q) { const int u = F.tid + q * NTHREADS; if (u < n) t[q] = *(const GAS v4u*)(src + (size_t)u * 8); }
#pragma unroll
    for (int q = 0; q < 4; ++q) { const int u = F.tid + q * NTHREADS; if (u < n) *(LAS v4u*)(dst + u * 16) = t[q]; }
}
__device__ __forceinline__ void meta_proj(Frame& F) {
    unsigned char* ws = F.ws; const bf16* WIN = (const bf16*)(ws + WS_WIN); const float* lbl = F.in[IN_LBL];
    LAS unsigned char* A = F.lds + RING_OFF;
    __syncthreads(); meta_stage(F, A, (const bf16*)(ws + WS_XN0) + (size_t)NTOK * D, D); __syncthreads();
    for (int c = F.vcu * NWAVES + F.wave; c < NPROJ; c += F.G * NWAVES) {
        const float v = meta_col<16>(A, WIN + (size_t)c * D, F.lane);
        if ((F.lane & 3) == 0) { const size_t row = NTOK + meta_row(F.lane); const int kind = c < 3072 ? (c >> 9) : 6, cc = c & 511;
            if (kind == 0) ((bf16*)(ws + WS_HQ))[row * HW + cc] = (bf16)f2bf(fsilu(v));
            else if (kind == 1) { const float lb = fsigmoid(lbl[cc] - lbl[HW + cc]); ((bf16*)(ws + WS_HG))[row * HW + cc] = (bf16)f2bf(__logf(lb + (1.f - lb) * fsigmoid(v))); }
            else if (kind == 2) ((bf16*)(ws + WS_HV))[row * HW + cc] = (bf16)f2bf(v);
            else if (kind == 3) ((bf16*)(ws + WS_HGATE))[row * HW + cc] = (bf16)f2bf(fsilu(v));
            else if (kind == 4) ((bf16*)(ws + WS_MM))[row * HW + cc] = (bf16)f2bf(v);
            else if (kind == 5) ((bf16*)(ws + WS_MO))[row * HW + cc] = (bf16)f2bf(fsigmoid(v));
            else (ws + WS_GATES)[row * 2048 + pg8::gate_pos(c - 3072)] = (unsigned char)(__builtin_bit_cast(unsigned, __builtin_fmaf(fsigmoid(v), 255.f, 8388608.f)) & 0xffu); } }
}
__device__ __forceinline__ void meta_merged(Frame& F) {
    unsigned char* ws = F.ws; const unsigned char* GATES = ws + WS_GATES;
    LAS unsigned char* A0 = F.lds + RING_OFF; LAS unsigned char* A1 = A0 + 16 * HW * 2;
    __syncthreads(); meta_stage(F, A0, (const bf16*)(ws + WS_YHG) + (size_t)NTOK * HW, HW); meta_stage(F, A1, (const bf16*)(ws + WS_YML) + (size_t)NTOK * HW, HW); __syncthreads();
    for (int c = F.vcu * NWAVES + F.wave; c < D; c += F.G * NWAVES) {
        const float vh = meta_col<8>(A0, (const bf16*)(ws + WS_WBH) + (size_t)c * HW, F.lane), vm = meta_col<8>(A1, (const bf16*)(ws + WS_WBM) + (size_t)c * HW, F.lane);
        if ((F.lane & 3) == 0) { const size_t row = NTOK + meta_row(F.lane); ((bf16*)(ws + WS_MERGED))[row * D + c] = (bf16)f2bf((float)GATES[row * 2048 + pg8::gate_pos(c)] * vh + (float)GATES[row * 2048 + pg8::gate_pos(D + c)] * vm); } }
}
__device__ __forceinline__ void meta_wout(Frame& F) {
    unsigned char* ws = F.ws; LAS unsigned char* A = F.lds + RING_OFF;
    __syncthreads(); meta_stage(F, A, (const bf16*)(ws + WS_MERGED) + (size_t)NTOK * D, D); __syncthreads();
    for (int c = F.vcu * NWAVES + F.wave; c < D; c += F.G * NWAVES) {
        const float d = meta_col<16>(A, (const bf16*)(ws + WS_WOUT) + (size_t)c * D, F.lane);
        if ((F.lane & 3) == 0) { const int mr_ = meta_row(F.lane); const size_t row = NTOK + mr_; const float v = F.in[IN_META][(size_t)mr_ * D + c] + d;
            ((bf16*)(ws + WS_H1))[row * D + c] = (bf16)f2bf(v); ((unsigned char*)(ws + WS_H1B))[row * D + c] = (unsigned char)(__builtin_amdgcn_cvt_pk_fp8_f32(__builtin_amdgcn_fmed3f(v, -448.f, 448.f), 0.f, 0u, false) & 0xffu); } }
}

__device__ __forceinline__ void ph_proj(Frame& F, int variant) {
    unsigned char* ws = F.ws;
    pg8::Gemm g{(const pg8::bf16_t*)(ws + WS_XQ), (const pg8::bf16_t*)(ws + WS_WIN8), NTOK, NPROJ, D / 2}; pg8::StaticOrder S; S.init(NTOK, NPROJ, F.G, (int)blockIdx.x);
    pg8::EpiProjT<true> E{ws, F.in[IN_LBL], (const float*)(ws + WS_SROW), (const float*)(ws + WS_SCOL)};
#if MK_N_LAUNCHES != 1 && PROBE_VARIANT == 1
    if (variant) { pg8::EpiNull EN{(int*)(ws + WS_TOPE)}; pg8::gemm_phase<pg8::EpiNull, pg8::StaticOrder, true, true, false, true>(F.lds + RING_OFF, g, S, EN); return; }
#elif MK_N_LAUNCHES != 1 && PROBE_VARIANT == 2
    if (variant) { pg8::EpiProjT<true, true> EV{ws, F.in[IN_LBL], (const float*)(ws + WS_SROW), (const float*)(ws + WS_SCOL)}; pg8::gemm_phase<pg8::EpiProjT<true, true>, pg8::StaticOrder, true, true, false, true>(F.lds + RING_OFF, g, S, EV); return; }
#endif
    (void)variant;
    pg8::gemm_phase<pg8::EpiProjT<true>, pg8::StaticOrder, true, true, false, true>(F.lds + RING_OFF, g, S, E);
    meta_proj(F);
}
__device__ __forceinline__ void ph_scan(Frame& F) {
    const int sb = (int)blockIdx.x;
    if (sb < 64) p3_hgrn2_mfma(F, sb); else if (sb < 128) p3_mlstm_mfma(F, sb - 64);
#if !CONV_IN_P0
    else px_experts(F, sb - 128, F.G - 128);
#endif
}
__device__ __forceinline__ void ph_merged(Frame& F) {
    unsigned char* ws = F.ws;
    static_assert(WS_YML - WS_YHG == (size_t)pg8::PAIR_DA * 256 * HW * 2 && WS_WBM - WS_WBH == (size_t)pg8::PAIR_DB * 256 * HW * 2, "the second branch's operands sit a whole number of tiles behind the first's");
    pg8::PairOrder S; S.S.init(NTOK, D, F.G, (int)blockIdx.x);
    pg8::Gemm g{(const pg8::bf16_t*)(ws + WS_YHG), (const pg8::bf16_t*)(ws + WS_WBH), NTOK, D, HW};
    pg8::EpiGate2 E{(const unsigned char*)(ws + WS_GATES), (pg8::bf16_t*)(ws + WS_TMP), (pg8::bf16_t*)(ws + WS_MERGED)};
    pg8::gemm_phase<pg8::EpiGate2, pg8::PairOrder, true, true>(F.lds + RING_OFF, g, S, E);
    meta_merged(F);
}
__device__ __forceinline__ void ph_wout(Frame& F) {
    unsigned char* ws = F.ws;
    pg8::Gemm g{(const pg8::bf16_t*)(ws + WS_MERGED), (const pg8::bf16_t*)(ws + WS_WOUT), NTOK, D, D}; pg8::StaticOrder S; S.init(NTOK, D, F.G, (int)blockIdx.x);
    pg8::EpiH1 E{(const pg8::bf16_t*)(ws + WS_XN0), (const float*)(ws + WS_XSQ), (pg8::bf16_t*)(ws + WS_H1), (unsigned char*)(ws + WS_H1B)};
    pg8::gemm_phase<pg8::EpiH1, pg8::StaticOrder, true, true>(F.lds + RING_OFF, g, S, E);
    meta_wout(F);
}
__device__ __forceinline__ void ph_gu(Frame& F, int variant = 0) {
    unsigned char* ws = F.ws; build_tables(F);
    const LAS int* pst = (const LAS int*)(F.lds + PST_OFF); LAS unsigned short* tok16 = (LAS unsigned short*)(F.lds + TOK_OFF);
    pg8::Gemm g{(const pg8::bf16_t*)(ws + WS_H1B), (const pg8::bf16_t*)(ws + WS_WGU), NV, NE * 2 * DFF, D / 2};
    pg8::GroupOrder S{pst[32], 8, F.G, (int)blockIdx.x, (const LAS unsigned char*)(F.lds + TEXP_OFF)};
    { const int* ETOK = (const int*)(ws + WS_ETOK);
      int tokv[18];
#pragma unroll
      for (int i = 0; i < 18; ++i) { pg8::Unit u; int t = 0; if (S.next(i, u) && F.tid < 256) { const int e = u.pn >> 3, pos = u.pm * 256 - pst[e] + F.tid; if (pos < pst[33 + e]) t = ETOK[(size_t)e * NV + pos]; } tokv[i] = t; }
      if (F.tid < 256) {
#pragma unroll
          for (int i = 0; i < 18; ++i) tok16[i * 256 + F.tid] = (unsigned short)tokv[i]; }
      __syncthreads(); }
    pg8::EpiGU E{(const float*)(ws + WS_BGUP), (const float*)(ws + WS_ERS), (unsigned char*)(ws + WS_ACT), pst};
#if MK_N_LAUNCHES != 1 && PROBE_VARIANT == 1
    if (variant) { pg8::EpiNull EN{(int*)(ws + WS_TOPE)}; pg8::gemm_phase_g<pg8::EpiNull, pg8::GroupOrder, true>(F.lds + RING_OFF, g, S, EN, tok16); return; }
#elif MK_N_LAUNCHES != 1 && PROBE_VARIANT == 2
    if (variant) { pg8::EpiGUT<true> EV{(const float*)(ws + WS_BGUP), (const float*)(ws + WS_ERS), (unsigned char*)(ws + WS_ACT), pst}; pg8::gemm_phase_g<pg8::EpiGUT<true>, pg8::GroupOrder, true>(F.lds + RING_OFF, g, S, EV, tok16); return; }
#endif
    (void)variant;
    pg8::gemm_phase_g<pg8::EpiGU, pg8::GroupOrder, true>(F.lds + RING_OFF, g, S, E, tok16);
}
__device__ __forceinline__ void ph_down(Frame& F, int variant = 0) {
    unsigned char* ws = F.ws; build_tables(F);
    pg8::Gemm g{(const pg8::bf16_t*)(ws + WS_ACT), (const pg8::bf16_t*)(ws + WS_WDN), MAXTILES * 256, NE * D, DFF / 2};
    pg8::GroupOrder S{((const LAS int*)(F.lds + PST_OFF))[32], 4, F.G, (int)blockIdx.x, (const LAS unsigned char*)(F.lds + TEXP_OFF)};
    pg8::EpiDown E{F.in[IN_BDN], (const float*)(ws + WS_EW), (unsigned char*)(ws + WS_YB), (const LAS int*)(F.lds + PST_OFF)};
#if MK_N_LAUNCHES != 1 && PROBE_VARIANT == 1
    if (variant) { pg8::EpiNull EN{(int*)(ws + WS_TOPE)}; pg8::gemm_phase<pg8::EpiNull, pg8::GroupOrder, true, true, true>(F.lds + RING_OFF, g, S, EN); return; }
#elif MK_N_LAUNCHES != 1 && PROBE_VARIANT == 2
    if (variant) { pg8::EpiDownT<true> EV{F.in[IN_BDN], (const float*)(ws + WS_EW), (unsigned char*)(ws + WS_YB), (const LAS int*)(F.lds + PST_OFF)}; pg8::gemm_phase<pg8::EpiDownT<true>, pg8::GroupOrder, true, true, true>(F.lds + RING_OFF, g, S, EV); return; }
#endif
    (void)variant;
    pg8::gemm_phase<pg8::EpiDown, pg8::GroupOrder, true, true, true>(F.lds + RING_OFF, g, S, E);
}

#ifndef CONV_IN_P0
#define CONV_IN_P0 0
#endif
#ifndef PROBE_DOUBLE
#define PROBE_DOUBLE 0
#endif
#define DBL(k) ((PROBE_DOUBLE >> (k)) & 1)
#ifndef MK_N_LAUNCHES
#define MK_N_LAUNCHES 1
#endif
constexpr int NPHASE = 10;
#ifndef PROBE_VARIANT
#define PROBE_VARIANT 0
#endif
struct Args { const float* in[25]; float* out; unsigned char* ws; int ph_lo, ph_hi, li, pad; };
__global__ void __launch_bounds__(NTHREADS, 2) fwd_kernel(Args args) {
    extern __shared__ __attribute__((aligned(16))) unsigned char lds[];
    Frame F;
    F.lds = (LAS unsigned char*)lds; F.MISC = (volatile LAS unsigned*)(F.lds + MISC_OFF);
    F.tid = threadIdx.x; F.lane = F.tid & 63; F.wave = __builtin_amdgcn_readfirstlane(F.tid >> 6);
    F.G = gridDim.x; { const int bx = blockIdx.x; F.vcu = (F.G % 8 == 0) ? (bx % 8) * (F.G / 8) + bx / 8 : bx; }
    F.ws = args.ws; F.ctl = (gu32*)(args.ws + WS_CTL); F.out = args.out;
#pragma unroll
    for (int i = 0; i < 25; ++i) F.in[i] = args.in[i];
    { int t0 = F.tid; asm volatile("" : "+v"(t0)); if (t0 < 64) F.MISC[t0] = 0u; }
    __syncthreads();
    const int lo = args.ph_lo, hi = args.ph_hi;
    XcdBarrier bar; bar.bar = (unsigned*)(F.ctl + CW_BAR) + args.li * XCD_BAR_WORDS; bar.x = 0; bar.st = nullptr;
    if (hi - lo > 1) bar = xcd_barrier_post((unsigned*)(F.ctl + CW_BAR) + args.li * XCD_BAR_WORDS, F.MISC + 8);
#define IN(k) (lo <= (k) && (k) < hi)
#define SEAM(k) do { if (IN(k) && IN((k) + 1)) xcd_barrier(bar); } while (0)

    if (IN(0)) { p0_prologue(F);
#if CONV_IN_P0
        __syncthreads(); px_experts(F, F.vcu, F.G);
#endif
    } SEAM(0);
    if (IN(1)) { p0b_quant(F); } SEAM(1);
    if (IN(2)) { ph_proj(F, args.pad); } SEAM(2);
    if (IN(3)) { ph_scan(F); } SEAM(3);
    if (IN(4)) { ph_merged(F); } SEAM(4);
    if (IN(5)) { ph_wout(F); } SEAM(5);
    if (IN(6)) { p6_router(F); } SEAM(6);
    if (IN(7)) { ph_gu(F, args.pad); } SEAM(7);
    if (IN(8)) { ph_down(F, args.pad); } SEAM(8);
    if (IN(9)) { p10_combine(F); }
#undef IN
#undef SEAM
}

extern "C" void kernel_launch(void* const* d_in, const int* in_sizes, int n_in, void* d_out, int out_size, void* d_ws, size_t ws_size, hipStream_t stream) {
    static int grid = 0;
    if (grid == 0) {
        if (n_in != 25 || in_sizes[0] != BATCH * SEQ * D || out_size != BATCH * SEQ * D || ws_size < WS_END) { fprintf(stderr, "kernel_launch: unexpected shapes (n_in %d, in0 %d, out %d, ws %zu); nothing launched\n", n_in, n_in > 0 ? in_sizes[0] : -1, out_size, ws_size); grid = -1; return; }
        int dev = 0, cus = 0, per_cu = 0;
        if (hipGetDevice(&dev) != hipSuccess || hipDeviceGetAttribute(&cus, hipDeviceAttributeMultiprocessorCount, dev) != hipSuccess) { grid = -1; return; }
        if (hipFuncSetAttribute((const void*)fwd_kernel, hipFuncAttributeMaxDynamicSharedMemorySize, LDS_BYTES) != hipSuccess) { fprintf(stderr, "kernel_launch: hipFuncSetAttribute failed\n"); grid = -1; return; }
        if (hipOccupancyMaxActiveBlocksPerMultiprocessor(&per_cu, (const void*)fwd_kernel, NTHREADS, LDS_BYTES) != hipSuccess || per_cu < 1) { fprintf(stderr, "kernel_launch: occupancy query reports %d blocks per CU\n", per_cu); }
        (void)hipGetLastError();
        grid = 256;
        if (cus < 256) { fprintf(stderr, "kernel_launch: %d CUs < 256: the grid would not be resident; nothing launched\n", cus); grid = -1; return; }
    }
    if (grid < 0) return;
    if (hipMemsetAsync((char*)d_ws + WS_CTL, 0, CTL_ZERO_BYTES, stream) != hipSuccess) return;
    Args a{};
    for (int i = 0; i < 25; ++i) a.in[i] = (const float*)d_in[i];
    a.out = (float*)d_out; a.ws = (unsigned char*)d_ws; a.pad = 0;
#if MK_N_LAUNCHES == 1
    a.ph_lo = 0; a.ph_hi = NPHASE; a.li = 0;
    hipLaunchKernelGGL(fwd_kernel, dim3(grid), dim3(NTHREADS), LDS_BYTES, stream, a);
#else
    for (int p = 0; p < NPHASE; ++p) for (int rep = 0; rep <= DBL(p); ++rep) { a.ph_lo = p; a.ph_hi = p + 1; a.li = 0; a.pad = rep; hipLaunchKernelGGL(fwd_kernel, dim3(grid), dim3(NTHREADS), LDS_BYTES, stream, a); }
#endif
}
```

```cpp
#include <hip/hip_runtime.h>
#include <cstdio>
#include <cstdint>
namespace pg8 {
#define PG8_LAS __attribute__((address_space(3)))
typedef unsigned short bf16_t;
typedef short bf16x8 __attribute__((ext_vector_type(8)));
typedef float f32x4 __attribute__((ext_vector_type(4)));
typedef unsigned u32x4 __attribute__((ext_vector_type(4)));
constexpr int BM = 256, BK = 64, HALF = 128, HTB = HALF * BK * 2  , STAGE_BYTES = 8 * HTB, NXCD = 8, WGM = 8;

__host__ __device__ __forceinline__ int lds_byte(int r, int c) { const int st = (r >> 4) * 2 + (c >> 5), rr = r & 15, cc = c & 31, ob = rr * 64 + cc * 2; return st * 1024 + (ob ^ (((ob >> 9) & 1) << 5)); }
__host__ __device__ __forceinline__ void stage_rc(int b, int& R, int& C) { const int st = b / 1024, sb = b % 1024, swz = sb ^ (((sb >> 9) & 1) << 5); R = (st >> 1) * 16 + swz / 64; C = (st & 1) * 32 + (swz % 64) / 2; }
__host__ __device__ __forceinline__ int perm32(int rho) { const int n = rho >> 4, i = rho & 15; return 8 * (i >> 2) + 4 * n + (i & 3); }

struct Unit { int pm, pn; };
struct Gemm { const bf16_t* A; const bf16_t* Bt; int M, N, K; };

struct StaticOrder {
    int nM, nN, nwg, G, c;
    __host__ __device__ void init(int M, int N, int G_, int c_) { nM = M / BM; nN = N / BM; nwg = nM * nN; G = G_; c = c_; }
    __host__ __device__ __forceinline__ bool next(int i, Unit& u) const {
        const long L = (long)i * G + c; if (L >= nwg) return false;
        int wgid = (int)L; { const int q = nwg / NXCD, r = nwg % NXCD, xcd = wgid % NXCD, off = wgid / NXCD; wgid = (xcd < r ? xcd * (q + 1) : r * (q + 1) + (xcd - r) * q) + off; }
        const int nig = WGM * nN, gid = wgid / nig, fm = gid * WGM, gsz = (nM - fm) < WGM ? (nM - fm) : WGM;
        u.pm = fm + ((wgid % nig) % gsz); u.pn = (wgid % nig) / gsz; return true;
    }
    __device__ __forceinline__ void a_ready(const Unit&) const {}
    __device__ __forceinline__ void done(const Unit&) const {}
};

typedef __bf16 bf16v2 __attribute__((ext_vector_type(2)));
typedef float f32v2 __attribute__((ext_vector_type(2)));
__device__ __forceinline__ unsigned cvt_pk_bf16(float lo, float hi) { const f32v2 v = {lo, hi}; return __builtin_bit_cast(unsigned, __builtin_convertvector(v, bf16v2)); }
typedef float f32x2 __attribute__((ext_vector_type(2)));
typedef int i32x4 __attribute__((ext_vector_type(4)));
typedef int i32x8 __attribute__((ext_vector_type(8)));
__device__ __forceinline__ i32x8 cat8(const bf16x8 a, const bf16x8 b) { const i32x4 x = __builtin_bit_cast(i32x4, a), y = __builtin_bit_cast(i32x4, b); return __builtin_shufflevector(x, y, 0, 1, 2, 3, 4, 5, 6, 7); }
template <class Epi, class Sched, bool ALIGN_EPI = false, bool SP2 = false, bool FP8 = false, bool I8 = false>
__device__ __forceinline__ void gemm_phase(PG8_LAS unsigned char* lds, const Gemm g, const Sched& S, const Epi& E) {
    const int tid = threadIdx.x, wid = __builtin_amdgcn_readfirstlane(tid >> 6), lane = tid & 63, wr = wid >> 2, wc = wid & 3, fr = lane & 15, fq = lane >> 4;
    const int K = g.K, nt = K / BK;
    unsigned voffA[2], voffB[2];
#pragma unroll
    for (int i = 0; i < 2; ++i) { int R, C; stage_rc(tid * 16 + i * 8192, R, C); const int Rb = Epi::PERM ? ((R & ~31) + perm32(R & 31)) : R;
        voffA[i] = (unsigned)(R * K + C) * 2u; voffB[i] = (unsigned)(Rb * K + C) * 2u; }
    const size_t kstep = (size_t)(BK * 2);
    const size_t hstep = (size_t)HALF * K * 2;
    const size_t tstep = 2 * hstep;
    const unsigned ldsw = (unsigned)wid * 1024u;
    const int aoff = lds_byte(wr * 64 + fr, fq * 8), boff = lds_byte(wc * 32 + fr, fq * 8);
#define PG8_SA(b, h) (((b) * 2 + (h)) * HTB)
#define PG8_SB(b, h) ((4 + (b) * 2 + (h)) * HTB)
#define PG8_STAGE(bufoff, gbase, voff) do { _Pragma("unroll") for (int _i = 0; _i < 2; ++_i) \
        __builtin_amdgcn_global_load_lds((const unsigned*)((const char*)(gbase) + (voff)[_i]), (PG8_LAS unsigned*)(lds + (bufoff) + ldsw + _i * 8192), 16, 0, 0); } while (0)
#define PG8_LDA(dst, b, h) do { _Pragma("unroll") for (int m = 0; m < 4; ++m) { if constexpr (FP8) dst##8[m] = cat8(*(const PG8_LAS bf16x8*)(lds + PG8_SA(b, h) + aoff + m * 2048), *(const PG8_LAS bf16x8*)(lds + PG8_SA(b, h) + aoff + m * 2048 + 1024)); \
        else { _Pragma("unroll") for (int k = 0; k < 2; ++k) dst[m][k] = *(const PG8_LAS bf16x8*)(lds + PG8_SA(b, h) + aoff + m * 2048 + k * 1024); } } } while (0)
#define PG8_LDB(dst, b, h) do { _Pragma("unroll") for (int n = 0; n < 2; ++n) { if constexpr (FP8) dst##8[n] = cat8(*(const PG8_LAS bf16x8*)(lds + PG8_SB(b, h) + boff + n * 2048), *(const PG8_LAS bf16x8*)(lds + PG8_SB(b, h) + boff + n * 2048 + 1024)); \
        else { _Pragma("unroll") for (int k = 0; k < 2; ++k) dst[n][k] = *(const PG8_LAS bf16x8*)(lds + PG8_SB(b, h) + boff + n * 2048 + k * 1024); } } } while (0)
#define PG8_MMA(ai, bj, At, Bt) do { __builtin_amdgcn_s_setprio(1); _Pragma("unroll") for (int m = 0; m < 4; ++m) _Pragma("unroll") for (int n = 0; n < 2; ++n) { \
        if constexpr (FP8) acc[ai][bj][m][n] = __builtin_amdgcn_mfma_scale_f32_16x16x128_f8f6f4(Bt##8[n], At##8[m], acc[ai][bj][m][n], 0, 0, 0, 0x7f7f7f7f, 0, 0x7f7f7f7f); \
        else if constexpr (I8) { _Pragma("unroll") for (int k = 0; k < 2; ++k) acc[ai][bj][m][n] = __builtin_bit_cast(f32x4, __builtin_amdgcn_mfma_i32_16x16x64_i8(__builtin_bit_cast(i32x4, Bt[n][k]), __builtin_bit_cast(i32x4, At[m][k]), __builtin_bit_cast(i32x4, acc[ai][bj][m][n]), 0, 0, 0)); } \
        else { _Pragma("unroll") for (int k = 0; k < 2; ++k) acc[ai][bj][m][n] = __builtin_amdgcn_mfma_f32_16x16x32_bf16(Bt[n][k], At[m][k], acc[ai][bj][m][n], 0, 0, 0); } } \
        if constexpr (FP8) { _Pragma("unroll") for (int m = 0; m < 4; ++m) _Pragma("unroll") for (int n = 0; n < 2; ++n) asm volatile("" : "+v"(acc[ai][bj][m][n])); }     \
        __builtin_amdgcn_s_setprio(0); } while (0)
#define PG8_WAIT_V(n) asm volatile("s_waitcnt vmcnt(" #n ")" ::: "memory")
#define PG8_WAIT_L(n) asm volatile("s_waitcnt lgkmcnt(" #n ")" ::: "memory")
#define PG8_BAR __builtin_amdgcn_s_barrier()
#define PG8_SCHED __builtin_amdgcn_sched_barrier(0)
    Unit cur, nxt; int ui = 0;
    if (!S.next(0, cur)) return;
    f32x4 acc[2][2][4][2];
#pragma unroll
    for (int a = 0; a < 2; ++a)
#pragma unroll
        for (int b = 0; b < 2; ++b)
#pragma unroll
            for (int m = 0; m < 4; ++m)
#pragma unroll
                for (int n = 0; n < 2; ++n) acc[a][b][m][n] = (f32x4){0.f, 0.f, 0.f, 0.f};
    bf16x8 At[4][2], B0[2][2], B1[2][2]; i32x8 At8[4], B08[2], B18[2];
    const char* cA = (const char*)g.A + (size_t)cur.pm * tstep; const char* cB = (const char*)g.Bt + (size_t)cur.pn * tstep;
    S.a_ready(cur);
    if constexpr (SP2) {
        PG8_STAGE(PG8_SB(0, 0), cB, voffB); PG8_STAGE(PG8_SB(0, 1), cB + hstep, voffB); PG8_STAGE(PG8_SA(0, 0), cA, voffA); PG8_STAGE(PG8_SA(0, 1), cA + hstep, voffA);
        if (wr == 1) PG8_BAR;
        PG8_WAIT_V(2); PG8_BAR;
        PG8_STAGE(PG8_SB(1, 0), cB + kstep, voffB); PG8_STAGE(PG8_SA(1, 0), cA + kstep, voffA); PG8_STAGE(PG8_SB(1, 1), cB + hstep + kstep, voffB);
        PG8_WAIT_V(6); PG8_BAR;
    } else {
        PG8_STAGE(PG8_SB(0, 0), cB, voffB); PG8_STAGE(PG8_SA(0, 0), cA, voffA); PG8_STAGE(PG8_SB(0, 1), cB + hstep, voffB); PG8_STAGE(PG8_SA(0, 1), cA + hstep, voffA);
        if (wr == 1) PG8_BAR;
        PG8_WAIT_V(4); PG8_BAR;
        PG8_STAGE(PG8_SB(1, 0), cB + kstep, voffB); PG8_STAGE(PG8_SA(1, 0), cA + kstep, voffA); PG8_STAGE(PG8_SB(1, 1), cB + hstep + kstep, voffB);
        PG8_WAIT_V(6); PG8_BAR;
    }
    for (;;) {
        const bool has_next = S.next(ui + 1, nxt);
        const char* nA = has_next ? (const char*)g.A + (size_t)nxt.pm * tstep : cA; const char* nB = has_next ? (const char*)g.Bt + (size_t)nxt.pn * tstep : cB;
        for (int t = 0; t < nt; t += 2) {
            const bool last = (t == nt - 2);
            const char* a1 = cA + (size_t)(t + 1) * kstep;
            const char* a2 = last ? nA : cA + (size_t)(t + 2) * kstep; const char* b2 = last ? nB : cB + (size_t)(t + 2) * kstep;
            const char* a3 = a2 + kstep; const char* b3 = b2 + kstep;
            if (last && has_next) S.a_ready(nxt);
            if constexpr (SP2) {
            PG8_LDB(B0, 0, 0); PG8_LDB(B1, 0, 1); PG8_SCHED; PG8_LDA(At, 0, 0); PG8_STAGE(PG8_SA(1, 1), a1 + hstep, voffA);
            PG8_WAIT_V(8); PG8_WAIT_L(0); PG8_BAR; PG8_MMA(0, 0, At, B0); PG8_MMA(0, 1, At, B1); PG8_BAR; PG8_SCHED;
            PG8_LDA(At, 0, 1); PG8_STAGE(PG8_SB(0, 0), b2, voffB); PG8_STAGE(PG8_SB(0, 1), b2 + hstep, voffB); PG8_STAGE(PG8_SA(0, 0), a2, voffA);
            PG8_WAIT_V(8); PG8_WAIT_L(0); PG8_BAR; PG8_MMA(1, 0, At, B0); PG8_MMA(1, 1, At, B1); PG8_BAR; PG8_SCHED;
            PG8_LDB(B0, 1, 0); PG8_LDB(B1, 1, 1); PG8_SCHED; PG8_LDA(At, 1, 0); PG8_STAGE(PG8_SA(0, 1), a2 + hstep, voffA);
            PG8_WAIT_V(8); PG8_WAIT_L(0); PG8_BAR; PG8_MMA(0, 0, At, B0); PG8_MMA(0, 1, At, B1); PG8_BAR; PG8_SCHED;
            PG8_LDA(At, 1, 1); PG8_STAGE(PG8_SB(1, 0), b3, voffB); PG8_STAGE(PG8_SB(1, 1), b3 + hstep, voffB); PG8_STAGE(PG8_SA(1, 0), a3, voffA);
            PG8_WAIT_V(8); PG8_WAIT_L(0); PG8_BAR; PG8_MMA(1, 0, At, B0); PG8_MMA(1, 1, At, B1); PG8_BAR; PG8_SCHED;
            } else {
            PG8_LDB(B0, 0, 0); PG8_SCHED; PG8_LDA(At, 0, 0); PG8_STAGE(PG8_SA(1, 1), a1 + hstep, voffA);
            PG8_WAIT_L(8); PG8_BAR; PG8_WAIT_L(0); PG8_MMA(0, 0, At, B0); PG8_BAR; PG8_SCHED;
            PG8_LDB(B1, 0, 1); PG8_STAGE(PG8_SB(0, 0), b2, voffB);
            PG8_BAR; PG8_WAIT_L(0); PG8_MMA(0, 1, At, B1); PG8_BAR;
            PG8_LDA(At, 0, 1); PG8_STAGE(PG8_SA(0, 0), a2, voffA);
            PG8_BAR; PG8_WAIT_L(0); PG8_MMA(1, 0, At, B0); PG8_BAR; PG8_SCHED;
            PG8_STAGE(PG8_SB(0, 1), b2 + hstep, voffB);
            PG8_WAIT_V(6); PG8_BAR; PG8_MMA(1, 1, At, B1); PG8_BAR;
            PG8_LDB(B0, 1, 0); PG8_SCHED; PG8_LDA(At, 1, 0); PG8_STAGE(PG8_SA(0, 1), a2 + hstep, voffA);
            PG8_WAIT_L(8); PG8_BAR; PG8_WAIT_L(0); PG8_MMA(0, 0, At, B0); PG8_BAR; PG8_SCHED;
            PG8_LDB(B1, 1, 1); PG8_STAGE(PG8_SB(1, 0), b3, voffB);
            PG8_BAR; PG8_WAIT_L(0); PG8_MMA(0, 1, At, B1); PG8_BAR;
            PG8_LDA(At, 1, 1); PG8_STAGE(PG8_SA(1, 0), a3, voffA);
            PG8_BAR; PG8_WAIT_L(0); PG8_MMA(1, 0, At, B0); PG8_BAR; PG8_SCHED;
            PG8_STAGE(PG8_SB(1, 1), b3 + hstep, voffB);
            PG8_WAIT_V(6); PG8_BAR; PG8_MMA(1, 1, At, B1); PG8_BAR;
            }
        }
        if constexpr (ALIGN_EPI) { if (wr == 0) PG8_BAR; }
        if constexpr (!Epi::AFTER_DRAIN) { E(acc, cur, wr, wc, fr, fq); S.done(cur); }
        if (!has_next) break;
#pragma unroll
        for (int a = 0; a < 2; ++a)
#pragma unroll
            for (int b = 0; b < 2; ++b)
#pragma unroll
                for (int m = 0; m < 4; ++m)
#pragma unroll
                    for (int n = 0; n < 2; ++n) acc[a][b][m][n] = (f32x4){0.f, 0.f, 0.f, 0.f};
        cur = nxt; cA = nA; cB = nB; ++ui;
        if constexpr (ALIGN_EPI) { if (wr == 1) PG8_BAR; }
    }
    PG8_WAIT_V(0);
    if constexpr (!ALIGN_EPI) { if (wr == 0) PG8_BAR; }
    PG8_BAR;
    if constexpr (Epi::AFTER_DRAIN) { E.fused(acc, cur, wr, wc, fr, fq, lds, wid, lane); S.done(cur); }
#undef PG8_SA
#undef PG8_SB
#undef PG8_STAGE
#undef PG8_LDA
#undef PG8_LDB
#undef PG8_MMA
#undef PG8_WAIT_V
#undef PG8_WAIT_L
#undef PG8_BAR
#undef PG8_SCHED
}
template <class Epi, class Sched, bool FP8 = false>
__device__ __forceinline__ void gemm_phase_g(PG8_LAS unsigned char* lds, const Gemm g, const Sched& S, const Epi& E, const PG8_LAS unsigned short* tok16) {
    constexpr bool ALIGN_EPI = true, SP2 = true;
    const int tid = threadIdx.x, wid = __builtin_amdgcn_readfirstlane(tid >> 6), lane = tid & 63, wr = wid >> 2, wc = wid & 3, fr = lane & 15, fq = lane >> 4;
    const int K = g.K, nt = K / BK;
    unsigned voffB[2]; int RA[2]; unsigned CA[2];
#pragma unroll
    for (int i = 0; i < 2; ++i) { int R, C; stage_rc(tid * 16 + i * 8192, R, C); const int Rb = Epi::PERM ? ((R & ~31) + perm32(R & 31)) : R;
        RA[i] = R; CA[i] = (unsigned)C * 2u; voffB[i] = (unsigned)(Rb * K + C) * 2u; }
    unsigned oc[2][2];
#define PG8_TOKS(dst, ui_) do { _Pragma("unroll") for (int _h = 0; _h < 2; ++_h) _Pragma("unroll") for (int _i = 0; _i < 2; ++_i) \
        dst[_h][_i] = (unsigned)tok16[(ui_) * 256 + _h * HALF + RA[_i]] * (unsigned)(K * 2) + CA[_i]; } while (0)
    const size_t kstep = (size_t)(BK * 2);
    const size_t hstep = (size_t)HALF * K * 2;
    const size_t tstep = 2 * hstep;
    const unsigned ldsw = (unsigned)wid * 1024u;
    const int aoff = lds_byte(wr * 64 + fr, fq * 8), boff = lds_byte(wc * 32 + fr, fq * 8);
#define PG8_SA(b, h) (((b) * 2 + (h)) * HTB)
#define PG8_SB(b, h) ((4 + (b) * 2 + (h)) * HTB)
#define PG8_STAGE(bufoff, gbase, voff) do { _Pragma("unroll") for (int _i = 0; _i < 2; ++_i) \
        __builtin_amdgcn_global_load_lds((const unsigned*)((const char*)(gbase) + (voff)[_i]), (PG8_LAS unsigned*)(lds + (bufoff) + ldsw + _i * 8192), 16, 0, 0); } while (0)
#define PG8_LDA(dst, b, h) do { _Pragma("unroll") for (int m = 0; m < 4; ++m) { if constexpr (FP8) dst##8[m] = cat8(*(const PG8_LAS bf16x8*)(lds + PG8_SA(b, h) + aoff + m * 2048), *(const PG8_LAS bf16x8*)(lds + PG8_SA(b, h) + aoff + m * 2048 + 1024)); \
        else { _Pragma("unroll") for (int k = 0; k < 2; ++k) dst[m][k] = *(const PG8_LAS bf16x8*)(lds + PG8_SA(b, h) + aoff + m * 2048 + k * 1024); } } } while (0)
#define PG8_LDB(dst, b, h) do { _Pragma("unroll") for (int n = 0; n < 2; ++n) { if constexpr (FP8) dst##8[n] = cat8(*(const PG8_LAS bf16x8*)(lds + PG8_SB(b, h) + boff + n * 2048), *(const PG8_LAS bf16x8*)(lds + PG8_SB(b, h) + boff + n * 2048 + 1024)); \
        else { _Pragma("unroll") for (int k = 0; k < 2; ++k) dst[n][k] = *(const PG8_LAS bf16x8*)(lds + PG8_SB(b, h) + boff + n * 2048 + k * 1024); } } } while (0)
#define PG8_MMA(ai, bj, At, Bt) do { __builtin_amdgcn_s_setprio(1); _Pragma("unroll") for (int m = 0; m < 4; ++m) _Pragma("unroll") for (int n = 0; n < 2; ++n) { \
        if constexpr (FP8) acc[ai][bj][m][n] = __builtin_amdgcn_mfma_scale_f32_16x16x128_f8f6f4(Bt##8[n], At##8[m], acc[ai][bj][m][n], 0, 0, 0, 0x7f7f7f7f, 0, 0x7f7f7f7f); \
        else { _Pragma("unroll") for (int k = 0; k < 2; ++k) acc[ai][bj][m][n] = __builtin_amdgcn_mfma_f32_16x16x32_bf16(Bt[n][k], At[m][k], acc[ai][bj][m][n], 0, 0, 0); } } \
        if constexpr (FP8) { _Pragma("unroll") for (int m = 0; m < 4; ++m) _Pragma("unroll") for (int n = 0; n < 2; ++n) asm volatile("" : "+v"(acc[ai][bj][m][n])); }     \
        __builtin_amdgcn_s_setprio(0); } while (0)
#define PG8_WAIT_V(n) asm volatile("s_waitcnt vmcnt(" #n ")" ::: "memory")
#define PG8_WAIT_L(n) asm volatile("s_waitcnt lgkmcnt(" #n ")" ::: "memory")
#define PG8_BAR __builtin_amdgcn_s_barrier()
#define PG8_SCHED __builtin_amdgcn_sched_barrier(0)
    Unit cur, nxt; int ui = 0;
    if (!S.next(0, cur)) return;
    f32x4 acc[2][2][4][2];
#pragma unroll
    for (int a = 0; a < 2; ++a)
#pragma unroll
        for (int b = 0; b < 2; ++b)
#pragma unroll
            for (int m = 0; m < 4; ++m)
#pragma unroll
                for (int n = 0; n < 2; ++n) acc[a][b][m][n] = (f32x4){0.f, 0.f, 0.f, 0.f};
    bf16x8 At[4][2], B0[2][2], B1[2][2]; i32x8 At8[4], B08[2], B18[2];
    const char* cA = (const char*)g.A; const char* cB = (const char*)g.Bt + (size_t)cur.pn * tstep; PG8_TOKS(oc, 0);
    S.a_ready(cur);
    if constexpr (SP2) {
        PG8_STAGE(PG8_SB(0, 0), cB, voffB); PG8_STAGE(PG8_SB(0, 1), cB + hstep, voffB); PG8_STAGE(PG8_SA(0, 0), cA, oc[0]); PG8_STAGE(PG8_SA(0, 1), cA, oc[1]);
        if (wr == 1) PG8_BAR;
        PG8_WAIT_V(2); PG8_BAR;
        PG8_STAGE(PG8_SB(1, 0), cB + kstep, voffB); PG8_STAGE(PG8_SA(1, 0), cA + kstep, oc[0]); PG8_STAGE(PG8_SB(1, 1), cB + hstep + kstep, voffB);
        PG8_WAIT_V(6); PG8_BAR;
    } else {
        PG8_STAGE(PG8_SB(0, 0), cB, voffB); PG8_STAGE(PG8_SA(0, 0), cA, oc[0]); PG8_STAGE(PG8_SB(0, 1), cB + hstep, voffB); PG8_STAGE(PG8_SA(0, 1), cA + hstep, oc[0]);
        if (wr == 1) PG8_BAR;
        PG8_WAIT_V(4); PG8_BAR;
        PG8_STAGE(PG8_SB(1, 0), cB + kstep, voffB); PG8_STAGE(PG8_SA(1, 0), cA + kstep, oc[0]); PG8_STAGE(PG8_SB(1, 1), cB + hstep + kstep, voffB);
        PG8_WAIT_V(6); PG8_BAR;
    }
    for (;;) {
        const bool has_next = S.next(ui + 1, nxt);
        const char* nB = has_next ? (const char*)g.Bt + (size_t)nxt.pn * tstep : cB;
        for (int t = 0; t < nt; t += 2) {
            const bool last = (t == nt - 2);
            const char* a1 = cA + (size_t)(t + 1) * kstep;
            const char* a2 = last ? cA : cA + (size_t)(t + 2) * kstep; const char* b2 = last ? nB : cB + (size_t)(t + 2) * kstep;
            unsigned o2[2][2]; if (last && has_next) PG8_TOKS(o2, ui + 1); else { _Pragma("unroll") for (int _h = 0; _h < 2; ++_h) _Pragma("unroll") for (int _i = 0; _i < 2; ++_i) o2[_h][_i] = oc[_h][_i]; }
            const char* a3 = a2 + kstep; const char* b3 = b2 + kstep;
            if (last && has_next) S.a_ready(nxt);
            if constexpr (SP2) {
            PG8_LDB(B0, 0, 0); PG8_LDB(B1, 0, 1); PG8_SCHED; PG8_LDA(At, 0, 0); PG8_STAGE(PG8_SA(1, 1), a1, oc[1]);
            PG8_WAIT_V(8); PG8_WAIT_L(0); PG8_BAR; PG8_MMA(0, 0, At, B0); PG8_MMA(0, 1, At, B1); PG8_BAR; PG8_SCHED;
            PG8_LDA(At, 0, 1); PG8_STAGE(PG8_SB(0, 0), b2, voffB); PG8_STAGE(PG8_SB(0, 1), b2 + hstep, voffB); PG8_STAGE(PG8_SA(0, 0), a2, o2[0]);
            PG8_WAIT_V(8); PG8_WAIT_L(0); PG8_BAR; PG8_MMA(1, 0, At, B0); PG8_MMA(1, 1, At, B1); PG8_BAR; PG8_SCHED;
            PG8_LDB(B0, 1, 0); PG8_LDB(B1, 1, 1); PG8_SCHED; PG8_LDA(At, 1, 0); PG8_STAGE(PG8_SA(0, 1), a2, o2[1]);
            PG8_WAIT_V(8); PG8_WAIT_L(0); PG8_BAR; PG8_MMA(0, 0, At, B0); PG8_MMA(0, 1, At, B1); PG8_BAR; PG8_SCHED;
            PG8_LDA(At, 1, 1); PG8_STAGE(PG8_SB(1, 0), b3, voffB); PG8_STAGE(PG8_SB(1, 1), b3 + hstep, voffB); PG8_STAGE(PG8_SA(1, 0), a3, o2[0]);
            PG8_WAIT_V(8); PG8_WAIT_L(0); PG8_BAR; PG8_MMA(1, 0, At, B0); PG8_MMA(1, 1, At, B1); PG8_BAR; PG8_SCHED;
            } else {
            PG8_LDB(B0, 0, 0); PG8_SCHED; PG8_LDA(At, 0, 0); PG8_STAGE(PG8_SA(1, 1), a1 + hstep, oc[0]);
            PG8_WAIT_L(8); PG8_BAR; PG8_WAIT_L(0); PG8_MMA(0, 0, At, B0); PG8_BAR; PG8_SCHED;
            PG8_LDB(B1, 0, 1); PG8_STAGE(PG8_SB(0, 0), b2, voffB);
            PG8_BAR; PG8_WAIT_L(0); PG8_MMA(0, 1, At, B1); PG8_BAR;
            PG8_LDA(At, 0, 1); PG8_STAGE(PG8_SA(0, 0), a2, oc[0]);
            PG8_BAR; PG8_WAIT_L(0); PG8_MMA(1, 0, At, B0); PG8_BAR; PG8_SCHED;
            PG8_STAGE(PG8_SB(0, 1), b2 + hstep, voffB);
            PG8_WAIT_V(6); PG8_BAR; PG8_MMA(1, 1, At, B1); PG8_BAR;
            PG8_LDB(B0, 1, 0); PG8_SCHED; PG8_LDA(At, 1, 0); PG8_STAGE(PG8_SA(0, 1), a2 + hstep, oc[0]);
            PG8_WAIT_L(8); PG8_BAR; PG8_WAIT_L(0); PG8_MMA(0, 0, At, B0); PG8_BAR; PG8_SCHED;
            PG8_LDB(B1, 1, 1); PG8_STAGE(PG8_SB(1, 0), b3, voffB);
            PG8_BAR; PG8_WAIT_L(0); PG8_MMA(0, 1, At, B1); PG8_BAR;
            PG8_LDA(At, 1, 1); PG8_STAGE(PG8_SA(1, 0), a3, oc[0]);
            PG8_BAR; PG8_WAIT_L(0); PG8_MMA(1, 0, At, B0); PG8_BAR; PG8_SCHED;
            PG8_STAGE(PG8_SB(1, 1), b3 + hstep, voffB);
            PG8_WAIT_V(6); PG8_BAR; PG8_MMA(1, 1, At, B1); PG8_BAR;
            }
        }
        if constexpr (ALIGN_EPI) { if (wr == 0) PG8_BAR; }
        if constexpr (!Epi::AFTER_DRAIN) { E(acc, cur, wr, wc, fr, fq); S.done(cur); }
        if (!has_next) break;
#pragma unroll
        for (int a = 0; a < 2; ++a)
#pragma unroll
            for (int b = 0; b < 2; ++b)
#pragma unroll
                for (int m = 0; m < 4; ++m)
#pragma unroll
                    for (int n = 0; n < 2; ++n) acc[a][b][m][n] = (f32x4){0.f, 0.f, 0.f, 0.f};
        cur = nxt; cB = nB; ++ui; PG8_TOKS(oc, ui);
        if constexpr (ALIGN_EPI) { if (wr == 1) PG8_BAR; }
    }
    PG8_WAIT_V(0);
    if constexpr (!ALIGN_EPI) { if (wr == 0) PG8_BAR; }
    PG8_BAR;
    if constexpr (Epi::AFTER_DRAIN) { E.fused(acc, cur, wr, wc, fr, fq, lds, wid, lane); S.done(cur); }
#undef PG8_TOKS
#undef PG8_SA
#undef PG8_SB
#undef PG8_STAGE
#undef PG8_LDA
#undef PG8_LDB
#undef PG8_MMA
#undef PG8_WAIT_V
#undef PG8_WAIT_L
#undef PG8_BAR
#undef PG8_SCHED
}
}

constexpr int BATCH = 16, SEQ = 2048, D = 1024, NMETA = 16;
constexpr int TV = SEQ + NMETA;
constexpr int NV = BATCH * TV;
constexpr int NTOK = BATCH * SEQ;
constexpr int NR = NTOK + NMETA;
constexpr int NIN = 5128, NPROJ = 5120;
constexpr int HW = 512;
constexpr int NE = 32, TOPK = 4, DFF = 1024;
constexpr int MAXTILES = 548;
constexpr float EPS = 1e-6f;
constexpr int NWAVES = 8, NTHREADS = 512;

constexpr size_t MiB = 1u << 20, KiB = 1u << 10;
constexpr size_t WS_CTL = 0, CTL_ZERO_BYTES = 1 * MiB;
constexpr size_t WS_WIN = 2 * MiB;
constexpr size_t WS_WBH = 12 * MiB, WS_WBM = 13 * MiB, WS_WOUT = 14 * MiB;
constexpr size_t WS_WGU = 16 * MiB;
constexpr size_t WS_WDN = 144 * MiB;
constexpr size_t WS_BGUP = 208 * MiB;
constexpr size_t WS_RWT = WS_BGUP + 256 * KiB;
constexpr size_t WS_TOPE = WS_RWT + 128 * KiB;
constexpr size_t WS_TOPP = WS_TOPE + 520 * KiB;
constexpr size_t WS_TOPW = WS_TOPP + 520 * KiB;
constexpr size_t WS_RS = WS_TOPW + 520 * KiB;
constexpr size_t WS_LI = WS_RS + 136 * KiB;
constexpr size_t WS_LF = WS_LI + 520 * KiB;
constexpr size_t WS_SLOTRS = WS_LF + 520 * KiB;
constexpr size_t WS_SLOTW = WS_SLOTRS + 552 * KiB;
constexpr size_t WS_XSQ = WS_SLOTW + 552 * KiB;
constexpr size_t WS_SROW = WS_XSQ + 136 * KiB;
constexpr size_t WS_SCOL = WS_SROW + 136 * KiB;
constexpr size_t WS_SMALL_END = WS_SCOL + 32 * KiB;
constexpr size_t WS_RA = 214 * MiB;
constexpr size_t WS_HQ = WS_RA, WS_HG = WS_RA + 33 * MiB, WS_HV = WS_RA + 99 * MiB, WS_HGATE = WS_RA + 132 * MiB, WS_MM = WS_RA + 165 * MiB, WS_MO = WS_RA + 198 * MiB, WS_GATES = WS_RA + 231 * MiB;
constexpr size_t WS_MERGED = WS_RA, WS_TMP = WS_RA + 66 * MiB, WS_H1B = WS_RA + 364 * MiB, WS_ACT = WS_RA;
constexpr size_t WS_RB = WS_RA + 364 * MiB;
constexpr size_t WS_XQ = WS_RB;
constexpr size_t WS_QKVM = WS_RB, WS_CM = WS_RB + 130 * MiB, WS_YHG = WS_RB + 196 * MiB, WS_YML = WS_RB + 229 * MiB, WS_XS = WS_RB, WS_YB = WS_RB;
constexpr size_t WS_RC = WS_RB + 274 * MiB;
constexpr size_t WS_XN0 = WS_RC + 65 * MiB;
constexpr size_t WS_H1 = WS_RC, WS_ETOK = WS_RC + 130 * MiB, WS_ERS = WS_ETOK + 5 * MiB, WS_EW = WS_ERS + 5 * MiB, WS_WIN8 = WS_EW + 5 * MiB, WS_END = WS_WIN8 + 5 * MiB;
static_assert(WS_SMALL_END <= WS_RA && WS_END <= 1024 * MiB, "d_ws map");
static_assert((size_t)NV * HW * 2 <= 33 * MiB && (size_t)NV * HW * 4 <= 66 * MiB && (size_t)NV * 2048 * 2 <= 132 * MiB + MiB && (size_t)NV * D * 4 <= 130 * MiB && (size_t)MAXTILES * 256 * D * 2 <= 274 * MiB, "d_ws sizes");
static_assert((size_t)NE * NV * 4 <= 5 * MiB, "per-expert lists");
static_assert((size_t)NR * D * 2 <= 65 * MiB && (size_t)NR * 4 <= 136 * KiB, "H1 / XN0 / XSQ");
constexpr int CW_TMO = 0, CW_CNT = 64  , CW_BAR = 4096, CW_CMAX = 65536  ;

constexpr int RING_OFF = 0, RING_BYTES = 131072;
constexpr int MISC_OFF = RING_BYTES;
constexpr int TEXP_OFF = MISC_OFF + 256;
constexpr int PST_OFF = TEXP_OFF + 640;
constexpr int TOK_OFF = PST_OFF + 384;
constexpr int LDS_BYTES = 147456;
static_assert(TOK_OFF + 18 * 512 <= LDS_BYTES, "LDS map");

#define GAS __attribute__((address_space(1)))
#define LAS __attribute__((address_space(3)))
typedef unsigned short bf16;
typedef unsigned v4u __attribute__((ext_vector_type(4)));
typedef unsigned v2u __attribute__((ext_vector_type(2)));
typedef float f32x4 __attribute__((ext_vector_type(4)));
typedef GAS unsigned gu32;
#define RLX_AGENT __ATOMIC_RELAXED, __HIP_MEMORY_SCOPE_AGENT
#define LDS_WAIT() asm volatile("s_waitcnt lgkmcnt(0)" ::: "memory")
#define VM_WAIT() asm volatile("s_waitcnt vmcnt(0)" ::: "memory")
__device__ __forceinline__ unsigned pk2(float lo, float hi) { return pg8::cvt_pk_bf16(lo, hi); }
__device__ __forceinline__ unsigned f2bf(float f) { return pg8::cvt_pk_bf16(f, 0.f) & 0xffffu; }
__device__ __forceinline__ float bflo(unsigned w) { return __builtin_bit_cast(float, w << 16); }
__device__ __forceinline__ float bfhi(unsigned w) { return __builtin_bit_cast(float, w & 0xffff0000u); }
__device__ __forceinline__ float bf1(bf16 h) { return __builtin_bit_cast(float, (unsigned)h << 16); }
__device__ __forceinline__ float fsigmoid(float x) { return __builtin_amdgcn_rcpf(1.0f + __expf(-x)); }
__device__ __forceinline__ float fsilu(float x) { return x * fsigmoid(x); }
__device__ __forceinline__ size_t rowof(int b, int tt) { return tt < NMETA ? (size_t)(NTOK + tt) : (size_t)b * SEQ + (tt - NMETA); }
__host__ __device__ __forceinline__ int gu_slot(int j) { const int g = (j >> 3) & 3, p = ((g & 1) << 1) | (g >> 1); return (j & ~31) + 8 * p + (j & 7); }
__device__ __forceinline__ float wave_sum(float v) {
#pragma unroll
    for (int o = 1; o < 64; o <<= 1) v += __shfl_xor(v, o);
    return v;
}
__device__ __forceinline__ float wave_max(float v) {
#pragma unroll
    for (int o = 1; o < 64; o <<= 1) v = fmaxf(v, __shfl_xor(v, o));
    return v;
}
#define XB_TMO      128
#define XB_XCNT(j)  (256  + 64 * (j))
#define XB_XSUB(j)  (1280 + 64 * (j))
#define XB_XGEN(j)  (2304 + 64 * (j))
#define XB_TOP      3328
#define XB_TOPGEN   3392
#define XCD_BAR_WORDS 3456
#define XB_SPIN_CAP (1u << 18)

__device__ __forceinline__ unsigned xb_ld(unsigned* p)              { return __hip_atomic_load(p, __ATOMIC_RELAXED, __HIP_MEMORY_SCOPE_AGENT); }
__device__ __forceinline__ unsigned xb_add(unsigned* p, unsigned v) { return __hip_atomic_fetch_add(p, v, __ATOMIC_RELAXED, __HIP_MEMORY_SCOPE_AGENT); }
__device__ __forceinline__ unsigned xb_xcc_id() { return (unsigned)__builtin_amdgcn_s_getreg((3 << 11) | 20) & 0xFu; }
#define XB_SPIN(cond, bar) do { unsigned _sp = 0; while (cond) { __builtin_amdgcn_s_sleep(1); \
    if ((++_sp & 255u) == 0u) { if (xb_ld(&(bar)[XB_TMO])) break; if (_sp > XB_SPIN_CAP) { atomicAdd(&(bar)[XB_TMO], 1u); break; } } } } while (0)

struct XcdBarrier {
    unsigned* bar; unsigned x;
    volatile LAS unsigned* st;
};

__device__ __forceinline__ XcdBarrier xcd_barrier_post(unsigned* bar, volatile LAS unsigned* st) {
    XcdBarrier b; b.bar = bar; b.x = xb_xcc_id(); b.st = st;
    if (threadIdx.x == 0) (void)xb_add(&bar[XB_XCNT(b.x)], 1u);
    return b;
}
__device__ __forceinline__ void xcd_barrier_complete(unsigned* bar, unsigned x, unsigned& nloc, unsigned& nx) {
    const unsigned G = gridDim.x * gridDim.y * gridDim.z;
    unsigned sum, cnt, mine, sp = 0u;
    for (;;) {
        sum = 0u; cnt = 0u; mine = 0u;
#pragma unroll
        for (unsigned j = 0; j < 16; ++j) { const unsigned c = xb_ld(&bar[XB_XCNT(j)]); sum += c; cnt += (c > 0u) ? 1u : 0u; mine = (j == x) ? c : mine; }
        if (sum == G) break;
        __builtin_amdgcn_s_sleep(1);
        if ((++sp & 255u) == 0u) { if (xb_ld(&bar[XB_TMO])) break; if (sp > XB_SPIN_CAP) { atomicAdd(&bar[XB_TMO], 1u); break; } }
    }
    nloc = mine > 0u ? mine : 1u; nx = cnt > 0u ? cnt : 1u;
}

__device__ __forceinline__ void xcd_barrier(const XcdBarrier& b) {
    asm volatile("s_waitcnt vmcnt(0)" ::: "memory");
    __syncthreads();
    if (threadIdx.x == 0) {
        unsigned* bar = b.bar;
        __builtin_amdgcn_s_waitcnt(0);
        unsigned nloc = b.st[0], nx = b.st[1];
        if (nloc == 0u) { xcd_barrier_complete(bar, b.x, nloc, nx); b.st[0] = nloc; b.st[1] = nx; }
        const unsigned old = xb_add(&bar[XB_XSUB(b.x)], 1u);
        const unsigned gen = old / nloc;
        if (old + 1u == (gen + 1u) * nloc) {
            __builtin_amdgcn_fence(__ATOMIC_RELEASE, "agent");
            asm volatile("s_waitcnt vmcnt(0)" ::: "memory");
            const unsigned og = xb_add(&bar[XB_TOP], 1u);
            const unsigned tg = og / nx;
            if (og + 1u == (tg + 1u) * nx) xb_add(&bar[XB_TOPGEN], 1u);
            else XB_SPIN(xb_ld(&bar[XB_TOPGEN]) == tg, bar);
            __builtin_amdgcn_fence(__ATOMIC_ACQUIRE, "agent");
            xb_add(&bar[XB_XGEN(b.x)], 1u);
            asm volatile("s_waitcnt vmcnt(0)" ::: "memory");
        } else {
            XB_SPIN(xb_ld(&bar[XB_XGEN(b.x)]) == gen, bar);
            __builtin_amdgcn_fence(__ATOMIC_ACQUIRE, "agent");
            asm volatile("s_waitcnt vmcnt(0)" ::: "memory");
        }
    }
    __syncthreads();
}

struct Frame {
    LAS unsigned char* lds;
    volatile LAS unsigned* MISC;
    gu32* ctl;
    int tid, lane, wave, vcu, G;
    const float* in[25];
    float* out;
    unsigned char* ws;
};
#define IN_X 0
#define IN_META 1
#define IN_LBL 2
#define IN_NMIX 3
#define IN_WIN 4
#define IN_HGNORM 5
#define IN_CONVW 6
#define IN_CONVB 7
#define IN_WQ 8
#define IN_WK 9
#define IN_WV 10
#define IN_GATEB 11
#define IN_MLNORM 12
#define IN_MLSKIP 13
#define IN_WBH 14
#define IN_WBM 15
#define IN_WOUT 16
#define IN_NFFN 17
#define IN_RW 18
#define IN_RB 19
#define IN_WGU 20
#define IN_BGU 21
#define IN_WDN 22
#define IN_BDN 23
#define IN_NFIN 24

__device__ __forceinline__ void p0_item(const float* W, int ldw, int col0, int cstride, const float* kscale, bf16* WT, int K, int dstrow0, int k0, LAS float* scr, int lane, float gsc = 1.f, gu32* cmax = nullptr) {
    (void)cstride;
    const int r = lane >> 3, c4 = (lane & 7) * 4;
    f32x4 v[8];
#pragma unroll
    for (int i = 0; i < 8; ++i) v[i] = *(const GAS f32x4*)(W + (size_t)(k0 + 8 * i + r) * ldw + col0 + c4);
#pragma unroll
    for (int i = 0; i < 8; ++i) { const float sc = kscale ? kscale[k0 + 8 * i + r] : gsc; LAS float* s = scr + (8 * i + r) * 33 + c4; s[0] = v[i].x * sc; s[1] = v[i].y * sc; s[2] = v[i].z * sc; s[3] = v[i].w * sc; }
    LDS_WAIT(); asm volatile("" ::: "memory");
    const int c = lane & 7;
#pragma unroll
    for (int j = 0; j < 4; ++j) { const int n = (lane >> 3) + 8 * j; const LAS float* s = scr + (8 * c) * 33 + n;
        v4u o; o.x = pk2(s[0 * 33], s[1 * 33]); o.y = pk2(s[2 * 33], s[3 * 33]); o.z = pk2(s[4 * 33], s[5 * 33]); o.w = pk2(s[6 * 33], s[7 * 33]);
        if (cmax) { float m = fmaxf(fmaxf(fmaxf(fabsf(s[0 * 33]), fabsf(s[1 * 33])), fmaxf(fabsf(s[2 * 33]), fabsf(s[3 * 33]))), fmaxf(fmaxf(fabsf(s[4 * 33]), fabsf(s[5 * 33])), fmaxf(fabsf(s[6 * 33]), fabsf(s[7 * 33]))));
            m = fmaxf(m, __shfl_xor(m, 1)); m = fmaxf(m, __shfl_xor(m, 2)); m = fmaxf(m, __shfl_xor(m, 4));
            if (c == 0) (void)__hip_atomic_fetch_max(cmax + dstrow0 + n, __builtin_bit_cast(unsigned, m), RLX_AGENT); }
        *(GAS v4u*)(WT + (size_t)(dstrow0 + n) * K + k0 + 8 * c) = o; }
    LDS_WAIT(); asm volatile("" ::: "memory");
}
__device__ __forceinline__ void p0_prologue(Frame& F) {
    unsigned char* ws = F.ws;
    const int gw = F.vcu * NWAVES + F.wave, NGW = F.G * NWAVES, gt = F.vcu * NTHREADS + F.tid, NGT = F.G * NTHREADS;
    {
        LAS float* wm = (LAS float*)(F.lds + RING_OFF + 65536);
        { float wa[16], wb[16];
#pragma unroll
          for (int q = 0; q < 16; ++q) { const int u = F.tid + q * NTHREADS, j = u & 7, l = (u >> 3) & 63, i = u >> 9, k = 4 * l + 256 * (i >> 2) + (i & 3); wa[q] = F.in[IN_NMIX][k]; wb[q] = F.in[IN_WIN][(size_t)k * NIN + 3072 + j]; }
#pragma unroll
          for (int q = 0; q < 16; ++q) wm[F.tid + q * NTHREADS] = wa[q] * wb[q]; }
        __syncthreads();
        bf16* XN0 = (bf16*)(ws + WS_XN0); float* XSQ = (float*)(ws + WS_XSQ); unsigned char* XQ = ws + WS_XQ; float* SROW = (float*)(ws + WS_SROW); float* LI = (float*)(ws + WS_LI); float* LF = (float*)(ws + WS_LF);
        f32x4 vn[4];
#define P0_LOADROW(dst, V_) do { const int Vc_ = (V_) < NR ? (V_) : NR - 1; const float* src_ = (Vc_ >= NTOK) ? F.in[IN_META] + (size_t)(Vc_ - NTOK) * D : F.in[IN_X] + (size_t)Vc_ * D; \
        const GAS f32x4* xr_ = (const GAS f32x4*)src_ + F.lane; _Pragma("unroll") for (int j = 0; j < 4; ++j) dst[j] = xr_[64 * j]; } while (0)
        P0_LOADROW(vn, gw);
        for (int V = gw; V < NR; V += NGW) {
            f32x4 v[4]; float s = 0.f, am = 0.f;
#pragma unroll
            for (int j = 0; j < 4; ++j) { v[j] = vn[j]; s += (v[j].x * v[j].x + v[j].y * v[j].y) + (v[j].z * v[j].z + v[j].w * v[j].w); am = fmaxf(am, fmaxf(fmaxf(fabsf(v[j].x), fabsf(v[j].y)), fmaxf(fabsf(v[j].z), fabsf(v[j].w)))); }
            P0_LOADROW(vn, V + NGW);
            asm volatile("" ::: "memory");
            const float sq = sqrtf(wave_sum(s) * (1.f / D) + EPS), rs = 1.0f / sq;
            am = wave_max(am) * rs; const float srow = am > 0.f ? am * (1.f / 127.f) : 1.f, qi = 1.f / srow;
            if (F.lane == 0) { XSQ[V] = sq; SROW[V] = srow; }
            GAS unsigned* q4 = (GAS unsigned*)(XQ + (size_t)V * D) + F.lane;
            float g[8];
#pragma unroll
            for (int j = 0; j < 8; ++j) g[j] = 0.f;
            GAS unsigned long long* o8 = (GAS unsigned long long*)(XN0 + (size_t)V * D) + F.lane;
#pragma unroll
            for (int j = 0; j < 4; ++j) {
                v[j] = v[j] * rs;
                __builtin_nontemporal_store((unsigned long long)pk2(v[j].x, v[j].y) | ((unsigned long long)pk2(v[j].z, v[j].w) << 32), o8 + 64 * j);
                q4[64 * j] = ((unsigned)(int)rintf(v[j].x * qi) & 0xffu) | (((unsigned)(int)rintf(v[j].y * qi) & 0xffu) << 8) | (((unsigned)(int)rintf(v[j].z * qi) & 0xffu) << 16) | ((unsigned)(int)rintf(v[j].w * qi) << 24);
#pragma unroll
                for (int q = 0; q < 4; ++q) { const LAS f32x4* wp = (const LAS f32x4*)(wm + (((4 * j + q) * 64 + F.lane) * 8)); const f32x4 w0 = wp[0], w1 = wp[1]; const float xv = v[j][q];
                    g[0] += xv * w0.x; g[1] += xv * w0.y; g[2] += xv * w0.z; g[3] += xv * w0.w; g[4] += xv * w1.x; g[5] += xv * w1.y; g[6] += xv * w1.z; g[7] += xv * w1.w; }
            }
#pragma unroll
            for (int j = 0; j < 8; ++j) g[j] = wave_sum(g[j]);
            if (F.lane < 4) {
                const float gi = (F.lane == 0 ? g[0] : F.lane == 1 ? g[1] : F.lane == 2 ? g[2] : g[3]) + F.in[IN_GATEB][F.lane];
                const float gf = (F.lane == 0 ? g[4] : F.lane == 1 ? g[5] : F.lane == 2 ? g[6] : g[7]) + F.in[IN_GATEB][4 + F.lane];
                LI[(size_t)V * 4 + F.lane] = gi;
                LF[(size_t)V * 4 + F.lane] = fminf(gf, 0.f) - log1pf(__expf(-fabsf(gf)));
            }
        }
        __syncthreads();
    }
    {
        LAS float* scr = (LAS float*)(F.lds + RING_OFF + F.wave * 16384);
        constexpr int I_IN1 = 16 * 96, I_IN2 = 16 * 64, I_BH = 8 * 32, I_OUT = 16 * 32;
        constexpr int NITEMS = I_IN1 + I_IN2 + 2 * I_BH + I_OUT;
        for (int it = gw; it < NITEMS; it += NGW) {
            int r = it;
            if (r < I_IN1) { const int kb = r / 96, nb = r % 96; p0_item(F.in[IN_WIN], NIN, 32 * nb, 1, F.in[IN_NMIX], (bf16*)(ws + WS_WIN), D, 32 * nb, 64 * kb, scr, F.lane, 1.f, F.ctl + CW_CMAX); continue; } r -= I_IN1;
            if (r < I_IN2) { const int kb = r / 64, nb = r % 64; p0_item(F.in[IN_WIN], NIN, 3080 + 32 * nb, 1, F.in[IN_NMIX], (bf16*)(ws + WS_WIN), D, 3072 + 32 * nb, 64 * kb, scr, F.lane, 1.f, F.ctl + CW_CMAX); continue; } r -= I_IN2;
            if (r < I_BH) { const int kb = r / 32, nb = r % 32; p0_item(F.in[IN_WBH], D, 32 * nb, 1, nullptr, (bf16*)(ws + WS_WBH), HW, 32 * nb, 64 * kb, scr, F.lane, 1.f / 255.f); continue; } r -= I_BH;
            if (r < I_BH) { const int kb = r / 32, nb = r % 32; p0_item(F.in[IN_WBM], D, 32 * nb, 1, nullptr, (bf16*)(ws + WS_WBM), HW, 32 * nb, 64 * kb, scr, F.lane, 1.f / 255.f); continue; } r -= I_BH;
            { const int kb = r / 32, nb = r % 32; p0_item(F.in[IN_WOUT], D, 32 * nb, 1, nullptr, (bf16*)(ws + WS_WOUT), D, 32 * nb, 64 * kb, scr, F.lane); }
        }
    }
    { float* BGUP = (float*)(ws + WS_BGUP); float* RWT = (float*)(ws + WS_RWT);
      for (int u = gt; u < NE * 2 * DFF; u += NGT) { const int e = u >> 11, n = u & 2047, pn = n >> 8, bj = (n >> 7) & 1, j = gu_slot(n & 127); BGUP[u] = F.in[IN_BGU][(size_t)e * 2 * DFF + 2 * (128 * pn + j) + bj]; }
      for (int u = gt; u < NE * D; u += NGT) { const int e = u >> 10, k = u & 1023; RWT[u] = F.in[IN_NFFN][k] * F.in[IN_RW][(size_t)k * NE + e]; } }
}

__device__ __forceinline__ void p0b_quant(Frame& F) {
    unsigned char* ws = F.ws; const int gw = F.vcu * NWAVES + F.wave, NGW = F.G * NWAVES, lane = F.lane;
    LAS float* scr = (LAS float*)(F.lds + RING_OFF + F.wave * 16384);
    unsigned char* W8 = ws + WS_WIN8; float* SCOL = (float*)(ws + WS_SCOL); const float* W = F.in[IN_WIN]; const float* kscale = F.in[IN_NMIX];
    constexpr int I_IN1 = 16 * 96, I_IN2 = 16 * 64;
    const int r = lane >> 3, c4 = (lane & 7) * 4;
    for (int it = gw; it < I_IN1 + I_IN2; it += NGW) {
        int kb, nb, col0, dstrow0;
        if (it < I_IN1) { kb = it / 96; nb = it % 96; col0 = 32 * nb; dstrow0 = 32 * nb; } else { const int q = it - I_IN1; kb = q / 64; nb = q % 64; col0 = 3080 + 32 * nb; dstrow0 = 3072 + 32 * nb; }
        const int k0 = 64 * kb;
        f32x4 v[8];
#pragma unroll
        for (int i = 0; i < 8; ++i) v[i] = *(const GAS f32x4*)(W + (size_t)(k0 + 8 * i + r) * NIN + col0 + c4);
        float qs[4];
#pragma unroll
        for (int e = 0; e < 4; ++e) { const float m = __builtin_bit_cast(float, __hip_atomic_load(F.ctl + CW_CMAX + dstrow0 + c4 + e, RLX_AGENT)); qs[e] = 127.f / fmaxf(m, 1e-30f); }
        if (kb == 0 && lane < 8) {
#pragma unroll
            for (int e = 0; e < 4; ++e) SCOL[dstrow0 + c4 + e] = 1.f / qs[e]; }
#pragma unroll
        for (int i = 0; i < 8; ++i) { const float sc = kscale[k0 + 8 * i + r]; LAS float* s = scr + (8 * i + r) * 33 + c4; s[0] = rintf(v[i].x * sc * qs[0]); s[1] = rintf(v[i].y * sc * qs[1]); s[2] = rintf(v[i].z * sc * qs[2]); s[3] = rintf(v[i].w * sc * qs[3]); }
        LDS_WAIT(); asm volatile("" ::: "memory");
        const int c = lane & 7;
#pragma unroll
        for (int j = 0; j < 4; ++j) { const int n = (lane >> 3) + 8 * j; const LAS float* s = scr + (8 * c) * 33 + n;
            v2u o;
            o.x = ((unsigned)(int)s[0 * 33] & 0xffu) | (((unsigned)(int)s[1 * 33] & 0xffu) << 8) | (((unsigned)(int)s[2 * 33] & 0xffu) << 16) | ((unsigned)(int)s[3 * 33] << 24);
            o.y = ((unsigned)(int)s[4 * 33] & 0xffu) | (((unsigned)(int)s[5 * 33] & 0xffu) << 8) | (((unsigned)(int)s[6 * 33] & 0xffu) << 16) | ((unsigned)(int)s[7 * 33] << 24);
            *(GAS v2u*)(W8 + (size_t)(dstrow0 + n) * D + k0 + 8 * c) = o; }
        LDS_WAIT(); asm volatile("" ::: "memory");
    }
}

__device__ __forceinline__ unsigned pk4_fp8(float a, float b, float c, float d) { unsigned w = 0;
    a = __builtin_amdgcn_fmed3f(a, -448.f, 448.f); b = __builtin_amdgcn_fmed3f(b, -448.f, 448.f); c = __builtin_amdgcn_fmed3f(c, -448.f, 448.f); d = __builtin_amdgcn_fmed3f(d, -448.f, 448.f);
    w = __builtin_amdgcn_cvt_pk_fp8_f32(a, b, w, false); w = __builtin_amdgcn_cvt_pk_fp8_f32(c, d, w, true); return w; }
__device__ __forceinline__ void cvdn_load(const float* Wdn, int it, f32x4 (&v)[8], int lane) {
    const int e = it >> 9, kb = (it >> 5) & 15, nb = it & 31, r = lane >> 3, c4 = (lane & 7) * 4; const float* W = Wdn + (size_t)e * DFF * D;
#pragma unroll
    for (int i = 0; i < 8; ++i) v[i] = *(const GAS f32x4*)(W + (size_t)(64 * kb + 8 * i + r) * D + 32 * nb + c4);
}
__device__ __forceinline__ void cvdn_proc(unsigned char* WTdn, int it, const f32x4 (&v)[8], LAS float* scr, int lane) {
    const int e = it >> 9, kb = (it >> 5) & 15, nb = it & 31, r = lane >> 3, c4 = (lane & 7) * 4; unsigned char* WT = WTdn + (size_t)e * D * DFF;
#pragma unroll
    for (int i = 0; i < 8; ++i) { LAS float* s = scr + (8 * i + r) * 33 + c4; s[0] = v[i].x * 32.f; s[1] = v[i].y * 32.f; s[2] = v[i].z * 32.f; s[3] = v[i].w * 32.f; }
    LDS_WAIT(); asm volatile("" ::: "memory");
    const int c = lane & 7;
#pragma unroll
    for (int j = 0; j < 4; ++j) { const int n = (lane >> 3) + 8 * j; const LAS float* s = scr + (8 * c) * 33 + n;
        v2u o; o.x = pk4_fp8(s[0 * 33], s[1 * 33], s[2 * 33], s[3 * 33]); o.y = pk4_fp8(s[4 * 33], s[5 * 33], s[6 * 33], s[7 * 33]);
        const int cn = 32 * nb + n, rowp = (cn & ~255) + 128 * ((cn >> 3) & 1) + 32 * ((cn >> 6) & 3) + 8 * ((cn >> 4) & 3) + (cn & 7);
        *(GAS v2u*)(WT + (size_t)rowp * DFF + 64 * kb + 8 * c) = o; }
    LDS_WAIT(); asm volatile("" ::: "memory");
}
__device__ __forceinline__ void cvgu_load(const float* Wgu, const float* nffn, int it, f32x4 (&v)[8], float (&sc)[8], int lane) {
    const int e = it >> 10, kb = (it >> 5) & 31, nb = it & 31, r = lane >> 4, c4 = (lane & 15) * 4; const float* W = Wgu + (size_t)e * D * 2 * DFF;
#pragma unroll
    for (int i = 0; i < 8; ++i) { v[i] = *(const GAS f32x4*)(W + (size_t)(32 * kb + 4 * i + r) * (2 * DFF) + 64 * nb + c4); sc[i] = nffn[32 * kb + 4 * i + r] * 32.f; }
}
__device__ __forceinline__ void cvgu_proc(unsigned char* WTgu, int it, const f32x4 (&v)[8], const float (&sc)[8], LAS float* scr, int lane) {
    const int e = it >> 10, kb = (it >> 5) & 31, nb = it & 31, r = lane >> 4, c4 = (lane & 15) * 4, A0 = 32 * nb, k0 = 32 * kb; unsigned char* WT = WTgu + (size_t)e * 2 * DFF * D;
    LAS float* sg = scr; LAS float* su = scr + 32 * 33;
#pragma unroll
    for (int i = 0; i < 8; ++i) { const int o = (4 * i + r) * 33 + (c4 >> 1); sg[o] = v[i].x * sc[i]; su[o] = v[i].y * sc[i]; sg[o + 1] = v[i].z * sc[i]; su[o + 1] = v[i].w * sc[i]; }
    LDS_WAIT(); asm volatile("" ::: "memory");
    const int c = lane & 3;
#pragma unroll
    for (int j = 0; j < 4; ++j) { const int q = (lane >> 2) + 16 * j, isup = q >> 5, jj = q & 31, A = A0 + jj; const LAS float* s = scr + isup * 32 * 33 + (8 * c) * 33 + jj;
        v2u o; o.x = pk4_fp8(s[0 * 33], s[1 * 33], s[2 * 33], s[3 * 33]); o.y = pk4_fp8(s[4 * 33], s[5 * 33], s[6 * 33], s[7 * 33]);
        *(GAS v2u*)(WT + (size_t)(256 * (A >> 7) + 128 * isup + gu_slot(A & 127)) * D + k0 + 8 * c) = o; }
    LDS_WAIT(); asm volatile("" ::: "memory");
}
__device__ __forceinline__ void px_experts(Frame& F, int rank, int nwg) {
    unsigned char* ws = F.ws;
    LAS float* scr = (LAS float*)(F.lds + RING_OFF + F.wave * 16384);
    const int gw = rank * NWAVES + F.wave, NGW = nwg * NWAVES;
    { constexpr int NIT = NE * 1024; f32x4 v[8], vn[8]; float sc[8], sn[8]; int it = gw;
      if (it < NIT) cvgu_load(F.in[IN_WGU], F.in[IN_NFFN], it, v, sc, F.lane);
      while (it < NIT) { const int nx = it + NGW; if (nx < NIT) cvgu_load(F.in[IN_WGU], F.in[IN_NFFN], nx, vn, sn, F.lane);
          asm volatile("" ::: "memory");
          cvgu_proc((unsigned char*)(ws + WS_WGU), it, v, sc, scr, F.lane); asm volatile("" ::: "memory");
#pragma unroll
          for (int i = 0; i < 8; ++i) { v[i] = vn[i]; sc[i] = sn[i]; }
          it = nx; } }
    { constexpr int NIT = NE * 512; f32x4 v[8], vn[8]; int it = gw;
      if (it < NIT) cvdn_load(F.in[IN_WDN], it, v, F.lane);
      while (it < NIT) { const int nx = it + NGW; if (nx < NIT) cvdn_load(F.in[IN_WDN], nx, vn, F.lane);
          asm volatile("" ::: "memory");
          cvdn_proc((unsigned char*)(ws + WS_WDN), it, v, scr, F.lane); asm volatile("" ::: "memory");
#pragma unroll
          for (int i = 0; i < 8; ++i) v[i] = vn[i];
          it = nx; } }
}

namespace pg8 {
typedef unsigned v2u_t __attribute__((ext_vector_type(2)));
typedef float f32x2 __attribute__((ext_vector_type(2)));
__device__ __forceinline__ f32x2 sig2(f32x2 x) { const f32x2 t = x * (f32x2){-1.4426950408889634f, -1.4426950408889634f};
    const f32x2 d = (f32x2){__builtin_amdgcn_exp2f(t.x), __builtin_amdgcn_exp2f(t.y)} + (f32x2){1.f, 1.f}; return (f32x2){__builtin_amdgcn_rcpf(d.x), __builtin_amdgcn_rcpf(d.y)}; }
__device__ __forceinline__ u32x4 pack8(const f32x4& a, const f32x4& b) { u32x4 w; w.x = cvt_pk_bf16(a[0], a[1]); w.y = cvt_pk_bf16(a[2], a[3]); w.z = cvt_pk_bf16(b[0], b[1]); w.w = cvt_pk_bf16(b[2], b[3]); return w; }
__device__ __forceinline__ v2u_t pack8_fp8(const f32x4& a, const f32x4& b) { unsigned lo = 0, hi = 0;
    lo = __builtin_amdgcn_cvt_pk_fp8_f32(a[0], a[1], lo, false); lo = __builtin_amdgcn_cvt_pk_fp8_f32(a[2], a[3], lo, true);
    hi = __builtin_amdgcn_cvt_pk_fp8_f32(b[0], b[1], hi, false); hi = __builtin_amdgcn_cvt_pk_fp8_f32(b[2], b[3], hi, true); return (v2u_t){lo, hi}; }
__device__ __forceinline__ v2u_t pack8_fp8_sat(const f32x4& a, const f32x4& b) { f32x4 x, y;
#pragma unroll
    for (int i = 0; i < 4; ++i) { x[i] = __builtin_amdgcn_fmed3f(a[i], -448.f, 448.f); y[i] = __builtin_amdgcn_fmed3f(b[i], -448.f, 448.f); }
    return pack8_fp8(x, y); }
__device__ __forceinline__ void unpack8(const u32x4& w, f32x4& a, f32x4& b) { a = (f32x4){bflo(w.x), bfhi(w.x), bflo(w.y), bfhi(w.y)}; b = (f32x4){bflo(w.z), bfhi(w.z), bflo(w.w), bfhi(w.w)}; }
__host__ __device__ __forceinline__ int gate_pos(int c) { return (c & ~255) + ((((c >> 5) & 3) * 4 + ((c >> 3) & 3)) * 16) + (((c >> 7) & 1) * 8) + (c & 7); }
__device__ __forceinline__ unsigned q8x4(float a, float b, float c, float d) {
    const unsigned t0 = __builtin_bit_cast(unsigned, __builtin_fmaf(a, 255.f, 8388608.f)), t1 = __builtin_bit_cast(unsigned, __builtin_fmaf(b, 255.f, 8388608.f));
    const unsigned t2 = __builtin_bit_cast(unsigned, __builtin_fmaf(c, 255.f, 8388608.f)), t3 = __builtin_bit_cast(unsigned, __builtin_fmaf(d, 255.f, 8388608.f));
    return (t0 & 0xffu) | (t1 << 8) | (t2 << 16) | (t3 << 24); }
__device__ __forceinline__ f32x4 dq8x4(unsigned w) { return (f32x4){(float)(w & 0xffu), (float)((w >> 8) & 0xffu), (float)((w >> 16) & 0xffu), (float)(w >> 24)}; }
struct EpiNull { static constexpr bool PERM = true, AFTER_DRAIN = false; int* sink;
    __device__ __forceinline__ void operator()(const f32x4 (&acc)[2][2][4][2], const Unit& u, int wr, int wc, int fr, int fq) const { int s = 0;
#pragma unroll
        for (int a = 0; a < 2; ++a)
#pragma unroll
            for (int b = 0; b < 2; ++b)
#pragma unroll
                for (int m = 0; m < 4; ++m)
#pragma unroll
                    for (int n = 0; n < 2; ++n) { const i32x4 q = __builtin_bit_cast(i32x4, acc[a][b][m][n]); s += (q[0] ^ q[1]) + (q[2] ^ q[3]); }
        if (s == 0x7fffff01 + u.pm) sink[0] = s; } };
template <bool Q, bool NS = false>
struct EpiProjT {
    static constexpr bool PERM = true, AFTER_DRAIN = false;
    unsigned char* ws; const float* lbl; const float* srow; const float* scol;
    struct Sc { float rs[8]; f32x2 cs[2][4]; };
    __device__ __forceinline__ f32x2 val(const f32x4 (&acc)[2][2][4][2], const Sc& sc, int ai, int bj, int m, int k) const {
        const f32x4 a = acc[ai][bj][m][k >> 1];
        if constexpr (Q) { const i32x4 q = __builtin_bit_cast(i32x4, a); const float r = sc.rs[ai * 4 + m]; return ((f32x2){(float)q[2 * (k & 1)], (float)q[2 * (k & 1) + 1]} * sc.cs[bj][k]) * (f32x2){r, r}; }
        else return (f32x2){a[2 * (k & 1)], a[2 * (k & 1) + 1]};
    }
    template <int ACT>
    __device__ __forceinline__ void emit(const f32x4 (&acc)[2][2][4][2], const Sc& sc, bf16_t* O, int row0, int colt) const {
#pragma unroll
        for (int ai = 0; ai < 2; ++ai)
#pragma unroll
            for (int m = 0; m < 4; ++m) { bf16_t* rowp = O + (size_t)(row0 + ai * HALF + m * 16) * HW + colt;
#pragma unroll
                for (int bj = 0; bj < 2; ++bj) { u32x4 o;
#pragma unroll
                    for (int k = 0; k < 4; ++k) { f32x2 p = val(acc, sc, ai, bj, m, k);
                        if constexpr (ACT == 1) p = p * sig2(p); else if constexpr (ACT == 2) p = sig2(p);
                        o[k] = cvt_pk_bf16(p.x, p.y); }
                    if constexpr (NS) asm volatile("" :: "v"(o.x), "v"(o.y), "v"(o.z), "v"(o.w)); else *(u32x4*)(rowp + bj * HALF) = o; } }
    }
    __device__ __forceinline__ void operator()(const f32x4 (&acc)[2][2][4][2], const Unit& u, int wr, int wc, int fr, int fq) const {
        const int row0 = u.pm * BM + wr * 64 + fr, kind = u.pn < 12 ? (u.pn >> 1) : 6;
        const int colt = (u.pn < 12 ? (u.pn & 1) : (u.pn - 12)) * BM + wc * 32 + 8 * fq;
        Sc sc;
        if constexpr (Q) {
#pragma unroll
            for (int it = 0; it < 8; ++it) sc.rs[it] = srow[row0 + (it >> 2) * HALF + (it & 3) * 16];
#pragma unroll
            for (int bj = 0; bj < 2; ++bj) { const float* cp = scol + u.pn * BM + wc * 32 + 8 * fq + bj * HALF; const f32x4 c0 = *(const f32x4*)cp, c1 = *(const f32x4*)(cp + 4);
                sc.cs[bj][0] = (f32x2){c0[0], c0[1]}; sc.cs[bj][1] = (f32x2){c0[2], c0[3]}; sc.cs[bj][2] = (f32x2){c1[0], c1[1]}; sc.cs[bj][3] = (f32x2){c1[2], c1[3]}; }
        }
        if (kind == 1) {
            bf16_t* HG = (bf16_t*)(ws + WS_HG);
#pragma unroll
            for (int bj = 0; bj < 2; ++bj) { const int c = colt + bj * HALF; f32x2 lb[4], ol[4];
#pragma unroll
                for (int k = 0; k < 4; ++k) { lb[k] = sig2((f32x2){lbl[c + 2 * k] - lbl[HW + c + 2 * k], lbl[c + 2 * k + 1] - lbl[HW + c + 2 * k + 1]}); ol[k] = (f32x2){1.f, 1.f} - lb[k]; }
#pragma unroll
                for (int ai = 0; ai < 2; ++ai)
#pragma unroll
                    for (int m = 0; m < 4; ++m) { u32x4 o;
#pragma unroll
                        for (int k = 0; k < 4; ++k) { const f32x2 f = ol[k] * sig2(val(acc, sc, ai, bj, m, k)) + lb[k];
                            const f32x2 lg = (f32x2){__builtin_amdgcn_logf(f.x), __builtin_amdgcn_logf(f.y)} * (f32x2){0.6931471805599453f, 0.6931471805599453f}; o[k] = cvt_pk_bf16(lg.x, lg.y); }
                        if constexpr (NS) asm volatile("" :: "v"(o.x), "v"(o.y), "v"(o.z), "v"(o.w)); else *(u32x4*)(HG + (size_t)(row0 + ai * HALF + m * 16) * HW + c) = o; } }
            return;
        }
        if (kind == 6) {
            unsigned char* G8 = ws + WS_GATES; const int gofs = (u.pn - 12) * BM + (wc * 4 + fq) * 16;
#pragma unroll
            for (int ai = 0; ai < 2; ++ai)
#pragma unroll
                for (int m = 0; m < 4; ++m) { u32x4 o;
#pragma unroll
                    for (int bj = 0; bj < 2; ++bj)
#pragma unroll
                        for (int h = 0; h < 2; ++h) {
                            const f32x2 sa = sig2(val(acc, sc, ai, bj, m, 2 * h)), sb = sig2(val(acc, sc, ai, bj, m, 2 * h + 1));
                            o[2 * bj + h] = q8x4(sa.x, sa.y, sb.x, sb.y); }
                    if constexpr (NS) asm volatile("" :: "v"(o.x), "v"(o.y), "v"(o.z), "v"(o.w)); else __builtin_nontemporal_store(o, (u32x4*)(G8 + (size_t)(row0 + ai * HALF + m * 16) * 2048 + gofs)); }
            return;
        }
        if (kind == 0) emit<1>(acc, sc, (bf16_t*)(ws + WS_HQ), row0, colt); else if (kind == 2) emit<0>(acc, sc, (bf16_t*)(ws + WS_HV), row0, colt); else if (kind == 3) emit<1>(acc, sc, (bf16_t*)(ws + WS_HGATE), row0, colt);
        else if (kind == 4) emit<0>(acc, sc, (bf16_t*)(ws + WS_MM), row0, colt); else emit<2>(acc, sc, (bf16_t*)(ws + WS_MO), row0, colt);
    }
};
constexpr int PAIR_DA = 132, PAIR_DB = 4;
struct PairOrder { StaticOrder S;
    __device__ __forceinline__ bool next(int i, Unit& u) const { Unit t; if (!S.next(i >> 1, t)) return false; const int s = i & 1; u.pm = t.pm + PAIR_DA * s; u.pn = t.pn + PAIR_DB * s; return true; }
    __device__ __forceinline__ void a_ready(const Unit&) const {}
    __device__ __forceinline__ void done(const Unit&) const {}
};
struct EpiGate2 {
    static constexpr bool PERM = true, AFTER_DRAIN = false;
    const unsigned char* __restrict__ gates; bf16_t* __restrict__ tmp; bf16_t* __restrict__ merged;
    __device__ __forceinline__ void operator()(const f32x4 (&acc)[2][2][4][2], const Unit& u, int wr, int wc, int fr, int fq) const {
        const int step = u.pm >= PAIR_DA ? 1 : 0, pm = u.pm - PAIR_DA * step, pn = u.pn - PAIR_DB * step;
        const int row0 = pm * BM + wr * 64 + fr, col0 = pn * BM + wc * 32 + 8 * fq, gofs = step * D + pn * BM + (wc * 4 + fq) * 16;
        constexpr int NB = 2, NBAT = 8 / NB;
        bf16_t* obuf = tmp + (ptrdiff_t)(merged - tmp) * step;
        u32x4 gc[NB], tc[NB][2], gn[NB], tn[NB][2];
#define EG_LOAD(G, T, b_) do { _Pragma("unroll") for (int s_ = 0; s_ < NB; ++s_) { const int it_ = (b_) * NB + s_; const size_t row_ = (size_t)(row0 + (it_ >> 2) * HALF + (it_ & 3) * 16); G[s_] = *(const u32x4*)(gates + row_ * 2048 + gofs); _Pragma("unroll") for (int bj = 0; bj < 2; ++bj) { \
        if (step) T[s_][bj] = *(const u32x4*)(tmp + row_ * D + col0 + bj * HALF); else T[s_][bj] = (u32x4){0u, 0u, 0u, 0u}; } } } while (0)
        EG_LOAD(gc, tc, 0);
#pragma unroll
        for (int b = 0; b < NBAT; ++b) {
            if (b + 1 < NBAT) EG_LOAD(gn, tn, b + 1);
#pragma unroll
            for (int s = 0; s < NB; ++s) { const int it = b * NB + s, ai = it >> 2, m = it & 3; const size_t row = (size_t)(row0 + ai * HALF + m * 16);
#pragma unroll
                for (int bj = 0; bj < 2; ++bj) { const int c = col0 + bj * HALF; f32x4 t0, t1; unpack8(tc[s][bj], t0, t1); const f32x4 g0 = dq8x4(gc[s][2 * bj]), g1 = dq8x4(gc[s][2 * bj + 1]);
                    const u32x4 o = pack8(acc[ai][bj][m][0] * g0 + t0, acc[ai][bj][m][1] * g1 + t1);
                    *(u32x4*)(obuf + row * D + c) = o; } }
#pragma unroll
            for (int s = 0; s < NB; ++s)
#pragma unroll
                for (int bj = 0; bj < 2; ++bj) tc[s][bj] = tn[s][bj];
#pragma unroll
            for (int s = 0; s < NB; ++s) gc[s] = gn[s]; }
#undef EG_LOAD
    }
};
struct EpiH1 {
    static constexpr bool PERM = true, AFTER_DRAIN = false;
    const bf16_t* __restrict__ xn0; const float* __restrict__ xsq; bf16_t* __restrict__ H1; unsigned char* __restrict__ H1B8;
    __device__ __forceinline__ void operator()(const f32x4 (&acc)[2][2][4][2], const Unit& u, int wr, int wc, int fr, int fq) const {
        const int row0 = u.pm * BM + wr * 64 + fr, col0 = u.pn * BM + wc * 32 + 8 * fq;
        u32x4 xc[2], xn[2]; float sc, sn;
#define EH_LOAD(X, S_, it_) do { const size_t r_ = (size_t)(row0 + ((it_) >> 2) * HALF + ((it_) & 3) * 16); const bf16_t* src_ = xn0 + r_ * D + col0; S_ = xsq[r_]; _Pragma("unroll") for (int bj = 0; bj < 2; ++bj) X[bj] = *(const u32x4*)(src_ + bj * HALF); } while (0)
        EH_LOAD(xc, sc, 0);
#pragma unroll
        for (int it = 0; it < 8; ++it) { const int ai = it >> 2, m = it & 3; const size_t V = (size_t)(row0 + ai * HALF + m * 16);
            if (it + 1 < 8) EH_LOAD(xn, sn, it + 1);
#pragma unroll
            for (int bj = 0; bj < 2; ++bj) { const int c = col0 + bj * HALF; f32x4 x0, x1; unpack8(xc[bj], x0, x1);
                const f32x4 v0 = x0 * sc + acc[ai][bj][m][0], v1 = x1 * sc + acc[ai][bj][m][1];
                __builtin_nontemporal_store(pack8(v0, v1), (u32x4*)(H1 + V * D + c)); *(v2u_t*)(H1B8 + V * D + c) = pack8_fp8_sat(v0, v1); }
#pragma unroll
            for (int bj = 0; bj < 2; ++bj) xc[bj] = xn[bj];
            sc = sn; }
#undef EH_LOAD
    }
};
template <bool NS = false>
struct EpiGUT {
    static constexpr bool PERM = true, AFTER_DRAIN = false;
    const float* __restrict__ bgup; const float* __restrict__ ers; unsigned char* __restrict__ act; const PG8_LAS int* pst;
    __device__ __forceinline__ void operator()(const f32x4 (&acc)[2][2][4][2], const Unit& u, int wr, int wc, int fr, int fq) const {
        const int e = u.pn >> 3, pn = u.pn & 7, row0 = u.pm * BM + wr * 64 + fr, cc = wc * 32 + 8 * fq;
        const float* rsp = ers + (size_t)e * NV + (row0 - pst[e]);
        const float* bp = bgup + (size_t)e * 2 * DFF + pn * BM + cc;
        f32x2 bg[2][2], bu[2][2];
#pragma unroll
        for (int h = 0; h < 2; ++h) { const f32x4 g4 = *(const f32x4*)(bp + 4 * h), u4 = *(const f32x4*)(bp + HALF + 4 * h);
            bg[h][0] = (f32x2){g4[0], g4[1]}; bg[h][1] = (f32x2){g4[2], g4[3]}; bu[h][0] = (f32x2){u4[0] + 1.f, u4[1] + 1.f}; bu[h][1] = (f32x2){u4[2] + 1.f, u4[3] + 1.f}; }
        float rsv[8];
#pragma unroll
        for (int it = 0; it < 8; ++it) rsv[it] = rsp[(it >> 2) * HALF + (it & 3) * 16];
        const int hi = fq >> 1;
        unsigned char* obase = act + (size_t)(row0 + 16 * hi) * DFF + pn * HALF + wc * 32 + 16 * (fq & 1);
        constexpr float KS = -1.702f * 1.4426950408889634f;
#pragma unroll
        for (int ai = 0; ai < 2; ++ai)
#pragma unroll
            for (int mp = 0; mp < 2; ++mp) { v2u_t pk[2];
#pragma unroll
                for (int q = 0; q < 2; ++q) { const int m = 2 * mp + q; const float rs = rsv[ai * 4 + m] * 0.03125f;
                    const f32x2 rs2 = {rs, rs}; unsigned w[2];
#pragma unroll
                    for (int h = 0; h < 2; ++h) { f32x2 o[2];
#pragma unroll
                        for (int p = 0; p < 2; ++p) {
                            f32x2 g = (f32x2){acc[ai][0][m][h][2 * p], acc[ai][0][m][h][2 * p + 1]} * rs2 + bg[h][p];
                            f32x2 u1 = (f32x2){acc[ai][1][m][h][2 * p], acc[ai][1][m][h][2 * p + 1]} * rs2 + bu[h][p];
                            g.x = fminf(g.x, 7.f); g.y = fminf(g.y, 7.f); u1.x = __builtin_amdgcn_fmed3f(u1.x, -6.f, 8.f); u1.y = __builtin_amdgcn_fmed3f(u1.y, -6.f, 8.f);
                            const f32x2 t = g * (f32x2){KS, KS};
                            const f32x2 d = (f32x2){__builtin_amdgcn_exp2f(t.x), __builtin_amdgcn_exp2f(t.y)} + (f32x2){1.f, 1.f};
                            const f32x2 r = {__builtin_amdgcn_rcpf(d.x), __builtin_amdgcn_rcpf(d.y)};
                            o[p] = (g * r) * u1; }
                        w[h] = __builtin_amdgcn_cvt_pk_fp8_f32(o[0].x, o[0].y, 0u, false); w[h] = __builtin_amdgcn_cvt_pk_fp8_f32(o[1].x, o[1].y, w[h], true); }
                    pk[q] = (v2u_t){w[0], w[1]}; }
                const auto r0 = __builtin_amdgcn_permlane32_swap(pk[0][0], pk[1][0], false, false), r1 = __builtin_amdgcn_permlane32_swap(pk[0][1], pk[1][1], false, false);
                if constexpr (NS) asm volatile("" :: "v"(r0[0]), "v"(r1[0]), "v"(r0[1]), "v"(r1[1])); else *(u32x4*)(obase + (size_t)(ai * HALF + mp * 32) * DFF) = (u32x4){r0[0], r1[0], r0[1], r1[1]}; }
    }
};
template <bool NS = false>
struct EpiDownT {
    static constexpr bool PERM = true, AFTER_DRAIN = false;
    const float* __restrict__ bdn; const float* __restrict__ ew; unsigned char* __restrict__ yb; const PG8_LAS int* pst;
    __device__ __forceinline__ void operator()(const f32x4 (&acc)[2][2][4][2], const Unit& u, int wr, int wc, int fr, int fq) const {
        const int e = u.pn >> 2, pn = u.pn & 3, row0 = u.pm * BM + wr * 64 + fr, col0 = pn * BM + wc * 64 + 16 * fq;
        const float* wp = ew + (size_t)e * NV + (row0 - pst[e]);
        f32x4 bv[2][2];
#pragma unroll
        for (int bj = 0; bj < 2; ++bj) { bv[bj][0] = *(const f32x4*)(bdn + (size_t)e * D + col0 + 8 * bj); bv[bj][1] = *(const f32x4*)(bdn + (size_t)e * D + col0 + 8 * bj + 4); }
        float wv[8];
#pragma unroll
        for (int it = 0; it < 8; ++it) wv[it] = wp[(it >> 2) * HALF + (it & 3) * 16];
#pragma unroll
        for (int ai = 0; ai < 2; ++ai)
#pragma unroll
            for (int m = 0; m < 4; ++m) { const size_t row = (size_t)(row0 + ai * HALF + m * 16); const float w = wv[ai * 4 + m] * 16.f;
                const v2u_t lo = pack8_fp8_sat((acc[ai][0][m][0] * 0.03125f + bv[0][0]) * w, (acc[ai][0][m][1] * 0.03125f + bv[0][1]) * w), hi = pack8_fp8_sat((acc[ai][1][m][0] * 0.03125f + bv[1][0]) * w, (acc[ai][1][m][1] * 0.03125f + bv[1][1]) * w);
                if constexpr (NS) asm volatile("" :: "v"(lo[0]), "v"(lo[1]), "v"(hi[0]), "v"(hi[1])); else __builtin_nontemporal_store((u32x4){lo[0], lo[1], hi[0], hi[1]}, (u32x4*)(yb + row * D + col0)); }
    }
};
struct GroupOrder {
    int ntiles, ncol, G, c; const PG8_LAS unsigned char* texp;
    __device__ __forceinline__ bool next(int i, Unit& u) const { const int x = c & 7, w = c >> 3, uu = i * (G >> 3) + w, lj = uu / ncol, pn = uu - lj * ncol, j = lj * 8 + x; if (j >= ntiles) return false; u.pm = j; u.pn = (int)texp[j] * ncol + pn; return true; }
    __device__ __forceinline__ void a_ready(const Unit&) const {}
    __device__ __forceinline__ void done(const Unit&) const {}
};
typedef EpiDownT<false> EpiDown; typedef EpiGUT<false> EpiGU;
}

typedef short bf16x8 __attribute__((ext_vector_type(8)));
typedef float f32x16 __attribute__((ext_vector_type(16)));
#define MFMA32(a, b, c) __builtin_amdgcn_mfma_f32_32x32x16_bf16(a, b, c, 0, 0, 0)
__device__ __forceinline__ bf16x8 ldfrag(const LAS unsigned char* base, int st, int row0, int k0, int lane) { return *(const LAS bf16x8*)(base + (row0 + (lane & 31)) * st + (k0 + 8 * (lane >> 5)) * 2); }
__device__ __forceinline__ bf16x8 ldf(const LAS unsigned char* lanebase, int off) { return *(const LAS bf16x8*)(lanebase + off); }
__device__ __forceinline__ float fexp(float x) { return __builtin_amdgcn_exp2f(x * 1.4426950408889634f); }

__device__ __forceinline__ void p3_hgrn2_mfma(Frame& F, int bh) {
    unsigned char* ws = F.ws; const int b = bh >> 2, h = bh & 3, tid = F.tid, lane = F.lane, wave = F.wave, hh = lane >> 5, l31 = lane & 31;
    const bf16* HQ = (const bf16*)(ws + WS_HQ) + h * 128; const bf16* HG = (const bf16*)(ws + WS_HG) + h * 128; const bf16* HV = (const bf16*)(ws + WS_HV) + h * 128;
    const bf16* HGATE = (const bf16*)(ws + WS_HGATE) + h * 128; bf16* YHG = (bf16*)(ws + WS_YHG) + h * 128;
    LAS unsigned char* L = F.lds + RING_OFF;
    LAS unsigned char* QT = L; LAS unsigned char* KT = L + 17408; LAS unsigned char* KTT = L + 34816; LAS unsigned char* VT = L + 53248; LAS unsigned char* ST = L + 71680; LAS unsigned char* PP = L + 106496;
    LAS float* SEG = (LAS float*)(L + 115712); LAS float* ER = (LAS float*)(L + 117760); LAS float* EL = (LAS float*)(L + 118272); LAS float* OST = (LAS float*)(L + 17408);
    const int d = tid & 127, pq = tid >> 7;
    const int et = tid >> 3, evq = tid & 7;
    const int f144 = l31 * 144 + hh * 16, f272 = l31 * 272 + hh * 16;
    const int sst = wave == 2 ? 1 : 0, stt = wave == 0 ? 0 : 1, dt = wave & 3, vt0 = 2 * (wave >> 2), btt = wave & 1, bvt = wave >> 1;
    const LAS unsigned char* aK = KT + 32 * sst * 272 + f272; const LAS unsigned char* bQ = QT + 32 * stt * 272 + f272;
    LAS unsigned char* pst = PP + (32 * stt + l31) * 144 + (32 * sst + 4 * hh) * 2;
    const LAS unsigned char* aKTT = KTT + 32 * dt * 144 + f144; const LAS unsigned char* bV0 = VT + 32 * vt0 * 144 + f144;
    LAS unsigned char* sst_ = ST + (32 * vt0 + l31) * 272 + (32 * dt + 4 * hh) * 2;
    const LAS float* erp = ER + 32 * dt + 4 * hh; const LAS float* elp = EL + 32 * dt + 4 * hh;
    const LAS unsigned char* aP = PP + 32 * btt * 144 + f144; const LAS unsigned char* bVB = VT + 32 * bvt * 144 + f144;
    const LAS unsigned char* aQ = QT + 32 * btt * 272 + f272; const LAS unsigned char* bS = ST + 32 * bvt * 272 + f272;
    LAS float* ost = OST + (32 * btt + 4 * hh) * 132 + 32 * bvt + l31; const LAS float* oep = OST + et * 132 + 16 * evq;
    LAS unsigned char* tq = QT + 16 * pq * 272 + d * 2; LAS unsigned char* tk = KT + 16 * pq * 272 + d * 2; LAS unsigned char* tkt = KTT + d * 144 + pq * 32; LAS unsigned char* tv = VT + d * 144 + pq * 32;
    f32x16 S0, S1;
#pragma unroll
    for (int i = 0; i < 16; ++i) { S0[i] = 0.f; S1[i] = 0.f; }
    unsigned gr[16], qr[16], vr[16]; v4u gt0, gt1;
    float gn[16];
#pragma unroll
    for (int i = 0; i < 16; ++i) gn[i] = F.in[IN_HGNORM][h * 128 + 16 * evq + i];
#define HG_LOAD(c) do { const int ttb = 64 * (c) - 48 + 16 * pq; \
        _Pragma("unroll") for (int i = 0; i < 16; ++i) { const int tt = ttb + i; if (tt >= 0) { const size_t gi = rowof(b, tt) * HW + d; gr[i] = (unsigned)HG[gi]; qr[i] = (unsigned)HQ[gi]; vr[i] = (unsigned)HV[gi]; } else { gr[i] = 0u; qr[i] = 0u; vr[i] = 0u; } } \
        { const int tt = 64 * (c) - 48 + et; if (tt >= 0) { const GAS v4u* gp = (const GAS v4u*)(HGATE + rowof(b, tt) * HW + 16 * evq); gt0 = gp[0]; gt1 = gp[1]; } else { gt0 = (v4u){0u, 0u, 0u, 0u}; gt1 = gt0; } } } while (0)
    HG_LOAD(0);
    for (int c = 0; c < 33; ++c) {
        float bl[16], gq[16];
#pragma unroll
        for (int i = 0; i < 16; ++i) gq[i] = __builtin_bit_cast(float, gr[i] << 16);
        { float a = 0.f;
#pragma unroll
          for (int i = 0; i < 16; ++i) { a += gq[i]; bl[i] = a; } }
        SEG[pq * 128 + d] = bl[15];
        __syncthreads();
        { const float s0 = SEG[d], s1 = SEG[128 + d], s2 = SEG[256 + d], s3 = SEG[384 + d];
          const float off = pq == 0 ? 0.f : pq == 1 ? s0 : pq == 2 ? s0 + s1 : (s0 + s1) + s2, r = s0 + s1, blast = (s0 + s1) + (s2 + s3);
          unsigned kp[8], vp[8];
#pragma unroll
          for (int i = 0; i < 16; i += 2) {
              const float b0 = off + bl[i], b1 = off + bl[i + 1];
              const float q0 = __builtin_bit_cast(float, qr[i] << 16) * fexp(b0 - r), q1 = __builtin_bit_cast(float, qr[i + 1] << 16) * fexp(b1 - r);
              const float k0 = (1.f - fexp(gq[i])) * fexp(r - b0), k1 = (1.f - fexp(gq[i + 1])) * fexp(r - b1);
              const unsigned kk = pg8::cvt_pk_bf16(k0, k1), qq = pg8::cvt_pk_bf16(q0, q1);
              *(LAS unsigned short*)(tq + i * 272) = (unsigned short)qq; *(LAS unsigned short*)(tq + (i + 1) * 272) = (unsigned short)(qq >> 16);
              *(LAS unsigned short*)(tk + i * 272) = (unsigned short)kk; *(LAS unsigned short*)(tk + (i + 1) * 272) = (unsigned short)(kk >> 16);
              kp[i >> 1] = kk; vp[i >> 1] = vr[i] | (vr[i + 1] << 16); }
          *(LAS v4u*)(tkt) = (v4u){kp[0], kp[1], kp[2], kp[3]}; *(LAS v4u*)(tkt + 16) = (v4u){kp[4], kp[5], kp[6], kp[7]};
          *(LAS v4u*)(tv) = (v4u){vp[0], vp[1], vp[2], vp[3]}; *(LAS v4u*)(tv + 16) = (v4u){vp[4], vp[5], vp[6], vp[7]};
          if (pq == 0) { ER[d] = fexp(r); EL[d] = fexp(blast - r); } }
        const v4u g0 = gt0, g1 = gt1;
        __syncthreads();
        if (c + 1 < 33) HG_LOAD(c + 1);
        asm volatile("" ::: "memory");
        if (wave < 3) {
            f32x16 acc;
#pragma unroll
            for (int i = 0; i < 16; ++i) acc[i] = 0.f;
#pragma unroll
            for (int ks = 0; ks < 8; ++ks) acc = MFMA32(ldf(aK, 32 * ks), ldf(bQ, 32 * ks), acc);
            const int t = 32 * stt + l31;
#pragma unroll
            for (int g4 = 0; g4 < 4; ++g4) { const int s0 = 32 * sst + 8 * g4 + 4 * hh;
                const float x0 = (s0 + 0 <= t) ? acc[4 * g4 + 0] : 0.f, x1 = (s0 + 1 <= t) ? acc[4 * g4 + 1] : 0.f, x2 = (s0 + 2 <= t) ? acc[4 * g4 + 2] : 0.f, x3 = (s0 + 3 <= t) ? acc[4 * g4 + 3] : 0.f;
                *(LAS v2u*)(pst + 16 * g4) = (v2u){pg8::cvt_pk_bf16(x0, x1), pg8::cvt_pk_bf16(x2, x3)}; }
        }
        {
#pragma unroll
          for (int g4 = 0; g4 < 4; ++g4) { const f32x4 er = *(const LAS f32x4*)(erp + 8 * g4);
#pragma unroll
              for (int i = 0; i < 4; ++i) { S0[4 * g4 + i] *= er[i]; S1[4 * g4 + i] *= er[i]; }
              *(LAS v2u*)(sst_ + 16 * g4) = (v2u){pg8::cvt_pk_bf16(S0[4 * g4], S0[4 * g4 + 1]), pg8::cvt_pk_bf16(S0[4 * g4 + 2], S0[4 * g4 + 3])};
              *(LAS v2u*)(sst_ + 32 * 272 + 16 * g4) = (v2u){pg8::cvt_pk_bf16(S1[4 * g4], S1[4 * g4 + 1]), pg8::cvt_pk_bf16(S1[4 * g4 + 2], S1[4 * g4 + 3])}; }
#pragma unroll
          for (int ks = 0; ks < 4; ++ks) { const bf16x8 a = ldf(aKTT, 32 * ks); S0 = MFMA32(a, ldf(bV0, 32 * ks), S0); S1 = MFMA32(a, ldf(bV0, 32 * 144 + 32 * ks), S1); }
#pragma unroll
          for (int g4 = 0; g4 < 4; ++g4) { const f32x4 el = *(const LAS f32x4*)(elp + 8 * g4);
#pragma unroll
              for (int i = 0; i < 4; ++i) { S0[4 * g4 + i] *= el[i]; S1[4 * g4 + i] *= el[i]; } } }
        __syncthreads();
        { f32x16 acc;
#pragma unroll
          for (int i = 0; i < 16; ++i) acc[i] = 0.f;
#pragma unroll
          for (int ks = 0; ks < 4; ++ks) if (ks < 2 || btt == 1) acc = MFMA32(ldf(aP, 32 * ks), ldf(bVB, 32 * ks), acc);
#pragma unroll
          for (int ks = 0; ks < 8; ++ks) acc = MFMA32(ldf(aQ, 32 * ks), ldf(bS, 32 * ks), acc);
#pragma unroll
          for (int i = 0; i < 16; ++i) ost[((i & 3) + 8 * (i >> 2)) * 132] = acc[i]; }
        __syncthreads();
        { const int tt = 64 * c - 48 + et;
          f32x4 o[4]; float ss = 0.f;
#pragma unroll
          for (int j = 0; j < 4; ++j) { o[j] = *(const LAS f32x4*)(oep + 4 * j); ss += (o[j].x * o[j].x + o[j].y * o[j].y) + (o[j].z * o[j].z + o[j].w * o[j].w); }
          ss += __shfl_xor(ss, 1); ss += __shfl_xor(ss, 2); ss += __shfl_xor(ss, 4);
          const float rs = 1.0f / sqrtf(ss * (1.f / 128.f) + EPS);
          if (tt >= NMETA || (tt >= 0 && b == 0)) { const unsigned gw[8] = {g0.x, g0.y, g0.z, g0.w, g1.x, g1.y, g1.z, g1.w}; unsigned w[8];
#pragma unroll
              for (int j = 0; j < 4; ++j) { w[2 * j] = pk2(o[j].x * rs * gn[4 * j] * bflo(gw[2 * j]), o[j].y * rs * gn[4 * j + 1] * bfhi(gw[2 * j])); w[2 * j + 1] = pk2(o[j].z * rs * gn[4 * j + 2] * bflo(gw[2 * j + 1]), o[j].w * rs * gn[4 * j + 3] * bfhi(gw[2 * j + 1])); }
              GAS v4u* yp = (GAS v4u*)(YHG + rowof(b, tt) * HW + 16 * evq); yp[0] = (v4u){w[0], w[1], w[2], w[3]}; yp[1] = (v4u){w[4], w[5], w[6], w[7]}; } }
        __syncthreads();
    }
#undef HG_LOAD
}


#define DPP_F(old, v, ctrl, rmask) __builtin_bit_cast(float, __builtin_amdgcn_update_dpp(__builtin_bit_cast(int, (float)(old)), __builtin_bit_cast(int, (float)(v)), (ctrl), (rmask), 0xf, false))
__device__ __forceinline__ float wave_scan_add(float v) {
    v += DPP_F(0.f, v, 0x111, 0xf); v += DPP_F(0.f, v, 0x112, 0xf); v += DPP_F(0.f, v, 0x114, 0xf); v += DPP_F(0.f, v, 0x118, 0xf);
    v += DPP_F(0.f, v, 0x142, 0xa); v += DPP_F(0.f, v, 0x143, 0xc); return v;
}
__device__ __forceinline__ float wave_scan_max(float v) {
    const float ni = -INFINITY;
    v = fmaxf(v, DPP_F(ni, v, 0x111, 0xf)); v = fmaxf(v, DPP_F(ni, v, 0x112, 0xf)); v = fmaxf(v, DPP_F(ni, v, 0x114, 0xf)); v = fmaxf(v, DPP_F(ni, v, 0x118, 0xf));
    v = fmaxf(v, DPP_F(ni, v, 0x142, 0xa)); v = fmaxf(v, DPP_F(ni, v, 0x143, 0xc)); return v;
}
__device__ __forceinline__ void p3_mlstm_mfma(Frame& F, int bh) {
    unsigned char* ws = F.ws; const int b = bh >> 2, h = bh & 3, tid = F.tid, lane = F.lane, wave = F.wave, hh = lane >> 5, l31 = lane & 31;
    const bf16* MMg = (const bf16*)(ws + WS_MM) + h * 128; const bf16* MOg = (const bf16*)(ws + WS_MO) + h * 128; const float* LI = (const float*)(ws + WS_LI) + h; const float* LF = (const float*)(ws + WS_LF) + h;
    bf16* YML = (bf16*)(ws + WS_YML) + h * 128;
    LAS unsigned char* L = F.lds + RING_OFF;
    LAS unsigned char* CT = L; LAS unsigned char* MT = L + 17408; LAS unsigned char* KM = L + 34816; LAS unsigned char* KW = L + 44032; LAS unsigned char* QM = L + 53248; LAS unsigned char* QW = L + 62464;
    LAS unsigned char* VT = L + 71680; LAS unsigned char* SV = L + 90112; LAS unsigned char* PP = L + 108544; LAS float* OST = (LAS float*)(L + 17408);
    LAS float* SM = (LAS float*)(L + 117760);
    LAS float* U = SM; LAS float* MX = SM + 64; LAS float* BB = SM + 128; LAS float* WSs = SM + 192; LAS float* WI = SM + 256; LAS float* DENP = SM + 320  ; LAS float* NN = SM + 416; LAS float* DENI = SM + 480; LAS float* SC = SM + 544  ; LAS float* GNS = SM + 560  ;
    const int ch = tid & 127, pq = tid >> 7, et = tid >> 3, evq = tid & 7;
    const int f144 = l31 * 144 + hh * 16, f272 = l31 * 272 + hh * 16;
    const int sst = wave == 2 ? 1 : 0, stt = wave == 0 ? 0 : 1, dkt = wave & 1, svt = wave >> 1;
    const LAS unsigned char* cfp = (wave < 4 ? CT : MT) + f272;
    LAS unsigned char* qst = QM + l31 * 144 + (32 * (wave & 1) + 4 * hh) * 2; LAS unsigned char* qwst = QW + l31 * 144 + (32 * (wave & 1) + 4 * hh) * 2;
    const int kdk = 32 * (wave & 1) + l31;
    LAS unsigned char* kmst = KM + 4 * hh * 144 + kdk * 2; LAS unsigned char* kwst = KW + kdk * 144 + 4 * hh * 2; const LAS float* wsp = WSs + 4 * hh;
    LAS unsigned char* vst = VT + (32 * (wave & 3) + l31) * 144 + 4 * hh * 2;
    const LAS unsigned char* aKM = KM + 32 * sst * 144 + f144; const LAS unsigned char* bQM = QM + 32 * stt * 144 + f144;
    LAS unsigned char* pst = PP + (32 * stt + l31) * 144 + (32 * sst + 4 * hh) * 2; const LAS float* up = U + 32 * sst + 4 * hh;
    LAS unsigned char* svst = SV + (32 * svt + l31) * 144 + (32 * dkt + 4 * hh) * 2;
    const LAS unsigned char* aKW = KW + 32 * dkt * 144 + f144; const LAS unsigned char* bVT = VT + 32 * svt * 144 + f144;
    const LAS unsigned char* aP = PP + 32 * dkt * 144 + f144; const LAS unsigned char* aQW = QW + 32 * dkt * 144 + f144; const LAS unsigned char* bSV = SV + 32 * svt * 144 + f144;
    LAS float* ost = OST + (32 * dkt + 4 * hh) * 132 + 32 * svt + l31; const LAS float* oep = OST + et * 132 + 16 * evq;
    LAS unsigned char* tc = CT + 16 * pq * 272 + ch * 2; LAS unsigned char* tm = MT + 16 * pq * 272 + ch * 2;
    bf16x8 wf[8];
    { const float* W = wave < 2 ? F.in[IN_WQ] + (size_t)h * 128 * 64 + 32 * wave + l31 : wave < 4 ? F.in[IN_WK] + (size_t)h * 128 * 64 + 32 * (wave - 2) + l31 : F.in[IN_WV] + (size_t)h * 128 * 128 + 32 * (wave - 4) + l31;
      const int ld = wave < 4 ? 64 : 128; const float sc = wave < 2 ? 0.125f : 1.f;
#pragma unroll
      for (int ks = 0; ks < 8; ++ks) { unsigned p[4];
#pragma unroll
          for (int j = 0; j < 4; ++j) p[j] = pk2(W[(size_t)(16 * ks + 8 * hh + 2 * j) * ld] * sc, W[(size_t)(16 * ks + 8 * hh + 2 * j + 1) * ld] * sc);
          wf[ks] = __builtin_bit_cast(bf16x8, (v4u){p[0], p[1], p[2], p[3]}); } }
    float cw[4]; const float cb = F.in[IN_CONVB][h * 128 + ch];
#pragma unroll
    for (int j = 0; j < 4; ++j) cw[j] = F.in[IN_CONVW][j * HW + h * 128 + ch];
    if (tid < 128) GNS[tid] = F.in[IN_MLNORM][h * 128 + tid]; else if (tid < 256) GNS[tid] = F.in[IN_MLSKIP][h * 128 + tid - 128];
    f32x16 S;
#pragma unroll
    for (int i = 0; i < 16; ++i) S[i] = 0.f;
    float mcar = 0.f, nreg = 0.f;
    unsigned mr[19]; v4u gt0, gt1; float pli = 0.f, plf = 0.f;
#define ML_LOAD(c) do { const int ttb = 64 * (c) - 48 + 16 * pq - 3; \
        _Pragma("unroll") for (int i = 0; i < 19; ++i) { const int tt = ttb + i; mr[i] = tt >= 0 ? (unsigned)MMg[rowof(b, tt) * HW + ch] : 0u; } \
        { const int tt = 64 * (c) - 48 + et; if (tt >= 0) { const GAS v4u* gp = (const GAS v4u*)(MOg + rowof(b, tt) * HW + 16 * evq); gt0 = gp[0]; gt1 = gp[1]; } else { gt0 = (v4u){0u, 0u, 0u, 0u}; gt1 = gt0; } } \
        if (wave == 0) { const int tt = 64 * (c) - 48 + lane; if (tt >= 0) { pli = LI[rowof(b, tt) * 4]; plf = LF[rowof(b, tt) * 4]; } else { pli = -1e30f; plf = 0.f; } } } while (0)
    ML_LOAD(0);
    for (int c = 0; c < 33; ++c) {
#pragma unroll
        for (int i = 0; i < 16; ++i) { const float a = cb + (cw[0] * __builtin_bit_cast(float, mr[i] << 16) + cw[1] * __builtin_bit_cast(float, mr[i + 1] << 16)) + (cw[2] * __builtin_bit_cast(float, mr[i + 2] << 16) + cw[3] * __builtin_bit_cast(float, mr[i + 3] << 16));
            *(LAS unsigned short*)(tc + i * 272) = (unsigned short)f2bf(fsilu(a)); *(LAS unsigned short*)(tm + i * 272) = (unsigned short)mr[i + 3]; }
        if (wave == 0) {
            const float bs = wave_scan_add(plf);
            const float u = pli - bs; const float pm = wave_scan_max(u);
            const float M = fmaxf(mcar, pm), M63 = __shfl(M, 63), b63 = __shfl(bs, 63);
            U[lane] = u; MX[lane] = M; BB[lane] = bs; WSs[lane] = fexp(u - M63); WI[lane] = fexp(mcar - M);
            if (lane == 0) { SC[0] = b63; SC[1] = M63; }
        }
        __syncthreads();
        { f32x16 a0, a1;
#pragma unroll
          for (int i = 0; i < 16; ++i) { a0[i] = 0.f; a1[i] = 0.f; }
          if (wave < 2) {
#pragma unroll
              for (int ks = 0; ks < 8; ++ks) { a0 = MFMA32(wf[ks], ldf(cfp, 32 * ks), a0); a1 = MFMA32(wf[ks], ldf(cfp, 32 * 272 + 32 * ks), a1); }
              const float wi0 = WI[l31], wi1 = WI[32 + l31];
#pragma unroll
              for (int g4 = 0; g4 < 4; ++g4) {
                  *(LAS v2u*)(qst + 16 * g4) = (v2u){pg8::cvt_pk_bf16(a0[4 * g4], a0[4 * g4 + 1]), pg8::cvt_pk_bf16(a0[4 * g4 + 2], a0[4 * g4 + 3])};
                  *(LAS v2u*)(qst + 32 * 144 + 16 * g4) = (v2u){pg8::cvt_pk_bf16(a1[4 * g4], a1[4 * g4 + 1]), pg8::cvt_pk_bf16(a1[4 * g4 + 2], a1[4 * g4 + 3])};
                  *(LAS v2u*)(qwst + 16 * g4) = (v2u){pg8::cvt_pk_bf16(a0[4 * g4] * wi0, a0[4 * g4 + 1] * wi0), pg8::cvt_pk_bf16(a0[4 * g4 + 2] * wi0, a0[4 * g4 + 3] * wi0)};
                  *(LAS v2u*)(qwst + 32 * 144 + 16 * g4) = (v2u){pg8::cvt_pk_bf16(a1[4 * g4] * wi1, a1[4 * g4 + 1] * wi1), pg8::cvt_pk_bf16(a1[4 * g4 + 2] * wi1, a1[4 * g4 + 3] * wi1)}; }
          } else {
#pragma unroll
              for (int ks = 0; ks < 8; ++ks) { a0 = MFMA32(ldf(cfp, 32 * ks), wf[ks], a0); a1 = MFMA32(ldf(cfp, 32 * 272 + 32 * ks), wf[ks], a1); }
              if (wave < 4) {
                  float nsum = 0.f;
#pragma unroll
                  for (int g4 = 0; g4 < 4; ++g4) { const f32x4 w0 = *(const LAS f32x4*)(wsp + 8 * g4), w1 = *(const LAS f32x4*)(wsp + 32 + 8 * g4);
#pragma unroll
                      for (int i = 0; i < 4; ++i) { *(LAS unsigned short*)(kmst + (8 * g4 + i) * 144) = (unsigned short)f2bf(a0[4 * g4 + i]); *(LAS unsigned short*)(kmst + (32 + 8 * g4 + i) * 144) = (unsigned short)f2bf(a1[4 * g4 + i]); }
                      const float x0 = a0[4 * g4] * w0[0], x1 = a0[4 * g4 + 1] * w0[1], x2 = a0[4 * g4 + 2] * w0[2], x3 = a0[4 * g4 + 3] * w0[3];
                      const float y0 = a1[4 * g4] * w1[0], y1 = a1[4 * g4 + 1] * w1[1], y2 = a1[4 * g4 + 2] * w1[2], y3 = a1[4 * g4 + 3] * w1[3];
                      nsum += ((x0 + x1) + (x2 + x3)) + ((y0 + y1) + (y2 + y3));
                      *(LAS v2u*)(kwst + 16 * g4) = (v2u){pg8::cvt_pk_bf16(x0, x1), pg8::cvt_pk_bf16(x2, x3)};
                      *(LAS v2u*)(kwst + 64 + 16 * g4) = (v2u){pg8::cvt_pk_bf16(y0, y1), pg8::cvt_pk_bf16(y2, y3)}; }
                  nsum += __shfl_xor(nsum, 32);
                  if (hh == 0) NN[kdk] = nreg;
                  nreg = fexp(mcar - SC[1]) * nreg + nsum;
              } else {
#pragma unroll
                  for (int g4 = 0; g4 < 4; ++g4) {
                      *(LAS v2u*)(vst + 16 * g4) = (v2u){pg8::cvt_pk_bf16(a0[4 * g4], a0[4 * g4 + 1]), pg8::cvt_pk_bf16(a0[4 * g4 + 2], a0[4 * g4 + 3])};
                      *(LAS v2u*)(vst + 64 + 16 * g4) = (v2u){pg8::cvt_pk_bf16(a1[4 * g4], a1[4 * g4 + 1]), pg8::cvt_pk_bf16(a1[4 * g4 + 2], a1[4 * g4 + 3])}; }
              }
          } }
        __syncthreads();
        const v4u g0 = gt0, g1 = gt1;
        if (c + 1 < 33) ML_LOAD(c + 1);
        asm volatile("" ::: "memory");
        if (wave < 3) {
            f32x16 acc;
#pragma unroll
            for (int i = 0; i < 16; ++i) acc[i] = 0.f;
#pragma unroll
            for (int ks = 0; ks < 4; ++ks) acc = MFMA32(ldf(aKM, 32 * ks), ldf(bQM, 32 * ks), acc);
            const int t = 32 * stt + l31; const float mt = MX[t]; float dsum = 0.f;
#pragma unroll
            for (int g4 = 0; g4 < 4; ++g4) { const int s0 = 32 * sst + 8 * g4 + 4 * hh; const f32x4 us = *(const LAS f32x4*)(up + 8 * g4);
                const float x0 = (s0 + 0 <= t) ? acc[4 * g4 + 0] * fexp(us[0] - mt) : 0.f, x1 = (s0 + 1 <= t) ? acc[4 * g4 + 1] * fexp(us[1] - mt) : 0.f;
                const float x2 = (s0 + 2 <= t) ? acc[4 * g4 + 2] * fexp(us[2] - mt) : 0.f, x3 = (s0 + 3 <= t) ? acc[4 * g4 + 3] * fexp(us[3] - mt) : 0.f;
                dsum += (x0 + x1) + (x2 + x3);
                *(LAS v2u*)(pst + 16 * g4) = (v2u){pg8::cvt_pk_bf16(x0, x1), pg8::cvt_pk_bf16(x2, x3)}; }
            dsum += __shfl_xor(dsum, 32);
            if (hh == 0) DENP[wave * 32 + l31] = dsum;
        } else if (wave == 3) {
            float a = 0.f;
#pragma unroll 2
            for (int j = 0; j < 8; ++j) { const v4u q = *(const LAS v4u*)(QW + lane * 144 + 16 * j); const f32x4 n0 = *(const LAS f32x4*)(NN + 8 * j), n1 = *(const LAS f32x4*)(NN + 8 * j + 4);
                a += (bflo(q.x) * n0[0] + bfhi(q.x) * n0[1]) + (bflo(q.y) * n0[2] + bfhi(q.y) * n0[3]) + (bflo(q.z) * n1[0] + bfhi(q.z) * n1[1]) + (bflo(q.w) * n1[2] + bfhi(q.w) * n1[3]); }
            DENI[lane] = a;
        }
        { const float wp = fexp(mcar - SC[1]);
#pragma unroll
          for (int g4 = 0; g4 < 4; ++g4) {
              *(LAS v2u*)(svst + 16 * g4) = (v2u){pg8::cvt_pk_bf16(S[4 * g4], S[4 * g4 + 1]), pg8::cvt_pk_bf16(S[4 * g4 + 2], S[4 * g4 + 3])};
#pragma unroll
              for (int i = 0; i < 4; ++i) S[4 * g4 + i] *= wp; }
#pragma unroll
          for (int ks = 0; ks < 4; ++ks) S = MFMA32(ldf(aKW, 32 * ks), ldf(bVT, 32 * ks), S); }
        __syncthreads();
        { f32x16 acc;
#pragma unroll
          for (int i = 0; i < 16; ++i) acc[i] = 0.f;
#pragma unroll
          for (int ks = 0; ks < 4; ++ks) if (ks < 2 || dkt == 1) acc = MFMA32(ldf(aP, 32 * ks), ldf(bVT, 32 * ks), acc);
#pragma unroll
          for (int ks = 0; ks < 4; ++ks) acc = MFMA32(ldf(aQW, 32 * ks), ldf(bSV, 32 * ks), acc);
#pragma unroll
          for (int i = 0; i < 16; ++i) ost[((i & 3) + 8 * (i >> 2)) * 132] = acc[i]; }
        __syncthreads();
        { const int tt = 64 * c - 48 + et;
          const float den = (et < 32 ? DENP[et] : DENP[et] + DENP[32 + et]) + DENI[et];
          const float inv = 1.0f / fmaxf(fabsf(den), fexp(-(BB[et] + MX[et])));
          f32x4 o[4]; float ss = 0.f;
#pragma unroll
          for (int j = 0; j < 4; ++j) { o[j] = *(const LAS f32x4*)(oep + 4 * j) * inv; ss += (o[j].x * o[j].x + o[j].y * o[j].y) + (o[j].z * o[j].z + o[j].w * o[j].w); }
          ss += __shfl_xor(ss, 1); ss += __shfl_xor(ss, 2); ss += __shfl_xor(ss, 4);
          const float rs = 1.0f / sqrtf(ss * (1.f / 128.f) + EPS);
          if (tt >= NMETA || (tt >= 0 && b == 0)) { const unsigned gw[8] = {g0.x, g0.y, g0.z, g0.w, g1.x, g1.y, g1.z, g1.w}; unsigned w[8];
              const v4u c0 = *(const LAS v4u*)(CT + et * 272 + 32 * evq), c1 = *(const LAS v4u*)(CT + et * 272 + 32 * evq + 16); const unsigned cwd[8] = {c0.x, c0.y, c0.z, c0.w, c1.x, c1.y, c1.z, c1.w};
#pragma unroll
              for (int j = 0; j < 4; ++j) { const f32x4 gn = *(const LAS f32x4*)(GNS + 16 * evq + 4 * j), sk = *(const LAS f32x4*)(GNS + 128 + 16 * evq + 4 * j);
                  w[2 * j] = pk2((o[j].x * rs * gn[0] + sk[0] * bflo(cwd[2 * j])) * bflo(gw[2 * j]), (o[j].y * rs * gn[1] + sk[1] * bfhi(cwd[2 * j])) * bfhi(gw[2 * j]));
                  w[2 * j + 1] = pk2((o[j].z * rs * gn[2] + sk[2] * bflo(cwd[2 * j + 1])) * bflo(gw[2 * j + 1]), (o[j].w * rs * gn[3] + sk[3] * bfhi(cwd[2 * j + 1])) * bfhi(gw[2 * j + 1])); }
              GAS v4u* yp = (GAS v4u*)(YML + rowof(b, tt) * HW + 16 * evq); yp[0] = (v4u){w[0], w[1], w[2], w[3]}; yp[1] = (v4u){w[4], w[5], w[6], w[7]}; }
          mcar = SC[0] + SC[1]; }
        __syncthreads();
    }
#undef ML_LOAD
}

typedef float f32x4v __attribute__((ext_vector_type(4)));
#define MFMA16F(a, b, c) __builtin_amdgcn_mfma_f32_16x16x4f32(a, b, c, 0, 0, 0)
constexpr int RW_LD = 516;
__device__ __forceinline__ void router_topk16(LAS float* LGw, int V, float rsv, int resrow, int lane, LAS int* hist, LAS int* res, int* TOPE, float* TOPW, float* RS) {
    if (lane < 16) {
        int se[4]; float sv[4];
#pragma unroll
        for (int k = 0; k < 4; ++k) { float best = -INFINITY; int bi = 0;
            for (int e = 0; e < 32; ++e) { const float v = LGw[lane * 33 + e]; if (v > best) { best = v; bi = e; } }
            se[k] = bi; sv[k] = best; LGw[lane * 33 + bi] = -INFINITY; }
        const float e1 = __expf(sv[1] - sv[0]), e2 = __expf(sv[2] - sv[0]), e3 = __expf(sv[3] - sv[0]), inv = 1.0f / (1.f + e1 + e2 + e3);
        const float w4[4] = {inv, e1 * inv, e2 * inv, e3 * inv};
#pragma unroll
        for (int k = 0; k < 4; ++k) { const int lp = __hip_atomic_fetch_add(hist + se[k], 1, __ATOMIC_RELAXED, __HIP_MEMORY_SCOPE_WORKGROUP);
            TOPE[(size_t)V * 4 + k] = se[k]; TOPW[(size_t)V * 4 + k] = w4[k]; res[(resrow + lane) * 4 + k] = lp; }
        RS[V] = rsv;
    }
}
__device__ __forceinline__ void p6_router(Frame& F) {
    unsigned char* ws = F.ws;
    const bf16* H1 = (const bf16*)(ws + WS_H1); const float* RWT = (const float*)(ws + WS_RWT);
    int* TOPE = (int*)(ws + WS_TOPE); int* TOPP = (int*)(ws + WS_TOPP); float* TOPW = (float*)(ws + WS_TOPW); float* RS = (float*)(ws + WS_RS);
    int* ETOK = (int*)(ws + WS_ETOK); float* ERS = (float*)(ws + WS_ERS); float* EW = (float*)(ws + WS_EW);
    LAS float* rw = (LAS float*)(F.lds + RING_OFF);
    LAS float* LG = (LAS float*)(F.lds + RING_OFF + 66048) + F.wave * 528;
    LAS int* hist = (LAS int*)(F.lds + RING_OFF + 66048 + 8 * 2112);
    LAS int* res = hist + 64;
    LAS float* XP = (LAS float*)(res + 144 * 4);
    LAS float* XQ = XP + 8 * 528;
    const int lane = F.lane, wave = F.wave, i16 = lane & 15, kk = lane >> 4;
    constexpr int RPW = NTOK / 256;
    const bool has_meta = (F.vcu == 0);
    const int Vbase = F.vcu * RPW, Vt = Vbase + 16 * wave;
    if (F.tid < 64) hist[F.tid] = 0;
    f32x4v acc0 = {0.f, 0.f, 0.f, 0.f}, acc1 = {0.f, 0.f, 0.f, 0.f}, acx0 = {0.f, 0.f, 0.f, 0.f}, acx1 = {0.f, 0.f, 0.f, 0.f}; float ssq = 0.f, xss = 0.f;
    const bf16* arow = H1 + (size_t)(Vt + i16) * D + 8 * kk;
    const bf16* xrow = H1 + (size_t)(NTOK + i16) * D + 8 * kk;
    v4u a0[4], a1[4];
#define RT_MMA(A, SB, C0, C1, SS) do { const LAS float* b0p = rw + i16 * RW_LD + 8 * kk + 128 * (SB); const LAS float* b1p = rw + (16 + i16) * RW_LD + 8 * kk + 128 * (SB); \
        _Pragma("unroll") for (int s = 0; s < 4; ++s) { const v4u aw = A[s]; \
            _Pragma("unroll") for (int h = 0; h < 2; ++h) { const unsigned w0 = h ? aw.z : aw.x, w1 = h ? aw.w : aw.y; const f32x4 a = {bflo(w0), bfhi(w0), bflo(w1), bfhi(w1)}; \
            const f32x4 b0 = *(const LAS f32x4*)(b0p + 32 * s + 4 * h), b1 = *(const LAS f32x4*)(b1p + 32 * s + 4 * h); \
            SS += (a.x * a.x + a.y * a.y) + (a.z * a.z + a.w * a.w); \
            C0 = MFMA16F(a.x, b0.x, C0); C1 = MFMA16F(a.x, b1.x, C1); C0 = MFMA16F(a.y, b0.y, C0); C1 = MFMA16F(a.y, b1.y, C1); \
            C0 = MFMA16F(a.z, b0.z, C0); C1 = MFMA16F(a.z, b1.z, C1); C0 = MFMA16F(a.w, b0.w, C0); C1 = MFMA16F(a.w, b1.w, C1); } } } while (0)
#pragma unroll
    for (int s = 0; s < 4; ++s) a0[s] = *(const GAS v4u*)(arow + 32 * s);
#pragma unroll 1
    for (int it = 0; it < 4; ++it) {
        const int half = it >> 1, sb0 = (2 * it) & 3;
        if ((it & 1) == 0) {
            __syncthreads();
            { f32x4 stg[8];
#pragma unroll
              for (int q = 0; q < 8; ++q) { const int u = F.tid + q * NTHREADS, e = u >> 7, c = u & 127; stg[q] = *(const GAS f32x4*)(RWT + (size_t)e * D + 512 * half + 4 * c); }
#pragma unroll
              for (int q = 0; q < 8; ++q) { const int u = F.tid + q * NTHREADS, e = u >> 7, c = u & 127; *(LAS f32x4*)(rw + e * RW_LD + 4 * c) = stg[q]; } }
            __syncthreads();
        }
#pragma unroll
        for (int s = 0; s < 4; ++s) a1[s] = *(const GAS v4u*)(arow + 128 * (2 * it + 1) + 32 * s);
        RT_MMA(a0, sb0, acc0, acc1, ssq);
        if (it < 3) {
#pragma unroll
            for (int s = 0; s < 4; ++s) a0[s] = *(const GAS v4u*)(arow + 128 * (2 * it + 2) + 32 * s);
        }
        RT_MMA(a1, sb0 + 1, acc0, acc1, ssq);
        if (has_meta && (wave >> 1) == it) {
            v4u ax[4];
#pragma unroll
            for (int s = 0; s < 4; ++s) ax[s] = *(const GAS v4u*)(xrow + 128 * wave + 32 * s);
            RT_MMA(ax, wave & 3, acx0, acx1, xss);
        }
    }
#undef RT_MMA
    if (has_meta) {
        xss += __shfl_xor(xss, 16); xss += __shfl_xor(xss, 32);
#pragma unroll
        for (int r = 0; r < 4; ++r) { XP[wave * 528 + (4 * kk + r) * 33 + i16] = acx0[r]; XP[wave * 528 + (4 * kk + r) * 33 + 16 + i16] = acx1[r]; }
        if (kk == 0) XQ[wave * 16 + i16] = xss;
    }
    ssq += __shfl_xor(ssq, 16); ssq += __shfl_xor(ssq, 32);
    const float rsrow = 1.0f / sqrtf(ssq * (1.f / D) + EPS);
    const float rb0 = F.in[IN_RB][i16], rb1 = F.in[IN_RB][16 + i16];
#pragma unroll
    for (int r = 0; r < 4; ++r) { const float rsr = __shfl(rsrow, 4 * kk + r); LG[(4 * kk + r) * 33 + i16] = acc0[r] * rsr + rb0; LG[(4 * kk + r) * 33 + 16 + i16] = acc1[r] * rsr + rb1; }
    LDS_WAIT(); asm volatile("" ::: "memory");
    router_topk16(LG, Vt + lane, rsrow, 16 * wave, lane, hist, res, TOPE, TOPW, RS);
    __syncthreads();
    if (has_meta && wave == 7) {
        float q = 0.f;
#pragma unroll
        for (int w = 0; w < 8; ++w) q += XQ[w * 16 + i16];
        const float rsm = 1.0f / sqrtf(q * (1.f / D) + EPS);
#pragma unroll
        for (int r = 0; r < 4; ++r) { float v0 = 0.f, v1 = 0.f;
#pragma unroll
            for (int w = 0; w < 8; ++w) { v0 += XP[w * 528 + (4 * kk + r) * 33 + i16]; v1 += XP[w * 528 + (4 * kk + r) * 33 + 16 + i16]; }
            const float rsr = __shfl(rsm, 4 * kk + r); LG[(4 * kk + r) * 33 + i16] = v0 * rsr + rb0; LG[(4 * kk + r) * 33 + 16 + i16] = v1 * rsr + rb1; }
        LDS_WAIT(); asm volatile("" ::: "memory");
        router_topk16(LG, NTOK + lane, rsm, 128, lane, hist, res, TOPE, TOPW, RS);
    }
    __syncthreads();
    if (F.tid < NE) hist[32 + F.tid] = (int)__hip_atomic_fetch_add(F.ctl + CW_CNT + 64 * F.tid, (unsigned)hist[F.tid], RLX_AGENT);
    __syncthreads();
    const int nrows = has_meta ? RPW + 16 : RPW;
    for (int u = F.tid; u < nrows * 4; u += NTHREADS) { const int rr = u >> 2, V = rr < RPW ? Vbase + rr : NTOK + (rr - RPW); const size_t gi = (size_t)V * 4 + (u & 3); const int e = TOPE[gi], pos = hist[32 + e] + res[u];
        TOPP[gi] = pos; ETOK[(size_t)e * NV + pos] = V; ERS[(size_t)e * NV + pos] = RS[V]; EW[(size_t)e * NV + pos] = TOPW[gi]; }
}

__device__ __forceinline__ void build_tables(Frame& F) {
    LAS int* pst = (LAS int*)(F.lds + PST_OFF); LAS unsigned char* texp = (LAS unsigned char*)(F.lds + TEXP_OFF);
    __syncthreads();
    if (F.tid < 64) {
        const int e = F.lane & 31; const int c = (int)__hip_atomic_load(F.ctl + CW_CNT + 64 * e, RLX_AGENT); const int nt = (c + 255) >> 8;
        int incl = nt;
#pragma unroll
        for (int o = 1; o < 32; o <<= 1) { const int t = __shfl_up(incl, o); if ((F.lane & 31) >= o) incl += t; }
        const int start = incl - nt;
        if (F.lane < 32) { pst[e] = start * 256; pst[33 + e] = c; for (int j = 0; j < nt && start + j < MAXTILES; ++j) texp[start + j] = (unsigned char)e; if (e == 31) pst[32] = incl < MAXTILES ? incl : MAXTILES; }
    }
    __syncthreads();
}
typedef float f32v2_t __attribute__((ext_vector_type(2)));
__device__ __forceinline__ void p10_combine(Frame& F) {
    unsigned char* ws = F.ws; build_tables(F);
    const LAS int* pst = (const LAS int*)(F.lds + PST_OFF);
    const bf16* H1 = (const bf16*)(ws + WS_H1); const unsigned char* YB = (const unsigned char*)(ws + WS_YB);
    const int* TOPE = (const int*)(ws + WS_TOPE); const int* TOPP = (const int*)(ws + WS_TOPP);
    const int gw = F.vcu * NWAVES + F.wave, NGW = F.G * NWAVES;
    const GAS f32x4* nf = (const GAS f32x4*)F.in[IN_NFIN] + F.lane; f32x4 nfv[4];
#pragma unroll
    for (int j = 0; j < 4; ++j) nfv[j] = nf[64 * j];
    int sl[2][4];
#define CMB_SLOTS(Rbase) do { _Pragma("unroll") for (int q = 0; q < 2; ++q) { const int R = (Rbase) + q * NGW; if (R < BATCH * SEQ) { const size_t V = (size_t)R; \
        _Pragma("unroll") for (int k = 0; k < 4; ++k) sl[q][k] = pst[TOPE[V * 4 + k]] + TOPP[V * 4 + k]; } else { _Pragma("unroll") for (int k = 0; k < 4; ++k) sl[q][k] = 0; } } } while (0)
    CMB_SLOTS(gw);
    for (int R0 = gw; R0 < BATCH * SEQ; R0 += 2 * NGW) {
        f32x4 v[2][4]; unsigned y[2][4][4];
#pragma unroll
        for (int q = 0; q < 2; ++q) { const int R = (R0 + q * NGW < BATCH * SEQ) ? R0 + q * NGW : R0; const size_t V = (size_t)R;
            const GAS v2u* hr = (const GAS v2u*)(H1 + V * D) + F.lane;
#pragma unroll
            for (int j = 0; j < 4; ++j) { const v2u hw = hr[64 * j]; v[q][j] = (f32x4){bflo(hw.x), bfhi(hw.x), bflo(hw.y), bfhi(hw.y)}; }
#pragma unroll
            for (int k = 0; k < 4; ++k) { const GAS unsigned* yr = (const GAS unsigned*)(YB + (size_t)sl[q][k] * D) + F.lane;
#pragma unroll
                for (int j = 0; j < 4; ++j) y[q][k][j] = yr[64 * j]; } }
        CMB_SLOTS(R0 + 2 * NGW);
#pragma unroll
        for (int q = 0; q < 2; ++q) { const int R = R0 + q * NGW; if (R >= BATCH * SEQ) continue;
#pragma unroll
            for (int k = 0; k < 4; ++k)
#pragma unroll
                for (int j = 0; j < 4; ++j) { const unsigned w = y[q][k][j]; const f32v2_t lo = __builtin_amdgcn_cvt_pk_f32_fp8(w, false), hi = __builtin_amdgcn_cvt_pk_f32_fp8(w, true);
                    v[q][j].x += lo[0] * 0.0625f; v[q][j].y += lo[1] * 0.0625f; v[q][j].z += hi[0] * 0.0625f; v[q][j].w += hi[1] * 0.0625f; }
            float s = 0.f;
#pragma unroll
            for (int j = 0; j < 4; ++j) s += (v[q][j].x * v[q][j].x + v[q][j].y * v[q][j].y) + (v[q][j].z * v[q][j].z + v[q][j].w * v[q][j].w);
            const float rs = 1.0f / sqrtf(wave_sum(s) * (1.f / D) + EPS);
            GAS f32x4* orow = (GAS f32x4*)(F.out + (size_t)R * D) + F.lane;
#pragma unroll
            for (int j = 0; j < 4; ++j) orow[64 * j] = v[q][j] * rs * nfv[j]; }
    }
#undef CMB_SLOTS
}

__device__ __forceinline__ int meta_row(int lane) { return ((lane >> 5) & 1) * 8 + ((lane >> 4) & 1) * 4 + ((lane >> 3) & 1) * 2 + ((lane >> 2) & 1); }
template <int KPL> __device__ __forceinline__ float meta_col(const LAS unsigned char* A, const bf16* wrow, int lane) {
    constexpr int K = 64 * KPL; float w[KPL];
#pragma unroll
    for (int j = 0; j < KPL / 8; ++j) { const v4u x = *(const GAS v4u*)(wrow + lane * KPL + 8 * j);
        w[8 * j] = bflo(x.x); w[8 * j + 1] = bfhi(x.x); w[8 * j + 2] = bflo(x.y); w[8 * j + 3] = bfhi(x.y); w[8 * j + 4] = bflo(x.z); w[8 * j + 5] = bfhi(x.z); w[8 * j + 6] = bflo(x.w); w[8 * j + 7] = bfhi(x.w); }
    float p[16];
#pragma unroll
    for (int r = 0; r < 16; ++r) { float s = 0.f;
#pragma unroll
        for (int j = 0; j < KPL / 8; ++j) { const v4u a = *(const LAS v4u*)(A + (r * K + lane * KPL + 8 * j) * 2);
            s += (bflo(a.x) * w[8 * j] + bfhi(a.x) * w[8 * j + 1]) + (bflo(a.y) * w[8 * j + 2] + bfhi(a.y) * w[8 * j + 3]) + (bflo(a.z) * w[8 * j + 4] + bfhi(a.z) * w[8 * j + 5]) + (bflo(a.w) * w[8 * j + 6] + bfhi(a.w) * w[8 * j + 7]); }
        p[r] = s; if ((r & 3) == 3) asm volatile("" ::: "memory"); }
    const bool b32 = lane & 32, b16 = lane & 16, b8 = lane & 8, b4 = lane & 4;
    float q8[8], q4[4], q2[2];
#pragma unroll
    for (int i = 0; i < 8; ++i) { const float keep = b32 ? p[i + 8] : p[i], send = b32 ? p[i] : p[i + 8]; q8[i] = keep + __shfl_xor(send, 32); }
#pragma unroll
    for (int i = 0; i < 4; ++i) { const float keep = b16 ? q8[i + 4] : q8[i], send = b16 ? q8[i] : q8[i + 4]; q4[i] = keep + __shfl_xor(send, 16); }
#pragma unroll
    for (int i = 0; i < 2; ++i) { const float keep = b8 ? q4[i + 2] : q4[i], send = b8 ? q4[i] : q4[i + 2]; q2[i] = keep + __shfl_xor(send, 8); }
    float v = (b4 ? q2[1] : q2[0]) + __shfl_xor(b4 ? q2[0] : q2[1], 4);
    v += __shfl_xor(v, 2); v += __shfl_xor(v, 1);
    return v;
}
__device__ __forceinline__ void meta_stage(Frame& F, LAS unsigned char* dst, const bf16* src, int K) {
    v4u t[4]; const int n = 16 * K / 8;
#pragma unroll
    for (int q = 0; q < 4; ++q) { const int u = F.tid + q * NTHREADS; if (u < n) t[q] = *(const GAS v4u*)(src + (size_t)u * 8); }
#pragma unroll
    for (int q = 0; q < 4; ++q) { const int u = F.tid + q * NTHREADS; if (u < n) *(LAS v4u*)(dst + u * 16) = t[q]; }
}
__device__ __forceinline__ void meta_proj(Frame& F) {
    unsigned char* ws = F.ws; const bf16* WIN = (const bf16*)(ws + WS_WIN); const float* lbl = F.in[IN_LBL];
    LAS unsigned char* A = F.lds + RING_OFF;
    __syncthreads(); meta_stage(F, A, (const bf16*)(ws + WS_XN0) + (size_t)NTOK * D, D); __syncthreads();
    for (int c = F.vcu * NWAVES + F.wave; c < NPROJ; c += F.G * NWAVES) {
        const float v = meta_col<16>(A, WIN + (size_t)c * D, F.lane);
        if ((F.lane & 3) == 0) { const size_t row = NTOK + meta_row(F.lane); const int kind = c < 3072 ? (c >> 9) : 6, cc = c & 511;
            if (kind == 0) ((bf16*)(ws + WS_HQ))[row * HW + cc] = (bf16)f2bf(fsilu(v));
            else if (kind == 1) { const float lb = fsigmoid(lbl[cc] - lbl[HW + cc]); ((bf16*)(ws + WS_HG))[row * HW + cc] = (bf16)f2bf(__logf(lb + (1.f - lb) * fsigmoid(v))); }
            else if (kind == 2) ((bf16*)(ws + WS_HV))[row * HW + cc] = (bf16)f2bf(v);
            else if (kind == 3) ((bf16*)(ws + WS_HGATE))[row * HW + cc] = (bf16)f2bf(fsilu(v));
            else if (kind == 4) ((bf16*)(ws + WS_MM))[row * HW + cc] = (bf16)f2bf(v);
            else if (kind == 5) ((bf16*)(ws + WS_MO))[row * HW + cc] = (bf16)f2bf(fsigmoid(v));
            else (ws + WS_GATES)[row * 2048 + pg8::gate_pos(c - 3072)] = (unsigned char)(__builtin_bit_cast(unsigned, __builtin_fmaf(fsigmoid(v), 255.f, 8388608.f)) & 0xffu); } }
}
__device__ __forceinline__ void meta_merged(Frame& F) {
    unsigned char* ws = F.ws; const unsigned char* GATES = ws + WS_GATES;
    LAS unsigned char* A0 = F.lds + RING_OFF; LAS unsigned char* A1 = A0 + 16 * HW * 2;
    __syncthreads(); meta_stage(F, A0, (const bf16*)(ws + WS_YHG) + (size_t)NTOK * HW, HW); meta_stage(F, A1, (const bf16*)(ws + WS_YML) + (size_t)NTOK * HW, HW); __syncthreads();
    for (int c = F.vcu * NWAVES + F.wave; c < D; c += F.G * NWAVES) {
        const float vh = meta_col<8>(A0, (const bf16*)(ws + WS_WBH) + (size_t)c * HW, F.lane), vm = meta_col<8>(A1, (const bf16*)(ws + WS_WBM) + (size_t)c * HW, F.lane);
        if ((F.lane & 3) == 0) { const size_t row = NTOK + meta_row(F.lane); ((bf16*)(ws + WS_MERGED))[row * D + c] = (bf16)f2bf((float)GATES[row * 2048 + pg8::gate_pos(c)] * vh + (float)GATES[row * 2048 + pg8::gate_pos(D + c)] * vm); } }
}
__device__ __forceinline__ void meta_wout(Frame& F) {
    unsigned char* ws = F.ws; LAS unsigned char* A = F.lds + RING_OFF;
    __syncthreads(); meta_stage(F, A, (const bf16*)(ws + WS_MERGED) + (size_t)NTOK * D, D); __syncthreads();
    for (int c = F.vcu * NWAVES + F.wave; c < D; c += F.G * NWAVES) {
        const float d = meta_col<16>(A, (const bf16*)(ws + WS_WOUT) + (size_t)c * D, F.lane);
        if ((F.lane & 3) == 0) { const int mr_ = meta_row(F.lane); const size_t row = NTOK + mr_; const float v = F.in[IN_META][(size_t)mr_ * D + c] + d;
            ((bf16*)(ws + WS_H1))[row * D + c] = (bf16)f2bf(v); ((unsigned char*)(ws + WS_H1B))[row * D + c] = (unsigned char)(__builtin_amdgcn_cvt_pk_fp8_f32(__builtin_amdgcn_fmed3f(v, -448.f, 448.f), 0.f, 0u, false) & 0xffu); } }
}

__device__ __forceinline__ void ph_proj(Frame& F, int variant) {
    unsigned char* ws = F.ws;
    pg8::Gemm g{(const pg8::bf16_t*)(ws + WS_XQ), (const pg8::bf16_t*)(ws + WS_WIN8), NTOK, NPROJ, D / 2}; pg8::StaticOrder S; S.init(NTOK, NPROJ, F.G, (int)blockIdx.x);
    pg8::EpiProjT<true> E{ws, F.in[IN_LBL], (const float*)(ws + WS_SROW), (const float*)(ws + WS_SCOL)};
#if MK_N_LAUNCHES != 1 && PROBE_VARIANT == 1
    if (variant) { pg8::EpiNull EN{(int*)(ws + WS_TOPE)}; pg8::gemm_phase<pg8::EpiNull, pg8::StaticOrder, true, true, false, true>(F.lds + RING_OFF, g, S, EN); return; }
#elif MK_N_LAUNCHES != 1 && PROBE_VARIANT == 2
    if (variant) { pg8::EpiProjT<true, true> EV{ws, F.in[IN_LBL], (const float*)(ws + WS_SROW), (const float*)(ws + WS_SCOL)}; pg8::gemm_phase<pg8::EpiProjT<true, true>, pg8::StaticOrder, true, true, false, true>(F.lds + RING_OFF, g, S, EV); return; }
#endif
    (void)variant;
    pg8::gemm_phase<pg8::EpiProjT<true>, pg8::StaticOrder, true, true, false, true>(F.lds + RING_OFF, g, S, E);
    meta_proj(F);
}
__device__ __forceinline__ void ph_scan(Frame& F) {
    const int sb = (int)blockIdx.x;
    if (sb < 64) p3_hgrn2_mfma(F, sb); else if (sb < 128) p3_mlstm_mfma(F, sb - 64);
#if !CONV_IN_P0
    else px_experts(F, sb - 128, F.G - 128);
#endif
}
__device__ __forceinline__ void ph_merged(Frame& F) {
    unsigned char* ws = F.ws;
    static_assert(WS_YML - WS_YHG == (size_t)pg8::PAIR_DA * 256 * HW * 2 && WS_WBM - WS_WBH == (size_t)pg8::PAIR_DB * 256 * HW * 2, "the second branch's operands sit a whole number of tiles behind the first's");
    pg8::PairOrder S; S.S.init(NTOK, D, F.G, (int)blockIdx.x);
    pg8::Gemm g{(const pg8::bf16_t*)(ws + WS_YHG), (const pg8::bf16_t*)(ws + WS_WBH), NTOK, D, HW};
    pg8::EpiGate2 E{(const unsigned char*)(ws + WS_GATES), (pg8::bf16_t*)(ws + WS_TMP), (pg8::bf16_t*)(ws + WS_MERGED)};
    pg8::gemm_phase<pg8::EpiGate2, pg8::PairOrder, true, true>(F.lds + RING_OFF, g, S, E);
    meta_merged(F);
}
__device__ __forceinline__ void ph_wout(Frame& F) {
    unsigned char* ws = F.ws;
    pg8::Gemm g{(const pg8::bf16_t*)(ws + WS_MERGED), (const pg8::bf16_t*)(ws + WS_WOUT), NTOK, D, D}; pg8::StaticOrder S; S.init(NTOK, D, F.G, (int)blockIdx.x);
    pg8::EpiH1 E{(const pg8::bf16_t*)(ws + WS_XN0), (const float*)(ws + WS_XSQ), (pg8::bf16_t*)(ws + WS_H1), (unsigned char*)(ws + WS_H1B)};
    pg8::gemm_phase<pg8::EpiH1, pg8::StaticOrder, true, true>(F.lds + RING_OFF, g, S, E);
    meta_wout(F);
}
__device__ __forceinline__ void ph_gu(Frame& F, int variant = 0) {
    unsigned char* ws = F.ws; build_tables(F);
    const LAS int* pst = (const LAS int*)(F.lds + PST_OFF); LAS unsigned short* tok16 = (LAS unsigned short*)(F.lds + TOK_OFF);
    pg8::Gemm g{(const pg8::bf16_t*)(ws + WS_H1B), (const pg8::bf16_t*)(ws + WS_WGU), NV, NE * 2 * DFF, D / 2};
    pg8::GroupOrder S{pst[32], 8, F.G, (int)blockIdx.x, (const LAS unsigned char*)(F.lds + TEXP_OFF)};
    { const int* ETOK = (const int*)(ws + WS_ETOK);
      int tokv[18];
#pragma unroll
      for (int i = 0; i < 18; ++i) { pg8::Unit u; int t = 0; if (S.next(i, u) && F.tid < 256) { const int e = u.pn >> 3, pos = u.pm * 256 - pst[e] + F.tid; if (pos < pst[33 + e]) t = ETOK[(size_t)e * NV + pos]; } tokv[i] = t; }
      if (F.tid < 256) {
#pragma unroll
          for (int i = 0; i < 18; ++i) tok16[i * 256 + F.tid] = (unsigned short)tokv[i]; }
      __syncthreads(); }
    pg8::EpiGU E{(const float*)(ws + WS_BGUP), (const float*)(ws + WS_ERS), (unsigned char*)(ws + WS_ACT), pst};
#if MK_N_LAUNCHES != 1 && PROBE_VARIANT == 1
    if (variant) { pg8::EpiNull EN{(int*)(ws + WS_TOPE)}; pg8::gemm_phase_g<pg8::EpiNull, pg8::GroupOrder, true>(F.lds + RING_OFF, g, S, EN, tok16); return; }
#elif MK_N_LAUNCHES != 1 && PROBE_VARIANT == 2
    if (variant) { pg8::EpiGUT<true> EV{(const float*)(ws + WS_BGUP), (const float*)(ws + WS_ERS), (unsigned char*)(ws + WS_ACT), pst}; pg8::gemm_phase_g<pg8::EpiGUT<true>, pg8::GroupOrder, true>(F.lds + RING_OFF, g, S, EV, tok16); return; }
#endif
    (void)variant;
    pg8::gemm_phase_g<pg8::EpiGU, pg8::GroupOrder, true>(F.lds + RING_OFF, g, S, E, tok16);
}
__device__ __forceinline__ void ph_down(Frame& F, int variant = 0) {
    unsigned char* ws = F.ws; build_tables(F);
    pg8::Gemm g{(const pg8::bf16_t*)(ws + WS_ACT), (const pg8::bf16_t*)(ws + WS_WDN), MAXTILES * 256, NE * D, DFF / 2};
    pg8::GroupOrder S{((const LAS int*)(F.lds + PST_OFF))[32], 4, F.G, (int)blockIdx.x, (const LAS unsigned char*)(F.lds + TEXP_OFF)};
    pg8::EpiDown E{F.in[IN_BDN], (const float*)(ws + WS_EW), (unsigned char*)(ws + WS_YB), (const LAS int*)(F.lds + PST_OFF)};
#if MK_N_LAUNCHES != 1 && PROBE_VARIANT == 1
    if (variant) { pg8::EpiNull EN{(int*)(ws + WS_TOPE)}; pg8::gemm_phase<pg8::EpiNull, pg8::GroupOrder, true, true, true>(F.lds + RING_OFF, g, S, EN); return; }
#elif MK_N_LAUNCHES != 1 && PROBE_VARIANT == 2
    if (variant) { pg8::EpiDownT<true> EV{F.in[IN_BDN], (const float*)(ws + WS_EW), (unsigned char*)(ws + WS_YB), (const LAS int*)(F.lds + PST_OFF)}; pg8::gemm_phase<pg8::EpiDownT<true>, pg8::GroupOrder, true, true, true>(F.lds + RING_OFF, g, S, EV); return; }
#endif
    (void)variant;
    pg8::gemm_phase<pg8::EpiDown, pg8::GroupOrder, true, true, true>(F.lds + RING_OFF, g, S, E);
}

#ifndef CONV_IN_P0
#define CONV_IN_P0 0
#endif
#ifndef PROBE_DOUBLE
#define PROBE_DOUBLE 0
#endif
#define DBL(k) ((PROBE_DOUBLE >> (k)) & 1)
#ifndef MK_N_LAUNCHES
#define MK_N_LAUNCHES 1
#endif
constexpr int NPHASE = 10;
#ifndef PROBE_VARIANT
#define PROBE_VARIANT 0
#endif
struct Args { const float* in[25]; float* out; unsigned char* ws; int ph_lo, ph_hi, li, pad; };
__global__ void __launch_bounds__(NTHREADS, 2) fwd_kernel(Args args) {
    extern __shared__ __attribute__((aligned(16))) unsigned char lds[];
    Frame F;
    F.lds = (LAS unsigned char*)lds; F.MISC = (volatile LAS unsigned*)(F.lds + MISC_OFF);
    F.tid = threadIdx.x; F.lane = F.tid & 63; F.wave = __builtin_amdgcn_readfirstlane(F.tid >> 6);
    F.G = gridDim.x; { const int bx = blockIdx.x; F.vcu = (F.G % 8 == 0) ? (bx % 8) * (F.G / 8) + bx / 8 : bx; }
    F.ws = args.ws; F.ctl = (gu32*)(args.ws + WS_CTL); F.out = args.out;
#pragma unroll
    for (int i = 0; i < 25; ++i) F.in[i] = args.in[i];
    { int t0 = F.tid; asm volatile("" : "+v"(t0)); if (t0 < 64) F.MISC[t0] = 0u; }
    __syncthreads();
    const int lo = args.ph_lo, hi = args.ph_hi;
    XcdBarrier bar; bar.bar = (unsigned*)(F.ctl + CW_BAR) + args.li * XCD_BAR_WORDS; bar.x = 0; bar.st = nullptr;
    if (hi - lo > 1) bar = xcd_barrier_post((unsigned*)(F.ctl + CW_BAR) + args.li * XCD_BAR_WORDS, F.MISC + 8);
#define IN(k) (lo <= (k) && (k) < hi)
#define SEAM(k) do { if (IN(k) && IN((k) + 1)) xcd_barrier(bar); } while (0)

    if (IN(0)) { p0_prologue(F);
#if CONV_IN_P0
        __syncthreads(); px_experts(F, F.vcu, F.G);
#endif
    } SEAM(0);
    if (IN(1)) { p0b_quant(F); } SEAM(1);
    if (IN(2)) { ph_proj(F, args.pad); } SEAM(2);
    if (IN(3)) { ph_scan(F); } SEAM(3);
    if (IN(4)) { ph_merged(F); } SEAM(4);
    if (IN(5)) { ph_wout(F); } SEAM(5);
    if (IN(6)) { p6_router(F); } SEAM(6);
    if (IN(7)) { ph_gu(F, args.pad); } SEAM(7);
    if (IN(8)) { ph_down(F, args.pad); } SEAM(8);
    if (IN(9)) { p10_combine(F); }
#undef IN
#undef SEAM
}

extern "C" void kernel_launch(void* const* d_in, const int* in_sizes, int n_in, void* d_out, int out_size, void* d_ws, size_t ws_size, hipStream_t stream) {
    static int grid = 0;
    if (grid == 0) {
        if (n_in != 25 || in_sizes[0] != BATCH * SEQ * D || out_size != BATCH * SEQ * D || ws_size < WS_END) { fprintf(stderr, "kernel_launch: unexpected shapes (n_in %d, in0 %d, out %d, ws %zu); nothing launched\n", n_in, n_in > 0 ? in_sizes[0] : -1, out_size, ws_size); grid = -1; return; }
        int dev = 0, cus = 0, per_cu = 0;
        if (hipGetDevice(&dev) != hipSuccess || hipDeviceGetAttribute(&cus, hipDeviceAttributeMultiprocessorCount, dev) != hipSuccess) { grid = -1; return; }
        if (hipFuncSetAttribute((const void*)fwd_kernel, hipFuncAttributeMaxDynamicSharedMemorySize, LDS_BYTES) != hipSuccess) { fprintf(stderr, "kernel_launch: hipFuncSetAttribute failed\n"); grid = -1; return; }
        if (hipOccupancyMaxActiveBlocksPerMultiprocessor(&per_cu, (const void*)fwd_kernel, NTHREADS, LDS_BYTES) != hipSuccess || per_cu < 1) { fprintf(stderr, "kernel_launch: occupancy query reports %d blocks per CU\n", per_cu); }
        (void)hipGetLastError();
        grid = 256;
        if (cus < 256) { fprintf(stderr, "kernel_launch: %d CUs < 256: the grid would not be resident; nothing launched\n", cus); grid = -1; return; }
    }
    if (grid < 0) return;
    if (hipMemsetAsync((char*)d_ws + WS_CTL, 0, CTL_ZERO_BYTES, stream) != hipSuccess) return;
    Args a{};
    for (int i = 0; i < 25; ++i) a.in[i] = (const float*)d_in[i];
    a.out = (float*)d_out; a.ws = (unsigned char*)d_ws; a.pad = 0;
#if MK_N_LAUNCHES == 1
    a.ph_lo = 0; a.ph_hi = NPHASE; a.li = 0;
    hipLaunchKernelGGL(fwd_kernel, dim3(grid), dim3(NTHREADS), LDS_BYTES, stream, a);
#else
    for (int p = 0; p < NPHASE; ++p) for (int rep = 0; rep <= DBL(p); ++rep) { a.ph_lo = p; a.ph_hi = p + 1; a.li = 0; a.pad = rep; hipLaunchKernelGGL(fwd_kernel, dim3(grid), dim3(NTHREADS), LDS_BYTES, stream, a); }
#endif
}
```

```cpp
#include <hip/hip_runtime.h>
#include <cstdio>
#include <cstdint>
namespace pg8 {
#define PG8_LAS __attribute__((address_space(3)))
typedef unsigned short bf16_t;
typedef short bf16x8 __attribute__((ext_vector_type(8)));
typedef float f32x4 __attribute__((ext_vector_type(4)));
typedef unsigned u32x4 __attribute__((ext_vector_type(4)));
constexpr int BM = 256, BK = 64, HALF = 128, HTB = HALF * BK * 2  , STAGE_BYTES = 8 * HTB, NXCD = 8, WGM = 8;

__host__ __device__ __forceinline__ int lds_byte(int r, int c) { const int st = (r >> 4) * 2 + (c >> 5), rr = r & 15, cc = c & 31, ob = rr * 64 + cc * 2; return st * 1024 + (ob ^ (((ob >> 9) & 1) << 5)); }
__host__ __device__ __forceinline__ void stage_rc(int b, int& R, int& C) { const int st = b / 1024, sb = b % 1024, swz = sb ^ (((sb >> 9) & 1) << 5); R = (st >> 1) * 16 + swz / 64; C = (st & 1) * 32 + (swz % 64) / 2; }
__host__ __device__ __forceinline__ int perm32(int rho) { const int n = rho >> 4, i = rho & 15; return 8 * (i >> 2) + 4 * n + (i & 3); }

struct Unit { int pm, pn; };
struct Gemm { const bf16_t* A; const bf16_t* Bt; int M, N, K; };

struct StaticOrder {
    int nM, nN, nwg, G, c;
    __host__ __device__ void init(int M, int N, int G_, int c_) { nM = M / BM; nN = N / BM; nwg = nM * nN; G = G_; c = c_; }
    __host__ __device__ __forceinline__ bool next(int i, Unit& u) const {
        const long L = (long)i * G + c; if (L >= nwg) return false;
        int wgid = (int)L; { const int q = nwg / NXCD, r = nwg % NXCD, xcd = wgid % NXCD, off = wgid / NXCD; wgid = (xcd < r ? xcd * (q + 1) : r * (q + 1) + (xcd - r) * q) + off; }
        const int nig = WGM * nN, gid = wgid / nig, fm = gid * WGM, gsz = (nM - fm) < WGM ? (nM - fm) : WGM;
        u.pm = fm + ((wgid % nig) % gsz); u.pn = (wgid % nig) / gsz; return true;
    }
    __device__ __forceinline__ void a_ready(const Unit&) const {}
    __device__ __forceinline__ void done(const Unit&) const {}
};

typedef __bf16 bf16v2 __attribute__((ext_vector_type(2)));
typedef float f32v2 __attribute__((ext_vector_type(2)));
__device__ __forceinline__ unsigned cvt_pk_bf16(float lo, float hi) { const f32v2 v = {lo, hi}; return __builtin_bit_cast(unsigned, __builtin_convertvector(v, bf16v2)); }
typedef float f32x2 __attribute__((ext_vector_type(2)));
typedef int i32x4 __attribute__((ext_vector_type(4)));
typedef int i32x8 __attribute__((ext_vector_type(8)));
__device__ __forceinline__ i32x8 cat8(const bf16x8 a, const bf16x8 b) { const i32x4 x = __builtin_bit_cast(i32x4, a), y = __builtin_bit_cast(i32x4, b); return __builtin_shufflevector(x, y, 0, 1, 2, 3, 4, 5, 6, 7); }
template <class Epi, class Sched, bool ALIGN_EPI = false, bool SP2 = false, bool FP8 = false, bool I8 = false>
__device__ __forceinline__ void gemm_phase(PG8_LAS unsigned char* lds, const Gemm g, const Sched& S, const Epi& E) {
    const int tid = threadIdx.x, wid = __builtin_amdgcn_readfirstlane(tid >> 6), lane = tid & 63, wr = wid >> 2, wc = wid & 3, fr = lane & 15, fq = lane >> 4;
    const int K = g.K, nt = K / BK;
    unsigned voffA[2], voffB[2];
#pragma unroll
    for (int i = 0; i < 2; ++i) { int R, C; stage_rc(tid * 16 + i * 8192, R, C); const int Rb = Epi::PERM ? ((R & ~31) + perm32(R & 31)) : R;
        voffA[i] = (unsigned)(R * K + C) * 2u; voffB[i] = (unsigned)(Rb * K + C) * 2u; }
    const size_t kstep = (size_t)(BK * 2);
    const size_t hstep = (size_t)HALF * K * 2;
    const size_t tstep = 2 * hstep;
    const unsigned ldsw = (unsigned)wid * 1024u;
    const int aoff = lds_byte(wr * 64 + fr, fq * 8), boff = lds_byte(wc * 32 + fr, fq * 8);
#define PG8_SA(b, h) (((b) * 2 + (h)) * HTB)
#define PG8_SB(b, h) ((4 + (b) * 2 + (h)) * HTB)
#define PG8_STAGE(bufoff, gbase, voff) do { _Pragma("unroll") for (int _i = 0; _i < 2; ++_i) \
        __builtin_amdgcn_global_load_lds((const unsigned*)((const char*)(gbase) + (voff)[_i]), (PG8_LAS unsigned*)(lds + (bufoff) + ldsw + _i * 8192), 16, 0, 0); } while (0)
#define PG8_LDA(dst, b, h) do { _Pragma("unroll") for (int m = 0; m < 4; ++m) { if constexpr (FP8) dst##8[m] = cat8(*(const PG8_LAS bf16x8*)(lds + PG8_SA(b, h) + aoff + m * 2048), *(const PG8_LAS bf16x8*)(lds + PG8_SA(b, h) + aoff + m * 2048 + 1024)); \
        else { _Pragma("unroll") for (int k = 0; k < 2; ++k) dst[m][k] = *(const PG8_LAS bf16x8*)(lds + PG8_SA(b, h) + aoff + m * 2048 + k * 1024); } } } while (0)
#define PG8_LDB(dst, b, h) do { _Pragma("unroll") for (int n = 0; n < 2; ++n) { if constexpr (FP8) dst##8[n] = cat8(*(const PG8_LAS bf16x8*)(lds + PG8_SB(b, h) + boff + n * 2048), *(const PG8_LAS bf16x8*)(lds + PG8_SB(b, h) + boff + n * 2048 + 1024)); \
        else { _Pragma("unroll") for (int k = 0; k < 2; ++k) dst[n][k] = *(const PG8_LAS bf16x8*)(lds + PG8_SB(b, h) + boff + n * 2048 + k * 1024); } } } while (0)
#define PG8_MMA(ai, bj, At, Bt) do { __builtin_amdgcn_s_setprio(1); _Pragma("unroll") for (int m = 0; m < 4; ++m) _Pragma("unroll") for (int n = 0; n < 2; ++n) { \
        if constexpr (FP8) acc[ai][bj][m][n] = __builtin_amdgcn_mfma_scale_f32_16x16x128_f8f6f4(Bt##8[n], At##8[m], acc[ai][bj][m][n], 0, 0, 0, 0x7f7f7f7f, 0, 0x7f7f7f7f); \
        else if constexpr (I8) { _Pragma("unroll") for (int k = 0; k < 2; ++k) acc[ai][bj][m][n] = __builtin_bit_cast(f32x4, __builtin_amdgcn_mfma_i32_16x16x64_i8(__builtin_bit_cast(i32x4, Bt[n][k]), __builtin_bit_cast(i32x4, At[m][k]), __builtin_bit_cast(i32x4, acc[ai][bj][m][n]), 0, 0, 0)); } \
        else { _Pragma("unroll") for (int k = 0; k < 2; ++k) acc[ai][bj][m][n] = __builtin_amdgcn_mfma_f32_16x16x32_bf16(Bt[n][k], At[m][k], acc[ai][bj][m][n], 0, 0, 0); } } \
        if constexpr (FP8) { _Pragma("unroll") for (int m = 0; m < 4; ++m) _Pragma("unroll") for (int n = 0; n < 2; ++n) asm volatile("" : "+v"(acc[ai][bj][m][n])); }     \
        __builtin_amdgcn_s_setprio(0); } while (0)
#define PG8_WAIT_V(n) asm volatile("s_waitcnt vmcnt(" #n ")" ::: "memory")
#define PG8_WAIT_L(n) asm volatile("s_waitcnt lgkmcnt(" #n ")" ::: "memory")
#define PG8_BAR __builtin_amdgcn_s_barrier()
#define PG8_SCHED __builtin_amdgcn_sched_barrier(0)
    Unit cur, nxt; int ui = 0;
    if (!S.next(0, cur)) return;
    f32x4 acc[2][2][4][2];
#pragma unroll
    for (int a = 0; a < 2; ++a)
#pragma unroll
        for (int b = 0; b < 2; ++b)
#pragma unroll
            for (int m = 0; m < 4; ++m)
#pragma unroll
                for (int n = 0; n < 2; ++n) acc[a][b][m][n] = (f32x4){0.f, 0.f, 0.f, 0.f};
    bf16x8 At[4][2], B0[2][2], B1[2][2]; i32x8 At8[4], B08[2], B18[2];
    const char* cA = (const char*)g.A + (size_t)cur.pm * tstep; const char* cB = (const char*)g.Bt + (size_t)cur.pn * tstep;
    S.a_ready(cur);
    if constexpr (SP2) {
        PG8_STAGE(PG8_SB(0, 0), cB, voffB); PG8_STAGE(PG8_SB(0, 1), cB + hstep, voffB); PG8_STAGE(PG8_SA(0, 0), cA, voffA); PG8_STAGE(PG8_SA(0, 1), cA + hstep, voffA);
        if (wr == 1) PG8_BAR;
        PG8_WAIT_V(2); PG8_BAR;
        PG8_STAGE(PG8_SB(1, 0), cB + kstep, voffB); PG8_STAGE(PG8_SA(1, 0), cA + kstep, voffA); PG8_STAGE(PG8_SB(1, 1), cB + hstep + kstep, voffB);
        PG8_WAIT_V(6); PG8_BAR;
    } else {
        PG8_STAGE(PG8_SB(0, 0), cB, voffB); PG8_STAGE(PG8_SA(0, 0), cA, voffA); PG8_STAGE(PG8_SB(0, 1), cB + hstep, voffB); PG8_STAGE(PG8_SA(0, 1), cA + hstep, voffA);
        if (wr == 1) PG8_BAR;
        PG8_WAIT_V(4); PG8_BAR;
        PG8_STAGE(PG8_SB(1, 0), cB + kstep, voffB); PG8_STAGE(PG8_SA(1, 0), cA + kstep, voffA); PG8_STAGE(PG8_SB(1, 1), cB + hstep + kstep, voffB);
        PG8_WAIT_V(6); PG8_BAR;
    }
    for (;;) {
        const bool has_next = S.next(ui + 1, nxt);
        const char* nA = has_next ? (const char*)g.A + (size_t)nxt.pm * tstep : cA; const char* nB = has_next ? (const char*)g.Bt + (size_t)nxt.pn * tstep : cB;
        for (int t = 0; t < nt; t += 2) {
            const bool last = (t == nt - 2);
            const char* a1 = cA + (size_t)(t + 1) * kstep;
            const char* a2 = last ? nA : cA + (size_t)(t + 2) * kstep; const char* b2 = last ? nB : cB + (size_t)(t + 2) * kstep;
            const char* a3 = a2 + kstep; const char* b3 = b2 + kstep;
            if (last && has_next) S.a_ready(nxt);
            if constexpr (SP2) {
            PG8_LDB(B0, 0, 0); PG8_LDB(B1, 0, 1); PG8_SCHED; PG8_LDA(At, 0, 0); PG8_STAGE(PG8_SA(1, 1), a1 + hstep, voffA);
            PG8_WAIT_V(8); PG8_WAIT_L(0); PG8_BAR; PG8_MMA(0, 0, At, B0); PG8_MMA(0, 1, At, B1); PG8_BAR; PG8_SCHED;
            PG8_LDA(At, 0, 1); PG8_STAGE(PG8_SB(0, 0), b2, voffB); PG8_STAGE(PG8_SB(0, 1), b2 + hstep, voffB); PG8_STAGE(PG8_SA(0, 0), a2, voffA);
            PG8_WAIT_V(8); PG8_WAIT_L(0); PG8_BAR; PG8_MMA(1, 0, At, B0); PG8_MMA(1, 1, At, B1); PG8_BAR; PG8_SCHED;
            PG8_LDB(B0, 1, 0); PG8_LDB(B1, 1, 1); PG8_SCHED; PG8_LDA(At, 1, 0); PG8_STAGE(PG8_SA(0, 1), a2 + hstep, voffA);
            PG8_WAIT_V(8); PG8_WAIT_L(0); PG8_BAR; PG8_MMA(0, 0, At, B0); PG8_MMA(0, 1, At, B1); PG8_BAR; PG8_SCHED;
            PG8_LDA(At, 1, 1); PG8_STAGE(PG8_SB(1, 0), b3, voffB); PG8_STAGE(PG8_SB(1, 1), b3 + hstep, voffB); PG8_STAGE(PG8_SA(1, 0), a3, voffA);
            PG8_WAIT_V(8); PG8_WAIT_L(0); PG8_BAR; PG8_MMA(1, 0, At, B0); PG8_MMA(1, 1, At, B1); PG8_BAR; PG8_SCHED;
            } else {
            PG8_LDB(B0, 0, 0); PG8_SCHED; PG8_LDA(At, 0, 0); PG8_STAGE(PG8_SA(1, 1), a1 + hstep, voffA);
            PG8_WAIT_L(8); PG8_BAR; PG8_WAIT_L(0); PG8_MMA(0, 0, At, B0); PG8_BAR; PG8_SCHED;
            PG8_LDB(B1, 0, 1); PG8_STAGE(PG8_SB(0, 0), b2, voffB);
            PG8_BAR; PG8_WAIT_L(0); PG8_MMA(0, 1, At, B1); PG8_BAR;
            PG8_LDA(At, 0, 1); PG8_STAGE(PG8_SA(0, 0), a2, voffA);
            PG8_BAR; PG8_WAIT_L(0); PG8_MMA(1, 0, At, B0); PG8_BAR; PG8_SCHED;
            PG8_STAGE(PG8_SB(0, 1), b2 + hstep, voffB);
            PG8_WAIT_V(6); PG8_BAR; PG8_MMA(1, 1, At, B1); PG8_BAR;
            PG8_LDB(B0, 1, 0); PG8_SCHED; PG8_LDA(At, 1, 0); PG8_STAGE(PG8_SA(0, 1), a2 + hstep, voffA);
            PG8_WAIT_L(8); PG8_BAR; PG8_WAIT_L(0); PG8_MMA(0, 0, At, B0); PG8_BAR; PG8_SCHED;
            PG8_LDB(B1, 1, 1); PG8_STAGE(PG8_SB(1, 0), b3, voffB);
            PG8_BAR; PG8_WAIT_L(0); PG8_MMA(0, 1, At, B1); PG8_BAR;
            PG8_LDA(At, 1, 1); PG8_STAGE(PG8_SA(1, 0), a3, voffA);
            PG8_BAR; PG8_WAIT_L(0); PG8_MMA(1, 0, At, B0); PG8_BAR; PG8_SCHED;
            PG8_STAGE(PG8_SB(1, 1), b3 + hstep, voffB);
            PG8_WAIT_V(6); PG8_BAR; PG8_MMA(1, 1, At, B1); PG8_BAR;
            }
        }
        if constexpr (ALIGN_EPI) { if (wr == 0) PG8_BAR; }
        if constexpr (!Epi::AFTER_DRAIN) { E(acc, cur, wr, wc, fr, fq); S.done(cur); }
        if (!has_next) break;
#pragma unroll
        for (int a = 0; a < 2; ++a)
#pragma unroll
            for (int b = 0; b < 2; ++b)
#pragma unroll
                for (int m = 0; m < 4; ++m)
#pragma unroll
                    for (int n = 0; n < 2; ++n) acc[a][b][m][n] = (f32x4){0.f, 0.f, 0.f, 0.f};
        cur = nxt; cA = nA; cB = nB; ++ui;
        if constexpr (ALIGN_EPI) { if (wr == 1) PG8_BAR; }
    }
    PG8_WAIT_V(0);
    if constexpr (!ALIGN_EPI) { if (wr == 0) PG8_BAR; }
    PG8_BAR;
    if constexpr (Epi::AFTER_DRAIN) { E.fused(acc, cur, wr, wc, fr, fq, lds, wid, lane); S.done(cur); }
#undef PG8_SA
#undef PG8_SB
#undef PG8_STAGE
#undef PG8_LDA
#undef PG8_LDB
#undef PG8_MMA
#undef PG8_WAIT_V
#undef PG8_WAIT_L
#undef PG8_BAR
#undef PG8_SCHED
}
template <class Epi, class Sched, bool FP8 = false>
__device__ __forceinline__ void gemm_phase_g(PG8_LAS unsigned char* lds, const Gemm g, const Sched& S, const Epi& E, const PG8_LAS unsigned short* tok16) {
    constexpr bool ALIGN_EPI = true, SP2 = true;
    const int tid = threadIdx.x, wid = __builtin_amdgcn_readfirstlane(tid >> 6), lane = tid & 63, wr = wid >> 2, wc = wid & 3, fr = lane & 15, fq = lane >> 4;
    const int K = g.K, nt = K / BK;
    unsigned voffB[2]; int RA[2]; unsigned CA[2];
#pragma unroll
    for (int i = 0; i < 2; ++i) { int R, C; stage_rc(tid * 16 + i * 8192, R, C); const int Rb = Epi::PERM ? ((R & ~31) + perm32(R & 31)) : R;
        RA[i] = R; CA[i] = (unsigned)C * 2u; voffB[i] = (unsigned)(Rb * K + C) * 2u; }
    unsigned oc[2][2];
#define PG8_TOKS(dst, ui_) do { _Pragma("unroll") for (int _h = 0; _h < 2; ++_h) _Pragma("unroll") for (int _i = 0; _i < 2; ++_i) \
        dst[_h][_i] = (unsigned)tok16[(ui_) * 256 + _h * HALF + RA[_i]] * (unsigned)(K * 2) + CA[_i]; } while (0)
    const size_t kstep = (size_t)(BK * 2);
    const size_t hstep = (size_t)HALF * K * 2;
    const size_t tstep = 2 * hstep;
    const unsigned ldsw = (unsigned)wid * 1024u;
    const int aoff = lds_byte(wr * 64 + fr, fq * 8), boff = lds_byte(wc * 32 + fr, fq * 8);
#define PG8_SA(b, h) (((b) * 2 + (h)) * HTB)
#define PG8_SB(b, h) ((4 + (b) * 2 + (h)) * HTB)
#define PG8_STAGE(bufoff, gbase, voff) do { _Pragma("unroll") for (int _i = 0; _i < 2; ++_i) \
        __builtin_amdgcn_global_load_lds((const unsigned*)((const char*)(gbase) + (voff)[_i]), (PG8_LAS unsigned*)(lds + (bufoff) + ldsw + _i * 8192), 16, 0, 0); } while (0)
#define PG8_LDA(dst, b, h) do { _Pragma("unroll") for (int m = 0; m < 4; ++m) { if constexpr (FP8) dst##8[m] = cat8(*(const PG8_LAS bf16x8*)(lds + PG8_SA(b, h) + aoff + m * 2048), *(const PG8_LAS bf16x8*)(lds + PG8_SA(b, h) + aoff + m * 2048 + 1024)); \
        else { _Pragma("unroll") for (int k = 0; k < 2; ++k) dst[m][k] = *(const PG8_LAS bf16x8*)(lds + PG8_SA(b, h) + aoff + m * 2048 + k * 1024); } } } while (0)
#define PG8_LDB(dst, b, h) do { _Pragma("unroll") for (int n = 0; n < 2; ++n) { if constexpr (FP8) dst##8[n] = cat8(*(const PG8_LAS bf16x8*)(lds + PG8_SB(b, h) + boff + n * 2048), *(const PG8_LAS bf16x8*)(lds + PG8_SB(b, h) + boff + n * 2048 + 1024)); \
        else { _Pragma("unroll") for (int k = 0; k < 2; ++k) dst[n][k] = *(const PG8_LAS bf16x8*)(lds + PG8_SB(b, h) + boff + n * 2048 + k * 1024); } } } while (0)
#define PG8_MMA(ai, bj, At, Bt) do { __builtin_amdgcn_s_setprio(1); _Pragma("unroll") for (int m = 0; m < 4; ++m) _Pragma("unroll") for (int n = 0; n < 2; ++n) { \
        if constexpr (FP8) acc[ai][bj][m][n] = __builtin_amdgcn_mfma_scale_f32_16x16x128_f8f6f4(Bt##8[n], At##8[m], acc[ai][bj][m][n], 0, 0, 0, 0x7f7f7f7f, 0, 0x7f7f7f7f); \
        else { _Pragma("unroll") for (int k = 0; k < 2; ++k) acc[ai][bj][m][n] = __builtin_amdgcn_mfma_f32_16x16x32_bf16(Bt[n][k], At[m][k], acc[ai][bj][m][n], 0, 0, 0); } } \
        if constexpr (FP8) { _Pragma("unroll") for (int m = 0; m < 4; ++m) _Pragma("unroll") for (int n = 0; n < 2; ++n) asm volatile("" : "+v"(acc[ai][bj][m][n])); }     \
        __builtin_amdgcn_s_setprio(0); } while (0)
#define PG8_WAIT_V(n) asm volatile("s_waitcnt vmcnt(" #n ")" ::: "memory")
#define PG8_WAIT_L(n) asm volatile("s_waitcnt lgkmcnt(" #n ")" ::: "memory")
#define PG8_BAR __builtin_amdgcn_s_barrier()
#define PG8_SCHED __builtin_amdgcn_sched_barrier(0)
    Unit cur, nxt; int ui = 0;
    if (!S.next(0, cur)) return;
    f32x4 acc[2][2][4][2];
#pragma unroll
    for (int a = 0; a < 2; ++a)
#pragma unroll
        for (int b = 0; b < 2; ++b)
#pragma unroll
            for (int m = 0; m < 4; ++m)
#pragma unroll
                for (int n = 0; n < 2; ++n) acc[a][b][m][n] = (f32x4){0.f, 0.f, 0.f, 0.f};
    bf16x8 At[4][2], B0[2][2], B1[2][2]; i32x8 At8[4], B08[2], B18[2];
    const char* cA = (const char*)g.A; const char* cB = (const char*)g.Bt + (size_t)cur.pn * tstep; PG8_TOKS(oc, 0);
    S.a_ready(cur);
    if constexpr (SP2) {
        PG8_STAGE(PG8_SB(0, 0), cB, voffB); PG8_STAGE(PG8_SB(0, 1), cB + hstep, voffB); PG8_STAGE(PG8_SA(0, 0), cA, oc[0]); PG8_STAGE(PG8_SA(0, 1), cA, oc[1]);
        if (wr == 1) PG8_BAR;
        PG8_WAIT_V(2); PG8_BAR;
        PG8_STAGE(PG8_SB(1, 0), cB + kstep, voffB); PG8_STAGE(PG8_SA(1, 0), cA + kstep, oc[0]); PG8_STAGE(PG8_SB(1, 1), cB + hstep + kstep, voffB);
        PG8_WAIT_V(6); PG8_BAR;
    } else {
        PG8_STAGE(PG8_SB(0, 0), cB, voffB); PG8_STAGE(PG8_SA(0, 0), cA, oc[0]); PG8_STAGE(PG8_SB(0, 1), cB + hstep, voffB); PG8_STAGE(PG8_SA(0, 1), cA + hstep, oc[0]);
        if (wr == 1) PG8_BAR;
        PG8_WAIT_V(4); PG8_BAR;
        PG8_STAGE(PG8_SB(1, 0), cB + kstep, voffB); PG8_STAGE(PG8_SA(1, 0), cA + kstep, oc[0]); PG8_STAGE(PG8_SB(1, 1), cB + hstep + kstep, voffB);
        PG8_WAIT_V(6); PG8_BAR;
    }
    for (;;) {
        const bool has_next = S.next(ui + 1, nxt);
        const char* nB = has_next ? (const char*)g.Bt + (size_t)nxt.pn * tstep : cB;
        for (int t = 0; t < nt; t += 2) {
            const bool last = (t == nt - 2);
            const char* a1 = cA + (size_t)(t + 1) * kstep;
            const char* a2 = last ? cA : cA + (size_t)(t + 2) * kstep; const char* b2 = last ? nB : cB + (size_t)(t + 2) * kstep;
            unsigned o2[2][2]; if (last && has_next) PG8_TOKS(o2, ui + 1); else { _Pragma("unroll") for (int _h = 0; _h < 2; ++_h) _Pragma("unroll") for (int _i = 0; _i < 2; ++_i) o2[_h][_i] = oc[_h][_i]; }
            const char* a3 = a2 + kstep; const char* b3 = b2 + kstep;
            if (last && has_next) S.a_ready(nxt);
            if constexpr (SP2) {
            PG8_LDB(B0, 0, 0); PG8_LDB(B1, 0, 1); PG8_SCHED; PG8_LDA(At, 0, 0); PG8_STAGE(PG8_SA(1, 1), a1, oc[1]);
            PG8_WAIT_V(8); PG8_WAIT_L(0); PG8_BAR; PG8_MMA(0, 0, At, B0); PG8_MMA(0, 1, At, B1); PG8_BAR; PG8_SCHED;
            PG8_LDA(At, 0, 1); PG8_STAGE(PG8_SB(0, 0), b2, voffB); PG8_STAGE(PG8_SB(0, 1), b2 + hstep, voffB); PG8_STAGE(PG8_SA(0, 0), a2, o2[0]);
            PG8_WAIT_V(8); PG8_WAIT_L(0); PG8_BAR; PG8_MMA(1, 0, At, B0); PG8_MMA(1, 1, At, B1); PG8_BAR; PG8_SCHED;
            PG8_LDB(B0, 1, 0); PG8_LDB(B1, 1, 1); PG8_SCHED; PG8_LDA(At, 1, 0); PG8_STAGE(PG8_SA(0, 1), a2, o2[1]);
            PG8_WAIT_V(8); PG8_WAIT_L(0); PG8_BAR; PG8_MMA(0, 0, At, B0); PG8_MMA(0, 1, At, B1); PG8_BAR; PG8_SCHED;
            PG8_LDA(At, 1, 1); PG8_STAGE(PG8_SB(1, 0), b3, voffB); PG8_STAGE(PG8_SB(1, 1), b3 + hstep, voffB); PG8_STAGE(PG8_SA(1, 0), a3, o2[0]);
            PG8_WAIT_V(8); PG8_WAIT_L(0); PG8_BAR; PG8_MMA(1, 0, At, B0); PG8_MMA(1, 1, At, B1); PG8_BAR; PG8_SCHED;
            } else {
            PG8_LDB(B0, 0, 0); PG8_SCHED; PG8_LDA(At, 0, 0); PG8_STAGE(PG8_SA(1, 1), a1 + hstep, oc[0]);
            PG8_WAIT_L(8); PG8_BAR; PG8_WAIT_L(0); PG8_MMA(0, 0, At, B0); PG8_BAR; PG8_SCHED;
            PG8_LDB(B1, 0, 1); PG8_STAGE(PG8_SB(0, 0), b2, voffB);
            PG8_BAR; PG8_WAIT_L(0); PG8_MMA(0, 1, At, B1); PG8_BAR;
            PG8_LDA(At, 0, 1); PG8_STAGE(PG8_SA(0, 0), a2, oc[0]);
            PG8_BAR; PG8_WAIT_L(0); PG8_MMA(1, 0, At, B0); PG8_BAR; PG8_SCHED;
            PG8_STAGE(PG8_SB(0, 1), b2 + hstep, voffB);
            PG8_WAIT_V(6); PG8_BAR; PG8_MMA(1, 1, At, B1); PG8_BAR;
            PG8_LDB(B0, 1, 0); PG8_SCHED; PG8_LDA(At, 1, 0); PG8_STAGE(PG8_SA(0, 1), a2 + hstep, oc[0]);
            PG8_WAIT_L(8); PG8_BAR; PG8_WAIT_L(0); PG8_MMA(0, 0, At, B0); PG8_BAR; PG8_SCHED;
            PG8_LDB(B1, 1, 1); PG8_STAGE(PG8_SB(1, 0), b3, voffB);
            PG8_BAR; PG8_WAIT_L(0); PG8_MMA(0, 1, At, B1); PG8_BAR;
            PG8_LDA(At, 1, 1); PG8_STAGE(PG8_SA(1, 0), a3, oc[0]);
            PG8_BAR; PG8_WAIT_L(0); PG8_MMA(1, 0, At, B0); PG8_BAR; PG8_SCHED;
            PG8_STAGE(PG8_SB(1, 1), b3 + hstep, voffB);
            PG8_WAIT_V(6); PG8_BAR; PG8_MMA(1, 1, At, B1); PG8_BAR;
            }
        }
        if constexpr (ALIGN_EPI) { if (wr == 0) PG8_BAR; }
        if constexpr (!Epi::AFTER_DRAIN) { E(acc, cur, wr, wc, fr, fq); S.done(cur); }
        if (!has_next) break;
#pragma unroll
        for (int a = 0; a < 2; ++a)
#pragma unroll
            for (int b = 0; b < 2; ++b)
#pragma unroll
                for (int m = 0; m < 4; ++m)
#pragma unroll
                    for (int n = 0; n < 2; ++n) acc[a][b][m][n] = (f32x4){0.f, 0.f, 0.f, 0.f};
        cur = nxt; cB = nB; ++ui; PG8_TOKS(oc, ui);
        if constexpr (ALIGN_EPI) { if (wr == 1) PG8_BAR; }
    }
    PG8_WAIT_V(0);
    if constexpr (!ALIGN_EPI) { if (wr == 0) PG8_BAR; }
    PG8_BAR;
    if constexpr (Epi::AFTER_DRAIN) { E.fused(acc, cur, wr, wc, fr, fq, lds, wid, lane); S.done(cur); }
#undef PG8_TOKS
#undef PG8_SA
#undef PG8_SB
#undef PG8_STAGE
#undef PG8_LDA
#undef PG8_LDB
#undef PG8_MMA
#undef PG8_WAIT_V
#undef PG8_WAIT_L
#undef PG8_BAR
#undef PG8_SCHED
}
}

constexpr int BATCH = 16, SEQ = 2048, D = 1024, NMETA = 16;
constexpr int TV = SEQ + NMETA;
constexpr int NV = BATCH * TV;
constexpr int NTOK = BATCH * SEQ;
constexpr int NR = NTOK + NMETA;
constexpr int NIN = 5128, NPROJ = 5120;
constexpr int HW = 512;
constexpr int NE = 32, TOPK = 4, DFF = 1024;
constexpr int MAXTILES = 548;
constexpr float EPS = 1e-6f;
constexpr int NWAVES = 8, NTHREADS = 512;

constexpr size_t MiB = 1u << 20, KiB = 1u << 10;
constexpr size_t WS_CTL = 0, CTL_ZERO_BYTES = 1 * MiB;
constexpr size_t WS_WIN = 2 * MiB;
constexpr size_t WS_WBH = 12 * MiB, WS_WBM = 13 * MiB, WS_WOUT = 14 * MiB;
constexpr size_t WS_WGU = 16 * MiB;
constexpr size_t WS_WDN = 144 * MiB;
constexpr size_t WS_BGUP = 208 * MiB;
constexpr size_t WS_RWT = WS_BGUP + 256 * KiB;
constexpr size_t WS_TOPE = WS_RWT + 128 * KiB;
constexpr size_t WS_TOPP = WS_TOPE + 520 * KiB;
constexpr size_t WS_TOPW = WS_TOPP + 520 * KiB;
constexpr size_t WS_RS = WS_TOPW + 520 * KiB;
constexpr size_t WS_LI = WS_RS + 136 * KiB;
constexpr size_t WS_LF = WS_LI + 520 * KiB;
constexpr size_t WS_SLOTRS = WS_LF + 520 * KiB;
constexpr size_t WS_SLOTW = WS_SLOTRS + 552 * KiB;
constexpr size_t WS_XSQ = WS_SLOTW + 552 * KiB;
constexpr size_t WS_SROW = WS_XSQ + 136 * KiB;
constexpr size_t WS_SCOL = WS_SROW + 136 * KiB;
constexpr size_t WS_SMALL_END = WS_SCOL + 32 * KiB;
constexpr size_t WS_RA = 214 * MiB;
constexpr size_t WS_HQ = WS_RA, WS_HG = WS_RA + 33 * MiB, WS_HV = WS_RA + 99 * MiB, WS_HGATE = WS_RA + 132 * MiB, WS_MM = WS_RA + 165 * MiB, WS_MO = WS_RA + 198 * MiB, WS_GATES = WS_RA + 231 * MiB;
constexpr size_t WS_MERGED = WS_RA, WS_TMP = WS_RA + 66 * MiB, WS_H1B = WS_RA + 364 * MiB, WS_ACT = WS_RA;
constexpr size_t WS_RB = WS_RA + 364 * MiB;
constexpr size_t WS_XQ = WS_RB;
constexpr size_t WS_QKVM = WS_RB, WS_CM = WS_RB + 130 * MiB, WS_YHG = WS_RB + 196 * MiB, WS_YML = WS_RB + 229 * MiB, WS_XS = WS_RB, WS_YB = WS_RB;
constexpr size_t WS_RC = WS_RB + 274 * MiB;
constexpr size_t WS_XN0 = WS_RC + 65 * MiB;
constexpr size_t WS_H1 = WS_RC, WS_ETOK = WS_RC + 130 * MiB, WS_ERS = WS_ETOK + 5 * MiB, WS_EW = WS_ERS + 5 * MiB, WS_WIN8 = WS_EW + 5 * MiB, WS_END = WS_WIN8 + 5 * MiB;
static_assert(WS_SMALL_END <= WS_RA && WS_END <= 1024 * MiB, "d_ws map");
static_assert((size_t)NV * HW * 2 <= 33 * MiB && (size_t)NV * HW * 4 <= 66 * MiB && (size_t)NV * 2048 * 2 <= 132 * MiB + MiB && (size_t)NV * D * 4 <= 130 * MiB && (size_t)MAXTILES * 256 * D * 2 <= 274 * MiB, "d_ws sizes");
static_assert((size_t)NE * NV * 4 <= 5 * MiB, "per-expert lists");
static_assert((size_t)NR * D * 2 <= 65 * MiB && (size_t)NR * 4 <= 136 * KiB, "H1 / XN0 / XSQ");
constexpr int CW_TMO = 0, CW_CNT = 64  , CW_BAR = 4096, CW_P0ARR = 3072  , CW_CMAX = 65536  ;

constexpr int RING_OFF = 0, RING_BYTES = 131072;
constexpr int MISC_OFF = RING_BYTES;
constexpr int TEXP_OFF = MISC_OFF + 256;
constexpr int PST_OFF = TEXP_OFF + 640;
constexpr int TOK_OFF = PST_OFF + 384;
constexpr int LDS_BYTES = 147456;
static_assert(TOK_OFF + 18 * 512 <= LDS_BYTES, "LDS map");

#define GAS __attribute__((address_space(1)))
#define LAS __attribute__((address_space(3)))
typedef unsigned short bf16;
typedef unsigned v4u __attribute__((ext_vector_type(4)));
typedef unsigned v2u __attribute__((ext_vector_type(2)));
typedef float f32x4 __attribute__((ext_vector_type(4)));
typedef GAS unsigned gu32;
#define RLX_AGENT __ATOMIC_RELAXED, __HIP_MEMORY_SCOPE_AGENT
#define LDS_WAIT() asm volatile("s_waitcnt lgkmcnt(0)" ::: "memory")
#define VM_WAIT() asm volatile("s_waitcnt vmcnt(0)" ::: "memory")
__device__ __forceinline__ unsigned pk2(float lo, float hi) { return pg8::cvt_pk_bf16(lo, hi); }
__device__ __forceinline__ unsigned f2bf(float f) { return pg8::cvt_pk_bf16(f, 0.f) & 0xffffu; }
__device__ __forceinline__ float bflo(unsigned w) { return __builtin_bit_cast(float, w << 16); }
__device__ __forceinline__ float bfhi(unsigned w) { return __builtin_bit_cast(float, w & 0xffff0000u); }
__device__ __forceinline__ float bf1(bf16 h) { return __builtin_bit_cast(float, (unsigned)h << 16); }
__device__ __forceinline__ float fsigmoid(float x) { return __builtin_amdgcn_rcpf(1.0f + __expf(-x)); }
__device__ __forceinline__ float fsilu(float x) { return x * fsigmoid(x); }
__device__ __forceinline__ size_t rowof(int b, int tt) { return tt < NMETA ? (size_t)(NTOK + tt) : (size_t)b * SEQ + (tt - NMETA); }
__host__ __device__ __forceinline__ int gu_slot(int j) { const int g = (j >> 3) & 3, p = ((g & 1) << 1) | (g >> 1); return (j & ~31) + 8 * p + (j & 7); }
__device__ __forceinline__ float wave_sum(float v) {
#pragma unroll
    for (int o = 1; o < 64; o <<= 1) v += __shfl_xor(v, o);
    return v;
}
__device__ __forceinline__ float wave_max(float v) {
#pragma unroll
    for (int o = 1; o < 64; o <<= 1) v = fmaxf(v, __shfl_xor(v, o));
    return v;
}
#define XB_TMO      128
#define XB_XCNT(j)  (256  + 64 * (j))
#define XB_XSUB(j)  (1280 + 64 * (j))
#define XB_XGEN(j)  (2304 + 64 * (j))
#define XB_TOP      3328
#define XB_TOPGEN   3392
#define XCD_BAR_WORDS 3456
#define XB_SPIN_CAP (1u << 18)

__device__ __forceinline__ unsigned xb_ld(unsigned* p)              { return __hip_atomic_load(p, __ATOMIC_RELAXED, __HIP_MEMORY_SCOPE_AGENT); }
__device__ __forceinline__ unsigned xb_add(unsigned* p, unsigned v) { return __hip_atomic_fetch_add(p, v, __ATOMIC_RELAXED, __HIP_MEMORY_SCOPE_AGENT); }
__device__ __forceinline__ unsigned xb_xcc_id() { return (unsigned)__builtin_amdgcn_s_getreg((3 << 11) | 20) & 0xFu; }
#define XB_SPIN(cond, bar) do { unsigned _sp = 0; while (cond) { __builtin_amdgcn_s_sleep(1); \
    if ((++_sp & 255u) == 0u) { if (xb_ld(&(bar)[XB_TMO])) break; if (_sp > XB_SPIN_CAP) { atomicAdd(&(bar)[XB_TMO], 1u); break; } } } } while (0)

struct XcdBarrier {
    unsigned* bar; unsigned x;
    volatile LAS unsigned* st;
};

__device__ __forceinline__ XcdBarrier xcd_barrier_post(unsigned* bar, volatile LAS unsigned* st) {
    XcdBarrier b; b.bar = bar; b.x = xb_xcc_id(); b.st = st;
    if (threadIdx.x == 0) (void)xb_add(&bar[XB_XCNT(b.x)], 1u);
    return b;
}
__device__ __forceinline__ void xcd_barrier_complete(unsigned* bar, unsigned x, unsigned& nloc, unsigned& nx) {
    const unsigned G = gridDim.x * gridDim.y * gridDim.z;
    unsigned sum, cnt, mine, sp = 0u;
    for (;;) {
        sum = 0u; cnt = 0u; mine = 0u;
#pragma unroll
        for (unsigned j = 0; j < 16; ++j) { const unsigned c = xb_ld(&bar[XB_XCNT(j)]); sum += c; cnt += (c > 0u) ? 1u : 0u; mine = (j == x) ? c : mine; }
        if (sum == G) break;
        __builtin_amdgcn_s_sleep(1);
        if ((++sp & 255u) == 0u) { if (xb_ld(&bar[XB_TMO])) break; if (sp > XB_SPIN_CAP) { atomicAdd(&bar[XB_TMO], 1u); break; } }
    }
    nloc = mine > 0u ? mine : 1u; nx = cnt > 0u ? cnt : 1u;
}

__device__ __forceinline__ void xcd_barrier(const XcdBarrier& b) {
    asm volatile("s_waitcnt vmcnt(0)" ::: "memory");
    __syncthreads();
    if (threadIdx.x == 0) {
        unsigned* bar = b.bar;
        __builtin_amdgcn_s_waitcnt(0);
        unsigned nloc = b.st[0], nx = b.st[1];
        if (nloc == 0u) { xcd_barrier_complete(bar, b.x, nloc, nx); b.st[0] = nloc; b.st[1] = nx; }
        const unsigned old = xb_add(&bar[XB_XSUB(b.x)], 1u);
        const unsigned gen = old / nloc;
        if (old + 1u == (gen + 1u) * nloc) {
            __builtin_amdgcn_fence(__ATOMIC_RELEASE, "agent");
            asm volatile("s_waitcnt vmcnt(0)" ::: "memory");
            const unsigned og = xb_add(&bar[XB_TOP], 1u);
            const unsigned tg = og / nx;
            if (og + 1u == (tg + 1u) * nx) xb_add(&bar[XB_TOPGEN], 1u);
            else XB_SPIN(xb_ld(&bar[XB_TOPGEN]) == tg, bar);
            __builtin_amdgcn_fence(__ATOMIC_ACQUIRE, "agent");
            xb_add(&bar[XB_XGEN(b.x)], 1u);
            asm volatile("s_waitcnt vmcnt(0)" ::: "memory");
        } else {
            XB_SPIN(xb_ld(&bar[XB_XGEN(b.x)]) == gen, bar);
            __builtin_amdgcn_fence(__ATOMIC_ACQUIRE, "agent");
            asm volatile("s_waitcnt vmcnt(0)" ::: "memory");
        }
    }
    __syncthreads();
}

struct Frame {
    LAS unsigned char* lds;
    volatile LAS unsigned* MISC;
    gu32* ctl;
    int tid, lane, wave, vcu, G;
    const float* in[25];
    float* out;
    unsigned char* ws;
};
#define IN_X 0
#define IN_META 1
#define IN_LBL 2
#define IN_NMIX 3
#define IN_WIN 4
#define IN_HGNORM 5
#define IN_CONVW 6
#define IN_CONVB 7
#define IN_WQ 8
#define IN_WK 9
#define IN_WV 10
#define IN_GATEB 11
#define IN_MLNORM 12
#define IN_MLSKIP 13
#define IN_WBH 14
#define IN_WBM 15
#define IN_WOUT 16
#define IN_NFFN 17
#define IN_RW 18
#define IN_RB 19
#define IN_WGU 20
#define IN_BGU 21
#define IN_WDN 22
#define IN_BDN 23
#define IN_NFIN 24

__device__ __forceinline__ void p0_item(const float* W, int ldw, int col0, int cstride, const float* kscale, bf16* WT, int K, int dstrow0, int k0, LAS float* scr, int lane, float gsc = 1.f, gu32* cmax = nullptr) {
    (void)cstride;
    const int r = lane >> 3, c4 = (lane & 7) * 4;
    f32x4 v[8];
#pragma unroll
    for (int i = 0; i < 8; ++i) v[i] = *(const GAS f32x4*)(W + (size_t)(k0 + 8 * i + r) * ldw + col0 + c4);
#pragma unroll
    for (int i = 0; i < 8; ++i) { const float sc = kscale ? kscale[k0 + 8 * i + r] : gsc; LAS float* s = scr + (8 * i + r) * 33 + c4; s[0] = v[i].x * sc; s[1] = v[i].y * sc; s[2] = v[i].z * sc; s[3] = v[i].w * sc; }
    LDS_WAIT(); asm volatile("" ::: "memory");
    const int c = lane & 7;
#pragma unroll
    for (int j = 0; j < 4; ++j) { const int n = (lane >> 3) + 8 * j; const LAS float* s = scr + (8 * c) * 33 + n;
        v4u o; o.x = pk2(s[0 * 33], s[1 * 33]); o.y = pk2(s[2 * 33], s[3 * 33]); o.z = pk2(s[4 * 33], s[5 * 33]); o.w = pk2(s[6 * 33], s[7 * 33]);
        if (cmax) { float m = fmaxf(fmaxf(fmaxf(fabsf(s[0 * 33]), fabsf(s[1 * 33])), fmaxf(fabsf(s[2 * 33]), fabsf(s[3 * 33]))), fmaxf(fmaxf(fabsf(s[4 * 33]), fabsf(s[5 * 33])), fmaxf(fabsf(s[6 * 33]), fabsf(s[7 * 33]))));
            m = fmaxf(m, __shfl_xor(m, 1)); m = fmaxf(m, __shfl_xor(m, 2)); m = fmaxf(m, __shfl_xor(m, 4));
            if (c == 0) (void)__hip_atomic_fetch_max(cmax + dstrow0 + n, __builtin_bit_cast(unsigned, m), RLX_AGENT); }
        *(GAS v4u*)(WT + (size_t)(dstrow0 + n) * K + k0 + 8 * c) = o; }
    LDS_WAIT(); asm volatile("" ::: "memory");
}
__device__ __forceinline__ void p0_prologue(Frame& F) {
    unsigned char* ws = F.ws;
    const int gw = F.vcu * NWAVES + F.wave, NGW = F.G * NWAVES, gt = F.vcu * NTHREADS + F.tid, NGT = F.G * NTHREADS;
    {
        LAS float* scr = (LAS float*)(F.lds + RING_OFF + F.wave * 16384);
        constexpr int I_IN1 = 16 * 96, I_IN2 = 16 * 64, I_BH = 8 * 32, I_OUT = 16 * 32;
        constexpr int NITEMS = I_IN1 + I_IN2 + 2 * I_BH + I_OUT;
        for (int it = gw; it < NITEMS; it += NGW) {
            int r = it;
            if (r < I_IN1) { const int kb = r / 96, nb = r % 96; p0_item(F.in[IN_WIN], NIN, 32 * nb, 1, F.in[IN_NMIX], (bf16*)(ws + WS_WIN), D, 32 * nb, 64 * kb, scr, F.lane, 1.f, F.ctl + CW_CMAX); continue; } r -= I_IN1;
            if (r < I_IN2) { const int kb = r / 64, nb = r % 64; p0_item(F.in[IN_WIN], NIN, 3080 + 32 * nb, 1, F.in[IN_NMIX], (bf16*)(ws + WS_WIN), D, 3072 + 32 * nb, 64 * kb, scr, F.lane, 1.f, F.ctl + CW_CMAX); continue; } r -= I_IN2;
            if (r < I_BH) { const int kb = r / 32, nb = r % 32; p0_item(F.in[IN_WBH], D, 32 * nb, 1, nullptr, (bf16*)(ws + WS_WBH), HW, 32 * nb, 64 * kb, scr, F.lane, 1.f / 255.f); continue; } r -= I_BH;
            if (r < I_BH) { const int kb = r / 32, nb = r % 32; p0_item(F.in[IN_WBM], D, 32 * nb, 1, nullptr, (bf16*)(ws + WS_WBM), HW, 32 * nb, 64 * kb, scr, F.lane, 1.f / 255.f); continue; } r -= I_BH;
            { const int kb = r / 32, nb = r % 32; p0_item(F.in[IN_WOUT], D, 32 * nb, 1, nullptr, (bf16*)(ws + WS_WOUT), D, 32 * nb, 64 * kb, scr, F.lane); }
        }
    }
    asm volatile("s_waitcnt vmcnt(0)" ::: "memory"); __syncthreads();
    if (F.tid == 0) (void)__hip_atomic_fetch_add(F.ctl + CW_P0ARR, 1u, RLX_AGENT);
    {
        LAS float* wm = (LAS float*)(F.lds + RING_OFF + 65536);
        { float wa[16], wb[16];
#pragma unroll
          for (int q = 0; q < 16; ++q) { const int u = F.tid + q * NTHREADS, j = u & 7, l = (u >> 3) & 63, i = u >> 9, k = 4 * l + 256 * (i >> 2) + (i & 3); wa[q] = F.in[IN_NMIX][k]; wb[q] = F.in[IN_WIN][(size_t)k * NIN + 3072 + j]; }
#pragma unroll
          for (int q = 0; q < 16; ++q) wm[F.tid + q * NTHREADS] = wa[q] * wb[q]; }
        __syncthreads();
        bf16* XN0 = (bf16*)(ws + WS_XN0); float* XSQ = (float*)(ws + WS_XSQ); unsigned char* XQ = ws + WS_XQ; float* SROW = (float*)(ws + WS_SROW); float* LI = (float*)(ws + WS_LI); float* LF = (float*)(ws + WS_LF);
        f32x4 vn[4];
#define P0_LOADROW(dst, V_) do { const int Vc_ = (V_) < NR ? (V_) : NR - 1; const float* src_ = (Vc_ >= NTOK) ? F.in[IN_META] + (size_t)(Vc_ - NTOK) * D : F.in[IN_X] + (size_t)Vc_ * D; \
        const GAS f32x4* xr_ = (const GAS f32x4*)src_ + F.lane; _Pragma("unroll") for (int j = 0; j < 4; ++j) dst[j] = xr_[64 * j]; } while (0)
        P0_LOADROW(vn, gw);
        for (int V = gw; V < NR; V += NGW) {
            f32x4 v[4]; float s = 0.f, am = 0.f;
#pragma unroll
            for (int j = 0; j < 4; ++j) { v[j] = vn[j]; s += (v[j].x * v[j].x + v[j].y * v[j].y) + (v[j].z * v[j].z + v[j].w * v[j].w); am = fmaxf(am, fmaxf(fmaxf(fabsf(v[j].x), fabsf(v[j].y)), fmaxf(fabsf(v[j].z), fabsf(v[j].w)))); }
            P0_LOADROW(vn, V + NGW);
            asm volatile("" ::: "memory");
            const float sq = sqrtf(wave_sum(s) * (1.f / D) + EPS), rs = 1.0f / sq;
            am = wave_max(am) * rs; const float srow = am > 0.f ? am * (1.f / 127.f) : 1.f, qi = 1.f / srow;
            if (F.lane == 0) { XSQ[V] = sq; SROW[V] = srow; }
            GAS unsigned* q4 = (GAS unsigned*)(XQ + (size_t)V * D) + F.lane;
            float g[8];
#pragma unroll
            for (int j = 0; j < 8; ++j) g[j] = 0.f;
            GAS unsigned long long* o8 = (GAS unsigned long long*)(XN0 + (size_t)V * D) + F.lane;
#pragma unroll
            for (int j = 0; j < 4; ++j) {
                v[j] = v[j] * rs;
                __builtin_nontemporal_store((unsigned long long)pk2(v[j].x, v[j].y) | ((unsigned long long)pk2(v[j].z, v[j].w) << 32), o8 + 64 * j);
                q4[64 * j] = ((unsigned)(int)rintf(v[j].x * qi) & 0xffu) | (((unsigned)(int)rintf(v[j].y * qi) & 0xffu) << 8) | (((unsigned)(int)rintf(v[j].z * qi) & 0xffu) << 16) | ((unsigned)(int)rintf(v[j].w * qi) << 24);
#pragma unroll
                for (int q = 0; q < 4; ++q) { const LAS f32x4* wp = (const LAS f32x4*)(wm + (((4 * j + q) * 64 + F.lane) * 8)); const f32x4 w0 = wp[0], w1 = wp[1]; const float xv = v[j][q];
                    g[0] += xv * w0.x; g[1] += xv * w0.y; g[2] += xv * w0.z; g[3] += xv * w0.w; g[4] += xv * w1.x; g[5] += xv * w1.y; g[6] += xv * w1.z; g[7] += xv * w1.w; }
            }
#pragma unroll
            for (int j = 0; j < 8; ++j) g[j] = wave_sum(g[j]);
            if (F.lane < 4) {
                const float gi = (F.lane == 0 ? g[0] : F.lane == 1 ? g[1] : F.lane == 2 ? g[2] : g[3]) + F.in[IN_GATEB][F.lane];
                const float gf = (F.lane == 0 ? g[4] : F.lane == 1 ? g[5] : F.lane == 2 ? g[6] : g[7]) + F.in[IN_GATEB][4 + F.lane];
                LI[(size_t)V * 4 + F.lane] = gi;
                LF[(size_t)V * 4 + F.lane] = fminf(gf, 0.f) - log1pf(__expf(-fabsf(gf)));
            }
        }
        __syncthreads();
    }
    { float* BGUP = (float*)(ws + WS_BGUP); float* RWT = (float*)(ws + WS_RWT);
      for (int u = gt; u < NE * 2 * DFF; u += NGT) { const int e = u >> 11, n = u & 2047, pn = n >> 8, bj = (n >> 7) & 1, j = gu_slot(n & 127); BGUP[u] = F.in[IN_BGU][(size_t)e * 2 * DFF + 2 * (128 * pn + j) + bj]; }
      for (int u = gt; u < NE * D; u += NGT) { const int e = u >> 10, k = u & 1023; RWT[u] = F.in[IN_NFFN][k] * F.in[IN_RW][(size_t)k * NE + e]; } }
}

__device__ __forceinline__ void p0b_quant(Frame& F) {
    unsigned char* ws = F.ws; const int gw = F.vcu * NWAVES + F.wave, NGW = F.G * NWAVES, lane = F.lane;
    LAS float* scr = (LAS float*)(F.lds + RING_OFF + F.wave * 16384);
    unsigned char* W8 = ws + WS_WIN8; float* SCOL = (float*)(ws + WS_SCOL); const float* W = F.in[IN_WIN]; const float* kscale = F.in[IN_NMIX];
    constexpr int I_IN1 = 16 * 96, I_IN2 = 16 * 64;
    const int r = lane >> 3, c4 = (lane & 7) * 4;
    __syncthreads();
    if (F.tid == 0) { unsigned sp = 0; while (__hip_atomic_load(F.ctl + CW_P0ARR, RLX_AGENT) < (unsigned)F.G) { __builtin_amdgcn_s_sleep(2); if (++sp > (1u << 22)) break; } }
    __syncthreads();
    for (int it = gw; it < I_IN1 + I_IN2; it += NGW) {
        int kb, nb, col0, dstrow0;
        if (it < I_IN1) { kb = it / 96; nb = it % 96; col0 = 32 * nb; dstrow0 = 32 * nb; } else { const int q = it - I_IN1; kb = q / 64; nb = q % 64; col0 = 3080 + 32 * nb; dstrow0 = 3072 + 32 * nb; }
        const int k0 = 64 * kb;
        f32x4 v[8];
#pragma unroll
        for (int i = 0; i < 8; ++i) v[i] = *(const GAS f32x4*)(W + (size_t)(k0 + 8 * i + r) * NIN + col0 + c4);
        float qs[4];
#pragma unroll
        for (int e = 0; e < 4; ++e) { const float m = __builtin_bit_cast(float, __hip_atomic_load(F.ctl + CW_CMAX + dstrow0 + c4 + e, RLX_AGENT)); qs[e] = 127.f / fmaxf(m, 1e-30f); }
        if (kb == 0 && lane < 8) {
#pragma unroll
            for (int e = 0; e < 4; ++e) SCOL[dstrow0 + c4 + e] = 1.f / qs[e]; }
#pragma unroll
        for (int i = 0; i < 8; ++i) { const float sc = kscale[k0 + 8 * i + r]; LAS float* s = scr + (8 * i + r) * 33 + c4; s[0] = rintf(v[i].x * sc * qs[0]); s[1] = rintf(v[i].y * sc * qs[1]); s[2] = rintf(v[i].z * sc * qs[2]); s[3] = rintf(v[i].w * sc * qs[3]); }
        LDS_WAIT(); asm volatile("" ::: "memory");
        const int c = lane & 7;
#pragma unroll
        for (int j = 0; j < 4; ++j) { const int n = (lane >> 3) + 8 * j; const LAS float* s = scr + (8 * c) * 33 + n;
            v2u o;
            o.x = ((unsigned)(int)s[0 * 33] & 0xffu) | (((unsigned)(int)s[1 * 33] & 0xffu) << 8) | (((unsigned)(int)s[2 * 33] & 0xffu) << 16) | ((unsigned)(int)s[3 * 33] << 24);
            o.y = ((unsigned)(int)s[4 * 33] & 0xffu) | (((unsigned)(int)s[5 * 33] & 0xffu) << 8) | (((unsigned)(int)s[6 * 33] & 0xffu) << 16) | ((unsigned)(int)s[7 * 33] << 24);
            *(GAS v2u*)(W8 + (size_t)(dstrow0 + n) * D + k0 + 8 * c) = o; }
        LDS_WAIT(); asm volatile("" ::: "memory");
    }
}

__device__ __forceinline__ unsigned pk4_fp8(float a, float b, float c, float d) { unsigned w = 0;
    a = __builtin_amdgcn_fmed3f(a, -448.f, 448.f); b = __builtin_amdgcn_fmed3f(b, -448.f, 448.f); c = __builtin_amdgcn_fmed3f(c, -448.f, 448.f); d = __builtin_amdgcn_fmed3f(d, -448.f, 448.f);
    w = __builtin_amdgcn_cvt_pk_fp8_f32(a, b, w, false); w = __builtin_amdgcn_cvt_pk_fp8_f32(c, d, w, true); return w; }
__device__ __forceinline__ void cvdn_load(const float* Wdn, int it, f32x4 (&v)[8], int lane) {
    const int e = it >> 9, kb = (it >> 5) & 15, nb = it & 31, r = lane >> 3, c4 = (lane & 7) * 4; const float* W = Wdn + (size_t)e * DFF * D;
#pragma unroll
    for (int i = 0; i < 8; ++i) v[i] = *(const GAS f32x4*)(W + (size_t)(64 * kb + 8 * i + r) * D + 32 * nb + c4);
}
__device__ __forceinline__ void cvdn_proc(unsigned char* WTdn, int it, const f32x4 (&v)[8], LAS float* scr, int lane) {
    const int e = it >> 9, kb = (it >> 5) & 15, nb = it & 31, r = lane >> 3, c4 = (lane & 7) * 4; unsigned char* WT = WTdn + (size_t)e * D * DFF;
#pragma unroll
    for (int i = 0; i < 8; ++i) { LAS float* s = scr + (8 * i + r) * 33 + c4; s[0] = v[i].x * 32.f; s[1] = v[i].y * 32.f; s[2] = v[i].z * 32.f; s[3] = v[i].w * 32.f; }
    LDS_WAIT(); asm volatile("" ::: "memory");
    const int c = lane & 7;
#pragma unroll
    for (int j = 0; j < 4; ++j) { const int n = (lane >> 3) + 8 * j; const LAS float* s = scr + (8 * c) * 33 + n;
        v2u o; o.x = pk4_fp8(s[0 * 33], s[1 * 33], s[2 * 33], s[3 * 33]); o.y = pk4_fp8(s[4 * 33], s[5 * 33], s[6 * 33], s[7 * 33]);
        const int cn = 32 * nb + n, rowp = (cn & ~255) + 128 * ((cn >> 3) & 1) + 32 * ((cn >> 6) & 3) + 8 * ((cn >> 4) & 3) + (cn & 7);
        *(GAS v2u*)(WT + (size_t)rowp * DFF + 64 * kb + 8 * c) = o; }
    LDS_WAIT(); asm volatile("" ::: "memory");
}
__device__ __forceinline__ void cvgu_load(const float* Wgu, const float* nffn, int it, f32x4 (&v)[8], float (&sc)[8], int lane) {
    const int e = it >> 10, kb = (it >> 5) & 31, nb = it & 31, r = lane >> 4, c4 = (lane & 15) * 4; const float* W = Wgu + (size_t)e * D * 2 * DFF;
#pragma unroll
    for (int i = 0; i < 8; ++i) { v[i] = *(const GAS f32x4*)(W + (size_t)(32 * kb + 4 * i + r) * (2 * DFF) + 64 * nb + c4); sc[i] = nffn[32 * kb + 4 * i + r] * 32.f; }
}
__device__ __forceinline__ void cvgu_proc(unsigned char* WTgu, int it, const f32x4 (&v)[8], const float (&sc)[8], LAS float* scr, int lane) {
    const int e = it >> 10, kb = (it >> 5) & 31, nb = it & 31, r = lane >> 4, c4 = (lane & 15) * 4, A0 = 32 * nb, k0 = 32 * kb; unsigned char* WT = WTgu + (size_t)e * 2 * DFF * D;
    LAS float* sg = scr; LAS float* su = scr + 32 * 33;
#pragma unroll
    for (int i = 0; i < 8; ++i) { const int o = (4 * i + r) * 33 + (c4 >> 1); sg[o] = v[i].x * sc[i]; su[o] = v[i].y * sc[i]; sg[o + 1] = v[i].z * sc[i]; su[o + 1] = v[i].w * sc[i]; }
    LDS_WAIT(); asm volatile("" ::: "memory");
    const int c = lane & 3;
#pragma unroll
    for (int j = 0; j < 4; ++j) { const int q = (lane >> 2) + 16 * j, isup = q >> 5, jj = q & 31, A = A0 + jj; const LAS float* s = scr + isup * 32 * 33 + (8 * c) * 33 + jj;
        v2u o; o.x = pk4_fp8(s[0 * 33], s[1 * 33], s[2 * 33], s[3 * 33]); o.y = pk4_fp8(s[4 * 33], s[5 * 33], s[6 * 33], s[7 * 33]);
        *(GAS v2u*)(WT + (size_t)(256 * (A >> 7) + 128 * isup + gu_slot(A & 127)) * D + k0 + 8 * c) = o; }
    LDS_WAIT(); asm volatile("" ::: "memory");
}
__device__ __forceinline__ void px_experts(Frame& F, int rank, int nwg) {
    unsigned char* ws = F.ws;
    LAS float* scr = (LAS float*)(F.lds + RING_OFF + F.wave * 16384);
    const int gw = rank * NWAVES + F.wave, NGW = nwg * NWAVES;
    { constexpr int NIT = NE * 1024; f32x4 v[8], vn[8]; float sc[8], sn[8]; int it = gw;
      if (it < NIT) cvgu_load(F.in[IN_WGU], F.in[IN_NFFN], it, v, sc, F.lane);
      while (it < NIT) { const int nx = it + NGW; if (nx < NIT) cvgu_load(F.in[IN_WGU], F.in[IN_NFFN], nx, vn, sn, F.lane);
          asm volatile("" ::: "memory");
          cvgu_proc((unsigned char*)(ws + WS_WGU), it, v, sc, scr, F.lane); asm volatile("" ::: "memory");
#pragma unroll
          for (int i = 0; i < 8; ++i) { v[i] = vn[i]; sc[i] = sn[i]; }
          it = nx; } }
    { constexpr int NIT = NE * 512; f32x4 v[8], vn[8]; int it = gw;
      if (it < NIT) cvdn_load(F.in[IN_WDN], it, v, F.lane);
      while (it < NIT) { const int nx = it + NGW; if (nx < NIT) cvdn_load(F.in[IN_WDN], nx, vn, F.lane);
          asm volatile("" ::: "memory");
          cvdn_proc((unsigned char*)(ws + WS_WDN), it, v, scr, F.lane); asm volatile("" ::: "memory");
#pragma unroll
          for (int i = 0; i < 8; ++i) v[i] = vn[i];
          it = nx; } }
}

namespace pg8 {
typedef unsigned v2u_t __attribute__((ext_vector_type(2)));
typedef float f32x2 __attribute__((ext_vector_type(2)));
__device__ __forceinline__ f32x2 sig2(f32x2 x) { const f32x2 t = x * (f32x2){-1.4426950408889634f, -1.4426950408889634f};
    const f32x2 d = (f32x2){__builtin_amdgcn_exp2f(t.x), __builtin_amdgcn_exp2f(t.y)} + (f32x2){1.f, 1.f}; return (f32x2){__builtin_amdgcn_rcpf(d.x), __builtin_amdgcn_rcpf(d.y)}; }
__device__ __forceinline__ u32x4 pack8(const f32x4& a, const f32x4& b) { u32x4 w; w.x = cvt_pk_bf16(a[0], a[1]); w.y = cvt_pk_bf16(a[2], a[3]); w.z = cvt_pk_bf16(b[0], b[1]); w.w = cvt_pk_bf16(b[2], b[3]); return w; }
__device__ __forceinline__ v2u_t pack8_fp8(const f32x4& a, const f32x4& b) { unsigned lo = 0, hi = 0;
    lo = __builtin_amdgcn_cvt_pk_fp8_f32(a[0], a[1], lo, false); lo = __builtin_amdgcn_cvt_pk_fp8_f32(a[2], a[3], lo, true);
    hi = __builtin_amdgcn_cvt_pk_fp8_f32(b[0], b[1], hi, false); hi = __builtin_amdgcn_cvt_pk_fp8_f32(b[2], b[3], hi, true); return (v2u_t){lo, hi}; }
__device__ __forceinline__ v2u_t pack8_fp8_sat(const f32x4& a, const f32x4& b) { f32x4 x, y;
#pragma unroll
    for (int i = 0; i < 4; ++i) { x[i] = __builtin_amdgcn_fmed3f(a[i], -448.f, 448.f); y[i] = __builtin_amdgcn_fmed3f(b[i], -448.f, 448.f); }
    return pack8_fp8(x, y); }
__device__ __forceinline__ void unpack8(const u32x4& w, f32x4& a, f32x4& b) { a = (f32x4){bflo(w.x), bfhi(w.x), bflo(w.y), bfhi(w.y)}; b = (f32x4){bflo(w.z), bfhi(w.z), bflo(w.w), bfhi(w.w)}; }
__host__ __device__ __forceinline__ int gate_pos(int c) { return (c & ~255) + ((((c >> 5) & 3) * 4 + ((c >> 3) & 3)) * 16) + (((c >> 7) & 1) * 8) + (c & 7); }
__device__ __forceinline__ unsigned q8x4(float a, float b, float c, float d) {
    const unsigned t0 = __builtin_bit_cast(unsigned, __builtin_fmaf(a, 255.f, 8388608.f)), t1 = __builtin_bit_cast(unsigned, __builtin_fmaf(b, 255.f, 8388608.f));
    const unsigned t2 = __builtin_bit_cast(unsigned, __builtin_fmaf(c, 255.f, 8388608.f)), t3 = __builtin_bit_cast(unsigned, __builtin_fmaf(d, 255.f, 8388608.f));
    return (t0 & 0xffu) | (t1 << 8) | (t2 << 16) | (t3 << 24); }
__device__ __forceinline__ f32x4 dq8x4(unsigned w) { return (f32x4){(float)(w & 0xffu), (float)((w >> 8) & 0xffu), (float)((w >> 16) & 0xffu), (float)(w >> 24)}; }
struct EpiNull { static constexpr bool PERM = true, AFTER_DRAIN = false; int* sink;
    __device__ __forceinline__ void operator()(const f32x4 (&acc)[2][2][4][2], const Unit& u, int wr, int wc, int fr, int fq) const { int s = 0;
#pragma unroll
        for (int a = 0; a < 2; ++a)
#pragma unroll
            for (int b = 0; b < 2; ++b)
#pragma unroll
                for (int m = 0; m < 4; ++m)
#pragma unroll
                    for (int n = 0; n < 2; ++n) { const i32x4 q = __builtin_bit_cast(i32x4, acc[a][b][m][n]); s += (q[0] ^ q[1]) + (q[2] ^ q[3]); }
        if (s == 0x7fffff01 + u.pm) sink[0] = s; } };
template <bool Q, bool NS = false>
struct EpiProjT {
    static constexpr bool PERM = true, AFTER_DRAIN = false;
    unsigned char* ws; const float* lbl; const float* srow; const float* scol;
    struct Sc { float rs[8]; f32x2 cs[2][4]; };
    __device__ __forceinline__ f32x2 val(const f32x4 (&acc)[2][2][4][2], const Sc& sc, int ai, int bj, int m, int k) const {
        const f32x4 a = acc[ai][bj][m][k >> 1];
        if constexpr (Q) { const i32x4 q = __builtin_bit_cast(i32x4, a); const float r = sc.rs[ai * 4 + m]; return ((f32x2){(float)q[2 * (k & 1)], (float)q[2 * (k & 1) + 1]} * sc.cs[bj][k]) * (f32x2){r, r}; }
        else return (f32x2){a[2 * (k & 1)], a[2 * (k & 1) + 1]};
    }
    template <int ACT>
    __device__ __forceinline__ void emit(const f32x4 (&acc)[2][2][4][2], const Sc& sc, bf16_t* O, int row0, int colt) const {
#pragma unroll
        for (int ai = 0; ai < 2; ++ai)
#pragma unroll
            for (int m = 0; m < 4; ++m) { bf16_t* rowp = O + (size_t)(row0 + ai * HALF + m * 16) * HW + colt;
#pragma unroll
                for (int bj = 0; bj < 2; ++bj) { u32x4 o;
#pragma unroll
                    for (int k = 0; k < 4; ++k) { f32x2 p = val(acc, sc, ai, bj, m, k);
                        if constexpr (ACT == 1) p = p * sig2(p); else if constexpr (ACT == 2) p = sig2(p);
                        o[k] = cvt_pk_bf16(p.x, p.y); }
                    if constexpr (NS) asm volatile("" :: "v"(o.x), "v"(o.y), "v"(o.z), "v"(o.w)); else *(u32x4*)(rowp + bj * HALF) = o; } }
    }
    __device__ __forceinline__ void operator()(const f32x4 (&acc)[2][2][4][2], const Unit& u, int wr, int wc, int fr, int fq) const {
        const int row0 = u.pm * BM + wr * 64 + fr, kind = u.pn < 12 ? (u.pn >> 1) : 6;
        const int colt = (u.pn < 12 ? (u.pn & 1) : (u.pn - 12)) * BM + wc * 32 + 8 * fq;
        Sc sc;
        if constexpr (Q) {
#pragma unroll
            for (int it = 0; it < 8; ++it) sc.rs[it] = srow[row0 + (it >> 2) * HALF + (it & 3) * 16];
#pragma unroll
            for (int bj = 0; bj < 2; ++bj) { const float* cp = scol + u.pn * BM + wc * 32 + 8 * fq + bj * HALF; const f32x4 c0 = *(const f32x4*)cp, c1 = *(const f32x4*)(cp + 4);
                sc.cs[bj][0] = (f32x2){c0[0], c0[1]}; sc.cs[bj][1] = (f32x2){c0[2], c0[3]}; sc.cs[bj][2] = (f32x2){c1[0], c1[1]}; sc.cs[bj][3] = (f32x2){c1[2], c1[3]}; }
        }
        if (kind == 1) {
            bf16_t* HG = (bf16_t*)(ws + WS_HG);
#pragma unroll
            for (int bj = 0; bj < 2; ++bj) { const int c = colt + bj * HALF; f32x2 lb[4], ol[4];
#pragma unroll
                for (int k = 0; k < 4; ++k) { lb[k] = sig2((f32x2){lbl[c + 2 * k] - lbl[HW + c + 2 * k], lbl[c + 2 * k + 1] - lbl[HW + c + 2 * k + 1]}); ol[k] = (f32x2){1.f, 1.f} - lb[k]; }
#pragma unroll
                for (int ai = 0; ai < 2; ++ai)
#pragma unroll
                    for (int m = 0; m < 4; ++m) { u32x4 o;
#pragma unroll
                        for (int k = 0; k < 4; ++k) { const f32x2 f = ol[k] * sig2(val(acc, sc, ai, bj, m, k)) + lb[k];
                            const f32x2 lg = (f32x2){__builtin_amdgcn_logf(f.x), __builtin_amdgcn_logf(f.y)} * (f32x2){0.6931471805599453f, 0.6931471805599453f}; o[k] = cvt_pk_bf16(lg.x, lg.y); }
                        if constexpr (NS) asm volatile("" :: "v"(o.x), "v"(o.y), "v"(o.z), "v"(o.w)); else *(u32x4*)(HG + (size_t)(row0 + ai * HALF + m * 16) * HW + c) = o; } }
            return;
        }
        if (kind == 6) {
            unsigned char* G8 = ws + WS_GATES; const int gofs = (u.pn - 12) * BM + (wc * 4 + fq) * 16;
#pragma unroll
            for (int ai = 0; ai < 2; ++ai)
#pragma unroll
                for (int m = 0; m < 4; ++m) { u32x4 o;
#pragma unroll
                    for (int bj = 0; bj < 2; ++bj)
#pragma unroll
                        for (int h = 0; h < 2; ++h) {
                            const f32x2 sa = sig2(val(acc, sc, ai, bj, m, 2 * h)), sb = sig2(val(acc, sc, ai, bj, m, 2 * h + 1));
                            o[2 * bj + h] = q8x4(sa.x, sa.y, sb.x, sb.y); }
                    if constexpr (NS) asm volatile("" :: "v"(o.x), "v"(o.y), "v"(o.z), "v"(o.w)); else __builtin_nontemporal_store(o, (u32x4*)(G8 + (size_t)(row0 + ai * HALF + m * 16) * 2048 + gofs)); }
            return;
        }
        if (kind == 0) emit<1>(acc, sc, (bf16_t*)(ws + WS_HQ), row0, colt); else if (kind == 2) emit<0>(acc, sc, (bf16_t*)(ws + WS_HV), row0, colt); else if (kind == 3) emit<1>(acc, sc, (bf16_t*)(ws + WS_HGATE), row0, colt);
        else if (kind == 4) emit<0>(acc, sc, (bf16_t*)(ws + WS_MM), row0, colt); else emit<2>(acc, sc, (bf16_t*)(ws + WS_MO), row0, colt);
    }
};
constexpr int PAIR_DA = 132, PAIR_DB = 4;
struct PairOrder { StaticOrder S;
    __device__ __forceinline__ bool next(int i, Unit& u) const { Unit t; if (!S.next(i >> 1, t)) return false; const int s = i & 1; u.pm = t.pm + PAIR_DA * s; u.pn = t.pn + PAIR_DB * s; return true; }
    __device__ __forceinline__ void a_ready(const Unit&) const {}
    __device__ __forceinline__ void done(const Unit&) const {}
};
struct EpiGate2 {
    static constexpr bool PERM = true, AFTER_DRAIN = false;
    const unsigned char* __restrict__ gates; bf16_t* __restrict__ tmp; bf16_t* __restrict__ merged;
    __device__ __forceinline__ void operator()(const f32x4 (&acc)[2][2][4][2], const Unit& u, int wr, int wc, int fr, int fq) const {
        const int step = u.pm >= PAIR_DA ? 1 : 0, pm = u.pm - PAIR_DA * step, pn = u.pn - PAIR_DB * step;
        const int row0 = pm * BM + wr * 64 + fr, col0 = pn * BM + wc * 32 + 8 * fq, gofs = step * D + pn * BM + (wc * 4 + fq) * 16;
        constexpr int NB = 2, NBAT = 8 / NB;
        bf16_t* obuf = tmp + (ptrdiff_t)(merged - tmp) * step;
        u32x4 gc[NB], tc[NB][2], gn[NB], tn[NB][2];
#define EG_LOAD(G, T, b_) do { _Pragma("unroll") for (int s_ = 0; s_ < NB; ++s_) { const int it_ = (b_) * NB + s_; const size_t row_ = (size_t)(row0 + (it_ >> 2) * HALF + (it_ & 3) * 16); G[s_] = *(const u32x4*)(gates + row_ * 2048 + gofs); _Pragma("unroll") for (int bj = 0; bj < 2; ++bj) { \
        if (step) T[s_][bj] = *(const u32x4*)(tmp + row_ * D + col0 + bj * HALF); else T[s_][bj] = (u32x4){0u, 0u, 0u, 0u}; } } } while (0)
        EG_LOAD(gc, tc, 0);
#pragma unroll
        for (int b = 0; b < NBAT; ++b) {
            if (b + 1 < NBAT) EG_LOAD(gn, tn, b + 1);
#pragma unroll
            for (int s = 0; s < NB; ++s) { const int it = b * NB + s, ai = it >> 2, m = it & 3; const size_t row = (size_t)(row0 + ai * HALF + m * 16);
#pragma unroll
                for (int bj = 0; bj < 2; ++bj) { const int c = col0 + bj * HALF; f32x4 t0, t1; unpack8(tc[s][bj], t0, t1); const f32x4 g0 = dq8x4(gc[s][2 * bj]), g1 = dq8x4(gc[s][2 * bj + 1]);
                    const u32x4 o = pack8(acc[ai][bj][m][0] * g0 + t0, acc[ai][bj][m][1] * g1 + t1);
                    *(u32x4*)(obuf + row * D + c) = o; } }
#pragma unroll
            for (int s = 0; s < NB; ++s)
#pragma unroll
                for (int bj = 0; bj < 2; ++bj) tc[s][bj] = tn[s][bj];
#pragma unroll
            for (int s = 0; s < NB; ++s) gc[s] = gn[s]; }
#undef EG_LOAD
    }
};
struct EpiH1 {
    static constexpr bool PERM = true, AFTER_DRAIN = false;
    const bf16_t* __restrict__ xn0; const float* __restrict__ xsq; bf16_t* __restrict__ H1; unsigned char* __restrict__ H1B8;
    __device__ __forceinline__ void operator()(const f32x4 (&acc)[2][2][4][2], const Unit& u, int wr, int wc, int fr, int fq) const {
        const int row0 = u.pm * BM + wr * 64 + fr, col0 = u.pn * BM + wc * 32 + 8 * fq;
        u32x4 xc[2], xn[2]; float sc, sn;
#define EH_LOAD(X, S_, it_) do { const size_t r_ = (size_t)(row0 + ((it_) >> 2) * HALF + ((it_) & 3) * 16); const bf16_t* src_ = xn0 + r_ * D + col0; S_ = xsq[r_]; _Pragma("unroll") for (int bj = 0; bj < 2; ++bj) X[bj] = *(const u32x4*)(src_ + bj * HALF); } while (0)
        EH_LOAD(xc, sc, 0);
#pragma unroll
        for (int it = 0; it < 8; ++it) { const int ai = it >> 2, m = it & 3; const size_t V = (size_t)(row0 + ai * HALF + m * 16);
            if (it + 1 < 8) EH_LOAD(xn, sn, it + 1);
#pragma unroll
            for (int bj = 0; bj < 2; ++bj) { const int c = col0 + bj * HALF; f32x4 x0, x1; unpack8(xc[bj], x0, x1);
                const f32x4 v0 = x0 * sc + acc[ai][bj][m][0], v1 = x1 * sc + acc[ai][bj][m][1];
                __builtin_nontemporal_store(pack8(v0, v1), (u32x4*)(H1 + V * D + c)); *(v2u_t*)(H1B8 + V * D + c) = pack8_fp8_sat(v0, v1); }
#pragma unroll
            for (int bj = 0; bj < 2; ++bj) xc[bj] = xn[bj];
            sc = sn; }
#undef EH_LOAD
    }
};
template <bool NS = false>
struct EpiGUT {
    static constexpr bool PERM = true, AFTER_DRAIN = false;
    const float* __restrict__ bgup; const float* __restrict__ ers; unsigned char* __restrict__ act; const PG8_LAS int* pst;
    __device__ __forceinline__ void operator()(const f32x4 (&acc)[2][2][4][2], const Unit& u, int wr, int wc, int fr, int fq) const {
        const int e = u.pn >> 3, pn = u.pn & 7, row0 = u.pm * BM + wr * 64 + fr, cc = wc * 32 + 8 * fq;
        const float* rsp = ers + (size_t)e * NV + (row0 - pst[e]);
        const float* bp = bgup + (size_t)e * 2 * DFF + pn * BM + cc;
        f32x2 bg[2][2], bu[2][2];
#pragma unroll
        for (int h = 0; h < 2; ++h) { const f32x4 g4 = *(const f32x4*)(bp + 4 * h), u4 = *(const f32x4*)(bp + HALF + 4 * h);
            bg[h][0] = (f32x2){g4[0], g4[1]}; bg[h][1] = (f32x2){g4[2], g4[3]}; bu[h][0] = (f32x2){u4[0] + 1.f, u4[1] + 1.f}; bu[h][1] = (f32x2){u4[2] + 1.f, u4[3] + 1.f}; }
        float rsv[8];
#pragma unroll
        for (int it = 0; it < 8; ++it) rsv[it] = rsp[(it >> 2) * HALF + (it & 3) * 16];
        const int hi = fq >> 1;
        unsigned char* obase = act + (size_t)(row0 + 16 * hi) * DFF + pn * HALF + wc * 32 + 16 * (fq & 1);
        constexpr float KS = -1.702f * 1.4426950408889634f;
#pragma unroll
        for (int ai = 0; ai < 2; ++ai)
#pragma unroll
            for (int mp = 0; mp < 2; ++mp) { v2u_t pk[2];
#pragma unroll
                for (int q = 0; q < 2; ++q) { const int m = 2 * mp + q; const float rs = rsv[ai * 4 + m] * 0.03125f;
                    const f32x2 rs2 = {rs, rs}; unsigned w[2];
#pragma unroll
                    for (int h = 0; h < 2; ++h) { f32x2 o[2];
#pragma unroll
                        for (int p = 0; p < 2; ++p) {
                            f32x2 g = (f32x2){acc[ai][0][m][h][2 * p], acc[ai][0][m][h][2 * p + 1]} * rs2 + bg[h][p];
                            f32x2 u1 = (f32x2){acc[ai][1][m][h][2 * p], acc[ai][1][m][h][2 * p + 1]} * rs2 + bu[h][p];
                            g.x = fminf(g.x, 7.f); g.y = fminf(g.y, 7.f); u1.x = __builtin_amdgcn_fmed3f(u1.x, -6.f, 8.f); u1.y = __builtin_amdgcn_fmed3f(u1.y, -6.f, 8.f);
                            const f32x2 t = g * (f32x2){KS, KS};
                            const f32x2 d = (f32x2){__builtin_amdgcn_exp2f(t.x), __builtin_amdgcn_exp2f(t.y)} + (f32x2){1.f, 1.f};
                            const f32x2 r = {__builtin_amdgcn_rcpf(d.x), __builtin_amdgcn_rcpf(d.y)};
                            o[p] = (g * r) * u1; }
                        w[h] = __builtin_amdgcn_cvt_pk_fp8_f32(o[0].x, o[0].y, 0u, false); w[h] = __builtin_amdgcn_cvt_pk_fp8_f32(o[1].x, o[1].y, w[h], true); }
                    pk[q] = (v2u_t){w[0], w[1]}; }
                const auto r0 = __builtin_amdgcn_permlane32_swap(pk[0][0], pk[1][0], false, false), r1 = __builtin_amdgcn_permlane32_swap(pk[0][1], pk[1][1], false, false);
                if constexpr (NS) asm volatile("" :: "v"(r0[0]), "v"(r1[0]), "v"(r0[1]), "v"(r1[1])); else *(u32x4*)(obase + (size_t)(ai * HALF + mp * 32) * DFF) = (u32x4){r0[0], r1[0], r0[1], r1[1]}; }
    }
};
template <bool NS = false>
struct EpiDownT {
    static constexpr bool PERM = true, AFTER_DRAIN = false;
    const float* __restrict__ bdn; const float* __restrict__ ew; unsigned char* __restrict__ yb; const PG8_LAS int* pst;
    __device__ __forceinline__ void operator()(const f32x4 (&acc)[2][2][4][2], const Unit& u, int wr, int wc, int fr, int fq) const {
        const int e = u.pn >> 2, pn = u.pn & 3, row0 = u.pm * BM + wr * 64 + fr, col0 = pn * BM + wc * 64 + 16 * fq;
        const float* wp = ew + (size_t)e * NV + (row0 - pst[e]);
        f32x4 bv[2][2];
#pragma unroll
        for (int bj = 0; bj < 2; ++bj) { bv[bj][0] = *(const f32x4*)(bdn + (size_t)e * D + col0 + 8 * bj); bv[bj][1] = *(const f32x4*)(bdn + (size_t)e * D + col0 + 8 * bj + 4); }
        float wv[8];
#pragma unroll
        for (int it = 0; it < 8; ++it) wv[it] = wp[(it >> 2) * HALF + (it & 3) * 16];
#pragma unroll
        for (int ai = 0; ai < 2; ++ai)
#pragma unroll
            for (int m = 0; m < 4; ++m) { const size_t row = (size_t)(row0 + ai * HALF + m * 16); const float w = wv[ai * 4 + m] * 16.f;
                const v2u_t lo = pack8_fp8_sat((acc[ai][0][m][0] * 0.03125f + bv[0][0]) * w, (acc[ai][0][m][1] * 0.03125f + bv[0][1]) * w), hi = pack8_fp8_sat((acc[ai][1][m][0] * 0.03125f + bv[1][0]) * w, (acc[ai][1][m][1] * 0.03125f + bv[1][1]) * w);
                if constexpr (NS) asm volatile("" :: "v"(lo[0]), "v"(lo[1]), "v"(hi[0]), "v"(hi[1])); else __builtin_nontemporal_store((u32x4){lo[0], lo[1], hi[0], hi[1]}, (u32x4*)(yb + row * D + col0)); }
    }
};
struct GroupOrder {
    int ntiles, ncol, G, c; const PG8_LAS unsigned char* texp;
    __device__ __forceinline__ bool next(int i, Unit& u) const { const int x = c & 7, w = c >> 3, uu = i * (G >> 3) + w, lj = uu / ncol, pn = uu - lj * ncol, j = lj * 8 + x; if (j >= ntiles) return false; u.pm = j; u.pn = (int)texp[j] * ncol + pn; return true; }
    __device__ __forceinline__ void a_ready(const Unit&) const {}
    __device__ __forceinline__ void done(const Unit&) const {}
};
typedef EpiDownT<false> EpiDown; typedef EpiGUT<false> EpiGU;
}

typedef short bf16x8 __attribute__((ext_vector_type(8)));
typedef float f32x16 __attribute__((ext_vector_type(16)));
#define MFMA32(a, b, c) __builtin_amdgcn_mfma_f32_32x32x16_bf16(a, b, c, 0, 0, 0)
__device__ __forceinline__ bf16x8 ldfrag(const LAS unsigned char* base, int st, int row0, int k0, int lane) { return *(const LAS bf16x8*)(base + (row0 + (lane & 31)) * st + (k0 + 8 * (lane >> 5)) * 2); }
__device__ __forceinline__ bf16x8 ldf(const LAS unsigned char* lanebase, int off) { return *(const LAS bf16x8*)(lanebase + off); }
__device__ __forceinline__ float fexp(float x) { return __builtin_amdgcn_exp2f(x * 1.4426950408889634f); }

__device__ __forceinline__ void p3_hgrn2_mfma(Frame& F, int bh) {
    unsigned char* ws = F.ws; const int b = bh >> 2, h = bh & 3, tid = F.tid, lane = F.lane, wave = F.wave, hh = lane >> 5, l31 = lane & 31;
    const bf16* HQ = (const bf16*)(ws + WS_HQ) + h * 128; const bf16* HG = (const bf16*)(ws + WS_HG) + h * 128; const bf16* HV = (const bf16*)(ws + WS_HV) + h * 128;
    const bf16* HGATE = (const bf16*)(ws + WS_HGATE) + h * 128; bf16* YHG = (bf16*)(ws + WS_YHG) + h * 128;
    LAS unsigned char* L = F.lds + RING_OFF;
    LAS unsigned char* QT = L; LAS unsigned char* KT = L + 17408; LAS unsigned char* KTT = L + 34816; LAS unsigned char* VT = L + 53248; LAS unsigned char* ST = L + 71680; LAS unsigned char* PP = L + 106496;
    LAS float* SEG = (LAS float*)(L + 115712); LAS float* ER = (LAS float*)(L + 117760); LAS float* EL = (LAS float*)(L + 118272); LAS float* OST = (LAS float*)(L + 17408);
    const int d = tid & 127, pq = tid >> 7;
    const int et = tid >> 3, evq = tid & 7;
    const int f144 = l31 * 144 + hh * 16, f272 = l31 * 272 + hh * 16;
    const int sst = wave == 2 ? 1 : 0, stt = wave == 0 ? 0 : 1, dt = wave & 3, vt0 = 2 * (wave >> 2), btt = wave & 1, bvt = wave >> 1;
    const LAS unsigned char* aK = KT + 32 * sst * 272 + f272; const LAS unsigned char* bQ = QT + 32 * stt * 272 + f272;
    LAS unsigned char* pst = PP + (32 * stt + l31) * 144 + (32 * sst + 4 * hh) * 2;
    const LAS unsigned char* aKTT = KTT + 32 * dt * 144 + f144; const LAS unsigned char* bV0 = VT + 32 * vt0 * 144 + f144;
    LAS unsigned char* sst_ = ST + (32 * vt0 + l31) * 272 + (32 * dt + 4 * hh) * 2;
    const LAS float* erp = ER + 32 * dt + 4 * hh; const LAS float* elp = EL + 32 * dt + 4 * hh;
    const LAS unsigned char* aP = PP + 32 * btt * 144 + f144; const LAS unsigned char* bVB = VT + 32 * bvt * 144 + f144;
    const LAS unsigned char* aQ = QT + 32 * btt * 272 + f272; const LAS unsigned char* bS = ST + 32 * bvt * 272 + f272;
    LAS float* ost = OST + (32 * btt + 4 * hh) * 132 + 32 * bvt + l31; const LAS float* oep = OST + et * 132 + 16 * evq;
    LAS unsigned char* tq = QT + 16 * pq * 272 + d * 2; LAS unsigned char* tk = KT + 16 * pq * 272 + d * 2; LAS unsigned char* tkt = KTT + d * 144 + pq * 32; LAS unsigned char* tv = VT + d * 144 + pq * 32;
    f32x16 S0, S1;
#pragma unroll
    for (int i = 0; i < 16; ++i) { S0[i] = 0.f; S1[i] = 0.f; }
    unsigned gr[16], qr[16], vr[16]; v4u gt0, gt1;
    float gn[16];
#pragma unroll
    for (int i = 0; i < 16; ++i) gn[i] = F.in[IN_HGNORM][h * 128 + 16 * evq + i];
#define HG_LOAD(c) do { const int ttb = 64 * (c) - 48 + 16 * pq; \
        _Pragma("unroll") for (int i = 0; i < 16; ++i) { const int tt = ttb + i; if (tt >= 0) { const size_t gi = rowof(b, tt) * HW + d; gr[i] = (unsigned)HG[gi]; qr[i] = (unsigned)HQ[gi]; vr[i] = (unsigned)HV[gi]; } else { gr[i] = 0u; qr[i] = 0u; vr[i] = 0u; } } \
        { const int tt = 64 * (c) - 48 + et; if (tt >= 0) { const GAS v4u* gp = (const GAS v4u*)(HGATE + rowof(b, tt) * HW + 16 * evq); gt0 = gp[0]; gt1 = gp[1]; } else { gt0 = (v4u){0u, 0u, 0u, 0u}; gt1 = gt0; } } } while (0)
    HG_LOAD(0);
    for (int c = 0; c < 33; ++c) {
        float bl[16], gq[16];
#pragma unroll
        for (int i = 0; i < 16; ++i) gq[i] = __builtin_bit_cast(float, gr[i] << 16);
        { float a = 0.f;
#pragma unroll
          for (int i = 0; i < 16; ++i) { a += gq[i]; bl[i] = a; } }
        SEG[pq * 128 + d] = bl[15];
        __syncthreads();
        { const float s0 = SEG[d], s1 = SEG[128 + d], s2 = SEG[256 + d], s3 = SEG[384 + d];
          const float off = pq == 0 ? 0.f : pq == 1 ? s0 : pq == 2 ? s0 + s1 : (s0 + s1) + s2, r = s0 + s1, blast = (s0 + s1) + (s2 + s3);
          unsigned kp[8], vp[8];
#pragma unroll
          for (int i = 0; i < 16; i += 2) {
              const float b0 = off + bl[i], b1 = off + bl[i + 1];
              const float q0 = __builtin_bit_cast(float, qr[i] << 16) * fexp(b0 - r), q1 = __builtin_bit_cast(float, qr[i + 1] << 16) * fexp(b1 - r);
              const float k0 = (1.f - fexp(gq[i])) * fexp(r - b0), k1 = (1.f - fexp(gq[i + 1])) * fexp(r - b1);
              const unsigned kk = pg8::cvt_pk_bf16(k0, k1), qq = pg8::cvt_pk_bf16(q0, q1);
              *(LAS unsigned short*)(tq + i * 272) = (unsigned short)qq; *(LAS unsigned short*)(tq + (i + 1) * 272) = (unsigned short)(qq >> 16);
              *(LAS unsigned short*)(tk + i * 272) = (unsigned short)kk; *(LAS unsigned short*)(tk + (i + 1) * 272) = (unsigned short)(kk >> 16);
              kp[i >> 1] = kk; vp[i >> 1] = vr[i] | (vr[i + 1] << 16); }
          *(LAS v4u*)(tkt) = (v4u){kp[0], kp[1], kp[2], kp[3]}; *(LAS v4u*)(tkt + 16) = (v4u){kp[4], kp[5], kp[6], kp[7]};
          *(LAS v4u*)(tv) = (v4u){vp[0], vp[1], vp[2], vp[3]}; *(LAS v4u*)(tv + 16) = (v4u){vp[4], vp[5], vp[6], vp[7]};
          if (pq == 0) { ER[d] = fexp(r); EL[d] = fexp(blast - r); } }
        const v4u g0 = gt0, g1 = gt1;
        __syncthreads();
        if (c + 1 < 33) HG_LOAD(c + 1);
        asm volatile("" ::: "memory");
        if (wave < 3) {
            f32x16 acc;
#pragma unroll
            for (int i = 0; i < 16; ++i) acc[i] = 0.f;
#pragma unroll
            for (int ks = 0; ks < 8; ++ks) acc = MFMA32(ldf(aK, 32 * ks), ldf(bQ, 32 * ks), acc);
            const int t = 32 * stt + l31;
#pragma unroll
            for (int g4 = 0; g4 < 4; ++g4) { const int s0 = 32 * sst + 8 * g4 + 4 * hh;
                const float x0 = (s0 + 0 <= t) ? acc[4 * g4 + 0] : 0.f, x1 = (s0 + 1 <= t) ? acc[4 * g4 + 1] : 0.f, x2 = (s0 + 2 <= t) ? acc[4 * g4 + 2] : 0.f, x3 = (s0 + 3 <= t) ? acc[4 * g4 + 3] : 0.f;
                *(LAS v2u*)(pst + 16 * g4) = (v2u){pg8::cvt_pk_bf16(x0, x1), pg8::cvt_pk_bf16(x2, x3)}; }
        }
        {
#pragma unroll
          for (int g4 = 0; g4 < 4; ++g4) { const f32x4 er = *(const LAS f32x4*)(erp + 8 * g4);
#pragma unroll
              for (int i = 0; i < 4; ++i) { S0[4 * g4 + i] *= er[i]; S1[4 * g4 + i] *= er[i]; }
              *(LAS v2u*)(sst_ + 16 * g4) = (v2u){pg8::cvt_pk_bf16(S0[4 * g4], S0[4 * g4 + 1]), pg8::cvt_pk_bf16(S0[4 * g4 + 2], S0[4 * g4 + 3])};
              *(LAS v2u*)(sst_ + 32 * 272 + 16 * g4) = (v2u){pg8::cvt_pk_bf16(S1[4 * g4], S1[4 * g4 + 1]), pg8::cvt_pk_bf16(S1[4 * g4 + 2], S1[4 * g4 + 3])}; }
#pragma unroll
          for (int ks = 0; ks < 4; ++ks) { const bf16x8 a = ldf(aKTT, 32 * ks); S0 = MFMA32(a, ldf(bV0, 32 * ks), S0); S1 = MFMA32(a, ldf(bV0, 32 * 144 + 32 * ks), S1); }
#pragma unroll
          for (int g4 = 0; g4 < 4; ++g4) { const f32x4 el = *(const LAS f32x4*)(elp + 8 * g4);
#pragma unroll
              for (int i = 0; i < 4; ++i) { S0[4 * g4 + i] *= el[i]; S1[4 * g4 + i] *= el[i]; } } }
        __syncthreads();
        { f32x16 acc;
#pragma unroll
          for (int i = 0; i < 16; ++i) acc[i] = 0.f;
#pragma unroll
          for (int ks = 0; ks < 4; ++ks) if (ks < 2 || btt == 1) acc = MFMA32(ldf(aP, 32 * ks), ldf(bVB, 32 * ks), acc);
#pragma unroll
          for (int ks = 0; ks < 8; ++ks) acc = MFMA32(ldf(aQ, 32 * ks), ldf(bS, 32 * ks), acc);
#pragma unroll
          for (int i = 0; i < 16; ++i) ost[((i & 3) + 8 * (i >> 2)) * 132] = acc[i]; }
        __syncthreads();
        { const int tt = 64 * c - 48 + et;
          f32x4 o[4]; float ss = 0.f;
#pragma unroll
          for (int j = 0; j < 4; ++j) { o[j] = *(const LAS f32x4*)(oep + 4 * j); ss += (o[j].x * o[j].x + o[j].y * o[j].y) + (o[j].z * o[j].z + o[j].w * o[j].w); }
          ss += __shfl_xor(ss, 1); ss += __shfl_xor(ss, 2); ss += __shfl_xor(ss, 4);
          const float rs = 1.0f / sqrtf(ss * (1.f / 128.f) + EPS);
          if (tt >= NMETA || (tt >= 0 && b == 0)) { const unsigned gw[8] = {g0.x, g0.y, g0.z, g0.w, g1.x, g1.y, g1.z, g1.w}; unsigned w[8];
#pragma unroll
              for (int j = 0; j < 4; ++j) { w[2 * j] = pk2(o[j].x * rs * gn[4 * j] * bflo(gw[2 * j]), o[j].y * rs * gn[4 * j + 1] * bfhi(gw[2 * j])); w[2 * j + 1] = pk2(o[j].z * rs * gn[4 * j + 2] * bflo(gw[2 * j + 1]), o[j].w * rs * gn[4 * j + 3] * bfhi(gw[2 * j + 1])); }
              GAS v4u* yp = (GAS v4u*)(YHG + rowof(b, tt) * HW + 16 * evq); yp[0] = (v4u){w[0], w[1], w[2], w[3]}; yp[1] = (v4u){w[4], w[5], w[6], w[7]}; } }
        __syncthreads();
    }
#undef HG_LOAD
}


#define DPP_F(old, v, ctrl, rmask) __builtin_bit_cast(float, __builtin_amdgcn_update_dpp(__builtin_bit_cast(int, (float)(old)), __builtin_bit_cast(int, (float)(v)), (ctrl), (rmask), 0xf, false))
__device__ __forceinline__ float wave_scan_add(float v) {
    v += DPP_F(0.f, v, 0x111, 0xf); v += DPP_F(0.f, v, 0x112, 0xf); v += DPP_F(0.f, v, 0x114, 0xf); v += DPP_F(0.f, v, 0x118, 0xf);
    v += DPP_F(0.f, v, 0x142, 0xa); v += DPP_F(0.f, v, 0x143, 0xc); return v;
}
__device__ __forceinline__ float wave_scan_max(float v) {
    const float ni = -INFINITY;
    v = fmaxf(v, DPP_F(ni, v, 0x111, 0xf)); v = fmaxf(v, DPP_F(ni, v, 0x112, 0xf)); v = fmaxf(v, DPP_F(ni, v, 0x114, 0xf)); v = fmaxf(v, DPP_F(ni, v, 0x118, 0xf));
    v = fmaxf(v, DPP_F(ni, v, 0x142, 0xa)); v = fmaxf(v, DPP_F(ni, v, 0x143, 0xc)); return v;
}
__device__ __forceinline__ void p3_mlstm_mfma(Frame& F, int bh) {
    unsigned char* ws = F.ws; const int b = bh >> 2, h = bh & 3, tid = F.tid, lane = F.lane, wave = F.wave, hh = lane >> 5, l31 = lane & 31;
    const bf16* MMg = (const bf16*)(ws + WS_MM) + h * 128; const bf16* MOg = (const bf16*)(ws + WS_MO) + h * 128; const float* LI = (const float*)(ws + WS_LI) + h; const float* LF = (const float*)(ws + WS_LF) + h;
    bf16* YML = (bf16*)(ws + WS_YML) + h * 128;
    LAS unsigned char* L = F.lds + RING_OFF;
    LAS unsigned char* CT = L; LAS unsigned char* MT = L + 17408; LAS unsigned char* KM = L + 34816; LAS unsigned char* KW = L + 44032; LAS unsigned char* QM = L + 53248; LAS unsigned char* QW = L + 62464;
    LAS unsigned char* VT = L + 71680; LAS unsigned char* SV = L + 90112; LAS unsigned char* PP = L + 108544; LAS float* OST = (LAS float*)(L + 17408);
    LAS float* SM = (LAS float*)(L + 117760);
    LAS float* U = SM; LAS float* MX = SM + 64; LAS float* BB = SM + 128; LAS float* WSs = SM + 192; LAS float* WI = SM + 256; LAS float* DENP = SM + 320  ; LAS float* NN = SM + 416; LAS float* DENI = SM + 480; LAS float* SC = SM + 544  ; LAS float* GNS = SM + 560  ;
    const int ch = tid & 127, pq = tid >> 7, et = tid >> 3, evq = tid & 7;
    const int f144 = l31 * 144 + hh * 16, f272 = l31 * 272 + hh * 16;
    const int sst = wave == 2 ? 1 : 0, stt = wave == 0 ? 0 : 1, dkt = wave & 1, svt = wave >> 1;
    const LAS unsigned char* cfp = (wave < 4 ? CT : MT) + f272;
    LAS unsigned char* qst = QM + l31 * 144 + (32 * (wave & 1) + 4 * hh) * 2; LAS unsigned char* qwst = QW + l31 * 144 + (32 * (wave & 1) + 4 * hh) * 2;
    const int kdk = 32 * (wave & 1) + l31;
    LAS unsigned char* kmst = KM + 4 * hh * 144 + kdk * 2; LAS unsigned char* kwst = KW + kdk * 144 + 4 * hh * 2; const LAS float* wsp = WSs + 4 * hh;
    LAS unsigned char* vst = VT + (32 * (wave & 3) + l31) * 144 + 4 * hh * 2;
    const LAS unsigned char* aKM = KM + 32 * sst * 144 + f144; const LAS unsigned char* bQM = QM + 32 * stt * 144 + f144;
    LAS unsigned char* pst = PP + (32 * stt + l31) * 144 + (32 * sst + 4 * hh) * 2; const LAS float* up = U + 32 * sst + 4 * hh;
    LAS unsigned char* svst = SV + (32 * svt + l31) * 144 + (32 * dkt + 4 * hh) * 2;
    const LAS unsigned char* aKW = KW + 32 * dkt * 144 + f144; const LAS unsigned char* bVT = VT + 32 * svt * 144 + f144;
    const LAS unsigned char* aP = PP + 32 * dkt * 144 + f144; const LAS unsigned char* aQW = QW + 32 * dkt * 144 + f144; const LAS unsigned char* bSV = SV + 32 * svt * 144 + f144;
    LAS float* ost = OST + (32 * dkt + 4 * hh) * 132 + 32 * svt + l31; const LAS float* oep = OST + et * 132 + 16 * evq;
    LAS unsigned char* tc = CT + 16 * pq * 272 + ch * 2; LAS unsigned char* tm = MT + 16 * pq * 272 + ch * 2;
    bf16x8 wf[8];
    { const float* W = wave < 2 ? F.in[IN_WQ] + (size_t)h * 128 * 64 + 32 * wave + l31 : wave < 4 ? F.in[IN_WK] + (size_t)h * 128 * 64 + 32 * (wave - 2) + l31 : F.in[IN_WV] + (size_t)h * 128 * 128 + 32 * (wave - 4) + l31;
      const int ld = wave < 4 ? 64 : 128; const float sc = wave < 2 ? 0.125f : 1.f;
#pragma unroll
      for (int ks = 0; ks < 8; ++ks) { unsigned p[4];
#pragma unroll
          for (int j = 0; j < 4; ++j) p[j] = pk2(W[(size_t)(16 * ks + 8 * hh + 2 * j) * ld] * sc, W[(size_t)(16 * ks + 8 * hh + 2 * j + 1) * ld] * sc);
          wf[ks] = __builtin_bit_cast(bf16x8, (v4u){p[0], p[1], p[2], p[3]}); } }
    float cw[4]; const float cb = F.in[IN_CONVB][h * 128 + ch];
#pragma unroll
    for (int j = 0; j < 4; ++j) cw[j] = F.in[IN_CONVW][j * HW + h * 128 + ch];
    if (tid < 128) GNS[tid] = F.in[IN_MLNORM][h * 128 + tid]; else if (tid < 256) GNS[tid] = F.in[IN_MLSKIP][h * 128 + tid - 128];
    f32x16 S;
#pragma unroll
    for (int i = 0; i < 16; ++i) S[i] = 0.f;
    float mcar = 0.f, nreg = 0.f;
    unsigned mr[19]; v4u gt0, gt1; float pli = 0.f, plf = 0.f;
#define ML_LOAD(c) do { const int ttb = 64 * (c) - 48 + 16 * pq - 3; \
        _Pragma("unroll") for (int i = 0; i < 19; ++i) { const int tt = ttb + i; mr[i] = tt >= 0 ? (unsigned)MMg[rowof(b, tt) * HW + ch] : 0u; } \
        { const int tt = 64 * (c) - 48 + et; if (tt >= 0) { const GAS v4u* gp = (const GAS v4u*)(MOg + rowof(b, tt) * HW + 16 * evq); gt0 = gp[0]; gt1 = gp[1]; } else { gt0 = (v4u){0u, 0u, 0u, 0u}; gt1 = gt0; } } \
        if (wave == 0) { const int tt = 64 * (c) - 48 + lane; if (tt >= 0) { pli = LI[rowof(b, tt) * 4]; plf = LF[rowof(b, tt) * 4]; } else { pli = -1e30f; plf = 0.f; } } } while (0)
    ML_LOAD(0);
    for (int c = 0; c < 33; ++c) {
#pragma unroll
        for (int i = 0; i < 16; ++i) { const float a = cb + (cw[0] * __builtin_bit_cast(float, mr[i] << 16) + cw[1] * __builtin_bit_cast(float, mr[i + 1] << 16)) + (cw[2] * __builtin_bit_cast(float, mr[i + 2] << 16) + cw[3] * __builtin_bit_cast(float, mr[i + 3] << 16));
            *(LAS unsigned short*)(tc + i * 272) = (unsigned short)f2bf(fsilu(a)); *(LAS unsigned short*)(tm + i * 272) = (unsigned short)mr[i + 3]; }
        if (wave == 0) {
            const float bs = wave_scan_add(plf);
            const float u = pli - bs; const float pm = wave_scan_max(u);
            const float M = fmaxf(mcar, pm), M63 = __shfl(M, 63), b63 = __shfl(bs, 63);
            U[lane] = u; MX[lane] = M; BB[lane] = bs; WSs[lane] = fexp(u - M63); WI[lane] = fexp(mcar - M);
            if (lane == 0) { SC[0] = b63; SC[1] = M63; }
        }
        __syncthreads();
        { f32x16 a0, a1;
#pragma unroll
          for (int i = 0; i < 16; ++i) { a0[i] = 0.f; a1[i] = 0.f; }
          if (wave < 2) {
#pragma unroll
              for (int ks = 0; ks < 8; ++ks) { a0 = MFMA32(wf[ks], ldf(cfp, 32 * ks), a0); a1 = MFMA32(wf[ks], ldf(cfp, 32 * 272 + 32 * ks), a1); }
              const float wi0 = WI[l31], wi1 = WI[32 + l31];
#pragma unroll
              for (int g4 = 0; g4 < 4; ++g4) {
                  *(LAS v2u*)(qst + 16 * g4) = (v2u){pg8::cvt_pk_bf16(a0[4 * g4], a0[4 * g4 + 1]), pg8::cvt_pk_bf16(a0[4 * g4 + 2], a0[4 * g4 + 3])};
                  *(LAS v2u*)(qst + 32 * 144 + 16 * g4) = (v2u){pg8::cvt_pk_bf16(a1[4 * g4], a1[4 * g4 + 1]), pg8::cvt_pk_bf16(a1[4 * g4 + 2], a1[4 * g4 + 3])};
                  *(LAS v2u*)(qwst + 16 * g4) = (v2u){pg8::cvt_pk_bf16(a0[4 * g4] * wi0, a0[4 * g4 + 1] * wi0), pg8::cvt_pk_bf16(a0[4 * g4 + 2] * wi0, a0[4 * g4 + 3] * wi0)};
                  *(LAS v2u*)(qwst + 32 * 144 + 16 * g4) = (v2u){pg8::cvt_pk_bf16(a1[4 * g4] * wi1, a1[4 * g4 + 1] * wi1), pg8::cvt_pk_bf16(a1[4 * g4 + 2] * wi1, a1[4 * g4 + 3] * wi1)}; }
          } else {
#pragma unroll
              for (int ks = 0; ks < 8; ++ks) { a0 = MFMA32(ldf(cfp, 32 * ks), wf[ks], a0); a1 = MFMA32(ldf(cfp, 32 * 272 + 32 * ks), wf[ks], a1); }
              if (wave < 4) {
                  float nsum = 0.f;
#pragma unroll
                  for (int g4 = 0; g4 < 4; ++g4) { const f32x4 w0 = *(const LAS f32x4*)(wsp + 8 * g4), w1 = *(const LAS f32x4*)(wsp + 32 + 8 * g4);
#pragma unroll
                      for (int i = 0; i < 4; ++i) { *(LAS unsigned short*)(kmst + (8 * g4 + i) * 144) = (unsigned short)f2bf(a0[4 * g4 + i]); *(LAS unsigned short*)(kmst + (32 + 8 * g4 + i) * 144) = (unsigned short)f2bf(a1[4 * g4 + i]); }
                      const float x0 = a0[4 * g4] * w0[0], x1 = a0[4 * g4 + 1] * w0[1], x2 = a0[4 * g4 + 2] * w0[2], x3 = a0[4 * g4 + 3] * w0[3];
                      const float y0 = a1[4 * g4] * w1[0], y1 = a1[4 * g4 + 1] * w1[1], y2 = a1[4 * g4 + 2] * w1[2], y3 = a1[4 * g4 + 3] * w1[3];
                      nsum += ((x0 + x1) + (x2 + x3)) + ((y0 + y1) + (y2 + y3));
                      *(LAS v2u*)(kwst + 16 * g4) = (v2u){pg8::cvt_pk_bf16(x0, x1), pg8::cvt_pk_bf16(x2, x3)};
                      *(LAS v2u*)(kwst + 64 + 16 * g4) = (v2u){pg8::cvt_pk_bf16(y0, y1), pg8::cvt_pk_bf16(y2, y3)}; }
                  nsum += __shfl_xor(nsum, 32);
                  if (hh == 0) NN[kdk] = nreg;
                  nreg = fexp(mcar - SC[1]) * nreg + nsum;
              } else {
#pragma unroll
                  for (int g4 = 0; g4 < 4; ++g4) {
                      *(LAS v2u*)(vst + 16 * g4) = (v2u){pg8::cvt_pk_bf16(a0[4 * g4], a0[4 * g4 + 1]), pg8::cvt_pk_bf16(a0[4 * g4 + 2], a0[4 * g4 + 3])};
                      *(LAS v2u*)(vst + 64 + 16 * g4) = (v2u){pg8::cvt_pk_bf16(a1[4 * g4], a1[4 * g4 + 1]), pg8::cvt_pk_bf16(a1[4 * g4 + 2], a1[4 * g4 + 3])}; }
              }
          } }
        __syncthreads();
        const v4u g0 = gt0, g1 = gt1;
        if (c + 1 < 33) ML_LOAD(c + 1);
        asm volatile("" ::: "memory");
        if (wave < 3) {
            f32x16 acc;
#pragma unroll
            for (int i = 0; i < 16; ++i) acc[i] = 0.f;
#pragma unroll
            for (int ks = 0; ks < 4; ++ks) acc = MFMA32(ldf(aKM, 32 * ks), ldf(bQM, 32 * ks), acc);
            const int t = 32 * stt + l31; const float mt = MX[t]; float dsum = 0.f;
#pragma unroll
            for (int g4 = 0; g4 < 4; ++g4) { const int s0 = 32 * sst + 8 * g4 + 4 * hh; const f32x4 us = *(const LAS f32x4*)(up + 8 * g4);
                const float x0 = (s0 + 0 <= t) ? acc[4 * g4 + 0] * fexp(us[0] - mt) : 0.f, x1 = (s0 + 1 <= t) ? acc[4 * g4 + 1] * fexp(us[1] - mt) : 0.f;
                const float x2 = (s0 + 2 <= t) ? acc[4 * g4 + 2] * fexp(us[2] - mt) : 0.f, x3 = (s0 + 3 <= t) ? acc[4 * g4 + 3] * fexp(us[3] - mt) : 0.f;
                dsum += (x0 + x1) + (x2 + x3);
                *(LAS v2u*)(pst + 16 * g4) = (v2u){pg8::cvt_pk_bf16(x0, x1), pg8::cvt_pk_bf16(x2, x3)}; }
            dsum += __shfl_xor(dsum, 32);
            if (hh == 0) DENP[wave * 32 + l31] = dsum;
        } else if (wave == 3) {
            float a = 0.f;
#pragma unroll 2
            for (int j = 0; j < 8; ++j) { const v4u q = *(const LAS v4u*)(QW + lane * 144 + 16 * j); const f32x4 n0 = *(const LAS f32x4*)(NN + 8 * j), n1 = *(const LAS f32x4*)(NN + 8 * j + 4);
                a += (bflo(q.x) * n0[0] + bfhi(q.x) * n0[1]) + (bflo(q.y) * n0[2] + bfhi(q.y) * n0[3]) + (bflo(q.z) * n1[0] + bfhi(q.z) * n1[1]) + (bflo(q.w) * n1[2] + bfhi(q.w) * n1[3]); }
            DENI[lane] = a;
        }
        { const float wp = fexp(mcar - SC[1]);
#pragma unroll
          for (int g4 = 0; g4 < 4; ++g4) {
              *(LAS v2u*)(svst + 16 * g4) = (v2u){pg8::cvt_pk_bf16(S[4 * g4], S[4 * g4 + 1]), pg8::cvt_pk_bf16(S[4 * g4 + 2], S[4 * g4 + 3])};
#pragma unroll
              for (int i = 0; i < 4; ++i) S[4 * g4 + i] *= wp; }
#pragma unroll
          for (int ks = 0; ks < 4; ++ks) S = MFMA32(ldf(aKW, 32 * ks), ldf(bVT, 32 * ks), S); }
        __syncthreads();
        { f32x16 acc;
#pragma unroll
          for (int i = 0; i < 16; ++i) acc[i] = 0.f;
#pragma unroll
          for (int ks = 0; ks < 4; ++ks) if (ks < 2 || dkt == 1) acc = MFMA32(ldf(aP, 32 * ks), ldf(bVT, 32 * ks), acc);
#pragma unroll
          for (int ks = 0; ks < 4; ++ks) acc = MFMA32(ldf(aQW, 32 * ks), ldf(bSV, 32 * ks), acc);
#pragma unroll
          for (int i = 0; i < 16; ++i) ost[((i & 3) + 8 * (i >> 2)) * 132] = acc[i]; }
        __syncthreads();
        { const int tt = 64 * c - 48 + et;
          const float den = (et < 32 ? DENP[et] : DENP[et] + DENP[32 + et]) + DENI[et];
          const float inv = 1.0f / fmaxf(fabsf(den), fexp(-(BB[et] + MX[et])));
          f32x4 o[4]; float ss = 0.f;
#pragma unroll
          for (int j = 0; j < 4; ++j) { o[j] = *(const LAS f32x4*)(oep + 4 * j) * inv; ss += (o[j].x * o[j].x + o[j].y * o[j].y) + (o[j].z * o[j].z + o[j].w * o[j].w); }
          ss += __shfl_xor(ss, 1); ss += __shfl_xor(ss, 2); ss += __shfl_xor(ss, 4);
          const float rs = 1.0f / sqrtf(ss * (1.f / 128.f) + EPS);
          if (tt >= NMETA || (tt >= 0 && b == 0)) { const unsigned gw[8] = {g0.x, g0.y, g0.z, g0.w, g1.x, g1.y, g1.z, g1.w}; unsigned w[8];
              const v4u c0 = *(const LAS v4u*)(CT + et * 272 + 32 * evq), c1 = *(const LAS v4u*)(CT + et * 272 + 32 * evq + 16); const unsigned cwd[8] = {c0.x, c0.y, c0.z, c0.w, c1.x, c1.y, c1.z, c1.w};
#pragma unroll
              for (int j = 0; j < 4; ++j) { const f32x4 gn = *(const LAS f32x4*)(GNS + 16 * evq + 4 * j), sk = *(const LAS f32x4*)(GNS + 128 + 16 * evq + 4 * j);
                  w[2 * j] = pk2((o[j].x * rs * gn[0] + sk[0] * bflo(cwd[2 * j])) * bflo(gw[2 * j]), (o[j].y * rs * gn[1] + sk[1] * bfhi(cwd[2 * j])) * bfhi(gw[2 * j]));
                  w[2 * j + 1] = pk2((o[j].z * rs * gn[2] + sk[2] * bflo(cwd[2 * j + 1])) * bflo(gw[2 * j + 1]), (o[j].w * rs * gn[3] + sk[3] * bfhi(cwd[2 * j + 1])) * bfhi(gw[2 * j + 1])); }
              GAS v4u* yp = (GAS v4u*)(YML + rowof(b, tt) * HW + 16 * evq); yp[0] = (v4u){w[0], w[1], w[2], w[3]}; yp[1] = (v4u){w[4], w[5], w[6], w[7]}; }
          mcar = SC[0] + SC[1]; }
        __syncthreads();
    }
#undef ML_LOAD
}

typedef float f32x4v __attribute__((ext_vector_type(4)));
#define MFMA16F(a, b, c) __builtin_amdgcn_mfma_f32_16x16x4f32(a, b, c, 0, 0, 0)
constexpr int RW_LD = 516;
__device__ __forceinline__ void router_topk16(LAS float* LGw, int V, float rsv, int resrow, int lane, LAS int* hist, LAS int* res, int* TOPE, float* TOPW, float* RS) {
    if (lane < 16) {
        int se[4]; float sv[4];
#pragma unroll
        for (int k = 0; k < 4; ++k) { float best = -INFINITY; int bi = 0;
            for (int e = 0; e < 32; ++e) { const float v = LGw[lane * 33 + e]; if (v > best) { best = v; bi = e; } }
            se[k] = bi; sv[k] = best; LGw[lane * 33 + bi] = -INFINITY; }
        const float e1 = __expf(sv[1] - sv[0]), e2 = __expf(sv[2] - sv[0]), e3 = __expf(sv[3] - sv[0]), inv = 1.0f / (1.f + e1 + e2 + e3);
        const float w4[4] = {inv, e1 * inv, e2 * inv, e3 * inv};
#pragma unroll
        for (int k = 0; k < 4; ++k) { const int lp = __hip_atomic_fetch_add(hist + se[k], 1, __ATOMIC_RELAXED, __HIP_MEMORY_SCOPE_WORKGROUP);
            TOPE[(size_t)V * 4 + k] = se[k]; TOPW[(size_t)V * 4 + k] = w4[k]; res[(resrow + lane) * 4 + k] = lp; }
        RS[V] = rsv;
    }
}
__device__ __forceinline__ void p6_router(Frame& F) {
    unsigned char* ws = F.ws;
    const bf16* H1 = (const bf16*)(ws + WS_H1); const float* RWT = (const float*)(ws + WS_RWT);
    int* TOPE = (int*)(ws + WS_TOPE); int* TOPP = (int*)(ws + WS_TOPP); float* TOPW = (float*)(ws + WS_TOPW); float* RS = (float*)(ws + WS_RS);
    int* ETOK = (int*)(ws + WS_ETOK); float* ERS = (float*)(ws + WS_ERS); float* EW = (float*)(ws + WS_EW);
    LAS float* rw = (LAS float*)(F.lds + RING_OFF);
    LAS float* LG = (LAS float*)(F.lds + RING_OFF + 66048) + F.wave * 528;
    LAS int* hist = (LAS int*)(F.lds + RING_OFF + 66048 + 8 * 2112);
    LAS int* res = hist + 64;
    LAS float* XP = (LAS float*)(res + 144 * 4);
    LAS float* XQ = XP + 8 * 528;
    const int lane = F.lane, wave = F.wave, i16 = lane & 15, kk = lane >> 4;
    constexpr int RPW = NTOK / 256;
    const bool has_meta = (F.vcu == 0);
    const int Vbase = F.vcu * RPW, Vt = Vbase + 16 * wave;
    if (F.tid < 64) hist[F.tid] = 0;
    f32x4v acc0 = {0.f, 0.f, 0.f, 0.f}, acc1 = {0.f, 0.f, 0.f, 0.f}, acx0 = {0.f, 0.f, 0.f, 0.f}, acx1 = {0.f, 0.f, 0.f, 0.f}; float ssq = 0.f, xss = 0.f;
    const bf16* arow = H1 + (size_t)(Vt + i16) * D + 8 * kk;
    const bf16* xrow = H1 + (size_t)(NTOK + i16) * D + 8 * kk;
    v4u a0[4], a1[4];
#define RT_MMA(A, SB, C0, C1, SS) do { const LAS float* b0p = rw + i16 * RW_LD + 8 * kk + 128 * (SB); const LAS float* b1p = rw + (16 + i16) * RW_LD + 8 * kk + 128 * (SB); \
        _Pragma("unroll") for (int s = 0; s < 4; ++s) { const v4u aw = A[s]; \
            _Pragma("unroll") for (int h = 0; h < 2; ++h) { const unsigned w0 = h ? aw.z : aw.x, w1 = h ? aw.w : aw.y; const f32x4 a = {bflo(w0), bfhi(w0), bflo(w1), bfhi(w1)}; \
            const f32x4 b0 = *(const LAS f32x4*)(b0p + 32 * s + 4 * h), b1 = *(const LAS f32x4*)(b1p + 32 * s + 4 * h); \
            SS += (a.x * a.x + a.y * a.y) + (a.z * a.z + a.w * a.w); \
            C0 = MFMA16F(a.x, b0.x, C0); C1 = MFMA16F(a.x, b1.x, C1); C0 = MFMA16F(a.y, b0.y, C0); C1 = MFMA16F(a.y, b1.y, C1); \
            C0 = MFMA16F(a.z, b0.z, C0); C1 = MFMA16F(a.z, b1.z, C1); C0 = MFMA16F(a.w, b0.w, C0); C1 = MFMA16F(a.w, b1.w, C1); } } } while (0)
#pragma unroll
    for (int s = 0; s < 4; ++s) a0[s] = *(const GAS v4u*)(arow + 32 * s);
#pragma unroll 1
    for (int it = 0; it < 4; ++it) {
        const int half = it >> 1, sb0 = (2 * it) & 3;
        if ((it & 1) == 0) {
            __syncthreads();
            { f32x4 stg[8];
#pragma unroll
              for (int q = 0; q < 8; ++q) { const int u = F.tid + q * NTHREADS, e = u >> 7, c = u & 127; stg[q] = *(const GAS f32x4*)(RWT + (size_t)e * D + 512 * half + 4 * c); }
#pragma unroll
              for (int q = 0; q < 8; ++q) { const int u = F.tid + q * NTHREADS, e = u >> 7, c = u & 127; *(LAS f32x4*)(rw + e * RW_LD + 4 * c) = stg[q]; } }
            __syncthreads();
        }
#pragma unroll
        for (int s = 0; s < 4; ++s) a1[s] = *(const GAS v4u*)(arow + 128 * (2 * it + 1) + 32 * s);
        RT_MMA(a0, sb0, acc0, acc1, ssq);
        if (it < 3) {
#pragma unroll
            for (int s = 0; s < 4; ++s) a0[s] = *(const GAS v4u*)(arow + 128 * (2 * it + 2) + 32 * s);
        }
        RT_MMA(a1, sb0 + 1, acc0, acc1, ssq);
        if (has_meta && (wave >> 1) == it) {
            v4u ax[4];
#pragma unroll
            for (int s = 0; s < 4; ++s) ax[s] = *(const GAS v4u*)(xrow + 128 * wave + 32 * s);
            RT_MMA(ax, wave & 3, acx0, acx1, xss);
        }
    }
#undef RT_MMA
    if (has_meta) {
        xss += __shfl_xor(xss, 16); xss += __shfl_xor(xss, 32);
#pragma unroll
        for (int r = 0; r < 4; ++r) { XP[wave * 528 + (4 * kk + r) * 33 + i16] = acx0[r]; XP[wave * 528 + (4 * kk + r) * 33 + 16 + i16] = acx1[r]; }
        if (kk == 0) XQ[wave * 16 + i16] = xss;
    }
    ssq += __shfl_xor(ssq, 16); ssq += __shfl_xor(ssq, 32);
    const float rsrow = 1.0f / sqrtf(ssq * (1.f / D) + EPS);
    const float rb0 = F.in[IN_RB][i16], rb1 = F.in[IN_RB][16 + i16];
#pragma unroll
    for (int r = 0; r < 4; ++r) { const float rsr = __shfl(rsrow, 4 * kk + r); LG[(4 * kk + r) * 33 + i16] = acc0[r] * rsr + rb0; LG[(4 * kk + r) * 33 + 16 + i16] = acc1[r] * rsr + rb1; }
    LDS_WAIT(); asm volatile("" ::: "memory");
    router_topk16(LG, Vt + lane, rsrow, 16 * wave, lane, hist, res, TOPE, TOPW, RS);
    __syncthreads();
    if (has_meta && wave == 7) {
        float q = 0.f;
#pragma unroll
        for (int w = 0; w < 8; ++w) q += XQ[w * 16 + i16];
        const float rsm = 1.0f / sqrtf(q * (1.f / D) + EPS);
#pragma unroll
        for (int r = 0; r < 4; ++r) { float v0 = 0.f, v1 = 0.f;
#pragma unroll
            for (int w = 0; w < 8; ++w) { v0 += XP[w * 528 + (4 * kk + r) * 33 + i16]; v1 += XP[w * 528 + (4 * kk + r) * 33 + 16 + i16]; }
            const float rsr = __shfl(rsm, 4 * kk + r); LG[(4 * kk + r) * 33 + i16] = v0 * rsr + rb0; LG[(4 * kk + r) * 33 + 16 + i16] = v1 * rsr + rb1; }
        LDS_WAIT(); asm volatile("" ::: "memory");
        router_topk16(LG, NTOK + lane, rsm, 128, lane, hist, res, TOPE, TOPW, RS);
    }
    __syncthreads();
    if (F.tid < NE) hist[32 + F.tid] = (int)__hip_atomic_fetch_add(F.ctl + CW_CNT + 64 * F.tid, (unsigned)hist[F.tid], RLX_AGENT);
    __syncthreads();
    const int nrows = has_meta ? RPW + 16 : RPW;
    for (int u = F.tid; u < nrows * 4; u += NTHREADS) { const int rr = u >> 2, V = rr < RPW ? Vbase + rr : NTOK + (rr - RPW); const size_t gi = (size_t)V * 4 + (u & 3); const int e = TOPE[gi], pos = hist[32 + e] + res[u];
        TOPP[gi] = pos; ETOK[(size_t)e * NV + pos] = V; ERS[(size_t)e * NV + pos] = RS[V]; EW[(size_t)e * NV + pos] = TOPW[gi]; }
}

__device__ __forceinline__ void build_tables(Frame& F) {
    LAS int* pst = (LAS int*)(F.lds + PST_OFF); LAS unsigned char* texp = (LAS unsigned char*)(F.lds + TEXP_OFF);
    __syncthreads();
    if (F.tid < 64) {
        const int e = F.lane & 31; const int c = (int)__hip_atomic_load(F.ctl + CW_CNT + 64 * e, RLX_AGENT); const int nt = (c + 255) >> 8;
        int incl = nt;
#pragma unroll
        for (int o = 1; o < 32; o <<= 1) { const int t = __shfl_up(incl, o); if ((F.lane & 31) >= o) incl += t; }
        const int start = incl - nt;
        if (F.lane < 32) { pst[e] = start * 256; pst[33 + e] = c; for (int j = 0; j < nt && start + j < MAXTILES; ++j) texp[start + j] = (unsigned char)e; if (e == 31) pst[32] = incl < MAXTILES ? incl : MAXTILES; }
    }
    __syncthreads();
}
typedef float f32v2_t __attribute__((ext_vector_type(2)));
__device__ __forceinline__ void p10_combine(Frame& F) {
    unsigned char* ws = F.ws; build_tables(F);
    const LAS int* pst = (const LAS int*)(F.lds + PST_OFF);
    const bf16* H1 = (const bf16*)(ws + WS_H1); const unsigned char* YB = (const unsigned char*)(ws + WS_YB);
    const int* TOPE = (const int*)(ws + WS_TOPE); const int* TOPP = (const int*)(ws + WS_TOPP);
    const int gw = F.vcu * NWAVES + F.wave, NGW = F.G * NWAVES;
    const GAS f32x4* nf = (const GAS f32x4*)F.in[IN_NFIN] + F.lane; f32x4 nfv[4];
#pragma unroll
    for (int j = 0; j < 4; ++j) nfv[j] = nf[64 * j];
    int sl[2][4];
#define CMB_SLOTS(Rbase) do { _Pragma("unroll") for (int q = 0; q < 2; ++q) { const int R = (Rbase) + q * NGW; if (R < BATCH * SEQ) { const size_t V = (size_t)R; \
        _Pragma("unroll") for (int k = 0; k < 4; ++k) sl[q][k] = pst[TOPE[V * 4 + k]] + TOPP[V * 4 + k]; } else { _Pragma("unroll") for (int k = 0; k < 4; ++k) sl[q][k] = 0; } } } while (0)
    CMB_SLOTS(gw);
    for (int R0 = gw; R0 < BATCH * SEQ; R0 += 2 * NGW) {
        f32x4 v[2][4]; unsigned y[2][4][4];
#pragma unroll
        for (int q = 0; q < 2; ++q) { const int R = (R0 + q * NGW < BATCH * SEQ) ? R0 + q * NGW : R0; const size_t V = (size_t)R;
            const GAS v2u* hr = (const GAS v2u*)(H1 + V * D) + F.lane;
#pragma unroll
            for (int j = 0; j < 4; ++j) { const v2u hw = hr[64 * j]; v[q][j] = (f32x4){bflo(hw.x), bfhi(hw.x), bflo(hw.y), bfhi(hw.y)}; }
#pragma unroll
            for (int k = 0; k < 4; ++k) { const GAS unsigned* yr = (const GAS unsigned*)(YB + (size_t)sl[q][k] * D) + F.lane;
#pragma unroll
                for (int j = 0; j < 4; ++j) y[q][k][j] = yr[64 * j]; } }
        CMB_SLOTS(R0 + 2 * NGW);
#pragma unroll
        for (int q = 0; q < 2; ++q) { const int R = R0 + q * NGW; if (R >= BATCH * SEQ) continue;
#pragma unroll
            for (int k = 0; k < 4; ++k)
#pragma unroll
                for (int j = 0; j < 4; ++j) { const unsigned w = y[q][k][j]; const f32v2_t lo = __builtin_amdgcn_cvt_pk_f32_fp8(w, false), hi = __builtin_amdgcn_cvt_pk_f32_fp8(w, true);
                    v[q][j].x += lo[0] * 0.0625f; v[q][j].y += lo[1] * 0.0625f; v[q][j].z += hi[0] * 0.0625f; v[q][j].w += hi[1] * 0.0625f; }
            float s = 0.f;
#pragma unroll
            for (int j = 0; j < 4; ++j) s += (v[q][j].x * v[q][j].x + v[q][j].y * v[q][j].y) + (v[q][j].z * v[q][j].z + v[q][j].w * v[q][j].w);
            const float rs = 1.0f / sqrtf(wave_sum(s) * (1.f / D) + EPS);
            GAS f32x4* orow = (GAS f32x4*)(F.out + (size_t)R * D) + F.lane;
#pragma unroll
            for (int j = 0; j < 4; ++j) orow[64 * j] = v[q][j] * rs * nfv[j]; }
    }
#undef CMB_SLOTS
}

__device__ __forceinline__ int meta_row(int lane) { return ((lane >> 5) & 1) * 8 + ((lane >> 4) & 1) * 4 + ((lane >> 3) & 1) * 2 + ((lane >> 2) & 1); }
template <int KPL> __device__ __forceinline__ float meta_col(const LAS unsigned char* A, const bf16* wrow, int lane) {
    constexpr int K = 64 * KPL; float w[KPL];
#pragma unroll
    for (int j = 0; j < KPL / 8; ++j) { const v4u x = *(const GAS v4u*)(wrow + lane * KPL + 8 * j);
        w[8 * j] = bflo(x.x); w[8 * j + 1] = bfhi(x.x); w[8 * j + 2] = bflo(x.y); w[8 * j + 3] = bfhi(x.y); w[8 * j + 4] = bflo(x.z); w[8 * j + 5] = bfhi(x.z); w[8 * j + 6] = bflo(x.w); w[8 * j + 7] = bfhi(x.w); }
    float p[16];
#pragma unroll
    for (int r = 0; r < 16; ++r) { float s = 0.f;
#pragma unroll
        for (int j = 0; j < KPL / 8; ++j) { const v4u a = *(const LAS v4u*)(A + (r * K + lane * KPL + 8 * j) * 2);
            s += (bflo(a.x) * w[8 * j] + bfhi(a.x) * w[8 * j + 1]) + (bflo(a.y) * w[8 * j + 2] + bfhi(a.y) * w[8 * j + 3]) + (bflo(a.z) * w[8 * j + 4] + bfhi(a.z) * w[8 * j + 5]) + (bflo(a.w) * w[8 * j + 6] + bfhi(a.w) * w[8 * j + 7]); }
        p[r] = s; if ((r & 3) == 3) asm volatile("" ::: "memory"); }
    const bool b32 = lane & 32, b16 = lane & 16, b8 = lane & 8, b4 = lane & 4;
    float q8[8], q4[4], q2[2];
#pragma unroll
    for (int i = 0; i < 8; ++i) { const float keep = b32 ? p[i + 8] : p[i], send = b32 ? p[i] : p[i + 8]; q8[i] = keep + __shfl_xor(send, 32); }
#pragma unroll
    for (int i = 0; i < 4; ++i) { const float keep = b16 ? q8[i + 4] : q8[i], send = b16 ? q8[i] : q8[i + 4]; q4[i] = keep + __shfl_xor(send, 16); }
#pragma unroll
    for (int i = 0; i < 2; ++i) { const float keep = b8 ? q4[i + 2] : q4[i], send = b8 ? q4[i] : q4[i + 2]; q2[i] = keep + __shfl_xor(send, 8); }
    float v = (b4 ? q2[1] : q2[0]) + __shfl_xor(b4 ? q2[0] : q2[1], 4);
    v += __shfl_xor(v, 2); v += __shfl_xor(v, 1);
    return v;
}
__device__ __forceinline__ void meta_stage(Frame& F, LAS unsigned char* dst, const bf16* src, int K) {
    v4u t[4]; const int n = 16 * K / 8;
#pragma unroll
    for (int q = 0; q < 4; ++q) { const int u = F.tid + q * NTHREADS; if (u < n) t[q] = *(const GAS v4u*)(src + (size_t)u * 8); }
#pragma unroll
    for (int q = 0; q < 4; ++q) { const int u = F.tid + q * NTHREADS; if (u < n) *(LAS v4u*)(dst + u * 16) = t[q]; }
}
__device__ __forceinline__ void meta_proj(Frame& F) {
    unsigned char* ws = F.ws; const bf16* WIN = (const bf16*)(ws + WS_WIN); const float* lbl = F.in[IN_LBL];
    LAS unsigned char* A = F.lds + RING_OFF;
    __syncthreads(); meta_stage(F, A, (const bf16*)(ws + WS_XN0) + (size_t)NTOK * D, D); __syncthreads();
    for (int c = F.vcu * NWAVES + F.wave; c < NPROJ; c += F.G * NWAVES) {
        const float v = meta_col<16>(A, WIN + (size_t)c * D, F.lane);
        if ((F.lane & 3) == 0) { const size_t row = NTOK + meta_row(F.lane); const int kind = c < 3072 ? (c >> 9) : 6, cc = c & 511;
            if (kind == 0) ((bf16*)(ws + WS_HQ))[row * HW + cc] = (bf16)f2bf(fsilu(v));
            else if (kind == 1) { const float lb = fsigmoid(lbl[cc] - lbl[HW + cc]); ((bf16*)(ws + WS_HG))[row * HW + cc] = (bf16)f2bf(__logf(lb + (1.f - lb) * fsigmoid(v))); }
            else if (kind == 2) ((bf16*)(ws + WS_HV))[row * HW + cc] = (bf16)f2bf(v);
            else if (kind == 3) ((bf16*)(ws + WS_HGATE))[row * HW + cc] = (bf16)f2bf(fsilu(v));
            else if (kind == 4) ((bf16*)(ws + WS_MM))[row * HW + cc] = (bf16)f2bf(v);
            else if (kind == 5) ((bf16*)(ws + WS_MO))[row * HW + cc] = (bf16)f2bf(fsigmoid(v));
            else (ws + WS_GATES)[row * 2048 + pg8::gate_pos(c - 3072)] = (unsigned char)(__builtin_bit_cast(unsigned, __builtin_fmaf(fsigmoid(v), 255.f, 8388608.f)) & 0xffu); } }
}
__device__ __forceinline__ void meta_merged(Frame& F) {
    unsigned char* ws = F.ws; const unsigned char* GATES = ws + WS_GATES;
    LAS unsigned char* A0 = F.lds + RING_OFF; LAS unsigned char* A1 = A0 + 16 * HW * 2;
    __syncthreads(); meta_stage(F, A0, (const bf16*)(ws + WS_YHG) + (size_t)NTOK * HW, HW); meta_stage(F, A1, (const bf16*)(ws + WS_YML) + (size_t)NTOK * HW, HW); __syncthreads();
    for (int c = F.vcu * NWAVES + F.wave; c < D; c += F.G * NWAVES) {
        const float vh = meta_col<8>(A0, (const bf16*)(ws + WS_WBH) + (size_t)c * HW, F.lane), vm = meta_col<8>(A1, (const bf16*)(ws + WS_WBM) + (size_t)c * HW, F.lane);
        if ((F.lane & 3) == 0) { const size_t row = NTOK + meta_row(F.lane); ((bf16*)(ws + WS_MERGED))[row * D + c] = (bf16)f2bf((float)GATES[row * 2048 + pg8::gate_pos(c)] * vh + (float)GATES[row * 2048 + pg8::gate_pos(D + c)] * vm); } }
}
__device__ __forceinline__ void meta_wout(Frame& F) {
    unsigned char* ws = F.ws; LAS unsigned char* A = F.lds + RING_OFF;
    __syncthreads(); meta_stage(F, A, (const bf16*)(ws + WS_MERGED) + (size_t)NTOK * D, D); __syncthreads();
    for (int c = F.vcu * NWAVES + F.wave; c < D; c += F.G * NWAVES) {
        const float d = meta_col<16>(A, (const bf16*)(ws + WS_WOUT) + (size_t)c * D, F.lane);
        if ((F.lane & 3) == 0) { const int mr_ = meta_row(F.lane); const size_t row = NTOK + mr_; const float v = F.in[IN_META][(size_t)mr_ * D + c] + d;
            ((bf16*)(ws + WS_H1))[row * D + c] = (bf16)f2bf(v); ((unsigned char*)(ws + WS_H1B))[row * D + c] = (unsigned char)(__builtin_amdgcn_cvt_pk_fp8_f32(__builtin_amdgcn_fmed3f(v, -448.f, 448.f), 0.f, 0u, false) & 0xffu); } }
}

__device__ __forceinline__ void ph_proj(Frame& F, int variant) {
    unsigned char* ws = F.ws;
    pg8::Gemm g{(const pg8::bf16_t*)(ws + WS_XQ), (const pg8::bf16_t*)(ws + WS_WIN8), NTOK, NPROJ, D / 2}; pg8::StaticOrder S; S.init(NTOK, NPROJ, F.G, (int)blockIdx.x);
    pg8::EpiProjT<true> E{ws, F.in[IN_LBL], (const float*)(ws + WS_SROW), (const float*)(ws + WS_SCOL)};
#if MK_N_LAUNCHES != 1 && PROBE_VARIANT == 1
    if (variant) { pg8::EpiNull EN{(int*)(ws + WS_TOPE)}; pg8::gemm_phase<pg8::EpiNull, pg8::StaticOrder, true, true, false, true>(F.lds + RING_OFF, g, S, EN); return; }
#elif MK_N_LAUNCHES != 1 && PROBE_VARIANT == 2
    if (variant) { pg8::EpiProjT<true, true> EV{ws, F.in[IN_LBL], (const float*)(ws + WS_SROW), (const float*)(ws + WS_SCOL)}; pg8::gemm_phase<pg8::EpiProjT<true, true>, pg8::StaticOrder, true, true, false, true>(F.lds + RING_OFF, g, S, EV); return; }
#endif
    (void)variant;
    pg8::gemm_phase<pg8::EpiProjT<true>, pg8::StaticOrder, true, true, false, true>(F.lds + RING_OFF, g, S, E);
    meta_proj(F);
}
__device__ __forceinline__ void ph_scan(Frame& F) {
    const int sb = (int)blockIdx.x;
    if (sb < 64) p3_hgrn2_mfma(F, sb); else if (sb < 128) p3_mlstm_mfma(F, sb - 64);
#if !CONV_IN_P0
    else px_experts(F, sb - 128, F.G - 128);
#endif
}
__device__ __forceinline__ void ph_merged(Frame& F) {
    unsigned char* ws = F.ws;
    static_assert(WS_YML - WS_YHG == (size_t)pg8::PAIR_DA * 256 * HW * 2 && WS_WBM - WS_WBH == (size_t)pg8::PAIR_DB * 256 * HW * 2, "the second branch's operands sit a whole number of tiles behind the first's");
    pg8::PairOrder S; S.S.init(NTOK, D, F.G, (int)blockIdx.x);
    pg8::Gemm g{(const pg8::bf16_t*)(ws + WS_YHG), (const pg8::bf16_t*)(ws + WS_WBH), NTOK, D, HW};
    pg8::EpiGate2 E{(const unsigned char*)(ws + WS_GATES), (pg8::bf16_t*)(ws + WS_TMP), (pg8::bf16_t*)(ws + WS_MERGED)};
    pg8::gemm_phase<pg8::EpiGate2, pg8::PairOrder, true, true>(F.lds + RING_OFF, g, S, E);
    meta_merged(F);
}
__device__ __forceinline__ void ph_wout(Frame& F) {
    unsigned char* ws = F.ws;
    pg8::Gemm g{(const pg8::bf16_t*)(ws + WS_MERGED), (const pg8::bf16_t*)(ws + WS_WOUT), NTOK, D, D}; pg8::StaticOrder S; S.init(NTOK, D, F.G, (int)blockIdx.x);
    pg8::EpiH1 E{(const pg8::bf16_t*)(ws + WS_XN0), (const float*)(ws + WS_XSQ), (pg8::bf16_t*)(ws + WS_H1), (unsigned char*)(ws + WS_H1B)};
    pg8::gemm_phase<pg8::EpiH1, pg8::StaticOrder, true, true>(F.lds + RING_OFF, g, S, E);
    meta_wout(F);
}
__device__ __forceinline__ void ph_gu(Frame& F, int variant = 0) {
    unsigned char* ws = F.ws; build_tables(F);
    const LAS int* pst = (const LAS int*)(F.lds + PST_OFF); LAS unsigned short* tok16 = (LAS unsigned short*)(F.lds + TOK_OFF);
    pg8::Gemm g{(const pg8::bf16_t*)(ws + WS_H1B), (const pg8::bf16_t*)(ws + WS_WGU), NV, NE * 2 * DFF, D / 2};
    pg8::GroupOrder S{pst[32], 8, F.G, (int)blockIdx.x, (const LAS unsigned char*)(F.lds + TEXP_OFF)};
    { const int* ETOK = (const int*)(ws + WS_ETOK);
      int tokv[18];
#pragma unroll
      for (int i = 0; i < 18; ++i) { pg8::Unit u; int t = 0; if (S.next(i, u) && F.tid < 256) { const int e = u.pn >> 3, pos = u.pm * 256 - pst[e] + F.tid; if (pos < pst[33 + e]) t = ETOK[(size_t)e * NV + pos]; } tokv[i] = t; }
      if (F.tid < 256) {
#pragma unroll
          for (int i = 0; i < 18; ++i) tok16[i * 256 + F.tid] = (unsigned short)tokv[i]; }
      __syncthreads(); }
    pg8::EpiGU E{(const float*)(ws + WS_BGUP), (const float*)(ws + WS_ERS), (unsigned char*)(ws + WS_ACT), pst};
#if MK_N_LAUNCHES != 1 && PROBE_VARIANT == 1
    if (variant) { pg8::EpiNull EN{(int*)(ws + WS_TOPE)}; pg8::gemm_phase_g<pg8::EpiNull, pg8::GroupOrder, true>(F.lds + RING_OFF, g, S, EN, tok16); return; }
#elif MK_N_LAUNCHES != 1 && PROBE_VARIANT == 2
    if (variant) { pg8::EpiGUT<true> EV{(const float*)(ws + WS_BGUP), (const float*)(ws + WS_ERS), (unsigned char*)(ws + WS_ACT), pst}; pg8::gemm_phase_g<pg8::EpiGUT<true>, pg8::GroupOrder, true>(F.lds + RING_OFF, g, S, EV, tok16); return; }
#endif
    (void)variant;
    pg8::gemm_phase_g<pg8::EpiGU, pg8::GroupOrder, true>(F.lds + RING_OFF, g, S, E, tok16);
}
__device__ __forceinline__ void ph_down(Frame& F, int variant = 0) {
    unsigned char* ws = F.ws; build_tables(F);
    pg8::Gemm g{(const pg8::bf16_t*)(ws + WS_ACT), (const pg8::bf16_t*)(ws + WS_WDN), MAXTILES * 256, NE * D, DFF / 2};
    pg8::GroupOrder S{((const LAS int*)(F.lds + PST_OFF))[32], 4, F.G, (int)blockIdx.x, (const LAS unsigned char*)(F.lds + TEXP_OFF)};
    pg8::EpiDown E{F.in[IN_BDN], (const float*)(ws + WS_EW), (unsigned char*)(ws + WS_YB), (const LAS int*)(F.lds + PST_OFF)};
#if MK_N_LAUNCHES != 1 && PROBE_VARIANT == 1
    if (variant) { pg8::EpiNull EN{(int*)(ws + WS_TOPE)}; pg8::gemm_phase<pg8::EpiNull, pg8::GroupOrder, true, true, true>(F.lds + RING_OFF, g, S, EN); return; }
#elif MK_N_LAUNCHES != 1 && PROBE_VARIANT == 2
    if (variant) { pg8::EpiDownT<true> EV{F.in[IN_BDN], (const float*)(ws + WS_EW), (unsigned char*)(ws + WS_YB), (const LAS int*)(F.lds + PST_OFF)}; pg8::gemm_phase<pg8::EpiDownT<true>, pg8::GroupOrder, true, true, true>(F.lds + RING_OFF, g, S, EV); return; }
#endif
    (void)variant;
    pg8::gemm_phase<pg8::EpiDown, pg8::GroupOrder, true, true, true>(F.lds + RING_OFF, g, S, E);
}

#ifndef CONV_IN_P0
#define CONV_IN_P0 0
#endif
#ifndef PROBE_DOUBLE
#define PROBE_DOUBLE 0
#endif
#define DBL(k) ((PROBE_DOUBLE >> (k)) & 1)
#ifndef MK_N_LAUNCHES
#define MK_N_LAUNCHES 1
#endif
constexpr int NPHASE = 9;
#ifndef PROBE_VARIANT
#define PROBE_VARIANT 0
#endif
struct Args { const float* in[25]; float* out; unsigned char* ws; int ph_lo, ph_hi, li, pad; };
__global__ void __launch_bounds__(NTHREADS, 2) fwd_kernel(Args args) {
    extern __shared__ __attribute__((aligned(16))) unsigned char lds[];
    Frame F;
    F.lds = (LAS unsigned char*)lds; F.MISC = (volatile LAS unsigned*)(F.lds + MISC_OFF);
    F.tid = threadIdx.x; F.lane = F.tid & 63; F.wave = __builtin_amdgcn_readfirstlane(F.tid >> 6);
    F.G = gridDim.x; { const int bx = blockIdx.x; F.vcu = (F.G % 8 == 0) ? (bx % 8) * (F.G / 8) + bx / 8 : bx; }
    F.ws = args.ws; F.ctl = (gu32*)(args.ws + WS_CTL); F.out = args.out;
#pragma unroll
    for (int i = 0; i < 25; ++i) F.in[i] = args.in[i];
    { int t0 = F.tid; asm volatile("" : "+v"(t0)); if (t0 < 64) F.MISC[t0] = 0u; }
    __syncthreads();
    const int lo = args.ph_lo, hi = args.ph_hi;
    XcdBarrier bar; bar.bar = (unsigned*)(F.ctl + CW_BAR) + args.li * XCD_BAR_WORDS; bar.x = 0; bar.st = nullptr;
    if (hi - lo > 1) bar = xcd_barrier_post((unsigned*)(F.ctl + CW_BAR) + args.li * XCD_BAR_WORDS, F.MISC + 8);
#define IN(k) (lo <= (k) && (k) < hi)
#define SEAM(k) do { if (IN(k) && IN((k) + 1)) xcd_barrier(bar); } while (0)

    if (IN(0)) { p0_prologue(F); p0b_quant(F);
#if CONV_IN_P0
        __syncthreads(); px_experts(F, F.vcu, F.G);
#endif
    } SEAM(0);
    if (IN(1)) { ph_proj(F, args.pad); } SEAM(1);
    if (IN(2)) { ph_scan(F); } SEAM(2);
    if (IN(3)) { ph_merged(F); } SEAM(3);
    if (IN(4)) { ph_wout(F); } SEAM(4);
    if (IN(5)) { p6_router(F); } SEAM(5);
    if (IN(6)) { ph_gu(F, args.pad); } SEAM(6);
    if (IN(7)) { ph_down(F, args.pad); } SEAM(7);
    if (IN(8)) { p10_combine(F); }
#undef IN
#undef SEAM
}

extern "C" void kernel_launch(void* const* d_in, const int* in_sizes, int n_in, void* d_out, int out_size, void* d_ws, size_t ws_size, hipStream_t stream) {
    static int grid = 0;
    if (grid == 0) {
        if (n_in != 25 || in_sizes[0] != BATCH * SEQ * D || out_size != BATCH * SEQ * D || ws_size < WS_END) { fprintf(stderr, "kernel_launch: unexpected shapes (n_in %d, in0 %d, out %d, ws %zu); nothing launched\n", n_in, n_in > 0 ? in_sizes[0] : -1, out_size, ws_size); grid = -1; return; }
        int dev = 0, cus = 0, per_cu = 0;
        if (hipGetDevice(&dev) != hipSuccess || hipDeviceGetAttribute(&cus, hipDeviceAttributeMultiprocessorCount, dev) != hipSuccess) { grid = -1; return; }
        if (hipFuncSetAttribute((const void*)fwd_kernel, hipFuncAttributeMaxDynamicSharedMemorySize, LDS_BYTES) != hipSuccess) { fprintf(stderr, "kernel_launch: hipFuncSetAttribute failed\n"); grid = -1; return; }
        if (hipOccupancyMaxActiveBlocksPerMultiprocessor(&per_cu, (const void*)fwd_kernel, NTHREADS, LDS_BYTES) != hipSuccess || per_cu < 1) { fprintf(stderr, "kernel_launch: occupancy query reports %d blocks per CU\n", per_cu); }
        (void)hipGetLastError();
        grid = 256;
        if (cus < 256) { fprintf(stderr, "kernel_launch: %d CUs < 256: the grid would not be resident; nothing launched\n", cus); grid = -1; return; }
    }
    if (grid < 0) return;
    if (hipMemsetAsync((char*)d_ws + WS_CTL, 0, CTL_ZERO_BYTES, stream) != hipSuccess) return;
    Args a{};
    for (int i = 0; i < 25; ++i) a.in[i] = (const float*)d_in[i];
    a.out = (float*)d_out; a.ws = (unsigned char*)d_ws; a.pad = 0;
#if MK_N_LAUNCHES == 1
    a.ph_lo = 0; a.ph_hi = NPHASE; a.li = 0;
    hipLaunchKernelGGL(fwd_kernel, dim3(grid), dim3(NTHREADS), LDS_BYTES, stream, a);
#else
    for (int p = 0; p < NPHASE; ++p) for (int rep = 0; rep <= DBL(p); ++rep) { a.ph_lo = p; a.ph_hi = p + 1; a.li = 0; a.pad = rep; hipLaunchKernelGGL(fwd_kernel, dim3(grid), dim3(NTHREADS), LDS_BYTES, stream, a); }
#endif
}
```

```cpp
#include <hip/hip_runtime.h>
#include <cstdio>
#include <cstdint>
namespace pg8 {
#define PG8_LAS __attribute__((address_space(3)))
typedef unsigned short bf16_t;
typedef short bf16x8 __attribute__((ext_vector_type(8)));
typedef float f32x4 __attribute__((ext_vector_type(4)));
typedef unsigned u32x4 __attribute__((ext_vector_type(4)));
constexpr int BM = 256, BK = 64, HALF = 128, HTB = HALF * BK * 2  , STAGE_BYTES = 8 * HTB, NXCD = 8, WGM = 8;

__host__ __device__ __forceinline__ int lds_byte(int r, int c) { const int st = (r >> 4) * 2 + (c >> 5), rr = r & 15, cc = c & 31, ob = rr * 64 + cc * 2; return st * 1024 + (ob ^ (((ob >> 9) & 1) << 5)); }
__host__ __device__ __forceinline__ void stage_rc(int b, int& R, int& C) { const int st = b / 1024, sb = b % 1024, swz = sb ^ (((sb >> 9) & 1) << 5); R = (st >> 1) * 16 + swz / 64; C = (st & 1) * 32 + (swz % 64) / 2; }
__host__ __device__ __forceinline__ int perm32(int rho) { const int n = rho >> 4, i = rho & 15; return 8 * (i >> 2) + 4 * n + (i & 3); }

struct Unit { int pm, pn; };
struct Gemm { const bf16_t* A; const bf16_t* Bt; int M, N, K; };

struct StaticOrder {
    int nM, nN, nwg, G, c;
    __host__ __device__ void init(int M, int N, int G_, int c_) { nM = M / BM; nN = N / BM; nwg = nM * nN; G = G_; c = c_; }
    __host__ __device__ __forceinline__ bool next(int i, Unit& u) const {
        const long L = (long)i * G + c; if (L >= nwg) return false;
        int wgid = (int)L; { const int q = nwg / NXCD, r = nwg % NXCD, xcd = wgid % NXCD, off = wgid / NXCD; wgid = (xcd < r ? xcd * (q + 1) : r * (q + 1) + (xcd - r) * q) + off; }
        const int nig = WGM * nN, gid = wgid / nig, fm = gid * WGM, gsz = (nM - fm) < WGM ? (nM - fm) : WGM;
        u.pm = fm + ((wgid % nig) % gsz); u.pn = (wgid % nig) / gsz; return true;
    }
    __device__ __forceinline__ void a_ready(const Unit&) const {}
    __device__ __forceinline__ void done(const Unit&) const {}
};

typedef __bf16 bf16v2 __attribute__((ext_vector_type(2)));
typedef float f32v2 __attribute__((ext_vector_type(2)));
__device__ __forceinline__ unsigned cvt_pk_bf16(float lo, float hi) { const f32v2 v = {lo, hi}; return __builtin_bit_cast(unsigned, __builtin_convertvector(v, bf16v2)); }
typedef float f32x2 __attribute__((ext_vector_type(2)));
typedef int i32x4 __attribute__((ext_vector_type(4)));
typedef int i32x8 __attribute__((ext_vector_type(8)));
__device__ __forceinline__ i32x8 cat8(const bf16x8 a, const bf16x8 b) { const i32x4 x = __builtin_bit_cast(i32x4, a), y = __builtin_bit_cast(i32x4, b); return __builtin_shufflevector(x, y, 0, 1, 2, 3, 4, 5, 6, 7); }
template <class T, class = void> struct epi_chain { static constexpr bool value = false; };
template <class T> struct epi_chain<T, decltype((void)T::CHAIN)> { static constexpr bool value = T::CHAIN; };
template <class Epi, class Sched, bool ALIGN_EPI = false, bool SP2 = false, bool FP8 = false, bool I8 = false>
__device__ __forceinline__ void gemm_phase(PG8_LAS unsigned char* lds, const Gemm g, const Sched& S, const Epi& E) {
    const int tid = threadIdx.x, wid = __builtin_amdgcn_readfirstlane(tid >> 6), lane = tid & 63, wr = wid >> 2, wc = wid & 3, fr = lane & 15, fq = lane >> 4;
    const int K = g.K, nt = K / BK;
    unsigned voffA[2], voffB[2];
#pragma unroll
    for (int i = 0; i < 2; ++i) { int R, C; stage_rc(tid * 16 + i * 8192, R, C); const int Rb = Epi::PERM ? ((R & ~31) + perm32(R & 31)) : R;
        voffA[i] = (unsigned)(R * K + C) * 2u; voffB[i] = (unsigned)(Rb * K + C) * 2u; }
    const size_t kstep = (size_t)(BK * 2);
    const size_t hstep = (size_t)HALF * K * 2;
    const size_t tstep = 2 * hstep;
    const unsigned ldsw = (unsigned)wid * 1024u;
    const int aoff = lds_byte(wr * 64 + fr, fq * 8), boff = lds_byte(wc * 32 + fr, fq * 8);
#define PG8_SA(b, h) (((b) * 2 + (h)) * HTB)
#define PG8_SB(b, h) ((4 + (b) * 2 + (h)) * HTB)
#define PG8_STAGE(bufoff, gbase, voff) do { _Pragma("unroll") for (int _i = 0; _i < 2; ++_i) \
        __builtin_amdgcn_global_load_lds((const unsigned*)((const char*)(gbase) + (voff)[_i]), (PG8_LAS unsigned*)(lds + (bufoff) + ldsw + _i * 8192), 16, 0, 0); } while (0)
#define PG8_LDA(dst, b, h) do { _Pragma("unroll") for (int m = 0; m < 4; ++m) { if constexpr (FP8) dst##8[m] = cat8(*(const PG8_LAS bf16x8*)(lds + PG8_SA(b, h) + aoff + m * 2048), *(const PG8_LAS bf16x8*)(lds + PG8_SA(b, h) + aoff + m * 2048 + 1024)); \
        else { _Pragma("unroll") for (int k = 0; k < 2; ++k) dst[m][k] = *(const PG8_LAS bf16x8*)(lds + PG8_SA(b, h) + aoff + m * 2048 + k * 1024); } } } while (0)
#define PG8_LDB(dst, b, h) do { _Pragma("unroll") for (int n = 0; n < 2; ++n) { if constexpr (FP8) dst##8[n] = cat8(*(const PG8_LAS bf16x8*)(lds + PG8_SB(b, h) + boff + n * 2048), *(const PG8_LAS bf16x8*)(lds + PG8_SB(b, h) + boff + n * 2048 + 1024)); \
        else { _Pragma("unroll") for (int k = 0; k < 2; ++k) dst[n][k] = *(const PG8_LAS bf16x8*)(lds + PG8_SB(b, h) + boff + n * 2048 + k * 1024); } } } while (0)
#define PG8_MMA(ai, bj, At, Bt) do { __builtin_amdgcn_s_setprio(1); _Pragma("unroll") for (int m = 0; m < 4; ++m) _Pragma("unroll") for (int n = 0; n < 2; ++n) { \
        if constexpr (FP8) acc[ai][bj][m][n] = __builtin_amdgcn_mfma_scale_f32_16x16x128_f8f6f4(Bt##8[n], At##8[m], acc[ai][bj][m][n], 0, 0, 0, 0x7f7f7f7f, 0, 0x7f7f7f7f); \
        else if constexpr (I8) { _Pragma("unroll") for (int k = 0; k < 2; ++k) acc[ai][bj][m][n] = __builtin_bit_cast(f32x4, __builtin_amdgcn_mfma_i32_16x16x64_i8(__builtin_bit_cast(i32x4, Bt[n][k]), __builtin_bit_cast(i32x4, At[m][k]), __builtin_bit_cast(i32x4, acc[ai][bj][m][n]), 0, 0, 0)); } \
        else { _Pragma("unroll") for (int k = 0; k < 2; ++k) acc[ai][bj][m][n] = __builtin_amdgcn_mfma_f32_16x16x32_bf16(Bt[n][k], At[m][k], acc[ai][bj][m][n], 0, 0, 0); } } \
        if constexpr (FP8) { _Pragma("unroll") for (int m = 0; m < 4; ++m) _Pragma("unroll") for (int n = 0; n < 2; ++n) asm volatile("" : "+v"(acc[ai][bj][m][n])); }     \
        __builtin_amdgcn_s_setprio(0); } while (0)
#define PG8_WAIT_V(n) asm volatile("s_waitcnt vmcnt(" #n ")" ::: "memory")
#define PG8_WAIT_L(n) asm volatile("s_waitcnt lgkmcnt(" #n ")" ::: "memory")
#define PG8_BAR __builtin_amdgcn_s_barrier()
#define PG8_SCHED __builtin_amdgcn_sched_barrier(0)
    Unit cur, nxt; int ui = 0;
    if (!S.next(0, cur)) return;
    f32x4 acc[2][2][4][2];
#pragma unroll
    for (int a = 0; a < 2; ++a)
#pragma unroll
        for (int b = 0; b < 2; ++b)
#pragma unroll
            for (int m = 0; m < 4; ++m)
#pragma unroll
                for (int n = 0; n < 2; ++n) acc[a][b][m][n] = (f32x4){0.f, 0.f, 0.f, 0.f};
    bf16x8 At[4][2], B0[2][2], B1[2][2]; i32x8 At8[4], B08[2], B18[2];
    const char* cA = (const char*)g.A + (size_t)cur.pm * tstep; const char* cB = (const char*)g.Bt + (size_t)cur.pn * tstep;
    S.a_ready(cur);
    if constexpr (SP2) {
        PG8_STAGE(PG8_SB(0, 0), cB, voffB); PG8_STAGE(PG8_SB(0, 1), cB + hstep, voffB); PG8_STAGE(PG8_SA(0, 0), cA, voffA); PG8_STAGE(PG8_SA(0, 1), cA + hstep, voffA);
        if (wr == 1) PG8_BAR;
        PG8_WAIT_V(2); PG8_BAR;
        PG8_STAGE(PG8_SB(1, 0), cB + kstep, voffB); PG8_STAGE(PG8_SA(1, 0), cA + kstep, voffA); PG8_STAGE(PG8_SB(1, 1), cB + hstep + kstep, voffB);
        PG8_WAIT_V(6); PG8_BAR;
    } else {
        PG8_STAGE(PG8_SB(0, 0), cB, voffB); PG8_STAGE(PG8_SA(0, 0), cA, voffA); PG8_STAGE(PG8_SB(0, 1), cB + hstep, voffB); PG8_STAGE(PG8_SA(0, 1), cA + hstep, voffA);
        if (wr == 1) PG8_BAR;
        PG8_WAIT_V(4); PG8_BAR;
        PG8_STAGE(PG8_SB(1, 0), cB + kstep, voffB); PG8_STAGE(PG8_SA(1, 0), cA + kstep, voffA); PG8_STAGE(PG8_SB(1, 1), cB + hstep + kstep, voffB);
        PG8_WAIT_V(6); PG8_BAR;
    }
    for (;;) {
        const bool has_next = S.next(ui + 1, nxt);
        const char* nA = has_next ? (const char*)g.A + (size_t)nxt.pm * tstep : cA; const char* nB = has_next ? (const char*)g.Bt + (size_t)nxt.pn * tstep : cB;
        for (int t = 0; t < nt; t += 2) {
            const bool last = (t == nt - 2);
            const char* a1 = cA + (size_t)(t + 1) * kstep;
            const char* a2 = last ? nA : cA + (size_t)(t + 2) * kstep; const char* b2 = last ? nB : cB + (size_t)(t + 2) * kstep;
            const char* a3 = a2 + kstep; const char* b3 = b2 + kstep;
            if (last && has_next) S.a_ready(nxt);
            if constexpr (SP2) {
            PG8_LDB(B0, 0, 0); PG8_LDB(B1, 0, 1); PG8_SCHED; PG8_LDA(At, 0, 0); PG8_STAGE(PG8_SA(1, 1), a1 + hstep, voffA);
            PG8_WAIT_V(8); PG8_WAIT_L(0); PG8_BAR; PG8_MMA(0, 0, At, B0); PG8_MMA(0, 1, At, B1); PG8_BAR; PG8_SCHED;
            PG8_LDA(At, 0, 1); PG8_STAGE(PG8_SB(0, 0), b2, voffB); PG8_STAGE(PG8_SB(0, 1), b2 + hstep, voffB); PG8_STAGE(PG8_SA(0, 0), a2, voffA);
            PG8_WAIT_V(8); PG8_WAIT_L(0); PG8_BAR; PG8_MMA(1, 0, At, B0); PG8_MMA(1, 1, At, B1); PG8_BAR; PG8_SCHED;
            PG8_LDB(B0, 1, 0); PG8_LDB(B1, 1, 1); PG8_SCHED; PG8_LDA(At, 1, 0); PG8_STAGE(PG8_SA(0, 1), a2 + hstep, voffA);
            PG8_WAIT_V(8); PG8_WAIT_L(0); PG8_BAR; PG8_MMA(0, 0, At, B0); PG8_MMA(0, 1, At, B1); PG8_BAR; PG8_SCHED;
            PG8_LDA(At, 1, 1); PG8_STAGE(PG8_SB(1, 0), b3, voffB); PG8_STAGE(PG8_SB(1, 1), b3 + hstep, voffB); PG8_STAGE(PG8_SA(1, 0), a3, voffA);
            PG8_WAIT_V(8); PG8_WAIT_L(0); PG8_BAR; PG8_MMA(1, 0, At, B0); PG8_MMA(1, 1, At, B1); PG8_BAR; PG8_SCHED;
            } else {
            PG8_LDB(B0, 0, 0); PG8_SCHED; PG8_LDA(At, 0, 0); PG8_STAGE(PG8_SA(1, 1), a1 + hstep, voffA);
            PG8_WAIT_L(8); PG8_BAR; PG8_WAIT_L(0); PG8_MMA(0, 0, At, B0); PG8_BAR; PG8_SCHED;
            PG8_LDB(B1, 0, 1); PG8_STAGE(PG8_SB(0, 0), b2, voffB);
            PG8_BAR; PG8_WAIT_L(0); PG8_MMA(0, 1, At, B1); PG8_BAR;
            PG8_LDA(At, 0, 1); PG8_STAGE(PG8_SA(0, 0), a2, voffA);
            PG8_BAR; PG8_WAIT_L(0); PG8_MMA(1, 0, At, B0); PG8_BAR; PG8_SCHED;
            PG8_STAGE(PG8_SB(0, 1), b2 + hstep, voffB);
            PG8_WAIT_V(6); PG8_BAR; PG8_MMA(1, 1, At, B1); PG8_BAR;
            PG8_LDB(B0, 1, 0); PG8_SCHED; PG8_LDA(At, 1, 0); PG8_STAGE(PG8_SA(0, 1), a2 + hstep, voffA);
            PG8_WAIT_L(8); PG8_BAR; PG8_WAIT_L(0); PG8_MMA(0, 0, At, B0); PG8_BAR; PG8_SCHED;
            PG8_LDB(B1, 1, 1); PG8_STAGE(PG8_SB(1, 0), b3, voffB);
            PG8_BAR; PG8_WAIT_L(0); PG8_MMA(0, 1, At, B1); PG8_BAR;
            PG8_LDA(At, 1, 1); PG8_STAGE(PG8_SA(1, 0), a3, voffA);
            PG8_BAR; PG8_WAIT_L(0); PG8_MMA(1, 0, At, B0); PG8_BAR; PG8_SCHED;
            PG8_STAGE(PG8_SB(1, 1), b3 + hstep, voffB);
            PG8_WAIT_V(6); PG8_BAR; PG8_MMA(1, 1, At, B1); PG8_BAR;
            }
        }
        if constexpr (ALIGN_EPI) { if (wr == 0) PG8_BAR; }
        bool keep = false;
        if constexpr (epi_chain<Epi>::value) { keep = E.chain(acc, cur, wr, wc, fr, fq); S.done(cur); }
        else if constexpr (!Epi::AFTER_DRAIN) { E(acc, cur, wr, wc, fr, fq); S.done(cur); }
        if (!has_next) break;
        if (!keep) {
#pragma unroll
        for (int a = 0; a < 2; ++a)
#pragma unroll
            for (int b = 0; b < 2; ++b)
#pragma unroll
                for (int m = 0; m < 4; ++m)
#pragma unroll
                    for (int n = 0; n < 2; ++n) acc[a][b][m][n] = (f32x4){0.f, 0.f, 0.f, 0.f};
        }
        cur = nxt; cA = nA; cB = nB; ++ui;
        if constexpr (ALIGN_EPI) { if (wr == 1) PG8_BAR; }
    }
    PG8_WAIT_V(0);
    if constexpr (!ALIGN_EPI) { if (wr == 0) PG8_BAR; }
    PG8_BAR;
    if constexpr (Epi::AFTER_DRAIN) { E.fused(acc, cur, wr, wc, fr, fq, lds, wid, lane); S.done(cur); }
#undef PG8_SA
#undef PG8_SB
#undef PG8_STAGE
#undef PG8_LDA
#undef PG8_LDB
#undef PG8_MMA
#undef PG8_WAIT_V
#undef PG8_WAIT_L
#undef PG8_BAR
#undef PG8_SCHED
}
template <class Epi, class Sched, bool FP8 = false>
__device__ __forceinline__ void gemm_phase_g(PG8_LAS unsigned char* lds, const Gemm g, const Sched& S, const Epi& E, const PG8_LAS unsigned short* tok16) {
    constexpr bool ALIGN_EPI = true, SP2 = true;
    const int tid = threadIdx.x, wid = __builtin_amdgcn_readfirstlane(tid >> 6), lane = tid & 63, wr = wid >> 2, wc = wid & 3, fr = lane & 15, fq = lane >> 4;
    const int K = g.K, nt = K / BK;
    unsigned voffB[2]; int RA[2]; unsigned CA[2];
#pragma unroll
    for (int i = 0; i < 2; ++i) { int R, C; stage_rc(tid * 16 + i * 8192, R, C); const int Rb = Epi::PERM ? ((R & ~31) + perm32(R & 31)) : R;
        RA[i] = R; CA[i] = (unsigned)C * 2u; voffB[i] = (unsigned)(Rb * K + C) * 2u; }
    unsigned oc[2][2];
#define PG8_TOKS(dst, ui_) do { _Pragma("unroll") for (int _h = 0; _h < 2; ++_h) _Pragma("unroll") for (int _i = 0; _i < 2; ++_i) \
        dst[_h][_i] = (unsigned)tok16[(ui_) * 256 + _h * HALF + RA[_i]] * (unsigned)(K * 2) + CA[_i]; } while (0)
    const size_t kstep = (size_t)(BK * 2);
    const size_t hstep = (size_t)HALF * K * 2;
    const size_t tstep = 2 * hstep;
    const unsigned ldsw = (unsigned)wid * 1024u;
    const int aoff = lds_byte(wr * 64 + fr, fq * 8), boff = lds_byte(wc * 32 + fr, fq * 8);
#define PG8_SA(b, h) (((b) * 2 + (h)) * HTB)
#define PG8_SB(b, h) ((4 + (b) * 2 + (h)) * HTB)
#define PG8_STAGE(bufoff, gbase, voff) do { _Pragma("unroll") for (int _i = 0; _i < 2; ++_i) \
        __builtin_amdgcn_global_load_lds((const unsigned*)((const char*)(gbase) + (voff)[_i]), (PG8_LAS unsigned*)(lds + (bufoff) + ldsw + _i * 8192), 16, 0, 0); } while (0)
#define PG8_LDA(dst, b, h) do { _Pragma("unroll") for (int m = 0; m < 4; ++m) { if constexpr (FP8) dst##8[m] = cat8(*(const PG8_LAS bf16x8*)(lds + PG8_SA(b, h) + aoff + m * 2048), *(const PG8_LAS bf16x8*)(lds + PG8_SA(b, h) + aoff + m * 2048 + 1024)); \
        else { _Pragma("unroll") for (int k = 0; k < 2; ++k) dst[m][k] = *(const PG8_LAS bf16x8*)(lds + PG8_SA(b, h) + aoff + m * 2048 + k * 1024); } } } while (0)
#define PG8_LDB(dst, b, h) do { _Pragma("unroll") for (int n = 0; n < 2; ++n) { if constexpr (FP8) dst##8[n] = cat8(*(const PG8_LAS bf16x8*)(lds + PG8_SB(b, h) + boff + n * 2048), *(const PG8_LAS bf16x8*)(lds + PG8_SB(b, h) + boff + n * 2048 + 1024)); \
        else { _Pragma("unroll") for (int k = 0; k < 2; ++k) dst[n][k] = *(const PG8_LAS bf16x8*)(lds + PG8_SB(b, h) + boff + n * 2048 + k * 1024); } } } while (0)
#define PG8_MMA(ai, bj, At, Bt) do { __builtin_amdgcn_s_setprio(1); _Pragma("unroll") for (int m = 0; m < 4; ++m) _Pragma("unroll") for (int n = 0; n < 2; ++n) { \
        if constexpr (FP8) acc[ai][bj][m][n] = __builtin_amdgcn_mfma_scale_f32_16x16x128_f8f6f4(Bt##8[n], At##8[m], acc[ai][bj][m][n], 0, 0, 0, 0x7f7f7f7f, 0, 0x7f7f7f7f); \
        else { _Pragma("unroll") for (int k = 0; k < 2; ++k) acc[ai][bj][m][n] = __builtin_amdgcn_mfma_f32_16x16x32_bf16(Bt[n][k], At[m][k], acc[ai][bj][m][n], 0, 0, 0); } } \
        if constexpr (FP8) { _Pragma("unroll") for (int m = 0; m < 4; ++m) _Pragma("unroll") for (int n = 0; n < 2; ++n) asm volatile("" : "+v"(acc[ai][bj][m][n])); }     \
        __builtin_amdgcn_s_setprio(0); } while (0)
#define PG8_WAIT_V(n) asm volatile("s_waitcnt vmcnt(" #n ")" ::: "memory")
#define PG8_WAIT_L(n) asm volatile("s_waitcnt lgkmcnt(" #n ")" ::: "memory")
#define PG8_BAR __builtin_amdgcn_s_barrier()
#define PG8_SCHED __builtin_amdgcn_sched_barrier(0)
    Unit cur, nxt; int ui = 0;
    if (!S.next(0, cur)) return;
    f32x4 acc[2][2][4][2];
#pragma unroll
    for (int a = 0; a < 2; ++a)
#pragma unroll
        for (int b = 0; b < 2; ++b)
#pragma unroll
            for (int m = 0; m < 4; ++m)
#pragma unroll
                for (int n = 0; n < 2; ++n) acc[a][b][m][n] = (f32x4){0.f, 0.f, 0.f, 0.f};
    bf16x8 At[4][2], B0[2][2], B1[2][2]; i32x8 At8[4], B08[2], B18[2];
    const char* cA = (const char*)g.A; const char* cB = (const char*)g.Bt + (size_t)cur.pn * tstep; PG8_TOKS(oc, 0);
    S.a_ready(cur);
    if constexpr (SP2) {
        PG8_STAGE(PG8_SB(0, 0), cB, voffB); PG8_STAGE(PG8_SB(0, 1), cB + hstep, voffB); PG8_STAGE(PG8_SA(0, 0), cA, oc[0]); PG8_STAGE(PG8_SA(0, 1), cA, oc[1]);
        if (wr == 1) PG8_BAR;
        PG8_WAIT_V(2); PG8_BAR;
        PG8_STAGE(PG8_SB(1, 0), cB + kstep, voffB); PG8_STAGE(PG8_SA(1, 0), cA + kstep, oc[0]); PG8_STAGE(PG8_SB(1, 1), cB + hstep + kstep, voffB);
        PG8_WAIT_V(6); PG8_BAR;
    } else {
        PG8_STAGE(PG8_SB(0, 0), cB, voffB); PG8_STAGE(PG8_SA(0, 0), cA, oc[0]); PG8_STAGE(PG8_SB(0, 1), cB + hstep, voffB); PG8_STAGE(PG8_SA(0, 1), cA + hstep, oc[0]);
        if (wr == 1) PG8_BAR;
        PG8_WAIT_V(4); PG8_BAR;
        PG8_STAGE(PG8_SB(1, 0), cB + kstep, voffB); PG8_STAGE(PG8_SA(1, 0), cA + kstep, oc[0]); PG8_STAGE(PG8_SB(1, 1), cB + hstep + kstep, voffB);
        PG8_WAIT_V(6); PG8_BAR;
    }
    for (;;) {
        const bool has_next = S.next(ui + 1, nxt);
        const char* nB = has_next ? (const char*)g.Bt + (size_t)nxt.pn * tstep : cB;
        for (int t = 0; t < nt; t += 2) {
            const bool last = (t == nt - 2);
            const char* a1 = cA + (size_t)(t + 1) * kstep;
            const char* a2 = last ? cA : cA + (size_t)(t + 2) * kstep; const char* b2 = last ? nB : cB + (size_t)(t + 2) * kstep;
            unsigned o2[2][2]; if (last && has_next) PG8_TOKS(o2, ui + 1); else { _Pragma("unroll") for (int _h = 0; _h < 2; ++_h) _Pragma("unroll") for (int _i = 0; _i < 2; ++_i) o2[_h][_i] = oc[_h][_i]; }
            const char* a3 = a2 + kstep; const char* b3 = b2 + kstep;
            if (last && has_next) S.a_ready(nxt);
            if constexpr (SP2) {
            PG8_LDB(B0, 0, 0); PG8_LDB(B1, 0, 1); PG8_SCHED; PG8_LDA(At, 0, 0); PG8_STAGE(PG8_SA(1, 1), a1, oc[1]);
            PG8_WAIT_V(8); PG8_WAIT_L(0); PG8_BAR; PG8_MMA(0, 0, At, B0); PG8_MMA(0, 1, At, B1); PG8_BAR; PG8_SCHED;
            PG8_LDA(At, 0, 1); PG8_STAGE(PG8_SB(0, 0), b2, voffB); PG8_STAGE(PG8_SB(0, 1), b2 + hstep, voffB); PG8_STAGE(PG8_SA(0, 0), a2, o2[0]);
            PG8_WAIT_V(8); PG8_WAIT_L(0); PG8_BAR; PG8_MMA(1, 0, At, B0); PG8_MMA(1, 1, At, B1); PG8_BAR; PG8_SCHED;
            PG8_LDB(B0, 1, 0); PG8_LDB(B1, 1, 1); PG8_SCHED; PG8_LDA(At, 1, 0); PG8_STAGE(PG8_SA(0, 1), a2, o2[1]);
            PG8_WAIT_V(8); PG8_WAIT_L(0); PG8_BAR; PG8_MMA(0, 0, At, B0); PG8_MMA(0, 1, At, B1); PG8_BAR; PG8_SCHED;
            PG8_LDA(At, 1, 1); PG8_STAGE(PG8_SB(1, 0), b3, voffB); PG8_STAGE(PG8_SB(1, 1), b3 + hstep, voffB); PG8_STAGE(PG8_SA(1, 0), a3, o2[0]);
            PG8_WAIT_V(8); PG8_WAIT_L(0); PG8_BAR; PG8_MMA(1, 0, At, B0); PG8_MMA(1, 1, At, B1); PG8_BAR; PG8_SCHED;
            } else {
            PG8_LDB(B0, 0, 0); PG8_SCHED; PG8_LDA(At, 0, 0); PG8_STAGE(PG8_SA(1, 1), a1 + hstep, oc[0]);
            PG8_WAIT_L(8); PG8_BAR; PG8_WAIT_L(0); PG8_MMA(0, 0, At, B0); PG8_BAR; PG8_SCHED;
            PG8_LDB(B1, 0, 1); PG8_STAGE(PG8_SB(0, 0), b2, voffB);
            PG8_BAR; PG8_WAIT_L(0); PG8_MMA(0, 1, At, B1); PG8_BAR;
            PG8_LDA(At, 0, 1); PG8_STAGE(PG8_SA(0, 0), a2, oc[0]);
            PG8_BAR; PG8_WAIT_L(0); PG8_MMA(1, 0, At, B0); PG8_BAR; PG8_SCHED;
            PG8_STAGE(PG8_SB(0, 1), b2 + hstep, voffB);
            PG8_WAIT_V(6); PG8_BAR; PG8_MMA(1, 1, At, B1); PG8_BAR;
            PG8_LDB(B0, 1, 0); PG8_SCHED; PG8_LDA(At, 1, 0); PG8_STAGE(PG8_SA(0, 1), a2 + hstep, oc[0]);
            PG8_WAIT_L(8); PG8_BAR; PG8_WAIT_L(0); PG8_MMA(0, 0, At, B0); PG8_BAR; PG8_SCHED;
            PG8_LDB(B1, 1, 1); PG8_STAGE(PG8_SB(1, 0), b3, voffB);
            PG8_BAR; PG8_WAIT_L(0); PG8_MMA(0, 1, At, B1); PG8_BAR;
            PG8_LDA(At, 1, 1); PG8_STAGE(PG8_SA(1, 0), a3, oc[0]);
            PG8_BAR; PG8_WAIT_L(0); PG8_MMA(1, 0, At, B0); PG8_BAR; PG8_SCHED;
            PG8_STAGE(PG8_SB(1, 1), b3 + hstep, voffB);
            PG8_WAIT_V(6); PG8_BAR; PG8_MMA(1, 1, At, B1); PG8_BAR;
            }
        }
        if constexpr (ALIGN_EPI) { if (wr == 0) PG8_BAR; }
        if constexpr (!Epi::AFTER_DRAIN) { E(acc, cur, wr, wc, fr, fq); S.done(cur); }
        if (!has_next) break;
#pragma unroll
        for (int a = 0; a < 2; ++a)
#pragma unroll
            for (int b = 0; b < 2; ++b)
#pragma unroll
                for (int m = 0; m < 4; ++m)
#pragma unroll
                    for (int n = 0; n < 2; ++n) acc[a][b][m][n] = (f32x4){0.f, 0.f, 0.f, 0.f};
        cur = nxt; cB = nB; ++ui; PG8_TOKS(oc, ui);
        if constexpr (ALIGN_EPI) { if (wr == 1) PG8_BAR; }
    }
    PG8_WAIT_V(0);
    if constexpr (!ALIGN_EPI) { if (wr == 0) PG8_BAR; }
    PG8_BAR;
    if constexpr (Epi::AFTER_DRAIN) { E.fused(acc, cur, wr, wc, fr, fq, lds, wid, lane); S.done(cur); }
#undef PG8_TOKS
#undef PG8_SA
#undef PG8_SB
#undef PG8_STAGE
#undef PG8_LDA
#undef PG8_LDB
#undef PG8_MMA
#undef PG8_WAIT_V
#undef PG8_WAIT_L
#undef PG8_BAR
#undef PG8_SCHED
}
}

constexpr int BATCH = 16, SEQ = 2048, D = 1024, NMETA = 16;
constexpr int TV = SEQ + NMETA;
constexpr int NV = BATCH * TV;
constexpr int NTOK = BATCH * SEQ;
constexpr int NR = NTOK + NMETA;
constexpr int NIN = 5128, NPROJ = 5120;
constexpr int HW = 512;
constexpr int NE = 32, TOPK = 4, DFF = 1024;
constexpr int MAXTILES = 548;
constexpr float EPS = 1e-6f;
constexpr int NWAVES = 8, NTHREADS = 512;

constexpr size_t MiB = 1u << 20, KiB = 1u << 10;
constexpr size_t WS_CTL = 0, CTL_ZERO_BYTES = 1 * MiB;
constexpr size_t WS_WIN = 2 * MiB;
constexpr size_t WS_WBH = 12 * MiB, WS_WBM = 13 * MiB, WS_WOUT = 14 * MiB;
constexpr size_t WS_WGU = 16 * MiB;
constexpr size_t WS_WDN = 144 * MiB;
constexpr size_t WS_BGUP = 208 * MiB;
constexpr size_t WS_RWT = WS_BGUP + 256 * KiB;
constexpr size_t WS_TOPE = WS_RWT + 128 * KiB;
constexpr size_t WS_TOPP = WS_TOPE + 520 * KiB;
constexpr size_t WS_TOPW = WS_TOPP + 520 * KiB;
constexpr size_t WS_RS = WS_TOPW + 520 * KiB;
constexpr size_t WS_LI = WS_RS + 136 * KiB;
constexpr size_t WS_LF = WS_LI + 520 * KiB;
constexpr size_t WS_SLOTRS = WS_LF + 520 * KiB;
constexpr size_t WS_SLOTW = WS_SLOTRS + 552 * KiB;
constexpr size_t WS_XSQ = WS_SLOTW + 552 * KiB;
constexpr size_t WS_SROW = WS_XSQ + 136 * KiB;
constexpr size_t WS_SCOL = WS_SROW + 136 * KiB;
constexpr size_t WS_SMALL_END = WS_SCOL + 32 * KiB;
constexpr size_t WS_RA = 214 * MiB;
constexpr size_t WS_HQ = WS_RA, WS_HG = WS_RA + 33 * MiB, WS_HV = WS_RA + 99 * MiB, WS_HGATE = WS_RA + 132 * MiB, WS_MM = WS_RA + 165 * MiB, WS_MO = WS_RA + 198 * MiB, WS_GATES = WS_RA + 231 * MiB;
constexpr size_t WS_MERGED = WS_RA, WS_TMP = WS_RA + 66 * MiB, WS_H1B = WS_RA + 364 * MiB, WS_ACT = WS_RA;
constexpr size_t WS_RB = WS_RA + 364 * MiB;
constexpr size_t WS_XQ = WS_RB;
constexpr size_t WS_QKVM = WS_RB, WS_CM = WS_RB + 130 * MiB, WS_YHG = WS_RB + 196 * MiB, WS_YML = WS_RB + 229 * MiB, WS_XS = WS_RB, WS_YB = WS_RB;
constexpr size_t WS_RC = WS_RB + 274 * MiB;
constexpr size_t WS_XN0 = WS_RC + 65 * MiB;
constexpr size_t WS_H1 = WS_RC, WS_ETOK = WS_RC + 130 * MiB, WS_ERS = WS_ETOK + 5 * MiB, WS_EW = WS_ERS + 5 * MiB, WS_WIN8 = WS_EW + 5 * MiB, WS_END = WS_WIN8 + 5 * MiB;
static_assert(WS_SMALL_END <= WS_RA && WS_END <= 1024 * MiB, "d_ws map");
static_assert((size_t)NV * HW * 2 <= 33 * MiB && (size_t)NV * HW * 4 <= 66 * MiB && (size_t)NV * 2048 * 2 <= 132 * MiB + MiB && (size_t)NV * D * 4 <= 130 * MiB && (size_t)MAXTILES * 256 * D * 2 <= 274 * MiB, "d_ws sizes");
static_assert((size_t)NE * NV * 4 <= 5 * MiB, "per-expert lists");
static_assert((size_t)NR * D * 2 <= 65 * MiB && (size_t)NR * 4 <= 136 * KiB, "H1 / XN0 / XSQ");
constexpr int CW_TMO = 0, CW_CNT = 64  , CW_BAR = 4096, CW_P0ARR = 3072  , CW_CMAX = 65536  ;

constexpr int RING_OFF = 0, RING_BYTES = 131072;
constexpr int MISC_OFF = RING_BYTES;
constexpr int TEXP_OFF = MISC_OFF + 256;
constexpr int PST_OFF = TEXP_OFF + 640;
constexpr int TOK_OFF = PST_OFF + 384;
constexpr int LDS_BYTES = 147456;
static_assert(TOK_OFF + 18 * 512 <= LDS_BYTES, "LDS map");

#define GAS __attribute__((address_space(1)))
#define LAS __attribute__((address_space(3)))
typedef unsigned short bf16;
typedef unsigned v4u __attribute__((ext_vector_type(4)));
typedef unsigned v2u __attribute__((ext_vector_type(2)));
typedef float f32x4 __attribute__((ext_vector_type(4)));
typedef GAS unsigned gu32;
#define RLX_AGENT __ATOMIC_RELAXED, __HIP_MEMORY_SCOPE_AGENT
#define LDS_WAIT() asm volatile("s_waitcnt lgkmcnt(0)" ::: "memory")
#define VM_WAIT() asm volatile("s_waitcnt vmcnt(0)" ::: "memory")
__device__ __forceinline__ unsigned pk2(float lo, float hi) { return pg8::cvt_pk_bf16(lo, hi); }
__device__ __forceinline__ unsigned f2bf(float f) { return pg8::cvt_pk_bf16(f, 0.f) & 0xffffu; }
__device__ __forceinline__ float bflo(unsigned w) { return __builtin_bit_cast(float, w << 16); }
__device__ __forceinline__ float bfhi(unsigned w) { return __builtin_bit_cast(float, w & 0xffff0000u); }
__device__ __forceinline__ float bf1(bf16 h) { return __builtin_bit_cast(float, (unsigned)h << 16); }
__device__ __forceinline__ float fsigmoid(float x) { return __builtin_amdgcn_rcpf(1.0f + __expf(-x)); }
__device__ __forceinline__ float fsilu(float x) { return x * fsigmoid(x); }
__device__ __forceinline__ size_t rowof(int b, int tt) { return tt < NMETA ? (size_t)(NTOK + tt) : (size_t)b * SEQ + (tt - NMETA); }
__host__ __device__ __forceinline__ int gu_slot(int j) { const int g = (j >> 3) & 3, p = ((g & 1) << 1) | (g >> 1); return (j & ~31) + 8 * p + (j & 7); }
__device__ __forceinline__ float wave_sum(float v) {
#pragma unroll
    for (int o = 1; o < 64; o <<= 1) v += __shfl_xor(v, o);
    return v;
}
__device__ __forceinline__ float wave_max(float v) {
#pragma unroll
    for (int o = 1; o < 64; o <<= 1) v = fmaxf(v, __shfl_xor(v, o));
    return v;
}
#define XB_TMO      128
#define XB_XCNT(j)  (256  + 64 * (j))
#define XB_XSUB(j)  (1280 + 64 * (j))
#define XB_XGEN(j)  (2304 + 64 * (j))
#define XB_TOP      3328
#define XB_TOPGEN   3392
#define XCD_BAR_WORDS 3456
#define XB_SPIN_CAP (1u << 18)

__device__ __forceinline__ unsigned xb_ld(unsigned* p)              { return __hip_atomic_load(p, __ATOMIC_RELAXED, __HIP_MEMORY_SCOPE_AGENT); }
__device__ __forceinline__ unsigned xb_add(unsigned* p, unsigned v) { return __hip_atomic_fetch_add(p, v, __ATOMIC_RELAXED, __HIP_MEMORY_SCOPE_AGENT); }
__device__ __forceinline__ unsigned xb_xcc_id() { return (unsigned)__builtin_amdgcn_s_getreg((3 << 11) | 20) & 0xFu; }
#define XB_SPIN(cond, bar) do { unsigned _sp = 0; while (cond) { __builtin_amdgcn_s_sleep(1); \
    if ((++_sp & 255u) == 0u) { if (xb_ld(&(bar)[XB_TMO])) break; if (_sp > XB_SPIN_CAP) { atomicAdd(&(bar)[XB_TMO], 1u); break; } } } } while (0)

struct XcdBarrier {
    unsigned* bar; unsigned x;
    volatile LAS unsigned* st;
};

__device__ __forceinline__ XcdBarrier xcd_barrier_post(unsigned* bar, volatile LAS unsigned* st) {
    XcdBarrier b; b.bar = bar; b.x = xb_xcc_id(); b.st = st;
    if (threadIdx.x == 0) (void)xb_add(&bar[XB_XCNT(b.x)], 1u);
    return b;
}
__device__ __forceinline__ void xcd_barrier_complete(unsigned* bar, unsigned x, unsigned& nloc, unsigned& nx) {
    const unsigned G = gridDim.x * gridDim.y * gridDim.z;
    unsigned sum, cnt, mine, sp = 0u;
    for (;;) {
        sum = 0u; cnt = 0u; mine = 0u;
#pragma unroll
        for (unsigned j = 0; j < 16; ++j) { const unsigned c = xb_ld(&bar[XB_XCNT(j)]); sum += c; cnt += (c > 0u) ? 1u : 0u; mine = (j == x) ? c : mine; }
        if (sum == G) break;
        __builtin_amdgcn_s_sleep(1);
        if ((++sp & 255u) == 0u) { if (xb_ld(&bar[XB_TMO])) break; if (sp > XB_SPIN_CAP) { atomicAdd(&bar[XB_TMO], 1u); break; } }
    }
    nloc = mine > 0u ? mine : 1u; nx = cnt > 0u ? cnt : 1u;
}

__device__ __forceinline__ void xcd_barrier(const XcdBarrier& b) {
    asm volatile("s_waitcnt vmcnt(0)" ::: "memory");
    __syncthreads();
    if (threadIdx.x == 0) {
        unsigned* bar = b.bar;
        __builtin_amdgcn_s_waitcnt(0);
        unsigned nloc = b.st[0], nx = b.st[1];
        if (nloc == 0u) { xcd_barrier_complete(bar, b.x, nloc, nx); b.st[0] = nloc; b.st[1] = nx; }
        const unsigned old = xb_add(&bar[XB_XSUB(b.x)], 1u);
        const unsigned gen = old / nloc;
        if (old + 1u == (gen + 1u) * nloc) {
            __builtin_amdgcn_fence(__ATOMIC_RELEASE, "agent");
            asm volatile("s_waitcnt vmcnt(0)" ::: "memory");
            const unsigned og = xb_add(&bar[XB_TOP], 1u);
            const unsigned tg = og / nx;
            if (og + 1u == (tg + 1u) * nx) xb_add(&bar[XB_TOPGEN], 1u);
            else XB_SPIN(xb_ld(&bar[XB_TOPGEN]) == tg, bar);
            __builtin_amdgcn_fence(__ATOMIC_ACQUIRE, "agent");
            xb_add(&bar[XB_XGEN(b.x)], 1u);
            asm volatile("s_waitcnt vmcnt(0)" ::: "memory");
        } else {
            XB_SPIN(xb_ld(&bar[XB_XGEN(b.x)]) == gen, bar);
            __builtin_amdgcn_fence(__ATOMIC_ACQUIRE, "agent");
            asm volatile("s_waitcnt vmcnt(0)" ::: "memory");
        }
    }
    __syncthreads();
}

struct Frame {
    LAS unsigned char* lds;
    volatile LAS unsigned* MISC;
    gu32* ctl;
    int tid, lane, wave, vcu, G;
    const float* in[25];
    float* out;
    unsigned char* ws;
};
#define IN_X 0
#define IN_META 1
#define IN_LBL 2
#define IN_NMIX 3
#define IN_WIN 4
#define IN_HGNORM 5
#define IN_CONVW 6
#define IN_CONVB 7
#define IN_WQ 8
#define IN_WK 9
#define IN_WV 10
#define IN_GATEB 11
#define IN_MLNORM 12
#define IN_MLSKIP 13
#define IN_WBH 14
#define IN_WBM 15
#define IN_WOUT 16
#define IN_NFFN 17
#define IN_RW 18
#define IN_RB 19
#define IN_WGU 20
#define IN_BGU 21
#define IN_WDN 22
#define IN_BDN 23
#define IN_NFIN 24

__device__ __forceinline__ void p0_item(const float* W, int ldw, int col0, int cstride, const float* kscale, bf16* WT, int K, int dstrow0, int k0, LAS float* scr, int lane, float gsc = 1.f, gu32* cmax = nullptr) {
    (void)cstride;
    const int r = lane >> 3, c4 = (lane & 7) * 4;
    f32x4 v[8];
#pragma unroll
    for (int i = 0; i < 8; ++i) v[i] = *(const GAS f32x4*)(W + (size_t)(k0 + 8 * i + r) * ldw + col0 + c4);
#pragma unroll
    for (int i = 0; i < 8; ++i) { const float sc = kscale ? kscale[k0 + 8 * i + r] : gsc; LAS float* s = scr + (8 * i + r) * 33 + c4; s[0] = v[i].x * sc; s[1] = v[i].y * sc; s[2] = v[i].z * sc; s[3] = v[i].w * sc; }
    LDS_WAIT(); asm volatile("" ::: "memory");
    const int c = lane & 7;
#pragma unroll
    for (int j = 0; j < 4; ++j) { const int n = (lane >> 3) + 8 * j; const LAS float* s = scr + (8 * c) * 33 + n;
        v4u o; o.x = pk2(s[0 * 33], s[1 * 33]); o.y = pk2(s[2 * 33], s[3 * 33]); o.z = pk2(s[4 * 33], s[5 * 33]); o.w = pk2(s[6 * 33], s[7 * 33]);
        if (cmax) { float m = fmaxf(fmaxf(fmaxf(fabsf(s[0 * 33]), fabsf(s[1 * 33])), fmaxf(fabsf(s[2 * 33]), fabsf(s[3 * 33]))), fmaxf(fmaxf(fabsf(s[4 * 33]), fabsf(s[5 * 33])), fmaxf(fabsf(s[6 * 33]), fabsf(s[7 * 33]))));
            m = fmaxf(m, __shfl_xor(m, 1)); m = fmaxf(m, __shfl_xor(m, 2)); m = fmaxf(m, __shfl_xor(m, 4));
            if (c == 0) (void)__hip_atomic_fetch_max(cmax + dstrow0 + n, __builtin_bit_cast(unsigned, m), RLX_AGENT); }
        *(GAS v4u*)(WT + (size_t)(dstrow0 + n) * K + k0 + 8 * c) = o; }
    LDS_WAIT(); asm volatile("" ::: "memory");
}
__device__ __forceinline__ void p0_prologue(Frame& F) {
    unsigned char* ws = F.ws;
    const int gw = F.vcu * NWAVES + F.wave, NGW = F.G * NWAVES, gt = F.vcu * NTHREADS + F.tid, NGT = F.G * NTHREADS;
    {
        LAS float* scr = (LAS float*)(F.lds + RING_OFF + F.wave * 16384);
        constexpr int I_IN1 = 16 * 96, I_IN2 = 16 * 64, I_BH = 8 * 32, I_OUT = 16 * 32;
        constexpr int NITEMS = I_IN1 + I_IN2 + 2 * I_BH + I_OUT;
        for (int it = gw; it < NITEMS; it += NGW) {
            int r = it;
            if (r < I_IN1) { const int kb = r / 96, nb = r % 96; p0_item(F.in[IN_WIN], NIN, 32 * nb, 1, F.in[IN_NMIX], (bf16*)(ws + WS_WIN), D, 32 * nb, 64 * kb, scr, F.lane, 1.f, F.ctl + CW_CMAX); continue; } r -= I_IN1;
            if (r < I_IN2) { const int kb = r / 64, nb = r % 64; p0_item(F.in[IN_WIN], NIN, 3080 + 32 * nb, 1, F.in[IN_NMIX], (bf16*)(ws + WS_WIN), D, 3072 + 32 * nb, 64 * kb, scr, F.lane, 1.f, F.ctl + CW_CMAX); continue; } r -= I_IN2;
            if (r < I_BH) { const int kb = r / 32, nb = r % 32; p0_item(F.in[IN_WBH], D, 32 * nb, 1, nullptr, (bf16*)(ws + WS_WBH), HW, 32 * nb, 64 * kb, scr, F.lane, 1.f / 255.f); continue; } r -= I_BH;
            if (r < I_BH) { const int kb = r / 32, nb = r % 32; p0_item(F.in[IN_WBM], D, 32 * nb, 1, nullptr, (bf16*)(ws + WS_WBM), HW, 32 * nb, 64 * kb, scr, F.lane, 1.f / 255.f); continue; } r -= I_BH;
            { const int kb = r / 32, nb = r % 32; p0_item(F.in[IN_WOUT], D, 32 * nb, 1, nullptr, (bf16*)(ws + WS_WOUT), D, 32 * nb, 64 * kb, scr, F.lane); }
        }
    }
    asm volatile("s_waitcnt vmcnt(0)" ::: "memory"); __syncthreads();
    if (F.tid == 0) (void)__hip_atomic_fetch_add(F.ctl + CW_P0ARR, 1u, RLX_AGENT);
    {
        LAS float* wm = (LAS float*)(F.lds + RING_OFF + 65536);
        { float wa[16], wb[16];
#pragma unroll
          for (int q = 0; q < 16; ++q) { const int u = F.tid + q * NTHREADS, j = u & 7, l = (u >> 3) & 63, i = u >> 9, k = 4 * l + 256 * (i >> 2) + (i & 3); wa[q] = F.in[IN_NMIX][k]; wb[q] = F.in[IN_WIN][(size_t)k * NIN + 3072 + j]; }
#pragma unroll
          for (int q = 0; q < 16; ++q) wm[F.tid + q * NTHREADS] = wa[q] * wb[q]; }
        __syncthreads();
        bf16* XN0 = (bf16*)(ws + WS_XN0); float* XSQ = (float*)(ws + WS_XSQ); unsigned char* XQ = ws + WS_XQ; float* SROW = (float*)(ws + WS_SROW); float* LI = (float*)(ws + WS_LI); float* LF = (float*)(ws + WS_LF);
        f32x4 vn[4];
#define P0_LOADROW(dst, V_) do { const int Vc_ = (V_) < NR ? (V_) : NR - 1; const float* src_ = (Vc_ >= NTOK) ? F.in[IN_META] + (size_t)(Vc_ - NTOK) * D : F.in[IN_X] + (size_t)Vc_ * D; \
        const GAS f32x4* xr_ = (const GAS f32x4*)src_ + F.lane; _Pragma("unroll") for (int j = 0; j < 4; ++j) dst[j] = xr_[64 * j]; } while (0)
        P0_LOADROW(vn, gw);
        for (int V = gw; V < NR; V += NGW) {
            f32x4 v[4]; float s = 0.f, am = 0.f;
#pragma unroll
            for (int j = 0; j < 4; ++j) { v[j] = vn[j]; s += (v[j].x * v[j].x + v[j].y * v[j].y) + (v[j].z * v[j].z + v[j].w * v[j].w); am = fmaxf(am, fmaxf(fmaxf(fabsf(v[j].x), fabsf(v[j].y)), fmaxf(fabsf(v[j].z), fabsf(v[j].w)))); }
            P0_LOADROW(vn, V + NGW);
            asm volatile("" ::: "memory");
            const float sq = sqrtf(wave_sum(s) * (1.f / D) + EPS), rs = 1.0f / sq;
            am = wave_max(am) * rs; const float srow = am > 0.f ? am * (1.f / 127.f) : 1.f, qi = 1.f / srow;
            if (F.lane == 0) { XSQ[V] = sq; SROW[V] = srow; }
            GAS unsigned* q4 = (GAS unsigned*)(XQ + (size_t)V * D) + F.lane;
            float g[8];
#pragma unroll
            for (int j = 0; j < 8; ++j) g[j] = 0.f;
            GAS unsigned long long* o8 = (GAS unsigned long long*)(XN0 + (size_t)V * D) + F.lane;
#pragma unroll
            for (int j = 0; j < 4; ++j) {
                v[j] = v[j] * rs;
                __builtin_nontemporal_store((unsigned long long)pk2(v[j].x, v[j].y) | ((unsigned long long)pk2(v[j].z, v[j].w) << 32), o8 + 64 * j);
                q4[64 * j] = ((unsigned)(int)rintf(v[j].x * qi) & 0xffu) | (((unsigned)(int)rintf(v[j].y * qi) & 0xffu) << 8) | (((unsigned)(int)rintf(v[j].z * qi) & 0xffu) << 16) | ((unsigned)(int)rintf(v[j].w * qi) << 24);
#pragma unroll
                for (int q = 0; q < 4; ++q) { const LAS f32x4* wp = (const LAS f32x4*)(wm + (((4 * j + q) * 64 + F.lane) * 8)); const f32x4 w0 = wp[0], w1 = wp[1]; const float xv = v[j][q];
                    g[0] += xv * w0.x; g[1] += xv * w0.y; g[2] += xv * w0.z; g[3] += xv * w0.w; g[4] += xv * w1.x; g[5] += xv * w1.y; g[6] += xv * w1.z; g[7] += xv * w1.w; }
            }
#pragma unroll
            for (int j = 0; j < 8; ++j) g[j] = wave_sum(g[j]);
            if (F.lane < 4) {
                const float gi = (F.lane == 0 ? g[0] : F.lane == 1 ? g[1] : F.lane == 2 ? g[2] : g[3]) + F.in[IN_GATEB][F.lane];
                const float gf = (F.lane == 0 ? g[4] : F.lane == 1 ? g[5] : F.lane == 2 ? g[6] : g[7]) + F.in[IN_GATEB][4 + F.lane];
                LI[(size_t)V * 4 + F.lane] = gi;
                LF[(size_t)V * 4 + F.lane] = fminf(gf, 0.f) - log1pf(__expf(-fabsf(gf)));
            }
        }
        __syncthreads();
    }
    { float* BGUP = (float*)(ws + WS_BGUP); float* RWT = (float*)(ws + WS_RWT);
      for (int u = gt; u < NE * 2 * DFF; u += NGT) { const int e = u >> 11, n = u & 2047, pn = n >> 8, bj = (n >> 7) & 1, j = gu_slot(n & 127); BGUP[u] = F.in[IN_BGU][(size_t)e * 2 * DFF + 2 * (128 * pn + j) + bj]; }
      for (int u = gt; u < NE * D; u += NGT) { const int e = u >> 10, k = u & 1023; RWT[u] = F.in[IN_NFFN][k] * F.in[IN_RW][(size_t)k * NE + e]; } }
}

__device__ __forceinline__ void p0b_quant(Frame& F) {
    unsigned char* ws = F.ws; const int gw = F.vcu * NWAVES + F.wave, NGW = F.G * NWAVES, lane = F.lane;
    LAS float* scr = (LAS float*)(F.lds + RING_OFF + F.wave * 16384);
    unsigned char* W8 = ws + WS_WIN8; float* SCOL = (float*)(ws + WS_SCOL); const float* W = F.in[IN_WIN]; const float* kscale = F.in[IN_NMIX];
    constexpr int I_IN1 = 16 * 96, I_IN2 = 16 * 64;
    const int r = lane >> 3, c4 = (lane & 7) * 4;
    __syncthreads();
    if (F.tid == 0) { unsigned sp = 0; while (__hip_atomic_load(F.ctl + CW_P0ARR, RLX_AGENT) < (unsigned)F.G) { __builtin_amdgcn_s_sleep(2); if (++sp > (1u << 22)) break; } }
    __syncthreads();
    for (int it = gw; it < I_IN1 + I_IN2; it += NGW) {
        int kb, nb, col0, dstrow0;
        if (it < I_IN1) { kb = it / 96; nb = it % 96; col0 = 32 * nb; dstrow0 = 32 * nb; } else { const int q = it - I_IN1; kb = q / 64; nb = q % 64; col0 = 3080 + 32 * nb; dstrow0 = 3072 + 32 * nb; }
        const int k0 = 64 * kb;
        f32x4 v[8];
#pragma unroll
        for (int i = 0; i < 8; ++i) v[i] = *(const GAS f32x4*)(W + (size_t)(k0 + 8 * i + r) * NIN + col0 + c4);
        float qs[4];
#pragma unroll
        for (int e = 0; e < 4; ++e) { const float m = __builtin_bit_cast(float, __hip_atomic_load(F.ctl + CW_CMAX + dstrow0 + c4 + e, RLX_AGENT)); qs[e] = 127.f / fmaxf(m, 1e-30f); }
        if (kb == 0 && lane < 8) {
#pragma unroll
            for (int e = 0; e < 4; ++e) SCOL[dstrow0 + c4 + e] = 1.f / qs[e]; }
#pragma unroll
        for (int i = 0; i < 8; ++i) { const float sc = kscale[k0 + 8 * i + r]; LAS float* s = scr + (8 * i + r) * 33 + c4; s[0] = rintf(v[i].x * sc * qs[0]); s[1] = rintf(v[i].y * sc * qs[1]); s[2] = rintf(v[i].z * sc * qs[2]); s[3] = rintf(v[i].w * sc * qs[3]); }
        LDS_WAIT(); asm volatile("" ::: "memory");
        const int c = lane & 7;
#pragma unroll
        for (int j = 0; j < 4; ++j) { const int n = (lane >> 3) + 8 * j; const LAS float* s = scr + (8 * c) * 33 + n;
            v2u o;
            o.x = ((unsigned)(int)s[0 * 33] & 0xffu) | (((unsigned)(int)s[1 * 33] & 0xffu) << 8) | (((unsigned)(int)s[2 * 33] & 0xffu) << 16) | ((unsigned)(int)s[3 * 33] << 24);
            o.y = ((unsigned)(int)s[4 * 33] & 0xffu) | (((unsigned)(int)s[5 * 33] & 0xffu) << 8) | (((unsigned)(int)s[6 * 33] & 0xffu) << 16) | ((unsigned)(int)s[7 * 33] << 24);
            *(GAS v2u*)(W8 + (size_t)(dstrow0 + n) * D + k0 + 8 * c) = o; }
        LDS_WAIT(); asm volatile("" ::: "memory");
    }
}

__device__ __forceinline__ unsigned pk4_fp8(float a, float b, float c, float d) { unsigned w = 0;
    a = __builtin_amdgcn_fmed3f(a, -448.f, 448.f); b = __builtin_amdgcn_fmed3f(b, -448.f, 448.f); c = __builtin_amdgcn_fmed3f(c, -448.f, 448.f); d = __builtin_amdgcn_fmed3f(d, -448.f, 448.f);
    w = __builtin_amdgcn_cvt_pk_fp8_f32(a, b, w, false); w = __builtin_amdgcn_cvt_pk_fp8_f32(c, d, w, true); return w; }
__device__ __forceinline__ void cvdn_load(const float* Wdn, int it, f32x4 (&v)[8], int lane) {
    const int e = it >> 9, kb = (it >> 5) & 15, nb = it & 31, r = lane >> 3, c4 = (lane & 7) * 4; const float* W = Wdn + (size_t)e * DFF * D;
#pragma unroll
    for (int i = 0; i < 8; ++i) v[i] = *(const GAS f32x4*)(W + (size_t)(64 * kb + 8 * i + r) * D + 32 * nb + c4);
}
__device__ __forceinline__ void cvdn_proc(unsigned char* WTdn, int it, const f32x4 (&v)[8], LAS float* scr, int lane) {
    const int e = it >> 9, kb = (it >> 5) & 15, nb = it & 31, r = lane >> 3, c4 = (lane & 7) * 4; unsigned char* WT = WTdn + (size_t)e * D * DFF;
#pragma unroll
    for (int i = 0; i < 8; ++i) { LAS float* s = scr + (8 * i + r) * 33 + c4; s[0] = v[i].x * 32.f; s[1] = v[i].y * 32.f; s[2] = v[i].z * 32.f; s[3] = v[i].w * 32.f; }
    LDS_WAIT(); asm volatile("" ::: "memory");
    const int c = lane & 7;
#pragma unroll
    for (int j = 0; j < 4; ++j) { const int n = (lane >> 3) + 8 * j; const LAS float* s = scr + (8 * c) * 33 + n;
        v2u o; o.x = pk4_fp8(s[0 * 33], s[1 * 33], s[2 * 33], s[3 * 33]); o.y = pk4_fp8(s[4 * 33], s[5 * 33], s[6 * 33], s[7 * 33]);
        const int cn = 32 * nb + n, rowp = (cn & ~255) + 128 * ((cn >> 3) & 1) + 32 * ((cn >> 6) & 3) + 8 * ((cn >> 4) & 3) + (cn & 7);
        *(GAS v2u*)(WT + (size_t)rowp * DFF + 64 * kb + 8 * c) = o; }
    LDS_WAIT(); asm volatile("" ::: "memory");
}
__device__ __forceinline__ void cvgu_load(const float* Wgu, const float* nffn, int it, f32x4 (&v)[8], float (&sc)[8], int lane) {
    const int e = it >> 10, kb = (it >> 5) & 31, nb = it & 31, r = lane >> 4, c4 = (lane & 15) * 4; const float* W = Wgu + (size_t)e * D * 2 * DFF;
#pragma unroll
    for (int i = 0; i < 8; ++i) { v[i] = *(const GAS f32x4*)(W + (size_t)(32 * kb + 4 * i + r) * (2 * DFF) + 64 * nb + c4); sc[i] = nffn[32 * kb + 4 * i + r] * 32.f; }
}
__device__ __forceinline__ void cvgu_proc(unsigned char* WTgu, int it, const f32x4 (&v)[8], const float (&sc)[8], LAS float* scr, int lane) {
    const int e = it >> 10, kb = (it >> 5) & 31, nb = it & 31, r = lane >> 4, c4 = (lane & 15) * 4, A0 = 32 * nb, k0 = 32 * kb; unsigned char* WT = WTgu + (size_t)e * 2 * DFF * D;
    LAS float* sg = scr; LAS float* su = scr + 32 * 33;
#pragma unroll
    for (int i = 0; i < 8; ++i) { const int o = (4 * i + r) * 33 + (c4 >> 1); sg[o] = v[i].x * sc[i]; su[o] = v[i].y * sc[i]; sg[o + 1] = v[i].z * sc[i]; su[o + 1] = v[i].w * sc[i]; }
    LDS_WAIT(); asm volatile("" ::: "memory");
    const int c = lane & 3;
#pragma unroll
    for (int j = 0; j < 4; ++j) { const int q = (lane >> 2) + 16 * j, isup = q >> 5, jj = q & 31, A = A0 + jj; const LAS float* s = scr + isup * 32 * 33 + (8 * c) * 33 + jj;
        v2u o; o.x = pk4_fp8(s[0 * 33], s[1 * 33], s[2 * 33], s[3 * 33]); o.y = pk4_fp8(s[4 * 33], s[5 * 33], s[6 * 33], s[7 * 33]);
        *(GAS v2u*)(WT + (size_t)(256 * (A >> 7) + 128 * isup + gu_slot(A & 127)) * D + k0 + 8 * c) = o; }
    LDS_WAIT(); asm volatile("" ::: "memory");
}
__device__ __forceinline__ void px_experts(Frame& F, int rank, int nwg) {
    unsigned char* ws = F.ws;
    LAS float* scr = (LAS float*)(F.lds + RING_OFF + F.wave * 16384);
    const int gw = rank * NWAVES + F.wave, NGW = nwg * NWAVES;
    { constexpr int NIT = NE * 1024; f32x4 v[8], vn[8]; float sc[8], sn[8]; int it = gw;
      if (it < NIT) cvgu_load(F.in[IN_WGU], F.in[IN_NFFN], it, v, sc, F.lane);
      while (it < NIT) { const int nx = it + NGW; if (nx < NIT) cvgu_load(F.in[IN_WGU], F.in[IN_NFFN], nx, vn, sn, F.lane);
          asm volatile("" ::: "memory");
          cvgu_proc((unsigned char*)(ws + WS_WGU), it, v, sc, scr, F.lane); asm volatile("" ::: "memory");
#pragma unroll
          for (int i = 0; i < 8; ++i) { v[i] = vn[i]; sc[i] = sn[i]; }
          it = nx; } }
    { constexpr int NIT = NE * 512; f32x4 v[8], vn[8]; int it = gw;
      if (it < NIT) cvdn_load(F.in[IN_WDN], it, v, F.lane);
      while (it < NIT) { const int nx = it + NGW; if (nx < NIT) cvdn_load(F.in[IN_WDN], nx, vn, F.lane);
          asm volatile("" ::: "memory");
          cvdn_proc((unsigned char*)(ws + WS_WDN), it, v, scr, F.lane); asm volatile("" ::: "memory");
#pragma unroll
          for (int i = 0; i < 8; ++i) v[i] = vn[i];
          it = nx; } }
}

namespace pg8 {
typedef unsigned v2u_t __attribute__((ext_vector_type(2)));
typedef float f32x2 __attribute__((ext_vector_type(2)));
__device__ __forceinline__ f32x2 sig2(f32x2 x) { const f32x2 t = x * (f32x2){-1.4426950408889634f, -1.4426950408889634f};
    const f32x2 d = (f32x2){__builtin_amdgcn_exp2f(t.x), __builtin_amdgcn_exp2f(t.y)} + (f32x2){1.f, 1.f}; return (f32x2){__builtin_amdgcn_rcpf(d.x), __builtin_amdgcn_rcpf(d.y)}; }
__device__ __forceinline__ u32x4 pack8(const f32x4& a, const f32x4& b) { u32x4 w; w.x = cvt_pk_bf16(a[0], a[1]); w.y = cvt_pk_bf16(a[2], a[3]); w.z = cvt_pk_bf16(b[0], b[1]); w.w = cvt_pk_bf16(b[2], b[3]); return w; }
__device__ __forceinline__ v2u_t pack8_fp8(const f32x4& a, const f32x4& b) { unsigned lo = 0, hi = 0;
    lo = __builtin_amdgcn_cvt_pk_fp8_f32(a[0], a[1], lo, false); lo = __builtin_amdgcn_cvt_pk_fp8_f32(a[2], a[3], lo, true);
    hi = __builtin_amdgcn_cvt_pk_fp8_f32(b[0], b[1], hi, false); hi = __builtin_amdgcn_cvt_pk_fp8_f32(b[2], b[3], hi, true); return (v2u_t){lo, hi}; }
__device__ __forceinline__ v2u_t pack8_fp8_sat(const f32x4& a, const f32x4& b) { f32x4 x, y;
#pragma unroll
    for (int i = 0; i < 4; ++i) { x[i] = __builtin_amdgcn_fmed3f(a[i], -448.f, 448.f); y[i] = __builtin_amdgcn_fmed3f(b[i], -448.f, 448.f); }
    return pack8_fp8(x, y); }
__device__ __forceinline__ void unpack8(const u32x4& w, f32x4& a, f32x4& b) { a = (f32x4){bflo(w.x), bfhi(w.x), bflo(w.y), bfhi(w.y)}; b = (f32x4){bflo(w.z), bfhi(w.z), bflo(w.w), bfhi(w.w)}; }
__host__ __device__ __forceinline__ int gate_pos(int c) { return (c & ~255) + ((((c >> 5) & 3) * 4 + ((c >> 3) & 3)) * 16) + (((c >> 7) & 1) * 8) + (c & 7); }
__device__ __forceinline__ unsigned q8x4(float a, float b, float c, float d) {
    const unsigned t0 = __builtin_bit_cast(unsigned, __builtin_fmaf(a, 255.f, 8388608.f)), t1 = __builtin_bit_cast(unsigned, __builtin_fmaf(b, 255.f, 8388608.f));
    const unsigned t2 = __builtin_bit_cast(unsigned, __builtin_fmaf(c, 255.f, 8388608.f)), t3 = __builtin_bit_cast(unsigned, __builtin_fmaf(d, 255.f, 8388608.f));
    return (t0 & 0xffu) | (t1 << 8) | (t2 << 16) | (t3 << 24); }
__device__ __forceinline__ f32x4 dq8x4(unsigned w) { return (f32x4){(float)(w & 0xffu), (float)((w >> 8) & 0xffu), (float)((w >> 16) & 0xffu), (float)(w >> 24)}; }
struct EpiNull { static constexpr bool PERM = true, AFTER_DRAIN = false; int* sink;
    __device__ __forceinline__ void operator()(const f32x4 (&acc)[2][2][4][2], const Unit& u, int wr, int wc, int fr, int fq) const { int s = 0;
#pragma unroll
        for (int a = 0; a < 2; ++a)
#pragma unroll
            for (int b = 0; b < 2; ++b)
#pragma unroll
                for (int m = 0; m < 4; ++m)
#pragma unroll
                    for (int n = 0; n < 2; ++n) { const i32x4 q = __builtin_bit_cast(i32x4, acc[a][b][m][n]); s += (q[0] ^ q[1]) + (q[2] ^ q[3]); }
        if (s == 0x7fffff01 + u.pm) sink[0] = s; } };
template <bool Q, bool NS = false>
struct EpiProjT {
    static constexpr bool PERM = true, AFTER_DRAIN = false;
    unsigned char* ws; const float* lbl; const float* srow; const float* scol;
    struct Sc { float rs[8]; f32x2 cs[2][4]; };
    __device__ __forceinline__ f32x2 val(const f32x4 (&acc)[2][2][4][2], const Sc& sc, int ai, int bj, int m, int k) const {
        const f32x4 a = acc[ai][bj][m][k >> 1];
        if constexpr (Q) { const i32x4 q = __builtin_bit_cast(i32x4, a); const float r = sc.rs[ai * 4 + m]; return ((f32x2){(float)q[2 * (k & 1)], (float)q[2 * (k & 1) + 1]} * sc.cs[bj][k]) * (f32x2){r, r}; }
        else return (f32x2){a[2 * (k & 1)], a[2 * (k & 1) + 1]};
    }
    template <int ACT>
    __device__ __forceinline__ void emit(const f32x4 (&acc)[2][2][4][2], const Sc& sc, bf16_t* O, int row0, int colt) const {
#pragma unroll
        for (int ai = 0; ai < 2; ++ai)
#pragma unroll
            for (int m = 0; m < 4; ++m) { bf16_t* rowp = O + (size_t)(row0 + ai * HALF + m * 16) * HW + colt;
#pragma unroll
                for (int bj = 0; bj < 2; ++bj) { u32x4 o;
#pragma unroll
                    for (int k = 0; k < 4; ++k) { f32x2 p = val(acc, sc, ai, bj, m, k);
                        if constexpr (ACT == 1) p = p * sig2(p); else if constexpr (ACT == 2) p = sig2(p);
                        o[k] = cvt_pk_bf16(p.x, p.y); }
                    if constexpr (NS) asm volatile("" :: "v"(o.x), "v"(o.y), "v"(o.z), "v"(o.w)); else *(u32x4*)(rowp + bj * HALF) = o; } }
    }
    __device__ __forceinline__ void operator()(const f32x4 (&acc)[2][2][4][2], const Unit& u, int wr, int wc, int fr, int fq) const {
        const int row0 = u.pm * BM + wr * 64 + fr, kind = u.pn < 12 ? (u.pn >> 1) : 6;
        const int colt = (u.pn < 12 ? (u.pn & 1) : (u.pn - 12)) * BM + wc * 32 + 8 * fq;
        Sc sc;
        if constexpr (Q) {
#pragma unroll
            for (int it = 0; it < 8; ++it) sc.rs[it] = srow[row0 + (it >> 2) * HALF + (it & 3) * 16];
#pragma unroll
            for (int bj = 0; bj < 2; ++bj) { const float* cp = scol + u.pn * BM + wc * 32 + 8 * fq + bj * HALF; const f32x4 c0 = *(const f32x4*)cp, c1 = *(const f32x4*)(cp + 4);
                sc.cs[bj][0] = (f32x2){c0[0], c0[1]}; sc.cs[bj][1] = (f32x2){c0[2], c0[3]}; sc.cs[bj][2] = (f32x2){c1[0], c1[1]}; sc.cs[bj][3] = (f32x2){c1[2], c1[3]}; }
        }
        if (kind == 1) {
            bf16_t* HG = (bf16_t*)(ws + WS_HG);
#pragma unroll
            for (int bj = 0; bj < 2; ++bj) { const int c = colt + bj * HALF; f32x2 lb[4], ol[4];
#pragma unroll
                for (int k = 0; k < 4; ++k) { lb[k] = sig2((f32x2){lbl[c + 2 * k] - lbl[HW + c + 2 * k], lbl[c + 2 * k + 1] - lbl[HW + c + 2 * k + 1]}); ol[k] = (f32x2){1.f, 1.f} - lb[k]; }
#pragma unroll
                for (int ai = 0; ai < 2; ++ai)
#pragma unroll
                    for (int m = 0; m < 4; ++m) { u32x4 o;
#pragma unroll
                        for (int k = 0; k < 4; ++k) { const f32x2 f = ol[k] * sig2(val(acc, sc, ai, bj, m, k)) + lb[k];
                            const f32x2 lg = (f32x2){__builtin_amdgcn_logf(f.x), __builtin_amdgcn_logf(f.y)} * (f32x2){0.6931471805599453f, 0.6931471805599453f}; o[k] = cvt_pk_bf16(lg.x, lg.y); }
                        if constexpr (NS) asm volatile("" :: "v"(o.x), "v"(o.y), "v"(o.z), "v"(o.w)); else *(u32x4*)(HG + (size_t)(row0 + ai * HALF + m * 16) * HW + c) = o; } }
            return;
        }
        if (kind == 6) {
            unsigned char* G8 = ws + WS_GATES; const int gofs = (u.pn - 12) * BM + (wc * 4 + fq) * 16;
#pragma unroll
            for (int ai = 0; ai < 2; ++ai)
#pragma unroll
                for (int m = 0; m < 4; ++m) { u32x4 o;
#pragma unroll
                    for (int bj = 0; bj < 2; ++bj)
#pragma unroll
                        for (int h = 0; h < 2; ++h) {
                            const f32x2 sa = sig2(val(acc, sc, ai, bj, m, 2 * h)), sb = sig2(val(acc, sc, ai, bj, m, 2 * h + 1));
                            o[2 * bj + h] = q8x4(sa.x, sa.y, sb.x, sb.y); }
                    if constexpr (NS) asm volatile("" :: "v"(o.x), "v"(o.y), "v"(o.z), "v"(o.w)); else __builtin_nontemporal_store(o, (u32x4*)(G8 + (size_t)(row0 + ai * HALF + m * 16) * 2048 + gofs)); }
            return;
        }
        if (kind == 0) emit<1>(acc, sc, (bf16_t*)(ws + WS_HQ), row0, colt); else if (kind == 2) emit<0>(acc, sc, (bf16_t*)(ws + WS_HV), row0, colt); else if (kind == 3) emit<1>(acc, sc, (bf16_t*)(ws + WS_HGATE), row0, colt);
        else if (kind == 4) emit<0>(acc, sc, (bf16_t*)(ws + WS_MM), row0, colt); else emit<2>(acc, sc, (bf16_t*)(ws + WS_MO), row0, colt);
    }
};
constexpr int PAIR_DA = 132, PAIR_DB = 4;
struct PairOrder { StaticOrder S;
    __device__ __forceinline__ bool next(int i, Unit& u) const { Unit t; if (!S.next(i >> 1, t)) return false; const int s = i & 1; u.pm = t.pm + PAIR_DA * s; u.pn = t.pn + PAIR_DB * s; return true; }
    __device__ __forceinline__ void a_ready(const Unit&) const {}
    __device__ __forceinline__ void done(const Unit&) const {}
};
struct EpiGate2 {
    static constexpr bool PERM = true, AFTER_DRAIN = false, CHAIN = true;
    const unsigned char* __restrict__ gates; bf16_t* __restrict__ merged;
    __device__ __forceinline__ bool chain(f32x4 (&acc)[2][2][4][2], const Unit& u, int wr, int wc, int fr, int fq) const {
        const int step = u.pm >= PAIR_DA ? 1 : 0, pm = u.pm - PAIR_DA * step, pn = u.pn - PAIR_DB * step;
        const int row0 = pm * BM + wr * 64 + fr, col0 = pn * BM + wc * 32 + 8 * fq, gofs = pn * BM + (wc * 4 + fq) * 16;
        constexpr int NB = 2, NBAT = 8 / NB;
        u32x4 g0c[NB], g1c[NB], g0n[NB], g1n[NB];
#define EG_LOAD(G0, G1, b_) do { _Pragma("unroll") for (int s_ = 0; s_ < NB; ++s_) { const int it_ = (b_) * NB + s_; const size_t row_ = (size_t)(row0 + (it_ >> 2) * HALF + (it_ & 3) * 16); \
        G1[s_] = *(const u32x4*)(gates + row_ * 2048 + D + gofs); if (!step) G0[s_] = *(const u32x4*)(gates + row_ * 2048 + gofs); else G0[s_] = (u32x4){0u, 0u, 0u, 0u}; } } while (0)
        EG_LOAD(g0c, g1c, 0);
#pragma unroll
        for (int b = 0; b < NBAT; ++b) {
            if (b + 1 < NBAT) EG_LOAD(g0n, g1n, b + 1);
#pragma unroll
            for (int s = 0; s < NB; ++s) { const int it = b * NB + s, ai = it >> 2, m = it & 3; const size_t row = (size_t)(row0 + ai * HALF + m * 16);
#pragma unroll
                for (int bj = 0; bj < 2; ++bj) {
                    f32x4 q1a = dq8x4(g1c[s][2 * bj]), q1b = dq8x4(g1c[s][2 * bj + 1]);
#pragma unroll
                    for (int i = 0; i < 4; ++i) { q1a[i] = fmaxf(q1a[i], 1.f); q1b[i] = fmaxf(q1b[i], 1.f); }
                    if (!step) { const f32x4 q0a = dq8x4(g0c[s][2 * bj]), q0b = dq8x4(g0c[s][2 * bj + 1]); f32x4 ra, rb;
#pragma unroll
                        for (int i = 0; i < 4; ++i) { ra[i] = q0a[i] * __builtin_amdgcn_rcpf(q1a[i]); rb[i] = q0b[i] * __builtin_amdgcn_rcpf(q1b[i]); }
                        acc[ai][bj][m][0] = acc[ai][bj][m][0] * ra; acc[ai][bj][m][1] = acc[ai][bj][m][1] * rb; }
                    else *(u32x4*)(merged + row * D + col0 + bj * HALF) = pack8(acc[ai][bj][m][0] * q1a, acc[ai][bj][m][1] * q1b); } }
#pragma unroll
            for (int s = 0; s < NB; ++s) { g0c[s] = g0n[s]; g1c[s] = g1n[s]; } }
#undef EG_LOAD
        return !step;
    }
};
struct EpiH1 {
    static constexpr bool PERM = true, AFTER_DRAIN = false;
    const bf16_t* __restrict__ xn0; const float* __restrict__ xsq; bf16_t* __restrict__ H1; unsigned char* __restrict__ H1B8;
    __device__ __forceinline__ void operator()(const f32x4 (&acc)[2][2][4][2], const Unit& u, int wr, int wc, int fr, int fq) const {
        const int row0 = u.pm * BM + wr * 64 + fr, col0 = u.pn * BM + wc * 32 + 8 * fq;
        u32x4 xc[2], xn[2]; float sc, sn;
#define EH_LOAD(X, S_, it_) do { const size_t r_ = (size_t)(row0 + ((it_) >> 2) * HALF + ((it_) & 3) * 16); const bf16_t* src_ = xn0 + r_ * D + col0; S_ = xsq[r_]; _Pragma("unroll") for (int bj = 0; bj < 2; ++bj) X[bj] = *(const u32x4*)(src_ + bj * HALF); } while (0)
        EH_LOAD(xc, sc, 0);
#pragma unroll
        for (int it = 0; it < 8; ++it) { const int ai = it >> 2, m = it & 3; const size_t V = (size_t)(row0 + ai * HALF + m * 16);
            if (it + 1 < 8) EH_LOAD(xn, sn, it + 1);
#pragma unroll
            for (int bj = 0; bj < 2; ++bj) { const int c = col0 + bj * HALF; f32x4 x0, x1; unpack8(xc[bj], x0, x1);
                const f32x4 v0 = x0 * sc + acc[ai][bj][m][0], v1 = x1 * sc + acc[ai][bj][m][1];
                __builtin_nontemporal_store(pack8(v0, v1), (u32x4*)(H1 + V * D + c)); *(v2u_t*)(H1B8 + V * D + c) = pack8_fp8_sat(v0, v1); }
#pragma unroll
            for (int bj = 0; bj < 2; ++bj) xc[bj] = xn[bj];
            sc = sn; }
#undef EH_LOAD
    }
};
template <bool NS = false>
struct EpiGUT {
    static constexpr bool PERM = true, AFTER_DRAIN = false;
    const float* __restrict__ bgup; const float* __restrict__ ers; unsigned char* __restrict__ act; const PG8_LAS int* pst;
    __device__ __forceinline__ void operator()(const f32x4 (&acc)[2][2][4][2], const Unit& u, int wr, int wc, int fr, int fq) const {
        const int e = u.pn >> 3, pn = u.pn & 7, row0 = u.pm * BM + wr * 64 + fr, cc = wc * 32 + 8 * fq;
        const float* rsp = ers + (size_t)e * NV + (row0 - pst[e]);
        const float* bp = bgup + (size_t)e * 2 * DFF + pn * BM + cc;
        f32x2 bg[2][2], bu[2][2];
#pragma unroll
        for (int h = 0; h < 2; ++h) { const f32x4 g4 = *(const f32x4*)(bp + 4 * h), u4 = *(const f32x4*)(bp + HALF + 4 * h);
            bg[h][0] = (f32x2){g4[0], g4[1]}; bg[h][1] = (f32x2){g4[2], g4[3]}; bu[h][0] = (f32x2){u4[0] + 1.f, u4[1] + 1.f}; bu[h][1] = (f32x2){u4[2] + 1.f, u4[3] + 1.f}; }
        float rsv[8];
#pragma unroll
        for (int it = 0; it < 8; ++it) rsv[it] = rsp[(it >> 2) * HALF + (it & 3) * 16];
        const int hi = fq >> 1;
        unsigned char* obase = act + (size_t)(row0 + 16 * hi) * DFF + pn * HALF + wc * 32 + 16 * (fq & 1);
        constexpr float KS = -1.702f * 1.4426950408889634f;
#pragma unroll
        for (int ai = 0; ai < 2; ++ai)
#pragma unroll
            for (int mp = 0; mp < 2; ++mp) { v2u_t pk[2];
#pragma unroll
                for (int q = 0; q < 2; ++q) { const int m = 2 * mp + q; const float rs = rsv[ai * 4 + m] * 0.03125f;
                    const f32x2 rs2 = {rs, rs}; unsigned w[2];
#pragma unroll
                    for (int h = 0; h < 2; ++h) { f32x2 o[2];
#pragma unroll
                        for (int p = 0; p < 2; ++p) {
                            f32x2 g = (f32x2){acc[ai][0][m][h][2 * p], acc[ai][0][m][h][2 * p + 1]} * rs2 + bg[h][p];
                            f32x2 u1 = (f32x2){acc[ai][1][m][h][2 * p], acc[ai][1][m][h][2 * p + 1]} * rs2 + bu[h][p];
                            g.x = fminf(g.x, 7.f); g.y = fminf(g.y, 7.f); u1.x = __builtin_amdgcn_fmed3f(u1.x, -6.f, 8.f); u1.y = __builtin_amdgcn_fmed3f(u1.y, -6.f, 8.f);
                            const f32x2 t = g * (f32x2){KS, KS};
                            const f32x2 d = (f32x2){__builtin_amdgcn_exp2f(t.x), __builtin_amdgcn_exp2f(t.y)} + (f32x2){1.f, 1.f};
                            const f32x2 r = {__builtin_amdgcn_rcpf(d.x), __builtin_amdgcn_rcpf(d.y)};
                            o[p] = (g * r) * u1; }
                        w[h] = __builtin_amdgcn_cvt_pk_fp8_f32(o[0].x, o[0].y, 0u, false); w[h] = __builtin_amdgcn_cvt_pk_fp8_f32(o[1].x, o[1].y, w[h], true); }
                    pk[q] = (v2u_t){w[0], w[1]}; }
                const auto r0 = __builtin_amdgcn_permlane32_swap(pk[0][0], pk[1][0], false, false), r1 = __builtin_amdgcn_permlane32_swap(pk[0][1], pk[1][1], false, false);
                if constexpr (NS) asm volatile("" :: "v"(r0[0]), "v"(r1[0]), "v"(r0[1]), "v"(r1[1])); else *(u32x4*)(obase + (size_t)(ai * HALF + mp * 32) * DFF) = (u32x4){r0[0], r1[0], r0[1], r1[1]}; }
    }
};
template <bool NS = false>
struct EpiDownT {
    static constexpr bool PERM = true, AFTER_DRAIN = false;
    const float* __restrict__ bdn; const float* __restrict__ ew; unsigned char* __restrict__ yb; const PG8_LAS int* pst;
    __device__ __forceinline__ void operator()(const f32x4 (&acc)[2][2][4][2], const Unit& u, int wr, int wc, int fr, int fq) const {
        const int e = u.pn >> 2, pn = u.pn & 3, row0 = u.pm * BM + wr * 64 + fr, col0 = pn * BM + wc * 64 + 16 * fq;
        const float* wp = ew + (size_t)e * NV + (row0 - pst[e]);
        f32x4 bv[2][2];
#pragma unroll
        for (int bj = 0; bj < 2; ++bj) { bv[bj][0] = *(const f32x4*)(bdn + (size_t)e * D + col0 + 8 * bj); bv[bj][1] = *(const f32x4*)(bdn + (size_t)e * D + col0 + 8 * bj + 4); }
        float wv[8];
#pragma unroll
        for (int it = 0; it < 8; ++it) wv[it] = wp[(it >> 2) * HALF + (it & 3) * 16];
#pragma unroll
        for (int ai = 0; ai < 2; ++ai)
#pragma unroll
            for (int m = 0; m < 4; ++m) { const size_t row = (size_t)(row0 + ai * HALF + m * 16); const float w = wv[ai * 4 + m] * 16.f;
                const v2u_t lo = pack8_fp8_sat((acc[ai][0][m][0] * 0.03125f + bv[0][0]) * w, (acc[ai][0][m][1] * 0.03125f + bv[0][1]) * w), hi = pack8_fp8_sat((acc[ai][1][m][0] * 0.03125f + bv[1][0]) * w, (acc[ai][1][m][1] * 0.03125f + bv[1][1]) * w);
                if constexpr (NS) asm volatile("" :: "v"(lo[0]), "v"(lo[1]), "v"(hi[0]), "v"(hi[1])); else __builtin_nontemporal_store((u32x4){lo[0], lo[1], hi[0], hi[1]}, (u32x4*)(yb + row * D + col0)); }
    }
};
struct GroupOrder {
    int ntiles, ncol, G, c; const PG8_LAS unsigned char* texp;
    __device__ __forceinline__ bool next(int i, Unit& u) const { const int x = c & 7, w = c >> 3, uu = i * (G >> 3) + w, lj = uu / ncol, pn = uu - lj * ncol, j = lj * 8 + x; if (j >= ntiles) return false; u.pm = j; u.pn = (int)texp[j] * ncol + pn; return true; }
    __device__ __forceinline__ void a_ready(const Unit&) const {}
    __device__ __forceinline__ void done(const Unit&) const {}
};
typedef EpiDownT<false> EpiDown; typedef EpiGUT<false> EpiGU;
}

typedef short bf16x8 __attribute__((ext_vector_type(8)));
typedef float f32x16 __attribute__((ext_vector_type(16)));
#define MFMA32(a, b, c) __builtin_amdgcn_mfma_f32_32x32x16_bf16(a, b, c, 0, 0, 0)
__device__ __forceinline__ bf16x8 ldfrag(const LAS unsigned char* base, int st, int row0, int k0, int lane) { return *(const LAS bf16x8*)(base + (row0 + (lane & 31)) * st + (k0 + 8 * (lane >> 5)) * 2); }
__device__ __forceinline__ bf16x8 ldf(const LAS unsigned char* lanebase, int off) { return *(const LAS bf16x8*)(lanebase + off); }
__device__ __forceinline__ float fexp(float x) { return __builtin_amdgcn_exp2f(x * 1.4426950408889634f); }

__device__ __forceinline__ void p3_hgrn2_mfma(Frame& F, int bh) {
    unsigned char* ws = F.ws; const int b = bh >> 2, h = bh & 3, tid = F.tid, lane = F.lane, wave = F.wave, hh = lane >> 5, l31 = lane & 31;
    const bf16* HQ = (const bf16*)(ws + WS_HQ) + h * 128; const bf16* HG = (const bf16*)(ws + WS_HG) + h * 128; const bf16* HV = (const bf16*)(ws + WS_HV) + h * 128;
    const bf16* HGATE = (const bf16*)(ws + WS_HGATE) + h * 128; bf16* YHG = (bf16*)(ws + WS_YHG) + h * 128;
    LAS unsigned char* L = F.lds + RING_OFF;
    LAS unsigned char* QT = L; LAS unsigned char* KT = L + 17408; LAS unsigned char* KTT = L + 34816; LAS unsigned char* VT = L + 53248; LAS unsigned char* ST = L + 71680; LAS unsigned char* PP = L + 106496;
    LAS float* SEG = (LAS float*)(L + 115712); LAS float* ER = (LAS float*)(L + 117760); LAS float* EL = (LAS float*)(L + 118272); LAS float* OST = (LAS float*)(L + 17408);
    const int d = tid & 127, pq = tid >> 7;
    const int et = tid >> 3, evq = tid & 7;
    const int f144 = l31 * 144 + hh * 16, f272 = l31 * 272 + hh * 16;
    const int sst = wave == 2 ? 1 : 0, stt = wave == 0 ? 0 : 1, dt = wave & 3, vt0 = 2 * (wave >> 2), btt = wave & 1, bvt = wave >> 1;
    const LAS unsigned char* aK = KT + 32 * sst * 272 + f272; const LAS unsigned char* bQ = QT + 32 * stt * 272 + f272;
    LAS unsigned char* pst = PP + (32 * stt + l31) * 144 + (32 * sst + 4 * hh) * 2;
    const LAS unsigned char* aKTT = KTT + 32 * dt * 144 + f144; const LAS unsigned char* bV0 = VT + 32 * vt0 * 144 + f144;
    LAS unsigned char* sst_ = ST + (32 * vt0 + l31) * 272 + (32 * dt + 4 * hh) * 2;
    const LAS float* erp = ER + 32 * dt + 4 * hh; const LAS float* elp = EL + 32 * dt + 4 * hh;
    const LAS unsigned char* aP = PP + 32 * btt * 144 + f144; const LAS unsigned char* bVB = VT + 32 * bvt * 144 + f144;
    const LAS unsigned char* aQ = QT + 32 * btt * 272 + f272; const LAS unsigned char* bS = ST + 32 * bvt * 272 + f272;
    LAS float* ost = OST + (32 * btt + 4 * hh) * 132 + 32 * bvt + l31; const LAS float* oep = OST + et * 132 + 16 * evq;
    LAS unsigned char* tq = QT + 16 * pq * 272 + d * 2; LAS unsigned char* tk = KT + 16 * pq * 272 + d * 2; LAS unsigned char* tkt = KTT + d * 144 + pq * 32; LAS unsigned char* tv = VT + d * 144 + pq * 32;
    f32x16 S0, S1;
#pragma unroll
    for (int i = 0; i < 16; ++i) { S0[i] = 0.f; S1[i] = 0.f; }
    unsigned gr[16], qr[16], vr[16]; v4u gt0, gt1;
    float gn[16];
#pragma unroll
    for (int i = 0; i < 16; ++i) gn[i] = F.in[IN_HGNORM][h * 128 + 16 * evq + i];
#define HG_LOAD(c) do { const int ttb = 64 * (c) - 48 + 16 * pq; \
        _Pragma("unroll") for (int i = 0; i < 16; ++i) { const int tt = ttb + i; if (tt >= 0) { const size_t gi = rowof(b, tt) * HW + d; gr[i] = (unsigned)HG[gi]; qr[i] = (unsigned)HQ[gi]; vr[i] = (unsigned)HV[gi]; } else { gr[i] = 0u; qr[i] = 0u; vr[i] = 0u; } } \
        { const int tt = 64 * (c) - 48 + et; if (tt >= 0) { const GAS v4u* gp = (const GAS v4u*)(HGATE + rowof(b, tt) * HW + 16 * evq); gt0 = gp[0]; gt1 = gp[1]; } else { gt0 = (v4u){0u, 0u, 0u, 0u}; gt1 = gt0; } } } while (0)
    HG_LOAD(0);
    for (int c = 0; c < 33; ++c) {
        float bl[16], gq[16];
#pragma unroll
        for (int i = 0; i < 16; ++i) gq[i] = __builtin_bit_cast(float, gr[i] << 16);
        { float a = 0.f;
#pragma unroll
          for (int i = 0; i < 16; ++i) { a += gq[i]; bl[i] = a; } }
        SEG[pq * 128 + d] = bl[15];
        __syncthreads();
        { const float s0 = SEG[d], s1 = SEG[128 + d], s2 = SEG[256 + d], s3 = SEG[384 + d];
          const float off = pq == 0 ? 0.f : pq == 1 ? s0 : pq == 2 ? s0 + s1 : (s0 + s1) + s2, r = s0 + s1, blast = (s0 + s1) + (s2 + s3);
          unsigned kp[8], vp[8];
#pragma unroll
          for (int i = 0; i < 16; i += 2) {
              const float b0 = off + bl[i], b1 = off + bl[i + 1];
              const float q0 = __builtin_bit_cast(float, qr[i] << 16) * fexp(b0 - r), q1 = __builtin_bit_cast(float, qr[i + 1] << 16) * fexp(b1 - r);
              const float k0 = (1.f - fexp(gq[i])) * fexp(r - b0), k1 = (1.f - fexp(gq[i + 1])) * fexp(r - b1);
              const unsigned kk = pg8::cvt_pk_bf16(k0, k1), qq = pg8::cvt_pk_bf16(q0, q1);
              *(LAS unsigned short*)(tq + i * 272) = (unsigned short)qq; *(LAS unsigned short*)(tq + (i + 1) * 272) = (unsigned short)(qq >> 16);
              *(LAS unsigned short*)(tk + i * 272) = (unsigned short)kk; *(LAS unsigned short*)(tk + (i + 1) * 272) = (unsigned short)(kk >> 16);
              kp[i >> 1] = kk; vp[i >> 1] = vr[i] | (vr[i + 1] << 16); }
          *(LAS v4u*)(tkt) = (v4u){kp[0], kp[1], kp[2], kp[3]}; *(LAS v4u*)(tkt + 16) = (v4u){kp[4], kp[5], kp[6], kp[7]};
          *(LAS v4u*)(tv) = (v4u){vp[0], vp[1], vp[2], vp[3]}; *(LAS v4u*)(tv + 16) = (v4u){vp[4], vp[5], vp[6], vp[7]};
          if (pq == 0) { ER[d] = fexp(r); EL[d] = fexp(blast - r); } }
        const v4u g0 = gt0, g1 = gt1;
        __syncthreads();
        if (c + 1 < 33) HG_LOAD(c + 1);
        asm volatile("" ::: "memory");
        if (wave < 3) {
            f32x16 acc;
#pragma unroll
            for (int i = 0; i < 16; ++i) acc[i] = 0.f;
#pragma unroll
            for (int ks = 0; ks < 8; ++ks) acc = MFMA32(ldf(aK, 32 * ks), ldf(bQ, 32 * ks), acc);
            const int t = 32 * stt + l31;
#pragma unroll
            for (int g4 = 0; g4 < 4; ++g4) { const int s0 = 32 * sst + 8 * g4 + 4 * hh;
                const float x0 = (s0 + 0 <= t) ? acc[4 * g4 + 0] : 0.f, x1 = (s0 + 1 <= t) ? acc[4 * g4 + 1] : 0.f, x2 = (s0 + 2 <= t) ? acc[4 * g4 + 2] : 0.f, x3 = (s0 + 3 <= t) ? acc[4 * g4 + 3] : 0.f;
                *(LAS v2u*)(pst + 16 * g4) = (v2u){pg8::cvt_pk_bf16(x0, x1), pg8::cvt_pk_bf16(x2, x3)}; }
        }
        {
#pragma unroll
          for (int g4 = 0; g4 < 4; ++g4) { const f32x4 er = *(const LAS f32x4*)(erp + 8 * g4);
#pragma unroll
              for (int i = 0; i < 4; ++i) { S0[4 * g4 + i] *= er[i]; S1[4 * g4 + i] *= er[i]; }
              *(LAS v2u*)(sst_ + 16 * g4) = (v2u){pg8::cvt_pk_bf16(S0[4 * g4], S0[4 * g4 + 1]), pg8::cvt_pk_bf16(S0[4 * g4 + 2], S0[4 * g4 + 3])};
              *(LAS v2u*)(sst_ + 32 * 272 + 16 * g4) = (v2u){pg8::cvt_pk_bf16(S1[4 * g4], S1[4 * g4 + 1]), pg8::cvt_pk_bf16(S1[4 * g4 + 2], S1[4 * g4 + 3])}; }
#pragma unroll
          for (int ks = 0; ks < 4; ++ks) { const bf16x8 a = ldf(aKTT, 32 * ks); S0 = MFMA32(a, ldf(bV0, 32 * ks), S0); S1 = MFMA32(a, ldf(bV0, 32 * 144 + 32 * ks), S1); }
#pragma unroll
          for (int g4 = 0; g4 < 4; ++g4) { const f32x4 el = *(const LAS f32x4*)(elp + 8 * g4);
#pragma unroll
              for (int i = 0; i < 4; ++i) { S0[4 * g4 + i] *= el[i]; S1[4 * g4 + i] *= el[i]; } } }
        __syncthreads();
        { f32x16 acc;
#pragma unroll
          for (int i = 0; i < 16; ++i) acc[i] = 0.f;
#pragma unroll
          for (int ks = 0; ks < 4; ++ks) if (ks < 2 || btt == 1) acc = MFMA32(ldf(aP, 32 * ks), ldf(bVB, 32 * ks), acc);
#pragma unroll
          for (int ks = 0; ks < 8; ++ks) acc = MFMA32(ldf(aQ, 32 * ks), ldf(bS, 32 * ks), acc);
#pragma unroll
          for (int i = 0; i < 16; ++i) ost[((i & 3) + 8 * (i >> 2)) * 132] = acc[i]; }
        __syncthreads();
        { const int tt = 64 * c - 48 + et;
          f32x4 o[4]; float ss = 0.f;
#pragma unroll
          for (int j = 0; j < 4; ++j) { o[j] = *(const LAS f32x4*)(oep + 4 * j); ss += (o[j].x * o[j].x + o[j].y * o[j].y) + (o[j].z * o[j].z + o[j].w * o[j].w); }
          ss += __shfl_xor(ss, 1); ss += __shfl_xor(ss, 2); ss += __shfl_xor(ss, 4);
          const float rs = 1.0f / sqrtf(ss * (1.f / 128.f) + EPS);
          if (tt >= NMETA || (tt >= 0 && b == 0)) { const unsigned gw[8] = {g0.x, g0.y, g0.z, g0.w, g1.x, g1.y, g1.z, g1.w}; unsigned w[8];
#pragma unroll
              for (int j = 0; j < 4; ++j) { w[2 * j] = pk2(o[j].x * rs * gn[4 * j] * bflo(gw[2 * j]), o[j].y * rs * gn[4 * j + 1] * bfhi(gw[2 * j])); w[2 * j + 1] = pk2(o[j].z * rs * gn[4 * j + 2] * bflo(gw[2 * j + 1]), o[j].w * rs * gn[4 * j + 3] * bfhi(gw[2 * j + 1])); }
              GAS v4u* yp = (GAS v4u*)(YHG + rowof(b, tt) * HW + 16 * evq); yp[0] = (v4u){w[0], w[1], w[2], w[3]}; yp[1] = (v4u){w[4], w[5], w[6], w[7]}; } }
        __syncthreads();
    }
#undef HG_LOAD
}


#define DPP_F(old, v, ctrl, rmask) __builtin_bit_cast(float, __builtin_amdgcn_update_dpp(__builtin_bit_cast(int, (float)(old)), __builtin_bit_cast(int, (float)(v)), (ctrl), (rmask), 0xf, false))
__device__ __forceinline__ float wave_scan_add(float v) {
    v += DPP_F(0.f, v, 0x111, 0xf); v += DPP_F(0.f, v, 0x112, 0xf); v += DPP_F(0.f, v, 0x114, 0xf); v += DPP_F(0.f, v, 0x118, 0xf);
    v += DPP_F(0.f, v, 0x142, 0xa); v += DPP_F(0.f, v, 0x143, 0xc); return v;
}
__device__ __forceinline__ float wave_scan_max(float v) {
    const float ni = -INFINITY;
    v = fmaxf(v, DPP_F(ni, v, 0x111, 0xf)); v = fmaxf(v, DPP_F(ni, v, 0x112, 0xf)); v = fmaxf(v, DPP_F(ni, v, 0x114, 0xf)); v = fmaxf(v, DPP_F(ni, v, 0x118, 0xf));
    v = fmaxf(v, DPP_F(ni, v, 0x142, 0xa)); v = fmaxf(v, DPP_F(ni, v, 0x143, 0xc)); return v;
}
__device__ __forceinline__ void p3_mlstm_mfma(Frame& F, int bh) {
    unsigned char* ws = F.ws; const int b = bh >> 2, h = bh & 3, tid = F.tid, lane = F.lane, wave = F.wave, hh = lane >> 5, l31 = lane & 31;
    const bf16* MMg = (const bf16*)(ws + WS_MM) + h * 128; const bf16* MOg = (const bf16*)(ws + WS_MO) + h * 128; const float* LI = (const float*)(ws + WS_LI) + h; const float* LF = (const float*)(ws + WS_LF) + h;
    bf16* YML = (bf16*)(ws + WS_YML) + h * 128;
    LAS unsigned char* L = F.lds + RING_OFF;
    LAS unsigned char* CT = L; LAS unsigned char* MT = L + 17408; LAS unsigned char* KM = L + 34816; LAS unsigned char* KW = L + 44032; LAS unsigned char* QM = L + 53248; LAS unsigned char* QW = L + 62464;
    LAS unsigned char* VT = L + 71680; LAS unsigned char* SV = L + 90112; LAS unsigned char* PP = L + 108544; LAS float* OST = (LAS float*)(L + 17408);
    LAS float* SM = (LAS float*)(L + 117760);
    LAS float* U = SM; LAS float* MX = SM + 64; LAS float* BB = SM + 128; LAS float* WSs = SM + 192; LAS float* WI = SM + 256; LAS float* DENP = SM + 320  ; LAS float* NN = SM + 416; LAS float* DENI = SM + 480; LAS float* SC = SM + 544  ; LAS float* GNS = SM + 560  ;
    const int ch = tid & 127, pq = tid >> 7, et = tid >> 3, evq = tid & 7;
    const int f144 = l31 * 144 + hh * 16, f272 = l31 * 272 + hh * 16;
    const int sst = wave == 2 ? 1 : 0, stt = wave == 0 ? 0 : 1, dkt = wave & 1, svt = wave >> 1;
    const LAS unsigned char* cfp = (wave < 4 ? CT : MT) + f272;
    LAS unsigned char* qst = QM + l31 * 144 + (32 * (wave & 1) + 4 * hh) * 2; LAS unsigned char* qwst = QW + l31 * 144 + (32 * (wave & 1) + 4 * hh) * 2;
    const int kdk = 32 * (wave & 1) + l31;
    LAS unsigned char* kmst = KM + 4 * hh * 144 + kdk * 2; LAS unsigned char* kwst = KW + kdk * 144 + 4 * hh * 2; const LAS float* wsp = WSs + 4 * hh;
    LAS unsigned char* vst = VT + (32 * (wave & 3) + l31) * 144 + 4 * hh * 2;
    const LAS unsigned char* aKM = KM + 32 * sst * 144 + f144; const LAS unsigned char* bQM = QM + 32 * stt * 144 + f144;
    LAS unsigned char* pst = PP + (32 * stt + l31) * 144 + (32 * sst + 4 * hh) * 2; const LAS float* up = U + 32 * sst + 4 * hh;
    LAS unsigned char* svst = SV + (32 * svt + l31) * 144 + (32 * dkt + 4 * hh) * 2;
    const LAS unsigned char* aKW = KW + 32 * dkt * 144 + f144; const LAS unsigned char* bVT = VT + 32 * svt * 144 + f144;
    const LAS unsigned char* aP = PP + 32 * dkt * 144 + f144; const LAS unsigned char* aQW = QW + 32 * dkt * 144 + f144; const LAS unsigned char* bSV = SV + 32 * svt * 144 + f144;
    LAS float* ost = OST + (32 * dkt + 4 * hh) * 132 + 32 * svt + l31; const LAS float* oep = OST + et * 132 + 16 * evq;
    LAS unsigned char* tc = CT + 16 * pq * 272 + ch * 2; LAS unsigned char* tm = MT + 16 * pq * 272 + ch * 2;
    bf16x8 wf[8];
    { const float* W = wave < 2 ? F.in[IN_WQ] + (size_t)h * 128 * 64 + 32 * wave + l31 : wave < 4 ? F.in[IN_WK] + (size_t)h * 128 * 64 + 32 * (wave - 2) + l31 : F.in[IN_WV] + (size_t)h * 128 * 128 + 32 * (wave - 4) + l31;
      const int ld = wave < 4 ? 64 : 128; const float sc = wave < 2 ? 0.125f : 1.f;
#pragma unroll
      for (int ks = 0; ks < 8; ++ks) { unsigned p[4];
#pragma unroll
          for (int j = 0; j < 4; ++j) p[j] = pk2(W[(size_t)(16 * ks + 8 * hh + 2 * j) * ld] * sc, W[(size_t)(16 * ks + 8 * hh + 2 * j + 1) * ld] * sc);
          wf[ks] = __builtin_bit_cast(bf16x8, (v4u){p[0], p[1], p[2], p[3]}); } }
    float cw[4]; const float cb = F.in[IN_CONVB][h * 128 + ch];
#pragma unroll
    for (int j = 0; j < 4; ++j) cw[j] = F.in[IN_CONVW][j * HW + h * 128 + ch];
    if (tid < 128) GNS[tid] = F.in[IN_MLNORM][h * 128 + tid]; else if (tid < 256) GNS[tid] = F.in[IN_MLSKIP][h * 128 + tid - 128];
    f32x16 S;
#pragma unroll
    for (int i = 0; i < 16; ++i) S[i] = 0.f;
    float mcar = 0.f, nreg = 0.f;
    unsigned mr[19]; v4u gt0, gt1; float pli = 0.f, plf = 0.f;
#define ML_LOAD(c) do { const int ttb = 64 * (c) - 48 + 16 * pq - 3; \
        _Pragma("unroll") for (int i = 0; i < 19; ++i) { const int tt = ttb + i; mr[i] = tt >= 0 ? (unsigned)MMg[rowof(b, tt) * HW + ch] : 0u; } \
        { const int tt = 64 * (c) - 48 + et; if (tt >= 0) { const GAS v4u* gp = (const GAS v4u*)(MOg + rowof(b, tt) * HW + 16 * evq); gt0 = gp[0]; gt1 = gp[1]; } else { gt0 = (v4u){0u, 0u, 0u, 0u}; gt1 = gt0; } } \
        if (wave == 0) { const int tt = 64 * (c) - 48 + lane; if (tt >= 0) { pli = LI[rowof(b, tt) * 4]; plf = LF[rowof(b, tt) * 4]; } else { pli = -1e30f; plf = 0.f; } } } while (0)
    ML_LOAD(0);
    for (int c = 0; c < 33; ++c) {
#pragma unroll
        for (int i = 0; i < 16; ++i) { const float a = cb + (cw[0] * __builtin_bit_cast(float, mr[i] << 16) + cw[1] * __builtin_bit_cast(float, mr[i + 1] << 16)) + (cw[2] * __builtin_bit_cast(float, mr[i + 2] << 16) + cw[3] * __builtin_bit_cast(float, mr[i + 3] << 16));
            *(LAS unsigned short*)(tc + i * 272) = (unsigned short)f2bf(fsilu(a)); *(LAS unsigned short*)(tm + i * 272) = (unsigned short)mr[i + 3]; }
        if (wave == 0) {
            const float bs = wave_scan_add(plf);
            const float u = pli - bs; const float pm = wave_scan_max(u);
            const float M = fmaxf(mcar, pm), M63 = __shfl(M, 63), b63 = __shfl(bs, 63);
            U[lane] = u; MX[lane] = M; BB[lane] = bs; WSs[lane] = fexp(u - M63); WI[lane] = fexp(mcar - M);
            if (lane == 0) { SC[0] = b63; SC[1] = M63; }
        }
        __syncthreads();
        { f32x16 a0, a1;
#pragma unroll
          for (int i = 0; i < 16; ++i) { a0[i] = 0.f; a1[i] = 0.f; }
          if (wave < 2) {
#pragma unroll
              for (int ks = 0; ks < 8; ++ks) { a0 = MFMA32(wf[ks], ldf(cfp, 32 * ks), a0); a1 = MFMA32(wf[ks], ldf(cfp, 32 * 272 + 32 * ks), a1); }
              const float wi0 = WI[l31], wi1 = WI[32 + l31];
#pragma unroll
              for (int g4 = 0; g4 < 4; ++g4) {
                  *(LAS v2u*)(qst + 16 * g4) = (v2u){pg8::cvt_pk_bf16(a0[4 * g4], a0[4 * g4 + 1]), pg8::cvt_pk_bf16(a0[4 * g4 + 2], a0[4 * g4 + 3])};
                  *(LAS v2u*)(qst + 32 * 144 + 16 * g4) = (v2u){pg8::cvt_pk_bf16(a1[4 * g4], a1[4 * g4 + 1]), pg8::cvt_pk_bf16(a1[4 * g4 + 2], a1[4 * g4 + 3])};
                  *(LAS v2u*)(qwst + 16 * g4) = (v2u){pg8::cvt_pk_bf16(a0[4 * g4] * wi0, a0[4 * g4 + 1] * wi0), pg8::cvt_pk_bf16(a0[4 * g4 + 2] * wi0, a0[4 * g4 + 3] * wi0)};
                  *(LAS v2u*)(qwst + 32 * 144 + 16 * g4) = (v2u){pg8::cvt_pk_bf16(a1[4 * g4] * wi1, a1[4 * g4 + 1] * wi1), pg8::cvt_pk_bf16(a1[4 * g4 + 2] * wi1, a1[4 * g4 + 3] * wi1)}; }
          } else {
#pragma unroll
              for (int ks = 0; ks < 8; ++ks) { a0 = MFMA32(ldf(cfp, 32 * ks), wf[ks], a0); a1 = MFMA32(ldf(cfp, 32 * 272 + 32 * ks), wf[ks], a1); }
              if (wave < 4) {
                  float nsum = 0.f;
#pragma unroll
                  for (int g4 = 0; g4 < 4; ++g4) { const f32x4 w0 = *(const LAS f32x4*)(wsp + 8 * g4), w1 = *(const LAS f32x4*)(wsp + 32 + 8 * g4);
#pragma unroll
                      for (int i = 0; i < 4; ++i) { *(LAS unsigned short*)(kmst + (8 * g4 + i) * 144) = (unsigned short)f2bf(a0[4 * g4 + i]); *(LAS unsigned short*)(kmst + (32 + 8 * g4 + i) * 144) = (unsigned short)f2bf(a1[4 * g4 + i]); }
                      const float x0 = a0[4 * g4] * w0[0], x1 = a0[4 * g4 + 1] * w0[1], x2 = a0[4 * g4 + 2] * w0[2], x3 = a0[4 * g4 + 3] * w0[3];
                      const float y0 = a1[4 * g4] * w1[0], y1 = a1[4 * g4 + 1] * w1[1], y2 = a1[4 * g4 + 2] * w1[2], y3 = a1[4 * g4 + 3] * w1[3];
                      nsum += ((x0 + x1) + (x2 + x3)) + ((y0 + y1) + (y2 + y3));
                      *(LAS v2u*)(kwst + 16 * g4) = (v2u){pg8::cvt_pk_bf16(x0, x1), pg8::cvt_pk_bf16(x2, x3)};
                      *(LAS v2u*)(kwst + 64 + 16 * g4) = (v2u){pg8::cvt_pk_bf16(y0, y1), pg8::cvt_pk_bf16(y2, y3)}; }
                  nsum += __shfl_xor(nsum, 32);
                  if (hh == 0) NN[kdk] = nreg;
                  nreg = fexp(mcar - SC[1]) * nreg + nsum;
              } else {
#pragma unroll
                  for (int g4 = 0; g4 < 4; ++g4) {
                      *(LAS v2u*)(vst + 16 * g4) = (v2u){pg8::cvt_pk_bf16(a0[4 * g4], a0[4 * g4 + 1]), pg8::cvt_pk_bf16(a0[4 * g4 + 2], a0[4 * g4 + 3])};
                      *(LAS v2u*)(vst + 64 + 16 * g4) = (v2u){pg8::cvt_pk_bf16(a1[4 * g4], a1[4 * g4 + 1]), pg8::cvt_pk_bf16(a1[4 * g4 + 2], a1[4 * g4 + 3])}; }
              }
          } }
        __syncthreads();
        const v4u g0 = gt0, g1 = gt1;
        if (c + 1 < 33) ML_LOAD(c + 1);
        asm volatile("" ::: "memory");
        if (wave < 3) {
            f32x16 acc;
#pragma unroll
            for (int i = 0; i < 16; ++i) acc[i] = 0.f;
#pragma unroll
            for (int ks = 0; ks < 4; ++ks) acc = MFMA32(ldf(aKM, 32 * ks), ldf(bQM, 32 * ks), acc);
            const int t = 32 * stt + l31; const float mt = MX[t]; float dsum = 0.f;
#pragma unroll
            for (int g4 = 0; g4 < 4; ++g4) { const int s0 = 32 * sst + 8 * g4 + 4 * hh; const f32x4 us = *(const LAS f32x4*)(up + 8 * g4);
                const float x0 = (s0 + 0 <= t) ? acc[4 * g4 + 0] * fexp(us[0] - mt) : 0.f, x1 = (s0 + 1 <= t) ? acc[4 * g4 + 1] * fexp(us[1] - mt) : 0.f;
                const float x2 = (s0 + 2 <= t) ? acc[4 * g4 + 2] * fexp(us[2] - mt) : 0.f, x3 = (s0 + 3 <= t) ? acc[4 * g4 + 3] * fexp(us[3] - mt) : 0.f;
                dsum += (x0 + x1) + (x2 + x3);
                *(LAS v2u*)(pst + 16 * g4) = (v2u){pg8::cvt_pk_bf16(x0, x1), pg8::cvt_pk_bf16(x2, x3)}; }
            dsum += __shfl_xor(dsum, 32);
            if (hh == 0) DENP[wave * 32 + l31] = dsum;
        } else if (wave == 3) {
            float a = 0.f;
#pragma unroll 2
            for (int j = 0; j < 8; ++j) { const v4u q = *(const LAS v4u*)(QW + lane * 144 + 16 * j); const f32x4 n0 = *(const LAS f32x4*)(NN + 8 * j), n1 = *(const LAS f32x4*)(NN + 8 * j + 4);
                a += (bflo(q.x) * n0[0] + bfhi(q.x) * n0[1]) + (bflo(q.y) * n0[2] + bfhi(q.y) * n0[3]) + (bflo(q.z) * n1[0] + bfhi(q.z) * n1[1]) + (bflo(q.w) * n1[2] + bfhi(q.w) * n1[3]); }
            DENI[lane] = a;
        }
        { const float wp = fexp(mcar - SC[1]);
#pragma unroll
          for (int g4 = 0; g4 < 4; ++g4) {
              *(LAS v2u*)(svst + 16 * g4) = (v2u){pg8::cvt_pk_bf16(S[4 * g4], S[4 * g4 + 1]), pg8::cvt_pk_bf16(S[4 * g4 + 2], S[4 * g4 + 3])};
#pragma unroll
              for (int i = 0; i < 4; ++i) S[4 * g4 + i] *= wp; }
#pragma unroll
          for (int ks = 0; ks < 4; ++ks) S = MFMA32(ldf(aKW, 32 * ks), ldf(bVT, 32 * ks), S); }
        __syncthreads();
        { f32x16 acc;
#pragma unroll
          for (int i = 0; i < 16; ++i) acc[i] = 0.f;
#pragma unroll
          for (int ks = 0; ks < 4; ++ks) if (ks < 2 || dkt == 1) acc = MFMA32(ldf(aP, 32 * ks), ldf(bVT, 32 * ks), acc);
#pragma unroll
          for (int ks = 0; ks < 4; ++ks) acc = MFMA32(ldf(aQW, 32 * ks), ldf(bSV, 32 * ks), acc);
#pragma unroll
          for (int i = 0; i < 16; ++i) ost[((i & 3) + 8 * (i >> 2)) * 132] = acc[i]; }
        __syncthreads();
        { const int tt = 64 * c - 48 + et;
          const float den = (et < 32 ? DENP[et] : DENP[et] + DENP[32 + et]) + DENI[et];
          const float inv = 1.0f / fmaxf(fabsf(den), fexp(-(BB[et] + MX[et])));
          f32x4 o[4]; float ss = 0.f;
#pragma unroll
          for (int j = 0; j < 4; ++j) { o[j] = *(const LAS f32x4*)(oep + 4 * j) * inv; ss += (o[j].x * o[j].x + o[j].y * o[j].y) + (o[j].z * o[j].z + o[j].w * o[j].w); }
          ss += __shfl_xor(ss, 1); ss += __shfl_xor(ss, 2); ss += __shfl_xor(ss, 4);
          const float rs = 1.0f / sqrtf(ss * (1.f / 128.f) + EPS);
          if (tt >= NMETA || (tt >= 0 && b == 0)) { const unsigned gw[8] = {g0.x, g0.y, g0.z, g0.w, g1.x, g1.y, g1.z, g1.w}; unsigned w[8];
              const v4u c0 = *(const LAS v4u*)(CT + et * 272 + 32 * evq), c1 = *(const LAS v4u*)(CT + et * 272 + 32 * evq + 16); const unsigned cwd[8] = {c0.x, c0.y, c0.z, c0.w, c1.x, c1.y, c1.z, c1.w};
#pragma unroll
              for (int j = 0; j < 4; ++j) { const f32x4 gn = *(const LAS f32x4*)(GNS + 16 * evq + 4 * j), sk = *(const LAS f32x4*)(GNS + 128 + 16 * evq + 4 * j);
                  w[2 * j] = pk2((o[j].x * rs * gn[0] + sk[0] * bflo(cwd[2 * j])) * bflo(gw[2 * j]), (o[j].y * rs * gn[1] + sk[1] * bfhi(cwd[2 * j])) * bfhi(gw[2 * j]));
                  w[2 * j + 1] = pk2((o[j].z * rs * gn[2] + sk[2] * bflo(cwd[2 * j + 1])) * bflo(gw[2 * j + 1]), (o[j].w * rs * gn[3] + sk[3] * bfhi(cwd[2 * j + 1])) * bfhi(gw[2 * j + 1])); }
              GAS v4u* yp = (GAS v4u*)(YML + rowof(b, tt) * HW + 16 * evq); yp[0] = (v4u){w[0], w[1], w[2], w[3]}; yp[1] = (v4u){w[4], w[5], w[6], w[7]}; }
          mcar = SC[0] + SC[1]; }
        __syncthreads();
    }
#undef ML_LOAD
}

typedef float f32x4v __attribute__((ext_vector_type(4)));
#define MFMA16F(a, b, c) __builtin_amdgcn_mfma_f32_16x16x4f32(a, b, c, 0, 0, 0)
constexpr int RW_LD = 516;
__device__ __forceinline__ void router_topk16(LAS float* LGw, int V, float rsv, int resrow, int lane, LAS int* hist, LAS int* res, int* TOPE, float* TOPW, float* RS) {
    if (lane < 16) {
        int se[4]; float sv[4];
#pragma unroll
        for (int k = 0; k < 4; ++k) { float best = -INFINITY; int bi = 0;
            for (int e = 0; e < 32; ++e) { const float v = LGw[lane * 33 + e]; if (v > best) { best = v; bi = e; } }
            se[k] = bi; sv[k] = best; LGw[lane * 33 + bi] = -INFINITY; }
        const float e1 = __expf(sv[1] - sv[0]), e2 = __expf(sv[2] - sv[0]), e3 = __expf(sv[3] - sv[0]), inv = 1.0f / (1.f + e1 + e2 + e3);
        const float w4[4] = {inv, e1 * inv, e2 * inv, e3 * inv};
#pragma unroll
        for (int k = 0; k < 4; ++k) { const int lp = __hip_atomic_fetch_add(hist + se[k], 1, __ATOMIC_RELAXED, __HIP_MEMORY_SCOPE_WORKGROUP);
            TOPE[(size_t)V * 4 + k] = se[k]; TOPW[(size_t)V * 4 + k] = w4[k]; res[(resrow + lane) * 4 + k] = lp; }
        RS[V] = rsv;
    }
}
__device__ __forceinline__ void p6_router(Frame& F) {
    unsigned char* ws = F.ws;
    const bf16* H1 = (const bf16*)(ws + WS_H1); const float* RWT = (const float*)(ws + WS_RWT);
    int* TOPE = (int*)(ws + WS_TOPE); int* TOPP = (int*)(ws + WS_TOPP); float* TOPW = (float*)(ws + WS_TOPW); float* RS = (float*)(ws + WS_RS);
    int* ETOK = (int*)(ws + WS_ETOK); float* ERS = (float*)(ws + WS_ERS); float* EW = (float*)(ws + WS_EW);
    LAS float* rw = (LAS float*)(F.lds + RING_OFF);
    LAS float* LG = (LAS float*)(F.lds + RING_OFF + 66048) + F.wave * 528;
    LAS int* hist = (LAS int*)(F.lds + RING_OFF + 66048 + 8 * 2112);
    LAS int* res = hist + 64;
    LAS float* XP = (LAS float*)(res + 144 * 4);
    LAS float* XQ = XP + 8 * 528;
    const int lane = F.lane, wave = F.wave, i16 = lane & 15, kk = lane >> 4;
    constexpr int RPW = NTOK / 256;
    const bool has_meta = (F.vcu == 0);
    const int Vbase = F.vcu * RPW, Vt = Vbase + 16 * wave;
    if (F.tid < 64) hist[F.tid] = 0;
    f32x4v acc0 = {0.f, 0.f, 0.f, 0.f}, acc1 = {0.f, 0.f, 0.f, 0.f}, acx0 = {0.f, 0.f, 0.f, 0.f}, acx1 = {0.f, 0.f, 0.f, 0.f}; float ssq = 0.f, xss = 0.f;
    const bf16* arow = H1 + (size_t)(Vt + i16) * D + 8 * kk;
    const bf16* xrow = H1 + (size_t)(NTOK + i16) * D + 8 * kk;
    v4u a0[4], a1[4];
#define RT_MMA(A, SB, C0, C1, SS) do { const LAS float* b0p = rw + i16 * RW_LD + 8 * kk + 128 * (SB); const LAS float* b1p = rw + (16 + i16) * RW_LD + 8 * kk + 128 * (SB); \
        _Pragma("unroll") for (int s = 0; s < 4; ++s) { const v4u aw = A[s]; \
            _Pragma("unroll") for (int h = 0; h < 2; ++h) { const unsigned w0 = h ? aw.z : aw.x, w1 = h ? aw.w : aw.y; const f32x4 a = {bflo(w0), bfhi(w0), bflo(w1), bfhi(w1)}; \
            const f32x4 b0 = *(const LAS f32x4*)(b0p + 32 * s + 4 * h), b1 = *(const LAS f32x4*)(b1p + 32 * s + 4 * h); \
            SS += (a.x * a.x + a.y * a.y) + (a.z * a.z + a.w * a.w); \
            C0 = MFMA16F(a.x, b0.x, C0); C1 = MFMA16F(a.x, b1.x, C1); C0 = MFMA16F(a.y, b0.y, C0); C1 = MFMA16F(a.y, b1.y, C1); \
            C0 = MFMA16F(a.z, b0.z, C0); C1 = MFMA16F(a.z, b1.z, C1); C0 = MFMA16F(a.w, b0.w, C0); C1 = MFMA16F(a.w, b1.w, C1); } } } while (0)
#pragma unroll
    for (int s = 0; s < 4; ++s) a0[s] = *(const GAS v4u*)(arow + 32 * s);
#pragma unroll 1
    for (int it = 0; it < 4; ++it) {
        const int half = it >> 1, sb0 = (2 * it) & 3;
        if ((it & 1) == 0) {
            __syncthreads();
            { f32x4 stg[8];
#pragma unroll
              for (int q = 0; q < 8; ++q) { const int u = F.tid + q * NTHREADS, e = u >> 7, c = u & 127; stg[q] = *(const GAS f32x4*)(RWT + (size_t)e * D + 512 * half + 4 * c); }
#pragma unroll
              for (int q = 0; q < 8; ++q) { const int u = F.tid + q * NTHREADS, e = u >> 7, c = u & 127; *(LAS f32x4*)(rw + e * RW_LD + 4 * c) = stg[q]; } }
            __syncthreads();
        }
#pragma unroll
        for (int s = 0; s < 4; ++s) a1[s] = *(const GAS v4u*)(arow + 128 * (2 * it + 1) + 32 * s);
        RT_MMA(a0, sb0, acc0, acc1, ssq);
        if (it < 3) {
#pragma unroll
            for (int s = 0; s < 4; ++s) a0[s] = *(const GAS v4u*)(arow + 128 * (2 * it + 2) + 32 * s);
        }
        RT_MMA(a1, sb0 + 1, acc0, acc1, ssq);
        if (has_meta && (wave >> 1) == it) {
            v4u ax[4];
#pragma unroll
            for (int s = 0; s < 4; ++s) ax[s] = *(const GAS v4u*)(xrow + 128 * wave + 32 * s);
            RT_MMA(ax, wave & 3, acx0, acx1, xss);
        }
    }
#undef RT_MMA
    if (has_meta) {
        xss += __shfl_xor(xss, 16); xss += __shfl_xor(xss, 32);
#pragma unroll
        for (int r = 0; r < 4; ++r) { XP[wave * 528 + (4 * kk + r) * 33 + i16] = acx0[r]; XP[wave * 528 + (4 * kk + r) * 33 + 16 + i16] = acx1[r]; }
        if (kk == 0) XQ[wave * 16 + i16] = xss;
    }
    ssq += __shfl_xor(ssq, 16); ssq += __shfl_xor(ssq, 32);
    const float rsrow = 1.0f / sqrtf(ssq * (1.f / D) + EPS);
    const float rb0 = F.in[IN_RB][i16], rb1 = F.in[IN_RB][16 + i16];
#pragma unroll
    for (int r = 0; r < 4; ++r) { const float rsr = __shfl(rsrow, 4 * kk + r); LG[(4 * kk + r) * 33 + i16] = acc0[r] * rsr + rb0; LG[(4 * kk + r) * 33 + 16 + i16] = acc1[r] * rsr + rb1; }
    LDS_WAIT(); asm volatile("" ::: "memory");
    router_topk16(LG, Vt + lane, rsrow, 16 * wave, lane, hist, res, TOPE, TOPW, RS);
    __syncthreads();
    if (has_meta && wave == 7) {
        float q = 0.f;
#pragma unroll
        for (int w = 0; w < 8; ++w) q += XQ[w * 16 + i16];
        const float rsm = 1.0f / sqrtf(q * (1.f / D) + EPS);
#pragma unroll
        for (int r = 0; r < 4; ++r) { float v0 = 0.f, v1 = 0.f;
#pragma unroll
            for (int w = 0; w < 8; ++w) { v0 += XP[w * 528 + (4 * kk + r) * 33 + i16]; v1 += XP[w * 528 + (4 * kk + r) * 33 + 16 + i16]; }
            const float rsr = __shfl(rsm, 4 * kk + r); LG[(4 * kk + r) * 33 + i16] = v0 * rsr + rb0; LG[(4 * kk + r) * 33 + 16 + i16] = v1 * rsr + rb1; }
        LDS_WAIT(); asm volatile("" ::: "memory");
        router_topk16(LG, NTOK + lane, rsm, 128, lane, hist, res, TOPE, TOPW, RS);
    }
    __syncthreads();
    if (F.tid < NE) hist[32 + F.tid] = (int)__hip_atomic_fetch_add(F.ctl + CW_CNT + 64 * F.tid, (unsigned)hist[F.tid], RLX_AGENT);
    __syncthreads();
    const int nrows = has_meta ? RPW + 16 : RPW;
    for (int u = F.tid; u < nrows * 4; u += NTHREADS) { const int rr = u >> 2, V = rr < RPW ? Vbase + rr : NTOK + (rr - RPW); const size_t gi = (size_t)V * 4 + (u & 3); const int e = TOPE[gi], pos = hist[32 + e] + res[u];
        TOPP[gi] = pos; ETOK[(size_t)e * NV + pos] = V; ERS[(size_t)e * NV + pos] = RS[V]; EW[(size_t)e * NV + pos] = TOPW[gi]; }
}

__device__ __forceinline__ void build_tables(Frame& F) {
    LAS int* pst = (LAS int*)(F.lds + PST_OFF); LAS unsigned char* texp = (LAS unsigned char*)(F.lds + TEXP_OFF);
    __syncthreads();
    if (F.tid < 64) {
        const int e = F.lane & 31; const int c = (int)__hip_atomic_load(F.ctl + CW_CNT + 64 * e, RLX_AGENT); const int nt = (c + 255) >> 8;
        int incl = nt;
#pragma unroll
        for (int o = 1; o < 32; o <<= 1) { const int t = __shfl_up(incl, o); if ((F.lane & 31) >= o) incl += t; }
        const int start = incl - nt;
        if (F.lane < 32) { pst[e] = start * 256; pst[33 + e] = c; for (int j = 0; j < nt && start + j < MAXTILES; ++j) texp[start + j] = (unsigned char)e; if (e == 31) pst[32] = incl < MAXTILES ? incl : MAXTILES; }
    }
    __syncthreads();
}
typedef float f32v2_t __attribute__((ext_vector_type(2)));
__device__ __forceinline__ void p10_combine(Frame& F) {
    unsigned char* ws = F.ws; build_tables(F);
    const LAS int* pst = (const LAS int*)(F.lds + PST_OFF);
    const bf16* H1 = (const bf16*)(ws + WS_H1); const unsigned char* YB = (const unsigned char*)(ws + WS_YB);
    const int* TOPE = (const int*)(ws + WS_TOPE); const int* TOPP = (const int*)(ws + WS_TOPP);
    const int gw = F.vcu * NWAVES + F.wave, NGW = F.G * NWAVES;
    const GAS f32x4* nf = (const GAS f32x4*)F.in[IN_NFIN] + F.lane; f32x4 nfv[4];
#pragma unroll
    for (int j = 0; j < 4; ++j) nfv[j] = nf[64 * j];
    int sl[2][4];
#define CMB_SLOTS(Rbase) do { _Pragma("unroll") for (int q = 0; q < 2; ++q) { const int R = (Rbase) + q * NGW; if (R < BATCH * SEQ) { const size_t V = (size_t)R; \
        _Pragma("unroll") for (int k = 0; k < 4; ++k) sl[q][k] = pst[TOPE[V * 4 + k]] + TOPP[V * 4 + k]; } else { _Pragma("unroll") for (int k = 0; k < 4; ++k) sl[q][k] = 0; } } } while (0)
    CMB_SLOTS(gw);
    for (int R0 = gw; R0 < BATCH * SEQ; R0 += 2 * NGW) {
        f32x4 v[2][4]; unsigned y[2][4][4];
#pragma unroll
        for (int q = 0; q < 2; ++q) { const int R = (R0 + q * NGW < BATCH * SEQ) ? R0 + q * NGW : R0; const size_t V = (size_t)R;
            const GAS v2u* hr = (const GAS v2u*)(H1 + V * D) + F.lane;
#pragma unroll
            for (int j = 0; j < 4; ++j) { const v2u hw = hr[64 * j]; v[q][j] = (f32x4){bflo(hw.x), bfhi(hw.x), bflo(hw.y), bfhi(hw.y)}; }
#pragma unroll
            for (int k = 0; k < 4; ++k) { const GAS unsigned* yr = (const GAS unsigned*)(YB + (size_t)sl[q][k] * D) + F.lane;
#pragma unroll
                for (int j = 0; j < 4; ++j) y[q][k][j] = yr[64 * j]; } }
        CMB_SLOTS(R0 + 2 * NGW);
#pragma unroll
        for (int q = 0; q < 2; ++q) { const int R = R0 + q * NGW; if (R >= BATCH * SEQ) continue;
#pragma unroll
            for (int k = 0; k < 4; ++k)
#pragma unroll
                for (int j = 0; j < 4; ++j) { const unsigned w = y[q][k][j]; const f32v2_t lo = __builtin_amdgcn_cvt_pk_f32_fp8(w, false), hi = __builtin_amdgcn_cvt_pk_f32_fp8(w, true);
                    v[q][j].x += lo[0] * 0.0625f; v[q][j].y += lo[1] * 0.0625f; v[q][j].z += hi[0] * 0.0625f; v[q][j].w += hi[1] * 0.0625f; }
            float s = 0.f;
#pragma unroll
            for (int j = 0; j < 4; ++j) s += (v[q][j].x * v[q][j].x + v[q][j].y * v[q][j].y) + (v[q][j].z * v[q][j].z + v[q][j].w * v[q][j].w);
            const float rs = 1.0f / sqrtf(wave_sum(s) * (1.f / D) + EPS);
            GAS f32x4* orow = (GAS f32x4*)(F.out + (size_t)R * D) + F.lane;
#pragma unroll
            for (int j = 0; j < 4; ++j) orow[64 * j] = v[q][j] * rs * nfv[j]; }
    }
#undef CMB_SLOTS
}

__device__ __forceinline__ int meta_row(int lane) { return ((lane >> 5) & 1) * 8 + ((lane >> 4) & 1) * 4 + ((lane >> 3) & 1) * 2 + ((lane >> 2) & 1); }
template <int KPL> __device__ __forceinline__ float meta_col(const LAS unsigned char* A, const bf16* wrow, int lane) {
    constexpr int K = 64 * KPL; float w[KPL];
#pragma unroll
    for (int j = 0; j < KPL / 8; ++j) { const v4u x = *(const GAS v4u*)(wrow + lane * KPL + 8 * j);
        w[8 * j] = bflo(x.x); w[8 * j + 1] = bfhi(x.x); w[8 * j + 2] = bflo(x.y); w[8 * j + 3] = bfhi(x.y); w[8 * j + 4] = bflo(x.z); w[8 * j + 5] = bfhi(x.z); w[8 * j + 6] = bflo(x.w); w[8 * j + 7] = bfhi(x.w); }
    float p[16];
#pragma unroll
    for (int r = 0; r < 16; ++r) { float s = 0.f;
#pragma unroll
        for (int j = 0; j < KPL / 8; ++j) { const v4u a = *(const LAS v4u*)(A + (r * K + lane * KPL + 8 * j) * 2);
            s += (bflo(a.x) * w[8 * j] + bfhi(a.x) * w[8 * j + 1]) + (bflo(a.y) * w[8 * j + 2] + bfhi(a.y) * w[8 * j + 3]) + (bflo(a.z) * w[8 * j + 4] + bfhi(a.z) * w[8 * j + 5]) + (bflo(a.w) * w[8 * j + 6] + bfhi(a.w) * w[8 * j + 7]); }
        p[r] = s; if ((r & 3) == 3) asm volatile("" ::: "memory"); }
    const bool b32 = lane & 32, b16 = lane & 16, b8 = lane & 8, b4 = lane & 4;
    float q8[8], q4[4], q2[2];
#pragma unroll
    for (int i = 0; i < 8; ++i) { const float keep = b32 ? p[i + 8] : p[i], send = b32 ? p[i] : p[i + 8]; q8[i] = keep + __shfl_xor(send, 32); }
#pragma unroll
    for (int i = 0; i < 4; ++i) { const float keep = b16 ? q8[i + 4] : q8[i], send = b16 ? q8[i] : q8[i + 4]; q4[i] = keep + __shfl_xor(send, 16); }
#pragma unroll
    for (int i = 0; i < 2; ++i) { const float keep = b8 ? q4[i + 2] : q4[i], send = b8 ? q4[i] : q4[i + 2]; q2[i] = keep + __shfl_xor(send, 8); }
    float v = (b4 ? q2[1] : q2[0]) + __shfl_xor(b4 ? q2[0] : q2[1], 4);
    v += __shfl_xor(v, 2); v += __shfl_xor(v, 1);
    return v;
}
__device__ __forceinline__ void meta_stage(Frame& F, LAS unsigned char* dst, const bf16* src, int K) {
    v4u t[4]; const int n = 16 * K / 8;
#pragma unroll
    for (int q = 0; q < 4; ++q) { const int u = F.tid + q * NTHREADS; if (u < n) t[q] = *(const GAS v4u*)(src + (size_t)u * 8); }
#pragma unroll
    for (int q = 0; q < 4; ++q) { const int u = F.tid + q * NTHREADS; if (u < n) *(LAS v4u*)(dst + u * 16) = t[q]; }
}
__device__ __forceinline__ void meta_proj(Frame& F) {
    unsigned char* ws = F.ws; const bf16* WIN = (const bf16*)(ws + WS_WIN); const float* lbl = F.in[IN_LBL];
    LAS unsigned char* A = F.lds + RING_OFF;
    __syncthreads(); meta_stage(F, A, (const bf16*)(ws + WS_XN0) + (size_t)NTOK * D, D); __syncthreads();
    for (int c = F.vcu * NWAVES + F.wave; c < NPROJ; c += F.G * NWAVES) {
        const float v = meta_col<16>(A, WIN + (size_t)c * D, F.lane);
        if ((F.lane & 3) == 0) { const size_t row = NTOK + meta_row(F.lane); const int kind = c < 3072 ? (c >> 9) : 6, cc = c & 511;
            if (kind == 0) ((bf16*)(ws + WS_HQ))[row * HW + cc] = (bf16)f2bf(fsilu(v));
            else if (kind == 1) { const float lb = fsigmoid(lbl[cc] - lbl[HW + cc]); ((bf16*)(ws + WS_HG))[row * HW + cc] = (bf16)f2bf(__logf(lb + (1.f - lb) * fsigmoid(v))); }
            else if (kind == 2) ((bf16*)(ws + WS_HV))[row * HW + cc] = (bf16)f2bf(v);
            else if (kind == 3) ((bf16*)(ws + WS_HGATE))[row * HW + cc] = (bf16)f2bf(fsilu(v));
            else if (kind == 4) ((bf16*)(ws + WS_MM))[row * HW + cc] = (bf16)f2bf(v);
            else if (kind == 5) ((bf16*)(ws + WS_MO))[row * HW + cc] = (bf16)f2bf(fsigmoid(v));
            else (ws + WS_GATES)[row * 2048 + pg8::gate_pos(c - 3072)] = (unsigned char)(__builtin_bit_cast(unsigned, __builtin_fmaf(fsigmoid(v), 255.f, 8388608.f)) & 0xffu); } }
}
__device__ __forceinline__ void meta_merged(Frame& F) {
    unsigned char* ws = F.ws; const unsigned char* GATES = ws + WS_GATES;
    LAS unsigned char* A0 = F.lds + RING_OFF; LAS unsigned char* A1 = A0 + 16 * HW * 2;
    __syncthreads(); meta_stage(F, A0, (const bf16*)(ws + WS_YHG) + (size_t)NTOK * HW, HW); meta_stage(F, A1, (const bf16*)(ws + WS_YML) + (size_t)NTOK * HW, HW); __syncthreads();
    for (int c = F.vcu * NWAVES + F.wave; c < D; c += F.G * NWAVES) {
        const float vh = meta_col<8>(A0, (const bf16*)(ws + WS_WBH) + (size_t)c * HW, F.lane), vm = meta_col<8>(A1, (const bf16*)(ws + WS_WBM) + (size_t)c * HW, F.lane);
        if ((F.lane & 3) == 0) { const size_t row = NTOK + meta_row(F.lane); ((bf16*)(ws + WS_MERGED))[row * D + c] = (bf16)f2bf((float)GATES[row * 2048 + pg8::gate_pos(c)] * vh + fmaxf((float)GATES[row * 2048 + pg8::gate_pos(D + c)], 1.f) * vm); } }
}
__device__ __forceinline__ void meta_wout(Frame& F) {
    unsigned char* ws = F.ws; LAS unsigned char* A = F.lds + RING_OFF;
    __syncthreads(); meta_stage(F, A, (const bf16*)(ws + WS_MERGED) + (size_t)NTOK * D, D); __syncthreads();
    for (int c = F.vcu * NWAVES + F.wave; c < D; c += F.G * NWAVES) {
        const float d = meta_col<16>(A, (const bf16*)(ws + WS_WOUT) + (size_t)c * D, F.lane);
        if ((F.lane & 3) == 0) { const int mr_ = meta_row(F.lane); const size_t row = NTOK + mr_; const float v = F.in[IN_META][(size_t)mr_ * D + c] + d;
            ((bf16*)(ws + WS_H1))[row * D + c] = (bf16)f2bf(v); ((unsigned char*)(ws + WS_H1B))[row * D + c] = (unsigned char)(__builtin_amdgcn_cvt_pk_fp8_f32(__builtin_amdgcn_fmed3f(v, -448.f, 448.f), 0.f, 0u, false) & 0xffu); } }
}

__device__ __forceinline__ void ph_proj(Frame& F, int variant) {
    unsigned char* ws = F.ws;
    pg8::Gemm g{(const pg8::bf16_t*)(ws + WS_XQ), (const pg8::bf16_t*)(ws + WS_WIN8), NTOK, NPROJ, D / 2}; pg8::StaticOrder S; S.init(NTOK, NPROJ, F.G, (int)blockIdx.x);
    pg8::EpiProjT<true> E{ws, F.in[IN_LBL], (const float*)(ws + WS_SROW), (const float*)(ws + WS_SCOL)};
#if MK_N_LAUNCHES != 1 && PROBE_VARIANT == 1
    if (variant) { pg8::EpiNull EN{(int*)(ws + WS_TOPE)}; pg8::gemm_phase<pg8::EpiNull, pg8::StaticOrder, true, true, false, true>(F.lds + RING_OFF, g, S, EN); return; }
#elif MK_N_LAUNCHES != 1 && PROBE_VARIANT == 2
    if (variant) { pg8::EpiProjT<true, true> EV{ws, F.in[IN_LBL], (const float*)(ws + WS_SROW), (const float*)(ws + WS_SCOL)}; pg8::gemm_phase<pg8::EpiProjT<true, true>, pg8::StaticOrder, true, true, false, true>(F.lds + RING_OFF, g, S, EV); return; }
#endif
    (void)variant;
    pg8::gemm_phase<pg8::EpiProjT<true>, pg8::StaticOrder, true, true, false, true>(F.lds + RING_OFF, g, S, E);
    meta_proj(F);
}
__device__ __forceinline__ void ph_scan(Frame& F) {
    const int sb = (int)blockIdx.x;
    if (sb < 64) p3_hgrn2_mfma(F, sb); else if (sb < 128) p3_mlstm_mfma(F, sb - 64);
#if !CONV_IN_P0
    else px_experts(F, sb - 128, F.G - 128);
#endif
}
__device__ __forceinline__ void ph_merged(Frame& F, int variant = 0) {
    unsigned char* ws = F.ws;
    static_assert(WS_YML - WS_YHG == (size_t)pg8::PAIR_DA * 256 * HW * 2 && WS_WBM - WS_WBH == (size_t)pg8::PAIR_DB * 256 * HW * 2, "the second branch's operands sit a whole number of tiles behind the first's");
    pg8::PairOrder S; S.S.init(NTOK, D, F.G, (int)blockIdx.x);
    pg8::Gemm g{(const pg8::bf16_t*)(ws + WS_YHG), (const pg8::bf16_t*)(ws + WS_WBH), NTOK, D, HW};
    pg8::EpiGate2 E{(const unsigned char*)(ws + WS_GATES), (pg8::bf16_t*)(ws + WS_MERGED)};
#if MK_N_LAUNCHES != 1 && PROBE_VARIANT == 1
    if (variant) { pg8::EpiNull EN{(int*)(ws + WS_TOPE)}; pg8::gemm_phase<pg8::EpiNull, pg8::PairOrder, true, true>(F.lds + RING_OFF, g, S, EN); return; }
#endif
    (void)variant;
    pg8::gemm_phase<pg8::EpiGate2, pg8::PairOrder, true, true>(F.lds + RING_OFF, g, S, E);
    meta_merged(F);
}
__device__ __forceinline__ void ph_wout(Frame& F, int variant = 0) {
    unsigned char* ws = F.ws;
    pg8::Gemm g{(const pg8::bf16_t*)(ws + WS_MERGED), (const pg8::bf16_t*)(ws + WS_WOUT), NTOK, D, D}; pg8::StaticOrder S; S.init(NTOK, D, F.G, (int)blockIdx.x);
    pg8::EpiH1 E{(const pg8::bf16_t*)(ws + WS_XN0), (const float*)(ws + WS_XSQ), (pg8::bf16_t*)(ws + WS_H1), (unsigned char*)(ws + WS_H1B)};
#if MK_N_LAUNCHES != 1 && PROBE_VARIANT == 1
    if (variant) { pg8::EpiNull EN{(int*)(ws + WS_TOPE)}; pg8::gemm_phase<pg8::EpiNull, pg8::StaticOrder, true, true>(F.lds + RING_OFF, g, S, EN); return; }
#endif
    (void)variant;
    pg8::gemm_phase<pg8::EpiH1, pg8::StaticOrder, true, true>(F.lds + RING_OFF, g, S, E);
    meta_wout(F);
}
__device__ __forceinline__ void ph_gu(Frame& F, int variant = 0) {
    unsigned char* ws = F.ws; build_tables(F);
    const LAS int* pst = (const LAS int*)(F.lds + PST_OFF); LAS unsigned short* tok16 = (LAS unsigned short*)(F.lds + TOK_OFF);
    pg8::Gemm g{(const pg8::bf16_t*)(ws + WS_H1B), (const pg8::bf16_t*)(ws + WS_WGU), NV, NE * 2 * DFF, D / 2};
    pg8::GroupOrder S{pst[32], 8, F.G, (int)blockIdx.x, (const LAS unsigned char*)(F.lds + TEXP_OFF)};
    { const int* ETOK = (const int*)(ws + WS_ETOK);
      int tokv[18];
#pragma unroll
      for (int i = 0; i < 18; ++i) { pg8::Unit u; int t = 0; if (S.next(i, u) && F.tid < 256) { const int e = u.pn >> 3, pos = u.pm * 256 - pst[e] + F.tid; if (pos < pst[33 + e]) t = ETOK[(size_t)e * NV + pos]; } tokv[i] = t; }
      if (F.tid < 256) {
#pragma unroll
          for (int i = 0; i < 18; ++i) tok16[i * 256 + F.tid] = (unsigned short)tokv[i]; }
      __syncthreads(); }
    pg8::EpiGU E{(const float*)(ws + WS_BGUP), (const float*)(ws + WS_ERS), (unsigned char*)(ws + WS_ACT), pst};
#if MK_N_LAUNCHES != 1 && PROBE_VARIANT == 1
    if (variant) { pg8::EpiNull EN{(int*)(ws + WS_TOPE)}; pg8::gemm_phase_g<pg8::EpiNull, pg8::GroupOrder, true>(F.lds + RING_OFF, g, S, EN, tok16); return; }
#elif MK_N_LAUNCHES != 1 && PROBE_VARIANT == 2
    if (variant) { pg8::EpiGUT<true> EV{(const float*)(ws + WS_BGUP), (const float*)(ws + WS_ERS), (unsigned char*)(ws + WS_ACT), pst}; pg8::gemm_phase_g<pg8::EpiGUT<true>, pg8::GroupOrder, true>(F.lds + RING_OFF, g, S, EV, tok16); return; }
#endif
    (void)variant;
    pg8::gemm_phase_g<pg8::EpiGU, pg8::GroupOrder, true>(F.lds + RING_OFF, g, S, E, tok16);
}
__device__ __forceinline__ void ph_down(Frame& F, int variant = 0) {
    unsigned char* ws = F.ws; build_tables(F);
    pg8::Gemm g{(const pg8::bf16_t*)(ws + WS_ACT), (const pg8::bf16_t*)(ws + WS_WDN), MAXTILES * 256, NE * D, DFF / 2};
    pg8::GroupOrder S{((const LAS int*)(F.lds + PST_OFF))[32], 4, F.G, (int)blockIdx.x, (const LAS unsigned char*)(F.lds + TEXP_OFF)};
    pg8::EpiDown E{F.in[IN_BDN], (const float*)(ws + WS_EW), (unsigned char*)(ws + WS_YB), (const LAS int*)(F.lds + PST_OFF)};
#if MK_N_LAUNCHES != 1 && PROBE_VARIANT == 1
    if (variant) { pg8::EpiNull EN{(int*)(ws + WS_TOPE)}; pg8::gemm_phase<pg8::EpiNull, pg8::GroupOrder, true, true, true>(F.lds + RING_OFF, g, S, EN); return; }
#elif MK_N_LAUNCHES != 1 && PROBE_VARIANT == 2
    if (variant) { pg8::EpiDownT<true> EV{F.in[IN_BDN], (const float*)(ws + WS_EW), (unsigned char*)(ws + WS_YB), (const LAS int*)(F.lds + PST_OFF)}; pg8::gemm_phase<pg8::EpiDownT<true>, pg8::GroupOrder, true, true, true>(F.lds + RING_OFF, g, S, EV); return; }
#endif
    (void)variant;
    pg8::gemm_phase<pg8::EpiDown, pg8::GroupOrder, true, true, true>(F.lds + RING_OFF, g, S, E);
}

#ifndef CONV_IN_P0
#define CONV_IN_P0 0
#endif
#ifndef PROBE_DOUBLE
#define PROBE_DOUBLE 0
#endif
#define DBL(k) ((PROBE_DOUBLE >> (k)) & 1)
#ifndef MK_N_LAUNCHES
#define MK_N_LAUNCHES 1
#endif
constexpr int NPHASE = 9;
#ifndef PROBE_VARIANT
#define PROBE_VARIANT 0
#endif
struct Args { const float* in[25]; float* out; unsigned char* ws; int ph_lo, ph_hi, li, pad; };
__global__ void __launch_bounds__(NTHREADS, 2) fwd_kernel(Args args) {
    extern __shared__ __attribute__((aligned(16))) unsigned char lds[];
    Frame F;
    F.lds = (LAS unsigned char*)lds; F.MISC = (volatile LAS unsigned*)(F.lds + MISC_OFF);
    F.tid = threadIdx.x; F.lane = F.tid & 63; F.wave = __builtin_amdgcn_readfirstlane(F.tid >> 6);
    F.G = gridDim.x; { const int bx = blockIdx.x; F.vcu = (F.G % 8 == 0) ? (bx % 8) * (F.G / 8) + bx / 8 : bx; }
    F.ws = args.ws; F.ctl = (gu32*)(args.ws + WS_CTL); F.out = args.out;
#pragma unroll
    for (int i = 0; i < 25; ++i) F.in[i] = args.in[i];
    { int t0 = F.tid; asm volatile("" : "+v"(t0)); if (t0 < 64) F.MISC[t0] = 0u; }
    __syncthreads();
    const int lo = args.ph_lo, hi = args.ph_hi;
    XcdBarrier bar; bar.bar = (unsigned*)(F.ctl + CW_BAR) + args.li * XCD_BAR_WORDS; bar.x = 0; bar.st = nullptr;
    if (hi - lo > 1) bar = xcd_barrier_post((unsigned*)(F.ctl + CW_BAR) + args.li * XCD_BAR_WORDS, F.MISC + 8);
#define IN(k) (lo <= (k) && (k) < hi)
#define SEAM(k) do { if (IN(k) && IN((k) + 1)) xcd_barrier(bar); } while (0)

    if (IN(0)) { p0_prologue(F); p0b_quant(F);
#if CONV_IN_P0
        __syncthreads(); px_experts(F, F.vcu, F.G);
#endif
    } SEAM(0);
    if (IN(1)) { ph_proj(F, args.pad); } SEAM(1);
    if (IN(2)) { ph_scan(F); } SEAM(2);
    if (IN(3)) { ph_merged(F, args.pad); } SEAM(3);
    if (IN(4)) { ph_wout(F, args.pad); } SEAM(4);
    if (IN(5)) { p6_router(F); } SEAM(5);
    if (IN(6)) { ph_gu(F, args.pad); } SEAM(6);
    if (IN(7)) { ph_down(F, args.pad); } SEAM(7);
    if (IN(8)) { p10_combine(F); }
#undef IN
#undef SEAM
}

extern "C" void kernel_launch(void* const* d_in, const int* in_sizes, int n_in, void* d_out, int out_size, void* d_ws, size_t ws_size, hipStream_t stream) {
    static int grid = 0;
    if (grid == 0) {
        if (n_in != 25 || in_sizes[0] != BATCH * SEQ * D || out_size != BATCH * SEQ * D || ws_size < WS_END) { fprintf(stderr, "kernel_launch: unexpected shapes (n_in %d, in0 %d, out %d, ws %zu); nothing launched\n", n_in, n_in > 0 ? in_sizes[0] : -1, out_size, ws_size); grid = -1; return; }
        int dev = 0, cus = 0, per_cu = 0;
        if (hipGetDevice(&dev) != hipSuccess || hipDeviceGetAttribute(&cus, hipDeviceAttributeMultiprocessorCount, dev) != hipSuccess) { grid = -1; return; }
        if (hipFuncSetAttribute((const void*)fwd_kernel, hipFuncAttributeMaxDynamicSharedMemorySize, LDS_BYTES) != hipSuccess) { fprintf(stderr, "kernel_launch: hipFuncSetAttribute failed\n"); grid = -1; return; }
        if (hipOccupancyMaxActiveBlocksPerMultiprocessor(&per_cu, (const void*)fwd_kernel, NTHREADS, LDS_BYTES) != hipSuccess || per_cu < 1) { fprintf(stderr, "kernel_launch: occupancy query reports %d blocks per CU\n", per_cu); }
        (void)hipGetLastError();
        grid = 256;
        if (cus < 256) { fprintf(stderr, "kernel_launch: %d CUs < 256: the grid would not be resident; nothing launched\n", cus); grid = -1; return; }
    }
    if (grid < 0) return;
    if (hipMemsetAsync((char*)d_ws + WS_CTL, 0, CTL_ZERO_BYTES, stream) != hipSuccess) return;
    Args a{};
    for (int i = 0; i < 25; ++i) a.in[i] = (const float*)d_in[i];
    a.out = (float*)d_out; a.ws = (unsigned char*)d_ws; a.pad = 0;
#if MK_N_LAUNCHES == 1
    a.ph_lo = 0; a.ph_hi = NPHASE; a.li = 0;
    hipLaunchKernelGGL(fwd_kernel, dim3(grid), dim3(NTHREADS), LDS_BYTES, stream, a);
#else
    for (int p = 0; p < NPHASE; ++p) for (int rep = 0; rep <= DBL(p); ++rep) { a.ph_lo = p; a.ph_hi = p + 1; a.li = 0; a.pad = rep; hipLaunchKernelGGL(fwd_kernel, dim3(grid), dim3(NTHREADS), LDS_BYTES, stream, a); }
#endif
}
```

```cpp
#include <hip/hip_runtime.h>
#include <cstdio>
#include <cstdint>
namespace pg8 {
#define PG8_LAS __attribute__((address_space(3)))
typedef unsigned short bf16_t;
typedef short bf16x8 __attribute__((ext_vector_type(8)));
typedef float f32x4 __attribute__((ext_vector_type(4)));
typedef unsigned u32x4 __attribute__((ext_vector_type(4)));
constexpr int BM = 256, BK = 64, HALF = 128, HTB = HALF * BK * 2  , STAGE_BYTES = 8 * HTB, NXCD = 8, WGM = 8;

__host__ __device__ __forceinline__ int lds_byte(int r, int c) { const int st = (r >> 4) * 2 + (c >> 5), rr = r & 15, cc = c & 31, ob = rr * 64 + cc * 2; return st * 1024 + (ob ^ (((ob >> 9) & 1) << 5)); }
__host__ __device__ __forceinline__ void stage_rc(int b, int& R, int& C) { const int st = b / 1024, sb = b % 1024, swz = sb ^ (((sb >> 9) & 1) << 5); R = (st >> 1) * 16 + swz / 64; C = (st & 1) * 32 + (swz % 64) / 2; }
__host__ __device__ __forceinline__ int perm32(int rho) { const int n = rho >> 4, i = rho & 15; return 8 * (i >> 2) + 4 * n + (i & 3); }

struct Unit { int pm, pn; };
struct Gemm { const bf16_t* A; const bf16_t* Bt; int M, N, K; };

struct StaticOrder {
    int nM, nN, nwg, G, c;
    __host__ __device__ void init(int M, int N, int G_, int c_) { nM = M / BM; nN = N / BM; nwg = nM * nN; G = G_; c = c_; }
    __host__ __device__ __forceinline__ bool next(int i, Unit& u) const {
        const long L = (long)i * G + c; if (L >= nwg) return false;
        int wgid = (int)L; { const int q = nwg / NXCD, r = nwg % NXCD, xcd = wgid % NXCD, off = wgid / NXCD; wgid = (xcd < r ? xcd * (q + 1) : r * (q + 1) + (xcd - r) * q) + off; }
        const int nig = WGM * nN, gid = wgid / nig, fm = gid * WGM, gsz = (nM - fm) < WGM ? (nM - fm) : WGM;
        u.pm = fm + ((wgid % nig) % gsz); u.pn = (wgid % nig) / gsz; return true;
    }
    __device__ __forceinline__ void a_ready(const Unit&) const {}
    __device__ __forceinline__ void done(const Unit&) const {}
};

typedef __bf16 bf16v2 __attribute__((ext_vector_type(2)));
typedef float f32v2 __attribute__((ext_vector_type(2)));
__device__ __forceinline__ unsigned cvt_pk_bf16(float lo, float hi) { const f32v2 v = {lo, hi}; return __builtin_bit_cast(unsigned, __builtin_convertvector(v, bf16v2)); }
typedef float f32x2 __attribute__((ext_vector_type(2)));
typedef int i32x4 __attribute__((ext_vector_type(4)));
typedef int i32x8 __attribute__((ext_vector_type(8)));
__device__ __forceinline__ i32x8 cat8(const bf16x8 a, const bf16x8 b) { const i32x4 x = __builtin_bit_cast(i32x4, a), y = __builtin_bit_cast(i32x4, b); return __builtin_shufflevector(x, y, 0, 1, 2, 3, 4, 5, 6, 7); }
template <class T, class = void> struct epi_chain { static constexpr bool value = false; };
template <class T> struct epi_chain<T, decltype((void)T::CHAIN)> { static constexpr bool value = T::CHAIN; };
template <class Epi, class Sched, bool ALIGN_EPI = false, bool SP2 = false, bool FP8 = false, bool I8 = false>
__device__ __forceinline__ void gemm_phase(PG8_LAS unsigned char* lds, const Gemm g, const Sched& S, const Epi& E) {
    const int tid = threadIdx.x, wid = __builtin_amdgcn_readfirstlane(tid >> 6), lane = tid & 63, wr = wid >> 2, wc = wid & 3, fr = lane & 15, fq = lane >> 4;
    const int K = g.K, nt = K / BK;
    unsigned voffA[2], voffB[2];
#pragma unroll
    for (int i = 0; i < 2; ++i) { int R, C; stage_rc(tid * 16 + i * 8192, R, C); const int Rb = Epi::PERM ? ((R & ~31) + perm32(R & 31)) : R;
        voffA[i] = (unsigned)(R * K + C) * 2u; voffB[i] = (unsigned)(Rb * K + C) * 2u; }
    const size_t kstep = (size_t)(BK * 2);
    const size_t hstep = (size_t)HALF * K * 2;
    const size_t tstep = 2 * hstep;
    const unsigned ldsw = (unsigned)wid * 1024u;
    const int aoff = lds_byte(wr * 64 + fr, fq * 8), boff = lds_byte(wc * 32 + fr, fq * 8);
#define PG8_SA(b, h) (((b) * 2 + (h)) * HTB)
#define PG8_SB(b, h) ((4 + (b) * 2 + (h)) * HTB)
#define PG8_STAGE(bufoff, gbase, voff) do { _Pragma("unroll") for (int _i = 0; _i < 2; ++_i) \
        __builtin_amdgcn_global_load_lds((const unsigned*)((const char*)(gbase) + (voff)[_i]), (PG8_LAS unsigned*)(lds + (bufoff) + ldsw + _i * 8192), 16, 0, 0); } while (0)
#define PG8_LDA(dst, b, h) do { _Pragma("unroll") for (int m = 0; m < 4; ++m) { if constexpr (FP8) dst##8[m] = cat8(*(const PG8_LAS bf16x8*)(lds + PG8_SA(b, h) + aoff + m * 2048), *(const PG8_LAS bf16x8*)(lds + PG8_SA(b, h) + aoff + m * 2048 + 1024)); \
        else { _Pragma("unroll") for (int k = 0; k < 2; ++k) dst[m][k] = *(const PG8_LAS bf16x8*)(lds + PG8_SA(b, h) + aoff + m * 2048 + k * 1024); } } } while (0)
#define PG8_LDB(dst, b, h) do { _Pragma("unroll") for (int n = 0; n < 2; ++n) { if constexpr (FP8) dst##8[n] = cat8(*(const PG8_LAS bf16x8*)(lds + PG8_SB(b, h) + boff + n * 2048), *(const PG8_LAS bf16x8*)(lds + PG8_SB(b, h) + boff + n * 2048 + 1024)); \
        else { _Pragma("unroll") for (int k = 0; k < 2; ++k) dst[n][k] = *(const PG8_LAS bf16x8*)(lds + PG8_SB(b, h) + boff + n * 2048 + k * 1024); } } } while (0)
#define PG8_MMA(ai, bj, At, Bt) do { __builtin_amdgcn_s_setprio(1); _Pragma("unroll") for (int m = 0; m < 4; ++m) _Pragma("unroll") for (int n = 0; n < 2; ++n) { \
        if constexpr (FP8) acc[ai][bj][m][n] = __builtin_amdgcn_mfma_scale_f32_16x16x128_f8f6f4(Bt##8[n], At##8[m], acc[ai][bj][m][n], 0, 0, 0, 0x7f7f7f7f, 0, 0x7f7f7f7f); \
        else if constexpr (I8) { _Pragma("unroll") for (int k = 0; k < 2; ++k) acc[ai][bj][m][n] = __builtin_bit_cast(f32x4, __builtin_amdgcn_mfma_i32_16x16x64_i8(__builtin_bit_cast(i32x4, Bt[n][k]), __builtin_bit_cast(i32x4, At[m][k]), __builtin_bit_cast(i32x4, acc[ai][bj][m][n]), 0, 0, 0)); } \
        else { _Pragma("unroll") for (int k = 0; k < 2; ++k) acc[ai][bj][m][n] = __builtin_amdgcn_mfma_f32_16x16x32_bf16(Bt[n][k], At[m][k], acc[ai][bj][m][n], 0, 0, 0); } } \
        if constexpr (FP8) { _Pragma("unroll") for (int m = 0; m < 4; ++m) _Pragma("unroll") for (int n = 0; n < 2; ++n) asm volatile("" : "+v"(acc[ai][bj][m][n])); }     \
        __builtin_amdgcn_s_setprio(0); } while (0)
#define PG8_WAIT_V(n) asm volatile("s_waitcnt vmcnt(" #n ")" ::: "memory")
#define PG8_WAIT_L(n) asm volatile("s_waitcnt lgkmcnt(" #n ")" ::: "memory")
#define PG8_BAR __builtin_amdgcn_s_barrier()
#define PG8_SCHED __builtin_amdgcn_sched_barrier(0)
    Unit cur, nxt; int ui = 0;
    if (!S.next(0, cur)) return;
    f32x4 acc[2][2][4][2];
#pragma unroll
    for (int a = 0; a < 2; ++a)
#pragma unroll
        for (int b = 0; b < 2; ++b)
#pragma unroll
            for (int m = 0; m < 4; ++m)
#pragma unroll
                for (int n = 0; n < 2; ++n) acc[a][b][m][n] = (f32x4){0.f, 0.f, 0.f, 0.f};
    bf16x8 At[4][2], B0[2][2], B1[2][2]; i32x8 At8[4], B08[2], B18[2];
    const char* cA = (const char*)g.A + (size_t)cur.pm * tstep; const char* cB = (const char*)g.Bt + (size_t)cur.pn * tstep;
    S.a_ready(cur);
    if constexpr (SP2) {
        PG8_STAGE(PG8_SB(0, 0), cB, voffB); PG8_STAGE(PG8_SB(0, 1), cB + hstep, voffB); PG8_STAGE(PG8_SA(0, 0), cA, voffA); PG8_STAGE(PG8_SA(0, 1), cA + hstep, voffA);
        if (wr == 1) PG8_BAR;
        PG8_WAIT_V(2); PG8_BAR;
        PG8_STAGE(PG8_SB(1, 0), cB + kstep, voffB); PG8_STAGE(PG8_SA(1, 0), cA + kstep, voffA); PG8_STAGE(PG8_SB(1, 1), cB + hstep + kstep, voffB);
        PG8_WAIT_V(6); PG8_BAR;
    } else {
        PG8_STAGE(PG8_SB(0, 0), cB, voffB); PG8_STAGE(PG8_SA(0, 0), cA, voffA); PG8_STAGE(PG8_SB(0, 1), cB + hstep, voffB); PG8_STAGE(PG8_SA(0, 1), cA + hstep, voffA);
        if (wr == 1) PG8_BAR;
        PG8_WAIT_V(4); PG8_BAR;
        PG8_STAGE(PG8_SB(1, 0), cB + kstep, voffB); PG8_STAGE(PG8_SA(1, 0), cA + kstep, voffA); PG8_STAGE(PG8_SB(1, 1), cB + hstep + kstep, voffB);
        PG8_WAIT_V(6); PG8_BAR;
    }
    for (;;) {
        const bool has_next = S.next(ui + 1, nxt);
        const char* nA = has_next ? (const char*)g.A + (size_t)nxt.pm * tstep : cA; const char* nB = has_next ? (const char*)g.Bt + (size_t)nxt.pn * tstep : cB;
        for (int t = 0; t < nt; t += 2) {
            const bool last = (t == nt - 2);
            const char* a1 = cA + (size_t)(t + 1) * kstep;
            const char* a2 = last ? nA : cA + (size_t)(t + 2) * kstep; const char* b2 = last ? nB : cB + (size_t)(t + 2) * kstep;
            const char* a3 = a2 + kstep; const char* b3 = b2 + kstep;
            if (last && has_next) S.a_ready(nxt);
            if constexpr (SP2) {
            PG8_LDB(B0, 0, 0); PG8_LDB(B1, 0, 1); PG8_SCHED; PG8_LDA(At, 0, 0); PG8_STAGE(PG8_SA(1, 1), a1 + hstep, voffA);
            PG8_WAIT_V(8); PG8_WAIT_L(0); PG8_BAR; PG8_MMA(0, 0, At, B0); PG8_MMA(0, 1, At, B1); PG8_BAR; PG8_SCHED;
            PG8_LDA(At, 0, 1); PG8_STAGE(PG8_SB(0, 0), b2, voffB); PG8_STAGE(PG8_SB(0, 1), b2 + hstep, voffB); PG8_STAGE(PG8_SA(0, 0), a2, voffA);
            PG8_WAIT_V(8); PG8_WAIT_L(0); PG8_BAR; PG8_MMA(1, 0, At, B0); PG8_MMA(1, 1, At, B1); PG8_BAR; PG8_SCHED;
            PG8_LDB(B0, 1, 0); PG8_LDB(B1, 1, 1); PG8_SCHED; PG8_LDA(At, 1, 0); PG8_STAGE(PG8_SA(0, 1), a2 + hstep, voffA);
            PG8_WAIT_V(8); PG8_WAIT_L(0); PG8_BAR; PG8_MMA(0, 0, At, B0); PG8_MMA(0, 1, At, B1); PG8_BAR; PG8_SCHED;
            PG8_LDA(At, 1, 1); PG8_STAGE(PG8_SB(1, 0), b3, voffB); PG8_STAGE(PG8_SB(1, 1), b3 + hstep, voffB); PG8_STAGE(PG8_SA(1, 0), a3, voffA);
            PG8_WAIT_V(8); PG8_WAIT_L(0); PG8_BAR; PG8_MMA(1, 0, At, B0); PG8_MMA(1, 1, At, B1); PG8_BAR; PG8_SCHED;
            } else {
            PG8_LDB(B0, 0, 0); PG8_SCHED; PG8_LDA(At, 0, 0); PG8_STAGE(PG8_SA(1, 1), a1 + hstep, voffA);
            PG8_WAIT_L(8); PG8_BAR; PG8_WAIT_L(0); PG8_MMA(0, 0, At, B0); PG8_BAR; PG8_SCHED;
            PG8_LDB(B1, 0, 1); PG8_STAGE(PG8_SB(0, 0), b2, voffB);
            PG8_BAR; PG8_WAIT_L(0); PG8_MMA(0, 1, At, B1); PG8_BAR;
            PG8_LDA(At, 0, 1); PG8_STAGE(PG8_SA(0, 0), a2, voffA);
            PG8_BAR; PG8_WAIT_L(0); PG8_MMA(1, 0, At, B0); PG8_BAR; PG8_SCHED;
            PG8_STAGE(PG8_SB(0, 1), b2 + hstep, voffB);
            PG8_WAIT_V(6); PG8_BAR; PG8_MMA(1, 1, At, B1); PG8_BAR;
            PG8_LDB(B0, 1, 0); PG8_SCHED; PG8_LDA(At, 1, 0); PG8_STAGE(PG8_SA(0, 1), a2 + hstep, voffA);
            PG8_WAIT_L(8); PG8_BAR; PG8_WAIT_L(0); PG8_MMA(0, 0, At, B0); PG8_BAR; PG8_SCHED;
            PG8_LDB(B1, 1, 1); PG8_STAGE(PG8_SB(1, 0), b3, voffB);
            PG8_BAR; PG8_WAIT_L(0); PG8_MMA(0, 1, At, B1); PG8_BAR;
            PG8_LDA(At, 1, 1); PG8_STAGE(PG8_SA(1, 0), a3, voffA);
            PG8_BAR; PG8_WAIT_L(0); PG8_MMA(1, 0, At, B0); PG8_BAR; PG8_SCHED;
            PG8_STAGE(PG8_SB(1, 1), b3 + hstep, voffB);
            PG8_WAIT_V(6); PG8_BAR; PG8_MMA(1, 1, At, B1); PG8_BAR;
            }
        }
        if constexpr (ALIGN_EPI) { if (wr == 0) PG8_BAR; }
        bool keep = false;
        if constexpr (epi_chain<Epi>::value) { keep = E.chain(acc, cur, wr, wc, fr, fq); S.done(cur); }
        else if constexpr (!Epi::AFTER_DRAIN) { E(acc, cur, wr, wc, fr, fq); S.done(cur); }
        if (!has_next) break;
        if (!keep) {
#pragma unroll
        for (int a = 0; a < 2; ++a)
#pragma unroll
            for (int b = 0; b < 2; ++b)
#pragma unroll
                for (int m = 0; m < 4; ++m)
#pragma unroll
                    for (int n = 0; n < 2; ++n) acc[a][b][m][n] = (f32x4){0.f, 0.f, 0.f, 0.f};
        }
        cur = nxt; cA = nA; cB = nB; ++ui;
        if constexpr (ALIGN_EPI) { if (wr == 1) PG8_BAR; }
    }
    PG8_WAIT_V(0);
    if constexpr (!ALIGN_EPI) { if (wr == 0) PG8_BAR; }
    PG8_BAR;
    if constexpr (Epi::AFTER_DRAIN) { E.fused(acc, cur, wr, wc, fr, fq, lds, wid, lane); S.done(cur); }
#undef PG8_SA
#undef PG8_SB
#undef PG8_STAGE
#undef PG8_LDA
#undef PG8_LDB
#undef PG8_MMA
#undef PG8_WAIT_V
#undef PG8_WAIT_L
#undef PG8_BAR
#undef PG8_SCHED
}
template <class Epi, class Sched, bool FP8 = false>
__device__ __forceinline__ void gemm_phase_g(PG8_LAS unsigned char* lds, const Gemm g, const Sched& S, const Epi& E, const PG8_LAS unsigned short* tok16) {
    constexpr bool ALIGN_EPI = true, SP2 = true;
    const int tid = threadIdx.x, wid = __builtin_amdgcn_readfirstlane(tid >> 6), lane = tid & 63, wr = wid >> 2, wc = wid & 3, fr = lane & 15, fq = lane >> 4;
    const int K = g.K, nt = K / BK;
    unsigned voffB[2]; int RA[2]; unsigned CA[2];
#pragma unroll
    for (int i = 0; i < 2; ++i) { int R, C; stage_rc(tid * 16 + i * 8192, R, C); const int Rb = Epi::PERM ? ((R & ~31) + perm32(R & 31)) : R;
        RA[i] = R; CA[i] = (unsigned)C * 2u; voffB[i] = (unsigned)(Rb * K + C) * 2u; }
    unsigned oc[2][2];
#define PG8_TOKS(dst, ui_) do { _Pragma("unroll") for (int _h = 0; _h < 2; ++_h) _Pragma("unroll") for (int _i = 0; _i < 2; ++_i) \
        dst[_h][_i] = (unsigned)tok16[(ui_) * 256 + _h * HALF + RA[_i]] * (unsigned)(K * 2) + CA[_i]; } while (0)
    const size_t kstep = (size_t)(BK * 2);
    const size_t hstep = (size_t)HALF * K * 2;
    const size_t tstep = 2 * hstep;
    const unsigned ldsw = (unsigned)wid * 1024u;
    const int aoff = lds_byte(wr * 64 + fr, fq * 8), boff = lds_byte(wc * 32 + fr, fq * 8);
#define PG8_SA(b, h) (((b) * 2 + (h)) * HTB)
#define PG8_SB(b, h) ((4 + (b) * 2 + (h)) * HTB)
#define PG8_STAGE(bufoff, gbase, voff) do { _Pragma("unroll") for (int _i = 0; _i < 2; ++_i) \
        __builtin_amdgcn_global_load_lds((const unsigned*)((const char*)(gbase) + (voff)[_i]), (PG8_LAS unsigned*)(lds + (bufoff) + ldsw + _i * 8192), 16, 0, 0); } while (0)
#define PG8_LDA(dst, b, h) do { _Pragma("unroll") for (int m = 0; m < 4; ++m) { if constexpr (FP8) dst##8[m] = cat8(*(const PG8_LAS bf16x8*)(lds + PG8_SA(b, h) + aoff + m * 2048), *(const PG8_LAS bf16x8*)(lds + PG8_SA(b, h) + aoff + m * 2048 + 1024)); \
        else { _Pragma("unroll") for (int k = 0; k < 2; ++k) dst[m][k] = *(const PG8_LAS bf16x8*)(lds + PG8_SA(b, h) + aoff + m * 2048 + k * 1024); } } } while (0)
#define PG8_LDB(dst, b, h) do { _Pragma("unroll") for (int n = 0; n < 2; ++n) { if constexpr (FP8) dst##8[n] = cat8(*(const PG8_LAS bf16x8*)(lds + PG8_SB(b, h) + boff + n * 2048), *(const PG8_LAS bf16x8*)(lds + PG8_SB(b, h) + boff + n * 2048 + 1024)); \
        else { _Pragma("unroll") for (int k = 0; k < 2; ++k) dst[n][k] = *(const PG8_LAS bf16x8*)(lds + PG8_SB(b, h) + boff + n * 2048 + k * 1024); } } } while (0)
#define PG8_MMA(ai, bj, At, Bt) do { __builtin_amdgcn_s_setprio(1); _Pragma("unroll") for (int m = 0; m < 4; ++m) _Pragma("unroll") for (int n = 0; n < 2; ++n) { \
        if constexpr (FP8) acc[ai][bj][m][n] = __builtin_amdgcn_mfma_scale_f32_16x16x128_f8f6f4(Bt##8[n], At##8[m], acc[ai][bj][m][n], 0, 0, 0, 0x7f7f7f7f, 0, 0x7f7f7f7f); \
        else { _Pragma("unroll") for (int k = 0; k < 2; ++k) acc[ai][bj][m][n] = __builtin_amdgcn_mfma_f32_16x16x32_bf16(Bt[n][k], At[m][k], acc[ai][bj][m][n], 0, 0, 0); } } \
        if constexpr (FP8) { _Pragma("unroll") for (int m = 0; m < 4; ++m) _Pragma("unroll") for (int n = 0; n < 2; ++n) asm volatile("" : "+v"(acc[ai][bj][m][n])); }     \
        __builtin_amdgcn_s_setprio(0); } while (0)
#define PG8_WAIT_V(n) asm volatile("s_waitcnt vmcnt(" #n ")" ::: "memory")
#define PG8_WAIT_L(n) asm volatile("s_waitcnt lgkmcnt(" #n ")" ::: "memory")
#define PG8_BAR __builtin_amdgcn_s_barrier()
#define PG8_SCHED __builtin_amdgcn_sched_barrier(0)
    Unit cur, nxt; int ui = 0;
    if (!S.next(0, cur)) return;
    f32x4 acc[2][2][4][2];
#pragma unroll
    for (int a = 0; a < 2; ++a)
#pragma unroll
        for (int b = 0; b < 2; ++b)
#pragma unroll
            for (int m = 0; m < 4; ++m)
#pragma unroll
                for (int n = 0; n < 2; ++n) acc[a][b][m][n] = (f32x4){0.f, 0.f, 0.f, 0.f};
    bf16x8 At[4][2], B0[2][2], B1[2][2]; i32x8 At8[4], B08[2], B18[2];
    const char* cA = (const char*)g.A; const char* cB = (const char*)g.Bt + (size_t)cur.pn * tstep; PG8_TOKS(oc, 0);
    S.a_ready(cur);
    if constexpr (SP2) {
        PG8_STAGE(PG8_SB(0, 0), cB, voffB); PG8_STAGE(PG8_SB(0, 1), cB + hstep, voffB); PG8_STAGE(PG8_SA(0, 0), cA, oc[0]); PG8_STAGE(PG8_SA(0, 1), cA, oc[1]);
        if (wr == 1) PG8_BAR;
        PG8_WAIT_V(2); PG8_BAR;
        PG8_STAGE(PG8_SB(1, 0), cB + kstep, voffB); PG8_STAGE(PG8_SA(1, 0), cA + kstep, oc[0]); PG8_STAGE(PG8_SB(1, 1), cB + hstep + kstep, voffB);
        PG8_WAIT_V(6); PG8_BAR;
    } else {
        PG8_STAGE(PG8_SB(0, 0), cB, voffB); PG8_STAGE(PG8_SA(0, 0), cA, oc[0]); PG8_STAGE(PG8_SB(0, 1), cB + hstep, voffB); PG8_STAGE(PG8_SA(0, 1), cA + hstep, oc[0]);
        if (wr == 1) PG8_BAR;
        PG8_WAIT_V(4); PG8_BAR;
        PG8_STAGE(PG8_SB(1, 0), cB + kstep, voffB); PG8_STAGE(PG8_SA(1, 0), cA + kstep, oc[0]); PG8_STAGE(PG8_SB(1, 1), cB + hstep + kstep, voffB);
        PG8_WAIT_V(6); PG8_BAR;
    }
    for (;;) {
        const bool has_next = S.next(ui + 1, nxt);
        const char* nB = has_next ? (const char*)g.Bt + (size_t)nxt.pn * tstep : cB;
        for (int t = 0; t < nt; t += 2) {
            const bool last = (t == nt - 2);
            const char* a1 = cA + (size_t)(t + 1) * kstep;
            const char* a2 = last ? cA : cA + (size_t)(t + 2) * kstep; const char* b2 = last ? nB : cB + (size_t)(t + 2) * kstep;
            unsigned o2[2][2]; if (last && has_next) PG8_TOKS(o2, ui + 1); else { _Pragma("unroll") for (int _h = 0; _h < 2; ++_h) _Pragma("unroll") for (int _i = 0; _i < 2; ++_i) o2[_h][_i] = oc[_h][_i]; }
            const char* a3 = a2 + kstep; const char* b3 = b2 + kstep;
            if (last && has_next) S.a_ready(nxt);
            if constexpr (SP2) {
            PG8_LDB(B0, 0, 0); PG8_LDB(B1, 0, 1); PG8_SCHED; PG8_LDA(At, 0, 0); PG8_STAGE(PG8_SA(1, 1), a1, oc[1]);
            PG8_WAIT_V(8); PG8_WAIT_L(0); PG8_BAR; PG8_MMA(0, 0, At, B0); PG8_MMA(0, 1, At, B1); PG8_BAR; PG8_SCHED;
            PG8_LDA(At, 0, 1); PG8_STAGE(PG8_SB(0, 0), b2, voffB); PG8_STAGE(PG8_SB(0, 1), b2 + hstep, voffB); PG8_STAGE(PG8_SA(0, 0), a2, o2[0]);
            PG8_WAIT_V(8); PG8_WAIT_L(0); PG8_BAR; PG8_MMA(1, 0, At, B0); PG8_MMA(1, 1, At, B1); PG8_BAR; PG8_SCHED;
            PG8_LDB(B0, 1, 0); PG8_LDB(B1, 1, 1); PG8_SCHED; PG8_LDA(At, 1, 0); PG8_STAGE(PG8_SA(0, 1), a2, o2[1]);
            PG8_WAIT_V(8); PG8_WAIT_L(0); PG8_BAR; PG8_MMA(0, 0, At, B0); PG8_MMA(0, 1, At, B1); PG8_BAR; PG8_SCHED;
            PG8_LDA(At, 1, 1); PG8_STAGE(PG8_SB(1, 0), b3, voffB); PG8_STAGE(PG8_SB(1, 1), b3 + hstep, voffB); PG8_STAGE(PG8_SA(1, 0), a3, o2[0]);
            PG8_WAIT_V(8); PG8_WAIT_L(0); PG8_BAR; PG8_MMA(1, 0, At, B0); PG8_MMA(1, 1, At, B1); PG8_BAR; PG8_SCHED;
            } else {
            PG8_LDB(B0, 0, 0); PG8_SCHED; PG8_LDA(At, 0, 0); PG8_STAGE(PG8_SA(1, 1), a1 + hstep, oc[0]);
            PG8_WAIT_L(8); PG8_BAR; PG8_WAIT_L(0); PG8_MMA(0, 0, At, B0); PG8_BAR; PG8_SCHED;
            PG8_LDB(B1, 0, 1); PG8_STAGE(PG8_SB(0, 0), b2, voffB);
            PG8_BAR; PG8_WAIT_L(0); PG8_MMA(0, 1, At, B1); PG8_BAR;
            PG8_LDA(At, 0, 1); PG8_STAGE(PG8_SA(0, 0), a2, oc[0]);
            PG8_BAR; PG8_WAIT_L(0); PG8_MMA(1, 0, At, B0); PG8_BAR; PG8_SCHED;
            PG8_STAGE(PG8_SB(0, 1), b2 + hstep, voffB);
            PG8_WAIT_V(6); PG8_BAR; PG8_MMA(1, 1, At, B1); PG8_BAR;
            PG8_LDB(B0, 1, 0); PG8_SCHED; PG8_LDA(At, 1, 0); PG8_STAGE(PG8_SA(0, 1), a2 + hstep, oc[0]);
            PG8_WAIT_L(8); PG8_BAR; PG8_WAIT_L(0); PG8_MMA(0, 0, At, B0); PG8_BAR; PG8_SCHED;
            PG8_LDB(B1, 1, 1); PG8_STAGE(PG8_SB(1, 0), b3, voffB);
            PG8_BAR; PG8_WAIT_L(0); PG8_MMA(0, 1, At, B1); PG8_BAR;
            PG8_LDA(At, 1, 1); PG8_STAGE(PG8_SA(1, 0), a3, oc[0]);
            PG8_BAR; PG8_WAIT_L(0); PG8_MMA(1, 0, At, B0); PG8_BAR; PG8_SCHED;
            PG8_STAGE(PG8_SB(1, 1), b3 + hstep, voffB);
            PG8_WAIT_V(6); PG8_BAR; PG8_MMA(1, 1, At, B1); PG8_BAR;
            }
        }
        if constexpr (ALIGN_EPI) { if (wr == 0) PG8_BAR; }
        if constexpr (!Epi::AFTER_DRAIN) { E(acc, cur, wr, wc, fr, fq); S.done(cur); }
        if (!has_next) break;
#pragma unroll
        for (int a = 0; a < 2; ++a)
#pragma unroll
            for (int b = 0; b < 2; ++b)
#pragma unroll
                for (int m = 0; m < 4; ++m)
#pragma unroll
                    for (int n = 0; n < 2; ++n) acc[a][b][m][n] = (f32x4){0.f, 0.f, 0.f, 0.f};
        cur = nxt; cB = nB; ++ui; PG8_TOKS(oc, ui);
        if constexpr (ALIGN_EPI) { if (wr == 1) PG8_BAR; }
    }
    PG8_WAIT_V(0);
    if constexpr (!ALIGN_EPI) { if (wr == 0) PG8_BAR; }
    PG8_BAR;
    if constexpr (Epi::AFTER_DRAIN) { E.fused(acc, cur, wr, wc, fr, fq, lds, wid, lane); S.done(cur); }
#undef PG8_TOKS
#undef PG8_SA
#undef PG8_SB
#undef PG8_STAGE
#undef PG8_LDA
#undef PG8_LDB
#undef PG8_MMA
#undef PG8_WAIT_V
#undef PG8_WAIT_L
#undef PG8_BAR
#undef PG8_SCHED
}
}

constexpr int BATCH = 16, SEQ = 2048, D = 1024, NMETA = 16;
constexpr int TV = SEQ + NMETA;
constexpr int NV = BATCH * TV;
constexpr int NTOK = BATCH * SEQ;
constexpr int NR = NTOK + NMETA;
constexpr int NIN = 5128, NPROJ = 5120;
constexpr int HW = 512;
constexpr int NE = 32, TOPK = 4, DFF = 1024;
constexpr int MAXTILES = 548;
constexpr float EPS = 1e-6f;
constexpr int NWAVES = 8, NTHREADS = 512;

constexpr size_t MiB = 1u << 20, KiB = 1u << 10;
constexpr size_t WS_CTL = 0, CTL_ZERO_BYTES = 1 * MiB;
constexpr size_t WS_WIN = 2 * MiB;
constexpr size_t WS_WBH = 12 * MiB, WS_WBM = 13 * MiB, WS_WOUT = 14 * MiB;
constexpr size_t WS_WGU = 16 * MiB;
constexpr size_t WS_WDN = 144 * MiB;
constexpr size_t WS_BGUP = 208 * MiB;
constexpr size_t WS_RWT = WS_BGUP + 256 * KiB;
constexpr size_t WS_TOPE = WS_RWT + 128 * KiB;
constexpr size_t WS_TOPP = WS_TOPE + 520 * KiB;
constexpr size_t WS_TOPW = WS_TOPP + 520 * KiB;
constexpr size_t WS_RS = WS_TOPW + 520 * KiB;
constexpr size_t WS_LI = WS_RS + 136 * KiB;
constexpr size_t WS_LF = WS_LI + 520 * KiB;
constexpr size_t WS_SLOTRS = WS_LF + 520 * KiB;
constexpr size_t WS_SLOTW = WS_SLOTRS + 552 * KiB;
constexpr size_t WS_XSQ = WS_SLOTW + 552 * KiB;
constexpr size_t WS_SROW = WS_XSQ + 136 * KiB;
constexpr size_t WS_SCOL = WS_SROW + 136 * KiB;
constexpr size_t WS_SMALL_END = WS_SCOL + 32 * KiB;
constexpr size_t WS_RA = 214 * MiB;
constexpr size_t WS_HQ = WS_RA, WS_HG = WS_RA + 33 * MiB, WS_HV = WS_RA + 99 * MiB, WS_HGATE = WS_RA + 132 * MiB, WS_MM = WS_RA + 165 * MiB, WS_MO = WS_RA + 198 * MiB, WS_GATES = WS_RA + 231 * MiB;
constexpr size_t WS_MERGED = WS_RA, WS_TMP = WS_RA + 66 * MiB, WS_H1B = WS_RA + 364 * MiB, WS_ACT = WS_RA;
constexpr size_t WS_RB = WS_RA + 364 * MiB;
constexpr size_t WS_XQ = WS_RB;
constexpr size_t WS_QKVM = WS_RB, WS_CM = WS_RB + 130 * MiB, WS_YHG = WS_RB + 196 * MiB, WS_YML = WS_RB + 229 * MiB, WS_XS = WS_RB, WS_YB = WS_RB;
constexpr size_t WS_RC = WS_RB + 274 * MiB;
constexpr size_t WS_XN0 = WS_RC + 65 * MiB;
constexpr size_t WS_H1 = WS_RC, WS_ETOK = WS_RC + 130 * MiB, WS_ERS = WS_ETOK + 5 * MiB, WS_EW = WS_ERS + 5 * MiB, WS_WIN8 = WS_EW + 5 * MiB, WS_END = WS_WIN8 + 5 * MiB;
static_assert(WS_SMALL_END <= WS_RA && WS_END <= 1024 * MiB, "d_ws map");
static_assert((size_t)NV * HW * 2 <= 33 * MiB && (size_t)NV * HW * 4 <= 66 * MiB && (size_t)NV * 2048 * 2 <= 132 * MiB + MiB && (size_t)NV * D * 4 <= 130 * MiB && (size_t)MAXTILES * 256 * D * 2 <= 274 * MiB, "d_ws sizes");
static_assert((size_t)NE * NV * 4 <= 5 * MiB, "per-expert lists");
static_assert((size_t)NR * D * 2 <= 65 * MiB && (size_t)NR * 4 <= 136 * KiB, "H1 / XN0 / XSQ");
constexpr int CW_TMO = 0, CW_CNT = 64  , CW_BAR = 4096, CW_P0ARR = 3072  , CW_CMAX = 65536  ;

constexpr int RING_OFF = 0, RING_BYTES = 131072;
constexpr int MISC_OFF = RING_BYTES;
constexpr int TEXP_OFF = MISC_OFF + 256;
constexpr int PST_OFF = TEXP_OFF + 640;
constexpr int TOK_OFF = PST_OFF + 384;
constexpr int LDS_BYTES = 147456;
static_assert(TOK_OFF + 18 * 512 <= LDS_BYTES, "LDS map");

#define GAS __attribute__((address_space(1)))
#define LAS __attribute__((address_space(3)))
typedef unsigned short bf16;
typedef unsigned v4u __attribute__((ext_vector_type(4)));
typedef unsigned v2u __attribute__((ext_vector_type(2)));
typedef float f32x4 __attribute__((ext_vector_type(4)));
typedef GAS unsigned gu32;
#define RLX_AGENT __ATOMIC_RELAXED, __HIP_MEMORY_SCOPE_AGENT
#define LDS_WAIT() asm volatile("s_waitcnt lgkmcnt(0)" ::: "memory")
#define VM_WAIT() asm volatile("s_waitcnt vmcnt(0)" ::: "memory")
__device__ __forceinline__ unsigned pk2(float lo, float hi) { return pg8::cvt_pk_bf16(lo, hi); }
__device__ __forceinline__ unsigned f2bf(float f) { return pg8::cvt_pk_bf16(f, 0.f) & 0xffffu; }
__device__ __forceinline__ float bflo(unsigned w) { return __builtin_bit_cast(float, w << 16); }
__device__ __forceinline__ float bfhi(unsigned w) { return __builtin_bit_cast(float, w & 0xffff0000u); }
__device__ __forceinline__ float bf1(bf16 h) { return __builtin_bit_cast(float, (unsigned)h << 16); }
__device__ __forceinline__ float fsigmoid(float x) { return __builtin_amdgcn_rcpf(1.0f + __expf(-x)); }
__device__ __forceinline__ float fsilu(float x) { return x * fsigmoid(x); }
__device__ __forceinline__ size_t rowof(int b, int tt) { return tt < NMETA ? (size_t)(NTOK + tt) : (size_t)b * SEQ + (tt - NMETA); }
__host__ __device__ __forceinline__ int gu_slot(int j) { const int g = (j >> 3) & 3, p = ((g & 1) << 1) | (g >> 1); return (j & ~31) + 8 * p + (j & 7); }
__device__ __forceinline__ float wave_sum(float v) {
#pragma unroll
    for (int o = 1; o < 64; o <<= 1) v += __shfl_xor(v, o);
    return v;
}
__device__ __forceinline__ float wave_max(float v) {
#pragma unroll
    for (int o = 1; o < 64; o <<= 1) v = fmaxf(v, __shfl_xor(v, o));
    return v;
}
#define XB_TMO      128
#define XB_XCNT(j)  (256  + 64 * (j))
#define XB_XSUB(j)  (1280 + 64 * (j))
#define XB_XGEN(j)  (2304 + 64 * (j))
#define XB_TOP      3328
#define XB_TOPGEN   3392
#define XCD_BAR_WORDS 3456
#define XB_SPIN_CAP (1u << 18)

__device__ __forceinline__ unsigned xb_ld(unsigned* p)              { return __hip_atomic_load(p, __ATOMIC_RELAXED, __HIP_MEMORY_SCOPE_AGENT); }
__device__ __forceinline__ unsigned xb_add(unsigned* p, unsigned v) { return __hip_atomic_fetch_add(p, v, __ATOMIC_RELAXED, __HIP_MEMORY_SCOPE_AGENT); }
__device__ __forceinline__ unsigned xb_xcc_id() { return (unsigned)__builtin_amdgcn_s_getreg((3 << 11) | 20) & 0xFu; }
#define XB_SPIN(cond, bar) do { unsigned _sp = 0; while (cond) { __builtin_amdgcn_s_sleep(1); \
    if ((++_sp & 255u) == 0u) { if (xb_ld(&(bar)[XB_TMO])) break; if (_sp > XB_SPIN_CAP) { atomicAdd(&(bar)[XB_TMO], 1u); break; } } } } while (0)

struct XcdBarrier {
    unsigned* bar; unsigned x;
    volatile LAS unsigned* st;
};

__device__ __forceinline__ XcdBarrier xcd_barrier_post(unsigned* bar, volatile LAS unsigned* st) {
    XcdBarrier b; b.bar = bar; b.x = xb_xcc_id(); b.st = st;
    if (threadIdx.x == 0) (void)xb_add(&bar[XB_XCNT(b.x)], 1u);
    return b;
}
__device__ __forceinline__ void xcd_barrier_complete(unsigned* bar, unsigned x, unsigned& nloc, unsigned& nx) {
    const unsigned G = gridDim.x * gridDim.y * gridDim.z;
    unsigned sum, cnt, mine, sp = 0u;
    for (;;) {
        sum = 0u; cnt = 0u; mine = 0u;
#pragma unroll
        for (unsigned j = 0; j < 16; ++j) { const unsigned c = xb_ld(&bar[XB_XCNT(j)]); sum += c; cnt += (c > 0u) ? 1u : 0u; mine = (j == x) ? c : mine; }
        if (sum == G) break;
        __builtin_amdgcn_s_sleep(1);
        if ((++sp & 255u) == 0u) { if (xb_ld(&bar[XB_TMO])) break; if (sp > XB_SPIN_CAP) { atomicAdd(&bar[XB_TMO], 1u); break; } }
    }
    nloc = mine > 0u ? mine : 1u; nx = cnt > 0u ? cnt : 1u;
}

__device__ __forceinline__ void xcd_barrier(const XcdBarrier& b) {
    asm volatile("s_waitcnt vmcnt(0)" ::: "memory");
    __syncthreads();
    if (threadIdx.x == 0) {
        unsigned* bar = b.bar;
        __builtin_amdgcn_s_waitcnt(0);
        unsigned nloc = b.st[0], nx = b.st[1];
        if (nloc == 0u) { xcd_barrier_complete(bar, b.x, nloc, nx); b.st[0] = nloc; b.st[1] = nx; }
        const unsigned old = xb_add(&bar[XB_XSUB(b.x)], 1u);
        const unsigned gen = old / nloc;
        if (old + 1u == (gen + 1u) * nloc) {
            __builtin_amdgcn_fence(__ATOMIC_RELEASE, "agent");
            asm volatile("s_waitcnt vmcnt(0)" ::: "memory");
            const unsigned og = xb_add(&bar[XB_TOP], 1u);
            const unsigned tg = og / nx;
            if (og + 1u == (tg + 1u) * nx) xb_add(&bar[XB_TOPGEN], 1u);
            else XB_SPIN(xb_ld(&bar[XB_TOPGEN]) == tg, bar);
            __builtin_amdgcn_fence(__ATOMIC_ACQUIRE, "agent");
            xb_add(&bar[XB_XGEN(b.x)], 1u);
            asm volatile("s_waitcnt vmcnt(0)" ::: "memory");
        } else {
            XB_SPIN(xb_ld(&bar[XB_XGEN(b.x)]) == gen, bar);
            __builtin_amdgcn_fence(__ATOMIC_ACQUIRE, "agent");
            asm volatile("s_waitcnt vmcnt(0)" ::: "memory");
        }
    }
    __syncthreads();
}

struct Frame {
    LAS unsigned char* lds;
    volatile LAS unsigned* MISC;
    gu32* ctl;
    int tid, lane, wave, vcu, G;
    const float* in[25];
    float* out;
    unsigned char* ws;
};
#define IN_X 0
#define IN_META 1
#define IN_LBL 2
#define IN_NMIX 3
#define IN_WIN 4
#define IN_HGNORM 5
#define IN_CONVW 6
#define IN_CONVB 7
#define IN_WQ 8
#define IN_WK 9
#define IN_WV 10
#define IN_GATEB 11
#define IN_MLNORM 12
#define IN_MLSKIP 13
#define IN_WBH 14
#define IN_WBM 15
#define IN_WOUT 16
#define IN_NFFN 17
#define IN_RW 18
#define IN_RB 19
#define IN_WGU 20
#define IN_BGU 21
#define IN_WDN 22
#define IN_BDN 23
#define IN_NFIN 24

__device__ __forceinline__ void p0_item(const float* W, int ldw, int col0, int cstride, const float* kscale, bf16* WT, int K, int dstrow0, int k0, LAS float* scr, int lane, float gsc = 1.f, gu32* cmax = nullptr) {
    (void)cstride;
    const int r = lane >> 3, c4 = (lane & 7) * 4;
    f32x4 v[8];
#pragma unroll
    for (int i = 0; i < 8; ++i) v[i] = *(const GAS f32x4*)(W + (size_t)(k0 + 8 * i + r) * ldw + col0 + c4);
#pragma unroll
    for (int i = 0; i < 8; ++i) { const float sc = kscale ? kscale[k0 + 8 * i + r] : gsc; LAS float* s = scr + (8 * i + r) * 33 + c4; s[0] = v[i].x * sc; s[1] = v[i].y * sc; s[2] = v[i].z * sc; s[3] = v[i].w * sc; }
    LDS_WAIT(); asm volatile("" ::: "memory");
    const int c = lane & 7;
#pragma unroll
    for (int j = 0; j < 4; ++j) { const int n = (lane >> 3) + 8 * j; const LAS float* s = scr + (8 * c) * 33 + n;
        v4u o; o.x = pk2(s[0 * 33], s[1 * 33]); o.y = pk2(s[2 * 33], s[3 * 33]); o.z = pk2(s[4 * 33], s[5 * 33]); o.w = pk2(s[6 * 33], s[7 * 33]);
        if (cmax) { float m = fmaxf(fmaxf(fmaxf(fabsf(s[0 * 33]), fabsf(s[1 * 33])), fmaxf(fabsf(s[2 * 33]), fabsf(s[3 * 33]))), fmaxf(fmaxf(fabsf(s[4 * 33]), fabsf(s[5 * 33])), fmaxf(fabsf(s[6 * 33]), fabsf(s[7 * 33]))));
            m = fmaxf(m, __shfl_xor(m, 1)); m = fmaxf(m, __shfl_xor(m, 2)); m = fmaxf(m, __shfl_xor(m, 4));
            if (c == 0) (void)__hip_atomic_fetch_max(cmax + dstrow0 + n, __builtin_bit_cast(unsigned, m), RLX_AGENT); }
        *(GAS v4u*)(WT + (size_t)(dstrow0 + n) * K + k0 + 8 * c) = o; }
    LDS_WAIT(); asm volatile("" ::: "memory");
}
__device__ __forceinline__ void p0_prologue(Frame& F) {
    unsigned char* ws = F.ws;
    const int gw = F.vcu * NWAVES + F.wave, NGW = F.G * NWAVES, gt = F.vcu * NTHREADS + F.tid, NGT = F.G * NTHREADS;
    {
        LAS float* scr = (LAS float*)(F.lds + RING_OFF + F.wave * 16384);
        constexpr int I_IN1 = 16 * 96, I_IN2 = 16 * 64, I_BH = 8 * 32, I_OUT = 16 * 32;
        constexpr int NITEMS = I_IN1 + I_IN2 + 2 * I_BH + I_OUT;
        for (int it = gw; it < NITEMS; it += NGW) {
            int r = it;
            if (r < I_IN1) { const int kb = r / 96, nb = r % 96; p0_item(F.in[IN_WIN], NIN, 32 * nb, 1, F.in[IN_NMIX], (bf16*)(ws + WS_WIN), D, 32 * nb, 64 * kb, scr, F.lane, 1.f, F.ctl + CW_CMAX); continue; } r -= I_IN1;
            if (r < I_IN2) { const int kb = r / 64, nb = r % 64; p0_item(F.in[IN_WIN], NIN, 3080 + 32 * nb, 1, F.in[IN_NMIX], (bf16*)(ws + WS_WIN), D, 3072 + 32 * nb, 64 * kb, scr, F.lane, 1.f, F.ctl + CW_CMAX); continue; } r -= I_IN2;
            if (r < I_BH) { const int kb = r / 32, nb = r % 32; p0_item(F.in[IN_WBH], D, 32 * nb, 1, nullptr, (bf16*)(ws + WS_WBH), HW, 32 * nb, 64 * kb, scr, F.lane, 1.f / 255.f); continue; } r -= I_BH;
            if (r < I_BH) { const int kb = r / 32, nb = r % 32; p0_item(F.in[IN_WBM], D, 32 * nb, 1, nullptr, (bf16*)(ws + WS_WBM), HW, 32 * nb, 64 * kb, scr, F.lane, 1.f / 255.f); continue; } r -= I_BH;
            { const int kb = r / 32, nb = r % 32; p0_item(F.in[IN_WOUT], D, 32 * nb, 1, nullptr, (bf16*)(ws + WS_WOUT), D, 32 * nb, 64 * kb, scr, F.lane); }
        }
    }
    asm volatile("s_waitcnt vmcnt(0)" ::: "memory"); __syncthreads();
    if (F.tid == 0) (void)__hip_atomic_fetch_add(F.ctl + CW_P0ARR, 1u, RLX_AGENT);
    {
        LAS float* wm = (LAS float*)(F.lds + RING_OFF + 65536);
        { float wa[16], wb[16];
#pragma unroll
          for (int q = 0; q < 16; ++q) { const int u = F.tid + q * NTHREADS, j = u & 7, l = (u >> 3) & 63, i = u >> 9, k = 4 * l + 256 * (i >> 2) + (i & 3); wa[q] = F.in[IN_NMIX][k]; wb[q] = F.in[IN_WIN][(size_t)k * NIN + 3072 + j]; }
#pragma unroll
          for (int q = 0; q < 16; ++q) wm[F.tid + q * NTHREADS] = wa[q] * wb[q]; }
        __syncthreads();
        bf16* XN0 = (bf16*)(ws + WS_XN0); float* XSQ = (float*)(ws + WS_XSQ); unsigned char* XQ = ws + WS_XQ; float* SROW = (float*)(ws + WS_SROW); float* LI = (float*)(ws + WS_LI); float* LF = (float*)(ws + WS_LF);
        f32x4 vn[4];
#define P0_LOADROW(dst, V_) do { const int Vc_ = (V_) < NR ? (V_) : NR - 1; const float* src_ = (Vc_ >= NTOK) ? F.in[IN_META] + (size_t)(Vc_ - NTOK) * D : F.in[IN_X] + (size_t)Vc_ * D; \
        const GAS f32x4* xr_ = (const GAS f32x4*)src_ + F.lane; _Pragma("unroll") for (int j = 0; j < 4; ++j) dst[j] = __builtin_nontemporal_load(xr_ + 64 * j); } while (0)
        P0_LOADROW(vn, gw);
        for (int V = gw; V < NR; V += NGW) {
            f32x4 v[4]; float s = 0.f, am = 0.f;
#pragma unroll
            for (int j = 0; j < 4; ++j) { v[j] = vn[j]; s += (v[j].x * v[j].x + v[j].y * v[j].y) + (v[j].z * v[j].z + v[j].w * v[j].w); am = fmaxf(am, fmaxf(fmaxf(fabsf(v[j].x), fabsf(v[j].y)), fmaxf(fabsf(v[j].z), fabsf(v[j].w)))); }
            P0_LOADROW(vn, V + NGW);
            asm volatile("" ::: "memory");
            const float sq = sqrtf(wave_sum(s) * (1.f / D) + EPS), rs = 1.0f / sq;
            am = wave_max(am) * rs; const float srow = am > 0.f ? am * (1.f / 127.f) : 1.f, qi = 1.f / srow;
            if (F.lane == 0) { XSQ[V] = sq; SROW[V] = srow; }
            GAS unsigned* q4 = (GAS unsigned*)(XQ + (size_t)V * D) + F.lane;
            float g[8];
#pragma unroll
            for (int j = 0; j < 8; ++j) g[j] = 0.f;
            GAS unsigned long long* o8 = (GAS unsigned long long*)(XN0 + (size_t)V * D) + F.lane;
#pragma unroll
            for (int j = 0; j < 4; ++j) {
                v[j] = v[j] * rs;
                __builtin_nontemporal_store((unsigned long long)pk2(v[j].x, v[j].y) | ((unsigned long long)pk2(v[j].z, v[j].w) << 32), o8 + 64 * j);
                q4[64 * j] = ((unsigned)(int)rintf(v[j].x * qi) & 0xffu) | (((unsigned)(int)rintf(v[j].y * qi) & 0xffu) << 8) | (((unsigned)(int)rintf(v[j].z * qi) & 0xffu) << 16) | ((unsigned)(int)rintf(v[j].w * qi) << 24);
#pragma unroll
                for (int q = 0; q < 4; ++q) { const LAS f32x4* wp = (const LAS f32x4*)(wm + (((4 * j + q) * 64 + F.lane) * 8)); const f32x4 w0 = wp[0], w1 = wp[1]; const float xv = v[j][q];
                    g[0] += xv * w0.x; g[1] += xv * w0.y; g[2] += xv * w0.z; g[3] += xv * w0.w; g[4] += xv * w1.x; g[5] += xv * w1.y; g[6] += xv * w1.z; g[7] += xv * w1.w; }
            }
#pragma unroll
            for (int j = 0; j < 8; ++j) g[j] = wave_sum(g[j]);
            if (F.lane < 4) {
                const float gi = (F.lane == 0 ? g[0] : F.lane == 1 ? g[1] : F.lane == 2 ? g[2] : g[3]) + F.in[IN_GATEB][F.lane];
                const float gf = (F.lane == 0 ? g[4] : F.lane == 1 ? g[5] : F.lane == 2 ? g[6] : g[7]) + F.in[IN_GATEB][4 + F.lane];
                LI[(size_t)V * 4 + F.lane] = gi;
                LF[(size_t)V * 4 + F.lane] = fminf(gf, 0.f) - log1pf(__expf(-fabsf(gf)));
            }
        }
        __syncthreads();
    }
    { float* BGUP = (float*)(ws + WS_BGUP); float* RWT = (float*)(ws + WS_RWT);
      for (int u = gt; u < NE * 2 * DFF; u += NGT) { const int e = u >> 11, n = u & 2047, pn = n >> 8, bj = (n >> 7) & 1, j = gu_slot(n & 127); BGUP[u] = F.in[IN_BGU][(size_t)e * 2 * DFF + 2 * (128 * pn + j) + bj]; }
      for (int u = gt; u < NE * D; u += NGT) { const int e = u >> 10, k = u & 1023; RWT[u] = F.in[IN_NFFN][k] * F.in[IN_RW][(size_t)k * NE + e]; } }
}

__device__ __forceinline__ void p0b_quant(Frame& F) {
    unsigned char* ws = F.ws; const int gw = F.vcu * NWAVES + F.wave, NGW = F.G * NWAVES, lane = F.lane;
    LAS float* scr = (LAS float*)(F.lds + RING_OFF + F.wave * 16384);
    unsigned char* W8 = ws + WS_WIN8; float* SCOL = (float*)(ws + WS_SCOL); const float* W = F.in[IN_WIN]; const float* kscale = F.in[IN_NMIX];
    constexpr int I_IN1 = 16 * 96, I_IN2 = 16 * 64;
    const int r = lane >> 3, c4 = (lane & 7) * 4;
    __syncthreads();
    if (F.tid == 0) { unsigned sp = 0; while (__hip_atomic_load(F.ctl + CW_P0ARR, RLX_AGENT) < (unsigned)F.G) { __builtin_amdgcn_s_sleep(2); if (++sp > (1u << 22)) break; } }
    __syncthreads();
    for (int it = gw; it < I_IN1 + I_IN2; it += NGW) {
        int kb, nb, col0, dstrow0;
        if (it < I_IN1) { kb = it / 96; nb = it % 96; col0 = 32 * nb; dstrow0 = 32 * nb; } else { const int q = it - I_IN1; kb = q / 64; nb = q % 64; col0 = 3080 + 32 * nb; dstrow0 = 3072 + 32 * nb; }
        const int k0 = 64 * kb;
        f32x4 v[8];
#pragma unroll
        for (int i = 0; i < 8; ++i) v[i] = *(const GAS f32x4*)(W + (size_t)(k0 + 8 * i + r) * NIN + col0 + c4);
        float qs[4];
#pragma unroll
        for (int e = 0; e < 4; ++e) { const float m = __builtin_bit_cast(float, __hip_atomic_load(F.ctl + CW_CMAX + dstrow0 + c4 + e, RLX_AGENT)); qs[e] = 127.f / fmaxf(m, 1e-30f); }
        if (kb == 0 && lane < 8) {
#pragma unroll
            for (int e = 0; e < 4; ++e) SCOL[dstrow0 + c4 + e] = 1.f / qs[e]; }
#pragma unroll
        for (int i = 0; i < 8; ++i) { const float sc = kscale[k0 + 8 * i + r]; LAS float* s = scr + (8 * i + r) * 33 + c4; s[0] = rintf(v[i].x * sc * qs[0]); s[1] = rintf(v[i].y * sc * qs[1]); s[2] = rintf(v[i].z * sc * qs[2]); s[3] = rintf(v[i].w * sc * qs[3]); }
        LDS_WAIT(); asm volatile("" ::: "memory");
        const int c = lane & 7;
#pragma unroll
        for (int j = 0; j < 4; ++j) { const int n = (lane >> 3) + 8 * j; const LAS float* s = scr + (8 * c) * 33 + n;
            v2u o;
            o.x = ((unsigned)(int)s[0 * 33] & 0xffu) | (((unsigned)(int)s[1 * 33] & 0xffu) << 8) | (((unsigned)(int)s[2 * 33] & 0xffu) << 16) | ((unsigned)(int)s[3 * 33] << 24);
            o.y = ((unsigned)(int)s[4 * 33] & 0xffu) | (((unsigned)(int)s[5 * 33] & 0xffu) << 8) | (((unsigned)(int)s[6 * 33] & 0xffu) << 16) | ((unsigned)(int)s[7 * 33] << 24);
            *(GAS v2u*)(W8 + (size_t)(dstrow0 + n) * D + k0 + 8 * c) = o; }
        LDS_WAIT(); asm volatile("" ::: "memory");
    }
}

__device__ __forceinline__ unsigned pk4_fp8(float a, float b, float c, float d) { unsigned w = 0;
    a = __builtin_amdgcn_fmed3f(a, -448.f, 448.f); b = __builtin_amdgcn_fmed3f(b, -448.f, 448.f); c = __builtin_amdgcn_fmed3f(c, -448.f, 448.f); d = __builtin_amdgcn_fmed3f(d, -448.f, 448.f);
    w = __builtin_amdgcn_cvt_pk_fp8_f32(a, b, w, false); w = __builtin_amdgcn_cvt_pk_fp8_f32(c, d, w, true); return w; }
__device__ __forceinline__ void cvdn_load(const float* Wdn, int it, f32x4 (&v)[8], int lane) {
    const int e = it >> 9, kb = (it >> 5) & 15, nb = it & 31, r = lane >> 3, c4 = (lane & 7) * 4; const float* W = Wdn + (size_t)e * DFF * D;
#pragma unroll
    for (int i = 0; i < 8; ++i) v[i] = *(const GAS f32x4*)(W + (size_t)(64 * kb + 8 * i + r) * D + 32 * nb + c4);
}
__device__ __forceinline__ void cvdn_proc(unsigned char* WTdn, int it, const f32x4 (&v)[8], LAS float* scr, int lane) {
    const int e = it >> 9, kb = (it >> 5) & 15, nb = it & 31, r = lane >> 3, c4 = (lane & 7) * 4; unsigned char* WT = WTdn + (size_t)e * D * DFF;
#pragma unroll
    for (int i = 0; i < 8; ++i) { LAS float* s = scr + (8 * i + r) * 33 + c4; s[0] = v[i].x * 32.f; s[1] = v[i].y * 32.f; s[2] = v[i].z * 32.f; s[3] = v[i].w * 32.f; }
    LDS_WAIT(); asm volatile("" ::: "memory");
    const int c = lane & 7;
#pragma unroll
    for (int j = 0; j < 4; ++j) { const int n = (lane >> 3) + 8 * j; const LAS float* s = scr + (8 * c) * 33 + n;
        v2u o; o.x = pk4_fp8(s[0 * 33], s[1 * 33], s[2 * 33], s[3 * 33]); o.y = pk4_fp8(s[4 * 33], s[5 * 33], s[6 * 33], s[7 * 33]);
        const int cn = 32 * nb + n, rowp = (cn & ~255) + 128 * ((cn >> 3) & 1) + 32 * ((cn >> 6) & 3) + 8 * ((cn >> 4) & 3) + (cn & 7);
        *(GAS v2u*)(WT + (size_t)rowp * DFF + 64 * kb + 8 * c) = o; }
    LDS_WAIT(); asm volatile("" ::: "memory");
}
__device__ __forceinline__ void cvgu_load(const float* Wgu, const float* nffn, int it, f32x4 (&v)[8], float (&sc)[8], int lane) {
    const int e = it >> 10, kb = (it >> 5) & 31, nb = it & 31, r = lane >> 4, c4 = (lane & 15) * 4; const float* W = Wgu + (size_t)e * D * 2 * DFF;
#pragma unroll
    for (int i = 0; i < 8; ++i) { v[i] = *(const GAS f32x4*)(W + (size_t)(32 * kb + 4 * i + r) * (2 * DFF) + 64 * nb + c4); sc[i] = nffn[32 * kb + 4 * i + r] * 32.f; }
}
__device__ __forceinline__ void cvgu_proc(unsigned char* WTgu, int it, const f32x4 (&v)[8], const float (&sc)[8], LAS float* scr, int lane) {
    const int e = it >> 10, kb = (it >> 5) & 31, nb = it & 31, r = lane >> 4, c4 = (lane & 15) * 4, A0 = 32 * nb, k0 = 32 * kb; unsigned char* WT = WTgu + (size_t)e * 2 * DFF * D;
    LAS float* sg = scr; LAS float* su = scr + 32 * 33;
#pragma unroll
    for (int i = 0; i < 8; ++i) { const int o = (4 * i + r) * 33 + (c4 >> 1); sg[o] = v[i].x * sc[i]; su[o] = v[i].y * sc[i]; sg[o + 1] = v[i].z * sc[i]; su[o + 1] = v[i].w * sc[i]; }
    LDS_WAIT(); asm volatile("" ::: "memory");
    const int c = lane & 3;
#pragma unroll
    for (int j = 0; j < 4; ++j) { const int q = (lane >> 2) + 16 * j, isup = q >> 5, jj = q & 31, A = A0 + jj; const LAS float* s = scr + isup * 32 * 33 + (8 * c) * 33 + jj;
        v2u o; o.x = pk4_fp8(s[0 * 33], s[1 * 33], s[2 * 33], s[3 * 33]); o.y = pk4_fp8(s[4 * 33], s[5 * 33], s[6 * 33], s[7 * 33]);
        *(GAS v2u*)(WT + (size_t)(256 * (A >> 7) + 128 * isup + gu_slot(A & 127)) * D + k0 + 8 * c) = o; }
    LDS_WAIT(); asm volatile("" ::: "memory");
}
__device__ __forceinline__ void px_experts(Frame& F, int rank, int nwg) {
    unsigned char* ws = F.ws;
    LAS float* scr = (LAS float*)(F.lds + RING_OFF + F.wave * 16384);
    const int gw = rank * NWAVES + F.wave, NGW = nwg * NWAVES;
    { constexpr int NIT = NE * 1024; f32x4 v[8], vn[8]; float sc[8], sn[8]; int it = gw;
      if (it < NIT) cvgu_load(F.in[IN_WGU], F.in[IN_NFFN], it, v, sc, F.lane);
      while (it < NIT) { const int nx = it + NGW; if (nx < NIT) cvgu_load(F.in[IN_WGU], F.in[IN_NFFN], nx, vn, sn, F.lane);
          asm volatile("" ::: "memory");
          cvgu_proc((unsigned char*)(ws + WS_WGU), it, v, sc, scr, F.lane); asm volatile("" ::: "memory");
#pragma unroll
          for (int i = 0; i < 8; ++i) { v[i] = vn[i]; sc[i] = sn[i]; }
          it = nx; } }
    { constexpr int NIT = NE * 512; f32x4 v[8], vn[8]; int it = gw;
      if (it < NIT) cvdn_load(F.in[IN_WDN], it, v, F.lane);
      while (it < NIT) { const int nx = it + NGW; if (nx < NIT) cvdn_load(F.in[IN_WDN], nx, vn, F.lane);
          asm volatile("" ::: "memory");
          cvdn_proc((unsigned char*)(ws + WS_WDN), it, v, scr, F.lane); asm volatile("" ::: "memory");
#pragma unroll
          for (int i = 0; i < 8; ++i) v[i] = vn[i];
          it = nx; } }
}

namespace pg8 {
typedef unsigned v2u_t __attribute__((ext_vector_type(2)));
typedef float f32x2 __attribute__((ext_vector_type(2)));
__device__ __forceinline__ f32x2 sig2(f32x2 x) { const f32x2 t = x * (f32x2){-1.4426950408889634f, -1.4426950408889634f};
    const f32x2 d = (f32x2){__builtin_amdgcn_exp2f(t.x), __builtin_amdgcn_exp2f(t.y)} + (f32x2){1.f, 1.f}; return (f32x2){__builtin_amdgcn_rcpf(d.x), __builtin_amdgcn_rcpf(d.y)}; }
__device__ __forceinline__ u32x4 pack8(const f32x4& a, const f32x4& b) { u32x4 w; w.x = cvt_pk_bf16(a[0], a[1]); w.y = cvt_pk_bf16(a[2], a[3]); w.z = cvt_pk_bf16(b[0], b[1]); w.w = cvt_pk_bf16(b[2], b[3]); return w; }
__device__ __forceinline__ v2u_t pack8_fp8(const f32x4& a, const f32x4& b) { unsigned lo = 0, hi = 0;
    lo = __builtin_amdgcn_cvt_pk_fp8_f32(a[0], a[1], lo, false); lo = __builtin_amdgcn_cvt_pk_fp8_f32(a[2], a[3], lo, true);
    hi = __builtin_amdgcn_cvt_pk_fp8_f32(b[0], b[1], hi, false); hi = __builtin_amdgcn_cvt_pk_fp8_f32(b[2], b[3], hi, true); return (v2u_t){lo, hi}; }
__device__ __forceinline__ v2u_t pack8_fp8_sat(const f32x4& a, const f32x4& b) { f32x4 x, y;
#pragma unroll
    for (int i = 0; i < 4; ++i) { x[i] = __builtin_amdgcn_fmed3f(a[i], -448.f, 448.f); y[i] = __builtin_amdgcn_fmed3f(b[i], -448.f, 448.f); }
    return pack8_fp8(x, y); }
__device__ __forceinline__ void unpack8(const u32x4& w, f32x4& a, f32x4& b) { a = (f32x4){bflo(w.x), bfhi(w.x), bflo(w.y), bfhi(w.y)}; b = (f32x4){bflo(w.z), bfhi(w.z), bflo(w.w), bfhi(w.w)}; }
__host__ __device__ __forceinline__ int gate_pos(int c) { return (c & ~255) + ((((c >> 5) & 3) * 4 + ((c >> 3) & 3)) * 16) + (((c >> 7) & 1) * 8) + (c & 7); }
__device__ __forceinline__ unsigned q8x4(float a, float b, float c, float d) {
    const unsigned t0 = __builtin_bit_cast(unsigned, __builtin_fmaf(a, 255.f, 8388608.f)), t1 = __builtin_bit_cast(unsigned, __builtin_fmaf(b, 255.f, 8388608.f));
    const unsigned t2 = __builtin_bit_cast(unsigned, __builtin_fmaf(c, 255.f, 8388608.f)), t3 = __builtin_bit_cast(unsigned, __builtin_fmaf(d, 255.f, 8388608.f));
    return (t0 & 0xffu) | (t1 << 8) | (t2 << 16) | (t3 << 24); }
__device__ __forceinline__ f32x4 dq8x4(unsigned w) { return (f32x4){(float)(w & 0xffu), (float)((w >> 8) & 0xffu), (float)((w >> 16) & 0xffu), (float)(w >> 24)}; }
struct EpiNull { static constexpr bool PERM = true, AFTER_DRAIN = false; int* sink;
    __device__ __forceinline__ void operator()(const f32x4 (&acc)[2][2][4][2], const Unit& u, int wr, int wc, int fr, int fq) const { int s = 0;
#pragma unroll
        for (int a = 0; a < 2; ++a)
#pragma unroll
            for (int b = 0; b < 2; ++b)
#pragma unroll
                for (int m = 0; m < 4; ++m)
#pragma unroll
                    for (int n = 0; n < 2; ++n) { const i32x4 q = __builtin_bit_cast(i32x4, acc[a][b][m][n]); s += (q[0] ^ q[1]) + (q[2] ^ q[3]); }
        if (s == 0x7fffff01 + u.pm) sink[0] = s; } };
template <bool Q, bool NS = false>
struct EpiProjT {
    static constexpr bool PERM = true, AFTER_DRAIN = false;
    unsigned char* ws; const float* lbl; const float* srow; const float* scol;
    struct Sc { float rs[8]; f32x2 cs[2][4]; };
    __device__ __forceinline__ f32x2 val(const f32x4 (&acc)[2][2][4][2], const Sc& sc, int ai, int bj, int m, int k) const {
        const f32x4 a = acc[ai][bj][m][k >> 1];
        if constexpr (Q) { const i32x4 q = __builtin_bit_cast(i32x4, a); const float r = sc.rs[ai * 4 + m]; return ((f32x2){(float)q[2 * (k & 1)], (float)q[2 * (k & 1) + 1]} * sc.cs[bj][k]) * (f32x2){r, r}; }
        else return (f32x2){a[2 * (k & 1)], a[2 * (k & 1) + 1]};
    }
    template <int ACT>
    __device__ __forceinline__ void emit(const f32x4 (&acc)[2][2][4][2], const Sc& sc, bf16_t* O, int row0, int colt) const {
#pragma unroll
        for (int ai = 0; ai < 2; ++ai)
#pragma unroll
            for (int m = 0; m < 4; ++m) { bf16_t* rowp = O + (size_t)(row0 + ai * HALF + m * 16) * HW + colt;
#pragma unroll
                for (int bj = 0; bj < 2; ++bj) { u32x4 o;
#pragma unroll
                    for (int k = 0; k < 4; ++k) { f32x2 p = val(acc, sc, ai, bj, m, k);
                        if constexpr (ACT == 1) p = p * sig2(p); else if constexpr (ACT == 2) p = sig2(p);
                        o[k] = cvt_pk_bf16(p.x, p.y); }
                    if constexpr (NS) asm volatile("" :: "v"(o.x), "v"(o.y), "v"(o.z), "v"(o.w)); else *(u32x4*)(rowp + bj * HALF) = o; } }
    }
    __device__ __forceinline__ void operator()(const f32x4 (&acc)[2][2][4][2], const Unit& u, int wr, int wc, int fr, int fq) const {
        const int row0 = u.pm * BM + wr * 64 + fr, kind = u.pn < 12 ? (u.pn >> 1) : 6;
        const int colt = (u.pn < 12 ? (u.pn & 1) : (u.pn - 12)) * BM + wc * 32 + 8 * fq;
        Sc sc;
        if constexpr (Q) {
#pragma unroll
            for (int it = 0; it < 8; ++it) sc.rs[it] = srow[row0 + (it >> 2) * HALF + (it & 3) * 16];
#pragma unroll
            for (int bj = 0; bj < 2; ++bj) { const float* cp = scol + u.pn * BM + wc * 32 + 8 * fq + bj * HALF; const f32x4 c0 = *(const f32x4*)cp, c1 = *(const f32x4*)(cp + 4);
                sc.cs[bj][0] = (f32x2){c0[0], c0[1]}; sc.cs[bj][1] = (f32x2){c0[2], c0[3]}; sc.cs[bj][2] = (f32x2){c1[0], c1[1]}; sc.cs[bj][3] = (f32x2){c1[2], c1[3]}; }
        }
        if (kind == 1) {
            bf16_t* HG = (bf16_t*)(ws + WS_HG);
#pragma unroll
            for (int bj = 0; bj < 2; ++bj) { const int c = colt + bj * HALF; f32x2 lb[4], ol[4];
#pragma unroll
                for (int k = 0; k < 4; ++k) { lb[k] = sig2((f32x2){lbl[c + 2 * k] - lbl[HW + c + 2 * k], lbl[c + 2 * k + 1] - lbl[HW + c + 2 * k + 1]}); ol[k] = (f32x2){1.f, 1.f} - lb[k]; }
#pragma unroll
                for (int ai = 0; ai < 2; ++ai)
#pragma unroll
                    for (int m = 0; m < 4; ++m) { u32x4 o;
#pragma unroll
                        for (int k = 0; k < 4; ++k) { const f32x2 f = ol[k] * sig2(val(acc, sc, ai, bj, m, k)) + lb[k];
                            const f32x2 lg = (f32x2){__builtin_amdgcn_logf(f.x), __builtin_amdgcn_logf(f.y)} * (f32x2){0.6931471805599453f, 0.6931471805599453f}; o[k] = cvt_pk_bf16(lg.x, lg.y); }
                        if constexpr (NS) asm volatile("" :: "v"(o.x), "v"(o.y), "v"(o.z), "v"(o.w)); else *(u32x4*)(HG + (size_t)(row0 + ai * HALF + m * 16) * HW + c) = o; } }
            return;
        }
        if (kind == 6) {
            unsigned char* G8 = ws + WS_GATES; const int gofs = (u.pn - 12) * BM + (wc * 4 + fq) * 16;
#pragma unroll
            for (int ai = 0; ai < 2; ++ai)
#pragma unroll
                for (int m = 0; m < 4; ++m) { u32x4 o;
#pragma unroll
                    for (int bj = 0; bj < 2; ++bj)
#pragma unroll
                        for (int h = 0; h < 2; ++h) {
                            const f32x2 sa = sig2(val(acc, sc, ai, bj, m, 2 * h)), sb = sig2(val(acc, sc, ai, bj, m, 2 * h + 1));
                            o[2 * bj + h] = q8x4(sa.x, sa.y, sb.x, sb.y); }
                    if constexpr (NS) asm volatile("" :: "v"(o.x), "v"(o.y), "v"(o.z), "v"(o.w)); else __builtin_nontemporal_store(o, (u32x4*)(G8 + (size_t)(row0 + ai * HALF + m * 16) * 2048 + gofs)); }
            return;
        }
        if (kind == 0) emit<1>(acc, sc, (bf16_t*)(ws + WS_HQ), row0, colt); else if (kind == 2) emit<0>(acc, sc, (bf16_t*)(ws + WS_HV), row0, colt); else if (kind == 3) emit<1>(acc, sc, (bf16_t*)(ws + WS_HGATE), row0, colt);
        else if (kind == 4) emit<0>(acc, sc, (bf16_t*)(ws + WS_MM), row0, colt); else emit<2>(acc, sc, (bf16_t*)(ws + WS_MO), row0, colt);
    }
};
constexpr int PAIR_DA = 132, PAIR_DB = 4;
struct PairOrder { StaticOrder S;
    __device__ __forceinline__ bool next(int i, Unit& u) const { Unit t; if (!S.next(i >> 1, t)) return false; const int s = i & 1; u.pm = t.pm + PAIR_DA * s; u.pn = t.pn + PAIR_DB * s; return true; }
    __device__ __forceinline__ void a_ready(const Unit&) const {}
    __device__ __forceinline__ void done(const Unit&) const {}
};
struct EpiGate2 {
    static constexpr bool PERM = true, AFTER_DRAIN = false, CHAIN = true;
    const unsigned char* __restrict__ gates; bf16_t* __restrict__ merged;
    __device__ __forceinline__ bool chain(f32x4 (&acc)[2][2][4][2], const Unit& u, int wr, int wc, int fr, int fq) const {
        const int step = u.pm >= PAIR_DA ? 1 : 0, pm = u.pm - PAIR_DA * step, pn = u.pn - PAIR_DB * step;
        const int row0 = pm * BM + wr * 64 + fr, col0 = pn * BM + wc * 32 + 8 * fq, gofs = pn * BM + (wc * 4 + fq) * 16;
        constexpr int NB = 2, NBAT = 8 / NB;
        u32x4 g0c[NB], g1c[NB], g0n[NB], g1n[NB];
#define EG_LOAD(G0, G1, b_) do { _Pragma("unroll") for (int s_ = 0; s_ < NB; ++s_) { const int it_ = (b_) * NB + s_; const size_t row_ = (size_t)(row0 + (it_ >> 2) * HALF + (it_ & 3) * 16); \
        G1[s_] = *(const u32x4*)(gates + row_ * 2048 + D + gofs); if (!step) G0[s_] = *(const u32x4*)(gates + row_ * 2048 + gofs); else G0[s_] = (u32x4){0u, 0u, 0u, 0u}; } } while (0)
        EG_LOAD(g0c, g1c, 0);
#pragma unroll
        for (int b = 0; b < NBAT; ++b) {
            if (b + 1 < NBAT) EG_LOAD(g0n, g1n, b + 1);
#pragma unroll
            for (int s = 0; s < NB; ++s) { const int it = b * NB + s, ai = it >> 2, m = it & 3; const size_t row = (size_t)(row0 + ai * HALF + m * 16);
#pragma unroll
                for (int bj = 0; bj < 2; ++bj) {
                    f32x4 q1a = dq8x4(g1c[s][2 * bj]), q1b = dq8x4(g1c[s][2 * bj + 1]);
#pragma unroll
                    for (int i = 0; i < 4; ++i) { q1a[i] = fmaxf(q1a[i], 1.f); q1b[i] = fmaxf(q1b[i], 1.f); }
                    if (!step) { const f32x4 q0a = dq8x4(g0c[s][2 * bj]), q0b = dq8x4(g0c[s][2 * bj + 1]); f32x4 ra, rb;
#pragma unroll
                        for (int i = 0; i < 4; ++i) { ra[i] = q0a[i] * __builtin_amdgcn_rcpf(q1a[i]); rb[i] = q0b[i] * __builtin_amdgcn_rcpf(q1b[i]); }
                        acc[ai][bj][m][0] = acc[ai][bj][m][0] * ra; acc[ai][bj][m][1] = acc[ai][bj][m][1] * rb; }
                    else *(u32x4*)(merged + row * D + col0 + bj * HALF) = pack8(acc[ai][bj][m][0] * q1a, acc[ai][bj][m][1] * q1b); } }
#pragma unroll
            for (int s = 0; s < NB; ++s) { g0c[s] = g0n[s]; g1c[s] = g1n[s]; } }
#undef EG_LOAD
        return !step;
    }
};
struct EpiH1 {
    static constexpr bool PERM = true, AFTER_DRAIN = false;
    const bf16_t* __restrict__ xn0; const float* __restrict__ xsq; bf16_t* __restrict__ H1; unsigned char* __restrict__ H1B8;
    __device__ __forceinline__ void operator()(const f32x4 (&acc)[2][2][4][2], const Unit& u, int wr, int wc, int fr, int fq) const {
        const int row0 = u.pm * BM + wr * 64 + fr, col0 = u.pn * BM + wc * 32 + 8 * fq;
        u32x4 xc[2], xn[2]; float sc, sn;
#define EH_LOAD(X, S_, it_) do { const size_t r_ = (size_t)(row0 + ((it_) >> 2) * HALF + ((it_) & 3) * 16); const bf16_t* src_ = xn0 + r_ * D + col0; S_ = xsq[r_]; _Pragma("unroll") for (int bj = 0; bj < 2; ++bj) X[bj] = *(const u32x4*)(src_ + bj * HALF); } while (0)
        EH_LOAD(xc, sc, 0);
#pragma unroll
        for (int it = 0; it < 8; ++it) { const int ai = it >> 2, m = it & 3; const size_t V = (size_t)(row0 + ai * HALF + m * 16);
            if (it + 1 < 8) EH_LOAD(xn, sn, it + 1);
#pragma unroll
            for (int bj = 0; bj < 2; ++bj) { const int c = col0 + bj * HALF; f32x4 x0, x1; unpack8(xc[bj], x0, x1);
                const f32x4 v0 = x0 * sc + acc[ai][bj][m][0], v1 = x1 * sc + acc[ai][bj][m][1];
                __builtin_nontemporal_store(pack8(v0, v1), (u32x4*)(H1 + V * D + c)); *(v2u_t*)(H1B8 + V * D + c) = pack8_fp8_sat(v0, v1); }
#pragma unroll
            for (int bj = 0; bj < 2; ++bj) xc[bj] = xn[bj];
            sc = sn; }
#undef EH_LOAD
    }
};
template <bool NS = false>
struct EpiGUT {
    static constexpr bool PERM = true, AFTER_DRAIN = false;
    const float* __restrict__ bgup; const float* __restrict__ ers; unsigned char* __restrict__ act; const PG8_LAS int* pst;
    __device__ __forceinline__ void operator()(const f32x4 (&acc)[2][2][4][2], const Unit& u, int wr, int wc, int fr, int fq) const {
        const int e = u.pn >> 3, pn = u.pn & 7, row0 = u.pm * BM + wr * 64 + fr, cc = wc * 32 + 8 * fq;
        const float* rsp = ers + (size_t)e * NV + (row0 - pst[e]);
        const float* bp = bgup + (size_t)e * 2 * DFF + pn * BM + cc;
        f32x2 bg[2][2], bu[2][2];
#pragma unroll
        for (int h = 0; h < 2; ++h) { const f32x4 g4 = *(const f32x4*)(bp + 4 * h), u4 = *(const f32x4*)(bp + HALF + 4 * h);
            bg[h][0] = (f32x2){g4[0], g4[1]}; bg[h][1] = (f32x2){g4[2], g4[3]}; bu[h][0] = (f32x2){u4[0] + 1.f, u4[1] + 1.f}; bu[h][1] = (f32x2){u4[2] + 1.f, u4[3] + 1.f}; }
        float rsv[8];
#pragma unroll
        for (int it = 0; it < 8; ++it) rsv[it] = rsp[(it >> 2) * HALF + (it & 3) * 16];
        const int hi = fq >> 1;
        unsigned char* obase = act + (size_t)(row0 + 16 * hi) * DFF + pn * HALF + wc * 32 + 16 * (fq & 1);
        constexpr float KS = -1.702f * 1.4426950408889634f;
#pragma unroll
        for (int ai = 0; ai < 2; ++ai)
#pragma unroll
            for (int mp = 0; mp < 2; ++mp) { v2u_t pk[2];
#pragma unroll
                for (int q = 0; q < 2; ++q) { const int m = 2 * mp + q; const float rs = rsv[ai * 4 + m] * 0.03125f;
                    const f32x2 rs2 = {rs, rs}; unsigned w[2];
#pragma unroll
                    for (int h = 0; h < 2; ++h) { f32x2 o[2];
#pragma unroll
                        for (int p = 0; p < 2; ++p) {
                            f32x2 g = (f32x2){acc[ai][0][m][h][2 * p], acc[ai][0][m][h][2 * p + 1]} * rs2 + bg[h][p];
                            f32x2 u1 = (f32x2){acc[ai][1][m][h][2 * p], acc[ai][1][m][h][2 * p + 1]} * rs2 + bu[h][p];
                            g.x = fminf(g.x, 7.f); g.y = fminf(g.y, 7.f); u1.x = __builtin_amdgcn_fmed3f(u1.x, -6.f, 8.f); u1.y = __builtin_amdgcn_fmed3f(u1.y, -6.f, 8.f);
                            const f32x2 t = g * (f32x2){KS, KS};
                            const f32x2 d = (f32x2){__builtin_amdgcn_exp2f(t.x), __builtin_amdgcn_exp2f(t.y)} + (f32x2){1.f, 1.f};
                            const f32x2 r = {__builtin_amdgcn_rcpf(d.x), __builtin_amdgcn_rcpf(d.y)};
                            o[p] = (g * r) * u1; }
                        w[h] = __builtin_amdgcn_cvt_pk_fp8_f32(o[0].x, o[0].y, 0u, false); w[h] = __builtin_amdgcn_cvt_pk_fp8_f32(o[1].x, o[1].y, w[h], true); }
                    pk[q] = (v2u_t){w[0], w[1]}; }
                const auto r0 = __builtin_amdgcn_permlane32_swap(pk[0][0], pk[1][0], false, false), r1 = __builtin_amdgcn_permlane32_swap(pk[0][1], pk[1][1], false, false);
                if constexpr (NS) asm volatile("" :: "v"(r0[0]), "v"(r1[0]), "v"(r0[1]), "v"(r1[1])); else *(u32x4*)(obase + (size_t)(ai * HALF + mp * 32) * DFF) = (u32x4){r0[0], r1[0], r0[1], r1[1]}; }
    }
};
template <bool NS = false>
struct EpiDownT {
    static constexpr bool PERM = true, AFTER_DRAIN = false;
    const float* __restrict__ bdn; const float* __restrict__ ew; unsigned char* __restrict__ yb; const PG8_LAS int* pst;
    __device__ __forceinline__ void operator()(const f32x4 (&acc)[2][2][4][2], const Unit& u, int wr, int wc, int fr, int fq) const {
        const int e = u.pn >> 2, pn = u.pn & 3, row0 = u.pm * BM + wr * 64 + fr, col0 = pn * BM + wc * 64 + 16 * fq;
        const float* wp = ew + (size_t)e * NV + (row0 - pst[e]);
        f32x4 bv[2][2];
#pragma unroll
        for (int bj = 0; bj < 2; ++bj) { bv[bj][0] = *(const f32x4*)(bdn + (size_t)e * D + col0 + 8 * bj); bv[bj][1] = *(const f32x4*)(bdn + (size_t)e * D + col0 + 8 * bj + 4); }
        float wv[8];
#pragma unroll
        for (int it = 0; it < 8; ++it) wv[it] = wp[(it >> 2) * HALF + (it & 3) * 16];
#pragma unroll
        for (int ai = 0; ai < 2; ++ai)
#pragma unroll
            for (int m = 0; m < 4; ++m) { const size_t row = (size_t)(row0 + ai * HALF + m * 16); const float w = wv[ai * 4 + m] * 16.f;
                const v2u_t lo = pack8_fp8_sat((acc[ai][0][m][0] * 0.03125f + bv[0][0]) * w, (acc[ai][0][m][1] * 0.03125f + bv[0][1]) * w), hi = pack8_fp8_sat((acc[ai][1][m][0] * 0.03125f + bv[1][0]) * w, (acc[ai][1][m][1] * 0.03125f + bv[1][1]) * w);
                if constexpr (NS) asm volatile("" :: "v"(lo[0]), "v"(lo[1]), "v"(hi[0]), "v"(hi[1])); else __builtin_nontemporal_store((u32x4){lo[0], lo[1], hi[0], hi[1]}, (u32x4*)(yb + row * D + col0)); }
    }
};
struct GroupOrder {
    int ntiles, ncol, G, c; const PG8_LAS unsigned char* texp;
    __device__ __forceinline__ bool next(int i, Unit& u) const { const int x = c & 7, w = c >> 3, uu = i * (G >> 3) + w, lj = uu / ncol, pn = uu - lj * ncol, j = lj * 8 + x; if (j >= ntiles) return false; u.pm = j; u.pn = (int)texp[j] * ncol + pn; return true; }
    __device__ __forceinline__ void a_ready(const Unit&) const {}
    __device__ __forceinline__ void done(const Unit&) const {}
};
typedef EpiDownT<false> EpiDown; typedef EpiGUT<false> EpiGU;
}

typedef short bf16x8 __attribute__((ext_vector_type(8)));
typedef float f32x16 __attribute__((ext_vector_type(16)));
#define MFMA32(a, b, c) __builtin_amdgcn_mfma_f32_32x32x16_bf16(a, b, c, 0, 0, 0)
__device__ __forceinline__ bf16x8 ldfrag(const LAS unsigned char* base, int st, int row0, int k0, int lane) { return *(const LAS bf16x8*)(base + (row0 + (lane & 31)) * st + (k0 + 8 * (lane >> 5)) * 2); }
__device__ __forceinline__ bf16x8 ldf(const LAS unsigned char* lanebase, int off) { return *(const LAS bf16x8*)(lanebase + off); }
__device__ __forceinline__ float fexp(float x) { return __builtin_amdgcn_exp2f(x * 1.4426950408889634f); }

__device__ __forceinline__ void p3_hgrn2_mfma(Frame& F, int bh) {
    unsigned char* ws = F.ws; const int b = bh >> 2, h = bh & 3, tid = F.tid, lane = F.lane, wave = F.wave, hh = lane >> 5, l31 = lane & 31;
    const bf16* HQ = (const bf16*)(ws + WS_HQ) + h * 128; const bf16* HG = (const bf16*)(ws + WS_HG) + h * 128; const bf16* HV = (const bf16*)(ws + WS_HV) + h * 128;
    const bf16* HGATE = (const bf16*)(ws + WS_HGATE) + h * 128; bf16* YHG = (bf16*)(ws + WS_YHG) + h * 128;
    LAS unsigned char* L = F.lds + RING_OFF;
    LAS unsigned char* QT = L; LAS unsigned char* KT = L + 17408; LAS unsigned char* KTT = L + 34816; LAS unsigned char* VT = L + 53248; LAS unsigned char* ST = L + 71680; LAS unsigned char* PP = L + 106496;
    LAS float* SEG = (LAS float*)(L + 115712); LAS float* ER = (LAS float*)(L + 117760); LAS float* EL = (LAS float*)(L + 118272); LAS float* OST = (LAS float*)(L + 17408);
    const int d = tid & 127, pq = tid >> 7;
    const int et = tid >> 3, evq = tid & 7;
    const int f144 = l31 * 144 + hh * 16, f272 = l31 * 272 + hh * 16;
    const int sst = wave == 2 ? 1 : 0, stt = wave == 0 ? 0 : 1, dt = wave & 3, vt0 = 2 * (wave >> 2), btt = wave & 1, bvt = wave >> 1;
    const LAS unsigned char* aK = KT + 32 * sst * 272 + f272; const LAS unsigned char* bQ = QT + 32 * stt * 272 + f272;
    LAS unsigned char* pst = PP + (32 * stt + l31) * 144 + (32 * sst + 4 * hh) * 2;
    const LAS unsigned char* aKTT = KTT + 32 * dt * 144 + f144; const LAS unsigned char* bV0 = VT + 32 * vt0 * 144 + f144;
    LAS unsigned char* sst_ = ST + (32 * vt0 + l31) * 272 + (32 * dt + 4 * hh) * 2;
    const LAS float* erp = ER + 32 * dt + 4 * hh; const LAS float* elp = EL + 32 * dt + 4 * hh;
    const LAS unsigned char* aP = PP + 32 * btt * 144 + f144; const LAS unsigned char* bVB = VT + 32 * bvt * 144 + f144;
    const LAS unsigned char* aQ = QT + 32 * btt * 272 + f272; const LAS unsigned char* bS = ST + 32 * bvt * 272 + f272;
    LAS float* ost = OST + (32 * btt + 4 * hh) * 132 + 32 * bvt + l31; const LAS float* oep = OST + et * 132 + 16 * evq;
    LAS unsigned char* tq = QT + 16 * pq * 272 + d * 2; LAS unsigned char* tk = KT + 16 * pq * 272 + d * 2; LAS unsigned char* tkt = KTT + d * 144 + pq * 32; LAS unsigned char* tv = VT + d * 144 + pq * 32;
    f32x16 S0, S1;
#pragma unroll
    for (int i = 0; i < 16; ++i) { S0[i] = 0.f; S1[i] = 0.f; }
    unsigned gr[16], qr[16], vr[16]; v4u gt0, gt1;
    float gn[16];
#pragma unroll
    for (int i = 0; i < 16; ++i) gn[i] = F.in[IN_HGNORM][h * 128 + 16 * evq + i];
#define HG_LOAD(c) do { const int ttb = 64 * (c) - 48 + 16 * pq; \
        _Pragma("unroll") for (int i = 0; i < 16; ++i) { const int tt = ttb + i; if (tt >= 0) { const size_t gi = rowof(b, tt) * HW + d; gr[i] = (unsigned)HG[gi]; qr[i] = (unsigned)HQ[gi]; vr[i] = (unsigned)HV[gi]; } else { gr[i] = 0u; qr[i] = 0u; vr[i] = 0u; } } \
        { const int tt = 64 * (c) - 48 + et; if (tt >= 0) { const GAS v4u* gp = (const GAS v4u*)(HGATE + rowof(b, tt) * HW + 16 * evq); gt0 = gp[0]; gt1 = gp[1]; } else { gt0 = (v4u){0u, 0u, 0u, 0u}; gt1 = gt0; } } } while (0)
    HG_LOAD(0);
    for (int c = 0; c < 33; ++c) {
        float bl[16], gq[16];
#pragma unroll
        for (int i = 0; i < 16; ++i) gq[i] = __builtin_bit_cast(float, gr[i] << 16);
        { float a = 0.f;
#pragma unroll
          for (int i = 0; i < 16; ++i) { a += gq[i]; bl[i] = a; } }
        SEG[pq * 128 + d] = bl[15];
        __syncthreads();
        { const float s0 = SEG[d], s1 = SEG[128 + d], s2 = SEG[256 + d], s3 = SEG[384 + d];
          const float off = pq == 0 ? 0.f : pq == 1 ? s0 : pq == 2 ? s0 + s1 : (s0 + s1) + s2, r = s0 + s1, blast = (s0 + s1) + (s2 + s3);
          unsigned kp[8], vp[8];
#pragma unroll
          for (int i = 0; i < 16; i += 2) {
              const float b0 = off + bl[i], b1 = off + bl[i + 1];
              const float q0 = __builtin_bit_cast(float, qr[i] << 16) * fexp(b0 - r), q1 = __builtin_bit_cast(float, qr[i + 1] << 16) * fexp(b1 - r);
              const float k0 = (1.f - fexp(gq[i])) * fexp(r - b0), k1 = (1.f - fexp(gq[i + 1])) * fexp(r - b1);
              const unsigned kk = pg8::cvt_pk_bf16(k0, k1), qq = pg8::cvt_pk_bf16(q0, q1);
              *(LAS unsigned short*)(tq + i * 272) = (unsigned short)qq; *(LAS unsigned short*)(tq + (i + 1) * 272) = (unsigned short)(qq >> 16);
              *(LAS unsigned short*)(tk + i * 272) = (unsigned short)kk; *(LAS unsigned short*)(tk + (i + 1) * 272) = (unsigned short)(kk >> 16);
              kp[i >> 1] = kk; vp[i >> 1] = vr[i] | (vr[i + 1] << 16); }
          *(LAS v4u*)(tkt) = (v4u){kp[0], kp[1], kp[2], kp[3]}; *(LAS v4u*)(tkt + 16) = (v4u){kp[4], kp[5], kp[6], kp[7]};
          *(LAS v4u*)(tv) = (v4u){vp[0], vp[1], vp[2], vp[3]}; *(LAS v4u*)(tv + 16) = (v4u){vp[4], vp[5], vp[6], vp[7]};
          if (pq == 0) { ER[d] = fexp(r); EL[d] = fexp(blast - r); } }
        const v4u g0 = gt0, g1 = gt1;
        __syncthreads();
        if (c + 1 < 33) HG_LOAD(c + 1);
        asm volatile("" ::: "memory");
        if (wave < 3) {
            f32x16 acc;
#pragma unroll
            for (int i = 0; i < 16; ++i) acc[i] = 0.f;
#pragma unroll
            for (int ks = 0; ks < 8; ++ks) acc = MFMA32(ldf(aK, 32 * ks), ldf(bQ, 32 * ks), acc);
            const int t = 32 * stt + l31;
#pragma unroll
            for (int g4 = 0; g4 < 4; ++g4) { const int s0 = 32 * sst + 8 * g4 + 4 * hh;
                const float x0 = (s0 + 0 <= t) ? acc[4 * g4 + 0] : 0.f, x1 = (s0 + 1 <= t) ? acc[4 * g4 + 1] : 0.f, x2 = (s0 + 2 <= t) ? acc[4 * g4 + 2] : 0.f, x3 = (s0 + 3 <= t) ? acc[4 * g4 + 3] : 0.f;
                *(LAS v2u*)(pst + 16 * g4) = (v2u){pg8::cvt_pk_bf16(x0, x1), pg8::cvt_pk_bf16(x2, x3)}; }
        }
        {
#pragma unroll
          for (int g4 = 0; g4 < 4; ++g4) { const f32x4 er = *(const LAS f32x4*)(erp + 8 * g4);
#pragma unroll
              for (int i = 0; i < 4; ++i) { S0[4 * g4 + i] *= er[i]; S1[4 * g4 + i] *= er[i]; }
              *(LAS v2u*)(sst_ + 16 * g4) = (v2u){pg8::cvt_pk_bf16(S0[4 * g4], S0[4 * g4 + 1]), pg8::cvt_pk_bf16(S0[4 * g4 + 2], S0[4 * g4 + 3])};
              *(LAS v2u*)(sst_ + 32 * 272 + 16 * g4) = (v2u){pg8::cvt_pk_bf16(S1[4 * g4], S1[4 * g4 + 1]), pg8::cvt_pk_bf16(S1[4 * g4 + 2], S1[4 * g4 + 3])}; }
#pragma unroll
          for (int ks = 0; ks < 4; ++ks) { const bf16x8 a = ldf(aKTT, 32 * ks); S0 = MFMA32(a, ldf(bV0, 32 * ks), S0); S1 = MFMA32(a, ldf(bV0, 32 * 144 + 32 * ks), S1); }
#pragma unroll
          for (int g4 = 0; g4 < 4; ++g4) { const f32x4 el = *(const LAS f32x4*)(elp + 8 * g4);
#pragma unroll
              for (int i = 0; i < 4; ++i) { S0[4 * g4 + i] *= el[i]; S1[4 * g4 + i] *= el[i]; } } }
        __syncthreads();
        { f32x16 acc;
#pragma unroll
          for (int i = 0; i < 16; ++i) acc[i] = 0.f;
#pragma unroll
          for (int ks = 0; ks < 4; ++ks) if (ks < 2 || btt == 1) acc = MFMA32(ldf(aP, 32 * ks), ldf(bVB, 32 * ks), acc);
#pragma unroll
          for (int ks = 0; ks < 8; ++ks) acc = MFMA32(ldf(aQ, 32 * ks), ldf(bS, 32 * ks), acc);
#pragma unroll
          for (int i = 0; i < 16; ++i) ost[((i & 3) + 8 * (i >> 2)) * 132] = acc[i]; }
        __syncthreads();
        { const int tt = 64 * c - 48 + et;
          f32x4 o[4]; float ss = 0.f;
#pragma unroll
          for (int j = 0; j < 4; ++j) { o[j] = *(const LAS f32x4*)(oep + 4 * j); ss += (o[j].x * o[j].x + o[j].y * o[j].y) + (o[j].z * o[j].z + o[j].w * o[j].w); }
          ss += __shfl_xor(ss, 1); ss += __shfl_xor(ss, 2); ss += __shfl_xor(ss, 4);
          const float rs = 1.0f / sqrtf(ss * (1.f / 128.f) + EPS);
          if (tt >= NMETA || (tt >= 0 && b == 0)) { const unsigned gw[8] = {g0.x, g0.y, g0.z, g0.w, g1.x, g1.y, g1.z, g1.w}; unsigned w[8];
#pragma unroll
              for (int j = 0; j < 4; ++j) { w[2 * j] = pk2(o[j].x * rs * gn[4 * j] * bflo(gw[2 * j]), o[j].y * rs * gn[4 * j + 1] * bfhi(gw[2 * j])); w[2 * j + 1] = pk2(o[j].z * rs * gn[4 * j + 2] * bflo(gw[2 * j + 1]), o[j].w * rs * gn[4 * j + 3] * bfhi(gw[2 * j + 1])); }
              GAS v4u* yp = (GAS v4u*)(YHG + rowof(b, tt) * HW + 16 * evq); yp[0] = (v4u){w[0], w[1], w[2], w[3]}; yp[1] = (v4u){w[4], w[5], w[6], w[7]}; } }
        __syncthreads();
    }
#undef HG_LOAD
}


#define DPP_F(old, v, ctrl, rmask) __builtin_bit_cast(float, __builtin_amdgcn_update_dpp(__builtin_bit_cast(int, (float)(old)), __builtin_bit_cast(int, (float)(v)), (ctrl), (rmask), 0xf, false))
__device__ __forceinline__ float wave_scan_add(float v) {
    v += DPP_F(0.f, v, 0x111, 0xf); v += DPP_F(0.f, v, 0x112, 0xf); v += DPP_F(0.f, v, 0x114, 0xf); v += DPP_F(0.f, v, 0x118, 0xf);
    v += DPP_F(0.f, v, 0x142, 0xa); v += DPP_F(0.f, v, 0x143, 0xc); return v;
}
__device__ __forceinline__ float wave_scan_max(float v) {
    const float ni = -INFINITY;
    v = fmaxf(v, DPP_F(ni, v, 0x111, 0xf)); v = fmaxf(v, DPP_F(ni, v, 0x112, 0xf)); v = fmaxf(v, DPP_F(ni, v, 0x114, 0xf)); v = fmaxf(v, DPP_F(ni, v, 0x118, 0xf));
    v = fmaxf(v, DPP_F(ni, v, 0x142, 0xa)); v = fmaxf(v, DPP_F(ni, v, 0x143, 0xc)); return v;
}
__device__ __forceinline__ void p3_mlstm_mfma(Frame& F, int bh) {
    unsigned char* ws = F.ws; const int b = bh >> 2, h = bh & 3, tid = F.tid, lane = F.lane, wave = F.wave, hh = lane >> 5, l31 = lane & 31;
    const bf16* MMg = (const bf16*)(ws + WS_MM) + h * 128; const bf16* MOg = (const bf16*)(ws + WS_MO) + h * 128; const float* LI = (const float*)(ws + WS_LI) + h; const float* LF = (const float*)(ws + WS_LF) + h;
    bf16* YML = (bf16*)(ws + WS_YML) + h * 128;
    LAS unsigned char* L = F.lds + RING_OFF;
    LAS unsigned char* CT = L; LAS unsigned char* MT = L + 17408; LAS unsigned char* KM = L + 34816; LAS unsigned char* KW = L + 44032; LAS unsigned char* QM = L + 53248; LAS unsigned char* QW = L + 62464;
    LAS unsigned char* VT = L + 71680; LAS unsigned char* SV = L + 90112; LAS unsigned char* PP = L + 108544; LAS float* OST = (LAS float*)(L + 17408);
    LAS float* SM = (LAS float*)(L + 117760);
    LAS float* U = SM; LAS float* MX = SM + 64; LAS float* BB = SM + 128; LAS float* WSs = SM + 192; LAS float* WI = SM + 256; LAS float* DENP = SM + 320  ; LAS float* NN = SM + 416; LAS float* DENI = SM + 480; LAS float* SC = SM + 544  ; LAS float* GNS = SM + 560  ;
    const int ch = tid & 127, pq = tid >> 7, et = tid >> 3, evq = tid & 7;
    const int f144 = l31 * 144 + hh * 16, f272 = l31 * 272 + hh * 16;
    const int sst = wave == 2 ? 1 : 0, stt = wave == 0 ? 0 : 1, dkt = wave & 1, svt = wave >> 1;
    const LAS unsigned char* cfp = (wave < 4 ? CT : MT) + f272;
    LAS unsigned char* qst = QM + l31 * 144 + (32 * (wave & 1) + 4 * hh) * 2; LAS unsigned char* qwst = QW + l31 * 144 + (32 * (wave & 1) + 4 * hh) * 2;
    const int kdk = 32 * (wave & 1) + l31;
    LAS unsigned char* kmst = KM + 4 * hh * 144 + kdk * 2; LAS unsigned char* kwst = KW + kdk * 144 + 4 * hh * 2; const LAS float* wsp = WSs + 4 * hh;
    LAS unsigned char* vst = VT + (32 * (wave & 3) + l31) * 144 + 4 * hh * 2;
    const LAS unsigned char* aKM = KM + 32 * sst * 144 + f144; const LAS unsigned char* bQM = QM + 32 * stt * 144 + f144;
    LAS unsigned char* pst = PP + (32 * stt + l31) * 144 + (32 * sst + 4 * hh) * 2; const LAS float* up = U + 32 * sst + 4 * hh;
    LAS unsigned char* svst = SV + (32 * svt + l31) * 144 + (32 * dkt + 4 * hh) * 2;
    const LAS unsigned char* aKW = KW + 32 * dkt * 144 + f144; const LAS unsigned char* bVT = VT + 32 * svt * 144 + f144;
    const LAS unsigned char* aP = PP + 32 * dkt * 144 + f144; const LAS unsigned char* aQW = QW + 32 * dkt * 144 + f144; const LAS unsigned char* bSV = SV + 32 * svt * 144 + f144;
    LAS float* ost = OST + (32 * dkt + 4 * hh) * 132 + 32 * svt + l31; const LAS float* oep = OST + et * 132 + 16 * evq;
    LAS unsigned char* tc = CT + 16 * pq * 272 + ch * 2; LAS unsigned char* tm = MT + 16 * pq * 272 + ch * 2;
    bf16x8 wf[8];
    { const float* W = wave < 2 ? F.in[IN_WQ] + (size_t)h * 128 * 64 + 32 * wave + l31 : wave < 4 ? F.in[IN_WK] + (size_t)h * 128 * 64 + 32 * (wave - 2) + l31 : F.in[IN_WV] + (size_t)h * 128 * 128 + 32 * (wave - 4) + l31;
      const int ld = wave < 4 ? 64 : 128; const float sc = wave < 2 ? 0.125f : 1.f;
#pragma unroll
      for (int ks = 0; ks < 8; ++ks) { unsigned p[4];
#pragma unroll
          for (int j = 0; j < 4; ++j) p[j] = pk2(W[(size_t)(16 * ks + 8 * hh + 2 * j) * ld] * sc, W[(size_t)(16 * ks + 8 * hh + 2 * j + 1) * ld] * sc);
          wf[ks] = __builtin_bit_cast(bf16x8, (v4u){p[0], p[1], p[2], p[3]}); } }
    float cw[4]; const float cb = F.in[IN_CONVB][h * 128 + ch];
#pragma unroll
    for (int j = 0; j < 4; ++j) cw[j] = F.in[IN_CONVW][j * HW + h * 128 + ch];
    if (tid < 128) GNS[tid] = F.in[IN_MLNORM][h * 128 + tid]; else if (tid < 256) GNS[tid] = F.in[IN_MLSKIP][h * 128 + tid - 128];
    f32x16 S;
#pragma unroll
    for (int i = 0; i < 16; ++i) S[i] = 0.f;
    float mcar = 0.f, nreg = 0.f;
    unsigned mr[19]; v4u gt0, gt1; float pli = 0.f, plf = 0.f;
#define ML_LOAD(c) do { const int ttb = 64 * (c) - 48 + 16 * pq - 3; \
        _Pragma("unroll") for (int i = 0; i < 19; ++i) { const int tt = ttb + i; mr[i] = tt >= 0 ? (unsigned)MMg[rowof(b, tt) * HW + ch] : 0u; } \
        { const int tt = 64 * (c) - 48 + et; if (tt >= 0) { const GAS v4u* gp = (const GAS v4u*)(MOg + rowof(b, tt) * HW + 16 * evq); gt0 = gp[0]; gt1 = gp[1]; } else { gt0 = (v4u){0u, 0u, 0u, 0u}; gt1 = gt0; } } \
        if (wave == 0) { const int tt = 64 * (c) - 48 + lane; if (tt >= 0) { pli = LI[rowof(b, tt) * 4]; plf = LF[rowof(b, tt) * 4]; } else { pli = -1e30f; plf = 0.f; } } } while (0)
    ML_LOAD(0);
    for (int c = 0; c < 33; ++c) {
#pragma unroll
        for (int i = 0; i < 16; ++i) { const float a = cb + (cw[0] * __builtin_bit_cast(float, mr[i] << 16) + cw[1] * __builtin_bit_cast(float, mr[i + 1] << 16)) + (cw[2] * __builtin_bit_cast(float, mr[i + 2] << 16) + cw[3] * __builtin_bit_cast(float, mr[i + 3] << 16));
            *(LAS unsigned short*)(tc + i * 272) = (unsigned short)f2bf(fsilu(a)); *(LAS unsigned short*)(tm + i * 272) = (unsigned short)mr[i + 3]; }
        if (wave == 0) {
            const float bs = wave_scan_add(plf);
            const float u = pli - bs; const float pm = wave_scan_max(u);
            const float M = fmaxf(mcar, pm), M63 = __shfl(M, 63), b63 = __shfl(bs, 63);
            U[lane] = u; MX[lane] = M; BB[lane] = bs; WSs[lane] = fexp(u - M63); WI[lane] = fexp(mcar - M);
            if (lane == 0) { SC[0] = b63; SC[1] = M63; }
        }
        __syncthreads();
        { f32x16 a0, a1;
#pragma unroll
          for (int i = 0; i < 16; ++i) { a0[i] = 0.f; a1[i] = 0.f; }
          if (wave < 2) {
#pragma unroll
              for (int ks = 0; ks < 8; ++ks) { a0 = MFMA32(wf[ks], ldf(cfp, 32 * ks), a0); a1 = MFMA32(wf[ks], ldf(cfp, 32 * 272 + 32 * ks), a1); }
              const float wi0 = WI[l31], wi1 = WI[32 + l31];
#pragma unroll
              for (int g4 = 0; g4 < 4; ++g4) {
                  *(LAS v2u*)(qst + 16 * g4) = (v2u){pg8::cvt_pk_bf16(a0[4 * g4], a0[4 * g4 + 1]), pg8::cvt_pk_bf16(a0[4 * g4 + 2], a0[4 * g4 + 3])};
                  *(LAS v2u*)(qst + 32 * 144 + 16 * g4) = (v2u){pg8::cvt_pk_bf16(a1[4 * g4], a1[4 * g4 + 1]), pg8::cvt_pk_bf16(a1[4 * g4 + 2], a1[4 * g4 + 3])};
                  *(LAS v2u*)(qwst + 16 * g4) = (v2u){pg8::cvt_pk_bf16(a0[4 * g4] * wi0, a0[4 * g4 + 1] * wi0), pg8::cvt_pk_bf16(a0[4 * g4 + 2] * wi0, a0[4 * g4 + 3] * wi0)};
                  *(LAS v2u*)(qwst + 32 * 144 + 16 * g4) = (v2u){pg8::cvt_pk_bf16(a1[4 * g4] * wi1, a1[4 * g4 + 1] * wi1), pg8::cvt_pk_bf16(a1[4 * g4 + 2] * wi1, a1[4 * g4 + 3] * wi1)}; }
          } else {
#pragma unroll
              for (int ks = 0; ks < 8; ++ks) { a0 = MFMA32(ldf(cfp, 32 * ks), wf[ks], a0); a1 = MFMA32(ldf(cfp, 32 * 272 + 32 * ks), wf[ks], a1); }
              if (wave < 4) {
                  float nsum = 0.f;
#pragma unroll
                  for (int g4 = 0; g4 < 4; ++g4) { const f32x4 w0 = *(const LAS f32x4*)(wsp + 8 * g4), w1 = *(const LAS f32x4*)(wsp + 32 + 8 * g4);
#pragma unroll
                      for (int i = 0; i < 4; ++i) { *(LAS unsigned short*)(kmst + (8 * g4 + i) * 144) = (unsigned short)f2bf(a0[4 * g4 + i]); *(LAS unsigned short*)(kmst + (32 + 8 * g4 + i) * 144) = (unsigned short)f2bf(a1[4 * g4 + i]); }
                      const float x0 = a0[4 * g4] * w0[0], x1 = a0[4 * g4 + 1] * w0[1], x2 = a0[4 * g4 + 2] * w0[2], x3 = a0[4 * g4 + 3] * w0[3];
                      const float y0 = a1[4 * g4] * w1[0], y1 = a1[4 * g4 + 1] * w1[1], y2 = a1[4 * g4 + 2] * w1[2], y3 = a1[4 * g4 + 3] * w1[3];
                      nsum += ((x0 + x1) + (x2 + x3)) + ((y0 + y1) + (y2 + y3));
                      *(LAS v2u*)(kwst + 16 * g4) = (v2u){pg8::cvt_pk_bf16(x0, x1), pg8::cvt_pk_bf16(x2, x3)};
                      *(LAS v2u*)(kwst + 64 + 16 * g4) = (v2u){pg8::cvt_pk_bf16(y0, y1), pg8::cvt_pk_bf16(y2, y3)}; }
                  nsum += __shfl_xor(nsum, 32);
                  if (hh == 0) NN[kdk] = nreg;
                  nreg = fexp(mcar - SC[1]) * nreg + nsum;
              } else {
#pragma unroll
                  for (int g4 = 0; g4 < 4; ++g4) {
                      *(LAS v2u*)(vst + 16 * g4) = (v2u){pg8::cvt_pk_bf16(a0[4 * g4], a0[4 * g4 + 1]), pg8::cvt_pk_bf16(a0[4 * g4 + 2], a0[4 * g4 + 3])};
                      *(LAS v2u*)(vst + 64 + 16 * g4) = (v2u){pg8::cvt_pk_bf16(a1[4 * g4], a1[4 * g4 + 1]), pg8::cvt_pk_bf16(a1[4 * g4 + 2], a1[4 * g4 + 3])}; }
              }
          } }
        __syncthreads();
        const v4u g0 = gt0, g1 = gt1;
        if (c + 1 < 33) ML_LOAD(c + 1);
        asm volatile("" ::: "memory");
        if (wave < 3) {
            f32x16 acc;
#pragma unroll
            for (int i = 0; i < 16; ++i) acc[i] = 0.f;
#pragma unroll
            for (int ks = 0; ks < 4; ++ks) acc = MFMA32(ldf(aKM, 32 * ks), ldf(bQM, 32 * ks), acc);
            const int t = 32 * stt + l31; const float mt = MX[t]; float dsum = 0.f;
#pragma unroll
            for (int g4 = 0; g4 < 4; ++g4) { const int s0 = 32 * sst + 8 * g4 + 4 * hh; const f32x4 us = *(const LAS f32x4*)(up + 8 * g4);
                const float x0 = (s0 + 0 <= t) ? acc[4 * g4 + 0] * fexp(us[0] - mt) : 0.f, x1 = (s0 + 1 <= t) ? acc[4 * g4 + 1] * fexp(us[1] - mt) : 0.f;
                const float x2 = (s0 + 2 <= t) ? acc[4 * g4 + 2] * fexp(us[2] - mt) : 0.f, x3 = (s0 + 3 <= t) ? acc[4 * g4 + 3] * fexp(us[3] - mt) : 0.f;
                dsum += (x0 + x1) + (x2 + x3);
                *(LAS v2u*)(pst + 16 * g4) = (v2u){pg8::cvt_pk_bf16(x0, x1), pg8::cvt_pk_bf16(x2, x3)}; }
            dsum += __shfl_xor(dsum, 32);
            if (hh == 0) DENP[wave * 32 + l31] = dsum;
        } else if (wave == 3) {
            float a = 0.f;
#pragma unroll 2
            for (int j = 0; j < 8; ++j) { const v4u q = *(const LAS v4u*)(QW + lane * 144 + 16 * j); const f32x4 n0 = *(const LAS f32x4*)(NN + 8 * j), n1 = *(const LAS f32x4*)(NN + 8 * j + 4);
                a += (bflo(q.x) * n0[0] + bfhi(q.x) * n0[1]) + (bflo(q.y) * n0[2] + bfhi(q.y) * n0[3]) + (bflo(q.z) * n1[0] + bfhi(q.z) * n1[1]) + (bflo(q.w) * n1[2] + bfhi(q.w) * n1[3]); }
            DENI[lane] = a;
        }
        { const float wp = fexp(mcar - SC[1]);
#pragma unroll
          for (int g4 = 0; g4 < 4; ++g4) {
              *(LAS v2u*)(svst + 16 * g4) = (v2u){pg8::cvt_pk_bf16(S[4 * g4], S[4 * g4 + 1]), pg8::cvt_pk_bf16(S[4 * g4 + 2], S[4 * g4 + 3])};
#pragma unroll
              for (int i = 0; i < 4; ++i) S[4 * g4 + i] *= wp; }
#pragma unroll
          for (int ks = 0; ks < 4; ++ks) S = MFMA32(ldf(aKW, 32 * ks), ldf(bVT, 32 * ks), S); }
        __syncthreads();
        { f32x16 acc;
#pragma unroll
          for (int i = 0; i < 16; ++i) acc[i] = 0.f;
#pragma unroll
          for (int ks = 0; ks < 4; ++ks) if (ks < 2 || dkt == 1) acc = MFMA32(ldf(aP, 32 * ks), ldf(bVT, 32 * ks), acc);
#pragma unroll
          for (int ks = 0; ks < 4; ++ks) acc = MFMA32(ldf(aQW, 32 * ks), ldf(bSV, 32 * ks), acc);
#pragma unroll
          for (int i = 0; i < 16; ++i) ost[((i & 3) + 8 * (i >> 2)) * 132] = acc[i]; }
        __syncthreads();
        { const int tt = 64 * c - 48 + et;
          const float den = (et < 32 ? DENP[et] : DENP[et] + DENP[32 + et]) + DENI[et];
          const float inv = 1.0f / fmaxf(fabsf(den), fexp(-(BB[et] + MX[et])));
          f32x4 o[4]; float ss = 0.f;
#pragma unroll
          for (int j = 0; j < 4; ++j) { o[j] = *(const LAS f32x4*)(oep + 4 * j) * inv; ss += (o[j].x * o[j].x + o[j].y * o[j].y) + (o[j].z * o[j].z + o[j].w * o[j].w); }
          ss += __shfl_xor(ss, 1); ss += __shfl_xor(ss, 2); ss += __shfl_xor(ss, 4);
          const float rs = 1.0f / sqrtf(ss * (1.f / 128.f) + EPS);
          if (tt >= NMETA || (tt >= 0 && b == 0)) { const unsigned gw[8] = {g0.x, g0.y, g0.z, g0.w, g1.x, g1.y, g1.z, g1.w}; unsigned w[8];
              const v4u c0 = *(const LAS v4u*)(CT + et * 272 + 32 * evq), c1 = *(const LAS v4u*)(CT + et * 272 + 32 * evq + 16); const unsigned cwd[8] = {c0.x, c0.y, c0.z, c0.w, c1.x, c1.y, c1.z, c1.w};
#pragma unroll
              for (int j = 0; j < 4; ++j) { const f32x4 gn = *(const LAS f32x4*)(GNS + 16 * evq + 4 * j), sk = *(const LAS f32x4*)(GNS + 128 + 16 * evq + 4 * j);
                  w[2 * j] = pk2((o[j].x * rs * gn[0] + sk[0] * bflo(cwd[2 * j])) * bflo(gw[2 * j]), (o[j].y * rs * gn[1] + sk[1] * bfhi(cwd[2 * j])) * bfhi(gw[2 * j]));
                  w[2 * j + 1] = pk2((o[j].z * rs * gn[2] + sk[2] * bflo(cwd[2 * j + 1])) * bflo(gw[2 * j + 1]), (o[j].w * rs * gn[3] + sk[3] * bfhi(cwd[2 * j + 1])) * bfhi(gw[2 * j + 1])); }
              GAS v4u* yp = (GAS v4u*)(YML + rowof(b, tt) * HW + 16 * evq); yp[0] = (v4u){w[0], w[1], w[2], w[3]}; yp[1] = (v4u){w[4], w[5], w[6], w[7]}; }
          mcar = SC[0] + SC[1]; }
        __syncthreads();
    }
#undef ML_LOAD
}

typedef float f32x4v __attribute__((ext_vector_type(4)));
#define MFMA16F(a, b, c) __builtin_amdgcn_mfma_f32_16x16x4f32(a, b, c, 0, 0, 0)
constexpr int RW_LD = 516;
__device__ __forceinline__ void router_topk16(LAS float* LGw, int V, float rsv, int resrow, int lane, LAS int* hist, LAS int* res, int* TOPE, float* TOPW, float* RS) {
    if (lane < 16) {
        int se[4]; float sv[4];
#pragma unroll
        for (int k = 0; k < 4; ++k) { float best = -INFINITY; int bi = 0;
            for (int e = 0; e < 32; ++e) { const float v = LGw[lane * 33 + e]; if (v > best) { best = v; bi = e; } }
            se[k] = bi; sv[k] = best; LGw[lane * 33 + bi] = -INFINITY; }
        const float e1 = __expf(sv[1] - sv[0]), e2 = __expf(sv[2] - sv[0]), e3 = __expf(sv[3] - sv[0]), inv = 1.0f / (1.f + e1 + e2 + e3);
        const float w4[4] = {inv, e1 * inv, e2 * inv, e3 * inv};
#pragma unroll
        for (int k = 0; k < 4; ++k) { const int lp = __hip_atomic_fetch_add(hist + se[k], 1, __ATOMIC_RELAXED, __HIP_MEMORY_SCOPE_WORKGROUP);
            TOPE[(size_t)V * 4 + k] = se[k]; TOPW[(size_t)V * 4 + k] = w4[k]; res[(resrow + lane) * 4 + k] = lp; }
        RS[V] = rsv;
    }
}
__device__ __forceinline__ void p6_router(Frame& F) {
    unsigned char* ws = F.ws;
    const bf16* H1 = (const bf16*)(ws + WS_H1); const float* RWT = (const float*)(ws + WS_RWT);
    int* TOPE = (int*)(ws + WS_TOPE); int* TOPP = (int*)(ws + WS_TOPP); float* TOPW = (float*)(ws + WS_TOPW); float* RS = (float*)(ws + WS_RS);
    int* ETOK = (int*)(ws + WS_ETOK); float* ERS = (float*)(ws + WS_ERS); float* EW = (float*)(ws + WS_EW);
    LAS float* rw = (LAS float*)(F.lds + RING_OFF);
    LAS float* LG = (LAS float*)(F.lds + RING_OFF + 66048) + F.wave * 528;
    LAS int* hist = (LAS int*)(F.lds + RING_OFF + 66048 + 8 * 2112);
    LAS int* res = hist + 64;
    LAS float* XP = (LAS float*)(res + 144 * 4);
    LAS float* XQ = XP + 8 * 528;
    const int lane = F.lane, wave = F.wave, i16 = lane & 15, kk = lane >> 4;
    constexpr int RPW = NTOK / 256;
    const bool has_meta = (F.vcu == 0);
    const int Vbase = F.vcu * RPW, Vt = Vbase + 16 * wave;
    if (F.tid < 64) hist[F.tid] = 0;
    f32x4v acc0 = {0.f, 0.f, 0.f, 0.f}, acc1 = {0.f, 0.f, 0.f, 0.f}, acx0 = {0.f, 0.f, 0.f, 0.f}, acx1 = {0.f, 0.f, 0.f, 0.f}; float ssq = 0.f, xss = 0.f;
    const bf16* arow = H1 + (size_t)(Vt + i16) * D + 8 * kk;
    const bf16* xrow = H1 + (size_t)(NTOK + i16) * D + 8 * kk;
    v4u a0[4], a1[4];
#define RT_MMA(A, SB, C0, C1, SS) do { const LAS float* b0p = rw + i16 * RW_LD + 8 * kk + 128 * (SB); const LAS float* b1p = rw + (16 + i16) * RW_LD + 8 * kk + 128 * (SB); \
        _Pragma("unroll") for (int s = 0; s < 4; ++s) { const v4u aw = A[s]; \
            _Pragma("unroll") for (int h = 0; h < 2; ++h) { const unsigned w0 = h ? aw.z : aw.x, w1 = h ? aw.w : aw.y; const f32x4 a = {bflo(w0), bfhi(w0), bflo(w1), bfhi(w1)}; \
            const f32x4 b0 = *(const LAS f32x4*)(b0p + 32 * s + 4 * h), b1 = *(const LAS f32x4*)(b1p + 32 * s + 4 * h); \
            SS += (a.x * a.x + a.y * a.y) + (a.z * a.z + a.w * a.w); \
            C0 = MFMA16F(a.x, b0.x, C0); C1 = MFMA16F(a.x, b1.x, C1); C0 = MFMA16F(a.y, b0.y, C0); C1 = MFMA16F(a.y, b1.y, C1); \
            C0 = MFMA16F(a.z, b0.z, C0); C1 = MFMA16F(a.z, b1.z, C1); C0 = MFMA16F(a.w, b0.w, C0); C1 = MFMA16F(a.w, b1.w, C1); } } } while (0)
#pragma unroll
    for (int s = 0; s < 4; ++s) a0[s] = *(const GAS v4u*)(arow + 32 * s);
#pragma unroll 1
    for (int it = 0; it < 4; ++it) {
        const int half = it >> 1, sb0 = (2 * it) & 3;
        if ((it & 1) == 0) {
            __syncthreads();
            { f32x4 stg[8];
#pragma unroll
              for (int q = 0; q < 8; ++q) { const int u = F.tid + q * NTHREADS, e = u >> 7, c = u & 127; stg[q] = *(const GAS f32x4*)(RWT + (size_t)e * D + 512 * half + 4 * c); }
#pragma unroll
              for (int q = 0; q < 8; ++q) { const int u = F.tid + q * NTHREADS, e = u >> 7, c = u & 127; *(LAS f32x4*)(rw + e * RW_LD + 4 * c) = stg[q]; } }
            __syncthreads();
        }
#pragma unroll
        for (int s = 0; s < 4; ++s) a1[s] = *(const GAS v4u*)(arow + 128 * (2 * it + 1) + 32 * s);
        RT_MMA(a0, sb0, acc0, acc1, ssq);
        if (it < 3) {
#pragma unroll
            for (int s = 0; s < 4; ++s) a0[s] = *(const GAS v4u*)(arow + 128 * (2 * it + 2) + 32 * s);
        }
        RT_MMA(a1, sb0 + 1, acc0, acc1, ssq);
        if (has_meta && (wave >> 1) == it) {
            v4u ax[4];
#pragma unroll
            for (int s = 0; s < 4; ++s) ax[s] = *(const GAS v4u*)(xrow + 128 * wave + 32 * s);
            RT_MMA(ax, wave & 3, acx0, acx1, xss);
        }
    }
#undef RT_MMA
    if (has_meta) {
        xss += __shfl_xor(xss, 16); xss += __shfl_xor(xss, 32);
#pragma unroll
        for (int r = 0; r < 4; ++r) { XP[wave * 528 + (4 * kk + r) * 33 + i16] = acx0[r]; XP[wave * 528 + (4 * kk + r) * 33 + 16 + i16] = acx1[r]; }
        if (kk == 0) XQ[wave * 16 + i16] = xss;
    }
    ssq += __shfl_xor(ssq, 16); ssq += __shfl_xor(ssq, 32);
    const float rsrow = 1.0f / sqrtf(ssq * (1.f / D) + EPS);
    const float rb0 = F.in[IN_RB][i16], rb1 = F.in[IN_RB][16 + i16];
#pragma unroll
    for (int r = 0; r < 4; ++r) { const float rsr = __shfl(rsrow, 4 * kk + r); LG[(4 * kk + r) * 33 + i16] = acc0[r] * rsr + rb0; LG[(4 * kk + r) * 33 + 16 + i16] = acc1[r] * rsr + rb1; }
    LDS_WAIT(); asm volatile("" ::: "memory");
    router_topk16(LG, Vt + lane, rsrow, 16 * wave, lane, hist, res, TOPE, TOPW, RS);
    __syncthreads();
    if (has_meta && wave == 7) {
        float q = 0.f;
#pragma unroll
        for (int w = 0; w < 8; ++w) q += XQ[w * 16 + i16];
        const float rsm = 1.0f / sqrtf(q * (1.f / D) + EPS);
#pragma unroll
        for (int r = 0; r < 4; ++r) { float v0 = 0.f, v1 = 0.f;
#pragma unroll
            for (int w = 0; w < 8; ++w) { v0 += XP[w * 528 + (4 * kk + r) * 33 + i16]; v1 += XP[w * 528 + (4 * kk + r) * 33 + 16 + i16]; }
            const float rsr = __shfl(rsm, 4 * kk + r); LG[(4 * kk + r) * 33 + i16] = v0 * rsr + rb0; LG[(4 * kk + r) * 33 + 16 + i16] = v1 * rsr + rb1; }
        LDS_WAIT(); asm volatile("" ::: "memory");
        router_topk16(LG, NTOK + lane, rsm, 128, lane, hist, res, TOPE, TOPW, RS);
    }
    __syncthreads();
    if (F.tid < NE) hist[32 + F.tid] = (int)__hip_atomic_fetch_add(F.ctl + CW_CNT + 64 * F.tid, (unsigned)hist[F.tid], RLX_AGENT);
    __syncthreads();
    const int nrows = has_meta ? RPW + 16 : RPW;
    for (int u = F.tid; u < nrows * 4; u += NTHREADS) { const int rr = u >> 2, V = rr < RPW ? Vbase + rr : NTOK + (rr - RPW); const size_t gi = (size_t)V * 4 + (u & 3); const int e = TOPE[gi], pos = hist[32 + e] + res[u];
        TOPP[gi] = pos; ETOK[(size_t)e * NV + pos] = V; ERS[(size_t)e * NV + pos] = RS[V]; EW[(size_t)e * NV + pos] = TOPW[gi]; }
}

__device__ __forceinline__ void build_tables(Frame& F) {
    LAS int* pst = (LAS int*)(F.lds + PST_OFF); LAS unsigned char* texp = (LAS unsigned char*)(F.lds + TEXP_OFF);
    __syncthreads();
    if (F.tid < 64) {
        const int e = F.lane & 31; const int c = (int)__hip_atomic_load(F.ctl + CW_CNT + 64 * e, RLX_AGENT); const int nt = (c + 255) >> 8;
        int incl = nt;
#pragma unroll
        for (int o = 1; o < 32; o <<= 1) { const int t = __shfl_up(incl, o); if ((F.lane & 31) >= o) incl += t; }
        const int start = incl - nt;
        if (F.lane < 32) { pst[e] = start * 256; pst[33 + e] = c; for (int j = 0; j < nt && start + j < MAXTILES; ++j) texp[start + j] = (unsigned char)e; if (e == 31) pst[32] = incl < MAXTILES ? incl : MAXTILES; }
    }
    __syncthreads();
}
typedef float f32v2_t __attribute__((ext_vector_type(2)));
__device__ __forceinline__ void p10_combine(Frame& F) {
    unsigned char* ws = F.ws; build_tables(F);
    const LAS int* pst = (const LAS int*)(F.lds + PST_OFF);
    const bf16* H1 = (const bf16*)(ws + WS_H1); const unsigned char* YB = (const unsigned char*)(ws + WS_YB);
    const int* TOPE = (const int*)(ws + WS_TOPE); const int* TOPP = (const int*)(ws + WS_TOPP);
    const int gw = F.vcu * NWAVES + F.wave, NGW = F.G * NWAVES;
    const GAS f32x4* nf = (const GAS f32x4*)F.in[IN_NFIN] + F.lane; f32x4 nfv[4];
#pragma unroll
    for (int j = 0; j < 4; ++j) nfv[j] = nf[64 * j];
    int sl[2][4];
#define CMB_SLOTS(Rbase) do { _Pragma("unroll") for (int q = 0; q < 2; ++q) { const int R = (Rbase) + q * NGW; if (R < BATCH * SEQ) { const size_t V = (size_t)R; \
        _Pragma("unroll") for (int k = 0; k < 4; ++k) sl[q][k] = pst[TOPE[V * 4 + k]] + TOPP[V * 4 + k]; } else { _Pragma("unroll") for (int k = 0; k < 4; ++k) sl[q][k] = 0; } } } while (0)
    CMB_SLOTS(gw);
    for (int R0 = gw; R0 < BATCH * SEQ; R0 += 2 * NGW) {
        f32x4 v[2][4]; unsigned y[2][4][4];
#pragma unroll
        for (int q = 0; q < 2; ++q) { const int R = (R0 + q * NGW < BATCH * SEQ) ? R0 + q * NGW : R0; const size_t V = (size_t)R;
            const GAS v2u* hr = (const GAS v2u*)(H1 + V * D) + F.lane;
#pragma unroll
            for (int j = 0; j < 4; ++j) { const v2u hw = __builtin_nontemporal_load(hr + 64 * j); v[q][j] = (f32x4){bflo(hw.x), bfhi(hw.x), bflo(hw.y), bfhi(hw.y)}; }
#pragma unroll
            for (int k = 0; k < 4; ++k) { const GAS unsigned* yr = (const GAS unsigned*)(YB + (size_t)sl[q][k] * D) + F.lane;
#pragma unroll
                for (int j = 0; j < 4; ++j) y[q][k][j] = __builtin_nontemporal_load(yr + 64 * j); } }
        CMB_SLOTS(R0 + 2 * NGW);
#pragma unroll
        for (int q = 0; q < 2; ++q) { const int R = R0 + q * NGW; if (R >= BATCH * SEQ) continue;
#pragma unroll
            for (int k = 0; k < 4; ++k)
#pragma unroll
                for (int j = 0; j < 4; ++j) { const unsigned w = y[q][k][j]; const f32v2_t lo = __builtin_amdgcn_cvt_pk_f32_fp8(w, false), hi = __builtin_amdgcn_cvt_pk_f32_fp8(w, true);
                    v[q][j].x += lo[0] * 0.0625f; v[q][j].y += lo[1] * 0.0625f; v[q][j].z += hi[0] * 0.0625f; v[q][j].w += hi[1] * 0.0625f; }
            float s = 0.f;
#pragma unroll
            for (int j = 0; j < 4; ++j) s += (v[q][j].x * v[q][j].x + v[q][j].y * v[q][j].y) + (v[q][j].z * v[q][j].z + v[q][j].w * v[q][j].w);
            const float rs = 1.0f / sqrtf(wave_sum(s) * (1.f / D) + EPS);
            GAS f32x4* orow = (GAS f32x4*)(F.out + (size_t)R * D) + F.lane;
#pragma unroll
            for (int j = 0; j < 4; ++j) orow[64 * j] = v[q][j] * rs * nfv[j]; }
    }
#undef CMB_SLOTS
}

__device__ __forceinline__ int meta_row(int lane) { return ((lane >> 5) & 1) * 8 + ((lane >> 4) & 1) * 4 + ((lane >> 3) & 1) * 2 + ((lane >> 2) & 1); }
template <int KPL> __device__ __forceinline__ float meta_col(const LAS unsigned char* A, const bf16* wrow, int lane) {
    constexpr int K = 64 * KPL; float w[KPL];
#pragma unroll
    for (int j = 0; j < KPL / 8; ++j) { const v4u x = *(const GAS v4u*)(wrow + lane * KPL + 8 * j);
        w[8 * j] = bflo(x.x); w[8 * j + 1] = bfhi(x.x); w[8 * j + 2] = bflo(x.y); w[8 * j + 3] = bfhi(x.y); w[8 * j + 4] = bflo(x.z); w[8 * j + 5] = bfhi(x.z); w[8 * j + 6] = bflo(x.w); w[8 * j + 7] = bfhi(x.w); }
    float p[16];
#pragma unroll
    for (int r = 0; r < 16; ++r) { float s = 0.f;
#pragma unroll
        for (int j = 0; j < KPL / 8; ++j) { const v4u a = *(const LAS v4u*)(A + (r * K + lane * KPL + 8 * j) * 2);
            s += (bflo(a.x) * w[8 * j] + bfhi(a.x) * w[8 * j + 1]) + (bflo(a.y) * w[8 * j + 2] + bfhi(a.y) * w[8 * j + 3]) + (bflo(a.z) * w[8 * j + 4] + bfhi(a.z) * w[8 * j + 5]) + (bflo(a.w) * w[8 * j + 6] + bfhi(a.w) * w[8 * j + 7]); }
        p[r] = s; if ((r & 3) == 3) asm volatile("" ::: "memory"); }
    const bool b32 = lane & 32, b16 = lane & 16, b8 = lane & 8, b4 = lane & 4;
    float q8[8], q4[4], q2[2];
#pragma unroll
    for (int i = 0; i < 8; ++i) { const float keep = b32 ? p[i + 8] : p[i], send = b32 ? p[i] : p[i + 8]; q8[i] = keep + __shfl_xor(send, 32); }
#pragma unroll
    for (int i = 0; i < 4; ++i) { const float keep = b16 ? q8[i + 4] : q8[i], send = b16 ? q8[i] : q8[i + 4]; q4[i] = keep + __shfl_xor(send, 16); }
#pragma unroll
    for (int i = 0; i < 2; ++i) { const float keep = b8 ? q4[i + 2] : q4[i], send = b8 ? q4[i] : q4[i + 2]; q2[i] = keep + __shfl_xor(send, 8); }
    float v = (b4 ? q2[1] : q2[0]) + __shfl_xor(b4 ? q2[0] : q2[1], 4);
    v += __shfl_xor(v, 2); v += __shfl_xor(v, 1);
    return v;
}
__device__ __forceinline__ void meta_stage(Frame& F, LAS unsigned char* dst, const bf16* src, int K) {
    v4u t[4]; const int n = 16 * K / 8;
#pragma unroll
    for (int q = 0; q < 4; ++q) { const int u = F.tid + q * NTHREADS; if (u < n) t[q] = *(const GAS v4u*)(src + (size_t)u * 8); }
#pragma unroll
    for (int q = 0; q < 4; ++q) { const int u = F.tid + q * NTHREADS; if (u < n) *(LAS v4u*)(dst + u * 16) = t[q]; }
}
__device__ __forceinline__ void meta_proj(Frame& F) {
    unsigned char* ws = F.ws; const bf16* WIN = (const bf16*)(ws + WS_WIN); const float* lbl = F.in[IN_LBL];
    LAS unsigned char* A = F.lds + RING_OFF;
    __syncthreads(); meta_stage(F, A, (const bf16*)(ws + WS_XN0) + (size_t)NTOK * D, D); __syncthreads();
    for (int c = F.vcu * NWAVES + F.wave; c < NPROJ; c += F.G * NWAVES) {
        const float v = meta_col<16>(A, WIN + (size_t)c * D, F.lane);
        if ((F.lane & 3) == 0) { const size_t row = NTOK + meta_row(F.lane); const int kind = c < 3072 ? (c >> 9) : 6, cc = c & 511;
            if (kind == 0) ((bf16*)(ws + WS_HQ))[row * HW + cc] = (bf16)f2bf(fsilu(v));
            else if (kind == 1) { const float lb = fsigmoid(lbl[cc] - lbl[HW + cc]); ((bf16*)(ws + WS_HG))[row * HW + cc] = (bf16)f2bf(__logf(lb + (1.f - lb) * fsigmoid(v))); }
            else if (kind == 2) ((bf16*)(ws + WS_HV))[row * HW + cc] = (bf16)f2bf(v);
            else if (kind == 3) ((bf16*)(ws + WS_HGATE))[row * HW + cc] = (bf16)f2bf(fsilu(v));
            else if (kind == 4) ((bf16*)(ws + WS_MM))[row * HW + cc] = (bf16)f2bf(v);
            else if (kind == 5) ((bf16*)(ws + WS_MO))[row * HW + cc] = (bf16)f2bf(fsigmoid(v));
            else (ws + WS_GATES)[row * 2048 + pg8::gate_pos(c - 3072)] = (unsigned char)(__builtin_bit_cast(unsigned, __builtin_fmaf(fsigmoid(v), 255.f, 8388608.f)) & 0xffu); } }
}
__device__ __forceinline__ void meta_merged(Frame& F) {
    unsigned char* ws = F.ws; const unsigned char* GATES = ws + WS_GATES;
    LAS unsigned char* A0 = F.lds + RING_OFF; LAS unsigned char* A1 = A0 + 16 * HW * 2;
    __syncthreads(); meta_stage(F, A0, (const bf16*)(ws + WS_YHG) + (size_t)NTOK * HW, HW); meta_stage(F, A1, (const bf16*)(ws + WS_YML) + (size_t)NTOK * HW, HW); __syncthreads();
    for (int c = F.vcu * NWAVES + F.wave; c < D; c += F.G * NWAVES) {
        const float vh = meta_col<8>(A0, (const bf16*)(ws + WS_WBH) + (size_t)c * HW, F.lane), vm = meta_col<8>(A1, (const bf16*)(ws + WS_WBM) + (size_t)c * HW, F.lane);
        if ((F.lane & 3) == 0) { const size_t row = NTOK + meta_row(F.lane); ((bf16*)(ws + WS_MERGED))[row * D + c] = (bf16)f2bf((float)GATES[row * 2048 + pg8::gate_pos(c)] * vh + fmaxf((float)GATES[row * 2048 + pg8::gate_pos(D + c)], 1.f) * vm); } }
}
__device__ __forceinline__ void meta_wout(Frame& F) {
    unsigned char* ws = F.ws; LAS unsigned char* A = F.lds + RING_OFF;
    __syncthreads(); meta_stage(F, A, (const bf16*)(ws + WS_MERGED) + (size_t)NTOK * D, D); __syncthreads();
    for (int c = F.vcu * NWAVES + F.wave; c < D; c += F.G * NWAVES) {
        const float d = meta_col<16>(A, (const bf16*)(ws + WS_WOUT) + (size_t)c * D, F.lane);
        if ((F.lane & 3) == 0) { const int mr_ = meta_row(F.lane); const size_t row = NTOK + mr_; const float v = F.in[IN_META][(size_t)mr_ * D + c] + d;
            ((bf16*)(ws + WS_H1))[row * D + c] = (bf16)f2bf(v); ((unsigned char*)(ws + WS_H1B))[row * D + c] = (unsigned char)(__builtin_amdgcn_cvt_pk_fp8_f32(__builtin_amdgcn_fmed3f(v, -448.f, 448.f), 0.f, 0u, false) & 0xffu); } }
}

__device__ __forceinline__ void ph_proj(Frame& F, int variant) {
    unsigned char* ws = F.ws;
    pg8::Gemm g{(const pg8::bf16_t*)(ws + WS_XQ), (const pg8::bf16_t*)(ws + WS_WIN8), NTOK, NPROJ, D / 2}; pg8::StaticOrder S; S.init(NTOK, NPROJ, F.G, (int)blockIdx.x);
    pg8::EpiProjT<true> E{ws, F.in[IN_LBL], (const float*)(ws + WS_SROW), (const float*)(ws + WS_SCOL)};
#if MK_N_LAUNCHES != 1 && PROBE_VARIANT == 1
    if (variant) { pg8::EpiNull EN{(int*)(ws + WS_TOPE)}; pg8::gemm_phase<pg8::EpiNull, pg8::StaticOrder, true, true, false, true>(F.lds + RING_OFF, g, S, EN); return; }
#elif MK_N_LAUNCHES != 1 && PROBE_VARIANT == 2
    if (variant) { pg8::EpiProjT<true, true> EV{ws, F.in[IN_LBL], (const float*)(ws + WS_SROW), (const float*)(ws + WS_SCOL)}; pg8::gemm_phase<pg8::EpiProjT<true, true>, pg8::StaticOrder, true, true, false, true>(F.lds + RING_OFF, g, S, EV); return; }
#endif
    (void)variant;
    pg8::gemm_phase<pg8::EpiProjT<true>, pg8::StaticOrder, true, true, false, true>(F.lds + RING_OFF, g, S, E);
    meta_proj(F);
}
__device__ __forceinline__ void ph_scan(Frame& F) {
    const int sb = (int)blockIdx.x;
    if (sb < 64) p3_hgrn2_mfma(F, sb); else if (sb < 128) p3_mlstm_mfma(F, sb - 64);
#if !CONV_IN_P0
    else px_experts(F, sb - 128, F.G - 128);
#endif
}
__device__ __forceinline__ void ph_merged(Frame& F, int variant = 0) {
    unsigned char* ws = F.ws;
    static_assert(WS_YML - WS_YHG == (size_t)pg8::PAIR_DA * 256 * HW * 2 && WS_WBM - WS_WBH == (size_t)pg8::PAIR_DB * 256 * HW * 2, "the second branch's operands sit a whole number of tiles behind the first's");
    pg8::PairOrder S; S.S.init(NTOK, D, F.G, (int)blockIdx.x);
    pg8::Gemm g{(const pg8::bf16_t*)(ws + WS_YHG), (const pg8::bf16_t*)(ws + WS_WBH), NTOK, D, HW};
    pg8::EpiGate2 E{(const unsigned char*)(ws + WS_GATES), (pg8::bf16_t*)(ws + WS_MERGED)};
#if MK_N_LAUNCHES != 1 && PROBE_VARIANT == 1
    if (variant) { pg8::EpiNull EN{(int*)(ws + WS_TOPE)}; pg8::gemm_phase<pg8::EpiNull, pg8::PairOrder, true, true>(F.lds + RING_OFF, g, S, EN); return; }
#endif
    (void)variant;
    pg8::gemm_phase<pg8::EpiGate2, pg8::PairOrder, true, true>(F.lds + RING_OFF, g, S, E);
    meta_merged(F);
}
__device__ __forceinline__ void ph_wout(Frame& F, int variant = 0) {
    unsigned char* ws = F.ws;
    pg8::Gemm g{(const pg8::bf16_t*)(ws + WS_MERGED), (const pg8::bf16_t*)(ws + WS_WOUT), NTOK, D, D}; pg8::StaticOrder S; S.init(NTOK, D, F.G, (int)blockIdx.x);
    pg8::EpiH1 E{(const pg8::bf16_t*)(ws + WS_XN0), (const float*)(ws + WS_XSQ), (pg8::bf16_t*)(ws + WS_H1), (unsigned char*)(ws + WS_H1B)};
#if MK_N_LAUNCHES != 1 && PROBE_VARIANT == 1
    if (variant) { pg8::EpiNull EN{(int*)(ws + WS_TOPE)}; pg8::gemm_phase<pg8::EpiNull, pg8::StaticOrder, true, true>(F.lds + RING_OFF, g, S, EN); return; }
#endif
    (void)variant;
    pg8::gemm_phase<pg8::EpiH1, pg8::StaticOrder, true, true>(F.lds + RING_OFF, g, S, E);
    meta_wout(F);
}
__device__ __forceinline__ void ph_gu(Frame& F, int variant = 0) {
    unsigned char* ws = F.ws; build_tables(F);
    const LAS int* pst = (const LAS int*)(F.lds + PST_OFF); LAS unsigned short* tok16 = (LAS unsigned short*)(F.lds + TOK_OFF);
    pg8::Gemm g{(const pg8::bf16_t*)(ws + WS_H1B), (const pg8::bf16_t*)(ws + WS_WGU), NV, NE * 2 * DFF, D / 2};
    pg8::GroupOrder S{pst[32], 8, F.G, (int)blockIdx.x, (const LAS unsigned char*)(F.lds + TEXP_OFF)};
    { const int* ETOK = (const int*)(ws + WS_ETOK);
      int tokv[18];
#pragma unroll
      for (int i = 0; i < 18; ++i) { pg8::Unit u; int t = 0; if (S.next(i, u) && F.tid < 256) { const int e = u.pn >> 3, pos = u.pm * 256 - pst[e] + F.tid; if (pos < pst[33 + e]) t = ETOK[(size_t)e * NV + pos]; } tokv[i] = t; }
      if (F.tid < 256) {
#pragma unroll
          for (int i = 0; i < 18; ++i) tok16[i * 256 + F.tid] = (unsigned short)tokv[i]; }
      __syncthreads(); }
    pg8::EpiGU E{(const float*)(ws + WS_BGUP), (const float*)(ws + WS_ERS), (unsigned char*)(ws + WS_ACT), pst};
#if MK_N_LAUNCHES != 1 && PROBE_VARIANT == 1
    if (variant) { pg8::EpiNull EN{(int*)(ws + WS_TOPE)}; pg8::gemm_phase_g<pg8::EpiNull, pg8::GroupOrder, true>(F.lds + RING_OFF, g, S, EN, tok16); return; }
#elif MK_N_LAUNCHES != 1 && PROBE_VARIANT == 2
    if (variant) { pg8::EpiGUT<true> EV{(const float*)(ws + WS_BGUP), (const float*)(ws + WS_ERS), (unsigned char*)(ws + WS_ACT), pst}; pg8::gemm_phase_g<pg8::EpiGUT<true>, pg8::GroupOrder, true>(F.lds + RING_OFF, g, S, EV, tok16); return; }
#endif
    (void)variant;
    pg8::gemm_phase_g<pg8::EpiGU, pg8::GroupOrder, true>(F.lds + RING_OFF, g, S, E, tok16);
}
__device__ __forceinline__ void ph_down(Frame& F, int variant = 0) {
    unsigned char* ws = F.ws; build_tables(F);
    pg8::Gemm g{(const pg8::bf16_t*)(ws + WS_ACT), (const pg8::bf16_t*)(ws + WS_WDN), MAXTILES * 256, NE * D, DFF / 2};
    pg8::GroupOrder S{((const LAS int*)(F.lds + PST_OFF))[32], 4, F.G, (int)blockIdx.x, (const LAS unsigned char*)(F.lds + TEXP_OFF)};
    pg8::EpiDown E{F.in[IN_BDN], (const float*)(ws + WS_EW), (unsigned char*)(ws + WS_YB), (const LAS int*)(F.lds + PST_OFF)};
#if MK_N_LAUNCHES != 1 && PROBE_VARIANT == 1
    if (variant) { pg8::EpiNull EN{(int*)(ws + WS_TOPE)}; pg8::gemm_phase<pg8::EpiNull, pg8::GroupOrder, true, true, true>(F.lds + RING_OFF, g, S, EN); return; }
#elif MK_N_LAUNCHES != 1 && PROBE_VARIANT == 2
    if (variant) { pg8::EpiDownT<true> EV{F.in[IN_BDN], (const float*)(ws + WS_EW), (unsigned char*)(ws + WS_YB), (const LAS int*)(F.lds + PST_OFF)}; pg8::gemm_phase<pg8::EpiDownT<true>, pg8::GroupOrder, true, true, true>(F.lds + RING_OFF, g, S, EV); return; }
#endif
    (void)variant;
    pg8::gemm_phase<pg8::EpiDown, pg8::GroupOrder, true, true, true>(F.lds + RING_OFF, g, S, E);
}

#ifndef CONV_IN_P0
#define CONV_IN_P0 0
#endif
#ifndef PROBE_DOUBLE
#define PROBE_DOUBLE 0
#endif
#define DBL(k) ((PROBE_DOUBLE >> (k)) & 1)
#ifndef MK_N_LAUNCHES
#define MK_N_LAUNCHES 1
#endif
constexpr int NPHASE = 9;
#ifndef PROBE_VARIANT
#define PROBE_VARIANT 0
#endif
struct Args { const float* in[25]; float* out; unsigned char* ws; int ph_lo, ph_hi, li, pad; };
__global__ void __launch_bounds__(NTHREADS, 2) fwd_kernel(Args args) {
    extern __shared__ __attribute__((aligned(16))) unsigned char lds[];
    Frame F;
    F.lds = (LAS unsigned char*)lds; F.MISC = (volatile LAS unsigned*)(F.lds + MISC_OFF);
    F.tid = threadIdx.x; F.lane = F.tid & 63; F.wave = __builtin_amdgcn_readfirstlane(F.tid >> 6);
    F.G = gridDim.x; { const int bx = blockIdx.x; F.vcu = (F.G % 8 == 0) ? (bx % 8) * (F.G / 8) + bx / 8 : bx; }
    F.ws = args.ws; F.ctl = (gu32*)(args.ws + WS_CTL); F.out = args.out;
#pragma unroll
    for (int i = 0; i < 25; ++i) F.in[i] = args.in[i];
    { int t0 = F.tid; asm volatile("" : "+v"(t0)); if (t0 < 64) F.MISC[t0] = 0u; }
    __syncthreads();
    const int lo = args.ph_lo, hi = args.ph_hi;
    XcdBarrier bar; bar.bar = (unsigned*)(F.ctl + CW_BAR) + args.li * XCD_BAR_WORDS; bar.x = 0; bar.st = nullptr;
    if (hi - lo > 1) bar = xcd_barrier_post((unsigned*)(F.ctl + CW_BAR) + args.li * XCD_BAR_WORDS, F.MISC + 8);
#define IN(k) (lo <= (k) && (k) < hi)
#define SEAM(k) do { if (IN(k) && IN((k) + 1)) xcd_barrier(bar); } while (0)

    if (IN(0)) { p0_prologue(F); p0b_quant(F);
#if CONV_IN_P0
        __syncthreads(); px_experts(F, F.vcu, F.G);
#endif
    } SEAM(0);
    if (IN(1)) { ph_proj(F, args.pad); } SEAM(1);
    if (IN(2)) { ph_scan(F); } SEAM(2);
    if (IN(3)) { ph_merged(F, args.pad); } SEAM(3);
    if (IN(4)) { ph_wout(F, args.pad); } SEAM(4);
    if (IN(5)) { p6_router(F); } SEAM(5);
    if (IN(6)) { ph_gu(F, args.pad); } SEAM(6);
    if (IN(7)) { ph_down(F, args.pad); } SEAM(7);
    if (IN(8)) { p10_combine(F); }
#undef IN
#undef SEAM
}

extern "C" void kernel_launch(void* const* d_in, const int* in_sizes, int n_in, void* d_out, int out_size, void* d_ws, size_t ws_size, hipStream_t stream) {
    static int grid = 0;
    if (grid == 0) {
        if (n_in != 25 || in_sizes[0] != BATCH * SEQ * D || out_size != BATCH * SEQ * D || ws_size < WS_END) { fprintf(stderr, "kernel_launch: unexpected shapes (n_in %d, in0 %d, out %d, ws %zu); nothing launched\n", n_in, n_in > 0 ? in_sizes[0] : -1, out_size, ws_size); grid = -1; return; }
        int dev = 0, cus = 0, per_cu = 0;
        if (hipGetDevice(&dev) != hipSuccess || hipDeviceGetAttribute(&cus, hipDeviceAttributeMultiprocessorCount, dev) != hipSuccess) { grid = -1; return; }
        if (hipFuncSetAttribute((const void*)fwd_kernel, hipFuncAttributeMaxDynamicSharedMemorySize, LDS_BYTES) != hipSuccess) { fprintf(stderr, "kernel_launch: hipFuncSetAttribute failed\n"); grid = -1; return; }
        if (hipOccupancyMaxActiveBlocksPerMultiprocessor(&per_cu, (const void*)fwd_kernel, NTHREADS, LDS_BYTES) != hipSuccess || per_cu < 1) { fprintf(stderr, "kernel_launch: occupancy query reports %d blocks per CU\n", per_cu); }
        (void)hipGetLastError();
        grid = 256;
        if (cus < 256) { fprintf(stderr, "kernel_launch: %d CUs < 256: the grid would not be resident; nothing launched\n", cus); grid = -1; return; }
    }
    if (grid < 0) return;
    if (hipMemsetAsync((char*)d_ws + WS_CTL, 0, CTL_ZERO_BYTES, stream) != hipSuccess) return;
    Args a{};
    for (int i = 0; i < 25; ++i) a.in[i] = (const float*)d_in[i];
    a.out = (float*)d_out; a.ws = (unsigned char*)d_ws; a.pad = 0;
#if MK_N_LAUNCHES == 1
    a.ph_lo = 0; a.ph_hi = NPHASE; a.li = 0;
    hipLaunchKernelGGL(fwd_kernel, dim3(grid), dim3(NTHREADS), LDS_BYTES, stream, a);
#else
    for (int p = 0; p < NPHASE; ++p) for (int rep = 0; rep <= DBL(p); ++rep) { a.ph_lo = p; a.ph_hi = p + 1; a.li = 0; a.pad = rep; hipLaunchKernelGGL(fwd_kernel, dim3(grid), dim3(NTHREADS), LDS_BYTES, stream, a); }
#endif
}
```

```cpp
#include <hip/hip_runtime.h>
#include <cstdio>
#include <cstdint>
namespace pg8 {
#define PG8_LAS __attribute__((address_space(3)))
typedef unsigned short bf16_t;
typedef short bf16x8 __attribute__((ext_vector_type(8)));
typedef float f32x4 __attribute__((ext_vector_type(4)));
typedef unsigned u32x4 __attribute__((ext_vector_type(4)));
constexpr int BM = 256, BK = 64, HALF = 128, HTB = HALF * BK * 2  , STAGE_BYTES = 8 * HTB, NXCD = 8, WGM = 8;

__host__ __device__ __forceinline__ int lds_byte(int r, int c) { const int st = (r >> 4) * 2 + (c >> 5), rr = r & 15, cc = c & 31, ob = rr * 64 + cc * 2; return st * 1024 + (ob ^ (((ob >> 9) & 1) << 5)); }
__host__ __device__ __forceinline__ void stage_rc(int b, int& R, int& C) { const int st = b / 1024, sb = b % 1024, swz = sb ^ (((sb >> 9) & 1) << 5); R = (st >> 1) * 16 + swz / 64; C = (st & 1) * 32 + (swz % 64) / 2; }
__host__ __device__ __forceinline__ int perm32(int rho) { const int n = rho >> 4, i = rho & 15; return 8 * (i >> 2) + 4 * n + (i & 3); }

struct Unit { int pm, pn; };
struct Gemm { const bf16_t* A; const bf16_t* Bt; int M, N, K; };

struct StaticOrder {
    int nM, nN, nwg, G, c;
    __host__ __device__ void init(int M, int N, int G_, int c_) { nM = M / BM; nN = N / BM; nwg = nM * nN; G = G_; c = c_; }
    __host__ __device__ __forceinline__ bool next(int i, Unit& u) const {
        const long L = (long)i * G + c; if (L >= nwg) return false;
        int wgid = (int)L; { const int q = nwg / NXCD, r = nwg % NXCD, xcd = wgid % NXCD, off = wgid / NXCD; wgid = (xcd < r ? xcd * (q + 1) : r * (q + 1) + (xcd - r) * q) + off; }
        const int nig = WGM * nN, gid = wgid / nig, fm = gid * WGM, gsz = (nM - fm) < WGM ? (nM - fm) : WGM;
        u.pm = fm + ((wgid % nig) % gsz); u.pn = (wgid % nig) / gsz; return true;
    }
    __device__ __forceinline__ void a_ready(const Unit&) const {}
    __device__ __forceinline__ void done(const Unit&) const {}
};

typedef __bf16 bf16v2 __attribute__((ext_vector_type(2)));
typedef float f32v2 __attribute__((ext_vector_type(2)));
__device__ __forceinline__ unsigned cvt_pk_bf16(float lo, float hi) { const f32v2 v = {lo, hi}; return __builtin_bit_cast(unsigned, __builtin_convertvector(v, bf16v2)); }
typedef float f32x2 __attribute__((ext_vector_type(2)));
typedef int i32x4 __attribute__((ext_vector_type(4)));
typedef int i32x8 __attribute__((ext_vector_type(8)));
__device__ __forceinline__ i32x8 cat8(const bf16x8 a, const bf16x8 b) { const i32x4 x = __builtin_bit_cast(i32x4, a), y = __builtin_bit_cast(i32x4, b); return __builtin_shufflevector(x, y, 0, 1, 2, 3, 4, 5, 6, 7); }
template <class T, class = void> struct epi_chain { static constexpr bool value = false; };
template <class T> struct epi_chain<T, decltype((void)T::CHAIN)> { static constexpr bool value = T::CHAIN; };
template <class Epi, class Sched, bool ALIGN_EPI = false, bool SP2 = false, bool FP8 = false, bool I8 = false>
__device__ __forceinline__ void gemm_phase(PG8_LAS unsigned char* lds, const Gemm g, const Sched& S, const Epi& E) {
    const int tid = threadIdx.x, wid = __builtin_amdgcn_readfirstlane(tid >> 6), lane = tid & 63, wr = wid >> 2, wc = wid & 3, fr = lane & 15, fq = lane >> 4;
    const int K = g.K, nt = K / BK;
    unsigned voffA[2], voffB[2];
#pragma unroll
    for (int i = 0; i < 2; ++i) { int R, C; stage_rc(tid * 16 + i * 8192, R, C); const int Rb = Epi::PERM ? ((R & ~31) + perm32(R & 31)) : R;
        voffA[i] = (unsigned)(R * K + C) * 2u; voffB[i] = (unsigned)(Rb * K + C) * 2u; }
    const size_t kstep = (size_t)(BK * 2);
    const size_t hstep = (size_t)HALF * K * 2;
    const size_t tstep = 2 * hstep;
    const unsigned ldsw = (unsigned)wid * 1024u;
    const int aoff = lds_byte(wr * 64 + fr, fq * 8), boff = lds_byte(wc * 32 + fr, fq * 8);
#define PG8_SA(b, h) (((b) * 2 + (h)) * HTB)
#define PG8_SB(b, h) ((4 + (b) * 2 + (h)) * HTB)
#define PG8_STAGE(bufoff, gbase, voff) do { _Pragma("unroll") for (int _i = 0; _i < 2; ++_i) \
        __builtin_amdgcn_global_load_lds((const unsigned*)((const char*)(gbase) + (voff)[_i]), (PG8_LAS unsigned*)(lds + (bufoff) + ldsw + _i * 8192), 16, 0, 0); } while (0)
#define PG8_LDA(dst, b, h) do { _Pragma("unroll") for (int m = 0; m < 4; ++m) { if constexpr (FP8) dst##8[m] = cat8(*(const PG8_LAS bf16x8*)(lds + PG8_SA(b, h) + aoff + m * 2048), *(const PG8_LAS bf16x8*)(lds + PG8_SA(b, h) + aoff + m * 2048 + 1024)); \
        else { _Pragma("unroll") for (int k = 0; k < 2; ++k) dst[m][k] = *(const PG8_LAS bf16x8*)(lds + PG8_SA(b, h) + aoff + m * 2048 + k * 1024); } } } while (0)
#define PG8_LDB(dst, b, h) do { _Pragma("unroll") for (int n = 0; n < 2; ++n) { if constexpr (FP8) dst##8[n] = cat8(*(const PG8_LAS bf16x8*)(lds + PG8_SB(b, h) + boff + n * 2048), *(const PG8_LAS bf16x8*)(lds + PG8_SB(b, h) + boff + n * 2048 + 1024)); \
        else { _Pragma("unroll") for (int k = 0; k < 2; ++k) dst[n][k] = *(const PG8_LAS bf16x8*)(lds + PG8_SB(b, h) + boff + n * 2048 + k * 1024); } } } while (0)
#define PG8_MMA(ai, bj, At, Bt) do { __builtin_amdgcn_s_setprio(1); _Pragma("unroll") for (int m = 0; m < 4; ++m) _Pragma("unroll") for (int n = 0; n < 2; ++n) { \
        if constexpr (FP8) acc[ai][bj][m][n] = __builtin_amdgcn_mfma_scale_f32_16x16x128_f8f6f4(Bt##8[n], At##8[m], acc[ai][bj][m][n], 0, 0, 0, 0x7f7f7f7f, 0, 0x7f7f7f7f); \
        else if constexpr (I8) { _Pragma("unroll") for (int k = 0; k < 2; ++k) acc[ai][bj][m][n] = __builtin_bit_cast(f32x4, __builtin_amdgcn_mfma_i32_16x16x64_i8(__builtin_bit_cast(i32x4, Bt[n][k]), __builtin_bit_cast(i32x4, At[m][k]), __builtin_bit_cast(i32x4, acc[ai][bj][m][n]), 0, 0, 0)); } \
        else { _Pragma("unroll") for (int k = 0; k < 2; ++k) acc[ai][bj][m][n] = __builtin_amdgcn_mfma_f32_16x16x32_bf16(Bt[n][k], At[m][k], acc[ai][bj][m][n], 0, 0, 0); } } \
        if constexpr (FP8) { _Pragma("unroll") for (int m = 0; m < 4; ++m) _Pragma("unroll") for (int n = 0; n < 2; ++n) asm volatile("" : "+v"(acc[ai][bj][m][n])); }     \
        __builtin_amdgcn_s_setprio(0); } while (0)
#define PG8_WAIT_V(n) asm volatile("s_waitcnt vmcnt(" #n ")" ::: "memory")
#define PG8_WAIT_L(n) asm volatile("s_waitcnt lgkmcnt(" #n ")" ::: "memory")
#define PG8_BAR __builtin_amdgcn_s_barrier()
#define PG8_SCHED __builtin_amdgcn_sched_barrier(0)
    Unit cur, nxt; int ui = 0;
    if (!S.next(0, cur)) return;
    f32x4 acc[2][2][4][2];
#pragma unroll
    for (int a = 0; a < 2; ++a)
#pragma unroll
        for (int b = 0; b < 2; ++b)
#pragma unroll
            for (int m = 0; m < 4; ++m)
#pragma unroll
                for (int n = 0; n < 2; ++n) acc[a][b][m][n] = (f32x4){0.f, 0.f, 0.f, 0.f};
    bf16x8 At[4][2], B0[2][2], B1[2][2]; i32x8 At8[4], B08[2], B18[2];
    const char* cA = (const char*)g.A + (size_t)cur.pm * tstep; const char* cB = (const char*)g.Bt + (size_t)cur.pn * tstep;
    S.a_ready(cur);
    if constexpr (SP2) {
        PG8_STAGE(PG8_SB(0, 0), cB, voffB); PG8_STAGE(PG8_SB(0, 1), cB + hstep, voffB); PG8_STAGE(PG8_SA(0, 0), cA, voffA); PG8_STAGE(PG8_SA(0, 1), cA + hstep, voffA);
        if (wr == 1) PG8_BAR;
        PG8_WAIT_V(2); PG8_BAR;
        PG8_STAGE(PG8_SB(1, 0), cB + kstep, voffB); PG8_STAGE(PG8_SA(1, 0), cA + kstep, voffA); PG8_STAGE(PG8_SB(1, 1), cB + hstep + kstep, voffB);
        PG8_WAIT_V(6); PG8_BAR;
    } else {
        PG8_STAGE(PG8_SB(0, 0), cB, voffB); PG8_STAGE(PG8_SA(0, 0), cA, voffA); PG8_STAGE(PG8_SB(0, 1), cB + hstep, voffB); PG8_STAGE(PG8_SA(0, 1), cA + hstep, voffA);
        if (wr == 1) PG8_BAR;
        PG8_WAIT_V(4); PG8_BAR;
        PG8_STAGE(PG8_SB(1, 0), cB + kstep, voffB); PG8_STAGE(PG8_SA(1, 0), cA + kstep, voffA); PG8_STAGE(PG8_SB(1, 1), cB + hstep + kstep, voffB);
        PG8_WAIT_V(6); PG8_BAR;
    }
    for (;;) {
        const bool has_next = S.next(ui + 1, nxt);
        const char* nA = has_next ? (const char*)g.A + (size_t)nxt.pm * tstep : cA; const char* nB = has_next ? (const char*)g.Bt + (size_t)nxt.pn * tstep : cB;
        for (int t = 0; t < nt; t += 2) {
            const bool last = (t == nt - 2);
            const char* a1 = cA + (size_t)(t + 1) * kstep;
            const char* a2 = last ? nA : cA + (size_t)(t + 2) * kstep; const char* b2 = last ? nB : cB + (size_t)(t + 2) * kstep;
            const char* a3 = a2 + kstep; const char* b3 = b2 + kstep;
            if (last && has_next) S.a_ready(nxt);
            if constexpr (SP2) {
            PG8_LDB(B0, 0, 0); PG8_LDB(B1, 0, 1); PG8_SCHED; PG8_LDA(At, 0, 0); PG8_STAGE(PG8_SA(1, 1), a1 + hstep, voffA);
            PG8_WAIT_V(8); PG8_WAIT_L(0); PG8_BAR; PG8_MMA(0, 0, At, B0); PG8_MMA(0, 1, At, B1); PG8_BAR; PG8_SCHED;
            PG8_LDA(At, 0, 1); PG8_STAGE(PG8_SB(0, 0), b2, voffB); PG8_STAGE(PG8_SB(0, 1), b2 + hstep, voffB); PG8_STAGE(PG8_SA(0, 0), a2, voffA);
            PG8_WAIT_V(8); PG8_WAIT_L(0); PG8_BAR; PG8_MMA(1, 0, At, B0); PG8_MMA(1, 1, At, B1); PG8_BAR; PG8_SCHED;
            PG8_LDB(B0, 1, 0); PG8_LDB(B1, 1, 1); PG8_SCHED; PG8_LDA(At, 1, 0); PG8_STAGE(PG8_SA(0, 1), a2 + hstep, voffA);
            PG8_WAIT_V(8); PG8_WAIT_L(0); PG8_BAR; PG8_MMA(0, 0, At, B0); PG8_MMA(0, 1, At, B1); PG8_BAR; PG8_SCHED;
            PG8_LDA(At, 1, 1); PG8_STAGE(PG8_SB(1, 0), b3, voffB); PG8_STAGE(PG8_SB(1, 1), b3 + hstep, voffB); PG8_STAGE(PG8_SA(1, 0), a3, voffA);
            PG8_WAIT_V(8); PG8_WAIT_L(0); PG8_BAR; PG8_MMA(1, 0, At, B0); PG8_MMA(1, 1, At, B1); PG8_BAR; PG8_SCHED;
            } else {
            PG8_LDB(B0, 0, 0); PG8_SCHED; PG8_LDA(At, 0, 0); PG8_STAGE(PG8_SA(1, 1), a1 + hstep, voffA);
            PG8_WAIT_L(8); PG8_BAR; PG8_WAIT_L(0); PG8_MMA(0, 0, At, B0); PG8_BAR; PG8_SCHED;
            PG8_LDB(B1, 0, 1); PG8_STAGE(PG8_SB(0, 0), b2, voffB);
            PG8_BAR; PG8_WAIT_L(0); PG8_MMA(0, 1, At, B1); PG8_BAR;
            PG8_LDA(At, 0, 1); PG8_STAGE(PG8_SA(0, 0), a2, voffA);
            PG8_BAR; PG8_WAIT_L(0); PG8_MMA(1, 0, At, B0); PG8_BAR; PG8_SCHED;
            PG8_STAGE(PG8_SB(0, 1), b2 + hstep, voffB);
            PG8_WAIT_V(6); PG8_BAR; PG8_MMA(1, 1, At, B1); PG8_BAR;
            PG8_LDB(B0, 1, 0); PG8_SCHED; PG8_LDA(At, 1, 0); PG8_STAGE(PG8_SA(0, 1), a2 + hstep, voffA);
            PG8_WAIT_L(8); PG8_BAR; PG8_WAIT_L(0); PG8_MMA(0, 0, At, B0); PG8_BAR; PG8_SCHED;
            PG8_LDB(B1, 1, 1); PG8_STAGE(PG8_SB(1, 0), b3, voffB);
            PG8_BAR; PG8_WAIT_L(0); PG8_MMA(0, 1, At, B1); PG8_BAR;
            PG8_LDA(At, 1, 1); PG8_STAGE(PG8_SA(1, 0), a3, voffA);
            PG8_BAR; PG8_WAIT_L(0); PG8_MMA(1, 0, At, B0); PG8_BAR; PG8_SCHED;
            PG8_STAGE(PG8_SB(1, 1), b3 + hstep, voffB);
            PG8_WAIT_V(6); PG8_BAR; PG8_MMA(1, 1, At, B1); PG8_BAR;
            }
        }
        if constexpr (ALIGN_EPI) { if (wr == 0) PG8_BAR; }
        bool keep = false;
        if constexpr (epi_chain<Epi>::value) { keep = E.chain(acc, cur, wr, wc, fr, fq); S.done(cur); }
        else if constexpr (!Epi::AFTER_DRAIN) { E(acc, cur, wr, wc, fr, fq); S.done(cur); }
        if (!has_next) break;
        if (!keep) {
#pragma unroll
        for (int a = 0; a < 2; ++a)
#pragma unroll
            for (int b = 0; b < 2; ++b)
#pragma unroll
                for (int m = 0; m < 4; ++m)
#pragma unroll
                    for (int n = 0; n < 2; ++n) acc[a][b][m][n] = (f32x4){0.f, 0.f, 0.f, 0.f};
        }
        cur = nxt; cA = nA; cB = nB; ++ui;
        if constexpr (ALIGN_EPI) { if (wr == 1) PG8_BAR; }
    }
    PG8_WAIT_V(0);
    if constexpr (!ALIGN_EPI) { if (wr == 0) PG8_BAR; }
    PG8_BAR;
    if constexpr (Epi::AFTER_DRAIN) { E.fused(acc, cur, wr, wc, fr, fq, lds, wid, lane); S.done(cur); }
#undef PG8_SA
#undef PG8_SB
#undef PG8_STAGE
#undef PG8_LDA
#undef PG8_LDB
#undef PG8_MMA
#undef PG8_WAIT_V
#undef PG8_WAIT_L
#undef PG8_BAR
#undef PG8_SCHED
}
template <class Epi, class Sched, bool FP8 = false>
__device__ __forceinline__ void gemm_phase_g(PG8_LAS unsigned char* lds, const Gemm g, const Sched& S, const Epi& E, const PG8_LAS unsigned short* tok16) {
    constexpr bool ALIGN_EPI = true, SP2 = true;
    const int tid = threadIdx.x, wid = __builtin_amdgcn_readfirstlane(tid >> 6), lane = tid & 63, wr = wid >> 2, wc = wid & 3, fr = lane & 15, fq = lane >> 4;
    const int K = g.K, nt = K / BK;
    unsigned voffB[2]; int RA[2]; unsigned CA[2];
#pragma unroll
    for (int i = 0; i < 2; ++i) { int R, C; stage_rc(tid * 16 + i * 8192, R, C); const int Rb = Epi::PERM ? ((R & ~31) + perm32(R & 31)) : R;
        RA[i] = R; CA[i] = (unsigned)C * 2u; voffB[i] = (unsigned)(Rb * K + C) * 2u; }
    unsigned oc[2][2];
#define PG8_TOKS(dst, ui_) do { _Pragma("unroll") for (int _h = 0; _h < 2; ++_h) _Pragma("unroll") for (int _i = 0; _i < 2; ++_i) \
        dst[_h][_i] = (unsigned)tok16[(ui_) * 256 + _h * HALF + RA[_i]] * (unsigned)(K * 2) + CA[_i]; } while (0)
    const size_t kstep = (size_t)(BK * 2);
    const size_t hstep = (size_t)HALF * K * 2;
    const size_t tstep = 2 * hstep;
    const unsigned ldsw = (unsigned)wid * 1024u;
    const int aoff = lds_byte(wr * 64 + fr, fq * 8), boff = lds_byte(wc * 32 + fr, fq * 8);
#define PG8_SA(b, h) (((b) * 2 + (h)) * HTB)
#define PG8_SB(b, h) ((4 + (b) * 2 + (h)) * HTB)
#define PG8_STAGE(bufoff, gbase, voff) do { _Pragma("unroll") for (int _i = 0; _i < 2; ++_i) \
        __builtin_amdgcn_global_load_lds((const unsigned*)((const char*)(gbase) + (voff)[_i]), (PG8_LAS unsigned*)(lds + (bufoff) + ldsw + _i * 8192), 16, 0, 0); } while (0)
#define PG8_LDA(dst, b, h) do { _Pragma("unroll") for (int m = 0; m < 4; ++m) { if constexpr (FP8) dst##8[m] = cat8(*(const PG8_LAS bf16x8*)(lds + PG8_SA(b, h) + aoff + m * 2048), *(const PG8_LAS bf16x8*)(lds + PG8_SA(b, h) + aoff + m * 2048 + 1024)); \
        else { _Pragma("unroll") for (int k = 0; k < 2; ++k) dst[m][k] = *(const PG8_LAS bf16x8*)(lds + PG8_SA(b, h) + aoff + m * 2048 + k * 1024); } } } while (0)
#define PG8_LDB(dst, b, h) do { _Pragma("unroll") for (int n = 0; n < 2; ++n) { if constexpr (FP8) dst##8[n] = cat8(*(const PG8_LAS bf16x8*)(lds + PG8_SB(b, h) + boff + n * 2048), *(const PG8_LAS bf16x8*)(lds + PG8_SB(b, h) + boff + n * 2048 + 1024)); \
        else { _Pragma("unroll") for (int k = 0; k < 2; ++k) dst[n][k] = *(const PG8_LAS bf16x8*)(lds + PG8_SB(b, h) + boff + n * 2048 + k * 1024); } } } while (0)
#define PG8_MMA(ai, bj, At, Bt) do { __builtin_amdgcn_s_setprio(1); _Pragma("unroll") for (int m = 0; m < 4; ++m) _Pragma("unroll") for (int n = 0; n < 2; ++n) { \
        if constexpr (FP8) acc[ai][bj][m][n] = __builtin_amdgcn_mfma_scale_f32_16x16x128_f8f6f4(Bt##8[n], At##8[m], acc[ai][bj][m][n], 0, 0, 0, 0x7f7f7f7f, 0, 0x7f7f7f7f); \
        else { _Pragma("unroll") for (int k = 0; k < 2; ++k) acc[ai][bj][m][n] = __builtin_amdgcn_mfma_f32_16x16x32_bf16(Bt[n][k], At[m][k], acc[ai][bj][m][n], 0, 0, 0); } } \
        if constexpr (FP8) { _Pragma("unroll") for (int m = 0; m < 4; ++m) _Pragma("unroll") for (int n = 0; n < 2; ++n) asm volatile("" : "+v"(acc[ai][bj][m][n])); }     \
        __builtin_amdgcn_s_setprio(0); } while (0)
#define PG8_WAIT_V(n) asm volatile("s_waitcnt vmcnt(" #n ")" ::: "memory")
#define PG8_WAIT_L(n) asm volatile("s_waitcnt lgkmcnt(" #n ")" ::: "memory")
#define PG8_BAR __builtin_amdgcn_s_barrier()
#define PG8_SCHED __builtin_amdgcn_sched_barrier(0)
    Unit cur, nxt; int ui = 0;
    if (!S.next(0, cur)) return;
    f32x4 acc[2][2][4][2];
#pragma unroll
    for (int a = 0; a < 2; ++a)
#pragma unroll
        for (int b = 0; b < 2; ++b)
#pragma unroll
            for (int m = 0; m < 4; ++m)
#pragma unroll
                for (int n = 0; n < 2; ++n) acc[a][b][m][n] = (f32x4){0.f, 0.f, 0.f, 0.f};
    bf16x8 At[4][2], B0[2][2], B1[2][2]; i32x8 At8[4], B08[2], B18[2];
    const char* cA = (const char*)g.A; const char* cB = (const char*)g.Bt + (size_t)cur.pn * tstep; PG8_TOKS(oc, 0);
    S.a_ready(cur);
    if constexpr (SP2) {
        PG8_STAGE(PG8_SB(0, 0), cB, voffB); PG8_STAGE(PG8_SB(0, 1), cB + hstep, voffB); PG8_STAGE(PG8_SA(0, 0), cA, oc[0]); PG8_STAGE(PG8_SA(0, 1), cA, oc[1]);
        if (wr == 1) PG8_BAR;
        PG8_WAIT_V(2); PG8_BAR;
        PG8_STAGE(PG8_SB(1, 0), cB + kstep, voffB); PG8_STAGE(PG8_SA(1, 0), cA + kstep, oc[0]); PG8_STAGE(PG8_SB(1, 1), cB + hstep + kstep, voffB);
        PG8_WAIT_V(6); PG8_BAR;
    } else {
        PG8_STAGE(PG8_SB(0, 0), cB, voffB); PG8_STAGE(PG8_SA(0, 0), cA, oc[0]); PG8_STAGE(PG8_SB(0, 1), cB + hstep, voffB); PG8_STAGE(PG8_SA(0, 1), cA + hstep, oc[0]);
        if (wr == 1) PG8_BAR;
        PG8_WAIT_V(4); PG8_BAR;
        PG8_STAGE(PG8_SB(1, 0), cB + kstep, voffB); PG8_STAGE(PG8_SA(1, 0), cA + kstep, oc[0]); PG8_STAGE(PG8_SB(1, 1), cB + hstep + kstep, voffB);
        PG8_WAIT_V(6); PG8_BAR;
    }
    for (;;) {
        const bool has_next = S.next(ui + 1, nxt);
        const char* nB = has_next ? (const char*)g.Bt + (size_t)nxt.pn * tstep : cB;
        for (int t = 0; t < nt; t += 2) {
            const bool last = (t == nt - 2);
            const char* a1 = cA + (size_t)(t + 1) * kstep;
            const char* a2 = last ? cA : cA + (size_t)(t + 2) * kstep; const char* b2 = last ? nB : cB + (size_t)(t + 2) * kstep;
            unsigned o2[2][2]; if (last && has_next) PG8_TOKS(o2, ui + 1); else { _Pragma("unroll") for (int _h = 0; _h < 2; ++_h) _Pragma("unroll") for (int _i = 0; _i < 2; ++_i) o2[_h][_i] = oc[_h][_i]; }
            const char* a3 = a2 + kstep; const char* b3 = b2 + kstep;
            if (last && has_next) S.a_ready(nxt);
            if constexpr (SP2) {
            PG8_LDB(B0, 0, 0); PG8_LDB(B1, 0, 1); PG8_SCHED; PG8_LDA(At, 0, 0); PG8_STAGE(PG8_SA(1, 1), a1, oc[1]);
            PG8_WAIT_V(8); PG8_WAIT_L(0); PG8_BAR; PG8_MMA(0, 0, At, B0); PG8_MMA(0, 1, At, B1); PG8_BAR; PG8_SCHED;
            PG8_LDA(At, 0, 1); PG8_STAGE(PG8_SB(0, 0), b2, voffB); PG8_STAGE(PG8_SB(0, 1), b2 + hstep, voffB); PG8_STAGE(PG8_SA(0, 0), a2, o2[0]);
            PG8_WAIT_V(8); PG8_WAIT_L(0); PG8_BAR; PG8_MMA(1, 0, At, B0); PG8_MMA(1, 1, At, B1); PG8_BAR; PG8_SCHED;
            PG8_LDB(B0, 1, 0); PG8_LDB(B1, 1, 1); PG8_SCHED; PG8_LDA(At, 1, 0); PG8_STAGE(PG8_SA(0, 1), a2, o2[1]);
            PG8_WAIT_V(8); PG8_WAIT_L(0); PG8_BAR; PG8_MMA(0, 0, At, B0); PG8_MMA(0, 1, At, B1); PG8_BAR; PG8_SCHED;
            PG8_LDA(At, 1, 1); PG8_STAGE(PG8_SB(1, 0), b3, voffB); PG8_STAGE(PG8_SB(1, 1), b3 + hstep, voffB); PG8_STAGE(PG8_SA(1, 0), a3, o2[0]);
            PG8_WAIT_V(8); PG8_WAIT_L(0); PG8_BAR; PG8_MMA(1, 0, At, B0); PG8_MMA(1, 1, At, B1); PG8_BAR; PG8_SCHED;
            } else {
            PG8_LDB(B0, 0, 0); PG8_SCHED; PG8_LDA(At, 0, 0); PG8_STAGE(PG8_SA(1, 1), a1 + hstep, oc[0]);
            PG8_WAIT_L(8); PG8_BAR; PG8_WAIT_L(0); PG8_MMA(0, 0, At, B0); PG8_BAR; PG8_SCHED;
            PG8_LDB(B1, 0, 1); PG8_STAGE(PG8_SB(0, 0), b2, voffB);
            PG8_BAR; PG8_WAIT_L(0); PG8_MMA(0, 1, At, B1); PG8_BAR;
            PG8_LDA(At, 0, 1); PG8_STAGE(PG8_SA(0, 0), a2, oc[0]);
            PG8_BAR; PG8_WAIT_L(0); PG8_MMA(1, 0, At, B0); PG8_BAR; PG8_SCHED;
            PG8_STAGE(PG8_SB(0, 1), b2 + hstep, voffB);
            PG8_WAIT_V(6); PG8_BAR; PG8_MMA(1, 1, At, B1); PG8_BAR;
            PG8_LDB(B0, 1, 0); PG8_SCHED; PG8_LDA(At, 1, 0); PG8_STAGE(PG8_SA(0, 1), a2 + hstep, oc[0]);
            PG8_WAIT_L(8); PG8_BAR; PG8_WAIT_L(0); PG8_MMA(0, 0, At, B0); PG8_BAR; PG8_SCHED;
            PG8_LDB(B1, 1, 1); PG8_STAGE(PG8_SB(1, 0), b3, voffB);
            PG8_BAR; PG8_WAIT_L(0); PG8_MMA(0, 1, At, B1); PG8_BAR;
            PG8_LDA(At, 1, 1); PG8_STAGE(PG8_SA(1, 0), a3, oc[0]);
            PG8_BAR; PG8_WAIT_L(0); PG8_MMA(1, 0, At, B0); PG8_BAR; PG8_SCHED;
            PG8_STAGE(PG8_SB(1, 1), b3 + hstep, voffB);
            PG8_WAIT_V(6); PG8_BAR; PG8_MMA(1, 1, At, B1); PG8_BAR;
            }
        }
        if constexpr (ALIGN_EPI) { if (wr == 0) PG8_BAR; }
        if constexpr (!Epi::AFTER_DRAIN) { E(acc, cur, wr, wc, fr, fq); S.done(cur); }
        if (!has_next) break;
#pragma unroll
        for (int a = 0; a < 2; ++a)
#pragma unroll
            for (int b = 0; b < 2; ++b)
#pragma unroll
                for (int m = 0; m < 4; ++m)
#pragma unroll
                    for (int n = 0; n < 2; ++n) acc[a][b][m][n] = (f32x4){0.f, 0.f, 0.f, 0.f};
        cur = nxt; cB = nB; ++ui; PG8_TOKS(oc, ui);
        if constexpr (ALIGN_EPI) { if (wr == 1) PG8_BAR; }
    }
    PG8_WAIT_V(0);
    if constexpr (!ALIGN_EPI) { if (wr == 0) PG8_BAR; }
    PG8_BAR;
    if constexpr (Epi::AFTER_DRAIN) { E.fused(acc, cur, wr, wc, fr, fq, lds, wid, lane); S.done(cur); }
#undef PG8_TOKS
#undef PG8_SA
#undef PG8_SB
#undef PG8_STAGE
#undef PG8_LDA
#undef PG8_LDB
#undef PG8_MMA
#undef PG8_WAIT_V
#undef PG8_WAIT_L
#undef PG8_BAR
#undef PG8_SCHED
}
}

constexpr int BATCH = 16, SEQ = 2048, D = 1024, NMETA = 16;
constexpr int TV = SEQ + NMETA;
constexpr int NV = BATCH * TV;
constexpr int NTOK = BATCH * SEQ;
constexpr int NR = NTOK + NMETA;
constexpr int NIN = 5128, NPROJ = 5120;
constexpr int HW = 512;
constexpr int NE = 32, TOPK = 4, DFF = 1024;
constexpr int MAXTILES = 548;
constexpr float EPS = 1e-6f;
constexpr int NWAVES = 8, NTHREADS = 512;

constexpr size_t MiB = 1u << 20, KiB = 1u << 10;
constexpr size_t WS_CTL = 0, CTL_ZERO_BYTES = 1 * MiB;
constexpr size_t WS_WIN = 2 * MiB;
constexpr size_t WS_WBH = 12 * MiB, WS_WBM = 13 * MiB, WS_WOUT = 14 * MiB;
constexpr size_t WS_WGU = 16 * MiB;
constexpr size_t WS_WDN = 144 * MiB;
constexpr size_t WS_BGUP = 208 * MiB;
constexpr size_t WS_RWT = WS_BGUP + 256 * KiB;
constexpr size_t WS_TOPE = WS_RWT + 128 * KiB;
constexpr size_t WS_TOPP = WS_TOPE + 520 * KiB;
constexpr size_t WS_TOPW = WS_TOPP + 520 * KiB;
constexpr size_t WS_RS = WS_TOPW + 520 * KiB;
constexpr size_t WS_LI = WS_RS + 136 * KiB;
constexpr size_t WS_LF = WS_LI + 520 * KiB;
constexpr size_t WS_SLOTRS = WS_LF + 520 * KiB;
constexpr size_t WS_SLOTW = WS_SLOTRS + 552 * KiB;
constexpr size_t WS_XSQ = WS_SLOTW + 552 * KiB;
constexpr size_t WS_SROW = WS_XSQ + 136 * KiB;
constexpr size_t WS_SCOL = WS_SROW + 136 * KiB;
constexpr size_t WS_SMALL_END = WS_SCOL + 32 * KiB;
constexpr size_t WS_RA = 214 * MiB;
constexpr size_t WS_HQ = WS_RA, WS_HG = WS_RA + 33 * MiB, WS_HV = WS_RA + 99 * MiB, WS_HGATE = WS_RA + 132 * MiB, WS_MM = WS_RA + 165 * MiB, WS_MO = WS_RA + 198 * MiB, WS_GATES = WS_RA + 231 * MiB;
constexpr size_t WS_MERGED = WS_RA, WS_TMP = WS_RA + 66 * MiB, WS_H1B = WS_RA + 364 * MiB, WS_ACT = WS_RA;
constexpr size_t WS_RB = WS_RA + 364 * MiB;
constexpr size_t WS_XQ = WS_RB;
constexpr size_t WS_QKVM = WS_RB, WS_CM = WS_RB + 130 * MiB, WS_YHG = WS_RB + 196 * MiB, WS_YML = WS_RB + 229 * MiB, WS_XS = WS_RB, WS_YB = WS_RB;
constexpr size_t WS_RC = WS_RB + 274 * MiB;
constexpr size_t WS_XN0 = WS_RC + 65 * MiB;
constexpr size_t WS_H1 = WS_RC, WS_ETOK = WS_RC + 130 * MiB, WS_ERS = WS_ETOK + 5 * MiB, WS_EW = WS_ERS + 5 * MiB, WS_WIN8 = WS_EW + 5 * MiB, WS_END = WS_WIN8 + 5 * MiB;
static_assert(WS_SMALL_END <= WS_RA && WS_END <= 1024 * MiB, "d_ws map");
static_assert((size_t)NV * HW * 2 <= 33 * MiB && (size_t)NV * HW * 4 <= 66 * MiB && (size_t)NV * 2048 * 2 <= 132 * MiB + MiB && (size_t)NV * D * 4 <= 130 * MiB && (size_t)MAXTILES * 256 * D * 2 <= 274 * MiB, "d_ws sizes");
static_assert((size_t)NE * NV * 4 <= 5 * MiB, "per-expert lists");
static_assert((size_t)NR * D * 2 <= 65 * MiB && (size_t)NR * 4 <= 136 * KiB, "H1 / XN0 / XSQ");
constexpr int CW_TMO = 0, CW_CNT = 64  , CW_BAR = 4096, CW_P0ARR = 3072  , CW_CMAX = 65536  ;

constexpr int RING_OFF = 0, RING_BYTES = 131072;
constexpr int MISC_OFF = RING_BYTES;
constexpr int TEXP_OFF = MISC_OFF + 256;
constexpr int PST_OFF = TEXP_OFF + 640;
constexpr int TOK_OFF = PST_OFF + 384;
constexpr int LDS_BYTES = 147456;
static_assert(TOK_OFF + 18 * 512 <= LDS_BYTES, "LDS map");

#define GAS __attribute__((address_space(1)))
#define LAS __attribute__((address_space(3)))
typedef unsigned short bf16;
typedef unsigned v4u __attribute__((ext_vector_type(4)));
typedef unsigned v2u __attribute__((ext_vector_type(2)));
typedef float f32x4 __attribute__((ext_vector_type(4)));
typedef GAS unsigned gu32;
#define RLX_AGENT __ATOMIC_RELAXED, __HIP_MEMORY_SCOPE_AGENT
#define LDS_WAIT() asm volatile("s_waitcnt lgkmcnt(0)" ::: "memory")
#define VM_WAIT() asm volatile("s_waitcnt vmcnt(0)" ::: "memory")
__device__ __forceinline__ unsigned pk2(float lo, float hi) { return pg8::cvt_pk_bf16(lo, hi); }
__device__ __forceinline__ unsigned f2bf(float f) { return pg8::cvt_pk_bf16(f, 0.f) & 0xffffu; }
__device__ __forceinline__ float bflo(unsigned w) { return __builtin_bit_cast(float, w << 16); }
__device__ __forceinline__ float bfhi(unsigned w) { return __builtin_bit_cast(float, w & 0xffff0000u); }
__device__ __forceinline__ float bf1(bf16 h) { return __builtin_bit_cast(float, (unsigned)h << 16); }
__device__ __forceinline__ float fsigmoid(float x) { return __builtin_amdgcn_rcpf(1.0f + __expf(-x)); }
__device__ __forceinline__ float fsilu(float x) { return x * fsigmoid(x); }
__device__ __forceinline__ size_t rowof(int b, int tt) { return tt < NMETA ? (size_t)(NTOK + tt) : (size_t)b * SEQ + (tt - NMETA); }
__host__ __device__ __forceinline__ int gu_slot(int j) { const int g = (j >> 3) & 3, p = ((g & 1) << 1) | (g >> 1); return (j & ~31) + 8 * p + (j & 7); }
__device__ __forceinline__ float wave_sum(float v) {
#pragma unroll
    for (int o = 1; o < 64; o <<= 1) v += __shfl_xor(v, o);
    return v;
}
#define SUM8_DPP(v, ctrl) __builtin_bit_cast(float, __builtin_amdgcn_update_dpp(0, __builtin_bit_cast(int, (float)(v)), (ctrl), 0xf, 0xf, false))
__device__ __forceinline__ float sum8_dpp(float v) { v += SUM8_DPP(v, 0xB1); v += SUM8_DPP(v, 0x4E); v += SUM8_DPP(v, 0x141); return v; }
__device__ __forceinline__ float wave_max(float v) {
#pragma unroll
    for (int o = 1; o < 64; o <<= 1) v = fmaxf(v, __shfl_xor(v, o));
    return v;
}
#define XB_TMO      128
#define XB_XCNT(j)  (256  + 64 * (j))
#define XB_XSUB(j)  (1280 + 64 * (j))
#define XB_XGEN(j)  (2304 + 64 * (j))
#define XB_TOP      3328
#define XB_TOPGEN   3392
#define XCD_BAR_WORDS 3456
#define XB_SPIN_CAP (1u << 18)

__device__ __forceinline__ unsigned xb_ld(unsigned* p)              { return __hip_atomic_load(p, __ATOMIC_RELAXED, __HIP_MEMORY_SCOPE_AGENT); }
__device__ __forceinline__ unsigned xb_add(unsigned* p, unsigned v) { return __hip_atomic_fetch_add(p, v, __ATOMIC_RELAXED, __HIP_MEMORY_SCOPE_AGENT); }
__device__ __forceinline__ unsigned xb_xcc_id() { return (unsigned)__builtin_amdgcn_s_getreg((3 << 11) | 20) & 0xFu; }
#define XB_SPIN(cond, bar) do { unsigned _sp = 0; while (cond) { __builtin_amdgcn_s_sleep(1); \
    if ((++_sp & 255u) == 0u) { if (xb_ld(&(bar)[XB_TMO])) break; if (_sp > XB_SPIN_CAP) { atomicAdd(&(bar)[XB_TMO], 1u); break; } } } } while (0)

struct XcdBarrier {
    unsigned* bar; unsigned x;
    volatile LAS unsigned* st;
};

__device__ __forceinline__ XcdBarrier xcd_barrier_post(unsigned* bar, volatile LAS unsigned* st) {
    XcdBarrier b; b.bar = bar; b.x = xb_xcc_id(); b.st = st;
    if (threadIdx.x == 0) (void)xb_add(&bar[XB_XCNT(b.x)], 1u);
    return b;
}
__device__ __forceinline__ void xcd_barrier_complete(unsigned* bar, unsigned x, unsigned& nloc, unsigned& nx) {
    const unsigned G = gridDim.x * gridDim.y * gridDim.z;
    unsigned sum, cnt, mine, sp = 0u;
    for (;;) {
        sum = 0u; cnt = 0u; mine = 0u;
#pragma unroll
        for (unsigned j = 0; j < 16; ++j) { const unsigned c = xb_ld(&bar[XB_XCNT(j)]); sum += c; cnt += (c > 0u) ? 1u : 0u; mine = (j == x) ? c : mine; }
        if (sum == G) break;
        __builtin_amdgcn_s_sleep(1);
        if ((++sp & 255u) == 0u) { if (xb_ld(&bar[XB_TMO])) break; if (sp > XB_SPIN_CAP) { atomicAdd(&bar[XB_TMO], 1u); break; } }
    }
    nloc = mine > 0u ? mine : 1u; nx = cnt > 0u ? cnt : 1u;
}

__device__ __forceinline__ void xcd_barrier(const XcdBarrier& b) {
    asm volatile("s_waitcnt vmcnt(0)" ::: "memory");
    __syncthreads();
    if (threadIdx.x == 0) {
        unsigned* bar = b.bar;
        __builtin_amdgcn_s_waitcnt(0);
        unsigned nloc = b.st[0], nx = b.st[1];
        if (nloc == 0u) { xcd_barrier_complete(bar, b.x, nloc, nx); b.st[0] = nloc; b.st[1] = nx; }
        const unsigned old = xb_add(&bar[XB_XSUB(b.x)], 1u);
        const unsigned gen = old / nloc;
        if (old + 1u == (gen + 1u) * nloc) {
            __builtin_amdgcn_fence(__ATOMIC_RELEASE, "agent");
            asm volatile("s_waitcnt vmcnt(0)" ::: "memory");
            const unsigned og = xb_add(&bar[XB_TOP], 1u);
            const unsigned tg = og / nx;
            if (og + 1u == (tg + 1u) * nx) xb_add(&bar[XB_TOPGEN], 1u);
            else XB_SPIN(xb_ld(&bar[XB_TOPGEN]) == tg, bar);
            __builtin_amdgcn_fence(__ATOMIC_ACQUIRE, "agent");
            xb_add(&bar[XB_XGEN(b.x)], 1u);
            asm volatile("s_waitcnt vmcnt(0)" ::: "memory");
        } else {
            XB_SPIN(xb_ld(&bar[XB_XGEN(b.x)]) == gen, bar);
            __builtin_amdgcn_fence(__ATOMIC_ACQUIRE, "agent");
            asm volatile("s_waitcnt vmcnt(0)" ::: "memory");
        }
    }
    __syncthreads();
}

struct Frame {
    LAS unsigned char* lds;
    volatile LAS unsigned* MISC;
    gu32* ctl;
    int tid, lane, wave, vcu, G;
    const float* in[25];
    float* out;
    unsigned char* ws;
};
#define IN_X 0
#define IN_META 1
#define IN_LBL 2
#define IN_NMIX 3
#define IN_WIN 4
#define IN_HGNORM 5
#define IN_CONVW 6
#define IN_CONVB 7
#define IN_WQ 8
#define IN_WK 9
#define IN_WV 10
#define IN_GATEB 11
#define IN_MLNORM 12
#define IN_MLSKIP 13
#define IN_WBH 14
#define IN_WBM 15
#define IN_WOUT 16
#define IN_NFFN 17
#define IN_RW 18
#define IN_RB 19
#define IN_WGU 20
#define IN_BGU 21
#define IN_WDN 22
#define IN_BDN 23
#define IN_NFIN 24

__device__ __forceinline__ void p0_item(const float* W, int ldw, int col0, int cstride, const float* kscale, bf16* WT, int K, int dstrow0, int k0, LAS float* scr, int lane, float gsc = 1.f, gu32* cmax = nullptr) {
    (void)cstride;
    const int r = lane >> 3, c4 = (lane & 7) * 4;
    f32x4 v[8];
#pragma unroll
    for (int i = 0; i < 8; ++i) v[i] = *(const GAS f32x4*)(W + (size_t)(k0 + 8 * i + r) * ldw + col0 + c4);
#pragma unroll
    for (int i = 0; i < 8; ++i) { const float sc = kscale ? kscale[k0 + 8 * i + r] : gsc; LAS float* s = scr + (8 * i + r) * 33 + c4; s[0] = v[i].x * sc; s[1] = v[i].y * sc; s[2] = v[i].z * sc; s[3] = v[i].w * sc; }
    LDS_WAIT(); asm volatile("" ::: "memory");
    const int c = lane & 7;
#pragma unroll
    for (int j = 0; j < 4; ++j) { const int n = (lane >> 3) + 8 * j; const LAS float* s = scr + (8 * c) * 33 + n;
        v4u o; o.x = pk2(s[0 * 33], s[1 * 33]); o.y = pk2(s[2 * 33], s[3 * 33]); o.z = pk2(s[4 * 33], s[5 * 33]); o.w = pk2(s[6 * 33], s[7 * 33]);
        if (cmax) { float m = fmaxf(fmaxf(fmaxf(fabsf(s[0 * 33]), fabsf(s[1 * 33])), fmaxf(fabsf(s[2 * 33]), fabsf(s[3 * 33]))), fmaxf(fmaxf(fabsf(s[4 * 33]), fabsf(s[5 * 33])), fmaxf(fabsf(s[6 * 33]), fabsf(s[7 * 33]))));
            m = fmaxf(m, __shfl_xor(m, 1)); m = fmaxf(m, __shfl_xor(m, 2)); m = fmaxf(m, __shfl_xor(m, 4));
            if (c == 0) (void)__hip_atomic_fetch_max(cmax + dstrow0 + n, __builtin_bit_cast(unsigned, m), RLX_AGENT); }
        *(GAS v4u*)(WT + (size_t)(dstrow0 + n) * K + k0 + 8 * c) = o; }
    LDS_WAIT(); asm volatile("" ::: "memory");
}
typedef float p0f2 __attribute__((ext_vector_type(2)));
__device__ __forceinline__ void p0_prologue(Frame& F) {
    unsigned char* ws = F.ws;
    const int gw = F.vcu * NWAVES + F.wave, NGW = F.G * NWAVES, gt = F.vcu * NTHREADS + F.tid, NGT = F.G * NTHREADS;
    {
        LAS float* scr = (LAS float*)(F.lds + RING_OFF + F.wave * 16384);
        constexpr int I_IN1 = 16 * 96, I_IN2 = 16 * 64, I_BH = 8 * 32, I_OUT = 16 * 32;
        constexpr int NITEMS = I_IN1 + I_IN2 + 2 * I_BH + I_OUT;
        for (int it = gw; it < NITEMS; it += NGW) {
            int r = it;
            if (r < I_IN1) { const int kb = r / 96, nb = r % 96; p0_item(F.in[IN_WIN], NIN, 32 * nb, 1, F.in[IN_NMIX], (bf16*)(ws + WS_WIN), D, 32 * nb, 64 * kb, scr, F.lane, 1.f, F.ctl + CW_CMAX); continue; } r -= I_IN1;
            if (r < I_IN2) { const int kb = r / 64, nb = r % 64; p0_item(F.in[IN_WIN], NIN, 3080 + 32 * nb, 1, F.in[IN_NMIX], (bf16*)(ws + WS_WIN), D, 3072 + 32 * nb, 64 * kb, scr, F.lane, 1.f, F.ctl + CW_CMAX); continue; } r -= I_IN2;
            if (r < I_BH) { const int kb = r / 32, nb = r % 32; p0_item(F.in[IN_WBH], D, 32 * nb, 1, nullptr, (bf16*)(ws + WS_WBH), HW, 32 * nb, 64 * kb, scr, F.lane, 1.f / 255.f); continue; } r -= I_BH;
            if (r < I_BH) { const int kb = r / 32, nb = r % 32; p0_item(F.in[IN_WBM], D, 32 * nb, 1, nullptr, (bf16*)(ws + WS_WBM), HW, 32 * nb, 64 * kb, scr, F.lane, 1.f / 255.f); continue; } r -= I_BH;
            { const int kb = r / 32, nb = r % 32; p0_item(F.in[IN_WOUT], D, 32 * nb, 1, nullptr, (bf16*)(ws + WS_WOUT), D, 32 * nb, 64 * kb, scr, F.lane); }
        }
    }
    asm volatile("s_waitcnt vmcnt(0)" ::: "memory"); __syncthreads();
    if (F.tid == 0) (void)__hip_atomic_fetch_add(F.ctl + CW_P0ARR, 1u, RLX_AGENT);
    {
        LAS float* wm = (LAS float*)(F.lds + RING_OFF + 65536);
        { float wa[16], wb[16];
#pragma unroll
          for (int q = 0; q < 16; ++q) { const int u = F.tid + q * NTHREADS, j = u & 7, l = (u >> 3) & 63, i = u >> 9, k = 4 * l + 256 * (i >> 2) + (i & 3); wa[q] = F.in[IN_NMIX][k]; wb[q] = F.in[IN_WIN][(size_t)k * NIN + 3072 + j]; }
#pragma unroll
          for (int q = 0; q < 16; ++q) wm[F.tid + q * NTHREADS] = wa[q] * wb[q]; }
        __syncthreads();
        bf16* XN0 = (bf16*)(ws + WS_XN0); float* XSQ = (float*)(ws + WS_XSQ); unsigned char* XQ = ws + WS_XQ; float* SROW = (float*)(ws + WS_SROW); float* LI = (float*)(ws + WS_LI); float* LF = (float*)(ws + WS_LF);
#define P0_DPP(old, v, ctrl, rmask) __builtin_bit_cast(float, __builtin_amdgcn_update_dpp(__builtin_bit_cast(int, (float)(old)), __builtin_bit_cast(int, (float)(v)), (ctrl), (rmask), 0xf, false))
#define P0_WSUM(v) do { v += P0_DPP(0.f, v, 0x111, 0xf); v += P0_DPP(0.f, v, 0x112, 0xf); v += P0_DPP(0.f, v, 0x114, 0xf); v += P0_DPP(0.f, v, 0x118, 0xf); v += P0_DPP(0.f, v, 0x142, 0xa); v += P0_DPP(0.f, v, 0x143, 0xc); \
        v = __builtin_bit_cast(float, __builtin_amdgcn_readlane(__builtin_bit_cast(int, v), 63)); } while (0)
#define P0_WMAX(v) do { v = fmaxf(v, P0_DPP(0.f, v, 0x111, 0xf)); v = fmaxf(v, P0_DPP(0.f, v, 0x112, 0xf)); v = fmaxf(v, P0_DPP(0.f, v, 0x114, 0xf)); v = fmaxf(v, P0_DPP(0.f, v, 0x118, 0xf)); v = fmaxf(v, P0_DPP(0.f, v, 0x142, 0xa)); v = fmaxf(v, P0_DPP(0.f, v, 0x143, 0xc)); \
        v = __builtin_bit_cast(float, __builtin_amdgcn_readlane(__builtin_bit_cast(int, v), 63)); } while (0)
        f32x4 vn[2][4];
#define P0_LOADROW(dst, V_) do { const int Vc_ = (V_) < NR ? (V_) : NR - 1; const float* src_ = (Vc_ >= NTOK) ? F.in[IN_META] + (size_t)(Vc_ - NTOK) * D : F.in[IN_X] + (size_t)Vc_ * D; \
        const GAS f32x4* xr_ = (const GAS f32x4*)src_ + F.lane; _Pragma("unroll") for (int j = 0; j < 4; ++j) dst[j] = __builtin_nontemporal_load(xr_ + 64 * j); } while (0)
        P0_LOADROW(vn[0], gw); P0_LOADROW(vn[1], gw + NGW);
        const float gb_l = F.in[IN_GATEB][((F.lane >> 4) & 1) * 4 + (F.lane & 3)];
        for (int V0 = gw; V0 < NR; V0 += 2 * NGW) {
            f32x4 v[2][4]; float s[2], am[2];
#pragma unroll
            for (int q = 0; q < 2; ++q) { s[q] = 0.f; am[q] = 0.f;
#pragma unroll
                for (int j = 0; j < 4; ++j) { v[q][j] = vn[q][j]; s[q] += (v[q][j].x * v[q][j].x + v[q][j].y * v[q][j].y) + (v[q][j].z * v[q][j].z + v[q][j].w * v[q][j].w); am[q] = fmaxf(am[q], fmaxf(fmaxf(fabsf(v[q][j].x), fabsf(v[q][j].y)), fmaxf(fabsf(v[q][j].z), fabsf(v[q][j].w)))); } }
            P0_LOADROW(vn[0], V0 + 2 * NGW); P0_LOADROW(vn[1], V0 + 3 * NGW);
            asm volatile("" ::: "memory");
            { float a_ = s[0], b_ = s[1], c_ = am[0], e_ = am[1];
              asm volatile("s_nop 1\n\tv_permlane32_swap_b32 %0, %1\n\tv_permlane32_swap_b32 %2, %3\n\ts_nop 1" : "+v"(a_), "+v"(b_), "+v"(c_), "+v"(e_));
              float ss = a_ + b_, mm = fmaxf(c_, e_);
              ss += P0_DPP(0.f, ss, 0x111, 0xf); mm = fmaxf(mm, P0_DPP(0.f, mm, 0x111, 0xf)); ss += P0_DPP(0.f, ss, 0x112, 0xf); mm = fmaxf(mm, P0_DPP(0.f, mm, 0x112, 0xf));
              ss += P0_DPP(0.f, ss, 0x114, 0xf); mm = fmaxf(mm, P0_DPP(0.f, mm, 0x114, 0xf)); ss += P0_DPP(0.f, ss, 0x118, 0xf); mm = fmaxf(mm, P0_DPP(0.f, mm, 0x118, 0xf));
              ss += P0_DPP(0.f, ss, 0x142, 0xa); mm = fmaxf(mm, P0_DPP(0.f, mm, 0x142, 0xa));
              s[0] = __builtin_bit_cast(float, __builtin_amdgcn_readlane(__builtin_bit_cast(int, ss), 31)); s[1] = __builtin_bit_cast(float, __builtin_amdgcn_readlane(__builtin_bit_cast(int, ss), 63));
              am[0] = __builtin_bit_cast(float, __builtin_amdgcn_readlane(__builtin_bit_cast(int, mm), 31)); am[1] = __builtin_bit_cast(float, __builtin_amdgcn_readlane(__builtin_bit_cast(int, mm), 63)); }
            p0f2 gp[8];
#pragma unroll
            for (int q = 0; q < 2; ++q)
#pragma unroll
                for (int j = 0; j < 8; ++j) gp[j] = (p0f2){0.f, 0.f};
            float rs[2], qi[2];
#pragma unroll
            for (int q = 0; q < 2; ++q) { const int V = V0 + q * NGW; const float ms = s[q] * (1.f / D) + EPS; rs[q] = __builtin_amdgcn_rsqf(ms); const float sq = ms * rs[q];
                const float amx = am[q] * rs[q], srow = amx > 0.f ? amx * (1.f / 127.f) : 1.f; qi[q] = 1.f / srow;
                if (F.lane == 0 && V < NR) { XSQ[V] = sq; SROW[V] = srow; } }
#pragma unroll
            for (int j = 0; j < 4; ++j) {
#pragma unroll
                for (int q = 0; q < 2; ++q) { const int V = V0 + q * NGW; v[q][j] = v[q][j] * rs[q];
                    if (V < NR) {
                        __builtin_nontemporal_store((unsigned long long)pk2(v[q][j].x, v[q][j].y) | ((unsigned long long)pk2(v[q][j].z, v[q][j].w) << 32), (GAS unsigned long long*)(XN0 + (size_t)V * D) + F.lane + 64 * j);
                        { const unsigned t0 = __builtin_bit_cast(unsigned, __builtin_fmaf(v[q][j].x, qi[q], 12582912.f)), t1 = __builtin_bit_cast(unsigned, __builtin_fmaf(v[q][j].y, qi[q], 12582912.f)), t2 = __builtin_bit_cast(unsigned, __builtin_fmaf(v[q][j].z, qi[q], 12582912.f)), t3 = __builtin_bit_cast(unsigned, __builtin_fmaf(v[q][j].w, qi[q], 12582912.f));
                          ((GAS unsigned*)(XQ + (size_t)V * D))[F.lane + 64 * j] = (t0 & 0xffu) | ((t1 & 0xffu) << 8) | ((t2 & 0xffu) << 16) | (t3 << 24); } } }
#pragma unroll
                for (int c = 0; c < 4; ++c) { const LAS f32x4* wp = (const LAS f32x4*)(wm + (((4 * j + c) * 64 + F.lane) * 8)); const f32x4 w0 = wp[0], w1 = wp[1];
                    { const p0f2 xv = {v[0][j][c], v[1][j][c]};
                      gp[0] += xv * (p0f2){w0.x, w0.x}; gp[1] += xv * (p0f2){w0.y, w0.y}; gp[2] += xv * (p0f2){w0.z, w0.z}; gp[3] += xv * (p0f2){w0.w, w0.w};
                      gp[4] += xv * (p0f2){w1.x, w1.x}; gp[5] += xv * (p0f2){w1.y, w1.y}; gp[6] += xv * (p0f2){w1.z, w1.z}; gp[7] += xv * (p0f2){w1.w, w1.w}; } }
            }
            float d;
            { float t8[8], t4[4];
#pragma unroll
              for (int j = 0; j < 8; ++j) { float a_ = gp[j].x, b_ = gp[j].y; asm volatile("s_nop 1\n\tv_permlane32_swap_b32 %0, %1\n\ts_nop 1" : "+v"(a_), "+v"(b_)); t8[j] = a_ + b_; }
#pragma unroll
              for (int j = 0; j < 4; ++j) { float a_ = t8[j], b_ = t8[j + 4]; asm volatile("s_nop 1\n\tv_permlane16_swap_b32 %0, %1\n\ts_nop 1" : "+v"(a_), "+v"(b_)); t4[j] = a_ + b_; }
              const bool b0 = (F.lane & 1) != 0, b1 = (F.lane & 2) != 0;
              const float c0 = (b0 ? t4[1] : t4[0]) + P0_DPP(0.f, b0 ? t4[0] : t4[1], 0xB1, 0xf);
              const float c1 = (b0 ? t4[3] : t4[2]) + P0_DPP(0.f, b0 ? t4[2] : t4[3], 0xB1, 0xf);
              d = (b1 ? c1 : c0) + P0_DPP(0.f, b1 ? c0 : c1, 0x4E, 0xf);
              d += P0_DPP(0.f, d, 0x114, 0xf); d += P0_DPP(0.f, d, 0x118, 0xf); }
            { const int V = V0 + (F.lane >> 5) * NGW; const bool isf = (F.lane & 16) != 0;
              if ((F.lane & 12) == 12 && V < NR) { const float gv = d + gb_l;
                  (isf ? LF : LI)[(size_t)V * 4 + (F.lane & 3)] = isf ? fminf(gv, 0.f) - __logf(1.f + __expf(-fabsf(gv))) : gv; } }
        }
#undef P0_DPP
#undef P0_WSUM
#undef P0_WMAX
        __syncthreads();
    }
    { float* BGUP = (float*)(ws + WS_BGUP); float* RWT = (float*)(ws + WS_RWT);
      for (int u = gt; u < NE * 2 * DFF; u += NGT) { const int e = u >> 11, n = u & 2047, pn = n >> 8, bj = (n >> 7) & 1, j = gu_slot(n & 127); BGUP[u] = F.in[IN_BGU][(size_t)e * 2 * DFF + 2 * (128 * pn + j) + bj]; }
      for (int u = gt; u < NE * D; u += NGT) { const int e = u >> 10, k = u & 1023; RWT[u] = F.in[IN_NFFN][k] * F.in[IN_RW][(size_t)k * NE + e]; } }
}

__device__ __forceinline__ void p0b_quant(Frame& F) {
    unsigned char* ws = F.ws; const int gw = F.vcu * NWAVES + F.wave, NGW = F.G * NWAVES, lane = F.lane;
    LAS float* scr = (LAS float*)(F.lds + RING_OFF + F.wave * 16384);
    unsigned char* W8 = ws + WS_WIN8; float* SCOL = (float*)(ws + WS_SCOL); const float* W = F.in[IN_WIN]; const float* kscale = F.in[IN_NMIX];
    constexpr int I_IN1 = 16 * 96, I_IN2 = 16 * 64;
    const int r = lane >> 3, c4 = (lane & 7) * 4;
    __syncthreads();
    if (F.tid == 0) { unsigned sp = 0; while (__hip_atomic_load(F.ctl + CW_P0ARR, RLX_AGENT) < (unsigned)F.G) { __builtin_amdgcn_s_sleep(2); if (++sp > (1u << 22)) break; } }
    __syncthreads();
    for (int it = gw; it < I_IN1 + I_IN2; it += NGW) {
        int kb, nb, col0, dstrow0;
        if (it < I_IN1) { kb = it / 96; nb = it % 96; col0 = 32 * nb; dstrow0 = 32 * nb; } else { const int q = it - I_IN1; kb = q / 64; nb = q % 64; col0 = 3080 + 32 * nb; dstrow0 = 3072 + 32 * nb; }
        const int k0 = 64 * kb;
        f32x4 v[8];
#pragma unroll
        for (int i = 0; i < 8; ++i) v[i] = *(const GAS f32x4*)(W + (size_t)(k0 + 8 * i + r) * NIN + col0 + c4);
        float qs[4];
#pragma unroll
        for (int e = 0; e < 4; ++e) { const float m = __builtin_bit_cast(float, __hip_atomic_load(F.ctl + CW_CMAX + dstrow0 + c4 + e, RLX_AGENT)); qs[e] = 127.f / fmaxf(m, 1e-30f); }
        if (kb == 0 && lane < 8) {
#pragma unroll
            for (int e = 0; e < 4; ++e) SCOL[dstrow0 + c4 + e] = 1.f / qs[e]; }
#pragma unroll
        for (int i = 0; i < 8; ++i) { const float sc = kscale[k0 + 8 * i + r]; LAS float* s = scr + (8 * i + r) * 33 + c4; s[0] = rintf(v[i].x * sc * qs[0]); s[1] = rintf(v[i].y * sc * qs[1]); s[2] = rintf(v[i].z * sc * qs[2]); s[3] = rintf(v[i].w * sc * qs[3]); }
        LDS_WAIT(); asm volatile("" ::: "memory");
        const int c = lane & 7;
#pragma unroll
        for (int j = 0; j < 4; ++j) { const int n = (lane >> 3) + 8 * j; const LAS float* s = scr + (8 * c) * 33 + n;
            v2u o;
            o.x = ((unsigned)(int)s[0 * 33] & 0xffu) | (((unsigned)(int)s[1 * 33] & 0xffu) << 8) | (((unsigned)(int)s[2 * 33] & 0xffu) << 16) | ((unsigned)(int)s[3 * 33] << 24);
            o.y = ((unsigned)(int)s[4 * 33] & 0xffu) | (((unsigned)(int)s[5 * 33] & 0xffu) << 8) | (((unsigned)(int)s[6 * 33] & 0xffu) << 16) | ((unsigned)(int)s[7 * 33] << 24);
            *(GAS v2u*)(W8 + (size_t)(dstrow0 + n) * D + k0 + 8 * c) = o; }
        LDS_WAIT(); asm volatile("" ::: "memory");
    }
}

__device__ __forceinline__ unsigned pk4_fp8(float a, float b, float c, float d) { unsigned w = 0;
    a = __builtin_amdgcn_fmed3f(a, -448.f, 448.f); b = __builtin_amdgcn_fmed3f(b, -448.f, 448.f); c = __builtin_amdgcn_fmed3f(c, -448.f, 448.f); d = __builtin_amdgcn_fmed3f(d, -448.f, 448.f);
    w = __builtin_amdgcn_cvt_pk_fp8_f32(a, b, w, false); w = __builtin_amdgcn_cvt_pk_fp8_f32(c, d, w, true); return w; }
__device__ __forceinline__ void cvdn_load(const float* Wdn, int it, f32x4 (&v)[8], int lane) {
    const int e = it >> 9, kb = (it >> 5) & 15, nb = it & 31, r = lane >> 3, c4 = (lane & 7) * 4; const float* W = Wdn + (size_t)e * DFF * D;
#pragma unroll
    for (int i = 0; i < 8; ++i) v[i] = *(const GAS f32x4*)(W + (size_t)(64 * kb + 8 * i + r) * D + 32 * nb + c4);
}
__device__ __forceinline__ void cvdn_proc(unsigned char* WTdn, int it, const f32x4 (&v)[8], LAS float* scr, int lane) {
    const int e = it >> 9, kb = (it >> 5) & 15, nb = it & 31, r = lane >> 3, c4 = (lane & 7) * 4; unsigned char* WT = WTdn + (size_t)e * D * DFF;
#pragma unroll
    for (int i = 0; i < 8; ++i) { LAS float* s = scr + (8 * i + r) * 33 + c4; s[0] = v[i].x * 32.f; s[1] = v[i].y * 32.f; s[2] = v[i].z * 32.f; s[3] = v[i].w * 32.f; }
    LDS_WAIT(); asm volatile("" ::: "memory");
    const int c = lane & 7;
#pragma unroll
    for (int j = 0; j < 4; ++j) { const int n = (lane >> 3) + 8 * j; const LAS float* s = scr + (8 * c) * 33 + n;
        v2u o; o.x = pk4_fp8(s[0 * 33], s[1 * 33], s[2 * 33], s[3 * 33]); o.y = pk4_fp8(s[4 * 33], s[5 * 33], s[6 * 33], s[7 * 33]);
        const int cn = 32 * nb + n, rowp = (cn & ~255) + 128 * ((cn >> 3) & 1) + 32 * ((cn >> 6) & 3) + 8 * ((cn >> 4) & 3) + (cn & 7);
        *(GAS v2u*)(WT + (size_t)rowp * DFF + 64 * kb + 8 * c) = o; }
    LDS_WAIT(); asm volatile("" ::: "memory");
}
__device__ __forceinline__ void cvgu_load(const float* Wgu, const float* nffn, int it, f32x4 (&v)[8], float (&sc)[8], int lane) {
    const int e = it >> 10, kb = (it >> 5) & 31, nb = it & 31, r = lane >> 4, c4 = (lane & 15) * 4; const float* W = Wgu + (size_t)e * D * 2 * DFF;
#pragma unroll
    for (int i = 0; i < 8; ++i) { v[i] = *(const GAS f32x4*)(W + (size_t)(32 * kb + 4 * i + r) * (2 * DFF) + 64 * nb + c4); sc[i] = nffn[32 * kb + 4 * i + r] * 32.f; }
}
__device__ __forceinline__ void cvgu_proc(unsigned char* WTgu, int it, const f32x4 (&v)[8], const float (&sc)[8], LAS float* scr, int lane) {
    const int e = it >> 10, kb = (it >> 5) & 31, nb = it & 31, r = lane >> 4, c4 = (lane & 15) * 4, A0 = 32 * nb, k0 = 32 * kb; unsigned char* WT = WTgu + (size_t)e * 2 * DFF * D;
    LAS float* sg = scr; LAS float* su = scr + 32 * 33;
#pragma unroll
    for (int i = 0; i < 8; ++i) { const int o = (4 * i + r) * 33 + (c4 >> 1); sg[o] = v[i].x * sc[i]; su[o] = v[i].y * sc[i]; sg[o + 1] = v[i].z * sc[i]; su[o + 1] = v[i].w * sc[i]; }
    LDS_WAIT(); asm volatile("" ::: "memory");
    const int c = lane & 3;
#pragma unroll
    for (int j = 0; j < 4; ++j) { const int q = (lane >> 2) + 16 * j, isup = q >> 5, jj = q & 31, A = A0 + jj; const LAS float* s = scr + isup * 32 * 33 + (8 * c) * 33 + jj;
        v2u o; o.x = pk4_fp8(s[0 * 33], s[1 * 33], s[2 * 33], s[3 * 33]); o.y = pk4_fp8(s[4 * 33], s[5 * 33], s[6 * 33], s[7 * 33]);
        *(GAS v2u*)(WT + (size_t)(256 * (A >> 7) + 128 * isup + gu_slot(A & 127)) * D + k0 + 8 * c) = o; }
    LDS_WAIT(); asm volatile("" ::: "memory");
}
__device__ __forceinline__ void px_experts(Frame& F, int rank, int nwg) {
    unsigned char* ws = F.ws;
    LAS float* scr = (LAS float*)(F.lds + RING_OFF + F.wave * 16384);
    const int gw = rank * NWAVES + F.wave, NGW = nwg * NWAVES;
    { constexpr int NIT = NE * 1024, PER = NIT / (128 * NWAVES); f32x4 v[8], vn[8]; float sc[8], sn[8];
      static_assert(PER * 128 * NWAVES == NIT, "whole runs");
      const int L0 = gw * PER;
#define CV_IT_GU(L) ((((L) >> 10) << 10) + (((L) & 31) << 5) + (((L) >> 5) & 31))
      if (gw < NGW) cvgu_load(F.in[IN_WGU], F.in[IN_NFFN], CV_IT_GU(L0), v, sc, F.lane);
      for (int j = 0; j < PER; ++j) { const int L = L0 + j; if (j + 1 < PER) cvgu_load(F.in[IN_WGU], F.in[IN_NFFN], CV_IT_GU(L + 1), vn, sn, F.lane);
          asm volatile("" ::: "memory");
          cvgu_proc((unsigned char*)(ws + WS_WGU), CV_IT_GU(L), v, sc, scr, F.lane); asm volatile("" ::: "memory");
#pragma unroll
          for (int i = 0; i < 8; ++i) { v[i] = vn[i]; sc[i] = sn[i]; } }
#undef CV_IT_GU
    }
    { constexpr int NIT = NE * 512, PER = NIT / (128 * NWAVES); f32x4 v[8], vn[8];
      static_assert(PER * 128 * NWAVES == NIT, "whole runs");
      const int L0 = gw * PER;
#define CV_IT_DN(L) ((((L) >> 9) << 9) + (((L) & 15) << 5) + (((L) >> 4) & 31))
      if (gw < NGW) cvdn_load(F.in[IN_WDN], CV_IT_DN(L0), v, F.lane);
      for (int j = 0; j < PER; ++j) { const int L = L0 + j; if (j + 1 < PER) cvdn_load(F.in[IN_WDN], CV_IT_DN(L + 1), vn, F.lane);
          asm volatile("" ::: "memory");
          cvdn_proc((unsigned char*)(ws + WS_WDN), CV_IT_DN(L), v, scr, F.lane); asm volatile("" ::: "memory");
#pragma unroll
          for (int i = 0; i < 8; ++i) v[i] = vn[i]; }
#undef CV_IT_DN
    }
}

namespace pg8 {
typedef unsigned v2u_t __attribute__((ext_vector_type(2)));
typedef float f32x2 __attribute__((ext_vector_type(2)));
__device__ __forceinline__ f32x2 sig2(f32x2 x) { const f32x2 t = x * (f32x2){-1.4426950408889634f, -1.4426950408889634f};
    const f32x2 d = (f32x2){__builtin_amdgcn_exp2f(t.x), __builtin_amdgcn_exp2f(t.y)} + (f32x2){1.f, 1.f}; return (f32x2){__builtin_amdgcn_rcpf(d.x), __builtin_amdgcn_rcpf(d.y)}; }
__device__ __forceinline__ u32x4 pack8(const f32x4& a, const f32x4& b) { u32x4 w; w.x = cvt_pk_bf16(a[0], a[1]); w.y = cvt_pk_bf16(a[2], a[3]); w.z = cvt_pk_bf16(b[0], b[1]); w.w = cvt_pk_bf16(b[2], b[3]); return w; }
__device__ __forceinline__ v2u_t pack8_fp8(const f32x4& a, const f32x4& b) { unsigned lo = 0, hi = 0;
    lo = __builtin_amdgcn_cvt_pk_fp8_f32(a[0], a[1], lo, false); lo = __builtin_amdgcn_cvt_pk_fp8_f32(a[2], a[3], lo, true);
    hi = __builtin_amdgcn_cvt_pk_fp8_f32(b[0], b[1], hi, false); hi = __builtin_amdgcn_cvt_pk_fp8_f32(b[2], b[3], hi, true); return (v2u_t){lo, hi}; }
__device__ __forceinline__ v2u_t pack8_fp8_sat(const f32x4& a, const f32x4& b) { f32x4 x, y;
#pragma unroll
    for (int i = 0; i < 4; ++i) { x[i] = __builtin_amdgcn_fmed3f(a[i], -448.f, 448.f); y[i] = __builtin_amdgcn_fmed3f(b[i], -448.f, 448.f); }
    return pack8_fp8(x, y); }
__device__ __forceinline__ void unpack8(const u32x4& w, f32x4& a, f32x4& b) { a = (f32x4){bflo(w.x), bfhi(w.x), bflo(w.y), bfhi(w.y)}; b = (f32x4){bflo(w.z), bfhi(w.z), bflo(w.w), bfhi(w.w)}; }
__host__ __device__ __forceinline__ int gate_pos(int c) { return (c & ~255) + ((((c >> 5) & 3) * 4 + ((c >> 3) & 3)) * 16) + (((c >> 7) & 1) * 8) + (c & 7); }
__device__ __forceinline__ unsigned q8x4(float a, float b, float c, float d) {
    const unsigned t0 = __builtin_bit_cast(unsigned, __builtin_fmaf(a, 255.f, 8388608.f)), t1 = __builtin_bit_cast(unsigned, __builtin_fmaf(b, 255.f, 8388608.f));
    const unsigned t2 = __builtin_bit_cast(unsigned, __builtin_fmaf(c, 255.f, 8388608.f)), t3 = __builtin_bit_cast(unsigned, __builtin_fmaf(d, 255.f, 8388608.f));
    return (t0 & 0xffu) | (t1 << 8) | (t2 << 16) | (t3 << 24); }
__device__ __forceinline__ f32x4 dq8x4(unsigned w) { return (f32x4){(float)(w & 0xffu), (float)((w >> 8) & 0xffu), (float)((w >> 16) & 0xffu), (float)(w >> 24)}; }
struct EpiNull { static constexpr bool PERM = true, AFTER_DRAIN = false; int* sink;
    __device__ __forceinline__ void operator()(const f32x4 (&acc)[2][2][4][2], const Unit& u, int wr, int wc, int fr, int fq) const { int s = 0;
#pragma unroll
        for (int a = 0; a < 2; ++a)
#pragma unroll
            for (int b = 0; b < 2; ++b)
#pragma unroll
                for (int m = 0; m < 4; ++m)
#pragma unroll
                    for (int n = 0; n < 2; ++n) { const i32x4 q = __builtin_bit_cast(i32x4, acc[a][b][m][n]); s += (q[0] ^ q[1]) + (q[2] ^ q[3]); }
        if (s == 0x7fffff01 + u.pm) sink[0] = s; } };
template <bool Q, bool NS = false>
struct EpiProjT {
    static constexpr bool PERM = true, AFTER_DRAIN = false;
    unsigned char* ws; const float* lbl; const float* srow; const float* scol;
    struct Sc { float rs[8]; f32x2 cs[2][4]; };
    __device__ __forceinline__ f32x2 val(const f32x4 (&acc)[2][2][4][2], const Sc& sc, int ai, int bj, int m, int k) const {
        const f32x4 a = acc[ai][bj][m][k >> 1];
        if constexpr (Q) { const i32x4 q = __builtin_bit_cast(i32x4, a); const float r = sc.rs[ai * 4 + m]; return ((f32x2){(float)q[2 * (k & 1)], (float)q[2 * (k & 1) + 1]} * sc.cs[bj][k]) * (f32x2){r, r}; }
        else return (f32x2){a[2 * (k & 1)], a[2 * (k & 1) + 1]};
    }
    template <int ACT>
    __device__ __forceinline__ void emit(const f32x4 (&acc)[2][2][4][2], const Sc& sc, bf16_t* O, int row0, int colt) const {
#pragma unroll
        for (int ai = 0; ai < 2; ++ai)
#pragma unroll
            for (int m = 0; m < 4; ++m) { bf16_t* rowp = O + (size_t)(row0 + ai * HALF + m * 16) * HW + colt;
#pragma unroll
                for (int bj = 0; bj < 2; ++bj) { u32x4 o;
#pragma unroll
                    for (int k = 0; k < 4; ++k) { f32x2 p = val(acc, sc, ai, bj, m, k);
                        if constexpr (ACT == 1) p = p * sig2(p); else if constexpr (ACT == 2) p = sig2(p);
                        o[k] = cvt_pk_bf16(p.x, p.y); }
                    if constexpr (NS) asm volatile("" :: "v"(o.x), "v"(o.y), "v"(o.z), "v"(o.w)); else *(u32x4*)(rowp + bj * HALF) = o; } }
    }
    __device__ __forceinline__ void operator()(const f32x4 (&acc)[2][2][4][2], const Unit& u, int wr, int wc, int fr, int fq) const {
        const int row0 = u.pm * BM + wr * 64 + fr, kind = u.pn < 12 ? (u.pn >> 1) : 6;
        const int colt = (u.pn < 12 ? (u.pn & 1) : (u.pn - 12)) * BM + wc * 32 + 8 * fq;
        Sc sc;
        if constexpr (Q) {
#pragma unroll
            for (int it = 0; it < 8; ++it) sc.rs[it] = srow[row0 + (it >> 2) * HALF + (it & 3) * 16];
#pragma unroll
            for (int bj = 0; bj < 2; ++bj) { const float* cp = scol + u.pn * BM + wc * 32 + 8 * fq + bj * HALF; const f32x4 c0 = *(const f32x4*)cp, c1 = *(const f32x4*)(cp + 4);
                sc.cs[bj][0] = (f32x2){c0[0], c0[1]}; sc.cs[bj][1] = (f32x2){c0[2], c0[3]}; sc.cs[bj][2] = (f32x2){c1[0], c1[1]}; sc.cs[bj][3] = (f32x2){c1[2], c1[3]}; }
        }
        if (kind == 1) {
            bf16_t* HG = (bf16_t*)(ws + WS_HG);
#pragma unroll
            for (int bj = 0; bj < 2; ++bj) { const int c = colt + bj * HALF; f32x2 lb[4], ol[4];
#pragma unroll
                for (int k = 0; k < 4; ++k) { lb[k] = sig2((f32x2){lbl[c + 2 * k] - lbl[HW + c + 2 * k], lbl[c + 2 * k + 1] - lbl[HW + c + 2 * k + 1]}); ol[k] = (f32x2){1.f, 1.f} - lb[k]; }
#pragma unroll
                for (int ai = 0; ai < 2; ++ai)
#pragma unroll
                    for (int m = 0; m < 4; ++m) { u32x4 o;
#pragma unroll
                        for (int k = 0; k < 4; ++k) { const f32x2 f = ol[k] * sig2(val(acc, sc, ai, bj, m, k)) + lb[k];
                            const f32x2 lg = (f32x2){__builtin_amdgcn_logf(f.x), __builtin_amdgcn_logf(f.y)} * (f32x2){0.6931471805599453f, 0.6931471805599453f}; o[k] = cvt_pk_bf16(lg.x, lg.y); }
                        if constexpr (NS) asm volatile("" :: "v"(o.x), "v"(o.y), "v"(o.z), "v"(o.w)); else *(u32x4*)(HG + (size_t)(row0 + ai * HALF + m * 16) * HW + c) = o; } }
            return;
        }
        if (kind == 6) {
            unsigned char* G8 = ws + WS_GATES; const int gofs = (u.pn - 12) * BM + (wc * 4 + fq) * 16;
#pragma unroll
            for (int ai = 0; ai < 2; ++ai)
#pragma unroll
                for (int m = 0; m < 4; ++m) { u32x4 o;
#pragma unroll
                    for (int bj = 0; bj < 2; ++bj)
#pragma unroll
                        for (int h = 0; h < 2; ++h) {
                            const f32x2 sa = sig2(val(acc, sc, ai, bj, m, 2 * h)), sb = sig2(val(acc, sc, ai, bj, m, 2 * h + 1));
                            o[2 * bj + h] = q8x4(sa.x, sa.y, sb.x, sb.y); }
                    if constexpr (NS) asm volatile("" :: "v"(o.x), "v"(o.y), "v"(o.z), "v"(o.w)); else __builtin_nontemporal_store(o, (u32x4*)(G8 + (size_t)(row0 + ai * HALF + m * 16) * 2048 + gofs)); }
            return;
        }
        if (kind == 0) emit<1>(acc, sc, (bf16_t*)(ws + WS_HQ), row0, colt); else if (kind == 2) emit<0>(acc, sc, (bf16_t*)(ws + WS_HV), row0, colt); else if (kind == 3) emit<1>(acc, sc, (bf16_t*)(ws + WS_HGATE), row0, colt);
        else if (kind == 4) emit<0>(acc, sc, (bf16_t*)(ws + WS_MM), row0, colt); else emit<2>(acc, sc, (bf16_t*)(ws + WS_MO), row0, colt);
    }
};
constexpr int PAIR_DA = 132, PAIR_DB = 4;
struct PairOrder { StaticOrder S;
    __device__ __forceinline__ bool next(int i, Unit& u) const { Unit t; if (!S.next(i >> 1, t)) return false; const int s = i & 1; u.pm = t.pm + PAIR_DA * s; u.pn = t.pn + PAIR_DB * s; return true; }
    __device__ __forceinline__ void a_ready(const Unit&) const {}
    __device__ __forceinline__ void done(const Unit&) const {}
};
struct EpiGate2 {
    static constexpr bool PERM = true, AFTER_DRAIN = false, CHAIN = true;
    const unsigned char* __restrict__ gates; bf16_t* __restrict__ merged;
    __device__ __forceinline__ bool chain(f32x4 (&acc)[2][2][4][2], const Unit& u, int wr, int wc, int fr, int fq) const {
        const int step = u.pm >= PAIR_DA ? 1 : 0, pm = u.pm - PAIR_DA * step, pn = u.pn - PAIR_DB * step;
        const int row0 = pm * BM + wr * 64 + fr, col0 = pn * BM + wc * 32 + 8 * fq, gofs = pn * BM + (wc * 4 + fq) * 16;
        constexpr int NB = 2, NBAT = 8 / NB;
        u32x4 g0c[NB], g1c[NB], g0n[NB], g1n[NB];
#define EG_LOAD(G0, G1, b_) do { _Pragma("unroll") for (int s_ = 0; s_ < NB; ++s_) { const int it_ = (b_) * NB + s_; const size_t row_ = (size_t)(row0 + (it_ >> 2) * HALF + (it_ & 3) * 16); \
        G1[s_] = *(const u32x4*)(gates + row_ * 2048 + D + gofs); if (!step) G0[s_] = *(const u32x4*)(gates + row_ * 2048 + gofs); else G0[s_] = (u32x4){0u, 0u, 0u, 0u}; } } while (0)
        EG_LOAD(g0c, g1c, 0);
#pragma unroll
        for (int b = 0; b < NBAT; ++b) {
            if (b + 1 < NBAT) EG_LOAD(g0n, g1n, b + 1);
#pragma unroll
            for (int s = 0; s < NB; ++s) { const int it = b * NB + s, ai = it >> 2, m = it & 3; const size_t row = (size_t)(row0 + ai * HALF + m * 16);
#pragma unroll
                for (int bj = 0; bj < 2; ++bj) {
                    f32x4 q1a = dq8x4(g1c[s][2 * bj]), q1b = dq8x4(g1c[s][2 * bj + 1]);
#pragma unroll
                    for (int i = 0; i < 4; ++i) { q1a[i] = fmaxf(q1a[i], 1.f); q1b[i] = fmaxf(q1b[i], 1.f); }
                    if (!step) { const f32x4 q0a = dq8x4(g0c[s][2 * bj]), q0b = dq8x4(g0c[s][2 * bj + 1]); f32x4 ra, rb;
#pragma unroll
                        for (int i = 0; i < 4; ++i) { ra[i] = q0a[i] * __builtin_amdgcn_rcpf(q1a[i]); rb[i] = q0b[i] * __builtin_amdgcn_rcpf(q1b[i]); }
                        acc[ai][bj][m][0] = acc[ai][bj][m][0] * ra; acc[ai][bj][m][1] = acc[ai][bj][m][1] * rb; }
                    else *(u32x4*)(merged + row * D + col0 + bj * HALF) = pack8(acc[ai][bj][m][0] * q1a, acc[ai][bj][m][1] * q1b); } }
#pragma unroll
            for (int s = 0; s < NB; ++s) { g0c[s] = g0n[s]; g1c[s] = g1n[s]; } }
#undef EG_LOAD
        return !step;
    }
};
struct EpiH1 {
    static constexpr bool PERM = true, AFTER_DRAIN = false;
    const bf16_t* __restrict__ xn0; const float* __restrict__ xsq; bf16_t* __restrict__ H1; unsigned char* __restrict__ H1B8;
    __device__ __forceinline__ void operator()(const f32x4 (&acc)[2][2][4][2], const Unit& u, int wr, int wc, int fr, int fq) const {
        const int row0 = u.pm * BM + wr * 64 + fr, col0 = u.pn * BM + wc * 32 + 8 * fq;
        u32x4 xc[2], xn[2]; float sc, sn;
#define EH_LOAD(X, S_, it_) do { const size_t r_ = (size_t)(row0 + ((it_) >> 2) * HALF + ((it_) & 3) * 16); const bf16_t* src_ = xn0 + r_ * D + col0; S_ = xsq[r_]; _Pragma("unroll") for (int bj = 0; bj < 2; ++bj) X[bj] = *(const u32x4*)(src_ + bj * HALF); } while (0)
        EH_LOAD(xc, sc, 0);
#pragma unroll
        for (int it = 0; it < 8; ++it) { const int ai = it >> 2, m = it & 3; const size_t V = (size_t)(row0 + ai * HALF + m * 16);
            if (it + 1 < 8) EH_LOAD(xn, sn, it + 1);
#pragma unroll
            for (int bj = 0; bj < 2; ++bj) { const int c = col0 + bj * HALF; f32x4 x0, x1; unpack8(xc[bj], x0, x1);
                const f32x4 v0 = x0 * sc + acc[ai][bj][m][0], v1 = x1 * sc + acc[ai][bj][m][1];
                __builtin_nontemporal_store(pack8(v0, v1), (u32x4*)(H1 + V * D + c)); *(v2u_t*)(H1B8 + V * D + c) = pack8_fp8_sat(v0, v1); }
#pragma unroll
            for (int bj = 0; bj < 2; ++bj) xc[bj] = xn[bj];
            sc = sn; }
#undef EH_LOAD
    }
};
template <bool NS = false>
struct EpiGUT {
    static constexpr bool PERM = true, AFTER_DRAIN = false;
    const float* __restrict__ bgup; const float* __restrict__ ers; unsigned char* __restrict__ act; const PG8_LAS int* pst;
    __device__ __forceinline__ void operator()(const f32x4 (&acc)[2][2][4][2], const Unit& u, int wr, int wc, int fr, int fq) const {
        const int e = u.pn >> 3, pn = u.pn & 7, row0 = u.pm * BM + wr * 64 + fr, cc = wc * 32 + 8 * fq;
        const float* rsp = ers + (size_t)e * NV + (row0 - pst[e]);
        const float* bp = bgup + (size_t)e * 2 * DFF + pn * BM + cc;
        f32x2 bg[2][2], bu[2][2];
#pragma unroll
        for (int h = 0; h < 2; ++h) { const f32x4 g4 = *(const f32x4*)(bp + 4 * h), u4 = *(const f32x4*)(bp + HALF + 4 * h);
            bg[h][0] = (f32x2){g4[0], g4[1]}; bg[h][1] = (f32x2){g4[2], g4[3]}; bu[h][0] = (f32x2){u4[0] + 1.f, u4[1] + 1.f}; bu[h][1] = (f32x2){u4[2] + 1.f, u4[3] + 1.f}; }
        float rsv[8];
#pragma unroll
        for (int it = 0; it < 8; ++it) rsv[it] = rsp[(it >> 2) * HALF + (it & 3) * 16];
        const int hi = fq >> 1;
        unsigned char* obase = act + (size_t)(row0 + 16 * hi) * DFF + pn * HALF + wc * 32 + 16 * (fq & 1);
        constexpr float KS = -1.702f * 1.4426950408889634f;
#pragma unroll
        for (int ai = 0; ai < 2; ++ai)
#pragma unroll
            for (int mp = 0; mp < 2; ++mp) { v2u_t pk[2];
#pragma unroll
                for (int q = 0; q < 2; ++q) { const int m = 2 * mp + q; const float rs = rsv[ai * 4 + m] * 0.03125f;
                    const f32x2 rs2 = {rs, rs}; unsigned w[2];
#pragma unroll
                    for (int h = 0; h < 2; ++h) { f32x2 o[2];
#pragma unroll
                        for (int p = 0; p < 2; ++p) {
                            f32x2 g = (f32x2){acc[ai][0][m][h][2 * p], acc[ai][0][m][h][2 * p + 1]} * rs2 + bg[h][p];
                            f32x2 u1 = (f32x2){acc[ai][1][m][h][2 * p], acc[ai][1][m][h][2 * p + 1]} * rs2 + bu[h][p];
                            g.x = fminf(g.x, 7.f); g.y = fminf(g.y, 7.f); u1.x = __builtin_amdgcn_fmed3f(u1.x, -6.f, 8.f); u1.y = __builtin_amdgcn_fmed3f(u1.y, -6.f, 8.f);
                            const f32x2 t = g * (f32x2){KS, KS};
                            const f32x2 d = (f32x2){__builtin_amdgcn_exp2f(t.x), __builtin_amdgcn_exp2f(t.y)} + (f32x2){1.f, 1.f};
                            const f32x2 r = {__builtin_amdgcn_rcpf(d.x), __builtin_amdgcn_rcpf(d.y)};
                            o[p] = (g * r) * u1; }
                        w[h] = __builtin_amdgcn_cvt_pk_fp8_f32(o[0].x, o[0].y, 0u, false); w[h] = __builtin_amdgcn_cvt_pk_fp8_f32(o[1].x, o[1].y, w[h], true); }
                    pk[q] = (v2u_t){w[0], w[1]}; }
                const auto r0 = __builtin_amdgcn_permlane32_swap(pk[0][0], pk[1][0], false, false), r1 = __builtin_amdgcn_permlane32_swap(pk[0][1], pk[1][1], false, false);
                if constexpr (NS) asm volatile("" :: "v"(r0[0]), "v"(r1[0]), "v"(r0[1]), "v"(r1[1])); else *(u32x4*)(obase + (size_t)(ai * HALF + mp * 32) * DFF) = (u32x4){r0[0], r1[0], r0[1], r1[1]}; }
    }
};
template <bool NS = false>
struct EpiDownT {
    static constexpr bool PERM = true, AFTER_DRAIN = false;
    const float* __restrict__ bdn; const float* __restrict__ ew; unsigned char* __restrict__ yb; const PG8_LAS int* pst;
    __device__ __forceinline__ void operator()(const f32x4 (&acc)[2][2][4][2], const Unit& u, int wr, int wc, int fr, int fq) const {
        const int e = u.pn >> 2, pn = u.pn & 3, row0 = u.pm * BM + wr * 64 + fr, col0 = pn * BM + wc * 64 + 16 * fq;
        const float* wp = ew + (size_t)e * NV + (row0 - pst[e]);
        f32x4 bv[2][2];
#pragma unroll
        for (int bj = 0; bj < 2; ++bj) { bv[bj][0] = *(const f32x4*)(bdn + (size_t)e * D + col0 + 8 * bj); bv[bj][1] = *(const f32x4*)(bdn + (size_t)e * D + col0 + 8 * bj + 4); }
        float wv[8];
#pragma unroll
        for (int it = 0; it < 8; ++it) wv[it] = wp[(it >> 2) * HALF + (it & 3) * 16];
#pragma unroll
        for (int ai = 0; ai < 2; ++ai)
#pragma unroll
            for (int m = 0; m < 4; ++m) { const size_t row = (size_t)(row0 + ai * HALF + m * 16); const float w = wv[ai * 4 + m] * 16.f;
                const v2u_t lo = pack8_fp8_sat((acc[ai][0][m][0] * 0.03125f + bv[0][0]) * w, (acc[ai][0][m][1] * 0.03125f + bv[0][1]) * w), hi = pack8_fp8_sat((acc[ai][1][m][0] * 0.03125f + bv[1][0]) * w, (acc[ai][1][m][1] * 0.03125f + bv[1][1]) * w);
                if constexpr (NS) asm volatile("" :: "v"(lo[0]), "v"(lo[1]), "v"(hi[0]), "v"(hi[1])); else __builtin_nontemporal_store((u32x4){lo[0], lo[1], hi[0], hi[1]}, (u32x4*)(yb + row * D + col0)); }
    }
};
struct GroupOrder {
    int ntiles, ncol, G, c; const PG8_LAS unsigned char* texp;
    __device__ __forceinline__ bool next(int i, Unit& u) const { const int x = c & 7, w = c >> 3, uu = i * (G >> 3) + w, lj = uu / ncol, pn = uu - lj * ncol, bs = ncol == 4 ? 3 : 2  , j = ((lj >> bs) << (bs + 3)) + (x << bs) + (lj & ((1 << bs) - 1)); if (j >= ntiles) return false; u.pm = j; u.pn = (int)texp[j] * ncol + pn; return true; }
    __device__ __forceinline__ void a_ready(const Unit&) const {}
    __device__ __forceinline__ void done(const Unit&) const {}
};
typedef EpiDownT<false> EpiDown; typedef EpiGUT<false> EpiGU;
}
typedef float f32v2_hg __attribute__((ext_vector_type(2)));

typedef short bf16x8 __attribute__((ext_vector_type(8)));
typedef float f32x16 __attribute__((ext_vector_type(16)));
#define MFMA32(a, b, c) __builtin_amdgcn_mfma_f32_32x32x16_bf16(a, b, c, 0, 0, 0)
__device__ __forceinline__ bf16x8 ldfrag(const LAS unsigned char* base, int st, int row0, int k0, int lane) { return *(const LAS bf16x8*)(base + (row0 + (lane & 31)) * st + (k0 + 8 * (lane >> 5)) * 2); }
__device__ __forceinline__ bf16x8 ldf(const LAS unsigned char* lanebase, int off) { return *(const LAS bf16x8*)(lanebase + off); }
__device__ __forceinline__ float fexp(float x) { return __builtin_amdgcn_exp2f(x * 1.4426950408889634f); }

__device__ __forceinline__ void p3_hgrn2_mfma(Frame& F, int bh) {
    unsigned char* ws = F.ws; const int b = bh >> 2, h = bh & 3, tid = F.tid, lane = F.lane, wave = F.wave, hh = lane >> 5, l31 = lane & 31;
    const bf16* HQ = (const bf16*)(ws + WS_HQ) + h * 128; const bf16* HG = (const bf16*)(ws + WS_HG) + h * 128; const bf16* HV = (const bf16*)(ws + WS_HV) + h * 128;
    const bf16* HGATE = (const bf16*)(ws + WS_HGATE) + h * 128; bf16* YHG = (bf16*)(ws + WS_YHG) + h * 128;
    LAS unsigned char* L = F.lds + RING_OFF;
    LAS unsigned char* QT = L; LAS unsigned char* KT = L + 17408; LAS unsigned char* KTT = L + 34816; LAS unsigned char* VT = L + 53248; LAS unsigned char* ST = L + 71680; LAS unsigned char* PP = L + 106496;
    LAS float* SEG = (LAS float*)(L + 118784)  ; LAS float* ER = (LAS float*)(L + 117760); LAS float* EL = (LAS float*)(L + 118272); LAS float* OST = (LAS float*)(L + 17408);
    const int dp = tid & 63, p8 = tid >> 6;
    const int et = tid >> 3, evq = tid & 7;
    const int f144 = l31 * 144 + hh * 16, f272 = l31 * 272 + hh * 16;
    const int sst = wave == 2 ? 1 : 0, stt = wave == 0 ? 0 : 1, dt = wave & 3, vt0 = 2 * (wave >> 2), btt = wave & 1, bvt = wave >> 1;
    const LAS unsigned char* aK = KT + 32 * sst * 272 + f272; const LAS unsigned char* bQ = QT + 32 * stt * 272 + f272;
    LAS unsigned char* pst = PP + (32 * stt + l31) * 144 + (32 * sst + 4 * hh) * 2;
    const LAS unsigned char* aKTT = KTT + 32 * dt * 144 + f144; const LAS unsigned char* bV0 = VT + 32 * vt0 * 144 + f144;
    LAS unsigned char* sst_ = ST + (32 * vt0 + l31) * 272 + (32 * dt + 4 * hh) * 2;
    const LAS float* erp = ER + 32 * dt + 4 * hh; const LAS float* elp = EL + 32 * dt + 4 * hh;
    const LAS unsigned char* aP = PP + 32 * btt * 144 + f144; const LAS unsigned char* bVB = VT + 32 * bvt * 144 + f144;
    const LAS unsigned char* aQ = QT + 32 * btt * 272 + f272; const LAS unsigned char* bS = ST + 32 * bvt * 272 + f272;
    LAS float* ost = OST + (32 * btt + 4 * hh) * 132 + 32 * bvt + l31; const LAS float* oep = OST + et * 132 + 16 * evq;
    LAS unsigned char* tq = QT + 8 * p8 * 272 + dp * 4; LAS unsigned char* tk = KT + 8 * p8 * 272 + dp * 4; LAS unsigned char* tkt = KTT + 2 * dp * 144 + p8 * 16; LAS unsigned char* tv = VT + 2 * dp * 144 + p8 * 16;
    f32x16 S0, S1;
#pragma unroll
    for (int i = 0; i < 16; ++i) { S0[i] = 0.f; S1[i] = 0.f; }
    unsigned gr[8], qr[8], vr[8]; v4u gt0, gt1;
    float gn[16];
#pragma unroll
    for (int i = 0; i < 16; ++i) gn[i] = F.in[IN_HGNORM][h * 128 + 16 * evq + i];
#define HG_LOAD(c) do { const int ttb = 64 * (c) - 48 + 8 * p8; \
        _Pragma("unroll") for (int i = 0; i < 8; ++i) { const int tt = ttb + i; if (tt >= 0) { const size_t gi = rowof(b, tt) * HW + 2 * dp; gr[i] = *(const GAS unsigned*)(HG + gi); qr[i] = *(const GAS unsigned*)(HQ + gi); vr[i] = *(const GAS unsigned*)(HV + gi); } else { gr[i] = 0u; qr[i] = 0u; vr[i] = 0u; } } \
        { const int tt = 64 * (c) - 48 + et; if (tt >= 0) { const GAS v4u* gp = (const GAS v4u*)(HGATE + rowof(b, tt) * HW + 16 * evq); gt0 = gp[0]; gt1 = gp[1]; } else { gt0 = (v4u){0u, 0u, 0u, 0u}; gt1 = gt0; } } } while (0)
    HG_LOAD(0);
    for (int c = 0; c < 33; ++c) {
        float bl[2][8], gq[2][8];
#pragma unroll
        for (int i = 0; i < 8; ++i) { gq[0][i] = bflo(gr[i]); gq[1][i] = bfhi(gr[i]); }
        { float a0 = 0.f, a1 = 0.f;
#pragma unroll
          for (int i = 0; i < 8; ++i) { a0 += gq[0][i]; bl[0][i] = a0; a1 += gq[1][i]; bl[1][i] = a1; } }
        *(LAS f32v2_hg*)(SEG + p8 * 128 + 2 * dp) = (f32v2_hg){bl[0][7], bl[1][7]};
        __syncthreads();
        { f32v2_hg sg[8];
#pragma unroll
          for (int g = 0; g < 8; ++g) sg[g] = *(const LAS f32v2_hg*)(SEG + g * 128 + 2 * dp);
          float off[2], r[2], blast[2];
#pragma unroll
          for (int e = 0; e < 2; ++e) { float o = 0.f;
#pragma unroll
              for (int g = 0; g < 7; ++g) o += (g < p8) ? sg[g][e] : 0.f;
              off[e] = o; r[e] = (sg[0][e] + sg[1][e]) + (sg[2][e] + sg[3][e]); blast[e] = r[e] + ((sg[4][e] + sg[5][e]) + (sg[6][e] + sg[7][e])); }
          unsigned kp[2][4], vp[2][4];
#pragma unroll
          for (int i = 0; i < 8; i += 2) {
              unsigned kk[2], qq[2];
#pragma unroll
              for (int e = 0; e < 2; ++e) { const float b0 = off[e] + bl[e][i], b1 = off[e] + bl[e][i + 1];
                  const float q0 = (e ? bfhi(qr[i]) : bflo(qr[i])) * fexp(b0 - r[e]), q1 = (e ? bfhi(qr[i + 1]) : bflo(qr[i + 1])) * fexp(b1 - r[e]);
                  const float k0 = (1.f - fexp(gq[e][i])) * fexp(r[e] - b0), k1 = (1.f - fexp(gq[e][i + 1])) * fexp(r[e] - b1);
                  kk[e] = pg8::cvt_pk_bf16(k0, k1); qq[e] = pg8::cvt_pk_bf16(q0, q1); kp[e][i >> 1] = kk[e]; }
              *(LAS unsigned*)(tq + i * 272) = (qq[0] & 0xffffu) | (qq[1] << 16); *(LAS unsigned*)(tq + (i + 1) * 272) = (qq[0] >> 16) | (qq[1] & 0xffff0000u);
              *(LAS unsigned*)(tk + i * 272) = (kk[0] & 0xffffu) | (kk[1] << 16); *(LAS unsigned*)(tk + (i + 1) * 272) = (kk[0] >> 16) | (kk[1] & 0xffff0000u);
              vp[0][i >> 1] = (vr[i] & 0xffffu) | (vr[i + 1] << 16); vp[1][i >> 1] = (vr[i] >> 16) | (vr[i + 1] & 0xffff0000u); }
#pragma unroll
          for (int e = 0; e < 2; ++e) { *(LAS v4u*)(tkt + e * 144) = (v4u){kp[e][0], kp[e][1], kp[e][2], kp[e][3]}; *(LAS v4u*)(tv + e * 144) = (v4u){vp[e][0], vp[e][1], vp[e][2], vp[e][3]}; }
          if (p8 == 0) { *(LAS f32v2_hg*)(ER + 2 * dp) = (f32v2_hg){fexp(r[0]), fexp(r[1])}; *(LAS f32v2_hg*)(EL + 2 * dp) = (f32v2_hg){fexp(blast[0] - r[0]), fexp(blast[1] - r[1])}; } }
        const v4u g0 = gt0, g1 = gt1;
        __syncthreads();
        if (c + 1 < 33) HG_LOAD(c + 1);
        asm volatile("" ::: "memory");
        if (wave < 3) {
            f32x16 acc;
#pragma unroll
            for (int i = 0; i < 16; ++i) acc[i] = 0.f;
#pragma unroll
            for (int ks = 0; ks < 8; ++ks) acc = MFMA32(ldf(aK, 32 * ks), ldf(bQ, 32 * ks), acc);
            const int t = 32 * stt + l31;
#pragma unroll
            for (int g4 = 0; g4 < 4; ++g4) { const int s0 = 32 * sst + 8 * g4 + 4 * hh;
                const float x0 = (s0 + 0 <= t) ? acc[4 * g4 + 0] : 0.f, x1 = (s0 + 1 <= t) ? acc[4 * g4 + 1] : 0.f, x2 = (s0 + 2 <= t) ? acc[4 * g4 + 2] : 0.f, x3 = (s0 + 3 <= t) ? acc[4 * g4 + 3] : 0.f;
                *(LAS v2u*)(pst + 16 * g4) = (v2u){pg8::cvt_pk_bf16(x0, x1), pg8::cvt_pk_bf16(x2, x3)}; }
        }
        {
#pragma unroll
          for (int g4 = 0; g4 < 4; ++g4) { const f32x4 er = *(const LAS f32x4*)(erp + 8 * g4);
#pragma unroll
              for (int i = 0; i < 4; ++i) { S0[4 * g4 + i] *= er[i]; S1[4 * g4 + i] *= er[i]; }
              *(LAS v2u*)(sst_ + 16 * g4) = (v2u){pg8::cvt_pk_bf16(S0[4 * g4], S0[4 * g4 + 1]), pg8::cvt_pk_bf16(S0[4 * g4 + 2], S0[4 * g4 + 3])};
              *(LAS v2u*)(sst_ + 32 * 272 + 16 * g4) = (v2u){pg8::cvt_pk_bf16(S1[4 * g4], S1[4 * g4 + 1]), pg8::cvt_pk_bf16(S1[4 * g4 + 2], S1[4 * g4 + 3])}; }
#pragma unroll
          for (int ks = 0; ks < 4; ++ks) { const bf16x8 a = ldf(aKTT, 32 * ks); S0 = MFMA32(a, ldf(bV0, 32 * ks), S0); S1 = MFMA32(a, ldf(bV0, 32 * 144 + 32 * ks), S1); }
#pragma unroll
          for (int g4 = 0; g4 < 4; ++g4) { const f32x4 el = *(const LAS f32x4*)(elp + 8 * g4);
#pragma unroll
              for (int i = 0; i < 4; ++i) { S0[4 * g4 + i] *= el[i]; S1[4 * g4 + i] *= el[i]; } } }
        __syncthreads();
        { f32x16 acc;
#pragma unroll
          for (int i = 0; i < 16; ++i) acc[i] = 0.f;
#pragma unroll
          for (int ks = 0; ks < 4; ++ks) if (ks < 2 || btt == 1) acc = MFMA32(ldf(aP, 32 * ks), ldf(bVB, 32 * ks), acc);
#pragma unroll
          for (int ks = 0; ks < 8; ++ks) acc = MFMA32(ldf(aQ, 32 * ks), ldf(bS, 32 * ks), acc);
#pragma unroll
          for (int i = 0; i < 16; ++i) ost[((i & 3) + 8 * (i >> 2)) * 132] = acc[i]; }
        __syncthreads();
        { const int tt = 64 * c - 48 + et;
          f32x4 o[4]; float ss = 0.f;
#pragma unroll
          for (int j = 0; j < 4; ++j) { o[j] = *(const LAS f32x4*)(oep + 4 * j); ss += (o[j].x * o[j].x + o[j].y * o[j].y) + (o[j].z * o[j].z + o[j].w * o[j].w); }
          ss = sum8_dpp(ss);
          const float rs = 1.0f / sqrtf(ss * (1.f / 128.f) + EPS);
          if (tt >= NMETA || (tt >= 0 && b == 0)) { const unsigned gw[8] = {g0.x, g0.y, g0.z, g0.w, g1.x, g1.y, g1.z, g1.w}; unsigned w[8];
#pragma unroll
              for (int j = 0; j < 4; ++j) { w[2 * j] = pk2(o[j].x * rs * gn[4 * j] * bflo(gw[2 * j]), o[j].y * rs * gn[4 * j + 1] * bfhi(gw[2 * j])); w[2 * j + 1] = pk2(o[j].z * rs * gn[4 * j + 2] * bflo(gw[2 * j + 1]), o[j].w * rs * gn[4 * j + 3] * bfhi(gw[2 * j + 1])); }
              GAS v4u* yp = (GAS v4u*)(YHG + rowof(b, tt) * HW + 16 * evq); yp[0] = (v4u){w[0], w[1], w[2], w[3]}; yp[1] = (v4u){w[4], w[5], w[6], w[7]}; } }
        __syncthreads();
    }
#undef HG_LOAD
}


typedef float sf2 __attribute__((ext_vector_type(2)));
#define DPP_F(old, v, ctrl, rmask) __builtin_bit_cast(float, __builtin_amdgcn_update_dpp(__builtin_bit_cast(int, (float)(old)), __builtin_bit_cast(int, (float)(v)), (ctrl), (rmask), 0xf, false))
__device__ __forceinline__ float wave_scan_add(float v) {
    v += DPP_F(0.f, v, 0x111, 0xf); v += DPP_F(0.f, v, 0x112, 0xf); v += DPP_F(0.f, v, 0x114, 0xf); v += DPP_F(0.f, v, 0x118, 0xf);
    v += DPP_F(0.f, v, 0x142, 0xa); v += DPP_F(0.f, v, 0x143, 0xc); return v;
}
__device__ __forceinline__ float wave_scan_max(float v) {
    const float ni = -INFINITY;
    v = fmaxf(v, DPP_F(ni, v, 0x111, 0xf)); v = fmaxf(v, DPP_F(ni, v, 0x112, 0xf)); v = fmaxf(v, DPP_F(ni, v, 0x114, 0xf)); v = fmaxf(v, DPP_F(ni, v, 0x118, 0xf));
    v = fmaxf(v, DPP_F(ni, v, 0x142, 0xa)); v = fmaxf(v, DPP_F(ni, v, 0x143, 0xc)); return v;
}
__device__ __forceinline__ void p3_mlstm_mfma(Frame& F, int bh) {
    unsigned char* ws = F.ws; const int b = bh >> 2, h = bh & 3, tid = F.tid, lane = F.lane, wave = F.wave, hh = lane >> 5, l31 = lane & 31;
    const bf16* MMg = (const bf16*)(ws + WS_MM) + h * 128; const bf16* MOg = (const bf16*)(ws + WS_MO) + h * 128; const float* LI = (const float*)(ws + WS_LI) + h; const float* LF = (const float*)(ws + WS_LF) + h;
    bf16* YML = (bf16*)(ws + WS_YML) + h * 128;
    LAS unsigned char* L = F.lds + RING_OFF;
    LAS unsigned char* CT = L; LAS unsigned char* MT = L + 17408; LAS unsigned char* KM = L + 34816; LAS unsigned char* KW = L + 44032; LAS unsigned char* QM = L + 53248; LAS unsigned char* QW = L + 62464;
    LAS unsigned char* VT = L + 71680; LAS unsigned char* SV = L + 90112; LAS unsigned char* PP = L + 108544; LAS float* OST = (LAS float*)(L + 17408);
    LAS float* SM = (LAS float*)(L + 117760);
    LAS float* U = SM; LAS float* MX = SM + 64; LAS float* BB = SM + 128; LAS float* WSs = SM + 192; LAS float* WI = SM + 256; LAS float* DENP = SM + 320  ; LAS float* NN = SM + 416; LAS float* DENI = SM + 480; LAS float* SC = SM + 544  ; LAS float* GNS = SM + 560  ;
    const int chp = tid & 63, pq8 = tid >> 6, et = tid >> 3, evq = tid & 7;
    const int f144 = l31 * 144 + hh * 16, f272 = l31 * 272 + hh * 16;
    const int sst = wave == 2 ? 1 : 0, stt = wave == 0 ? 0 : 1, dkt = wave & 1, svt = wave >> 1;
    const LAS unsigned char* cfp = (wave < 4 ? CT : MT) + f272;
    LAS unsigned char* qst = QM + l31 * 144 + (32 * (wave & 1) + 4 * hh) * 2; LAS unsigned char* qwst = QW + l31 * 144 + (32 * (wave & 1) + 4 * hh) * 2;
    const int kdk = 32 * (wave & 1) + l31;
    LAS unsigned char* kmst = KM + 4 * hh * 144 + kdk * 2; LAS unsigned char* kwst = KW + kdk * 144 + 4 * hh * 2; const LAS float* wsp = WSs + 4 * hh;
    LAS unsigned char* vst = VT + (32 * (wave & 3) + l31) * 144 + 4 * hh * 2;
    const LAS unsigned char* aKM = KM + 32 * sst * 144 + f144; const LAS unsigned char* bQM = QM + 32 * stt * 144 + f144;
    LAS unsigned char* pst = PP + (32 * stt + l31) * 144 + (32 * sst + 4 * hh) * 2; const LAS float* up = U + 32 * sst + 4 * hh;
    LAS unsigned char* svst = SV + (32 * svt + l31) * 144 + (32 * dkt + 4 * hh) * 2;
    const LAS unsigned char* aKW = KW + 32 * dkt * 144 + f144; const LAS unsigned char* bVT = VT + 32 * svt * 144 + f144;
    const LAS unsigned char* aP = PP + 32 * dkt * 144 + f144; const LAS unsigned char* aQW = QW + 32 * dkt * 144 + f144; const LAS unsigned char* bSV = SV + 32 * svt * 144 + f144;
    LAS float* ost = OST + (32 * dkt + 4 * hh) * 132 + 32 * svt + l31; const LAS float* oep = OST + et * 132 + 16 * evq;
    LAS unsigned char* tc = CT + 8 * pq8 * 272 + chp * 4; LAS unsigned char* tm = MT + 8 * pq8 * 272 + chp * 4;
    bf16x8 wf[8];
    { const float* W = wave < 2 ? F.in[IN_WQ] + (size_t)h * 128 * 64 + 32 * wave + l31 : wave < 4 ? F.in[IN_WK] + (size_t)h * 128 * 64 + 32 * (wave - 2) + l31 : F.in[IN_WV] + (size_t)h * 128 * 128 + 32 * (wave - 4) + l31;
      const int ld = wave < 4 ? 64 : 128; const float sc = wave < 2 ? 0.125f : 1.f;
#pragma unroll
      for (int ks = 0; ks < 8; ++ks) { unsigned p[4];
#pragma unroll
          for (int j = 0; j < 4; ++j) p[j] = pk2(W[(size_t)(16 * ks + 8 * hh + 2 * j) * ld] * sc, W[(size_t)(16 * ks + 8 * hh + 2 * j + 1) * ld] * sc);
          wf[ks] = __builtin_bit_cast(bf16x8, (v4u){p[0], p[1], p[2], p[3]}); } }
    float cw[4], cx[4]; const float cb = F.in[IN_CONVB][h * 128 + 2 * chp], cc = F.in[IN_CONVB][h * 128 + 2 * chp + 1];
#pragma unroll
    for (int j = 0; j < 4; ++j) { cw[j] = F.in[IN_CONVW][j * HW + h * 128 + 2 * chp]; cx[j] = F.in[IN_CONVW][j * HW + h * 128 + 2 * chp + 1]; }
    if (tid < 128) GNS[tid] = F.in[IN_MLNORM][h * 128 + tid]; else if (tid < 256) GNS[tid] = F.in[IN_MLSKIP][h * 128 + tid - 128];
    f32x16 S;
#pragma unroll
    for (int i = 0; i < 16; ++i) S[i] = 0.f;
    float mcar = 0.f, nreg = 0.f;
    unsigned mr[11]; v4u gt0, gt1; float pli = 0.f, plf = 0.f;
#define ML_LOAD(c) do { const int ttb = 64 * (c) - 48 + 8 * pq8 - 3; \
        _Pragma("unroll") for (int i = 0; i < 11; ++i) { const int tt = ttb + i; mr[i] = tt >= 0 ? *(const GAS unsigned*)(MMg + rowof(b, tt) * HW + 2 * chp) : 0u; } \
        { const int tt = 64 * (c) - 48 + et; if (tt >= 0) { const GAS v4u* gp = (const GAS v4u*)(MOg + rowof(b, tt) * HW + 16 * evq); gt0 = gp[0]; gt1 = gp[1]; } else { gt0 = (v4u){0u, 0u, 0u, 0u}; gt1 = gt0; } } \
        if (wave == 0) { const int tt = 64 * (c) - 48 + lane; if (tt >= 0) { pli = LI[rowof(b, tt) * 4]; plf = LF[rowof(b, tt) * 4]; } else { pli = -1e30f; plf = 0.f; } } } while (0)
    ML_LOAD(0);
    for (int c = 0; c < 33; ++c) {
#pragma unroll
        for (int i = 0; i < 8; ++i) {
            const sf2 x0 = {bflo(mr[i]), bfhi(mr[i])}, x1 = {bflo(mr[i + 1]), bfhi(mr[i + 1])}, x2 = {bflo(mr[i + 2]), bfhi(mr[i + 2])}, x3 = {bflo(mr[i + 3]), bfhi(mr[i + 3])};
            const sf2 a = (sf2){cb, cc} + ((sf2){cw[0], cx[0]} * x0 + (sf2){cw[1], cx[1]} * x1) + ((sf2){cw[2], cx[2]} * x2 + (sf2){cw[3], cx[3]} * x3);
            const sf2 t = a * (sf2){-1.4426950408889634f, -1.4426950408889634f}; const sf2 d = (sf2){__builtin_amdgcn_exp2f(t.x), __builtin_amdgcn_exp2f(t.y)} + (sf2){1.f, 1.f};
            const sf2 s = a * (sf2){__builtin_amdgcn_rcpf(d.x), __builtin_amdgcn_rcpf(d.y)};
            *(LAS unsigned*)(tc + i * 272) = pk2(s.x, s.y); *(LAS unsigned*)(tm + i * 272) = mr[i + 3]; }
        if (wave == 0) {
            const float bs = wave_scan_add(plf);
            const float u = pli - bs; const float pm = wave_scan_max(u);
            const float M = fmaxf(mcar, pm), M63 = __builtin_bit_cast(float, __builtin_amdgcn_readlane(__builtin_bit_cast(int, M), 63)), b63 = __builtin_bit_cast(float, __builtin_amdgcn_readlane(__builtin_bit_cast(int, bs), 63));
            U[lane] = u; MX[lane] = M; BB[lane] = bs; WSs[lane] = fexp(u - M63); WI[lane] = fexp(mcar - M);
            if (lane == 0) { SC[0] = b63; SC[1] = M63; }
        }
        __syncthreads();
        { f32x16 a0, a1;
#pragma unroll
          for (int i = 0; i < 16; ++i) { a0[i] = 0.f; a1[i] = 0.f; }
          if (wave < 2) {
#pragma unroll
              for (int ks = 0; ks < 8; ++ks) { a0 = MFMA32(wf[ks], ldf(cfp, 32 * ks), a0); a1 = MFMA32(wf[ks], ldf(cfp, 32 * 272 + 32 * ks), a1); }
              const float wi0 = WI[l31], wi1 = WI[32 + l31];
#pragma unroll
              for (int g4 = 0; g4 < 4; ++g4) {
                  *(LAS v2u*)(qst + 16 * g4) = (v2u){pg8::cvt_pk_bf16(a0[4 * g4], a0[4 * g4 + 1]), pg8::cvt_pk_bf16(a0[4 * g4 + 2], a0[4 * g4 + 3])};
                  *(LAS v2u*)(qst + 32 * 144 + 16 * g4) = (v2u){pg8::cvt_pk_bf16(a1[4 * g4], a1[4 * g4 + 1]), pg8::cvt_pk_bf16(a1[4 * g4 + 2], a1[4 * g4 + 3])};
                  *(LAS v2u*)(qwst + 16 * g4) = (v2u){pg8::cvt_pk_bf16(a0[4 * g4] * wi0, a0[4 * g4 + 1] * wi0), pg8::cvt_pk_bf16(a0[4 * g4 + 2] * wi0, a0[4 * g4 + 3] * wi0)};
                  *(LAS v2u*)(qwst + 32 * 144 + 16 * g4) = (v2u){pg8::cvt_pk_bf16(a1[4 * g4] * wi1, a1[4 * g4 + 1] * wi1), pg8::cvt_pk_bf16(a1[4 * g4 + 2] * wi1, a1[4 * g4 + 3] * wi1)}; }
          } else {
#pragma unroll
              for (int ks = 0; ks < 8; ++ks) { a0 = MFMA32(ldf(cfp, 32 * ks), wf[ks], a0); a1 = MFMA32(ldf(cfp, 32 * 272 + 32 * ks), wf[ks], a1); }
              if (wave < 4) {
                  float nsum = 0.f;
#pragma unroll
                  for (int g4 = 0; g4 < 4; ++g4) { const f32x4 w0 = *(const LAS f32x4*)(wsp + 8 * g4), w1 = *(const LAS f32x4*)(wsp + 32 + 8 * g4);
#pragma unroll
                      for (int i = 0; i < 4; ++i) { *(LAS unsigned short*)(kmst + (8 * g4 + i) * 144) = (unsigned short)f2bf(a0[4 * g4 + i]); *(LAS unsigned short*)(kmst + (32 + 8 * g4 + i) * 144) = (unsigned short)f2bf(a1[4 * g4 + i]); }
                      const float x0 = a0[4 * g4] * w0[0], x1 = a0[4 * g4 + 1] * w0[1], x2 = a0[4 * g4 + 2] * w0[2], x3 = a0[4 * g4 + 3] * w0[3];
                      const float y0 = a1[4 * g4] * w1[0], y1 = a1[4 * g4 + 1] * w1[1], y2 = a1[4 * g4 + 2] * w1[2], y3 = a1[4 * g4 + 3] * w1[3];
                      nsum += ((x0 + x1) + (x2 + x3)) + ((y0 + y1) + (y2 + y3));
                      *(LAS v2u*)(kwst + 16 * g4) = (v2u){pg8::cvt_pk_bf16(x0, x1), pg8::cvt_pk_bf16(x2, x3)};
                      *(LAS v2u*)(kwst + 64 + 16 * g4) = (v2u){pg8::cvt_pk_bf16(y0, y1), pg8::cvt_pk_bf16(y2, y3)}; }
                  nsum += __shfl_xor(nsum, 32);
                  if (hh == 0) NN[kdk] = nreg;
                  nreg = fexp(mcar - SC[1]) * nreg + nsum;
              } else {
#pragma unroll
                  for (int g4 = 0; g4 < 4; ++g4) {
                      *(LAS v2u*)(vst + 16 * g4) = (v2u){pg8::cvt_pk_bf16(a0[4 * g4], a0[4 * g4 + 1]), pg8::cvt_pk_bf16(a0[4 * g4 + 2], a0[4 * g4 + 3])};
                      *(LAS v2u*)(vst + 64 + 16 * g4) = (v2u){pg8::cvt_pk_bf16(a1[4 * g4], a1[4 * g4 + 1]), pg8::cvt_pk_bf16(a1[4 * g4 + 2], a1[4 * g4 + 3])}; }
              }
          } }
        __syncthreads();
        const v4u g0 = gt0, g1 = gt1;
        if (c + 1 < 33) ML_LOAD(c + 1);
        asm volatile("" ::: "memory");
        if (wave < 3) {
            f32x16 acc;
#pragma unroll
            for (int i = 0; i < 16; ++i) acc[i] = 0.f;
#pragma unroll
            for (int ks = 0; ks < 4; ++ks) acc = MFMA32(ldf(aKM, 32 * ks), ldf(bQM, 32 * ks), acc);
            const int t = 32 * stt + l31; const float mt = MX[t]; float dsum = 0.f;
#pragma unroll
            for (int g4 = 0; g4 < 4; ++g4) { const int s0 = 32 * sst + 8 * g4 + 4 * hh; const f32x4 us = *(const LAS f32x4*)(up + 8 * g4);
                const float x0 = (s0 + 0 <= t) ? acc[4 * g4 + 0] * fexp(us[0] - mt) : 0.f, x1 = (s0 + 1 <= t) ? acc[4 * g4 + 1] * fexp(us[1] - mt) : 0.f;
                const float x2 = (s0 + 2 <= t) ? acc[4 * g4 + 2] * fexp(us[2] - mt) : 0.f, x3 = (s0 + 3 <= t) ? acc[4 * g4 + 3] * fexp(us[3] - mt) : 0.f;
                dsum += (x0 + x1) + (x2 + x3);
                *(LAS v2u*)(pst + 16 * g4) = (v2u){pg8::cvt_pk_bf16(x0, x1), pg8::cvt_pk_bf16(x2, x3)}; }
            dsum += __shfl_xor(dsum, 32);
            if (hh == 0) DENP[wave * 32 + l31] = dsum;
        } else if (wave == 3) {
            float a = 0.f;
#pragma unroll
            for (int j = 0; j < 8; ++j) { const v4u q = *(const LAS v4u*)(QW + lane * 144 + 16 * j); const f32x4 n0 = *(const LAS f32x4*)(NN + 8 * j), n1 = *(const LAS f32x4*)(NN + 8 * j + 4);
                a += (bflo(q.x) * n0[0] + bfhi(q.x) * n0[1]) + (bflo(q.y) * n0[2] + bfhi(q.y) * n0[3]) + (bflo(q.z) * n1[0] + bfhi(q.z) * n1[1]) + (bflo(q.w) * n1[2] + bfhi(q.w) * n1[3]); }
            DENI[lane] = a;
        }
        { const float wp = fexp(mcar - SC[1]);
#pragma unroll
          for (int g4 = 0; g4 < 4; ++g4) {
              *(LAS v2u*)(svst + 16 * g4) = (v2u){pg8::cvt_pk_bf16(S[4 * g4], S[4 * g4 + 1]), pg8::cvt_pk_bf16(S[4 * g4 + 2], S[4 * g4 + 3])};
#pragma unroll
              for (int i = 0; i < 4; ++i) S[4 * g4 + i] *= wp; }
#pragma unroll
          for (int ks = 0; ks < 4; ++ks) S = MFMA32(ldf(aKW, 32 * ks), ldf(bVT, 32 * ks), S); }
        __syncthreads();
        { f32x16 acc;
#pragma unroll
          for (int i = 0; i < 16; ++i) acc[i] = 0.f;
#pragma unroll
          for (int ks = 0; ks < 4; ++ks) if (ks < 2 || dkt == 1) acc = MFMA32(ldf(aP, 32 * ks), ldf(bVT, 32 * ks), acc);
#pragma unroll
          for (int ks = 0; ks < 4; ++ks) acc = MFMA32(ldf(aQW, 32 * ks), ldf(bSV, 32 * ks), acc);
#pragma unroll
          for (int i = 0; i < 16; ++i) ost[((i & 3) + 8 * (i >> 2)) * 132] = acc[i]; }
        __syncthreads();
        { const int tt = 64 * c - 48 + et;
          const float den = (et < 32 ? DENP[et] : DENP[et] + DENP[32 + et]) + DENI[et];
          const float inv = __builtin_amdgcn_rcpf(fmaxf(fabsf(den), fexp(-(BB[et] + MX[et]))));
          f32x4 o[4]; float ss = 0.f;
#pragma unroll
          for (int j = 0; j < 4; ++j) { o[j] = *(const LAS f32x4*)(oep + 4 * j) * inv; ss += (o[j].x * o[j].x + o[j].y * o[j].y) + (o[j].z * o[j].z + o[j].w * o[j].w); }
          ss = sum8_dpp(ss);
          const float rs = __builtin_amdgcn_rsqf(ss * (1.f / 128.f) + EPS);
          if (tt >= NMETA || (tt >= 0 && b == 0)) { const unsigned gw[8] = {g0.x, g0.y, g0.z, g0.w, g1.x, g1.y, g1.z, g1.w}; unsigned w[8];
              const v4u c0 = *(const LAS v4u*)(CT + et * 272 + 32 * evq), c1 = *(const LAS v4u*)(CT + et * 272 + 32 * evq + 16); const unsigned cwd[8] = {c0.x, c0.y, c0.z, c0.w, c1.x, c1.y, c1.z, c1.w};
#pragma unroll
              for (int j = 0; j < 4; ++j) { const f32x4 gn = *(const LAS f32x4*)(GNS + 16 * evq + 4 * j), sk = *(const LAS f32x4*)(GNS + 128 + 16 * evq + 4 * j);
                  const sf2 ya = (((sf2){o[j].x, o[j].y} * (sf2){rs, rs}) * (sf2){gn[0], gn[1]} + (sf2){sk[0], sk[1]} * (sf2){bflo(cwd[2 * j]), bfhi(cwd[2 * j])}) * (sf2){bflo(gw[2 * j]), bfhi(gw[2 * j])};
                  const sf2 yb = (((sf2){o[j].z, o[j].w} * (sf2){rs, rs}) * (sf2){gn[2], gn[3]} + (sf2){sk[2], sk[3]} * (sf2){bflo(cwd[2 * j + 1]), bfhi(cwd[2 * j + 1])}) * (sf2){bflo(gw[2 * j + 1]), bfhi(gw[2 * j + 1])};
                  w[2 * j] = pk2(ya.x, ya.y); w[2 * j + 1] = pk2(yb.x, yb.y); }
              GAS v4u* yp = (GAS v4u*)(YML + rowof(b, tt) * HW + 16 * evq); yp[0] = (v4u){w[0], w[1], w[2], w[3]}; yp[1] = (v4u){w[4], w[5], w[6], w[7]}; }
          mcar = SC[0] + SC[1]; }
        __syncthreads();
    }
#undef ML_LOAD
}

typedef float f32x4v __attribute__((ext_vector_type(4)));
#define MFMA16B(a, b, c) __builtin_amdgcn_mfma_f32_16x16x32_bf16(a, b, c, 0, 0, 0)
constexpr int RW_LD = 516;
__device__ __forceinline__ void router_topk16(LAS float* LGw, int V, float rsv, int resrow, int lane, LAS int* hist, LAS int* res, int* TOPE, float* TOPW, float* RS) {
    if (lane < 16) {
        int se[4]; float sv[4];
#pragma unroll
        for (int k = 0; k < 4; ++k) { float best = -INFINITY; int bi = 0;
            for (int e = 0; e < 32; ++e) { const float v = LGw[lane * 33 + e]; if (v > best) { best = v; bi = e; } }
            se[k] = bi; sv[k] = best; LGw[lane * 33 + bi] = -INFINITY; }
        const float e1 = __expf(sv[1] - sv[0]), e2 = __expf(sv[2] - sv[0]), e3 = __expf(sv[3] - sv[0]), inv = 1.0f / (1.f + e1 + e2 + e3);
        const float w4[4] = {inv, e1 * inv, e2 * inv, e3 * inv};
#pragma unroll
        for (int k = 0; k < 4; ++k) { const int lp = __hip_atomic_fetch_add(hist + se[k], 1, __ATOMIC_RELAXED, __HIP_MEMORY_SCOPE_WORKGROUP);
            TOPE[(size_t)V * 4 + k] = se[k]; TOPW[(size_t)V * 4 + k] = w4[k]; res[(resrow + lane) * 4 + k] = lp; }
        RS[V] = rsv;
    }
}
__device__ __forceinline__ void p6_router(Frame& F) {
    unsigned char* ws = F.ws;
    const bf16* H1 = (const bf16*)(ws + WS_H1); const float* RWT = (const float*)(ws + WS_RWT);
    int* TOPE = (int*)(ws + WS_TOPE); int* TOPP = (int*)(ws + WS_TOPP); float* TOPW = (float*)(ws + WS_TOPW); float* RS = (float*)(ws + WS_RS);
    int* ETOK = (int*)(ws + WS_ETOK); float* ERS = (float*)(ws + WS_ERS); float* EW = (float*)(ws + WS_EW);
    constexpr int RWB_LD = 520;
    LAS bf16* rwh = (LAS bf16*)(F.lds + RING_OFF);
    LAS float* LG = (LAS float*)(F.lds + RING_OFF + 66560) + F.wave * 528;
    LAS int* hist = (LAS int*)(F.lds + RING_OFF + 66560 + 8 * 2112);
    LAS int* res = hist + 64;
    LAS float* XP = (LAS float*)(res + 144 * 4);
    LAS float* XQ = XP + 8 * 528;
    const int lane = F.lane, wave = F.wave, i16 = lane & 15, kk = lane >> 4;
    constexpr int RPW = NTOK / 256;
    const bool has_meta = (F.vcu == 0);
    const int Vbase = F.vcu * RPW, Vt = Vbase + 16 * wave;
    if (F.tid < 64) hist[F.tid] = 0;
    f32x4v acc0 = {0.f, 0.f, 0.f, 0.f}, acc1 = {0.f, 0.f, 0.f, 0.f}, acx0 = {0.f, 0.f, 0.f, 0.f}, acx1 = {0.f, 0.f, 0.f, 0.f}; float ssq = 0.f, xss = 0.f;
    const bf16* arow = H1 + (size_t)(Vt + i16) * D + 8 * kk;
    const bf16* xrow = H1 + (size_t)(NTOK + i16) * D + 8 * kk;
    f32x4 stg0[8], stg1[8]; v4u ax[4], a[8][4];
#pragma unroll
    for (int q = 0; q < 8; ++q) { const int u = F.tid + q * NTHREADS, e = u >> 7, c = u & 127; stg0[q] = *(const GAS f32x4*)(RWT + (size_t)e * D + 4 * c); }
#pragma unroll
    for (int q = 0; q < 8; ++q) { const int u = F.tid + q * NTHREADS, e = u >> 7, c = u & 127; stg1[q] = *(const GAS f32x4*)(RWT + (size_t)e * D + 512 + 4 * c); }
    if (has_meta) {
#pragma unroll
        for (int s = 0; s < 4; ++s) ax[s] = *(const GAS v4u*)(xrow + 128 * wave + 32 * s);
    }
#pragma unroll
    for (int b = 0; b < 8; ++b)
#pragma unroll
        for (int s = 0; s < 4; ++s) a[b][s] = *(const GAS v4u*)(arow + 128 * b + 32 * s);
    asm volatile("" ::: "memory");
#define RT_STAGE(STG) do { _Pragma("unroll") for (int q = 0; q < 8; ++q) { const int u = F.tid + q * NTHREADS, e = u >> 7, c = u & 127; const f32x4 w = STG[q]; \
        const unsigned h0 = pk2(w.x, w.y), h1 = pk2(w.z, w.w), l0 = pk2(w.x - bflo(h0), w.y - bfhi(h0)), l1 = pk2(w.z - bflo(h1), w.w - bfhi(h1)); \
        *(LAS v2u*)(rwh + e * RWB_LD + 4 * c) = (v2u){h0, h1}; *(LAS v2u*)(rwh + (32 + e) * RWB_LD + 4 * c) = (v2u){l0, l1}; } } while (0)
#define RT_MMA(A, SB, C0, C1, SS) do { const LAS bf16* bp = rwh + i16 * RWB_LD + 8 * kk + 128 * (SB); \
        _Pragma("unroll") for (int s = 0; s < 4; ++s) { const v4u aw = A[s]; const pg8::bf16x8 av = __builtin_bit_cast(pg8::bf16x8, aw); \
            SS += ((bflo(aw.x) * bflo(aw.x) + bfhi(aw.x) * bfhi(aw.x)) + (bflo(aw.y) * bflo(aw.y) + bfhi(aw.y) * bfhi(aw.y))) + ((bflo(aw.z) * bflo(aw.z) + bfhi(aw.z) * bfhi(aw.z)) + (bflo(aw.w) * bflo(aw.w) + bfhi(aw.w) * bfhi(aw.w))); \
            const pg8::bf16x8 h0 = *(const LAS pg8::bf16x8*)(bp + 32 * s), h1 = *(const LAS pg8::bf16x8*)(bp + 16 * RWB_LD + 32 * s), l0 = *(const LAS pg8::bf16x8*)(bp + 32 * RWB_LD + 32 * s), l1 = *(const LAS pg8::bf16x8*)(bp + 48 * RWB_LD + 32 * s); \
            C0 = MFMA16B(av, h0, C0); C1 = MFMA16B(av, h1, C1); C0 = MFMA16B(av, l0, C0); C1 = MFMA16B(av, l1, C1); } } while (0)
#pragma unroll
    for (int half = 0; half < 2; ++half) {
        __syncthreads();
        if (half == 0) RT_STAGE(stg0); else RT_STAGE(stg1);
        __syncthreads();
#pragma unroll
        for (int b = 0; b < 4; ++b) RT_MMA(a[4 * half + b], b, acc0, acc1, ssq);
        if (has_meta && (wave >> 2) == half) RT_MMA(ax, wave & 3, acx0, acx1, xss);
    }
#undef RT_MMA
#undef RT_STAGE
    if (has_meta) {
        xss += __shfl_xor(xss, 16); xss += __shfl_xor(xss, 32);
#pragma unroll
        for (int r = 0; r < 4; ++r) { XP[wave * 528 + (4 * kk + r) * 33 + i16] = acx0[r]; XP[wave * 528 + (4 * kk + r) * 33 + 16 + i16] = acx1[r]; }
        if (kk == 0) XQ[wave * 16 + i16] = xss;
    }
    ssq += __shfl_xor(ssq, 16); ssq += __shfl_xor(ssq, 32);
    const float rsrow = 1.0f / sqrtf(ssq * (1.f / D) + EPS);
    const float rb0 = F.in[IN_RB][i16], rb1 = F.in[IN_RB][16 + i16];
#define RT_DF(v, c) __builtin_bit_cast(float, __builtin_amdgcn_update_dpp(__builtin_bit_cast(int, (float)(v)), __builtin_bit_cast(int, (float)(v)), (c), 0xf, 0xf, true))
#define RT_DI(v, c) __builtin_amdgcn_update_dpp((int)(v), (int)(v), (c), 0xf, 0xf, true)
    auto topk4 = [&](const float (&v0_in)[4], const float (&v1_in)[4], const float (&rsr_in)[4], int Vbase_, int resbase_) {
    { float v0[4], v1[4], rsr4[4]; int se[4][4]; float sv[4][4];
#pragma unroll
      for (int r = 0; r < 4; ++r) { rsr4[r] = rsr_in[r]; v0[r] = v0_in[r]; v1[r] = v1_in[r]; }
#pragma unroll
      for (int p = 0; p < 4; ++p) {
          float m[4]; int im[4];
#pragma unroll
          for (int r = 0; r < 4; ++r) m[r] = fmaxf(v0[r], v1[r]);
#pragma unroll
          for (int r = 0; r < 4; ++r) m[r] = fmaxf(m[r], RT_DF(m[r], 0xB1));
#pragma unroll
          for (int r = 0; r < 4; ++r) m[r] = fmaxf(m[r], RT_DF(m[r], 0x4E));
#pragma unroll
          for (int r = 0; r < 4; ++r) m[r] = fmaxf(m[r], RT_DF(m[r], 0x141));
#pragma unroll
          for (int r = 0; r < 4; ++r) m[r] = fmaxf(m[r], RT_DF(m[r], 0x140));
#pragma unroll
          for (int r = 0; r < 4; ++r) im[r] = v0[r] == m[r] ? i16 : (v1[r] == m[r] ? 16 + i16 : 64);
#pragma unroll
          for (int r = 0; r < 4; ++r) im[r] = min(im[r], RT_DI(im[r], 0xB1));
#pragma unroll
          for (int r = 0; r < 4; ++r) im[r] = min(im[r], RT_DI(im[r], 0x4E));
#pragma unroll
          for (int r = 0; r < 4; ++r) im[r] = min(im[r], RT_DI(im[r], 0x141));
#pragma unroll
          for (int r = 0; r < 4; ++r) im[r] = min(im[r], RT_DI(im[r], 0x140));
#pragma unroll
          for (int r = 0; r < 4; ++r) { se[r][p] = im[r]; sv[r][p] = m[r]; if (im[r] == i16) v0[r] = -INFINITY; if (im[r] == 16 + i16) v1[r] = -INFINITY; } }
      if (i16 < 4) {
#pragma unroll
          for (int r = 0; r < 4; ++r) { const int row = 4 * kk + r, V = Vbase_ + row;
              const float e1 = __expf(sv[r][1] - sv[r][0]), e2 = __expf(sv[r][2] - sv[r][0]), e3 = __expf(sv[r][3] - sv[r][0]), inv = 1.0f / (1.f + e1 + e2 + e3);
              const int e = i16 == 0 ? se[r][0] : i16 == 1 ? se[r][1] : i16 == 2 ? se[r][2] : se[r][3];
              const float w = i16 == 0 ? inv : (i16 == 1 ? e1 : i16 == 2 ? e2 : e3) * inv;
              const int lp = __hip_atomic_fetch_add(hist + e, 1, __ATOMIC_RELAXED, __HIP_MEMORY_SCOPE_WORKGROUP);
              TOPE[(size_t)V * 4 + i16] = e; TOPW[(size_t)V * 4 + i16] = w; res[(resbase_ + row) * 4 + i16] = lp;
              if (i16 == 0) RS[V] = rsr4[r]; } } }
    };
    { float a0[4], a1[4], rr[4];
#pragma unroll
      for (int r = 0; r < 4; ++r) { rr[r] = __shfl(rsrow, 4 * kk + r); a0[r] = acc0[r] * rr[r] + rb0; a1[r] = acc1[r] * rr[r] + rb1; }
      topk4(a0, a1, rr, Vt, 16 * wave); }
    __syncthreads();
    if (has_meta && wave == 7) {
        float q = 0.f;
#pragma unroll
        for (int w = 0; w < 8; ++w) q += XQ[w * 16 + i16];
        const float rsm = 1.0f / sqrtf(q * (1.f / D) + EPS);
        float m0[4], m1[4], mr4[4];
#pragma unroll
        for (int r = 0; r < 4; ++r) { float v0 = 0.f, v1 = 0.f;
#pragma unroll
            for (int w = 0; w < 8; ++w) { v0 += XP[w * 528 + (4 * kk + r) * 33 + i16]; v1 += XP[w * 528 + (4 * kk + r) * 33 + 16 + i16]; }
            mr4[r] = __shfl(rsm, 4 * kk + r); m0[r] = v0 * mr4[r] + rb0; m1[r] = v1 * mr4[r] + rb1; }
        topk4(m0, m1, mr4, NTOK, 128);
    }
    __syncthreads();
    if (F.tid < NE) hist[32 + F.tid] = (int)__hip_atomic_fetch_add(F.ctl + CW_CNT + 64 * F.tid, (unsigned)hist[F.tid], RLX_AGENT);
    __syncthreads();
    const int nrows = has_meta ? RPW + 16 : RPW;
    for (int u = F.tid; u < nrows * 4; u += NTHREADS) { const int rr = u >> 2, V = rr < RPW ? Vbase + rr : NTOK + (rr - RPW); const size_t gi = (size_t)V * 4 + (u & 3); const int e = TOPE[gi], pos = hist[32 + e] + res[u];
        TOPP[gi] = pos; ETOK[(size_t)e * NV + pos] = V; ERS[(size_t)e * NV + pos] = RS[V]; EW[(size_t)e * NV + pos] = TOPW[gi]; }
}

__device__ __forceinline__ void build_tables(Frame& F) {
    LAS int* pst = (LAS int*)(F.lds + PST_OFF); LAS unsigned char* texp = (LAS unsigned char*)(F.lds + TEXP_OFF);
    __syncthreads();
    if (F.tid < 64) {
        const int e = F.lane & 31; const int c = (int)__hip_atomic_load(F.ctl + CW_CNT + 64 * e, RLX_AGENT); const int nt = (c + 255) >> 8;
        int incl = nt;
#pragma unroll
        for (int o = 1; o < 32; o <<= 1) { const int t = __shfl_up(incl, o); if ((F.lane & 31) >= o) incl += t; }
        const int start = incl - nt;
        if (F.lane < 32) { pst[e] = start * 256; pst[33 + e] = c; for (int j = 0; j < nt && start + j < MAXTILES; ++j) texp[start + j] = (unsigned char)e; if (e == 31) pst[32] = incl < MAXTILES ? incl : MAXTILES; }
    }
    __syncthreads();
}
typedef float f32v2_t __attribute__((ext_vector_type(2)));
__device__ __forceinline__ void p10_combine(Frame& F) {
    unsigned char* ws = F.ws; build_tables(F);
    const LAS int* pst = (const LAS int*)(F.lds + PST_OFF);
    const bf16* H1 = (const bf16*)(ws + WS_H1); const unsigned char* YB = (const unsigned char*)(ws + WS_YB);
    const int* TOPE = (const int*)(ws + WS_TOPE); const int* TOPP = (const int*)(ws + WS_TOPP);
    const int gw = F.vcu * NWAVES + F.wave, NGW = F.G * NWAVES;
    const GAS f32x4* nf = (const GAS f32x4*)F.in[IN_NFIN] + F.lane; f32x4 nfv[4];
#pragma unroll
    for (int j = 0; j < 4; ++j) nfv[j] = nf[64 * j];
    int sl[2][4];
#define CMB_SLOTS(Rbase) do { _Pragma("unroll") for (int q = 0; q < 2; ++q) { const int R = (Rbase) + q * NGW; if (R < BATCH * SEQ) { const size_t V = (size_t)R; \
        _Pragma("unroll") for (int k = 0; k < 4; ++k) sl[q][k] = pst[TOPE[V * 4 + k]] + TOPP[V * 4 + k]; } else { _Pragma("unroll") for (int k = 0; k < 4; ++k) sl[q][k] = 0; } } } while (0)
    CMB_SLOTS(gw);
    for (int R0 = gw; R0 < BATCH * SEQ; R0 += 2 * NGW) {
        f32x4 v[2][4]; unsigned y[2][4][4];
#pragma unroll
        for (int q = 0; q < 2; ++q) { const int R = (R0 + q * NGW < BATCH * SEQ) ? R0 + q * NGW : R0; const size_t V = (size_t)R;
            const GAS v2u* hr = (const GAS v2u*)(H1 + V * D) + F.lane;
#pragma unroll
            for (int j = 0; j < 4; ++j) { const v2u hw = __builtin_nontemporal_load(hr + 64 * j); v[q][j] = (f32x4){bflo(hw.x), bfhi(hw.x), bflo(hw.y), bfhi(hw.y)}; }
#pragma unroll
            for (int k = 0; k < 4; ++k) { const GAS unsigned* yr = (const GAS unsigned*)(YB + (size_t)sl[q][k] * D) + F.lane;
#pragma unroll
                for (int j = 0; j < 4; ++j) y[q][k][j] = __builtin_nontemporal_load(yr + 64 * j); } }
        CMB_SLOTS(R0 + 2 * NGW);
#pragma unroll
        for (int q = 0; q < 2; ++q) { const int R = R0 + q * NGW; if (R >= BATCH * SEQ) continue;
#pragma unroll
            for (int k = 0; k < 4; ++k)
#pragma unroll
                for (int j = 0; j < 4; ++j) { const unsigned w = y[q][k][j]; const f32v2_t lo = __builtin_amdgcn_cvt_pk_f32_fp8(w, false), hi = __builtin_amdgcn_cvt_pk_f32_fp8(w, true);
                    v[q][j].x += lo[0] * 0.0625f; v[q][j].y += lo[1] * 0.0625f; v[q][j].z += hi[0] * 0.0625f; v[q][j].w += hi[1] * 0.0625f; }
            float s = 0.f;
#pragma unroll
            for (int j = 0; j < 4; ++j) s += (v[q][j].x * v[q][j].x + v[q][j].y * v[q][j].y) + (v[q][j].z * v[q][j].z + v[q][j].w * v[q][j].w);
            const float rs = 1.0f / sqrtf(wave_sum(s) * (1.f / D) + EPS);
            GAS f32x4* orow = (GAS f32x4*)(F.out + (size_t)R * D) + F.lane;
#pragma unroll
            for (int j = 0; j < 4; ++j) orow[64 * j] = v[q][j] * rs * nfv[j]; }
    }
#undef CMB_SLOTS
}

__device__ __forceinline__ int meta_row(int lane) { return ((lane >> 5) & 1) * 8 + ((lane >> 4) & 1) * 4 + ((lane >> 3) & 1) * 2 + ((lane >> 2) & 1); }
template <int KPL> __device__ __forceinline__ float meta_col(const LAS unsigned char* A, const bf16* wrow, int lane) {
    constexpr int K = 64 * KPL; float w[KPL];
#pragma unroll
    for (int j = 0; j < KPL / 8; ++j) { const v4u x = *(const GAS v4u*)(wrow + lane * KPL + 8 * j);
        w[8 * j] = bflo(x.x); w[8 * j + 1] = bfhi(x.x); w[8 * j + 2] = bflo(x.y); w[8 * j + 3] = bfhi(x.y); w[8 * j + 4] = bflo(x.z); w[8 * j + 5] = bfhi(x.z); w[8 * j + 6] = bflo(x.w); w[8 * j + 7] = bfhi(x.w); }
    float p[16];
#pragma unroll
    for (int r = 0; r < 16; ++r) { float s = 0.f;
#pragma unroll
        for (int j = 0; j < KPL / 8; ++j) { const v4u a = *(const LAS v4u*)(A + (r * K + lane * KPL + 8 * j) * 2);
            s += (bflo(a.x) * w[8 * j] + bfhi(a.x) * w[8 * j + 1]) + (bflo(a.y) * w[8 * j + 2] + bfhi(a.y) * w[8 * j + 3]) + (bflo(a.z) * w[8 * j + 4] + bfhi(a.z) * w[8 * j + 5]) + (bflo(a.w) * w[8 * j + 6] + bfhi(a.w) * w[8 * j + 7]); }
        p[r] = s; if ((r & 3) == 3) asm volatile("" ::: "memory"); }
    const bool b32 = lane & 32, b16 = lane & 16, b8 = lane & 8, b4 = lane & 4;
    float q8[8], q4[4], q2[2];
#pragma unroll
    for (int i = 0; i < 8; ++i) { const float keep = b32 ? p[i + 8] : p[i], send = b32 ? p[i] : p[i + 8]; q8[i] = keep + __shfl_xor(send, 32); }
#pragma unroll
    for (int i = 0; i < 4; ++i) { const float keep = b16 ? q8[i + 4] : q8[i], send = b16 ? q8[i] : q8[i + 4]; q4[i] = keep + __shfl_xor(send, 16); }
#pragma unroll
    for (int i = 0; i < 2; ++i) { const float keep = b8 ? q4[i + 2] : q4[i], send = b8 ? q4[i] : q4[i + 2]; q2[i] = keep + __shfl_xor(send, 8); }
    float v = (b4 ? q2[1] : q2[0]) + __shfl_xor(b4 ? q2[0] : q2[1], 4);
    v += __shfl_xor(v, 2); v += __shfl_xor(v, 1);
    return v;
}
__device__ __forceinline__ void meta_stage(Frame& F, LAS unsigned char* dst, const bf16* src, int K) {
    v4u t[4]; const int n = 16 * K / 8;
#pragma unroll
    for (int q = 0; q < 4; ++q) { const int u = F.tid + q * NTHREADS; if (u < n) t[q] = *(const GAS v4u*)(src + (size_t)u * 8); }
#pragma unroll
    for (int q = 0; q < 4; ++q) { const int u = F.tid + q * NTHREADS; if (u < n) *(LAS v4u*)(dst + u * 16) = t[q]; }
}
__device__ __forceinline__ void meta_proj(Frame& F) {
    unsigned char* ws = F.ws; const bf16* WIN = (const bf16*)(ws + WS_WIN); const float* lbl = F.in[IN_LBL];
    LAS unsigned char* A = F.lds + RING_OFF;
    const int lane = F.lane, i16 = lane & 15, kk = lane >> 4;
    const int g = (int)blockIdx.x + F.wave * F.G;
    const bool act = g < NPROJ / 16;
    v4u bw[32];
    if (act) { const bf16* wp = WIN + (size_t)(16 * g + i16) * D + 8 * kk;
#pragma unroll
        for (int s = 0; s < 32; ++s) bw[s] = *(const GAS v4u*)(wp + 32 * s); }
    asm volatile("" ::: "memory");
    __syncthreads(); meta_stage(F, A, (const bf16*)(ws + WS_XN0) + (size_t)NTOK * D, D); __syncthreads();
    if (act) {
        f32x4 acc = {0.f, 0.f, 0.f, 0.f};
#pragma unroll
        for (int s = 0; s < 32; ++s) { const pg8::bf16x8 a = *(const LAS pg8::bf16x8*)(A + (i16 * D + 32 * s + 8 * kk) * 2); acc = __builtin_amdgcn_mfma_f32_16x16x32_bf16(a, __builtin_bit_cast(pg8::bf16x8, bw[s]), acc, 0, 0, 0); }
        const int c = 16 * g + i16, kind = c < 3072 ? (c >> 9) : 6, cc = c & 511;
#pragma unroll
        for (int r = 0; r < 4; ++r) { const size_t row = NTOK + 4 * kk + r; const float v = acc[r];
            if (kind == 0) ((bf16*)(ws + WS_HQ))[row * HW + cc] = (bf16)f2bf(fsilu(v));
            else if (kind == 1) { const float lb = fsigmoid(lbl[cc] - lbl[HW + cc]); ((bf16*)(ws + WS_HG))[row * HW + cc] = (bf16)f2bf(__logf(lb + (1.f - lb) * fsigmoid(v))); }
            else if (kind == 2) ((bf16*)(ws + WS_HV))[row * HW + cc] = (bf16)f2bf(v);
            else if (kind == 3) ((bf16*)(ws + WS_HGATE))[row * HW + cc] = (bf16)f2bf(fsilu(v));
            else if (kind == 4) ((bf16*)(ws + WS_MM))[row * HW + cc] = (bf16)f2bf(v);
            else if (kind == 5) ((bf16*)(ws + WS_MO))[row * HW + cc] = (bf16)f2bf(fsigmoid(v));
            else (ws + WS_GATES)[row * 2048 + pg8::gate_pos(c - 3072)] = (unsigned char)(__builtin_bit_cast(unsigned, __builtin_fmaf(fsigmoid(v), 255.f, 8388608.f)) & 0xffu); } }
}
__device__ __forceinline__ void meta_merged(Frame& F) {
    unsigned char* ws = F.ws; const unsigned char* GATES = ws + WS_GATES;
    LAS unsigned char* A0 = F.lds + RING_OFF; LAS unsigned char* A1 = A0 + 16 * HW * 2;
    const int lane = F.lane, i16 = lane & 15, kk = lane >> 4, g = (int)blockIdx.x + F.wave * F.G, c = 16 * g + i16; const bool act = g < D / 16;
    v4u bh[16], bm[16]; unsigned char g0[4], g1[4];
    if (act) { const bf16* wh = (const bf16*)(ws + WS_WBH) + (size_t)c * HW + 8 * kk; const bf16* wm = (const bf16*)(ws + WS_WBM) + (size_t)c * HW + 8 * kk;
#pragma unroll
        for (int s = 0; s < 16; ++s) { bh[s] = *(const GAS v4u*)(wh + 32 * s); bm[s] = *(const GAS v4u*)(wm + 32 * s); }
#pragma unroll
        for (int r = 0; r < 4; ++r) { const size_t row = NTOK + 4 * kk + r; g0[r] = GATES[row * 2048 + pg8::gate_pos(c)]; g1[r] = GATES[row * 2048 + pg8::gate_pos(D + c)]; } }
    asm volatile("" ::: "memory");
    __syncthreads(); meta_stage(F, A0, (const bf16*)(ws + WS_YHG) + (size_t)NTOK * HW, HW); meta_stage(F, A1, (const bf16*)(ws + WS_YML) + (size_t)NTOK * HW, HW); __syncthreads();
    if (act) {
        f32x4 ah = {0.f, 0.f, 0.f, 0.f}, am = {0.f, 0.f, 0.f, 0.f};
#pragma unroll
        for (int s = 0; s < 16; ++s) { const pg8::bf16x8 a0 = *(const LAS pg8::bf16x8*)(A0 + (i16 * HW + 32 * s + 8 * kk) * 2), a1 = *(const LAS pg8::bf16x8*)(A1 + (i16 * HW + 32 * s + 8 * kk) * 2);
            ah = __builtin_amdgcn_mfma_f32_16x16x32_bf16(a0, __builtin_bit_cast(pg8::bf16x8, bh[s]), ah, 0, 0, 0); am = __builtin_amdgcn_mfma_f32_16x16x32_bf16(a1, __builtin_bit_cast(pg8::bf16x8, bm[s]), am, 0, 0, 0); }
#pragma unroll
        for (int r = 0; r < 4; ++r) { const size_t row = NTOK + 4 * kk + r; ((bf16*)(ws + WS_MERGED))[row * D + c] = (bf16)f2bf((float)g0[r] * ah[r] + fmaxf((float)g1[r], 1.f) * am[r]); } }
}
__device__ __forceinline__ void meta_wout(Frame& F) {
    unsigned char* ws = F.ws; LAS unsigned char* A = F.lds + RING_OFF;
    const int lane = F.lane, i16 = lane & 15, kk = lane >> 4, g = (int)blockIdx.x + F.wave * F.G, c = 16 * g + i16; const bool act = g < D / 16;
    v4u bw[32]; float xm[4];
    if (act) { const bf16* wp = (const bf16*)(ws + WS_WOUT) + (size_t)c * D + 8 * kk;
#pragma unroll
        for (int s = 0; s < 32; ++s) bw[s] = *(const GAS v4u*)(wp + 32 * s);
#pragma unroll
        for (int r = 0; r < 4; ++r) xm[r] = F.in[IN_META][(size_t)(4 * kk + r) * D + c]; }
    asm volatile("" ::: "memory");
    __syncthreads(); meta_stage(F, A, (const bf16*)(ws + WS_MERGED) + (size_t)NTOK * D, D); __syncthreads();
    if (act) {
        f32x4 acc = {0.f, 0.f, 0.f, 0.f};
#pragma unroll
        for (int s = 0; s < 32; ++s) { const pg8::bf16x8 a = *(const LAS pg8::bf16x8*)(A + (i16 * D + 32 * s + 8 * kk) * 2); acc = __builtin_amdgcn_mfma_f32_16x16x32_bf16(a, __builtin_bit_cast(pg8::bf16x8, bw[s]), acc, 0, 0, 0); }
#pragma unroll
        for (int r = 0; r < 4; ++r) { const size_t row = NTOK + 4 * kk + r; const float v = xm[r] + acc[r];
            ((bf16*)(ws + WS_H1))[row * D + c] = (bf16)f2bf(v); ((unsigned char*)(ws + WS_H1B))[row * D + c] = (unsigned char)(__builtin_amdgcn_cvt_pk_fp8_f32(__builtin_amdgcn_fmed3f(v, -448.f, 448.f), 0.f, 0u, false) & 0xffu); } }
}

__device__ __forceinline__ void ph_proj(Frame& F, int variant) {
    unsigned char* ws = F.ws;
    pg8::Gemm g{(const pg8::bf16_t*)(ws + WS_XQ), (const pg8::bf16_t*)(ws + WS_WIN8), NTOK, NPROJ, D / 2}; pg8::StaticOrder S; S.init(NTOK, NPROJ, F.G, (int)blockIdx.x);
    pg8::EpiProjT<true> E{ws, F.in[IN_LBL], (const float*)(ws + WS_SROW), (const float*)(ws + WS_SCOL)};
#if MK_N_LAUNCHES != 1 && PROBE_VARIANT == 1
    if (variant) { pg8::EpiNull EN{(int*)(ws + WS_TOPE)}; pg8::gemm_phase<pg8::EpiNull, pg8::StaticOrder, true, true, false, true>(F.lds + RING_OFF, g, S, EN); return; }
#elif MK_N_LAUNCHES != 1 && PROBE_VARIANT == 2
    if (variant) { pg8::EpiProjT<true, true> EV{ws, F.in[IN_LBL], (const float*)(ws + WS_SROW), (const float*)(ws + WS_SCOL)}; pg8::gemm_phase<pg8::EpiProjT<true, true>, pg8::StaticOrder, true, true, false, true>(F.lds + RING_OFF, g, S, EV); return; }
#endif
    (void)variant;
    pg8::gemm_phase<pg8::EpiProjT<true>, pg8::StaticOrder, true, true, false, true>(F.lds + RING_OFF, g, S, E);
    meta_proj(F);
}
__device__ __forceinline__ void ph_scan(Frame& F) {
    const int sb = (int)blockIdx.x;
    if (sb < 64) p3_hgrn2_mfma(F, sb); else if (sb < 128) p3_mlstm_mfma(F, sb - 64);
#if !CONV_IN_P0
    else px_experts(F, sb - 128, F.G - 128);
#endif
}
__device__ __forceinline__ void ph_merged(Frame& F, int variant = 0) {
    unsigned char* ws = F.ws;
    static_assert(WS_YML - WS_YHG == (size_t)pg8::PAIR_DA * 256 * HW * 2 && WS_WBM - WS_WBH == (size_t)pg8::PAIR_DB * 256 * HW * 2, "the second branch's operands sit a whole number of tiles behind the first's");
    pg8::PairOrder S; S.S.init(NTOK, D, F.G, (int)blockIdx.x);
    pg8::Gemm g{(const pg8::bf16_t*)(ws + WS_YHG), (const pg8::bf16_t*)(ws + WS_WBH), NTOK, D, HW};
    pg8::EpiGate2 E{(const unsigned char*)(ws + WS_GATES), (pg8::bf16_t*)(ws + WS_MERGED)};
#if MK_N_LAUNCHES != 1 && PROBE_VARIANT == 1
    if (variant) { pg8::EpiNull EN{(int*)(ws + WS_TOPE)}; pg8::gemm_phase<pg8::EpiNull, pg8::PairOrder, true, true>(F.lds + RING_OFF, g, S, EN); return; }
#endif
    (void)variant;
    pg8::gemm_phase<pg8::EpiGate2, pg8::PairOrder, true, true>(F.lds + RING_OFF, g, S, E);
    meta_merged(F);
}
__device__ __forceinline__ void ph_wout(Frame& F, int variant = 0) {
    unsigned char* ws = F.ws;
    pg8::Gemm g{(const pg8::bf16_t*)(ws + WS_MERGED), (const pg8::bf16_t*)(ws + WS_WOUT), NTOK, D, D}; pg8::StaticOrder S; S.init(NTOK, D, F.G, (int)blockIdx.x);
    pg8::EpiH1 E{(const pg8::bf16_t*)(ws + WS_XN0), (const float*)(ws + WS_XSQ), (pg8::bf16_t*)(ws + WS_H1), (unsigned char*)(ws + WS_H1B)};
#if MK_N_LAUNCHES != 1 && PROBE_VARIANT == 1
    if (variant) { pg8::EpiNull EN{(int*)(ws + WS_TOPE)}; pg8::gemm_phase<pg8::EpiNull, pg8::StaticOrder, true, true>(F.lds + RING_OFF, g, S, EN); return; }
#endif
    (void)variant;
    pg8::gemm_phase<pg8::EpiH1, pg8::StaticOrder, true, true>(F.lds + RING_OFF, g, S, E);
    meta_wout(F);
}
__device__ __forceinline__ void ph_gu(Frame& F, int variant = 0) {
    unsigned char* ws = F.ws; build_tables(F);
    const LAS int* pst = (const LAS int*)(F.lds + PST_OFF); LAS unsigned short* tok16 = (LAS unsigned short*)(F.lds + TOK_OFF);
    pg8::Gemm g{(const pg8::bf16_t*)(ws + WS_H1B), (const pg8::bf16_t*)(ws + WS_WGU), NV, NE * 2 * DFF, D / 2};
    pg8::GroupOrder S{pst[32], 8, F.G, (int)blockIdx.x, (const LAS unsigned char*)(F.lds + TEXP_OFF)};
    { const int* ETOK = (const int*)(ws + WS_ETOK);
      int tokv[18];
#pragma unroll
      for (int i = 0; i < 18; ++i) { pg8::Unit u; int t = 0; if (S.next(i, u) && F.tid < 256) { const int e = u.pn >> 3, pos = u.pm * 256 - pst[e] + F.tid; if (pos < pst[33 + e]) t = ETOK[(size_t)e * NV + pos]; } tokv[i] = t; }
      if (F.tid < 256) {
#pragma unroll
          for (int i = 0; i < 18; ++i) tok16[i * 256 + F.tid] = (unsigned short)tokv[i]; }
      __syncthreads(); }
    pg8::EpiGU E{(const float*)(ws + WS_BGUP), (const float*)(ws + WS_ERS), (unsigned char*)(ws + WS_ACT), pst};
#if MK_N_LAUNCHES != 1 && PROBE_VARIANT == 1
    if (variant) { pg8::EpiNull EN{(int*)(ws + WS_TOPE)}; pg8::gemm_phase_g<pg8::EpiNull, pg8::GroupOrder, true>(F.lds + RING_OFF, g, S, EN, tok16); return; }
#elif MK_N_LAUNCHES != 1 && PROBE_VARIANT == 2
    if (variant) { pg8::EpiGUT<true> EV{(const float*)(ws + WS_BGUP), (const float*)(ws + WS_ERS), (unsigned char*)(ws + WS_ACT), pst}; pg8::gemm_phase_g<pg8::EpiGUT<true>, pg8::GroupOrder, true>(F.lds + RING_OFF, g, S, EV, tok16); return; }
#endif
    (void)variant;
    pg8::gemm_phase_g<pg8::EpiGU, pg8::GroupOrder, true>(F.lds + RING_OFF, g, S, E, tok16);
}
__device__ __forceinline__ void ph_down(Frame& F, int variant = 0) {
    unsigned char* ws = F.ws; build_tables(F);
    pg8::Gemm g{(const pg8::bf16_t*)(ws + WS_ACT), (const pg8::bf16_t*)(ws + WS_WDN), MAXTILES * 256, NE * D, DFF / 2};
    pg8::GroupOrder S{((const LAS int*)(F.lds + PST_OFF))[32], 4, F.G, (int)blockIdx.x, (const LAS unsigned char*)(F.lds + TEXP_OFF)};
    pg8::EpiDown E{F.in[IN_BDN], (const float*)(ws + WS_EW), (unsigned char*)(ws + WS_YB), (const LAS int*)(F.lds + PST_OFF)};
#if MK_N_LAUNCHES != 1 && PROBE_VARIANT == 1
    if (variant) { pg8::EpiNull EN{(int*)(ws + WS_TOPE)}; pg8::gemm_phase<pg8::EpiNull, pg8::GroupOrder, true, true, true>(F.lds + RING_OFF, g, S, EN); return; }
#elif MK_N_LAUNCHES != 1 && PROBE_VARIANT == 2
    if (variant) { pg8::EpiDownT<true> EV{F.in[IN_BDN], (const float*)(ws + WS_EW), (unsigned char*)(ws + WS_YB), (const LAS int*)(F.lds + PST_OFF)}; pg8::gemm_phase<pg8::EpiDownT<true>, pg8::GroupOrder, true, true, true>(F.lds + RING_OFF, g, S, EV); return; }
#endif
    (void)variant;
    pg8::gemm_phase<pg8::EpiDown, pg8::GroupOrder, true, true, true>(F.lds + RING_OFF, g, S, E);
}

#ifndef CONV_IN_P0
#define CONV_IN_P0 0
#endif
#ifndef PROBE_DOUBLE
#define PROBE_DOUBLE 0
#endif
#define DBL(k) ((PROBE_DOUBLE >> (k)) & 1)
#ifndef MK_N_LAUNCHES
#define MK_N_LAUNCHES 1
#endif
constexpr int NPHASE = 9;
#ifndef PROBE_VARIANT
#define PROBE_VARIANT 0
#endif
struct Args { const float* in[25]; float* out; unsigned char* ws; int ph_lo, ph_hi, li, pad; };
__global__ void __launch_bounds__(NTHREADS, 2) fwd_kernel(Args args) {
    extern __shared__ __attribute__((aligned(16))) unsigned char lds[];
    Frame F;
    F.lds = (LAS unsigned char*)lds; F.MISC = (volatile LAS unsigned*)(F.lds + MISC_OFF);
    F.tid = threadIdx.x; F.lane = F.tid & 63; F.wave = __builtin_amdgcn_readfirstlane(F.tid >> 6);
    F.G = gridDim.x; { const int bx = blockIdx.x; F.vcu = (F.G % 8 == 0) ? (bx % 8) * (F.G / 8) + bx / 8 : bx; }
    F.ws = args.ws; F.ctl = (gu32*)(args.ws + WS_CTL); F.out = args.out;
#pragma unroll
    for (int i = 0; i < 25; ++i) F.in[i] = args.in[i];
    { int t0 = F.tid; asm volatile("" : "+v"(t0)); if (t0 < 64) F.MISC[t0] = 0u; }
    __syncthreads();
    const int lo = args.ph_lo, hi = args.ph_hi;
    XcdBarrier bar; bar.bar = (unsigned*)(F.ctl + CW_BAR) + args.li * XCD_BAR_WORDS; bar.x = 0; bar.st = nullptr;
    if (hi - lo > 1) bar = xcd_barrier_post((unsigned*)(F.ctl + CW_BAR) + args.li * XCD_BAR_WORDS, F.MISC + 8);
#define IN(k) (lo <= (k) && (k) < hi)
#define SEAM(k) do { if (IN(k) && IN((k) + 1)) xcd_barrier(bar); } while (0)

    if (IN(0)) { p0_prologue(F); p0b_quant(F);
#if CONV_IN_P0
        __syncthreads(); px_experts(F, F.vcu, F.G);
#endif
    } SEAM(0);
    if (IN(1)) { ph_proj(F, args.pad); } SEAM(1);
    if (IN(2)) { ph_scan(F); } SEAM(2);
    if (IN(3)) { ph_merged(F, args.pad); } SEAM(3);
    if (IN(4)) { ph_wout(F, args.pad); } SEAM(4);
    if (IN(5)) { p6_router(F); } SEAM(5);
    if (IN(6)) { ph_gu(F, args.pad); } SEAM(6);
    if (IN(7)) { ph_down(F, args.pad); } SEAM(7);
    if (IN(8)) { p10_combine(F); }
#undef IN
#undef SEAM
}

extern "C" void kernel_launch(void* const* d_in, const int* in_sizes, int n_in, void* d_out, int out_size, void* d_ws, size_t ws_size, hipStream_t stream) {
    static int grid = 0;
    if (grid == 0) {
        if (n_in != 25 || in_sizes[0] != BATCH * SEQ * D || out_size != BATCH * SEQ * D || ws_size < WS_END) { fprintf(stderr, "kernel_launch: unexpected shapes (n_in %d, in0 %d, out %d, ws %zu); nothing launched\n", n_in, n_in > 0 ? in_sizes[0] : -1, out_size, ws_size); grid = -1; return; }
        int dev = 0, cus = 0, per_cu = 0;
        if (hipGetDevice(&dev) != hipSuccess || hipDeviceGetAttribute(&cus, hipDeviceAttributeMultiprocessorCount, dev) != hipSuccess) { grid = -1; return; }
        if (hipFuncSetAttribute((const void*)fwd_kernel, hipFuncAttributeMaxDynamicSharedMemorySize, LDS_BYTES) != hipSuccess) { fprintf(stderr, "kernel_launch: hipFuncSetAttribute failed\n"); grid = -1; return; }
        if (hipOccupancyMaxActiveBlocksPerMultiprocessor(&per_cu, (const void*)fwd_kernel, NTHREADS, LDS_BYTES) != hipSuccess || per_cu < 1) { fprintf(stderr, "kernel_launch: occupancy query reports %d blocks per CU\n", per_cu); }
        (void)hipGetLastError();
        grid = 256;
        if (cus < 256) { fprintf(stderr, "kernel_launch: %d CUs < 256: the grid would not be resident; nothing launched\n", cus); grid = -1; return; }
    }
    if (grid < 0) return;
    if (hipMemsetAsync((char*)d_ws + WS_CTL, 0, CTL_ZERO_BYTES, stream) != hipSuccess) return;
    Args a{};
    for (int i = 0; i < 25; ++i) a.in[i] = (const float*)d_in[i];
    a.out = (float*)d_out; a.ws = (unsigned char*)d_ws; a.pad = 0;
#if MK_N_LAUNCHES == 1
    a.ph_lo = 0; a.ph_hi = NPHASE; a.li = 0;
    hipLaunchKernelGGL(fwd_kernel, dim3(grid), dim3(NTHREADS), LDS_BYTES, stream, a);
#else
    for (int p = 0; p < NPHASE; ++p) for (int rep = 0; rep <= DBL(p); ++rep) { a.ph_lo = p; a.ph_hi = p + 1; a.li = 0; a.pad = rep; hipLaunchKernelGGL(fwd_kernel, dim3(grid), dim3(NTHREADS), LDS_BYTES, stream, a); }
#endif
}
```
